# Optimizing an MI355X kernel written in HIP

```python
import math
import jax, jax.numpy as jnp
from jax import lax
import numpy as np

D_MODEL = 1024
BATCH = 8
SEQ = 2048
DEPTH = 1

RW_HEADS = 8
RW_HEAD_DIM = 64
RW_WIDTH = RW_HEADS * RW_HEAD_DIM
DECAY_LORA = 64
AAA_LORA = 64
GATE_LORA = 128
GN_EPS = 64e-5

NSA_HEADS = 8
NSA_KV_HEADS = 2
NSA_HEAD_DIM = 64
NSA_WIDTH = NSA_HEADS * NSA_HEAD_DIM
NSA_KV_WIDTH = NSA_KV_HEADS * NSA_HEAD_DIM
CMP_BLOCK = 32
CMP_STRIDE = 16
SEL_BLOCK = 64
N_SELECT = 8
WINDOW = 512
Q_BLOCK = 128
N_NSA_BRANCH = 3
FORCE_SCORE = 1e6
NEG_INF = -1e30

N_GROUPS = 4
EXPERTS_PER_GROUP = 8
N_EXPERTS = N_GROUPS * EXPERTS_PER_GROUP
TOP_K = 2
D_EXPERT = 512
ROW_BLOCK = 128

PLE_DIM = 256
NORM_EPS = 1e-6

RW_SIZES = (RW_WIDTH, RW_WIDTH, RW_WIDTH, DECAY_LORA, AAA_LORA, GATE_LORA)
REST_SIZES = (NSA_WIDTH, NSA_KV_WIDTH, NSA_KV_WIDTH, NSA_KV_WIDTH, NSA_KV_WIDTH,
              NSA_KV_WIDTH, NSA_KV_WIDTH, N_NSA_BRANCH * NSA_HEADS, D_MODEL, D_MODEL)
RW_IN = 3 * RW_WIDTH + DECAY_LORA + AAA_LORA + GATE_LORA
N_IN = RW_IN + NSA_WIDTH + 6 * NSA_KV_WIDTH + N_NSA_BRANCH * NSA_HEADS + 2 * D_MODEL

kernel_name = 'hybrid_rwkv7_nsa_hiermoe_block'


def _rmsnorm(x, g):
    xf = x.astype(jnp.float32)
    y = xf * lax.rsqrt(jnp.mean(xf * xf, axis=-1, keepdims=True) + NORM_EPS)
    return (y * g.astype(jnp.float32)).astype(x.dtype)


def _split(z, sizes):
    offs = np.cumsum(sizes)[:-1].tolist()
    return jnp.split(z, offs, axis=-1)


def _token_shift(z, mu):
    prev = jnp.pad(z, ((0, 0), (1, 0), (0, 0)))[:, :-1]
    return z + (prev - z) * mu


def _rwkv7_time_mix(zr, zk, zv, zw, za, zg, w0, w2, a0, a2, g2, k_k, k_a, r_k, ln_w, ln_b):
    B, S, _ = zr.shape
    f32 = jnp.float32
    heads = lambda t: t.reshape(B, S, RW_HEADS, RW_HEAD_DIM)
    tm = lambda t: jnp.moveaxis(t, 1, 0)
    w_raw = (w0 + jnp.tanh(zw) @ w2).astype(f32)
    decay = jnp.exp(-jnp.exp(-jax.nn.softplus(-w_raw) - 0.5))
    a = jax.nn.sigmoid((a0 + za @ a2).astype(f32))
    g = jax.nn.sigmoid(zg) @ g2
    kk = heads(zk * k_k).astype(f32)
    kk = kk / jnp.maximum(jnp.sqrt(jnp.sum(kk * kk, axis=-1, keepdims=True)), 1e-12)
    k = zk * (1 + (a - 1) * k_a)
    r_h, k_h, v_h = heads(zr).astype(f32), heads(k).astype(f32), heads(zv).astype(f32)
    a_h, w_h = heads(a), heads(decay)

    def step(state, inp):
        r_t, w_t, k_t, v_t, kk_t, a_t = inp
        sa = jnp.einsum('bhij,bhj->bhi', state, -kk_t)
        state = (state * w_t[:, :, None, :]
                 + sa[..., None] * (kk_t * a_t)[:, :, None, :]
                 + v_t[..., None] * k_t[:, :, None, :])
        return state, jnp.einsum('bhij,bhj->bhi', state, r_t)

    state0 = jnp.zeros((B, RW_HEADS, RW_HEAD_DIM, RW_HEAD_DIM), f32)
    _, o = lax.scan(step, state0, (tm(r_h), tm(w_h), tm(k_h), tm(v_h), tm(kk), tm(a_h)))
    o = jnp.moveaxis(o, 0, 1)
    mu = jnp.mean(o, axis=-1, keepdims=True)
    var = jnp.mean(jnp.square(o - mu), axis=-1, keepdims=True)
    o = ((o - mu) * lax.rsqrt(var + GN_EPS)).reshape(B, S, RW_WIDTH) * ln_w + ln_b
    bonus = jnp.sum(r_h * k_h * r_k, axis=-1, keepdims=True) * v_h
    o = (o + bonus.reshape(B, S, RW_WIDTH)) * g
    return o.astype(zr.dtype)


def _nsa(q, kc, vc, ks, vs, kw, vw, gate_logits, cmp_pos_k, cmp_pos_v,
         cmp_k_w1, cmp_k_w2, cmp_v_w1, cmp_v_w2, gate_b):
    B, S, _ = q.shape
    f32 = jnp.float32
    G, R, Dh = NSA_KV_HEADS, NSA_HEADS // NSA_KV_HEADS, NSA_HEAD_DIM
    out_dtype = q.dtype
    q = q.reshape(B, S, G, R, Dh).astype(f32) * (Dh ** -0.5)
    kv = lambda t: t.reshape(B, S, G, Dh).astype(f32)
    kc, vc, ks, vs, kw, vw = kv(kc), kv(vc), kv(ks), kv(vs), kv(kw), kv(vw)
    slopes = jnp.asarray((2.0 ** (-8.0 * np.arange(1, NSA_HEADS + 1) / NSA_HEADS))
                         .astype(np.float32).reshape(G, R))
    t_pos = jnp.arange(S)

    n_cmp = (S - CMP_BLOCK) // CMP_STRIDE + 1
    cmp_start = np.arange(n_cmp) * CMP_STRIDE
    win = cmp_start[:, None] + np.arange(CMP_BLOCK)[None, :]

    def compress(t, pos_emb, w1, w2):
        blocks = t[:, win] + pos_emb[None, None, :, None, :]
        blocks = jnp.moveaxis(blocks, 3, 2).reshape(B, n_cmp, G, CMP_BLOCK * Dh)
        return jax.nn.gelu(blocks @ w1.astype(f32)) @ w2.astype(f32)

    kcmp = compress(kc, cmp_pos_k.astype(f32), cmp_k_w1, cmp_k_w2)
    vcmp = compress(vc, cmp_pos_v.astype(f32), cmp_v_w1, cmp_v_w2)
    cmp_end = jnp.asarray(cmp_start + CMP_BLOCK - 1)
    cmp_ctr = jnp.asarray((cmp_start + 0.5 * (CMP_BLOCK - 1)).astype(np.float32))
    dist_c = t_pos.astype(f32)[:, None] - cmp_ctr[None, :]
    mask_c = cmp_end[None, :] <= t_pos[:, None]
    s_c = jnp.einsum('bqgrd,bjgd->bgrqj', q, kcmp) - slopes[..., None, None] * dist_c
    p_c = jax.nn.softmax(jnp.where(mask_c, s_c, NEG_INF), axis=-1) * mask_c
    o_cmp = jnp.einsum('bgrqj,bjgd->bqgrd', p_c, vcmp)

    n_sel = S // SEL_BLOCK
    n_pick = min(N_SELECT, n_sel)
    sel_start = np.arange(n_sel) * SEL_BLOCK
    overlap = np.clip(np.minimum(cmp_start[:, None] + CMP_BLOCK, sel_start[None, :] + SEL_BLOCK)
                      - np.maximum(cmp_start[:, None], sel_start[None, :]), 0, None) / CMP_BLOCK
    imp = jnp.einsum('bgrqj,jk->bgqk', p_c, jnp.asarray(overlap.astype(np.float32)))
    blk_t = (t_pos // SEL_BLOCK)[:, None]
    sel_blk = jnp.arange(n_sel)[None, :]
    forced = (sel_blk == 0) | (sel_blk == blk_t) | (sel_blk == blk_t - 1)
    imp = jnp.where(forced, FORCE_SCORE, jnp.where(sel_blk <= blk_t, imp, -FORCE_SCORE))
    _, sel_idx = lax.top_k(imp, n_pick)

    ks_blocks = jnp.moveaxis(ks.reshape(B, n_sel, SEL_BLOCK, G, Dh), 3, 1)
    vs_blocks = jnp.moveaxis(vs.reshape(B, n_sel, SEL_BLOCK, G, Dh), 3, 1)
    kw_pad = jnp.pad(kw, ((0, 0), (WINDOW, 0), (0, 0), (0, 0)))
    vw_pad = jnp.pad(vw, ((0, 0), (WINDOW, 0), (0, 0), (0, 0)))
    bidx = jnp.arange(B)[:, None, None, None]
    gidx = jnp.arange(G)[None, :, None, None]
    n_keys = n_pick * SEL_BLOCK

    def query_block(i):
        qs = i * Q_BLOCK
        qb = lax.dynamic_slice_in_dim(q, qs, Q_BLOCK, axis=1)
        tq = qs + jnp.arange(Q_BLOCK)
        idx = lax.dynamic_slice_in_dim(sel_idx, qs, Q_BLOCK, axis=2)
        kg = ks_blocks[bidx, gidx, idx].reshape(B, G, Q_BLOCK, n_keys, Dh)
        vg = vs_blocks[bidx, gidx, idx].reshape(B, G, Q_BLOCK, n_keys, Dh)
        kpos = (idx[..., None] * SEL_BLOCK + jnp.arange(SEL_BLOCK)).reshape(B, G, Q_BLOCK, n_keys)
        dist = (tq[None, None, :, None] - kpos)[:, :, None]
        s = (jnp.einsum('bqgrd,bgqkd->bgrqk', qb, kg)
             - slopes[None, :, :, None, None] * dist.astype(f32))
        p = jax.nn.softmax(jnp.where(dist >= 0, s, NEG_INF), axis=-1)
        o_sel = jnp.einsum('bgrqk,bgqkd->bqgrd', p, vg)
        kwb = lax.dynamic_slice_in_dim(kw_pad, qs, Q_BLOCK + WINDOW, axis=1)
        vwb = lax.dynamic_slice_in_dim(vw_pad, qs, Q_BLOCK + WINDOW, axis=1)
        kp = qs - WINDOW + jnp.arange(Q_BLOCK + WINDOW)
        dw = tq[:, None] - kp[None, :]
        mw = (dw >= 0) & (dw < WINDOW) & (kp[None, :] >= 0)
        sw = jnp.einsum('bqgrd,bkgd->bgrqk', qb, kwb) - slopes[..., None, None] * dw.astype(f32)
        pw = jax.nn.softmax(jnp.where(mw, sw, NEG_INF), axis=-1)
        o_win = jnp.einsum('bgrqk,bkgd->bqgrd', pw, vwb)
        return o_sel, o_win

    o_sel, o_win = lax.map(query_block, jnp.arange(S // Q_BLOCK))
    o_sel = jnp.moveaxis(o_sel, 0, 1).reshape(B, S, G, R, Dh)
    o_win = jnp.moveaxis(o_win, 0, 1).reshape(B, S, G, R, Dh)

    gate = jax.nn.sigmoid((gate_logits + gate_b).astype(f32)).reshape(B, S, G, R, N_NSA_BRANCH)
    o = gate[..., 0:1] * o_cmp + gate[..., 1:2] * o_sel + gate[..., 2:3] * o_win
    return o.reshape(B, S, NSA_WIDTH).astype(out_dtype)


def _hier_moe(h, w_group, b_group, w_router, b_router, w_gate_up, w_down):
    B, S, D = h.shape
    T = B * S
    A = T * TOP_K
    f32 = jnp.float32
    hf = h.reshape(T, D)
    g_logits = (hf @ w_group).astype(f32) + b_group
    g_sel = jnp.argmax(g_logits, axis=-1)
    p_group = jnp.take_along_axis(jax.nn.softmax(g_logits, axis=-1), g_sel[:, None], axis=1)
    e_logits = ((hf @ w_router).astype(f32) + b_router).reshape(T, N_GROUPS, EXPERTS_PER_GROUP)
    e_logits = jnp.take_along_axis(e_logits, g_sel[:, None, None], axis=1)[:, 0]
    top_p, top_i = lax.top_k(jax.nn.softmax(e_logits, axis=-1), TOP_K)
    gate = p_group * top_p / jnp.sum(top_p, axis=-1, keepdims=True)
    expert = g_sel[:, None] * EXPERTS_PER_GROUP + top_i

    e_flat = expert.reshape(A)
    order = jnp.argsort(e_flat)
    e_sorted = e_flat[order]
    tok_sorted = order // TOP_K
    counts = jnp.bincount(e_flat, length=N_EXPERTS)
    starts = jnp.cumsum(counts) - counts
    padded = (counts + ROW_BLOCK - 1) // ROW_BLOCK * ROW_BLOCK
    pends = jnp.cumsum(padded)
    dest = (pends - padded)[e_sorted] + jnp.arange(A) - starts[e_sorted]
    n_rows = A + N_EXPERTS * ROW_BLOCK
    n_blk = n_rows // ROW_BLOCK
    rows = jnp.zeros((n_rows, D), h.dtype).at[dest].set(hf[tok_sorted])
    blk_expert = jnp.minimum(jnp.searchsorted(pends, jnp.arange(n_blk) * ROW_BLOCK, side='right'),
                             N_EXPERTS - 1)

    def expert_block(args):
        xb, e = args
        gate_h, up_h = jnp.split(xb @ w_gate_up[e], 2, axis=-1)
        return (jax.nn.silu(gate_h) * up_h) @ w_down[e]

    out_rows = lax.map(expert_block, (rows.reshape(n_blk, ROW_BLOCK, D), blk_expert)).reshape(n_rows, D)
    contrib = out_rows[dest].astype(f32) * gate.reshape(A)[order][:, None]
    y = jax.ops.segment_sum(contrib, tok_sorted, num_segments=T)
    return y.astype(h.dtype).reshape(B, S, D)


def setup_inputs(seed: int = 0) -> dict:
    key = jax.random.key(seed)
    keys = iter(jax.random.split(key, 48))
    f32 = jnp.float32
    nrm = lambda shape, scale: jax.random.normal(next(keys), shape, f32) * scale
    gain = lambda shape: 1.0 + nrm(shape, 0.05)
    L, Dh = DEPTH, NSA_HEAD_DIM
    return {
        'x': nrm((BATCH, SEQ, D_MODEL), 1.0),
        'p': nrm((DEPTH, BATCH, SEQ, PLE_DIM), 1.0),
        'g_mix': gain((L, D_MODEL)),
        'w_in': nrm((L, D_MODEL, N_IN), D_MODEL ** -0.5),
        'mu_shift': jax.random.uniform(next(keys), (L, RW_IN), f32, 0.1, 0.9),
        'rw_w0': jax.random.uniform(next(keys), (L, RW_WIDTH), f32, -6.0, 1.0),
        'rw_w2': nrm((L, DECAY_LORA, RW_WIDTH), 0.1 * DECAY_LORA ** -0.5),
        'rw_a0': nrm((L, RW_WIDTH), 0.1),
        'rw_a2': nrm((L, AAA_LORA, RW_WIDTH), 0.3 * AAA_LORA ** -0.5),
        'rw_g2': nrm((L, GATE_LORA, RW_WIDTH), GATE_LORA ** -0.5),
        'rw_k_k': 0.85 + nrm((L, RW_WIDTH), 0.05),
        'rw_k_a': 1.0 + nrm((L, RW_WIDTH), 0.05),
        'rw_r_k': nrm((L, RW_HEADS, RW_HEAD_DIM), 0.1),
        'rw_ln_w': gain((L, RW_WIDTH)),
        'rw_ln_b': nrm((L, RW_WIDTH), 0.02),
        'cmp_pos_k': nrm((L, CMP_BLOCK, Dh), 0.1),
        'cmp_pos_v': nrm((L, CMP_BLOCK, Dh), 0.1),
        'cmp_k_w1': nrm((L, CMP_BLOCK * Dh, Dh), (CMP_BLOCK * Dh) ** -0.5),
        'cmp_k_w2': nrm((L, Dh, Dh), Dh ** -0.5),
        'cmp_v_w1': nrm((L, CMP_BLOCK * Dh, Dh), (CMP_BLOCK * Dh) ** -0.5),
        'cmp_v_w2': nrm((L, Dh, Dh), Dh ** -0.5),
        'nsa_gate_b': nrm((L, N_NSA_BRANCH * NSA_HEADS), 0.1),
        'w_up_rwkv': nrm((L, RW_WIDTH, D_MODEL), RW_WIDTH ** -0.5),
        'w_up_nsa': nrm((L, NSA_WIDTH, D_MODEL), NSA_WIDTH ** -0.5),
        'w_out': nrm((L, D_MODEL, D_MODEL), D_MODEL ** -0.5),
        'g_ffn': gain((L, D_MODEL)),
        'w_group': nrm((L, D_MODEL, N_GROUPS), D_MODEL ** -0.5),
        'b_group': nrm((L, N_GROUPS), 0.01),
        'w_router': nrm((L, D_MODEL, N_EXPERTS), D_MODEL ** -0.5),
        'b_router': nrm((L, N_EXPERTS), 0.01),
        'w_exp_gate_up': nrm((L, N_EXPERTS, D_MODEL, 2 * D_EXPERT), D_MODEL ** -0.5),
        'w_exp_down': nrm((L, N_EXPERTS, D_EXPERT, D_MODEL), D_EXPERT ** -0.5),
        'w_ple_proj': nrm((L, PLE_DIM, D_MODEL), PLE_DIM ** -0.5),
        'g_ple_norm': gain((L, D_MODEL)),
        'g_ple_gate_in': gain((L, D_MODEL)),
        'w_ple_gate': nrm((L, D_MODEL, D_MODEL), D_MODEL ** -0.5),
        'g_final': gain((D_MODEL,)),
    }


def reference(x, p, g_mix, w_in, mu_shift, rw_w0, rw_w2, rw_a0, rw_a2, rw_g2, rw_k_k, rw_k_a,
              rw_r_k, rw_ln_w, rw_ln_b, cmp_pos_k, cmp_pos_v, cmp_k_w1, cmp_k_w2, cmp_v_w1,
              cmp_v_w2, nsa_gate_b, w_up_rwkv, w_up_nsa, w_out, g_ffn, w_group, b_group,
              w_router, b_router, w_exp_gate_up, w_exp_down, w_ple_proj, g_ple_norm,
              g_ple_gate_in, w_ple_gate, g_final):
    for i in range(DEPTH):
        h = _rmsnorm(x, g_mix[i])
        z = h @ w_in[i]
        zr, zk, zv, zw, za, zg = _split(_token_shift(z[..., :RW_IN], mu_shift[i]), RW_SIZES)
        zq, zkc, zvc, zks, zvs, zkw, zvw, zgate, zmr, zmn = _split(z[..., RW_IN:], REST_SIZES)
        y_rw = _rwkv7_time_mix(zr, zk, zv, zw, za, zg, rw_w0[i], rw_w2[i], rw_a0[i], rw_a2[i],
                               rw_g2[i], rw_k_k[i], rw_k_a[i], rw_r_k[i], rw_ln_w[i], rw_ln_b[i])
        y_nsa = _nsa(zq, zkc, zvc, zks, zvs, zkw, zvw, zgate, cmp_pos_k[i], cmp_pos_v[i],
                     cmp_k_w1[i], cmp_k_w2[i], cmp_v_w1[i], cmp_v_w2[i], nsa_gate_b[i])
        mixed = (jax.nn.sigmoid(zmr) * (y_rw @ w_up_rwkv[i])
                 + jax.nn.sigmoid(zmn) * (y_nsa @ w_up_nsa[i]))
        x = x + mixed @ w_out[i]
        x = x + _hier_moe(_rmsnorm(x, g_ffn[i]), w_group[i], b_group[i], w_router[i],
                          b_router[i], w_exp_gate_up[i], w_exp_down[i])
        e = _rmsnorm(p[i] @ w_ple_proj[i], g_ple_norm[i])
        x = x + jax.nn.sigmoid(_rmsnorm(x, g_ple_gate_in[i]) @ w_ple_gate[i]) * e
    return _rmsnorm(x, g_final)
```

```cpp
#include <hip/hip_runtime.h>
#include <hip/hip_cooperative_groups.h>
#include <cstdio>
#include <cstdint>
namespace cg = cooperative_groups;

namespace pg8 {
#define PG8_LAS __attribute__((address_space(3)))
typedef unsigned short bf16_t;
typedef short bf16x8 __attribute__((ext_vector_type(8)));
typedef float f32x4 __attribute__((ext_vector_type(4)));
typedef unsigned u32x4 __attribute__((ext_vector_type(4)));
typedef unsigned u32x2 __attribute__((ext_vector_type(2)));
constexpr int BM = 256, BK = 64, HALF = 128, HTB = HALF * BK * 2  , STAGE_BYTES = 8 * HTB, NXCD = 8, WGM = 8;

__host__ __device__ __forceinline__ int lds_byte(int r, int c) { const int st = (r >> 4) * 2 + (c >> 5), rr = r & 15, cc = c & 31, ob = rr * 64 + cc * 2; return st * 1024 + (ob ^ (((ob >> 9) & 1) << 5)); }
__host__ __device__ __forceinline__ void stage_rc(int b, int& R, int& C) { const int st = b / 1024, sb = b % 1024, swz = sb ^ (((sb >> 9) & 1) << 5); R = (st >> 1) * 16 + swz / 64; C = (st & 1) * 32 + (swz % 64) / 2; }
__host__ __device__ __forceinline__ int perm32(int rho) { const int n = rho >> 4, i = rho & 15; return 8 * (i >> 2) + 4 * n + (i & 3); }

struct Unit { int pm, pn, pmo, lt, nvalid, pnl; };
struct Gemm { const bf16_t* A; const bf16_t* Bt; int M, N, K; const int* rowidx; };

struct StaticOrder {
    int nM, nN, nwg, G, c;
    __host__ __device__ void init(int M, int N, int G_, int c_) { nM = M / BM; nN = N / BM; nwg = nM * nN; G = G_; c = c_; }
    __host__ __device__ bool next(int i, Unit& u) const {
        const long L = (long)i * G + c; if (L >= nwg) return false;
        int wgid = (int)L; { const int q = nwg / NXCD, r = nwg % NXCD, xcd = wgid % NXCD, off = wgid / NXCD; wgid = (xcd < r ? xcd * (q + 1) : r * (q + 1) + (xcd - r) * q) + off; }
        const int nig = WGM * nN, gid = wgid / nig, fm = gid * WGM, gsz = (nM - fm) < WGM ? (nM - fm) : WGM;
        u.pm = fm + ((wgid % nig) % gsz); u.pn = (wgid % nig) / gsz; u.pmo = u.pm; u.lt = u.pm; u.nvalid = 256; u.pnl = u.pn; return true;
    }
};
struct MoeOrder {
    const unsigned* cnt; int G, c; bool a_is_out;
    __device__ bool next(int i, Unit& u) const {
        const int L = i * G + c; const int tile = L >> 2, pnl = L & 3;
        int acc = 0;
        for (int e = 0; e < 32; ++e) { const int ce = (int)cnt[e]; const int nt = (ce + 255) >> 8;
            if (tile < acc + nt) { const int rt = tile - acc; u.pmo = tile; u.pm = a_is_out ? tile : 0; u.lt = e * 64 + rt; u.pn = e * 4 + pnl; u.pnl = pnl; const int rem = ce - rt * 256; u.nvalid = rem < 256 ? rem : 256; return true; }
            acc += nt; }
        return false;
    }
};

__device__ __forceinline__ unsigned cvt_pk_bf16(float lo, float hi) { unsigned r; asm volatile("v_cvt_pk_bf16_f32 %0, %1, %2" : "=v"(r) : "v"(lo), "v"(hi)); return r; }

template <class Epi, class Sched, bool ALIGN_EPI, bool GATHER>
__device__ __forceinline__ void gemm_phase(PG8_LAS unsigned char* lds, const Gemm g, const Sched& S, const Epi& E) {
    const int tid = threadIdx.x, wid = __builtin_amdgcn_readfirstlane(tid >> 6), lane = tid & 63, wr = wid >> 2, wc = wid & 3, fr = lane & 15, fq = lane >> 4;
    int K_ = g.K; asm volatile("" : "+s"(K_));
    const int K = K_, nt = K / BK;
    unsigned voffB[2]; int RA[2], CA[2];
#pragma unroll
    for (int i = 0; i < 2; ++i) { int R, C; stage_rc(tid * 16 + i * 8192, R, C); const int Rb = Epi::PERM ? ((R & ~31) + perm32(R & 31)) : R;
        RA[i] = R; CA[i] = C; voffB[i] = (unsigned)(Rb * K + C) * 2u; }
    const size_t kstep = (size_t)(BK * 2);
    const size_t hstep = (size_t)HALF * K * 2;
    const size_t tstep = 2 * hstep;
    const unsigned ldsw = (unsigned)wid * 1024u;
    const int aoff = lds_byte(wr * 64 + fr, fq * 8), boff = lds_byte(wc * 32 + fr, fq * 8);
    unsigned vA[2][2], vN[2][2];
    auto compute_v = [&](const Unit& u, unsigned (&v)[2][2]) {
#pragma unroll
        for (int h = 0; h < 2; ++h)
#pragma unroll
            for (int i = 0; i < 2; ++i) {
                const int rl = h * HALF + RA[i];
                if constexpr (GATHER) { int tok = 0; if (rl < u.nvalid) tok = g.rowidx[(size_t)u.lt * 256 + rl] >> 1; v[h][i] = ((unsigned)tok * (unsigned)K + (unsigned)CA[i]) * 2u; }
                else v[h][i] = ((unsigned)rl * (unsigned)K + (unsigned)CA[i]) * 2u;
            }
    };
#define PG8_SA(b, h) (((b) * 2 + (h)) * HTB)
#define PG8_SB(b, h) ((4 + (b) * 2 + (h)) * HTB)
#define PG8_STAGE(bufoff, gbase, voff) do { _Pragma("unroll") for (int _i = 0; _i < 2; ++_i) \
        __builtin_amdgcn_global_load_lds((const unsigned*)((const char*)(gbase) + (voff)[_i]), (PG8_LAS unsigned*)(lds + (bufoff) + ldsw + _i * 8192), 16, 0, 0); } while (0)
#define PG8_LDA(dst, b, h) do { _Pragma("unroll") for (int m = 0; m < 4; ++m) _Pragma("unroll") for (int k = 0; k < 2; ++k) dst[m][k] = *(const PG8_LAS bf16x8*)(lds + PG8_SA(b, h) + aoff + m * 2048 + k * 1024); } while (0)
#define PG8_LDB(dst, b, h) do { _Pragma("unroll") for (int n = 0; n < 2; ++n) _Pragma("unroll") for (int k = 0; k < 2; ++k) dst[n][k] = *(const PG8_LAS bf16x8*)(lds + PG8_SB(b, h) + boff + n * 2048 + k * 1024); } while (0)
#define PG8_MMA(ai, bj, At, Bt) do { __builtin_amdgcn_s_setprio(1); _Pragma("unroll") for (int m = 0; m < 4; ++m) _Pragma("unroll") for (int n = 0; n < 2; ++n) _Pragma("unroll") for (int k = 0; k < 2; ++k) \
        acc[ai][bj][m][n] = __builtin_amdgcn_mfma_f32_16x16x32_bf16(Bt[n][k], At[m][k], acc[ai][bj][m][n], 0, 0, 0); __builtin_amdgcn_s_setprio(0); } while (0)
#define PG8_WAIT_V(n) asm volatile("s_waitcnt vmcnt(" #n ")" ::: "memory")
#define PG8_WAIT_L(n) asm volatile("s_waitcnt lgkmcnt(" #n ")" ::: "memory")
#define PG8_BAR __builtin_amdgcn_s_barrier()
#define PG8_SCHED __builtin_amdgcn_sched_barrier(0)
    Unit cur, nxt; int ui = 0;
    if (!S.next(0, cur)) return;
    f32x4 acc[2][2][4][2];
#pragma unroll
    for (int a = 0; a < 2; ++a)
#pragma unroll
        for (int b = 0; b < 2; ++b)
#pragma unroll
            for (int m = 0; m < 4; ++m)
#pragma unroll
                for (int n = 0; n < 2; ++n) acc[a][b][m][n] = (f32x4){0.f, 0.f, 0.f, 0.f};
    bf16x8 At[4][2], B0[2][2], B1[2][2];
    compute_v(cur, vA);
    const char* cA = (const char*)g.A + (GATHER ? (size_t)0 : (size_t)cur.pm * tstep); const char* cB = (const char*)g.Bt + (size_t)cur.pn * tstep;
    PG8_STAGE(PG8_SB(0, 0), cB, voffB); PG8_STAGE(PG8_SB(0, 1), cB + hstep, voffB); PG8_STAGE(PG8_SA(0, 0), cA, vA[0]); PG8_STAGE(PG8_SA(0, 1), cA, vA[1]);
    if (wr == 1) PG8_BAR;
    PG8_WAIT_V(2); PG8_BAR;
    PG8_STAGE(PG8_SB(1, 0), cB + kstep, voffB); PG8_STAGE(PG8_SA(1, 0), cA + kstep, vA[0]); PG8_STAGE(PG8_SB(1, 1), cB + hstep + kstep, voffB);
    PG8_WAIT_V(6); PG8_BAR;
    for (;;) {
        const bool has_next = S.next(ui + 1, nxt);
        if (has_next) compute_v(nxt, vN);
        else {
#pragma unroll
            for (int h = 0; h < 2; ++h)
#pragma unroll
                for (int i = 0; i < 2; ++i) vN[h][i] = vA[h][i];
        }
        const char* nA = has_next ? ((const char*)g.A + (GATHER ? (size_t)0 : (size_t)nxt.pm * tstep)) : cA; const char* nB = has_next ? (const char*)g.Bt + (size_t)nxt.pn * tstep : cB;
#pragma unroll 1
        for (int t = 0; t < nt; t += 2) {
            const bool last = (t == nt - 2);
            const char* a1 = cA + (size_t)(t + 1) * kstep;
            const char* a2 = last ? nA : cA + (size_t)(t + 2) * kstep; const char* b2 = last ? nB : cB + (size_t)(t + 2) * kstep;
            const char* a3 = a2 + kstep; const char* b3 = b2 + kstep;
            unsigned vX0[2], vX1[2];
#pragma unroll
            for (int i = 0; i < 2; ++i) { vX0[i] = last ? vN[0][i] : vA[0][i]; vX1[i] = last ? vN[1][i] : vA[1][i]; }
            PG8_LDB(B0, 0, 0); PG8_LDB(B1, 0, 1); PG8_SCHED; PG8_LDA(At, 0, 0); PG8_STAGE(PG8_SA(1, 1), a1, vA[1]);
            PG8_WAIT_V(8); PG8_WAIT_L(0); PG8_BAR; PG8_MMA(0, 0, At, B0); PG8_MMA(0, 1, At, B1); PG8_BAR; PG8_SCHED;
            PG8_LDA(At, 0, 1); PG8_STAGE(PG8_SB(0, 0), b2, voffB); PG8_STAGE(PG8_SB(0, 1), b2 + hstep, voffB); PG8_STAGE(PG8_SA(0, 0), a2, vX0);
            PG8_WAIT_V(8); PG8_WAIT_L(0); PG8_BAR; PG8_MMA(1, 0, At, B0); PG8_MMA(1, 1, At, B1); PG8_BAR; PG8_SCHED;
            PG8_LDB(B0, 1, 0); PG8_LDB(B1, 1, 1); PG8_SCHED; PG8_LDA(At, 1, 0); PG8_STAGE(PG8_SA(0, 1), a2, vX1);
            PG8_WAIT_V(8); PG8_WAIT_L(0); PG8_BAR; PG8_MMA(0, 0, At, B0); PG8_MMA(0, 1, At, B1); PG8_BAR; PG8_SCHED;
            PG8_LDA(At, 1, 1); PG8_STAGE(PG8_SB(1, 0), b3, voffB); PG8_STAGE(PG8_SB(1, 1), b3 + hstep, voffB); PG8_STAGE(PG8_SA(1, 0), a3, vX0);
            PG8_WAIT_V(8); PG8_WAIT_L(0); PG8_BAR; PG8_MMA(1, 0, At, B0); PG8_MMA(1, 1, At, B1); PG8_BAR; PG8_SCHED;
        }
        if constexpr (ALIGN_EPI) { if (wr == 0) PG8_BAR; }
        E(acc, cur, wr, wc, fr, fq);
        if (!has_next) break;
#pragma unroll
        for (int a = 0; a < 2; ++a)
#pragma unroll
            for (int b = 0; b < 2; ++b)
#pragma unroll
                for (int m = 0; m < 4; ++m)
#pragma unroll
                    for (int n = 0; n < 2; ++n) acc[a][b][m][n] = (f32x4){0.f, 0.f, 0.f, 0.f};
        cur = nxt; cA = nA; cB = nB; ++ui;
#pragma unroll
        for (int h = 0; h < 2; ++h)
#pragma unroll
            for (int i = 0; i < 2; ++i) vA[h][i] = vN[h][i];
        if constexpr (ALIGN_EPI) { if (wr == 1) PG8_BAR; }
    }
    PG8_WAIT_V(0);
    if constexpr (!ALIGN_EPI) { if (wr == 0) PG8_BAR; }
    PG8_BAR;
#undef PG8_SA
#undef PG8_SB
#undef PG8_STAGE
#undef PG8_LDA
#undef PG8_LDB
#undef PG8_MMA
#undef PG8_WAIT_V
#undef PG8_WAIT_L
#undef PG8_BAR
#undef PG8_SCHED
}
}

constexpr int NWAVES = 8;
constexpr int M = 16384, D = 1024, SEQ = 2048, NBATCH = 8;
constexpr int NIN = 5144;
constexpr int NZ = 5120;
constexpr int ZC_R = 0, ZC_K = 512, ZC_V = 1024, ZC_W = 1536, ZC_Q = 1792, ZC_KC = 2304, ZC_VC = 2432, ZC_KS = 2560, ZC_VS = 2688, ZC_KW = 2816, ZC_VW = 2944, ZC_MR = 3072, ZC_MN = 4096;
constexpr float NORM_EPS = 1e-6f, GN_EPS = 64e-5f;

constexpr size_t MiB = 1u << 20;
constexpr size_t WS_CTL = 0, CTL_ZERO_BYTES = 64 * 1024;
constexpr size_t WS_LIST = 1 * MiB;
constexpr size_t WS_GATEA = 3 * MiB;
constexpr size_t WS_RSE = 4 * MiB;
constexpr size_t WS_SLOTA = 4 * MiB + 512 * 1024;
constexpr size_t WS_SELMASK = 5 * MiB;
constexpr size_t WS_ZGATE = 6 * MiB;
constexpr size_t WS_SMALLW = 8 * MiB;
constexpr size_t SW_W2T = 0, SW_A2T = 65536, SW_G2T = 131072, SW_CK1 = 262144, SW_CV1 = 524288, SW_CK2 = 786432, SW_CV2 = 794624, SW_GATEW = 802816, SW_ROUTEW = 868352;
constexpr size_t WS_KCMP = 10 * MiB;
constexpr size_t WS_VST = 11 * MiB, WS_VWT = 15 * MiB;
constexpr size_t WS_WIN = 19 * MiB, WS_UR = 29 * MiB, WS_UN = 30 * MiB, WS_WO = 31 * MiB, WS_WPP = 33 * MiB, WS_WPG = 34 * MiB, WS_WGU = 36 * MiB, WS_WD = 100 * MiB;
constexpr size_t WS_XN = 132 * MiB;
constexpr size_t WS_PBF = 164 * MiB;
constexpr size_t WS_Z = 172 * MiB;
constexpr size_t WS_S = 332 * MiB;
constexpr size_t WS_YRW = 428 * MiB, WS_YB = 444 * MiB, WS_G = 492 * MiB, WS_END = 508 * MiB;
constexpr int CW_CNT = 0;

constexpr int LDS_BYTES = 147456;

#define GAS __attribute__((address_space(1)))
#define LAS __attribute__((address_space(3)))
typedef unsigned short bf16;
typedef unsigned v4u __attribute__((ext_vector_type(4)));
typedef unsigned v2u __attribute__((ext_vector_type(2)));
typedef float f32x4 __attribute__((ext_vector_type(4)));
typedef float f32x2 __attribute__((ext_vector_type(2)));
typedef short bf16x8 __attribute__((ext_vector_type(8)));
typedef short bf16x4 __attribute__((ext_vector_type(4)));
typedef __bf16 bf16x2_t __attribute__((ext_vector_type(2)));
#define LDS_WAIT() asm volatile("s_waitcnt lgkmcnt(0)" ::: "memory")
#define MFMA16(a, b, c) __builtin_amdgcn_mfma_f32_16x16x32_bf16((a), (b), (c), 0, 0, 0)

__device__ __forceinline__ float bf2f(unsigned short v) { return __uint_as_float((unsigned)v << 16); }
__device__ __forceinline__ unsigned pk2(float lo, float hi) { f32x2 v = {lo, hi}; bf16x2_t b = __builtin_convertvector(v, bf16x2_t); return __builtin_bit_cast(unsigned, b); }
__device__ __forceinline__ v2u pk4(f32x4 v) { v2u r; r.x = pk2(v.x, v.y); r.y = pk2(v.z, v.w); return r; }
__device__ __forceinline__ f32x4 unpk4(v2u w) { f32x4 r; r.x = __uint_as_float(w.x << 16); r.y = __uint_as_float(w.x & 0xffff0000u); r.z = __uint_as_float(w.y << 16); r.w = __uint_as_float(w.y & 0xffff0000u); return r; }
__device__ __forceinline__ void unpk8(v4u w, float (&f)[8]) { f[0] = __uint_as_float(w.x << 16); f[1] = __uint_as_float(w.x & 0xffff0000u); f[2] = __uint_as_float(w.y << 16); f[3] = __uint_as_float(w.y & 0xffff0000u);
    f[4] = __uint_as_float(w.z << 16); f[5] = __uint_as_float(w.z & 0xffff0000u); f[6] = __uint_as_float(w.w << 16); f[7] = __uint_as_float(w.w & 0xffff0000u); }
__device__ __forceinline__ float sigmoidf_(float x) { return __builtin_amdgcn_rcpf(1.0f + __expf(-x)); }
__device__ __forceinline__ float wave_sum(float v) {
#pragma unroll
    for (int o = 1; o < 64; o <<= 1) v += __shfl_xor(v, o);
    return v;
}
template <int CTRL> __device__ __forceinline__ float dppf(float x) { return __builtin_bit_cast(float, __builtin_amdgcn_update_dpp(0, __builtin_bit_cast(int, x), CTRL, 0xf, 0xf, false)); }
__device__ __forceinline__ float row16_sum(float x) { x += dppf<0x128>(x); x += dppf<0x124>(x); x += dppf<0x122>(x); x += dppf<0x121>(x); return x; }

struct Args { const float* in[37]; float* out; unsigned char* ws; int ph_lo, ph_hi; };
typedef __attribute__((address_space(4))) const Args* ArgsP;
struct Frame {
    LAS unsigned char* lds;
    int tid, lane, wave, vcu, G, gw, NGW;
    unsigned char* ws;
    ArgsP ap;
    float* out;
};

template <class RowF>
__device__ __forceinline__ void tr_item(const float* W, int K, int ld, int ncols, LAS float* scr, int item, int lane, RowF rowptr) {
    const int nblk = (ncols + 31) / 32, kb = item / nblk, nb = item % nblk, k0 = 64 * kb, n0 = 32 * nb;
    const int nn = n0 + (lane & 31);
#pragma unroll 8
    for (int i = 0; i < 32; ++i) { const int kk = 2 * i + (lane >> 5); scr[kk * 33 + (lane & 31)] = (nn < ncols) ? W[(size_t)(k0 + kk) * ld + nn] : 0.f; }
    LDS_WAIT(); asm volatile("" ::: "memory");
    const int c = lane & 7;
#pragma unroll
    for (int j = 0; j < 4; ++j) { const int nl = (lane >> 3) + 8 * j, n = n0 + nl; const LAS float* s = scr + (8 * c) * 33 + nl;
        v4u o; o.x = pk2(s[0 * 33], s[1 * 33]); o.y = pk2(s[2 * 33], s[3 * 33]); o.z = pk2(s[4 * 33], s[5 * 33]); o.w = pk2(s[6 * 33], s[7 * 33]);
        if (n < ncols) { bf16* rp = rowptr(n); if (rp) *(v4u*)(rp + k0 + 8 * c) = o; } }
    LDS_WAIT(); asm volatile("" ::: "memory");
}
__device__ __forceinline__ void rms_row_to_bf16(int lane, const float* xrow, const float* gain, bf16* orow) {
    const f32x4* xr = (const f32x4*)xrow + lane; const f32x4* gr = (const f32x4*)gain + lane;
    f32x4 v[4]; float s = 0.f;
#pragma unroll
    for (int j = 0; j < 4; ++j) { v[j] = xr[64 * j]; s += (v[j].x * v[j].x + v[j].y * v[j].y) + (v[j].z * v[j].z + v[j].w * v[j].w); }
    const float rs = 1.0f / sqrtf(wave_sum(s) * (1.f / D) + NORM_EPS);
    v2u* o8 = (v2u*)orow + lane;
#pragma unroll
    for (int j = 0; j < 4; ++j) { const f32x4 g = gr[64 * j]; o8[64 * j] = pk4(v[j] * rs * g); }
}

__device__ __forceinline__ void p0_prologue(Frame& F) {
    LAS float* scr = (LAS float*)(F.lds + F.wave * 16384);
    unsigned char* ws = F.ws;
    const float* w_in = F.ap->in[3];
    bf16* gateWT = (bf16*)(ws + WS_SMALLW + SW_GATEW);
    constexpr int I_WIN = 16 * 161, I_UR = 8 * 32, I_WO = 16 * 32, I_WPP = 4 * 32, I_L64 = 16, I_L128 = 32, I_C1 = 32 * 2, I_C2 = 2, I_GU = 16 * 32, I_DN = 8 * 32;
    constexpr int E0 = I_WIN, E1 = E0 + I_UR, E2 = E1 + I_UR, E3 = E2 + I_WO, E4 = E3 + I_WPP, E5 = E4 + I_WO, E6 = E5 + I_L64, E7 = E6 + I_L64, E8 = E7 + I_L128, E9 = E8 + I_C1, E10 = E9 + I_C1, E11 = E10 + I_C2, E12 = E11 + I_C2,
                  E13 = E12 + 32 * I_GU, NITEMS = E13 + 32 * I_DN;
    for (int it = F.gw; it < NITEMS; it += F.NGW) {
        const float* W; int K, ld, nc, item, mode = 0; size_t dst;
        if (it < E0) { W = w_in; K = 1024; ld = NIN; nc = NIN; item = it; mode = 1; dst = WS_WIN; }
        else if (it < E1) { W = F.ap->in[22]; K = 512; ld = 1024; nc = 1024; item = it - E0; dst = WS_UR; }
        else if (it < E2) { W = F.ap->in[23]; K = 512; ld = 1024; nc = 1024; item = it - E1; dst = WS_UN; }
        else if (it < E3) { W = F.ap->in[24]; K = 1024; ld = 1024; nc = 1024; item = it - E2; dst = WS_WO; }
        else if (it < E4) { W = F.ap->in[32]; K = 256; ld = 1024; nc = 1024; item = it - E3; dst = WS_WPP; }
        else if (it < E5) { W = F.ap->in[35]; K = 1024; ld = 1024; nc = 1024; item = it - E4; dst = WS_WPG; }
        else if (it < E6) { W = F.ap->in[6]; K = 64; ld = 512; nc = 512; item = it - E5; dst = WS_SMALLW + SW_W2T; }
        else if (it < E7) { W = F.ap->in[8]; K = 64; ld = 512; nc = 512; item = it - E6; dst = WS_SMALLW + SW_A2T; }
        else if (it < E8) { W = F.ap->in[9]; K = 128; ld = 512; nc = 512; item = it - E7; dst = WS_SMALLW + SW_G2T; }
        else if (it < E9) { W = F.ap->in[17]; K = 2048; ld = 64; nc = 64; item = it - E8; dst = WS_SMALLW + SW_CK1; }
        else if (it < E10) { W = F.ap->in[19]; K = 2048; ld = 64; nc = 64; item = it - E9; dst = WS_SMALLW + SW_CV1; }
        else if (it < E11) { W = F.ap->in[18]; K = 64; ld = 64; nc = 64; item = it - E10; dst = WS_SMALLW + SW_CK2; }
        else if (it < E12) { W = F.ap->in[20]; K = 64; ld = 64; nc = 64; item = it - E11; dst = WS_SMALLW + SW_CV2; }
        else if (it < E13) { const int r = it - E12, e = r / I_GU; W = F.ap->in[30] + (size_t)e * 1024 * 1024; K = 1024; ld = 1024; nc = 1024; item = r % I_GU; mode = 2; dst = WS_WGU + (size_t)e * 1024 * 1024 * 2; }
        else { const int r = it - E13, e = r / I_DN; W = F.ap->in[31] + (size_t)e * 512 * 1024; K = 512; ld = 1024; nc = 1024; item = r % I_DN; dst = WS_WD + (size_t)e * 1024 * 512 * 2; }
        bf16* T = (bf16*)(ws + dst);
        tr_item(W, K, ld, nc, scr, item, F.lane, [&](int n) -> bf16* {
            if (mode == 1) return n < 3072 ? T + (size_t)n * 1024 : (n < 3096 ? gateWT + (size_t)(n - 3072) * 1024 : T + (size_t)(n - 24) * 1024);
            if (mode == 2) { const int n2 = n & 511; return T + (size_t)((n2 >> 7) * 256 + (n >> 9) * 128 + (n2 & 127)) * 1024; }
            return T + (size_t)n * K; });
    }
    for (int m = F.gw; m < M; m += F.NGW) rms_row_to_bf16(F.lane, F.ap->in[0] + (size_t)m * D, F.ap->in[2], (bf16*)(ws + WS_XN) + (size_t)m * D);
    {
        float* RW = (float*)(ws + WS_SMALLW + SW_ROUTEW); const float* gf = F.ap->in[25]; const float* wg = F.ap->in[26]; const float* wr = F.ap->in[28];
        for (int idx = F.gw * 64 + F.lane; idx < 48 * 1024; idx += F.NGW * 64) { const int c = idx >> 10, k = idx & 1023; float v = 0.f;
            if (c < 4) v = wg[k * 4 + c]; else if (c < 36) v = wr[k * 32 + (c - 4)];
            RW[idx] = v * gf[k]; }
        for (int idx = F.gw * 64 + F.lane; idx < 8 * 1024; idx += F.NGW * 64) gateWT[24 * 1024 + idx] = 0;
    }
}

struct EpiStoreBf16 {
    static constexpr bool PERM = true;
    bf16* O; int ldc;
    __device__ __forceinline__ void operator()(const f32x4 (&acc)[2][2][4][2], const pg8::Unit& u, int wr, int wc, int fr, int fq) const {
        const int row0 = u.pmo * 256 + wr * 64 + fr, col0 = u.pnl * 256 + wc * 32 + 8 * fq;
#pragma unroll
        for (int ai = 0; ai < 2; ++ai)
#pragma unroll
            for (int m = 0; m < 4; ++m) { bf16* rowp = O + (size_t)(row0 + ai * 128 + m * 16) * ldc + col0;
#pragma unroll
                for (int bj = 0; bj < 2; ++bj) { const f32x4 v0 = acc[ai][bj][m][0], v1 = acc[ai][bj][m][1]; v4u w; w.x = pk2(v0[0], v0[1]); w.y = pk2(v0[2], v0[3]); w.z = pk2(v1[0], v1[1]); w.w = pk2(v1[2], v1[3]);
                    *(v4u*)(rowp + bj * 128) = w; } }
    }
};
#define EPI_LOOP_BEGIN \
    _Pragma("unroll") for (int ai = 0; ai < 2; ++ai) _Pragma("unroll") for (int m = 0; m < 4; ++m) { const int rl = ai * 128 + wr * 64 + m * 16 + fr; const size_t row = (size_t)u.pmo * 256 + rl; (void)row; \
    _Pragma("unroll") for (int bj = 0; bj < 2; ++bj) _Pragma("unroll") for (int n = 0; n < 2; ++n) { const int col = u.pnl * 256 + bj * 128 + wc * 32 + n * 16 + 4 * fq; (void)col; const f32x4 a = acc[ai][bj][m][n];
#define EPI_LOOP_END } asm volatile("" ::: "memory"); }
struct EpiMix {
    static constexpr bool PERM = false;
    const bf16* z; float* A; bf16* O;
    __device__ __forceinline__ void operator()(const f32x4 (&acc)[2][2][4][2], const pg8::Unit& u, int wr, int wc, int fr, int fq) const {
        const int zc = u.lt ? ZC_MN : ZC_MR;
        EPI_LOOP_BEGIN
            const f32x4 zz = unpk4(*(const v2u*)(z + row * NZ + zc + col)); f32x4 o;
            o.x = sigmoidf_(zz.x) * a.x; o.y = sigmoidf_(zz.y) * a.y; o.z = sigmoidf_(zz.z) * a.z; o.w = sigmoidf_(zz.w) * a.w;
            if (u.lt == 0) *(f32x4*)(A + row * D + col) = o;
            else { o = o + *(const f32x4*)(A + row * D + col); *(v2u*)(O + row * D + col) = pk4(o); }
        EPI_LOOP_END
    }
};
struct DualOrder {
    pg8::StaticOrder S;
    __device__ bool next(int i, pg8::Unit& u) const { if (i >= 2) return false; if (!S.next(0, u)) return false; if (i == 1) { u.pm += 64; u.pn += 4; } u.lt = i; return true; }
};
struct EpiResF32 {
    static constexpr bool PERM = false;
    const float* base; float* O;
    __device__ __forceinline__ void operator()(const f32x4 (&acc)[2][2][4][2], const pg8::Unit& u, int wr, int wc, int fr, int fq) const {
        EPI_LOOP_BEGIN
            *(f32x4*)(O + row * D + col) = *(const f32x4*)(base + row * D + col) + a;
        EPI_LOOP_END
    }
};
struct EpiMoe1 {
    static constexpr bool PERM = false;
    bf16* H;
    __device__ __forceinline__ void operator()(const f32x4 (&acc)[2][2][4][2], const pg8::Unit& u, int wr, int wc, int fr, int fq) const {
#pragma unroll
        for (int ai = 0; ai < 2; ++ai)
#pragma unroll
            for (int m = 0; m < 4; ++m) { const size_t row = (size_t)u.pmo * 256 + ai * 128 + wr * 64 + m * 16 + fr;
#pragma unroll
                for (int n = 0; n < 2; ++n) { const f32x4 gt = acc[ai][0][m][n], up = acc[ai][1][m][n]; f32x4 o;
                    o.x = gt.x * sigmoidf_(gt.x) * up.x; o.y = gt.y * sigmoidf_(gt.y) * up.y; o.z = gt.z * sigmoidf_(gt.z) * up.z; o.w = gt.w * sigmoidf_(gt.w) * up.w;
                    *(v2u*)(H + row * 512 + u.pnl * 128 + wc * 32 + n * 16 + 4 * fq) = pk4(o); } }
    }
};
struct EpiPle {
    static constexpr bool PERM = false;
    const float* x2; const bf16* Eraw; const float* rse; const float* gpn; float* O;
    __device__ __forceinline__ void operator()(const f32x4 (&acc)[2][2][4][2], const pg8::Unit& u, int wr, int wc, int fr, int fq) const {
        EPI_LOOP_BEGIN
            const f32x4 e = unpk4(*(const v2u*)(Eraw + row * D + col)); const f32x4 g = *(const f32x4*)(gpn + col); const float rs = rse[row]; f32x4 o = *(const f32x4*)(x2 + row * D + col);
            o.x += sigmoidf_(a.x) * e.x * rs * g.x; o.y += sigmoidf_(a.y) * e.y * rs * g.y; o.z += sigmoidf_(a.z) * e.z * rs * g.z; o.w += sigmoidf_(a.w) * e.w * rs * g.w;
            *(f32x4*)(O + row * D + col) = o;
        EPI_LOOP_END
    }
};

__device__ __forceinline__ float gelu_tanh(float x) { const float u = 0.7978845608028654f * (x + 0.044715f * x * x * x); const float t = 1.0f - 2.0f * __builtin_amdgcn_rcpf(__expf(2.0f * u) + 1.0f); return 0.5f * x * (1.0f + t); }

__device__ __forceinline__ void compress_task(Frame& F, int idx) {
    const int kv = idx & 1, tile8 = (idx >> 1) & 7, bg = idx >> 4, b = bg >> 1, g = bg & 1;
    const int fr = F.lane & 15, fq = F.lane >> 4;
    const bf16* z = (const bf16*)(F.ws + WS_Z);
    const bf16* w1T = (const bf16*)(F.ws + WS_SMALLW + (kv ? SW_CV1 : SW_CK1));
    const bf16* w2T = (const bf16*)(F.ws + WS_SMALLW + (kv ? SW_CV2 : SW_CK2));
    const float* pos = kv ? F.ap->in[16] : F.ap->in[15];
    const int j0 = 16 * tile8; int j = j0 + fr; const bool jvalid = j < 127; if (!jvalid) j = 126;
    const bf16* zb = z + ((size_t)b * SEQ + 16 * j) * NZ + (kv ? ZC_VC : ZC_KC) + g * 64;
    f32x4 acc[4];
#pragma unroll
    for (int mt = 0; mt < 4; ++mt) acc[mt] = (f32x4){0.f, 0.f, 0.f, 0.f};
#pragma unroll 2
    for (int ks = 0; ks < 64; ++ks) {
        const int l = ks >> 1, d = 32 * (ks & 1) + 8 * fq;
        const v4u zr = *(const v4u*)(zb + (size_t)l * NZ + d);
        const f32x4 p0 = *(const f32x4*)(pos + l * 64 + d), p1 = *(const f32x4*)(pos + l * 64 + d + 4);
        float f[8]; unpk8(zr, f);
        v4u bb; bb.x = pk2(f[0] + p0.x, f[1] + p0.y); bb.y = pk2(f[2] + p0.z, f[3] + p0.w); bb.z = pk2(f[4] + p1.x, f[5] + p1.y); bb.w = pk2(f[6] + p1.z, f[7] + p1.w);
        const bf16x8 bop = __builtin_bit_cast(bf16x8, bb);
#pragma unroll
        for (int mt = 0; mt < 4; ++mt) { const bf16x8 aop = *(const bf16x8*)(w1T + (size_t)(16 * mt + fr) * 2048 + 32 * ks + 8 * fq); acc[mt] = MFMA16(aop, bop, acc[mt]); }
    }
    bf16x8 hb[2];
#pragma unroll
    for (int s2 = 0; s2 < 2; ++s2) { v4u w; const f32x4 a0 = acc[2 * s2], a1 = acc[2 * s2 + 1];
        w.x = pk2(gelu_tanh(a0.x), gelu_tanh(a0.y)); w.y = pk2(gelu_tanh(a0.z), gelu_tanh(a0.w)); w.z = pk2(gelu_tanh(a1.x), gelu_tanh(a1.y)); w.w = pk2(gelu_tanh(a1.z), gelu_tanh(a1.w));
        hb[s2] = __builtin_bit_cast(bf16x8, w); }
    bf16* kcmp = (bf16*)(F.ws + WS_KCMP); bf16* vcmpT = (bf16*)(F.ws + WS_KCMP + 512 * 1024);
#pragma unroll
    for (int ntl = 0; ntl < 4; ++ntl) {
        f32x4 o = (f32x4){0.f, 0.f, 0.f, 0.f};
#pragma unroll
        for (int s2 = 0; s2 < 2; ++s2) { const bf16* wp = w2T + (size_t)(16 * ntl + fr) * 64 + 32 * s2 + 4 * fq; const v2u lo = *(const v2u*)wp, hi = *(const v2u*)(wp + 16);
            v4u aw; aw.x = lo.x; aw.y = lo.y; aw.z = hi.x; aw.w = hi.y; o = MFMA16(__builtin_bit_cast(bf16x8, aw), hb[s2], o); }
        if (!jvalid) o = (f32x4){0.f, 0.f, 0.f, 0.f};
        const int jj = j0 + fr, n = 16 * ntl + 4 * fq;
        if (kv == 0) *(v2u*)(kcmp + ((size_t)bg * 128 + jj) * 64 + n) = pk4(o);
        else { const v2u w = pk4(o); bf16* vp = vcmpT + ((size_t)bg * 64 + n) * 128 + jj; vp[0] = (bf16)(w.x & 0xffff); vp[128] = (bf16)(w.x >> 16); vp[256] = (bf16)(w.y & 0xffff); vp[384] = (bf16)(w.y >> 16); }
    }
}
__device__ __forceinline__ void zgate_task(Frame& F, int tile) {
    const int fr = F.lane & 15, fq = F.lane >> 4, m0 = tile * 16;
    const bf16* XN = (const bf16*)(F.ws + WS_XN); const bf16* gw = (const bf16*)(F.ws + WS_SMALLW + SW_GATEW);
    f32x4 acc[2] = {(f32x4){0.f, 0.f, 0.f, 0.f}, (f32x4){0.f, 0.f, 0.f, 0.f}};
#pragma unroll 4
    for (int ks = 0; ks < 32; ++ks) {
        const bf16x8 bop = *(const bf16x8*)(XN + (size_t)(m0 + fr) * D + 32 * ks + 8 * fq);
#pragma unroll
        for (int ct = 0; ct < 2; ++ct) { const bf16x8 aop = *(const bf16x8*)(gw + (size_t)(16 * ct + fr) * D + 32 * ks + 8 * fq); acc[ct] = MFMA16(aop, bop, acc[ct]); }
    }
    float* zg = (float*)(F.ws + WS_ZGATE);
#pragma unroll
    for (int ct = 0; ct < 2; ++ct) *(f32x4*)(zg + (size_t)(m0 + fr) * 32 + 16 * ct + 4 * fq) = acc[ct];
}
__device__ __forceinline__ void vt_task(Frame& F, int idx) {
    const int which = idx & 1, blk = (idx >> 1) & 31, bg = idx >> 6, b = bg >> 1, g = bg & 1;
    const bf16* z = (const bf16*)(F.ws + WS_Z);
    bf16* vT = (bf16*)(F.ws + (which ? WS_VWT : WS_VST));
    const int t = 64 * blk + F.lane;
    const bf16* src = z + ((size_t)b * SEQ + t) * NZ + (which ? ZC_VW : ZC_VS) + g * 64;
#pragma unroll
    for (int dc = 0; dc < 8; ++dc) { const v4u w = *(const v4u*)(src + 8 * dc); bf16* dst = vT + ((size_t)bg * 64 + 8 * dc) * SEQ + t;
        dst[0 * SEQ] = (bf16)(w.x & 0xffff); dst[1 * SEQ] = (bf16)(w.x >> 16); dst[2 * SEQ] = (bf16)(w.y & 0xffff); dst[3 * SEQ] = (bf16)(w.y >> 16);
        dst[4 * SEQ] = (bf16)(w.z & 0xffff); dst[5 * SEQ] = (bf16)(w.z >> 16); dst[6 * SEQ] = (bf16)(w.w & 0xffff); dst[7 * SEQ] = (bf16)(w.w >> 16); }
}
__device__ __forceinline__ void alora_task(Frame& F, int m) {
    const bf16* z = (const bf16*)(F.ws + WS_Z); bf16* AL = (bf16*)(F.ws + WS_PBF);
    const int l = F.lane, t = m & (SEQ - 1);
    const f32x4 cur = unpk4(*(const v2u*)(z + (size_t)m * NZ + ZC_W + 4 * l));
    f32x4 prev = (f32x4){0.f, 0.f, 0.f, 0.f}; if (t > 0) prev = unpk4(*(const v2u*)(z + (size_t)(m - 1) * NZ + ZC_W + 4 * l));
    const f32x4 mu = *(const f32x4*)(F.ap->in[4] + ZC_W + 4 * l);
    f32x4 s = cur + (prev - cur) * mu;
    if (l < 16) { s.x = tanhf(s.x); s.y = tanhf(s.y); s.z = tanhf(s.z); s.w = tanhf(s.w); }
    else if (l >= 32) { s.x = sigmoidf_(s.x); s.y = sigmoidf_(s.y); s.z = sigmoidf_(s.z); s.w = sigmoidf_(s.w); }
    *(v2u*)(AL + (size_t)m * 256 + 4 * l) = pk4(s);
}
__device__ __forceinline__ void p2_prep(Frame& F) {
    constexpr int T0 = 256, T1 = T0 + 1024, T2 = T1 + 1024, T3 = T2 + M;
    for (int task = F.gw; task < T3; task += F.NGW) {
        if (task < T0) compress_task(F, task);
        else if (task < T1) zgate_task(F, task - T0);
        else if (task < T2) vt_task(F, task - T1);
        else alora_task(F, task - T2);
    }
}

__device__ __forceinline__ void rwkv_prep_task(Frame& F, int task) {
    const int h = task & 7, m0 = (task >> 3) * 16, fr = F.lane & 15, fq = F.lane >> 4, m = m0 + fr, t = m & (SEQ - 1);
    const bf16* z = (const bf16*)(F.ws + WS_Z); const bf16* AL = (const bf16*)(F.ws + WS_PBF);
    const bf16* w2T = (const bf16*)(F.ws + WS_SMALLW + SW_W2T); const bf16* a2T = (const bf16*)(F.ws + WS_SMALLW + SW_A2T); const bf16* g2T = (const bf16*)(F.ws + WS_SMALLW + SW_G2T);
    bf16* scanin = (bf16*)(F.ws + WS_S); bf16* vbuf = (bf16*)(F.ws + WS_S + 80 * MiB); bf16* gbuf = (bf16*)(F.ws + WS_G);
    bf16x8 bw[2], ba[2], bgf[4];
    const bf16* alr = AL + (size_t)m * 256 + 8 * fq;
#pragma unroll
    for (int ks = 0; ks < 2; ++ks) { bw[ks] = *(const bf16x8*)(alr + 32 * ks); ba[ks] = *(const bf16x8*)(alr + 64 + 32 * ks); }
#pragma unroll
    for (int ks = 0; ks < 4; ++ks) bgf[ks] = *(const bf16x8*)(alr + 128 + 32 * ks);
    const float* mu = F.ap->in[4]; const float* w0 = F.ap->in[5]; const float* a0 = F.ap->in[7]; const float* k_k = F.ap->in[10]; const float* k_a = F.ap->in[11];
    float kkraw[4][4], av[4][4], zkv[4][4];
    float ss = 0.f;
#pragma unroll
    for (int n = 0; n < 4; ++n) {
        const int c0 = h * 64 + 16 * n;
        f32x4 accw = (f32x4){0.f, 0.f, 0.f, 0.f}, acca = accw, accg = accw;
#pragma unroll
        for (int ks = 0; ks < 2; ++ks) { accw = MFMA16(*(const bf16x8*)(w2T + (size_t)(c0 + fr) * 64 + 32 * ks + 8 * fq), bw[ks], accw); acca = MFMA16(*(const bf16x8*)(a2T + (size_t)(c0 + fr) * 64 + 32 * ks + 8 * fq), ba[ks], acca); }
#pragma unroll
        for (int ks = 0; ks < 4; ++ks) accg = MFMA16(*(const bf16x8*)(g2T + (size_t)(c0 + fr) * 128 + 32 * ks + 8 * fq), bgf[ks], accg);
        const int c = c0 + 4 * fq;
        const bf16* zc = z + (size_t)m * NZ + c; const bf16* zp = zc - NZ;
        f32x4 zr = unpk4(*(const v2u*)(zc + ZC_R)), zk = unpk4(*(const v2u*)(zc + ZC_K)), zv = unpk4(*(const v2u*)(zc + ZC_V));
        f32x4 pr = (f32x4){0.f, 0.f, 0.f, 0.f}, pk = pr, pv = pr;
        if (t > 0) { pr = unpk4(*(const v2u*)(zp + ZC_R)); pk = unpk4(*(const v2u*)(zp + ZC_K)); pv = unpk4(*(const v2u*)(zp + ZC_V)); }
        zr = zr + (pr - zr) * *(const f32x4*)(mu + ZC_R + c); zk = zk + (pk - zk) * *(const f32x4*)(mu + ZC_K + c); zv = zv + (pv - zv) * *(const f32x4*)(mu + ZC_V + c);
        const f32x4 w0v = *(const f32x4*)(w0 + c), a0v = *(const f32x4*)(a0 + c), kkv = *(const f32x4*)(k_k + c);
        f32x4 ev;
#pragma unroll
        for (int r = 0; r < 4; ++r) {
            const float x = -(w0v[r] + accw[r]);
            const float sp = fmaxf(x, 0.f) + __logf(1.0f + __expf(-fabsf(x)));
            ev[r] = __expf(-sp - 0.5f);
            av[n][r] = sigmoidf_(a0v[r] + acca[r]);
            zkv[n][r] = zk[r]; kkraw[n][r] = zk[r] * kkv[r]; ss += kkraw[n][r] * kkraw[n][r];
        }
        bf16* sp_ = scanin + ((size_t)m * 8 + h) * 320 + 16 * n + 4 * fq;
        *(v2u*)(sp_ + 0) = pk4(zr); *(v2u*)(sp_ + 64) = pk4(ev);
        *(v2u*)(vbuf + (size_t)m * 512 + c) = pk4(zv);
        *(v2u*)(gbuf + (size_t)m * 512 + c) = pk4(accg);
    }
    ss += __shfl_xor(ss, 16); ss += __shfl_xor(ss, 32);
    const float inv = 1.0f / fmaxf(sqrtf(ss), 1e-12f);
#pragma unroll
    for (int n = 0; n < 4; ++n) {
        const int c = h * 64 + 16 * n + 4 * fq; const f32x4 kav = *(const f32x4*)(k_a + c);
        f32x4 kp, kk, kka;
#pragma unroll
        for (int r = 0; r < 4; ++r) { kk[r] = kkraw[n][r] * inv; kka[r] = kk[r] * av[n][r]; kp[r] = zkv[n][r] * (1.0f + (av[n][r] - 1.0f) * kav[r]); }
        bf16* sp_ = scanin + ((size_t)m * 8 + h) * 320 + 16 * n + 4 * fq;
        *(v2u*)(sp_ + 128) = pk4(kp); *(v2u*)(sp_ + 192) = pk4(kk); *(v2u*)(sp_ + 256) = pk4(kka);
    }
}

__device__ __forceinline__ float nsa_slope(int g, int r) { return __uint_as_float((unsigned)(127 - (g * 4 + r + 1)) << 23); }

__device__ __forceinline__ void nsa_cmp_task(Frame& F, int task) {
    const int tile = task & 127, bg = task >> 7, b = bg >> 1, g = bg & 1;
    const int fr = F.lane & 15, fq = F.lane >> 4, t = tile * 16 + fr, m = b * SEQ + t;
    const bf16* z = (const bf16*)(F.ws + WS_Z);
    const bf16* kcmp = (const bf16*)(F.ws + WS_KCMP) + (size_t)bg * 128 * 64; const bf16* vcmpT = (const bf16*)(F.ws + WS_KCMP + 512 * 1024) + (size_t)bg * 64 * 128;
    const float* zg = (const float*)(F.ws + WS_ZGATE); const float* gb = F.ap->in[21];
    bf16* Y = (bf16*)(F.ws + WS_YB);
    const int tv = t - 31 - 64 * fq; const float tb = (float)t - 15.5f - 64.0f * (float)fq;
    float impl[8], imp3[8];
#pragma unroll
    for (int kt = 0; kt < 8; ++kt) { impl[kt] = 0.f; imp3[kt] = 0.f; }
#pragma unroll 1
    for (int r = 0; r < 4; ++r) {
        const float slope = nsa_slope(g, r);
        const bf16* qp = z + (size_t)m * NZ + ZC_Q + (g * 4 + r) * 64 + 8 * fq;
        const bf16x8 q0 = *(const bf16x8*)qp, q1 = *(const bf16x8*)(qp + 32);
        float s[8][4]; float mx = -1e30f;
#pragma unroll
        for (int kt = 0; kt < 8; ++kt) {
            const bf16* kp = kcmp + (size_t)(16 * kt + fr) * 64 + 8 * fq;
            f32x4 a = (f32x4){0.f, 0.f, 0.f, 0.f};
            a = MFMA16(*(const bf16x8*)kp, q0, a); a = MFMA16(*(const bf16x8*)(kp + 32), q1, a);
#pragma unroll
            for (int rg = 0; rg < 4; ++rg) { const bool valid = ((256 * kt + 16 * rg) <= tv);
                const float sc = a[rg] * 0.125f - slope * (tb - (float)(256 * kt + 16 * rg)); s[kt][rg] = valid ? sc : -1e30f; mx = fmaxf(mx, s[kt][rg]); }
            if (kt & 1) asm volatile("" ::: "memory");
        }
        mx = fmaxf(mx, __shfl_xor(mx, 16)); mx = fmaxf(mx, __shfl_xor(mx, 32));
        float sum = 0.f;
#pragma unroll
        for (int kt = 0; kt < 8; ++kt)
#pragma unroll
            for (int rg = 0; rg < 4; ++rg) { const float p = (s[kt][rg] > -1e29f) ? __expf(s[kt][rg] - mx) : 0.f; s[kt][rg] = p; sum += p; }
        sum += __shfl_xor(sum, 16); sum += __shfl_xor(sum, 32);
        const float inv = sum > 0.f ? 1.0f / sum : 0.f;
#pragma unroll
        for (int kt = 0; kt < 8; ++kt) {
#pragma unroll
            for (int rg = 0; rg < 4; ++rg) s[kt][rg] *= inv;
            impl[kt] += s[kt][0] + s[kt][1] + s[kt][2] + 0.5f * s[kt][3]; imp3[kt] += s[kt][3]; }
        f32x4 o[4];
#pragma unroll
        for (int dt = 0; dt < 4; ++dt) o[dt] = (f32x4){0.f, 0.f, 0.f, 0.f};
#pragma unroll
        for (int s2 = 0; s2 < 4; ++s2) {
            v4u pw; pw.x = pk2(s[2 * s2][0], s[2 * s2][1]); pw.y = pk2(s[2 * s2][2], s[2 * s2][3]); pw.z = pk2(s[2 * s2 + 1][0], s[2 * s2 + 1][1]); pw.w = pk2(s[2 * s2 + 1][2], s[2 * s2 + 1][3]);
            const bf16x8 pb = __builtin_bit_cast(bf16x8, pw);
#pragma unroll
            for (int dt = 0; dt < 4; ++dt) { const bf16* vp = vcmpT + (size_t)(16 * dt + fr) * 128 + 32 * s2 + 4 * fq; const v2u lo = *(const v2u*)vp, hi = *(const v2u*)(vp + 16);
                v4u aw; aw.x = lo.x; aw.y = lo.y; aw.z = hi.x; aw.w = hi.y; o[dt] = MFMA16(__builtin_bit_cast(bf16x8, aw), pb, o[dt]); }
            asm volatile("" ::: "memory");
        }
        const int hh = g * 4 + r; const float gate = sigmoidf_(zg[(size_t)m * 32 + hh * 3 + 0] + gb[hh * 3 + 0]);
#pragma unroll
        for (int dt = 0; dt < 4; ++dt) *(v2u*)(Y + (size_t)m * 512 + hh * 64 + 16 * dt + 4 * fq) = pk4(o[dt] * gate);
    }
    LAS float* sc = (LAS float*)(F.lds + F.wave * 4096);
    float y3prev = 0.f;
#pragma unroll
    for (int kt = 0; kt < 8; ++kt) {
        const float y3 = __shfl(imp3[kt], (F.lane + 48) & 63);
        const float prev = (fq > 0) ? y3 : y3prev; y3prev = y3;
        sc[fr * 33 + 4 * kt + fq] = impl[kt] + 0.5f * prev;
    }
    LDS_WAIT(); __builtin_amdgcn_wave_barrier(); asm volatile("" ::: "memory");
    const int blk_t = t >> 6, chi = blk_t - 2;
    unsigned mask = 1u | (1u << blk_t) | (blk_t > 0 ? (1u << (blk_t - 1)) : 0u);
#pragma unroll
    for (int kt = 0; kt < 8; ++kt) {
        const int k = 4 * kt + fq;
        if (k >= 1 && k <= chi) { const float me = sc[fr * 33 + k]; int rank = 0;
            for (int k2 = 1; k2 <= chi; ++k2) { const float o = sc[fr * 33 + k2]; rank += (o > me || (o == me && k2 < k)) ? 1 : 0; }
            if (rank < 5) mask |= (1u << k); }
    }
    mask |= (unsigned)__shfl_xor((int)mask, 16); mask |= (unsigned)__shfl_xor((int)mask, 32);
    if (fq == 0) ((unsigned*)(F.ws + WS_SELMASK))[(size_t)bg * SEQ + t] = mask;
    LDS_WAIT(); __builtin_amdgcn_wave_barrier(); asm volatile("" ::: "memory");
}
__device__ __forceinline__ void p3_phase(Frame& F) {
    constexpr int T0 = 2048, T1 = T0 + 8192;
    for (int task = F.gw; task < T0; task += F.NGW) nsa_cmp_task(F, task);
    asm volatile("" ::: "memory");
    for (int task = F.gw; task < T1 - T0; task += F.NGW) rwkv_prep_task(F, task);
}

template <int WHICH>
__device__ __forceinline__ void nsa_blk_task(Frame& F, int task) {
    const int hp = task & 1, tile = (task >> 1) & 127, bg = task >> 8, b = bg >> 1, g = bg & 1;
    const int fr = F.lane & 15, fq = F.lane >> 4, t0 = tile * 16, t = t0 + fr, m = b * SEQ + t;
    const bf16* z = (const bf16*)(F.ws + WS_Z);
    const bf16* Kb = z + (size_t)b * SEQ * NZ + (WHICH ? ZC_KW : ZC_KS) + g * 64;
    const bf16* VT = (const bf16*)(F.ws + (WHICH ? WS_VWT : WS_VST)) + (size_t)bg * 64 * SEQ;
    unsigned mymask, tile_or; const int kb_hi = (t0 + 15) >> 6;
    if (WHICH == 0) { mymask = ((const unsigned*)(F.ws + WS_SELMASK))[(size_t)bg * SEQ + t]; unsigned x = mymask; x |= (unsigned)__shfl_xor((int)x, 1); x |= (unsigned)__shfl_xor((int)x, 2); x |= (unsigned)__shfl_xor((int)x, 4); x |= (unsigned)__shfl_xor((int)x, 8);
        tile_or = (unsigned)__builtin_amdgcn_readfirstlane((int)x); }
    else { mymask = 0xffffffffu; const int lo = (t0 - 511) > 0 ? ((t0 - 511) >> 6) : 0; tile_or = 0u; for (int k = lo; k <= kb_hi; ++k) tile_or |= (1u << k); }
    const int h0 = g * 4 + 2 * hp;
    bf16x8 qf[2][2];
#pragma unroll
    for (int r = 0; r < 2; ++r) { const bf16* qp = z + (size_t)m * NZ + ZC_Q + (h0 + r) * 64 + 8 * fq; qf[r][0] = *(const bf16x8*)qp; qf[r][1] = *(const bf16x8*)(qp + 32); }
    f32x4 O[2][4]; float mrun[2], lrun[2];
#pragma unroll
    for (int r = 0; r < 2; ++r) { mrun[r] = -1e30f; lrun[r] = 0.f;
#pragma unroll
        for (int dt = 0; dt < 4; ++dt) O[r][dt] = (f32x4){0.f, 0.f, 0.f, 0.f}; }
    const float slope0 = __uint_as_float((unsigned)(127 - (h0 + 1)) << 23);
    for (int kb = 0; kb <= kb_hi; ++kb) {
        if (!((tile_or >> kb) & 1u)) continue;
        const int kpos0 = 64 * kb;
        bf16x8 kf[4][2];
#pragma unroll
        for (int kt = 0; kt < 4; ++kt) { const bf16* kp = Kb + (size_t)(kpos0 + 16 * kt + fr) * NZ + 8 * fq; kf[kt][0] = *(const bf16x8*)kp; kf[kt][1] = *(const bf16x8*)(kp + 32); }
        const bool bsel = (mymask >> kb) & 1u; const int dbase = t - 4 * fq - kpos0;
        bf16x8 P[2][2];
#pragma unroll
        for (int r = 0; r < 2; ++r) {
            const float slope = r ? 0.5f * slope0 : slope0;
            float s[4][4]; float bm = -1e30f;
#pragma unroll
            for (int kt = 0; kt < 4; ++kt) { f32x4 a = (f32x4){0.f, 0.f, 0.f, 0.f}; a = MFMA16(kf[kt][0], qf[r][0], a); a = MFMA16(kf[kt][1], qf[r][1], a);
#pragma unroll
                for (int rg = 0; rg < 4; ++rg) { const int dist = dbase - (16 * kt + rg); const bool valid = bsel && dist >= 0 && (WHICH == 0 || dist < 512);
                    s[kt][rg] = valid ? (a[rg] * 0.125f - slope * (float)dist) : -1e30f; bm = fmaxf(bm, s[kt][rg]); } }
            bm = fmaxf(bm, __shfl_xor(bm, 16)); bm = fmaxf(bm, __shfl_xor(bm, 32));
            const float mnew = fmaxf(mrun[r], bm); const float scale = __expf(mrun[r] - mnew); mrun[r] = mnew;
            float ps = 0.f;
#pragma unroll
            for (int kt = 0; kt < 4; ++kt)
#pragma unroll
                for (int rg = 0; rg < 4; ++rg) { const float p = (s[kt][rg] > -1e29f) ? __expf(s[kt][rg] - mnew) : 0.f; s[kt][rg] = p; ps += p; }
            lrun[r] = lrun[r] * scale + ps;
#pragma unroll
            for (int dt = 0; dt < 4; ++dt) O[r][dt] = O[r][dt] * scale;
#pragma unroll
            for (int s2 = 0; s2 < 2; ++s2) { v4u pw; pw.x = pk2(s[2 * s2][0], s[2 * s2][1]); pw.y = pk2(s[2 * s2][2], s[2 * s2][3]); pw.z = pk2(s[2 * s2 + 1][0], s[2 * s2 + 1][1]); pw.w = pk2(s[2 * s2 + 1][2], s[2 * s2 + 1][3]);
                P[r][s2] = __builtin_bit_cast(bf16x8, pw); }
        }
#pragma unroll
        for (int dt = 0; dt < 4; ++dt)
#pragma unroll
            for (int s2 = 0; s2 < 2; ++s2) { const bf16* vp = VT + (size_t)(16 * dt + fr) * SEQ + kpos0 + 32 * s2 + 4 * fq; const v2u lo = *(const v2u*)vp, hi = *(const v2u*)(vp + 16);
                v4u aw; aw.x = lo.x; aw.y = lo.y; aw.z = hi.x; aw.w = hi.y; const bf16x8 vf = __builtin_bit_cast(bf16x8, aw);
#pragma unroll
                for (int r = 0; r < 2; ++r) O[r][dt] = MFMA16(vf, P[r][s2], O[r][dt]); }
    }
    const float* zg = (const float*)(F.ws + WS_ZGATE); const float* gb = F.ap->in[21];
    bf16* Y = (bf16*)(F.ws + WS_YB + (size_t)(1 + WHICH) * 16 * MiB);
#pragma unroll
    for (int r = 0; r < 2; ++r) { float l = lrun[r]; l += __shfl_xor(l, 16); l += __shfl_xor(l, 32);
        const int hh = h0 + r; const float gate = sigmoidf_(zg[(size_t)m * 32 + hh * 3 + 1 + WHICH] + gb[hh * 3 + 1 + WHICH]); const float f = gate / l;
#pragma unroll
        for (int dt = 0; dt < 4; ++dt) *(v2u*)(Y + (size_t)m * 512 + hh * 64 + 16 * dt + 4 * fq) = pk4(O[r][dt] * f); }
}
__device__ __forceinline__ void p4_phase(Frame& F) {
    for (int task = F.gw; task < 4096; task += F.NGW) nsa_blk_task<1>(F, task);
    asm volatile("" ::: "memory");
    for (int task = F.gw; task < 4096; task += F.NGW) nsa_blk_task<0>(F, task);
}

constexpr int SC_T = 32, SC_BUF_F = SC_T * 320 + SC_T * 16;
__device__ __forceinline__ void scan_load_chunk(Frame& F, int b, int h, int i0, int c, LAS float* buf) {
    const int lt = F.tid - 256;
    const bf16* scanin = (const bf16*)(F.ws + WS_S); const bf16* vbuf = (const bf16*)(F.ws + WS_S + 80 * MiB);
    const size_t mbase = (size_t)b * SEQ + (size_t)c * SC_T;
    v4u w[5];
#pragma unroll
    for (int i = 0; i < 5; ++i) { const int p = lt + 256 * i, step = p / 40, q = p % 40; w[i] = *(const v4u*)(scanin + ((mbase + step) * 8 + h) * 320 + q * 8); }
    v4u wv = (v4u){0u, 0u, 0u, 0u};
    if (lt < 64) { const int step = lt >> 1, half = lt & 1; wv = *(const v4u*)(vbuf + (mbase + step) * 512 + h * 64 + i0 + 8 * half); }
#pragma unroll
    for (int i = 0; i < 5; ++i) { const int p = lt + 256 * i, step = p / 40, q = p % 40; float f[8]; unpk8(w[i], f);
        if ((q >> 3) == 1) {
#pragma unroll
            for (int j = 0; j < 8; ++j) f[j] = __expf(-f[j]); }
        LAS float* d = buf + step * 320 + q * 8; *(LAS f32x4*)d = (f32x4){f[0], f[1], f[2], f[3]}; *(LAS f32x4*)(d + 4) = (f32x4){f[4], f[5], f[6], f[7]}; }
    if (lt < 64) { const int step = lt >> 1, half = lt & 1; float f[8]; unpk8(wv, f); LAS float* d = buf + SC_T * 320 + step * 16 + 8 * half; *(LAS f32x4*)d = (f32x4){f[0], f[1], f[2], f[3]}; *(LAS f32x4*)(d + 4) = (f32x4){f[4], f[5], f[6], f[7]}; }
}
__device__ __forceinline__ void p5_scan(Frame& F) {
    const int bh = F.vcu >> 2, b = bh >> 3, h = bh & 7, i0 = (F.vcu & 3) * 16;
    LAS float* ring = (LAS float*)F.lds;
    float* oraw = (float*)(F.ws + WS_XN);
    const bool loader = F.wave >= 4;
    if (loader) { scan_load_chunk(F, b, h, i0, 0, ring); scan_load_chunk(F, b, h, i0, 1, ring + SC_BUF_F); }
    LDS_WAIT(); __syncthreads();
    const int jq = F.lane & 15, il = 4 * F.wave + (F.lane >> 4);
    f32x4 S = (f32x4){0.f, 0.f, 0.f, 0.f};
    constexpr int NCH = SEQ / SC_T;
    for (int c = 0; c < NCH; ++c) {
        if (loader) { if (c + 2 < NCH) scan_load_chunk(F, b, h, i0, c + 2, ring + ((c + 2) % 3) * SC_BUF_F); }
        else {
            const LAS float* buf = ring + (c % 3) * SC_BUF_F;
            float* op = oraw + ((size_t)b * SEQ + (size_t)c * SC_T) * 512 + h * 64 + i0 + il;
#pragma unroll 4
            for (int st = 0; st < SC_T; ++st) {
                const LAS float* sp = buf + st * 320 + 4 * jq;
                const f32x4 r = *(const LAS f32x4*)(sp), w = *(const LAS f32x4*)(sp + 64), k = *(const LAS f32x4*)(sp + 128), kk = *(const LAS f32x4*)(sp + 192), kka = *(const LAS f32x4*)(sp + 256);
                const float v = buf[SC_T * 320 + st * 16 + il];
                float dot = (S.x * kk.x + S.y * kk.y) + (S.z * kk.z + S.w * kk.w);
                dot = row16_sum(dot);
                const float sa = -dot;
                S.x = S.x * w.x + (sa * kka.x + v * k.x); S.y = S.y * w.y + (sa * kka.y + v * k.y); S.z = S.z * w.z + (sa * kka.z + v * k.z); S.w = S.w * w.w + (sa * kka.w + v * k.w);
                float o = (S.x * r.x + S.y * r.y) + (S.z * r.z + S.w * r.w);
                o = row16_sum(o);
                if (jq == 0) op[(size_t)st * 512] = o;
            }
        }
        LDS_WAIT(); __syncthreads();
    }
}

__device__ __forceinline__ void p6_task(Frame& F, int m) {
    const int l = F.lane, c = 8 * l, h = l >> 3, i = c & 63;
    const float* oraw = (const float*)(F.ws + WS_XN) + (size_t)m * 512 + c;
    const bf16* scanin = (const bf16*)(F.ws + WS_S) + ((size_t)m * 8 + h) * 320 + i;
    const bf16* vbuf = (const bf16*)(F.ws + WS_S + 80 * MiB) + (size_t)m * 512 + c; const bf16* gbuf = (const bf16*)(F.ws + WS_G) + (size_t)m * 512 + c;
    float o[8]; { const f32x4 a = *(const f32x4*)oraw, b2 = *(const f32x4*)(oraw + 4); o[0] = a.x; o[1] = a.y; o[2] = a.z; o[3] = a.w; o[4] = b2.x; o[5] = b2.y; o[6] = b2.z; o[7] = b2.w; }
    float s = 0.f;
#pragma unroll
    for (int j = 0; j < 8; ++j) s += o[j];
    s += __shfl_xor(s, 1); s += __shfl_xor(s, 2); s += __shfl_xor(s, 4);
    const float mu = s * (1.f / 64.f); float q = 0.f;
#pragma unroll
    for (int j = 0; j < 8; ++j) { o[j] -= mu; q += o[j] * o[j]; }
    q += __shfl_xor(q, 1); q += __shfl_xor(q, 2); q += __shfl_xor(q, 4);
    const float rstd = 1.0f / sqrtf(q * (1.f / 64.f) + GN_EPS);
    float rr[8], kp[8], vv[8], gg[8];
    unpk8(*(const v4u*)(scanin), rr); unpk8(*(const v4u*)(scanin + 128), kp); unpk8(*(const v4u*)vbuf, vv); unpk8(*(const v4u*)gbuf, gg);
    const float* rk = F.ap->in[12] + h * 64 + i; const float* lw = F.ap->in[13] + c; const float* lb = F.ap->in[14] + c;
    float bs = 0.f;
#pragma unroll
    for (int j = 0; j < 8; ++j) bs += rr[j] * kp[j] * rk[j];
    bs += __shfl_xor(bs, 1); bs += __shfl_xor(bs, 2); bs += __shfl_xor(bs, 4);
    float y[8];
#pragma unroll
    for (int j = 0; j < 8; ++j) y[j] = (o[j] * rstd * lw[j] + lb[j] + bs * vv[j]) * gg[j];
    v4u w; w.x = pk2(y[0], y[1]); w.y = pk2(y[2], y[3]); w.z = pk2(y[4], y[5]); w.w = pk2(y[6], y[7]);
    *(v4u*)((bf16*)(F.ws + WS_YRW) + (size_t)m * 512 + c) = w;
    bf16* y0 = (bf16*)(F.ws + WS_YB) + (size_t)m * 512 + c; const bf16* y1 = y0 + 8 * MiB; const bf16* y2 = y0 + 16 * MiB;
    float a0[8], a1[8], a2[8]; unpk8(*(const v4u*)y0, a0); unpk8(*(const v4u*)y1, a1); unpk8(*(const v4u*)y2, a2);
    v4u w2; w2.x = pk2(a0[0] + a1[0] + a2[0], a0[1] + a1[1] + a2[1]); w2.y = pk2(a0[2] + a1[2] + a2[2], a0[3] + a1[3] + a2[3]); w2.z = pk2(a0[4] + a1[4] + a2[4], a0[5] + a1[5] + a2[5]); w2.w = pk2(a0[6] + a1[6] + a2[6], a0[7] + a1[7] + a2[7]);
    *(v4u*)y0 = w2;
}

__device__ __forceinline__ void route_task(Frame& F, int tile) {
    const int fr = F.lane & 15, fq = F.lane >> 4, m0 = tile * 16;
    const float* x1 = (const float*)(F.ws + WS_Z); const float* RW = (const float*)(F.ws + WS_SMALLW + SW_ROUTEW);
    f32x4 acc[3] = {(f32x4){0.f, 0.f, 0.f, 0.f}, (f32x4){0.f, 0.f, 0.f, 0.f}, (f32x4){0.f, 0.f, 0.f, 0.f}};
    float ssq = 0.f;
    const float* xp = x1 + (size_t)(m0 + fr) * D + fq; const float* wp = RW + (size_t)fr * D + fq;
#pragma unroll 8
    for (int ks = 0; ks < 256; ++ks) {
        const float bv = xp[4 * ks]; ssq += bv * bv;
#pragma unroll
        for (int ct = 0; ct < 3; ++ct) acc[ct] = __builtin_amdgcn_mfma_f32_16x16x4f32(wp[(size_t)ct * 16 * D + 4 * ks], bv, acc[ct], 0, 0, 0);
    }
    ssq += __shfl_xor(ssq, 16); ssq += __shfl_xor(ssq, 32);
    const float rs = 1.0f / sqrtf(ssq * (1.f / D) + NORM_EPS);
    LAS float* sc = (LAS float*)(F.lds + F.wave * 4096);
#pragma unroll
    for (int ct = 0; ct < 3; ++ct)
#pragma unroll
        for (int r = 0; r < 4; ++r) sc[fr * 49 + 16 * ct + 4 * fq + r] = acc[ct][r] * rs;
    if (fq == 0) sc[800 + fr] = rs;
    LDS_WAIT(); __builtin_amdgcn_wave_barrier(); asm volatile("" ::: "memory");
    if (F.lane < 16) {
        const int tok = m0 + F.lane; const LAS float* lg = sc + F.lane * 49;
        const float* bg = F.ap->in[27]; const float* br = F.ap->in[29];
        float gl[4]; int gs = 0; float gm = -3.0e38f;
#pragma unroll
        for (int c = 0; c < 4; ++c) { gl[c] = lg[c] + bg[c]; if (gl[c] > gm) { gm = gl[c]; gs = c; } }
        float gsum = 0.f;
#pragma unroll
        for (int c = 0; c < 4; ++c) gsum += __expf(gl[c] - gm);
        const float pgroup = 1.0f / gsum;
        float el[8]; float em = -3.0e38f;
#pragma unroll
        for (int c = 0; c < 8; ++c) { el[c] = lg[4 + gs * 8 + c] + br[gs * 8 + c]; em = fmaxf(em, el[c]); }
        int i1 = 0; float v1 = -3.0e38f;
#pragma unroll
        for (int c = 0; c < 8; ++c) if (el[c] > v1) { v1 = el[c]; i1 = c; }
        int i2 = 0; float v2 = -3.0e38f;
#pragma unroll
        for (int c = 0; c < 8; ++c) if (c != i1 && el[c] > v2) { v2 = el[c]; i2 = c; }
        const float p1 = __expf(v1 - em), p2 = __expf(v2 - em);
        const float g1 = pgroup * p1 / (p1 + p2), g2 = pgroup * p2 / (p1 + p2);
        unsigned* cnt = (unsigned*)(F.ws + WS_CTL) + CW_CNT; int* list = (int*)(F.ws + WS_LIST); float* gateA = (float*)(F.ws + WS_GATEA);
        const int e1 = gs * 8 + i1, e2 = gs * 8 + i2;
        unsigned* slotA = (unsigned*)(F.ws + WS_SLOTA);
        const unsigned q1 = atomicAdd(&cnt[e1], 1u); list[(size_t)e1 * 16384 + q1] = tok * 2 + 0; gateA[tok * 2 + 0] = g1; slotA[tok * 2 + 0] = ((unsigned)e1 << 16) | q1;
        const unsigned q2 = atomicAdd(&cnt[e2], 1u); list[(size_t)e2 * 16384 + q2] = tok * 2 + 1; gateA[tok * 2 + 1] = g2; slotA[tok * 2 + 1] = ((unsigned)e2 << 16) | q2;
    }
    const f32x4* gr = (const f32x4*)F.ap->in[25] + F.lane;
    bf16* XN = (bf16*)(F.ws + WS_XN);
    for (int rr = 0; rr < 16; ++rr) { const float rsr = sc[800 + rr]; const f32x4* xr = (const f32x4*)(x1 + (size_t)(m0 + rr) * D) + F.lane; v2u* o8 = (v2u*)(XN + (size_t)(m0 + rr) * D) + F.lane;
#pragma unroll
        for (int j = 0; j < 4; ++j) o8[64 * j] = pk4(xr[64 * j] * rsr * gr[64 * j]); }
    LDS_WAIT(); __builtin_amdgcn_wave_barrier(); asm volatile("" ::: "memory");
}
__device__ __forceinline__ void p9_phase(Frame& F) {
    for (int task = F.gw; task < 1024; task += F.NGW) route_task(F, task);
    const float* p = F.ap->in[1]; bf16* PB = (bf16*)(F.ws + WS_PBF);
    for (size_t idx = (size_t)F.gw * 64 + F.lane; idx < (size_t)M * 256 / 4; idx += (size_t)F.NGW * 64) *(v2u*)(PB + idx * 4) = pk4(*(const f32x4*)(p + idx * 4));
}

__device__ __forceinline__ void p12_row(Frame& F, int m) {
    float* x1 = (float*)(F.ws + WS_Z) + (size_t)m * D;
    const unsigned* cnt = (const unsigned*)(F.ws + WS_CTL) + CW_CNT; const unsigned* slotA = (const unsigned*)(F.ws + WS_SLOTA); const float* gateA = (const float*)(F.ws + WS_GATEA);
    const unsigned s0 = slotA[2 * m], s1 = slotA[2 * m + 1]; const int e0 = (int)(s0 >> 16), e1 = (int)(s1 >> 16);
    int acc = 0, pre0 = 0, pre1 = 0;
    for (int e = 0; e < 32; ++e) { if (e == e0) pre0 = acc; if (e == e1) pre1 = acc; acc += ((int)cnt[e] + 255) >> 8; }
    const size_t r0 = (size_t)pre0 * 256 + (s0 & 0xffffu), r1 = (size_t)pre1 * 256 + (s1 & 0xffffu);
    const float g0 = gateA[2 * m], g1 = gateA[2 * m + 1];
    const bf16* c0 = (const bf16*)(F.ws + WS_Z + 64 * MiB) + r0 * D; const bf16* c1 = (const bf16*)(F.ws + WS_Z + 64 * MiB) + r1 * D;
    const bf16* er = (const bf16*)(F.ws + WS_S + 64 * MiB) + (size_t)m * D;
    f32x4 v[4]; float s = 0.f, se = 0.f;
#pragma unroll
    for (int j = 0; j < 4; ++j) { const int o = 4 * F.lane + 256 * j; v[j] = *(const f32x4*)(x1 + o) + unpk4(*(const v2u*)(c0 + o)) * g0 + unpk4(*(const v2u*)(c1 + o)) * g1;
        s += (v[j].x * v[j].x + v[j].y * v[j].y) + (v[j].z * v[j].z + v[j].w * v[j].w);
        const f32x4 e = unpk4(*(const v2u*)(er + o)); se += (e.x * e.x + e.y * e.y) + (e.z * e.z + e.w * e.w);
        *(f32x4*)(x1 + o) = v[j]; }
    const float rs = 1.0f / sqrtf(wave_sum(s) * (1.f / D) + NORM_EPS); const float rse = 1.0f / sqrtf(wave_sum(se) * (1.f / D) + NORM_EPS);
    bf16* xn = (bf16*)(F.ws + WS_XN) + (size_t)m * D; const float* gi = F.ap->in[34];
#pragma unroll
    for (int j = 0; j < 4; ++j) { const int o = 4 * F.lane + 256 * j; *(v2u*)(xn + o) = pk4(v[j] * rs * *(const f32x4*)(gi + o)); }
    if (F.lane == 0) ((float*)(F.ws + WS_RSE))[m] = rse;
}
__device__ __forceinline__ void p14_row(Frame& F, int m) {
    float* xr = F.out + (size_t)m * D; const float* gf = F.ap->in[36];
    f32x4 v[4]; float s = 0.f;
#pragma unroll
    for (int j = 0; j < 4; ++j) { const int o = 4 * F.lane + 256 * j; v[j] = *(const f32x4*)(xr + o); s += (v[j].x * v[j].x + v[j].y * v[j].y) + (v[j].z * v[j].z + v[j].w * v[j].w); }
    const float rs = 1.0f / sqrtf(wave_sum(s) * (1.f / D) + NORM_EPS);
#pragma unroll
    for (int j = 0; j < 4; ++j) { const int o = 4 * F.lane + 256 * j; *(f32x4*)(xr + o) = v[j] * rs * *(const f32x4*)(gf + o); }
}

#ifndef MK_ONE_LAUNCH
#define MK_ONE_LAUNCH 0
#endif
constexpr int N_PHASES = 15;
__global__ void __launch_bounds__(NWAVES * 64, 2) mk_fwd(Args args) {
    extern __shared__ __attribute__((aligned(16))) unsigned char lds[];
    Frame F;
    F.lds = (LAS unsigned char*)lds;
    F.tid = threadIdx.x; F.lane = F.tid & 63; F.wave = __builtin_amdgcn_readfirstlane(F.tid >> 6);
    F.G = gridDim.x; { const int bx = blockIdx.x; F.vcu = (F.G % 8 == 0) ? (bx % 8) * (F.G / 8) + bx / 8 : bx; }
    F.gw = F.vcu * NWAVES + F.wave; F.NGW = F.G * NWAVES;
    F.ws = args.ws; F.out = args.out;
    F.ap = (ArgsP)__builtin_amdgcn_kernarg_segment_ptr();
    unsigned char* ws = args.ws;
    const int lo = args.ph_lo, hi = args.ph_hi;
#ifdef ONLY
#define IN(k) ((k) == ONLY && lo <= (k) && (k) < hi)
#else
#define IN(k) (lo <= (k) && (k) < hi)
#endif
#if MK_ONE_LAUNCH
#define GRID_BAR(k) do { if (IN(k) && IN((k) + 1)) { __threadfence(); cg::this_grid().sync(); } } while (0)
#else
#define GRID_BAR(k) do { } while (0)
#endif
    LAS unsigned char* L = F.lds;
    const bf16* z = (const bf16*)(ws + WS_Z);

    if (IN(0)) { p0_prologue(F); } GRID_BAR(0);

    if (IN(1)) {
        pg8::Gemm g{(const bf16*)(ws + WS_XN), (const bf16*)(ws + WS_WIN), M, NZ, D, nullptr}; pg8::StaticOrder S; S.init(M, NZ, F.G, (int)blockIdx.x);
        EpiStoreBf16 E{(bf16*)(ws + WS_Z), NZ};
        pg8::gemm_phase<EpiStoreBf16, pg8::StaticOrder, true, false>(L, g, S, E);
    } GRID_BAR(1);

    if (IN(2)) { p2_prep(F); } GRID_BAR(2);
    if (IN(3)) { p3_phase(F); } GRID_BAR(3);
    if (IN(4)) { p4_phase(F); } GRID_BAR(4);
    if (IN(5)) { if (F.G == 256) p5_scan(F); } GRID_BAR(5);
    if (IN(6)) { for (int m = F.gw; m < M; m += F.NGW) p6_task(F, m); } GRID_BAR(6);

    if (IN(7)) {
        pg8::Gemm g{(const bf16*)(ws + WS_YRW), (const bf16*)(ws + WS_UR), 2 * M, 2 * D, 512, nullptr}; DualOrder S; S.S.init(M, D, F.G, (int)blockIdx.x);
        EpiMix E{z, (float*)(ws + WS_S), (bf16*)(ws + WS_S + 64 * MiB)};
        pg8::gemm_phase<EpiMix, DualOrder, true, false>(L, g, S, E);
    } GRID_BAR(7);

    if (IN(8)) {
        pg8::Gemm g{(const bf16*)(ws + WS_S + 64 * MiB), (const bf16*)(ws + WS_WO), M, D, D, nullptr}; pg8::StaticOrder S; S.init(M, D, F.G, (int)blockIdx.x);
        EpiResF32 E{F.ap->in[0], (float*)(ws + WS_Z)};
        pg8::gemm_phase<EpiResF32, pg8::StaticOrder, true, false>(L, g, S, E);
    } GRID_BAR(8);

    if (IN(9)) { p9_phase(F); } GRID_BAR(9);

    if (IN(10)) {
        pg8::Gemm g{(const bf16*)(ws + WS_XN), (const bf16*)(ws + WS_WGU), M, 1024, D, (const int*)(ws + WS_LIST)};
        pg8::MoeOrder S{(const unsigned*)(ws + WS_CTL) + CW_CNT, F.G, (int)blockIdx.x, false};
        EpiMoe1 E{(bf16*)(ws + WS_S)};
        pg8::gemm_phase<EpiMoe1, pg8::MoeOrder, true, true>(L, g, S, E);
    } GRID_BAR(10);

    if (IN(11)) {
#ifndef NO_MOE2
        { pg8::Gemm g{(const bf16*)(ws + WS_S), (const bf16*)(ws + WS_WD), M, 1024, 512, nullptr};
          pg8::MoeOrder S{(const unsigned*)(ws + WS_CTL) + CW_CNT, F.G, (int)blockIdx.x, true};
          EpiStoreBf16 E{(bf16*)(ws + WS_Z + 64 * MiB), D};
          pg8::gemm_phase<EpiStoreBf16, pg8::MoeOrder, true, false>(L, g, S, E); }
#endif
#ifndef NO_ERAW
        { pg8::Gemm g{(const bf16*)(ws + WS_PBF), (const bf16*)(ws + WS_WPP), M, D, 256, nullptr}; pg8::StaticOrder S; S.init(M, D, F.G, (int)blockIdx.x);
          EpiStoreBf16 E{(bf16*)(ws + WS_S + 64 * MiB), D};
          pg8::gemm_phase<EpiStoreBf16, pg8::StaticOrder, true, false>(L, g, S, E); }
#endif
    } GRID_BAR(11);

    if (IN(12)) { for (int m = F.gw; m < M; m += F.NGW) p12_row(F, m); } GRID_BAR(12);

    if (IN(13)) {
        pg8::Gemm g{(const bf16*)(ws + WS_XN), (const bf16*)(ws + WS_WPG), M, D, D, nullptr}; pg8::StaticOrder S; S.init(M, D, F.G, (int)blockIdx.x);
        EpiPle E{(const float*)(ws + WS_Z), (const bf16*)(ws + WS_S + 64 * MiB), (const float*)(ws + WS_RSE), F.ap->in[33], F.out};
        pg8::gemm_phase<EpiPle, pg8::StaticOrder, true, false>(L, g, S, E);
    } GRID_BAR(13);

    if (IN(14)) { for (int m = F.gw; m < M; m += F.NGW) p14_row(F, m); }
#undef IN
#undef GRID_BAR
}

extern "C" void kernel_launch(void* const* d_in, const int* in_sizes, int n_in, void* d_out, int out_size, void* d_ws, size_t ws_size, hipStream_t stream) {
    static int grid = 0;
    if (grid == 0) {
        if (n_in != 37 || out_size != M * D || ws_size < WS_END) { fprintf(stderr, "kernel_launch: unexpected problem (n_in %d, out %d, ws %zu < %zu); nothing launched\n", n_in, out_size, ws_size, (size_t)WS_END); grid = -1; return; }
        int dev = 0, cus = 0, per_cu = 0;
        if (hipGetDevice(&dev) != hipSuccess || hipDeviceGetAttribute(&cus, hipDeviceAttributeMultiprocessorCount, dev) != hipSuccess) { grid = -1; return; }
        if (hipFuncSetAttribute((const void*)mk_fwd, hipFuncAttributeMaxDynamicSharedMemorySize, LDS_BYTES) != hipSuccess) { fprintf(stderr, "kernel_launch: hipFuncSetAttribute failed\n"); grid = -1; return; }
        if (hipOccupancyMaxActiveBlocksPerMultiprocessor(&per_cu, (const void*)mk_fwd, NWAVES * 64, LDS_BYTES) != hipSuccess || per_cu < 1) { fprintf(stderr, "kernel_launch: occupancy query says %d blocks per CU\n", per_cu); (void)hipGetLastError(); grid = -1; return; }
        grid = cus;
        if (grid != 256) fprintf(stderr, "kernel_launch: %d CUs; this kernel is built for 256\n", grid);
    }
    if (grid < 0) return;
    (void)hipMemsetAsync((char*)d_ws + WS_CTL, 0, CTL_ZERO_BYTES, stream);
    Args a{};
    for (int i = 0; i < 37; ++i) a.in[i] = (const float*)d_in[i];
    a.out = (float*)d_out; a.ws = (unsigned char*)d_ws;
#if MK_ONE_LAUNCH
    a.ph_lo = 0; a.ph_hi = N_PHASES;
    void* kargs[] = {&a};
    hipError_t e = hipLaunchCooperativeKernel((const void*)mk_fwd, dim3(grid), dim3(NWAVES * 64), kargs, LDS_BYTES, stream);
    if (e != hipSuccess) fprintf(stderr, "kernel_launch: cooperative launch failed: %s (grid %d)\n", hipGetErrorString(e), grid);
#else
    for (int ph = 0; ph < N_PHASES; ++ph) { a.ph_lo = ph; a.ph_hi = ph + 1; hipLaunchKernelGGL(mk_fwd, dim3(grid), dim3(NWAVES * 64), LDS_BYTES, stream, a); }
#endif
}
```

```cpp
#include <hip/hip_runtime.h>
#include <hip/hip_cooperative_groups.h>
#include <cstdio>
#include <cstdint>
namespace cg = cooperative_groups;

namespace pg8 {
#define PG8_LAS __attribute__((address_space(3)))
typedef unsigned short bf16_t;
typedef short bf16x8 __attribute__((ext_vector_type(8)));
typedef float f32x4 __attribute__((ext_vector_type(4)));
typedef unsigned u32x4 __attribute__((ext_vector_type(4)));
typedef unsigned u32x2 __attribute__((ext_vector_type(2)));
constexpr int BM = 256, BK = 64, HALF = 128, HTB = HALF * BK * 2  , STAGE_BYTES = 8 * HTB, NXCD = 8, WGM = 8;

__host__ __device__ __forceinline__ int lds_byte(int r, int c) { const int st = (r >> 4) * 2 + (c >> 5), rr = r & 15, cc = c & 31, ob = rr * 64 + cc * 2; return st * 1024 + (ob ^ (((ob >> 9) & 1) << 5)); }
__host__ __device__ __forceinline__ void stage_rc(int b, int& R, int& C) { const int st = b / 1024, sb = b % 1024, swz = sb ^ (((sb >> 9) & 1) << 5); R = (st >> 1) * 16 + swz / 64; C = (st & 1) * 32 + (swz % 64) / 2; }
__host__ __device__ __forceinline__ int perm32(int rho) { const int n = rho >> 4, i = rho & 15; return 8 * (i >> 2) + 4 * n + (i & 3); }

struct Unit { int pm, pn, pmo, lt, nvalid, pnl; };
struct Gemm { const bf16_t* A; const bf16_t* Bt; int M, N, K; const int* rowidx; };

struct StaticOrder {
    int nM, nN, nwg, G, c;
    __host__ __device__ void init(int M, int N, int G_, int c_) { nM = M / BM; nN = N / BM; nwg = nM * nN; G = G_; c = c_; }
    __host__ __device__ bool next(int i, Unit& u) const {
        const long L = (long)i * G + c; if (L >= nwg) return false;
        int wgid = (int)L; { const int q = nwg / NXCD, r = nwg % NXCD, xcd = wgid % NXCD, off = wgid / NXCD; wgid = (xcd < r ? xcd * (q + 1) : r * (q + 1) + (xcd - r) * q) + off; }
        const int nig = WGM * nN, gid = wgid / nig, fm = gid * WGM, gsz = (nM - fm) < WGM ? (nM - fm) : WGM;
        u.pm = fm + ((wgid % nig) % gsz); u.pn = (wgid % nig) / gsz; u.pmo = u.pm; u.lt = u.pm; u.nvalid = 256; u.pnl = u.pn; return true;
    }
};
struct MoeOrder {
    const unsigned* cnt; int G, c; bool a_is_out;
    __device__ bool next(int i, Unit& u) const {
        const int L = i * G + c; const int tile = L >> 2, pnl = L & 3;
        int acc = 0;
        for (int e = 0; e < 32; ++e) { const int ce = (int)cnt[e]; const int nt = (ce + 255) >> 8;
            if (tile < acc + nt) { const int rt = tile - acc; u.pmo = tile; u.pm = a_is_out ? tile : 0; u.lt = e * 64 + rt; u.pn = e * 4 + pnl; u.pnl = pnl; const int rem = ce - rt * 256; u.nvalid = rem < 256 ? rem : 256; return true; }
            acc += nt; }
        return false;
    }
};

__device__ __forceinline__ unsigned cvt_pk_bf16(float lo, float hi) { unsigned r; asm volatile("v_cvt_pk_bf16_f32 %0, %1, %2" : "=v"(r) : "v"(lo), "v"(hi)); return r; }

template <class Epi, class Sched, bool ALIGN_EPI, bool GATHER>
__device__ __forceinline__ void gemm_phase(PG8_LAS unsigned char* lds, const Gemm g, const Sched& S, const Epi& E) {
    const int tid = threadIdx.x, wid = __builtin_amdgcn_readfirstlane(tid >> 6), lane = tid & 63, wr = wid >> 2, wc = wid & 3, fr = lane & 15, fq = lane >> 4;
    int K_ = g.K; asm volatile("" : "+s"(K_));
    const int K = K_, nt = K / BK;
    unsigned voffB[2]; int RA[2], CA[2];
#pragma unroll
    for (int i = 0; i < 2; ++i) { int R, C; stage_rc(tid * 16 + i * 8192, R, C); const int Rb = Epi::PERM ? ((R & ~31) + perm32(R & 31)) : R;
        RA[i] = R; CA[i] = C; voffB[i] = (unsigned)(Rb * K + C) * 2u; }
    const size_t kstep = (size_t)(BK * 2);
    const size_t hstep = (size_t)HALF * K * 2;
    const size_t tstep = 2 * hstep;
    const unsigned ldsw = (unsigned)wid * 1024u;
    const int aoff = lds_byte(wr * 64 + fr, fq * 8), boff = lds_byte(wc * 32 + fr, fq * 8);
    unsigned vA[2][2], vN[2][2];
    auto compute_v = [&](const Unit& u, unsigned (&v)[2][2]) {
#pragma unroll
        for (int h = 0; h < 2; ++h)
#pragma unroll
            for (int i = 0; i < 2; ++i) {
                const int rl = h * HALF + RA[i];
                if constexpr (GATHER) { int tok = 0; if (rl < u.nvalid) tok = g.rowidx[(size_t)u.lt * 256 + rl] >> 1; v[h][i] = ((unsigned)tok * (unsigned)K + (unsigned)CA[i]) * 2u; }
                else v[h][i] = ((unsigned)rl * (unsigned)K + (unsigned)CA[i]) * 2u;
            }
    };
#define PG8_SA(b, h) (((b) * 2 + (h)) * HTB)
#define PG8_SB(b, h) ((4 + (b) * 2 + (h)) * HTB)
#define PG8_STAGE(bufoff, gbase, voff) do { _Pragma("unroll") for (int _i = 0; _i < 2; ++_i) \
        __builtin_amdgcn_global_load_lds((const unsigned*)((const char*)(gbase) + (voff)[_i]), (PG8_LAS unsigned*)(lds + (bufoff) + ldsw + _i * 8192), 16, 0, 0); } while (0)
#define PG8_LDA(dst, b, h) do { _Pragma("unroll") for (int m = 0; m < 4; ++m) _Pragma("unroll") for (int k = 0; k < 2; ++k) dst[m][k] = *(const PG8_LAS bf16x8*)(lds + PG8_SA(b, h) + aoff + m * 2048 + k * 1024); } while (0)
#define PG8_LDB(dst, b, h) do { _Pragma("unroll") for (int n = 0; n < 2; ++n) _Pragma("unroll") for (int k = 0; k < 2; ++k) dst[n][k] = *(const PG8_LAS bf16x8*)(lds + PG8_SB(b, h) + boff + n * 2048 + k * 1024); } while (0)
#define PG8_MMA(ai, bj, At, Bt) do { __builtin_amdgcn_s_setprio(1); _Pragma("unroll") for (int m = 0; m < 4; ++m) _Pragma("unroll") for (int n = 0; n < 2; ++n) _Pragma("unroll") for (int k = 0; k < 2; ++k) \
        acc[ai][bj][m][n] = __builtin_amdgcn_mfma_f32_16x16x32_bf16(Bt[n][k], At[m][k], acc[ai][bj][m][n], 0, 0, 0); __builtin_amdgcn_s_setprio(0); } while (0)
#define PG8_WAIT_V(n) asm volatile("s_waitcnt vmcnt(" #n ")" ::: "memory")
#define PG8_WAIT_L(n) asm volatile("s_waitcnt lgkmcnt(" #n ")" ::: "memory")
#define PG8_BAR __builtin_amdgcn_s_barrier()
#define PG8_SCHED __builtin_amdgcn_sched_barrier(0)
    Unit cur, nxt; int ui = 0;
    if (!S.next(0, cur)) return;
    f32x4 acc[2][2][4][2];
#pragma unroll
    for (int a = 0; a < 2; ++a)
#pragma unroll
        for (int b = 0; b < 2; ++b)
#pragma unroll
            for (int m = 0; m < 4; ++m)
#pragma unroll
                for (int n = 0; n < 2; ++n) acc[a][b][m][n] = (f32x4){0.f, 0.f, 0.f, 0.f};
    bf16x8 At[4][2], B0[2][2], B1[2][2];
    compute_v(cur, vA);
    const char* cA = (const char*)g.A + (GATHER ? (size_t)0 : (size_t)cur.pm * tstep); const char* cB = (const char*)g.Bt + (size_t)cur.pn * tstep;
    PG8_STAGE(PG8_SB(0, 0), cB, voffB); PG8_STAGE(PG8_SB(0, 1), cB + hstep, voffB); PG8_STAGE(PG8_SA(0, 0), cA, vA[0]); PG8_STAGE(PG8_SA(0, 1), cA, vA[1]);
    if (wr == 1) PG8_BAR;
    PG8_WAIT_V(2); PG8_BAR;
    PG8_STAGE(PG8_SB(1, 0), cB + kstep, voffB); PG8_STAGE(PG8_SA(1, 0), cA + kstep, vA[0]); PG8_STAGE(PG8_SB(1, 1), cB + hstep + kstep, voffB);
    PG8_WAIT_V(6); PG8_BAR;
    for (;;) {
        const bool has_next = S.next(ui + 1, nxt);
        if (has_next) compute_v(nxt, vN);
        else {
#pragma unroll
            for (int h = 0; h < 2; ++h)
#pragma unroll
                for (int i = 0; i < 2; ++i) vN[h][i] = vA[h][i];
        }
        const char* nA = has_next ? ((const char*)g.A + (GATHER ? (size_t)0 : (size_t)nxt.pm * tstep)) : cA; const char* nB = has_next ? (const char*)g.Bt + (size_t)nxt.pn * tstep : cB;
#pragma unroll 1
        for (int t = 0; t < nt; t += 2) {
            const bool last = (t == nt - 2);
            const char* a1 = cA + (size_t)(t + 1) * kstep;
            const char* a2 = last ? nA : cA + (size_t)(t + 2) * kstep; const char* b2 = last ? nB : cB + (size_t)(t + 2) * kstep;
            const char* a3 = a2 + kstep; const char* b3 = b2 + kstep;
            unsigned vX0[2], vX1[2];
#pragma unroll
            for (int i = 0; i < 2; ++i) { vX0[i] = last ? vN[0][i] : vA[0][i]; vX1[i] = last ? vN[1][i] : vA[1][i]; }
            PG8_LDB(B0, 0, 0); PG8_LDB(B1, 0, 1); PG8_SCHED; PG8_LDA(At, 0, 0); PG8_STAGE(PG8_SA(1, 1), a1, vA[1]);
            PG8_WAIT_V(8); PG8_WAIT_L(0); PG8_BAR; PG8_MMA(0, 0, At, B0); PG8_MMA(0, 1, At, B1); PG8_BAR; PG8_SCHED;
            PG8_LDA(At, 0, 1); PG8_STAGE(PG8_SB(0, 0), b2, voffB); PG8_STAGE(PG8_SB(0, 1), b2 + hstep, voffB); PG8_STAGE(PG8_SA(0, 0), a2, vX0);
            PG8_WAIT_V(8); PG8_WAIT_L(0); PG8_BAR; PG8_MMA(1, 0, At, B0); PG8_MMA(1, 1, At, B1); PG8_BAR; PG8_SCHED;
            PG8_LDB(B0, 1, 0); PG8_LDB(B1, 1, 1); PG8_SCHED; PG8_LDA(At, 1, 0); PG8_STAGE(PG8_SA(0, 1), a2, vX1);
            PG8_WAIT_V(8); PG8_WAIT_L(0); PG8_BAR; PG8_MMA(0, 0, At, B0); PG8_MMA(0, 1, At, B1); PG8_BAR; PG8_SCHED;
            PG8_LDA(At, 1, 1); PG8_STAGE(PG8_SB(1, 0), b3, voffB); PG8_STAGE(PG8_SB(1, 1), b3 + hstep, voffB); PG8_STAGE(PG8_SA(1, 0), a3, vX0);
            PG8_WAIT_V(8); PG8_WAIT_L(0); PG8_BAR; PG8_MMA(1, 0, At, B0); PG8_MMA(1, 1, At, B1); PG8_BAR; PG8_SCHED;
        }
        if constexpr (ALIGN_EPI) { if (wr == 0) PG8_BAR; }
        E(acc, cur, wr, wc, fr, fq);
        if (!has_next) break;
#pragma unroll
        for (int a = 0; a < 2; ++a)
#pragma unroll
            for (int b = 0; b < 2; ++b)
#pragma unroll
                for (int m = 0; m < 4; ++m)
#pragma unroll
                    for (int n = 0; n < 2; ++n) acc[a][b][m][n] = (f32x4){0.f, 0.f, 0.f, 0.f};
        cur = nxt; cA = nA; cB = nB; ++ui;
#pragma unroll
        for (int h = 0; h < 2; ++h)
#pragma unroll
            for (int i = 0; i < 2; ++i) vA[h][i] = vN[h][i];
        if constexpr (ALIGN_EPI) { if (wr == 1) PG8_BAR; }
    }
    PG8_WAIT_V(0);
    if constexpr (!ALIGN_EPI) { if (wr == 0) PG8_BAR; }
    PG8_BAR;
#undef PG8_SA
#undef PG8_SB
#undef PG8_STAGE
#undef PG8_LDA
#undef PG8_LDB
#undef PG8_MMA
#undef PG8_WAIT_V
#undef PG8_WAIT_L
#undef PG8_BAR
#undef PG8_SCHED
}
}

constexpr int NWAVES = 8;
constexpr int M = 16384, D = 1024, SEQ = 2048, NBATCH = 8;
constexpr int NIN = 5144;
constexpr int NZ = 5120;
constexpr int ZC_R = 0, ZC_K = 512, ZC_V = 1024, ZC_W = 1536, ZC_Q = 1792, ZC_KC = 2304, ZC_VC = 2432, ZC_KS = 2560, ZC_VS = 2688, ZC_KW = 2816, ZC_VW = 2944, ZC_MR = 3072, ZC_MN = 4096;
constexpr float NORM_EPS = 1e-6f, GN_EPS = 64e-5f;

constexpr size_t MiB = 1u << 20;
constexpr size_t WS_CTL = 0, CTL_ZERO_BYTES = 64 * 1024;
constexpr size_t WS_LIST = 1 * MiB;
constexpr size_t WS_GATEA = 3 * MiB;
constexpr size_t WS_RSE = 4 * MiB;
constexpr size_t WS_SLOTA = 4 * MiB + 512 * 1024;
constexpr size_t WS_SELMASK = 5 * MiB;
constexpr size_t WS_ZGATE = 6 * MiB;
constexpr size_t WS_SMALLW = 8 * MiB;
constexpr size_t SW_W2T = 0, SW_A2T = 65536, SW_G2T = 131072, SW_CK1 = 262144, SW_CV1 = 524288, SW_CK2 = 786432, SW_CV2 = 794624, SW_GATEW = 802816, SW_ROUTEW = 868352;
constexpr size_t WS_KCMP = 10 * MiB;
constexpr size_t WS_VST = 11 * MiB, WS_VWT = 15 * MiB;
constexpr size_t WS_WIN = 19 * MiB, WS_UR = 29 * MiB, WS_UN = 30 * MiB, WS_WO = 31 * MiB, WS_WPP = 33 * MiB, WS_WPG = 34 * MiB, WS_WGU = 36 * MiB, WS_WD = 100 * MiB;
constexpr size_t WS_XN = 132 * MiB;
constexpr size_t WS_PBF = 164 * MiB;
constexpr size_t WS_Z = 172 * MiB;
constexpr size_t WS_S = 332 * MiB;
constexpr size_t WS_YRW = 428 * MiB, WS_YB = 444 * MiB, WS_G = 492 * MiB, WS_END = 508 * MiB;
constexpr int CW_CNT = 0;
constexpr int CW_BAR = 1024;
constexpr int MISC_OFF = 147456 - 64;

constexpr int LDS_BYTES = 147456;

#define GAS __attribute__((address_space(1)))
#define LAS __attribute__((address_space(3)))
typedef unsigned short bf16;
typedef unsigned v4u __attribute__((ext_vector_type(4)));
typedef unsigned v2u __attribute__((ext_vector_type(2)));
typedef float f32x4 __attribute__((ext_vector_type(4)));
typedef float f32x2 __attribute__((ext_vector_type(2)));
typedef short bf16x8 __attribute__((ext_vector_type(8)));
typedef short bf16x4 __attribute__((ext_vector_type(4)));
typedef __bf16 bf16x2_t __attribute__((ext_vector_type(2)));
#define LDS_WAIT() asm volatile("s_waitcnt lgkmcnt(0)" ::: "memory")
#define MFMA16(a, b, c) __builtin_amdgcn_mfma_f32_16x16x32_bf16((a), (b), (c), 0, 0, 0)

__device__ __forceinline__ float bf2f(unsigned short v) { return __uint_as_float((unsigned)v << 16); }
__device__ __forceinline__ unsigned pk2(float lo, float hi) { f32x2 v = {lo, hi}; bf16x2_t b = __builtin_convertvector(v, bf16x2_t); return __builtin_bit_cast(unsigned, b); }
__device__ __forceinline__ v2u pk4(f32x4 v) { v2u r; r.x = pk2(v.x, v.y); r.y = pk2(v.z, v.w); return r; }
__device__ __forceinline__ f32x4 unpk4(v2u w) { f32x4 r; r.x = __uint_as_float(w.x << 16); r.y = __uint_as_float(w.x & 0xffff0000u); r.z = __uint_as_float(w.y << 16); r.w = __uint_as_float(w.y & 0xffff0000u); return r; }
__device__ __forceinline__ void unpk8(v4u w, float (&f)[8]) { f[0] = __uint_as_float(w.x << 16); f[1] = __uint_as_float(w.x & 0xffff0000u); f[2] = __uint_as_float(w.y << 16); f[3] = __uint_as_float(w.y & 0xffff0000u);
    f[4] = __uint_as_float(w.z << 16); f[5] = __uint_as_float(w.z & 0xffff0000u); f[6] = __uint_as_float(w.w << 16); f[7] = __uint_as_float(w.w & 0xffff0000u); }
__device__ __forceinline__ float sigmoidf_(float x) { return __builtin_amdgcn_rcpf(1.0f + __expf(-x)); }
__device__ __forceinline__ float wave_sum(float v) {
#pragma unroll
    for (int o = 1; o < 64; o <<= 1) v += __shfl_xor(v, o);
    return v;
}
template <int CTRL> __device__ __forceinline__ float dppf(float x) { return __builtin_bit_cast(float, __builtin_amdgcn_update_dpp(0, __builtin_bit_cast(int, x), CTRL, 0xf, 0xf, false)); }
__device__ __forceinline__ float row16_sum(float x) { x += dppf<0x128>(x); x += dppf<0x124>(x); x += dppf<0x122>(x); x += dppf<0x121>(x); return x; }

typedef GAS unsigned gu32;
#define XB_TMO      128
#define XB_XCNT(j)  (256  + 64 * (j))
#define XB_XSUB(j)  (1280 + 64 * (j))
#define XB_XGEN(j)  (2304 + 64 * (j))
#define XB_TOP      3328
#define XB_TOPGEN   3392
#define XCD_BAR_WORDS 3456
#define XB_SPIN_CAP (1u << 18)

__device__ __forceinline__ unsigned xb_ld(unsigned* p)              { return __hip_atomic_load(p, __ATOMIC_RELAXED, __HIP_MEMORY_SCOPE_AGENT); }
__device__ __forceinline__ unsigned xb_add(unsigned* p, unsigned v) { return __hip_atomic_fetch_add(p, v, __ATOMIC_RELAXED, __HIP_MEMORY_SCOPE_AGENT); }
__device__ __forceinline__ unsigned xb_xcc_id() { return (unsigned)__builtin_amdgcn_s_getreg((3 << 11) | 20) & 0xFu; }
#define XB_SPIN(cond, bar) do { unsigned _sp = 0; while (cond) { __builtin_amdgcn_s_sleep(1); \
    if ((++_sp & 255u) == 0u) { if (xb_ld(&(bar)[XB_TMO])) break; if (_sp > XB_SPIN_CAP) { atomicAdd(&(bar)[XB_TMO], 1u); break; } } } } while (0)

struct XcdBarrier {
    unsigned* bar; unsigned x;
    volatile LAS unsigned* st;
};

__device__ __forceinline__ XcdBarrier xcd_barrier_post(unsigned* bar, volatile LAS unsigned* st) {
    XcdBarrier b; b.bar = bar; b.x = xb_xcc_id(); b.st = st;
    if (threadIdx.x == 0) (void)xb_add(&bar[XB_XCNT(b.x)], 1u);
    return b;
}
__device__ __forceinline__ void xcd_barrier_complete(unsigned* bar, unsigned x, unsigned& nloc, unsigned& nx) {
    const unsigned G = gridDim.x * gridDim.y * gridDim.z;
    unsigned sum, cnt, mine, sp = 0u;
    for (;;) {
        sum = 0u; cnt = 0u; mine = 0u;
#pragma unroll
        for (unsigned j = 0; j < 16; ++j) { const unsigned c = xb_ld(&bar[XB_XCNT(j)]); sum += c; cnt += (c > 0u) ? 1u : 0u; mine = (j == x) ? c : mine; }
        if (sum == G) break;
        __builtin_amdgcn_s_sleep(1);
        if ((++sp & 255u) == 0u) { if (xb_ld(&bar[XB_TMO])) break; if (sp > XB_SPIN_CAP) { atomicAdd(&bar[XB_TMO], 1u); break; } }
    }
    nloc = mine > 0u ? mine : 1u; nx = cnt > 0u ? cnt : 1u;
}

__device__ __forceinline__ void xcd_barrier(const XcdBarrier& b) {
    asm volatile("s_waitcnt vmcnt(0)" ::: "memory");
    __syncthreads();
    if (threadIdx.x == 0) {
        unsigned* bar = b.bar;
        __builtin_amdgcn_s_waitcnt(0);
        unsigned nloc = b.st[0], nx = b.st[1];
        if (nloc == 0u) { xcd_barrier_complete(bar, b.x, nloc, nx); b.st[0] = nloc; b.st[1] = nx; }
        const unsigned old = xb_add(&bar[XB_XSUB(b.x)], 1u);
        const unsigned gen = old / nloc;
        if (old + 1u == (gen + 1u) * nloc) {
            __builtin_amdgcn_fence(__ATOMIC_RELEASE, "agent");
            asm volatile("s_waitcnt vmcnt(0)" ::: "memory");
            const unsigned og = xb_add(&bar[XB_TOP], 1u);
            const unsigned tg = og / nx;
            if (og + 1u == (tg + 1u) * nx) xb_add(&bar[XB_TOPGEN], 1u);
            else XB_SPIN(xb_ld(&bar[XB_TOPGEN]) == tg, bar);
            __builtin_amdgcn_fence(__ATOMIC_ACQUIRE, "agent");
            xb_add(&bar[XB_XGEN(b.x)], 1u);
            asm volatile("s_waitcnt vmcnt(0)" ::: "memory");
        } else {
            XB_SPIN(xb_ld(&bar[XB_XGEN(b.x)]) == gen, bar);
            __builtin_amdgcn_fence(__ATOMIC_ACQUIRE, "agent");
            asm volatile("s_waitcnt vmcnt(0)" ::: "memory");
        }
    }
    __syncthreads();
}

struct Args { const float* in[37]; float* out; unsigned char* ws; int ph_lo, ph_hi; };
typedef __attribute__((address_space(4))) const Args* ArgsP;
struct Frame {
    LAS unsigned char* lds;
    int tid, lane, wave, vcu, G, gw, NGW;
    unsigned char* ws;
    ArgsP ap;
    float* out;
};

template <class RowF>
__device__ __forceinline__ void tr_item(const float* W, int K, int ld, int ncols, LAS float* scr, int item, int lane, RowF rowptr) {
    const int nblk = (ncols + 31) / 32, kb = item / nblk, nb = item % nblk, k0 = 64 * kb, n0 = 32 * nb;
    const int nn = n0 + (lane & 31);
#pragma unroll 8
    for (int i = 0; i < 32; ++i) { const int kk = 2 * i + (lane >> 5); scr[kk * 33 + (lane & 31)] = (nn < ncols) ? W[(size_t)(k0 + kk) * ld + nn] : 0.f; }
    LDS_WAIT(); asm volatile("" ::: "memory");
    const int c = lane & 7;
#pragma unroll
    for (int j = 0; j < 4; ++j) { const int nl = (lane >> 3) + 8 * j, n = n0 + nl; const LAS float* s = scr + (8 * c) * 33 + nl;
        v4u o; o.x = pk2(s[0 * 33], s[1 * 33]); o.y = pk2(s[2 * 33], s[3 * 33]); o.z = pk2(s[4 * 33], s[5 * 33]); o.w = pk2(s[6 * 33], s[7 * 33]);
        if (n < ncols) { bf16* rp = rowptr(n); if (rp) *(v4u*)(rp + k0 + 8 * c) = o; } }
    LDS_WAIT(); asm volatile("" ::: "memory");
}
__device__ __forceinline__ void rms_row_to_bf16(int lane, const float* xrow, const float* gain, bf16* orow) {
    const f32x4* xr = (const f32x4*)xrow + lane; const f32x4* gr = (const f32x4*)gain + lane;
    f32x4 v[4]; float s = 0.f;
#pragma unroll
    for (int j = 0; j < 4; ++j) { v[j] = xr[64 * j]; s += (v[j].x * v[j].x + v[j].y * v[j].y) + (v[j].z * v[j].z + v[j].w * v[j].w); }
    const float rs = 1.0f / sqrtf(wave_sum(s) * (1.f / D) + NORM_EPS);
    v2u* o8 = (v2u*)orow + lane;
#pragma unroll
    for (int j = 0; j < 4; ++j) { const f32x4 g = gr[64 * j]; o8[64 * j] = pk4(v[j] * rs * g); }
}

__device__ __forceinline__ void p0_prologue(Frame& F) {
    LAS float* scr = (LAS float*)(F.lds + F.wave * 16384);
    unsigned char* ws = F.ws;
    const float* w_in = F.ap->in[3];
    bf16* gateWT = (bf16*)(ws + WS_SMALLW + SW_GATEW);
    constexpr int I_WIN = 16 * 161, I_UR = 8 * 32, I_WO = 16 * 32, I_WPP = 4 * 32, I_L64 = 16, I_L128 = 32, I_C1 = 32 * 2, I_C2 = 2, I_GU = 16 * 32, I_DN = 8 * 32;
    constexpr int E0 = I_WIN, E1 = E0 + I_UR, E2 = E1 + I_UR, E3 = E2 + I_WO, E4 = E3 + I_WPP, E5 = E4 + I_WO, E6 = E5 + I_L64, E7 = E6 + I_L64, E8 = E7 + I_L128, E9 = E8 + I_C1, E10 = E9 + I_C1, E11 = E10 + I_C2, E12 = E11 + I_C2,
                  E13 = E12 + 32 * I_GU, NITEMS = E13 + 32 * I_DN;
    for (int it = F.gw; it < NITEMS; it += F.NGW) {
        const float* W; int K, ld, nc, item, mode = 0; size_t dst;
        if (it < E0) { W = w_in; K = 1024; ld = NIN; nc = NIN; item = it; mode = 1; dst = WS_WIN; }
        else if (it < E1) { W = F.ap->in[22]; K = 512; ld = 1024; nc = 1024; item = it - E0; dst = WS_UR; }
        else if (it < E2) { W = F.ap->in[23]; K = 512; ld = 1024; nc = 1024; item = it - E1; dst = WS_UN; }
        else if (it < E3) { W = F.ap->in[24]; K = 1024; ld = 1024; nc = 1024; item = it - E2; dst = WS_WO; }
        else if (it < E4) { W = F.ap->in[32]; K = 256; ld = 1024; nc = 1024; item = it - E3; dst = WS_WPP; }
        else if (it < E5) { W = F.ap->in[35]; K = 1024; ld = 1024; nc = 1024; item = it - E4; dst = WS_WPG; }
        else if (it < E6) { W = F.ap->in[6]; K = 64; ld = 512; nc = 512; item = it - E5; dst = WS_SMALLW + SW_W2T; }
        else if (it < E7) { W = F.ap->in[8]; K = 64; ld = 512; nc = 512; item = it - E6; dst = WS_SMALLW + SW_A2T; }
        else if (it < E8) { W = F.ap->in[9]; K = 128; ld = 512; nc = 512; item = it - E7; dst = WS_SMALLW + SW_G2T; }
        else if (it < E9) { W = F.ap->in[17]; K = 2048; ld = 64; nc = 64; item = it - E8; dst = WS_SMALLW + SW_CK1; }
        else if (it < E10) { W = F.ap->in[19]; K = 2048; ld = 64; nc = 64; item = it - E9; dst = WS_SMALLW + SW_CV1; }
        else if (it < E11) { W = F.ap->in[18]; K = 64; ld = 64; nc = 64; item = it - E10; dst = WS_SMALLW + SW_CK2; }
        else if (it < E12) { W = F.ap->in[20]; K = 64; ld = 64; nc = 64; item = it - E11; dst = WS_SMALLW + SW_CV2; }
        else if (it < E13) { const int r = it - E12, e = r / I_GU; W = F.ap->in[30] + (size_t)e * 1024 * 1024; K = 1024; ld = 1024; nc = 1024; item = r % I_GU; mode = 2; dst = WS_WGU + (size_t)e * 1024 * 1024 * 2; }
        else { const int r = it - E13, e = r / I_DN; W = F.ap->in[31] + (size_t)e * 512 * 1024; K = 512; ld = 1024; nc = 1024; item = r % I_DN; dst = WS_WD + (size_t)e * 1024 * 512 * 2; }
        bf16* T = (bf16*)(ws + dst);
        tr_item(W, K, ld, nc, scr, item, F.lane, [&](int n) -> bf16* {
            if (mode == 1) return n < 3072 ? T + (size_t)n * 1024 : (n < 3096 ? gateWT + (size_t)(n - 3072) * 1024 : T + (size_t)(n - 24) * 1024);
            if (mode == 2) { const int n2 = n & 511; return T + (size_t)((n2 >> 7) * 256 + (n >> 9) * 128 + (n2 & 127)) * 1024; }
            return T + (size_t)n * K; });
    }
    for (int m = F.gw; m < M; m += F.NGW) rms_row_to_bf16(F.lane, F.ap->in[0] + (size_t)m * D, F.ap->in[2], (bf16*)(ws + WS_XN) + (size_t)m * D);
    {
        float* RW = (float*)(ws + WS_SMALLW + SW_ROUTEW); const float* gf = F.ap->in[25]; const float* wg = F.ap->in[26]; const float* wr = F.ap->in[28];
        for (int idx = F.gw * 64 + F.lane; idx < 48 * 1024; idx += F.NGW * 64) { const int c = idx >> 10, k = idx & 1023; float v = 0.f;
            if (c < 4) v = wg[k * 4 + c]; else if (c < 36) v = wr[k * 32 + (c - 4)];
            RW[idx] = v * gf[k]; }
        for (int idx = F.gw * 64 + F.lane; idx < 8 * 1024; idx += F.NGW * 64) gateWT[24 * 1024 + idx] = 0;
    }
}

struct EpiStoreBf16 {
    static constexpr bool PERM = true;
    bf16* O; int ldc;
    __device__ __forceinline__ void operator()(const f32x4 (&acc)[2][2][4][2], const pg8::Unit& u, int wr, int wc, int fr, int fq) const {
        const int row0 = u.pmo * 256 + wr * 64 + fr, col0 = u.pnl * 256 + wc * 32 + 8 * fq;
#pragma unroll
        for (int ai = 0; ai < 2; ++ai)
#pragma unroll
            for (int m = 0; m < 4; ++m) { bf16* rowp = O + (size_t)(row0 + ai * 128 + m * 16) * ldc + col0;
#pragma unroll
                for (int bj = 0; bj < 2; ++bj) { const f32x4 v0 = acc[ai][bj][m][0], v1 = acc[ai][bj][m][1]; v4u w; w.x = pk2(v0[0], v0[1]); w.y = pk2(v0[2], v0[3]); w.z = pk2(v1[0], v1[1]); w.w = pk2(v1[2], v1[3]);
                    *(v4u*)(rowp + bj * 128) = w; } }
    }
};
#define EPI_LOOP_BEGIN \
    _Pragma("unroll") for (int ai = 0; ai < 2; ++ai) _Pragma("unroll") for (int m = 0; m < 4; ++m) { const int rl = ai * 128 + wr * 64 + m * 16 + fr; const size_t row = (size_t)u.pmo * 256 + rl; (void)row; \
    _Pragma("unroll") for (int bj = 0; bj < 2; ++bj) _Pragma("unroll") for (int n = 0; n < 2; ++n) { const int col = u.pnl * 256 + bj * 128 + wc * 32 + n * 16 + 4 * fq; (void)col; const f32x4 a = acc[ai][bj][m][n];
#define EPI_LOOP_END } asm volatile("" ::: "memory"); }
struct EpiMix {
    static constexpr bool PERM = false;
    const bf16* z; float* A; bf16* O;
    __device__ __forceinline__ void operator()(const f32x4 (&acc)[2][2][4][2], const pg8::Unit& u, int wr, int wc, int fr, int fq) const {
        const int zc = u.lt ? ZC_MN : ZC_MR;
        EPI_LOOP_BEGIN
            const f32x4 zz = unpk4(*(const v2u*)(z + row * NZ + zc + col)); f32x4 o;
            o.x = sigmoidf_(zz.x) * a.x; o.y = sigmoidf_(zz.y) * a.y; o.z = sigmoidf_(zz.z) * a.z; o.w = sigmoidf_(zz.w) * a.w;
            if (u.lt == 0) *(f32x4*)(A + row * D + col) = o;
            else { o = o + *(const f32x4*)(A + row * D + col); *(v2u*)(O + row * D + col) = pk4(o); }
        EPI_LOOP_END
    }
};
struct DualOrder {
    pg8::StaticOrder S;
    __device__ bool next(int i, pg8::Unit& u) const { if (i >= 2) return false; if (!S.next(0, u)) return false; if (i == 1) { u.pm += 64; u.pn += 4; } u.lt = i; return true; }
};
struct EpiResF32 {
    static constexpr bool PERM = false;
    const float* base; float* O;
    __device__ __forceinline__ void operator()(const f32x4 (&acc)[2][2][4][2], const pg8::Unit& u, int wr, int wc, int fr, int fq) const {
        EPI_LOOP_BEGIN
            *(f32x4*)(O + row * D + col) = *(const f32x4*)(base + row * D + col) + a;
        EPI_LOOP_END
    }
};
struct EpiMoe1 {
    static constexpr bool PERM = false;
    bf16* H;
    __device__ __forceinline__ void operator()(const f32x4 (&acc)[2][2][4][2], const pg8::Unit& u, int wr, int wc, int fr, int fq) const {
#pragma unroll
        for (int ai = 0; ai < 2; ++ai)
#pragma unroll
            for (int m = 0; m < 4; ++m) { const size_t row = (size_t)u.pmo * 256 + ai * 128 + wr * 64 + m * 16 + fr;
#pragma unroll
                for (int n = 0; n < 2; ++n) { const f32x4 gt = acc[ai][0][m][n], up = acc[ai][1][m][n]; f32x4 o;
                    o.x = gt.x * sigmoidf_(gt.x) * up.x; o.y = gt.y * sigmoidf_(gt.y) * up.y; o.z = gt.z * sigmoidf_(gt.z) * up.z; o.w = gt.w * sigmoidf_(gt.w) * up.w;
                    *(v2u*)(H + row * 512 + u.pnl * 128 + wc * 32 + n * 16 + 4 * fq) = pk4(o); } }
    }
};
struct EpiPle {
    static constexpr bool PERM = false;
    const float* x2; const bf16* Eraw; const float* rse; const float* gpn; float* O;
    __device__ __forceinline__ void operator()(const f32x4 (&acc)[2][2][4][2], const pg8::Unit& u, int wr, int wc, int fr, int fq) const {
        EPI_LOOP_BEGIN
            const f32x4 e = unpk4(*(const v2u*)(Eraw + row * D + col)); const f32x4 g = *(const f32x4*)(gpn + col); const float rs = rse[row]; f32x4 o = *(const f32x4*)(x2 + row * D + col);
            o.x += sigmoidf_(a.x) * e.x * rs * g.x; o.y += sigmoidf_(a.y) * e.y * rs * g.y; o.z += sigmoidf_(a.z) * e.z * rs * g.z; o.w += sigmoidf_(a.w) * e.w * rs * g.w;
            *(f32x4*)(O + row * D + col) = o;
        EPI_LOOP_END
    }
};

__device__ __forceinline__ float gelu_tanh(float x) { const float u = 0.7978845608028654f * (x + 0.044715f * x * x * x); const float t = 1.0f - 2.0f * __builtin_amdgcn_rcpf(__expf(2.0f * u) + 1.0f); return 0.5f * x * (1.0f + t); }

__device__ __forceinline__ void compress_task(Frame& F, int idx) {
    const int kv = idx & 1, tile8 = (idx >> 1) & 7, bg = idx >> 4, b = bg >> 1, g = bg & 1;
    const int fr = F.lane & 15, fq = F.lane >> 4;
    const bf16* z = (const bf16*)(F.ws + WS_Z);
    const bf16* w1T = (const bf16*)(F.ws + WS_SMALLW + (kv ? SW_CV1 : SW_CK1));
    const bf16* w2T = (const bf16*)(F.ws + WS_SMALLW + (kv ? SW_CV2 : SW_CK2));
    const float* pos = kv ? F.ap->in[16] : F.ap->in[15];
    const int j0 = 16 * tile8; int j = j0 + fr; const bool jvalid = j < 127; if (!jvalid) j = 126;
    const bf16* zb = z + ((size_t)b * SEQ + 16 * j) * NZ + (kv ? ZC_VC : ZC_KC) + g * 64;
    f32x4 acc[4];
#pragma unroll
    for (int mt = 0; mt < 4; ++mt) acc[mt] = (f32x4){0.f, 0.f, 0.f, 0.f};
#pragma unroll 2
    for (int ks = 0; ks < 64; ++ks) {
        const int l = ks >> 1, d = 32 * (ks & 1) + 8 * fq;
        const v4u zr = *(const v4u*)(zb + (size_t)l * NZ + d);
        const f32x4 p0 = *(const f32x4*)(pos + l * 64 + d), p1 = *(const f32x4*)(pos + l * 64 + d + 4);
        float f[8]; unpk8(zr, f);
        v4u bb; bb.x = pk2(f[0] + p0.x, f[1] + p0.y); bb.y = pk2(f[2] + p0.z, f[3] + p0.w); bb.z = pk2(f[4] + p1.x, f[5] + p1.y); bb.w = pk2(f[6] + p1.z, f[7] + p1.w);
        const bf16x8 bop = __builtin_bit_cast(bf16x8, bb);
#pragma unroll
        for (int mt = 0; mt < 4; ++mt) { const bf16x8 aop = *(const bf16x8*)(w1T + (size_t)(16 * mt + fr) * 2048 + 32 * ks + 8 * fq); acc[mt] = MFMA16(aop, bop, acc[mt]); }
    }
    bf16x8 hb[2];
#pragma unroll
    for (int s2 = 0; s2 < 2; ++s2) { v4u w; const f32x4 a0 = acc[2 * s2], a1 = acc[2 * s2 + 1];
        w.x = pk2(gelu_tanh(a0.x), gelu_tanh(a0.y)); w.y = pk2(gelu_tanh(a0.z), gelu_tanh(a0.w)); w.z = pk2(gelu_tanh(a1.x), gelu_tanh(a1.y)); w.w = pk2(gelu_tanh(a1.z), gelu_tanh(a1.w));
        hb[s2] = __builtin_bit_cast(bf16x8, w); }
    bf16* kcmp = (bf16*)(F.ws + WS_KCMP); bf16* vcmpT = (bf16*)(F.ws + WS_KCMP + 512 * 1024);
#pragma unroll
    for (int ntl = 0; ntl < 4; ++ntl) {
        f32x4 o = (f32x4){0.f, 0.f, 0.f, 0.f};
#pragma unroll
        for (int s2 = 0; s2 < 2; ++s2) { const bf16* wp = w2T + (size_t)(16 * ntl + fr) * 64 + 32 * s2 + 4 * fq; const v2u lo = *(const v2u*)wp, hi = *(const v2u*)(wp + 16);
            v4u aw; aw.x = lo.x; aw.y = lo.y; aw.z = hi.x; aw.w = hi.y; o = MFMA16(__builtin_bit_cast(bf16x8, aw), hb[s2], o); }
        if (!jvalid) o = (f32x4){0.f, 0.f, 0.f, 0.f};
        const int jj = j0 + fr, n = 16 * ntl + 4 * fq;
        if (kv == 0) *(v2u*)(kcmp + ((size_t)bg * 128 + jj) * 64 + n) = pk4(o);
        else { const v2u w = pk4(o); bf16* vp = vcmpT + ((size_t)bg * 64 + n) * 128 + jj; vp[0] = (bf16)(w.x & 0xffff); vp[128] = (bf16)(w.x >> 16); vp[256] = (bf16)(w.y & 0xffff); vp[384] = (bf16)(w.y >> 16); }
    }
}
__device__ __forceinline__ void zgate_task(Frame& F, int tile) {
    const int fr = F.lane & 15, fq = F.lane >> 4, m0 = tile * 16;
    const bf16* XN = (const bf16*)(F.ws + WS_XN); const bf16* gw = (const bf16*)(F.ws + WS_SMALLW + SW_GATEW);
    f32x4 acc[2] = {(f32x4){0.f, 0.f, 0.f, 0.f}, (f32x4){0.f, 0.f, 0.f, 0.f}};
#pragma unroll 4
    for (int ks = 0; ks < 32; ++ks) {
        const bf16x8 bop = *(const bf16x8*)(XN + (size_t)(m0 + fr) * D + 32 * ks + 8 * fq);
#pragma unroll
        for (int ct = 0; ct < 2; ++ct) { const bf16x8 aop = *(const bf16x8*)(gw + (size_t)(16 * ct + fr) * D + 32 * ks + 8 * fq); acc[ct] = MFMA16(aop, bop, acc[ct]); }
    }
    float* zg = (float*)(F.ws + WS_ZGATE);
#pragma unroll
    for (int ct = 0; ct < 2; ++ct) *(f32x4*)(zg + (size_t)(m0 + fr) * 32 + 16 * ct + 4 * fq) = acc[ct];
}
__device__ __forceinline__ void vt_task(Frame& F, int idx) {
    const int which = idx & 1, blk = (idx >> 1) & 31, bg = idx >> 6, b = bg >> 1, g = bg & 1;
    const bf16* z = (const bf16*)(F.ws + WS_Z);
    bf16* vT = (bf16*)(F.ws + (which ? WS_VWT : WS_VST));
    const int t = 64 * blk + F.lane;
    const bf16* src = z + ((size_t)b * SEQ + t) * NZ + (which ? ZC_VW : ZC_VS) + g * 64;
#pragma unroll
    for (int dc = 0; dc < 8; ++dc) { const v4u w = *(const v4u*)(src + 8 * dc); bf16* dst = vT + ((size_t)bg * 64 + 8 * dc) * SEQ + t;
        dst[0 * SEQ] = (bf16)(w.x & 0xffff); dst[1 * SEQ] = (bf16)(w.x >> 16); dst[2 * SEQ] = (bf16)(w.y & 0xffff); dst[3 * SEQ] = (bf16)(w.y >> 16);
        dst[4 * SEQ] = (bf16)(w.z & 0xffff); dst[5 * SEQ] = (bf16)(w.z >> 16); dst[6 * SEQ] = (bf16)(w.w & 0xffff); dst[7 * SEQ] = (bf16)(w.w >> 16); }
}
__device__ __forceinline__ void alora_task(Frame& F, int m) {
    const bf16* z = (const bf16*)(F.ws + WS_Z); bf16* AL = (bf16*)(F.ws + WS_PBF);
    const int l = F.lane, t = m & (SEQ - 1);
    const f32x4 cur = unpk4(*(const v2u*)(z + (size_t)m * NZ + ZC_W + 4 * l));
    f32x4 prev = (f32x4){0.f, 0.f, 0.f, 0.f}; if (t > 0) prev = unpk4(*(const v2u*)(z + (size_t)(m - 1) * NZ + ZC_W + 4 * l));
    const f32x4 mu = *(const f32x4*)(F.ap->in[4] + ZC_W + 4 * l);
    f32x4 s = cur + (prev - cur) * mu;
    if (l < 16) { s.x = tanhf(s.x); s.y = tanhf(s.y); s.z = tanhf(s.z); s.w = tanhf(s.w); }
    else if (l >= 32) { s.x = sigmoidf_(s.x); s.y = sigmoidf_(s.y); s.z = sigmoidf_(s.z); s.w = sigmoidf_(s.w); }
    *(v2u*)(AL + (size_t)m * 256 + 4 * l) = pk4(s);
}
__device__ __forceinline__ void p2_prep(Frame& F) {
    constexpr int T0 = 256, T1 = T0 + 1024, T2 = T1 + 1024, T3 = T2 + M;
    for (int task = F.gw; task < T3; task += F.NGW) {
        if (task < T0) compress_task(F, task);
        else if (task < T1) zgate_task(F, task - T0);
        else if (task < T2) vt_task(F, task - T1);
        else alora_task(F, task - T2);
    }
}

__device__ __forceinline__ void rwkv_prep_task(Frame& F, int task) {
    const int h = task & 7, m0 = (task >> 3) * 16, fr = F.lane & 15, fq = F.lane >> 4, m = m0 + fr, t = m & (SEQ - 1);
    const bf16* z = (const bf16*)(F.ws + WS_Z); const bf16* AL = (const bf16*)(F.ws + WS_PBF);
    const bf16* w2T = (const bf16*)(F.ws + WS_SMALLW + SW_W2T); const bf16* a2T = (const bf16*)(F.ws + WS_SMALLW + SW_A2T); const bf16* g2T = (const bf16*)(F.ws + WS_SMALLW + SW_G2T);
    bf16* scanin = (bf16*)(F.ws + WS_S); bf16* vbuf = (bf16*)(F.ws + WS_S + 80 * MiB); bf16* gbuf = (bf16*)(F.ws + WS_G);
    bf16x8 bw[2], ba[2], bgf[4];
    const bf16* alr = AL + (size_t)m * 256 + 8 * fq;
#pragma unroll
    for (int ks = 0; ks < 2; ++ks) { bw[ks] = *(const bf16x8*)(alr + 32 * ks); ba[ks] = *(const bf16x8*)(alr + 64 + 32 * ks); }
#pragma unroll
    for (int ks = 0; ks < 4; ++ks) bgf[ks] = *(const bf16x8*)(alr + 128 + 32 * ks);
    const float* mu = F.ap->in[4]; const float* w0 = F.ap->in[5]; const float* a0 = F.ap->in[7]; const float* k_k = F.ap->in[10]; const float* k_a = F.ap->in[11];
    float kkraw[4][4], av[4][4], zkv[4][4];
    float ss = 0.f;
#pragma unroll
    for (int n = 0; n < 4; ++n) {
        const int c0 = h * 64 + 16 * n;
        f32x4 accw = (f32x4){0.f, 0.f, 0.f, 0.f}, acca = accw, accg = accw;
#pragma unroll
        for (int ks = 0; ks < 2; ++ks) { accw = MFMA16(*(const bf16x8*)(w2T + (size_t)(c0 + fr) * 64 + 32 * ks + 8 * fq), bw[ks], accw); acca = MFMA16(*(const bf16x8*)(a2T + (size_t)(c0 + fr) * 64 + 32 * ks + 8 * fq), ba[ks], acca); }
#pragma unroll
        for (int ks = 0; ks < 4; ++ks) accg = MFMA16(*(const bf16x8*)(g2T + (size_t)(c0 + fr) * 128 + 32 * ks + 8 * fq), bgf[ks], accg);
        const int c = c0 + 4 * fq;
        const bf16* zc = z + (size_t)m * NZ + c; const bf16* zp = zc - NZ;
        f32x4 zr = unpk4(*(const v2u*)(zc + ZC_R)), zk = unpk4(*(const v2u*)(zc + ZC_K)), zv = unpk4(*(const v2u*)(zc + ZC_V));
        f32x4 pr = (f32x4){0.f, 0.f, 0.f, 0.f}, pk = pr, pv = pr;
        if (t > 0) { pr = unpk4(*(const v2u*)(zp + ZC_R)); pk = unpk4(*(const v2u*)(zp + ZC_K)); pv = unpk4(*(const v2u*)(zp + ZC_V)); }
        zr = zr + (pr - zr) * *(const f32x4*)(mu + ZC_R + c); zk = zk + (pk - zk) * *(const f32x4*)(mu + ZC_K + c); zv = zv + (pv - zv) * *(const f32x4*)(mu + ZC_V + c);
        const f32x4 w0v = *(const f32x4*)(w0 + c), a0v = *(const f32x4*)(a0 + c), kkv = *(const f32x4*)(k_k + c);
        f32x4 ev;
#pragma unroll
        for (int r = 0; r < 4; ++r) {
            const float x = -(w0v[r] + accw[r]);
            const float sp = fmaxf(x, 0.f) + __logf(1.0f + __expf(-fabsf(x)));
            ev[r] = __expf(-sp - 0.5f);
            av[n][r] = sigmoidf_(a0v[r] + acca[r]);
            zkv[n][r] = zk[r]; kkraw[n][r] = zk[r] * kkv[r]; ss += kkraw[n][r] * kkraw[n][r];
        }
        bf16* sp_ = scanin + ((size_t)m * 8 + h) * 320 + 16 * n + 4 * fq;
        *(v2u*)(sp_ + 0) = pk4(zr); *(v2u*)(sp_ + 64) = pk4(ev);
        *(v2u*)(vbuf + (size_t)m * 512 + c) = pk4(zv);
        *(v2u*)(gbuf + (size_t)m * 512 + c) = pk4(accg);
    }
    ss += __shfl_xor(ss, 16); ss += __shfl_xor(ss, 32);
    const float inv = 1.0f / fmaxf(sqrtf(ss), 1e-12f);
#pragma unroll
    for (int n = 0; n < 4; ++n) {
        const int c = h * 64 + 16 * n + 4 * fq; const f32x4 kav = *(const f32x4*)(k_a + c);
        f32x4 kp, kk, kka;
#pragma unroll
        for (int r = 0; r < 4; ++r) { kk[r] = kkraw[n][r] * inv; kka[r] = kk[r] * av[n][r]; kp[r] = zkv[n][r] * (1.0f + (av[n][r] - 1.0f) * kav[r]); }
        bf16* sp_ = scanin + ((size_t)m * 8 + h) * 320 + 16 * n + 4 * fq;
        *(v2u*)(sp_ + 128) = pk4(kp); *(v2u*)(sp_ + 192) = pk4(kk); *(v2u*)(sp_ + 256) = pk4(kka);
    }
}

__device__ __forceinline__ float nsa_slope(int g, int r) { return __uint_as_float((unsigned)(127 - (g * 4 + r + 1)) << 23); }

__device__ __forceinline__ void nsa_cmp_task(Frame& F, int task) {
    const int tile = task & 127, bg = task >> 7, b = bg >> 1, g = bg & 1;
    const int fr = F.lane & 15, fq = F.lane >> 4, t = tile * 16 + fr, m = b * SEQ + t;
    const bf16* z = (const bf16*)(F.ws + WS_Z);
    const bf16* kcmp = (const bf16*)(F.ws + WS_KCMP) + (size_t)bg * 128 * 64; const bf16* vcmpT = (const bf16*)(F.ws + WS_KCMP + 512 * 1024) + (size_t)bg * 64 * 128;
    const float* zg = (const float*)(F.ws + WS_ZGATE); const float* gb = F.ap->in[21];
    bf16* Y = (bf16*)(F.ws + WS_YB);
    const int tv = t - 31 - 64 * fq; const float tb = (float)t - 15.5f - 64.0f * (float)fq;
    float impl[8], imp3[8];
#pragma unroll
    for (int kt = 0; kt < 8; ++kt) { impl[kt] = 0.f; imp3[kt] = 0.f; }
#pragma unroll 1
    for (int r = 0; r < 4; ++r) {
        const float slope = nsa_slope(g, r);
        const bf16* qp = z + (size_t)m * NZ + ZC_Q + (g * 4 + r) * 64 + 8 * fq;
        const bf16x8 q0 = *(const bf16x8*)qp, q1 = *(const bf16x8*)(qp + 32);
        float s[8][4]; float mx = -1e30f;
#pragma unroll
        for (int kt = 0; kt < 8; ++kt) {
            const bf16* kp = kcmp + (size_t)(16 * kt + fr) * 64 + 8 * fq;
            f32x4 a = (f32x4){0.f, 0.f, 0.f, 0.f};
            a = MFMA16(*(const bf16x8*)kp, q0, a); a = MFMA16(*(const bf16x8*)(kp + 32), q1, a);
#pragma unroll
            for (int rg = 0; rg < 4; ++rg) { const bool valid = ((256 * kt + 16 * rg) <= tv);
                const float sc = a[rg] * 0.125f - slope * (tb - (float)(256 * kt + 16 * rg)); s[kt][rg] = valid ? sc : -1e30f; mx = fmaxf(mx, s[kt][rg]); }
            if (kt & 1) asm volatile("" ::: "memory");
        }
        mx = fmaxf(mx, __shfl_xor(mx, 16)); mx = fmaxf(mx, __shfl_xor(mx, 32));
        float sum = 0.f;
#pragma unroll
        for (int kt = 0; kt < 8; ++kt)
#pragma unroll
            for (int rg = 0; rg < 4; ++rg) { const float p = (s[kt][rg] > -1e29f) ? __expf(s[kt][rg] - mx) : 0.f; s[kt][rg] = p; sum += p; }
        sum += __shfl_xor(sum, 16); sum += __shfl_xor(sum, 32);
        const float inv = sum > 0.f ? 1.0f / sum : 0.f;
#pragma unroll
        for (int kt = 0; kt < 8; ++kt) {
#pragma unroll
            for (int rg = 0; rg < 4; ++rg) s[kt][rg] *= inv;
            impl[kt] += s[kt][0] + s[kt][1] + s[kt][2] + 0.5f * s[kt][3]; imp3[kt] += s[kt][3]; }
        f32x4 o[4];
#pragma unroll
        for (int dt = 0; dt < 4; ++dt) o[dt] = (f32x4){0.f, 0.f, 0.f, 0.f};
#pragma unroll
        for (int s2 = 0; s2 < 4; ++s2) {
            v4u pw; pw.x = pk2(s[2 * s2][0], s[2 * s2][1]); pw.y = pk2(s[2 * s2][2], s[2 * s2][3]); pw.z = pk2(s[2 * s2 + 1][0], s[2 * s2 + 1][1]); pw.w = pk2(s[2 * s2 + 1][2], s[2 * s2 + 1][3]);
            const bf16x8 pb = __builtin_bit_cast(bf16x8, pw);
#pragma unroll
            for (int dt = 0; dt < 4; ++dt) { const bf16* vp = vcmpT + (size_t)(16 * dt + fr) * 128 + 32 * s2 + 4 * fq; const v2u lo = *(const v2u*)vp, hi = *(const v2u*)(vp + 16);
                v4u aw; aw.x = lo.x; aw.y = lo.y; aw.z = hi.x; aw.w = hi.y; o[dt] = MFMA16(__builtin_bit_cast(bf16x8, aw), pb, o[dt]); }
            asm volatile("" ::: "memory");
        }
        const int hh = g * 4 + r; const float gate = sigmoidf_(zg[(size_t)m * 32 + hh * 3 + 0] + gb[hh * 3 + 0]);
#pragma unroll
        for (int dt = 0; dt < 4; ++dt) *(v2u*)(Y + (size_t)m * 512 + hh * 64 + 16 * dt + 4 * fq) = pk4(o[dt] * gate);
    }
    LAS float* sc = (LAS float*)(F.lds + F.wave * 4096);
    float y3prev = 0.f;
#pragma unroll
    for (int kt = 0; kt < 8; ++kt) {
        const float y3 = __shfl(imp3[kt], (F.lane + 48) & 63);
        const float prev = (fq > 0) ? y3 : y3prev; y3prev = y3;
        sc[fr * 33 + 4 * kt + fq] = impl[kt] + 0.5f * prev;
    }
    LDS_WAIT(); __builtin_amdgcn_wave_barrier(); asm volatile("" ::: "memory");
    const int blk_t = t >> 6, chi = blk_t - 2;
    unsigned mask = 1u | (1u << blk_t) | (blk_t > 0 ? (1u << (blk_t - 1)) : 0u);
#pragma unroll
    for (int kt = 0; kt < 8; ++kt) {
        const int k = 4 * kt + fq;
        if (k >= 1 && k <= chi) { const float me = sc[fr * 33 + k]; int rank = 0;
            for (int k2 = 1; k2 <= chi; ++k2) { const float o = sc[fr * 33 + k2]; rank += (o > me || (o == me && k2 < k)) ? 1 : 0; }
            if (rank < 5) mask |= (1u << k); }
    }
    mask |= (unsigned)__shfl_xor((int)mask, 16); mask |= (unsigned)__shfl_xor((int)mask, 32);
    if (fq == 0) ((unsigned*)(F.ws + WS_SELMASK))[(size_t)bg * SEQ + t] = mask;
    LDS_WAIT(); __builtin_amdgcn_wave_barrier(); asm volatile("" ::: "memory");
}
__device__ __forceinline__ void p3_phase(Frame& F) {
    constexpr int T0 = 2048, T1 = T0 + 8192;
    for (int task = F.gw; task < T0; task += F.NGW) nsa_cmp_task(F, task);
    asm volatile("" ::: "memory");
    for (int task = F.gw; task < T1 - T0; task += F.NGW) rwkv_prep_task(F, task);
}

template <int WHICH>
__device__ __forceinline__ void nsa_blk_task(Frame& F, int task) {
    const int hp = task & 1, tile = (task >> 1) & 127, bg = task >> 8, b = bg >> 1, g = bg & 1;
    const int fr = F.lane & 15, fq = F.lane >> 4, t0 = tile * 16, t = t0 + fr, m = b * SEQ + t;
    const bf16* z = (const bf16*)(F.ws + WS_Z);
    const bf16* Kb = z + (size_t)b * SEQ * NZ + (WHICH ? ZC_KW : ZC_KS) + g * 64;
    const bf16* VT = (const bf16*)(F.ws + (WHICH ? WS_VWT : WS_VST)) + (size_t)bg * 64 * SEQ;
    unsigned mymask, tile_or; const int kb_hi = (t0 + 15) >> 6;
    if (WHICH == 0) { mymask = ((const unsigned*)(F.ws + WS_SELMASK))[(size_t)bg * SEQ + t]; unsigned x = mymask; x |= (unsigned)__shfl_xor((int)x, 1); x |= (unsigned)__shfl_xor((int)x, 2); x |= (unsigned)__shfl_xor((int)x, 4); x |= (unsigned)__shfl_xor((int)x, 8);
        tile_or = (unsigned)__builtin_amdgcn_readfirstlane((int)x); }
    else { mymask = 0xffffffffu; const int lo = (t0 - 511) > 0 ? ((t0 - 511) >> 6) : 0; tile_or = 0u; for (int k = lo; k <= kb_hi; ++k) tile_or |= (1u << k); }
    const int h0 = g * 4 + 2 * hp;
    bf16x8 qf[2][2];
#pragma unroll
    for (int r = 0; r < 2; ++r) { const bf16* qp = z + (size_t)m * NZ + ZC_Q + (h0 + r) * 64 + 8 * fq; qf[r][0] = *(const bf16x8*)qp; qf[r][1] = *(const bf16x8*)(qp + 32); }
    f32x4 O[2][4]; float mrun[2], lrun[2];
#pragma unroll
    for (int r = 0; r < 2; ++r) { mrun[r] = -1e30f; lrun[r] = 0.f;
#pragma unroll
        for (int dt = 0; dt < 4; ++dt) O[r][dt] = (f32x4){0.f, 0.f, 0.f, 0.f}; }
    const float slope0 = __uint_as_float((unsigned)(127 - (h0 + 1)) << 23);
    for (int kb = 0; kb <= kb_hi; ++kb) {
        if (!((tile_or >> kb) & 1u)) continue;
        const int kpos0 = 64 * kb;
        bf16x8 kf[4][2];
#pragma unroll
        for (int kt = 0; kt < 4; ++kt) { const bf16* kp = Kb + (size_t)(kpos0 + 16 * kt + fr) * NZ + 8 * fq; kf[kt][0] = *(const bf16x8*)kp; kf[kt][1] = *(const bf16x8*)(kp + 32); }
        const bool bsel = (mymask >> kb) & 1u; const int dbase = t - 4 * fq - kpos0;
        bf16x8 P[2][2];
#pragma unroll
        for (int r = 0; r < 2; ++r) {
            const float slope = r ? 0.5f * slope0 : slope0;
            float s[4][4]; float bm = -1e30f;
#pragma unroll
            for (int kt = 0; kt < 4; ++kt) { f32x4 a = (f32x4){0.f, 0.f, 0.f, 0.f}; a = MFMA16(kf[kt][0], qf[r][0], a); a = MFMA16(kf[kt][1], qf[r][1], a);
#pragma unroll
                for (int rg = 0; rg < 4; ++rg) { const int dist = dbase - (16 * kt + rg); const bool valid = bsel && dist >= 0 && (WHICH == 0 || dist < 512);
                    s[kt][rg] = valid ? (a[rg] * 0.125f - slope * (float)dist) : -1e30f; bm = fmaxf(bm, s[kt][rg]); } }
            bm = fmaxf(bm, __shfl_xor(bm, 16)); bm = fmaxf(bm, __shfl_xor(bm, 32));
            const float mnew = fmaxf(mrun[r], bm); const float scale = __expf(mrun[r] - mnew); mrun[r] = mnew;
            float ps = 0.f;
#pragma unroll
            for (int kt = 0; kt < 4; ++kt)
#pragma unroll
                for (int rg = 0; rg < 4; ++rg) { const float p = (s[kt][rg] > -1e29f) ? __expf(s[kt][rg] - mnew) : 0.f; s[kt][rg] = p; ps += p; }
            lrun[r] = lrun[r] * scale + ps;
#pragma unroll
            for (int dt = 0; dt < 4; ++dt) O[r][dt] = O[r][dt] * scale;
#pragma unroll
            for (int s2 = 0; s2 < 2; ++s2) { v4u pw; pw.x = pk2(s[2 * s2][0], s[2 * s2][1]); pw.y = pk2(s[2 * s2][2], s[2 * s2][3]); pw.z = pk2(s[2 * s2 + 1][0], s[2 * s2 + 1][1]); pw.w = pk2(s[2 * s2 + 1][2], s[2 * s2 + 1][3]);
                P[r][s2] = __builtin_bit_cast(bf16x8, pw); }
        }
#pragma unroll
        for (int dt = 0; dt < 4; ++dt)
#pragma unroll
            for (int s2 = 0; s2 < 2; ++s2) { const bf16* vp = VT + (size_t)(16 * dt + fr) * SEQ + kpos0 + 32 * s2 + 4 * fq; const v2u lo = *(const v2u*)vp, hi = *(const v2u*)(vp + 16);
                v4u aw; aw.x = lo.x; aw.y = lo.y; aw.z = hi.x; aw.w = hi.y; const bf16x8 vf = __builtin_bit_cast(bf16x8, aw);
#pragma unroll
                for (int r = 0; r < 2; ++r) O[r][dt] = MFMA16(vf, P[r][s2], O[r][dt]); }
    }
    const float* zg = (const float*)(F.ws + WS_ZGATE); const float* gb = F.ap->in[21];
    bf16* Y = (bf16*)(F.ws + WS_YB + (size_t)(1 + WHICH) * 16 * MiB);
#pragma unroll
    for (int r = 0; r < 2; ++r) { float l = lrun[r]; l += __shfl_xor(l, 16); l += __shfl_xor(l, 32);
        const int hh = h0 + r; const float gate = sigmoidf_(zg[(size_t)m * 32 + hh * 3 + 1 + WHICH] + gb[hh * 3 + 1 + WHICH]); const float f = gate / l;
#pragma unroll
        for (int dt = 0; dt < 4; ++dt) *(v2u*)(Y + (size_t)m * 512 + hh * 64 + 16 * dt + 4 * fq) = pk4(O[r][dt] * f); }
}
__device__ __forceinline__ void p4_phase(Frame& F) {
    for (int task = F.gw; task < 4096; task += F.NGW) nsa_blk_task<1>(F, task);
    asm volatile("" ::: "memory");
    for (int task = F.gw; task < 4096; task += F.NGW) nsa_blk_task<0>(F, task);
}

constexpr int SC_T = 32, SC_BUF_F = SC_T * 320 + SC_T * 16;
__device__ __forceinline__ void scan_load_chunk(Frame& F, int b, int h, int i0, int c, LAS float* buf) {
    const int lt = F.tid - 256;
    const bf16* scanin = (const bf16*)(F.ws + WS_S); const bf16* vbuf = (const bf16*)(F.ws + WS_S + 80 * MiB);
    const size_t mbase = (size_t)b * SEQ + (size_t)c * SC_T;
    v4u w[5];
#pragma unroll
    for (int i = 0; i < 5; ++i) { const int p = lt + 256 * i, step = p / 40, q = p % 40; w[i] = *(const v4u*)(scanin + ((mbase + step) * 8 + h) * 320 + q * 8); }
    v4u wv = (v4u){0u, 0u, 0u, 0u};
    if (lt < 64) { const int step = lt >> 1, half = lt & 1; wv = *(const v4u*)(vbuf + (mbase + step) * 512 + h * 64 + i0 + 8 * half); }
#pragma unroll
    for (int i = 0; i < 5; ++i) { const int p = lt + 256 * i, step = p / 40, q = p % 40; float f[8]; unpk8(w[i], f);
        if ((q >> 3) == 1) {
#pragma unroll
            for (int j = 0; j < 8; ++j) f[j] = __expf(-f[j]); }
        LAS float* d = buf + step * 320 + q * 8; *(LAS f32x4*)d = (f32x4){f[0], f[1], f[2], f[3]}; *(LAS f32x4*)(d + 4) = (f32x4){f[4], f[5], f[6], f[7]}; }
    if (lt < 64) { const int step = lt >> 1, half = lt & 1; float f[8]; unpk8(wv, f); LAS float* d = buf + SC_T * 320 + step * 16 + 8 * half; *(LAS f32x4*)d = (f32x4){f[0], f[1], f[2], f[3]}; *(LAS f32x4*)(d + 4) = (f32x4){f[4], f[5], f[6], f[7]}; }
}
__device__ __forceinline__ void p5_scan(Frame& F) {
    const int bh = F.vcu >> 2, b = bh >> 3, h = bh & 7, i0 = (F.vcu & 3) * 16;
    LAS float* ring = (LAS float*)F.lds;
    float* oraw = (float*)(F.ws + WS_XN);
    const bool loader = F.wave >= 4;
    if (loader) { scan_load_chunk(F, b, h, i0, 0, ring); scan_load_chunk(F, b, h, i0, 1, ring + SC_BUF_F); }
    LDS_WAIT(); __syncthreads();
    const int jq = F.lane & 15, il = 4 * F.wave + (F.lane >> 4);
    f32x4 S = (f32x4){0.f, 0.f, 0.f, 0.f};
    constexpr int NCH = SEQ / SC_T;
    for (int c = 0; c < NCH; ++c) {
        if (loader) { if (c + 2 < NCH) scan_load_chunk(F, b, h, i0, c + 2, ring + ((c + 2) % 3) * SC_BUF_F); }
        else {
            const LAS float* buf = ring + (c % 3) * SC_BUF_F;
            float* op = oraw + ((size_t)b * SEQ + (size_t)c * SC_T) * 512 + h * 64 + i0 + il;
#pragma unroll 4
            for (int st = 0; st < SC_T; ++st) {
                const LAS float* sp = buf + st * 320 + 4 * jq;
                const f32x4 r = *(const LAS f32x4*)(sp), w = *(const LAS f32x4*)(sp + 64), k = *(const LAS f32x4*)(sp + 128), kk = *(const LAS f32x4*)(sp + 192), kka = *(const LAS f32x4*)(sp + 256);
                const float v = buf[SC_T * 320 + st * 16 + il];
                float dot = (S.x * kk.x + S.y * kk.y) + (S.z * kk.z + S.w * kk.w);
                dot = row16_sum(dot);
                const float sa = -dot;
                S.x = S.x * w.x + (sa * kka.x + v * k.x); S.y = S.y * w.y + (sa * kka.y + v * k.y); S.z = S.z * w.z + (sa * kka.z + v * k.z); S.w = S.w * w.w + (sa * kka.w + v * k.w);
                float o = (S.x * r.x + S.y * r.y) + (S.z * r.z + S.w * r.w);
                o = row16_sum(o);
                if (jq == 0) op[(size_t)st * 512] = o;
            }
        }
        LDS_WAIT(); __syncthreads();
    }
}

__device__ __forceinline__ void p6_task(Frame& F, int m) {
    const int l = F.lane, c = 8 * l, h = l >> 3, i = c & 63;
    const float* oraw = (const float*)(F.ws + WS_XN) + (size_t)m * 512 + c;
    const bf16* scanin = (const bf16*)(F.ws + WS_S) + ((size_t)m * 8 + h) * 320 + i;
    const bf16* vbuf = (const bf16*)(F.ws + WS_S + 80 * MiB) + (size_t)m * 512 + c; const bf16* gbuf = (const bf16*)(F.ws + WS_G) + (size_t)m * 512 + c;
    float o[8]; { const f32x4 a = *(const f32x4*)oraw, b2 = *(const f32x4*)(oraw + 4); o[0] = a.x; o[1] = a.y; o[2] = a.z; o[3] = a.w; o[4] = b2.x; o[5] = b2.y; o[6] = b2.z; o[7] = b2.w; }
    float s = 0.f;
#pragma unroll
    for (int j = 0; j < 8; ++j) s += o[j];
    s += __shfl_xor(s, 1); s += __shfl_xor(s, 2); s += __shfl_xor(s, 4);
    const float mu = s * (1.f / 64.f); float q = 0.f;
#pragma unroll
    for (int j = 0; j < 8; ++j) { o[j] -= mu; q += o[j] * o[j]; }
    q += __shfl_xor(q, 1); q += __shfl_xor(q, 2); q += __shfl_xor(q, 4);
    const float rstd = 1.0f / sqrtf(q * (1.f / 64.f) + GN_EPS);
    float rr[8], kp[8], vv[8], gg[8];
    unpk8(*(const v4u*)(scanin), rr); unpk8(*(const v4u*)(scanin + 128), kp); unpk8(*(const v4u*)vbuf, vv); unpk8(*(const v4u*)gbuf, gg);
    const float* rk = F.ap->in[12] + h * 64 + i; const float* lw = F.ap->in[13] + c; const float* lb = F.ap->in[14] + c;
    float bs = 0.f;
#pragma unroll
    for (int j = 0; j < 8; ++j) bs += rr[j] * kp[j] * rk[j];
    bs += __shfl_xor(bs, 1); bs += __shfl_xor(bs, 2); bs += __shfl_xor(bs, 4);
    float y[8];
#pragma unroll
    for (int j = 0; j < 8; ++j) y[j] = (o[j] * rstd * lw[j] + lb[j] + bs * vv[j]) * gg[j];
    v4u w; w.x = pk2(y[0], y[1]); w.y = pk2(y[2], y[3]); w.z = pk2(y[4], y[5]); w.w = pk2(y[6], y[7]);
    *(v4u*)((bf16*)(F.ws + WS_YRW) + (size_t)m * 512 + c) = w;
    bf16* y0 = (bf16*)(F.ws + WS_YB) + (size_t)m * 512 + c; const bf16* y1 = y0 + 8 * MiB; const bf16* y2 = y0 + 16 * MiB;
    float a0[8], a1[8], a2[8]; unpk8(*(const v4u*)y0, a0); unpk8(*(const v4u*)y1, a1); unpk8(*(const v4u*)y2, a2);
    v4u w2; w2.x = pk2(a0[0] + a1[0] + a2[0], a0[1] + a1[1] + a2[1]); w2.y = pk2(a0[2] + a1[2] + a2[2], a0[3] + a1[3] + a2[3]); w2.z = pk2(a0[4] + a1[4] + a2[4], a0[5] + a1[5] + a2[5]); w2.w = pk2(a0[6] + a1[6] + a2[6], a0[7] + a1[7] + a2[7]);
    *(v4u*)y0 = w2;
}

__device__ __forceinline__ void route_task(Frame& F, int tile) {
    const int fr = F.lane & 15, fq = F.lane >> 4, m0 = tile * 16;
    const float* x1 = (const float*)(F.ws + WS_Z); const float* RW = (const float*)(F.ws + WS_SMALLW + SW_ROUTEW);
    f32x4 acc[3] = {(f32x4){0.f, 0.f, 0.f, 0.f}, (f32x4){0.f, 0.f, 0.f, 0.f}, (f32x4){0.f, 0.f, 0.f, 0.f}};
    float ssq = 0.f;
    const float* xp = x1 + (size_t)(m0 + fr) * D + fq; const float* wp = RW + (size_t)fr * D + fq;
#pragma unroll 8
    for (int ks = 0; ks < 256; ++ks) {
        const float bv = xp[4 * ks]; ssq += bv * bv;
#pragma unroll
        for (int ct = 0; ct < 3; ++ct) acc[ct] = __builtin_amdgcn_mfma_f32_16x16x4f32(wp[(size_t)ct * 16 * D + 4 * ks], bv, acc[ct], 0, 0, 0);
    }
    ssq += __shfl_xor(ssq, 16); ssq += __shfl_xor(ssq, 32);
    const float rs = 1.0f / sqrtf(ssq * (1.f / D) + NORM_EPS);
    LAS float* sc = (LAS float*)(F.lds + F.wave * 4096);
#pragma unroll
    for (int ct = 0; ct < 3; ++ct)
#pragma unroll
        for (int r = 0; r < 4; ++r) sc[fr * 49 + 16 * ct + 4 * fq + r] = acc[ct][r] * rs;
    if (fq == 0) sc[800 + fr] = rs;
    LDS_WAIT(); __builtin_amdgcn_wave_barrier(); asm volatile("" ::: "memory");
    if (F.lane < 16) {
        const int tok = m0 + F.lane; const LAS float* lg = sc + F.lane * 49;
        const float* bg = F.ap->in[27]; const float* br = F.ap->in[29];
        float gl[4]; int gs = 0; float gm = -3.0e38f;
#pragma unroll
        for (int c = 0; c < 4; ++c) { gl[c] = lg[c] + bg[c]; if (gl[c] > gm) { gm = gl[c]; gs = c; } }
        float gsum = 0.f;
#pragma unroll
        for (int c = 0; c < 4; ++c) gsum += __expf(gl[c] - gm);
        const float pgroup = 1.0f / gsum;
        float el[8]; float em = -3.0e38f;
#pragma unroll
        for (int c = 0; c < 8; ++c) { el[c] = lg[4 + gs * 8 + c] + br[gs * 8 + c]; em = fmaxf(em, el[c]); }
        int i1 = 0; float v1 = -3.0e38f;
#pragma unroll
        for (int c = 0; c < 8; ++c) if (el[c] > v1) { v1 = el[c]; i1 = c; }
        int i2 = 0; float v2 = -3.0e38f;
#pragma unroll
        for (int c = 0; c < 8; ++c) if (c != i1 && el[c] > v2) { v2 = el[c]; i2 = c; }
        const float p1 = __expf(v1 - em), p2 = __expf(v2 - em);
        const float g1 = pgroup * p1 / (p1 + p2), g2 = pgroup * p2 / (p1 + p2);
        unsigned* cnt = (unsigned*)(F.ws + WS_CTL) + CW_CNT; int* list = (int*)(F.ws + WS_LIST); float* gateA = (float*)(F.ws + WS_GATEA);
        const int e1 = gs * 8 + i1, e2 = gs * 8 + i2;
        unsigned* slotA = (unsigned*)(F.ws + WS_SLOTA);
        const unsigned q1 = atomicAdd(&cnt[e1], 1u); list[(size_t)e1 * 16384 + q1] = tok * 2 + 0; gateA[tok * 2 + 0] = g1; slotA[tok * 2 + 0] = ((unsigned)e1 << 16) | q1;
        const unsigned q2 = atomicAdd(&cnt[e2], 1u); list[(size_t)e2 * 16384 + q2] = tok * 2 + 1; gateA[tok * 2 + 1] = g2; slotA[tok * 2 + 1] = ((unsigned)e2 << 16) | q2;
    }
    const f32x4* gr = (const f32x4*)F.ap->in[25] + F.lane;
    bf16* XN = (bf16*)(F.ws + WS_XN);
    for (int rr = 0; rr < 16; ++rr) { const float rsr = sc[800 + rr]; const f32x4* xr = (const f32x4*)(x1 + (size_t)(m0 + rr) * D) + F.lane; v2u* o8 = (v2u*)(XN + (size_t)(m0 + rr) * D) + F.lane;
#pragma unroll
        for (int j = 0; j < 4; ++j) o8[64 * j] = pk4(xr[64 * j] * rsr * gr[64 * j]); }
    LDS_WAIT(); __builtin_amdgcn_wave_barrier(); asm volatile("" ::: "memory");
}
__device__ __forceinline__ void p9_phase(Frame& F) {
    for (int task = F.gw; task < 1024; task += F.NGW) route_task(F, task);
    const float* p = F.ap->in[1]; bf16* PB = (bf16*)(F.ws + WS_PBF);
    for (size_t idx = (size_t)F.gw * 64 + F.lane; idx < (size_t)M * 256 / 4; idx += (size_t)F.NGW * 64) *(v2u*)(PB + idx * 4) = pk4(*(const f32x4*)(p + idx * 4));
}

__device__ __forceinline__ void p12_row(Frame& F, int m) {
    float* x1 = (float*)(F.ws + WS_Z) + (size_t)m * D;
    const unsigned* cnt = (const unsigned*)(F.ws + WS_CTL) + CW_CNT; const unsigned* slotA = (const unsigned*)(F.ws + WS_SLOTA); const float* gateA = (const float*)(F.ws + WS_GATEA);
    const unsigned s0 = slotA[2 * m], s1 = slotA[2 * m + 1]; const int e0 = (int)(s0 >> 16), e1 = (int)(s1 >> 16);
    int acc = 0, pre0 = 0, pre1 = 0;
    for (int e = 0; e < 32; ++e) { if (e == e0) pre0 = acc; if (e == e1) pre1 = acc; acc += ((int)cnt[e] + 255) >> 8; }
    const size_t r0 = (size_t)pre0 * 256 + (s0 & 0xffffu), r1 = (size_t)pre1 * 256 + (s1 & 0xffffu);
    const float g0 = gateA[2 * m], g1 = gateA[2 * m + 1];
    const bf16* c0 = (const bf16*)(F.ws + WS_Z + 64 * MiB) + r0 * D; const bf16* c1 = (const bf16*)(F.ws + WS_Z + 64 * MiB) + r1 * D;
    const bf16* er = (const bf16*)(F.ws + WS_S + 64 * MiB) + (size_t)m * D;
    f32x4 v[4]; float s = 0.f, se = 0.f;
#pragma unroll
    for (int j = 0; j < 4; ++j) { const int o = 4 * F.lane + 256 * j; v[j] = *(const f32x4*)(x1 + o) + unpk4(*(const v2u*)(c0 + o)) * g0 + unpk4(*(const v2u*)(c1 + o)) * g1;
        s += (v[j].x * v[j].x + v[j].y * v[j].y) + (v[j].z * v[j].z + v[j].w * v[j].w);
        const f32x4 e = unpk4(*(const v2u*)(er + o)); se += (e.x * e.x + e.y * e.y) + (e.z * e.z + e.w * e.w);
        *(f32x4*)(x1 + o) = v[j]; }
    const float rs = 1.0f / sqrtf(wave_sum(s) * (1.f / D) + NORM_EPS); const float rse = 1.0f / sqrtf(wave_sum(se) * (1.f / D) + NORM_EPS);
    bf16* xn = (bf16*)(F.ws + WS_XN) + (size_t)m * D; const float* gi = F.ap->in[34];
#pragma unroll
    for (int j = 0; j < 4; ++j) { const int o = 4 * F.lane + 256 * j; *(v2u*)(xn + o) = pk4(v[j] * rs * *(const f32x4*)(gi + o)); }
    if (F.lane == 0) ((float*)(F.ws + WS_RSE))[m] = rse;
}
__device__ __forceinline__ void p14_row(Frame& F, int m) {
    float* xr = F.out + (size_t)m * D; const float* gf = F.ap->in[36];
    f32x4 v[4]; float s = 0.f;
#pragma unroll
    for (int j = 0; j < 4; ++j) { const int o = 4 * F.lane + 256 * j; v[j] = *(const f32x4*)(xr + o); s += (v[j].x * v[j].x + v[j].y * v[j].y) + (v[j].z * v[j].z + v[j].w * v[j].w); }
    const float rs = 1.0f / sqrtf(wave_sum(s) * (1.f / D) + NORM_EPS);
#pragma unroll
    for (int j = 0; j < 4; ++j) { const int o = 4 * F.lane + 256 * j; *(f32x4*)(xr + o) = v[j] * rs * *(const f32x4*)(gf + o); }
}

#ifndef MK_ONE_LAUNCH
#define MK_ONE_LAUNCH 1
#endif
constexpr int N_PHASES = 15;
__global__ void __launch_bounds__(NWAVES * 64, 2) mk_fwd(Args args) {
    extern __shared__ __attribute__((aligned(16))) unsigned char lds[];
    Frame F;
    F.lds = (LAS unsigned char*)lds;
    F.tid = threadIdx.x; F.lane = F.tid & 63; F.wave = __builtin_amdgcn_readfirstlane(F.tid >> 6);
    F.G = gridDim.x; { const int bx = blockIdx.x; F.vcu = (F.G % 8 == 0) ? (bx % 8) * (F.G / 8) + bx / 8 : bx; }
    F.gw = F.vcu * NWAVES + F.wave; F.NGW = F.G * NWAVES;
    F.ws = args.ws; F.out = args.out;
    F.ap = (ArgsP)__builtin_amdgcn_kernarg_segment_ptr();
    unsigned char* ws = args.ws;
    const int lo = args.ph_lo, hi = args.ph_hi;
#ifdef ONLY
#define IN(k) ((k) == ONLY && lo <= (k) && (k) < hi)
#else
#define IN(k) (lo <= (k) && (k) < hi)
#endif
#if MK_ONE_LAUNCH
    if (F.tid < 16) ((LAS unsigned*)(F.lds + MISC_OFF))[F.tid] = 0u;
    __syncthreads();
    XcdBarrier bar = xcd_barrier_post((unsigned*)(ws + WS_CTL) + CW_BAR, (volatile LAS unsigned*)(F.lds + MISC_OFF));
#define GRID_BAR(k) do { if (IN(k) && IN((k) + 1)) { if ((k) == 0) cg::this_grid().sync(); else xcd_barrier(bar); } } while (0)
#else
#define GRID_BAR(k) do { } while (0)
#endif
    LAS unsigned char* L = F.lds;
    const bf16* z = (const bf16*)(ws + WS_Z);

    if (IN(0)) { p0_prologue(F); } GRID_BAR(0);

    if (IN(1)) {
        pg8::Gemm g{(const bf16*)(ws + WS_XN), (const bf16*)(ws + WS_WIN), M, NZ, D, nullptr}; pg8::StaticOrder S; S.init(M, NZ, F.G, (int)blockIdx.x);
        EpiStoreBf16 E{(bf16*)(ws + WS_Z), NZ};
        pg8::gemm_phase<EpiStoreBf16, pg8::StaticOrder, true, false>(L, g, S, E);
    } GRID_BAR(1);

    if (IN(2)) { p2_prep(F); } GRID_BAR(2);
    if (IN(3)) { p3_phase(F); } GRID_BAR(3);
    if (IN(4)) { p4_phase(F); } GRID_BAR(4);
    if (IN(5)) { if (F.G == 256) p5_scan(F); } GRID_BAR(5);
    if (IN(6)) { for (int m = F.gw; m < M; m += F.NGW) p6_task(F, m); } GRID_BAR(6);

    if (IN(7)) {
        pg8::Gemm g{(const bf16*)(ws + WS_YRW), (const bf16*)(ws + WS_UR), 2 * M, 2 * D, 512, nullptr}; DualOrder S; S.S.init(M, D, F.G, (int)blockIdx.x);
        EpiMix E{z, (float*)(ws + WS_S), (bf16*)(ws + WS_S + 64 * MiB)};
        pg8::gemm_phase<EpiMix, DualOrder, true, false>(L, g, S, E);
    } GRID_BAR(7);

    if (IN(8)) {
        pg8::Gemm g{(const bf16*)(ws + WS_S + 64 * MiB), (const bf16*)(ws + WS_WO), M, D, D, nullptr}; pg8::StaticOrder S; S.init(M, D, F.G, (int)blockIdx.x);
        EpiResF32 E{F.ap->in[0], (float*)(ws + WS_Z)};
        pg8::gemm_phase<EpiResF32, pg8::StaticOrder, true, false>(L, g, S, E);
    } GRID_BAR(8);

    if (IN(9)) { p9_phase(F); } GRID_BAR(9);

    if (IN(10)) {
        pg8::Gemm g{(const bf16*)(ws + WS_XN), (const bf16*)(ws + WS_WGU), M, 1024, D, (const int*)(ws + WS_LIST)};
        pg8::MoeOrder S{(const unsigned*)(ws + WS_CTL) + CW_CNT, F.G, (int)blockIdx.x, false};
        EpiMoe1 E{(bf16*)(ws + WS_S)};
        pg8::gemm_phase<EpiMoe1, pg8::MoeOrder, true, true>(L, g, S, E);
    } GRID_BAR(10);

    if (IN(11)) {
#ifndef NO_MOE2
        { pg8::Gemm g{(const bf16*)(ws + WS_S), (const bf16*)(ws + WS_WD), M, 1024, 512, nullptr};
          pg8::MoeOrder S{(const unsigned*)(ws + WS_CTL) + CW_CNT, F.G, (int)blockIdx.x, true};
          EpiStoreBf16 E{(bf16*)(ws + WS_Z + 64 * MiB), D};
          pg8::gemm_phase<EpiStoreBf16, pg8::MoeOrder, true, false>(L, g, S, E); }
#endif
#ifndef NO_ERAW
        { pg8::Gemm g{(const bf16*)(ws + WS_PBF), (const bf16*)(ws + WS_WPP), M, D, 256, nullptr}; pg8::StaticOrder S; S.init(M, D, F.G, (int)blockIdx.x);
          EpiStoreBf16 E{(bf16*)(ws + WS_S + 64 * MiB), D};
          pg8::gemm_phase<EpiStoreBf16, pg8::StaticOrder, true, false>(L, g, S, E); }
#endif
    } GRID_BAR(11);

    if (IN(12)) { for (int m = F.gw; m < M; m += F.NGW) p12_row(F, m); } GRID_BAR(12);

    if (IN(13)) {
        pg8::Gemm g{(const bf16*)(ws + WS_XN), (const bf16*)(ws + WS_WPG), M, D, D, nullptr}; pg8::StaticOrder S; S.init(M, D, F.G, (int)blockIdx.x);
        EpiPle E{(const float*)(ws + WS_Z), (const bf16*)(ws + WS_S + 64 * MiB), (const float*)(ws + WS_RSE), F.ap->in[33], F.out};
        pg8::gemm_phase<EpiPle, pg8::StaticOrder, true, false>(L, g, S, E);
    } GRID_BAR(13);

    if (IN(14)) { for (int m = F.gw; m < M; m += F.NGW) p14_row(F, m); }
#undef IN
#undef GRID_BAR
}

extern "C" void kernel_launch(void* const* d_in, const int* in_sizes, int n_in, void* d_out, int out_size, void* d_ws, size_t ws_size, hipStream_t stream) {
    static int grid = 0;
    if (grid == 0) {
        if (n_in != 37 || out_size != M * D || ws_size < WS_END) { fprintf(stderr, "kernel_launch: unexpected problem (n_in %d, out %d, ws %zu < %zu); nothing launched\n", n_in, out_size, ws_size, (size_t)WS_END); grid = -1; return; }
        int dev = 0, cus = 0, per_cu = 0;
        if (hipGetDevice(&dev) != hipSuccess || hipDeviceGetAttribute(&cus, hipDeviceAttributeMultiprocessorCount, dev) != hipSuccess) { grid = -1; return; }
        if (hipFuncSetAttribute((const void*)mk_fwd, hipFuncAttributeMaxDynamicSharedMemorySize, LDS_BYTES) != hipSuccess) { fprintf(stderr, "kernel_launch: hipFuncSetAttribute failed\n"); grid = -1; return; }
        if (hipOccupancyMaxActiveBlocksPerMultiprocessor(&per_cu, (const void*)mk_fwd, NWAVES * 64, LDS_BYTES) != hipSuccess || per_cu < 1) { fprintf(stderr, "kernel_launch: occupancy query says %d blocks per CU\n", per_cu); (void)hipGetLastError(); grid = -1; return; }
        grid = cus;
        if (grid != 256) fprintf(stderr, "kernel_launch: %d CUs; this kernel is built for 256\n", grid);
    }
    if (grid < 0) return;
    (void)hipMemsetAsync((char*)d_ws + WS_CTL, 0, CTL_ZERO_BYTES, stream);
    Args a{};
    for (int i = 0; i < 37; ++i) a.in[i] = (const float*)d_in[i];
    a.out = (float*)d_out; a.ws = (unsigned char*)d_ws;
#if MK_ONE_LAUNCH
    a.ph_lo = 0; a.ph_hi = N_PHASES;
    void* kargs[] = {&a};
    hipError_t e = hipLaunchCooperativeKernel((const void*)mk_fwd, dim3(grid), dim3(NWAVES * 64), kargs, LDS_BYTES, stream);
    if (e != hipSuccess) fprintf(stderr, "kernel_launch: cooperative launch failed: %s (grid %d)\n", hipGetErrorString(e), grid);
#else
    for (int ph = 0; ph < N_PHASES; ++ph) { a.ph_lo = ph; a.ph_hi = ph + 1; hipLaunchKernelGGL(mk_fwd, dim3(grid), dim3(NWAVES * 64), LDS_BYTES, stream, a); }
#endif
}
```

```cpp
#include <hip/hip_runtime.h>
#include <hip/hip_cooperative_groups.h>
#include <cstdio>
#include <cstdint>
namespace cg = cooperative_groups;

namespace pg8 {
#define PG8_LAS __attribute__((address_space(3)))
typedef unsigned short bf16_t;
typedef short bf16x8 __attribute__((ext_vector_type(8)));
typedef float f32x4 __attribute__((ext_vector_type(4)));
typedef unsigned u32x4 __attribute__((ext_vector_type(4)));
typedef unsigned u32x2 __attribute__((ext_vector_type(2)));
constexpr int BM = 256, BK = 64, HALF = 128, HTB = HALF * BK * 2  , STAGE_BYTES = 8 * HTB, NXCD = 8, WGM = 8;

__host__ __device__ __forceinline__ int lds_byte(int r, int c) { const int st = (r >> 4) * 2 + (c >> 5), rr = r & 15, cc = c & 31, ob = rr * 64 + cc * 2; return st * 1024 + (ob ^ (((ob >> 9) & 1) << 5)); }
__host__ __device__ __forceinline__ void stage_rc(int b, int& R, int& C) { const int st = b / 1024, sb = b % 1024, swz = sb ^ (((sb >> 9) & 1) << 5); R = (st >> 1) * 16 + swz / 64; C = (st & 1) * 32 + (swz % 64) / 2; }
__host__ __device__ __forceinline__ int perm32(int rho) { const int n = rho >> 4, i = rho & 15; return 8 * (i >> 2) + 4 * n + (i & 3); }

struct Unit { int pm, pn, pmo, lt, nvalid, pnl; };
struct Gemm { const bf16_t* A; const bf16_t* Bt; int M, N, K; const int* rowidx; };

struct StaticOrder {
    int nM, nN, nwg, G, c;
    __host__ __device__ void init(int M, int N, int G_, int c_) { nM = M / BM; nN = N / BM; nwg = nM * nN; G = G_; c = c_; }
    __host__ __device__ bool next(int i, Unit& u) const {
        const long L = (long)i * G + c; if (L >= nwg) return false;
        int wgid = (int)L; { const int q = nwg / NXCD, r = nwg % NXCD, xcd = wgid % NXCD, off = wgid / NXCD; wgid = (xcd < r ? xcd * (q + 1) : r * (q + 1) + (xcd - r) * q) + off; }
        const int nig = WGM * nN, gid = wgid / nig, fm = gid * WGM, gsz = (nM - fm) < WGM ? (nM - fm) : WGM;
        u.pm = fm + ((wgid % nig) % gsz); u.pn = (wgid % nig) / gsz; u.pmo = u.pm; u.lt = u.pm; u.nvalid = 256; u.pnl = u.pn; return true;
    }
};
struct MoeOrder {
    const PG8_LAS int* tab; int G, c; bool a_is_out;
    __device__ bool next(int i, Unit& u) const {
        const int L = i * G + c; const int tile = L >> 2, pnl = L & 3;
        const int lane = (int)__builtin_amdgcn_mbcnt_hi(~0u, __builtin_amdgcn_mbcnt_lo(~0u, 0u)), e_ = lane & 31;
        const int pre = tab[e_], ce = tab[32 + e_]; const int nt = (ce + 255) >> 8;
        const unsigned long long mk = __ballot(lane < 32 && tile >= pre && tile < pre + nt);
        if (mk == 0ull) return false;
        const int e = (int)__builtin_ctzll(mk);
        const int pre_e = __builtin_amdgcn_readlane(pre, e), ce_e = __builtin_amdgcn_readlane(ce, e);
        const int rt = tile - pre_e; u.pmo = tile; u.pm = a_is_out ? tile : 0; u.lt = e * 64 + rt; u.pn = e * 4 + pnl; u.pnl = pnl; const int rem = ce_e - rt * 256; u.nvalid = rem < 256 ? rem : 256; return true;
    }
};
__device__ __forceinline__ void moe_fill_tab(PG8_LAS int* tab, const unsigned* cnt) {
    const int lane = (int)__builtin_amdgcn_mbcnt_hi(~0u, __builtin_amdgcn_mbcnt_lo(~0u, 0u));
    const int ce = (lane < 32) ? (int)cnt[lane & 31] : 0; const int nt = (ce + 255) >> 8;
    int incl = nt;
#pragma unroll
    for (int o = 1; o < 32; o <<= 1) { const int v = __shfl_up(incl, o); if (lane >= o) incl += v; }
    if (lane < 32) { tab[lane] = incl - nt; tab[32 + lane] = ce; }
}

__device__ __forceinline__ unsigned cvt_pk_bf16(float lo, float hi) { unsigned r; asm volatile("v_cvt_pk_bf16_f32 %0, %1, %2" : "=v"(r) : "v"(lo), "v"(hi)); return r; }

template <class Epi, class Sched, bool ALIGN_EPI, bool GATHER>
__device__ __forceinline__ void gemm_phase(PG8_LAS unsigned char* lds, const Gemm g, const Sched& S, const Epi& E) {
    const int tid = threadIdx.x, wid = __builtin_amdgcn_readfirstlane(tid >> 6), lane = tid & 63, wr = wid >> 2, wc = wid & 3, fr = lane & 15, fq = lane >> 4;
    int K_ = g.K; asm volatile("" : "+s"(K_));
    const int K = K_, nt = K / BK;
    unsigned voffB[2]; int RA[2], CA[2];
#pragma unroll
    for (int i = 0; i < 2; ++i) { int R, C; stage_rc(tid * 16 + i * 8192, R, C); const int Rb = Epi::PERM ? ((R & ~31) + perm32(R & 31)) : R;
        RA[i] = R; CA[i] = C; voffB[i] = (unsigned)(Rb * K + C) * 2u; }
    const size_t kstep = (size_t)(BK * 2);
    const size_t hstep = (size_t)HALF * K * 2;
    const size_t tstep = 2 * hstep;
    const unsigned ldsw = (unsigned)wid * 1024u;
    const int aoff = lds_byte(wr * 64 + fr, fq * 8), boff = lds_byte(wc * 32 + fr, fq * 8);
    unsigned vA[2][2], vN[2][2];
    PG8_LAS int* rowl = (PG8_LAS int*)(lds + STAGE_BYTES);
    if constexpr (GATHER) {
        for (int i = 0; i < 4; ++i) { Unit uu; if (!S.next(i, uu)) break; if (tid < 256) rowl[i * 256 + tid] = (tid < uu.nvalid) ? (g.rowidx[(size_t)uu.lt * 256 + tid] >> 1) : 0; }
        asm volatile("s_waitcnt vmcnt(0) lgkmcnt(0)" ::: "memory"); __builtin_amdgcn_s_barrier(); asm volatile("" ::: "memory");
    }
    auto compute_v = [&](const Unit& u, unsigned (&v)[2][2], int ui_) {
#pragma unroll
        for (int h = 0; h < 2; ++h)
#pragma unroll
            for (int i = 0; i < 2; ++i) {
                const int rl = h * HALF + RA[i];
                if constexpr (GATHER) { const int tok = rowl[ui_ * 256 + rl]; v[h][i] = ((unsigned)tok * (unsigned)K + (unsigned)CA[i]) * 2u; }
                else v[h][i] = ((unsigned)rl * (unsigned)K + (unsigned)CA[i]) * 2u;
            }
    };
#define PG8_SA(b, h) (((b) * 2 + (h)) * HTB)
#define PG8_SB(b, h) ((4 + (b) * 2 + (h)) * HTB)
#define PG8_STAGE(bufoff, gbase, voff) do { _Pragma("unroll") for (int _i = 0; _i < 2; ++_i) \
        __builtin_amdgcn_global_load_lds((const unsigned*)((const char*)(gbase) + (voff)[_i]), (PG8_LAS unsigned*)(lds + (bufoff) + ldsw + _i * 8192), 16, 0, 0); } while (0)
#define PG8_LDA(dst, b, h) do { _Pragma("unroll") for (int m = 0; m < 4; ++m) _Pragma("unroll") for (int k = 0; k < 2; ++k) dst[m][k] = *(const PG8_LAS bf16x8*)(lds + PG8_SA(b, h) + aoff + m * 2048 + k * 1024); } while (0)
#define PG8_LDB(dst, b, h) do { _Pragma("unroll") for (int n = 0; n < 2; ++n) _Pragma("unroll") for (int k = 0; k < 2; ++k) dst[n][k] = *(const PG8_LAS bf16x8*)(lds + PG8_SB(b, h) + boff + n * 2048 + k * 1024); } while (0)
#define PG8_MMA(ai, bj, At, Bt) do { __builtin_amdgcn_s_setprio(1); _Pragma("unroll") for (int m = 0; m < 4; ++m) _Pragma("unroll") for (int n = 0; n < 2; ++n) _Pragma("unroll") for (int k = 0; k < 2; ++k) \
        acc[ai][bj][m][n] = __builtin_amdgcn_mfma_f32_16x16x32_bf16(Bt[n][k], At[m][k], acc[ai][bj][m][n], 0, 0, 0); __builtin_amdgcn_s_setprio(0); } while (0)
#define PG8_WAIT_V(n) asm volatile("s_waitcnt vmcnt(" #n ")" ::: "memory")
#define PG8_WAIT_L(n) asm volatile("s_waitcnt lgkmcnt(" #n ")" ::: "memory")
#define PG8_BAR __builtin_amdgcn_s_barrier()
#define PG8_SCHED __builtin_amdgcn_sched_barrier(0)
    Unit cur, nxt; int ui = 0;
    if (!S.next(0, cur)) return;
    f32x4 acc[2][2][4][2];
#pragma unroll
    for (int a = 0; a < 2; ++a)
#pragma unroll
        for (int b = 0; b < 2; ++b)
#pragma unroll
            for (int m = 0; m < 4; ++m)
#pragma unroll
                for (int n = 0; n < 2; ++n) acc[a][b][m][n] = (f32x4){0.f, 0.f, 0.f, 0.f};
    bf16x8 At[4][2], B0[2][2], B1[2][2];
    compute_v(cur, vA, 0);
    const char* cA = (const char*)g.A + (GATHER ? (size_t)0 : (size_t)cur.pm * tstep); const char* cB = (const char*)g.Bt + (size_t)cur.pn * tstep;
    PG8_STAGE(PG8_SB(0, 0), cB, voffB); PG8_STAGE(PG8_SB(0, 1), cB + hstep, voffB); PG8_STAGE(PG8_SA(0, 0), cA, vA[0]); PG8_STAGE(PG8_SA(0, 1), cA, vA[1]);
    if (wr == 1) PG8_BAR;
    PG8_WAIT_V(2); PG8_BAR;
    PG8_STAGE(PG8_SB(1, 0), cB + kstep, voffB); PG8_STAGE(PG8_SA(1, 0), cA + kstep, vA[0]); PG8_STAGE(PG8_SB(1, 1), cB + hstep + kstep, voffB);
    PG8_WAIT_V(6); PG8_BAR;
    for (;;) {
        const bool has_next = S.next(ui + 1, nxt);
        if (has_next) compute_v(nxt, vN, ui + 1);
        else {
#pragma unroll
            for (int h = 0; h < 2; ++h)
#pragma unroll
                for (int i = 0; i < 2; ++i) vN[h][i] = vA[h][i];
        }
        const char* nA = has_next ? ((const char*)g.A + (GATHER ? (size_t)0 : (size_t)nxt.pm * tstep)) : cA; const char* nB = has_next ? (const char*)g.Bt + (size_t)nxt.pn * tstep : cB;
#pragma unroll 1
        for (int t = 0; t < nt; t += 2) {
            const bool last = (t == nt - 2);
            const char* a1 = cA + (size_t)(t + 1) * kstep;
            const char* a2 = last ? nA : cA + (size_t)(t + 2) * kstep; const char* b2 = last ? nB : cB + (size_t)(t + 2) * kstep;
            const char* a3 = a2 + kstep; const char* b3 = b2 + kstep;
            unsigned vX0[2], vX1[2];
#pragma unroll
            for (int i = 0; i < 2; ++i) { vX0[i] = last ? vN[0][i] : vA[0][i]; vX1[i] = last ? vN[1][i] : vA[1][i]; }
            PG8_LDB(B0, 0, 0); PG8_LDB(B1, 0, 1); PG8_SCHED; PG8_LDA(At, 0, 0); PG8_STAGE(PG8_SA(1, 1), a1, vA[1]);
            PG8_WAIT_V(8); PG8_WAIT_L(0); PG8_BAR; PG8_MMA(0, 0, At, B0); PG8_MMA(0, 1, At, B1); PG8_BAR; PG8_SCHED;
            PG8_LDA(At, 0, 1); PG8_STAGE(PG8_SB(0, 0), b2, voffB); PG8_STAGE(PG8_SB(0, 1), b2 + hstep, voffB); PG8_STAGE(PG8_SA(0, 0), a2, vX0);
            PG8_WAIT_V(8); PG8_WAIT_L(0); PG8_BAR; PG8_MMA(1, 0, At, B0); PG8_MMA(1, 1, At, B1); PG8_BAR; PG8_SCHED;
            PG8_LDB(B0, 1, 0); PG8_LDB(B1, 1, 1); PG8_SCHED; PG8_LDA(At, 1, 0); PG8_STAGE(PG8_SA(0, 1), a2, vX1);
            PG8_WAIT_V(8); PG8_WAIT_L(0); PG8_BAR; PG8_MMA(0, 0, At, B0); PG8_MMA(0, 1, At, B1); PG8_BAR; PG8_SCHED;
            PG8_LDA(At, 1, 1); PG8_STAGE(PG8_SB(1, 0), b3, voffB); PG8_STAGE(PG8_SB(1, 1), b3 + hstep, voffB); PG8_STAGE(PG8_SA(1, 0), a3, vX0);
            PG8_WAIT_V(8); PG8_WAIT_L(0); PG8_BAR; PG8_MMA(1, 0, At, B0); PG8_MMA(1, 1, At, B1); PG8_BAR; PG8_SCHED;
        }
        if constexpr (ALIGN_EPI) { if (wr == 0) PG8_BAR; }
        E(acc, cur, wr, wc, fr, fq);
        if (!has_next) break;
#pragma unroll
        for (int a = 0; a < 2; ++a)
#pragma unroll
            for (int b = 0; b < 2; ++b)
#pragma unroll
                for (int m = 0; m < 4; ++m)
#pragma unroll
                    for (int n = 0; n < 2; ++n) acc[a][b][m][n] = (f32x4){0.f, 0.f, 0.f, 0.f};
        cur = nxt; cA = nA; cB = nB; ++ui;
#pragma unroll
        for (int h = 0; h < 2; ++h)
#pragma unroll
            for (int i = 0; i < 2; ++i) vA[h][i] = vN[h][i];
        if constexpr (ALIGN_EPI) { if (wr == 1) PG8_BAR; }
    }
    PG8_WAIT_V(0);
    if constexpr (!ALIGN_EPI) { if (wr == 0) PG8_BAR; }
    PG8_BAR;
#undef PG8_SA
#undef PG8_SB
#undef PG8_STAGE
#undef PG8_LDA
#undef PG8_LDB
#undef PG8_MMA
#undef PG8_WAIT_V
#undef PG8_WAIT_L
#undef PG8_BAR
#undef PG8_SCHED
}
}

constexpr int NWAVES = 8;
constexpr int M = 16384, D = 1024, SEQ = 2048, NBATCH = 8;
constexpr int NIN = 5144;
constexpr int NZ = 5120;
constexpr int ZC_R = 0, ZC_K = 512, ZC_V = 1024, ZC_W = 1536, ZC_Q = 1792, ZC_KC = 2304, ZC_VC = 2432, ZC_KS = 2560, ZC_VS = 2688, ZC_KW = 2816, ZC_VW = 2944, ZC_MR = 3072, ZC_MN = 4096;
constexpr float NORM_EPS = 1e-6f, GN_EPS = 64e-5f;

constexpr size_t MiB = 1u << 20;
constexpr size_t WS_CTL = 0, CTL_ZERO_BYTES = 64 * 1024;
constexpr size_t WS_LIST = 1 * MiB;
constexpr size_t WS_GATEA = 3 * MiB;
constexpr size_t WS_RSE = 4 * MiB;
constexpr size_t WS_SLOTA = 4 * MiB + 512 * 1024;
constexpr size_t WS_SELMASK = 5 * MiB;
constexpr size_t WS_ZGATE = 6 * MiB;
constexpr size_t WS_SMALLW = 8 * MiB;
constexpr size_t SW_W2T = 0, SW_A2T = 65536, SW_G2T = 131072, SW_CK1 = 262144, SW_CV1 = 524288, SW_CK2 = 786432, SW_CV2 = 794624, SW_GATEW = 802816, SW_ROUTEW = 868352;
constexpr size_t WS_KCMP = 10 * MiB;
constexpr size_t WS_VST = 11 * MiB, WS_VWT = 15 * MiB;
constexpr size_t WS_WIN = 19 * MiB, WS_UR = 29 * MiB, WS_UN = 30 * MiB, WS_WO = 31 * MiB, WS_WPP = 33 * MiB, WS_WPG = 34 * MiB, WS_WGU = 36 * MiB, WS_WD = 100 * MiB;
constexpr size_t WS_XN = 132 * MiB;
constexpr size_t WS_PBF = 164 * MiB;
constexpr size_t WS_Z = 172 * MiB;
constexpr size_t WS_S = 332 * MiB;
constexpr size_t WS_YRW = 428 * MiB, WS_YB = 444 * MiB, WS_G = 492 * MiB, WS_LOGITS = 508 * MiB  , WS_BONUS = 508 * MiB  , WS_END = 511 * MiB;
constexpr int CH_PP = 144, CH_P = 0, CH_R = 2304, CH_Q = 4608, CH_K = 6656, CH_G = 8704, CH_AC = 10752, CH_REC = 11008, CH_V = 11008, CH_SLOT = 11520;
constexpr int CW_CNT = 0;
constexpr int CW_PANEL = 8192;
constexpr int CW_BAR = 1024;
constexpr int MISC_OFF = 163840 - 64;

constexpr int LDS_BYTES = 163840;

#define GAS __attribute__((address_space(1)))
#define LAS __attribute__((address_space(3)))
typedef unsigned short bf16;
typedef unsigned v4u __attribute__((ext_vector_type(4)));
typedef unsigned v2u __attribute__((ext_vector_type(2)));
typedef float f32x4 __attribute__((ext_vector_type(4)));
typedef float f32x2 __attribute__((ext_vector_type(2)));
typedef short bf16x8 __attribute__((ext_vector_type(8)));
typedef short bf16x4 __attribute__((ext_vector_type(4)));
typedef __bf16 bf16x2_t __attribute__((ext_vector_type(2)));
#define LDS_WAIT() asm volatile("s_waitcnt lgkmcnt(0)" ::: "memory")
#define MFMA16(a, b, c) __builtin_amdgcn_mfma_f32_16x16x32_bf16((a), (b), (c), 0, 0, 0)

__device__ __forceinline__ float bf2f(unsigned short v) { return __uint_as_float((unsigned)v << 16); }
__device__ __forceinline__ unsigned pk2(float lo, float hi) { f32x2 v = {lo, hi}; bf16x2_t b = __builtin_convertvector(v, bf16x2_t); return __builtin_bit_cast(unsigned, b); }
__device__ __forceinline__ v2u pk4(f32x4 v) { v2u r; r.x = pk2(v.x, v.y); r.y = pk2(v.z, v.w); return r; }
__device__ __forceinline__ f32x4 unpk4(v2u w) { f32x4 r; r.x = __uint_as_float(w.x << 16); r.y = __uint_as_float(w.x & 0xffff0000u); r.z = __uint_as_float(w.y << 16); r.w = __uint_as_float(w.y & 0xffff0000u); return r; }
__device__ __forceinline__ void unpk8(v4u w, float (&f)[8]) { f[0] = __uint_as_float(w.x << 16); f[1] = __uint_as_float(w.x & 0xffff0000u); f[2] = __uint_as_float(w.y << 16); f[3] = __uint_as_float(w.y & 0xffff0000u);
    f[4] = __uint_as_float(w.z << 16); f[5] = __uint_as_float(w.z & 0xffff0000u); f[6] = __uint_as_float(w.w << 16); f[7] = __uint_as_float(w.w & 0xffff0000u); }
__device__ __forceinline__ float sigmoidf_(float x) { return __builtin_amdgcn_rcpf(1.0f + __expf(-x)); }
__device__ __forceinline__ float wave_sum(float v) {
#pragma unroll
    for (int o = 1; o < 64; o <<= 1) v += __shfl_xor(v, o);
    return v;
}
template <int CTRL> __device__ __forceinline__ float dppf(float x) { return __builtin_bit_cast(float, __builtin_amdgcn_update_dpp(0, __builtin_bit_cast(int, x), CTRL, 0xf, 0xf, false)); }
__device__ __forceinline__ float row16_sum(float x) { x += dppf<0x128>(x); x += dppf<0x124>(x); x += dppf<0x122>(x); x += dppf<0x121>(x); return x; }

typedef GAS unsigned gu32;
#define XB_TMO      128
#define XB_XCNT(j)  (256  + 64 * (j))
#define XB_XSUB(j)  (1280 + 64 * (j))
#define XB_XGEN(j)  (2304 + 64 * (j))
#define XB_TOP      3328
#define XB_TOPGEN   3392
#define XCD_BAR_WORDS 3456
#define XB_SPIN_CAP (1u << 18)

__device__ __forceinline__ unsigned xb_ld(unsigned* p)              { return __hip_atomic_load(p, __ATOMIC_RELAXED, __HIP_MEMORY_SCOPE_AGENT); }
__device__ __forceinline__ unsigned xb_add(unsigned* p, unsigned v) { return __hip_atomic_fetch_add(p, v, __ATOMIC_RELAXED, __HIP_MEMORY_SCOPE_AGENT); }
__device__ __forceinline__ unsigned xb_xcc_id() { return (unsigned)__builtin_amdgcn_s_getreg((3 << 11) | 20) & 0xFu; }
#define XB_SPIN(cond, bar) do { unsigned _sp = 0; while (cond) { __builtin_amdgcn_s_sleep(1); \
    if ((++_sp & 255u) == 0u) { if (xb_ld(&(bar)[XB_TMO])) break; if (_sp > XB_SPIN_CAP) { atomicAdd(&(bar)[XB_TMO], 1u); break; } } } } while (0)

struct XcdBarrier {
    unsigned* bar; unsigned x;
    volatile LAS unsigned* st;
};

__device__ __forceinline__ XcdBarrier xcd_barrier_post(unsigned* bar, volatile LAS unsigned* st) {
    XcdBarrier b; b.bar = bar; b.x = xb_xcc_id(); b.st = st;
    if (threadIdx.x == 0) (void)xb_add(&bar[XB_XCNT(b.x)], 1u);
    return b;
}
__device__ __forceinline__ void xcd_barrier_complete(unsigned* bar, unsigned x, unsigned& nloc, unsigned& nx) {
    const unsigned G = gridDim.x * gridDim.y * gridDim.z;
    unsigned sum, cnt, mine, sp = 0u;
    for (;;) {
        sum = 0u; cnt = 0u; mine = 0u;
#pragma unroll
        for (unsigned j = 0; j < 16; ++j) { const unsigned c = xb_ld(&bar[XB_XCNT(j)]); sum += c; cnt += (c > 0u) ? 1u : 0u; mine = (j == x) ? c : mine; }
        if (sum == G) break;
        __builtin_amdgcn_s_sleep(1);
        if ((++sp & 255u) == 0u) { if (xb_ld(&bar[XB_TMO])) break; if (sp > XB_SPIN_CAP) { atomicAdd(&bar[XB_TMO], 1u); break; } }
    }
    nloc = mine > 0u ? mine : 1u; nx = cnt > 0u ? cnt : 1u;
}

__device__ __forceinline__ void xcd_barrier(const XcdBarrier& b) {
    asm volatile("s_waitcnt vmcnt(0)" ::: "memory");
    __syncthreads();
    if (threadIdx.x == 0) {
        unsigned* bar = b.bar;
        __builtin_amdgcn_s_waitcnt(0);
        unsigned nloc = b.st[0], nx = b.st[1];
        if (nloc == 0u) { xcd_barrier_complete(bar, b.x, nloc, nx); b.st[0] = nloc; b.st[1] = nx; }
        const unsigned old = xb_add(&bar[XB_XSUB(b.x)], 1u);
        const unsigned gen = old / nloc;
        if (old + 1u == (gen + 1u) * nloc) {
            __builtin_amdgcn_fence(__ATOMIC_RELEASE, "agent");
            asm volatile("s_waitcnt vmcnt(0)" ::: "memory");
            const unsigned og = xb_add(&bar[XB_TOP], 1u);
            const unsigned tg = og / nx;
            if (og + 1u == (tg + 1u) * nx) xb_add(&bar[XB_TOPGEN], 1u);
            else XB_SPIN(xb_ld(&bar[XB_TOPGEN]) == tg, bar);
            __builtin_amdgcn_fence(__ATOMIC_ACQUIRE, "agent");
            xb_add(&bar[XB_XGEN(b.x)], 1u);
            asm volatile("s_waitcnt vmcnt(0)" ::: "memory");
        } else {
            XB_SPIN(xb_ld(&bar[XB_XGEN(b.x)]) == gen, bar);
            __builtin_amdgcn_fence(__ATOMIC_ACQUIRE, "agent");
            asm volatile("s_waitcnt vmcnt(0)" ::: "memory");
        }
    }
    __syncthreads();
}

struct Args { const float* in[37]; float* out; unsigned char* ws; int ph_lo, ph_hi, rep_mask, pad; };
typedef __attribute__((address_space(4))) const Args* ArgsP;
struct Frame {
    LAS unsigned char* lds;
    int tid, lane, wave, vcu, G, gw, NGW;
    unsigned char* ws;
    ArgsP ap;
    float* out;
};

struct TrDesc { const float* W; bf16* T; bf16* T2; int K, ld, nc, item, mode; };
__device__ __forceinline__ void tr_load(const TrDesc& d, int lane, float (&tv)[32]) {
    const int nblk = (d.nc + 31) / 32, kb = d.item / nblk, nb = d.item % nblk, k0 = 64 * kb, n0 = 32 * nb;
    const int nn = n0 + (lane & 31);
    const float* wsrc = d.W + (size_t)(k0 + (lane >> 5)) * d.ld + (nn < d.nc ? nn : 0);
#pragma unroll
    for (int i = 0; i < 32; ++i) tv[i] = wsrc[(size_t)(2 * i) * d.ld];
}
__device__ __forceinline__ void tr_finish(const TrDesc& d, LAS float* scr, int lane, const float (&tv)[32]) {
    const int nblk = (d.nc + 31) / 32, kb = d.item / nblk, nb = d.item % nblk, k0 = 64 * kb, n0 = 32 * nb;
#pragma unroll
    for (int i = 0; i < 32; ++i) scr[(2 * i + (lane >> 5)) * 33 + (lane & 31)] = tv[i];
    LDS_WAIT(); asm volatile("" ::: "memory");
    const int c = lane & 7;
#pragma unroll
    for (int j = 0; j < 4; ++j) { const int nl = (lane >> 3) + 8 * j, n = n0 + nl; const LAS float* s = scr + (8 * c) * 33 + nl;
        v4u o; o.x = pk2(s[0 * 33], s[1 * 33]); o.y = pk2(s[2 * 33], s[3 * 33]); o.z = pk2(s[4 * 33], s[5 * 33]); o.w = pk2(s[6 * 33], s[7 * 33]);
        if (n < d.nc) { bf16* rp;
            if (d.mode == 1) rp = n < 3072 ? d.T + (size_t)n * 1024 : (n < 3096 ? d.T2 + (size_t)(n - 3072) * 1024 : d.T + (size_t)(n - 24) * 1024);
            else if (d.mode == 2) { const int n2 = n & 511; rp = d.T + (size_t)((n2 >> 7) * 256 + (n >> 9) * 128 + (n2 & 127)) * 1024; }
            else rp = d.T + (size_t)n * d.K;
            *(v4u*)(rp + k0 + 8 * c) = o; } }
    LDS_WAIT(); asm volatile("" ::: "memory");
}
__device__ __forceinline__ void rms_row_to_bf16(int lane, const float* xrow, const float* gain, bf16* orow) {
    const f32x4* xr = (const f32x4*)xrow + lane; const f32x4* gr = (const f32x4*)gain + lane;
    f32x4 v[4]; float s = 0.f;
#pragma unroll
    for (int j = 0; j < 4; ++j) { v[j] = xr[64 * j]; s += (v[j].x * v[j].x + v[j].y * v[j].y) + (v[j].z * v[j].z + v[j].w * v[j].w); }
    const float rs = 1.0f / sqrtf(wave_sum(s) * (1.f / D) + NORM_EPS);
    v2u* o8 = (v2u*)orow + lane;
#pragma unroll
    for (int j = 0; j < 4; ++j) { const f32x4 g = gr[64 * j]; o8[64 * j] = pk4(v[j] * rs * g); }
}

namespace tri {
constexpr int I_WIN = 16 * 161, I_UR = 8 * 32, I_WO = 16 * 32, I_WPP = 4 * 32, I_L64 = 16, I_L128 = 32, I_C1 = 32 * 2, I_C2 = 2, I_GU = 16 * 32, I_DN = 8 * 32;
constexpr int E0 = I_WIN, E1 = E0 + I_UR, E2 = E1 + I_UR, E3 = E2 + I_WO, E4 = E3 + I_WPP, E5 = E4 + I_WO, E6 = E5 + I_L64, E7 = E6 + I_L64, E8 = E7 + I_L128, E9 = E8 + I_C1, E10 = E9 + I_C1, E11 = E10 + I_C2, E12 = E11 + I_C2,
              E13 = E12 + 32 * I_GU, NITEMS = E13 + 32 * I_DN;
}
__device__ __forceinline__ TrDesc tr_desc(Frame& F, int it) {
    using namespace tri;
    unsigned char* ws = F.ws;
    const float* W; int K, ld, nc, item, mode = 0; size_t dst;
    if (it < E0) { W = F.ap->in[3]; K = 1024; ld = NIN; nc = NIN; item = it; mode = 1; dst = WS_WIN; }
    else if (it < E1) { W = F.ap->in[22]; K = 512; ld = 1024; nc = 1024; item = it - E0; dst = WS_UR; }
    else if (it < E2) { W = F.ap->in[23]; K = 512; ld = 1024; nc = 1024; item = it - E1; dst = WS_UN; }
    else if (it < E3) { W = F.ap->in[24]; K = 1024; ld = 1024; nc = 1024; item = it - E2; dst = WS_WO; }
    else if (it < E4) { W = F.ap->in[32]; K = 256; ld = 1024; nc = 1024; item = it - E3; dst = WS_WPP; }
    else if (it < E5) { W = F.ap->in[35]; K = 1024; ld = 1024; nc = 1024; item = it - E4; dst = WS_WPG; }
    else if (it < E6) { W = F.ap->in[6]; K = 64; ld = 512; nc = 512; item = it - E5; dst = WS_SMALLW + SW_W2T; }
    else if (it < E7) { W = F.ap->in[8]; K = 64; ld = 512; nc = 512; item = it - E6; dst = WS_SMALLW + SW_A2T; }
    else if (it < E8) { W = F.ap->in[9]; K = 128; ld = 512; nc = 512; item = it - E7; dst = WS_SMALLW + SW_G2T; }
    else if (it < E9) { W = F.ap->in[17]; K = 2048; ld = 64; nc = 64; item = it - E8; dst = WS_SMALLW + SW_CK1; }
    else if (it < E10) { W = F.ap->in[19]; K = 2048; ld = 64; nc = 64; item = it - E9; dst = WS_SMALLW + SW_CV1; }
    else if (it < E11) { W = F.ap->in[18]; K = 64; ld = 64; nc = 64; item = it - E10; dst = WS_SMALLW + SW_CK2; }
    else if (it < E12) { W = F.ap->in[20]; K = 64; ld = 64; nc = 64; item = it - E11; dst = WS_SMALLW + SW_CV2; }
    else if (it < E13) { const int r = it - E12, e = r / I_GU; W = F.ap->in[30] + (size_t)e * 1024 * 1024; K = 1024; ld = 1024; nc = 1024; item = r % I_GU; mode = 2; dst = WS_WGU + (size_t)e * 1024 * 1024 * 2; }
    else { const int r = it - E13, e = r / I_DN; W = F.ap->in[31] + (size_t)e * 512 * 1024; K = 512; ld = 1024; nc = 1024; item = r % I_DN; dst = WS_WD + (size_t)e * 1024 * 512 * 2; }
    return TrDesc{W, (bf16*)(ws + dst), (bf16*)(ws + WS_SMALLW + SW_GATEW), K, ld, nc, item, mode};
}
__device__ __forceinline__ void tr_run(Frame& F, LAS float* scr, int it0, int stride, int it_end) {
    if (it0 >= it_end) return;
    float tvA[32], tvB[32];
    int it = it0; TrDesc cur = tr_desc(F, it); tr_load(cur, F.lane, tvA);
    for (;;) {
        const int nxt = it + stride; const bool has = nxt < it_end; TrDesc dn = cur;
        if (has) { dn = tr_desc(F, nxt); tr_load(dn, F.lane, tvB); }
        __builtin_amdgcn_sched_barrier(0);
        tr_finish(cur, scr, F.lane, tvA);
        if (!has) break;
        cur = dn; it = nxt;
#pragma unroll
        for (int i = 0; i < 32; ++i) tvA[i] = tvB[i];
    }
}
__device__ __forceinline__ int tr_qnext(LAS int* qh) {
    int k = 0; const unsigned a = (unsigned)(size_t)qh; const int one = 1;
    if (__builtin_amdgcn_mbcnt_hi(~0u, __builtin_amdgcn_mbcnt_lo(~0u, 0u)) == 0) asm volatile("ds_add_rtn_u32 %0, %1, %2\n\ts_waitcnt lgkmcnt(0)" : "=&v"(k) : "v"(a), "v"(one) : "memory");
    return __builtin_amdgcn_readfirstlane(k);
}
__device__ __forceinline__ void tr_run_q(Frame& F, LAS float* scr, LAS int* qh, int base, int stride, int nk) {
    int k = tr_qnext(qh); if (k >= nk) return;
    float tvA[32], tvB[32];
    TrDesc cur = tr_desc(F, base + k * stride); tr_load(cur, F.lane, tvA);
    for (;;) {
        const int kn = tr_qnext(qh); const bool has = kn < nk; TrDesc dn = cur;
        if (has) { dn = tr_desc(F, base + kn * stride); tr_load(dn, F.lane, tvB); }
        __builtin_amdgcn_sched_barrier(0);
        tr_finish(cur, scr, F.lane, tvA);
        if (!has) break;
        cur = dn;
#pragma unroll
        for (int i = 0; i < 32; ++i) tvA[i] = tvB[i];
    }
}
#ifndef MK_EXPERTS_IN_SCAN
#define MK_EXPERTS_IN_SCAN 1
#endif
__device__ __forceinline__ void p0_prologue(Frame& F) {
    LAS float* scr = (LAS float*)(F.lds + F.wave * 16384);
    unsigned char* ws = F.ws;
    bf16* gateWT = (bf16*)(ws + WS_SMALLW + SW_GATEW);
    tr_run(F, scr, F.gw, F.NGW, MK_EXPERTS_IN_SCAN ? tri::E12 : tri::NITEMS);
    for (int mb = F.gw; mb < M; mb += 4 * F.NGW) {
        f32x4 v[4][4]; float s[4];
#pragma unroll
        for (int u = 0; u < 4; ++u) { const f32x4* xr = (const f32x4*)(F.ap->in[0] + (size_t)(mb + u * F.NGW) * D) + F.lane;
#pragma unroll
            for (int j = 0; j < 4; ++j) v[u][j] = xr[64 * j]; }
#pragma unroll
        for (int u = 0; u < 4; ++u) { s[u] = 0.f;
#pragma unroll
            for (int j = 0; j < 4; ++j) s[u] += (v[u][j].x * v[u][j].x + v[u][j].y * v[u][j].y) + (v[u][j].z * v[u][j].z + v[u][j].w * v[u][j].w); }
#pragma unroll
        for (int o = 1; o < 64; o <<= 1) {
#pragma unroll
            for (int u = 0; u < 4; ++u) s[u] += __shfl_xor(s[u], o); }
        const f32x4* gr = (const f32x4*)F.ap->in[2] + F.lane;
#pragma unroll
        for (int u = 0; u < 4; ++u) { const float rs = 1.0f / sqrtf(s[u] * (1.f / D) + NORM_EPS); v2u* o8 = (v2u*)((bf16*)(ws + WS_XN) + (size_t)(mb + u * F.NGW) * D) + F.lane;
#pragma unroll
            for (int j = 0; j < 4; ++j) o8[64 * j] = pk4(v[u][j] * rs * gr[64 * j]); }
    }
    {
        float* RW = (float*)(ws + WS_SMALLW + SW_ROUTEW); const float* gf = F.ap->in[25]; const float* wg = F.ap->in[26]; const float* wr = F.ap->in[28];
        for (int idx = F.gw * 64 + F.lane; idx < 48 * 1024; idx += F.NGW * 64) { const int c = idx >> 10, k = idx & 1023; float v = 0.f;
            if (c < 4) v = wg[k * 4 + c]; else if (c < 36) v = wr[k * 32 + (c - 4)];
            RW[idx] = v * gf[k]; }
        for (int idx = F.gw * 64 + F.lane; idx < 8 * 1024; idx += F.NGW * 64) gateWT[24 * 1024 + idx] = 0;
    }
}

struct EpiStoreBf16 {
    static constexpr bool PERM = true;
    bf16* O; int ldc;
    __device__ __forceinline__ void operator()(const f32x4 (&acc)[2][2][4][2], const pg8::Unit& u, int wr, int wc, int fr, int fq) const {
        const int row0 = u.pmo * 256 + wr * 64 + fr, col0 = u.pnl * 256 + wc * 32 + 8 * fq;
#pragma unroll
        for (int ai = 0; ai < 2; ++ai)
#pragma unroll
            for (int m = 0; m < 4; ++m) { bf16* rowp = O + (size_t)(row0 + ai * 128 + m * 16) * ldc + col0;
#pragma unroll
                for (int bj = 0; bj < 2; ++bj) { const f32x4 v0 = acc[ai][bj][m][0], v1 = acc[ai][bj][m][1]; v4u w; w.x = pk2(v0[0], v0[1]); w.y = pk2(v0[2], v0[3]); w.z = pk2(v1[0], v1[1]); w.w = pk2(v1[2], v1[3]);
                    *(v4u*)(rowp + bj * 128) = w; } }
    }
};
#define EPI_LOOP_BEGIN \
    _Pragma("unroll") for (int ai = 0; ai < 2; ++ai) _Pragma("unroll") for (int m = 0; m < 4; ++m) { if (m == 0 || m == 2) asm volatile("" ::: "memory"); const int rl = ai * 128 + wr * 64 + m * 16 + fr; const size_t row = (size_t)u.pmo * 256 + rl; (void)row; \
    _Pragma("unroll") for (int bj = 0; bj < 2; ++bj) _Pragma("unroll") for (int n = 0; n < 2; ++n) { const int col = u.pnl * 256 + bj * 128 + wc * 32 + n * 16 + 4 * fq; (void)col; const f32x4 a = acc[ai][bj][m][n];
#define EPI_LOOP_END } }
struct EpiMix {
    static constexpr bool PERM = false;
    const bf16* z; bf16* A; bf16* O;
    __device__ __forceinline__ void operator()(const f32x4 (&acc)[2][2][4][2], const pg8::Unit& u, int wr, int wc, int fr, int fq) const {
        const int zc = u.lt ? ZC_MN : ZC_MR;
        EPI_LOOP_BEGIN
            const f32x4 zz = unpk4(*(const v2u*)(z + row * NZ + zc + col)); f32x4 o;
            o.x = sigmoidf_(zz.x) * a.x; o.y = sigmoidf_(zz.y) * a.y; o.z = sigmoidf_(zz.z) * a.z; o.w = sigmoidf_(zz.w) * a.w;
            if (u.lt == 0) *(v2u*)(A + row * D + col) = pk4(o);
            else { o = o + unpk4(*(const v2u*)(A + row * D + col)); *(v2u*)(O + row * D + col) = pk4(o); }
        EPI_LOOP_END
    }
};
struct ErawOrder {
    pg8::StaticOrder S; int c, G, nheavy;
    __device__ bool next(int i, pg8::Unit& u) const { const int nl = G - nheavy, l = c - nheavy; if (l < 0) return false; const int q = l + i * nl; if (q >= S.nwg) return false;
        pg8::StaticOrder T = S; T.c = q; T.G = S.nwg + 1; return T.next(0, u); }
};
struct DualOrder {
    pg8::StaticOrder S;
    __device__ bool next(int i, pg8::Unit& u) const { if (i >= 2) return false; if (!S.next(0, u)) return false; if (i == 1) { u.pm += 64; u.pn += 4; } u.lt = i; return true; }
};
struct EpiResF32 {
    static constexpr bool PERM = false;
    const float* base; float* O;
    __device__ __forceinline__ void operator()(const f32x4 (&acc)[2][2][4][2], const pg8::Unit& u, int wr, int wc, int fr, int fq) const {
        EPI_LOOP_BEGIN
            *(f32x4*)(O + row * D + col) = *(const f32x4*)(base + row * D + col) + a;
        EPI_LOOP_END
    }
};
struct EpiMoe1 {
    static constexpr bool PERM = false;
    bf16* H;
    __device__ __forceinline__ void operator()(const f32x4 (&acc)[2][2][4][2], const pg8::Unit& u, int wr, int wc, int fr, int fq) const {
#pragma unroll
        for (int ai = 0; ai < 2; ++ai)
#pragma unroll
            for (int m = 0; m < 4; ++m) { const size_t row = (size_t)u.pmo * 256 + ai * 128 + wr * 64 + m * 16 + fr;
#pragma unroll
                for (int n = 0; n < 2; ++n) { const f32x4 gt = acc[ai][0][m][n], up = acc[ai][1][m][n]; f32x4 o;
                    o.x = gt.x * sigmoidf_(gt.x) * up.x; o.y = gt.y * sigmoidf_(gt.y) * up.y; o.z = gt.z * sigmoidf_(gt.z) * up.z; o.w = gt.w * sigmoidf_(gt.w) * up.w;
                    *(v2u*)(H + row * 512 + u.pnl * 128 + wc * 32 + n * 16 + 4 * fq) = pk4(o); } }
    }
};
struct EpiPle {
    static constexpr bool PERM = false;
    const bf16* x2; const bf16* Eraw; const float* rse; const float* gpn; bf16* O;
    __device__ __forceinline__ void operator()(const f32x4 (&acc)[2][2][4][2], const pg8::Unit& u, int wr, int wc, int fr, int fq) const {
        EPI_LOOP_BEGIN
            const f32x4 e = unpk4(*(const v2u*)(Eraw + row * D + col)); const f32x4 g = *(const f32x4*)(gpn + col); const float rs = rse[row]; f32x4 o = unpk4(*(const v2u*)(x2 + row * D + col));
            o.x += sigmoidf_(a.x) * e.x * rs * g.x; o.y += sigmoidf_(a.y) * e.y * rs * g.y; o.z += sigmoidf_(a.z) * e.z * rs * g.z; o.w += sigmoidf_(a.w) * e.w * rs * g.w;
            *(v2u*)(O + row * D + col) = pk4(o);
        EPI_LOOP_END
    }
};

struct EpiPleNorm {
    static constexpr bool PERM = false;
    const bf16* x2; const bf16* Eraw; const float* gfin; float* out; float* xbuf; unsigned* cnt; LAS float* ldsx;
    __device__ __forceinline__ void operator()(const f32x4 (&acc_)[2][2][4][2], const pg8::Unit& u_, int wr, int wc, int fr, int fq) const {
        f32x4 (&acc)[2][2][4][2] = const_cast<f32x4 (&)[2][2][4][2]>(acc_);
        pg8::Unit u = u_; asm volatile("" : "+s"(u.pmo), "+s"(u.pnl)); asm volatile("" : "+v"(fr), "+v"(fq)); asm volatile("" : "+s"(wr), "+s"(wc));
        int tid = threadIdx.x; asm volatile("" : "+v"(tid)); const int lane = tid & 63, wid = __builtin_amdgcn_readfirstlane(tid >> 6);
        LAS float* Pl = ldsx; LAS float* Sl = ldsx + 1024; LAS unsigned* flag = (LAS unsigned*)(ldsx + 1280);
#pragma unroll
        for (int ai = 0; ai < 2; ++ai)
#pragma unroll
            for (int m = 0; m < 4; ++m) { if (m == 0 || m == 2) asm volatile("" ::: "memory"); const int rl = ai * 128 + wr * 64 + m * 16 + fr; const size_t row = (size_t)u.pmo * 256 + rl;
                float ss = 0.f;
#pragma unroll
                for (int bj = 0; bj < 2; ++bj)
#pragma unroll
                    for (int n = 0; n < 2; ++n) { const int col = u.pnl * 256 + bj * 128 + wc * 32 + n * 16 + 4 * fq; const f32x4 a = acc[ai][bj][m][n];
                        const f32x4 e = unpk4(*(const v2u*)(Eraw + row * D + col)); f32x4 o = unpk4(*(const v2u*)(x2 + row * D + col));
                        o.x += sigmoidf_(a.x) * e.x; o.y += sigmoidf_(a.y) * e.y; o.z += sigmoidf_(a.z) * e.z; o.w += sigmoidf_(a.w) * e.w;
                        acc[ai][bj][m][n] = o; ss += (o.x * o.x + o.y * o.y) + (o.z * o.z + o.w * o.w); }
                ss += __shfl_xor(ss, 16); ss += __shfl_xor(ss, 32);
                if (fq == 0) Pl[rl * 4 + wc] = ss; }
        asm volatile("s_waitcnt lgkmcnt(0)" ::: "memory"); __builtin_amdgcn_s_barrier(); asm volatile("" ::: "memory");
        if (tid < 256) { const float tot = (Pl[tid * 4 + 0] + Pl[tid * 4 + 1]) + (Pl[tid * 4 + 2] + Pl[tid * 4 + 3]);
            __hip_atomic_store(xbuf + ((size_t)u.pmo * 256 + tid) * 4 + u.pnl, tot, __ATOMIC_RELAXED, __HIP_MEMORY_SCOPE_AGENT);
            asm volatile("s_waitcnt vmcnt(0)" ::: "memory");
            if (lane == 0) __hip_atomic_fetch_add(cnt + 64 * u.pmo, 1u, __ATOMIC_RELAXED, __HIP_MEMORY_SCOPE_AGENT); }
        if (wid == 0) {
            unsigned spins = 0;
            while ((unsigned)__builtin_amdgcn_readfirstlane((int)__hip_atomic_load(cnt + 64 * u.pmo, __ATOMIC_RELAXED, __HIP_MEMORY_SCOPE_AGENT)) < 16u) { __builtin_amdgcn_s_sleep(2); if (++spins > (1u << 22)) break; }
            __builtin_amdgcn_fence(__ATOMIC_ACQUIRE, "agent");
            if (lane == 0) flag[0] = 1u; }
        asm volatile("s_waitcnt vmcnt(0) lgkmcnt(0)" ::: "memory"); __builtin_amdgcn_s_barrier(); asm volatile("" ::: "memory");
        if (tid < 256) { const float* sp = xbuf + ((size_t)u.pmo * 256 + tid) * 4; float tot = 0.f;
#pragma unroll
            for (int t = 0; t < 4; ++t) tot += __hip_atomic_load(sp + t, __ATOMIC_RELAXED, __HIP_MEMORY_SCOPE_AGENT);
            Sl[tid] = 1.0f / sqrtf(tot * (1.f / D) + NORM_EPS); }
        asm volatile("s_waitcnt vmcnt(0) lgkmcnt(0)" ::: "memory"); __builtin_amdgcn_s_barrier(); asm volatile("" ::: "memory");
#pragma unroll
        for (int ai = 0; ai < 2; ++ai)
#pragma unroll
            for (int m = 0; m < 4; ++m) { const int rl = ai * 128 + wr * 64 + m * 16 + fr; const size_t row = (size_t)u.pmo * 256 + rl; const float rs = Sl[rl];
#pragma unroll
                for (int bj = 0; bj < 2; ++bj)
#pragma unroll
                    for (int n = 0; n < 2; ++n) { const int col = u.pnl * 256 + bj * 128 + wc * 32 + n * 16 + 4 * fq; *(f32x4*)(out + row * D + col) = acc[ai][bj][m][n] * rs * *(const f32x4*)(gfin + col); } }
    }
};

__device__ __forceinline__ float gelu_tanh(float x) { const float u = 0.7978845608028654f * (x + 0.044715f * x * x * x); const float t = 1.0f - 2.0f * __builtin_amdgcn_rcpf(__expf(2.0f * u) + 1.0f); return 0.5f * x * (1.0f + t); }

__device__ __forceinline__ void compress_wg_task(Frame& F, int idx) {
    const int kv = idx & 1, tile8 = (idx >> 1) & 7, bg = idx >> 4, b = bg >> 1, g = bg & 1;
    const int fr = F.lane & 15, fq = F.lane >> 4;
    const bf16* z = (const bf16*)(F.ws + WS_Z);
    const bf16* w1T = (const bf16*)(F.ws + WS_SMALLW + (kv ? SW_CV1 : SW_CK1));
    const bf16* w2T = (const bf16*)(F.ws + WS_SMALLW + (kv ? SW_CV2 : SW_CK2));
    const float* pos = kv ? F.ap->in[16] : F.ap->in[15];
    const int j0 = 16 * tile8; int j = j0 + fr; const bool jvalid = j < 127; if (!jvalid) j = 126;
    const bf16* zb = z + ((size_t)b * SEQ + 16 * j) * NZ + (kv ? ZC_VC : ZC_KC) + g * 64;
    v4u zr[8]; f32x4 p0[8], p1[8]; bf16x8 aop[8][4];
#pragma unroll
    for (int i = 0; i < 8; ++i) { const int ks = 8 * F.wave + i, l = ks >> 1, d = 32 * (ks & 1) + 8 * fq;
        zr[i] = *(const v4u*)(zb + (size_t)l * NZ + d); p0[i] = *(const f32x4*)(pos + l * 64 + d); p1[i] = *(const f32x4*)(pos + l * 64 + d + 4);
#pragma unroll
        for (int mt = 0; mt < 4; ++mt) aop[i][mt] = *(const bf16x8*)(w1T + (size_t)(16 * mt + fr) * 2048 + 32 * ks + 8 * fq); }
    f32x4 acc[4];
#pragma unroll
    for (int mt = 0; mt < 4; ++mt) acc[mt] = (f32x4){0.f, 0.f, 0.f, 0.f};
#pragma unroll
    for (int i = 0; i < 8; ++i) {
        float f[8]; unpk8(zr[i], f);
        v4u bb; bb.x = pk2(f[0] + p0[i].x, f[1] + p0[i].y); bb.y = pk2(f[2] + p0[i].z, f[3] + p0[i].w); bb.z = pk2(f[4] + p1[i].x, f[5] + p1[i].y); bb.w = pk2(f[6] + p1[i].z, f[7] + p1[i].w);
        const bf16x8 bop = __builtin_bit_cast(bf16x8, bb);
#pragma unroll
        for (int mt = 0; mt < 4; ++mt) acc[mt] = MFMA16(aop[i][mt], bop, acc[mt]);
    }
    LAS float* red = (LAS float*)F.lds;
    __syncthreads();
#pragma unroll
    for (int mt = 0; mt < 4; ++mt) *(LAS f32x4*)(red + ((F.wave * 4 + mt) * 64 + F.lane) * 4) = acc[mt];
    LDS_WAIT(); __syncthreads();
    if (F.wave != 0) return;
#pragma unroll
    for (int mt = 0; mt < 4; ++mt) { f32x4 t = (f32x4){0.f, 0.f, 0.f, 0.f};
#pragma unroll
        for (int w = 0; w < 8; ++w) t = t + *(const LAS f32x4*)(red + ((w * 4 + mt) * 64 + F.lane) * 4);
        acc[mt] = t; }
    bf16x8 hb[2];
#pragma unroll
    for (int s2 = 0; s2 < 2; ++s2) { v4u w; const f32x4 a0 = acc[2 * s2], a1 = acc[2 * s2 + 1];
        w.x = pk2(gelu_tanh(a0.x), gelu_tanh(a0.y)); w.y = pk2(gelu_tanh(a0.z), gelu_tanh(a0.w)); w.z = pk2(gelu_tanh(a1.x), gelu_tanh(a1.y)); w.w = pk2(gelu_tanh(a1.z), gelu_tanh(a1.w));
        hb[s2] = __builtin_bit_cast(bf16x8, w); }
    bf16* kcmp = (bf16*)(F.ws + WS_KCMP); bf16* vcmpT = (bf16*)(F.ws + WS_KCMP + 512 * 1024);
#pragma unroll
    for (int ntl = 0; ntl < 4; ++ntl) {
        f32x4 o = (f32x4){0.f, 0.f, 0.f, 0.f};
#pragma unroll
        for (int s2 = 0; s2 < 2; ++s2) { const bf16* wp = w2T + (size_t)(16 * ntl + fr) * 64 + 32 * s2 + 4 * fq; const v2u lo = *(const v2u*)wp, hi = *(const v2u*)(wp + 16);
            v4u aw; aw.x = lo.x; aw.y = lo.y; aw.z = hi.x; aw.w = hi.y; o = MFMA16(__builtin_bit_cast(bf16x8, aw), hb[s2], o); }
        if (!jvalid) o = (f32x4){0.f, 0.f, 0.f, 0.f};
        const int jj = j0 + fr, n = 16 * ntl + 4 * fq;
        if (kv == 0) *(v2u*)(kcmp + ((size_t)bg * 128 + jj) * 64 + n) = pk4(o);
        else { const v2u w = pk4(o); bf16* vp = vcmpT + ((size_t)bg * 64 + n) * 128 + jj; vp[0] = (bf16)(w.x & 0xffff); vp[128] = (bf16)(w.x >> 16); vp[256] = (bf16)(w.y & 0xffff); vp[384] = (bf16)(w.y >> 16); }
    }
}
__device__ __forceinline__ void zgate_task(Frame& F, int tile) {
    const int fr = F.lane & 15, fq = F.lane >> 4, m0 = tile * 16;
    const bf16* XN = (const bf16*)(F.ws + WS_XN); const bf16* gw = (const bf16*)(F.ws + WS_SMALLW + SW_GATEW);
    f32x4 acc[2] = {(f32x4){0.f, 0.f, 0.f, 0.f}, (f32x4){0.f, 0.f, 0.f, 0.f}};
#pragma unroll 16
    for (int ks = 0; ks < 32; ++ks) {
        const bf16x8 bop = *(const bf16x8*)(XN + (size_t)(m0 + fr) * D + 32 * ks + 8 * fq);
#pragma unroll
        for (int ct = 0; ct < 2; ++ct) { const bf16x8 aop = *(const bf16x8*)(gw + (size_t)(16 * ct + fr) * D + 32 * ks + 8 * fq); acc[ct] = MFMA16(aop, bop, acc[ct]); }
    }
    float* zg = (float*)(F.ws + WS_ZGATE);
#pragma unroll
    for (int ct = 0; ct < 2; ++ct) *(f32x4*)(zg + (size_t)(m0 + fr) * 32 + 16 * ct + 4 * fq) = acc[ct];
}
__device__ __forceinline__ void vt_task(Frame& F, int idx) {
    const int which = idx & 1, blk = (idx >> 1) & 31, bg = idx >> 6, b = bg >> 1, g = bg & 1;
    const bf16* z = (const bf16*)(F.ws + WS_Z);
    bf16* vT = (bf16*)(F.ws + (which ? WS_VWT : WS_VST));
    const int t = 64 * blk + F.lane;
    const bf16* src = z + ((size_t)b * SEQ + t) * NZ + (which ? ZC_VW : ZC_VS) + g * 64;
#pragma unroll
    for (int dc = 0; dc < 8; ++dc) { const v4u w = *(const v4u*)(src + 8 * dc); bf16* dst = vT + ((size_t)bg * 64 + 8 * dc) * SEQ + t;
        dst[0 * SEQ] = (bf16)(w.x & 0xffff); dst[1 * SEQ] = (bf16)(w.x >> 16); dst[2 * SEQ] = (bf16)(w.y & 0xffff); dst[3 * SEQ] = (bf16)(w.y >> 16);
        dst[4 * SEQ] = (bf16)(w.z & 0xffff); dst[5 * SEQ] = (bf16)(w.z >> 16); dst[6 * SEQ] = (bf16)(w.w & 0xffff); dst[7 * SEQ] = (bf16)(w.w >> 16); }
}
__device__ __forceinline__ void alora_task4(Frame& F, int mb) {
    const bf16* z = (const bf16*)(F.ws + WS_Z); bf16* AL = (bf16*)(F.ws + WS_PBF);
    const int l = F.lane;
    const f32x4 mu = *(const f32x4*)(F.ap->in[4] + ZC_W + 4 * l);
    v2u cw[4], pw[4];
#pragma unroll
    for (int u = 0; u < 4; ++u) { const int m = mb + u * F.NGW; const int t = m & (SEQ - 1); cw[u] = *(const v2u*)(z + (size_t)m * NZ + ZC_W + 4 * l); pw[u] = *(const v2u*)(z + (size_t)(t > 0 ? m - 1 : m) * NZ + ZC_W + 4 * l); }
#pragma unroll
    for (int u = 0; u < 4; ++u) { const int m = mb + u * F.NGW; const int t = m & (SEQ - 1);
        const f32x4 cur = unpk4(cw[u]); const f32x4 prev = unpk4(pw[u]) * (t > 0 ? 1.0f : 0.0f);
        f32x4 s = cur + (prev - cur) * mu;
        if (l < 16) { s.x = tanhf(s.x); s.y = tanhf(s.y); s.z = tanhf(s.z); s.w = tanhf(s.w); }
        else if (l >= 32) { s.x = sigmoidf_(s.x); s.y = sigmoidf_(s.y); s.z = sigmoidf_(s.z); s.w = sigmoidf_(s.w); }
        *(v2u*)(AL + (size_t)m * 256 + 4 * l) = pk4(s); }
}
__device__ __forceinline__ void p2_prep(Frame& F) {
    constexpr int T1 = 1024, T2 = T1 + 1024;
    for (int it = F.vcu; it < 256; it += F.G) compress_wg_task(F, it);
    for (int task = F.gw; task < T2; task += F.NGW) {
        if (task < T1) zgate_task(F, task);
        else vt_task(F, task - T1);
    }
    for (int base = F.gw; base < M; base += 4 * F.NGW) alora_task4(F, base);
}

__device__ __forceinline__ void ld16(const bf16* p, float (&f)[16]) { float a[8], b[8]; unpk8(*(const v4u*)p, a); unpk8(*(const v4u*)(p + 8), b);
#pragma unroll
    for (int i = 0; i < 8; ++i) { f[i] = a[i]; f[8 + i] = b[i]; } }
__device__ __forceinline__ void ld16f(const float* p, float (&f)[16]) {
#pragma unroll
    for (int q = 0; q < 4; ++q) { const f32x4 v = *(const f32x4*)(p + 4 * q); f[4 * q] = v.x; f[4 * q + 1] = v.y; f[4 * q + 2] = v.z; f[4 * q + 3] = v.w; } }
__device__ __forceinline__ void st16(bf16* p, const float (&f)[16]) { v4u a, b; a.x = pk2(f[0], f[1]); a.y = pk2(f[2], f[3]); a.z = pk2(f[4], f[5]); a.w = pk2(f[6], f[7]); b.x = pk2(f[8], f[9]); b.y = pk2(f[10], f[11]); b.z = pk2(f[12], f[13]); b.w = pk2(f[14], f[15]);
    *(v4u*)p = a; *(v4u*)(p + 8) = b; }
struct PrepW { bf16x8 w[2], a[2], g[4]; };
constexpr int PW_OFF = 32768, PW_P64 = 144, PW_P128 = 272, PW_A_OFF = PW_OFF + 64 * PW_P64, PW_G_OFF = PW_A_OFF + 64 * PW_P64;
__device__ __forceinline__ void prep_stage_w(Frame& F, int h) {
    const bf16* w2T = (const bf16*)(F.ws + WS_SMALLW + SW_W2T) + (size_t)h * 64 * 64; const bf16* a2T = (const bf16*)(F.ws + WS_SMALLW + SW_A2T) + (size_t)h * 64 * 64; const bf16* g2T = (const bf16*)(F.ws + WS_SMALLW + SW_G2T) + (size_t)h * 64 * 128;
    { const int R = F.tid >> 3, c = F.tid & 7, slot = ((R >> 2) & 3) * 16 + (R >> 4) * 4 + (R & 3);
      *(LAS v4u*)(F.lds + PW_OFF + slot * PW_P64 + c * 16) = *(const v4u*)(w2T + R * 64 + c * 8); *(LAS v4u*)(F.lds + PW_A_OFF + slot * PW_P64 + c * 16) = *(const v4u*)(a2T + R * 64 + c * 8); }
#pragma unroll
    for (int i = 0; i < 2; ++i) { const int id = F.tid + 512 * i, R = id >> 4, c = id & 15, slot = ((R >> 2) & 3) * 16 + (R >> 4) * 4 + (R & 3);
      *(LAS v4u*)(F.lds + PW_G_OFF + slot * PW_P128 + c * 16) = *(const v4u*)(g2T + R * 128 + c * 8); }
}
__device__ __forceinline__ void prep_ldw(PrepW& W, const LAS unsigned char* lds, int n, int fr, int fq) {
#pragma unroll
    for (int ks = 0; ks < 2; ++ks) { W.w[ks] = *(const LAS bf16x8*)(lds + PW_OFF + (n * 16 + fr) * PW_P64 + 64 * ks + 16 * fq); W.a[ks] = *(const LAS bf16x8*)(lds + PW_A_OFF + (n * 16 + fr) * PW_P64 + 64 * ks + 16 * fq); }
#pragma unroll
    for (int ks = 0; ks < 4; ++ks) W.g[ks] = *(const LAS bf16x8*)(lds + PW_G_OFF + (n * 16 + fr) * PW_P128 + 64 * ks + 16 * fq);
}
__device__ __forceinline__ void ldpar(const LAS float* p, float (&f)[16]) {
#pragma unroll
    for (int q = 0; q < 4; ++q) { const f32x4 v = *(const LAS f32x4*)(p + 4 * q); f[4 * q] = v.x; f[4 * q + 1] = v.y; f[4 * q + 2] = v.z; f[4 * q + 3] = v.w; } }
__device__ __forceinline__ void rwkv_prep_task(Frame& F, int task, const LAS float* par) {
    const int h = task & 7, m0 = (task >> 3) * 16, fr = F.lane & 15, fq = F.lane >> 4, m = m0 + fr, t = m & (SEQ - 1);
    const bf16* z = (const bf16*)(F.ws + WS_Z); const bf16* AL = (const bf16*)(F.ws + WS_PBF);
    bf16* vbuf = (bf16*)F.out; bf16* gbuf = (bf16*)(F.ws + WS_G);
    const int cl = h * 64 + 16 * fq;
    bf16x8 bw[2], ba[2], bgf[4];
    const bf16* alr = AL + (size_t)m * 256 + 8 * fq;
#pragma unroll
    for (int ks = 0; ks < 2; ++ks) { bw[ks] = *(const bf16x8*)(alr + 32 * ks); ba[ks] = *(const bf16x8*)(alr + 64 + 32 * ks); }
#pragma unroll
    for (int ks = 0; ks < 4; ++ks) bgf[ks] = *(const bf16x8*)(alr + 128 + 32 * ks);
    const bf16* zc = z + (size_t)m * NZ + cl; const bf16* zp = (t > 0) ? zc - NZ : zc;
    v4u zraw[6][2];
#pragma unroll
    for (int q = 0; q < 3; ++q) { zraw[q][0] = *(const v4u*)(zc + 512 * q); zraw[q][1] = *(const v4u*)(zc + 512 * q + 8); zraw[3 + q][0] = *(const v4u*)(zp + 512 * q); zraw[3 + q][1] = *(const v4u*)(zp + 512 * q + 8); }
    __builtin_amdgcn_sched_barrier(0);
    float ev[16], av[16], gv[16];
#define PREP_MM(W, n) do { f32x4 accw = (f32x4){0.f, 0.f, 0.f, 0.f}, acca = accw, accg = accw; \
        _Pragma("unroll") for (int ks = 0; ks < 2; ++ks) { accw = MFMA16(W.w[ks], bw[ks], accw); acca = MFMA16(W.a[ks], ba[ks], acca); } \
        _Pragma("unroll") for (int ks = 0; ks < 4; ++ks) accg = MFMA16(W.g[ks], bgf[ks], accg); \
        _Pragma("unroll") for (int r = 0; r < 4; ++r) { ev[4 * (n) + r] = accw[r]; av[4 * (n) + r] = acca[r]; gv[4 * (n) + r] = accg[r]; } } while (0)
    { PrepW Wa, Wb;
      prep_ldw(Wa, F.lds, 0, fr, fq); prep_ldw(Wb, F.lds, 1, fr, fq); PREP_MM(Wa, 0); PREP_MM(Wb, 1);
      prep_ldw(Wa, F.lds, 2, fr, fq); prep_ldw(Wb, F.lds, 3, fr, fq); PREP_MM(Wa, 2); PREP_MM(Wb, 3); }
    float zr[16], zk[16], zv[16], tmp[16];
    const float pm = (t > 0) ? 1.0f : 0.0f;
    {   float c[16], p[16];
#define PREP_UNP(q, dst) do { float a_[8], b_[8]; unpk8(zraw[q][0], a_); unpk8(zraw[q][1], b_); _Pragma("unroll") for (int i = 0; i < 8; ++i) { dst[i] = a_[i]; dst[8 + i] = b_[i]; } } while (0)
        PREP_UNP(0, c); PREP_UNP(3, p); ldpar(par + 0 * 64 + 16 * fq, tmp);
#pragma unroll
        for (int e = 0; e < 16; ++e) zr[e] = c[e] + (p[e] * pm - c[e]) * tmp[e];
        PREP_UNP(1, c); PREP_UNP(4, p); ldpar(par + 1 * 64 + 16 * fq, tmp);
#pragma unroll
        for (int e = 0; e < 16; ++e) zk[e] = c[e] + (p[e] * pm - c[e]) * tmp[e];
        PREP_UNP(2, c); PREP_UNP(5, p); ldpar(par + 2 * 64 + 16 * fq, tmp);
#pragma unroll
        for (int e = 0; e < 16; ++e) zv[e] = c[e] + (p[e] * pm - c[e]) * tmp[e];
    }
    float kkr[16]; float ss = 0.f;
    ldpar(par + 3 * 64 + 16 * fq, tmp);
#pragma unroll
    for (int e = 0; e < 16; ++e) { const float x = -(tmp[e] + ev[e]); const float sp = fmaxf(x, 0.f) + __logf(1.0f + __expf(-fabsf(x))); ev[e] = __expf(-sp - 0.5f); }
    ldpar(par + 4 * 64 + 16 * fq, tmp);
#pragma unroll
    for (int e = 0; e < 16; ++e) av[e] = sigmoidf_(tmp[e] + av[e]);
    ldpar(par + 5 * 64 + 16 * fq, tmp);
#pragma unroll
    for (int e = 0; e < 16; ++e) { kkr[e] = zk[e] * tmp[e]; ss += kkr[e] * kkr[e]; }
    ss += __shfl_xor(ss, 16); ss += __shfl_xor(ss, 32);
    const float inv = 1.0f / fmaxf(sqrtf(ss), 1e-12f);
    ldpar(par + 6 * 64 + 16 * fq, tmp);
    float kp[16], kka[16];
#pragma unroll
    for (int e = 0; e < 16; ++e) { kkr[e] *= inv; kka[e] = kkr[e] * av[e]; kp[e] = zk[e] * (1.0f + (av[e] - 1.0f) * tmp[e]); }
    st16(vbuf + (size_t)m * 512 + cl, zv); st16(gbuf + (size_t)m * 512 + cl, gv);
    { ldpar(par + 7 * 64 + 16 * fq, tmp);
      float bsum = 0.f;
#pragma unroll
      for (int e = 0; e < 16; ++e) bsum += zr[e] * kp[e] * tmp[e];
      bsum += __shfl_xor(bsum, 16); bsum += __shfl_xor(bsum, 32);
      if (fq == 0) ((float*)(F.ws + WS_BONUS))[(size_t)m * 8 + h] = bsum; }
    asm volatile("" ::: "memory");
    unsigned char* rec = F.ws + WS_S + (size_t)task * CH_REC;
    bf16x8 Pb[2], Qb[2], Kb[2], Rb[2];
#pragma unroll
    for (int ks = 0; ks < 2; ++ks) {
        float Pm[8], Qm[8], Km[8], Rm[8], acv[8];
#pragma unroll
        for (int e8 = 0; e8 < 8; ++e8) { const int e = 8 * ks + e8;
            float cs = ev[e]; cs += dppf<0x111>(cs); cs += dppf<0x112>(cs); cs += dppf<0x114>(cs); cs += dppf<0x118>(cs);
            const float A = __expf(-cs), Ap = __expf(ev[e] - cs), iA = __expf(cs);
            Pm[e8] = kkr[e] * Ap; Qm[e8] = -kka[e] * iA; Km[e8] = kp[e] * iA; Rm[e8] = zr[e] * A; acv[e8] = A; }
        v4u w;
        w.x = pk2(Pm[0], Pm[1]); w.y = pk2(Pm[2], Pm[3]); w.z = pk2(Pm[4], Pm[5]); w.w = pk2(Pm[6], Pm[7]); Pb[ks] = __builtin_bit_cast(bf16x8, w);
        w.x = pk2(Qm[0], Qm[1]); w.y = pk2(Qm[2], Qm[3]); w.z = pk2(Qm[4], Qm[5]); w.w = pk2(Qm[6], Qm[7]); Qb[ks] = __builtin_bit_cast(bf16x8, w);
        w.x = pk2(Km[0], Km[1]); w.y = pk2(Km[2], Km[3]); w.z = pk2(Km[4], Km[5]); w.w = pk2(Km[6], Km[7]); Kb[ks] = __builtin_bit_cast(bf16x8, w);
        w.x = pk2(Rm[0], Rm[1]); w.y = pk2(Rm[2], Rm[3]); w.z = pk2(Rm[4], Rm[5]); w.w = pk2(Rm[6], Rm[7]); Rb[ks] = __builtin_bit_cast(bf16x8, w);
        if (fr == 15) { *(f32x4*)(rec + CH_AC + (16 * fq + 8 * ks) * 4) = (f32x4){acv[0], acv[1], acv[2], acv[3]}; *(f32x4*)(rec + CH_AC + (16 * fq + 8 * ks + 4) * 4) = (f32x4){acv[4], acv[5], acv[6], acv[7]}; }
    }
    *(v4u*)(rec + CH_P + fr * CH_PP + 32 * fq) = __builtin_bit_cast(v4u, Pb[0]); *(v4u*)(rec + CH_P + fr * CH_PP + 32 * fq + 16) = __builtin_bit_cast(v4u, Pb[1]);
    *(v4u*)(rec + CH_R + fr * CH_PP + 32 * fq) = __builtin_bit_cast(v4u, Rb[0]); *(v4u*)(rec + CH_R + fr * CH_PP + 32 * fq + 16) = __builtin_bit_cast(v4u, Rb[1]);
    *(v4u*)(rec + CH_Q + (fq * 16 + fr) * 32) = __builtin_bit_cast(v4u, Qb[0]); *(v4u*)(rec + CH_Q + (fq * 16 + fr) * 32 + 16) = __builtin_bit_cast(v4u, Qb[1]);
    *(v4u*)(rec + CH_K + (fq * 16 + fr) * 32) = __builtin_bit_cast(v4u, Kb[0]); *(v4u*)(rec + CH_K + (fq * 16 + fr) * 32 + 16) = __builtin_bit_cast(v4u, Kb[1]);
    f32x4 gqp = (f32x4){0.f, 0.f, 0.f, 0.f}, gkp = gqp, gqr = gqp, gkr = gqp;
#pragma unroll
    for (int ks = 0; ks < 2; ++ks) { gqp = MFMA16(Qb[ks], Pb[ks], gqp); gkp = MFMA16(Kb[ks], Pb[ks], gkp); gqr = MFMA16(Qb[ks], Rb[ks], gqr); gkr = MFMA16(Kb[ks], Rb[ks], gkr); }
#pragma unroll
    for (int rg = 0; rg < 4; ++rg) { const int s = 4 * fq + rg; if (!(s < fr)) { gqp[rg] = 0.f; gkp[rg] = 0.f; } if (!(s <= fr)) { gqr[rg] = 0.f; gkr[rg] = 0.f; } }
    *(v2u*)(rec + CH_G + 0 * 512 + (fr * 16 + 4 * fq) * 2) = pk4(gkp);
    *(v2u*)(rec + CH_G + 2 * 512 + (fr * 16 + 4 * fq) * 2) = pk4(gqr);
    *(v2u*)(rec + CH_G + 3 * 512 + (fr * 16 + 4 * fq) * 2) = pk4(gkr);
    LAS float* Nl = (LAS float*)(F.lds + F.wave * 4096);
#pragma unroll
    for (int rg = 0; rg < 4; ++rg) Nl[(4 * fq + rg) * 20 + fr] = gqp[rg];
    LDS_WAIT(); __builtin_amdgcn_wave_barrier(); asm volatile("" ::: "memory");
    float Tc[16];
#pragma unroll
    for (int s = 15; s >= 0; --s) {
        float acc = 0.f;
#pragma unroll
        for (int q4 = 0; q4 < 4; ++q4) if (4 * q4 + 3 > s) { const f32x4 nv = *(const LAS f32x4*)(Nl + s * 20 + 4 * q4);
#pragma unroll
            for (int u = 0; u < 4; ++u) if (4 * q4 + u > s) acc += nv[u] * Tc[4 * q4 + u]; }
        Tc[s] = (s == fr) ? 1.0f : acc; }
    { f32x4 tv;
#pragma unroll
      for (int u = 0; u < 4; ++u) tv[u] = fq == 0 ? Tc[u] : (fq == 1 ? Tc[4 + u] : (fq == 2 ? Tc[8 + u] : Tc[12 + u]));
      *(v2u*)(rec + CH_G + 1 * 512 + (fr * 16 + 4 * fq) * 2) = pk4(tv); }
    LDS_WAIT(); __builtin_amdgcn_wave_barrier(); asm volatile("" ::: "memory");
#undef PREP_MM
#undef PREP_UNP
}
__device__ __forceinline__ void prep_fill_par(Frame& F, LAS float* par, int h) {
    const int l = F.lane; const float* mu = F.ap->in[4];
    par[0 * 64 + l] = mu[ZC_R + h * 64 + l]; par[1 * 64 + l] = mu[ZC_K + h * 64 + l]; par[2 * 64 + l] = mu[ZC_V + h * 64 + l];
    par[3 * 64 + l] = F.ap->in[5][h * 64 + l]; par[4 * 64 + l] = F.ap->in[7][h * 64 + l]; par[5 * 64 + l] = F.ap->in[10][h * 64 + l]; par[6 * 64 + l] = F.ap->in[11][h * 64 + l]; par[7 * 64 + l] = F.ap->in[12][h * 64 + l];
    LDS_WAIT(); __builtin_amdgcn_wave_barrier(); asm volatile("" ::: "memory");
}

__device__ __forceinline__ float nsa_slope(int g, int r) { return __uint_as_float((unsigned)(127 - (g * 4 + r + 1)) << 23); }

constexpr int CMP_KC_OFF = 32768, CMP_KP = 144, CMP_VC_OFF = CMP_KC_OFF + 128 * CMP_KP, CMP_VP = 264;
__device__ __forceinline__ void nsa_cmp_stage(Frame& F, int bg) {
    const bf16* kcmp = (const bf16*)(F.ws + WS_KCMP) + (size_t)bg * 128 * 64; const bf16* vcmpT = (const bf16*)(F.ws + WS_KCMP + 512 * 1024) + (size_t)bg * 64 * 128;
    v4u a[2], v[2];
#pragma unroll
    for (int i = 0; i < 2; ++i) { const int id = F.tid + 512 * i; a[i] = *(const v4u*)(kcmp + (size_t)(id >> 3) * 64 + (id & 7) * 8); v[i] = *(const v4u*)(vcmpT + (size_t)(id >> 4) * 128 + (id & 15) * 8); }
#pragma unroll
    for (int i = 0; i < 2; ++i) { const int id = F.tid + 512 * i; *(LAS v4u*)(F.lds + CMP_KC_OFF + (id >> 3) * CMP_KP + (id & 7) * 16) = a[i]; *(LAS v4u*)(F.lds + CMP_VC_OFF + (id >> 4) * CMP_VP + (id & 15) * 16) = v[i]; }
}
template <int ABL>
__device__ __forceinline__ void nsa_cmp_task(Frame& F, int task) {
    const int tile = task & 127, bg = task >> 7, b = bg >> 1, g = bg & 1;
    const int fr = F.lane & 15, fq = F.lane >> 4, t = tile * 16 + fr, m = b * SEQ + t;
    const bf16* z = (const bf16*)(F.ws + WS_Z);
    const float* zg = (const float*)(F.ws + WS_ZGATE); const float* gb = F.ap->in[21];
    bf16* Y = (bf16*)(F.ws + WS_YB);
    bf16x8 qall[4][2]; float gl[4];
#pragma unroll
    for (int r = 0; r < 4; ++r) { const bf16* qp = z + (size_t)m * NZ + ZC_Q + (g * 4 + r) * 64 + 8 * fq; qall[r][0] = *(const bf16x8*)qp; qall[r][1] = *(const bf16x8*)(qp + 32);
        gl[r] = zg[(size_t)m * 32 + (g * 4 + r) * 3 + 0] + gb[(g * 4 + r) * 3 + 0]; }
    const LAS unsigned char* kc = F.lds + CMP_KC_OFF + fr * CMP_KP + 16 * fq; const LAS unsigned char* vc = F.lds + CMP_VC_OFF + fr * CMP_VP + 8 * fq;
    const int tv = t - 31 - 64 * fq; const float tb = (float)t - 15.5f - 64.0f * (float)fq;
    float impl[8], imp3[8];
#pragma unroll
    for (int kt = 0; kt < 8; ++kt) { impl[kt] = 0.f; imp3[kt] = 0.f; }
#pragma unroll
    for (int r = 0; r < 4; ++r) {
        const float slope = nsa_slope(g, r);
        const bf16x8 q0 = qall[r][0], q1 = qall[r][1];
        float s[8][4]; float mx = -1e30f;
#pragma unroll
        for (int kt = 0; kt < 8; ++kt) {
            f32x4 a = (f32x4){0.f, 0.f, 0.f, 0.f};
            a = MFMA16(*(const LAS bf16x8*)(kc + 16 * kt * CMP_KP), q0, a); a = MFMA16(*(const LAS bf16x8*)(kc + 16 * kt * CMP_KP + 64), q1, a);
#pragma unroll
            for (int rg = 0; rg < 4; ++rg) { const bool valid = ((256 * kt + 16 * rg) <= tv);
                const float sc = a[rg] * 0.125f - slope * (tb - (float)(256 * kt + 16 * rg)); s[kt][rg] = valid ? sc : -1e30f; mx = fmaxf(mx, s[kt][rg]); }
        }
        mx = fmaxf(mx, __shfl_xor(mx, 16)); mx = fmaxf(mx, __shfl_xor(mx, 32));
        float sum = 0.f;
#pragma unroll
        for (int kt = 0; kt < 8; ++kt)
#pragma unroll
            for (int rg = 0; rg < 4; ++rg) { const float p = (s[kt][rg] > -1e29f) ? __expf(s[kt][rg] - mx) : 0.f; s[kt][rg] = p; sum += p; }
        sum += __shfl_xor(sum, 16); sum += __shfl_xor(sum, 32);
        const float inv = sum > 0.f ? 1.0f / sum : 0.f;
#pragma unroll
        for (int kt = 0; kt < 8; ++kt) {
#pragma unroll
            for (int rg = 0; rg < 4; ++rg) s[kt][rg] *= inv;
            impl[kt] += s[kt][0] + s[kt][1] + s[kt][2] + 0.5f * s[kt][3]; imp3[kt] += s[kt][3]; }
        f32x4 o[4];
#pragma unroll
        for (int dt = 0; dt < 4; ++dt) o[dt] = (f32x4){0.f, 0.f, 0.f, 0.f};
#pragma unroll
        for (int s2 = 0; s2 < 4; ++s2) {
            v4u pw; pw.x = pk2(s[2 * s2][0], s[2 * s2][1]); pw.y = pk2(s[2 * s2][2], s[2 * s2][3]); pw.z = pk2(s[2 * s2 + 1][0], s[2 * s2 + 1][1]); pw.w = pk2(s[2 * s2 + 1][2], s[2 * s2 + 1][3]);
            const bf16x8 pb = __builtin_bit_cast(bf16x8, pw);
#pragma unroll
            for (int dt = 0; dt < 4; ++dt) { const LAS unsigned char* vp = vc + 16 * dt * CMP_VP + 64 * s2; const v2u lo = *(const LAS v2u*)vp, hi = *(const LAS v2u*)(vp + 32);
                v4u aw; aw.x = lo.x; aw.y = lo.y; aw.z = hi.x; aw.w = hi.y; o[dt] = MFMA16(__builtin_bit_cast(bf16x8, aw), pb, o[dt]); }
        }
        const int hh = g * 4 + r; const float gate = sigmoidf_(gl[r]);
#pragma unroll
        for (int dt = 0; dt < 4; ++dt) *(v2u*)(Y + (size_t)m * 512 + hh * 64 + 16 * dt + 4 * fq) = pk4(o[dt] * gate);
        __builtin_amdgcn_sched_barrier(0);
    }
    if (ABL == 1) return;
    LAS float* sc = (LAS float*)(F.lds + F.wave * 4096);
    float y3prev = 0.f;
#pragma unroll
    for (int kt = 0; kt < 8; ++kt) {
        const float y3 = __shfl(imp3[kt], (F.lane + 48) & 63);
        const float prev = (fq > 0) ? y3 : y3prev; y3prev = y3;
        sc[fr * 33 + 4 * kt + fq] = impl[kt] + 0.5f * prev;
    }
    LDS_WAIT(); __builtin_amdgcn_wave_barrier(); asm volatile("" ::: "memory");
    const int blk_t = t >> 6, chi = blk_t - 2;
    unsigned mask = 1u | (1u << blk_t) | (blk_t > 0 ? (1u << (blk_t - 1)) : 0u);
#pragma unroll
    for (int kt = 0; kt < 8; ++kt) {
        const int k = 4 * kt + fq;
        if (k >= 1 && k <= chi) { const float me = sc[fr * 33 + k]; int rank = 0;
            for (int k2 = 1; k2 <= chi; ++k2) { const float o = sc[fr * 33 + k2]; rank += (o > me || (o == me && k2 < k)) ? 1 : 0; }
            if (rank < 5) mask |= (1u << k); }
    }
    mask |= (unsigned)__shfl_xor((int)mask, 16); mask |= (unsigned)__shfl_xor((int)mask, 32);
    if (fq == 0) ((unsigned*)(F.ws + WS_SELMASK))[(size_t)bg * SEQ + t] = mask;
    LDS_WAIT(); __builtin_amdgcn_wave_barrier(); asm volatile("" ::: "memory");
}
__device__ __forceinline__ void p3_phase(Frame& F) {
    constexpr int T0 = 2048, T1 = T0 + 8192;
#ifdef DUP_P3A
    for (int task = F.gw; task < T0; task += F.NGW) { __syncthreads(); nsa_cmp_stage(F, task >> 7); LDS_WAIT(); __syncthreads(); nsa_cmp_task<DUP_P3A>(F, task); }
    asm volatile("" ::: "memory");
#endif
    for (int task = F.gw; task < T0; task += F.NGW) { __syncthreads(); nsa_cmp_stage(F, task >> 7); LDS_WAIT(); __syncthreads(); nsa_cmp_task<0>(F, task); }
    asm volatile("" ::: "memory");
    const int h = F.vcu & 7;
    LAS float* par = (LAS float*)(F.lds + F.wave * 4096 + 2048);
    __syncthreads();
    prep_fill_par(F, par, h); prep_stage_w(F, h);
    LDS_WAIT(); __syncthreads();
#ifdef DUP_P3B
    for (int i = F.wave; i < 32; i += 8) rwkv_prep_task(F, (((F.vcu >> 3) + 32 * i) << 3) | h, par);
    asm volatile("" ::: "memory");
#endif
    for (int i = F.wave; i < 32; i += 8) rwkv_prep_task(F, (((F.vcu >> 3) + 32 * i) << 3) | h, par);
}

constexpr int NSA_KP = 144, NSA_VP = 136, NSA_BUF = 64 * NSA_KP + 64 * NSA_VP, NSA_CTL = 2 * NSA_BUF + 1024;
struct NsaState { f32x4 O[2][4]; float mrun[2], lrun[2]; };
template <int WHICH, bool MASKED>
__device__ __forceinline__ void nsa_block(NsaState& St, const LAS unsigned char* kb_, const LAS unsigned char* vb_, const bf16x8 (&qf)[2][2], int kb, unsigned mymask, int t, int fq, float slope0) {
    const int kpos0 = 64 * kb;
    bf16x8 kf[4][2];
#pragma unroll
    for (int kt = 0; kt < 4; ++kt) { kf[kt][0] = *(const LAS bf16x8*)(kb_ + 16 * kt * NSA_KP); kf[kt][1] = *(const LAS bf16x8*)(kb_ + 16 * kt * NSA_KP + 64); }
    const bool bsel = (mymask >> kb) & 1u; const int dbase = t - 4 * fq - kpos0;
    const float fdb = (float)dbase;
    bf16x8 P[2][2];
#pragma unroll
    for (int r = 0; r < 2; ++r) {
        const float slope = r ? 0.5f * slope0 : slope0;
        float s[4][4]; float bm = -1e30f;
        float base = -slope * fdb;
        const float s1 = slope, s2_ = 2.0f * slope, s3 = 3.0f * slope, s16 = 16.0f * slope;
#pragma unroll
        for (int kt = 0; kt < 4; ++kt) { f32x4 a = (f32x4){base, base + s1, base + s2_, base + s3}; base += s16;
            a = MFMA16(kf[kt][0], qf[r][0], a); a = MFMA16(kf[kt][1], qf[r][1], a);
#pragma unroll
            for (int rg = 0; rg < 4; ++rg) {
                if (MASKED) { const int dist = dbase - (16 * kt + rg); const bool valid = bsel && dist >= 0 && (WHICH == 0 || dist < 512); s[kt][rg] = valid ? a[rg] : -1e30f; }
                else s[kt][rg] = a[rg];
                bm = fmaxf(bm, s[kt][rg]); } }
        bm = fmaxf(bm, __shfl_xor(bm, 16)); bm = fmaxf(bm, __shfl_xor(bm, 32));
        const float mnew = fmaxf(St.mrun[r], bm); const float scale = __builtin_amdgcn_exp2f(St.mrun[r] - mnew); St.mrun[r] = mnew;
        float ps = 0.f;
#pragma unroll
        for (int kt = 0; kt < 4; ++kt)
#pragma unroll
            for (int rg = 0; rg < 4; ++rg) { float p = __builtin_amdgcn_exp2f(s[kt][rg] - mnew); if (MASKED) p = (s[kt][rg] > -1e29f) ? p : 0.f; s[kt][rg] = p; ps += p; }
        St.lrun[r] = St.lrun[r] * scale + ps;
#pragma unroll
        for (int dt = 0; dt < 4; ++dt) St.O[r][dt] = St.O[r][dt] * scale;
#pragma unroll
        for (int s2 = 0; s2 < 2; ++s2) { v4u pw; pw.x = pk2(s[2 * s2][0], s[2 * s2][1]); pw.y = pk2(s[2 * s2][2], s[2 * s2][3]); pw.z = pk2(s[2 * s2 + 1][0], s[2 * s2 + 1][1]); pw.w = pk2(s[2 * s2 + 1][2], s[2 * s2 + 1][3]);
            P[r][s2] = __builtin_bit_cast(bf16x8, pw); }
    }
#pragma unroll
    for (int dt = 0; dt < 4; ++dt)
#pragma unroll
        for (int s2 = 0; s2 < 2; ++s2) { const LAS unsigned char* vp = vb_ + 16 * dt * NSA_VP + 64 * s2; const v2u lo = *(const LAS v2u*)vp, hi = *(const LAS v2u*)(vp + 32);
            v4u aw; aw.x = lo.x; aw.y = lo.y; aw.z = hi.x; aw.w = hi.y; const bf16x8 vf = __builtin_bit_cast(bf16x8, aw);
#pragma unroll
            for (int r = 0; r < 2; ++r) St.O[r][dt] = MFMA16(vf, P[r][s2], St.O[r][dt]); }
}
template <int WHICH>
__device__ __forceinline__ void nsa_wg_task(Frame& F, int item) {
    const int hp = item & 1, bg = item >> 5, tg = (item >> 1) & 15, b = bg >> 1, g = bg & 1;
    const int fr = F.lane & 15, fq = F.lane >> 4, tile = tg * 8 + F.wave, t0 = tile * 16, t = t0 + fr, m = b * SEQ + t;
    const int h0 = g * 4 + 2 * hp;
    const bf16* z = (const bf16*)(F.ws + WS_Z);
    const bf16* Kb = z + (size_t)b * SEQ * NZ + (WHICH ? ZC_KW : ZC_KS) + g * 64;
    const bf16* VT = (const bf16*)(F.ws + (WHICH ? WS_VWT : WS_VST)) + (size_t)bg * 64 * SEQ;
    unsigned mymask, tile_or, full; const int kb_hi = (t0 + 15) >> 6;
    if (WHICH == 0) { mymask = ((const unsigned*)(F.ws + WS_SELMASK))[(size_t)bg * SEQ + t]; unsigned x = mymask, y = mymask;
        x |= (unsigned)__shfl_xor((int)x, 1); x |= (unsigned)__shfl_xor((int)x, 2); x |= (unsigned)__shfl_xor((int)x, 4); x |= (unsigned)__shfl_xor((int)x, 8);
        y &= (unsigned)__shfl_xor((int)y, 1); y &= (unsigned)__shfl_xor((int)y, 2); y &= (unsigned)__shfl_xor((int)y, 4); y &= (unsigned)__shfl_xor((int)y, 8);
        tile_or = (unsigned)__builtin_amdgcn_readfirstlane((int)x); full = (unsigned)__builtin_amdgcn_readfirstlane((int)y) & ((1u << kb_hi) - 1u); }
    else { mymask = 0xffffffffu; const int lo = (t0 - 511) > 0 ? ((t0 - 511) >> 6) : 0; tile_or = 0u; full = 0u;
        for (int k = lo; k <= kb_hi; ++k) { tile_or |= (1u << k); if (k < kb_hi && 64 * k >= t0 - 496) full |= (1u << k); } }
    tile_or &= (kb_hi >= 31) ? 0xffffffffu : ((2u << kb_hi) - 1u);
    LAS unsigned* ctl = (LAS unsigned*)(F.lds + NSA_CTL);
    __syncthreads();
    if (F.lane == 0) ctl[F.wave] = tile_or;
    LDS_WAIT(); __syncthreads();
    unsigned rem = 0u;
#pragma unroll
    for (int w = 0; w < 8; ++w) rem |= ctl[w];
    rem = (unsigned)__builtin_amdgcn_readfirstlane((int)rem);
    bf16x8 qf[2][2];
#pragma unroll
    for (int r = 0; r < 2; ++r)
#pragma unroll
        for (int ks = 0; ks < 2; ++ks) { const v4u raw = *(const v4u*)(z + (size_t)m * NZ + ZC_Q + (h0 + r) * 64 + 8 * fq + 32 * ks); float f[8]; unpk8(raw, f);
            constexpr float QS = 0.125f * 1.4426950408889634f; v4u w; w.x = pk2(f[0] * QS, f[1] * QS); w.y = pk2(f[2] * QS, f[3] * QS); w.z = pk2(f[4] * QS, f[5] * QS); w.w = pk2(f[6] * QS, f[7] * QS);
            qf[r][ks] = __builtin_bit_cast(bf16x8, w); }
    NsaState St;
#pragma unroll
    for (int r = 0; r < 2; ++r) { St.mrun[r] = -1e30f; St.lrun[r] = 0.f;
#pragma unroll
        for (int dt = 0; dt < 4; ++dt) St.O[r][dt] = (f32x4){0.f, 0.f, 0.f, 0.f}; }
    const float slope0 = 1.4426950408889634f * __uint_as_float((unsigned)(127 - (h0 + 1)) << 23);
    const int srow = F.tid >> 3, sc = F.tid & 7;
    const bf16* ksrc = Kb + (size_t)srow * NZ + sc * 8; const bf16* vsrc = VT + (size_t)srow * SEQ + sc * 8;
    const int kdst = srow * NSA_KP + sc * 16, vdst = 64 * NSA_KP + srow * NSA_VP + sc * 16;
    const LAS unsigned char* kfr = F.lds + fr * NSA_KP + 16 * fq; const LAS unsigned char* vfr = F.lds + 64 * NSA_KP + fr * NSA_VP + 8 * fq;
    int kb = __builtin_ctz(rem); rem &= rem - 1u;
    v4u kreg = *(const v4u*)(ksrc + (size_t)64 * kb * NZ), vreg = *(const v4u*)(vsrc + 64 * kb);
    *(LAS v4u*)(F.lds + kdst) = kreg; *(LAS v2u*)(F.lds + vdst) = (v2u){vreg.x, vreg.y}; *(LAS v2u*)(F.lds + vdst + 8) = (v2u){vreg.z, vreg.w};
    LDS_WAIT(); __syncthreads();
    int buf = 0;
    for (;;) {
        int kbn = -1;
        if (rem) { kbn = __builtin_ctz(rem); rem &= rem - 1u; kreg = *(const v4u*)(ksrc + (size_t)64 * kbn * NZ); vreg = *(const v4u*)(vsrc + 64 * kbn); }
        __builtin_amdgcn_sched_barrier(0);
        if ((tile_or >> kb) & 1u) {
            if ((full >> kb) & 1u) nsa_block<WHICH, false>(St, kfr + buf * NSA_BUF, vfr + buf * NSA_BUF, qf, kb, mymask, t, fq, slope0);
            else nsa_block<WHICH, true>(St, kfr + buf * NSA_BUF, vfr + buf * NSA_BUF, qf, kb, mymask, t, fq, slope0);
        }
        __builtin_amdgcn_sched_barrier(0);
        if (kbn < 0) break;
        buf ^= 1;
        *(LAS v4u*)(F.lds + buf * NSA_BUF + kdst) = kreg; *(LAS v2u*)(F.lds + buf * NSA_BUF + vdst) = (v2u){vreg.x, vreg.y}; *(LAS v2u*)(F.lds + buf * NSA_BUF + vdst + 8) = (v2u){vreg.z, vreg.w};
        LDS_WAIT(); __syncthreads();
        kb = kbn;
    }
    const float* zg = (const float*)(F.ws + WS_ZGATE); const float* gb = F.ap->in[21];
    bf16* Y = (bf16*)(F.ws + WS_YB + (size_t)(1 + WHICH) * 16 * MiB);
#pragma unroll
    for (int r = 0; r < 2; ++r) { float l = St.lrun[r]; l += __shfl_xor(l, 16); l += __shfl_xor(l, 32);
        const int hh = h0 + r; const float gate = sigmoidf_(zg[(size_t)m * 32 + hh * 3 + 1 + WHICH] + gb[hh * 3 + 1 + WHICH]); const float f = gate / l;
#pragma unroll
        for (int dt = 0; dt < 4; ++dt) *(v2u*)(Y + (size_t)m * 512 + hh * 64 + 16 * dt + 4 * fq) = pk4(St.O[r][dt] * f); }
}
__device__ __forceinline__ void p4_phase(Frame& F) {
    for (int it = F.vcu; it < 512; it += F.G) { nsa_wg_task<1>(F, it); nsa_wg_task<0>(F, 511 - it); }
}

typedef short v4i16_t __attribute__((ext_vector_type(4)));
__device__ __forceinline__ bf16x8 tr_lo(const LAS unsigned char* p) {
    const v4i16_t t = __builtin_amdgcn_ds_read_tr16_b64_v4i16((LAS v4i16_t*)p);
    return (bf16x8){t[0], t[1], t[2], t[3], 0, 0, 0, 0};
}
__device__ __forceinline__ bf16x8 lo4(v2u g) { v4u w; w.x = g.x; w.y = g.y; w.z = 0u; w.w = 0u; return __builtin_bit_cast(bf16x8, w); }
__device__ __forceinline__ bf16x8 cat8(v2u a, v2u b) { v4u w; w.x = a.x; w.y = a.y; w.z = b.x; w.w = b.y; return __builtin_bit_cast(bf16x8, w); }
struct ChunkOps { v2u pA[2][2], rA[2][2], g[4]; f32x4 ac[4]; bf16x8 aq[4], ak[4], bv; };
__device__ __forceinline__ void chunk_load(const LAS unsigned char* sl, ChunkOps& X, int lane) {
    const int fr = lane & 15, fq = lane >> 4;
#pragma unroll
    for (int m = 0; m < 2; ++m) { X.pA[m][0] = *(const LAS v2u*)(sl + CH_P + fr * CH_PP + 64 * m + 8 * fq); X.pA[m][1] = *(const LAS v2u*)(sl + CH_P + fr * CH_PP + 64 * m + 32 + 8 * fq);
        X.rA[m][0] = *(const LAS v2u*)(sl + CH_R + fr * CH_PP + 64 * m + 8 * fq); X.rA[m][1] = *(const LAS v2u*)(sl + CH_R + fr * CH_PP + 64 * m + 32 + 8 * fq); }
#pragma unroll
    for (int x = 0; x < 4; ++x) X.g[x] = *(const LAS v2u*)(sl + CH_G + 512 * x + (fr * 16 + 4 * fq) * 2);
    X.bv = tr_lo(sl + CH_V + 8 * lane);
#pragma unroll
    for (int jt = 0; jt < 4; ++jt) { X.aq[jt] = tr_lo(sl + CH_Q + jt * 512 + 8 * lane); X.ak[jt] = tr_lo(sl + CH_K + jt * 512 + 8 * lane);
        X.ac[jt] = *(const LAS f32x4*)(sl + CH_AC + (16 * jt + 4 * fq) * 4); }
}
__device__ __forceinline__ bf16x8 lo4t(bf16x8 t) { return t; }
__device__ __forceinline__ void chunk_math(const ChunkOps& X, f32x4 (&S)[4], f32x4& o_out) {
    bf16x8 bs[2];
#pragma unroll
    for (int m = 0; m < 2; ++m) { v4u w; w.x = pk2(S[2 * m][0], S[2 * m][1]); w.y = pk2(S[2 * m][2], S[2 * m][3]); w.z = pk2(S[2 * m + 1][0], S[2 * m + 1][1]); w.w = pk2(S[2 * m + 1][2], S[2 * m + 1][3]); bs[m] = __builtin_bit_cast(bf16x8, w); }
    const f32x4 z4 = (f32x4){0.f, 0.f, 0.f, 0.f};
    const bf16x8 bv = lo4t(X.bv);
    f32x4 y = MFMA16(cat8(X.pA[0][0], X.pA[0][1]), bs[0], z4); y = MFMA16(cat8(X.pA[1][0], X.pA[1][1]), bs[1], y); y = MFMA16(lo4(X.g[0]), bv, y);
    f32x4 o = MFMA16(cat8(X.rA[0][0], X.rA[0][1]), bs[0], z4); o = MFMA16(cat8(X.rA[1][0], X.rA[1][1]), bs[1], o); o = MFMA16(lo4(X.g[3]), bv, o);
    const bf16x8 by = lo4(pk4(y));
    const f32x4 u = MFMA16(lo4(X.g[1]), by, z4);
    const bf16x8 bu = lo4(pk4(u));
    o_out = MFMA16(lo4(X.g[2]), bu, o);
#pragma unroll
    for (int jt = 0; jt < 4; ++jt) { S[jt] = MFMA16(lo4t(X.aq[jt]), bu, S[jt]); S[jt] = MFMA16(lo4t(X.ak[jt]), bv, S[jt]); S[jt] = S[jt] * X.ac[jt]; }
}
#ifndef SC_CONVW
#define SC_CONVW 3
#endif
constexpr int SC_NS = 7, SC_AHEAD = 5, SC_CTL = SC_NS * CH_SLOT, SCAN_TR_OFF = 81920;
__device__ __forceinline__ void scan_dma(const unsigned char* rec, const bf16* vt, LAS unsigned char* slot, int lane) {
#pragma unroll
    for (int i = 0; i < 10; ++i) __builtin_amdgcn_global_load_lds((const unsigned*)(rec + (lane + 64 * i) * 16), (LAS unsigned*)(slot + i * 1024), 16, 0, 0);
    if (lane < 48) __builtin_amdgcn_global_load_lds((const unsigned*)(rec + (lane + 640) * 16), (LAS unsigned*)(slot + 10240), 16, 0, 0);
    if (lane < 32) __builtin_amdgcn_global_load_lds((const unsigned*)(vt + (size_t)(lane >> 1) * 512 + 8 * (lane & 1)), (LAS unsigned*)(slot + CH_V), 16, 0, 0);
}
__device__ __forceinline__ int sc_ld(LAS int* p) { int v; const unsigned a = (unsigned)(size_t)p; asm volatile("ds_read_b32 %0, %1\n\ts_waitcnt lgkmcnt(0)" : "=&v"(v) : "v"(a) : "memory"); return v; }
__device__ __forceinline__ void sc_st(LAS int* p, int v) { const unsigned a = (unsigned)(size_t)p; asm volatile("ds_write_b32 %0, %1" :: "v"(a), "v"(v) : "memory"); }
#define SC_LD(p) sc_ld(p)
#define SC_ST(p, v) sc_st((p), (v))
__device__ __forceinline__ void p5_scan(Frame& F, bool extras = true, int abl = 0) {
    LAS int* ctl = (LAS int*)(F.lds + SC_CTL);
    if (F.tid < 4) ctl[F.tid] = 0;
    LDS_WAIT(); __syncthreads();
    constexpr int NKQ = (tri::NITEMS - tri::E12) / 256;
    LAS float* mytile = (LAS float*)(F.lds + SCAN_TR_OFF + F.wave * 8448);
    const int bh = F.vcu >> 2, b = bh >> 3, h = bh & 7, i0 = (F.vcu & 3) * 16;
    if (F.wave == 0) {
        if (abl & 1) return;
        __builtin_amdgcn_s_setprio(3);
        float* o0 = (float*)(F.ws + WS_XN) + (size_t)b * SEQ * 512 + h * 64 + i0;
        const int fr = F.lane & 15, fq = F.lane >> 4;
        f32x4 S[4];
#pragma unroll
        for (int jt = 0; jt < 4; ++jt) S[jt] = (f32x4){0.f, 0.f, 0.f, 0.f};
        ChunkOps XA, XB;
        while (SC_LD(&ctl[0]) <= 0) __builtin_amdgcn_s_sleep(1);
        asm volatile("" ::: "memory");
        chunk_load(F.lds, XA, F.lane);
        LDS_WAIT(); asm volatile("" ::: "memory");
        if (F.lane == 0) SC_ST(&ctl[1], 1);
#define SCAN_ITER(XC, XN_, c_) do { const int cc = (c_); \
            if (cc + 1 < 128) { while (SC_LD(&ctl[0]) <= cc + 1) __builtin_amdgcn_s_sleep(1); asm volatile("" ::: "memory"); chunk_load(F.lds + ((cc + 1) % SC_NS) * CH_SLOT, XN_, F.lane); } \
            __builtin_amdgcn_sched_barrier(0); \
            f32x4 o; chunk_math(XC, S, o); \
            __builtin_amdgcn_sched_barrier(0); \
            float* orow = o0 + (size_t)cc * 16 * 512; \
            _Pragma("unroll") for (int rg = 0; rg < 4; ++rg) { float* pp = orow + (size_t)(4 * fq + rg) * 512 + fr; const float vv = o[rg]; asm volatile("global_store_dword %0, %1, off" :: "v"(pp), "v"(vv) : "memory"); } \
            if (cc + 1 < 128) { LDS_WAIT(); asm volatile("" ::: "memory"); if (F.lane == 0) SC_ST(&ctl[1], cc + 2); } } while (0)
#pragma unroll 1
        for (int c = 0; c < 128; c += 2) { SCAN_ITER(XA, XB, c); SCAN_ITER(XB, XA, c + 1); }
#undef SCAN_ITER
        asm volatile("s_waitcnt vmcnt(0)" ::: "memory");
        __builtin_amdgcn_s_setprio(0);
        if (F.lane == 0) SC_ST(&ctl[3], 1);
        if (!(abl & 2)) tr_run_q(F, mytile, &ctl[2], tri::E12 + F.vcu, F.G, NKQ);
    } else if (F.wave == 1) {
        if (abl & 1) return;
        const unsigned char* rec0 = F.ws + WS_S + ((size_t)(b * 128) * 8 + h) * CH_REC;
        const bf16* vt0 = (const bf16*)F.out + (size_t)b * SEQ * 512 + h * 64 + i0;
        for (int n = 0; n < 128; ++n) {
            while (SC_LD(&ctl[1]) < n - SC_NS + 1) __builtin_amdgcn_s_sleep(1);
            asm volatile("" ::: "memory");
            scan_dma(rec0 + (size_t)n * 8 * CH_REC, vt0 + (size_t)n * 16 * 512, F.lds + (n % SC_NS) * CH_SLOT, F.lane);
            if (n >= SC_AHEAD) { asm volatile("s_waitcnt vmcnt(60)" ::: "memory"); if (F.lane == 0) SC_ST(&ctl[0], n - SC_AHEAD + 1); }
        }
        asm volatile("s_waitcnt vmcnt(48)" ::: "memory"); if (F.lane == 0) SC_ST(&ctl[0], 124);
        asm volatile("s_waitcnt vmcnt(36)" ::: "memory"); if (F.lane == 0) SC_ST(&ctl[0], 125);
        asm volatile("s_waitcnt vmcnt(24)" ::: "memory"); if (F.lane == 0) SC_ST(&ctl[0], 126);
        asm volatile("s_waitcnt vmcnt(12)" ::: "memory"); if (F.lane == 0) SC_ST(&ctl[0], 127);
        asm volatile("s_waitcnt vmcnt(0)" ::: "memory"); if (F.lane == 0) SC_ST(&ctl[0], 128);
        if (!(abl & 2)) { while (SC_LD(&ctl[3]) == 0) __builtin_amdgcn_s_sleep(8); tr_run_q(F, mytile, &ctl[2], tri::E12 + F.vcu, F.G, NKQ); }
    } else {
        const int w2 = F.vcu * 6 + (F.wave - 2), NW2 = F.G * 6;
        if (!(abl & 2) && F.wave - 2 < SC_CONVW) tr_run_q(F, mytile, &ctl[2], tri::E12 + F.vcu, F.G, NKQ);
        if (!extras) return;
        for (int mb = w2; mb < M; mb += 4 * NW2) {
            v4u a0[4], a1[4], a2[4];
#pragma unroll
            for (int u = 0; u < 4; ++u) { const int mr = (mb + u * NW2 < M) ? mb + u * NW2 : mb; const bf16* y0 = (const bf16*)(F.ws + WS_YB) + (size_t)mr * 512 + 8 * F.lane; a0[u] = *(const v4u*)y0; a1[u] = *(const v4u*)(y0 + 8 * MiB); a2[u] = *(const v4u*)(y0 + 16 * MiB); }
#pragma unroll
            for (int u = 0; u < 4; ++u) { float f0[8], f1[8], f2[8]; unpk8(a0[u], f0); unpk8(a1[u], f1); unpk8(a2[u], f2);
                v4u w; w.x = pk2(f0[0] + f1[0] + f2[0], f0[1] + f1[1] + f2[1]); w.y = pk2(f0[2] + f1[2] + f2[2], f0[3] + f1[3] + f2[3]); w.z = pk2(f0[4] + f1[4] + f2[4], f0[5] + f1[5] + f2[5]); w.w = pk2(f0[6] + f1[6] + f2[6], f0[7] + f1[7] + f2[7]);
                if (mb + u * NW2 < M) *(v4u*)((bf16*)(F.ws + WS_YB) + (size_t)(mb + u * NW2) * 512 + 8 * F.lane) = w; } }
        const float* p = F.ap->in[1]; bf16* PB = (bf16*)(F.ws + WS_PBF);
        constexpr size_t NV = (size_t)M * 256 / 4;
        for (size_t b0 = (size_t)w2 * 64 + F.lane; b0 < NV; b0 += (size_t)8 * NW2 * 64) {
            f32x4 pv[8];
#pragma unroll
            for (int i = 0; i < 8; ++i) { const size_t idx = b0 + (size_t)i * NW2 * 64; pv[i] = (idx < NV) ? *(const f32x4*)(p + idx * 4) : (f32x4){0.f, 0.f, 0.f, 0.f}; }
#pragma unroll
            for (int i = 0; i < 8; ++i) { const size_t idx = b0 + (size_t)i * NW2 * 64; if (idx < NV) *(v2u*)(PB + idx * 4) = pk4(pv[i]); } }
        if (!(abl & 2) && F.wave - 2 >= SC_CONVW) { while (SC_LD(&ctl[3]) == 0) __builtin_amdgcn_s_sleep(8); tr_run_q(F, mytile, &ctl[2], tri::E12 + F.vcu, F.G, NKQ); }
    }
}

struct P6Par { float lw[8], lb[8]; };
__device__ __forceinline__ void p6_rows2(Frame& F, int ma, int mb_, const P6Par& P) {
    const int l = F.lane, c = 8 * l, h = l >> 3;
    f32x4 oa[2][2]; v4u vv_[2], gg_[2]; float bsv[2];
#pragma unroll
    for (int u = 0; u < 2; ++u) { const int m = u ? mb_ : ma;
        const float* oraw = (const float*)(F.ws + WS_XN) + (size_t)m * 512 + c;
        oa[u][0] = *(const f32x4*)oraw; oa[u][1] = *(const f32x4*)(oraw + 4); bsv[u] = ((const float*)(F.ws + WS_BONUS))[(size_t)m * 8 + h];
        vv_[u] = *(const v4u*)((const bf16*)F.out + (size_t)m * 512 + c); gg_[u] = *(const v4u*)((const bf16*)(F.ws + WS_G) + (size_t)m * 512 + c);
    }
    __builtin_amdgcn_sched_barrier(0);
#pragma unroll
    for (int u = 0; u < 2; ++u) { const int m = u ? mb_ : ma;
        float o[8] = {oa[u][0].x, oa[u][0].y, oa[u][0].z, oa[u][0].w, oa[u][1].x, oa[u][1].y, oa[u][1].z, oa[u][1].w};
        float s = 0.f;
#pragma unroll
        for (int j = 0; j < 8; ++j) s += o[j];
        s += __shfl_xor(s, 1); s += __shfl_xor(s, 2); s += __shfl_xor(s, 4);
        const float mu = s * (1.f / 64.f); float q = 0.f;
#pragma unroll
        for (int j = 0; j < 8; ++j) { o[j] -= mu; q += o[j] * o[j]; }
        q += __shfl_xor(q, 1); q += __shfl_xor(q, 2); q += __shfl_xor(q, 4);
        const float rstd = 1.0f / sqrtf(q * (1.f / 64.f) + GN_EPS);
        float vv[8], gg[8];
        unpk8(vv_[u], vv); unpk8(gg_[u], gg);
        const float bs = bsv[u];
        float y[8];
#pragma unroll
        for (int j = 0; j < 8; ++j) y[j] = (o[j] * rstd * P.lw[j] + P.lb[j] + bs * vv[j]) * gg[j];
        v4u w; w.x = pk2(y[0], y[1]); w.y = pk2(y[2], y[3]); w.z = pk2(y[4], y[5]); w.w = pk2(y[6], y[7]);
        *(v4u*)((bf16*)(F.ws + WS_YRW) + (size_t)m * 512 + c) = w;
    }
}
__device__ __forceinline__ void p6_phase(Frame& F) {
    const int l = F.lane, c = 8 * l;
    P6Par P;
#pragma unroll
    for (int j = 0; j < 8; ++j) { P.lw[j] = F.ap->in[13][c + j]; P.lb[j] = F.ap->in[14][c + j]; }
    for (int m = F.gw; m < M; m += 2 * F.NGW) p6_rows2(F, m, m + F.NGW, P);
}

struct RouteW { f32x4 wv[3][8]; };
__device__ __forceinline__ void route_ldx(Frame& F, int tile, f32x4 (&xv)[8]) {
    const int fr = F.lane & 15, fq = F.lane >> 4; const float* xp = (const float*)(F.ws + WS_Z) + (size_t)(tile * 16 + fr) * D + F.wave * 128 + 4 * fq;
#pragma unroll
    for (int g = 0; g < 8; ++g) xv[g] = *(const f32x4*)(xp + 16 * g);
}
__device__ __forceinline__ void route_tile(Frame& F, int tile, const RouteW& W, const f32x4 (&xv)[8], int par, const f32x4 (&gr)[4]) {
    const int fr = F.lane & 15, fq = F.lane >> 4, m0 = tile * 16;
    const float* x1 = (const float*)(F.ws + WS_Z);
    f32x4 rv[2][4];
#pragma unroll
    for (int i = 0; i < 2; ++i) { const f32x4* xr = (const f32x4*)(x1 + (size_t)(m0 + 2 * F.wave + i) * D) + F.lane;
#pragma unroll
        for (int j = 0; j < 4; ++j) rv[i][j] = xr[64 * j]; }
    f32x4 acc[3] = {(f32x4){0.f, 0.f, 0.f, 0.f}, (f32x4){0.f, 0.f, 0.f, 0.f}, (f32x4){0.f, 0.f, 0.f, 0.f}};
    float ssq = 0.f;
#pragma unroll
    for (int g = 0; g < 8; ++g) {
        ssq += (xv[g].x * xv[g].x + xv[g].y * xv[g].y) + (xv[g].z * xv[g].z + xv[g].w * xv[g].w);
#pragma unroll
        for (int s = 0; s < 4; ++s)
#pragma unroll
            for (int ct = 0; ct < 3; ++ct) acc[ct] = __builtin_amdgcn_mfma_f32_16x16x4f32(W.wv[ct][g][s], xv[g][s], acc[ct], 0, 0, 0);
    }
    ssq += __shfl_xor(ssq, 16); ssq += __shfl_xor(ssq, 32);
    LAS float* red = (LAS float*)(F.lds + par * 32768);
    LAS float* ssqb = red + 8 * 3 * 64 * 4; LAS float* rsb = ssqb + 128;
#pragma unroll
    for (int ct = 0; ct < 3; ++ct) *(LAS f32x4*)(red + ((F.wave * 3 + ct) * 64 + F.lane) * 4) = acc[ct];
    if (fq == 0) ssqb[F.wave * 16 + fr] = ssq;
    LDS_WAIT(); __syncthreads();
    { float st = 0.f;
#pragma unroll
      for (int w = 0; w < 8; ++w) st += ssqb[w * 16 + (F.lane & 15)];
      const float rs = 1.0f / sqrtf(st * (1.f / D) + NORM_EPS);
      if (F.wave == 0) {
#pragma unroll
          for (int ct = 0; ct < 3; ++ct) { f32x4 t = (f32x4){0.f, 0.f, 0.f, 0.f};
#pragma unroll
              for (int w = 0; w < 8; ++w) t = t + *(const LAS f32x4*)(red + ((w * 3 + ct) * 64 + F.lane) * 4);
              *(f32x4*)((float*)(F.ws + WS_LOGITS) + (size_t)(m0 + fr) * 48 + 16 * ct + 4 * fq) = t * rs; } }
      bf16* XN = (bf16*)(F.ws + WS_XN);
#pragma unroll
      for (int i = 0; i < 2; ++i) { const int rr = 2 * F.wave + i; const float rsr = __shfl(rs, rr); v2u* o8 = (v2u*)(XN + (size_t)(m0 + rr) * D) + F.lane;
#pragma unroll
          for (int j = 0; j < 4; ++j) o8[64 * j] = pk4(rv[i][j] * rsr * gr[j]); } }
}
__device__ __forceinline__ void p9_phase(Frame& F, int rep_ = 0) {
    const int fr = F.lane & 15, fq = F.lane >> 4;
    RouteW W;
    { const float* wp = (const float*)(F.ws + WS_SMALLW + SW_ROUTEW) + (size_t)fr * D + F.wave * 128 + 4 * fq;
#pragma unroll
      for (int ct = 0; ct < 3; ++ct)
#pragma unroll
          for (int g = 0; g < 8; ++g) W.wv[ct][g] = *(const f32x4*)(wp + (size_t)ct * 16 * D + 16 * g); }
    f32x4 gr[4];
#pragma unroll
    for (int j = 0; j < 4; ++j) gr[j] = ((const f32x4*)F.ap->in[25])[F.lane + 64 * j];
    f32x4 xa[8], xb[8];
    int tile = F.vcu, par = 0;
    if (tile < 1024) route_ldx(F, tile, xa);
    while (tile < 1024) {
        const int nt = tile + F.G;
        if (nt < 1024) route_ldx(F, nt, xb);
        __builtin_amdgcn_sched_barrier(0);
        route_tile(F, tile, W, xa, par, gr);
#pragma unroll
        for (int g = 0; g < 8; ++g) xa[g] = xb[g];
        tile = nt; par ^= 1;
    }
}

__device__ __forceinline__ void p9b_phase(Frame& F) {
    if (F.wave != 0) return;
    for (int base = F.vcu * 64; base < M; base += F.G * 64) {
        const int tok = base + F.lane;
        const float* lgp = (const float*)(F.ws + WS_LOGITS) + (size_t)tok * 48;
        float lg[36];
#pragma unroll
        for (int q = 0; q < 9; ++q) { const f32x4 v = *(const f32x4*)(lgp + 4 * q); lg[4 * q] = v.x; lg[4 * q + 1] = v.y; lg[4 * q + 2] = v.z; lg[4 * q + 3] = v.w; }
        const float* bg = F.ap->in[27]; const float* br = F.ap->in[29];
        float gl[4]; int gs = 0; float gm = -3.0e38f;
#pragma unroll
        for (int c = 0; c < 4; ++c) { gl[c] = lg[c] + bg[c]; if (gl[c] > gm) { gm = gl[c]; gs = c; } }
        float gsum = 0.f;
#pragma unroll
        for (int c = 0; c < 4; ++c) gsum += __expf(gl[c] - gm);
        const float pgroup = 1.0f / gsum;
        float el[8]; float em = -3.0e38f;
#pragma unroll
        for (int c = 0; c < 8; ++c) { const float lv = gs == 0 ? lg[4 + c] : (gs == 1 ? lg[12 + c] : (gs == 2 ? lg[20 + c] : lg[28 + c])); el[c] = lv + br[gs * 8 + c]; em = fmaxf(em, el[c]); }
        int i1 = 0; float v1 = -3.0e38f;
#pragma unroll
        for (int c = 0; c < 8; ++c) if (el[c] > v1) { v1 = el[c]; i1 = c; }
        int i2 = 0; float v2 = -3.0e38f;
#pragma unroll
        for (int c = 0; c < 8; ++c) if (c != i1 && el[c] > v2) { v2 = el[c]; i2 = c; }
        const float p1 = __expf(v1 - em), p2 = __expf(v2 - em);
        const float g1 = pgroup * p1 / (p1 + p2), g2 = pgroup * p2 / (p1 + p2);
        const int e1 = gs * 8 + i1, e2 = gs * 8 + i2;
        const unsigned long long lt = (1ull << F.lane) - 1ull;
        int r1 = 0, r2 = 0, mycnt = 0;
        for (int e = 0; e < 32; ++e) {
            const unsigned long long m1 = __ballot(e1 == e), m2 = __ballot(e2 == e);
            const int c1 = __popcll(m1), c2 = __popcll(m2);
            if (e1 == e) r1 = __popcll(m1 & lt);
            if (e2 == e) r2 = c1 + __popcll(m2 & lt);
            if (F.lane == e) mycnt = c1 + c2;
        }
        unsigned* cnt = (unsigned*)(F.ws + WS_CTL) + CW_CNT; int* list = (int*)(F.ws + WS_LIST); float* gateA = (float*)(F.ws + WS_GATEA); unsigned* slotA = (unsigned*)(F.ws + WS_SLOTA);
        int bs = 0;
        if (F.lane < 32 && mycnt > 0) bs = (int)atomicAdd(&cnt[F.lane], (unsigned)mycnt);
        const unsigned q1 = (unsigned)(__shfl(bs, e1) + r1), q2 = (unsigned)(__shfl(bs, e2) + r2);
        gateA[tok * 2 + 0] = g1; gateA[tok * 2 + 1] = g2;
        list[(size_t)e1 * 16384 + q1] = tok * 2 + 0; slotA[tok * 2 + 0] = ((unsigned)e1 << 16) | q1;
        list[(size_t)e2 * 16384 + q2] = tok * 2 + 1; slotA[tok * 2 + 1] = ((unsigned)e2 << 16) | q2;
    }
}

__device__ __forceinline__ void p12_rows2(Frame& F, int ma, int mb_, int prelane) {
    const unsigned* slotA = (const unsigned*)(F.ws + WS_SLOTA); const float* gateA = (const float*)(F.ws + WS_GATEA);
    unsigned sl[2][2]; float gt[2][2];
#pragma unroll
    for (int u = 0; u < 2; ++u) { const int m = u ? mb_ : ma; sl[u][0] = slotA[2 * m]; sl[u][1] = slotA[2 * m + 1]; gt[u][0] = gateA[2 * m]; gt[u][1] = gateA[2 * m + 1]; }
    f32x4 xv[2][4]; v2u cv[2][2][4], ev[2][4];
#pragma unroll
    for (int u = 0; u < 2; ++u) { const int m = u ? mb_ : ma;
        const float* x1 = (const float*)(F.ws + WS_Z) + (size_t)m * D; const bf16* er = (const bf16*)(F.ws + WS_S + 64 * MiB) + (size_t)m * D;
#pragma unroll
        for (int j = 0; j < 4; ++j) { const int o = 4 * F.lane + 256 * j; xv[u][j] = *(const f32x4*)(x1 + o); ev[u][j] = *(const v2u*)(er + o); }
#pragma unroll
        for (int k = 0; k < 2; ++k) { const unsigned s = (unsigned)__builtin_amdgcn_readfirstlane((int)sl[u][k]); const int pre = __builtin_amdgcn_readlane(prelane, (int)(s >> 16));
            const bf16* cp = (const bf16*)(F.ws + WS_Z + 64 * MiB) + ((size_t)pre * 256 + (s & 0xffffu)) * D;
#pragma unroll
            for (int j = 0; j < 4; ++j) cv[u][k][j] = *(const v2u*)(cp + 4 * F.lane + 256 * j); } }
    __builtin_amdgcn_sched_barrier(0);
    float s2[2], se[2];
#pragma unroll
    for (int u = 0; u < 2; ++u) { s2[u] = 0.f; se[u] = 0.f;
#pragma unroll
        for (int j = 0; j < 4; ++j) { xv[u][j] = xv[u][j] + unpk4(cv[u][0][j]) * gt[u][0] + unpk4(cv[u][1][j]) * gt[u][1];
            s2[u] += (xv[u][j].x * xv[u][j].x + xv[u][j].y * xv[u][j].y) + (xv[u][j].z * xv[u][j].z + xv[u][j].w * xv[u][j].w);
            const f32x4 e = unpk4(ev[u][j]); se[u] += (e.x * e.x + e.y * e.y) + (e.z * e.z + e.w * e.w); } }
#pragma unroll
    for (int o = 1; o < 64; o <<= 1) {
#pragma unroll
        for (int u = 0; u < 2; ++u) { s2[u] += __shfl_xor(s2[u], o); se[u] += __shfl_xor(se[u], o); } }
    const float* gi = F.ap->in[34];
#pragma unroll
    for (int u = 0; u < 2; ++u) { const int m = u ? mb_ : ma;
        const float rs = 1.0f / sqrtf(s2[u] * (1.f / D) + NORM_EPS); const float rse = 1.0f / sqrtf(se[u] * (1.f / D) + NORM_EPS);
        bf16* x2 = (bf16*)(F.ws + WS_S) + (size_t)m * D; bf16* xn = (bf16*)(F.ws + WS_XN) + (size_t)m * D;
#pragma unroll
        for (int j = 0; j < 4; ++j) { const int o = 4 * F.lane + 256 * j; *(v2u*)(x2 + o) = pk4(xv[u][j]); *(v2u*)(xn + o) = pk4(xv[u][j] * rs * *(const f32x4*)(gi + o)); }
        bf16* erw = (bf16*)(F.ws + WS_S + 64 * MiB) + (size_t)m * D; const float* gpn = F.ap->in[33];
#pragma unroll
        for (int j = 0; j < 4; ++j) { const int o = 4 * F.lane + 256 * j; *(v2u*)(erw + o) = pk4(unpk4(ev[u][j]) * rse * *(const f32x4*)(gpn + o)); } }
}
__device__ __forceinline__ void p12_phase(Frame& F) {
    const unsigned* cnt = (const unsigned*)(F.ws + WS_CTL) + CW_CNT;
    int nt = (F.lane < 32) ? (((int)cnt[F.lane & 31] + 255) >> 8) : 0;
    int incl = nt;
#pragma unroll
    for (int o = 1; o < 32; o <<= 1) { const int v = __shfl_up(incl, o); if (F.lane >= o) incl += v; }
    const int prelane = incl - nt;
    for (int m = F.gw; m < M; m += 2 * F.NGW) p12_rows2(F, m, m + F.NGW, prelane);
}
__device__ __forceinline__ void p14_rows4(Frame& F, int mb) {
    const float* gf = F.ap->in[36];
    f32x4 v[4][4]; float s[4];
#pragma unroll
    for (int u = 0; u < 4; ++u) { const bf16* xr = (const bf16*)(F.ws + WS_Z) + (size_t)(mb + u * F.NGW) * D;
#pragma unroll
        for (int j = 0; j < 4; ++j) v[u][j] = unpk4(*(const v2u*)(xr + 4 * F.lane + 256 * j)); }
#pragma unroll
    for (int u = 0; u < 4; ++u) { s[u] = 0.f;
#pragma unroll
        for (int j = 0; j < 4; ++j) s[u] += (v[u][j].x * v[u][j].x + v[u][j].y * v[u][j].y) + (v[u][j].z * v[u][j].z + v[u][j].w * v[u][j].w); }
#pragma unroll
    for (int o = 1; o < 64; o <<= 1) {
#pragma unroll
        for (int u = 0; u < 4; ++u) s[u] += __shfl_xor(s[u], o); }
#pragma unroll
    for (int u = 0; u < 4; ++u) { const float rs = 1.0f / sqrtf(s[u] * (1.f / D) + NORM_EPS); float* orow = F.out + (size_t)(mb + u * F.NGW) * D;
#pragma unroll
        for (int j = 0; j < 4; ++j) { const int o = 4 * F.lane + 256 * j; *(f32x4*)(orow + o) = v[u][j] * rs * *(const f32x4*)(gf + o); } }
}

#ifndef MK_ONE_LAUNCH
#define MK_ONE_LAUNCH 1
#endif
constexpr int N_PHASES = 14;
__global__ void __launch_bounds__(NWAVES * 64, 2) mk_fwd(Args args) {
    extern __shared__ __attribute__((aligned(16))) unsigned char lds[];
    Frame F;
    F.lds = (LAS unsigned char*)lds;
    F.tid = threadIdx.x; F.lane = F.tid & 63; F.wave = __builtin_amdgcn_readfirstlane(F.tid >> 6);
    F.G = gridDim.x; { const int bx = blockIdx.x; F.vcu = (F.G % 8 == 0) ? (bx % 8) * (F.G / 8) + bx / 8 : bx; }
    F.gw = F.vcu * NWAVES + F.wave; F.NGW = F.G * NWAVES;
    F.ws = args.ws; F.out = args.out;
    F.ap = (ArgsP)__builtin_amdgcn_kernarg_segment_ptr();
    unsigned char* ws = args.ws;
    const int lo = args.ph_lo, hi = args.ph_hi;
#ifdef ONLY
#define IN(k) ((k) == ONLY && lo <= (k) && (k) < hi)
#else
#define IN(k) (lo <= (k) && (k) < hi)
#endif
#if MK_ONE_LAUNCH
    if (F.tid < 16) ((LAS unsigned*)(F.lds + MISC_OFF))[F.tid] = 0u;
    __syncthreads();
    XcdBarrier bar = xcd_barrier_post((unsigned*)(ws + WS_CTL) + CW_BAR, (volatile LAS unsigned*)(F.lds + MISC_OFF));
#define GRID_BAR(k) do { if (IN(k) && IN((k) + 1)) { if ((k) == 12) cg::this_grid().sync(); else xcd_barrier(bar); } } while (0)
#else
#define GRID_BAR(k) do { } while (0)
#endif
    LAS unsigned char* L = F.lds;
#ifdef PROBE_A
    unsigned long long* tsb = (unsigned long long*)(ws + WS_CTL + 32768);
    int n_st = 0;
#define STAMP() do { if (blockIdx.x == 0 && F.tid == 0) tsb[n_st] = __builtin_amdgcn_s_memrealtime(); ++n_st; } while (0)
    STAMP();
#else
#define STAMP() do { } while (0)
#endif
    const bf16* z = (const bf16*)(ws + WS_Z);

    if (IN(0)) { p0_prologue(F); } GRID_BAR(0); STAMP();

    if (IN(1)) {
        pg8::Gemm g{(const bf16*)(ws + WS_XN), (const bf16*)(ws + WS_WIN), M, NZ, D, nullptr}; pg8::StaticOrder S; S.init(M, NZ, F.G, (int)blockIdx.x);
        EpiStoreBf16 E{(bf16*)(ws + WS_Z), NZ};
        pg8::gemm_phase<EpiStoreBf16, pg8::StaticOrder, true, false>(L, g, S, E);
    } GRID_BAR(1); STAMP();

    if (IN(2)) { p2_prep(F); } GRID_BAR(2); STAMP();
    if (IN(3)) { p3_phase(F); } GRID_BAR(3); STAMP();
    if (IN(4)) { p4_phase(F); } GRID_BAR(4); STAMP();
    if (IN(5)) { if (F.G == 256) p5_scan(F); } GRID_BAR(5); STAMP();
    if (IN(6)) { p6_phase(F); } GRID_BAR(6); STAMP();

    if (IN(7)) {
        pg8::Gemm g{(const bf16*)(ws + WS_YRW), (const bf16*)(ws + WS_UR), 2 * M, 2 * D, 512, nullptr}; DualOrder S; S.S.init(M, D, F.G, (int)blockIdx.x);
        EpiMix E{z, (bf16*)(ws + WS_S), (bf16*)(ws + WS_S + 64 * MiB)};
        pg8::gemm_phase<EpiMix, DualOrder, true, false>(L, g, S, E);
    } GRID_BAR(7); STAMP();

    if (IN(8)) {
        pg8::Gemm g{(const bf16*)(ws + WS_S + 64 * MiB), (const bf16*)(ws + WS_WO), M, D, D, nullptr}; pg8::StaticOrder S; S.init(M, D, F.G, (int)blockIdx.x);
        EpiResF32 E{F.ap->in[0], (float*)(ws + WS_Z)};
        pg8::gemm_phase<EpiResF32, pg8::StaticOrder, true, false>(L, g, S, E);
    } GRID_BAR(8); STAMP();

    if (IN(9)) { p9_phase(F); xcd_barrier(bar); p9b_phase(F); } GRID_BAR(9); STAMP();

    if (IN(10)) {
        pg8::Gemm g{(const bf16*)(ws + WS_XN), (const bf16*)(ws + WS_WGU), M, 1024, D, (const int*)(ws + WS_LIST)};
        pg8::moe_fill_tab((LAS int*)(F.lds + MISC_OFF - 256), (const unsigned*)(ws + WS_CTL) + CW_CNT); LDS_WAIT(); __syncthreads();
        pg8::MoeOrder S{(const LAS int*)(F.lds + MISC_OFF - 256), F.G, (int)blockIdx.x, false};
        EpiMoe1 E{(bf16*)(ws + WS_S)};
        pg8::gemm_phase<EpiMoe1, pg8::MoeOrder, true, true>(L, g, S, E);
    } GRID_BAR(10); STAMP();

    if (IN(11)) {
#ifndef NO_MOE2
        { pg8::Gemm g{(const bf16*)(ws + WS_S), (const bf16*)(ws + WS_WD), M, 1024, 512, nullptr};
          pg8::moe_fill_tab((LAS int*)(F.lds + MISC_OFF - 256), (const unsigned*)(ws + WS_CTL) + CW_CNT); LDS_WAIT(); __syncthreads();
          pg8::MoeOrder S{(const LAS int*)(F.lds + MISC_OFF - 256), F.G, (int)blockIdx.x, true};
          EpiStoreBf16 E{(bf16*)(ws + WS_Z + 64 * MiB), D};
          pg8::gemm_phase<EpiStoreBf16, pg8::MoeOrder, true, false>(L, g, S, E); }
#endif
        { pg8::Gemm g2{(const bf16*)(ws + WS_PBF), (const bf16*)(ws + WS_WPP), M, D, 256, nullptr}; ErawOrder S2; S2.S.init(M, D, F.G, 0); S2.c = (int)blockIdx.x; S2.G = F.G;
          { const LAS int* tb = (const LAS int*)(F.lds + MISC_OFF - 256); const int units = 4 * (tb[31] + ((tb[63] + 255) >> 8)); int nh = units - 2 * F.G; nh = nh < 0 ? 0 : (nh > F.G - 1 ? F.G - 1 : nh); S2.nheavy = nh; }
          EpiStoreBf16 E2{(bf16*)(ws + WS_S + 64 * MiB), D};
          pg8::gemm_phase<EpiStoreBf16, ErawOrder, true, false>(L, g2, S2, E2); }
    } GRID_BAR(11); STAMP();

    if (IN(12)) { p12_phase(F); } GRID_BAR(12); STAMP();

    if (IN(13)) {
        pg8::Gemm g{(const bf16*)(ws + WS_XN), (const bf16*)(ws + WS_WPG), M, D, D, nullptr}; pg8::StaticOrder S; S.init(M, D, F.G, (int)blockIdx.x);
        EpiPleNorm E{(const bf16*)(ws + WS_S), (const bf16*)(ws + WS_S + 64 * MiB), F.ap->in[36], F.out, (float*)(ws + WS_ZGATE), (unsigned*)(ws + WS_CTL) + CW_PANEL, (LAS float*)(F.lds + 131072)};
        pg8::gemm_phase<EpiPleNorm, pg8::StaticOrder, true, false>(L, g, S, E);
    } STAMP();

#ifdef PROBE_A
    xcd_barrier(bar); STAMP(); __threadfence();
    if (blockIdx.x == 0 && F.tid == 0) { __threadfence(); }
    xcd_barrier(bar);
    {
        volatile unsigned long long* tv = (volatile unsigned long long*)tsb;
        const float dA = (float)(tv[PROBE_A + 1] - tv[PROBE_A]) * 0.01f, dB = (float)(tv[PROBE_B + 1] - tv[PROBE_B]) * 0.01f;
        for (size_t i = (size_t)blockIdx.x * 512 + F.tid; i < (size_t)M * D; i += (size_t)F.G * 512) F.out[i] = 10.0f * dB;
        __syncthreads();
        if (blockIdx.x == 0 && F.tid == 0) F.out[0] = 300.0f * dA;
    }
#endif
#undef IN
#undef GRID_BAR
}

extern "C" void kernel_launch(void* const* d_in, const int* in_sizes, int n_in, void* d_out, int out_size, void* d_ws, size_t ws_size, hipStream_t stream) {
    static int grid = 0;
    if (grid == 0) {
        if (n_in != 37 || out_size != M * D || ws_size < WS_END) { fprintf(stderr, "kernel_launch: unexpected problem (n_in %d, out %d, ws %zu < %zu); nothing launched\n", n_in, out_size, ws_size, (size_t)WS_END); grid = -1; return; }
        int dev = 0, cus = 0, per_cu = 0;
        if (hipGetDevice(&dev) != hipSuccess || hipDeviceGetAttribute(&cus, hipDeviceAttributeMultiprocessorCount, dev) != hipSuccess) { grid = -1; return; }
        if (hipFuncSetAttribute((const void*)mk_fwd, hipFuncAttributeMaxDynamicSharedMemorySize, LDS_BYTES) != hipSuccess) { fprintf(stderr, "kernel_launch: hipFuncSetAttribute failed\n"); grid = -1; return; }
        if (hipOccupancyMaxActiveBlocksPerMultiprocessor(&per_cu, (const void*)mk_fwd, NWAVES * 64, LDS_BYTES) != hipSuccess || per_cu < 1) { fprintf(stderr, "kernel_launch: occupancy query says %d blocks per CU\n", per_cu); (void)hipGetLastError(); grid = -1; return; }
        grid = cus;
        if (grid != 256) fprintf(stderr, "kernel_launch: %d CUs; this kernel is built for 256\n", grid);
    }
    if (grid < 0) return;
    (void)hipMemsetAsync((char*)d_ws + WS_CTL, 0, CTL_ZERO_BYTES, stream);
    Args a{};
    for (int i = 0; i < 37; ++i) a.in[i] = (const float*)d_in[i];
    a.out = (float*)d_out; a.ws = (unsigned char*)d_ws;
#if MK_ONE_LAUNCH
    a.ph_lo = 0; a.ph_hi = N_PHASES;
    void* kargs[] = {&a};
    hipError_t e = hipLaunchCooperativeKernel((const void*)mk_fwd, dim3(grid), dim3(NWAVES * 64), kargs, LDS_BYTES, stream);
    if (e != hipSuccess) fprintf(stderr, "kernel_launch: cooperative launch failed: %s (grid %d)\n", hipGetErrorString(e), grid);
#else
    for (int ph = 0; ph < N_PHASES; ++ph) { a.ph_lo = ph; a.ph_hi = ph + 1; hipLaunchKernelGGL(mk_fwd, dim3(grid), dim3(NWAVES * 64), LDS_BYTES, stream, a); }
#endif
}
```

```cpp
#include <hip/hip_runtime.h>
#include <hip/hip_cooperative_groups.h>
#include <cstdio>
#include <cstdint>
namespace cg = cooperative_groups;

namespace pg8 {
#define PG8_LAS __attribute__((address_space(3)))
typedef unsigned short bf16_t;
typedef short bf16x8 __attribute__((ext_vector_type(8)));
typedef float f32x4 __attribute__((ext_vector_type(4)));
typedef unsigned u32x4 __attribute__((ext_vector_type(4)));
typedef unsigned u32x2 __attribute__((ext_vector_type(2)));
constexpr int BM = 256, BK = 64, HALF = 128, HTB = HALF * BK * 2  , STAGE_BYTES = 8 * HTB, NXCD = 8, WGM = 8;

__host__ __device__ __forceinline__ int lds_byte(int r, int c) { const int st = (r >> 4) * 2 + (c >> 5), rr = r & 15, cc = c & 31, ob = rr * 64 + cc * 2; return st * 1024 + (ob ^ (((ob >> 9) & 1) << 5)); }
__host__ __device__ __forceinline__ void stage_rc(int b, int& R, int& C) { const int st = b / 1024, sb = b % 1024, swz = sb ^ (((sb >> 9) & 1) << 5); R = (st >> 1) * 16 + swz / 64; C = (st & 1) * 32 + (swz % 64) / 2; }
__host__ __device__ __forceinline__ int perm32(int rho) { const int n = rho >> 4, i = rho & 15; return 8 * (i >> 2) + 4 * n + (i & 3); }

struct Unit { int pm, pn, pmo, lt, nvalid, pnl; };
struct Gemm { const bf16_t* A; const bf16_t* Bt; int M, N, K; const int* rowidx; };

struct StaticOrder {
    int nM, nN, nwg, G, c;
    __host__ __device__ void init(int M, int N, int G_, int c_) { nM = M / BM; nN = N / BM; nwg = nM * nN; G = G_; c = c_; }
    __host__ __device__ bool next(int i, Unit& u) const {
        const long L = (long)i * G + c; if (L >= nwg) return false;
        int wgid = (int)L; { const int q = nwg / NXCD, r = nwg % NXCD, xcd = wgid % NXCD, off = wgid / NXCD; wgid = (xcd < r ? xcd * (q + 1) : r * (q + 1) + (xcd - r) * q) + off; }
        const int nig = WGM * nN, gid = wgid / nig, fm = gid * WGM, gsz = (nM - fm) < WGM ? (nM - fm) : WGM;
        u.pm = fm + ((wgid % nig) % gsz); u.pn = (wgid % nig) / gsz; u.pmo = u.pm; u.lt = u.pm; u.nvalid = 256; u.pnl = u.pn; return true;
    }
};
struct MoeOrder {
    const PG8_LAS int* tab; int G, c; bool a_is_out;
    __device__ bool next(int i, Unit& u) const {
        const int L = i * G + c; const int tile = L >> 2, pnl = L & 3;
        const int lane = (int)__builtin_amdgcn_mbcnt_hi(~0u, __builtin_amdgcn_mbcnt_lo(~0u, 0u)), e_ = lane & 31;
        const int pre = tab[e_], ce = tab[32 + e_]; const int nt = (ce + 255) >> 8;
        const unsigned long long mk = __ballot(lane < 32 && tile >= pre && tile < pre + nt);
        if (mk == 0ull) return false;
        const int e = (int)__builtin_ctzll(mk);
        const int pre_e = __builtin_amdgcn_readlane(pre, e), ce_e = __builtin_amdgcn_readlane(ce, e);
        const int rt = tile - pre_e; u.pmo = tile; u.pm = a_is_out ? tile : 0; u.lt = e * 64 + rt; u.pn = e * 4 + pnl; u.pnl = pnl; const int rem = ce_e - rt * 256; u.nvalid = rem < 256 ? rem : 256; return true;
    }
};
__device__ __forceinline__ void moe_fill_tab(PG8_LAS int* tab, const unsigned* cnt) {
    const int lane = (int)__builtin_amdgcn_mbcnt_hi(~0u, __builtin_amdgcn_mbcnt_lo(~0u, 0u));
    const int ce = (lane < 32) ? (int)cnt[lane & 31] : 0; const int nt = (ce + 255) >> 8;
    int incl = nt;
#pragma unroll
    for (int o = 1; o < 32; o <<= 1) { const int v = __shfl_up(incl, o); if (lane >= o) incl += v; }
    if (lane < 32) { tab[lane] = incl - nt; tab[32 + lane] = ce; }
}

__device__ __forceinline__ unsigned cvt_pk_bf16(float lo, float hi) { unsigned r; asm volatile("v_cvt_pk_bf16_f32 %0, %1, %2" : "=v"(r) : "v"(lo), "v"(hi)); return r; }

template <class Epi, class Sched, bool ALIGN_EPI, bool GATHER>
__device__ __forceinline__ void gemm_phase(PG8_LAS unsigned char* lds, const Gemm g, const Sched& S, const Epi& E) {
    const int tid = threadIdx.x, wid = __builtin_amdgcn_readfirstlane(tid >> 6), lane = tid & 63, wr = wid >> 2, wc = wid & 3, fr = lane & 15, fq = lane >> 4;
    int K_ = g.K; asm volatile("" : "+s"(K_));
    const int K = K_, nt = K / BK;
    unsigned voffB[2]; int RA[2], CA[2];
#pragma unroll
    for (int i = 0; i < 2; ++i) { int R, C; stage_rc(tid * 16 + i * 8192, R, C); const int Rb = Epi::PERM ? ((R & ~31) + perm32(R & 31)) : R;
        RA[i] = R; CA[i] = C; voffB[i] = (unsigned)(Rb * K + C) * 2u; }
    const size_t kstep = (size_t)(BK * 2);
    const size_t hstep = (size_t)HALF * K * 2;
    const size_t tstep = 2 * hstep;
    const unsigned ldsw = (unsigned)wid * 1024u;
    const int aoff = lds_byte(wr * 64 + fr, fq * 8), boff = lds_byte(wc * 32 + fr, fq * 8);
    unsigned vA[2][2], vN[2][2];
    PG8_LAS int* rowl = (PG8_LAS int*)(lds + STAGE_BYTES);
    if constexpr (GATHER) {
        for (int i = 0; i < 4; ++i) { Unit uu; if (!S.next(i, uu)) break; if (tid < 256) rowl[i * 256 + tid] = (tid < uu.nvalid) ? (g.rowidx[(size_t)uu.lt * 256 + tid] >> 1) : 0; }
        asm volatile("s_waitcnt vmcnt(0) lgkmcnt(0)" ::: "memory"); __builtin_amdgcn_s_barrier(); asm volatile("" ::: "memory");
    }
    auto compute_v = [&](const Unit& u, unsigned (&v)[2][2], int ui_) {
#pragma unroll
        for (int h = 0; h < 2; ++h)
#pragma unroll
            for (int i = 0; i < 2; ++i) {
                const int rl = h * HALF + RA[i];
                if constexpr (GATHER) { const int tok = rowl[ui_ * 256 + rl]; v[h][i] = ((unsigned)tok * (unsigned)K + (unsigned)CA[i]) * 2u; }
                else v[h][i] = ((unsigned)rl * (unsigned)K + (unsigned)CA[i]) * 2u;
            }
    };
#define PG8_SA(b, h) (((b) * 2 + (h)) * HTB)
#define PG8_SB(b, h) ((4 + (b) * 2 + (h)) * HTB)
#define PG8_STAGE(bufoff, gbase, voff) do { _Pragma("unroll") for (int _i = 0; _i < 2; ++_i) \
        __builtin_amdgcn_global_load_lds((const unsigned*)((const char*)(gbase) + (voff)[_i]), (PG8_LAS unsigned*)(lds + (bufoff) + ldsw + _i * 8192), 16, 0, 0); } while (0)
#define PG8_LDA(dst, b, h) do { _Pragma("unroll") for (int m = 0; m < 4; ++m) _Pragma("unroll") for (int k = 0; k < 2; ++k) dst[m][k] = *(const PG8_LAS bf16x8*)(lds + PG8_SA(b, h) + aoff + m * 2048 + k * 1024); } while (0)
#define PG8_LDB(dst, b, h) do { _Pragma("unroll") for (int n = 0; n < 2; ++n) _Pragma("unroll") for (int k = 0; k < 2; ++k) dst[n][k] = *(const PG8_LAS bf16x8*)(lds + PG8_SB(b, h) + boff + n * 2048 + k * 1024); } while (0)
#define PG8_MMA(ai, bj, At, Bt) do { __builtin_amdgcn_s_setprio(1); _Pragma("unroll") for (int m = 0; m < 4; ++m) _Pragma("unroll") for (int n = 0; n < 2; ++n) _Pragma("unroll") for (int k = 0; k < 2; ++k) \
        acc[ai][bj][m][n] = __builtin_amdgcn_mfma_f32_16x16x32_bf16(Bt[n][k], At[m][k], acc[ai][bj][m][n], 0, 0, 0); __builtin_amdgcn_s_setprio(0); } while (0)
#define PG8_WAIT_V(n) asm volatile("s_waitcnt vmcnt(" #n ")" ::: "memory")
#define PG8_WAIT_L(n) asm volatile("s_waitcnt lgkmcnt(" #n ")" ::: "memory")
#define PG8_BAR __builtin_amdgcn_s_barrier()
#define PG8_SCHED __builtin_amdgcn_sched_barrier(0)
    Unit cur, nxt; int ui = 0;
    if (!S.next(0, cur)) return;
    f32x4 acc[2][2][4][2];
#pragma unroll
    for (int a = 0; a < 2; ++a)
#pragma unroll
        for (int b = 0; b < 2; ++b)
#pragma unroll
            for (int m = 0; m < 4; ++m)
#pragma unroll
                for (int n = 0; n < 2; ++n) acc[a][b][m][n] = (f32x4){0.f, 0.f, 0.f, 0.f};
    bf16x8 At[4][2], B0[2][2], B1[2][2];
    compute_v(cur, vA, 0);
    const char* cA = (const char*)g.A + (GATHER ? (size_t)0 : (size_t)cur.pm * tstep); const char* cB = (const char*)g.Bt + (size_t)cur.pn * tstep;
    PG8_STAGE(PG8_SB(0, 0), cB, voffB); PG8_STAGE(PG8_SB(0, 1), cB + hstep, voffB); PG8_STAGE(PG8_SA(0, 0), cA, vA[0]); PG8_STAGE(PG8_SA(0, 1), cA, vA[1]);
    if (wr == 1) PG8_BAR;
    PG8_WAIT_V(2); PG8_BAR;
    PG8_STAGE(PG8_SB(1, 0), cB + kstep, voffB); PG8_STAGE(PG8_SA(1, 0), cA + kstep, vA[0]); PG8_STAGE(PG8_SB(1, 1), cB + hstep + kstep, voffB);
    PG8_WAIT_V(6); PG8_BAR;
    for (;;) {
        const bool has_next = S.next(ui + 1, nxt);
        if (has_next) compute_v(nxt, vN, ui + 1);
        else {
#pragma unroll
            for (int h = 0; h < 2; ++h)
#pragma unroll
                for (int i = 0; i < 2; ++i) vN[h][i] = vA[h][i];
        }
        const char* nA = has_next ? ((const char*)g.A + (GATHER ? (size_t)0 : (size_t)nxt.pm * tstep)) : cA; const char* nB = has_next ? (const char*)g.Bt + (size_t)nxt.pn * tstep : cB;
#pragma unroll 1
        for (int t = 0; t < nt; t += 2) {
            const bool last = (t == nt - 2);
            const char* a1 = cA + (size_t)(t + 1) * kstep;
            const char* a2 = last ? nA : cA + (size_t)(t + 2) * kstep; const char* b2 = last ? nB : cB + (size_t)(t + 2) * kstep;
            const char* a3 = a2 + kstep; const char* b3 = b2 + kstep;
            unsigned vX0[2], vX1[2];
#pragma unroll
            for (int i = 0; i < 2; ++i) { vX0[i] = last ? vN[0][i] : vA[0][i]; vX1[i] = last ? vN[1][i] : vA[1][i]; }
            PG8_LDB(B0, 0, 0); PG8_LDB(B1, 0, 1); PG8_SCHED; PG8_LDA(At, 0, 0); PG8_STAGE(PG8_SA(1, 1), a1, vA[1]);
            PG8_WAIT_V(8); PG8_WAIT_L(0); PG8_BAR; PG8_MMA(0, 0, At, B0); PG8_MMA(0, 1, At, B1); PG8_BAR; PG8_SCHED;
            PG8_LDA(At, 0, 1); PG8_STAGE(PG8_SB(0, 0), b2, voffB); PG8_STAGE(PG8_SB(0, 1), b2 + hstep, voffB); PG8_STAGE(PG8_SA(0, 0), a2, vX0);
            PG8_WAIT_V(8); PG8_WAIT_L(0); PG8_BAR; PG8_MMA(1, 0, At, B0); PG8_MMA(1, 1, At, B1); PG8_BAR; PG8_SCHED;
            PG8_LDB(B0, 1, 0); PG8_LDB(B1, 1, 1); PG8_SCHED; PG8_LDA(At, 1, 0); PG8_STAGE(PG8_SA(0, 1), a2, vX1);
            PG8_WAIT_V(8); PG8_WAIT_L(0); PG8_BAR; PG8_MMA(0, 0, At, B0); PG8_MMA(0, 1, At, B1); PG8_BAR; PG8_SCHED;
            PG8_LDA(At, 1, 1); PG8_STAGE(PG8_SB(1, 0), b3, voffB); PG8_STAGE(PG8_SB(1, 1), b3 + hstep, voffB); PG8_STAGE(PG8_SA(1, 0), a3, vX0);
            PG8_WAIT_V(8); PG8_WAIT_L(0); PG8_BAR; PG8_MMA(1, 0, At, B0); PG8_MMA(1, 1, At, B1); PG8_BAR; PG8_SCHED;
        }
        if constexpr (ALIGN_EPI) { if (wr == 0) PG8_BAR; }
        E(acc, cur, wr, wc, fr, fq);
        if (!has_next) break;
#pragma unroll
        for (int a = 0; a < 2; ++a)
#pragma unroll
            for (int b = 0; b < 2; ++b)
#pragma unroll
                for (int m = 0; m < 4; ++m)
#pragma unroll
                    for (int n = 0; n < 2; ++n) acc[a][b][m][n] = (f32x4){0.f, 0.f, 0.f, 0.f};
        cur = nxt; cA = nA; cB = nB; ++ui;
#pragma unroll
        for (int h = 0; h < 2; ++h)
#pragma unroll
            for (int i = 0; i < 2; ++i) vA[h][i] = vN[h][i];
        if constexpr (ALIGN_EPI) { if (wr == 1) PG8_BAR; }
    }
    PG8_WAIT_V(0);
    if constexpr (!ALIGN_EPI) { if (wr == 0) PG8_BAR; }
    PG8_BAR;
#undef PG8_SA
#undef PG8_SB
#undef PG8_STAGE
#undef PG8_LDA
#undef PG8_LDB
#undef PG8_MMA
#undef PG8_WAIT_V
#undef PG8_WAIT_L
#undef PG8_BAR
#undef PG8_SCHED
}
}

constexpr int NWAVES = 8;
constexpr int M = 16384, D = 1024, SEQ = 2048, NBATCH = 8;
constexpr int NIN = 5144;
constexpr int NZ = 5120;
constexpr int ZC_R = 0, ZC_K = 512, ZC_V = 1024, ZC_W = 1536, ZC_Q = 1792, ZC_KC = 2304, ZC_VC = 2432, ZC_KS = 2560, ZC_VS = 2688, ZC_KW = 2816, ZC_VW = 2944, ZC_MR = 3072, ZC_MN = 4096;
constexpr float NORM_EPS = 1e-6f, GN_EPS = 64e-5f;

constexpr size_t MiB = 1u << 20;
constexpr size_t WS_CTL = 0, CTL_ZERO_BYTES = 64 * 1024;
constexpr size_t WS_LIST = 1 * MiB;
constexpr size_t WS_GATEA = 3 * MiB;
constexpr size_t WS_RSE = 4 * MiB;
constexpr size_t WS_SLOTA = 4 * MiB + 512 * 1024;
constexpr size_t WS_SELMASK = 5 * MiB;
constexpr size_t WS_ZGATE = 6 * MiB;
constexpr size_t WS_SMALLW = 8 * MiB;
constexpr size_t SW_W2T = 0, SW_A2T = 65536, SW_G2T = 131072, SW_CK1 = 262144, SW_CV1 = 524288, SW_CK2 = 786432, SW_CV2 = 794624, SW_GATEW = 802816, SW_ROUTEW = 868352;
constexpr size_t WS_KCMP = 10 * MiB;
constexpr size_t WS_VST = 11 * MiB, WS_VWT = 15 * MiB;
constexpr size_t WS_WIN = 19 * MiB, WS_UR = 29 * MiB, WS_UN = 30 * MiB, WS_WO = 31 * MiB, WS_WPP = 33 * MiB, WS_WPG = 34 * MiB, WS_WGU = 36 * MiB, WS_WD = 100 * MiB;
constexpr size_t WS_XN = 132 * MiB;
constexpr size_t WS_PBF = 164 * MiB;
constexpr size_t WS_Z = 172 * MiB;
constexpr size_t WS_S = 332 * MiB;
constexpr size_t WS_YRW = 428 * MiB, WS_YB = 444 * MiB, WS_G = 492 * MiB, WS_LOGITS = 508 * MiB  , WS_BONUS = 508 * MiB  , WS_END = 511 * MiB;
constexpr int CH_PP = 144, CH_P = 0, CH_R = 2304, CH_Q = 4608, CH_K = 6656, CH_G = 8704, CH_AC = 10752, CH_REC = 11008, CH_V = 11008, CH_SLOT = 11520;
constexpr int CW_CNT = 0;
constexpr int CW_PANEL = 8192;
constexpr int CW_BAR = 1024;
constexpr int MISC_OFF = 163840 - 64;

constexpr int LDS_BYTES = 163840;

#define GAS __attribute__((address_space(1)))
#define LAS __attribute__((address_space(3)))
typedef unsigned short bf16;
typedef unsigned v4u __attribute__((ext_vector_type(4)));
typedef unsigned v2u __attribute__((ext_vector_type(2)));
typedef float f32x4 __attribute__((ext_vector_type(4)));
typedef float f32x2 __attribute__((ext_vector_type(2)));
typedef short bf16x8 __attribute__((ext_vector_type(8)));
typedef short bf16x4 __attribute__((ext_vector_type(4)));
typedef __bf16 bf16x2_t __attribute__((ext_vector_type(2)));
#define LDS_WAIT() asm volatile("s_waitcnt lgkmcnt(0)" ::: "memory")
#define MFMA16(a, b, c) __builtin_amdgcn_mfma_f32_16x16x32_bf16((a), (b), (c), 0, 0, 0)

__device__ __forceinline__ float bf2f(unsigned short v) { return __uint_as_float((unsigned)v << 16); }
__device__ __forceinline__ unsigned pk2(float lo, float hi) { f32x2 v = {lo, hi}; bf16x2_t b = __builtin_convertvector(v, bf16x2_t); return __builtin_bit_cast(unsigned, b); }
__device__ __forceinline__ v2u pk4(f32x4 v) { v2u r; r.x = pk2(v.x, v.y); r.y = pk2(v.z, v.w); return r; }
__device__ __forceinline__ f32x4 unpk4(v2u w) { f32x4 r; r.x = __uint_as_float(w.x << 16); r.y = __uint_as_float(w.x & 0xffff0000u); r.z = __uint_as_float(w.y << 16); r.w = __uint_as_float(w.y & 0xffff0000u); return r; }
__device__ __forceinline__ void unpk8(v4u w, float (&f)[8]) { f[0] = __uint_as_float(w.x << 16); f[1] = __uint_as_float(w.x & 0xffff0000u); f[2] = __uint_as_float(w.y << 16); f[3] = __uint_as_float(w.y & 0xffff0000u);
    f[4] = __uint_as_float(w.z << 16); f[5] = __uint_as_float(w.z & 0xffff0000u); f[6] = __uint_as_float(w.w << 16); f[7] = __uint_as_float(w.w & 0xffff0000u); }
__device__ __forceinline__ float sigmoidf_(float x) { return __builtin_amdgcn_rcpf(1.0f + __expf(-x)); }
__device__ __forceinline__ float wave_sum(float v) {
#pragma unroll
    for (int o = 1; o < 64; o <<= 1) v += __shfl_xor(v, o);
    return v;
}
template <int CTRL> __device__ __forceinline__ float dppf(float x) { return __builtin_bit_cast(float, __builtin_amdgcn_update_dpp(0, __builtin_bit_cast(int, x), CTRL, 0xf, 0xf, false)); }
__device__ __forceinline__ float row16_sum(float x) { x += dppf<0x128>(x); x += dppf<0x124>(x); x += dppf<0x122>(x); x += dppf<0x121>(x); return x; }

typedef GAS unsigned gu32;
#define XB_TMO      128
#define XB_XCNT(j)  (256  + 64 * (j))
#define XB_XSUB(j)  (1280 + 64 * (j))
#define XB_XGEN(j)  (2304 + 64 * (j))
#define XB_TOP      3328
#define XB_TOPGEN   3392
#define XCD_BAR_WORDS 3456
#define XB_SPIN_CAP (1u << 18)

__device__ __forceinline__ unsigned xb_ld(unsigned* p)              { return __hip_atomic_load(p, __ATOMIC_RELAXED, __HIP_MEMORY_SCOPE_AGENT); }
__device__ __forceinline__ unsigned xb_add(unsigned* p, unsigned v) { return __hip_atomic_fetch_add(p, v, __ATOMIC_RELAXED, __HIP_MEMORY_SCOPE_AGENT); }
__device__ __forceinline__ unsigned xb_xcc_id() { return (unsigned)__builtin_amdgcn_s_getreg((3 << 11) | 20) & 0xFu; }
#define XB_SPIN(cond, bar) do { unsigned _sp = 0; while (cond) { __builtin_amdgcn_s_sleep(1); \
    if ((++_sp & 255u) == 0u) { if (xb_ld(&(bar)[XB_TMO])) break; if (_sp > XB_SPIN_CAP) { atomicAdd(&(bar)[XB_TMO], 1u); break; } } } } while (0)

struct XcdBarrier {
    unsigned* bar; unsigned x;
    volatile LAS unsigned* st;
};

__device__ __forceinline__ XcdBarrier xcd_barrier_post(unsigned* bar, volatile LAS unsigned* st) {
    XcdBarrier b; b.bar = bar; b.x = xb_xcc_id(); b.st = st;
    if (threadIdx.x == 0) (void)xb_add(&bar[XB_XCNT(b.x)], 1u);
    return b;
}
__device__ __forceinline__ void xcd_barrier_complete(unsigned* bar, unsigned x, unsigned& nloc, unsigned& nx) {
    const unsigned G = gridDim.x * gridDim.y * gridDim.z;
    unsigned sum, cnt, mine, sp = 0u;
    for (;;) {
        sum = 0u; cnt = 0u; mine = 0u;
#pragma unroll
        for (unsigned j = 0; j < 16; ++j) { const unsigned c = xb_ld(&bar[XB_XCNT(j)]); sum += c; cnt += (c > 0u) ? 1u : 0u; mine = (j == x) ? c : mine; }
        if (sum == G) break;
        __builtin_amdgcn_s_sleep(1);
        if ((++sp & 255u) == 0u) { if (xb_ld(&bar[XB_TMO])) break; if (sp > XB_SPIN_CAP) { atomicAdd(&bar[XB_TMO], 1u); break; } }
    }
    nloc = mine > 0u ? mine : 1u; nx = cnt > 0u ? cnt : 1u;
}

__device__ __forceinline__ void xcd_barrier(const XcdBarrier& b) {
    asm volatile("s_waitcnt vmcnt(0)" ::: "memory");
    __syncthreads();
    if (threadIdx.x == 0) {
        unsigned* bar = b.bar;
        __builtin_amdgcn_s_waitcnt(0);
        unsigned nloc = b.st[0], nx = b.st[1];
        if (nloc == 0u) { xcd_barrier_complete(bar, b.x, nloc, nx); b.st[0] = nloc; b.st[1] = nx; }
        const unsigned old = xb_add(&bar[XB_XSUB(b.x)], 1u);
        const unsigned gen = old / nloc;
        if (old + 1u == (gen + 1u) * nloc) {
            __builtin_amdgcn_fence(__ATOMIC_RELEASE, "agent");
            asm volatile("s_waitcnt vmcnt(0)" ::: "memory");
            const unsigned og = xb_add(&bar[XB_TOP], 1u);
            const unsigned tg = og / nx;
            if (og + 1u == (tg + 1u) * nx) xb_add(&bar[XB_TOPGEN], 1u);
            else XB_SPIN(xb_ld(&bar[XB_TOPGEN]) == tg, bar);
            __builtin_amdgcn_fence(__ATOMIC_ACQUIRE, "agent");
            xb_add(&bar[XB_XGEN(b.x)], 1u);
            asm volatile("s_waitcnt vmcnt(0)" ::: "memory");
        } else {
            XB_SPIN(xb_ld(&bar[XB_XGEN(b.x)]) == gen, bar);
            __builtin_amdgcn_fence(__ATOMIC_ACQUIRE, "agent");
            asm volatile("s_waitcnt vmcnt(0)" ::: "memory");
        }
    }
    __syncthreads();
}

struct Args { const float* in[37]; float* out; unsigned char* ws; int ph_lo, ph_hi, rep_mask, pad; };
typedef __attribute__((address_space(4))) const Args* ArgsP;
struct Frame {
    LAS unsigned char* lds;
    int tid, lane, wave, vcu, G, gw, NGW;
    unsigned char* ws;
    ArgsP ap;
    float* out;
};

struct TrDesc { const float* W; bf16* T; bf16* T2; int K, ld, nc, item, mode; };
__device__ __forceinline__ void tr_load(const TrDesc& d, int lane, float (&tv)[32]) {
    const int nblk = (d.nc + 31) / 32, kb = d.item / nblk, nb = d.item % nblk, k0 = 64 * kb, n0 = 32 * nb;
    const int nn = n0 + (lane & 31);
    const float* wsrc = d.W + (size_t)(k0 + (lane >> 5)) * d.ld + (nn < d.nc ? nn : 0);
#pragma unroll
    for (int i = 0; i < 32; ++i) tv[i] = wsrc[(size_t)(2 * i) * d.ld];
}
__device__ __forceinline__ void tr_finish(const TrDesc& d, LAS float* scr, int lane, const float (&tv)[32]) {
    const int nblk = (d.nc + 31) / 32, kb = d.item / nblk, nb = d.item % nblk, k0 = 64 * kb, n0 = 32 * nb;
#pragma unroll
    for (int i = 0; i < 32; ++i) scr[(2 * i + (lane >> 5)) * 33 + (lane & 31)] = tv[i];
    LDS_WAIT(); asm volatile("" ::: "memory");
    const int c = lane & 7;
#pragma unroll
    for (int j = 0; j < 4; ++j) { const int nl = (lane >> 3) + 8 * j, n = n0 + nl; const LAS float* s = scr + (8 * c) * 33 + nl;
        v4u o; o.x = pk2(s[0 * 33], s[1 * 33]); o.y = pk2(s[2 * 33], s[3 * 33]); o.z = pk2(s[4 * 33], s[5 * 33]); o.w = pk2(s[6 * 33], s[7 * 33]);
        if (n < d.nc) { bf16* rp;
            if (d.mode == 1) rp = n < 3072 ? d.T + (size_t)n * 1024 : (n < 3096 ? d.T2 + (size_t)(n - 3072) * 1024 : d.T + (size_t)(n - 24) * 1024);
            else if (d.mode == 2) { const int n2 = n & 511; rp = d.T + (size_t)((n2 >> 7) * 256 + (n >> 9) * 128 + (n2 & 127)) * 1024; }
            else rp = d.T + (size_t)n * d.K;
            *(v4u*)(rp + k0 + 8 * c) = o; } }
    LDS_WAIT(); asm volatile("" ::: "memory");
}
__device__ __forceinline__ void rms_row_to_bf16(int lane, const float* xrow, const float* gain, bf16* orow) {
    const f32x4* xr = (const f32x4*)xrow + lane; const f32x4* gr = (const f32x4*)gain + lane;
    f32x4 v[4]; float s = 0.f;
#pragma unroll
    for (int j = 0; j < 4; ++j) { v[j] = xr[64 * j]; s += (v[j].x * v[j].x + v[j].y * v[j].y) + (v[j].z * v[j].z + v[j].w * v[j].w); }
    const float rs = 1.0f / sqrtf(wave_sum(s) * (1.f / D) + NORM_EPS);
    v2u* o8 = (v2u*)orow + lane;
#pragma unroll
    for (int j = 0; j < 4; ++j) { const f32x4 g = gr[64 * j]; o8[64 * j] = pk4(v[j] * rs * g); }
}

namespace tri {
constexpr int I_WIN = 16 * 161, I_UR = 8 * 32, I_WO = 16 * 32, I_WPP = 4 * 32, I_L64 = 16, I_L128 = 32, I_C1 = 32 * 2, I_C2 = 2, I_GU = 16 * 32, I_DN = 8 * 32;
constexpr int E0 = I_WIN, E1 = E0 + I_UR, E2 = E1 + I_UR, E3 = E2 + I_WO, E4 = E3 + I_WPP, E5 = E4 + I_WO, E6 = E5 + I_L64, E7 = E6 + I_L64, E8 = E7 + I_L128, E9 = E8 + I_C1, E10 = E9 + I_C1, E11 = E10 + I_C2, E12 = E11 + I_C2,
              E13 = E12 + 32 * I_GU, NITEMS = E13 + 32 * I_DN;
}
__device__ __forceinline__ TrDesc tr_desc(Frame& F, int it) {
    using namespace tri;
    unsigned char* ws = F.ws;
    const float* W; int K, ld, nc, item, mode = 0; size_t dst;
    if (it < E0) { W = F.ap->in[3]; K = 1024; ld = NIN; nc = NIN; item = it; mode = 1; dst = WS_WIN; }
    else if (it < E1) { W = F.ap->in[22]; K = 512; ld = 1024; nc = 1024; item = it - E0; dst = WS_UR; }
    else if (it < E2) { W = F.ap->in[23]; K = 512; ld = 1024; nc = 1024; item = it - E1; dst = WS_UN; }
    else if (it < E3) { W = F.ap->in[24]; K = 1024; ld = 1024; nc = 1024; item = it - E2; dst = WS_WO; }
    else if (it < E4) { W = F.ap->in[32]; K = 256; ld = 1024; nc = 1024; item = it - E3; dst = WS_WPP; }
    else if (it < E5) { W = F.ap->in[35]; K = 1024; ld = 1024; nc = 1024; item = it - E4; dst = WS_WPG; }
    else if (it < E6) { W = F.ap->in[6]; K = 64; ld = 512; nc = 512; item = it - E5; dst = WS_SMALLW + SW_W2T; }
    else if (it < E7) { W = F.ap->in[8]; K = 64; ld = 512; nc = 512; item = it - E6; dst = WS_SMALLW + SW_A2T; }
    else if (it < E8) { W = F.ap->in[9]; K = 128; ld = 512; nc = 512; item = it - E7; dst = WS_SMALLW + SW_G2T; }
    else if (it < E9) { W = F.ap->in[17]; K = 2048; ld = 64; nc = 64; item = it - E8; dst = WS_SMALLW + SW_CK1; }
    else if (it < E10) { W = F.ap->in[19]; K = 2048; ld = 64; nc = 64; item = it - E9; dst = WS_SMALLW + SW_CV1; }
    else if (it < E11) { W = F.ap->in[18]; K = 64; ld = 64; nc = 64; item = it - E10; dst = WS_SMALLW + SW_CK2; }
    else if (it < E12) { W = F.ap->in[20]; K = 64; ld = 64; nc = 64; item = it - E11; dst = WS_SMALLW + SW_CV2; }
    else if (it < E13) { const int r = it - E12, e = r / I_GU; W = F.ap->in[30] + (size_t)e * 1024 * 1024; K = 1024; ld = 1024; nc = 1024; item = r % I_GU; mode = 2; dst = WS_WGU + (size_t)e * 1024 * 1024 * 2; }
    else { const int r = it - E13, e = r / I_DN; W = F.ap->in[31] + (size_t)e * 512 * 1024; K = 512; ld = 1024; nc = 1024; item = r % I_DN; dst = WS_WD + (size_t)e * 1024 * 512 * 2; }
    return TrDesc{W, (bf16*)(ws + dst), (bf16*)(ws + WS_SMALLW + SW_GATEW), K, ld, nc, item, mode};
}
__device__ __forceinline__ void tr_run(Frame& F, LAS float* scr, int it0, int stride, int it_end) {
    if (it0 >= it_end) return;
    float tvA[32], tvB[32];
    int it = it0; TrDesc cur = tr_desc(F, it); tr_load(cur, F.lane, tvA);
    for (;;) {
        const int nxt = it + stride; const bool has = nxt < it_end; TrDesc dn = cur;
        if (has) { dn = tr_desc(F, nxt); tr_load(dn, F.lane, tvB); }
        __builtin_amdgcn_sched_barrier(0);
        tr_finish(cur, scr, F.lane, tvA);
        if (!has) break;
        cur = dn; it = nxt;
#pragma unroll
        for (int i = 0; i < 32; ++i) tvA[i] = tvB[i];
    }
}
__device__ __forceinline__ int tr_qnext(LAS int* qh) {
    int k = 0; const unsigned a = (unsigned)(size_t)qh; const int one = 1;
    if (__builtin_amdgcn_mbcnt_hi(~0u, __builtin_amdgcn_mbcnt_lo(~0u, 0u)) == 0) asm volatile("ds_add_rtn_u32 %0, %1, %2\n\ts_waitcnt lgkmcnt(0)" : "=&v"(k) : "v"(a), "v"(one) : "memory");
    return __builtin_amdgcn_readfirstlane(k);
}
__device__ __forceinline__ void tr_run_q(Frame& F, LAS float* scr, LAS int* qh, int base, int stride, int nk) {
    int k = tr_qnext(qh); if (k >= nk) return;
    float tvA[32], tvB[32];
    TrDesc cur = tr_desc(F, base + k * stride); tr_load(cur, F.lane, tvA);
    for (;;) {
        const int kn = tr_qnext(qh); const bool has = kn < nk; TrDesc dn = cur;
        if (has) { dn = tr_desc(F, base + kn * stride); tr_load(dn, F.lane, tvB); }
        __builtin_amdgcn_sched_barrier(0);
        tr_finish(cur, scr, F.lane, tvA);
        if (!has) break;
        cur = dn;
#pragma unroll
        for (int i = 0; i < 32; ++i) tvA[i] = tvB[i];
    }
}
#ifndef MK_EXPERTS_IN_SCAN
#define MK_EXPERTS_IN_SCAN 1
#endif
__device__ __forceinline__ void p0_prologue(Frame& F) {
    LAS float* scr = (LAS float*)(F.lds + F.wave * 16384);
    unsigned char* ws = F.ws;
    bf16* gateWT = (bf16*)(ws + WS_SMALLW + SW_GATEW);
    tr_run(F, scr, F.gw, F.NGW, MK_EXPERTS_IN_SCAN ? tri::E12 : tri::NITEMS);
    for (int mb = F.gw; mb < M; mb += 4 * F.NGW) {
        f32x4 v[4][4]; float s[4];
#pragma unroll
        for (int u = 0; u < 4; ++u) { const f32x4* xr = (const f32x4*)(F.ap->in[0] + (size_t)(mb + u * F.NGW) * D) + F.lane;
#pragma unroll
            for (int j = 0; j < 4; ++j) v[u][j] = xr[64 * j]; }
#pragma unroll
        for (int u = 0; u < 4; ++u) { s[u] = 0.f;
#pragma unroll
            for (int j = 0; j < 4; ++j) s[u] += (v[u][j].x * v[u][j].x + v[u][j].y * v[u][j].y) + (v[u][j].z * v[u][j].z + v[u][j].w * v[u][j].w); }
#pragma unroll
        for (int o = 1; o < 64; o <<= 1) {
#pragma unroll
            for (int u = 0; u < 4; ++u) s[u] += __shfl_xor(s[u], o); }
        const f32x4* gr = (const f32x4*)F.ap->in[2] + F.lane;
#pragma unroll
        for (int u = 0; u < 4; ++u) { const float rs = 1.0f / sqrtf(s[u] * (1.f / D) + NORM_EPS); v2u* o8 = (v2u*)((bf16*)(ws + WS_XN) + (size_t)(mb + u * F.NGW) * D) + F.lane;
#pragma unroll
            for (int j = 0; j < 4; ++j) o8[64 * j] = pk4(v[u][j] * rs * gr[64 * j]); }
    }
    {
        float* RW = (float*)(ws + WS_SMALLW + SW_ROUTEW); const float* gf = F.ap->in[25]; const float* wg = F.ap->in[26]; const float* wr = F.ap->in[28];
        for (int idx = F.gw * 64 + F.lane; idx < 48 * 1024; idx += F.NGW * 64) { const int c = idx >> 10, k = idx & 1023; float v = 0.f;
            if (c < 4) v = wg[k * 4 + c]; else if (c < 36) v = wr[k * 32 + (c - 4)];
            RW[idx] = v * gf[k]; }
        for (int idx = F.gw * 64 + F.lane; idx < 8 * 1024; idx += F.NGW * 64) gateWT[24 * 1024 + idx] = 0;
    }
}

struct EpiStoreBf16 {
    static constexpr bool PERM = true;
    bf16* O; int ldc;
    __device__ __forceinline__ void operator()(const f32x4 (&acc)[2][2][4][2], const pg8::Unit& u, int wr, int wc, int fr, int fq) const {
        const int row0 = u.pmo * 256 + wr * 64 + fr, col0 = u.pnl * 256 + wc * 32 + 8 * fq;
#pragma unroll
        for (int ai = 0; ai < 2; ++ai)
#pragma unroll
            for (int m = 0; m < 4; ++m) { bf16* rowp = O + (size_t)(row0 + ai * 128 + m * 16) * ldc + col0;
#pragma unroll
                for (int bj = 0; bj < 2; ++bj) { const f32x4 v0 = acc[ai][bj][m][0], v1 = acc[ai][bj][m][1]; v4u w; w.x = pk2(v0[0], v0[1]); w.y = pk2(v0[2], v0[3]); w.z = pk2(v1[0], v1[1]); w.w = pk2(v1[2], v1[3]);
                    *(v4u*)(rowp + bj * 128) = w; } }
    }
};
#define EPI_LOOP_BEGIN \
    _Pragma("unroll") for (int ai = 0; ai < 2; ++ai) _Pragma("unroll") for (int m = 0; m < 4; ++m) { if (m == 0 || m == 2) asm volatile("" ::: "memory"); const int rl = ai * 128 + wr * 64 + m * 16 + fr; const size_t row = (size_t)u.pmo * 256 + rl; (void)row; \
    _Pragma("unroll") for (int bj = 0; bj < 2; ++bj) _Pragma("unroll") for (int n = 0; n < 2; ++n) { const int col = u.pnl * 256 + bj * 128 + wc * 32 + n * 16 + 4 * fq; (void)col; const f32x4 a = acc[ai][bj][m][n];
#define EPI_LOOP_END } }
struct EpiMix {
    static constexpr bool PERM = false;
    const bf16* z; bf16* A; bf16* O;
    __device__ __forceinline__ void operator()(const f32x4 (&acc)[2][2][4][2], const pg8::Unit& u, int wr, int wc, int fr, int fq) const {
        const int zc = u.lt ? ZC_MN : ZC_MR;
        EPI_LOOP_BEGIN
            const f32x4 zz = unpk4(*(const v2u*)(z + row * NZ + zc + col)); f32x4 o;
            o.x = sigmoidf_(zz.x) * a.x; o.y = sigmoidf_(zz.y) * a.y; o.z = sigmoidf_(zz.z) * a.z; o.w = sigmoidf_(zz.w) * a.w;
            if (u.lt == 0) *(v2u*)(A + row * D + col) = pk4(o);
            else { o = o + unpk4(*(const v2u*)(A + row * D + col)); *(v2u*)(O + row * D + col) = pk4(o); }
        EPI_LOOP_END
    }
};
struct ErawOrder {
    pg8::StaticOrder S; int c, G, nheavy;
    __device__ bool next(int i, pg8::Unit& u) const { const int nl = G - nheavy, l = c - nheavy; if (l < 0) return false; const int q = l + i * nl; if (q >= S.nwg) return false;
        pg8::StaticOrder T = S; T.c = q; T.G = S.nwg + 1; return T.next(0, u); }
};
struct DualOrder {
    pg8::StaticOrder S;
    __device__ bool next(int i, pg8::Unit& u) const { if (i >= 2) return false; if (!S.next(0, u)) return false; if (i == 1) { u.pm += 64; u.pn += 4; } u.lt = i; return true; }
};
struct EpiResBf16 {
    static constexpr bool PERM = true;
    const float* base; bf16* O;
    __device__ __forceinline__ void operator()(const f32x4 (&acc)[2][2][4][2], const pg8::Unit& u, int wr, int wc, int fr, int fq) const {
        const int row0 = u.pmo * 256 + wr * 64 + fr, col0 = u.pnl * 256 + wc * 32 + 8 * fq;
#pragma unroll
        for (int ai = 0; ai < 2; ++ai)
#pragma unroll
            for (int m = 0; m < 4; ++m) { if (m == 0 || m == 2) asm volatile("" ::: "memory"); const size_t ro = (size_t)(row0 + ai * 128 + m * 16) * D + col0;
#pragma unroll
                for (int bj = 0; bj < 2; ++bj) { const f32x4 v0 = acc[ai][bj][m][0] + *(const f32x4*)(base + ro + bj * 128), v1 = acc[ai][bj][m][1] + *(const f32x4*)(base + ro + bj * 128 + 4);
                    v4u w; w.x = pk2(v0[0], v0[1]); w.y = pk2(v0[2], v0[3]); w.z = pk2(v1[0], v1[1]); w.w = pk2(v1[2], v1[3]);
                    *(v4u*)(O + ro + bj * 128) = w; } }
    }
};
struct EpiResF32 {
    static constexpr bool PERM = false;
    const float* base; float* O;
    __device__ __forceinline__ void operator()(const f32x4 (&acc)[2][2][4][2], const pg8::Unit& u, int wr, int wc, int fr, int fq) const {
        EPI_LOOP_BEGIN
            *(f32x4*)(O + row * D + col) = *(const f32x4*)(base + row * D + col) + a;
        EPI_LOOP_END
    }
};
struct EpiMoe1 {
    static constexpr bool PERM = false;
    bf16* H;
    __device__ __forceinline__ void operator()(const f32x4 (&acc)[2][2][4][2], const pg8::Unit& u, int wr, int wc, int fr, int fq) const {
#pragma unroll
        for (int ai = 0; ai < 2; ++ai)
#pragma unroll
            for (int m = 0; m < 4; ++m) { const size_t row = (size_t)u.pmo * 256 + ai * 128 + wr * 64 + m * 16 + fr;
#pragma unroll
                for (int n = 0; n < 2; ++n) { const f32x4 gt = acc[ai][0][m][n], up = acc[ai][1][m][n]; f32x4 o;
                    o.x = gt.x * sigmoidf_(gt.x) * up.x; o.y = gt.y * sigmoidf_(gt.y) * up.y; o.z = gt.z * sigmoidf_(gt.z) * up.z; o.w = gt.w * sigmoidf_(gt.w) * up.w;
                    *(v2u*)(H + row * 512 + u.pnl * 128 + wc * 32 + n * 16 + 4 * fq) = pk4(o); } }
    }
};
struct EpiPle {
    static constexpr bool PERM = false;
    const bf16* x2; const bf16* Eraw; const float* rse; const float* gpn; bf16* O;
    __device__ __forceinline__ void operator()(const f32x4 (&acc)[2][2][4][2], const pg8::Unit& u, int wr, int wc, int fr, int fq) const {
        EPI_LOOP_BEGIN
            const f32x4 e = unpk4(*(const v2u*)(Eraw + row * D + col)); const f32x4 g = *(const f32x4*)(gpn + col); const float rs = rse[row]; f32x4 o = unpk4(*(const v2u*)(x2 + row * D + col));
            o.x += sigmoidf_(a.x) * e.x * rs * g.x; o.y += sigmoidf_(a.y) * e.y * rs * g.y; o.z += sigmoidf_(a.z) * e.z * rs * g.z; o.w += sigmoidf_(a.w) * e.w * rs * g.w;
            *(v2u*)(O + row * D + col) = pk4(o);
        EPI_LOOP_END
    }
};

struct EpiPleNorm {
    static constexpr bool PERM = false;
    const bf16* x2; const bf16* Eraw; const float* gfin; float* out; float* xbuf; unsigned* cnt; LAS float* ldsx;
    __device__ __forceinline__ void operator()(const f32x4 (&acc_)[2][2][4][2], const pg8::Unit& u_, int wr, int wc, int fr, int fq) const {
        f32x4 (&acc)[2][2][4][2] = const_cast<f32x4 (&)[2][2][4][2]>(acc_);
        pg8::Unit u = u_; asm volatile("" : "+s"(u.pmo), "+s"(u.pnl)); asm volatile("" : "+v"(fr), "+v"(fq)); asm volatile("" : "+s"(wr), "+s"(wc));
        int tid = threadIdx.x; asm volatile("" : "+v"(tid)); const int lane = tid & 63, wid = __builtin_amdgcn_readfirstlane(tid >> 6);
        LAS float* Pl = ldsx; LAS float* Sl = ldsx + 1024; LAS unsigned* flag = (LAS unsigned*)(ldsx + 1280);
#pragma unroll
        for (int ai = 0; ai < 2; ++ai)
#pragma unroll
            for (int m = 0; m < 4; ++m) { if (m == 0 || m == 2) asm volatile("" ::: "memory"); const int rl = ai * 128 + wr * 64 + m * 16 + fr; const size_t row = (size_t)u.pmo * 256 + rl;
                float ss = 0.f;
#pragma unroll
                for (int bj = 0; bj < 2; ++bj)
#pragma unroll
                    for (int n = 0; n < 2; ++n) { const int col = u.pnl * 256 + bj * 128 + wc * 32 + n * 16 + 4 * fq; const f32x4 a = acc[ai][bj][m][n];
                        const f32x4 e = unpk4(*(const v2u*)(Eraw + row * D + col)); f32x4 o = unpk4(*(const v2u*)(x2 + row * D + col));
                        o.x += sigmoidf_(a.x) * e.x; o.y += sigmoidf_(a.y) * e.y; o.z += sigmoidf_(a.z) * e.z; o.w += sigmoidf_(a.w) * e.w;
                        acc[ai][bj][m][n] = o; ss += (o.x * o.x + o.y * o.y) + (o.z * o.z + o.w * o.w); }
                ss += __shfl_xor(ss, 16); ss += __shfl_xor(ss, 32);
                if (fq == 0) Pl[rl * 4 + wc] = ss; }
        asm volatile("s_waitcnt lgkmcnt(0)" ::: "memory"); __builtin_amdgcn_s_barrier(); asm volatile("" ::: "memory");
        if (tid < 256) { const float tot = (Pl[tid * 4 + 0] + Pl[tid * 4 + 1]) + (Pl[tid * 4 + 2] + Pl[tid * 4 + 3]);
            __hip_atomic_store(xbuf + ((size_t)u.pmo * 256 + tid) * 4 + u.pnl, tot, __ATOMIC_RELAXED, __HIP_MEMORY_SCOPE_AGENT);
            asm volatile("s_waitcnt vmcnt(0)" ::: "memory");
            if (lane == 0) __hip_atomic_fetch_add(cnt + 64 * u.pmo, 1u, __ATOMIC_RELAXED, __HIP_MEMORY_SCOPE_AGENT); }
        if (wid == 0) {
            unsigned spins = 0;
            while ((unsigned)__builtin_amdgcn_readfirstlane((int)__hip_atomic_load(cnt + 64 * u.pmo, __ATOMIC_RELAXED, __HIP_MEMORY_SCOPE_AGENT)) < 16u) { __builtin_amdgcn_s_sleep(2); if (++spins > (1u << 22)) break; }
            __builtin_amdgcn_fence(__ATOMIC_ACQUIRE, "agent");
            if (lane == 0) flag[0] = 1u; }
        asm volatile("s_waitcnt vmcnt(0) lgkmcnt(0)" ::: "memory"); __builtin_amdgcn_s_barrier(); asm volatile("" ::: "memory");
        if (tid < 256) { const float* sp = xbuf + ((size_t)u.pmo * 256 + tid) * 4; float tot = 0.f;
#pragma unroll
            for (int t = 0; t < 4; ++t) tot += __hip_atomic_load(sp + t, __ATOMIC_RELAXED, __HIP_MEMORY_SCOPE_AGENT);
            Sl[tid] = 1.0f / sqrtf(tot * (1.f / D) + NORM_EPS); }
        asm volatile("s_waitcnt vmcnt(0) lgkmcnt(0)" ::: "memory"); __builtin_amdgcn_s_barrier(); asm volatile("" ::: "memory");
#pragma unroll
        for (int ai = 0; ai < 2; ++ai)
#pragma unroll
            for (int m = 0; m < 4; ++m) { const int rl = ai * 128 + wr * 64 + m * 16 + fr; const size_t row = (size_t)u.pmo * 256 + rl; const float rs = Sl[rl];
#pragma unroll
                for (int bj = 0; bj < 2; ++bj)
#pragma unroll
                    for (int n = 0; n < 2; ++n) { const int col = u.pnl * 256 + bj * 128 + wc * 32 + n * 16 + 4 * fq; *(f32x4*)(out + row * D + col) = acc[ai][bj][m][n] * rs * *(const f32x4*)(gfin + col); } }
    }
};

__device__ __forceinline__ float gelu_tanh(float x) { const float u = 0.7978845608028654f * (x + 0.044715f * x * x * x); const float t = 1.0f - 2.0f * __builtin_amdgcn_rcpf(__expf(2.0f * u) + 1.0f); return 0.5f * x * (1.0f + t); }

__device__ __forceinline__ void compress_wg_task(Frame& F, int idx) {
    const int kv = idx & 1, tile8 = (idx >> 1) & 7, bg = idx >> 4, b = bg >> 1, g = bg & 1;
    const int fr = F.lane & 15, fq = F.lane >> 4;
    const bf16* z = (const bf16*)(F.ws + WS_Z);
    const bf16* w1T = (const bf16*)(F.ws + WS_SMALLW + (kv ? SW_CV1 : SW_CK1));
    const bf16* w2T = (const bf16*)(F.ws + WS_SMALLW + (kv ? SW_CV2 : SW_CK2));
    const float* pos = kv ? F.ap->in[16] : F.ap->in[15];
    const int j0 = 16 * tile8; int j = j0 + fr; const bool jvalid = j < 127; if (!jvalid) j = 126;
    const bf16* zb = z + ((size_t)b * SEQ + 16 * j) * NZ + (kv ? ZC_VC : ZC_KC) + g * 64;
    v4u zr[8]; f32x4 p0[8], p1[8]; bf16x8 aop[8][4];
#pragma unroll
    for (int i = 0; i < 8; ++i) { const int ks = 8 * F.wave + i, l = ks >> 1, d = 32 * (ks & 1) + 8 * fq;
        zr[i] = *(const v4u*)(zb + (size_t)l * NZ + d); p0[i] = *(const f32x4*)(pos + l * 64 + d); p1[i] = *(const f32x4*)(pos + l * 64 + d + 4);
#pragma unroll
        for (int mt = 0; mt < 4; ++mt) aop[i][mt] = *(const bf16x8*)(w1T + (size_t)(16 * mt + fr) * 2048 + 32 * ks + 8 * fq); }
    f32x4 acc[4];
#pragma unroll
    for (int mt = 0; mt < 4; ++mt) acc[mt] = (f32x4){0.f, 0.f, 0.f, 0.f};
#pragma unroll
    for (int i = 0; i < 8; ++i) {
        float f[8]; unpk8(zr[i], f);
        v4u bb; bb.x = pk2(f[0] + p0[i].x, f[1] + p0[i].y); bb.y = pk2(f[2] + p0[i].z, f[3] + p0[i].w); bb.z = pk2(f[4] + p1[i].x, f[5] + p1[i].y); bb.w = pk2(f[6] + p1[i].z, f[7] + p1[i].w);
        const bf16x8 bop = __builtin_bit_cast(bf16x8, bb);
#pragma unroll
        for (int mt = 0; mt < 4; ++mt) acc[mt] = MFMA16(aop[i][mt], bop, acc[mt]);
    }
    LAS float* red = (LAS float*)F.lds;
    __syncthreads();
#pragma unroll
    for (int mt = 0; mt < 4; ++mt) *(LAS f32x4*)(red + ((F.wave * 4 + mt) * 64 + F.lane) * 4) = acc[mt];
    LDS_WAIT(); __syncthreads();
    if (F.wave != 0) return;
#pragma unroll
    for (int mt = 0; mt < 4; ++mt) { f32x4 t = (f32x4){0.f, 0.f, 0.f, 0.f};
#pragma unroll
        for (int w = 0; w < 8; ++w) t = t + *(const LAS f32x4*)(red + ((w * 4 + mt) * 64 + F.lane) * 4);
        acc[mt] = t; }
    bf16x8 hb[2];
#pragma unroll
    for (int s2 = 0; s2 < 2; ++s2) { v4u w; const f32x4 a0 = acc[2 * s2], a1 = acc[2 * s2 + 1];
        w.x = pk2(gelu_tanh(a0.x), gelu_tanh(a0.y)); w.y = pk2(gelu_tanh(a0.z), gelu_tanh(a0.w)); w.z = pk2(gelu_tanh(a1.x), gelu_tanh(a1.y)); w.w = pk2(gelu_tanh(a1.z), gelu_tanh(a1.w));
        hb[s2] = __builtin_bit_cast(bf16x8, w); }
    bf16* kcmp = (bf16*)(F.ws + WS_KCMP); bf16* vcmpT = (bf16*)(F.ws + WS_KCMP + 512 * 1024);
#pragma unroll
    for (int ntl = 0; ntl < 4; ++ntl) {
        f32x4 o = (f32x4){0.f, 0.f, 0.f, 0.f};
#pragma unroll
        for (int s2 = 0; s2 < 2; ++s2) { const bf16* wp = w2T + (size_t)(16 * ntl + fr) * 64 + 32 * s2 + 4 * fq; const v2u lo = *(const v2u*)wp, hi = *(const v2u*)(wp + 16);
            v4u aw; aw.x = lo.x; aw.y = lo.y; aw.z = hi.x; aw.w = hi.y; o = MFMA16(__builtin_bit_cast(bf16x8, aw), hb[s2], o); }
        if (!jvalid) o = (f32x4){0.f, 0.f, 0.f, 0.f};
        const int jj = j0 + fr, n = 16 * ntl + 4 * fq;
        if (kv == 0) *(v2u*)(kcmp + ((size_t)bg * 128 + jj) * 64 + n) = pk4(o);
        else { const v2u w = pk4(o); bf16* vp = vcmpT + ((size_t)bg * 64 + n) * 128 + jj; vp[0] = (bf16)(w.x & 0xffff); vp[128] = (bf16)(w.x >> 16); vp[256] = (bf16)(w.y & 0xffff); vp[384] = (bf16)(w.y >> 16); }
    }
}
__device__ __forceinline__ void zgate_task(Frame& F, int tile) {
    const int fr = F.lane & 15, fq = F.lane >> 4, m0 = tile * 16;
    const bf16* XN = (const bf16*)(F.ws + WS_XN); const bf16* gw = (const bf16*)(F.ws + WS_SMALLW + SW_GATEW);
    f32x4 acc[2] = {(f32x4){0.f, 0.f, 0.f, 0.f}, (f32x4){0.f, 0.f, 0.f, 0.f}};
#pragma unroll 16
    for (int ks = 0; ks < 32; ++ks) {
        const bf16x8 bop = *(const bf16x8*)(XN + (size_t)(m0 + fr) * D + 32 * ks + 8 * fq);
#pragma unroll
        for (int ct = 0; ct < 2; ++ct) { const bf16x8 aop = *(const bf16x8*)(gw + (size_t)(16 * ct + fr) * D + 32 * ks + 8 * fq); acc[ct] = MFMA16(aop, bop, acc[ct]); }
    }
    float* zg = (float*)(F.ws + WS_ZGATE);
#pragma unroll
    for (int ct = 0; ct < 2; ++ct) *(f32x4*)(zg + (size_t)(m0 + fr) * 32 + 16 * ct + 4 * fq) = acc[ct];
}
__device__ __forceinline__ void vt_task(Frame& F, int idx) {
    const int which = idx & 1, blk = (idx >> 1) & 31, bg = idx >> 6, b = bg >> 1, g = bg & 1;
    const bf16* z = (const bf16*)(F.ws + WS_Z);
    bf16* vT = (bf16*)(F.ws + (which ? WS_VWT : WS_VST));
    const int t = 64 * blk + F.lane;
    const bf16* src = z + ((size_t)b * SEQ + t) * NZ + (which ? ZC_VW : ZC_VS) + g * 64;
#pragma unroll
    for (int dc = 0; dc < 8; ++dc) { const v4u w = *(const v4u*)(src + 8 * dc); bf16* dst = vT + ((size_t)bg * 64 + 8 * dc) * SEQ + t;
        dst[0 * SEQ] = (bf16)(w.x & 0xffff); dst[1 * SEQ] = (bf16)(w.x >> 16); dst[2 * SEQ] = (bf16)(w.y & 0xffff); dst[3 * SEQ] = (bf16)(w.y >> 16);
        dst[4 * SEQ] = (bf16)(w.z & 0xffff); dst[5 * SEQ] = (bf16)(w.z >> 16); dst[6 * SEQ] = (bf16)(w.w & 0xffff); dst[7 * SEQ] = (bf16)(w.w >> 16); }
}
__device__ __forceinline__ void alora_task4(Frame& F, int mb) {
    const bf16* z = (const bf16*)(F.ws + WS_Z); bf16* AL = (bf16*)(F.ws + WS_PBF);
    const int l = F.lane;
    const f32x4 mu = *(const f32x4*)(F.ap->in[4] + ZC_W + 4 * l);
    v2u cw[4], pw[4];
#pragma unroll
    for (int u = 0; u < 4; ++u) { const int m = mb + u * F.NGW; const int t = m & (SEQ - 1); cw[u] = *(const v2u*)(z + (size_t)m * NZ + ZC_W + 4 * l); pw[u] = *(const v2u*)(z + (size_t)(t > 0 ? m - 1 : m) * NZ + ZC_W + 4 * l); }
#pragma unroll
    for (int u = 0; u < 4; ++u) { const int m = mb + u * F.NGW; const int t = m & (SEQ - 1);
        const f32x4 cur = unpk4(cw[u]); const f32x4 prev = unpk4(pw[u]) * (t > 0 ? 1.0f : 0.0f);
        f32x4 s = cur + (prev - cur) * mu;
        if (l < 16) { s.x = tanhf(s.x); s.y = tanhf(s.y); s.z = tanhf(s.z); s.w = tanhf(s.w); }
        else if (l >= 32) { s.x = sigmoidf_(s.x); s.y = sigmoidf_(s.y); s.z = sigmoidf_(s.z); s.w = sigmoidf_(s.w); }
        *(v2u*)(AL + (size_t)m * 256 + 4 * l) = pk4(s); }
}
__device__ __forceinline__ void p2_prep(Frame& F) {
    constexpr int T1 = 1024, T2 = T1 + 1024;
    for (int it = F.vcu; it < 256; it += F.G) compress_wg_task(F, it);
    for (int task = F.gw; task < T2; task += F.NGW) {
        if (task < T1) zgate_task(F, task);
        else vt_task(F, task - T1);
    }
    for (int base = F.gw; base < M; base += 4 * F.NGW) alora_task4(F, base);
}

__device__ __forceinline__ void ld16(const bf16* p, float (&f)[16]) { float a[8], b[8]; unpk8(*(const v4u*)p, a); unpk8(*(const v4u*)(p + 8), b);
#pragma unroll
    for (int i = 0; i < 8; ++i) { f[i] = a[i]; f[8 + i] = b[i]; } }
__device__ __forceinline__ void ld16f(const float* p, float (&f)[16]) {
#pragma unroll
    for (int q = 0; q < 4; ++q) { const f32x4 v = *(const f32x4*)(p + 4 * q); f[4 * q] = v.x; f[4 * q + 1] = v.y; f[4 * q + 2] = v.z; f[4 * q + 3] = v.w; } }
__device__ __forceinline__ void st16(bf16* p, const float (&f)[16]) { v4u a, b; a.x = pk2(f[0], f[1]); a.y = pk2(f[2], f[3]); a.z = pk2(f[4], f[5]); a.w = pk2(f[6], f[7]); b.x = pk2(f[8], f[9]); b.y = pk2(f[10], f[11]); b.z = pk2(f[12], f[13]); b.w = pk2(f[14], f[15]);
    *(v4u*)p = a; *(v4u*)(p + 8) = b; }
struct PrepW { bf16x8 w[2], a[2], g[4]; };
constexpr int PW_OFF = 32768, PW_P64 = 144, PW_P128 = 272, PW_A_OFF = PW_OFF + 64 * PW_P64, PW_G_OFF = PW_A_OFF + 64 * PW_P64;
__device__ __forceinline__ void prep_stage_w(Frame& F, int h) {
    const bf16* w2T = (const bf16*)(F.ws + WS_SMALLW + SW_W2T) + (size_t)h * 64 * 64; const bf16* a2T = (const bf16*)(F.ws + WS_SMALLW + SW_A2T) + (size_t)h * 64 * 64; const bf16* g2T = (const bf16*)(F.ws + WS_SMALLW + SW_G2T) + (size_t)h * 64 * 128;
    { const int R = F.tid >> 3, c = F.tid & 7, slot = ((R >> 2) & 3) * 16 + (R >> 4) * 4 + (R & 3);
      *(LAS v4u*)(F.lds + PW_OFF + slot * PW_P64 + c * 16) = *(const v4u*)(w2T + R * 64 + c * 8); *(LAS v4u*)(F.lds + PW_A_OFF + slot * PW_P64 + c * 16) = *(const v4u*)(a2T + R * 64 + c * 8); }
#pragma unroll
    for (int i = 0; i < 2; ++i) { const int id = F.tid + 512 * i, R = id >> 4, c = id & 15, slot = ((R >> 2) & 3) * 16 + (R >> 4) * 4 + (R & 3);
      *(LAS v4u*)(F.lds + PW_G_OFF + slot * PW_P128 + c * 16) = *(const v4u*)(g2T + R * 128 + c * 8); }
}
__device__ __forceinline__ void prep_ldw(PrepW& W, const LAS unsigned char* lds, int n, int fr, int fq) {
#pragma unroll
    for (int ks = 0; ks < 2; ++ks) { W.w[ks] = *(const LAS bf16x8*)(lds + PW_OFF + (n * 16 + fr) * PW_P64 + 64 * ks + 16 * fq); W.a[ks] = *(const LAS bf16x8*)(lds + PW_A_OFF + (n * 16 + fr) * PW_P64 + 64 * ks + 16 * fq); }
#pragma unroll
    for (int ks = 0; ks < 4; ++ks) W.g[ks] = *(const LAS bf16x8*)(lds + PW_G_OFF + (n * 16 + fr) * PW_P128 + 64 * ks + 16 * fq);
}
__device__ __forceinline__ void ldpar(const LAS float* p, float (&f)[16]) {
#pragma unroll
    for (int q = 0; q < 4; ++q) { const f32x4 v = *(const LAS f32x4*)(p + 4 * q); f[4 * q] = v.x; f[4 * q + 1] = v.y; f[4 * q + 2] = v.z; f[4 * q + 3] = v.w; } }
__device__ __forceinline__ void rwkv_prep_task(Frame& F, int task, const LAS float* par) {
    const int h = task & 7, m0 = (task >> 3) * 16, fr = F.lane & 15, fq = F.lane >> 4, m = m0 + fr, t = m & (SEQ - 1);
    const bf16* z = (const bf16*)(F.ws + WS_Z); const bf16* AL = (const bf16*)(F.ws + WS_PBF);
    bf16* vbuf = (bf16*)F.out; bf16* gbuf = (bf16*)(F.ws + WS_G);
    const int cl = h * 64 + 16 * fq;
    bf16x8 bw[2], ba[2], bgf[4];
    const bf16* alr = AL + (size_t)m * 256 + 8 * fq;
#pragma unroll
    for (int ks = 0; ks < 2; ++ks) { bw[ks] = *(const bf16x8*)(alr + 32 * ks); ba[ks] = *(const bf16x8*)(alr + 64 + 32 * ks); }
#pragma unroll
    for (int ks = 0; ks < 4; ++ks) bgf[ks] = *(const bf16x8*)(alr + 128 + 32 * ks);
    const bf16* zc = z + (size_t)m * NZ + cl; const bf16* zp = (t > 0) ? zc - NZ : zc;
    v4u zraw[6][2];
#pragma unroll
    for (int q = 0; q < 3; ++q) { zraw[q][0] = *(const v4u*)(zc + 512 * q); zraw[q][1] = *(const v4u*)(zc + 512 * q + 8); zraw[3 + q][0] = *(const v4u*)(zp + 512 * q); zraw[3 + q][1] = *(const v4u*)(zp + 512 * q + 8); }
    __builtin_amdgcn_sched_barrier(0);
    float ev[16], av[16], gv[16];
#define PREP_MM(W, n) do { f32x4 accw = (f32x4){0.f, 0.f, 0.f, 0.f}, acca = accw, accg = accw; \
        _Pragma("unroll") for (int ks = 0; ks < 2; ++ks) { accw = MFMA16(W.w[ks], bw[ks], accw); acca = MFMA16(W.a[ks], ba[ks], acca); } \
        _Pragma("unroll") for (int ks = 0; ks < 4; ++ks) accg = MFMA16(W.g[ks], bgf[ks], accg); \
        _Pragma("unroll") for (int r = 0; r < 4; ++r) { ev[4 * (n) + r] = accw[r]; av[4 * (n) + r] = acca[r]; gv[4 * (n) + r] = accg[r]; } } while (0)
    { PrepW Wa, Wb;
      prep_ldw(Wa, F.lds, 0, fr, fq); prep_ldw(Wb, F.lds, 1, fr, fq); PREP_MM(Wa, 0); PREP_MM(Wb, 1);
      prep_ldw(Wa, F.lds, 2, fr, fq); prep_ldw(Wb, F.lds, 3, fr, fq); PREP_MM(Wa, 2); PREP_MM(Wb, 3); }
    float zr[16], zk[16], zv[16], tmp[16];
    const float pm = (t > 0) ? 1.0f : 0.0f;
    {   float c[16], p[16];
#define PREP_UNP(q, dst) do { float a_[8], b_[8]; unpk8(zraw[q][0], a_); unpk8(zraw[q][1], b_); _Pragma("unroll") for (int i = 0; i < 8; ++i) { dst[i] = a_[i]; dst[8 + i] = b_[i]; } } while (0)
        PREP_UNP(0, c); PREP_UNP(3, p); ldpar(par + 0 * 64 + 16 * fq, tmp);
#pragma unroll
        for (int e = 0; e < 16; ++e) zr[e] = c[e] + (p[e] * pm - c[e]) * tmp[e];
        PREP_UNP(1, c); PREP_UNP(4, p); ldpar(par + 1 * 64 + 16 * fq, tmp);
#pragma unroll
        for (int e = 0; e < 16; ++e) zk[e] = c[e] + (p[e] * pm - c[e]) * tmp[e];
        PREP_UNP(2, c); PREP_UNP(5, p); ldpar(par + 2 * 64 + 16 * fq, tmp);
#pragma unroll
        for (int e = 0; e < 16; ++e) zv[e] = c[e] + (p[e] * pm - c[e]) * tmp[e];
    }
    float kkr[16]; float ss = 0.f;
    ldpar(par + 3 * 64 + 16 * fq, tmp);
#pragma unroll
    for (int e = 0; e < 16; ++e) { const float x = -(tmp[e] + ev[e]); const float sp = fmaxf(x, 0.f) + __logf(1.0f + __expf(-fabsf(x))); ev[e] = __expf(-sp - 0.5f); }
    ldpar(par + 4 * 64 + 16 * fq, tmp);
#pragma unroll
    for (int e = 0; e < 16; ++e) av[e] = sigmoidf_(tmp[e] + av[e]);
    ldpar(par + 5 * 64 + 16 * fq, tmp);
#pragma unroll
    for (int e = 0; e < 16; ++e) { kkr[e] = zk[e] * tmp[e]; ss += kkr[e] * kkr[e]; }
    ss += __shfl_xor(ss, 16); ss += __shfl_xor(ss, 32);
    const float inv = 1.0f / fmaxf(sqrtf(ss), 1e-12f);
    ldpar(par + 6 * 64 + 16 * fq, tmp);
    float kp[16], kka[16];
#pragma unroll
    for (int e = 0; e < 16; ++e) { kkr[e] *= inv; kka[e] = kkr[e] * av[e]; kp[e] = zk[e] * (1.0f + (av[e] - 1.0f) * tmp[e]); }
    st16(vbuf + (size_t)m * 512 + cl, zv); st16(gbuf + (size_t)m * 512 + cl, gv);
    { ldpar(par + 7 * 64 + 16 * fq, tmp);
      float bsum = 0.f;
#pragma unroll
      for (int e = 0; e < 16; ++e) bsum += zr[e] * kp[e] * tmp[e];
      bsum += __shfl_xor(bsum, 16); bsum += __shfl_xor(bsum, 32);
      if (fq == 0) ((float*)(F.ws + WS_BONUS))[(size_t)m * 8 + h] = bsum; }
    asm volatile("" ::: "memory");
    unsigned char* rec = F.ws + WS_S + (size_t)task * CH_REC;
    bf16x8 Pb[2], Qb[2], Kb[2], Rb[2];
#pragma unroll
    for (int ks = 0; ks < 2; ++ks) {
        float Pm[8], Qm[8], Km[8], Rm[8], acv[8];
#pragma unroll
        for (int e8 = 0; e8 < 8; ++e8) { const int e = 8 * ks + e8;
            float cs = ev[e]; cs += dppf<0x111>(cs); cs += dppf<0x112>(cs); cs += dppf<0x114>(cs); cs += dppf<0x118>(cs);
            const float A = __expf(-cs), Ap = __expf(ev[e] - cs), iA = __expf(cs);
            Pm[e8] = kkr[e] * Ap; Qm[e8] = -kka[e] * iA; Km[e8] = kp[e] * iA; Rm[e8] = zr[e] * A; acv[e8] = A; }
        v4u w;
        w.x = pk2(Pm[0], Pm[1]); w.y = pk2(Pm[2], Pm[3]); w.z = pk2(Pm[4], Pm[5]); w.w = pk2(Pm[6], Pm[7]); Pb[ks] = __builtin_bit_cast(bf16x8, w);
        w.x = pk2(Qm[0], Qm[1]); w.y = pk2(Qm[2], Qm[3]); w.z = pk2(Qm[4], Qm[5]); w.w = pk2(Qm[6], Qm[7]); Qb[ks] = __builtin_bit_cast(bf16x8, w);
        w.x = pk2(Km[0], Km[1]); w.y = pk2(Km[2], Km[3]); w.z = pk2(Km[4], Km[5]); w.w = pk2(Km[6], Km[7]); Kb[ks] = __builtin_bit_cast(bf16x8, w);
        w.x = pk2(Rm[0], Rm[1]); w.y = pk2(Rm[2], Rm[3]); w.z = pk2(Rm[4], Rm[5]); w.w = pk2(Rm[6], Rm[7]); Rb[ks] = __builtin_bit_cast(bf16x8, w);
        if (fr == 15) { *(f32x4*)(rec + CH_AC + (16 * fq + 8 * ks) * 4) = (f32x4){acv[0], acv[1], acv[2], acv[3]}; *(f32x4*)(rec + CH_AC + (16 * fq + 8 * ks + 4) * 4) = (f32x4){acv[4], acv[5], acv[6], acv[7]}; }
    }
    *(v4u*)(rec + CH_P + fr * CH_PP + 32 * fq) = __builtin_bit_cast(v4u, Pb[0]); *(v4u*)(rec + CH_P + fr * CH_PP + 32 * fq + 16) = __builtin_bit_cast(v4u, Pb[1]);
    *(v4u*)(rec + CH_R + fr * CH_PP + 32 * fq) = __builtin_bit_cast(v4u, Rb[0]); *(v4u*)(rec + CH_R + fr * CH_PP + 32 * fq + 16) = __builtin_bit_cast(v4u, Rb[1]);
    *(v4u*)(rec + CH_Q + (fq * 16 + fr) * 32) = __builtin_bit_cast(v4u, Qb[0]); *(v4u*)(rec + CH_Q + (fq * 16 + fr) * 32 + 16) = __builtin_bit_cast(v4u, Qb[1]);
    *(v4u*)(rec + CH_K + (fq * 16 + fr) * 32) = __builtin_bit_cast(v4u, Kb[0]); *(v4u*)(rec + CH_K + (fq * 16 + fr) * 32 + 16) = __builtin_bit_cast(v4u, Kb[1]);
    f32x4 gqp = (f32x4){0.f, 0.f, 0.f, 0.f}, gkp = gqp, gqr = gqp, gkr = gqp;
#pragma unroll
    for (int ks = 0; ks < 2; ++ks) { gqp = MFMA16(Qb[ks], Pb[ks], gqp); gkp = MFMA16(Kb[ks], Pb[ks], gkp); gqr = MFMA16(Qb[ks], Rb[ks], gqr); gkr = MFMA16(Kb[ks], Rb[ks], gkr); }
#pragma unroll
    for (int rg = 0; rg < 4; ++rg) { const int s = 4 * fq + rg; if (!(s < fr)) { gqp[rg] = 0.f; gkp[rg] = 0.f; } if (!(s <= fr)) { gqr[rg] = 0.f; gkr[rg] = 0.f; } }
    *(v2u*)(rec + CH_G + 0 * 512 + (fr * 16 + 4 * fq) * 2) = pk4(gkp);
    *(v2u*)(rec + CH_G + 2 * 512 + (fr * 16 + 4 * fq) * 2) = pk4(gqr);
    *(v2u*)(rec + CH_G + 3 * 512 + (fr * 16 + 4 * fq) * 2) = pk4(gkr);
    LAS float* Nl = (LAS float*)(F.lds + F.wave * 4096);
#pragma unroll
    for (int rg = 0; rg < 4; ++rg) Nl[(4 * fq + rg) * 20 + fr] = gqp[rg];
    LDS_WAIT(); __builtin_amdgcn_wave_barrier(); asm volatile("" ::: "memory");
    float Tc[16];
#pragma unroll
    for (int s = 15; s >= 0; --s) {
        float acc = 0.f;
#pragma unroll
        for (int q4 = 0; q4 < 4; ++q4) if (4 * q4 + 3 > s) { const f32x4 nv = *(const LAS f32x4*)(Nl + s * 20 + 4 * q4);
#pragma unroll
            for (int u = 0; u < 4; ++u) if (4 * q4 + u > s) acc += nv[u] * Tc[4 * q4 + u]; }
        Tc[s] = (s == fr) ? 1.0f : acc; }
    { f32x4 tv;
#pragma unroll
      for (int u = 0; u < 4; ++u) tv[u] = fq == 0 ? Tc[u] : (fq == 1 ? Tc[4 + u] : (fq == 2 ? Tc[8 + u] : Tc[12 + u]));
      *(v2u*)(rec + CH_G + 1 * 512 + (fr * 16 + 4 * fq) * 2) = pk4(tv); }
    LDS_WAIT(); __builtin_amdgcn_wave_barrier(); asm volatile("" ::: "memory");
#undef PREP_MM
#undef PREP_UNP
}
__device__ __forceinline__ void prep_fill_par(Frame& F, LAS float* par, int h) {
    const int l = F.lane; const float* mu = F.ap->in[4];
    par[0 * 64 + l] = mu[ZC_R + h * 64 + l]; par[1 * 64 + l] = mu[ZC_K + h * 64 + l]; par[2 * 64 + l] = mu[ZC_V + h * 64 + l];
    par[3 * 64 + l] = F.ap->in[5][h * 64 + l]; par[4 * 64 + l] = F.ap->in[7][h * 64 + l]; par[5 * 64 + l] = F.ap->in[10][h * 64 + l]; par[6 * 64 + l] = F.ap->in[11][h * 64 + l]; par[7 * 64 + l] = F.ap->in[12][h * 64 + l];
    LDS_WAIT(); __builtin_amdgcn_wave_barrier(); asm volatile("" ::: "memory");
}

__device__ __forceinline__ float nsa_slope(int g, int r) { return __uint_as_float((unsigned)(127 - (g * 4 + r + 1)) << 23); }

constexpr int CMP_KC_OFF = 32768, CMP_KP = 144, CMP_VC_OFF = CMP_KC_OFF + 128 * CMP_KP, CMP_VP = 264;
__device__ __forceinline__ void nsa_cmp_stage(Frame& F, int bg) {
    const bf16* kcmp = (const bf16*)(F.ws + WS_KCMP) + (size_t)bg * 128 * 64; const bf16* vcmpT = (const bf16*)(F.ws + WS_KCMP + 512 * 1024) + (size_t)bg * 64 * 128;
    v4u a[2], v[2];
#pragma unroll
    for (int i = 0; i < 2; ++i) { const int id = F.tid + 512 * i; a[i] = *(const v4u*)(kcmp + (size_t)(id >> 3) * 64 + (id & 7) * 8); v[i] = *(const v4u*)(vcmpT + (size_t)(id >> 4) * 128 + (id & 15) * 8); }
#pragma unroll
    for (int i = 0; i < 2; ++i) { const int id = F.tid + 512 * i; *(LAS v4u*)(F.lds + CMP_KC_OFF + (id >> 3) * CMP_KP + (id & 7) * 16) = a[i]; *(LAS v4u*)(F.lds + CMP_VC_OFF + (id >> 4) * CMP_VP + (id & 15) * 16) = v[i]; }
}
template <int ABL>
__device__ __forceinline__ void nsa_cmp_task(Frame& F, int task) {
    const int tile = task & 127, bg = task >> 7, b = bg >> 1, g = bg & 1;
    const int fr = F.lane & 15, fq = F.lane >> 4, t = tile * 16 + fr, m = b * SEQ + t;
    const bf16* z = (const bf16*)(F.ws + WS_Z);
    const float* zg = (const float*)(F.ws + WS_ZGATE); const float* gb = F.ap->in[21];
    bf16* Y = (bf16*)(F.ws + WS_YB);
    bf16x8 qall[4][2]; float gl[4];
#pragma unroll
    for (int r = 0; r < 4; ++r) { const bf16* qp = z + (size_t)m * NZ + ZC_Q + (g * 4 + r) * 64 + 8 * fq; qall[r][0] = *(const bf16x8*)qp; qall[r][1] = *(const bf16x8*)(qp + 32);
        gl[r] = zg[(size_t)m * 32 + (g * 4 + r) * 3 + 0] + gb[(g * 4 + r) * 3 + 0]; }
    const LAS unsigned char* kc = F.lds + CMP_KC_OFF + fr * CMP_KP + 16 * fq; const LAS unsigned char* vc = F.lds + CMP_VC_OFF + fr * CMP_VP + 8 * fq;
    const int tv = t - 31 - 64 * fq; const float tb = (float)t - 15.5f - 64.0f * (float)fq;
    float impl[8], imp3[8];
#pragma unroll
    for (int kt = 0; kt < 8; ++kt) { impl[kt] = 0.f; imp3[kt] = 0.f; }
#pragma unroll
    for (int r = 0; r < 4; ++r) {
        const float slope = nsa_slope(g, r);
        const bf16x8 q0 = qall[r][0], q1 = qall[r][1];
        float s[8][4]; float mx = -1e30f;
#pragma unroll
        for (int kt = 0; kt < 8; ++kt) {
            f32x4 a = (f32x4){0.f, 0.f, 0.f, 0.f};
            a = MFMA16(*(const LAS bf16x8*)(kc + 16 * kt * CMP_KP), q0, a); a = MFMA16(*(const LAS bf16x8*)(kc + 16 * kt * CMP_KP + 64), q1, a);
#pragma unroll
            for (int rg = 0; rg < 4; ++rg) { const bool valid = ((256 * kt + 16 * rg) <= tv);
                const float sc = a[rg] * 0.125f - slope * (tb - (float)(256 * kt + 16 * rg)); s[kt][rg] = valid ? sc : -1e30f; mx = fmaxf(mx, s[kt][rg]); }
        }
        mx = fmaxf(mx, __shfl_xor(mx, 16)); mx = fmaxf(mx, __shfl_xor(mx, 32));
        float sum = 0.f;
#pragma unroll
        for (int kt = 0; kt < 8; ++kt)
#pragma unroll
            for (int rg = 0; rg < 4; ++rg) { const float p = (s[kt][rg] > -1e29f) ? __expf(s[kt][rg] - mx) : 0.f; s[kt][rg] = p; sum += p; }
        sum += __shfl_xor(sum, 16); sum += __shfl_xor(sum, 32);
        const float inv = sum > 0.f ? 1.0f / sum : 0.f;
#pragma unroll
        for (int kt = 0; kt < 8; ++kt) {
#pragma unroll
            for (int rg = 0; rg < 4; ++rg) s[kt][rg] *= inv;
            impl[kt] += s[kt][0] + s[kt][1] + s[kt][2] + 0.5f * s[kt][3]; imp3[kt] += s[kt][3]; }
        f32x4 o[4];
#pragma unroll
        for (int dt = 0; dt < 4; ++dt) o[dt] = (f32x4){0.f, 0.f, 0.f, 0.f};
#pragma unroll
        for (int s2 = 0; s2 < 4; ++s2) {
            v4u pw; pw.x = pk2(s[2 * s2][0], s[2 * s2][1]); pw.y = pk2(s[2 * s2][2], s[2 * s2][3]); pw.z = pk2(s[2 * s2 + 1][0], s[2 * s2 + 1][1]); pw.w = pk2(s[2 * s2 + 1][2], s[2 * s2 + 1][3]);
            const bf16x8 pb = __builtin_bit_cast(bf16x8, pw);
#pragma unroll
            for (int dt = 0; dt < 4; ++dt) { const LAS unsigned char* vp = vc + 16 * dt * CMP_VP + 64 * s2; const v2u lo = *(const LAS v2u*)vp, hi = *(const LAS v2u*)(vp + 32);
                v4u aw; aw.x = lo.x; aw.y = lo.y; aw.z = hi.x; aw.w = hi.y; o[dt] = MFMA16(__builtin_bit_cast(bf16x8, aw), pb, o[dt]); }
        }
        const int hh = g * 4 + r; const float gate = sigmoidf_(gl[r]);
#pragma unroll
        for (int dt = 0; dt < 4; ++dt) *(v2u*)(Y + (size_t)m * 512 + hh * 64 + 16 * dt + 4 * fq) = pk4(o[dt] * gate);
        __builtin_amdgcn_sched_barrier(0);
    }
    if (ABL == 1) return;
    LAS float* sc = (LAS float*)(F.lds + F.wave * 4096);
    float y3prev = 0.f;
#pragma unroll
    for (int kt = 0; kt < 8; ++kt) {
        const float y3 = __shfl(imp3[kt], (F.lane + 48) & 63);
        const float prev = (fq > 0) ? y3 : y3prev; y3prev = y3;
        sc[fr * 33 + 4 * kt + fq] = impl[kt] + 0.5f * prev;
    }
    LDS_WAIT(); __builtin_amdgcn_wave_barrier(); asm volatile("" ::: "memory");
    const int blk_t = t >> 6, chi = blk_t - 2;
    unsigned mask = 1u | (1u << blk_t) | (blk_t > 0 ? (1u << (blk_t - 1)) : 0u);
#pragma unroll
    for (int kt = 0; kt < 8; ++kt) {
        const int k = 4 * kt + fq;
        if (k >= 1 && k <= chi) { const float me = sc[fr * 33 + k]; int rank = 0;
            for (int k2 = 1; k2 <= chi; ++k2) { const float o = sc[fr * 33 + k2]; rank += (o > me || (o == me && k2 < k)) ? 1 : 0; }
            if (rank < 5) mask |= (1u << k); }
    }
    mask |= (unsigned)__shfl_xor((int)mask, 16); mask |= (unsigned)__shfl_xor((int)mask, 32);
    if (fq == 0) ((unsigned*)(F.ws + WS_SELMASK))[(size_t)bg * SEQ + t] = mask;
    LDS_WAIT(); __builtin_amdgcn_wave_barrier(); asm volatile("" ::: "memory");
}
__device__ __forceinline__ void p3_phase(Frame& F) {
    constexpr int T0 = 2048, T1 = T0 + 8192;
#ifdef DUP_P3A
    for (int task = F.gw; task < T0; task += F.NGW) { __syncthreads(); nsa_cmp_stage(F, task >> 7); LDS_WAIT(); __syncthreads(); nsa_cmp_task<DUP_P3A>(F, task); }
    asm volatile("" ::: "memory");
#endif
    for (int task = F.gw; task < T0; task += F.NGW) { __syncthreads(); nsa_cmp_stage(F, task >> 7); LDS_WAIT(); __syncthreads(); nsa_cmp_task<0>(F, task); }
    asm volatile("" ::: "memory");
    const int h = F.vcu & 7;
    LAS float* par = (LAS float*)(F.lds + F.wave * 4096 + 2048);
    __syncthreads();
    prep_fill_par(F, par, h); prep_stage_w(F, h);
    LDS_WAIT(); __syncthreads();
#ifdef DUP_P3B
    for (int i = F.wave; i < 32; i += 8) rwkv_prep_task(F, (((F.vcu >> 3) + 32 * i) << 3) | h, par);
    asm volatile("" ::: "memory");
#endif
    for (int i = F.wave; i < 32; i += 8) rwkv_prep_task(F, (((F.vcu >> 3) + 32 * i) << 3) | h, par);
}

constexpr int NSA_KP = 144, NSA_VP = 136, NSA_BUF = 64 * NSA_KP + 64 * NSA_VP, NSA_CTL = 2 * NSA_BUF + 1024;
struct NsaState { f32x4 O[2][4]; float mrun[2], lrun[2]; };
template <int WHICH, bool MASKED>
__device__ __forceinline__ void nsa_block(NsaState& St, const LAS unsigned char* kb_, const LAS unsigned char* vb_, const bf16x8 (&qf)[2][2], int kb, unsigned mymask, int t, int fq, float slope0) {
    const int kpos0 = 64 * kb;
    bf16x8 kf[4][2];
#pragma unroll
    for (int kt = 0; kt < 4; ++kt) { kf[kt][0] = *(const LAS bf16x8*)(kb_ + 16 * kt * NSA_KP); kf[kt][1] = *(const LAS bf16x8*)(kb_ + 16 * kt * NSA_KP + 64); }
    const bool bsel = (mymask >> kb) & 1u; const int dbase = t - 4 * fq - kpos0;
    const float fdb = (float)dbase;
    bf16x8 P[2][2];
#pragma unroll
    for (int r = 0; r < 2; ++r) {
        const float slope = r ? 0.5f * slope0 : slope0;
        float s[4][4]; float bm = -1e30f;
        float base = -slope * fdb;
        const float s1 = slope, s2_ = 2.0f * slope, s3 = 3.0f * slope, s16 = 16.0f * slope;
#pragma unroll
        for (int kt = 0; kt < 4; ++kt) { f32x4 a = (f32x4){base, base + s1, base + s2_, base + s3}; base += s16;
            a = MFMA16(kf[kt][0], qf[r][0], a); a = MFMA16(kf[kt][1], qf[r][1], a);
#pragma unroll
            for (int rg = 0; rg < 4; ++rg) {
                if (MASKED) { const int dist = dbase - (16 * kt + rg); const bool valid = bsel && dist >= 0 && (WHICH == 0 || dist < 512); s[kt][rg] = valid ? a[rg] : -1e30f; }
                else s[kt][rg] = a[rg];
                bm = fmaxf(bm, s[kt][rg]); } }
        bm = fmaxf(bm, __shfl_xor(bm, 16)); bm = fmaxf(bm, __shfl_xor(bm, 32));
        const float mnew = fmaxf(St.mrun[r], bm); const float scale = __builtin_amdgcn_exp2f(St.mrun[r] - mnew); St.mrun[r] = mnew;
        float ps = 0.f;
#pragma unroll
        for (int kt = 0; kt < 4; ++kt)
#pragma unroll
            for (int rg = 0; rg < 4; ++rg) { float p = __builtin_amdgcn_exp2f(s[kt][rg] - mnew); if (MASKED) p = (s[kt][rg] > -1e29f) ? p : 0.f; s[kt][rg] = p; ps += p; }
        St.lrun[r] = St.lrun[r] * scale + ps;
#pragma unroll
        for (int dt = 0; dt < 4; ++dt) St.O[r][dt] = St.O[r][dt] * scale;
#pragma unroll
        for (int s2 = 0; s2 < 2; ++s2) { v4u pw; pw.x = pk2(s[2 * s2][0], s[2 * s2][1]); pw.y = pk2(s[2 * s2][2], s[2 * s2][3]); pw.z = pk2(s[2 * s2 + 1][0], s[2 * s2 + 1][1]); pw.w = pk2(s[2 * s2 + 1][2], s[2 * s2 + 1][3]);
            P[r][s2] = __builtin_bit_cast(bf16x8, pw); }
    }
#pragma unroll
    for (int dt = 0; dt < 4; ++dt)
#pragma unroll
        for (int s2 = 0; s2 < 2; ++s2) { const LAS unsigned char* vp = vb_ + 16 * dt * NSA_VP + 64 * s2; const v2u lo = *(const LAS v2u*)vp, hi = *(const LAS v2u*)(vp + 32);
            v4u aw; aw.x = lo.x; aw.y = lo.y; aw.z = hi.x; aw.w = hi.y; const bf16x8 vf = __builtin_bit_cast(bf16x8, aw);
#pragma unroll
            for (int r = 0; r < 2; ++r) St.O[r][dt] = MFMA16(vf, P[r][s2], St.O[r][dt]); }
}
template <int WHICH>
__device__ __forceinline__ void nsa_wg_task(Frame& F, int item) {
    const int hp = item & 1, bg = item >> 5, tg = (item >> 1) & 15, b = bg >> 1, g = bg & 1;
    const int fr = F.lane & 15, fq = F.lane >> 4, tile = tg * 8 + F.wave, t0 = tile * 16, t = t0 + fr, m = b * SEQ + t;
    const int h0 = g * 4 + 2 * hp;
    const bf16* z = (const bf16*)(F.ws + WS_Z);
    const bf16* Kb = z + (size_t)b * SEQ * NZ + (WHICH ? ZC_KW : ZC_KS) + g * 64;
    const bf16* VT = (const bf16*)(F.ws + (WHICH ? WS_VWT : WS_VST)) + (size_t)bg * 64 * SEQ;
    unsigned mymask, tile_or, full; const int kb_hi = (t0 + 15) >> 6;
    if (WHICH == 0) { mymask = ((const unsigned*)(F.ws + WS_SELMASK))[(size_t)bg * SEQ + t]; unsigned x = mymask, y = mymask;
        x |= (unsigned)__shfl_xor((int)x, 1); x |= (unsigned)__shfl_xor((int)x, 2); x |= (unsigned)__shfl_xor((int)x, 4); x |= (unsigned)__shfl_xor((int)x, 8);
        y &= (unsigned)__shfl_xor((int)y, 1); y &= (unsigned)__shfl_xor((int)y, 2); y &= (unsigned)__shfl_xor((int)y, 4); y &= (unsigned)__shfl_xor((int)y, 8);
        tile_or = (unsigned)__builtin_amdgcn_readfirstlane((int)x); full = (unsigned)__builtin_amdgcn_readfirstlane((int)y) & ((1u << kb_hi) - 1u); }
    else { mymask = 0xffffffffu; const int lo = (t0 - 511) > 0 ? ((t0 - 511) >> 6) : 0; tile_or = 0u; full = 0u;
        for (int k = lo; k <= kb_hi; ++k) { tile_or |= (1u << k); if (k < kb_hi && 64 * k >= t0 - 496) full |= (1u << k); } }
    tile_or &= (kb_hi >= 31) ? 0xffffffffu : ((2u << kb_hi) - 1u);
    LAS unsigned* ctl = (LAS unsigned*)(F.lds + NSA_CTL);
    __syncthreads();
    if (F.lane == 0) ctl[F.wave] = tile_or;
    LDS_WAIT(); __syncthreads();
    unsigned rem = 0u;
#pragma unroll
    for (int w = 0; w < 8; ++w) rem |= ctl[w];
    rem = (unsigned)__builtin_amdgcn_readfirstlane((int)rem);
    bf16x8 qf[2][2];
#pragma unroll
    for (int r = 0; r < 2; ++r)
#pragma unroll
        for (int ks = 0; ks < 2; ++ks) { const v4u raw = *(const v4u*)(z + (size_t)m * NZ + ZC_Q + (h0 + r) * 64 + 8 * fq + 32 * ks); float f[8]; unpk8(raw, f);
            constexpr float QS = 0.125f * 1.4426950408889634f; v4u w; w.x = pk2(f[0] * QS, f[1] * QS); w.y = pk2(f[2] * QS, f[3] * QS); w.z = pk2(f[4] * QS, f[5] * QS); w.w = pk2(f[6] * QS, f[7] * QS);
            qf[r][ks] = __builtin_bit_cast(bf16x8, w); }
    NsaState St;
#pragma unroll
    for (int r = 0; r < 2; ++r) { St.mrun[r] = -1e30f; St.lrun[r] = 0.f;
#pragma unroll
        for (int dt = 0; dt < 4; ++dt) St.O[r][dt] = (f32x4){0.f, 0.f, 0.f, 0.f}; }
    const float slope0 = 1.4426950408889634f * __uint_as_float((unsigned)(127 - (h0 + 1)) << 23);
    const int srow = F.tid >> 3, sc = F.tid & 7;
    const bf16* ksrc = Kb + (size_t)srow * NZ + sc * 8; const bf16* vsrc = VT + (size_t)srow * SEQ + sc * 8;
    const int kdst = srow * NSA_KP + sc * 16, vdst = 64 * NSA_KP + srow * NSA_VP + sc * 16;
    const LAS unsigned char* kfr = F.lds + fr * NSA_KP + 16 * fq; const LAS unsigned char* vfr = F.lds + 64 * NSA_KP + fr * NSA_VP + 8 * fq;
    int kb = __builtin_ctz(rem); rem &= rem - 1u;
    v4u kreg = *(const v4u*)(ksrc + (size_t)64 * kb * NZ), vreg = *(const v4u*)(vsrc + 64 * kb);
    *(LAS v4u*)(F.lds + kdst) = kreg; *(LAS v2u*)(F.lds + vdst) = (v2u){vreg.x, vreg.y}; *(LAS v2u*)(F.lds + vdst + 8) = (v2u){vreg.z, vreg.w};
    LDS_WAIT(); __syncthreads();
    int buf = 0;
    for (;;) {
        int kbn = -1;
        if (rem) { kbn = __builtin_ctz(rem); rem &= rem - 1u; kreg = *(const v4u*)(ksrc + (size_t)64 * kbn * NZ); vreg = *(const v4u*)(vsrc + 64 * kbn); }
        __builtin_amdgcn_sched_barrier(0);
        if ((tile_or >> kb) & 1u) {
            if ((full >> kb) & 1u) nsa_block<WHICH, false>(St, kfr + buf * NSA_BUF, vfr + buf * NSA_BUF, qf, kb, mymask, t, fq, slope0);
            else nsa_block<WHICH, true>(St, kfr + buf * NSA_BUF, vfr + buf * NSA_BUF, qf, kb, mymask, t, fq, slope0);
        }
        __builtin_amdgcn_sched_barrier(0);
        if (kbn < 0) break;
        buf ^= 1;
        *(LAS v4u*)(F.lds + buf * NSA_BUF + kdst) = kreg; *(LAS v2u*)(F.lds + buf * NSA_BUF + vdst) = (v2u){vreg.x, vreg.y}; *(LAS v2u*)(F.lds + buf * NSA_BUF + vdst + 8) = (v2u){vreg.z, vreg.w};
        LDS_WAIT(); __syncthreads();
        kb = kbn;
    }
    const float* zg = (const float*)(F.ws + WS_ZGATE); const float* gb = F.ap->in[21];
    bf16* Y = (bf16*)(F.ws + WS_YB + (size_t)(1 + WHICH) * 16 * MiB);
#pragma unroll
    for (int r = 0; r < 2; ++r) { float l = St.lrun[r]; l += __shfl_xor(l, 16); l += __shfl_xor(l, 32);
        const int hh = h0 + r; const float gate = sigmoidf_(zg[(size_t)m * 32 + hh * 3 + 1 + WHICH] + gb[hh * 3 + 1 + WHICH]); const float f = gate / l;
#pragma unroll
        for (int dt = 0; dt < 4; ++dt) *(v2u*)(Y + (size_t)m * 512 + hh * 64 + 16 * dt + 4 * fq) = pk4(St.O[r][dt] * f); }
}
__device__ __forceinline__ void p4_phase(Frame& F) {
    for (int it = F.vcu; it < 512; it += F.G) { nsa_wg_task<1>(F, it); nsa_wg_task<0>(F, 511 - it); }
}

typedef short v4i16_t __attribute__((ext_vector_type(4)));
__device__ __forceinline__ bf16x8 tr_lo(const LAS unsigned char* p) {
    const v4i16_t t = __builtin_amdgcn_ds_read_tr16_b64_v4i16((LAS v4i16_t*)p);
    return (bf16x8){t[0], t[1], t[2], t[3], 0, 0, 0, 0};
}
__device__ __forceinline__ bf16x8 lo4(v2u g) { v4u w; w.x = g.x; w.y = g.y; w.z = 0u; w.w = 0u; return __builtin_bit_cast(bf16x8, w); }
__device__ __forceinline__ bf16x8 cat8(v2u a, v2u b) { v4u w; w.x = a.x; w.y = a.y; w.z = b.x; w.w = b.y; return __builtin_bit_cast(bf16x8, w); }
struct ChunkOps { v2u pA[2][2], rA[2][2], g[4]; f32x4 ac[4]; bf16x8 aq[4], ak[4], bv; };
__device__ __forceinline__ void chunk_load(const LAS unsigned char* sl, ChunkOps& X, int lane) {
    const int fr = lane & 15, fq = lane >> 4;
#pragma unroll
    for (int m = 0; m < 2; ++m) { X.pA[m][0] = *(const LAS v2u*)(sl + CH_P + fr * CH_PP + 64 * m + 8 * fq); X.pA[m][1] = *(const LAS v2u*)(sl + CH_P + fr * CH_PP + 64 * m + 32 + 8 * fq);
        X.rA[m][0] = *(const LAS v2u*)(sl + CH_R + fr * CH_PP + 64 * m + 8 * fq); X.rA[m][1] = *(const LAS v2u*)(sl + CH_R + fr * CH_PP + 64 * m + 32 + 8 * fq); }
#pragma unroll
    for (int x = 0; x < 4; ++x) X.g[x] = *(const LAS v2u*)(sl + CH_G + 512 * x + (fr * 16 + 4 * fq) * 2);
    X.bv = tr_lo(sl + CH_V + 8 * lane);
#pragma unroll
    for (int jt = 0; jt < 4; ++jt) { X.aq[jt] = tr_lo(sl + CH_Q + jt * 512 + 8 * lane); X.ak[jt] = tr_lo(sl + CH_K + jt * 512 + 8 * lane);
        X.ac[jt] = *(const LAS f32x4*)(sl + CH_AC + (16 * jt + 4 * fq) * 4); }
}
__device__ __forceinline__ bf16x8 lo4t(bf16x8 t) { return t; }
__device__ __forceinline__ void chunk_math(const ChunkOps& X, f32x4 (&S)[4], f32x4& o_out) {
    bf16x8 bs[2];
#pragma unroll
    for (int m = 0; m < 2; ++m) { v4u w; w.x = pk2(S[2 * m][0], S[2 * m][1]); w.y = pk2(S[2 * m][2], S[2 * m][3]); w.z = pk2(S[2 * m + 1][0], S[2 * m + 1][1]); w.w = pk2(S[2 * m + 1][2], S[2 * m + 1][3]); bs[m] = __builtin_bit_cast(bf16x8, w); }
    const f32x4 z4 = (f32x4){0.f, 0.f, 0.f, 0.f};
    const bf16x8 bv = lo4t(X.bv);
    f32x4 y = MFMA16(cat8(X.pA[0][0], X.pA[0][1]), bs[0], z4); y = MFMA16(cat8(X.pA[1][0], X.pA[1][1]), bs[1], y); y = MFMA16(lo4(X.g[0]), bv, y);
    f32x4 o = MFMA16(cat8(X.rA[0][0], X.rA[0][1]), bs[0], z4); o = MFMA16(cat8(X.rA[1][0], X.rA[1][1]), bs[1], o); o = MFMA16(lo4(X.g[3]), bv, o);
    const bf16x8 by = lo4(pk4(y));
    const f32x4 u = MFMA16(lo4(X.g[1]), by, z4);
    const bf16x8 bu = lo4(pk4(u));
    o_out = MFMA16(lo4(X.g[2]), bu, o);
#pragma unroll
    for (int jt = 0; jt < 4; ++jt) { S[jt] = MFMA16(lo4t(X.aq[jt]), bu, S[jt]); S[jt] = MFMA16(lo4t(X.ak[jt]), bv, S[jt]); S[jt] = S[jt] * X.ac[jt]; }
}
#ifndef SC_CONVW
#define SC_CONVW 3
#endif
constexpr int SC_NS = 7, SC_AHEAD = 5, SC_CTL = SC_NS * CH_SLOT, SCAN_TR_OFF = 81920;
__device__ __forceinline__ void scan_dma(const unsigned char* rec, const bf16* vt, LAS unsigned char* slot, int lane) {
#pragma unroll
    for (int i = 0; i < 10; ++i) __builtin_amdgcn_global_load_lds((const unsigned*)(rec + (lane + 64 * i) * 16), (LAS unsigned*)(slot + i * 1024), 16, 0, 0);
    if (lane < 48) __builtin_amdgcn_global_load_lds((const unsigned*)(rec + (lane + 640) * 16), (LAS unsigned*)(slot + 10240), 16, 0, 0);
    if (lane < 32) __builtin_amdgcn_global_load_lds((const unsigned*)(vt + (size_t)(lane >> 1) * 512 + 8 * (lane & 1)), (LAS unsigned*)(slot + CH_V), 16, 0, 0);
}
__device__ __forceinline__ int sc_ld(LAS int* p) { int v; const unsigned a = (unsigned)(size_t)p; asm volatile("ds_read_b32 %0, %1\n\ts_waitcnt lgkmcnt(0)" : "=&v"(v) : "v"(a) : "memory"); return v; }
__device__ __forceinline__ void sc_st(LAS int* p, int v) { const unsigned a = (unsigned)(size_t)p; asm volatile("ds_write_b32 %0, %1" :: "v"(a), "v"(v) : "memory"); }
#define SC_LD(p) sc_ld(p)
#define SC_ST(p, v) sc_st((p), (v))
__device__ __forceinline__ void p5_scan(Frame& F, bool extras = true, int abl = 0) {
    LAS int* ctl = (LAS int*)(F.lds + SC_CTL);
    if (F.tid < 4) ctl[F.tid] = 0;
    LDS_WAIT(); __syncthreads();
    constexpr int NKQ = (tri::NITEMS - tri::E12) / 256;
    LAS float* mytile = (LAS float*)(F.lds + SCAN_TR_OFF + F.wave * 8448);
    const int bh = F.vcu >> 2, b = bh >> 3, h = bh & 7, i0 = (F.vcu & 3) * 16;
    if (F.wave == 0) {
        if (abl & 1) return;
        __builtin_amdgcn_s_setprio(3);
        float* o0 = (float*)(F.ws + WS_XN) + (size_t)b * SEQ * 512 + h * 64 + i0;
        const int fr = F.lane & 15, fq = F.lane >> 4;
        f32x4 S[4];
#pragma unroll
        for (int jt = 0; jt < 4; ++jt) S[jt] = (f32x4){0.f, 0.f, 0.f, 0.f};
        ChunkOps XA, XB;
        while (SC_LD(&ctl[0]) <= 0) __builtin_amdgcn_s_sleep(1);
        asm volatile("" ::: "memory");
        chunk_load(F.lds, XA, F.lane);
        LDS_WAIT(); asm volatile("" ::: "memory");
        if (F.lane == 0) SC_ST(&ctl[1], 1);
#define SCAN_ITER(XC, XN_, c_) do { const int cc = (c_); \
            if (cc + 1 < 128) { while (SC_LD(&ctl[0]) <= cc + 1) __builtin_amdgcn_s_sleep(1); asm volatile("" ::: "memory"); chunk_load(F.lds + ((cc + 1) % SC_NS) * CH_SLOT, XN_, F.lane); } \
            __builtin_amdgcn_sched_barrier(0); \
            f32x4 o; chunk_math(XC, S, o); \
            __builtin_amdgcn_sched_barrier(0); \
            float* orow = o0 + (size_t)cc * 16 * 512; \
            _Pragma("unroll") for (int rg = 0; rg < 4; ++rg) { float* pp = orow + (size_t)(4 * fq + rg) * 512 + fr; const float vv = o[rg]; asm volatile("global_store_dword %0, %1, off" :: "v"(pp), "v"(vv) : "memory"); } \
            if (cc + 1 < 128) { LDS_WAIT(); asm volatile("" ::: "memory"); if (F.lane == 0) SC_ST(&ctl[1], cc + 2); } } while (0)
#pragma unroll 1
        for (int c = 0; c < 128; c += 2) { SCAN_ITER(XA, XB, c); SCAN_ITER(XB, XA, c + 1); }
#undef SCAN_ITER
        asm volatile("s_waitcnt vmcnt(0)" ::: "memory");
        __builtin_amdgcn_s_setprio(0);
        if (F.lane == 0) SC_ST(&ctl[3], 1);
        if (!(abl & 2)) tr_run_q(F, mytile, &ctl[2], tri::E12 + F.vcu, F.G, NKQ);
    } else if (F.wave == 1) {
        if (abl & 1) return;
        const unsigned char* rec0 = F.ws + WS_S + ((size_t)(b * 128) * 8 + h) * CH_REC;
        const bf16* vt0 = (const bf16*)F.out + (size_t)b * SEQ * 512 + h * 64 + i0;
        for (int n = 0; n < 128; ++n) {
            while (SC_LD(&ctl[1]) < n - SC_NS + 1) __builtin_amdgcn_s_sleep(1);
            asm volatile("" ::: "memory");
            scan_dma(rec0 + (size_t)n * 8 * CH_REC, vt0 + (size_t)n * 16 * 512, F.lds + (n % SC_NS) * CH_SLOT, F.lane);
            if (n >= SC_AHEAD) { asm volatile("s_waitcnt vmcnt(60)" ::: "memory"); if (F.lane == 0) SC_ST(&ctl[0], n - SC_AHEAD + 1); }
        }
        asm volatile("s_waitcnt vmcnt(48)" ::: "memory"); if (F.lane == 0) SC_ST(&ctl[0], 124);
        asm volatile("s_waitcnt vmcnt(36)" ::: "memory"); if (F.lane == 0) SC_ST(&ctl[0], 125);
        asm volatile("s_waitcnt vmcnt(24)" ::: "memory"); if (F.lane == 0) SC_ST(&ctl[0], 126);
        asm volatile("s_waitcnt vmcnt(12)" ::: "memory"); if (F.lane == 0) SC_ST(&ctl[0], 127);
        asm volatile("s_waitcnt vmcnt(0)" ::: "memory"); if (F.lane == 0) SC_ST(&ctl[0], 128);
        if (!(abl & 2)) { while (SC_LD(&ctl[3]) == 0) __builtin_amdgcn_s_sleep(8); tr_run_q(F, mytile, &ctl[2], tri::E12 + F.vcu, F.G, NKQ); }
    } else {
        const int w2 = F.vcu * 6 + (F.wave - 2), NW2 = F.G * 6;
        if (!(abl & 2) && F.wave - 2 < SC_CONVW) tr_run_q(F, mytile, &ctl[2], tri::E12 + F.vcu, F.G, NKQ);
        if (!extras) return;
        for (int mb = w2; mb < M; mb += 4 * NW2) {
            v4u a0[4], a1[4], a2[4];
#pragma unroll
            for (int u = 0; u < 4; ++u) { const int mr = (mb + u * NW2 < M) ? mb + u * NW2 : mb; const bf16* y0 = (const bf16*)(F.ws + WS_YB) + (size_t)mr * 512 + 8 * F.lane; a0[u] = *(const v4u*)y0; a1[u] = *(const v4u*)(y0 + 8 * MiB); a2[u] = *(const v4u*)(y0 + 16 * MiB); }
#pragma unroll
            for (int u = 0; u < 4; ++u) { float f0[8], f1[8], f2[8]; unpk8(a0[u], f0); unpk8(a1[u], f1); unpk8(a2[u], f2);
                v4u w; w.x = pk2(f0[0] + f1[0] + f2[0], f0[1] + f1[1] + f2[1]); w.y = pk2(f0[2] + f1[2] + f2[2], f0[3] + f1[3] + f2[3]); w.z = pk2(f0[4] + f1[4] + f2[4], f0[5] + f1[5] + f2[5]); w.w = pk2(f0[6] + f1[6] + f2[6], f0[7] + f1[7] + f2[7]);
                if (mb + u * NW2 < M) *(v4u*)((bf16*)(F.ws + WS_YB) + (size_t)(mb + u * NW2) * 512 + 8 * F.lane) = w; } }
        const float* p = F.ap->in[1]; bf16* PB = (bf16*)(F.ws + WS_PBF);
        constexpr size_t NV = (size_t)M * 256 / 4;
        for (size_t b0 = (size_t)w2 * 64 + F.lane; b0 < NV; b0 += (size_t)8 * NW2 * 64) {
            f32x4 pv[8];
#pragma unroll
            for (int i = 0; i < 8; ++i) { const size_t idx = b0 + (size_t)i * NW2 * 64; pv[i] = (idx < NV) ? *(const f32x4*)(p + idx * 4) : (f32x4){0.f, 0.f, 0.f, 0.f}; }
#pragma unroll
            for (int i = 0; i < 8; ++i) { const size_t idx = b0 + (size_t)i * NW2 * 64; if (idx < NV) *(v2u*)(PB + idx * 4) = pk4(pv[i]); } }
        if (!(abl & 2) && F.wave - 2 >= SC_CONVW) { while (SC_LD(&ctl[3]) == 0) __builtin_amdgcn_s_sleep(8); tr_run_q(F, mytile, &ctl[2], tri::E12 + F.vcu, F.G, NKQ); }
    }
}

struct P6Par { float lw[8], lb[8]; };
__device__ __forceinline__ void p6_rows2(Frame& F, int ma, int mb_, const P6Par& P) {
    const int l = F.lane, c = 8 * l, h = l >> 3;
    f32x4 oa[2][2]; v4u vv_[2], gg_[2]; float bsv[2];
#pragma unroll
    for (int u = 0; u < 2; ++u) { const int m = u ? mb_ : ma;
        const float* oraw = (const float*)(F.ws + WS_XN) + (size_t)m * 512 + c;
        oa[u][0] = *(const f32x4*)oraw; oa[u][1] = *(const f32x4*)(oraw + 4); bsv[u] = ((const float*)(F.ws + WS_BONUS))[(size_t)m * 8 + h];
        vv_[u] = *(const v4u*)((const bf16*)F.out + (size_t)m * 512 + c); gg_[u] = *(const v4u*)((const bf16*)(F.ws + WS_G) + (size_t)m * 512 + c);
    }
    __builtin_amdgcn_sched_barrier(0);
#pragma unroll
    for (int u = 0; u < 2; ++u) { const int m = u ? mb_ : ma;
        float o[8] = {oa[u][0].x, oa[u][0].y, oa[u][0].z, oa[u][0].w, oa[u][1].x, oa[u][1].y, oa[u][1].z, oa[u][1].w};
        float s = 0.f;
#pragma unroll
        for (int j = 0; j < 8; ++j) s += o[j];
        s += __shfl_xor(s, 1); s += __shfl_xor(s, 2); s += __shfl_xor(s, 4);
        const float mu = s * (1.f / 64.f); float q = 0.f;
#pragma unroll
        for (int j = 0; j < 8; ++j) { o[j] -= mu; q += o[j] * o[j]; }
        q += __shfl_xor(q, 1); q += __shfl_xor(q, 2); q += __shfl_xor(q, 4);
        const float rstd = 1.0f / sqrtf(q * (1.f / 64.f) + GN_EPS);
        float vv[8], gg[8];
        unpk8(vv_[u], vv); unpk8(gg_[u], gg);
        const float bs = bsv[u];
        float y[8];
#pragma unroll
        for (int j = 0; j < 8; ++j) y[j] = (o[j] * rstd * P.lw[j] + P.lb[j] + bs * vv[j]) * gg[j];
        v4u w; w.x = pk2(y[0], y[1]); w.y = pk2(y[2], y[3]); w.z = pk2(y[4], y[5]); w.w = pk2(y[6], y[7]);
        *(v4u*)((bf16*)(F.ws + WS_YRW) + (size_t)m * 512 + c) = w;
    }
}
__device__ __forceinline__ void p6_phase(Frame& F) {
    const int l = F.lane, c = 8 * l;
    P6Par P;
#pragma unroll
    for (int j = 0; j < 8; ++j) { P.lw[j] = F.ap->in[13][c + j]; P.lb[j] = F.ap->in[14][c + j]; }
    for (int m = F.gw; m < M; m += 2 * F.NGW) p6_rows2(F, m, m + F.NGW, P);
}

struct RouteW { f32x4 wv[3][8]; };
__device__ __forceinline__ void route_ldx(Frame& F, int tile, v4u (&xv)[4]) {
    const int fr = F.lane & 15, fq = F.lane >> 4; const bf16* xp = (const bf16*)(F.ws + WS_Z) + (size_t)(tile * 16 + fr) * D + F.wave * 128 + 8 * fq;
#pragma unroll
    for (int g = 0; g < 4; ++g) xv[g] = *(const v4u*)(xp + 32 * g);
}
__device__ __forceinline__ void route_tile(Frame& F, int tile, const RouteW& W, const v4u (&xv_)[4], int par, const f32x4 (&gr)[4]) {
    const int fr = F.lane & 15, fq = F.lane >> 4, m0 = tile * 16;
    const bf16* x1 = (const bf16*)(F.ws + WS_Z);
    v2u rv[2][4];
#pragma unroll
    for (int i = 0; i < 2; ++i) { const v2u* xr = (const v2u*)(x1 + (size_t)(m0 + 2 * F.wave + i) * D) + F.lane;
#pragma unroll
        for (int j = 0; j < 4; ++j) rv[i][j] = xr[64 * j]; }
    f32x4 acc[3] = {(f32x4){0.f, 0.f, 0.f, 0.f}, (f32x4){0.f, 0.f, 0.f, 0.f}, (f32x4){0.f, 0.f, 0.f, 0.f}};
    float ssq = 0.f;
#pragma unroll
    for (int g2 = 0; g2 < 4; ++g2) {
        float xf[8]; unpk8(xv_[g2], xf);
#pragma unroll
        for (int hh = 0; hh < 2; ++hh) { const int g = 2 * g2 + hh;
            ssq += (xf[4 * hh] * xf[4 * hh] + xf[4 * hh + 1] * xf[4 * hh + 1]) + (xf[4 * hh + 2] * xf[4 * hh + 2] + xf[4 * hh + 3] * xf[4 * hh + 3]);
#pragma unroll
            for (int s = 0; s < 4; ++s)
#pragma unroll
                for (int ct = 0; ct < 3; ++ct) acc[ct] = __builtin_amdgcn_mfma_f32_16x16x4f32(W.wv[ct][g][s], xf[4 * hh + s], acc[ct], 0, 0, 0); }
    }
    ssq += __shfl_xor(ssq, 16); ssq += __shfl_xor(ssq, 32);
    LAS float* red = (LAS float*)(F.lds + par * 32768);
    LAS float* ssqb = red + 8 * 3 * 64 * 4; LAS float* rsb = ssqb + 128;
#pragma unroll
    for (int ct = 0; ct < 3; ++ct) *(LAS f32x4*)(red + ((F.wave * 3 + ct) * 64 + F.lane) * 4) = acc[ct];
    if (fq == 0) ssqb[F.wave * 16 + fr] = ssq;
    LDS_WAIT(); __syncthreads();
    { float st = 0.f;
#pragma unroll
      for (int w = 0; w < 8; ++w) st += ssqb[w * 16 + (F.lane & 15)];
      const float rs = 1.0f / sqrtf(st * (1.f / D) + NORM_EPS);
      if (F.wave == 0) {
#pragma unroll
          for (int ct = 0; ct < 3; ++ct) { f32x4 t = (f32x4){0.f, 0.f, 0.f, 0.f};
#pragma unroll
              for (int w = 0; w < 8; ++w) t = t + *(const LAS f32x4*)(red + ((w * 3 + ct) * 64 + F.lane) * 4);
              *(f32x4*)((float*)(F.ws + WS_LOGITS) + (size_t)(m0 + fr) * 48 + 16 * ct + 4 * fq) = t * rs; } }
      bf16* XN = (bf16*)(F.ws + WS_XN);
#pragma unroll
      for (int i = 0; i < 2; ++i) { const int rr = 2 * F.wave + i; const float rsr = __shfl(rs, rr); v2u* o8 = (v2u*)(XN + (size_t)(m0 + rr) * D) + F.lane;
#pragma unroll
          for (int j = 0; j < 4; ++j) o8[64 * j] = pk4(unpk4(rv[i][j]) * rsr * gr[j]); } }
}
__device__ __forceinline__ void p9_phase(Frame& F, int rep_ = 0) {
    const int fr = F.lane & 15, fq = F.lane >> 4;
    RouteW W;
    { const float* wp = (const float*)(F.ws + WS_SMALLW + SW_ROUTEW) + (size_t)fr * D + F.wave * 128 + 8 * fq;
#pragma unroll
      for (int ct = 0; ct < 3; ++ct)
#pragma unroll
          for (int g = 0; g < 8; ++g) W.wv[ct][g] = *(const f32x4*)(wp + (size_t)ct * 16 * D + 32 * (g >> 1) + 4 * (g & 1)); }
    f32x4 gr[4];
#pragma unroll
    for (int j = 0; j < 4; ++j) gr[j] = ((const f32x4*)F.ap->in[25])[F.lane + 64 * j];
    v4u xa[4], xb[4];
    int tile = F.vcu, par = 0;
    if (tile < 1024) route_ldx(F, tile, xa);
    while (tile < 1024) {
        const int nt = tile + F.G;
        if (nt < 1024) route_ldx(F, nt, xb);
        __builtin_amdgcn_sched_barrier(0);
        route_tile(F, tile, W, xa, par, gr);
#pragma unroll
        for (int g = 0; g < 4; ++g) xa[g] = xb[g];
        tile = nt; par ^= 1;
    }
}

__device__ __forceinline__ void p9b_phase(Frame& F) {
    if (F.wave != 0) return;
    for (int base = F.vcu * 64; base < M; base += F.G * 64) {
        const int tok = base + F.lane;
        const float* lgp = (const float*)(F.ws + WS_LOGITS) + (size_t)tok * 48;
        float lg[36];
#pragma unroll
        for (int q = 0; q < 9; ++q) { const f32x4 v = *(const f32x4*)(lgp + 4 * q); lg[4 * q] = v.x; lg[4 * q + 1] = v.y; lg[4 * q + 2] = v.z; lg[4 * q + 3] = v.w; }
        const float* bg = F.ap->in[27]; const float* br = F.ap->in[29];
        float gl[4]; int gs = 0; float gm = -3.0e38f;
#pragma unroll
        for (int c = 0; c < 4; ++c) { gl[c] = lg[c] + bg[c]; if (gl[c] > gm) { gm = gl[c]; gs = c; } }
        float gsum = 0.f;
#pragma unroll
        for (int c = 0; c < 4; ++c) gsum += __expf(gl[c] - gm);
        const float pgroup = 1.0f / gsum;
        float el[8]; float em = -3.0e38f;
#pragma unroll
        for (int c = 0; c < 8; ++c) { const float lv = gs == 0 ? lg[4 + c] : (gs == 1 ? lg[12 + c] : (gs == 2 ? lg[20 + c] : lg[28 + c])); el[c] = lv + br[gs * 8 + c]; em = fmaxf(em, el[c]); }
        int i1 = 0; float v1 = -3.0e38f;
#pragma unroll
        for (int c = 0; c < 8; ++c) if (el[c] > v1) { v1 = el[c]; i1 = c; }
        int i2 = 0; float v2 = -3.0e38f;
#pragma unroll
        for (int c = 0; c < 8; ++c) if (c != i1 && el[c] > v2) { v2 = el[c]; i2 = c; }
        const float p1 = __expf(v1 - em), p2 = __expf(v2 - em);
        const float g1 = pgroup * p1 / (p1 + p2), g2 = pgroup * p2 / (p1 + p2);
        const int e1 = gs * 8 + i1, e2 = gs * 8 + i2;
        const unsigned long long lt = (1ull << F.lane) - 1ull;
        int r1 = 0, r2 = 0, mycnt = 0;
        for (int e = 0; e < 32; ++e) {
            const unsigned long long m1 = __ballot(e1 == e), m2 = __ballot(e2 == e);
            const int c1 = __popcll(m1), c2 = __popcll(m2);
            if (e1 == e) r1 = __popcll(m1 & lt);
            if (e2 == e) r2 = c1 + __popcll(m2 & lt);
            if (F.lane == e) mycnt = c1 + c2;
        }
        unsigned* cnt = (unsigned*)(F.ws + WS_CTL) + CW_CNT; int* list = (int*)(F.ws + WS_LIST); float* gateA = (float*)(F.ws + WS_GATEA); unsigned* slotA = (unsigned*)(F.ws + WS_SLOTA);
        int bs = 0;
        if (F.lane < 32 && mycnt > 0) bs = (int)atomicAdd(&cnt[F.lane], (unsigned)mycnt);
        const unsigned q1 = (unsigned)(__shfl(bs, e1) + r1), q2 = (unsigned)(__shfl(bs, e2) + r2);
        gateA[tok * 2 + 0] = g1; gateA[tok * 2 + 1] = g2;
        list[(size_t)e1 * 16384 + q1] = tok * 2 + 0; slotA[tok * 2 + 0] = ((unsigned)e1 << 16) | q1;
        list[(size_t)e2 * 16384 + q2] = tok * 2 + 1; slotA[tok * 2 + 1] = ((unsigned)e2 << 16) | q2;
    }
}

__device__ __forceinline__ void p12_rows2(Frame& F, int ma, int mb_, int prelane) {
    const unsigned* slotA = (const unsigned*)(F.ws + WS_SLOTA); const float* gateA = (const float*)(F.ws + WS_GATEA);
    unsigned sl[2][2]; float gt[2][2];
#pragma unroll
    for (int u = 0; u < 2; ++u) { const int m = u ? mb_ : ma; sl[u][0] = slotA[2 * m]; sl[u][1] = slotA[2 * m + 1]; gt[u][0] = gateA[2 * m]; gt[u][1] = gateA[2 * m + 1]; }
    f32x4 xv[2][4]; v2u cv[2][2][4], ev[2][4];
#pragma unroll
    for (int u = 0; u < 2; ++u) { const int m = u ? mb_ : ma;
        const bf16* x1 = (const bf16*)(F.ws + WS_Z) + (size_t)m * D; const bf16* er = (const bf16*)(F.ws + WS_S + 64 * MiB) + (size_t)m * D;
#pragma unroll
        for (int j = 0; j < 4; ++j) { const int o = 4 * F.lane + 256 * j; xv[u][j] = unpk4(*(const v2u*)(x1 + o)); ev[u][j] = *(const v2u*)(er + o); }
#pragma unroll
        for (int k = 0; k < 2; ++k) { const unsigned s = (unsigned)__builtin_amdgcn_readfirstlane((int)sl[u][k]); const int pre = __builtin_amdgcn_readlane(prelane, (int)(s >> 16));
            const bf16* cp = (const bf16*)(F.ws + WS_Z + 64 * MiB) + ((size_t)pre * 256 + (s & 0xffffu)) * D;
#pragma unroll
            for (int j = 0; j < 4; ++j) cv[u][k][j] = *(const v2u*)(cp + 4 * F.lane + 256 * j); } }
    __builtin_amdgcn_sched_barrier(0);
    float s2[2], se[2];
#pragma unroll
    for (int u = 0; u < 2; ++u) { s2[u] = 0.f; se[u] = 0.f;
#pragma unroll
        for (int j = 0; j < 4; ++j) { xv[u][j] = xv[u][j] + unpk4(cv[u][0][j]) * gt[u][0] + unpk4(cv[u][1][j]) * gt[u][1];
            s2[u] += (xv[u][j].x * xv[u][j].x + xv[u][j].y * xv[u][j].y) + (xv[u][j].z * xv[u][j].z + xv[u][j].w * xv[u][j].w);
            const f32x4 e = unpk4(ev[u][j]); se[u] += (e.x * e.x + e.y * e.y) + (e.z * e.z + e.w * e.w); } }
#pragma unroll
    for (int o = 1; o < 64; o <<= 1) {
#pragma unroll
        for (int u = 0; u < 2; ++u) { s2[u] += __shfl_xor(s2[u], o); se[u] += __shfl_xor(se[u], o); } }
    const float* gi = F.ap->in[34];
#pragma unroll
    for (int u = 0; u < 2; ++u) { const int m = u ? mb_ : ma;
        const float rs = 1.0f / sqrtf(s2[u] * (1.f / D) + NORM_EPS); const float rse = 1.0f / sqrtf(se[u] * (1.f / D) + NORM_EPS);
        bf16* x2 = (bf16*)(F.ws + WS_S) + (size_t)m * D; bf16* xn = (bf16*)(F.ws + WS_XN) + (size_t)m * D;
#pragma unroll
        for (int j = 0; j < 4; ++j) { const int o = 4 * F.lane + 256 * j; *(v2u*)(x2 + o) = pk4(xv[u][j]); *(v2u*)(xn + o) = pk4(xv[u][j] * rs * *(const f32x4*)(gi + o)); }
        bf16* erw = (bf16*)(F.ws + WS_S + 64 * MiB) + (size_t)m * D; const float* gpn = F.ap->in[33];
#pragma unroll
        for (int j = 0; j < 4; ++j) { const int o = 4 * F.lane + 256 * j; *(v2u*)(erw + o) = pk4(unpk4(ev[u][j]) * rse * *(const f32x4*)(gpn + o)); } }
}
__device__ __forceinline__ void p12_phase(Frame& F) {
    const unsigned* cnt = (const unsigned*)(F.ws + WS_CTL) + CW_CNT;
    int nt = (F.lane < 32) ? (((int)cnt[F.lane & 31] + 255) >> 8) : 0;
    int incl = nt;
#pragma unroll
    for (int o = 1; o < 32; o <<= 1) { const int v = __shfl_up(incl, o); if (F.lane >= o) incl += v; }
    const int prelane = incl - nt;
    for (int m = F.gw; m < M; m += 2 * F.NGW) p12_rows2(F, m, m + F.NGW, prelane);
}
__device__ __forceinline__ void p14_rows4(Frame& F, int mb) {
    const float* gf = F.ap->in[36];
    f32x4 v[4][4]; float s[4];
#pragma unroll
    for (int u = 0; u < 4; ++u) { const bf16* xr = (const bf16*)(F.ws + WS_Z) + (size_t)(mb + u * F.NGW) * D;
#pragma unroll
        for (int j = 0; j < 4; ++j) v[u][j] = unpk4(*(const v2u*)(xr + 4 * F.lane + 256 * j)); }
#pragma unroll
    for (int u = 0; u < 4; ++u) { s[u] = 0.f;
#pragma unroll
        for (int j = 0; j < 4; ++j) s[u] += (v[u][j].x * v[u][j].x + v[u][j].y * v[u][j].y) + (v[u][j].z * v[u][j].z + v[u][j].w * v[u][j].w); }
#pragma unroll
    for (int o = 1; o < 64; o <<= 1) {
#pragma unroll
        for (int u = 0; u < 4; ++u) s[u] += __shfl_xor(s[u], o); }
#pragma unroll
    for (int u = 0; u < 4; ++u) { const float rs = 1.0f / sqrtf(s[u] * (1.f / D) + NORM_EPS); float* orow = F.out + (size_t)(mb + u * F.NGW) * D;
#pragma unroll
        for (int j = 0; j < 4; ++j) { const int o = 4 * F.lane + 256 * j; *(f32x4*)(orow + o) = v[u][j] * rs * *(const f32x4*)(gf + o); } }
}

#ifndef MK_ONE_LAUNCH
#define MK_ONE_LAUNCH 1
#endif
constexpr int N_PHASES = 14;
__global__ void __launch_bounds__(NWAVES * 64, 2) mk_fwd(Args args) {
    extern __shared__ __attribute__((aligned(16))) unsigned char lds[];
    Frame F;
    F.lds = (LAS unsigned char*)lds;
    F.tid = threadIdx.x; F.lane = F.tid & 63; F.wave = __builtin_amdgcn_readfirstlane(F.tid >> 6);
    F.G = gridDim.x; { const int bx = blockIdx.x; F.vcu = (F.G % 8 == 0) ? (bx % 8) * (F.G / 8) + bx / 8 : bx; }
    F.gw = F.vcu * NWAVES + F.wave; F.NGW = F.G * NWAVES;
    F.ws = args.ws; F.out = args.out;
    F.ap = (ArgsP)__builtin_amdgcn_kernarg_segment_ptr();
    unsigned char* ws = args.ws;
    const int lo = args.ph_lo, hi = args.ph_hi;
#ifdef ONLY
#define IN(k) ((k) == ONLY && lo <= (k) && (k) < hi)
#else
#define IN(k) (lo <= (k) && (k) < hi)
#endif
#if MK_ONE_LAUNCH
    if (F.tid < 16) ((LAS unsigned*)(F.lds + MISC_OFF))[F.tid] = 0u;
    __syncthreads();
    XcdBarrier bar = xcd_barrier_post((unsigned*)(ws + WS_CTL) + CW_BAR, (volatile LAS unsigned*)(F.lds + MISC_OFF));
#define GRID_BAR(k) do { if (IN(k) && IN((k) + 1)) { if ((k) == 12) cg::this_grid().sync(); else xcd_barrier(bar); } } while (0)
#else
#define GRID_BAR(k) do { } while (0)
#endif
    LAS unsigned char* L = F.lds;
#ifdef PROBE_A
    unsigned long long* tsb = (unsigned long long*)(ws + WS_CTL + 32768);
    int n_st = 0;
#define STAMP() do { if (blockIdx.x == 0 && F.tid == 0) tsb[n_st] = __builtin_amdgcn_s_memrealtime(); ++n_st; } while (0)
    STAMP();
#else
#define STAMP() do { } while (0)
#endif
    const bf16* z = (const bf16*)(ws + WS_Z);

    if (IN(0)) { p0_prologue(F); } GRID_BAR(0); STAMP();

    if (IN(1)) {
        pg8::Gemm g{(const bf16*)(ws + WS_XN), (const bf16*)(ws + WS_WIN), M, NZ, D, nullptr}; pg8::StaticOrder S; S.init(M, NZ, F.G, (int)blockIdx.x);
        EpiStoreBf16 E{(bf16*)(ws + WS_Z), NZ};
        pg8::gemm_phase<EpiStoreBf16, pg8::StaticOrder, true, false>(L, g, S, E);
    } GRID_BAR(1); STAMP();

    if (IN(2)) { p2_prep(F); } GRID_BAR(2); STAMP();
    if (IN(3)) { p3_phase(F); } GRID_BAR(3); STAMP();
    if (IN(4)) { p4_phase(F); } GRID_BAR(4); STAMP();
    if (IN(5)) { if (F.G == 256) p5_scan(F); } GRID_BAR(5); STAMP();
    if (IN(6)) { p6_phase(F); } GRID_BAR(6); STAMP();

    if (IN(7)) {
        pg8::Gemm g{(const bf16*)(ws + WS_YRW), (const bf16*)(ws + WS_UR), 2 * M, 2 * D, 512, nullptr}; DualOrder S; S.S.init(M, D, F.G, (int)blockIdx.x);
        EpiMix E{z, (bf16*)(ws + WS_S), (bf16*)(ws + WS_S + 64 * MiB)};
        pg8::gemm_phase<EpiMix, DualOrder, true, false>(L, g, S, E);
    } GRID_BAR(7); STAMP();

    if (IN(8)) {
        pg8::Gemm g{(const bf16*)(ws + WS_S + 64 * MiB), (const bf16*)(ws + WS_WO), M, D, D, nullptr}; pg8::StaticOrder S; S.init(M, D, F.G, (int)blockIdx.x);
        EpiResBf16 E{F.ap->in[0], (bf16*)(ws + WS_Z)};
        pg8::gemm_phase<EpiResBf16, pg8::StaticOrder, true, false>(L, g, S, E);
    } GRID_BAR(8); STAMP();

    if (IN(9)) { p9_phase(F); xcd_barrier(bar); p9b_phase(F); } GRID_BAR(9); STAMP();

    if (IN(10)) {
        pg8::Gemm g{(const bf16*)(ws + WS_XN), (const bf16*)(ws + WS_WGU), M, 1024, D, (const int*)(ws + WS_LIST)};
        pg8::moe_fill_tab((LAS int*)(F.lds + MISC_OFF - 256), (const unsigned*)(ws + WS_CTL) + CW_CNT); LDS_WAIT(); __syncthreads();
        pg8::MoeOrder S{(const LAS int*)(F.lds + MISC_OFF - 256), F.G, (int)blockIdx.x, false};
        EpiMoe1 E{(bf16*)(ws + WS_S)};
        pg8::gemm_phase<EpiMoe1, pg8::MoeOrder, true, true>(L, g, S, E);
    } GRID_BAR(10); STAMP();

    if (IN(11)) {
#ifndef NO_MOE2
        { pg8::Gemm g{(const bf16*)(ws + WS_S), (const bf16*)(ws + WS_WD), M, 1024, 512, nullptr};
          pg8::moe_fill_tab((LAS int*)(F.lds + MISC_OFF - 256), (const unsigned*)(ws + WS_CTL) + CW_CNT); LDS_WAIT(); __syncthreads();
          pg8::MoeOrder S{(const LAS int*)(F.lds + MISC_OFF - 256), F.G, (int)blockIdx.x, true};
          EpiStoreBf16 E{(bf16*)(ws + WS_Z + 64 * MiB), D};
          pg8::gemm_phase<EpiStoreBf16, pg8::MoeOrder, true, false>(L, g, S, E); }
#endif
        { pg8::Gemm g2{(const bf16*)(ws + WS_PBF), (const bf16*)(ws + WS_WPP), M, D, 256, nullptr}; ErawOrder S2; S2.S.init(M, D, F.G, 0); S2.c = (int)blockIdx.x; S2.G = F.G;
          { const LAS int* tb = (const LAS int*)(F.lds + MISC_OFF - 256); const int units = 4 * (tb[31] + ((tb[63] + 255) >> 8)); int nh = units - 2 * F.G; nh = nh < 0 ? 0 : (nh > F.G - 1 ? F.G - 1 : nh); S2.nheavy = nh; }
          EpiStoreBf16 E2{(bf16*)(ws + WS_S + 64 * MiB), D};
          pg8::gemm_phase<EpiStoreBf16, ErawOrder, true, false>(L, g2, S2, E2); }
    } GRID_BAR(11); STAMP();

    if (IN(12)) { p12_phase(F); } GRID_BAR(12); STAMP();

    if (IN(13)) {
        pg8::Gemm g{(const bf16*)(ws + WS_XN), (const bf16*)(ws + WS_WPG), M, D, D, nullptr}; pg8::StaticOrder S; S.init(M, D, F.G, (int)blockIdx.x);
        EpiPleNorm E{(const bf16*)(ws + WS_S), (const bf16*)(ws + WS_S + 64 * MiB), F.ap->in[36], F.out, (float*)(ws + WS_ZGATE), (unsigned*)(ws + WS_CTL) + CW_PANEL, (LAS float*)(F.lds + 131072)};
        pg8::gemm_phase<EpiPleNorm, pg8::StaticOrder, true, false>(L, g, S, E);
    } STAMP();

#ifdef PROBE_A
    xcd_barrier(bar); STAMP(); __threadfence();
    if (blockIdx.x == 0 && F.tid == 0) { __threadfence(); }
    xcd_barrier(bar);
    {
        volatile unsigned long long* tv = (volatile unsigned long long*)tsb;
        const float dA = (float)(tv[PROBE_A + 1] - tv[PROBE_A]) * 0.01f, dB = (float)(tv[PROBE_B + 1] - tv[PROBE_B]) * 0.01f;
        for (size_t i = (size_t)blockIdx.x * 512 + F.tid; i < (size_t)M * D; i += (size_t)F.G * 512) F.out[i] = 10.0f * dB;
        __syncthreads();
        if (blockIdx.x == 0 && F.tid == 0) F.out[0] = 300.0f * dA;
    }
#endif
#undef IN
#undef GRID_BAR
}

extern "C" void kernel_launch(void* const* d_in, const int* in_sizes, int n_in, void* d_out, int out_size, void* d_ws, size_t ws_size, hipStream_t stream) {
    static int grid = 0;
    if (grid == 0) {
        if (n_in != 37 || out_size != M * D || ws_size < WS_END) { fprintf(stderr, "kernel_launch: unexpected problem (n_in %d, out %d, ws %zu < %zu); nothing launched\n", n_in, out_size, ws_size, (size_t)WS_END); grid = -1; return; }
        int dev = 0, cus = 0, per_cu = 0;
        if (hipGetDevice(&dev) != hipSuccess || hipDeviceGetAttribute(&cus, hipDeviceAttributeMultiprocessorCount, dev) != hipSuccess) { grid = -1; return; }
        if (hipFuncSetAttribute((const void*)mk_fwd, hipFuncAttributeMaxDynamicSharedMemorySize, LDS_BYTES) != hipSuccess) { fprintf(stderr, "kernel_launch: hipFuncSetAttribute failed\n"); grid = -1; return; }
        if (hipOccupancyMaxActiveBlocksPerMultiprocessor(&per_cu, (const void*)mk_fwd, NWAVES * 64, LDS_BYTES) != hipSuccess || per_cu < 1) { fprintf(stderr, "kernel_launch: occupancy query says %d blocks per CU\n", per_cu); (void)hipGetLastError(); grid = -1; return; }
        grid = cus;
        if (grid != 256) fprintf(stderr, "kernel_launch: %d CUs; this kernel is built for 256\n", grid);
    }
    if (grid < 0) return;
    (void)hipMemsetAsync((char*)d_ws + WS_CTL, 0, CTL_ZERO_BYTES, stream);
    Args a{};
    for (int i = 0; i < 37; ++i) a.in[i] = (const float*)d_in[i];
    a.out = (float*)d_out; a.ws = (unsigned char*)d_ws;
#if MK_ONE_LAUNCH
    a.ph_lo = 0; a.ph_hi = N_PHASES;
    void* kargs[] = {&a};
    hipError_t e = hipLaunchCooperativeKernel((const void*)mk_fwd, dim3(grid), dim3(NWAVES * 64), kargs, LDS_BYTES, stream);
    if (e != hipSuccess) fprintf(stderr, "kernel_launch: cooperative launch failed: %s (grid %d)\n", hipGetErrorString(e), grid);
#else
    for (int ph = 0; ph < N_PHASES; ++ph) { a.ph_lo = ph; a.ph_hi = ph + 1; hipLaunchKernelGGL(mk_fwd, dim3(grid), dim3(NWAVES * 64), LDS_BYTES, stream, a); }
#endif
}
```

```cpp
#include <hip/hip_runtime.h>
#include <hip/hip_cooperative_groups.h>
#include <cstdio>
#include <cstdint>
namespace cg = cooperative_groups;

namespace pg8 {
#define PG8_LAS __attribute__((address_space(3)))
typedef unsigned short bf16_t;
typedef short bf16x8 __attribute__((ext_vector_type(8)));
typedef float f32x4 __attribute__((ext_vector_type(4)));
typedef unsigned u32x4 __attribute__((ext_vector_type(4)));
typedef unsigned u32x2 __attribute__((ext_vector_type(2)));
constexpr int BM = 256, BK = 64, HALF = 128, HTB = HALF * BK * 2  , STAGE_BYTES = 8 * HTB, NXCD = 8, WGM = 8;

__host__ __device__ __forceinline__ int lds_byte(int r, int c) { const int st = (r >> 4) * 2 + (c >> 5), rr = r & 15, cc = c & 31, ob = rr * 64 + cc * 2; return st * 1024 + (ob ^ (((ob >> 9) & 1) << 5)); }
__host__ __device__ __forceinline__ void stage_rc(int b, int& R, int& C) { const int st = b / 1024, sb = b % 1024, swz = sb ^ (((sb >> 9) & 1) << 5); R = (st >> 1) * 16 + swz / 64; C = (st & 1) * 32 + (swz % 64) / 2; }
__host__ __device__ __forceinline__ int perm32(int rho) { const int n = rho >> 4, i = rho & 15; return 8 * (i >> 2) + 4 * n + (i & 3); }

struct Unit { int pm, pn, pmo, lt, nvalid, pnl; };
struct Gemm { const bf16_t* A; const bf16_t* Bt; int M, N, K; const int* rowidx; const float* rowscale; };

struct StaticOrder {
    int nM, nN, nwg, G, c;
    __host__ __device__ void init(int M, int N, int G_, int c_) { nM = M / BM; nN = N / BM; nwg = nM * nN; G = G_; c = c_; }
    __host__ __device__ bool next(int i, Unit& u) const {
        const long L = (long)i * G + c; if (L >= nwg) return false;
        int wgid = (int)L; { const int q = nwg / NXCD, r = nwg % NXCD, xcd = wgid % NXCD, off = wgid / NXCD; wgid = (xcd < r ? xcd * (q + 1) : r * (q + 1) + (xcd - r) * q) + off; }
        const int nig = WGM * nN, gid = wgid / nig, fm = gid * WGM, gsz = (nM - fm) < WGM ? (nM - fm) : WGM;
        u.pm = fm + ((wgid % nig) % gsz); u.pn = (wgid % nig) / gsz; u.pmo = u.pm; u.lt = u.pm; u.nvalid = 256; u.pnl = u.pn; return true;
    }
};
struct MoeOrder {
    const PG8_LAS int* tab; int G, c; bool a_is_out;
    __device__ bool next(int i, Unit& u) const {
        const int L = i * G + c; const int tile = L >> 2, pnl = L & 3;
        const int lane = (int)__builtin_amdgcn_mbcnt_hi(~0u, __builtin_amdgcn_mbcnt_lo(~0u, 0u)), e_ = lane & 31;
        const int pre = tab[e_], ce = tab[32 + e_]; const int nt = (ce + 255) >> 8;
        const unsigned long long mk = __ballot(lane < 32 && tile >= pre && tile < pre + nt);
        if (mk == 0ull) return false;
        const int e = (int)__builtin_ctzll(mk);
        const int pre_e = __builtin_amdgcn_readlane(pre, e), ce_e = __builtin_amdgcn_readlane(ce, e);
        const int rt = tile - pre_e; u.pmo = tile; u.pm = a_is_out ? tile : 0; u.lt = e * 64 + rt; u.pn = e * 4 + pnl; u.pnl = pnl; const int rem = ce_e - rt * 256; u.nvalid = rem < 256 ? rem : 256; return true;
    }
};
__device__ __forceinline__ void moe_fill_tab(PG8_LAS int* tab, const unsigned* cnt) {
    const int lane = (int)__builtin_amdgcn_mbcnt_hi(~0u, __builtin_amdgcn_mbcnt_lo(~0u, 0u));
    const int ce = (lane < 32) ? (int)cnt[lane & 31] : 0; const int nt = (ce + 255) >> 8;
    int incl = nt;
#pragma unroll
    for (int o = 1; o < 32; o <<= 1) { const int v = __shfl_up(incl, o); if (lane >= o) incl += v; }
    if (lane < 32) { tab[lane] = incl - nt; tab[32 + lane] = ce; }
}

__device__ __forceinline__ unsigned cvt_pk_bf16(float lo, float hi) { unsigned r; asm volatile("v_cvt_pk_bf16_f32 %0, %1, %2" : "=v"(r) : "v"(lo), "v"(hi)); return r; }

template <class Epi, class Sched, bool ALIGN_EPI, bool GATHER>
__device__ __forceinline__ void gemm_phase(PG8_LAS unsigned char* lds, const Gemm g, const Sched& S, const Epi& E) {
    const int tid = threadIdx.x, wid = __builtin_amdgcn_readfirstlane(tid >> 6), lane = tid & 63, wr = wid >> 2, wc = wid & 3, fr = lane & 15, fq = lane >> 4;
    int K_ = g.K; asm volatile("" : "+s"(K_));
    const int K = K_, nt = K / BK;
    unsigned voffB[2]; int RA[2], CA[2];
#pragma unroll
    for (int i = 0; i < 2; ++i) { int R, C; stage_rc(tid * 16 + i * 8192, R, C); const int Rb = Epi::PERM ? ((R & ~31) + perm32(R & 31)) : R;
        RA[i] = R; CA[i] = C; voffB[i] = (unsigned)(Rb * K + C) * 2u; }
    const size_t kstep = (size_t)(BK * 2);
    const size_t hstep = (size_t)HALF * K * 2;
    const size_t tstep = 2 * hstep;
    const unsigned ldsw = (unsigned)wid * 1024u;
    const int aoff = lds_byte(wr * 64 + fr, fq * 8), boff = lds_byte(wc * 32 + fr, fq * 8);
    unsigned vA[2][2], vN[2][2];
    PG8_LAS int* rowl = (PG8_LAS int*)(lds + STAGE_BYTES);
    if constexpr (GATHER) {
        for (int i = 0; i < 4; ++i) { Unit uu; if (!S.next(i, uu)) break; if (tid < 256) { const int tk = (tid < uu.nvalid) ? (g.rowidx[(size_t)uu.lt * 256 + tid] >> 1) : 0; rowl[i * 256 + tid] = tk; ((PG8_LAS float*)(rowl + 1024))[i * 256 + tid] = g.rowscale[tk]; } }
        asm volatile("s_waitcnt vmcnt(0) lgkmcnt(0)" ::: "memory"); __builtin_amdgcn_s_barrier(); asm volatile("" ::: "memory");
    }
    auto compute_v = [&](const Unit& u, unsigned (&v)[2][2], int ui_) {
#pragma unroll
        for (int h = 0; h < 2; ++h)
#pragma unroll
            for (int i = 0; i < 2; ++i) {
                const int rl = h * HALF + RA[i];
                if constexpr (GATHER) { const int tok = rowl[ui_ * 256 + rl]; v[h][i] = ((unsigned)tok * (unsigned)K + (unsigned)CA[i]) * 2u; }
                else v[h][i] = ((unsigned)rl * (unsigned)K + (unsigned)CA[i]) * 2u;
            }
    };
#define PG8_SA(b, h) (((b) * 2 + (h)) * HTB)
#define PG8_SB(b, h) ((4 + (b) * 2 + (h)) * HTB)
#define PG8_STAGE(bufoff, gbase, voff) do { _Pragma("unroll") for (int _i = 0; _i < 2; ++_i) \
        __builtin_amdgcn_global_load_lds((const unsigned*)((const char*)(gbase) + (voff)[_i]), (PG8_LAS unsigned*)(lds + (bufoff) + ldsw + _i * 8192), 16, 0, 0); } while (0)
#define PG8_LDA(dst, b, h) do { _Pragma("unroll") for (int m = 0; m < 4; ++m) _Pragma("unroll") for (int k = 0; k < 2; ++k) dst[m][k] = *(const PG8_LAS bf16x8*)(lds + PG8_SA(b, h) + aoff + m * 2048 + k * 1024); } while (0)
#define PG8_LDB(dst, b, h) do { _Pragma("unroll") for (int n = 0; n < 2; ++n) _Pragma("unroll") for (int k = 0; k < 2; ++k) dst[n][k] = *(const PG8_LAS bf16x8*)(lds + PG8_SB(b, h) + boff + n * 2048 + k * 1024); } while (0)
#define PG8_MMA(ai, bj, At, Bt) do { __builtin_amdgcn_s_setprio(1); _Pragma("unroll") for (int m = 0; m < 4; ++m) _Pragma("unroll") for (int n = 0; n < 2; ++n) _Pragma("unroll") for (int k = 0; k < 2; ++k) \
        acc[ai][bj][m][n] = __builtin_amdgcn_mfma_f32_16x16x32_bf16(Bt[n][k], At[m][k], acc[ai][bj][m][n], 0, 0, 0); __builtin_amdgcn_s_setprio(0); } while (0)
#define PG8_WAIT_V(n) asm volatile("s_waitcnt vmcnt(" #n ")" ::: "memory")
#define PG8_WAIT_L(n) asm volatile("s_waitcnt lgkmcnt(" #n ")" ::: "memory")
#define PG8_BAR __builtin_amdgcn_s_barrier()
#define PG8_SCHED __builtin_amdgcn_sched_barrier(0)
    Unit cur, nxt; int ui = 0;
    if (!S.next(0, cur)) return;
    f32x4 acc[2][2][4][2];
#pragma unroll
    for (int a = 0; a < 2; ++a)
#pragma unroll
        for (int b = 0; b < 2; ++b)
#pragma unroll
            for (int m = 0; m < 4; ++m)
#pragma unroll
                for (int n = 0; n < 2; ++n) acc[a][b][m][n] = (f32x4){0.f, 0.f, 0.f, 0.f};
    bf16x8 At[4][2], B0[2][2], B1[2][2];
    compute_v(cur, vA, 0);
    const char* cA = (const char*)g.A + (GATHER ? (size_t)0 : (size_t)cur.pm * tstep); const char* cB = (const char*)g.Bt + (size_t)cur.pn * tstep;
    PG8_STAGE(PG8_SB(0, 0), cB, voffB); PG8_STAGE(PG8_SB(0, 1), cB + hstep, voffB); PG8_STAGE(PG8_SA(0, 0), cA, vA[0]); PG8_STAGE(PG8_SA(0, 1), cA, vA[1]);
    if (wr == 1) PG8_BAR;
    PG8_WAIT_V(2); PG8_BAR;
    PG8_STAGE(PG8_SB(1, 0), cB + kstep, voffB); PG8_STAGE(PG8_SA(1, 0), cA + kstep, vA[0]); PG8_STAGE(PG8_SB(1, 1), cB + hstep + kstep, voffB);
    PG8_WAIT_V(6); PG8_BAR;
    for (;;) {
        const bool has_next = S.next(ui + 1, nxt);
        if (has_next) compute_v(nxt, vN, ui + 1);
        else {
#pragma unroll
            for (int h = 0; h < 2; ++h)
#pragma unroll
                for (int i = 0; i < 2; ++i) vN[h][i] = vA[h][i];
        }
        const char* nA = has_next ? ((const char*)g.A + (GATHER ? (size_t)0 : (size_t)nxt.pm * tstep)) : cA; const char* nB = has_next ? (const char*)g.Bt + (size_t)nxt.pn * tstep : cB;
#pragma unroll 1
        for (int t = 0; t < nt; t += 2) {
            const bool last = (t == nt - 2);
            const char* a1 = cA + (size_t)(t + 1) * kstep;
            const char* a2 = last ? nA : cA + (size_t)(t + 2) * kstep; const char* b2 = last ? nB : cB + (size_t)(t + 2) * kstep;
            const char* a3 = a2 + kstep; const char* b3 = b2 + kstep;
            unsigned vX0[2], vX1[2];
#pragma unroll
            for (int i = 0; i < 2; ++i) { vX0[i] = last ? vN[0][i] : vA[0][i]; vX1[i] = last ? vN[1][i] : vA[1][i]; }
            PG8_LDB(B0, 0, 0); PG8_LDB(B1, 0, 1); PG8_SCHED; PG8_LDA(At, 0, 0); PG8_STAGE(PG8_SA(1, 1), a1, vA[1]);
            PG8_WAIT_V(8); PG8_WAIT_L(0); PG8_BAR; PG8_MMA(0, 0, At, B0); PG8_MMA(0, 1, At, B1); PG8_BAR; PG8_SCHED;
            PG8_LDA(At, 0, 1); PG8_STAGE(PG8_SB(0, 0), b2, voffB); PG8_STAGE(PG8_SB(0, 1), b2 + hstep, voffB); PG8_STAGE(PG8_SA(0, 0), a2, vX0);
            PG8_WAIT_V(8); PG8_WAIT_L(0); PG8_BAR; PG8_MMA(1, 0, At, B0); PG8_MMA(1, 1, At, B1); PG8_BAR; PG8_SCHED;
            PG8_LDB(B0, 1, 0); PG8_LDB(B1, 1, 1); PG8_SCHED; PG8_LDA(At, 1, 0); PG8_STAGE(PG8_SA(0, 1), a2, vX1);
            PG8_WAIT_V(8); PG8_WAIT_L(0); PG8_BAR; PG8_MMA(0, 0, At, B0); PG8_MMA(0, 1, At, B1); PG8_BAR; PG8_SCHED;
            PG8_LDA(At, 1, 1); PG8_STAGE(PG8_SB(1, 0), b3, voffB); PG8_STAGE(PG8_SB(1, 1), b3 + hstep, voffB); PG8_STAGE(PG8_SA(1, 0), a3, vX0);
            PG8_WAIT_V(8); PG8_WAIT_L(0); PG8_BAR; PG8_MMA(1, 0, At, B0); PG8_MMA(1, 1, At, B1); PG8_BAR; PG8_SCHED;
        }
        if constexpr (ALIGN_EPI) { if (wr == 0) PG8_BAR; }
        if constexpr (GATHER) cur.pm = ui;
        E(acc, cur, wr, wc, fr, fq);
        if (!has_next) break;
#pragma unroll
        for (int a = 0; a < 2; ++a)
#pragma unroll
            for (int b = 0; b < 2; ++b)
#pragma unroll
                for (int m = 0; m < 4; ++m)
#pragma unroll
                    for (int n = 0; n < 2; ++n) acc[a][b][m][n] = (f32x4){0.f, 0.f, 0.f, 0.f};
        cur = nxt; cA = nA; cB = nB; ++ui;
#pragma unroll
        for (int h = 0; h < 2; ++h)
#pragma unroll
            for (int i = 0; i < 2; ++i) vA[h][i] = vN[h][i];
        if constexpr (ALIGN_EPI) { if (wr == 1) PG8_BAR; }
    }
    PG8_WAIT_V(0);
    if constexpr (!ALIGN_EPI) { if (wr == 0) PG8_BAR; }
    PG8_BAR;
#undef PG8_SA
#undef PG8_SB
#undef PG8_STAGE
#undef PG8_LDA
#undef PG8_LDB
#undef PG8_MMA
#undef PG8_WAIT_V
#undef PG8_WAIT_L
#undef PG8_BAR
#undef PG8_SCHED
}
}

constexpr int NWAVES = 8;
constexpr int M = 16384, D = 1024, SEQ = 2048, NBATCH = 8;
constexpr int NIN = 5144;
constexpr int NZ = 5120;
constexpr int ZC_R = 0, ZC_K = 512, ZC_V = 1024, ZC_W = 1536, ZC_Q = 1792, ZC_KC = 2304, ZC_VC = 2432, ZC_KS = 2560, ZC_VS = 2688, ZC_KW = 2816, ZC_VW = 2944, ZC_MR = 3072, ZC_MN = 4096;
constexpr float NORM_EPS = 1e-6f, GN_EPS = 64e-5f;

constexpr size_t MiB = 1u << 20;
constexpr size_t WS_CTL = 0, CTL_ZERO_BYTES = 64 * 1024;
constexpr size_t WS_LIST = 1 * MiB;
constexpr size_t WS_GATEA = 3 * MiB;
constexpr size_t WS_RSE = 4 * MiB;
constexpr size_t WS_SLOTA = 4 * MiB + 512 * 1024;
constexpr size_t WS_SELMASK = 5 * MiB;
constexpr size_t WS_ZGATE = 6 * MiB;
constexpr size_t WS_SMALLW = 8 * MiB;
constexpr size_t SW_W2T = 0, SW_A2T = 65536, SW_G2T = 131072, SW_CK1 = 262144, SW_CV1 = 524288, SW_CK2 = 786432, SW_CV2 = 794624, SW_GATEW = 802816, SW_ROUTEW = 868352;
constexpr size_t WS_KCMP = 10 * MiB;
constexpr size_t WS_VST = 11 * MiB, WS_VWT = 15 * MiB;
constexpr size_t WS_WIN = 19 * MiB, WS_UR = 29 * MiB, WS_UN = 30 * MiB, WS_WO = 31 * MiB, WS_WPP = 33 * MiB, WS_WPG = 34 * MiB, WS_WGU = 36 * MiB, WS_WD = 100 * MiB;
constexpr size_t WS_XN = 132 * MiB;
constexpr size_t WS_PBF = 164 * MiB;
constexpr size_t WS_Z = 172 * MiB;
constexpr size_t WS_S = 332 * MiB;
constexpr size_t WS_YRW = 428 * MiB, WS_YB = 444 * MiB, WS_G = 492 * MiB, WS_LOGITS = 508 * MiB  , WS_BONUS = 508 * MiB  , WS_END = 511 * MiB;
constexpr int CH_PP = 144, CH_P = 0, CH_R = 2304, CH_Q = 4608, CH_K = 6656, CH_G = 8704, CH_AC = 10752, CH_REC = 11008, CH_V = 11008, CH_SLOT = 11520;
constexpr int CW_CNT = 0;
constexpr int CW_PANEL = 8192;
constexpr int CW_BAR = 1024;
constexpr int MISC_OFF = 163840 - 64;

constexpr int LDS_BYTES = 163840;

#define GAS __attribute__((address_space(1)))
#define LAS __attribute__((address_space(3)))
typedef unsigned short bf16;
typedef unsigned v4u __attribute__((ext_vector_type(4)));
typedef unsigned v2u __attribute__((ext_vector_type(2)));
typedef float f32x4 __attribute__((ext_vector_type(4)));
typedef float f32x2 __attribute__((ext_vector_type(2)));
typedef short bf16x8 __attribute__((ext_vector_type(8)));
typedef short bf16x4 __attribute__((ext_vector_type(4)));
typedef __bf16 bf16x2_t __attribute__((ext_vector_type(2)));
#define LDS_WAIT() asm volatile("s_waitcnt lgkmcnt(0)" ::: "memory")
#define MFMA16(a, b, c) __builtin_amdgcn_mfma_f32_16x16x32_bf16((a), (b), (c), 0, 0, 0)

__device__ __forceinline__ float bf2f(unsigned short v) { return __uint_as_float((unsigned)v << 16); }
__device__ __forceinline__ unsigned pk2(float lo, float hi) { f32x2 v = {lo, hi}; bf16x2_t b = __builtin_convertvector(v, bf16x2_t); return __builtin_bit_cast(unsigned, b); }
__device__ __forceinline__ v2u pk4(f32x4 v) { v2u r; r.x = pk2(v.x, v.y); r.y = pk2(v.z, v.w); return r; }
__device__ __forceinline__ f32x4 unpk4(v2u w) { f32x4 r; r.x = __uint_as_float(w.x << 16); r.y = __uint_as_float(w.x & 0xffff0000u); r.z = __uint_as_float(w.y << 16); r.w = __uint_as_float(w.y & 0xffff0000u); return r; }
__device__ __forceinline__ void unpk8(v4u w, float (&f)[8]) { f[0] = __uint_as_float(w.x << 16); f[1] = __uint_as_float(w.x & 0xffff0000u); f[2] = __uint_as_float(w.y << 16); f[3] = __uint_as_float(w.y & 0xffff0000u);
    f[4] = __uint_as_float(w.z << 16); f[5] = __uint_as_float(w.z & 0xffff0000u); f[6] = __uint_as_float(w.w << 16); f[7] = __uint_as_float(w.w & 0xffff0000u); }
__device__ __forceinline__ float sigmoidf_(float x) { return __builtin_amdgcn_rcpf(1.0f + __expf(-x)); }
__device__ __forceinline__ float wave_sum(float v) {
#pragma unroll
    for (int o = 1; o < 64; o <<= 1) v += __shfl_xor(v, o);
    return v;
}
template <int CTRL> __device__ __forceinline__ float dppf(float x) { return __builtin_bit_cast(float, __builtin_amdgcn_update_dpp(0, __builtin_bit_cast(int, x), CTRL, 0xf, 0xf, false)); }
__device__ __forceinline__ float row16_sum(float x) { x += dppf<0x128>(x); x += dppf<0x124>(x); x += dppf<0x122>(x); x += dppf<0x121>(x); return x; }

typedef GAS unsigned gu32;
#define XB_TMO      128
#define XB_XCNT(j)  (256  + 64 * (j))
#define XB_XSUB(j)  (1280 + 64 * (j))
#define XB_XGEN(j)  (2304 + 64 * (j))
#define XB_TOP      3328
#define XB_TOPGEN   3392
#define XCD_BAR_WORDS 3456
#define XB_SPIN_CAP (1u << 18)

__device__ __forceinline__ unsigned xb_ld(unsigned* p)              { return __hip_atomic_load(p, __ATOMIC_RELAXED, __HIP_MEMORY_SCOPE_AGENT); }
__device__ __forceinline__ unsigned xb_add(unsigned* p, unsigned v) { return __hip_atomic_fetch_add(p, v, __ATOMIC_RELAXED, __HIP_MEMORY_SCOPE_AGENT); }
__device__ __forceinline__ unsigned xb_xcc_id() { return (unsigned)__builtin_amdgcn_s_getreg((3 << 11) | 20) & 0xFu; }
#define XB_SPIN(cond, bar) do { unsigned _sp = 0; while (cond) { __builtin_amdgcn_s_sleep(1); \
    if ((++_sp & 255u) == 0u) { if (xb_ld(&(bar)[XB_TMO])) break; if (_sp > XB_SPIN_CAP) { atomicAdd(&(bar)[XB_TMO], 1u); break; } } } } while (0)

struct XcdBarrier {
    unsigned* bar; unsigned x;
    volatile LAS unsigned* st;
};

__device__ __forceinline__ XcdBarrier xcd_barrier_post(unsigned* bar, volatile LAS unsigned* st) {
    XcdBarrier b; b.bar = bar; b.x = xb_xcc_id(); b.st = st;
    if (threadIdx.x == 0) (void)xb_add(&bar[XB_XCNT(b.x)], 1u);
    return b;
}
__device__ __forceinline__ void xcd_barrier_complete(unsigned* bar, unsigned x, unsigned& nloc, unsigned& nx) {
    const unsigned G = gridDim.x * gridDim.y * gridDim.z;
    unsigned sum, cnt, mine, sp = 0u;
    for (;;) {
        sum = 0u; cnt = 0u; mine = 0u;
#pragma unroll
        for (unsigned j = 0; j < 16; ++j) { const unsigned c = xb_ld(&bar[XB_XCNT(j)]); sum += c; cnt += (c > 0u) ? 1u : 0u; mine = (j == x) ? c : mine; }
        if (sum == G) break;
        __builtin_amdgcn_s_sleep(1);
        if ((++sp & 255u) == 0u) { if (xb_ld(&bar[XB_TMO])) break; if (sp > XB_SPIN_CAP) { atomicAdd(&bar[XB_TMO], 1u); break; } }
    }
    nloc = mine > 0u ? mine : 1u; nx = cnt > 0u ? cnt : 1u;
}

__device__ __forceinline__ void xcd_barrier(const XcdBarrier& b) {
    asm volatile("s_waitcnt vmcnt(0)" ::: "memory");
    __syncthreads();
    if (threadIdx.x == 0) {
        unsigned* bar = b.bar;
        __builtin_amdgcn_s_waitcnt(0);
        unsigned nloc = b.st[0], nx = b.st[1];
        if (nloc == 0u) { xcd_barrier_complete(bar, b.x, nloc, nx); b.st[0] = nloc; b.st[1] = nx; }
        const unsigned old = xb_add(&bar[XB_XSUB(b.x)], 1u);
        const unsigned gen = old / nloc;
        if (old + 1u == (gen + 1u) * nloc) {
            __builtin_amdgcn_fence(__ATOMIC_RELEASE, "agent");
            asm volatile("s_waitcnt vmcnt(0)" ::: "memory");
            const unsigned og = xb_add(&bar[XB_TOP], 1u);
            const unsigned tg = og / nx;
            if (og + 1u == (tg + 1u) * nx) xb_add(&bar[XB_TOPGEN], 1u);
            else XB_SPIN(xb_ld(&bar[XB_TOPGEN]) == tg, bar);
            __builtin_amdgcn_fence(__ATOMIC_ACQUIRE, "agent");
            xb_add(&bar[XB_XGEN(b.x)], 1u);
            asm volatile("s_waitcnt vmcnt(0)" ::: "memory");
        } else {
            XB_SPIN(xb_ld(&bar[XB_XGEN(b.x)]) == gen, bar);
            __builtin_amdgcn_fence(__ATOMIC_ACQUIRE, "agent");
            asm volatile("s_waitcnt vmcnt(0)" ::: "memory");
        }
    }
    __syncthreads();
}

struct Args { const float* in[37]; float* out; unsigned char* ws; int ph_lo, ph_hi, rep_mask, pad; };
typedef __attribute__((address_space(4))) const Args* ArgsP;
struct Frame {
    LAS unsigned char* lds;
    int tid, lane, wave, vcu, G, gw, NGW;
    unsigned char* ws;
    ArgsP ap;
    float* out;
};

struct TrDesc { const float* W; bf16* T; bf16* T2; const float* gain; int K, ld, nc, item, mode; };
__device__ __forceinline__ void tr_load(const TrDesc& d, int lane, float (&tv)[32], f32x4 (&gn)[2]) {
    const int nblk = (d.nc + 31) / 32, kb = d.item / nblk, nb = d.item % nblk, k0 = 64 * kb, n0 = 32 * nb;
    const int nn = n0 + (lane & 31);
    gn[0] = (f32x4){1.f, 1.f, 1.f, 1.f}; gn[1] = gn[0];
    if (d.gain) { const float* gp = d.gain + k0 + 8 * (lane & 7); gn[0] = *(const f32x4*)gp; gn[1] = *(const f32x4*)(gp + 4); }
    const float* wsrc = d.W + (size_t)(k0 + (lane >> 5)) * d.ld + (nn < d.nc ? nn : 0);
#pragma unroll
    for (int i = 0; i < 32; ++i) tv[i] = wsrc[(size_t)(2 * i) * d.ld];
}
__device__ __forceinline__ void tr_finish(const TrDesc& d, LAS float* scr, int lane, const float (&tv)[32], const f32x4 (&gn)[2]) {
    const int nblk = (d.nc + 31) / 32, kb = d.item / nblk, nb = d.item % nblk, k0 = 64 * kb, n0 = 32 * nb;
#pragma unroll
    for (int i = 0; i < 32; ++i) scr[(2 * i + (lane >> 5)) * 33 + (lane & 31)] = tv[i];
    LDS_WAIT(); asm volatile("" ::: "memory");
    const int c = lane & 7;
#pragma unroll
    for (int j = 0; j < 4; ++j) { const int nl = (lane >> 3) + 8 * j, n = n0 + nl; const LAS float* s = scr + (8 * c) * 33 + nl;
        v4u o; o.x = pk2(s[0 * 33] * gn[0].x, s[1 * 33] * gn[0].y); o.y = pk2(s[2 * 33] * gn[0].z, s[3 * 33] * gn[0].w); o.z = pk2(s[4 * 33] * gn[1].x, s[5 * 33] * gn[1].y); o.w = pk2(s[6 * 33] * gn[1].z, s[7 * 33] * gn[1].w);
        if (n < d.nc) { bf16* rp;
            if (d.mode == 1) rp = n < 3072 ? d.T + (size_t)n * 1024 : (n < 3096 ? d.T2 + (size_t)(n - 3072) * 1024 : d.T + (size_t)(n - 24) * 1024);
            else if (d.mode == 2) { const int n2 = n & 511; rp = d.T + (size_t)((n2 >> 7) * 256 + (n >> 9) * 128 + (n2 & 127)) * 1024; }
            else rp = d.T + (size_t)n * d.K;
            *(v4u*)(rp + k0 + 8 * c) = o; } }
    LDS_WAIT(); asm volatile("" ::: "memory");
}
__device__ __forceinline__ void rms_row_to_bf16(int lane, const float* xrow, const float* gain, bf16* orow) {
    const f32x4* xr = (const f32x4*)xrow + lane; const f32x4* gr = (const f32x4*)gain + lane;
    f32x4 v[4]; float s = 0.f;
#pragma unroll
    for (int j = 0; j < 4; ++j) { v[j] = xr[64 * j]; s += (v[j].x * v[j].x + v[j].y * v[j].y) + (v[j].z * v[j].z + v[j].w * v[j].w); }
    const float rs = 1.0f / sqrtf(wave_sum(s) * (1.f / D) + NORM_EPS);
    v2u* o8 = (v2u*)orow + lane;
#pragma unroll
    for (int j = 0; j < 4; ++j) { const f32x4 g = gr[64 * j]; o8[64 * j] = pk4(v[j] * rs * g); }
}

namespace tri {
constexpr int I_WIN = 16 * 161, I_UR = 8 * 32, I_WO = 16 * 32, I_WPP = 4 * 32, I_L64 = 16, I_L128 = 32, I_C1 = 32 * 2, I_C2 = 2, I_GU = 16 * 32, I_DN = 8 * 32;
constexpr int E0 = I_WIN, E1 = E0 + I_UR, E2 = E1 + I_UR, E3 = E2 + I_WO, E4 = E3 + I_WPP, E5 = E4 + I_WO, E6 = E5 + I_L64, E7 = E6 + I_L64, E8 = E7 + I_L128, E9 = E8 + I_C1, E10 = E9 + I_C1, E11 = E10 + I_C2, E12 = E11 + I_C2,
              E13 = E12 + 32 * I_GU, NITEMS = E13 + 32 * I_DN;
}
__device__ __forceinline__ TrDesc tr_desc(Frame& F, int it) {
    using namespace tri;
    unsigned char* ws = F.ws;
    const float* W; const float* gain = nullptr; int K, ld, nc, item, mode = 0; size_t dst;
    if (it < E0) { W = F.ap->in[3]; K = 1024; ld = NIN; nc = NIN; item = it; mode = 1; dst = WS_WIN; }
    else if (it < E1) { W = F.ap->in[22]; K = 512; ld = 1024; nc = 1024; item = it - E0; dst = WS_UR; }
    else if (it < E2) { W = F.ap->in[23]; K = 512; ld = 1024; nc = 1024; item = it - E1; dst = WS_UN; }
    else if (it < E3) { W = F.ap->in[24]; K = 1024; ld = 1024; nc = 1024; item = it - E2; dst = WS_WO; }
    else if (it < E4) { W = F.ap->in[32]; K = 256; ld = 1024; nc = 1024; item = it - E3; dst = WS_WPP; }
    else if (it < E5) { W = F.ap->in[35]; K = 1024; ld = 1024; nc = 1024; item = it - E4; dst = WS_WPG; gain = F.ap->in[34]; }
    else if (it < E6) { W = F.ap->in[6]; K = 64; ld = 512; nc = 512; item = it - E5; dst = WS_SMALLW + SW_W2T; }
    else if (it < E7) { W = F.ap->in[8]; K = 64; ld = 512; nc = 512; item = it - E6; dst = WS_SMALLW + SW_A2T; }
    else if (it < E8) { W = F.ap->in[9]; K = 128; ld = 512; nc = 512; item = it - E7; dst = WS_SMALLW + SW_G2T; }
    else if (it < E9) { W = F.ap->in[17]; K = 2048; ld = 64; nc = 64; item = it - E8; dst = WS_SMALLW + SW_CK1; }
    else if (it < E10) { W = F.ap->in[19]; K = 2048; ld = 64; nc = 64; item = it - E9; dst = WS_SMALLW + SW_CV1; }
    else if (it < E11) { W = F.ap->in[18]; K = 64; ld = 64; nc = 64; item = it - E10; dst = WS_SMALLW + SW_CK2; }
    else if (it < E12) { W = F.ap->in[20]; K = 64; ld = 64; nc = 64; item = it - E11; dst = WS_SMALLW + SW_CV2; }
    else if (it < E13) { const int r = it - E12, e = r / I_GU; W = F.ap->in[30] + (size_t)e * 1024 * 1024; K = 1024; ld = 1024; nc = 1024; item = r % I_GU; mode = 2; dst = WS_WGU + (size_t)e * 1024 * 1024 * 2; gain = F.ap->in[25]; }
    else { const int r = it - E13, e = r / I_DN; W = F.ap->in[31] + (size_t)e * 512 * 1024; K = 512; ld = 1024; nc = 1024; item = r % I_DN; dst = WS_WD + (size_t)e * 1024 * 512 * 2; }
    return TrDesc{W, (bf16*)(ws + dst), (bf16*)(ws + WS_SMALLW + SW_GATEW), gain, K, ld, nc, item, mode};
}
__device__ __forceinline__ void tr_run(Frame& F, LAS float* scr, int it0, int stride, int it_end) {
    if (it0 >= it_end) return;
    float tvA[32], tvB[32]; f32x4 gnA[2], gnB[2];
    int it = it0; TrDesc cur = tr_desc(F, it); tr_load(cur, F.lane, tvA, gnA);
    for (;;) {
        const int nxt = it + stride; const bool has = nxt < it_end; TrDesc dn = cur;
        if (has) { dn = tr_desc(F, nxt); tr_load(dn, F.lane, tvB, gnB); }
        __builtin_amdgcn_sched_barrier(0);
        tr_finish(cur, scr, F.lane, tvA, gnA);
        if (!has) break;
        cur = dn; it = nxt;
#pragma unroll
        for (int i = 0; i < 32; ++i) tvA[i] = tvB[i];
        gnA[0] = gnB[0]; gnA[1] = gnB[1];
    }
}
__device__ __forceinline__ int tr_qnext(LAS int* qh) {
    int k = 0; const unsigned a = (unsigned)(size_t)qh; const int one = 1;
    if (__builtin_amdgcn_mbcnt_hi(~0u, __builtin_amdgcn_mbcnt_lo(~0u, 0u)) == 0) asm volatile("ds_add_rtn_u32 %0, %1, %2\n\ts_waitcnt lgkmcnt(0)" : "=&v"(k) : "v"(a), "v"(one) : "memory");
    return __builtin_amdgcn_readfirstlane(k);
}
__device__ __forceinline__ void tr_run_q(Frame& F, LAS float* scr, LAS int* qh, int base, int stride, int nk) {
    int k = tr_qnext(qh); if (k >= nk) return;
    float tvA[32], tvB[32]; f32x4 gnA[2], gnB[2];
    TrDesc cur = tr_desc(F, base + k * stride); tr_load(cur, F.lane, tvA, gnA);
    for (;;) {
        const int kn = tr_qnext(qh); const bool has = kn < nk; TrDesc dn = cur;
        if (has) { dn = tr_desc(F, base + kn * stride); tr_load(dn, F.lane, tvB, gnB); }
        __builtin_amdgcn_sched_barrier(0);
        tr_finish(cur, scr, F.lane, tvA, gnA);
        if (!has) break;
        cur = dn;
#pragma unroll
        for (int i = 0; i < 32; ++i) tvA[i] = tvB[i];
        gnA[0] = gnB[0]; gnA[1] = gnB[1];
    }
}
#ifndef MK_EXPERTS_IN_SCAN
#define MK_EXPERTS_IN_SCAN 1
#endif
__device__ __forceinline__ void p0_prologue(Frame& F) {
    LAS float* scr = (LAS float*)(F.lds + F.wave * 16384);
    unsigned char* ws = F.ws;
    bf16* gateWT = (bf16*)(ws + WS_SMALLW + SW_GATEW);
    tr_run(F, scr, F.gw, F.NGW, MK_EXPERTS_IN_SCAN ? tri::E12 : tri::NITEMS);
    for (int mb = F.gw; mb < M; mb += 4 * F.NGW) {
        f32x4 v[4][4]; float s[4];
#pragma unroll
        for (int u = 0; u < 4; ++u) { const f32x4* xr = (const f32x4*)(F.ap->in[0] + (size_t)(mb + u * F.NGW) * D) + F.lane;
#pragma unroll
            for (int j = 0; j < 4; ++j) v[u][j] = xr[64 * j]; }
#pragma unroll
        for (int u = 0; u < 4; ++u) { s[u] = 0.f;
#pragma unroll
            for (int j = 0; j < 4; ++j) s[u] += (v[u][j].x * v[u][j].x + v[u][j].y * v[u][j].y) + (v[u][j].z * v[u][j].z + v[u][j].w * v[u][j].w); }
#pragma unroll
        for (int o = 1; o < 64; o <<= 1) {
#pragma unroll
            for (int u = 0; u < 4; ++u) s[u] += __shfl_xor(s[u], o); }
        const f32x4* gr = (const f32x4*)F.ap->in[2] + F.lane;
#pragma unroll
        for (int u = 0; u < 4; ++u) { const float rs = 1.0f / sqrtf(s[u] * (1.f / D) + NORM_EPS); v2u* o8 = (v2u*)((bf16*)(ws + WS_XN) + (size_t)(mb + u * F.NGW) * D) + F.lane;
#pragma unroll
            for (int j = 0; j < 4; ++j) o8[64 * j] = pk4(v[u][j] * rs * gr[64 * j]); }
    }
    {
        float* RW = (float*)(ws + WS_SMALLW + SW_ROUTEW); const float* gf = F.ap->in[25]; const float* wg = F.ap->in[26]; const float* wr = F.ap->in[28];
        for (int idx = F.gw * 64 + F.lane; idx < 48 * 1024; idx += F.NGW * 64) { const int c = idx >> 10, k = idx & 1023; float v = 0.f;
            if (c < 4) v = wg[k * 4 + c]; else if (c < 36) v = wr[k * 32 + (c - 4)];
            RW[idx] = v * gf[k]; }
        for (int idx = F.gw * 64 + F.lane; idx < 8 * 1024; idx += F.NGW * 64) gateWT[24 * 1024 + idx] = 0;
    }
}

struct EpiStoreBf16 {
    static constexpr bool PERM = true;
    bf16* O; int ldc;
    __device__ __forceinline__ void operator()(const f32x4 (&acc)[2][2][4][2], const pg8::Unit& u, int wr, int wc, int fr, int fq) const {
        const int row0 = u.pmo * 256 + wr * 64 + fr, col0 = u.pnl * 256 + wc * 32 + 8 * fq;
#pragma unroll
        for (int ai = 0; ai < 2; ++ai)
#pragma unroll
            for (int m = 0; m < 4; ++m) { bf16* rowp = O + (size_t)(row0 + ai * 128 + m * 16) * ldc + col0;
#pragma unroll
                for (int bj = 0; bj < 2; ++bj) { const f32x4 v0 = acc[ai][bj][m][0], v1 = acc[ai][bj][m][1]; v4u w; w.x = pk2(v0[0], v0[1]); w.y = pk2(v0[2], v0[3]); w.z = pk2(v1[0], v1[1]); w.w = pk2(v1[2], v1[3]);
                    *(v4u*)(rowp + bj * 128) = w; } }
    }
};
#define EPI_LOOP_BEGIN \
    _Pragma("unroll") for (int ai = 0; ai < 2; ++ai) _Pragma("unroll") for (int m = 0; m < 4; ++m) { if (m == 0 || m == 2) asm volatile("" ::: "memory"); const int rl = ai * 128 + wr * 64 + m * 16 + fr; const size_t row = (size_t)u.pmo * 256 + rl; (void)row; \
    _Pragma("unroll") for (int bj = 0; bj < 2; ++bj) _Pragma("unroll") for (int n = 0; n < 2; ++n) { const int col = u.pnl * 256 + bj * 128 + wc * 32 + n * 16 + 4 * fq; (void)col; const f32x4 a = acc[ai][bj][m][n];
#define EPI_LOOP_END } }
struct EpiMix {
    static constexpr bool PERM = false;
    const bf16* z; bf16* A; bf16* O;
    __device__ __forceinline__ void operator()(const f32x4 (&acc)[2][2][4][2], const pg8::Unit& u, int wr, int wc, int fr, int fq) const {
        const int zc = u.lt ? ZC_MN : ZC_MR;
        EPI_LOOP_BEGIN
            const f32x4 zz = unpk4(*(const v2u*)(z + row * NZ + zc + col)); f32x4 o;
            o.x = sigmoidf_(zz.x) * a.x; o.y = sigmoidf_(zz.y) * a.y; o.z = sigmoidf_(zz.z) * a.z; o.w = sigmoidf_(zz.w) * a.w;
            if (u.lt == 0) *(v2u*)(A + row * D + col) = pk4(o);
            else { o = o + unpk4(*(const v2u*)(A + row * D + col)); *(v2u*)(O + row * D + col) = pk4(o); }
        EPI_LOOP_END
    }
};
struct ErawOrder {
    pg8::StaticOrder S; int c, G, nheavy;
    __device__ bool next(int i, pg8::Unit& u) const { const int nl = G - nheavy, l = c - nheavy; if (l < 0) return false; const int q = l + i * nl; if (q >= S.nwg) return false;
        pg8::StaticOrder T = S; T.c = q; T.G = S.nwg + 1; return T.next(0, u); }
};
struct DualOrder {
    pg8::StaticOrder S;
    __device__ bool next(int i, pg8::Unit& u) const { if (i >= 2) return false; if (!S.next(0, u)) return false; if (i == 1) { u.pm += 64; u.pn += 4; } u.lt = i; return true; }
};
struct EpiResBf16 {
    static constexpr bool PERM = true;
    const float* base; bf16* O;
    __device__ __forceinline__ void operator()(const f32x4 (&acc)[2][2][4][2], const pg8::Unit& u, int wr, int wc, int fr, int fq) const {
        const int row0 = u.pmo * 256 + wr * 64 + fr, col0 = u.pnl * 256 + wc * 32 + 8 * fq;
#pragma unroll
        for (int ai = 0; ai < 2; ++ai)
#pragma unroll
            for (int m = 0; m < 4; ++m) { if (m == 0 || m == 2) asm volatile("" ::: "memory"); const size_t ro = (size_t)(row0 + ai * 128 + m * 16) * D + col0;
#pragma unroll
                for (int bj = 0; bj < 2; ++bj) { const f32x4 v0 = acc[ai][bj][m][0] + *(const f32x4*)(base + ro + bj * 128), v1 = acc[ai][bj][m][1] + *(const f32x4*)(base + ro + bj * 128 + 4);
                    v4u w; w.x = pk2(v0[0], v0[1]); w.y = pk2(v0[2], v0[3]); w.z = pk2(v1[0], v1[1]); w.w = pk2(v1[2], v1[3]);
                    *(v4u*)(O + ro + bj * 128) = w; } }
    }
};
struct EpiResF32 {
    static constexpr bool PERM = false;
    const float* base; float* O;
    __device__ __forceinline__ void operator()(const f32x4 (&acc)[2][2][4][2], const pg8::Unit& u, int wr, int wc, int fr, int fq) const {
        EPI_LOOP_BEGIN
            *(f32x4*)(O + row * D + col) = *(const f32x4*)(base + row * D + col) + a;
        EPI_LOOP_END
    }
};
struct EpiMoe1 {
    static constexpr bool PERM = false;
    bf16* H; const LAS float* rsl;
    __device__ __forceinline__ void operator()(const f32x4 (&acc)[2][2][4][2], const pg8::Unit& u, int wr, int wc, int fr, int fq) const {
#pragma unroll
        for (int ai = 0; ai < 2; ++ai)
#pragma unroll
            for (int m = 0; m < 4; ++m) { const int rl = ai * 128 + wr * 64 + m * 16 + fr; const size_t row = (size_t)u.pmo * 256 + rl; const float rs = rsl[u.pm * 256 + rl];
#pragma unroll
                for (int n = 0; n < 2; ++n) { const f32x4 gt = acc[ai][0][m][n] * rs, up = acc[ai][1][m][n] * rs; f32x4 o;
                    o.x = gt.x * sigmoidf_(gt.x) * up.x; o.y = gt.y * sigmoidf_(gt.y) * up.y; o.z = gt.z * sigmoidf_(gt.z) * up.z; o.w = gt.w * sigmoidf_(gt.w) * up.w;
                    *(v2u*)(H + row * 512 + u.pnl * 128 + wc * 32 + n * 16 + 4 * fq) = pk4(o); } }
    }
};
struct EpiPle {
    static constexpr bool PERM = false;
    const bf16* x2; const bf16* Eraw; const float* rse; const float* gpn; bf16* O;
    __device__ __forceinline__ void operator()(const f32x4 (&acc)[2][2][4][2], const pg8::Unit& u, int wr, int wc, int fr, int fq) const {
        EPI_LOOP_BEGIN
            const f32x4 e = unpk4(*(const v2u*)(Eraw + row * D + col)); const f32x4 g = *(const f32x4*)(gpn + col); const float rs = rse[row]; f32x4 o = unpk4(*(const v2u*)(x2 + row * D + col));
            o.x += sigmoidf_(a.x) * e.x * rs * g.x; o.y += sigmoidf_(a.y) * e.y * rs * g.y; o.z += sigmoidf_(a.z) * e.z * rs * g.z; o.w += sigmoidf_(a.w) * e.w * rs * g.w;
            *(v2u*)(O + row * D + col) = pk4(o);
        EPI_LOOP_END
    }
};

struct EpiPleNorm {
    static constexpr bool PERM = false;
    const bf16* x2; const bf16* Eraw; const float* rs3; const float* gfin; float* out; float* xbuf; unsigned* cnt; LAS float* ldsx;
    __device__ __forceinline__ void operator()(const f32x4 (&acc_)[2][2][4][2], const pg8::Unit& u_, int wr, int wc, int fr, int fq) const {
        f32x4 (&acc)[2][2][4][2] = const_cast<f32x4 (&)[2][2][4][2]>(acc_);
        pg8::Unit u = u_; asm volatile("" : "+s"(u.pmo), "+s"(u.pnl)); asm volatile("" : "+v"(fr), "+v"(fq)); asm volatile("" : "+s"(wr), "+s"(wc));
        int tid = threadIdx.x; asm volatile("" : "+v"(tid)); const int lane = tid & 63, wid = __builtin_amdgcn_readfirstlane(tid >> 6);
        LAS float* Pl = ldsx; LAS float* Sl = ldsx + 1024; LAS unsigned* flag = (LAS unsigned*)(ldsx + 1280);
#pragma unroll
        for (int ai = 0; ai < 2; ++ai)
#pragma unroll
            for (int m = 0; m < 4; ++m) { if (m == 0 || m == 2) asm volatile("" ::: "memory"); const int rl = ai * 128 + wr * 64 + m * 16 + fr; const size_t row = (size_t)u.pmo * 256 + rl;
                float ss = 0.f; const float r3 = rs3[row];
#pragma unroll
                for (int bj = 0; bj < 2; ++bj)
#pragma unroll
                    for (int n = 0; n < 2; ++n) { const int col = u.pnl * 256 + bj * 128 + wc * 32 + n * 16 + 4 * fq; const f32x4 a = acc[ai][bj][m][n];
                        const f32x4 e = unpk4(*(const v2u*)(Eraw + row * D + col)); f32x4 o = unpk4(*(const v2u*)(x2 + row * D + col));
                        o.x += sigmoidf_(a.x * r3) * e.x; o.y += sigmoidf_(a.y * r3) * e.y; o.z += sigmoidf_(a.z * r3) * e.z; o.w += sigmoidf_(a.w * r3) * e.w;
                        acc[ai][bj][m][n] = o; ss += (o.x * o.x + o.y * o.y) + (o.z * o.z + o.w * o.w); }
                ss += __shfl_xor(ss, 16); ss += __shfl_xor(ss, 32);
                if (fq == 0) Pl[rl * 4 + wc] = ss; }
        asm volatile("s_waitcnt lgkmcnt(0)" ::: "memory"); __builtin_amdgcn_s_barrier(); asm volatile("" ::: "memory");
        if (tid < 256) { const float tot = (Pl[tid * 4 + 0] + Pl[tid * 4 + 1]) + (Pl[tid * 4 + 2] + Pl[tid * 4 + 3]);
            __hip_atomic_store(xbuf + ((size_t)u.pmo * 256 + tid) * 4 + u.pnl, tot, __ATOMIC_RELAXED, __HIP_MEMORY_SCOPE_AGENT);
            asm volatile("s_waitcnt vmcnt(0)" ::: "memory");
            if (lane == 0) __hip_atomic_fetch_add(cnt + 64 * u.pmo, 1u, __ATOMIC_RELAXED, __HIP_MEMORY_SCOPE_AGENT); }
        if (wid == 0) {
            unsigned spins = 0;
            while ((unsigned)__builtin_amdgcn_readfirstlane((int)__hip_atomic_load(cnt + 64 * u.pmo, __ATOMIC_RELAXED, __HIP_MEMORY_SCOPE_AGENT)) < 16u) { __builtin_amdgcn_s_sleep(2); if (++spins > (1u << 22)) break; }
            __builtin_amdgcn_fence(__ATOMIC_ACQUIRE, "agent");
            if (lane == 0) flag[0] = 1u; }
        asm volatile("s_waitcnt vmcnt(0) lgkmcnt(0)" ::: "memory"); __builtin_amdgcn_s_barrier(); asm volatile("" ::: "memory");
        if (tid < 256) { const float* sp = xbuf + ((size_t)u.pmo * 256 + tid) * 4; float tot = 0.f;
#pragma unroll
            for (int t = 0; t < 4; ++t) tot += __hip_atomic_load(sp + t, __ATOMIC_RELAXED, __HIP_MEMORY_SCOPE_AGENT);
            Sl[tid] = 1.0f / sqrtf(tot * (1.f / D) + NORM_EPS); }
        asm volatile("s_waitcnt vmcnt(0) lgkmcnt(0)" ::: "memory"); __builtin_amdgcn_s_barrier(); asm volatile("" ::: "memory");
#pragma unroll
        for (int ai = 0; ai < 2; ++ai)
#pragma unroll
            for (int m = 0; m < 4; ++m) { const int rl = ai * 128 + wr * 64 + m * 16 + fr; const size_t row = (size_t)u.pmo * 256 + rl; const float rs = Sl[rl];
#pragma unroll
                for (int bj = 0; bj < 2; ++bj)
#pragma unroll
                    for (int n = 0; n < 2; ++n) { const int col = u.pnl * 256 + bj * 128 + wc * 32 + n * 16 + 4 * fq; *(f32x4*)(out + row * D + col) = acc[ai][bj][m][n] * rs * *(const f32x4*)(gfin + col); } }
    }
};

__device__ __forceinline__ float gelu_tanh(float x) { const float u = 0.7978845608028654f * (x + 0.044715f * x * x * x); const float t = 1.0f - 2.0f * __builtin_amdgcn_rcpf(__expf(2.0f * u) + 1.0f); return 0.5f * x * (1.0f + t); }

__device__ __forceinline__ void compress_wg_task(Frame& F, int idx) {
    const int kv = idx & 1, tile8 = (idx >> 1) & 7, bg = idx >> 4, b = bg >> 1, g = bg & 1;
    const int fr = F.lane & 15, fq = F.lane >> 4;
    const bf16* z = (const bf16*)(F.ws + WS_Z);
    const bf16* w1T = (const bf16*)(F.ws + WS_SMALLW + (kv ? SW_CV1 : SW_CK1));
    const bf16* w2T = (const bf16*)(F.ws + WS_SMALLW + (kv ? SW_CV2 : SW_CK2));
    const float* pos = kv ? F.ap->in[16] : F.ap->in[15];
    const int j0 = 16 * tile8; int j = j0 + fr; const bool jvalid = j < 127; if (!jvalid) j = 126;
    const bf16* zb = z + ((size_t)b * SEQ + 16 * j) * NZ + (kv ? ZC_VC : ZC_KC) + g * 64;
    v4u zr[8]; f32x4 p0[8], p1[8]; bf16x8 aop[8][4];
#pragma unroll
    for (int i = 0; i < 8; ++i) { const int ks = 8 * F.wave + i, l = ks >> 1, d = 32 * (ks & 1) + 8 * fq;
        zr[i] = *(const v4u*)(zb + (size_t)l * NZ + d); p0[i] = *(const f32x4*)(pos + l * 64 + d); p1[i] = *(const f32x4*)(pos + l * 64 + d + 4);
#pragma unroll
        for (int mt = 0; mt < 4; ++mt) aop[i][mt] = *(const bf16x8*)(w1T + (size_t)(16 * mt + fr) * 2048 + 32 * ks + 8 * fq); }
    f32x4 acc[4];
#pragma unroll
    for (int mt = 0; mt < 4; ++mt) acc[mt] = (f32x4){0.f, 0.f, 0.f, 0.f};
#pragma unroll
    for (int i = 0; i < 8; ++i) {
        float f[8]; unpk8(zr[i], f);
        v4u bb; bb.x = pk2(f[0] + p0[i].x, f[1] + p0[i].y); bb.y = pk2(f[2] + p0[i].z, f[3] + p0[i].w); bb.z = pk2(f[4] + p1[i].x, f[5] + p1[i].y); bb.w = pk2(f[6] + p1[i].z, f[7] + p1[i].w);
        const bf16x8 bop = __builtin_bit_cast(bf16x8, bb);
#pragma unroll
        for (int mt = 0; mt < 4; ++mt) acc[mt] = MFMA16(aop[i][mt], bop, acc[mt]);
    }
    LAS float* red = (LAS float*)F.lds;
    __syncthreads();
#pragma unroll
    for (int mt = 0; mt < 4; ++mt) *(LAS f32x4*)(red + ((F.wave * 4 + mt) * 64 + F.lane) * 4) = acc[mt];
    LDS_WAIT(); __syncthreads();
    if (F.wave != 0) return;
#pragma unroll
    for (int mt = 0; mt < 4; ++mt) { f32x4 t = (f32x4){0.f, 0.f, 0.f, 0.f};
#pragma unroll
        for (int w = 0; w < 8; ++w) t = t + *(const LAS f32x4*)(red + ((w * 4 + mt) * 64 + F.lane) * 4);
        acc[mt] = t; }
    bf16x8 hb[2];
#pragma unroll
    for (int s2 = 0; s2 < 2; ++s2) { v4u w; const f32x4 a0 = acc[2 * s2], a1 = acc[2 * s2 + 1];
        w.x = pk2(gelu_tanh(a0.x), gelu_tanh(a0.y)); w.y = pk2(gelu_tanh(a0.z), gelu_tanh(a0.w)); w.z = pk2(gelu_tanh(a1.x), gelu_tanh(a1.y)); w.w = pk2(gelu_tanh(a1.z), gelu_tanh(a1.w));
        hb[s2] = __builtin_bit_cast(bf16x8, w); }
    bf16* kcmp = (bf16*)(F.ws + WS_KCMP); bf16* vcmpT = (bf16*)(F.ws + WS_KCMP + 512 * 1024);
#pragma unroll
    for (int ntl = 0; ntl < 4; ++ntl) {
        f32x4 o = (f32x4){0.f, 0.f, 0.f, 0.f};
#pragma unroll
        for (int s2 = 0; s2 < 2; ++s2) { const bf16* wp = w2T + (size_t)(16 * ntl + fr) * 64 + 32 * s2 + 4 * fq; const v2u lo = *(const v2u*)wp, hi = *(const v2u*)(wp + 16);
            v4u aw; aw.x = lo.x; aw.y = lo.y; aw.z = hi.x; aw.w = hi.y; o = MFMA16(__builtin_bit_cast(bf16x8, aw), hb[s2], o); }
        if (!jvalid) o = (f32x4){0.f, 0.f, 0.f, 0.f};
        const int jj = j0 + fr, n = 16 * ntl + 4 * fq;
        if (kv == 0) *(v2u*)(kcmp + ((size_t)bg * 128 + jj) * 64 + n) = pk4(o);
        else { const v2u w = pk4(o); bf16* vp = vcmpT + ((size_t)bg * 64 + n) * 128 + jj; vp[0] = (bf16)(w.x & 0xffff); vp[128] = (bf16)(w.x >> 16); vp[256] = (bf16)(w.y & 0xffff); vp[384] = (bf16)(w.y >> 16); }
    }
}
__device__ __forceinline__ void zgate_task(Frame& F, int tile) {
    const int fr = F.lane & 15, fq = F.lane >> 4, m0 = tile * 16;
    const bf16* XN = (const bf16*)(F.ws + WS_XN); const bf16* gw = (const bf16*)(F.ws + WS_SMALLW + SW_GATEW);
    f32x4 acc[2] = {(f32x4){0.f, 0.f, 0.f, 0.f}, (f32x4){0.f, 0.f, 0.f, 0.f}};
#pragma unroll 16
    for (int ks = 0; ks < 32; ++ks) {
        const bf16x8 bop = *(const bf16x8*)(XN + (size_t)(m0 + fr) * D + 32 * ks + 8 * fq);
#pragma unroll
        for (int ct = 0; ct < 2; ++ct) { const bf16x8 aop = *(const bf16x8*)(gw + (size_t)(16 * ct + fr) * D + 32 * ks + 8 * fq); acc[ct] = MFMA16(aop, bop, acc[ct]); }
    }
    float* zg = (float*)(F.ws + WS_ZGATE);
#pragma unroll
    for (int ct = 0; ct < 2; ++ct) *(f32x4*)(zg + (size_t)(m0 + fr) * 32 + 16 * ct + 4 * fq) = acc[ct];
}
__device__ __forceinline__ void vt_task(Frame& F, int idx) {
    const int which = idx & 1, blk = (idx >> 1) & 31, bg = idx >> 6, b = bg >> 1, g = bg & 1;
    const bf16* z = (const bf16*)(F.ws + WS_Z);
    bf16* vT = (bf16*)(F.ws + (which ? WS_VWT : WS_VST));
    const int t = 64 * blk + F.lane;
    const bf16* src = z + ((size_t)b * SEQ + t) * NZ + (which ? ZC_VW : ZC_VS) + g * 64;
#pragma unroll
    for (int dc = 0; dc < 8; ++dc) { const v4u w = *(const v4u*)(src + 8 * dc); bf16* dst = vT + ((size_t)bg * 64 + 8 * dc) * SEQ + t;
        dst[0 * SEQ] = (bf16)(w.x & 0xffff); dst[1 * SEQ] = (bf16)(w.x >> 16); dst[2 * SEQ] = (bf16)(w.y & 0xffff); dst[3 * SEQ] = (bf16)(w.y >> 16);
        dst[4 * SEQ] = (bf16)(w.z & 0xffff); dst[5 * SEQ] = (bf16)(w.z >> 16); dst[6 * SEQ] = (bf16)(w.w & 0xffff); dst[7 * SEQ] = (bf16)(w.w >> 16); }
}
__device__ __forceinline__ void alora_task4(Frame& F, int mb) {
    const bf16* z = (const bf16*)(F.ws + WS_Z); bf16* AL = (bf16*)(F.ws + WS_PBF);
    const int l = F.lane;
    const f32x4 mu = *(const f32x4*)(F.ap->in[4] + ZC_W + 4 * l);
    v2u cw[4], pw[4];
#pragma unroll
    for (int u = 0; u < 4; ++u) { const int m = mb + u * F.NGW; const int t = m & (SEQ - 1); cw[u] = *(const v2u*)(z + (size_t)m * NZ + ZC_W + 4 * l); pw[u] = *(const v2u*)(z + (size_t)(t > 0 ? m - 1 : m) * NZ + ZC_W + 4 * l); }
#pragma unroll
    for (int u = 0; u < 4; ++u) { const int m = mb + u * F.NGW; const int t = m & (SEQ - 1);
        const f32x4 cur = unpk4(cw[u]); const f32x4 prev = unpk4(pw[u]) * (t > 0 ? 1.0f : 0.0f);
        f32x4 s = cur + (prev - cur) * mu;
        if (l < 16) { s.x = tanhf(s.x); s.y = tanhf(s.y); s.z = tanhf(s.z); s.w = tanhf(s.w); }
        else if (l >= 32) { s.x = sigmoidf_(s.x); s.y = sigmoidf_(s.y); s.z = sigmoidf_(s.z); s.w = sigmoidf_(s.w); }
        *(v2u*)(AL + (size_t)m * 256 + 4 * l) = pk4(s); }
}
__device__ __forceinline__ void p2_prep(Frame& F) {
    constexpr int T1 = 1024, T2 = T1 + 1024;
    for (int it = F.vcu; it < 256; it += F.G) compress_wg_task(F, it);
    for (int task = F.gw; task < T2; task += F.NGW) {
        if (task < T1) zgate_task(F, task);
        else vt_task(F, task - T1);
    }
    for (int base = F.gw; base < M; base += 4 * F.NGW) alora_task4(F, base);
}

__device__ __forceinline__ void ld16(const bf16* p, float (&f)[16]) { float a[8], b[8]; unpk8(*(const v4u*)p, a); unpk8(*(const v4u*)(p + 8), b);
#pragma unroll
    for (int i = 0; i < 8; ++i) { f[i] = a[i]; f[8 + i] = b[i]; } }
__device__ __forceinline__ void ld16f(const float* p, float (&f)[16]) {
#pragma unroll
    for (int q = 0; q < 4; ++q) { const f32x4 v = *(const f32x4*)(p + 4 * q); f[4 * q] = v.x; f[4 * q + 1] = v.y; f[4 * q + 2] = v.z; f[4 * q + 3] = v.w; } }
__device__ __forceinline__ void st16(bf16* p, const float (&f)[16]) { v4u a, b; a.x = pk2(f[0], f[1]); a.y = pk2(f[2], f[3]); a.z = pk2(f[4], f[5]); a.w = pk2(f[6], f[7]); b.x = pk2(f[8], f[9]); b.y = pk2(f[10], f[11]); b.z = pk2(f[12], f[13]); b.w = pk2(f[14], f[15]);
    *(v4u*)p = a; *(v4u*)(p + 8) = b; }
struct PrepW { bf16x8 w[2], a[2], g[4]; };
constexpr int PW_OFF = 32768, PW_P64 = 144, PW_P128 = 272, PW_A_OFF = PW_OFF + 64 * PW_P64, PW_G_OFF = PW_A_OFF + 64 * PW_P64;
__device__ __forceinline__ void prep_stage_w(Frame& F, int h) {
    const bf16* w2T = (const bf16*)(F.ws + WS_SMALLW + SW_W2T) + (size_t)h * 64 * 64; const bf16* a2T = (const bf16*)(F.ws + WS_SMALLW + SW_A2T) + (size_t)h * 64 * 64; const bf16* g2T = (const bf16*)(F.ws + WS_SMALLW + SW_G2T) + (size_t)h * 64 * 128;
    { const int R = F.tid >> 3, c = F.tid & 7, slot = ((R >> 2) & 3) * 16 + (R >> 4) * 4 + (R & 3);
      *(LAS v4u*)(F.lds + PW_OFF + slot * PW_P64 + c * 16) = *(const v4u*)(w2T + R * 64 + c * 8); *(LAS v4u*)(F.lds + PW_A_OFF + slot * PW_P64 + c * 16) = *(const v4u*)(a2T + R * 64 + c * 8); }
#pragma unroll
    for (int i = 0; i < 2; ++i) { const int id = F.tid + 512 * i, R = id >> 4, c = id & 15, slot = ((R >> 2) & 3) * 16 + (R >> 4) * 4 + (R & 3);
      *(LAS v4u*)(F.lds + PW_G_OFF + slot * PW_P128 + c * 16) = *(const v4u*)(g2T + R * 128 + c * 8); }
}
__device__ __forceinline__ void prep_ldw(PrepW& W, const LAS unsigned char* lds, int n, int fr, int fq) {
#pragma unroll
    for (int ks = 0; ks < 2; ++ks) { W.w[ks] = *(const LAS bf16x8*)(lds + PW_OFF + (n * 16 + fr) * PW_P64 + 64 * ks + 16 * fq); W.a[ks] = *(const LAS bf16x8*)(lds + PW_A_OFF + (n * 16 + fr) * PW_P64 + 64 * ks + 16 * fq); }
#pragma unroll
    for (int ks = 0; ks < 4; ++ks) W.g[ks] = *(const LAS bf16x8*)(lds + PW_G_OFF + (n * 16 + fr) * PW_P128 + 64 * ks + 16 * fq);
}
__device__ __forceinline__ void ldpar(const LAS float* p, float (&f)[16]) {
#pragma unroll
    for (int q = 0; q < 4; ++q) { const f32x4 v = *(const LAS f32x4*)(p + 4 * q); f[4 * q] = v.x; f[4 * q + 1] = v.y; f[4 * q + 2] = v.z; f[4 * q + 3] = v.w; } }
__device__ __forceinline__ void rwkv_prep_task(Frame& F, int task, const LAS float* par) {
    const int h = task & 7, m0 = (task >> 3) * 16, fr = F.lane & 15, fq = F.lane >> 4, m = m0 + fr, t = m & (SEQ - 1);
    const bf16* z = (const bf16*)(F.ws + WS_Z); const bf16* AL = (const bf16*)(F.ws + WS_PBF);
    bf16* vbuf = (bf16*)F.out; bf16* gbuf = (bf16*)(F.ws + WS_G);
    const int cl = h * 64 + 16 * fq;
    bf16x8 bw[2], ba[2], bgf[4];
    const bf16* alr = AL + (size_t)m * 256 + 8 * fq;
#pragma unroll
    for (int ks = 0; ks < 2; ++ks) { bw[ks] = *(const bf16x8*)(alr + 32 * ks); ba[ks] = *(const bf16x8*)(alr + 64 + 32 * ks); }
#pragma unroll
    for (int ks = 0; ks < 4; ++ks) bgf[ks] = *(const bf16x8*)(alr + 128 + 32 * ks);
    const bf16* zc = z + (size_t)m * NZ + cl; const bf16* zp = (t > 0) ? zc - NZ : zc;
    v4u zraw[6][2];
#pragma unroll
    for (int q = 0; q < 3; ++q) { zraw[q][0] = *(const v4u*)(zc + 512 * q); zraw[q][1] = *(const v4u*)(zc + 512 * q + 8); zraw[3 + q][0] = *(const v4u*)(zp + 512 * q); zraw[3 + q][1] = *(const v4u*)(zp + 512 * q + 8); }
    __builtin_amdgcn_sched_barrier(0);
    float ev[16], av[16], gv[16];
#define PREP_MM(W, n) do { f32x4 accw = (f32x4){0.f, 0.f, 0.f, 0.f}, acca = accw, accg = accw; \
        _Pragma("unroll") for (int ks = 0; ks < 2; ++ks) { accw = MFMA16(W.w[ks], bw[ks], accw); acca = MFMA16(W.a[ks], ba[ks], acca); } \
        _Pragma("unroll") for (int ks = 0; ks < 4; ++ks) accg = MFMA16(W.g[ks], bgf[ks], accg); \
        _Pragma("unroll") for (int r = 0; r < 4; ++r) { ev[4 * (n) + r] = accw[r]; av[4 * (n) + r] = acca[r]; gv[4 * (n) + r] = accg[r]; } } while (0)
    { PrepW Wa, Wb;
      prep_ldw(Wa, F.lds, 0, fr, fq); prep_ldw(Wb, F.lds, 1, fr, fq); PREP_MM(Wa, 0); PREP_MM(Wb, 1);
      prep_ldw(Wa, F.lds, 2, fr, fq); prep_ldw(Wb, F.lds, 3, fr, fq); PREP_MM(Wa, 2); PREP_MM(Wb, 3); }
    float zr[16], zk[16], zv[16], tmp[16];
    const float pm = (t > 0) ? 1.0f : 0.0f;
    {   float c[16], p[16];
#define PREP_UNP(q, dst) do { float a_[8], b_[8]; unpk8(zraw[q][0], a_); unpk8(zraw[q][1], b_); _Pragma("unroll") for (int i = 0; i < 8; ++i) { dst[i] = a_[i]; dst[8 + i] = b_[i]; } } while (0)
        PREP_UNP(0, c); PREP_UNP(3, p); ldpar(par + 0 * 64 + 16 * fq, tmp);
#pragma unroll
        for (int e = 0; e < 16; ++e) zr[e] = c[e] + (p[e] * pm - c[e]) * tmp[e];
        PREP_UNP(1, c); PREP_UNP(4, p); ldpar(par + 1 * 64 + 16 * fq, tmp);
#pragma unroll
        for (int e = 0; e < 16; ++e) zk[e] = c[e] + (p[e] * pm - c[e]) * tmp[e];
        PREP_UNP(2, c); PREP_UNP(5, p); ldpar(par + 2 * 64 + 16 * fq, tmp);
#pragma unroll
        for (int e = 0; e < 16; ++e) zv[e] = c[e] + (p[e] * pm - c[e]) * tmp[e];
    }
    float kkr[16]; float ss = 0.f;
    ldpar(par + 3 * 64 + 16 * fq, tmp);
#pragma unroll
    for (int e = 0; e < 16; ++e) { const float x = -(tmp[e] + ev[e]); const float sp = fmaxf(x, 0.f) + __logf(1.0f + __expf(-fabsf(x))); ev[e] = __expf(-sp - 0.5f); }
    ldpar(par + 4 * 64 + 16 * fq, tmp);
#pragma unroll
    for (int e = 0; e < 16; ++e) av[e] = sigmoidf_(tmp[e] + av[e]);
    ldpar(par + 5 * 64 + 16 * fq, tmp);
#pragma unroll
    for (int e = 0; e < 16; ++e) { kkr[e] = zk[e] * tmp[e]; ss += kkr[e] * kkr[e]; }
    ss += __shfl_xor(ss, 16); ss += __shfl_xor(ss, 32);
    const float inv = 1.0f / fmaxf(sqrtf(ss), 1e-12f);
    ldpar(par + 6 * 64 + 16 * fq, tmp);
    float kp[16], kka[16];
#pragma unroll
    for (int e = 0; e < 16; ++e) { kkr[e] *= inv; kka[e] = kkr[e] * av[e]; kp[e] = zk[e] * (1.0f + (av[e] - 1.0f) * tmp[e]); }
    st16(vbuf + (size_t)m * 512 + cl, zv); st16(gbuf + (size_t)m * 512 + cl, gv);
    { ldpar(par + 7 * 64 + 16 * fq, tmp);
      float bsum = 0.f;
#pragma unroll
      for (int e = 0; e < 16; ++e) bsum += zr[e] * kp[e] * tmp[e];
      bsum += __shfl_xor(bsum, 16); bsum += __shfl_xor(bsum, 32);
      if (fq == 0) ((float*)(F.ws + WS_BONUS))[(size_t)m * 8 + h] = bsum; }
    asm volatile("" ::: "memory");
    unsigned char* rec = F.ws + WS_S + (size_t)task * CH_REC;
    bf16x8 Pb[2], Qb[2], Kb[2], Rb[2];
#pragma unroll
    for (int ks = 0; ks < 2; ++ks) {
        float Pm[8], Qm[8], Km[8], Rm[8], acv[8];
#pragma unroll
        for (int e8 = 0; e8 < 8; ++e8) { const int e = 8 * ks + e8;
            float cs = ev[e]; cs += dppf<0x111>(cs); cs += dppf<0x112>(cs); cs += dppf<0x114>(cs); cs += dppf<0x118>(cs);
            const float A = __expf(-cs), Ap = __expf(ev[e] - cs), iA = __expf(cs);
            Pm[e8] = kkr[e] * Ap; Qm[e8] = -kka[e] * iA; Km[e8] = kp[e] * iA; Rm[e8] = zr[e] * A; acv[e8] = A; }
        v4u w;
        w.x = pk2(Pm[0], Pm[1]); w.y = pk2(Pm[2], Pm[3]); w.z = pk2(Pm[4], Pm[5]); w.w = pk2(Pm[6], Pm[7]); Pb[ks] = __builtin_bit_cast(bf16x8, w);
        w.x = pk2(Qm[0], Qm[1]); w.y = pk2(Qm[2], Qm[3]); w.z = pk2(Qm[4], Qm[5]); w.w = pk2(Qm[6], Qm[7]); Qb[ks] = __builtin_bit_cast(bf16x8, w);
        w.x = pk2(Km[0], Km[1]); w.y = pk2(Km[2], Km[3]); w.z = pk2(Km[4], Km[5]); w.w = pk2(Km[6], Km[7]); Kb[ks] = __builtin_bit_cast(bf16x8, w);
        w.x = pk2(Rm[0], Rm[1]); w.y = pk2(Rm[2], Rm[3]); w.z = pk2(Rm[4], Rm[5]); w.w = pk2(Rm[6], Rm[7]); Rb[ks] = __builtin_bit_cast(bf16x8, w);
        if (fr == 15) { *(f32x4*)(rec + CH_AC + (16 * fq + 8 * ks) * 4) = (f32x4){acv[0], acv[1], acv[2], acv[3]}; *(f32x4*)(rec + CH_AC + (16 * fq + 8 * ks + 4) * 4) = (f32x4){acv[4], acv[5], acv[6], acv[7]}; }
    }
    *(v4u*)(rec + CH_P + fr * CH_PP + 32 * fq) = __builtin_bit_cast(v4u, Pb[0]); *(v4u*)(rec + CH_P + fr * CH_PP + 32 * fq + 16) = __builtin_bit_cast(v4u, Pb[1]);
    *(v4u*)(rec + CH_R + fr * CH_PP + 32 * fq) = __builtin_bit_cast(v4u, Rb[0]); *(v4u*)(rec + CH_R + fr * CH_PP + 32 * fq + 16) = __builtin_bit_cast(v4u, Rb[1]);
    *(v4u*)(rec + CH_Q + (fq * 16 + fr) * 32) = __builtin_bit_cast(v4u, Qb[0]); *(v4u*)(rec + CH_Q + (fq * 16 + fr) * 32 + 16) = __builtin_bit_cast(v4u, Qb[1]);
    *(v4u*)(rec + CH_K + (fq * 16 + fr) * 32) = __builtin_bit_cast(v4u, Kb[0]); *(v4u*)(rec + CH_K + (fq * 16 + fr) * 32 + 16) = __builtin_bit_cast(v4u, Kb[1]);
    f32x4 gqp = (f32x4){0.f, 0.f, 0.f, 0.f}, gkp = gqp, gqr = gqp, gkr = gqp;
#pragma unroll
    for (int ks = 0; ks < 2; ++ks) { gqp = MFMA16(Qb[ks], Pb[ks], gqp); gkp = MFMA16(Kb[ks], Pb[ks], gkp); gqr = MFMA16(Qb[ks], Rb[ks], gqr); gkr = MFMA16(Kb[ks], Rb[ks], gkr); }
#pragma unroll
    for (int rg = 0; rg < 4; ++rg) { const int s = 4 * fq + rg; if (!(s < fr)) { gqp[rg] = 0.f; gkp[rg] = 0.f; } if (!(s <= fr)) { gqr[rg] = 0.f; gkr[rg] = 0.f; } }
    *(v2u*)(rec + CH_G + 0 * 512 + (fr * 16 + 4 * fq) * 2) = pk4(gkp);
    *(v2u*)(rec + CH_G + 2 * 512 + (fr * 16 + 4 * fq) * 2) = pk4(gqr);
    *(v2u*)(rec + CH_G + 3 * 512 + (fr * 16 + 4 * fq) * 2) = pk4(gkr);
    LAS float* Nl = (LAS float*)(F.lds + F.wave * 4096);
#pragma unroll
    for (int rg = 0; rg < 4; ++rg) Nl[(4 * fq + rg) * 20 + fr] = gqp[rg];
    LDS_WAIT(); __builtin_amdgcn_wave_barrier(); asm volatile("" ::: "memory");
    float Tc[16];
#pragma unroll
    for (int s = 15; s >= 0; --s) {
        float acc = 0.f;
#pragma unroll
        for (int q4 = 0; q4 < 4; ++q4) if (4 * q4 + 3 > s) { const f32x4 nv = *(const LAS f32x4*)(Nl + s * 20 + 4 * q4);
#pragma unroll
            for (int u = 0; u < 4; ++u) if (4 * q4 + u > s) acc += nv[u] * Tc[4 * q4 + u]; }
        Tc[s] = (s == fr) ? 1.0f : acc; }
    { f32x4 tv;
#pragma unroll
      for (int u = 0; u < 4; ++u) tv[u] = fq == 0 ? Tc[u] : (fq == 1 ? Tc[4 + u] : (fq == 2 ? Tc[8 + u] : Tc[12 + u]));
      *(v2u*)(rec + CH_G + 1 * 512 + (fr * 16 + 4 * fq) * 2) = pk4(tv); }
    LDS_WAIT(); __builtin_amdgcn_wave_barrier(); asm volatile("" ::: "memory");
#undef PREP_MM
#undef PREP_UNP
}
__device__ __forceinline__ void prep_fill_par(Frame& F, LAS float* par, int h) {
    const int l = F.lane; const float* mu = F.ap->in[4];
    par[0 * 64 + l] = mu[ZC_R + h * 64 + l]; par[1 * 64 + l] = mu[ZC_K + h * 64 + l]; par[2 * 64 + l] = mu[ZC_V + h * 64 + l];
    par[3 * 64 + l] = F.ap->in[5][h * 64 + l]; par[4 * 64 + l] = F.ap->in[7][h * 64 + l]; par[5 * 64 + l] = F.ap->in[10][h * 64 + l]; par[6 * 64 + l] = F.ap->in[11][h * 64 + l]; par[7 * 64 + l] = F.ap->in[12][h * 64 + l];
    LDS_WAIT(); __builtin_amdgcn_wave_barrier(); asm volatile("" ::: "memory");
}

__device__ __forceinline__ float nsa_slope(int g, int r) { return __uint_as_float((unsigned)(127 - (g * 4 + r + 1)) << 23); }

constexpr int CMP_KC_OFF = 32768, CMP_KP = 144, CMP_VC_OFF = CMP_KC_OFF + 128 * CMP_KP, CMP_VP = 264;
__device__ __forceinline__ void nsa_cmp_stage(Frame& F, int bg) {
    const bf16* kcmp = (const bf16*)(F.ws + WS_KCMP) + (size_t)bg * 128 * 64; const bf16* vcmpT = (const bf16*)(F.ws + WS_KCMP + 512 * 1024) + (size_t)bg * 64 * 128;
    v4u a[2], v[2];
#pragma unroll
    for (int i = 0; i < 2; ++i) { const int id = F.tid + 512 * i; a[i] = *(const v4u*)(kcmp + (size_t)(id >> 3) * 64 + (id & 7) * 8); v[i] = *(const v4u*)(vcmpT + (size_t)(id >> 4) * 128 + (id & 15) * 8); }
#pragma unroll
    for (int i = 0; i < 2; ++i) { const int id = F.tid + 512 * i; *(LAS v4u*)(F.lds + CMP_KC_OFF + (id >> 3) * CMP_KP + (id & 7) * 16) = a[i]; *(LAS v4u*)(F.lds + CMP_VC_OFF + (id >> 4) * CMP_VP + (id & 15) * 16) = v[i]; }
}
template <int ABL>
__device__ __forceinline__ void nsa_cmp_task(Frame& F, int task) {
    const int tile = task & 127, bg = task >> 7, b = bg >> 1, g = bg & 1;
    const int fr = F.lane & 15, fq = F.lane >> 4, t = tile * 16 + fr, m = b * SEQ + t;
    const bf16* z = (const bf16*)(F.ws + WS_Z);
    const float* zg = (const float*)(F.ws + WS_ZGATE); const float* gb = F.ap->in[21];
    bf16* Y = (bf16*)(F.ws + WS_YB);
    bf16x8 qall[4][2]; float gl[4];
#pragma unroll
    for (int r = 0; r < 4; ++r) { const bf16* qp = z + (size_t)m * NZ + ZC_Q + (g * 4 + r) * 64 + 8 * fq; qall[r][0] = *(const bf16x8*)qp; qall[r][1] = *(const bf16x8*)(qp + 32);
        gl[r] = zg[(size_t)m * 32 + (g * 4 + r) * 3 + 0] + gb[(g * 4 + r) * 3 + 0]; }
    const LAS unsigned char* kc = F.lds + CMP_KC_OFF + fr * CMP_KP + 16 * fq; const LAS unsigned char* vc = F.lds + CMP_VC_OFF + fr * CMP_VP + 8 * fq;
    const int tv = t - 31 - 64 * fq; const float tb = (float)t - 15.5f - 64.0f * (float)fq;
    float impl[8], imp3[8];
#pragma unroll
    for (int kt = 0; kt < 8; ++kt) { impl[kt] = 0.f; imp3[kt] = 0.f; }
#pragma unroll
    for (int r = 0; r < 4; ++r) {
        const float slope = nsa_slope(g, r);
        const bf16x8 q0 = qall[r][0], q1 = qall[r][1];
        float s[8][4]; float mx = -1e30f;
#pragma unroll
        for (int kt = 0; kt < 8; ++kt) {
            f32x4 a = (f32x4){0.f, 0.f, 0.f, 0.f};
            a = MFMA16(*(const LAS bf16x8*)(kc + 16 * kt * CMP_KP), q0, a); a = MFMA16(*(const LAS bf16x8*)(kc + 16 * kt * CMP_KP + 64), q1, a);
#pragma unroll
            for (int rg = 0; rg < 4; ++rg) { const bool valid = ((256 * kt + 16 * rg) <= tv);
                const float sc = a[rg] * 0.125f - slope * (tb - (float)(256 * kt + 16 * rg)); s[kt][rg] = valid ? sc : -1e30f; mx = fmaxf(mx, s[kt][rg]); }
        }
        mx = fmaxf(mx, __shfl_xor(mx, 16)); mx = fmaxf(mx, __shfl_xor(mx, 32));
        float sum = 0.f;
#pragma unroll
        for (int kt = 0; kt < 8; ++kt)
#pragma unroll
            for (int rg = 0; rg < 4; ++rg) { const float p = (s[kt][rg] > -1e29f) ? __expf(s[kt][rg] - mx) : 0.f; s[kt][rg] = p; sum += p; }
        sum += __shfl_xor(sum, 16); sum += __shfl_xor(sum, 32);
        const float inv = sum > 0.f ? 1.0f / sum : 0.f;
#pragma unroll
        for (int kt = 0; kt < 8; ++kt) {
#pragma unroll
            for (int rg = 0; rg < 4; ++rg) s[kt][rg] *= inv;
            impl[kt] += s[kt][0] + s[kt][1] + s[kt][2] + 0.5f * s[kt][3]; imp3[kt] += s[kt][3]; }
        f32x4 o[4];
#pragma unroll
        for (int dt = 0; dt < 4; ++dt) o[dt] = (f32x4){0.f, 0.f, 0.f, 0.f};
#pragma unroll
        for (int s2 = 0; s2 < 4; ++s2) {
            v4u pw; pw.x = pk2(s[2 * s2][0], s[2 * s2][1]); pw.y = pk2(s[2 * s2][2], s[2 * s2][3]); pw.z = pk2(s[2 * s2 + 1][0], s[2 * s2 + 1][1]); pw.w = pk2(s[2 * s2 + 1][2], s[2 * s2 + 1][3]);
            const bf16x8 pb = __builtin_bit_cast(bf16x8, pw);
#pragma unroll
            for (int dt = 0; dt < 4; ++dt) { const LAS unsigned char* vp = vc + 16 * dt * CMP_VP + 64 * s2; const v2u lo = *(const LAS v2u*)vp, hi = *(const LAS v2u*)(vp + 32);
                v4u aw; aw.x = lo.x; aw.y = lo.y; aw.z = hi.x; aw.w = hi.y; o[dt] = MFMA16(__builtin_bit_cast(bf16x8, aw), pb, o[dt]); }
        }
        const int hh = g * 4 + r; const float gate = sigmoidf_(gl[r]);
#pragma unroll
        for (int dt = 0; dt < 4; ++dt) *(v2u*)(Y + (size_t)m * 512 + hh * 64 + 16 * dt + 4 * fq) = pk4(o[dt] * gate);
        __builtin_amdgcn_sched_barrier(0);
    }
    if (ABL == 1) return;
    LAS float* sc = (LAS float*)(F.lds + F.wave * 4096);
    float y3prev = 0.f;
#pragma unroll
    for (int kt = 0; kt < 8; ++kt) {
        const float y3 = __shfl(imp3[kt], (F.lane + 48) & 63);
        const float prev = (fq > 0) ? y3 : y3prev; y3prev = y3;
        sc[fr * 33 + 4 * kt + fq] = impl[kt] + 0.5f * prev;
    }
    LDS_WAIT(); __builtin_amdgcn_wave_barrier(); asm volatile("" ::: "memory");
    const int blk_t = t >> 6, chi = blk_t - 2;
    unsigned mask = 1u | (1u << blk_t) | (blk_t > 0 ? (1u << (blk_t - 1)) : 0u);
#pragma unroll
    for (int kt = 0; kt < 8; ++kt) {
        const int k = 4 * kt + fq;
        if (k >= 1 && k <= chi) { const float me = sc[fr * 33 + k]; int rank = 0;
            for (int k2 = 1; k2 <= chi; ++k2) { const float o = sc[fr * 33 + k2]; rank += (o > me || (o == me && k2 < k)) ? 1 : 0; }
            if (rank < 5) mask |= (1u << k); }
    }
    mask |= (unsigned)__shfl_xor((int)mask, 16); mask |= (unsigned)__shfl_xor((int)mask, 32);
    if (fq == 0) ((unsigned*)(F.ws + WS_SELMASK))[(size_t)bg * SEQ + t] = mask;
    LDS_WAIT(); __builtin_amdgcn_wave_barrier(); asm volatile("" ::: "memory");
}
__device__ __forceinline__ void p3_phase(Frame& F) {
    constexpr int T0 = 2048, T1 = T0 + 8192;
#ifdef DUP_P3A
    for (int task = F.gw; task < T0; task += F.NGW) { __syncthreads(); nsa_cmp_stage(F, task >> 7); LDS_WAIT(); __syncthreads(); nsa_cmp_task<DUP_P3A>(F, task); }
    asm volatile("" ::: "memory");
#endif
    for (int task = F.gw; task < T0; task += F.NGW) { __syncthreads(); nsa_cmp_stage(F, task >> 7); LDS_WAIT(); __syncthreads(); nsa_cmp_task<0>(F, task); }
    asm volatile("" ::: "memory");
    const int h = F.vcu & 7;
    LAS float* par = (LAS float*)(F.lds + F.wave * 4096 + 2048);
    __syncthreads();
    prep_fill_par(F, par, h); prep_stage_w(F, h);
    LDS_WAIT(); __syncthreads();
#ifdef DUP_P3B
    for (int i = F.wave; i < 32; i += 8) rwkv_prep_task(F, (((F.vcu >> 3) + 32 * i) << 3) | h, par);
    asm volatile("" ::: "memory");
#endif
    for (int i = F.wave; i < 32; i += 8) rwkv_prep_task(F, (((F.vcu >> 3) + 32 * i) << 3) | h, par);
}

constexpr int NSA_KP = 144, NSA_VP = 136, NSA_BUF = 64 * NSA_KP + 64 * NSA_VP, NSA_CTL = 2 * NSA_BUF + 1024;
struct NsaState { f32x4 O[2][4]; float mrun[2], lrun[2]; };
template <int WHICH, bool MASKED>
__device__ __forceinline__ void nsa_block(NsaState& St, const LAS unsigned char* kb_, const LAS unsigned char* vb_, const bf16x8 (&qf)[2][2], int kb, unsigned mymask, int t, int fq, float slope0) {
    const int kpos0 = 64 * kb;
    bf16x8 kf[4][2];
#pragma unroll
    for (int kt = 0; kt < 4; ++kt) { kf[kt][0] = *(const LAS bf16x8*)(kb_ + 16 * kt * NSA_KP); kf[kt][1] = *(const LAS bf16x8*)(kb_ + 16 * kt * NSA_KP + 64); }
    const bool bsel = (mymask >> kb) & 1u; const int dbase = t - 4 * fq - kpos0;
    const float fdb = (float)dbase;
    bf16x8 P[2][2];
#pragma unroll
    for (int r = 0; r < 2; ++r) {
        const float slope = r ? 0.5f * slope0 : slope0;
        float s[4][4]; float bm = -1e30f;
        float base = -slope * fdb;
        const float s1 = slope, s2_ = 2.0f * slope, s3 = 3.0f * slope, s16 = 16.0f * slope;
#pragma unroll
        for (int kt = 0; kt < 4; ++kt) { f32x4 a = (f32x4){base, base + s1, base + s2_, base + s3}; base += s16;
            a = MFMA16(kf[kt][0], qf[r][0], a); a = MFMA16(kf[kt][1], qf[r][1], a);
#pragma unroll
            for (int rg = 0; rg < 4; ++rg) {
                if (MASKED) { const int dist = dbase - (16 * kt + rg); const bool valid = bsel && dist >= 0 && (WHICH == 0 || dist < 512); s[kt][rg] = valid ? a[rg] : -1e30f; }
                else s[kt][rg] = a[rg];
                bm = fmaxf(bm, s[kt][rg]); } }
        bm = fmaxf(bm, __shfl_xor(bm, 16)); bm = fmaxf(bm, __shfl_xor(bm, 32));
        const float mnew = fmaxf(St.mrun[r], bm); const float scale = __builtin_amdgcn_exp2f(St.mrun[r] - mnew); St.mrun[r] = mnew;
        float ps = 0.f;
#pragma unroll
        for (int kt = 0; kt < 4; ++kt)
#pragma unroll
            for (int rg = 0; rg < 4; ++rg) { float p = __builtin_amdgcn_exp2f(s[kt][rg] - mnew); if (MASKED) p = (s[kt][rg] > -1e29f) ? p : 0.f; s[kt][rg] = p; ps += p; }
        St.lrun[r] = St.lrun[r] * scale + ps;
#pragma unroll
        for (int dt = 0; dt < 4; ++dt) St.O[r][dt] = St.O[r][dt] * scale;
#pragma unroll
        for (int s2 = 0; s2 < 2; ++s2) { v4u pw; pw.x = pk2(s[2 * s2][0], s[2 * s2][1]); pw.y = pk2(s[2 * s2][2], s[2 * s2][3]); pw.z = pk2(s[2 * s2 + 1][0], s[2 * s2 + 1][1]); pw.w = pk2(s[2 * s2 + 1][2], s[2 * s2 + 1][3]);
            P[r][s2] = __builtin_bit_cast(bf16x8, pw); }
    }
#pragma unroll
    for (int dt = 0; dt < 4; ++dt)
#pragma unroll
        for (int s2 = 0; s2 < 2; ++s2) { const LAS unsigned char* vp = vb_ + 16 * dt * NSA_VP + 64 * s2; const v2u lo = *(const LAS v2u*)vp, hi = *(const LAS v2u*)(vp + 32);
            v4u aw; aw.x = lo.x; aw.y = lo.y; aw.z = hi.x; aw.w = hi.y; const bf16x8 vf = __builtin_bit_cast(bf16x8, aw);
#pragma unroll
            for (int r = 0; r < 2; ++r) St.O[r][dt] = MFMA16(vf, P[r][s2], St.O[r][dt]); }
}
template <int WHICH>
__device__ __forceinline__ void nsa_wg_task(Frame& F, int item) {
    const int hp = item & 1, bg = item >> 5, tg = (item >> 1) & 15, b = bg >> 1, g = bg & 1;
    const int fr = F.lane & 15, fq = F.lane >> 4, tile = tg * 8 + F.wave, t0 = tile * 16, t = t0 + fr, m = b * SEQ + t;
    const int h0 = g * 4 + 2 * hp;
    const bf16* z = (const bf16*)(F.ws + WS_Z);
    const bf16* Kb = z + (size_t)b * SEQ * NZ + (WHICH ? ZC_KW : ZC_KS) + g * 64;
    const bf16* VT = (const bf16*)(F.ws + (WHICH ? WS_VWT : WS_VST)) + (size_t)bg * 64 * SEQ;
    unsigned mymask, tile_or, full; const int kb_hi = (t0 + 15) >> 6;
    if (WHICH == 0) { mymask = ((const unsigned*)(F.ws + WS_SELMASK))[(size_t)bg * SEQ + t]; unsigned x = mymask, y = mymask;
        x |= (unsigned)__shfl_xor((int)x, 1); x |= (unsigned)__shfl_xor((int)x, 2); x |= (unsigned)__shfl_xor((int)x, 4); x |= (unsigned)__shfl_xor((int)x, 8);
        y &= (unsigned)__shfl_xor((int)y, 1); y &= (unsigned)__shfl_xor((int)y, 2); y &= (unsigned)__shfl_xor((int)y, 4); y &= (unsigned)__shfl_xor((int)y, 8);
        tile_or = (unsigned)__builtin_amdgcn_readfirstlane((int)x); full = (unsigned)__builtin_amdgcn_readfirstlane((int)y) & ((1u << kb_hi) - 1u); }
    else { mymask = 0xffffffffu; const int lo = (t0 - 511) > 0 ? ((t0 - 511) >> 6) : 0; tile_or = 0u; full = 0u;
        for (int k = lo; k <= kb_hi; ++k) { tile_or |= (1u << k); if (k < kb_hi && 64 * k >= t0 - 496) full |= (1u << k); } }
    tile_or &= (kb_hi >= 31) ? 0xffffffffu : ((2u << kb_hi) - 1u);
    LAS unsigned* ctl = (LAS unsigned*)(F.lds + NSA_CTL);
    __syncthreads();
    if (F.lane == 0) ctl[F.wave] = tile_or;
    LDS_WAIT(); __syncthreads();
    unsigned rem = 0u;
#pragma unroll
    for (int w = 0; w < 8; ++w) rem |= ctl[w];
    rem = (unsigned)__builtin_amdgcn_readfirstlane((int)rem);
    bf16x8 qf[2][2];
#pragma unroll
    for (int r = 0; r < 2; ++r)
#pragma unroll
        for (int ks = 0; ks < 2; ++ks) { const v4u raw = *(const v4u*)(z + (size_t)m * NZ + ZC_Q + (h0 + r) * 64 + 8 * fq + 32 * ks); float f[8]; unpk8(raw, f);
            constexpr float QS = 0.125f * 1.4426950408889634f; v4u w; w.x = pk2(f[0] * QS, f[1] * QS); w.y = pk2(f[2] * QS, f[3] * QS); w.z = pk2(f[4] * QS, f[5] * QS); w.w = pk2(f[6] * QS, f[7] * QS);
            qf[r][ks] = __builtin_bit_cast(bf16x8, w); }
    NsaState St;
#pragma unroll
    for (int r = 0; r < 2; ++r) { St.mrun[r] = -1e30f; St.lrun[r] = 0.f;
#pragma unroll
        for (int dt = 0; dt < 4; ++dt) St.O[r][dt] = (f32x4){0.f, 0.f, 0.f, 0.f}; }
    const float slope0 = 1.4426950408889634f * __uint_as_float((unsigned)(127 - (h0 + 1)) << 23);
    const int srow = F.tid >> 3, sc = F.tid & 7;
    const bf16* ksrc = Kb + (size_t)srow * NZ + sc * 8; const bf16* vsrc = VT + (size_t)srow * SEQ + sc * 8;
    const int kdst = srow * NSA_KP + sc * 16, vdst = 64 * NSA_KP + srow * NSA_VP + sc * 16;
    const LAS unsigned char* kfr = F.lds + fr * NSA_KP + 16 * fq; const LAS unsigned char* vfr = F.lds + 64 * NSA_KP + fr * NSA_VP + 8 * fq;
    int kb = __builtin_ctz(rem); rem &= rem - 1u;
    v4u kreg = *(const v4u*)(ksrc + (size_t)64 * kb * NZ), vreg = *(const v4u*)(vsrc + 64 * kb);
    *(LAS v4u*)(F.lds + kdst) = kreg; *(LAS v2u*)(F.lds + vdst) = (v2u){vreg.x, vreg.y}; *(LAS v2u*)(F.lds + vdst + 8) = (v2u){vreg.z, vreg.w};
    LDS_WAIT(); __syncthreads();
    int buf = 0;
    for (;;) {
        int kbn = -1;
        if (rem) { kbn = __builtin_ctz(rem); rem &= rem - 1u; kreg = *(const v4u*)(ksrc + (size_t)64 * kbn * NZ); vreg = *(const v4u*)(vsrc + 64 * kbn); }
        __builtin_amdgcn_sched_barrier(0);
        if ((tile_or >> kb) & 1u) {
            if ((full >> kb) & 1u) nsa_block<WHICH, false>(St, kfr + buf * NSA_BUF, vfr + buf * NSA_BUF, qf, kb, mymask, t, fq, slope0);
            else nsa_block<WHICH, true>(St, kfr + buf * NSA_BUF, vfr + buf * NSA_BUF, qf, kb, mymask, t, fq, slope0);
        }
        __builtin_amdgcn_sched_barrier(0);
        if (kbn < 0) break;
        buf ^= 1;
        *(LAS v4u*)(F.lds + buf * NSA_BUF + kdst) = kreg; *(LAS v2u*)(F.lds + buf * NSA_BUF + vdst) = (v2u){vreg.x, vreg.y}; *(LAS v2u*)(F.lds + buf * NSA_BUF + vdst + 8) = (v2u){vreg.z, vreg.w};
        LDS_WAIT(); __syncthreads();
        kb = kbn;
    }
    const float* zg = (const float*)(F.ws + WS_ZGATE); const float* gb = F.ap->in[21];
    bf16* Y = (bf16*)(F.ws + WS_YB + (size_t)(1 + WHICH) * 16 * MiB);
#pragma unroll
    for (int r = 0; r < 2; ++r) { float l = St.lrun[r]; l += __shfl_xor(l, 16); l += __shfl_xor(l, 32);
        const int hh = h0 + r; const float gate = sigmoidf_(zg[(size_t)m * 32 + hh * 3 + 1 + WHICH] + gb[hh * 3 + 1 + WHICH]); const float f = gate / l;
#pragma unroll
        for (int dt = 0; dt < 4; ++dt) *(v2u*)(Y + (size_t)m * 512 + hh * 64 + 16 * dt + 4 * fq) = pk4(St.O[r][dt] * f); }
}
__device__ __forceinline__ void p4_phase(Frame& F) {
    for (int it = F.vcu; it < 512; it += F.G) { nsa_wg_task<1>(F, it); nsa_wg_task<0>(F, 511 - it); }
}

typedef short v4i16_t __attribute__((ext_vector_type(4)));
__device__ __forceinline__ bf16x8 tr_lo(const LAS unsigned char* p) {
    const v4i16_t t = __builtin_amdgcn_ds_read_tr16_b64_v4i16((LAS v4i16_t*)p);
    return (bf16x8){t[0], t[1], t[2], t[3], 0, 0, 0, 0};
}
__device__ __forceinline__ bf16x8 lo4(v2u g) { v4u w; w.x = g.x; w.y = g.y; w.z = 0u; w.w = 0u; return __builtin_bit_cast(bf16x8, w); }
__device__ __forceinline__ bf16x8 cat8(v2u a, v2u b) { v4u w; w.x = a.x; w.y = a.y; w.z = b.x; w.w = b.y; return __builtin_bit_cast(bf16x8, w); }
struct ChunkOps { v2u pA[2][2], rA[2][2], g[4]; f32x4 ac[4]; bf16x8 aq[4], ak[4], bv; };
__device__ __forceinline__ void chunk_load(const LAS unsigned char* sl, ChunkOps& X, int lane) {
    const int fr = lane & 15, fq = lane >> 4;
#pragma unroll
    for (int m = 0; m < 2; ++m) { X.pA[m][0] = *(const LAS v2u*)(sl + CH_P + fr * CH_PP + 64 * m + 8 * fq); X.pA[m][1] = *(const LAS v2u*)(sl + CH_P + fr * CH_PP + 64 * m + 32 + 8 * fq);
        X.rA[m][0] = *(const LAS v2u*)(sl + CH_R + fr * CH_PP + 64 * m + 8 * fq); X.rA[m][1] = *(const LAS v2u*)(sl + CH_R + fr * CH_PP + 64 * m + 32 + 8 * fq); }
#pragma unroll
    for (int x = 0; x < 4; ++x) X.g[x] = *(const LAS v2u*)(sl + CH_G + 512 * x + (fr * 16 + 4 * fq) * 2);
    X.bv = tr_lo(sl + CH_V + 8 * lane);
#pragma unroll
    for (int jt = 0; jt < 4; ++jt) { X.aq[jt] = tr_lo(sl + CH_Q + jt * 512 + 8 * lane); X.ak[jt] = tr_lo(sl + CH_K + jt * 512 + 8 * lane);
        X.ac[jt] = *(const LAS f32x4*)(sl + CH_AC + (16 * jt + 4 * fq) * 4); }
}
__device__ __forceinline__ bf16x8 lo4t(bf16x8 t) { return t; }
__device__ __forceinline__ void chunk_math(const ChunkOps& X, f32x4 (&S)[4], f32x4& o_out) {
    bf16x8 bs[2];
#pragma unroll
    for (int m = 0; m < 2; ++m) { v4u w; w.x = pk2(S[2 * m][0], S[2 * m][1]); w.y = pk2(S[2 * m][2], S[2 * m][3]); w.z = pk2(S[2 * m + 1][0], S[2 * m + 1][1]); w.w = pk2(S[2 * m + 1][2], S[2 * m + 1][3]); bs[m] = __builtin_bit_cast(bf16x8, w); }
    const f32x4 z4 = (f32x4){0.f, 0.f, 0.f, 0.f};
    const bf16x8 bv = lo4t(X.bv);
    f32x4 y = MFMA16(cat8(X.pA[0][0], X.pA[0][1]), bs[0], z4); y = MFMA16(cat8(X.pA[1][0], X.pA[1][1]), bs[1], y); y = MFMA16(lo4(X.g[0]), bv, y);
    f32x4 o = MFMA16(cat8(X.rA[0][0], X.rA[0][1]), bs[0], z4); o = MFMA16(cat8(X.rA[1][0], X.rA[1][1]), bs[1], o); o = MFMA16(lo4(X.g[3]), bv, o);
    const bf16x8 by = lo4(pk4(y));
    const f32x4 u = MFMA16(lo4(X.g[1]), by, z4);
    const bf16x8 bu = lo4(pk4(u));
    o_out = MFMA16(lo4(X.g[2]), bu, o);
#pragma unroll
    for (int jt = 0; jt < 4; ++jt) { S[jt] = MFMA16(lo4t(X.aq[jt]), bu, S[jt]); S[jt] = MFMA16(lo4t(X.ak[jt]), bv, S[jt]); S[jt] = S[jt] * X.ac[jt]; }
}
#ifndef SC_CONVW
#define SC_CONVW 3
#endif
constexpr int SC_NS = 7, SC_AHEAD = 5, SC_CTL = SC_NS * CH_SLOT, SCAN_TR_OFF = 81920;
__device__ __forceinline__ void scan_dma(const unsigned char* rec, const bf16* vt, LAS unsigned char* slot, int lane) {
#pragma unroll
    for (int i = 0; i < 10; ++i) __builtin_amdgcn_global_load_lds((const unsigned*)(rec + (lane + 64 * i) * 16), (LAS unsigned*)(slot + i * 1024), 16, 0, 0);
    if (lane < 48) __builtin_amdgcn_global_load_lds((const unsigned*)(rec + (lane + 640) * 16), (LAS unsigned*)(slot + 10240), 16, 0, 0);
    if (lane < 32) __builtin_amdgcn_global_load_lds((const unsigned*)(vt + (size_t)(lane >> 1) * 512 + 8 * (lane & 1)), (LAS unsigned*)(slot + CH_V), 16, 0, 0);
}
__device__ __forceinline__ int sc_ld(LAS int* p) { int v; const unsigned a = (unsigned)(size_t)p; asm volatile("ds_read_b32 %0, %1\n\ts_waitcnt lgkmcnt(0)" : "=&v"(v) : "v"(a) : "memory"); return v; }
__device__ __forceinline__ void sc_st(LAS int* p, int v) { const unsigned a = (unsigned)(size_t)p; asm volatile("ds_write_b32 %0, %1" :: "v"(a), "v"(v) : "memory"); }
#define SC_LD(p) sc_ld(p)
#define SC_ST(p, v) sc_st((p), (v))
__device__ __forceinline__ void p5_scan(Frame& F, bool extras = true, int abl = 0) {
    LAS int* ctl = (LAS int*)(F.lds + SC_CTL);
    if (F.tid < 4) ctl[F.tid] = 0;
    LDS_WAIT(); __syncthreads();
    constexpr int NKQ = (tri::NITEMS - tri::E12) / 256;
    LAS float* mytile = (LAS float*)(F.lds + SCAN_TR_OFF + F.wave * 8448);
    const int bh = F.vcu >> 2, b = bh >> 3, h = bh & 7, i0 = (F.vcu & 3) * 16;
    if (F.wave == 0) {
        if (abl & 1) return;
        __builtin_amdgcn_s_setprio(3);
        float* o0 = (float*)(F.ws + WS_XN) + (size_t)b * SEQ * 512 + h * 64 + i0;
        const int fr = F.lane & 15, fq = F.lane >> 4;
        f32x4 S[4];
#pragma unroll
        for (int jt = 0; jt < 4; ++jt) S[jt] = (f32x4){0.f, 0.f, 0.f, 0.f};
        ChunkOps XA, XB;
        while (SC_LD(&ctl[0]) <= 0) __builtin_amdgcn_s_sleep(1);
        asm volatile("" ::: "memory");
        chunk_load(F.lds, XA, F.lane);
        LDS_WAIT(); asm volatile("" ::: "memory");
        if (F.lane == 0) SC_ST(&ctl[1], 1);
#define SCAN_ITER(XC, XN_, c_) do { const int cc = (c_); \
            if (cc + 1 < 128) { while (SC_LD(&ctl[0]) <= cc + 1) __builtin_amdgcn_s_sleep(1); asm volatile("" ::: "memory"); chunk_load(F.lds + ((cc + 1) % SC_NS) * CH_SLOT, XN_, F.lane); } \
            __builtin_amdgcn_sched_barrier(0); \
            f32x4 o; chunk_math(XC, S, o); \
            __builtin_amdgcn_sched_barrier(0); \
            float* orow = o0 + (size_t)cc * 16 * 512; \
            _Pragma("unroll") for (int rg = 0; rg < 4; ++rg) { float* pp = orow + (size_t)(4 * fq + rg) * 512 + fr; const float vv = o[rg]; asm volatile("global_store_dword %0, %1, off" :: "v"(pp), "v"(vv) : "memory"); } \
            if (cc + 1 < 128) { LDS_WAIT(); asm volatile("" ::: "memory"); if (F.lane == 0) SC_ST(&ctl[1], cc + 2); } } while (0)
#pragma unroll 1
        for (int c = 0; c < 128; c += 2) { SCAN_ITER(XA, XB, c); SCAN_ITER(XB, XA, c + 1); }
#undef SCAN_ITER
        asm volatile("s_waitcnt vmcnt(0)" ::: "memory");
        __builtin_amdgcn_s_setprio(0);
        if (F.lane == 0) SC_ST(&ctl[3], 1);
        if (!(abl & 2)) tr_run_q(F, mytile, &ctl[2], tri::E12 + F.vcu, F.G, NKQ);
    } else if (F.wave == 1) {
        if (abl & 1) return;
        const unsigned char* rec0 = F.ws + WS_S + ((size_t)(b * 128) * 8 + h) * CH_REC;
        const bf16* vt0 = (const bf16*)F.out + (size_t)b * SEQ * 512 + h * 64 + i0;
        for (int n = 0; n < 128; ++n) {
            while (SC_LD(&ctl[1]) < n - SC_NS + 1) __builtin_amdgcn_s_sleep(1);
            asm volatile("" ::: "memory");
            scan_dma(rec0 + (size_t)n * 8 * CH_REC, vt0 + (size_t)n * 16 * 512, F.lds + (n % SC_NS) * CH_SLOT, F.lane);
            if (n >= SC_AHEAD) { asm volatile("s_waitcnt vmcnt(60)" ::: "memory"); if (F.lane == 0) SC_ST(&ctl[0], n - SC_AHEAD + 1); }
        }
        asm volatile("s_waitcnt vmcnt(48)" ::: "memory"); if (F.lane == 0) SC_ST(&ctl[0], 124);
        asm volatile("s_waitcnt vmcnt(36)" ::: "memory"); if (F.lane == 0) SC_ST(&ctl[0], 125);
        asm volatile("s_waitcnt vmcnt(24)" ::: "memory"); if (F.lane == 0) SC_ST(&ctl[0], 126);
        asm volatile("s_waitcnt vmcnt(12)" ::: "memory"); if (F.lane == 0) SC_ST(&ctl[0], 127);
        asm volatile("s_waitcnt vmcnt(0)" ::: "memory"); if (F.lane == 0) SC_ST(&ctl[0], 128);
        if (!(abl & 2)) { while (SC_LD(&ctl[3]) == 0) __builtin_amdgcn_s_sleep(8); tr_run_q(F, mytile, &ctl[2], tri::E12 + F.vcu, F.G, NKQ); }
    } else {
        const int w2 = F.vcu * 6 + (F.wave - 2), NW2 = F.G * 6;
        if (!(abl & 2) && F.wave - 2 < SC_CONVW) tr_run_q(F, mytile, &ctl[2], tri::E12 + F.vcu, F.G, NKQ);
        if (!extras) return;
        for (int mb = w2; mb < M; mb += 4 * NW2) {
            v4u a0[4], a1[4], a2[4];
#pragma unroll
            for (int u = 0; u < 4; ++u) { const int mr = (mb + u * NW2 < M) ? mb + u * NW2 : mb; const bf16* y0 = (const bf16*)(F.ws + WS_YB) + (size_t)mr * 512 + 8 * F.lane; a0[u] = *(const v4u*)y0; a1[u] = *(const v4u*)(y0 + 8 * MiB); a2[u] = *(const v4u*)(y0 + 16 * MiB); }
#pragma unroll
            for (int u = 0; u < 4; ++u) { float f0[8], f1[8], f2[8]; unpk8(a0[u], f0); unpk8(a1[u], f1); unpk8(a2[u], f2);
                v4u w; w.x = pk2(f0[0] + f1[0] + f2[0], f0[1] + f1[1] + f2[1]); w.y = pk2(f0[2] + f1[2] + f2[2], f0[3] + f1[3] + f2[3]); w.z = pk2(f0[4] + f1[4] + f2[4], f0[5] + f1[5] + f2[5]); w.w = pk2(f0[6] + f1[6] + f2[6], f0[7] + f1[7] + f2[7]);
                if (mb + u * NW2 < M) *(v4u*)((bf16*)(F.ws + WS_YB) + (size_t)(mb + u * NW2) * 512 + 8 * F.lane) = w; } }
        const float* p = F.ap->in[1]; bf16* PB = (bf16*)(F.ws + WS_PBF);
        constexpr size_t NV = (size_t)M * 256 / 4;
        for (size_t b0 = (size_t)w2 * 64 + F.lane; b0 < NV; b0 += (size_t)8 * NW2 * 64) {
            f32x4 pv[8];
#pragma unroll
            for (int i = 0; i < 8; ++i) { const size_t idx = b0 + (size_t)i * NW2 * 64; pv[i] = (idx < NV) ? *(const f32x4*)(p + idx * 4) : (f32x4){0.f, 0.f, 0.f, 0.f}; }
#pragma unroll
            for (int i = 0; i < 8; ++i) { const size_t idx = b0 + (size_t)i * NW2 * 64; if (idx < NV) *(v2u*)(PB + idx * 4) = pk4(pv[i]); } }
        if (!(abl & 2) && F.wave - 2 >= SC_CONVW) { while (SC_LD(&ctl[3]) == 0) __builtin_amdgcn_s_sleep(8); tr_run_q(F, mytile, &ctl[2], tri::E12 + F.vcu, F.G, NKQ); }
    }
}

struct P6Par { float lw[8], lb[8]; };
__device__ __forceinline__ void p6_rows2(Frame& F, int ma, int mb_, const P6Par& P) {
    const int l = F.lane, c = 8 * l, h = l >> 3;
    f32x4 oa[2][2]; v4u vv_[2], gg_[2]; float bsv[2];
#pragma unroll
    for (int u = 0; u < 2; ++u) { const int m = u ? mb_ : ma;
        const float* oraw = (const float*)(F.ws + WS_XN) + (size_t)m * 512 + c;
        oa[u][0] = *(const f32x4*)oraw; oa[u][1] = *(const f32x4*)(oraw + 4); bsv[u] = ((const float*)(F.ws + WS_BONUS))[(size_t)m * 8 + h];
        vv_[u] = *(const v4u*)((const bf16*)F.out + (size_t)m * 512 + c); gg_[u] = *(const v4u*)((const bf16*)(F.ws + WS_G) + (size_t)m * 512 + c);
    }
    __builtin_amdgcn_sched_barrier(0);
#pragma unroll
    for (int u = 0; u < 2; ++u) { const int m = u ? mb_ : ma;
        float o[8] = {oa[u][0].x, oa[u][0].y, oa[u][0].z, oa[u][0].w, oa[u][1].x, oa[u][1].y, oa[u][1].z, oa[u][1].w};
        float s = 0.f;
#pragma unroll
        for (int j = 0; j < 8; ++j) s += o[j];
        s += __shfl_xor(s, 1); s += __shfl_xor(s, 2); s += __shfl_xor(s, 4);
        const float mu = s * (1.f / 64.f); float q = 0.f;
#pragma unroll
        for (int j = 0; j < 8; ++j) { o[j] -= mu; q += o[j] * o[j]; }
        q += __shfl_xor(q, 1); q += __shfl_xor(q, 2); q += __shfl_xor(q, 4);
        const float rstd = 1.0f / sqrtf(q * (1.f / 64.f) + GN_EPS);
        float vv[8], gg[8];
        unpk8(vv_[u], vv); unpk8(gg_[u], gg);
        const float bs = bsv[u];
        float y[8];
#pragma unroll
        for (int j = 0; j < 8; ++j) y[j] = (o[j] * rstd * P.lw[j] + P.lb[j] + bs * vv[j]) * gg[j];
        v4u w; w.x = pk2(y[0], y[1]); w.y = pk2(y[2], y[3]); w.z = pk2(y[4], y[5]); w.w = pk2(y[6], y[7]);
        *(v4u*)((bf16*)(F.ws + WS_YRW) + (size_t)m * 512 + c) = w;
    }
}
__device__ __forceinline__ void p6_phase(Frame& F) {
    const int l = F.lane, c = 8 * l;
    P6Par P;
#pragma unroll
    for (int j = 0; j < 8; ++j) { P.lw[j] = F.ap->in[13][c + j]; P.lb[j] = F.ap->in[14][c + j]; }
    for (int m = F.gw; m < M; m += 2 * F.NGW) p6_rows2(F, m, m + F.NGW, P);
}

struct RouteW { f32x4 wv[3][8]; };
__device__ __forceinline__ void route_ldx(Frame& F, int tile, v4u (&xv)[4]) {
    const int fr = F.lane & 15, fq = F.lane >> 4; const bf16* xp = (const bf16*)(F.ws + WS_Z) + (size_t)(tile * 16 + fr) * D + F.wave * 128 + 8 * fq;
#pragma unroll
    for (int g = 0; g < 4; ++g) xv[g] = *(const v4u*)(xp + 32 * g);
}
__device__ __forceinline__ void route_tile(Frame& F, int tile, const RouteW& W, const v4u (&xv_)[4], int par) {
    const int fr = F.lane & 15, fq = F.lane >> 4, m0 = tile * 16;
    f32x4 acc[3] = {(f32x4){0.f, 0.f, 0.f, 0.f}, (f32x4){0.f, 0.f, 0.f, 0.f}, (f32x4){0.f, 0.f, 0.f, 0.f}};
    float ssq = 0.f;
#pragma unroll
    for (int g2 = 0; g2 < 4; ++g2) {
        float xf[8]; unpk8(xv_[g2], xf);
#pragma unroll
        for (int hh = 0; hh < 2; ++hh) { const int g = 2 * g2 + hh;
            ssq += (xf[4 * hh] * xf[4 * hh] + xf[4 * hh + 1] * xf[4 * hh + 1]) + (xf[4 * hh + 2] * xf[4 * hh + 2] + xf[4 * hh + 3] * xf[4 * hh + 3]);
#pragma unroll
            for (int s = 0; s < 4; ++s)
#pragma unroll
                for (int ct = 0; ct < 3; ++ct) acc[ct] = __builtin_amdgcn_mfma_f32_16x16x4f32(W.wv[ct][g][s], xf[4 * hh + s], acc[ct], 0, 0, 0); }
    }
    ssq += __shfl_xor(ssq, 16); ssq += __shfl_xor(ssq, 32);
    LAS float* red = (LAS float*)(F.lds + par * 32768);
    LAS float* ssqb = red + 8 * 3 * 64 * 4; LAS float* rsb = ssqb + 128;
#pragma unroll
    for (int ct = 0; ct < 3; ++ct) *(LAS f32x4*)(red + ((F.wave * 3 + ct) * 64 + F.lane) * 4) = acc[ct];
    if (fq == 0) ssqb[F.wave * 16 + fr] = ssq;
    LDS_WAIT(); __syncthreads();
    if (F.wave == 0) { float st = 0.f;
#pragma unroll
      for (int w = 0; w < 8; ++w) st += ssqb[w * 16 + (F.lane & 15)];
      const float rs = 1.0f / sqrtf(st * (1.f / D) + NORM_EPS);
      if (fq == 0) ((float*)(F.ws + WS_RSE))[m0 + fr] = rs;
#pragma unroll
      for (int ct = 0; ct < 3; ++ct) { f32x4 t = (f32x4){0.f, 0.f, 0.f, 0.f};
#pragma unroll
          for (int w = 0; w < 8; ++w) t = t + *(const LAS f32x4*)(red + ((w * 3 + ct) * 64 + F.lane) * 4);
          *(f32x4*)((float*)(F.ws + WS_LOGITS) + (size_t)(m0 + fr) * 48 + 16 * ct + 4 * fq) = t * rs; } }
}
__device__ __forceinline__ void p9_phase(Frame& F, int rep_ = 0) {
    const int fr = F.lane & 15, fq = F.lane >> 4;
    RouteW W;
    { const float* wp = (const float*)(F.ws + WS_SMALLW + SW_ROUTEW) + (size_t)fr * D + F.wave * 128 + 8 * fq;
#pragma unroll
      for (int ct = 0; ct < 3; ++ct)
#pragma unroll
          for (int g = 0; g < 8; ++g) W.wv[ct][g] = *(const f32x4*)(wp + (size_t)ct * 16 * D + 32 * (g >> 1) + 4 * (g & 1)); }
    v4u xa[4], xb[4];
    int tile = F.vcu, par = 0;
    if (tile < 1024) route_ldx(F, tile, xa);
    while (tile < 1024) {
        const int nt = tile + F.G;
        if (nt < 1024) route_ldx(F, nt, xb);
        __builtin_amdgcn_sched_barrier(0);
        route_tile(F, tile, W, xa, par);
#pragma unroll
        for (int g = 0; g < 4; ++g) xa[g] = xb[g];
        tile = nt; par ^= 1;
    }
}

__device__ __forceinline__ void p9b_phase(Frame& F) {
    if (F.wave != 0) return;
    for (int base = F.vcu * 64; base < M; base += F.G * 64) {
        const int tok = base + F.lane;
        const float* lgp = (const float*)(F.ws + WS_LOGITS) + (size_t)tok * 48;
        float lg[36];
#pragma unroll
        for (int q = 0; q < 9; ++q) { const f32x4 v = *(const f32x4*)(lgp + 4 * q); lg[4 * q] = v.x; lg[4 * q + 1] = v.y; lg[4 * q + 2] = v.z; lg[4 * q + 3] = v.w; }
        const float* bg = F.ap->in[27]; const float* br = F.ap->in[29];
        float gl[4]; int gs = 0; float gm = -3.0e38f;
#pragma unroll
        for (int c = 0; c < 4; ++c) { gl[c] = lg[c] + bg[c]; if (gl[c] > gm) { gm = gl[c]; gs = c; } }
        float gsum = 0.f;
#pragma unroll
        for (int c = 0; c < 4; ++c) gsum += __expf(gl[c] - gm);
        const float pgroup = 1.0f / gsum;
        float el[8]; float em = -3.0e38f;
#pragma unroll
        for (int c = 0; c < 8; ++c) { const float lv = gs == 0 ? lg[4 + c] : (gs == 1 ? lg[12 + c] : (gs == 2 ? lg[20 + c] : lg[28 + c])); el[c] = lv + br[gs * 8 + c]; em = fmaxf(em, el[c]); }
        int i1 = 0; float v1 = -3.0e38f;
#pragma unroll
        for (int c = 0; c < 8; ++c) if (el[c] > v1) { v1 = el[c]; i1 = c; }
        int i2 = 0; float v2 = -3.0e38f;
#pragma unroll
        for (int c = 0; c < 8; ++c) if (c != i1 && el[c] > v2) { v2 = el[c]; i2 = c; }
        const float p1 = __expf(v1 - em), p2 = __expf(v2 - em);
        const float g1 = pgroup * p1 / (p1 + p2), g2 = pgroup * p2 / (p1 + p2);
        const int e1 = gs * 8 + i1, e2 = gs * 8 + i2;
        const unsigned long long lt = (1ull << F.lane) - 1ull;
        int r1 = 0, r2 = 0, mycnt = 0;
        for (int e = 0; e < 32; ++e) {
            const unsigned long long m1 = __ballot(e1 == e), m2 = __ballot(e2 == e);
            const int c1 = __popcll(m1), c2 = __popcll(m2);
            if (e1 == e) r1 = __popcll(m1 & lt);
            if (e2 == e) r2 = c1 + __popcll(m2 & lt);
            if (F.lane == e) mycnt = c1 + c2;
        }
        unsigned* cnt = (unsigned*)(F.ws + WS_CTL) + CW_CNT; int* list = (int*)(F.ws + WS_LIST); float* gateA = (float*)(F.ws + WS_GATEA); unsigned* slotA = (unsigned*)(F.ws + WS_SLOTA);
        int bs = 0;
        if (F.lane < 32 && mycnt > 0) bs = (int)atomicAdd(&cnt[F.lane], (unsigned)mycnt);
        const unsigned q1 = (unsigned)(__shfl(bs, e1) + r1), q2 = (unsigned)(__shfl(bs, e2) + r2);
        gateA[tok * 2 + 0] = g1; gateA[tok * 2 + 1] = g2;
        list[(size_t)e1 * 16384 + q1] = tok * 2 + 0; slotA[tok * 2 + 0] = ((unsigned)e1 << 16) | q1;
        list[(size_t)e2 * 16384 + q2] = tok * 2 + 1; slotA[tok * 2 + 1] = ((unsigned)e2 << 16) | q2;
    }
}

__device__ __forceinline__ void p12_rows2(Frame& F, int ma, int mb_, int prelane) {
    const unsigned* slotA = (const unsigned*)(F.ws + WS_SLOTA); const float* gateA = (const float*)(F.ws + WS_GATEA);
    unsigned sl[2][2]; float gt[2][2];
#pragma unroll
    for (int u = 0; u < 2; ++u) { const int m = u ? mb_ : ma; sl[u][0] = slotA[2 * m]; sl[u][1] = slotA[2 * m + 1]; gt[u][0] = gateA[2 * m]; gt[u][1] = gateA[2 * m + 1]; }
    f32x4 xv[2][4]; v2u cv[2][2][4], ev[2][4];
#pragma unroll
    for (int u = 0; u < 2; ++u) { const int m = u ? mb_ : ma;
        const bf16* x1 = (const bf16*)(F.ws + WS_Z) + (size_t)m * D; const bf16* er = (const bf16*)(F.ws + WS_S + 64 * MiB) + (size_t)m * D;
#pragma unroll
        for (int j = 0; j < 4; ++j) { const int o = 4 * F.lane + 256 * j; xv[u][j] = unpk4(*(const v2u*)(x1 + o)); ev[u][j] = *(const v2u*)(er + o); }
#pragma unroll
        for (int k = 0; k < 2; ++k) { const unsigned s = (unsigned)__builtin_amdgcn_readfirstlane((int)sl[u][k]); const int pre = __builtin_amdgcn_readlane(prelane, (int)(s >> 16));
            const bf16* cp = (const bf16*)(F.ws + WS_Z + 64 * MiB) + ((size_t)pre * 256 + (s & 0xffffu)) * D;
#pragma unroll
            for (int j = 0; j < 4; ++j) cv[u][k][j] = *(const v2u*)(cp + 4 * F.lane + 256 * j); } }
    __builtin_amdgcn_sched_barrier(0);
    float s2[2], se[2];
#pragma unroll
    for (int u = 0; u < 2; ++u) { s2[u] = 0.f; se[u] = 0.f;
#pragma unroll
        for (int j = 0; j < 4; ++j) { xv[u][j] = xv[u][j] + unpk4(cv[u][0][j]) * gt[u][0] + unpk4(cv[u][1][j]) * gt[u][1];
            s2[u] += (xv[u][j].x * xv[u][j].x + xv[u][j].y * xv[u][j].y) + (xv[u][j].z * xv[u][j].z + xv[u][j].w * xv[u][j].w);
            const f32x4 e = unpk4(ev[u][j]); se[u] += (e.x * e.x + e.y * e.y) + (e.z * e.z + e.w * e.w); } }
#pragma unroll
    for (int o = 1; o < 64; o <<= 1) {
#pragma unroll
        for (int u = 0; u < 2; ++u) { s2[u] += __shfl_xor(s2[u], o); se[u] += __shfl_xor(se[u], o); } }
#pragma unroll
    for (int u = 0; u < 2; ++u) { const int m = u ? mb_ : ma;
        const float rs = 1.0f / sqrtf(s2[u] * (1.f / D) + NORM_EPS); const float rse = 1.0f / sqrtf(se[u] * (1.f / D) + NORM_EPS);
        bf16* x2 = (bf16*)(F.ws + WS_S) + (size_t)m * D; if (F.lane == 0) ((float*)(F.ws + WS_RSE))[M + m] = rs;
#pragma unroll
        for (int j = 0; j < 4; ++j) { const int o = 4 * F.lane + 256 * j; *(v2u*)(x2 + o) = pk4(xv[u][j]); }
        bf16* erw = (bf16*)(F.ws + WS_S + 64 * MiB) + (size_t)m * D; const float* gpn = F.ap->in[33];
#pragma unroll
        for (int j = 0; j < 4; ++j) { const int o = 4 * F.lane + 256 * j; *(v2u*)(erw + o) = pk4(unpk4(ev[u][j]) * rse * *(const f32x4*)(gpn + o)); } }
}
__device__ __forceinline__ void p12_phase(Frame& F) {
    const unsigned* cnt = (const unsigned*)(F.ws + WS_CTL) + CW_CNT;
    int nt = (F.lane < 32) ? (((int)cnt[F.lane & 31] + 255) >> 8) : 0;
    int incl = nt;
#pragma unroll
    for (int o = 1; o < 32; o <<= 1) { const int v = __shfl_up(incl, o); if (F.lane >= o) incl += v; }
    const int prelane = incl - nt;
    for (int m = F.gw; m < M; m += 2 * F.NGW) p12_rows2(F, m, m + F.NGW, prelane);
}
__device__ __forceinline__ void p14_rows4(Frame& F, int mb) {
    const float* gf = F.ap->in[36];
    f32x4 v[4][4]; float s[4];
#pragma unroll
    for (int u = 0; u < 4; ++u) { const bf16* xr = (const bf16*)(F.ws + WS_Z) + (size_t)(mb + u * F.NGW) * D;
#pragma unroll
        for (int j = 0; j < 4; ++j) v[u][j] = unpk4(*(const v2u*)(xr + 4 * F.lane + 256 * j)); }
#pragma unroll
    for (int u = 0; u < 4; ++u) { s[u] = 0.f;
#pragma unroll
        for (int j = 0; j < 4; ++j) s[u] += (v[u][j].x * v[u][j].x + v[u][j].y * v[u][j].y) + (v[u][j].z * v[u][j].z + v[u][j].w * v[u][j].w); }
#pragma unroll
    for (int o = 1; o < 64; o <<= 1) {
#pragma unroll
        for (int u = 0; u < 4; ++u) s[u] += __shfl_xor(s[u], o); }
#pragma unroll
    for (int u = 0; u < 4; ++u) { const float rs = 1.0f / sqrtf(s[u] * (1.f / D) + NORM_EPS); float* orow = F.out + (size_t)(mb + u * F.NGW) * D;
#pragma unroll
        for (int j = 0; j < 4; ++j) { const int o = 4 * F.lane + 256 * j; *(f32x4*)(orow + o) = v[u][j] * rs * *(const f32x4*)(gf + o); } }
}

#ifndef MK_ONE_LAUNCH
#define MK_ONE_LAUNCH 1
#endif
constexpr int N_PHASES = 14;
__global__ void __launch_bounds__(NWAVES * 64, 2) mk_fwd(Args args) {
    extern __shared__ __attribute__((aligned(16))) unsigned char lds[];
    Frame F;
    F.lds = (LAS unsigned char*)lds;
    F.tid = threadIdx.x; F.lane = F.tid & 63; F.wave = __builtin_amdgcn_readfirstlane(F.tid >> 6);
    F.G = gridDim.x; { const int bx = blockIdx.x; F.vcu = (F.G % 8 == 0) ? (bx % 8) * (F.G / 8) + bx / 8 : bx; }
    F.gw = F.vcu * NWAVES + F.wave; F.NGW = F.G * NWAVES;
    F.ws = args.ws; F.out = args.out;
    F.ap = (ArgsP)__builtin_amdgcn_kernarg_segment_ptr();
    unsigned char* ws = args.ws;
    const int lo = args.ph_lo, hi = args.ph_hi;
#ifdef ONLY
#define IN(k) ((k) == ONLY && lo <= (k) && (k) < hi)
#else
#define IN(k) (lo <= (k) && (k) < hi)
#endif
#if MK_ONE_LAUNCH
    if (F.tid < 16) ((LAS unsigned*)(F.lds + MISC_OFF))[F.tid] = 0u;
    __syncthreads();
    XcdBarrier bar = xcd_barrier_post((unsigned*)(ws + WS_CTL) + CW_BAR, (volatile LAS unsigned*)(F.lds + MISC_OFF));
#define GRID_BAR(k) do { if (IN(k) && IN((k) + 1)) { if ((k) == 12) cg::this_grid().sync(); else xcd_barrier(bar); } } while (0)
#else
#define GRID_BAR(k) do { } while (0)
#endif
    LAS unsigned char* L = F.lds;
#ifdef PROBE_A
    unsigned long long* tsb = (unsigned long long*)(ws + WS_CTL + 32768);
    int n_st = 0;
#define STAMP() do { if (blockIdx.x == 0 && F.tid == 0) tsb[n_st] = __builtin_amdgcn_s_memrealtime(); ++n_st; } while (0)
    STAMP();
#else
#define STAMP() do { } while (0)
#endif
    const bf16* z = (const bf16*)(ws + WS_Z);

    if (IN(0)) { p0_prologue(F); } GRID_BAR(0); STAMP();

    if (IN(1)) {
        pg8::Gemm g{(const bf16*)(ws + WS_XN), (const bf16*)(ws + WS_WIN), M, NZ, D, nullptr}; pg8::StaticOrder S; S.init(M, NZ, F.G, (int)blockIdx.x);
        EpiStoreBf16 E{(bf16*)(ws + WS_Z), NZ};
        pg8::gemm_phase<EpiStoreBf16, pg8::StaticOrder, true, false>(L, g, S, E);
    } GRID_BAR(1); STAMP();

    if (IN(2)) { p2_prep(F); } GRID_BAR(2); STAMP();
    if (IN(3)) { p3_phase(F); } GRID_BAR(3); STAMP();
    if (IN(4)) { p4_phase(F); } GRID_BAR(4); STAMP();
    if (IN(5)) { if (F.G == 256) p5_scan(F); } GRID_BAR(5); STAMP();
    if (IN(6)) { p6_phase(F); } GRID_BAR(6); STAMP();

    if (IN(7)) {
        pg8::Gemm g{(const bf16*)(ws + WS_YRW), (const bf16*)(ws + WS_UR), 2 * M, 2 * D, 512, nullptr}; DualOrder S; S.S.init(M, D, F.G, (int)blockIdx.x);
        EpiMix E{z, (bf16*)(ws + WS_S), (bf16*)(ws + WS_S + 64 * MiB)};
        pg8::gemm_phase<EpiMix, DualOrder, true, false>(L, g, S, E);
    } GRID_BAR(7); STAMP();

    if (IN(8)) {
        pg8::Gemm g{(const bf16*)(ws + WS_S + 64 * MiB), (const bf16*)(ws + WS_WO), M, D, D, nullptr}; pg8::StaticOrder S; S.init(M, D, F.G, (int)blockIdx.x);
        EpiResBf16 E{F.ap->in[0], (bf16*)(ws + WS_Z)};
        pg8::gemm_phase<EpiResBf16, pg8::StaticOrder, true, false>(L, g, S, E);
    } GRID_BAR(8); STAMP();

    if (IN(9)) { p9_phase(F); xcd_barrier(bar); p9b_phase(F); } GRID_BAR(9); STAMP();

    if (IN(10)) {
        pg8::Gemm g{(const bf16*)(ws + WS_Z), (const bf16*)(ws + WS_WGU), M, 1024, D, (const int*)(ws + WS_LIST), (const float*)(ws + WS_RSE)};
        pg8::moe_fill_tab((LAS int*)(F.lds + MISC_OFF - 256), (const unsigned*)(ws + WS_CTL) + CW_CNT); LDS_WAIT(); __syncthreads();
        pg8::MoeOrder S{(const LAS int*)(F.lds + MISC_OFF - 256), F.G, (int)blockIdx.x, false};
        EpiMoe1 E{(bf16*)(ws + WS_S), (const LAS float*)(F.lds + pg8::STAGE_BYTES + 4096)};
        pg8::gemm_phase<EpiMoe1, pg8::MoeOrder, true, true>(L, g, S, E);
    } GRID_BAR(10); STAMP();

    if (IN(11)) {
#ifndef NO_MOE2
        { pg8::Gemm g{(const bf16*)(ws + WS_S), (const bf16*)(ws + WS_WD), M, 1024, 512, nullptr};
          pg8::moe_fill_tab((LAS int*)(F.lds + MISC_OFF - 256), (const unsigned*)(ws + WS_CTL) + CW_CNT); LDS_WAIT(); __syncthreads();
          pg8::MoeOrder S{(const LAS int*)(F.lds + MISC_OFF - 256), F.G, (int)blockIdx.x, true};
          EpiStoreBf16 E{(bf16*)(ws + WS_Z + 64 * MiB), D};
          pg8::gemm_phase<EpiStoreBf16, pg8::MoeOrder, true, false>(L, g, S, E); }
#endif
        { pg8::Gemm g2{(const bf16*)(ws + WS_PBF), (const bf16*)(ws + WS_WPP), M, D, 256, nullptr}; ErawOrder S2; S2.S.init(M, D, F.G, 0); S2.c = (int)blockIdx.x; S2.G = F.G;
          { const LAS int* tb = (const LAS int*)(F.lds + MISC_OFF - 256); const int units = 4 * (tb[31] + ((tb[63] + 255) >> 8)); int nh = units - 2 * F.G; nh = nh < 0 ? 0 : (nh > F.G - 1 ? F.G - 1 : nh); S2.nheavy = nh; }
          EpiStoreBf16 E2{(bf16*)(ws + WS_S + 64 * MiB), D};
          pg8::gemm_phase<EpiStoreBf16, ErawOrder, true, false>(L, g2, S2, E2); }
    } GRID_BAR(11); STAMP();

    if (IN(12)) { p12_phase(F); } GRID_BAR(12); STAMP();

    if (IN(13)) {
        pg8::Gemm g{(const bf16*)(ws + WS_S), (const bf16*)(ws + WS_WPG), M, D, D, nullptr}; pg8::StaticOrder S; S.init(M, D, F.G, (int)blockIdx.x);
        EpiPleNorm E{(const bf16*)(ws + WS_S), (const bf16*)(ws + WS_S + 64 * MiB), (const float*)(ws + WS_RSE) + M, F.ap->in[36], F.out, (float*)(ws + WS_ZGATE), (unsigned*)(ws + WS_CTL) + CW_PANEL, (LAS float*)(F.lds + 131072)};
        pg8::gemm_phase<EpiPleNorm, pg8::StaticOrder, true, false>(L, g, S, E);
    } STAMP();

#ifdef PROBE_A
    xcd_barrier(bar); STAMP(); __threadfence();
    if (blockIdx.x == 0 && F.tid == 0) { __threadfence(); }
    xcd_barrier(bar);
    {
        volatile unsigned long long* tv = (volatile unsigned long long*)tsb;
        const float dA = (float)(tv[PROBE_A + 1] - tv[PROBE_A]) * 0.01f, dB = (float)(tv[PROBE_B + 1] - tv[PROBE_B]) * 0.01f;
        for (size_t i = (size_t)blockIdx.x * 512 + F.tid; i < (size_t)M * D; i += (size_t)F.G * 512) F.out[i] = 10.0f * dB;
        __syncthreads();
        if (blockIdx.x == 0 && F.tid == 0) F.out[0] = 300.0f * dA;
    }
#endif
#undef IN
#undef GRID_BAR
}

extern "C" void kernel_launch(void* const* d_in, const int* in_sizes, int n_in, void* d_out, int out_size, void* d_ws, size_t ws_size, hipStream_t stream) {
    static int grid = 0;
    if (grid == 0) {
        if (n_in != 37 || out_size != M * D || ws_size < WS_END) { fprintf(stderr, "kernel_launch: unexpected problem (n_in %d, out %d, ws %zu < %zu); nothing launched\n", n_in, out_size, ws_size, (size_t)WS_END); grid = -1; return; }
        int dev = 0, cus = 0, per_cu = 0;
        if (hipGetDevice(&dev) != hipSuccess || hipDeviceGetAttribute(&cus, hipDeviceAttributeMultiprocessorCount, dev) != hipSuccess) { grid = -1; return; }
        if (hipFuncSetAttribute((const void*)mk_fwd, hipFuncAttributeMaxDynamicSharedMemorySize, LDS_BYTES) != hipSuccess) { fprintf(stderr, "kernel_launch: hipFuncSetAttribute failed\n"); grid = -1; return; }
        if (hipOccupancyMaxActiveBlocksPerMultiprocessor(&per_cu, (const void*)mk_fwd, NWAVES * 64, LDS_BYTES) != hipSuccess || per_cu < 1) { fprintf(stderr, "kernel_launch: occupancy query says %d blocks per CU\n", per_cu); (void)hipGetLastError(); grid = -1; return; }
        grid = cus;
        if (grid != 256) fprintf(stderr, "kernel_launch: %d CUs; this kernel is built for 256\n", grid);
    }
    if (grid < 0) return;
    (void)hipMemsetAsync((char*)d_ws + WS_CTL, 0, CTL_ZERO_BYTES, stream);
    Args a{};
    for (int i = 0; i < 37; ++i) a.in[i] = (const float*)d_in[i];
    a.out = (float*)d_out; a.ws = (unsigned char*)d_ws;
#if MK_ONE_LAUNCH
    a.ph_lo = 0; a.ph_hi = N_PHASES;
    void* kargs[] = {&a};
    hipError_t e = hipLaunchCooperativeKernel((const void*)mk_fwd, dim3(grid), dim3(NWAVES * 64), kargs, LDS_BYTES, stream);
    if (e != hipSuccess) fprintf(stderr, "kernel_launch: cooperative launch failed: %s (grid %d)\n", hipGetErrorString(e), grid);
#else
    for (int ph = 0; ph < N_PHASES; ++ph) { a.ph_lo = ph; a.ph_hi = ph + 1; hipLaunchKernelGGL(mk_fwd, dim3(grid), dim3(NWAVES * 64), LDS_BYTES, stream, a); }
#endif
}
```

```cpp
#include <hip/hip_runtime.h>
#include <hip/hip_cooperative_groups.h>
#include <cstdio>
#include <cstdint>
namespace cg = cooperative_groups;

namespace pg8 {
#define PG8_LAS __attribute__((address_space(3)))
typedef unsigned short bf16_t;
typedef short bf16x8 __attribute__((ext_vector_type(8)));
typedef float f32x4 __attribute__((ext_vector_type(4)));
typedef unsigned u32x4 __attribute__((ext_vector_type(4)));
typedef unsigned u32x2 __attribute__((ext_vector_type(2)));
constexpr int BM = 256, BK = 64, HALF = 128, HTB = HALF * BK * 2  , STAGE_BYTES = 8 * HTB, NXCD = 8, WGM = 8;

__host__ __device__ __forceinline__ int lds_byte(int r, int c) { const int st = (r >> 4) * 2 + (c >> 5), rr = r & 15, cc = c & 31, ob = rr * 64 + cc * 2; return st * 1024 + (ob ^ (((ob >> 9) & 1) << 5)); }
__host__ __device__ __forceinline__ void stage_rc(int b, int& R, int& C) { const int st = b / 1024, sb = b % 1024, swz = sb ^ (((sb >> 9) & 1) << 5); R = (st >> 1) * 16 + swz / 64; C = (st & 1) * 32 + (swz % 64) / 2; }
__host__ __device__ __forceinline__ int perm32(int rho) { const int n = rho >> 4, i = rho & 15; return 8 * (i >> 2) + 4 * n + (i & 3); }

struct Unit { int pm, pn, pmo, lt, nvalid, pnl; };
struct Gemm { const bf16_t* A; const bf16_t* Bt; int M, N, K; const int* rowidx; const float* rowscale; };

struct StaticOrder {
    int nM, nN, nwg, G, c;
    __host__ __device__ void init(int M, int N, int G_, int c_) { nM = M / BM; nN = N / BM; nwg = nM * nN; G = G_; c = c_; }
    __host__ __device__ bool next(int i, Unit& u) const {
        const long L = (long)i * G + c; if (L >= nwg) return false;
        int wgid = (int)L; { const int q = nwg / NXCD, r = nwg % NXCD, xcd = wgid % NXCD, off = wgid / NXCD; wgid = (xcd < r ? xcd * (q + 1) : r * (q + 1) + (xcd - r) * q) + off; }
        const int nig = WGM * nN, gid = wgid / nig, fm = gid * WGM, gsz = (nM - fm) < WGM ? (nM - fm) : WGM;
        u.pm = fm + ((wgid % nig) % gsz); u.pn = (wgid % nig) / gsz; u.pmo = u.pm; u.lt = u.pm; u.nvalid = 256; u.pnl = u.pn; return true;
    }
};
struct MoeOrder {
    const PG8_LAS int* tab; int G, c; bool a_is_out;
    __device__ bool next(int i, Unit& u) const {
        const int L = i * G + c; const int tile = L >> 2, pnl = L & 3;
        const int lane = (int)__builtin_amdgcn_mbcnt_hi(~0u, __builtin_amdgcn_mbcnt_lo(~0u, 0u)), e_ = lane & 31;
        const int pre = tab[e_], ce = tab[32 + e_]; const int nt = (ce + 255) >> 8;
        const unsigned long long mk = __ballot(lane < 32 && tile >= pre && tile < pre + nt);
        if (mk == 0ull) return false;
        const int e = (int)__builtin_ctzll(mk);
        const int pre_e = __builtin_amdgcn_readlane(pre, e), ce_e = __builtin_amdgcn_readlane(ce, e);
        const int rt = tile - pre_e; u.pmo = tile; u.pm = a_is_out ? tile : 0; u.lt = e * 64 + rt; u.pn = e * 4 + pnl; u.pnl = pnl; const int rem = ce_e - rt * 256; u.nvalid = rem < 256 ? rem : 256; return true;
    }
};
__device__ __forceinline__ void moe_fill_tab(PG8_LAS int* tab, const unsigned* cnt) {
    const int lane = (int)__builtin_amdgcn_mbcnt_hi(~0u, __builtin_amdgcn_mbcnt_lo(~0u, 0u));
    const int ce = (lane < 32) ? (int)cnt[lane & 31] : 0; const int nt = (ce + 255) >> 8;
    int incl = nt;
#pragma unroll
    for (int o = 1; o < 32; o <<= 1) { const int v = __shfl_up(incl, o); if (lane >= o) incl += v; }
    if (lane < 32) { tab[lane] = incl - nt; tab[32 + lane] = ce; }
}

__device__ __forceinline__ unsigned cvt_pk_bf16(float lo, float hi) { unsigned r; asm volatile("v_cvt_pk_bf16_f32 %0, %1, %2" : "=v"(r) : "v"(lo), "v"(hi)); return r; }

template <class Epi, class Sched, bool ALIGN_EPI, bool GATHER>
__device__ __forceinline__ void gemm_phase(PG8_LAS unsigned char* lds, const Gemm g, const Sched& S, const Epi& E) {
    const int tid = threadIdx.x, wid = __builtin_amdgcn_readfirstlane(tid >> 6), lane = tid & 63, wr = wid >> 2, wc = wid & 3, fr = lane & 15, fq = lane >> 4;
    int K_ = g.K; asm volatile("" : "+s"(K_));
    const int K = K_, nt = K / BK;
    unsigned voffB[2]; int RA[2], CA[2];
#pragma unroll
    for (int i = 0; i < 2; ++i) { int R, C; stage_rc(tid * 16 + i * 8192, R, C); const int Rb = Epi::PERM ? ((R & ~31) + perm32(R & 31)) : R;
        RA[i] = R; CA[i] = C; voffB[i] = (unsigned)(Rb * K + C) * 2u; }
    const size_t kstep = (size_t)(BK * 2);
    const size_t hstep = (size_t)HALF * K * 2;
    const size_t tstep = 2 * hstep;
    const unsigned ldsw = (unsigned)wid * 1024u;
    const int aoff = lds_byte(wr * 64 + fr, fq * 8), boff = lds_byte(wc * 32 + fr, fq * 8);
    unsigned vA[2][2], vN[2][2];
    PG8_LAS int* rowl = (PG8_LAS int*)(lds + STAGE_BYTES);
    if constexpr (GATHER) {
        for (int i = 0; i < 4; ++i) { Unit uu; if (!S.next(i, uu)) break; if (tid < 256) { const int tk = (tid < uu.nvalid) ? (g.rowidx[(size_t)uu.lt * 256 + tid] >> 1) : 0; rowl[i * 256 + tid] = tk; ((PG8_LAS float*)(rowl + 1024))[i * 256 + tid] = g.rowscale[tk]; } }
        asm volatile("s_waitcnt vmcnt(0) lgkmcnt(0)" ::: "memory"); __builtin_amdgcn_s_barrier(); asm volatile("" ::: "memory");
    }
    auto compute_v = [&](const Unit& u, unsigned (&v)[2][2], int ui_) {
#pragma unroll
        for (int h = 0; h < 2; ++h)
#pragma unroll
            for (int i = 0; i < 2; ++i) {
                const int rl = h * HALF + RA[i];
                if constexpr (GATHER) { const int tok = rowl[ui_ * 256 + rl]; v[h][i] = ((unsigned)tok * (unsigned)K + (unsigned)CA[i]) * 2u; }
                else v[h][i] = ((unsigned)rl * (unsigned)K + (unsigned)CA[i]) * 2u;
            }
    };
#define PG8_SA(b, h) (((b) * 2 + (h)) * HTB)
#define PG8_SB(b, h) ((4 + (b) * 2 + (h)) * HTB)
#define PG8_STAGE(bufoff, gbase, voff) do { _Pragma("unroll") for (int _i = 0; _i < 2; ++_i) \
        __builtin_amdgcn_global_load_lds((const unsigned*)((const char*)(gbase) + (voff)[_i]), (PG8_LAS unsigned*)(lds + (bufoff) + ldsw + _i * 8192), 16, 0, 0); } while (0)
#define PG8_LDA(dst, b, h) do { _Pragma("unroll") for (int m = 0; m < 4; ++m) _Pragma("unroll") for (int k = 0; k < 2; ++k) dst[m][k] = *(const PG8_LAS bf16x8*)(lds + PG8_SA(b, h) + aoff + m * 2048 + k * 1024); } while (0)
#define PG8_LDB(dst, b, h) do { _Pragma("unroll") for (int n = 0; n < 2; ++n) _Pragma("unroll") for (int k = 0; k < 2; ++k) dst[n][k] = *(const PG8_LAS bf16x8*)(lds + PG8_SB(b, h) + boff + n * 2048 + k * 1024); } while (0)
#define PG8_MMA(ai, bj, At, Bt) do { __builtin_amdgcn_s_setprio(1); _Pragma("unroll") for (int m = 0; m < 4; ++m) _Pragma("unroll") for (int n = 0; n < 2; ++n) _Pragma("unroll") for (int k = 0; k < 2; ++k) \
        acc[ai][bj][m][n] = __builtin_amdgcn_mfma_f32_16x16x32_bf16(Bt[n][k], At[m][k], acc[ai][bj][m][n], 0, 0, 0); __builtin_amdgcn_s_setprio(0); } while (0)
#define PG8_WAIT_V(n) asm volatile("s_waitcnt vmcnt(" #n ")" ::: "memory")
#define PG8_WAIT_L(n) asm volatile("s_waitcnt lgkmcnt(" #n ")" ::: "memory")
#define PG8_BAR __builtin_amdgcn_s_barrier()
#define PG8_SCHED __builtin_amdgcn_sched_barrier(0)
    Unit cur, nxt; int ui = 0;
    if (!S.next(0, cur)) return;
    f32x4 acc[2][2][4][2];
#pragma unroll
    for (int a = 0; a < 2; ++a)
#pragma unroll
        for (int b = 0; b < 2; ++b)
#pragma unroll
            for (int m = 0; m < 4; ++m)
#pragma unroll
                for (int n = 0; n < 2; ++n) acc[a][b][m][n] = (f32x4){0.f, 0.f, 0.f, 0.f};
    bf16x8 At[4][2], B0[2][2], B1[2][2];
    compute_v(cur, vA, 0);
    const char* cA = (const char*)g.A + (GATHER ? (size_t)0 : (size_t)cur.pm * tstep); const char* cB = (const char*)g.Bt + (size_t)cur.pn * tstep;
    PG8_STAGE(PG8_SB(0, 0), cB, voffB); PG8_STAGE(PG8_SB(0, 1), cB + hstep, voffB); PG8_STAGE(PG8_SA(0, 0), cA, vA[0]); PG8_STAGE(PG8_SA(0, 1), cA, vA[1]);
    if (wr == 1) PG8_BAR;
    PG8_WAIT_V(2); PG8_BAR;
    PG8_STAGE(PG8_SB(1, 0), cB + kstep, voffB); PG8_STAGE(PG8_SA(1, 0), cA + kstep, vA[0]); PG8_STAGE(PG8_SB(1, 1), cB + hstep + kstep, voffB);
    PG8_WAIT_V(6); PG8_BAR;
    for (;;) {
        const bool has_next = S.next(ui + 1, nxt);
        if (has_next) compute_v(nxt, vN, ui + 1);
        else {
#pragma unroll
            for (int h = 0; h < 2; ++h)
#pragma unroll
                for (int i = 0; i < 2; ++i) vN[h][i] = vA[h][i];
        }
        const char* nA = has_next ? ((const char*)g.A + (GATHER ? (size_t)0 : (size_t)nxt.pm * tstep)) : cA; const char* nB = has_next ? (const char*)g.Bt + (size_t)nxt.pn * tstep : cB;
#pragma unroll 1
        for (int t = 0; t < nt; t += 2) {
            const bool last = (t == nt - 2);
            const char* a1 = cA + (size_t)(t + 1) * kstep;
            const char* a2 = last ? nA : cA + (size_t)(t + 2) * kstep; const char* b2 = last ? nB : cB + (size_t)(t + 2) * kstep;
            const char* a3 = a2 + kstep; const char* b3 = b2 + kstep;
            unsigned vX0[2], vX1[2];
#pragma unroll
            for (int i = 0; i < 2; ++i) { vX0[i] = last ? vN[0][i] : vA[0][i]; vX1[i] = last ? vN[1][i] : vA[1][i]; }
            PG8_LDB(B0, 0, 0); PG8_LDB(B1, 0, 1); PG8_SCHED; PG8_LDA(At, 0, 0); PG8_STAGE(PG8_SA(1, 1), a1, vA[1]);
            PG8_WAIT_V(8); PG8_WAIT_L(0); PG8_BAR; PG8_MMA(0, 0, At, B0); PG8_MMA(0, 1, At, B1); PG8_BAR; PG8_SCHED;
            PG8_LDA(At, 0, 1); PG8_STAGE(PG8_SB(0, 0), b2, voffB); PG8_STAGE(PG8_SB(0, 1), b2 + hstep, voffB); PG8_STAGE(PG8_SA(0, 0), a2, vX0);
            PG8_WAIT_V(8); PG8_WAIT_L(0); PG8_BAR; PG8_MMA(1, 0, At, B0); PG8_MMA(1, 1, At, B1); PG8_BAR; PG8_SCHED;
            PG8_LDB(B0, 1, 0); PG8_LDB(B1, 1, 1); PG8_SCHED; PG8_LDA(At, 1, 0); PG8_STAGE(PG8_SA(0, 1), a2, vX1);
            PG8_WAIT_V(8); PG8_WAIT_L(0); PG8_BAR; PG8_MMA(0, 0, At, B0); PG8_MMA(0, 1, At, B1); PG8_BAR; PG8_SCHED;
            PG8_LDA(At, 1, 1); PG8_STAGE(PG8_SB(1, 0), b3, voffB); PG8_STAGE(PG8_SB(1, 1), b3 + hstep, voffB); PG8_STAGE(PG8_SA(1, 0), a3, vX0);
            PG8_WAIT_V(8); PG8_WAIT_L(0); PG8_BAR; PG8_MMA(1, 0, At, B0); PG8_MMA(1, 1, At, B1); PG8_BAR; PG8_SCHED;
        }
        if constexpr (ALIGN_EPI) { if (wr == 0) PG8_BAR; }
        if constexpr (GATHER) cur.pm = ui;
        E(acc, cur, wr, wc, fr, fq);
        if (!has_next) break;
#pragma unroll
        for (int a = 0; a < 2; ++a)
#pragma unroll
            for (int b = 0; b < 2; ++b)
#pragma unroll
                for (int m = 0; m < 4; ++m)
#pragma unroll
                    for (int n = 0; n < 2; ++n) acc[a][b][m][n] = (f32x4){0.f, 0.f, 0.f, 0.f};
        cur = nxt; cA = nA; cB = nB; ++ui;
#pragma unroll
        for (int h = 0; h < 2; ++h)
#pragma unroll
            for (int i = 0; i < 2; ++i) vA[h][i] = vN[h][i];
        if constexpr (ALIGN_EPI) { if (wr == 1) PG8_BAR; }
    }
    PG8_WAIT_V(0);
    if constexpr (!ALIGN_EPI) { if (wr == 0) PG8_BAR; }
    PG8_BAR;
#undef PG8_SA
#undef PG8_SB
#undef PG8_STAGE
#undef PG8_LDA
#undef PG8_LDB
#undef PG8_MMA
#undef PG8_WAIT_V
#undef PG8_WAIT_L
#undef PG8_BAR
#undef PG8_SCHED
}
}

constexpr int NWAVES = 8;
constexpr int M = 16384, D = 1024, SEQ = 2048, NBATCH = 8;
constexpr int NIN = 5144;
constexpr int NZ = 5120;
constexpr int ZC_R = 0, ZC_K = 512, ZC_V = 1024, ZC_W = 1536, ZC_Q = 1792, ZC_KC = 2304, ZC_VC = 2432, ZC_KS = 2560, ZC_VS = 2688, ZC_KW = 2816, ZC_VW = 2944, ZC_MR = 3072, ZC_MN = 4096;
constexpr float NORM_EPS = 1e-6f, GN_EPS = 64e-5f;

constexpr size_t MiB = 1u << 20;
constexpr size_t WS_CTL = 0, CTL_ZERO_BYTES = 64 * 1024;
constexpr size_t WS_LIST = 1 * MiB;
constexpr size_t WS_GATEA = 3 * MiB;
constexpr size_t WS_RSE = 4 * MiB;
constexpr size_t WS_SLOTA = 4 * MiB + 512 * 1024;
constexpr size_t WS_SELMASK = 5 * MiB;
constexpr size_t WS_ZGATE = 6 * MiB;
constexpr size_t WS_SMALLW = 8 * MiB;
constexpr size_t SW_W2T = 0, SW_A2T = 65536, SW_G2T = 131072, SW_CK1 = 262144, SW_CV1 = 524288, SW_CK2 = 786432, SW_CV2 = 794624, SW_GATEW = 802816, SW_ROUTEW = 868352;
constexpr size_t WS_KCMP = 10 * MiB;
constexpr size_t WS_VST = 11 * MiB, WS_VWT = 15 * MiB;
constexpr size_t WS_WIN = 19 * MiB, WS_UR = 29 * MiB, WS_UN = 30 * MiB, WS_WO = 31 * MiB, WS_WPP = 33 * MiB, WS_WPG = 34 * MiB, WS_WGU = 36 * MiB, WS_WD = 100 * MiB;
constexpr size_t WS_XN = 132 * MiB;
constexpr size_t WS_PBF = 164 * MiB;
constexpr size_t WS_Z = 172 * MiB;
constexpr size_t WS_S = 332 * MiB;
constexpr size_t WS_YRW = 428 * MiB, WS_YB = 444 * MiB, WS_G = 492 * MiB, WS_LOGITS = 508 * MiB  , WS_BONUS = 508 * MiB  , WS_END = 511 * MiB;
constexpr int CH_PP = 144, CH_P = 0, CH_R = 2304, CH_Q = 4608, CH_K = 6656, CH_G = 8704, CH_AC = 10752, CH_REC = 11008, CH_V = 11008, CH_SLOT = 11520;
constexpr int CW_CNT = 0;
constexpr int CW_PANEL = 8192;
constexpr int CW_BAR = 1024;
constexpr int MISC_OFF = 163840 - 64;

constexpr int LDS_BYTES = 163840;

#define GAS __attribute__((address_space(1)))
#define LAS __attribute__((address_space(3)))
typedef unsigned short bf16;
typedef unsigned v4u __attribute__((ext_vector_type(4)));
typedef unsigned v2u __attribute__((ext_vector_type(2)));
typedef float f32x4 __attribute__((ext_vector_type(4)));
typedef float f32x2 __attribute__((ext_vector_type(2)));
typedef short bf16x8 __attribute__((ext_vector_type(8)));
typedef short bf16x4 __attribute__((ext_vector_type(4)));
typedef __bf16 bf16x2_t __attribute__((ext_vector_type(2)));
#define LDS_WAIT() asm volatile("s_waitcnt lgkmcnt(0)" ::: "memory")
#define MFMA16(a, b, c) __builtin_amdgcn_mfma_f32_16x16x32_bf16((a), (b), (c), 0, 0, 0)

__device__ __forceinline__ float bf2f(unsigned short v) { return __uint_as_float((unsigned)v << 16); }
__device__ __forceinline__ unsigned pk2(float lo, float hi) { f32x2 v = {lo, hi}; bf16x2_t b = __builtin_convertvector(v, bf16x2_t); return __builtin_bit_cast(unsigned, b); }
__device__ __forceinline__ v2u pk4(f32x4 v) { v2u r; r.x = pk2(v.x, v.y); r.y = pk2(v.z, v.w); return r; }
__device__ __forceinline__ f32x4 unpk4(v2u w) { f32x4 r; r.x = __uint_as_float(w.x << 16); r.y = __uint_as_float(w.x & 0xffff0000u); r.z = __uint_as_float(w.y << 16); r.w = __uint_as_float(w.y & 0xffff0000u); return r; }
__device__ __forceinline__ void unpk8(v4u w, float (&f)[8]) { f[0] = __uint_as_float(w.x << 16); f[1] = __uint_as_float(w.x & 0xffff0000u); f[2] = __uint_as_float(w.y << 16); f[3] = __uint_as_float(w.y & 0xffff0000u);
    f[4] = __uint_as_float(w.z << 16); f[5] = __uint_as_float(w.z & 0xffff0000u); f[6] = __uint_as_float(w.w << 16); f[7] = __uint_as_float(w.w & 0xffff0000u); }
__device__ __forceinline__ float sigmoidf_(float x) { return __builtin_amdgcn_rcpf(1.0f + __expf(-x)); }
__device__ __forceinline__ float wave_sum(float v) {
#pragma unroll
    for (int o = 1; o < 64; o <<= 1) v += __shfl_xor(v, o);
    return v;
}
template <int CTRL> __device__ __forceinline__ float dppf(float x) { return __builtin_bit_cast(float, __builtin_amdgcn_update_dpp(0, __builtin_bit_cast(int, x), CTRL, 0xf, 0xf, false)); }
__device__ __forceinline__ float row16_sum(float x) { x += dppf<0x128>(x); x += dppf<0x124>(x); x += dppf<0x122>(x); x += dppf<0x121>(x); return x; }

typedef GAS unsigned gu32;
#define XB_TMO      128
#define XB_XCNT(j)  (256  + 64 * (j))
#define XB_XSUB(j)  (1280 + 64 * (j))
#define XB_XGEN(j)  (2304 + 64 * (j))
#define XB_TOP      3328
#define XB_TOPGEN   3392
#define XCD_BAR_WORDS 3456
#define XB_SPIN_CAP (1u << 18)

__device__ __forceinline__ unsigned xb_ld(unsigned* p)              { return __hip_atomic_load(p, __ATOMIC_RELAXED, __HIP_MEMORY_SCOPE_AGENT); }
__device__ __forceinline__ unsigned xb_add(unsigned* p, unsigned v) { return __hip_atomic_fetch_add(p, v, __ATOMIC_RELAXED, __HIP_MEMORY_SCOPE_AGENT); }
__device__ __forceinline__ unsigned xb_xcc_id() { return (unsigned)__builtin_amdgcn_s_getreg((3 << 11) | 20) & 0xFu; }
#define XB_SPIN(cond, bar) do { unsigned _sp = 0; while (cond) { __builtin_amdgcn_s_sleep(1); \
    if ((++_sp & 255u) == 0u) { if (xb_ld(&(bar)[XB_TMO])) break; if (_sp > XB_SPIN_CAP) { atomicAdd(&(bar)[XB_TMO], 1u); break; } } } } while (0)

struct XcdBarrier {
    unsigned* bar; unsigned x;
    volatile LAS unsigned* st;
};

__device__ __forceinline__ XcdBarrier xcd_barrier_post(unsigned* bar, volatile LAS unsigned* st) {
    XcdBarrier b; b.bar = bar; b.x = xb_xcc_id(); b.st = st;
    if (threadIdx.x == 0) (void)xb_add(&bar[XB_XCNT(b.x)], 1u);
    return b;
}
__device__ __forceinline__ void xcd_barrier_complete(unsigned* bar, unsigned x, unsigned& nloc, unsigned& nx) {
    const unsigned G = gridDim.x * gridDim.y * gridDim.z;
    unsigned sum, cnt, mine, sp = 0u;
    for (;;) {
        sum = 0u; cnt = 0u; mine = 0u;
#pragma unroll
        for (unsigned j = 0; j < 16; ++j) { const unsigned c = xb_ld(&bar[XB_XCNT(j)]); sum += c; cnt += (c > 0u) ? 1u : 0u; mine = (j == x) ? c : mine; }
        if (sum == G) break;
        __builtin_amdgcn_s_sleep(1);
        if ((++sp & 255u) == 0u) { if (xb_ld(&bar[XB_TMO])) break; if (sp > XB_SPIN_CAP) { atomicAdd(&bar[XB_TMO], 1u); break; } }
    }
    nloc = mine > 0u ? mine : 1u; nx = cnt > 0u ? cnt : 1u;
}

__device__ __forceinline__ void xcd_barrier(const XcdBarrier& b) {
    asm volatile("s_waitcnt vmcnt(0)" ::: "memory");
    __syncthreads();
    if (threadIdx.x == 0) {
        unsigned* bar = b.bar;
        __builtin_amdgcn_s_waitcnt(0);
        unsigned nloc = b.st[0], nx = b.st[1];
        if (nloc == 0u) { xcd_barrier_complete(bar, b.x, nloc, nx); b.st[0] = nloc; b.st[1] = nx; }
        const unsigned old = xb_add(&bar[XB_XSUB(b.x)], 1u);
        const unsigned gen = old / nloc;
        if (old + 1u == (gen + 1u) * nloc) {
            __builtin_amdgcn_fence(__ATOMIC_RELEASE, "agent");
            asm volatile("s_waitcnt vmcnt(0)" ::: "memory");
            const unsigned og = xb_add(&bar[XB_TOP], 1u);
            const unsigned tg = og / nx;
            if (og + 1u == (tg + 1u) * nx) xb_add(&bar[XB_TOPGEN], 1u);
            else XB_SPIN(xb_ld(&bar[XB_TOPGEN]) == tg, bar);
            __builtin_amdgcn_fence(__ATOMIC_ACQUIRE, "agent");
            xb_add(&bar[XB_XGEN(b.x)], 1u);
            asm volatile("s_waitcnt vmcnt(0)" ::: "memory");
        } else {
            XB_SPIN(xb_ld(&bar[XB_XGEN(b.x)]) == gen, bar);
            __builtin_amdgcn_fence(__ATOMIC_ACQUIRE, "agent");
            asm volatile("s_waitcnt vmcnt(0)" ::: "memory");
        }
    }
    __syncthreads();
}

struct Args { const float* in[37]; float* out; unsigned char* ws; int ph_lo, ph_hi, rep_mask, pad; };
typedef __attribute__((address_space(4))) const Args* ArgsP;
struct Frame {
    LAS unsigned char* lds;
    int tid, lane, wave, vcu, G, gw, NGW;
    unsigned char* ws;
    ArgsP ap;
    float* out;
};

struct TrDesc { const float* W; bf16* T; bf16* T2; const float* gain; int K, ld, nc, item, mode; };
__device__ __forceinline__ void tr_load(const TrDesc& d, int lane, float (&tv)[32], f32x4 (&gn)[2]) {
    const int nblk = (d.nc + 31) / 32, kb = d.item / nblk, nb = d.item % nblk, k0 = 64 * kb, n0 = 32 * nb;
    const int nn = n0 + (lane & 31);
    gn[0] = (f32x4){1.f, 1.f, 1.f, 1.f}; gn[1] = gn[0];
    if (d.gain) { const float* gp = d.gain + k0 + 8 * (lane & 7); gn[0] = *(const f32x4*)gp; gn[1] = *(const f32x4*)(gp + 4); }
    const float* wsrc = d.W + (size_t)(k0 + (lane >> 5)) * d.ld + (nn < d.nc ? nn : 0);
#pragma unroll
    for (int i = 0; i < 32; ++i) tv[i] = wsrc[(size_t)(2 * i) * d.ld];
}
__device__ __forceinline__ void tr_finish(const TrDesc& d, LAS float* scr, int lane, const float (&tv)[32], const f32x4 (&gn)[2]) {
    const int nblk = (d.nc + 31) / 32, kb = d.item / nblk, nb = d.item % nblk, k0 = 64 * kb, n0 = 32 * nb;
#pragma unroll
    for (int i = 0; i < 32; ++i) scr[(2 * i + (lane >> 5)) * 33 + (lane & 31)] = tv[i];
    LDS_WAIT(); asm volatile("" ::: "memory");
    const int c = lane & 7;
#pragma unroll
    for (int j = 0; j < 4; ++j) { const int nl = (lane >> 3) + 8 * j, n = n0 + nl; const LAS float* s = scr + (8 * c) * 33 + nl;
        v4u o; o.x = pk2(s[0 * 33] * gn[0].x, s[1 * 33] * gn[0].y); o.y = pk2(s[2 * 33] * gn[0].z, s[3 * 33] * gn[0].w); o.z = pk2(s[4 * 33] * gn[1].x, s[5 * 33] * gn[1].y); o.w = pk2(s[6 * 33] * gn[1].z, s[7 * 33] * gn[1].w);
        if (n < d.nc) { bf16* rp;
            if (d.mode == 1) rp = n < 3072 ? d.T + (size_t)n * 1024 : (n < 3096 ? d.T2 + (size_t)(n - 3072) * 1024 : d.T + (size_t)(n - 24) * 1024);
            else if (d.mode == 2) { const int n2 = n & 511; rp = d.T + (size_t)((n2 >> 7) * 256 + (n >> 9) * 128 + (n2 & 127)) * 1024; }
            else rp = d.T + (size_t)n * d.K;
            *(v4u*)(rp + k0 + 8 * c) = o; } }
    LDS_WAIT(); asm volatile("" ::: "memory");
}
__device__ __forceinline__ void rms_row_to_bf16(int lane, const float* xrow, const float* gain, bf16* orow) {
    const f32x4* xr = (const f32x4*)xrow + lane; const f32x4* gr = (const f32x4*)gain + lane;
    f32x4 v[4]; float s = 0.f;
#pragma unroll
    for (int j = 0; j < 4; ++j) { v[j] = xr[64 * j]; s += (v[j].x * v[j].x + v[j].y * v[j].y) + (v[j].z * v[j].z + v[j].w * v[j].w); }
    const float rs = 1.0f / sqrtf(wave_sum(s) * (1.f / D) + NORM_EPS);
    v2u* o8 = (v2u*)orow + lane;
#pragma unroll
    for (int j = 0; j < 4; ++j) { const f32x4 g = gr[64 * j]; o8[64 * j] = pk4(v[j] * rs * g); }
}

namespace tri {
constexpr int I_WIN = 16 * 161, I_UR = 8 * 32, I_WO = 16 * 32, I_WPP = 4 * 32, I_L64 = 16, I_L128 = 32, I_C1 = 32 * 2, I_C2 = 2, I_GU = 16 * 32, I_DN = 8 * 32;
constexpr int E0 = I_WIN, E1 = E0 + I_UR, E2 = E1 + I_UR, E3 = E2 + I_WO, E4 = E3 + I_WPP, E5 = E4 + I_WO, E6 = E5 + I_L64, E7 = E6 + I_L64, E8 = E7 + I_L128, E9 = E8 + I_C1, E10 = E9 + I_C1, E11 = E10 + I_C2, E12 = E11 + I_C2,
              E13 = E12 + 32 * I_GU, NITEMS = E13 + 32 * I_DN;
}
__device__ __forceinline__ TrDesc tr_desc(Frame& F, int it) {
    using namespace tri;
    unsigned char* ws = F.ws;
    const float* W; const float* gain = nullptr; int K, ld, nc, item, mode = 0; size_t dst;
    if (it < E0) { W = F.ap->in[3]; K = 1024; ld = NIN; nc = NIN; item = it; mode = 1; dst = WS_WIN; }
    else if (it < E1) { W = F.ap->in[22]; K = 512; ld = 1024; nc = 1024; item = it - E0; dst = WS_UR; }
    else if (it < E2) { W = F.ap->in[23]; K = 512; ld = 1024; nc = 1024; item = it - E1; dst = WS_UN; }
    else if (it < E3) { W = F.ap->in[24]; K = 1024; ld = 1024; nc = 1024; item = it - E2; dst = WS_WO; }
    else if (it < E4) { W = F.ap->in[32]; K = 256; ld = 1024; nc = 1024; item = it - E3; dst = WS_WPP; }
    else if (it < E5) { W = F.ap->in[35]; K = 1024; ld = 1024; nc = 1024; item = it - E4; dst = WS_WPG; gain = F.ap->in[34]; }
    else if (it < E6) { W = F.ap->in[6]; K = 64; ld = 512; nc = 512; item = it - E5; dst = WS_SMALLW + SW_W2T; }
    else if (it < E7) { W = F.ap->in[8]; K = 64; ld = 512; nc = 512; item = it - E6; dst = WS_SMALLW + SW_A2T; }
    else if (it < E8) { W = F.ap->in[9]; K = 128; ld = 512; nc = 512; item = it - E7; dst = WS_SMALLW + SW_G2T; }
    else if (it < E9) { W = F.ap->in[17]; K = 2048; ld = 64; nc = 64; item = it - E8; dst = WS_SMALLW + SW_CK1; }
    else if (it < E10) { W = F.ap->in[19]; K = 2048; ld = 64; nc = 64; item = it - E9; dst = WS_SMALLW + SW_CV1; }
    else if (it < E11) { W = F.ap->in[18]; K = 64; ld = 64; nc = 64; item = it - E10; dst = WS_SMALLW + SW_CK2; }
    else if (it < E12) { W = F.ap->in[20]; K = 64; ld = 64; nc = 64; item = it - E11; dst = WS_SMALLW + SW_CV2; }
    else if (it < E13) { const int r = it - E12, e = r / I_GU; W = F.ap->in[30] + (size_t)e * 1024 * 1024; K = 1024; ld = 1024; nc = 1024; item = r % I_GU; mode = 2; dst = WS_WGU + (size_t)e * 1024 * 1024 * 2; gain = F.ap->in[25]; }
    else { const int r = it - E13, e = r / I_DN; W = F.ap->in[31] + (size_t)e * 512 * 1024; K = 512; ld = 1024; nc = 1024; item = r % I_DN; dst = WS_WD + (size_t)e * 1024 * 512 * 2; }
    return TrDesc{W, (bf16*)(ws + dst), (bf16*)(ws + WS_SMALLW + SW_GATEW), gain, K, ld, nc, item, mode};
}
__device__ __forceinline__ void tr_run(Frame& F, LAS float* scr, int it0, int stride, int it_end) {
    if (it0 >= it_end) return;
    float tvA[32], tvB[32]; f32x4 gnA[2], gnB[2];
    int it = it0; TrDesc cur = tr_desc(F, it); tr_load(cur, F.lane, tvA, gnA);
    for (;;) {
        const int nxt = it + stride; const bool has = nxt < it_end; TrDesc dn = cur;
        if (has) { dn = tr_desc(F, nxt); tr_load(dn, F.lane, tvB, gnB); }
        __builtin_amdgcn_sched_barrier(0);
        tr_finish(cur, scr, F.lane, tvA, gnA);
        if (!has) break;
        cur = dn; it = nxt;
#pragma unroll
        for (int i = 0; i < 32; ++i) tvA[i] = tvB[i];
        gnA[0] = gnB[0]; gnA[1] = gnB[1];
    }
}
__device__ __forceinline__ int tr_qnext(LAS int* qh) {
    int k = 0; const unsigned a = (unsigned)(size_t)qh; const int one = 1;
    if (__builtin_amdgcn_mbcnt_hi(~0u, __builtin_amdgcn_mbcnt_lo(~0u, 0u)) == 0) asm volatile("ds_add_rtn_u32 %0, %1, %2\n\ts_waitcnt lgkmcnt(0)" : "=&v"(k) : "v"(a), "v"(one) : "memory");
    return __builtin_amdgcn_readfirstlane(k);
}
__device__ __forceinline__ void tr_run_q(Frame& F, LAS float* scr, LAS int* qh, int base, int stride, int nk) {
    int k = tr_qnext(qh); if (k >= nk) return;
    float tvA[32], tvB[32]; f32x4 gnA[2], gnB[2];
    TrDesc cur = tr_desc(F, base + k * stride); tr_load(cur, F.lane, tvA, gnA);
    for (;;) {
        const int kn = tr_qnext(qh); const bool has = kn < nk; TrDesc dn = cur;
        if (has) { dn = tr_desc(F, base + kn * stride); tr_load(dn, F.lane, tvB, gnB); }
        __builtin_amdgcn_sched_barrier(0);
        tr_finish(cur, scr, F.lane, tvA, gnA);
        if (!has) break;
        cur = dn;
#pragma unroll
        for (int i = 0; i < 32; ++i) tvA[i] = tvB[i];
        gnA[0] = gnB[0]; gnA[1] = gnB[1];
    }
}
#ifndef MK_EXPERTS_IN_SCAN
#define MK_EXPERTS_IN_SCAN 1
#endif
__device__ __forceinline__ void p0_prologue(Frame& F) {
    LAS float* scr = (LAS float*)(F.lds + F.wave * 16384);
    unsigned char* ws = F.ws;
    bf16* gateWT = (bf16*)(ws + WS_SMALLW + SW_GATEW);
    tr_run(F, scr, F.gw, F.NGW, MK_EXPERTS_IN_SCAN ? tri::E12 : tri::NITEMS);
    for (int mb = F.gw; mb < M; mb += 4 * F.NGW) {
        f32x4 v[4][4]; float s[4];
#pragma unroll
        for (int u = 0; u < 4; ++u) { const f32x4* xr = (const f32x4*)(F.ap->in[0] + (size_t)(mb + u * F.NGW) * D) + F.lane;
#pragma unroll
            for (int j = 0; j < 4; ++j) v[u][j] = xr[64 * j]; }
#pragma unroll
        for (int u = 0; u < 4; ++u) { s[u] = 0.f;
#pragma unroll
            for (int j = 0; j < 4; ++j) s[u] += (v[u][j].x * v[u][j].x + v[u][j].y * v[u][j].y) + (v[u][j].z * v[u][j].z + v[u][j].w * v[u][j].w); }
#pragma unroll
        for (int o = 1; o < 64; o <<= 1) {
#pragma unroll
            for (int u = 0; u < 4; ++u) s[u] += __shfl_xor(s[u], o); }
        const f32x4* gr = (const f32x4*)F.ap->in[2] + F.lane;
#pragma unroll
        for (int u = 0; u < 4; ++u) { const float rs = 1.0f / sqrtf(s[u] * (1.f / D) + NORM_EPS); v2u* o8 = (v2u*)((bf16*)(ws + WS_XN) + (size_t)(mb + u * F.NGW) * D) + F.lane;
#pragma unroll
            for (int j = 0; j < 4; ++j) o8[64 * j] = pk4(v[u][j] * rs * gr[64 * j]); }
    }
    {
        float* RW = (float*)(ws + WS_SMALLW + SW_ROUTEW); const float* gf = F.ap->in[25]; const float* wg = F.ap->in[26]; const float* wr = F.ap->in[28];
        for (int idx = F.gw * 64 + F.lane; idx < 48 * 1024; idx += F.NGW * 64) { const int c = idx >> 10, k = idx & 1023; float v = 0.f;
            if (c < 4) v = wg[k * 4 + c]; else if (c < 36) v = wr[k * 32 + (c - 4)];
            RW[idx] = v * gf[k]; }
        for (int idx = F.gw * 64 + F.lane; idx < 8 * 1024; idx += F.NGW * 64) gateWT[24 * 1024 + idx] = 0;
    }
}

struct EpiStoreBf16 {
    static constexpr bool PERM = true;
    bf16* O; int ldc;
    __device__ __forceinline__ void operator()(const f32x4 (&acc)[2][2][4][2], const pg8::Unit& u, int wr, int wc, int fr, int fq) const {
        const int row0 = u.pmo * 256 + wr * 64 + fr, col0 = u.pnl * 256 + wc * 32 + 8 * fq;
#pragma unroll
        for (int ai = 0; ai < 2; ++ai)
#pragma unroll
            for (int m = 0; m < 4; ++m) { bf16* rowp = O + (size_t)(row0 + ai * 128 + m * 16) * ldc + col0;
#pragma unroll
                for (int bj = 0; bj < 2; ++bj) { const f32x4 v0 = acc[ai][bj][m][0], v1 = acc[ai][bj][m][1]; v4u w; w.x = pk2(v0[0], v0[1]); w.y = pk2(v0[2], v0[3]); w.z = pk2(v1[0], v1[1]); w.w = pk2(v1[2], v1[3]);
                    *(v4u*)(rowp + bj * 128) = w; } }
    }
};
struct EpiStoreSsq {
    static constexpr bool PERM = true;
    bf16* O; int ldc; float* part;
    __device__ __forceinline__ void operator()(const f32x4 (&acc)[2][2][4][2], const pg8::Unit& u, int wr, int wc, int fr, int fq) const {
        const int row0 = u.pmo * 256 + wr * 64 + fr, col0 = u.pnl * 256 + wc * 32 + 8 * fq;
#pragma unroll
        for (int ai = 0; ai < 2; ++ai)
#pragma unroll
            for (int m = 0; m < 4; ++m) { bf16* rowp = O + (size_t)(row0 + ai * 128 + m * 16) * ldc + col0; float ss = 0.f;
#pragma unroll
                for (int bj = 0; bj < 2; ++bj) { const f32x4 v0 = acc[ai][bj][m][0], v1 = acc[ai][bj][m][1]; v4u w; w.x = pk2(v0[0], v0[1]); w.y = pk2(v0[2], v0[3]); w.z = pk2(v1[0], v1[1]); w.w = pk2(v1[2], v1[3]);
                    *(v4u*)(rowp + bj * 128) = w;
                    ss += ((v0[0] * v0[0] + v0[1] * v0[1]) + (v0[2] * v0[2] + v0[3] * v0[3])) + ((v1[0] * v1[0] + v1[1] * v1[1]) + (v1[2] * v1[2] + v1[3] * v1[3])); }
                ss += __shfl_xor(ss, 16); ss += __shfl_xor(ss, 32);
                if (fq == 0) part[(size_t)(row0 + ai * 128 + m * 16) * 16 + u.pnl * 4 + wc] = ss; }
    }
};
#define EPI_LOOP_BEGIN \
    _Pragma("unroll") for (int ai = 0; ai < 2; ++ai) _Pragma("unroll") for (int m = 0; m < 4; ++m) { if (m == 0 || m == 2) asm volatile("" ::: "memory"); const int rl = ai * 128 + wr * 64 + m * 16 + fr; const size_t row = (size_t)u.pmo * 256 + rl; (void)row; \
    _Pragma("unroll") for (int bj = 0; bj < 2; ++bj) _Pragma("unroll") for (int n = 0; n < 2; ++n) { const int col = u.pnl * 256 + bj * 128 + wc * 32 + n * 16 + 4 * fq; (void)col; const f32x4 a = acc[ai][bj][m][n];
#define EPI_LOOP_END } }
struct EpiMix {
    static constexpr bool PERM = false;
    const bf16* z; bf16* A; bf16* O;
    __device__ __forceinline__ void operator()(const f32x4 (&acc)[2][2][4][2], const pg8::Unit& u, int wr, int wc, int fr, int fq) const {
        const int zc = u.lt ? ZC_MN : ZC_MR;
        EPI_LOOP_BEGIN
            const f32x4 zz = unpk4(*(const v2u*)(z + row * NZ + zc + col)); f32x4 o;
            o.x = sigmoidf_(zz.x) * a.x; o.y = sigmoidf_(zz.y) * a.y; o.z = sigmoidf_(zz.z) * a.z; o.w = sigmoidf_(zz.w) * a.w;
            if (u.lt == 0) *(v2u*)(A + row * D + col) = pk4(o);
            else { o = o + unpk4(*(const v2u*)(A + row * D + col)); *(v2u*)(O + row * D + col) = pk4(o); }
        EPI_LOOP_END
    }
};
struct ErawOrder {
    pg8::StaticOrder S; int c, G, nheavy;
    __device__ bool next(int i, pg8::Unit& u) const { const int nl = G - nheavy, l = c - nheavy; if (l < 0) return false; const int q = l + i * nl; if (q >= S.nwg) return false;
        pg8::StaticOrder T = S; T.c = q; T.G = S.nwg + 1; return T.next(0, u); }
};
struct DualOrder {
    pg8::StaticOrder S;
    __device__ bool next(int i, pg8::Unit& u) const { if (i >= 2) return false; if (!S.next(0, u)) return false; if (i == 1) { u.pm += 64; u.pn += 4; } u.lt = i; return true; }
};
struct EpiResBf16 {
    static constexpr bool PERM = true;
    const float* base; bf16* O;
    __device__ __forceinline__ void operator()(const f32x4 (&acc)[2][2][4][2], const pg8::Unit& u, int wr, int wc, int fr, int fq) const {
        const int row0 = u.pmo * 256 + wr * 64 + fr, col0 = u.pnl * 256 + wc * 32 + 8 * fq;
#pragma unroll
        for (int ai = 0; ai < 2; ++ai)
#pragma unroll
            for (int m = 0; m < 4; ++m) { if (m == 0 || m == 2) asm volatile("" ::: "memory"); const size_t ro = (size_t)(row0 + ai * 128 + m * 16) * D + col0;
#pragma unroll
                for (int bj = 0; bj < 2; ++bj) { const f32x4 v0 = acc[ai][bj][m][0] + *(const f32x4*)(base + ro + bj * 128), v1 = acc[ai][bj][m][1] + *(const f32x4*)(base + ro + bj * 128 + 4);
                    v4u w; w.x = pk2(v0[0], v0[1]); w.y = pk2(v0[2], v0[3]); w.z = pk2(v1[0], v1[1]); w.w = pk2(v1[2], v1[3]);
                    *(v4u*)(O + ro + bj * 128) = w; } }
    }
};
struct EpiResF32 {
    static constexpr bool PERM = false;
    const float* base; float* O;
    __device__ __forceinline__ void operator()(const f32x4 (&acc)[2][2][4][2], const pg8::Unit& u, int wr, int wc, int fr, int fq) const {
        EPI_LOOP_BEGIN
            *(f32x4*)(O + row * D + col) = *(const f32x4*)(base + row * D + col) + a;
        EPI_LOOP_END
    }
};
struct EpiMoe1 {
    static constexpr bool PERM = false;
    bf16* H; const LAS float* rsl;
    __device__ __forceinline__ void operator()(const f32x4 (&acc)[2][2][4][2], const pg8::Unit& u, int wr, int wc, int fr, int fq) const {
#pragma unroll
        for (int ai = 0; ai < 2; ++ai)
#pragma unroll
            for (int m = 0; m < 4; ++m) { const int rl = ai * 128 + wr * 64 + m * 16 + fr; const size_t row = (size_t)u.pmo * 256 + rl; const float rs = rsl[u.pm * 256 + rl];
#pragma unroll
                for (int n = 0; n < 2; ++n) { const f32x4 gt = acc[ai][0][m][n] * rs, up = acc[ai][1][m][n] * rs; f32x4 o;
                    o.x = gt.x * sigmoidf_(gt.x) * up.x; o.y = gt.y * sigmoidf_(gt.y) * up.y; o.z = gt.z * sigmoidf_(gt.z) * up.z; o.w = gt.w * sigmoidf_(gt.w) * up.w;
                    *(v2u*)(H + row * 512 + u.pnl * 128 + wc * 32 + n * 16 + 4 * fq) = pk4(o); } }
    }
};
struct EpiPle {
    static constexpr bool PERM = false;
    const bf16* x2; const bf16* Eraw; const float* rse; const float* gpn; bf16* O;
    __device__ __forceinline__ void operator()(const f32x4 (&acc)[2][2][4][2], const pg8::Unit& u, int wr, int wc, int fr, int fq) const {
        EPI_LOOP_BEGIN
            const f32x4 e = unpk4(*(const v2u*)(Eraw + row * D + col)); const f32x4 g = *(const f32x4*)(gpn + col); const float rs = rse[row]; f32x4 o = unpk4(*(const v2u*)(x2 + row * D + col));
            o.x += sigmoidf_(a.x) * e.x * rs * g.x; o.y += sigmoidf_(a.y) * e.y * rs * g.y; o.z += sigmoidf_(a.z) * e.z * rs * g.z; o.w += sigmoidf_(a.w) * e.w * rs * g.w;
            *(v2u*)(O + row * D + col) = pk4(o);
        EPI_LOOP_END
    }
};

struct EpiPleNorm {
    static constexpr bool PERM = false;
    const bf16* x2; const bf16* Eraw; const float* rse; const float* gpn; const float* rs3; const float* gfin; float* out; float* xbuf; unsigned* cnt; LAS float* ldsx;
    __device__ __forceinline__ void operator()(const f32x4 (&acc_)[2][2][4][2], const pg8::Unit& u_, int wr, int wc, int fr, int fq) const {
        f32x4 (&acc)[2][2][4][2] = const_cast<f32x4 (&)[2][2][4][2]>(acc_);
        pg8::Unit u = u_; asm volatile("" : "+s"(u.pmo), "+s"(u.pnl)); asm volatile("" : "+v"(fr), "+v"(fq)); asm volatile("" : "+s"(wr), "+s"(wc));
        int tid = threadIdx.x; asm volatile("" : "+v"(tid)); const int lane = tid & 63, wid = __builtin_amdgcn_readfirstlane(tid >> 6);
        LAS float* Pl = ldsx; LAS float* Sl = ldsx + 1024; LAS unsigned* flag = (LAS unsigned*)(ldsx + 1280);
#pragma unroll
        for (int ai = 0; ai < 2; ++ai)
#pragma unroll
            for (int m = 0; m < 4; ++m) { if (m == 0 || m == 2) asm volatile("" ::: "memory"); const int rl = ai * 128 + wr * 64 + m * 16 + fr; const size_t row = (size_t)u.pmo * 256 + rl;
                float ss = 0.f; const float r3 = rs3[row], re = rse[row];
#pragma unroll
                for (int bj = 0; bj < 2; ++bj)
#pragma unroll
                    for (int n = 0; n < 2; ++n) { const int col = u.pnl * 256 + bj * 128 + wc * 32 + n * 16 + 4 * fq; const f32x4 a = acc[ai][bj][m][n];
                        const f32x4 e = unpk4(*(const v2u*)(Eraw + row * D + col)) * re * *(const f32x4*)(gpn + col); f32x4 o = unpk4(*(const v2u*)(x2 + row * D + col));
                        o.x += sigmoidf_(a.x * r3) * e.x; o.y += sigmoidf_(a.y * r3) * e.y; o.z += sigmoidf_(a.z * r3) * e.z; o.w += sigmoidf_(a.w * r3) * e.w;
                        acc[ai][bj][m][n] = o; ss += (o.x * o.x + o.y * o.y) + (o.z * o.z + o.w * o.w); }
                ss += __shfl_xor(ss, 16); ss += __shfl_xor(ss, 32);
                if (fq == 0) Pl[rl * 4 + wc] = ss; }
        asm volatile("s_waitcnt lgkmcnt(0)" ::: "memory"); __builtin_amdgcn_s_barrier(); asm volatile("" ::: "memory");
        if (tid < 256) { const float tot = (Pl[tid * 4 + 0] + Pl[tid * 4 + 1]) + (Pl[tid * 4 + 2] + Pl[tid * 4 + 3]);
            __hip_atomic_store(xbuf + ((size_t)u.pmo * 256 + tid) * 4 + u.pnl, tot, __ATOMIC_RELAXED, __HIP_MEMORY_SCOPE_AGENT);
            asm volatile("s_waitcnt vmcnt(0)" ::: "memory");
            if (lane == 0) __hip_atomic_fetch_add(cnt + 64 * u.pmo, 1u, __ATOMIC_RELAXED, __HIP_MEMORY_SCOPE_AGENT); }
        if (wid == 0) {
            unsigned spins = 0;
            while ((unsigned)__builtin_amdgcn_readfirstlane((int)__hip_atomic_load(cnt + 64 * u.pmo, __ATOMIC_RELAXED, __HIP_MEMORY_SCOPE_AGENT)) < 16u) { __builtin_amdgcn_s_sleep(2); if (++spins > (1u << 22)) break; }
            __builtin_amdgcn_fence(__ATOMIC_ACQUIRE, "agent");
            if (lane == 0) flag[0] = 1u; }
        asm volatile("s_waitcnt vmcnt(0) lgkmcnt(0)" ::: "memory"); __builtin_amdgcn_s_barrier(); asm volatile("" ::: "memory");
        if (tid < 256) { const float* sp = xbuf + ((size_t)u.pmo * 256 + tid) * 4; float tot = 0.f;
#pragma unroll
            for (int t = 0; t < 4; ++t) tot += __hip_atomic_load(sp + t, __ATOMIC_RELAXED, __HIP_MEMORY_SCOPE_AGENT);
            Sl[tid] = 1.0f / sqrtf(tot * (1.f / D) + NORM_EPS); }
        asm volatile("s_waitcnt vmcnt(0) lgkmcnt(0)" ::: "memory"); __builtin_amdgcn_s_barrier(); asm volatile("" ::: "memory");
#pragma unroll
        for (int ai = 0; ai < 2; ++ai)
#pragma unroll
            for (int m = 0; m < 4; ++m) { const int rl = ai * 128 + wr * 64 + m * 16 + fr; const size_t row = (size_t)u.pmo * 256 + rl; const float rs = Sl[rl];
#pragma unroll
                for (int bj = 0; bj < 2; ++bj)
#pragma unroll
                    for (int n = 0; n < 2; ++n) { const int col = u.pnl * 256 + bj * 128 + wc * 32 + n * 16 + 4 * fq; *(f32x4*)(out + row * D + col) = acc[ai][bj][m][n] * rs * *(const f32x4*)(gfin + col); } }
    }
};

__device__ __forceinline__ float gelu_tanh(float x) { const float u = 0.7978845608028654f * (x + 0.044715f * x * x * x); const float t = 1.0f - 2.0f * __builtin_amdgcn_rcpf(__expf(2.0f * u) + 1.0f); return 0.5f * x * (1.0f + t); }

__device__ __forceinline__ void compress_wg_task(Frame& F, int idx) {
    const int kv = idx & 1, tile8 = (idx >> 1) & 7, bg = idx >> 4, b = bg >> 1, g = bg & 1;
    const int fr = F.lane & 15, fq = F.lane >> 4;
    const bf16* z = (const bf16*)(F.ws + WS_Z);
    const bf16* w1T = (const bf16*)(F.ws + WS_SMALLW + (kv ? SW_CV1 : SW_CK1));
    const bf16* w2T = (const bf16*)(F.ws + WS_SMALLW + (kv ? SW_CV2 : SW_CK2));
    const float* pos = kv ? F.ap->in[16] : F.ap->in[15];
    const int j0 = 16 * tile8; int j = j0 + fr; const bool jvalid = j < 127; if (!jvalid) j = 126;
    const bf16* zb = z + ((size_t)b * SEQ + 16 * j) * NZ + (kv ? ZC_VC : ZC_KC) + g * 64;
    v4u zr[8]; f32x4 p0[8], p1[8]; bf16x8 aop[8][4];
#pragma unroll
    for (int i = 0; i < 8; ++i) { const int ks = 8 * F.wave + i, l = ks >> 1, d = 32 * (ks & 1) + 8 * fq;
        zr[i] = *(const v4u*)(zb + (size_t)l * NZ + d); p0[i] = *(const f32x4*)(pos + l * 64 + d); p1[i] = *(const f32x4*)(pos + l * 64 + d + 4);
#pragma unroll
        for (int mt = 0; mt < 4; ++mt) aop[i][mt] = *(const bf16x8*)(w1T + (size_t)(16 * mt + fr) * 2048 + 32 * ks + 8 * fq); }
    f32x4 acc[4];
#pragma unroll
    for (int mt = 0; mt < 4; ++mt) acc[mt] = (f32x4){0.f, 0.f, 0.f, 0.f};
#pragma unroll
    for (int i = 0; i < 8; ++i) {
        float f[8]; unpk8(zr[i], f);
        v4u bb; bb.x = pk2(f[0] + p0[i].x, f[1] + p0[i].y); bb.y = pk2(f[2] + p0[i].z, f[3] + p0[i].w); bb.z = pk2(f[4] + p1[i].x, f[5] + p1[i].y); bb.w = pk2(f[6] + p1[i].z, f[7] + p1[i].w);
        const bf16x8 bop = __builtin_bit_cast(bf16x8, bb);
#pragma unroll
        for (int mt = 0; mt < 4; ++mt) acc[mt] = MFMA16(aop[i][mt], bop, acc[mt]);
    }
    LAS float* red = (LAS float*)F.lds;
    __syncthreads();
#pragma unroll
    for (int mt = 0; mt < 4; ++mt) *(LAS f32x4*)(red + ((F.wave * 4 + mt) * 64 + F.lane) * 4) = acc[mt];
    LDS_WAIT(); __syncthreads();
    if (F.wave != 0) return;
#pragma unroll
    for (int mt = 0; mt < 4; ++mt) { f32x4 t = (f32x4){0.f, 0.f, 0.f, 0.f};
#pragma unroll
        for (int w = 0; w < 8; ++w) t = t + *(const LAS f32x4*)(red + ((w * 4 + mt) * 64 + F.lane) * 4);
        acc[mt] = t; }
    bf16x8 hb[2];
#pragma unroll
    for (int s2 = 0; s2 < 2; ++s2) { v4u w; const f32x4 a0 = acc[2 * s2], a1 = acc[2 * s2 + 1];
        w.x = pk2(gelu_tanh(a0.x), gelu_tanh(a0.y)); w.y = pk2(gelu_tanh(a0.z), gelu_tanh(a0.w)); w.z = pk2(gelu_tanh(a1.x), gelu_tanh(a1.y)); w.w = pk2(gelu_tanh(a1.z), gelu_tanh(a1.w));
        hb[s2] = __builtin_bit_cast(bf16x8, w); }
    bf16* kcmp = (bf16*)(F.ws + WS_KCMP); bf16* vcmpT = (bf16*)(F.ws + WS_KCMP + 512 * 1024);
#pragma unroll
    for (int ntl = 0; ntl < 4; ++ntl) {
        f32x4 o = (f32x4){0.f, 0.f, 0.f, 0.f};
#pragma unroll
        for (int s2 = 0; s2 < 2; ++s2) { const bf16* wp = w2T + (size_t)(16 * ntl + fr) * 64 + 32 * s2 + 4 * fq; const v2u lo = *(const v2u*)wp, hi = *(const v2u*)(wp + 16);
            v4u aw; aw.x = lo.x; aw.y = lo.y; aw.z = hi.x; aw.w = hi.y; o = MFMA16(__builtin_bit_cast(bf16x8, aw), hb[s2], o); }
        if (!jvalid) o = (f32x4){0.f, 0.f, 0.f, 0.f};
        const int jj = j0 + fr, n = 16 * ntl + 4 * fq;
        if (kv == 0) *(v2u*)(kcmp + ((size_t)bg * 128 + jj) * 64 + n) = pk4(o);
        else { const v2u w = pk4(o); bf16* vp = vcmpT + ((size_t)bg * 64 + n) * 128 + jj; vp[0] = (bf16)(w.x & 0xffff); vp[128] = (bf16)(w.x >> 16); vp[256] = (bf16)(w.y & 0xffff); vp[384] = (bf16)(w.y >> 16); }
    }
}
__device__ __forceinline__ void zgate_task(Frame& F, int tile) {
    const int fr = F.lane & 15, fq = F.lane >> 4, m0 = tile * 16;
    const bf16* XN = (const bf16*)(F.ws + WS_XN); const bf16* gw = (const bf16*)(F.ws + WS_SMALLW + SW_GATEW);
    f32x4 acc[2] = {(f32x4){0.f, 0.f, 0.f, 0.f}, (f32x4){0.f, 0.f, 0.f, 0.f}};
#pragma unroll 16
    for (int ks = 0; ks < 32; ++ks) {
        const bf16x8 bop = *(const bf16x8*)(XN + (size_t)(m0 + fr) * D + 32 * ks + 8 * fq);
#pragma unroll
        for (int ct = 0; ct < 2; ++ct) { const bf16x8 aop = *(const bf16x8*)(gw + (size_t)(16 * ct + fr) * D + 32 * ks + 8 * fq); acc[ct] = MFMA16(aop, bop, acc[ct]); }
    }
    float* zg = (float*)(F.ws + WS_ZGATE);
#pragma unroll
    for (int ct = 0; ct < 2; ++ct) *(f32x4*)(zg + (size_t)(m0 + fr) * 32 + 16 * ct + 4 * fq) = acc[ct];
}
__device__ __forceinline__ void vt_task(Frame& F, int idx) {
    const int which = idx & 1, blk = (idx >> 1) & 31, bg = idx >> 6, b = bg >> 1, g = bg & 1;
    const bf16* z = (const bf16*)(F.ws + WS_Z);
    bf16* vT = (bf16*)(F.ws + (which ? WS_VWT : WS_VST));
    const int t = 64 * blk + F.lane;
    const bf16* src = z + ((size_t)b * SEQ + t) * NZ + (which ? ZC_VW : ZC_VS) + g * 64;
#pragma unroll
    for (int dc = 0; dc < 8; ++dc) { const v4u w = *(const v4u*)(src + 8 * dc); bf16* dst = vT + ((size_t)bg * 64 + 8 * dc) * SEQ + t;
        dst[0 * SEQ] = (bf16)(w.x & 0xffff); dst[1 * SEQ] = (bf16)(w.x >> 16); dst[2 * SEQ] = (bf16)(w.y & 0xffff); dst[3 * SEQ] = (bf16)(w.y >> 16);
        dst[4 * SEQ] = (bf16)(w.z & 0xffff); dst[5 * SEQ] = (bf16)(w.z >> 16); dst[6 * SEQ] = (bf16)(w.w & 0xffff); dst[7 * SEQ] = (bf16)(w.w >> 16); }
}
__device__ __forceinline__ void alora_task4(Frame& F, int mb) {
    const bf16* z = (const bf16*)(F.ws + WS_Z); bf16* AL = (bf16*)(F.ws + WS_PBF);
    const int l = F.lane;
    const f32x4 mu = *(const f32x4*)(F.ap->in[4] + ZC_W + 4 * l);
    v2u cw[4], pw[4];
#pragma unroll
    for (int u = 0; u < 4; ++u) { const int m = mb + u * F.NGW; const int t = m & (SEQ - 1); cw[u] = *(const v2u*)(z + (size_t)m * NZ + ZC_W + 4 * l); pw[u] = *(const v2u*)(z + (size_t)(t > 0 ? m - 1 : m) * NZ + ZC_W + 4 * l); }
#pragma unroll
    for (int u = 0; u < 4; ++u) { const int m = mb + u * F.NGW; const int t = m & (SEQ - 1);
        const f32x4 cur = unpk4(cw[u]); const f32x4 prev = unpk4(pw[u]) * (t > 0 ? 1.0f : 0.0f);
        f32x4 s = cur + (prev - cur) * mu;
        if (l < 16) { s.x = tanhf(s.x); s.y = tanhf(s.y); s.z = tanhf(s.z); s.w = tanhf(s.w); }
        else if (l >= 32) { s.x = sigmoidf_(s.x); s.y = sigmoidf_(s.y); s.z = sigmoidf_(s.z); s.w = sigmoidf_(s.w); }
        *(v2u*)(AL + (size_t)m * 256 + 4 * l) = pk4(s); }
}
__device__ __forceinline__ void p2_prep(Frame& F) {
    constexpr int T1 = 1024, T2 = T1 + 1024;
    for (int it = F.vcu; it < 256; it += F.G) compress_wg_task(F, it);
    for (int task = F.gw; task < T2; task += F.NGW) {
        if (task < T1) zgate_task(F, task);
        else vt_task(F, task - T1);
    }
    for (int base = F.gw; base < M; base += 4 * F.NGW) alora_task4(F, base);
}

__device__ __forceinline__ void ld16(const bf16* p, float (&f)[16]) { float a[8], b[8]; unpk8(*(const v4u*)p, a); unpk8(*(const v4u*)(p + 8), b);
#pragma unroll
    for (int i = 0; i < 8; ++i) { f[i] = a[i]; f[8 + i] = b[i]; } }
__device__ __forceinline__ void ld16f(const float* p, float (&f)[16]) {
#pragma unroll
    for (int q = 0; q < 4; ++q) { const f32x4 v = *(const f32x4*)(p + 4 * q); f[4 * q] = v.x; f[4 * q + 1] = v.y; f[4 * q + 2] = v.z; f[4 * q + 3] = v.w; } }
__device__ __forceinline__ void st16(bf16* p, const float (&f)[16]) { v4u a, b; a.x = pk2(f[0], f[1]); a.y = pk2(f[2], f[3]); a.z = pk2(f[4], f[5]); a.w = pk2(f[6], f[7]); b.x = pk2(f[8], f[9]); b.y = pk2(f[10], f[11]); b.z = pk2(f[12], f[13]); b.w = pk2(f[14], f[15]);
    *(v4u*)p = a; *(v4u*)(p + 8) = b; }
struct PrepW { bf16x8 w[2], a[2], g[4]; };
constexpr int PW_OFF = 32768, PW_P64 = 144, PW_P128 = 272, PW_A_OFF = PW_OFF + 64 * PW_P64, PW_G_OFF = PW_A_OFF + 64 * PW_P64;
__device__ __forceinline__ void prep_stage_w(Frame& F, int h) {
    const bf16* w2T = (const bf16*)(F.ws + WS_SMALLW + SW_W2T) + (size_t)h * 64 * 64; const bf16* a2T = (const bf16*)(F.ws + WS_SMALLW + SW_A2T) + (size_t)h * 64 * 64; const bf16* g2T = (const bf16*)(F.ws + WS_SMALLW + SW_G2T) + (size_t)h * 64 * 128;
    { const int R = F.tid >> 3, c = F.tid & 7, slot = ((R >> 2) & 3) * 16 + (R >> 4) * 4 + (R & 3);
      *(LAS v4u*)(F.lds + PW_OFF + slot * PW_P64 + c * 16) = *(const v4u*)(w2T + R * 64 + c * 8); *(LAS v4u*)(F.lds + PW_A_OFF + slot * PW_P64 + c * 16) = *(const v4u*)(a2T + R * 64 + c * 8); }
#pragma unroll
    for (int i = 0; i < 2; ++i) { const int id = F.tid + 512 * i, R = id >> 4, c = id & 15, slot = ((R >> 2) & 3) * 16 + (R >> 4) * 4 + (R & 3);
      *(LAS v4u*)(F.lds + PW_G_OFF + slot * PW_P128 + c * 16) = *(const v4u*)(g2T + R * 128 + c * 8); }
}
__device__ __forceinline__ void prep_ldw(PrepW& W, const LAS unsigned char* lds, int n, int fr, int fq) {
#pragma unroll
    for (int ks = 0; ks < 2; ++ks) { W.w[ks] = *(const LAS bf16x8*)(lds + PW_OFF + (n * 16 + fr) * PW_P64 + 64 * ks + 16 * fq); W.a[ks] = *(const LAS bf16x8*)(lds + PW_A_OFF + (n * 16 + fr) * PW_P64 + 64 * ks + 16 * fq); }
#pragma unroll
    for (int ks = 0; ks < 4; ++ks) W.g[ks] = *(const LAS bf16x8*)(lds + PW_G_OFF + (n * 16 + fr) * PW_P128 + 64 * ks + 16 * fq);
}
__device__ __forceinline__ void ldpar(const LAS float* p, float (&f)[16]) {
#pragma unroll
    for (int q = 0; q < 4; ++q) { const f32x4 v = *(const LAS f32x4*)(p + 4 * q); f[4 * q] = v.x; f[4 * q + 1] = v.y; f[4 * q + 2] = v.z; f[4 * q + 3] = v.w; } }
__device__ __forceinline__ void rwkv_prep_task(Frame& F, int task, const LAS float* par) {
    const int h = task & 7, m0 = (task >> 3) * 16, fr = F.lane & 15, fq = F.lane >> 4, m = m0 + fr, t = m & (SEQ - 1);
    const bf16* z = (const bf16*)(F.ws + WS_Z); const bf16* AL = (const bf16*)(F.ws + WS_PBF);
    bf16* vbuf = (bf16*)F.out; bf16* gbuf = (bf16*)(F.ws + WS_G);
    const int cl = h * 64 + 16 * fq;
    bf16x8 bw[2], ba[2], bgf[4];
    const bf16* alr = AL + (size_t)m * 256 + 8 * fq;
#pragma unroll
    for (int ks = 0; ks < 2; ++ks) { bw[ks] = *(const bf16x8*)(alr + 32 * ks); ba[ks] = *(const bf16x8*)(alr + 64 + 32 * ks); }
#pragma unroll
    for (int ks = 0; ks < 4; ++ks) bgf[ks] = *(const bf16x8*)(alr + 128 + 32 * ks);
    const bf16* zc = z + (size_t)m * NZ + cl; const bf16* zp = (t > 0) ? zc - NZ : zc;
    v4u zraw[6][2];
#pragma unroll
    for (int q = 0; q < 3; ++q) { zraw[q][0] = *(const v4u*)(zc + 512 * q); zraw[q][1] = *(const v4u*)(zc + 512 * q + 8); zraw[3 + q][0] = *(const v4u*)(zp + 512 * q); zraw[3 + q][1] = *(const v4u*)(zp + 512 * q + 8); }
    __builtin_amdgcn_sched_barrier(0);
    float ev[16], av[16], gv[16];
#define PREP_MM(W, n) do { f32x4 accw = (f32x4){0.f, 0.f, 0.f, 0.f}, acca = accw, accg = accw; \
        _Pragma("unroll") for (int ks = 0; ks < 2; ++ks) { accw = MFMA16(W.w[ks], bw[ks], accw); acca = MFMA16(W.a[ks], ba[ks], acca); } \
        _Pragma("unroll") for (int ks = 0; ks < 4; ++ks) accg = MFMA16(W.g[ks], bgf[ks], accg); \
        _Pragma("unroll") for (int r = 0; r < 4; ++r) { ev[4 * (n) + r] = accw[r]; av[4 * (n) + r] = acca[r]; gv[4 * (n) + r] = accg[r]; } } while (0)
    { PrepW Wa, Wb;
      prep_ldw(Wa, F.lds, 0, fr, fq); prep_ldw(Wb, F.lds, 1, fr, fq); PREP_MM(Wa, 0); PREP_MM(Wb, 1);
      prep_ldw(Wa, F.lds, 2, fr, fq); prep_ldw(Wb, F.lds, 3, fr, fq); PREP_MM(Wa, 2); PREP_MM(Wb, 3); }
    float zr[16], zk[16], zv[16], tmp[16];
    const float pm = (t > 0) ? 1.0f : 0.0f;
    {   float c[16], p[16];
#define PREP_UNP(q, dst) do { float a_[8], b_[8]; unpk8(zraw[q][0], a_); unpk8(zraw[q][1], b_); _Pragma("unroll") for (int i = 0; i < 8; ++i) { dst[i] = a_[i]; dst[8 + i] = b_[i]; } } while (0)
        PREP_UNP(0, c); PREP_UNP(3, p); ldpar(par + 0 * 64 + 16 * fq, tmp);
#pragma unroll
        for (int e = 0; e < 16; ++e) zr[e] = c[e] + (p[e] * pm - c[e]) * tmp[e];
        PREP_UNP(1, c); PREP_UNP(4, p); ldpar(par + 1 * 64 + 16 * fq, tmp);
#pragma unroll
        for (int e = 0; e < 16; ++e) zk[e] = c[e] + (p[e] * pm - c[e]) * tmp[e];
        PREP_UNP(2, c); PREP_UNP(5, p); ldpar(par + 2 * 64 + 16 * fq, tmp);
#pragma unroll
        for (int e = 0; e < 16; ++e) zv[e] = c[e] + (p[e] * pm - c[e]) * tmp[e];
    }
    float kkr[16]; float ss = 0.f;
    ldpar(par + 3 * 64 + 16 * fq, tmp);
#pragma unroll
    for (int e = 0; e < 16; ++e) { const float x = -(tmp[e] + ev[e]); const float sp = fmaxf(x, 0.f) + __logf(1.0f + __expf(-fabsf(x))); ev[e] = __expf(-sp - 0.5f); }
    ldpar(par + 4 * 64 + 16 * fq, tmp);
#pragma unroll
    for (int e = 0; e < 16; ++e) av[e] = sigmoidf_(tmp[e] + av[e]);
    ldpar(par + 5 * 64 + 16 * fq, tmp);
#pragma unroll
    for (int e = 0; e < 16; ++e) { kkr[e] = zk[e] * tmp[e]; ss += kkr[e] * kkr[e]; }
    ss += __shfl_xor(ss, 16); ss += __shfl_xor(ss, 32);
    const float inv = 1.0f / fmaxf(sqrtf(ss), 1e-12f);
    ldpar(par + 6 * 64 + 16 * fq, tmp);
    float kp[16], kka[16];
#pragma unroll
    for (int e = 0; e < 16; ++e) { kkr[e] *= inv; kka[e] = kkr[e] * av[e]; kp[e] = zk[e] * (1.0f + (av[e] - 1.0f) * tmp[e]); }
    st16(vbuf + (size_t)m * 512 + cl, zv); st16(gbuf + (size_t)m * 512 + cl, gv);
    { ldpar(par + 7 * 64 + 16 * fq, tmp);
      float bsum = 0.f;
#pragma unroll
      for (int e = 0; e < 16; ++e) bsum += zr[e] * kp[e] * tmp[e];
      bsum += __shfl_xor(bsum, 16); bsum += __shfl_xor(bsum, 32);
      if (fq == 0) ((float*)(F.ws + WS_BONUS))[(size_t)m * 8 + h] = bsum; }
    asm volatile("" ::: "memory");
    unsigned char* rec = F.ws + WS_S + (size_t)task * CH_REC;
    bf16x8 Pb[2], Qb[2], Kb[2], Rb[2];
#pragma unroll
    for (int ks = 0; ks < 2; ++ks) {
        float Pm[8], Qm[8], Km[8], Rm[8], acv[8];
#pragma unroll
        for (int e8 = 0; e8 < 8; ++e8) { const int e = 8 * ks + e8;
            float cs = ev[e]; cs += dppf<0x111>(cs); cs += dppf<0x112>(cs); cs += dppf<0x114>(cs); cs += dppf<0x118>(cs);
            const float A = __expf(-cs), Ap = __expf(ev[e] - cs), iA = __expf(cs);
            Pm[e8] = kkr[e] * Ap; Qm[e8] = -kka[e] * iA; Km[e8] = kp[e] * iA; Rm[e8] = zr[e] * A; acv[e8] = A; }
        v4u w;
        w.x = pk2(Pm[0], Pm[1]); w.y = pk2(Pm[2], Pm[3]); w.z = pk2(Pm[4], Pm[5]); w.w = pk2(Pm[6], Pm[7]); Pb[ks] = __builtin_bit_cast(bf16x8, w);
        w.x = pk2(Qm[0], Qm[1]); w.y = pk2(Qm[2], Qm[3]); w.z = pk2(Qm[4], Qm[5]); w.w = pk2(Qm[6], Qm[7]); Qb[ks] = __builtin_bit_cast(bf16x8, w);
        w.x = pk2(Km[0], Km[1]); w.y = pk2(Km[2], Km[3]); w.z = pk2(Km[4], Km[5]); w.w = pk2(Km[6], Km[7]); Kb[ks] = __builtin_bit_cast(bf16x8, w);
        w.x = pk2(Rm[0], Rm[1]); w.y = pk2(Rm[2], Rm[3]); w.z = pk2(Rm[4], Rm[5]); w.w = pk2(Rm[6], Rm[7]); Rb[ks] = __builtin_bit_cast(bf16x8, w);
        if (fr == 15) { *(f32x4*)(rec + CH_AC + (16 * fq + 8 * ks) * 4) = (f32x4){acv[0], acv[1], acv[2], acv[3]}; *(f32x4*)(rec + CH_AC + (16 * fq + 8 * ks + 4) * 4) = (f32x4){acv[4], acv[5], acv[6], acv[7]}; }
    }
    *(v4u*)(rec + CH_P + fr * CH_PP + 32 * fq) = __builtin_bit_cast(v4u, Pb[0]); *(v4u*)(rec + CH_P + fr * CH_PP + 32 * fq + 16) = __builtin_bit_cast(v4u, Pb[1]);
    *(v4u*)(rec + CH_R + fr * CH_PP + 32 * fq) = __builtin_bit_cast(v4u, Rb[0]); *(v4u*)(rec + CH_R + fr * CH_PP + 32 * fq + 16) = __builtin_bit_cast(v4u, Rb[1]);
    *(v4u*)(rec + CH_Q + (fq * 16 + fr) * 32) = __builtin_bit_cast(v4u, Qb[0]); *(v4u*)(rec + CH_Q + (fq * 16 + fr) * 32 + 16) = __builtin_bit_cast(v4u, Qb[1]);
    *(v4u*)(rec + CH_K + (fq * 16 + fr) * 32) = __builtin_bit_cast(v4u, Kb[0]); *(v4u*)(rec + CH_K + (fq * 16 + fr) * 32 + 16) = __builtin_bit_cast(v4u, Kb[1]);
    f32x4 gqp = (f32x4){0.f, 0.f, 0.f, 0.f}, gkp = gqp, gqr = gqp, gkr = gqp;
#pragma unroll
    for (int ks = 0; ks < 2; ++ks) { gqp = MFMA16(Qb[ks], Pb[ks], gqp); gkp = MFMA16(Kb[ks], Pb[ks], gkp); gqr = MFMA16(Qb[ks], Rb[ks], gqr); gkr = MFMA16(Kb[ks], Rb[ks], gkr); }
#pragma unroll
    for (int rg = 0; rg < 4; ++rg) { const int s = 4 * fq + rg; if (!(s < fr)) { gqp[rg] = 0.f; gkp[rg] = 0.f; } if (!(s <= fr)) { gqr[rg] = 0.f; gkr[rg] = 0.f; } }
    *(v2u*)(rec + CH_G + 0 * 512 + (fr * 16 + 4 * fq) * 2) = pk4(gkp);
    *(v2u*)(rec + CH_G + 2 * 512 + (fr * 16 + 4 * fq) * 2) = pk4(gqr);
    *(v2u*)(rec + CH_G + 3 * 512 + (fr * 16 + 4 * fq) * 2) = pk4(gkr);
    LAS float* Nl = (LAS float*)(F.lds + F.wave * 4096);
#pragma unroll
    for (int rg = 0; rg < 4; ++rg) Nl[(4 * fq + rg) * 20 + fr] = gqp[rg];
    LDS_WAIT(); __builtin_amdgcn_wave_barrier(); asm volatile("" ::: "memory");
    float Tc[16];
#pragma unroll
    for (int s = 15; s >= 0; --s) {
        float acc = 0.f;
#pragma unroll
        for (int q4 = 0; q4 < 4; ++q4) if (4 * q4 + 3 > s) { const f32x4 nv = *(const LAS f32x4*)(Nl + s * 20 + 4 * q4);
#pragma unroll
            for (int u = 0; u < 4; ++u) if (4 * q4 + u > s) acc += nv[u] * Tc[4 * q4 + u]; }
        Tc[s] = (s == fr) ? 1.0f : acc; }
    { f32x4 tv;
#pragma unroll
      for (int u = 0; u < 4; ++u) tv[u] = fq == 0 ? Tc[u] : (fq == 1 ? Tc[4 + u] : (fq == 2 ? Tc[8 + u] : Tc[12 + u]));
      *(v2u*)(rec + CH_G + 1 * 512 + (fr * 16 + 4 * fq) * 2) = pk4(tv); }
    LDS_WAIT(); __builtin_amdgcn_wave_barrier(); asm volatile("" ::: "memory");
#undef PREP_MM
#undef PREP_UNP
}
__device__ __forceinline__ void prep_fill_par(Frame& F, LAS float* par, int h) {
    const int l = F.lane; const float* mu = F.ap->in[4];
    par[0 * 64 + l] = mu[ZC_R + h * 64 + l]; par[1 * 64 + l] = mu[ZC_K + h * 64 + l]; par[2 * 64 + l] = mu[ZC_V + h * 64 + l];
    par[3 * 64 + l] = F.ap->in[5][h * 64 + l]; par[4 * 64 + l] = F.ap->in[7][h * 64 + l]; par[5 * 64 + l] = F.ap->in[10][h * 64 + l]; par[6 * 64 + l] = F.ap->in[11][h * 64 + l]; par[7 * 64 + l] = F.ap->in[12][h * 64 + l];
    LDS_WAIT(); __builtin_amdgcn_wave_barrier(); asm volatile("" ::: "memory");
}

__device__ __forceinline__ float nsa_slope(int g, int r) { return __uint_as_float((unsigned)(127 - (g * 4 + r + 1)) << 23); }

constexpr int CMP_KC_OFF = 32768, CMP_KP = 144, CMP_VC_OFF = CMP_KC_OFF + 128 * CMP_KP, CMP_VP = 264;
__device__ __forceinline__ void nsa_cmp_stage(Frame& F, int bg) {
    const bf16* kcmp = (const bf16*)(F.ws + WS_KCMP) + (size_t)bg * 128 * 64; const bf16* vcmpT = (const bf16*)(F.ws + WS_KCMP + 512 * 1024) + (size_t)bg * 64 * 128;
    v4u a[2], v[2];
#pragma unroll
    for (int i = 0; i < 2; ++i) { const int id = F.tid + 512 * i; a[i] = *(const v4u*)(kcmp + (size_t)(id >> 3) * 64 + (id & 7) * 8); v[i] = *(const v4u*)(vcmpT + (size_t)(id >> 4) * 128 + (id & 15) * 8); }
#pragma unroll
    for (int i = 0; i < 2; ++i) { const int id = F.tid + 512 * i; *(LAS v4u*)(F.lds + CMP_KC_OFF + (id >> 3) * CMP_KP + (id & 7) * 16) = a[i]; *(LAS v4u*)(F.lds + CMP_VC_OFF + (id >> 4) * CMP_VP + (id & 15) * 16) = v[i]; }
}
template <int ABL>
__device__ __forceinline__ void nsa_cmp_task(Frame& F, int task) {
    const int tile = task & 127, bg = task >> 7, b = bg >> 1, g = bg & 1;
    const int fr = F.lane & 15, fq = F.lane >> 4, t = tile * 16 + fr, m = b * SEQ + t;
    const bf16* z = (const bf16*)(F.ws + WS_Z);
    const float* zg = (const float*)(F.ws + WS_ZGATE); const float* gb = F.ap->in[21];
    bf16* Y = (bf16*)(F.ws + WS_YB);
    bf16x8 qall[4][2]; float gl[4];
#pragma unroll
    for (int r = 0; r < 4; ++r) { const bf16* qp = z + (size_t)m * NZ + ZC_Q + (g * 4 + r) * 64 + 8 * fq; qall[r][0] = *(const bf16x8*)qp; qall[r][1] = *(const bf16x8*)(qp + 32);
        gl[r] = zg[(size_t)m * 32 + (g * 4 + r) * 3 + 0] + gb[(g * 4 + r) * 3 + 0]; }
    const LAS unsigned char* kc = F.lds + CMP_KC_OFF + fr * CMP_KP + 16 * fq; const LAS unsigned char* vc = F.lds + CMP_VC_OFF + fr * CMP_VP + 8 * fq;
    const int tv = t - 31 - 64 * fq; const float tb = (float)t - 15.5f - 64.0f * (float)fq;
    float impl[8], imp3[8];
#pragma unroll
    for (int kt = 0; kt < 8; ++kt) { impl[kt] = 0.f; imp3[kt] = 0.f; }
#pragma unroll
    for (int r = 0; r < 4; ++r) {
        const float slope = nsa_slope(g, r);
        const bf16x8 q0 = qall[r][0], q1 = qall[r][1];
        float s[8][4]; float mx = -1e30f;
#pragma unroll
        for (int kt = 0; kt < 8; ++kt) {
            f32x4 a = (f32x4){0.f, 0.f, 0.f, 0.f};
            a = MFMA16(*(const LAS bf16x8*)(kc + 16 * kt * CMP_KP), q0, a); a = MFMA16(*(const LAS bf16x8*)(kc + 16 * kt * CMP_KP + 64), q1, a);
#pragma unroll
            for (int rg = 0; rg < 4; ++rg) { const bool valid = ((256 * kt + 16 * rg) <= tv);
                const float sc = a[rg] * 0.125f - slope * (tb - (float)(256 * kt + 16 * rg)); s[kt][rg] = valid ? sc : -1e30f; mx = fmaxf(mx, s[kt][rg]); }
        }
        mx = fmaxf(mx, __shfl_xor(mx, 16)); mx = fmaxf(mx, __shfl_xor(mx, 32));
        float sum = 0.f;
#pragma unroll
        for (int kt = 0; kt < 8; ++kt)
#pragma unroll
            for (int rg = 0; rg < 4; ++rg) { const float p = (s[kt][rg] > -1e29f) ? __expf(s[kt][rg] - mx) : 0.f; s[kt][rg] = p; sum += p; }
        sum += __shfl_xor(sum, 16); sum += __shfl_xor(sum, 32);
        const float inv = sum > 0.f ? 1.0f / sum : 0.f;
#pragma unroll
        for (int kt = 0; kt < 8; ++kt) {
#pragma unroll
            for (int rg = 0; rg < 4; ++rg) s[kt][rg] *= inv;
            impl[kt] += s[kt][0] + s[kt][1] + s[kt][2] + 0.5f * s[kt][3]; imp3[kt] += s[kt][3]; }
        f32x4 o[4];
#pragma unroll
        for (int dt = 0; dt < 4; ++dt) o[dt] = (f32x4){0.f, 0.f, 0.f, 0.f};
#pragma unroll
        for (int s2 = 0; s2 < 4; ++s2) {
            v4u pw; pw.x = pk2(s[2 * s2][0], s[2 * s2][1]); pw.y = pk2(s[2 * s2][2], s[2 * s2][3]); pw.z = pk2(s[2 * s2 + 1][0], s[2 * s2 + 1][1]); pw.w = pk2(s[2 * s2 + 1][2], s[2 * s2 + 1][3]);
            const bf16x8 pb = __builtin_bit_cast(bf16x8, pw);
#pragma unroll
            for (int dt = 0; dt < 4; ++dt) { const LAS unsigned char* vp = vc + 16 * dt * CMP_VP + 64 * s2; const v2u lo = *(const LAS v2u*)vp, hi = *(const LAS v2u*)(vp + 32);
                v4u aw; aw.x = lo.x; aw.y = lo.y; aw.z = hi.x; aw.w = hi.y; o[dt] = MFMA16(__builtin_bit_cast(bf16x8, aw), pb, o[dt]); }
        }
        const int hh = g * 4 + r; const float gate = sigmoidf_(gl[r]);
#pragma unroll
        for (int dt = 0; dt < 4; ++dt) *(v2u*)(Y + (size_t)m * 512 + hh * 64 + 16 * dt + 4 * fq) = pk4(o[dt] * gate);
        __builtin_amdgcn_sched_barrier(0);
    }
    if (ABL == 1) return;
    LAS float* sc = (LAS float*)(F.lds + F.wave * 4096);
    float y3prev = 0.f;
#pragma unroll
    for (int kt = 0; kt < 8; ++kt) {
        const float y3 = __shfl(imp3[kt], (F.lane + 48) & 63);
        const float prev = (fq > 0) ? y3 : y3prev; y3prev = y3;
        sc[fr * 33 + 4 * kt + fq] = impl[kt] + 0.5f * prev;
    }
    LDS_WAIT(); __builtin_amdgcn_wave_barrier(); asm volatile("" ::: "memory");
    const int blk_t = t >> 6, chi = blk_t - 2;
    unsigned mask = 1u | (1u << blk_t) | (blk_t > 0 ? (1u << (blk_t - 1)) : 0u);
#pragma unroll
    for (int kt = 0; kt < 8; ++kt) {
        const int k = 4 * kt + fq;
        if (k >= 1 && k <= chi) { const float me = sc[fr * 33 + k]; int rank = 0;
            for (int k2 = 1; k2 <= chi; ++k2) { const float o = sc[fr * 33 + k2]; rank += (o > me || (o == me && k2 < k)) ? 1 : 0; }
            if (rank < 5) mask |= (1u << k); }
    }
    mask |= (unsigned)__shfl_xor((int)mask, 16); mask |= (unsigned)__shfl_xor((int)mask, 32);
    if (fq == 0) ((unsigned*)(F.ws + WS_SELMASK))[(size_t)bg * SEQ + t] = mask;
    LDS_WAIT(); __builtin_amdgcn_wave_barrier(); asm volatile("" ::: "memory");
}
__device__ __forceinline__ void p3_phase(Frame& F) {
    constexpr int T0 = 2048, T1 = T0 + 8192;
#ifdef DUP_P3A
    for (int task = F.gw; task < T0; task += F.NGW) { __syncthreads(); nsa_cmp_stage(F, task >> 7); LDS_WAIT(); __syncthreads(); nsa_cmp_task<DUP_P3A>(F, task); }
    asm volatile("" ::: "memory");
#endif
    for (int task = F.gw; task < T0; task += F.NGW) { __syncthreads(); nsa_cmp_stage(F, task >> 7); LDS_WAIT(); __syncthreads(); nsa_cmp_task<0>(F, task); }
    asm volatile("" ::: "memory");
    const int h = F.vcu & 7;
    LAS float* par = (LAS float*)(F.lds + F.wave * 4096 + 2048);
    __syncthreads();
    prep_fill_par(F, par, h); prep_stage_w(F, h);
    LDS_WAIT(); __syncthreads();
#ifdef DUP_P3B
    for (int i = F.wave; i < 32; i += 8) rwkv_prep_task(F, (((F.vcu >> 3) + 32 * i) << 3) | h, par);
    asm volatile("" ::: "memory");
#endif
    for (int i = F.wave; i < 32; i += 8) rwkv_prep_task(F, (((F.vcu >> 3) + 32 * i) << 3) | h, par);
}

constexpr int NSA_KP = 144, NSA_VP = 136, NSA_BUF = 64 * NSA_KP + 64 * NSA_VP, NSA_CTL = 2 * NSA_BUF + 1024;
struct NsaState { f32x4 O[2][4]; float mrun[2], lrun[2]; };
template <int WHICH, bool MASKED>
__device__ __forceinline__ void nsa_block(NsaState& St, const LAS unsigned char* kb_, const LAS unsigned char* vb_, const bf16x8 (&qf)[2][2], int kb, unsigned mymask, int t, int fq, float slope0) {
    const int kpos0 = 64 * kb;
    bf16x8 kf[4][2];
#pragma unroll
    for (int kt = 0; kt < 4; ++kt) { kf[kt][0] = *(const LAS bf16x8*)(kb_ + 16 * kt * NSA_KP); kf[kt][1] = *(const LAS bf16x8*)(kb_ + 16 * kt * NSA_KP + 64); }
    const bool bsel = (mymask >> kb) & 1u; const int dbase = t - 4 * fq - kpos0;
    const float fdb = (float)dbase;
    bf16x8 P[2][2];
#pragma unroll
    for (int r = 0; r < 2; ++r) {
        const float slope = r ? 0.5f * slope0 : slope0;
        float s[4][4]; float bm = -1e30f;
        float base = -slope * fdb;
        const float s1 = slope, s2_ = 2.0f * slope, s3 = 3.0f * slope, s16 = 16.0f * slope;
#pragma unroll
        for (int kt = 0; kt < 4; ++kt) { f32x4 a = (f32x4){base, base + s1, base + s2_, base + s3}; base += s16;
            a = MFMA16(kf[kt][0], qf[r][0], a); a = MFMA16(kf[kt][1], qf[r][1], a);
#pragma unroll
            for (int rg = 0; rg < 4; ++rg) {
                if (MASKED) { const int dist = dbase - (16 * kt + rg); const bool valid = bsel && dist >= 0 && (WHICH == 0 || dist < 512); s[kt][rg] = valid ? a[rg] : -1e30f; }
                else s[kt][rg] = a[rg];
                bm = fmaxf(bm, s[kt][rg]); } }
        bm = fmaxf(bm, __shfl_xor(bm, 16)); bm = fmaxf(bm, __shfl_xor(bm, 32));
        const float mnew = fmaxf(St.mrun[r], bm); const float scale = __builtin_amdgcn_exp2f(St.mrun[r] - mnew); St.mrun[r] = mnew;
        float ps = 0.f;
#pragma unroll
        for (int kt = 0; kt < 4; ++kt)
#pragma unroll
            for (int rg = 0; rg < 4; ++rg) { float p = __builtin_amdgcn_exp2f(s[kt][rg] - mnew); if (MASKED) p = (s[kt][rg] > -1e29f) ? p : 0.f; s[kt][rg] = p; ps += p; }
        St.lrun[r] = St.lrun[r] * scale + ps;
#pragma unroll
        for (int dt = 0; dt < 4; ++dt) St.O[r][dt] = St.O[r][dt] * scale;
#pragma unroll
        for (int s2 = 0; s2 < 2; ++s2) { v4u pw; pw.x = pk2(s[2 * s2][0], s[2 * s2][1]); pw.y = pk2(s[2 * s2][2], s[2 * s2][3]); pw.z = pk2(s[2 * s2 + 1][0], s[2 * s2 + 1][1]); pw.w = pk2(s[2 * s2 + 1][2], s[2 * s2 + 1][3]);
            P[r][s2] = __builtin_bit_cast(bf16x8, pw); }
    }
#pragma unroll
    for (int dt = 0; dt < 4; ++dt)
#pragma unroll
        for (int s2 = 0; s2 < 2; ++s2) { const LAS unsigned char* vp = vb_ + 16 * dt * NSA_VP + 64 * s2; const v2u lo = *(const LAS v2u*)vp, hi = *(const LAS v2u*)(vp + 32);
            v4u aw; aw.x = lo.x; aw.y = lo.y; aw.z = hi.x; aw.w = hi.y; const bf16x8 vf = __builtin_bit_cast(bf16x8, aw);
#pragma unroll
            for (int r = 0; r < 2; ++r) St.O[r][dt] = MFMA16(vf, P[r][s2], St.O[r][dt]); }
}
template <int WHICH>
__device__ __forceinline__ void nsa_wg_task(Frame& F, int item) {
    const int hp = item & 1, bg = item >> 5, tg = (item >> 1) & 15, b = bg >> 1, g = bg & 1;
    const int fr = F.lane & 15, fq = F.lane >> 4, tile = tg * 8 + F.wave, t0 = tile * 16, t = t0 + fr, m = b * SEQ + t;
    const int h0 = g * 4 + 2 * hp;
    const bf16* z = (const bf16*)(F.ws + WS_Z);
    const bf16* Kb = z + (size_t)b * SEQ * NZ + (WHICH ? ZC_KW : ZC_KS) + g * 64;
    const bf16* VT = (const bf16*)(F.ws + (WHICH ? WS_VWT : WS_VST)) + (size_t)bg * 64 * SEQ;
    unsigned mymask, tile_or, full; const int kb_hi = (t0 + 15) >> 6;
    if (WHICH == 0) { mymask = ((const unsigned*)(F.ws + WS_SELMASK))[(size_t)bg * SEQ + t]; unsigned x = mymask, y = mymask;
        x |= (unsigned)__shfl_xor((int)x, 1); x |= (unsigned)__shfl_xor((int)x, 2); x |= (unsigned)__shfl_xor((int)x, 4); x |= (unsigned)__shfl_xor((int)x, 8);
        y &= (unsigned)__shfl_xor((int)y, 1); y &= (unsigned)__shfl_xor((int)y, 2); y &= (unsigned)__shfl_xor((int)y, 4); y &= (unsigned)__shfl_xor((int)y, 8);
        tile_or = (unsigned)__builtin_amdgcn_readfirstlane((int)x); full = (unsigned)__builtin_amdgcn_readfirstlane((int)y) & ((1u << kb_hi) - 1u); }
    else { mymask = 0xffffffffu; const int lo = (t0 - 511) > 0 ? ((t0 - 511) >> 6) : 0; tile_or = 0u; full = 0u;
        for (int k = lo; k <= kb_hi; ++k) { tile_or |= (1u << k); if (k < kb_hi && 64 * k >= t0 - 496) full |= (1u << k); } }
    tile_or &= (kb_hi >= 31) ? 0xffffffffu : ((2u << kb_hi) - 1u);
    LAS unsigned* ctl = (LAS unsigned*)(F.lds + NSA_CTL);
    __syncthreads();
    if (F.lane == 0) ctl[F.wave] = tile_or;
    LDS_WAIT(); __syncthreads();
    unsigned rem = 0u;
#pragma unroll
    for (int w = 0; w < 8; ++w) rem |= ctl[w];
    rem = (unsigned)__builtin_amdgcn_readfirstlane((int)rem);
    bf16x8 qf[2][2];
#pragma unroll
    for (int r = 0; r < 2; ++r)
#pragma unroll
        for (int ks = 0; ks < 2; ++ks) { const v4u raw = *(const v4u*)(z + (size_t)m * NZ + ZC_Q + (h0 + r) * 64 + 8 * fq + 32 * ks); float f[8]; unpk8(raw, f);
            constexpr float QS = 0.125f * 1.4426950408889634f; v4u w; w.x = pk2(f[0] * QS, f[1] * QS); w.y = pk2(f[2] * QS, f[3] * QS); w.z = pk2(f[4] * QS, f[5] * QS); w.w = pk2(f[6] * QS, f[7] * QS);
            qf[r][ks] = __builtin_bit_cast(bf16x8, w); }
    NsaState St;
#pragma unroll
    for (int r = 0; r < 2; ++r) { St.mrun[r] = -1e30f; St.lrun[r] = 0.f;
#pragma unroll
        for (int dt = 0; dt < 4; ++dt) St.O[r][dt] = (f32x4){0.f, 0.f, 0.f, 0.f}; }
    const float slope0 = 1.4426950408889634f * __uint_as_float((unsigned)(127 - (h0 + 1)) << 23);
    const int srow = F.tid >> 3, sc = F.tid & 7;
    const bf16* ksrc = Kb + (size_t)srow * NZ + sc * 8; const bf16* vsrc = VT + (size_t)srow * SEQ + sc * 8;
    const int kdst = srow * NSA_KP + sc * 16, vdst = 64 * NSA_KP + srow * NSA_VP + sc * 16;
    const LAS unsigned char* kfr = F.lds + fr * NSA_KP + 16 * fq; const LAS unsigned char* vfr = F.lds + 64 * NSA_KP + fr * NSA_VP + 8 * fq;
    int kb = __builtin_ctz(rem); rem &= rem - 1u;
    v4u kreg = *(const v4u*)(ksrc + (size_t)64 * kb * NZ), vreg = *(const v4u*)(vsrc + 64 * kb);
    *(LAS v4u*)(F.lds + kdst) = kreg; *(LAS v2u*)(F.lds + vdst) = (v2u){vreg.x, vreg.y}; *(LAS v2u*)(F.lds + vdst + 8) = (v2u){vreg.z, vreg.w};
    LDS_WAIT(); __syncthreads();
    int buf = 0;
    for (;;) {
        int kbn = -1;
        if (rem) { kbn = __builtin_ctz(rem); rem &= rem - 1u; kreg = *(const v4u*)(ksrc + (size_t)64 * kbn * NZ); vreg = *(const v4u*)(vsrc + 64 * kbn); }
        __builtin_amdgcn_sched_barrier(0);
        if ((tile_or >> kb) & 1u) {
            if ((full >> kb) & 1u) nsa_block<WHICH, false>(St, kfr + buf * NSA_BUF, vfr + buf * NSA_BUF, qf, kb, mymask, t, fq, slope0);
            else nsa_block<WHICH, true>(St, kfr + buf * NSA_BUF, vfr + buf * NSA_BUF, qf, kb, mymask, t, fq, slope0);
        }
        __builtin_amdgcn_sched_barrier(0);
        if (kbn < 0) break;
        buf ^= 1;
        *(LAS v4u*)(F.lds + buf * NSA_BUF + kdst) = kreg; *(LAS v2u*)(F.lds + buf * NSA_BUF + vdst) = (v2u){vreg.x, vreg.y}; *(LAS v2u*)(F.lds + buf * NSA_BUF + vdst + 8) = (v2u){vreg.z, vreg.w};
        LDS_WAIT(); __syncthreads();
        kb = kbn;
    }
    const float* zg = (const float*)(F.ws + WS_ZGATE); const float* gb = F.ap->in[21];
    bf16* Y = (bf16*)(F.ws + WS_YB + (size_t)(1 + WHICH) * 16 * MiB);
#pragma unroll
    for (int r = 0; r < 2; ++r) { float l = St.lrun[r]; l += __shfl_xor(l, 16); l += __shfl_xor(l, 32);
        const int hh = h0 + r; const float gate = sigmoidf_(zg[(size_t)m * 32 + hh * 3 + 1 + WHICH] + gb[hh * 3 + 1 + WHICH]); const float f = gate / l;
#pragma unroll
        for (int dt = 0; dt < 4; ++dt) *(v2u*)(Y + (size_t)m * 512 + hh * 64 + 16 * dt + 4 * fq) = pk4(St.O[r][dt] * f); }
}
__device__ __forceinline__ void p4_phase(Frame& F) {
    for (int it = F.vcu; it < 512; it += F.G) { nsa_wg_task<1>(F, it); nsa_wg_task<0>(F, 511 - it); }
}

typedef short v4i16_t __attribute__((ext_vector_type(4)));
__device__ __forceinline__ bf16x8 tr_lo(const LAS unsigned char* p) {
    const v4i16_t t = __builtin_amdgcn_ds_read_tr16_b64_v4i16((LAS v4i16_t*)p);
    return (bf16x8){t[0], t[1], t[2], t[3], 0, 0, 0, 0};
}
__device__ __forceinline__ bf16x8 lo4(v2u g) { v4u w; w.x = g.x; w.y = g.y; w.z = 0u; w.w = 0u; return __builtin_bit_cast(bf16x8, w); }
__device__ __forceinline__ bf16x8 cat8(v2u a, v2u b) { v4u w; w.x = a.x; w.y = a.y; w.z = b.x; w.w = b.y; return __builtin_bit_cast(bf16x8, w); }
struct ChunkOps { v2u pA[2][2], rA[2][2], g[4]; f32x4 ac[4]; bf16x8 aq[4], ak[4], bv; };
__device__ __forceinline__ void chunk_load(const LAS unsigned char* sl, ChunkOps& X, int lane) {
    const int fr = lane & 15, fq = lane >> 4;
#pragma unroll
    for (int m = 0; m < 2; ++m) { X.pA[m][0] = *(const LAS v2u*)(sl + CH_P + fr * CH_PP + 64 * m + 8 * fq); X.pA[m][1] = *(const LAS v2u*)(sl + CH_P + fr * CH_PP + 64 * m + 32 + 8 * fq);
        X.rA[m][0] = *(const LAS v2u*)(sl + CH_R + fr * CH_PP + 64 * m + 8 * fq); X.rA[m][1] = *(const LAS v2u*)(sl + CH_R + fr * CH_PP + 64 * m + 32 + 8 * fq); }
#pragma unroll
    for (int x = 0; x < 4; ++x) X.g[x] = *(const LAS v2u*)(sl + CH_G + 512 * x + (fr * 16 + 4 * fq) * 2);
    X.bv = tr_lo(sl + CH_V + 8 * lane);
#pragma unroll
    for (int jt = 0; jt < 4; ++jt) { X.aq[jt] = tr_lo(sl + CH_Q + jt * 512 + 8 * lane); X.ak[jt] = tr_lo(sl + CH_K + jt * 512 + 8 * lane);
        X.ac[jt] = *(const LAS f32x4*)(sl + CH_AC + (16 * jt + 4 * fq) * 4); }
}
__device__ __forceinline__ bf16x8 lo4t(bf16x8 t) { return t; }
__device__ __forceinline__ void chunk_math(const ChunkOps& X, f32x4 (&S)[4], f32x4& o_out) {
    bf16x8 bs[2];
#pragma unroll
    for (int m = 0; m < 2; ++m) { v4u w; w.x = pk2(S[2 * m][0], S[2 * m][1]); w.y = pk2(S[2 * m][2], S[2 * m][3]); w.z = pk2(S[2 * m + 1][0], S[2 * m + 1][1]); w.w = pk2(S[2 * m + 1][2], S[2 * m + 1][3]); bs[m] = __builtin_bit_cast(bf16x8, w); }
    const f32x4 z4 = (f32x4){0.f, 0.f, 0.f, 0.f};
    const bf16x8 bv = lo4t(X.bv);
    f32x4 y = MFMA16(cat8(X.pA[0][0], X.pA[0][1]), bs[0], z4); y = MFMA16(cat8(X.pA[1][0], X.pA[1][1]), bs[1], y); y = MFMA16(lo4(X.g[0]), bv, y);
    f32x4 o = MFMA16(cat8(X.rA[0][0], X.rA[0][1]), bs[0], z4); o = MFMA16(cat8(X.rA[1][0], X.rA[1][1]), bs[1], o); o = MFMA16(lo4(X.g[3]), bv, o);
    const bf16x8 by = lo4(pk4(y));
    const f32x4 u = MFMA16(lo4(X.g[1]), by, z4);
    const bf16x8 bu = lo4(pk4(u));
    o_out = MFMA16(lo4(X.g[2]), bu, o);
#pragma unroll
    for (int jt = 0; jt < 4; ++jt) { S[jt] = MFMA16(lo4t(X.aq[jt]), bu, S[jt]); S[jt] = MFMA16(lo4t(X.ak[jt]), bv, S[jt]); S[jt] = S[jt] * X.ac[jt]; }
}
#ifndef SC_CONVW
#define SC_CONVW 3
#endif
constexpr int SC_NS = 7, SC_AHEAD = 5, SC_CTL = SC_NS * CH_SLOT, SCAN_TR_OFF = 81920;
__device__ __forceinline__ void scan_dma(const unsigned char* rec, const bf16* vt, LAS unsigned char* slot, int lane) {
#pragma unroll
    for (int i = 0; i < 10; ++i) __builtin_amdgcn_global_load_lds((const unsigned*)(rec + (lane + 64 * i) * 16), (LAS unsigned*)(slot + i * 1024), 16, 0, 0);
    if (lane < 48) __builtin_amdgcn_global_load_lds((const unsigned*)(rec + (lane + 640) * 16), (LAS unsigned*)(slot + 10240), 16, 0, 0);
    if (lane < 32) __builtin_amdgcn_global_load_lds((const unsigned*)(vt + (size_t)(lane >> 1) * 512 + 8 * (lane & 1)), (LAS unsigned*)(slot + CH_V), 16, 0, 0);
}
__device__ __forceinline__ int sc_ld(LAS int* p) { int v; const unsigned a = (unsigned)(size_t)p; asm volatile("ds_read_b32 %0, %1\n\ts_waitcnt lgkmcnt(0)" : "=&v"(v) : "v"(a) : "memory"); return v; }
__device__ __forceinline__ void sc_st(LAS int* p, int v) { const unsigned a = (unsigned)(size_t)p; asm volatile("ds_write_b32 %0, %1" :: "v"(a), "v"(v) : "memory"); }
#define SC_LD(p) sc_ld(p)
#define SC_ST(p, v) sc_st((p), (v))
__device__ __forceinline__ void p5_scan(Frame& F, bool extras = true, int abl = 0) {
    LAS int* ctl = (LAS int*)(F.lds + SC_CTL);
    if (F.tid < 4) ctl[F.tid] = 0;
    LDS_WAIT(); __syncthreads();
    constexpr int NKQ = (tri::NITEMS - tri::E12) / 256;
    LAS float* mytile = (LAS float*)(F.lds + SCAN_TR_OFF + F.wave * 8448);
    const int bh = F.vcu >> 2, b = bh >> 3, h = bh & 7, i0 = (F.vcu & 3) * 16;
    if (F.wave == 0) {
        if (abl & 1) return;
        __builtin_amdgcn_s_setprio(3);
        float* o0 = (float*)(F.ws + WS_XN) + (size_t)b * SEQ * 512 + h * 64 + i0;
        const int fr = F.lane & 15, fq = F.lane >> 4;
        f32x4 S[4];
#pragma unroll
        for (int jt = 0; jt < 4; ++jt) S[jt] = (f32x4){0.f, 0.f, 0.f, 0.f};
        ChunkOps XA, XB;
        while (SC_LD(&ctl[0]) <= 0) __builtin_amdgcn_s_sleep(1);
        asm volatile("" ::: "memory");
        chunk_load(F.lds, XA, F.lane);
        LDS_WAIT(); asm volatile("" ::: "memory");
        if (F.lane == 0) SC_ST(&ctl[1], 1);
#define SCAN_ITER(XC, XN_, c_) do { const int cc = (c_); \
            if (cc + 1 < 128) { while (SC_LD(&ctl[0]) <= cc + 1) __builtin_amdgcn_s_sleep(1); asm volatile("" ::: "memory"); chunk_load(F.lds + ((cc + 1) % SC_NS) * CH_SLOT, XN_, F.lane); } \
            __builtin_amdgcn_sched_barrier(0); \
            f32x4 o; chunk_math(XC, S, o); \
            __builtin_amdgcn_sched_barrier(0); \
            float* orow = o0 + (size_t)cc * 16 * 512; \
            _Pragma("unroll") for (int rg = 0; rg < 4; ++rg) { float* pp = orow + (size_t)(4 * fq + rg) * 512 + fr; const float vv = o[rg]; asm volatile("global_store_dword %0, %1, off" :: "v"(pp), "v"(vv) : "memory"); } \
            if (cc + 1 < 128) { LDS_WAIT(); asm volatile("" ::: "memory"); if (F.lane == 0) SC_ST(&ctl[1], cc + 2); } } while (0)
#pragma unroll 1
        for (int c = 0; c < 128; c += 2) { SCAN_ITER(XA, XB, c); SCAN_ITER(XB, XA, c + 1); }
#undef SCAN_ITER
        asm volatile("s_waitcnt vmcnt(0)" ::: "memory");
        __builtin_amdgcn_s_setprio(0);
        if (F.lane == 0) SC_ST(&ctl[3], 1);
        if (!(abl & 2)) tr_run_q(F, mytile, &ctl[2], tri::E12 + F.vcu, F.G, NKQ);
    } else if (F.wave == 1) {
        if (abl & 1) return;
        const unsigned char* rec0 = F.ws + WS_S + ((size_t)(b * 128) * 8 + h) * CH_REC;
        const bf16* vt0 = (const bf16*)F.out + (size_t)b * SEQ * 512 + h * 64 + i0;
        for (int n = 0; n < 128; ++n) {
            while (SC_LD(&ctl[1]) < n - SC_NS + 1) __builtin_amdgcn_s_sleep(1);
            asm volatile("" ::: "memory");
            scan_dma(rec0 + (size_t)n * 8 * CH_REC, vt0 + (size_t)n * 16 * 512, F.lds + (n % SC_NS) * CH_SLOT, F.lane);
            if (n >= SC_AHEAD) { asm volatile("s_waitcnt vmcnt(60)" ::: "memory"); if (F.lane == 0) SC_ST(&ctl[0], n - SC_AHEAD + 1); }
        }
        asm volatile("s_waitcnt vmcnt(48)" ::: "memory"); if (F.lane == 0) SC_ST(&ctl[0], 124);
        asm volatile("s_waitcnt vmcnt(36)" ::: "memory"); if (F.lane == 0) SC_ST(&ctl[0], 125);
        asm volatile("s_waitcnt vmcnt(24)" ::: "memory"); if (F.lane == 0) SC_ST(&ctl[0], 126);
        asm volatile("s_waitcnt vmcnt(12)" ::: "memory"); if (F.lane == 0) SC_ST(&ctl[0], 127);
        asm volatile("s_waitcnt vmcnt(0)" ::: "memory"); if (F.lane == 0) SC_ST(&ctl[0], 128);
        if (!(abl & 2)) { while (SC_LD(&ctl[3]) == 0) __builtin_amdgcn_s_sleep(8); tr_run_q(F, mytile, &ctl[2], tri::E12 + F.vcu, F.G, NKQ); }
    } else {
        const int w2 = F.vcu * 6 + (F.wave - 2), NW2 = F.G * 6;
        if (!(abl & 2) && F.wave - 2 < SC_CONVW) tr_run_q(F, mytile, &ctl[2], tri::E12 + F.vcu, F.G, NKQ);
        if (!extras) return;
        for (int mb = w2; mb < M; mb += 4 * NW2) {
            v4u a0[4], a1[4], a2[4];
#pragma unroll
            for (int u = 0; u < 4; ++u) { const int mr = (mb + u * NW2 < M) ? mb + u * NW2 : mb; const bf16* y0 = (const bf16*)(F.ws + WS_YB) + (size_t)mr * 512 + 8 * F.lane; a0[u] = *(const v4u*)y0; a1[u] = *(const v4u*)(y0 + 8 * MiB); a2[u] = *(const v4u*)(y0 + 16 * MiB); }
#pragma unroll
            for (int u = 0; u < 4; ++u) { float f0[8], f1[8], f2[8]; unpk8(a0[u], f0); unpk8(a1[u], f1); unpk8(a2[u], f2);
                v4u w; w.x = pk2(f0[0] + f1[0] + f2[0], f0[1] + f1[1] + f2[1]); w.y = pk2(f0[2] + f1[2] + f2[2], f0[3] + f1[3] + f2[3]); w.z = pk2(f0[4] + f1[4] + f2[4], f0[5] + f1[5] + f2[5]); w.w = pk2(f0[6] + f1[6] + f2[6], f0[7] + f1[7] + f2[7]);
                if (mb + u * NW2 < M) *(v4u*)((bf16*)(F.ws + WS_YB) + (size_t)(mb + u * NW2) * 512 + 8 * F.lane) = w; } }
        const float* p = F.ap->in[1]; bf16* PB = (bf16*)(F.ws + WS_PBF);
        constexpr size_t NV = (size_t)M * 256 / 4;
        for (size_t b0 = (size_t)w2 * 64 + F.lane; b0 < NV; b0 += (size_t)8 * NW2 * 64) {
            f32x4 pv[8];
#pragma unroll
            for (int i = 0; i < 8; ++i) { const size_t idx = b0 + (size_t)i * NW2 * 64; pv[i] = (idx < NV) ? *(const f32x4*)(p + idx * 4) : (f32x4){0.f, 0.f, 0.f, 0.f}; }
#pragma unroll
            for (int i = 0; i < 8; ++i) { const size_t idx = b0 + (size_t)i * NW2 * 64; if (idx < NV) *(v2u*)(PB + idx * 4) = pk4(pv[i]); } }
        if (!(abl & 2) && F.wave - 2 >= SC_CONVW) { while (SC_LD(&ctl[3]) == 0) __builtin_amdgcn_s_sleep(8); tr_run_q(F, mytile, &ctl[2], tri::E12 + F.vcu, F.G, NKQ); }
    }
}

struct P6Par { float lw[8], lb[8]; };
__device__ __forceinline__ void p6_rows2(Frame& F, int ma, int mb_, const P6Par& P) {
    const int l = F.lane, c = 8 * l, h = l >> 3;
    f32x4 oa[2][2]; v4u vv_[2], gg_[2]; float bsv[2];
#pragma unroll
    for (int u = 0; u < 2; ++u) { const int m = u ? mb_ : ma;
        const float* oraw = (const float*)(F.ws + WS_XN) + (size_t)m * 512 + c;
        oa[u][0] = *(const f32x4*)oraw; oa[u][1] = *(const f32x4*)(oraw + 4); bsv[u] = ((const float*)(F.ws + WS_BONUS))[(size_t)m * 8 + h];
        vv_[u] = *(const v4u*)((const bf16*)F.out + (size_t)m * 512 + c); gg_[u] = *(const v4u*)((const bf16*)(F.ws + WS_G) + (size_t)m * 512 + c);
    }
    __builtin_amdgcn_sched_barrier(0);
#pragma unroll
    for (int u = 0; u < 2; ++u) { const int m = u ? mb_ : ma;
        float o[8] = {oa[u][0].x, oa[u][0].y, oa[u][0].z, oa[u][0].w, oa[u][1].x, oa[u][1].y, oa[u][1].z, oa[u][1].w};
        float s = 0.f;
#pragma unroll
        for (int j = 0; j < 8; ++j) s += o[j];
        s += __shfl_xor(s, 1); s += __shfl_xor(s, 2); s += __shfl_xor(s, 4);
        const float mu = s * (1.f / 64.f); float q = 0.f;
#pragma unroll
        for (int j = 0; j < 8; ++j) { o[j] -= mu; q += o[j] * o[j]; }
        q += __shfl_xor(q, 1); q += __shfl_xor(q, 2); q += __shfl_xor(q, 4);
        const float rstd = 1.0f / sqrtf(q * (1.f / 64.f) + GN_EPS);
        float vv[8], gg[8];
        unpk8(vv_[u], vv); unpk8(gg_[u], gg);
        const float bs = bsv[u];
        float y[8];
#pragma unroll
        for (int j = 0; j < 8; ++j) y[j] = (o[j] * rstd * P.lw[j] + P.lb[j] + bs * vv[j]) * gg[j];
        v4u w; w.x = pk2(y[0], y[1]); w.y = pk2(y[2], y[3]); w.z = pk2(y[4], y[5]); w.w = pk2(y[6], y[7]);
        *(v4u*)((bf16*)(F.ws + WS_YRW) + (size_t)m * 512 + c) = w;
    }
}
__device__ __forceinline__ void p6_phase(Frame& F) {
    const int l = F.lane, c = 8 * l;
    P6Par P;
#pragma unroll
    for (int j = 0; j < 8; ++j) { P.lw[j] = F.ap->in[13][c + j]; P.lb[j] = F.ap->in[14][c + j]; }
    for (int m = F.gw; m < M; m += 2 * F.NGW) p6_rows2(F, m, m + F.NGW, P);
}

struct RouteW { f32x4 wv[3][8]; };
__device__ __forceinline__ void route_ldx(Frame& F, int tile, v4u (&xv)[4]) {
    const int fr = F.lane & 15, fq = F.lane >> 4; const bf16* xp = (const bf16*)(F.ws + WS_Z) + (size_t)(tile * 16 + fr) * D + F.wave * 128 + 8 * fq;
#pragma unroll
    for (int g = 0; g < 4; ++g) xv[g] = *(const v4u*)(xp + 32 * g);
}
__device__ __forceinline__ void route_tile(Frame& F, int tile, const RouteW& W, const v4u (&xv_)[4], int par) {
    const int fr = F.lane & 15, fq = F.lane >> 4, m0 = tile * 16;
    f32x4 acc[3] = {(f32x4){0.f, 0.f, 0.f, 0.f}, (f32x4){0.f, 0.f, 0.f, 0.f}, (f32x4){0.f, 0.f, 0.f, 0.f}};
    float ssq = 0.f;
#pragma unroll
    for (int g2 = 0; g2 < 4; ++g2) {
        float xf[8]; unpk8(xv_[g2], xf);
#pragma unroll
        for (int hh = 0; hh < 2; ++hh) { const int g = 2 * g2 + hh;
            ssq += (xf[4 * hh] * xf[4 * hh] + xf[4 * hh + 1] * xf[4 * hh + 1]) + (xf[4 * hh + 2] * xf[4 * hh + 2] + xf[4 * hh + 3] * xf[4 * hh + 3]);
#pragma unroll
            for (int s = 0; s < 4; ++s)
#pragma unroll
                for (int ct = 0; ct < 3; ++ct) acc[ct] = __builtin_amdgcn_mfma_f32_16x16x4f32(W.wv[ct][g][s], xf[4 * hh + s], acc[ct], 0, 0, 0); }
    }
    ssq += __shfl_xor(ssq, 16); ssq += __shfl_xor(ssq, 32);
    LAS float* red = (LAS float*)(F.lds + par * 32768);
    LAS float* ssqb = red + 8 * 3 * 64 * 4; LAS float* rsb = ssqb + 128;
#pragma unroll
    for (int ct = 0; ct < 3; ++ct) *(LAS f32x4*)(red + ((F.wave * 3 + ct) * 64 + F.lane) * 4) = acc[ct];
    if (fq == 0) ssqb[F.wave * 16 + fr] = ssq;
    LDS_WAIT(); __syncthreads();
    if (F.wave == 0) { float st = 0.f;
#pragma unroll
      for (int w = 0; w < 8; ++w) st += ssqb[w * 16 + (F.lane & 15)];
      const float rs = 1.0f / sqrtf(st * (1.f / D) + NORM_EPS);
      if (fq == 0) ((float*)(F.ws + WS_RSE))[m0 + fr] = rs;
#pragma unroll
      for (int ct = 0; ct < 3; ++ct) { f32x4 t = (f32x4){0.f, 0.f, 0.f, 0.f};
#pragma unroll
          for (int w = 0; w < 8; ++w) t = t + *(const LAS f32x4*)(red + ((w * 3 + ct) * 64 + F.lane) * 4);
          *(f32x4*)((float*)(F.ws + WS_LOGITS) + (size_t)(m0 + fr) * 48 + 16 * ct + 4 * fq) = t * rs; } }
}
__device__ __forceinline__ void p9_phase(Frame& F, int rep_ = 0) {
    const int fr = F.lane & 15, fq = F.lane >> 4;
    RouteW W;
    { const float* wp = (const float*)(F.ws + WS_SMALLW + SW_ROUTEW) + (size_t)fr * D + F.wave * 128 + 8 * fq;
#pragma unroll
      for (int ct = 0; ct < 3; ++ct)
#pragma unroll
          for (int g = 0; g < 8; ++g) W.wv[ct][g] = *(const f32x4*)(wp + (size_t)ct * 16 * D + 32 * (g >> 1) + 4 * (g & 1)); }
    v4u xa[4], xb[4];
    int tile = F.vcu, par = 0;
    if (tile < 1024) route_ldx(F, tile, xa);
    while (tile < 1024) {
        const int nt = tile + F.G;
        if (nt < 1024) route_ldx(F, nt, xb);
        __builtin_amdgcn_sched_barrier(0);
        route_tile(F, tile, W, xa, par);
#pragma unroll
        for (int g = 0; g < 4; ++g) xa[g] = xb[g];
        tile = nt; par ^= 1;
    }
}

__device__ __forceinline__ void p9b_phase(Frame& F) {
    if (F.wave != 0) return;
    for (int base = F.vcu * 64; base < M; base += F.G * 64) {
        const int tok = base + F.lane;
        const float* lgp = (const float*)(F.ws + WS_LOGITS) + (size_t)tok * 48;
        float lg[36];
#pragma unroll
        for (int q = 0; q < 9; ++q) { const f32x4 v = *(const f32x4*)(lgp + 4 * q); lg[4 * q] = v.x; lg[4 * q + 1] = v.y; lg[4 * q + 2] = v.z; lg[4 * q + 3] = v.w; }
        const float* bg = F.ap->in[27]; const float* br = F.ap->in[29];
        float gl[4]; int gs = 0; float gm = -3.0e38f;
#pragma unroll
        for (int c = 0; c < 4; ++c) { gl[c] = lg[c] + bg[c]; if (gl[c] > gm) { gm = gl[c]; gs = c; } }
        float gsum = 0.f;
#pragma unroll
        for (int c = 0; c < 4; ++c) gsum += __expf(gl[c] - gm);
        const float pgroup = 1.0f / gsum;
        float el[8]; float em = -3.0e38f;
#pragma unroll
        for (int c = 0; c < 8; ++c) { const float lv = gs == 0 ? lg[4 + c] : (gs == 1 ? lg[12 + c] : (gs == 2 ? lg[20 + c] : lg[28 + c])); el[c] = lv + br[gs * 8 + c]; em = fmaxf(em, el[c]); }
        int i1 = 0; float v1 = -3.0e38f;
#pragma unroll
        for (int c = 0; c < 8; ++c) if (el[c] > v1) { v1 = el[c]; i1 = c; }
        int i2 = 0; float v2 = -3.0e38f;
#pragma unroll
        for (int c = 0; c < 8; ++c) if (c != i1 && el[c] > v2) { v2 = el[c]; i2 = c; }
        const float p1 = __expf(v1 - em), p2 = __expf(v2 - em);
        const float g1 = pgroup * p1 / (p1 + p2), g2 = pgroup * p2 / (p1 + p2);
        const int e1 = gs * 8 + i1, e2 = gs * 8 + i2;
        const unsigned long long lt = (1ull << F.lane) - 1ull;
        int r1 = 0, r2 = 0, mycnt = 0;
        for (int e = 0; e < 32; ++e) {
            const unsigned long long m1 = __ballot(e1 == e), m2 = __ballot(e2 == e);
            const int c1 = __popcll(m1), c2 = __popcll(m2);
            if (e1 == e) r1 = __popcll(m1 & lt);
            if (e2 == e) r2 = c1 + __popcll(m2 & lt);
            if (F.lane == e) mycnt = c1 + c2;
        }
        unsigned* cnt = (unsigned*)(F.ws + WS_CTL) + CW_CNT; int* list = (int*)(F.ws + WS_LIST); float* gateA = (float*)(F.ws + WS_GATEA); unsigned* slotA = (unsigned*)(F.ws + WS_SLOTA);
        int bs = 0;
        if (F.lane < 32 && mycnt > 0) bs = (int)atomicAdd(&cnt[F.lane], (unsigned)mycnt);
        const unsigned q1 = (unsigned)(__shfl(bs, e1) + r1), q2 = (unsigned)(__shfl(bs, e2) + r2);
        gateA[tok * 2 + 0] = g1; gateA[tok * 2 + 1] = g2;
        list[(size_t)e1 * 16384 + q1] = tok * 2 + 0; slotA[tok * 2 + 0] = ((unsigned)e1 << 16) | q1;
        list[(size_t)e2 * 16384 + q2] = tok * 2 + 1; slotA[tok * 2 + 1] = ((unsigned)e2 << 16) | q2;
    }
}

__device__ __forceinline__ void p12_rows2(Frame& F, int ma, int mb_, int prelane) {
    const unsigned* slotA = (const unsigned*)(F.ws + WS_SLOTA); const float* gateA = (const float*)(F.ws + WS_GATEA);
    unsigned sl[2][2]; float gt[2][2];
#pragma unroll
    for (int u = 0; u < 2; ++u) { const int m = u ? mb_ : ma; sl[u][0] = slotA[2 * m]; sl[u][1] = slotA[2 * m + 1]; gt[u][0] = gateA[2 * m]; gt[u][1] = gateA[2 * m + 1]; }
    f32x4 xv[2][4]; v2u cv[2][2][4]; float se[2];
#pragma unroll
    for (int u = 0; u < 2; ++u) { const int m = u ? mb_ : ma;
        const bf16* x1 = (const bf16*)(F.ws + WS_Z) + (size_t)m * D;
        se[u] = (F.lane < 16) ? ((const float*)(F.ws + WS_ZGATE + 1 * MiB))[(size_t)m * 16 + F.lane] : 0.f;
#pragma unroll
        for (int j = 0; j < 4; ++j) { const int o = 4 * F.lane + 256 * j; xv[u][j] = unpk4(*(const v2u*)(x1 + o)); }
#pragma unroll
        for (int k = 0; k < 2; ++k) { const unsigned s = (unsigned)__builtin_amdgcn_readfirstlane((int)sl[u][k]); const int pre = __builtin_amdgcn_readlane(prelane, (int)(s >> 16));
            const bf16* cp = (const bf16*)(F.ws + WS_Z + 64 * MiB) + ((size_t)pre * 256 + (s & 0xffffu)) * D;
#pragma unroll
            for (int j = 0; j < 4; ++j) cv[u][k][j] = *(const v2u*)(cp + 4 * F.lane + 256 * j); } }
    __builtin_amdgcn_sched_barrier(0);
    float s2[2];
#pragma unroll
    for (int u = 0; u < 2; ++u) { s2[u] = 0.f;
#pragma unroll
        for (int j = 0; j < 4; ++j) { xv[u][j] = xv[u][j] + unpk4(cv[u][0][j]) * gt[u][0] + unpk4(cv[u][1][j]) * gt[u][1];
            s2[u] += (xv[u][j].x * xv[u][j].x + xv[u][j].y * xv[u][j].y) + (xv[u][j].z * xv[u][j].z + xv[u][j].w * xv[u][j].w);
        } }
#pragma unroll
    for (int o = 1; o < 64; o <<= 1) {
#pragma unroll
        for (int u = 0; u < 2; ++u) { s2[u] += __shfl_xor(s2[u], o); se[u] += __shfl_xor(se[u], o); } }
#pragma unroll
    for (int u = 0; u < 2; ++u) { const int m = u ? mb_ : ma;
        const float rs = 1.0f / sqrtf(s2[u] * (1.f / D) + NORM_EPS); const float rse = 1.0f / sqrtf(se[u] * (1.f / D) + NORM_EPS);
        bf16* x2 = (bf16*)(F.ws + WS_S) + (size_t)m * D; if (F.lane == 0) { ((float*)(F.ws + WS_RSE))[M + m] = rs; ((float*)(F.ws + WS_RSE))[2 * M + m] = rse; }
#pragma unroll
        for (int j = 0; j < 4; ++j) { const int o = 4 * F.lane + 256 * j; *(v2u*)(x2 + o) = pk4(xv[u][j]); }
    }
}
__device__ __forceinline__ void p12_phase(Frame& F) {
    const unsigned* cnt = (const unsigned*)(F.ws + WS_CTL) + CW_CNT;
    int nt = (F.lane < 32) ? (((int)cnt[F.lane & 31] + 255) >> 8) : 0;
    int incl = nt;
#pragma unroll
    for (int o = 1; o < 32; o <<= 1) { const int v = __shfl_up(incl, o); if (F.lane >= o) incl += v; }
    const int prelane = incl - nt;
    for (int m = F.gw; m < M; m += 2 * F.NGW) p12_rows2(F, m, m + F.NGW, prelane);
}
__device__ __forceinline__ void p14_rows4(Frame& F, int mb) {
    const float* gf = F.ap->in[36];
    f32x4 v[4][4]; float s[4];
#pragma unroll
    for (int u = 0; u < 4; ++u) { const bf16* xr = (const bf16*)(F.ws + WS_Z) + (size_t)(mb + u * F.NGW) * D;
#pragma unroll
        for (int j = 0; j < 4; ++j) v[u][j] = unpk4(*(const v2u*)(xr + 4 * F.lane + 256 * j)); }
#pragma unroll
    for (int u = 0; u < 4; ++u) { s[u] = 0.f;
#pragma unroll
        for (int j = 0; j < 4; ++j) s[u] += (v[u][j].x * v[u][j].x + v[u][j].y * v[u][j].y) + (v[u][j].z * v[u][j].z + v[u][j].w * v[u][j].w); }
#pragma unroll
    for (int o = 1; o < 64; o <<= 1) {
#pragma unroll
        for (int u = 0; u < 4; ++u) s[u] += __shfl_xor(s[u], o); }
#pragma unroll
    for (int u = 0; u < 4; ++u) { const float rs = 1.0f / sqrtf(s[u] * (1.f / D) + NORM_EPS); float* orow = F.out + (size_t)(mb + u * F.NGW) * D;
#pragma unroll
        for (int j = 0; j < 4; ++j) { const int o = 4 * F.lane + 256 * j; *(f32x4*)(orow + o) = v[u][j] * rs * *(const f32x4*)(gf + o); } }
}

#ifndef MK_ONE_LAUNCH
#define MK_ONE_LAUNCH 1
#endif
constexpr int N_PHASES = 14;
__global__ void __launch_bounds__(NWAVES * 64, 2) mk_fwd(Args args) {
    extern __shared__ __attribute__((aligned(16))) unsigned char lds[];
    Frame F;
    F.lds = (LAS unsigned char*)lds;
    F.tid = threadIdx.x; F.lane = F.tid & 63; F.wave = __builtin_amdgcn_readfirstlane(F.tid >> 6);
    F.G = gridDim.x; { const int bx = blockIdx.x; F.vcu = (F.G % 8 == 0) ? (bx % 8) * (F.G / 8) + bx / 8 : bx; }
    F.gw = F.vcu * NWAVES + F.wave; F.NGW = F.G * NWAVES;
    F.ws = args.ws; F.out = args.out;
    F.ap = (ArgsP)__builtin_amdgcn_kernarg_segment_ptr();
    unsigned char* ws = args.ws;
    const int lo = args.ph_lo, hi = args.ph_hi;
#ifdef ONLY
#define IN(k) ((k) == ONLY && lo <= (k) && (k) < hi)
#else
#define IN(k) (lo <= (k) && (k) < hi)
#endif
#if MK_ONE_LAUNCH
    if (F.tid < 16) ((LAS unsigned*)(F.lds + MISC_OFF))[F.tid] = 0u;
    __syncthreads();
    XcdBarrier bar = xcd_barrier_post((unsigned*)(ws + WS_CTL) + CW_BAR, (volatile LAS unsigned*)(F.lds + MISC_OFF));
#define GRID_BAR(k) do { if (IN(k) && IN((k) + 1)) { if ((k) == 12) cg::this_grid().sync(); else xcd_barrier(bar); } } while (0)
#else
#define GRID_BAR(k) do { } while (0)
#endif
    LAS unsigned char* L = F.lds;
#ifdef PROBE_A
    unsigned long long* tsb = (unsigned long long*)(ws + WS_CTL + 32768);
    int n_st = 0;
#define STAMP() do { if (blockIdx.x == 0 && F.tid == 0) tsb[n_st] = __builtin_amdgcn_s_memrealtime(); ++n_st; } while (0)
    STAMP();
#else
#define STAMP() do { } while (0)
#endif
    const bf16* z = (const bf16*)(ws + WS_Z);

    if (IN(0)) { p0_prologue(F); } GRID_BAR(0); STAMP();

    if (IN(1)) {
        pg8::Gemm g{(const bf16*)(ws + WS_XN), (const bf16*)(ws + WS_WIN), M, NZ, D, nullptr}; pg8::StaticOrder S; S.init(M, NZ, F.G, (int)blockIdx.x);
        EpiStoreBf16 E{(bf16*)(ws + WS_Z), NZ};
        pg8::gemm_phase<EpiStoreBf16, pg8::StaticOrder, true, false>(L, g, S, E);
    } GRID_BAR(1); STAMP();

    if (IN(2)) { p2_prep(F); } GRID_BAR(2); STAMP();
    if (IN(3)) { p3_phase(F); } GRID_BAR(3); STAMP();
    if (IN(4)) { p4_phase(F); } GRID_BAR(4); STAMP();
    if (IN(5)) { if (F.G == 256) p5_scan(F); } GRID_BAR(5); STAMP();
    if (IN(6)) { p6_phase(F); } GRID_BAR(6); STAMP();

    if (IN(7)) {
        pg8::Gemm g{(const bf16*)(ws + WS_YRW), (const bf16*)(ws + WS_UR), 2 * M, 2 * D, 512, nullptr}; DualOrder S; S.S.init(M, D, F.G, (int)blockIdx.x);
        EpiMix E{z, (bf16*)(ws + WS_S), (bf16*)(ws + WS_S + 64 * MiB)};
        pg8::gemm_phase<EpiMix, DualOrder, true, false>(L, g, S, E);
    } GRID_BAR(7); STAMP();

    if (IN(8)) {
        pg8::Gemm g{(const bf16*)(ws + WS_S + 64 * MiB), (const bf16*)(ws + WS_WO), M, D, D, nullptr}; pg8::StaticOrder S; S.init(M, D, F.G, (int)blockIdx.x);
        EpiResBf16 E{F.ap->in[0], (bf16*)(ws + WS_Z)};
        pg8::gemm_phase<EpiResBf16, pg8::StaticOrder, true, false>(L, g, S, E);
    } GRID_BAR(8); STAMP();

    if (IN(9)) { p9_phase(F); xcd_barrier(bar); p9b_phase(F); } GRID_BAR(9); STAMP();

    if (IN(10)) {
        pg8::Gemm g{(const bf16*)(ws + WS_Z), (const bf16*)(ws + WS_WGU), M, 1024, D, (const int*)(ws + WS_LIST), (const float*)(ws + WS_RSE)};
        pg8::moe_fill_tab((LAS int*)(F.lds + MISC_OFF - 256), (const unsigned*)(ws + WS_CTL) + CW_CNT); LDS_WAIT(); __syncthreads();
        pg8::MoeOrder S{(const LAS int*)(F.lds + MISC_OFF - 256), F.G, (int)blockIdx.x, false};
        EpiMoe1 E{(bf16*)(ws + WS_S), (const LAS float*)(F.lds + pg8::STAGE_BYTES + 4096)};
        pg8::gemm_phase<EpiMoe1, pg8::MoeOrder, true, true>(L, g, S, E);
    } GRID_BAR(10); STAMP();

    if (IN(11)) {
#ifndef NO_MOE2
        { pg8::Gemm g{(const bf16*)(ws + WS_S), (const bf16*)(ws + WS_WD), M, 1024, 512, nullptr};
          pg8::moe_fill_tab((LAS int*)(F.lds + MISC_OFF - 256), (const unsigned*)(ws + WS_CTL) + CW_CNT); LDS_WAIT(); __syncthreads();
          pg8::MoeOrder S{(const LAS int*)(F.lds + MISC_OFF - 256), F.G, (int)blockIdx.x, true};
          EpiStoreBf16 E{(bf16*)(ws + WS_Z + 64 * MiB), D};
          pg8::gemm_phase<EpiStoreBf16, pg8::MoeOrder, true, false>(L, g, S, E); }
#endif
        { pg8::Gemm g2{(const bf16*)(ws + WS_PBF), (const bf16*)(ws + WS_WPP), M, D, 256, nullptr}; ErawOrder S2; S2.S.init(M, D, F.G, 0); S2.c = (int)blockIdx.x; S2.G = F.G;
          { const LAS int* tb = (const LAS int*)(F.lds + MISC_OFF - 256); const int units = 4 * (tb[31] + ((tb[63] + 255) >> 8)); int nh = units - 2 * F.G; nh = nh < 0 ? 0 : (nh > F.G - 1 ? F.G - 1 : nh); S2.nheavy = nh; }
          EpiStoreSsq E2{(bf16*)(ws + WS_S + 64 * MiB), D, (float*)(ws + WS_ZGATE + 1 * MiB)};
          pg8::gemm_phase<EpiStoreSsq, ErawOrder, true, false>(L, g2, S2, E2); }
    } GRID_BAR(11); STAMP();

    if (IN(12)) { p12_phase(F); } GRID_BAR(12); STAMP();

    if (IN(13)) {
        pg8::Gemm g{(const bf16*)(ws + WS_S), (const bf16*)(ws + WS_WPG), M, D, D, nullptr}; pg8::StaticOrder S; S.init(M, D, F.G, (int)blockIdx.x);
        EpiPleNorm E{(const bf16*)(ws + WS_S), (const bf16*)(ws + WS_S + 64 * MiB), (const float*)(ws + WS_RSE) + 2 * M, F.ap->in[33], (const float*)(ws + WS_RSE) + M, F.ap->in[36], F.out, (float*)(ws + WS_ZGATE), (unsigned*)(ws + WS_CTL) + CW_PANEL, (LAS float*)(F.lds + 131072)};
        pg8::gemm_phase<EpiPleNorm, pg8::StaticOrder, true, false>(L, g, S, E);
    } STAMP();

#ifdef PROBE_A
    xcd_barrier(bar); STAMP(); __threadfence();
    if (blockIdx.x == 0 && F.tid == 0) { __threadfence(); }
    xcd_barrier(bar);
    {
        volatile unsigned long long* tv = (volatile unsigned long long*)tsb;
        const float dA = (float)(tv[PROBE_A + 1] - tv[PROBE_A]) * 0.01f, dB = (float)(tv[PROBE_B + 1] - tv[PROBE_B]) * 0.01f;
        for (size_t i = (size_t)blockIdx.x * 512 + F.tid; i < (size_t)M * D; i += (size_t)F.G * 512) F.out[i] = 10.0f * dB;
        __syncthreads();
        if (blockIdx.x == 0 && F.tid == 0) F.out[0] = 300.0f * dA;
    }
#endif
#undef IN
#undef GRID_BAR
}

extern "C" void kernel_launch(void* const* d_in, const int* in_sizes, int n_in, void* d_out, int out_size, void* d_ws, size_t ws_size, hipStream_t stream) {
    static int grid = 0;
    if (grid == 0) {
        if (n_in != 37 || out_size != M * D || ws_size < WS_END) { fprintf(stderr, "kernel_launch: unexpected problem (n_in %d, out %d, ws %zu < %zu); nothing launched\n", n_in, out_size, ws_size, (size_t)WS_END); grid = -1; return; }
        int dev = 0, cus = 0, per_cu = 0;
        if (hipGetDevice(&dev) != hipSuccess || hipDeviceGetAttribute(&cus, hipDeviceAttributeMultiprocessorCount, dev) != hipSuccess) { grid = -1; return; }
        if (hipFuncSetAttribute((const void*)mk_fwd, hipFuncAttributeMaxDynamicSharedMemorySize, LDS_BYTES) != hipSuccess) { fprintf(stderr, "kernel_launch: hipFuncSetAttribute failed\n"); grid = -1; return; }
        if (hipOccupancyMaxActiveBlocksPerMultiprocessor(&per_cu, (const void*)mk_fwd, NWAVES * 64, LDS_BYTES) != hipSuccess || per_cu < 1) { fprintf(stderr, "kernel_launch: occupancy query says %d blocks per CU\n", per_cu); (void)hipGetLastError(); grid = -1; return; }
        grid = cus;
        if (grid != 256) fprintf(stderr, "kernel_launch: %d CUs; this kernel is built for 256\n", grid);
    }
    if (grid < 0) return;
    (void)hipMemsetAsync((char*)d_ws + WS_CTL, 0, CTL_ZERO_BYTES, stream);
    Args a{};
    for (int i = 0; i < 37; ++i) a.in[i] = (const float*)d_in[i];
    a.out = (float*)d_out; a.ws = (unsigned char*)d_ws;
#if MK_ONE_LAUNCH
    a.ph_lo = 0; a.ph_hi = N_PHASES;
    void* kargs[] = {&a};
    hipError_t e = hipLaunchCooperativeKernel((const void*)mk_fwd, dim3(grid), dim3(NWAVES * 64), kargs, LDS_BYTES, stream);
    if (e != hipSuccess) fprintf(stderr, "kernel_launch: cooperative launch failed: %s (grid %d)\n", hipGetErrorString(e), grid);
#else
    for (int ph = 0; ph < N_PHASES; ++ph) { a.ph_lo = ph; a.ph_hi = ph + 1; hipLaunchKernelGGL(mk_fwd, dim3(grid), dim3(NWAVES * 64), LDS_BYTES, stream, a); }
#endif
}
```

```cpp
#include <hip/hip_runtime.h>
#include <hip/hip_cooperative_groups.h>
#include <cstdio>
#include <cstdint>
namespace cg = cooperative_groups;

namespace pg8 {
#define PG8_LAS __attribute__((address_space(3)))
typedef unsigned short bf16_t;
typedef short bf16x8 __attribute__((ext_vector_type(8)));
typedef float f32x4 __attribute__((ext_vector_type(4)));
typedef unsigned u32x4 __attribute__((ext_vector_type(4)));
typedef unsigned u32x2 __attribute__((ext_vector_type(2)));
constexpr int BM = 256, BK = 64, HALF = 128, HTB = HALF * BK * 2  , STAGE_BYTES = 8 * HTB, NXCD = 8, WGM = 8;

__host__ __device__ __forceinline__ int lds_byte(int r, int c) { const int st = (r >> 4) * 2 + (c >> 5), rr = r & 15, cc = c & 31, ob = rr * 64 + cc * 2; return st * 1024 + (ob ^ (((ob >> 9) & 1) << 5)); }
__host__ __device__ __forceinline__ void stage_rc(int b, int& R, int& C) { const int st = b / 1024, sb = b % 1024, swz = sb ^ (((sb >> 9) & 1) << 5); R = (st >> 1) * 16 + swz / 64; C = (st & 1) * 32 + (swz % 64) / 2; }
__host__ __device__ __forceinline__ int perm32(int rho) { const int n = rho >> 4, i = rho & 15; return 8 * (i >> 2) + 4 * n + (i & 3); }

struct Unit { int pm, pn, pmo, lt, nvalid, pnl; };
struct Gemm { const bf16_t* A; const bf16_t* Bt; int M, N, K; const int* rowidx; const float* rowscale; };

struct StaticOrder {
    static constexpr bool DEP = false;
    int nM, nN, nwg, G, c;
    __host__ __device__ void init(int M, int N, int G_, int c_) { nM = M / BM; nN = N / BM; nwg = nM * nN; G = G_; c = c_; }
    __host__ __device__ bool next(int i, Unit& u) const {
        const long L = (long)i * G + c; if (L >= nwg) return false;
        int wgid = (int)L; { const int q = nwg / NXCD, r = nwg % NXCD, xcd = wgid % NXCD, off = wgid / NXCD; wgid = (xcd < r ? xcd * (q + 1) : r * (q + 1) + (xcd - r) * q) + off; }
        const int nig = WGM * nN, gid = wgid / nig, fm = gid * WGM, gsz = (nM - fm) < WGM ? (nM - fm) : WGM;
        u.pm = fm + ((wgid % nig) % gsz); u.pn = (wgid % nig) / gsz; u.pmo = u.pm; u.lt = u.pm; u.nvalid = 256; u.pnl = u.pn; return true;
    }
};
template <bool DEP_>
struct MoeOrderT {
    static constexpr bool DEP = DEP_;
    const PG8_LAS int* tab; int G, c; bool a_is_out;
    int nheavy; const unsigned* dep;
    __device__ void wait(const Unit& u) const {
        const unsigned* p = dep + 16 * u.pmo; unsigned sp = 0;
        while (__hip_atomic_load(p, __ATOMIC_RELAXED, __HIP_MEMORY_SCOPE_AGENT) < 4u) { __builtin_amdgcn_s_sleep(2); if (++sp > (1u << 22)) break; }
        asm volatile("s_waitcnt vmcnt(0)" ::: "memory");
    }
    __device__ bool next(int i, Unit& u) const {
        int L;
        if constexpr (DEP_) { const int nl = G - nheavy; L = (c >= nheavy) ? (i < 2 ? i * nl + (c - nheavy) : 2 * nl + (i - 2) * G + c) : 2 * nl + i * G + c; }
        else L = i * G + c;
        const int tile = L >> 2, pnl = L & 3;
        const int lane = (int)__builtin_amdgcn_mbcnt_hi(~0u, __builtin_amdgcn_mbcnt_lo(~0u, 0u)), e_ = lane & 31;
        const int pre = tab[e_], ce = tab[32 + e_]; const int nt = (ce + 255) >> 8;
        const unsigned long long mk = __ballot(lane < 32 && tile >= pre && tile < pre + nt);
        if (mk == 0ull) return false;
        const int e = (int)__builtin_ctzll(mk);
        const int pre_e = __builtin_amdgcn_readlane(pre, e), ce_e = __builtin_amdgcn_readlane(ce, e);
        const int rt = tile - pre_e; u.pmo = tile; u.pm = a_is_out ? tile : 0; u.lt = e * 64 + rt; u.pn = e * 4 + pnl; u.pnl = pnl; const int rem = ce_e - rt * 256; u.nvalid = rem < 256 ? rem : 256; return true;
    }
};
typedef MoeOrderT<false> MoeOrder;
__device__ __forceinline__ void moe_fill_tab(PG8_LAS int* tab, const unsigned* cnt) {
    const int lane = (int)__builtin_amdgcn_mbcnt_hi(~0u, __builtin_amdgcn_mbcnt_lo(~0u, 0u));
    const int ce = (lane < 32) ? (int)cnt[lane & 31] : 0; const int nt = (ce + 255) >> 8;
    int incl = nt;
#pragma unroll
    for (int o = 1; o < 32; o <<= 1) { const int v = __shfl_up(incl, o); if (lane >= o) incl += v; }
    if (lane < 32) { tab[lane] = incl - nt; tab[32 + lane] = ce; }
}

__device__ __forceinline__ unsigned cvt_pk_bf16(float lo, float hi) { unsigned r; asm volatile("v_cvt_pk_bf16_f32 %0, %1, %2" : "=v"(r) : "v"(lo), "v"(hi)); return r; }

template <class Epi, class Sched, bool ALIGN_EPI, bool GATHER>
__device__ __forceinline__ void gemm_phase(PG8_LAS unsigned char* lds, const Gemm g, const Sched& S, const Epi& E) {
    const int tid = threadIdx.x, wid = __builtin_amdgcn_readfirstlane(tid >> 6), lane = tid & 63, wr = wid >> 2, wc = wid & 3, fr = lane & 15, fq = lane >> 4;
    constexpr int AUX_A = Sched::DEP ? 16 : 0;
    int K_ = g.K; asm volatile("" : "+s"(K_));
    const int K = K_, nt = K / BK;
    unsigned voffB[2]; int RA[2], CA[2];
#pragma unroll
    for (int i = 0; i < 2; ++i) { int R, C; stage_rc(tid * 16 + i * 8192, R, C); const int Rb = Epi::PERM ? ((R & ~31) + perm32(R & 31)) : R;
        RA[i] = R; CA[i] = C; voffB[i] = (unsigned)(Rb * K + C) * 2u; }
    const size_t kstep = (size_t)(BK * 2);
    const size_t hstep = (size_t)HALF * K * 2;
    const size_t tstep = 2 * hstep;
    const unsigned ldsw = (unsigned)wid * 1024u;
    const int aoff = lds_byte(wr * 64 + fr, fq * 8), boff = lds_byte(wc * 32 + fr, fq * 8);
    unsigned vA[2][2], vN[2][2];
    PG8_LAS int* rowl = (PG8_LAS int*)(lds + STAGE_BYTES);
    if constexpr (GATHER) {
        for (int i = 0; i < 4; ++i) { Unit uu; if (!S.next(i, uu)) break; if (tid < 256) { const int tk = (tid < uu.nvalid) ? (g.rowidx[(size_t)uu.lt * 256 + tid] >> 1) : 0; rowl[i * 256 + tid] = tk; ((PG8_LAS float*)(rowl + 1024))[i * 256 + tid] = g.rowscale[tk]; } }
        asm volatile("s_waitcnt vmcnt(0) lgkmcnt(0)" ::: "memory"); __builtin_amdgcn_s_barrier(); asm volatile("" ::: "memory");
    }
    auto compute_v = [&](const Unit& u, unsigned (&v)[2][2], int ui_) {
#pragma unroll
        for (int h = 0; h < 2; ++h)
#pragma unroll
            for (int i = 0; i < 2; ++i) {
                const int rl = h * HALF + RA[i];
                if constexpr (GATHER) { const int tok = rowl[ui_ * 256 + rl]; v[h][i] = ((unsigned)tok * (unsigned)K + (unsigned)CA[i]) * 2u; }
                else v[h][i] = ((unsigned)rl * (unsigned)K + (unsigned)CA[i]) * 2u;
            }
    };
#define PG8_SA(b, h) (((b) * 2 + (h)) * HTB)
#define PG8_SB(b, h) ((4 + (b) * 2 + (h)) * HTB)
#define PG8_STAGE_X(bufoff, gbase, voff, aux) do { _Pragma("unroll") for (int _i = 0; _i < 2; ++_i) \
        __builtin_amdgcn_global_load_lds((const unsigned*)((const char*)(gbase) + (voff)[_i]), (PG8_LAS unsigned*)(lds + (bufoff) + ldsw + _i * 8192), 16, 0, aux); } while (0)
#define PG8_STAGE(bufoff, gbase, voff) PG8_STAGE_X(bufoff, gbase, voff, 0)
#define PG8_STAGE_A(bufoff, gbase, voff) PG8_STAGE_X(bufoff, gbase, voff, AUX_A)
#define PG8_LDA(dst, b, h) do { _Pragma("unroll") for (int m = 0; m < 4; ++m) _Pragma("unroll") for (int k = 0; k < 2; ++k) dst[m][k] = *(const PG8_LAS bf16x8*)(lds + PG8_SA(b, h) + aoff + m * 2048 + k * 1024); } while (0)
#define PG8_LDB(dst, b, h) do { _Pragma("unroll") for (int n = 0; n < 2; ++n) _Pragma("unroll") for (int k = 0; k < 2; ++k) dst[n][k] = *(const PG8_LAS bf16x8*)(lds + PG8_SB(b, h) + boff + n * 2048 + k * 1024); } while (0)
#define PG8_MMA(ai, bj, At, Bt) do { __builtin_amdgcn_s_setprio(1); _Pragma("unroll") for (int m = 0; m < 4; ++m) _Pragma("unroll") for (int n = 0; n < 2; ++n) _Pragma("unroll") for (int k = 0; k < 2; ++k) \
        acc[ai][bj][m][n] = __builtin_amdgcn_mfma_f32_16x16x32_bf16(Bt[n][k], At[m][k], acc[ai][bj][m][n], 0, 0, 0); __builtin_amdgcn_s_setprio(0); } while (0)
#define PG8_WAIT_V(n) asm volatile("s_waitcnt vmcnt(" #n ")" ::: "memory")
#define PG8_WAIT_L(n) asm volatile("s_waitcnt lgkmcnt(" #n ")" ::: "memory")
#define PG8_BAR __builtin_amdgcn_s_barrier()
#define PG8_SCHED __builtin_amdgcn_sched_barrier(0)
    Unit cur, nxt; int ui = 0;
    if (!S.next(0, cur)) return;
    f32x4 acc[2][2][4][2];
#pragma unroll
    for (int a = 0; a < 2; ++a)
#pragma unroll
        for (int b = 0; b < 2; ++b)
#pragma unroll
            for (int m = 0; m < 4; ++m)
#pragma unroll
                for (int n = 0; n < 2; ++n) acc[a][b][m][n] = (f32x4){0.f, 0.f, 0.f, 0.f};
    bf16x8 At[4][2], B0[2][2], B1[2][2];
    if constexpr (Sched::DEP) { if (tid == 0) S.wait(cur); PG8_BAR; }
    compute_v(cur, vA, 0);
    const char* cA = (const char*)g.A + (GATHER ? (size_t)0 : (size_t)cur.pm * tstep); const char* cB = (const char*)g.Bt + (size_t)cur.pn * tstep;
    PG8_STAGE(PG8_SB(0, 0), cB, voffB); PG8_STAGE(PG8_SB(0, 1), cB + hstep, voffB); PG8_STAGE_A(PG8_SA(0, 0), cA, vA[0]); PG8_STAGE_A(PG8_SA(0, 1), cA, vA[1]);
    if (wr == 1) PG8_BAR;
    PG8_WAIT_V(2); PG8_BAR;
    PG8_STAGE(PG8_SB(1, 0), cB + kstep, voffB); PG8_STAGE_A(PG8_SA(1, 0), cA + kstep, vA[0]); PG8_STAGE(PG8_SB(1, 1), cB + hstep + kstep, voffB);
    PG8_WAIT_V(6); PG8_BAR;
    for (;;) {
        const bool has_next = S.next(ui + 1, nxt);
        if (has_next) compute_v(nxt, vN, ui + 1);
        else {
#pragma unroll
            for (int h = 0; h < 2; ++h)
#pragma unroll
                for (int i = 0; i < 2; ++i) vN[h][i] = vA[h][i];
        }
        const char* nA = has_next ? ((const char*)g.A + (GATHER ? (size_t)0 : (size_t)nxt.pm * tstep)) : cA; const char* nB = has_next ? (const char*)g.Bt + (size_t)nxt.pn * tstep : cB;
#pragma unroll 1
        for (int t = 0; t < nt; t += 2) {
            const bool last = (t == nt - 2);
            if constexpr (Sched::DEP) { if (last && has_next) { if (tid == 0) S.wait(nxt); PG8_BAR; } }
            const char* a1 = cA + (size_t)(t + 1) * kstep;
            const char* a2 = last ? nA : cA + (size_t)(t + 2) * kstep; const char* b2 = last ? nB : cB + (size_t)(t + 2) * kstep;
            const char* a3 = a2 + kstep; const char* b3 = b2 + kstep;
            unsigned vX0[2], vX1[2];
#pragma unroll
            for (int i = 0; i < 2; ++i) { vX0[i] = last ? vN[0][i] : vA[0][i]; vX1[i] = last ? vN[1][i] : vA[1][i]; }
            PG8_LDB(B0, 0, 0); PG8_LDB(B1, 0, 1); PG8_SCHED; PG8_LDA(At, 0, 0); PG8_STAGE_A(PG8_SA(1, 1), a1, vA[1]);
            PG8_WAIT_V(8); PG8_WAIT_L(0); PG8_BAR; PG8_MMA(0, 0, At, B0); PG8_MMA(0, 1, At, B1); PG8_BAR; PG8_SCHED;
            PG8_LDA(At, 0, 1); PG8_STAGE(PG8_SB(0, 0), b2, voffB); PG8_STAGE(PG8_SB(0, 1), b2 + hstep, voffB); PG8_STAGE_A(PG8_SA(0, 0), a2, vX0);
            PG8_WAIT_V(8); PG8_WAIT_L(0); PG8_BAR; PG8_MMA(1, 0, At, B0); PG8_MMA(1, 1, At, B1); PG8_BAR; PG8_SCHED;
            PG8_LDB(B0, 1, 0); PG8_LDB(B1, 1, 1); PG8_SCHED; PG8_LDA(At, 1, 0); PG8_STAGE_A(PG8_SA(0, 1), a2, vX1);
            PG8_WAIT_V(8); PG8_WAIT_L(0); PG8_BAR; PG8_MMA(0, 0, At, B0); PG8_MMA(0, 1, At, B1); PG8_BAR; PG8_SCHED;
            PG8_LDA(At, 1, 1); PG8_STAGE(PG8_SB(1, 0), b3, voffB); PG8_STAGE(PG8_SB(1, 1), b3 + hstep, voffB); PG8_STAGE_A(PG8_SA(1, 0), a3, vX0);
            PG8_WAIT_V(8); PG8_WAIT_L(0); PG8_BAR; PG8_MMA(1, 0, At, B0); PG8_MMA(1, 1, At, B1); PG8_BAR; PG8_SCHED;
        }
        if constexpr (ALIGN_EPI) { if (wr == 0) PG8_BAR; }
        if constexpr (GATHER) cur.pm = ui;
        E(acc, cur, wr, wc, fr, fq);
        if (!has_next) break;
#pragma unroll
        for (int a = 0; a < 2; ++a)
#pragma unroll
            for (int b = 0; b < 2; ++b)
#pragma unroll
                for (int m = 0; m < 4; ++m)
#pragma unroll
                    for (int n = 0; n < 2; ++n) acc[a][b][m][n] = (f32x4){0.f, 0.f, 0.f, 0.f};
        cur = nxt; cA = nA; cB = nB; ++ui;
#pragma unroll
        for (int h = 0; h < 2; ++h)
#pragma unroll
            for (int i = 0; i < 2; ++i) vA[h][i] = vN[h][i];
        if constexpr (ALIGN_EPI) { if (wr == 1) PG8_BAR; }
    }
    PG8_WAIT_V(0);
    if constexpr (!ALIGN_EPI) { if (wr == 0) PG8_BAR; }
    PG8_BAR;
#undef PG8_SA
#undef PG8_SB
#undef PG8_STAGE
#undef PG8_STAGE_X
#undef PG8_STAGE_A
#undef PG8_LDA
#undef PG8_LDB
#undef PG8_MMA
#undef PG8_WAIT_V
#undef PG8_WAIT_L
#undef PG8_BAR
#undef PG8_SCHED
}
}

constexpr int NWAVES = 8;
constexpr int M = 16384, D = 1024, SEQ = 2048, NBATCH = 8;
constexpr int NIN = 5144;
constexpr int NZ = 5120;
constexpr int ZC_R = 0, ZC_K = 512, ZC_V = 1024, ZC_W = 1536, ZC_Q = 1792, ZC_KC = 2304, ZC_VC = 2432, ZC_KS = 2560, ZC_VS = 2688, ZC_KW = 2816, ZC_VW = 2944, ZC_MR = 3072, ZC_MN = 4096;
constexpr float NORM_EPS = 1e-6f, GN_EPS = 64e-5f;

constexpr size_t MiB = 1u << 20;
constexpr size_t WS_CTL = 0, CTL_ZERO_BYTES = 64 * 1024;
constexpr size_t WS_LIST = 1 * MiB;
constexpr size_t WS_GATEA = 3 * MiB;
constexpr size_t WS_RSE = 4 * MiB;
constexpr size_t WS_SLOTA = 4 * MiB + 512 * 1024;
constexpr size_t WS_SELMASK = 5 * MiB;
constexpr size_t WS_ZGATE = 6 * MiB;
constexpr size_t WS_SMALLW = 8 * MiB;
constexpr size_t SW_W2T = 0, SW_A2T = 65536, SW_G2T = 131072, SW_CK1 = 262144, SW_CV1 = 524288, SW_CK2 = 786432, SW_CV2 = 794624, SW_GATEW = 802816, SW_ROUTEW = 868352;
constexpr size_t WS_KCMP = 10 * MiB;
constexpr size_t WS_VST = 11 * MiB, WS_VWT = 15 * MiB;
constexpr size_t WS_WIN = 19 * MiB, WS_UR = 29 * MiB, WS_UN = 30 * MiB, WS_WO = 31 * MiB, WS_WPP = 33 * MiB, WS_WPG = 34 * MiB, WS_WGU = 36 * MiB, WS_WD = 100 * MiB;
constexpr size_t WS_XN = 132 * MiB;
constexpr size_t WS_PBF = 164 * MiB;
constexpr size_t WS_Z = 172 * MiB;
constexpr size_t WS_S = 332 * MiB;
constexpr size_t WS_YRW = 428 * MiB, WS_YB = 444 * MiB, WS_G = 492 * MiB, WS_LOGITS = 508 * MiB  , WS_BONUS = 508 * MiB  , WS_END = 511 * MiB;
constexpr int CH_PP = 144, CH_P = 0, CH_R = 2304, CH_Q = 4608, CH_K = 6656, CH_G = 8704, CH_AC = 10752, CH_REC = 11008, CH_V = 11008, CH_SLOT = 11520;
constexpr int CW_CNT = 0;
constexpr int CW_PANEL = 8192;
constexpr int CW_DEP = 12288;
constexpr int CW_BAR = 1024;
constexpr int MISC_OFF = 163840 - 64;

constexpr int LDS_BYTES = 163840;

#define GAS __attribute__((address_space(1)))
#define LAS __attribute__((address_space(3)))
typedef unsigned short bf16;
typedef unsigned v4u __attribute__((ext_vector_type(4)));
typedef unsigned v2u __attribute__((ext_vector_type(2)));
typedef float f32x4 __attribute__((ext_vector_type(4)));
typedef float f32x2 __attribute__((ext_vector_type(2)));
typedef short bf16x8 __attribute__((ext_vector_type(8)));
typedef short bf16x4 __attribute__((ext_vector_type(4)));
typedef __bf16 bf16x2_t __attribute__((ext_vector_type(2)));
#define LDS_WAIT() asm volatile("s_waitcnt lgkmcnt(0)" ::: "memory")
#define MFMA16(a, b, c) __builtin_amdgcn_mfma_f32_16x16x32_bf16((a), (b), (c), 0, 0, 0)

__device__ __forceinline__ float bf2f(unsigned short v) { return __uint_as_float((unsigned)v << 16); }
__device__ __forceinline__ unsigned pk2(float lo, float hi) { f32x2 v = {lo, hi}; bf16x2_t b = __builtin_convertvector(v, bf16x2_t); return __builtin_bit_cast(unsigned, b); }
__device__ __forceinline__ v2u pk4(f32x4 v) { v2u r; r.x = pk2(v.x, v.y); r.y = pk2(v.z, v.w); return r; }
__device__ __forceinline__ f32x4 unpk4(v2u w) { f32x4 r; r.x = __uint_as_float(w.x << 16); r.y = __uint_as_float(w.x & 0xffff0000u); r.z = __uint_as_float(w.y << 16); r.w = __uint_as_float(w.y & 0xffff0000u); return r; }
__device__ __forceinline__ void unpk8(v4u w, float (&f)[8]) { f[0] = __uint_as_float(w.x << 16); f[1] = __uint_as_float(w.x & 0xffff0000u); f[2] = __uint_as_float(w.y << 16); f[3] = __uint_as_float(w.y & 0xffff0000u);
    f[4] = __uint_as_float(w.z << 16); f[5] = __uint_as_float(w.z & 0xffff0000u); f[6] = __uint_as_float(w.w << 16); f[7] = __uint_as_float(w.w & 0xffff0000u); }
__device__ __forceinline__ float sigmoidf_(float x) { return __builtin_amdgcn_rcpf(1.0f + __expf(-x)); }
__device__ __forceinline__ float wave_sum(float v) {
#pragma unroll
    for (int o = 1; o < 64; o <<= 1) v += __shfl_xor(v, o);
    return v;
}
template <int CTRL> __device__ __forceinline__ float dppf(float x) { return __builtin_bit_cast(float, __builtin_amdgcn_update_dpp(0, __builtin_bit_cast(int, x), CTRL, 0xf, 0xf, false)); }
__device__ __forceinline__ float row16_sum(float x) { x += dppf<0x128>(x); x += dppf<0x124>(x); x += dppf<0x122>(x); x += dppf<0x121>(x); return x; }

typedef GAS unsigned gu32;
#define XB_TMO      128
#define XB_XCNT(j)  (256  + 64 * (j))
#define XB_XSUB(j)  (1280 + 64 * (j))
#define XB_XGEN(j)  (2304 + 64 * (j))
#define XB_TOP      3328
#define XB_TOPGEN   3392
#define XCD_BAR_WORDS 3456
#define XB_SPIN_CAP (1u << 18)

__device__ __forceinline__ unsigned xb_ld(unsigned* p)              { return __hip_atomic_load(p, __ATOMIC_RELAXED, __HIP_MEMORY_SCOPE_AGENT); }
__device__ __forceinline__ unsigned xb_add(unsigned* p, unsigned v) { return __hip_atomic_fetch_add(p, v, __ATOMIC_RELAXED, __HIP_MEMORY_SCOPE_AGENT); }
__device__ __forceinline__ unsigned xb_xcc_id() { return (unsigned)__builtin_amdgcn_s_getreg((3 << 11) | 20) & 0xFu; }
#define XB_SPIN(cond, bar) do { unsigned _sp = 0; while (cond) { __builtin_amdgcn_s_sleep(1); \
    if ((++_sp & 255u) == 0u) { if (xb_ld(&(bar)[XB_TMO])) break; if (_sp > XB_SPIN_CAP) { atomicAdd(&(bar)[XB_TMO], 1u); break; } } } } while (0)

struct XcdBarrier {
    unsigned* bar; unsigned x;
    volatile LAS unsigned* st;
};

__device__ __forceinline__ XcdBarrier xcd_barrier_post(unsigned* bar, volatile LAS unsigned* st) {
    XcdBarrier b; b.bar = bar; b.x = xb_xcc_id(); b.st = st;
    if (threadIdx.x == 0) (void)xb_add(&bar[XB_XCNT(b.x)], 1u);
    return b;
}
__device__ __forceinline__ void xcd_barrier_complete(unsigned* bar, unsigned x, unsigned& nloc, unsigned& nx) {
    const unsigned G = gridDim.x * gridDim.y * gridDim.z;
    unsigned sum, cnt, mine, sp = 0u;
    for (;;) {
        sum = 0u; cnt = 0u; mine = 0u;
#pragma unroll
        for (unsigned j = 0; j < 16; ++j) { const unsigned c = xb_ld(&bar[XB_XCNT(j)]); sum += c; cnt += (c > 0u) ? 1u : 0u; mine = (j == x) ? c : mine; }
        if (sum == G) break;
        __builtin_amdgcn_s_sleep(1);
        if ((++sp & 255u) == 0u) { if (xb_ld(&bar[XB_TMO])) break; if (sp > XB_SPIN_CAP) { atomicAdd(&bar[XB_TMO], 1u); break; } }
    }
    nloc = mine > 0u ? mine : 1u; nx = cnt > 0u ? cnt : 1u;
}

__device__ __forceinline__ void xcd_barrier(const XcdBarrier& b) {
    asm volatile("s_waitcnt vmcnt(0)" ::: "memory");
    __syncthreads();
    if (threadIdx.x == 0) {
        unsigned* bar = b.bar;
        __builtin_amdgcn_s_waitcnt(0);
        unsigned nloc = b.st[0], nx = b.st[1];
        if (nloc == 0u) { xcd_barrier_complete(bar, b.x, nloc, nx); b.st[0] = nloc; b.st[1] = nx; }
        const unsigned old = xb_add(&bar[XB_XSUB(b.x)], 1u);
        const unsigned gen = old / nloc;
        if (old + 1u == (gen + 1u) * nloc) {
            __builtin_amdgcn_fence(__ATOMIC_RELEASE, "agent");
            asm volatile("s_waitcnt vmcnt(0)" ::: "memory");
            const unsigned og = xb_add(&bar[XB_TOP], 1u);
            const unsigned tg = og / nx;
            if (og + 1u == (tg + 1u) * nx) xb_add(&bar[XB_TOPGEN], 1u);
            else XB_SPIN(xb_ld(&bar[XB_TOPGEN]) == tg, bar);
            __builtin_amdgcn_fence(__ATOMIC_ACQUIRE, "agent");
            xb_add(&bar[XB_XGEN(b.x)], 1u);
            asm volatile("s_waitcnt vmcnt(0)" ::: "memory");
        } else {
            XB_SPIN(xb_ld(&bar[XB_XGEN(b.x)]) == gen, bar);
            __builtin_amdgcn_fence(__ATOMIC_ACQUIRE, "agent");
            asm volatile("s_waitcnt vmcnt(0)" ::: "memory");
        }
    }
    __syncthreads();
}

struct Args { const float* in[37]; float* out; unsigned char* ws; int ph_lo, ph_hi, rep_mask, pad; };
typedef __attribute__((address_space(4))) const Args* ArgsP;
struct Frame {
    LAS unsigned char* lds;
    int tid, lane, wave, vcu, G, gw, NGW;
    unsigned char* ws;
    ArgsP ap;
    float* out;
};

struct TrDesc { const float* W; bf16* T; bf16* T2; const float* gain; int K, ld, nc, item, mode; };
__device__ __forceinline__ void tr_load(const TrDesc& d, int lane, float (&tv)[32], f32x4 (&gn)[2]) {
    const int nblk = (d.nc + 31) / 32, kb = d.item / nblk, nb = d.item % nblk, k0 = 64 * kb, n0 = 32 * nb;
    const int nn = n0 + (lane & 31);
    gn[0] = (f32x4){1.f, 1.f, 1.f, 1.f}; gn[1] = gn[0];
    if (d.gain) { const float* gp = d.gain + k0 + 8 * (lane & 7); gn[0] = *(const f32x4*)gp; gn[1] = *(const f32x4*)(gp + 4); }
    const float* wsrc = d.W + (size_t)(k0 + (lane >> 5)) * d.ld + (nn < d.nc ? nn : 0);
#pragma unroll
    for (int i = 0; i < 32; ++i) tv[i] = wsrc[(size_t)(2 * i) * d.ld];
}
__device__ __forceinline__ void tr_finish(const TrDesc& d, LAS float* scr, int lane, const float (&tv)[32], const f32x4 (&gn)[2]) {
    const int nblk = (d.nc + 31) / 32, kb = d.item / nblk, nb = d.item % nblk, k0 = 64 * kb, n0 = 32 * nb;
#pragma unroll
    for (int i = 0; i < 32; ++i) scr[(2 * i + (lane >> 5)) * 33 + (lane & 31)] = tv[i];
    LDS_WAIT(); asm volatile("" ::: "memory");
    const int c = lane & 7;
#pragma unroll
    for (int j = 0; j < 4; ++j) { const int nl = (lane >> 3) + 8 * j, n = n0 + nl; const LAS float* s = scr + (8 * c) * 33 + nl;
        v4u o; o.x = pk2(s[0 * 33] * gn[0].x, s[1 * 33] * gn[0].y); o.y = pk2(s[2 * 33] * gn[0].z, s[3 * 33] * gn[0].w); o.z = pk2(s[4 * 33] * gn[1].x, s[5 * 33] * gn[1].y); o.w = pk2(s[6 * 33] * gn[1].z, s[7 * 33] * gn[1].w);
        if (n < d.nc) { bf16* rp;
            if (d.mode == 1) rp = n < 3072 ? d.T + (size_t)n * 1024 : (n < 3096 ? d.T2 + (size_t)(n - 3072) * 1024 : d.T + (size_t)(n - 24) * 1024);
            else if (d.mode == 2) { const int n2 = n & 511; rp = d.T + (size_t)((n2 >> 7) * 256 + (n >> 9) * 128 + (n2 & 127)) * 1024; }
            else rp = d.T + (size_t)n * d.K;
            *(v4u*)(rp + k0 + 8 * c) = o; } }
    LDS_WAIT(); asm volatile("" ::: "memory");
}
__device__ __forceinline__ void rms_row_to_bf16(int lane, const float* xrow, const float* gain, bf16* orow) {
    const f32x4* xr = (const f32x4*)xrow + lane; const f32x4* gr = (const f32x4*)gain + lane;
    f32x4 v[4]; float s = 0.f;
#pragma unroll
    for (int j = 0; j < 4; ++j) { v[j] = xr[64 * j]; s += (v[j].x * v[j].x + v[j].y * v[j].y) + (v[j].z * v[j].z + v[j].w * v[j].w); }
    const float rs = 1.0f / sqrtf(wave_sum(s) * (1.f / D) + NORM_EPS);
    v2u* o8 = (v2u*)orow + lane;
#pragma unroll
    for (int j = 0; j < 4; ++j) { const f32x4 g = gr[64 * j]; o8[64 * j] = pk4(v[j] * rs * g); }
}

namespace tri {
constexpr int I_WIN = 16 * 161, I_UR = 8 * 32, I_WO = 16 * 32, I_WPP = 4 * 32, I_L64 = 16, I_L128 = 32, I_C1 = 32 * 2, I_C2 = 2, I_GU = 16 * 32, I_DN = 8 * 32;
constexpr int E0 = I_WIN, E1 = E0 + I_UR, E2 = E1 + I_UR, E3 = E2 + I_WO, E4 = E3 + I_WPP, E5 = E4 + I_WO, E6 = E5 + I_L64, E7 = E6 + I_L64, E8 = E7 + I_L128, E9 = E8 + I_C1, E10 = E9 + I_C1, E11 = E10 + I_C2, E12 = E11 + I_C2,
              E13 = E12 + 32 * I_GU, NITEMS = E13 + 32 * I_DN;
}
__device__ __forceinline__ TrDesc tr_desc(Frame& F, int it) {
    using namespace tri;
    unsigned char* ws = F.ws;
    const float* W; const float* gain = nullptr; int K, ld, nc, item, mode = 0; size_t dst;
    if (it < E0) { W = F.ap->in[3]; K = 1024; ld = NIN; nc = NIN; item = it; mode = 1; dst = WS_WIN; }
    else if (it < E1) { W = F.ap->in[22]; K = 512; ld = 1024; nc = 1024; item = it - E0; dst = WS_UR; }
    else if (it < E2) { W = F.ap->in[23]; K = 512; ld = 1024; nc = 1024; item = it - E1; dst = WS_UN; }
    else if (it < E3) { W = F.ap->in[24]; K = 1024; ld = 1024; nc = 1024; item = it - E2; dst = WS_WO; }
    else if (it < E4) { W = F.ap->in[32]; K = 256; ld = 1024; nc = 1024; item = it - E3; dst = WS_WPP; }
    else if (it < E5) { W = F.ap->in[35]; K = 1024; ld = 1024; nc = 1024; item = it - E4; dst = WS_WPG; gain = F.ap->in[34]; }
    else if (it < E6) { W = F.ap->in[6]; K = 64; ld = 512; nc = 512; item = it - E5; dst = WS_SMALLW + SW_W2T; }
    else if (it < E7) { W = F.ap->in[8]; K = 64; ld = 512; nc = 512; item = it - E6; dst = WS_SMALLW + SW_A2T; }
    else if (it < E8) { W = F.ap->in[9]; K = 128; ld = 512; nc = 512; item = it - E7; dst = WS_SMALLW + SW_G2T; }
    else if (it < E9) { W = F.ap->in[17]; K = 2048; ld = 64; nc = 64; item = it - E8; dst = WS_SMALLW + SW_CK1; }
    else if (it < E10) { W = F.ap->in[19]; K = 2048; ld = 64; nc = 64; item = it - E9; dst = WS_SMALLW + SW_CV1; }
    else if (it < E11) { W = F.ap->in[18]; K = 64; ld = 64; nc = 64; item = it - E10; dst = WS_SMALLW + SW_CK2; }
    else if (it < E12) { W = F.ap->in[20]; K = 64; ld = 64; nc = 64; item = it - E11; dst = WS_SMALLW + SW_CV2; }
    else if (it < E13) { const int r = it - E12, e = r / I_GU; W = F.ap->in[30] + (size_t)e * 1024 * 1024; K = 1024; ld = 1024; nc = 1024; item = r % I_GU; mode = 2; dst = WS_WGU + (size_t)e * 1024 * 1024 * 2; gain = F.ap->in[25]; }
    else { const int r = it - E13, e = r / I_DN; W = F.ap->in[31] + (size_t)e * 512 * 1024; K = 512; ld = 1024; nc = 1024; item = r % I_DN; dst = WS_WD + (size_t)e * 1024 * 512 * 2; }
    return TrDesc{W, (bf16*)(ws + dst), (bf16*)(ws + WS_SMALLW + SW_GATEW), gain, K, ld, nc, item, mode};
}
__device__ __forceinline__ void tr_run(Frame& F, LAS float* scr, int it0, int stride, int it_end) {
    if (it0 >= it_end) return;
    float tvA[32], tvB[32]; f32x4 gnA[2], gnB[2];
    int it = it0; TrDesc cur = tr_desc(F, it); tr_load(cur, F.lane, tvA, gnA);
    for (;;) {
        const int nxt = it + stride; const bool has = nxt < it_end; TrDesc dn = cur;
        if (has) { dn = tr_desc(F, nxt); tr_load(dn, F.lane, tvB, gnB); }
        __builtin_amdgcn_sched_barrier(0);
        tr_finish(cur, scr, F.lane, tvA, gnA);
        if (!has) break;
        cur = dn; it = nxt;
#pragma unroll
        for (int i = 0; i < 32; ++i) tvA[i] = tvB[i];
        gnA[0] = gnB[0]; gnA[1] = gnB[1];
    }
}
__device__ __forceinline__ int tr_qnext(LAS int* qh) {
    int k = 0; const unsigned a = (unsigned)(size_t)qh; const int one = 1;
    if (__builtin_amdgcn_mbcnt_hi(~0u, __builtin_amdgcn_mbcnt_lo(~0u, 0u)) == 0) asm volatile("ds_add_rtn_u32 %0, %1, %2\n\ts_waitcnt lgkmcnt(0)" : "=&v"(k) : "v"(a), "v"(one) : "memory");
    return __builtin_amdgcn_readfirstlane(k);
}
__device__ __forceinline__ void tr_run_q(Frame& F, LAS float* scr, LAS int* qh, int base, int stride, int nk) {
    int k = tr_qnext(qh); if (k >= nk) return;
    float tvA[32], tvB[32]; f32x4 gnA[2], gnB[2];
    TrDesc cur = tr_desc(F, base + k * stride); tr_load(cur, F.lane, tvA, gnA);
    for (;;) {
        const int kn = tr_qnext(qh); const bool has = kn < nk; TrDesc dn = cur;
        if (has) { dn = tr_desc(F, base + kn * stride); tr_load(dn, F.lane, tvB, gnB); }
        __builtin_amdgcn_sched_barrier(0);
        tr_finish(cur, scr, F.lane, tvA, gnA);
        if (!has) break;
        cur = dn;
#pragma unroll
        for (int i = 0; i < 32; ++i) tvA[i] = tvB[i];
        gnA[0] = gnB[0]; gnA[1] = gnB[1];
    }
}
#ifndef MK_EXPERTS_IN_SCAN
#define MK_EXPERTS_IN_SCAN 1
#endif
__device__ __forceinline__ void p0_prologue(Frame& F) {
    LAS float* scr = (LAS float*)(F.lds + F.wave * 16384);
    unsigned char* ws = F.ws;
    bf16* gateWT = (bf16*)(ws + WS_SMALLW + SW_GATEW);
    tr_run(F, scr, F.gw, F.NGW, MK_EXPERTS_IN_SCAN ? tri::E12 : tri::NITEMS);
    for (int mb = F.gw; mb < M; mb += 4 * F.NGW) {
        f32x4 v[4][4]; float s[4];
#pragma unroll
        for (int u = 0; u < 4; ++u) { const f32x4* xr = (const f32x4*)(F.ap->in[0] + (size_t)(mb + u * F.NGW) * D) + F.lane;
#pragma unroll
            for (int j = 0; j < 4; ++j) v[u][j] = xr[64 * j]; }
#pragma unroll
        for (int u = 0; u < 4; ++u) { s[u] = 0.f;
#pragma unroll
            for (int j = 0; j < 4; ++j) s[u] += (v[u][j].x * v[u][j].x + v[u][j].y * v[u][j].y) + (v[u][j].z * v[u][j].z + v[u][j].w * v[u][j].w); }
#pragma unroll
        for (int o = 1; o < 64; o <<= 1) {
#pragma unroll
            for (int u = 0; u < 4; ++u) s[u] += __shfl_xor(s[u], o); }
        const f32x4* gr = (const f32x4*)F.ap->in[2] + F.lane;
#pragma unroll
        for (int u = 0; u < 4; ++u) { const float rs = 1.0f / sqrtf(s[u] * (1.f / D) + NORM_EPS); v2u* o8 = (v2u*)((bf16*)(ws + WS_XN) + (size_t)(mb + u * F.NGW) * D) + F.lane;
#pragma unroll
            for (int j = 0; j < 4; ++j) o8[64 * j] = pk4(v[u][j] * rs * gr[64 * j]); }
    }
    {
        float* RW = (float*)(ws + WS_SMALLW + SW_ROUTEW); const float* gf = F.ap->in[25]; const float* wg = F.ap->in[26]; const float* wr = F.ap->in[28];
        for (int idx = F.gw * 64 + F.lane; idx < 48 * 1024; idx += F.NGW * 64) { const int c = idx >> 10, k = idx & 1023; float v = 0.f;
            if (c < 4) v = wg[k * 4 + c]; else if (c < 36) v = wr[k * 32 + (c - 4)];
            RW[idx] = v * gf[k]; }
        for (int idx = F.gw * 64 + F.lane; idx < 8 * 1024; idx += F.NGW * 64) gateWT[24 * 1024 + idx] = 0;
    }
}

struct EpiStoreBf16 {
    static constexpr bool PERM = true;
    bf16* O; int ldc;
    __device__ __forceinline__ void operator()(const f32x4 (&acc)[2][2][4][2], const pg8::Unit& u, int wr, int wc, int fr, int fq) const {
        const int row0 = u.pmo * 256 + wr * 64 + fr, col0 = u.pnl * 256 + wc * 32 + 8 * fq;
#pragma unroll
        for (int ai = 0; ai < 2; ++ai)
#pragma unroll
            for (int m = 0; m < 4; ++m) { bf16* rowp = O + (size_t)(row0 + ai * 128 + m * 16) * ldc + col0;
#pragma unroll
                for (int bj = 0; bj < 2; ++bj) { const f32x4 v0 = acc[ai][bj][m][0], v1 = acc[ai][bj][m][1]; v4u w; w.x = pk2(v0[0], v0[1]); w.y = pk2(v0[2], v0[3]); w.z = pk2(v1[0], v1[1]); w.w = pk2(v1[2], v1[3]);
                    *(v4u*)(rowp + bj * 128) = w; } }
    }
};
struct EpiStoreSsq {
    static constexpr bool PERM = true;
    bf16* O; int ldc; float* part;
    __device__ __forceinline__ void operator()(const f32x4 (&acc)[2][2][4][2], const pg8::Unit& u, int wr, int wc, int fr, int fq) const {
        const int row0 = u.pmo * 256 + wr * 64 + fr, col0 = u.pnl * 256 + wc * 32 + 8 * fq;
#pragma unroll
        for (int ai = 0; ai < 2; ++ai)
#pragma unroll
            for (int m = 0; m < 4; ++m) { bf16* rowp = O + (size_t)(row0 + ai * 128 + m * 16) * ldc + col0; float ss = 0.f;
#pragma unroll
                for (int bj = 0; bj < 2; ++bj) { const f32x4 v0 = acc[ai][bj][m][0], v1 = acc[ai][bj][m][1]; v4u w; w.x = pk2(v0[0], v0[1]); w.y = pk2(v0[2], v0[3]); w.z = pk2(v1[0], v1[1]); w.w = pk2(v1[2], v1[3]);
                    *(v4u*)(rowp + bj * 128) = w;
                    ss += ((v0[0] * v0[0] + v0[1] * v0[1]) + (v0[2] * v0[2] + v0[3] * v0[3])) + ((v1[0] * v1[0] + v1[1] * v1[1]) + (v1[2] * v1[2] + v1[3] * v1[3])); }
                ss += __shfl_xor(ss, 16); ss += __shfl_xor(ss, 32);
                if (fq == 0) part[(size_t)(row0 + ai * 128 + m * 16) * 16 + u.pnl * 4 + wc] = ss; }
    }
};
#define EPI_LOOP_BEGIN \
    _Pragma("unroll") for (int ai = 0; ai < 2; ++ai) _Pragma("unroll") for (int m = 0; m < 4; ++m) { if (m == 0 || m == 2) asm volatile("" ::: "memory"); const int rl = ai * 128 + wr * 64 + m * 16 + fr; const size_t row = (size_t)u.pmo * 256 + rl; (void)row; \
    _Pragma("unroll") for (int bj = 0; bj < 2; ++bj) _Pragma("unroll") for (int n = 0; n < 2; ++n) { const int col = u.pnl * 256 + bj * 128 + wc * 32 + n * 16 + 4 * fq; (void)col; const f32x4 a = acc[ai][bj][m][n];
#define EPI_LOOP_END } }
struct EpiMix {
    static constexpr bool PERM = false;
    const bf16* z; bf16* A; bf16* O;
    __device__ __forceinline__ void operator()(const f32x4 (&acc)[2][2][4][2], const pg8::Unit& u, int wr, int wc, int fr, int fq) const {
        const int zc = u.lt ? ZC_MN : ZC_MR;
        EPI_LOOP_BEGIN
            const f32x4 zz = unpk4(*(const v2u*)(z + row * NZ + zc + col)); f32x4 o;
            o.x = sigmoidf_(zz.x) * a.x; o.y = sigmoidf_(zz.y) * a.y; o.z = sigmoidf_(zz.z) * a.z; o.w = sigmoidf_(zz.w) * a.w;
            if (u.lt == 0) *(v2u*)(A + row * D + col) = pk4(o);
            else { o = o + unpk4(*(const v2u*)(A + row * D + col)); *(v2u*)(O + row * D + col) = pk4(o); }
        EPI_LOOP_END
    }
};
struct ErawOrder {
    static constexpr bool DEP = false;
    pg8::StaticOrder S; int c, G, nheavy;
    __device__ bool next(int i, pg8::Unit& u) const { const int nl = G - nheavy, l = c - nheavy; if (l < 0) return false; const int q = l + i * nl; if (q >= S.nwg) return false;
        pg8::StaticOrder T = S; T.c = q; T.G = S.nwg + 1; return T.next(0, u); }
};
struct DualOrder {
    static constexpr bool DEP = false;
    pg8::StaticOrder S;
    __device__ bool next(int i, pg8::Unit& u) const { if (i >= 2) return false; if (!S.next(0, u)) return false; if (i == 1) { u.pm += 64; u.pn += 4; } u.lt = i; return true; }
};
struct EpiResBf16 {
    static constexpr bool PERM = true;
    const float* base; bf16* O;
    __device__ __forceinline__ void operator()(const f32x4 (&acc)[2][2][4][2], const pg8::Unit& u, int wr, int wc, int fr, int fq) const {
        const int row0 = u.pmo * 256 + wr * 64 + fr, col0 = u.pnl * 256 + wc * 32 + 8 * fq;
#pragma unroll
        for (int ai = 0; ai < 2; ++ai)
#pragma unroll
            for (int m = 0; m < 4; ++m) { if (m == 0 || m == 2) asm volatile("" ::: "memory"); const size_t ro = (size_t)(row0 + ai * 128 + m * 16) * D + col0;
#pragma unroll
                for (int bj = 0; bj < 2; ++bj) { const f32x4 v0 = acc[ai][bj][m][0] + *(const f32x4*)(base + ro + bj * 128), v1 = acc[ai][bj][m][1] + *(const f32x4*)(base + ro + bj * 128 + 4);
                    v4u w; w.x = pk2(v0[0], v0[1]); w.y = pk2(v0[2], v0[3]); w.z = pk2(v1[0], v1[1]); w.w = pk2(v1[2], v1[3]);
                    *(v4u*)(O + ro + bj * 128) = w; } }
    }
};
struct EpiResF32 {
    static constexpr bool PERM = false;
    const float* base; float* O;
    __device__ __forceinline__ void operator()(const f32x4 (&acc)[2][2][4][2], const pg8::Unit& u, int wr, int wc, int fr, int fq) const {
        EPI_LOOP_BEGIN
            *(f32x4*)(O + row * D + col) = *(const f32x4*)(base + row * D + col) + a;
        EPI_LOOP_END
    }
};
struct EpiMoe1 {
    static constexpr bool PERM = false;
    bf16* H; const LAS float* rsl; unsigned* dep;
    __device__ __forceinline__ void operator()(const f32x4 (&acc)[2][2][4][2], const pg8::Unit& u, int wr, int wc, int fr, int fq) const {
#pragma unroll
        for (int ai = 0; ai < 2; ++ai)
#pragma unroll
            for (int m = 0; m < 4; ++m) { const int rl = ai * 128 + wr * 64 + m * 16 + fr; const size_t row = (size_t)u.pmo * 256 + rl; const float rs = rsl[u.pm * 256 + rl];
#pragma unroll
                for (int n = 0; n < 2; ++n) { const f32x4 gt = acc[ai][0][m][n] * rs, up = acc[ai][1][m][n] * rs; f32x4 o;
                    o.x = gt.x * sigmoidf_(gt.x) * up.x; o.y = gt.y * sigmoidf_(gt.y) * up.y; o.z = gt.z * sigmoidf_(gt.z) * up.z; o.w = gt.w * sigmoidf_(gt.w) * up.w;
                    { bf16* hp = H + row * 512 + u.pnl * 128 + wc * 32 + n * 16 + 4 * fq; const v2u hv = pk4(o); asm volatile("global_store_dwordx2 %0, %1, off sc1" :: "v"(hp), "v"(hv) : "memory"); } } }
        asm volatile("s_waitcnt vmcnt(0)" ::: "memory"); __builtin_amdgcn_s_barrier(); asm volatile("" ::: "memory");
        if (threadIdx.x == 0) __hip_atomic_fetch_add(dep + 16 * u.pmo, 1u, __ATOMIC_RELAXED, __HIP_MEMORY_SCOPE_AGENT);
    }
};
struct EpiPle {
    static constexpr bool PERM = false;
    const bf16* x2; const bf16* Eraw; const float* rse; const float* gpn; bf16* O;
    __device__ __forceinline__ void operator()(const f32x4 (&acc)[2][2][4][2], const pg8::Unit& u, int wr, int wc, int fr, int fq) const {
        EPI_LOOP_BEGIN
            const f32x4 e = unpk4(*(const v2u*)(Eraw + row * D + col)); const f32x4 g = *(const f32x4*)(gpn + col); const float rs = rse[row]; f32x4 o = unpk4(*(const v2u*)(x2 + row * D + col));
            o.x += sigmoidf_(a.x) * e.x * rs * g.x; o.y += sigmoidf_(a.y) * e.y * rs * g.y; o.z += sigmoidf_(a.z) * e.z * rs * g.z; o.w += sigmoidf_(a.w) * e.w * rs * g.w;
            *(v2u*)(O + row * D + col) = pk4(o);
        EPI_LOOP_END
    }
};

struct EpiPleNorm {
    static constexpr bool PERM = false;
    const bf16* x2; const bf16* Eraw; const float* rse; const float* gpn; const float* rs3; const float* gfin; float* out; float* xbuf; unsigned* cnt; LAS float* ldsx;
    __device__ __forceinline__ void operator()(const f32x4 (&acc_)[2][2][4][2], const pg8::Unit& u_, int wr, int wc, int fr, int fq) const {
        f32x4 (&acc)[2][2][4][2] = const_cast<f32x4 (&)[2][2][4][2]>(acc_);
        pg8::Unit u = u_; asm volatile("" : "+s"(u.pmo), "+s"(u.pnl)); asm volatile("" : "+v"(fr), "+v"(fq)); asm volatile("" : "+s"(wr), "+s"(wc));
        int tid = threadIdx.x; asm volatile("" : "+v"(tid)); const int lane = tid & 63, wid = __builtin_amdgcn_readfirstlane(tid >> 6);
        LAS float* Pl = ldsx; LAS float* Sl = ldsx + 1024; LAS unsigned* flag = (LAS unsigned*)(ldsx + 1280);
#pragma unroll
        for (int ai = 0; ai < 2; ++ai)
#pragma unroll
            for (int m = 0; m < 4; ++m) { if (m == 0 || m == 2) asm volatile("" ::: "memory"); const int rl = ai * 128 + wr * 64 + m * 16 + fr; const size_t row = (size_t)u.pmo * 256 + rl;
                float ss = 0.f; const float r3 = rs3[row], re = rse[row];
#pragma unroll
                for (int bj = 0; bj < 2; ++bj)
#pragma unroll
                    for (int n = 0; n < 2; ++n) { const int col = u.pnl * 256 + bj * 128 + wc * 32 + n * 16 + 4 * fq; const f32x4 a = acc[ai][bj][m][n];
                        const f32x4 e = unpk4(*(const v2u*)(Eraw + row * D + col)) * re * *(const f32x4*)(gpn + col); f32x4 o = unpk4(*(const v2u*)(x2 + row * D + col));
                        o.x += sigmoidf_(a.x * r3) * e.x; o.y += sigmoidf_(a.y * r3) * e.y; o.z += sigmoidf_(a.z * r3) * e.z; o.w += sigmoidf_(a.w * r3) * e.w;
                        acc[ai][bj][m][n] = o; ss += (o.x * o.x + o.y * o.y) + (o.z * o.z + o.w * o.w); }
                ss += __shfl_xor(ss, 16); ss += __shfl_xor(ss, 32);
                if (fq == 0) Pl[rl * 4 + wc] = ss; }
        asm volatile("s_waitcnt lgkmcnt(0)" ::: "memory"); __builtin_amdgcn_s_barrier(); asm volatile("" ::: "memory");
        if (tid < 256) { const float tot = (Pl[tid * 4 + 0] + Pl[tid * 4 + 1]) + (Pl[tid * 4 + 2] + Pl[tid * 4 + 3]);
            __hip_atomic_store(xbuf + ((size_t)u.pmo * 256 + tid) * 4 + u.pnl, tot, __ATOMIC_RELAXED, __HIP_MEMORY_SCOPE_AGENT);
            asm volatile("s_waitcnt vmcnt(0)" ::: "memory");
            if (lane == 0) __hip_atomic_fetch_add(cnt + 64 * u.pmo, 1u, __ATOMIC_RELAXED, __HIP_MEMORY_SCOPE_AGENT); }
        if (wid == 0) {
            unsigned spins = 0;
            while ((unsigned)__builtin_amdgcn_readfirstlane((int)__hip_atomic_load(cnt + 64 * u.pmo, __ATOMIC_RELAXED, __HIP_MEMORY_SCOPE_AGENT)) < 16u) { __builtin_amdgcn_s_sleep(2); if (++spins > (1u << 22)) break; }
            __builtin_amdgcn_fence(__ATOMIC_ACQUIRE, "agent");
            if (lane == 0) flag[0] = 1u; }
        asm volatile("s_waitcnt vmcnt(0) lgkmcnt(0)" ::: "memory"); __builtin_amdgcn_s_barrier(); asm volatile("" ::: "memory");
        if (tid < 256) { const float* sp = xbuf + ((size_t)u.pmo * 256 + tid) * 4; float tot = 0.f;
#pragma unroll
            for (int t = 0; t < 4; ++t) tot += __hip_atomic_load(sp + t, __ATOMIC_RELAXED, __HIP_MEMORY_SCOPE_AGENT);
            Sl[tid] = 1.0f / sqrtf(tot * (1.f / D) + NORM_EPS); }
        asm volatile("s_waitcnt vmcnt(0) lgkmcnt(0)" ::: "memory"); __builtin_amdgcn_s_barrier(); asm volatile("" ::: "memory");
#pragma unroll
        for (int ai = 0; ai < 2; ++ai)
#pragma unroll
            for (int m = 0; m < 4; ++m) { const int rl = ai * 128 + wr * 64 + m * 16 + fr; const size_t row = (size_t)u.pmo * 256 + rl; const float rs = Sl[rl];
#pragma unroll
                for (int bj = 0; bj < 2; ++bj)
#pragma unroll
                    for (int n = 0; n < 2; ++n) { const int col = u.pnl * 256 + bj * 128 + wc * 32 + n * 16 + 4 * fq; *(f32x4*)(out + row * D + col) = acc[ai][bj][m][n] * rs * *(const f32x4*)(gfin + col); } }
    }
};

__device__ __forceinline__ float gelu_tanh(float x) { const float u = 0.7978845608028654f * (x + 0.044715f * x * x * x); const float t = 1.0f - 2.0f * __builtin_amdgcn_rcpf(__expf(2.0f * u) + 1.0f); return 0.5f * x * (1.0f + t); }

__device__ __forceinline__ void compress_wg_task(Frame& F, int idx) {
    const int kv = idx & 1, tile8 = (idx >> 1) & 7, bg = idx >> 4, b = bg >> 1, g = bg & 1;
    const int fr = F.lane & 15, fq = F.lane >> 4;
    const bf16* z = (const bf16*)(F.ws + WS_Z);
    const bf16* w1T = (const bf16*)(F.ws + WS_SMALLW + (kv ? SW_CV1 : SW_CK1));
    const bf16* w2T = (const bf16*)(F.ws + WS_SMALLW + (kv ? SW_CV2 : SW_CK2));
    const float* pos = kv ? F.ap->in[16] : F.ap->in[15];
    const int j0 = 16 * tile8; int j = j0 + fr; const bool jvalid = j < 127; if (!jvalid) j = 126;
    const bf16* zb = z + ((size_t)b * SEQ + 16 * j) * NZ + (kv ? ZC_VC : ZC_KC) + g * 64;
    v4u zr[8]; f32x4 p0[8], p1[8]; bf16x8 aop[8][4];
#pragma unroll
    for (int i = 0; i < 8; ++i) { const int ks = 8 * F.wave + i, l = ks >> 1, d = 32 * (ks & 1) + 8 * fq;
        zr[i] = *(const v4u*)(zb + (size_t)l * NZ + d); p0[i] = *(const f32x4*)(pos + l * 64 + d); p1[i] = *(const f32x4*)(pos + l * 64 + d + 4);
#pragma unroll
        for (int mt = 0; mt < 4; ++mt) aop[i][mt] = *(const bf16x8*)(w1T + (size_t)(16 * mt + fr) * 2048 + 32 * ks + 8 * fq); }
    f32x4 acc[4];
#pragma unroll
    for (int mt = 0; mt < 4; ++mt) acc[mt] = (f32x4){0.f, 0.f, 0.f, 0.f};
#pragma unroll
    for (int i = 0; i < 8; ++i) {
        float f[8]; unpk8(zr[i], f);
        v4u bb; bb.x = pk2(f[0] + p0[i].x, f[1] + p0[i].y); bb.y = pk2(f[2] + p0[i].z, f[3] + p0[i].w); bb.z = pk2(f[4] + p1[i].x, f[5] + p1[i].y); bb.w = pk2(f[6] + p1[i].z, f[7] + p1[i].w);
        const bf16x8 bop = __builtin_bit_cast(bf16x8, bb);
#pragma unroll
        for (int mt = 0; mt < 4; ++mt) acc[mt] = MFMA16(aop[i][mt], bop, acc[mt]);
    }
    LAS float* red = (LAS float*)F.lds;
    __syncthreads();
#pragma unroll
    for (int mt = 0; mt < 4; ++mt) *(LAS f32x4*)(red + ((F.wave * 4 + mt) * 64 + F.lane) * 4) = acc[mt];
    LDS_WAIT(); __syncthreads();
    if (F.wave != 0) return;
#pragma unroll
    for (int mt = 0; mt < 4; ++mt) { f32x4 t = (f32x4){0.f, 0.f, 0.f, 0.f};
#pragma unroll
        for (int w = 0; w < 8; ++w) t = t + *(const LAS f32x4*)(red + ((w * 4 + mt) * 64 + F.lane) * 4);
        acc[mt] = t; }
    bf16x8 hb[2];
#pragma unroll
    for (int s2 = 0; s2 < 2; ++s2) { v4u w; const f32x4 a0 = acc[2 * s2], a1 = acc[2 * s2 + 1];
        w.x = pk2(gelu_tanh(a0.x), gelu_tanh(a0.y)); w.y = pk2(gelu_tanh(a0.z), gelu_tanh(a0.w)); w.z = pk2(gelu_tanh(a1.x), gelu_tanh(a1.y)); w.w = pk2(gelu_tanh(a1.z), gelu_tanh(a1.w));
        hb[s2] = __builtin_bit_cast(bf16x8, w); }
    bf16* kcmp = (bf16*)(F.ws + WS_KCMP); bf16* vcmpT = (bf16*)(F.ws + WS_KCMP + 512 * 1024);
#pragma unroll
    for (int ntl = 0; ntl < 4; ++ntl) {
        f32x4 o = (f32x4){0.f, 0.f, 0.f, 0.f};
#pragma unroll
        for (int s2 = 0; s2 < 2; ++s2) { const bf16* wp = w2T + (size_t)(16 * ntl + fr) * 64 + 32 * s2 + 4 * fq; const v2u lo = *(const v2u*)wp, hi = *(const v2u*)(wp + 16);
            v4u aw; aw.x = lo.x; aw.y = lo.y; aw.z = hi.x; aw.w = hi.y; o = MFMA16(__builtin_bit_cast(bf16x8, aw), hb[s2], o); }
        if (!jvalid) o = (f32x4){0.f, 0.f, 0.f, 0.f};
        const int jj = j0 + fr, n = 16 * ntl + 4 * fq;
        if (kv == 0) *(v2u*)(kcmp + ((size_t)bg * 128 + jj) * 64 + n) = pk4(o);
        else { const v2u w = pk4(o); bf16* vp = vcmpT + ((size_t)bg * 64 + n) * 128 + jj; vp[0] = (bf16)(w.x & 0xffff); vp[128] = (bf16)(w.x >> 16); vp[256] = (bf16)(w.y & 0xffff); vp[384] = (bf16)(w.y >> 16); }
    }
}
__device__ __forceinline__ void zgate_task(Frame& F, int tile) {
    const int fr = F.lane & 15, fq = F.lane >> 4, m0 = tile * 16;
    const bf16* XN = (const bf16*)(F.ws + WS_XN); const bf16* gw = (const bf16*)(F.ws + WS_SMALLW + SW_GATEW);
    f32x4 acc[2] = {(f32x4){0.f, 0.f, 0.f, 0.f}, (f32x4){0.f, 0.f, 0.f, 0.f}};
#pragma unroll 16
    for (int ks = 0; ks < 32; ++ks) {
        const bf16x8 bop = *(const bf16x8*)(XN + (size_t)(m0 + fr) * D + 32 * ks + 8 * fq);
#pragma unroll
        for (int ct = 0; ct < 2; ++ct) { const bf16x8 aop = *(const bf16x8*)(gw + (size_t)(16 * ct + fr) * D + 32 * ks + 8 * fq); acc[ct] = MFMA16(aop, bop, acc[ct]); }
    }
    float* zg = (float*)(F.ws + WS_ZGATE);
#pragma unroll
    for (int ct = 0; ct < 2; ++ct) *(f32x4*)(zg + (size_t)(m0 + fr) * 32 + 16 * ct + 4 * fq) = acc[ct];
}
__device__ __forceinline__ void vt_task(Frame& F, int idx) {
    const int which = idx & 1, blk = (idx >> 1) & 31, bg = idx >> 6, b = bg >> 1, g = bg & 1;
    const bf16* z = (const bf16*)(F.ws + WS_Z);
    bf16* vT = (bf16*)(F.ws + (which ? WS_VWT : WS_VST));
    const int t = 64 * blk + F.lane;
    const bf16* src = z + ((size_t)b * SEQ + t) * NZ + (which ? ZC_VW : ZC_VS) + g * 64;
#pragma unroll
    for (int dc = 0; dc < 8; ++dc) { const v4u w = *(const v4u*)(src + 8 * dc); bf16* dst = vT + ((size_t)bg * 64 + 8 * dc) * SEQ + t;
        dst[0 * SEQ] = (bf16)(w.x & 0xffff); dst[1 * SEQ] = (bf16)(w.x >> 16); dst[2 * SEQ] = (bf16)(w.y & 0xffff); dst[3 * SEQ] = (bf16)(w.y >> 16);
        dst[4 * SEQ] = (bf16)(w.z & 0xffff); dst[5 * SEQ] = (bf16)(w.z >> 16); dst[6 * SEQ] = (bf16)(w.w & 0xffff); dst[7 * SEQ] = (bf16)(w.w >> 16); }
}
__device__ __forceinline__ void alora_task4(Frame& F, int mb) {
    const bf16* z = (const bf16*)(F.ws + WS_Z); bf16* AL = (bf16*)(F.ws + WS_PBF);
    const int l = F.lane;
    const f32x4 mu = *(const f32x4*)(F.ap->in[4] + ZC_W + 4 * l);
    v2u cw[4], pw[4];
#pragma unroll
    for (int u = 0; u < 4; ++u) { const int m = mb + u * F.NGW; const int t = m & (SEQ - 1); cw[u] = *(const v2u*)(z + (size_t)m * NZ + ZC_W + 4 * l); pw[u] = *(const v2u*)(z + (size_t)(t > 0 ? m - 1 : m) * NZ + ZC_W + 4 * l); }
#pragma unroll
    for (int u = 0; u < 4; ++u) { const int m = mb + u * F.NGW; const int t = m & (SEQ - 1);
        const f32x4 cur = unpk4(cw[u]); const f32x4 prev = unpk4(pw[u]) * (t > 0 ? 1.0f : 0.0f);
        f32x4 s = cur + (prev - cur) * mu;
        if (l < 16) { s.x = tanhf(s.x); s.y = tanhf(s.y); s.z = tanhf(s.z); s.w = tanhf(s.w); }
        else if (l >= 32) { s.x = sigmoidf_(s.x); s.y = sigmoidf_(s.y); s.z = sigmoidf_(s.z); s.w = sigmoidf_(s.w); }
        *(v2u*)(AL + (size_t)m * 256 + 4 * l) = pk4(s); }
}
__device__ __forceinline__ void p2_prep(Frame& F) {
    constexpr int T1 = 1024, T2 = T1 + 1024;
    for (int it = F.vcu; it < 256; it += F.G) compress_wg_task(F, it);
    for (int task = F.gw; task < T2; task += F.NGW) {
        if (task < T1) zgate_task(F, task);
        else vt_task(F, task - T1);
    }
    for (int base = F.gw; base < M; base += 4 * F.NGW) alora_task4(F, base);
}

__device__ __forceinline__ void ld16(const bf16* p, float (&f)[16]) { float a[8], b[8]; unpk8(*(const v4u*)p, a); unpk8(*(const v4u*)(p + 8), b);
#pragma unroll
    for (int i = 0; i < 8; ++i) { f[i] = a[i]; f[8 + i] = b[i]; } }
__device__ __forceinline__ void ld16f(const float* p, float (&f)[16]) {
#pragma unroll
    for (int q = 0; q < 4; ++q) { const f32x4 v = *(const f32x4*)(p + 4 * q); f[4 * q] = v.x; f[4 * q + 1] = v.y; f[4 * q + 2] = v.z; f[4 * q + 3] = v.w; } }
__device__ __forceinline__ void st16(bf16* p, const float (&f)[16]) { v4u a, b; a.x = pk2(f[0], f[1]); a.y = pk2(f[2], f[3]); a.z = pk2(f[4], f[5]); a.w = pk2(f[6], f[7]); b.x = pk2(f[8], f[9]); b.y = pk2(f[10], f[11]); b.z = pk2(f[12], f[13]); b.w = pk2(f[14], f[15]);
    *(v4u*)p = a; *(v4u*)(p + 8) = b; }
struct PrepW { bf16x8 w[2], a[2], g[4]; };
constexpr int PW_OFF = 32768, PW_P64 = 144, PW_P128 = 272, PW_A_OFF = PW_OFF + 64 * PW_P64, PW_G_OFF = PW_A_OFF + 64 * PW_P64;
__device__ __forceinline__ void prep_stage_w(Frame& F, int h) {
    const bf16* w2T = (const bf16*)(F.ws + WS_SMALLW + SW_W2T) + (size_t)h * 64 * 64; const bf16* a2T = (const bf16*)(F.ws + WS_SMALLW + SW_A2T) + (size_t)h * 64 * 64; const bf16* g2T = (const bf16*)(F.ws + WS_SMALLW + SW_G2T) + (size_t)h * 64 * 128;
    { const int R = F.tid >> 3, c = F.tid & 7, slot = ((R >> 2) & 3) * 16 + (R >> 4) * 4 + (R & 3);
      *(LAS v4u*)(F.lds + PW_OFF + slot * PW_P64 + c * 16) = *(const v4u*)(w2T + R * 64 + c * 8); *(LAS v4u*)(F.lds + PW_A_OFF + slot * PW_P64 + c * 16) = *(const v4u*)(a2T + R * 64 + c * 8); }
#pragma unroll
    for (int i = 0; i < 2; ++i) { const int id = F.tid + 512 * i, R = id >> 4, c = id & 15, slot = ((R >> 2) & 3) * 16 + (R >> 4) * 4 + (R & 3);
      *(LAS v4u*)(F.lds + PW_G_OFF + slot * PW_P128 + c * 16) = *(const v4u*)(g2T + R * 128 + c * 8); }
}
__device__ __forceinline__ void prep_ldw(PrepW& W, const LAS unsigned char* lds, int n, int fr, int fq) {
#pragma unroll
    for (int ks = 0; ks < 2; ++ks) { W.w[ks] = *(const LAS bf16x8*)(lds + PW_OFF + (n * 16 + fr) * PW_P64 + 64 * ks + 16 * fq); W.a[ks] = *(const LAS bf16x8*)(lds + PW_A_OFF + (n * 16 + fr) * PW_P64 + 64 * ks + 16 * fq); }
#pragma unroll
    for (int ks = 0; ks < 4; ++ks) W.g[ks] = *(const LAS bf16x8*)(lds + PW_G_OFF + (n * 16 + fr) * PW_P128 + 64 * ks + 16 * fq);
}
__device__ __forceinline__ void ldpar(const LAS float* p, float (&f)[16]) {
#pragma unroll
    for (int q = 0; q < 4; ++q) { const f32x4 v = *(const LAS f32x4*)(p + 4 * q); f[4 * q] = v.x; f[4 * q + 1] = v.y; f[4 * q + 2] = v.z; f[4 * q + 3] = v.w; } }
__device__ __forceinline__ void rwkv_prep_task(Frame& F, int task, const LAS float* par) {
    const int h = task & 7, m0 = (task >> 3) * 16, fr = F.lane & 15, fq = F.lane >> 4, m = m0 + fr, t = m & (SEQ - 1);
    const bf16* z = (const bf16*)(F.ws + WS_Z); const bf16* AL = (const bf16*)(F.ws + WS_PBF);
    bf16* vbuf = (bf16*)F.out; bf16* gbuf = (bf16*)(F.ws + WS_G);
    const int cl = h * 64 + 16 * fq;
    bf16x8 bw[2], ba[2], bgf[4];
    const bf16* alr = AL + (size_t)m * 256 + 8 * fq;
#pragma unroll
    for (int ks = 0; ks < 2; ++ks) { bw[ks] = *(const bf16x8*)(alr + 32 * ks); ba[ks] = *(const bf16x8*)(alr + 64 + 32 * ks); }
#pragma unroll
    for (int ks = 0; ks < 4; ++ks) bgf[ks] = *(const bf16x8*)(alr + 128 + 32 * ks);
    const bf16* zc = z + (size_t)m * NZ + cl; const bf16* zp = (t > 0) ? zc - NZ : zc;
    v4u zraw[6][2];
#pragma unroll
    for (int q = 0; q < 3; ++q) { zraw[q][0] = *(const v4u*)(zc + 512 * q); zraw[q][1] = *(const v4u*)(zc + 512 * q + 8); zraw[3 + q][0] = *(const v4u*)(zp + 512 * q); zraw[3 + q][1] = *(const v4u*)(zp + 512 * q + 8); }
    __builtin_amdgcn_sched_barrier(0);
    float ev[16], av[16], gv[16];
#define PREP_MM(W, n) do { f32x4 accw = (f32x4){0.f, 0.f, 0.f, 0.f}, acca = accw, accg = accw; \
        _Pragma("unroll") for (int ks = 0; ks < 2; ++ks) { accw = MFMA16(W.w[ks], bw[ks], accw); acca = MFMA16(W.a[ks], ba[ks], acca); } \
        _Pragma("unroll") for (int ks = 0; ks < 4; ++ks) accg = MFMA16(W.g[ks], bgf[ks], accg); \
        _Pragma("unroll") for (int r = 0; r < 4; ++r) { ev[4 * (n) + r] = accw[r]; av[4 * (n) + r] = acca[r]; gv[4 * (n) + r] = accg[r]; } } while (0)
    { PrepW Wa, Wb;
      prep_ldw(Wa, F.lds, 0, fr, fq); prep_ldw(Wb, F.lds, 1, fr, fq); PREP_MM(Wa, 0); PREP_MM(Wb, 1);
      prep_ldw(Wa, F.lds, 2, fr, fq); prep_ldw(Wb, F.lds, 3, fr, fq); PREP_MM(Wa, 2); PREP_MM(Wb, 3); }
    float zr[16], zk[16], zv[16], tmp[16];
    const float pm = (t > 0) ? 1.0f : 0.0f;
    {   float c[16], p[16];
#define PREP_UNP(q, dst) do { float a_[8], b_[8]; unpk8(zraw[q][0], a_); unpk8(zraw[q][1], b_); _Pragma("unroll") for (int i = 0; i < 8; ++i) { dst[i] = a_[i]; dst[8 + i] = b_[i]; } } while (0)
        PREP_UNP(0, c); PREP_UNP(3, p); ldpar(par + 0 * 64 + 16 * fq, tmp);
#pragma unroll
        for (int e = 0; e < 16; ++e) zr[e] = c[e] + (p[e] * pm - c[e]) * tmp[e];
        PREP_UNP(1, c); PREP_UNP(4, p); ldpar(par + 1 * 64 + 16 * fq, tmp);
#pragma unroll
        for (int e = 0; e < 16; ++e) zk[e] = c[e] + (p[e] * pm - c[e]) * tmp[e];
        PREP_UNP(2, c); PREP_UNP(5, p); ldpar(par + 2 * 64 + 16 * fq, tmp);
#pragma unroll
        for (int e = 0; e < 16; ++e) zv[e] = c[e] + (p[e] * pm - c[e]) * tmp[e];
    }
    float kkr[16]; float ss = 0.f;
    ldpar(par + 3 * 64 + 16 * fq, tmp);
#pragma unroll
    for (int e = 0; e < 16; ++e) { const float x = -(tmp[e] + ev[e]); const float sp = fmaxf(x, 0.f) + __logf(1.0f + __expf(-fabsf(x))); ev[e] = __expf(-sp - 0.5f); }
    ldpar(par + 4 * 64 + 16 * fq, tmp);
#pragma unroll
    for (int e = 0; e < 16; ++e) av[e] = sigmoidf_(tmp[e] + av[e]);
    ldpar(par + 5 * 64 + 16 * fq, tmp);
#pragma unroll
    for (int e = 0; e < 16; ++e) { kkr[e] = zk[e] * tmp[e]; ss += kkr[e] * kkr[e]; }
    ss += __shfl_xor(ss, 16); ss += __shfl_xor(ss, 32);
    const float inv = 1.0f / fmaxf(sqrtf(ss), 1e-12f);
    ldpar(par + 6 * 64 + 16 * fq, tmp);
    float kp[16], kka[16];
#pragma unroll
    for (int e = 0; e < 16; ++e) { kkr[e] *= inv; kka[e] = kkr[e] * av[e]; kp[e] = zk[e] * (1.0f + (av[e] - 1.0f) * tmp[e]); }
    st16(vbuf + (size_t)m * 512 + cl, zv); st16(gbuf + (size_t)m * 512 + cl, gv);
    { ldpar(par + 7 * 64 + 16 * fq, tmp);
      float bsum = 0.f;
#pragma unroll
      for (int e = 0; e < 16; ++e) bsum += zr[e] * kp[e] * tmp[e];
      bsum += __shfl_xor(bsum, 16); bsum += __shfl_xor(bsum, 32);
      if (fq == 0) ((float*)(F.ws + WS_BONUS))[(size_t)m * 8 + h] = bsum; }
    asm volatile("" ::: "memory");
    unsigned char* rec = F.ws + WS_S + (size_t)task * CH_REC;
    bf16x8 Pb[2], Qb[2], Kb[2], Rb[2];
#pragma unroll
    for (int ks = 0; ks < 2; ++ks) {
        float Pm[8], Qm[8], Km[8], Rm[8], acv[8];
#pragma unroll
        for (int e8 = 0; e8 < 8; ++e8) { const int e = 8 * ks + e8;
            float cs = ev[e]; cs += dppf<0x111>(cs); cs += dppf<0x112>(cs); cs += dppf<0x114>(cs); cs += dppf<0x118>(cs);
            const float A = __expf(-cs), Ap = __expf(ev[e] - cs), iA = __expf(cs);
            Pm[e8] = kkr[e] * Ap; Qm[e8] = -kka[e] * iA; Km[e8] = kp[e] * iA; Rm[e8] = zr[e] * A; acv[e8] = A; }
        v4u w;
        w.x = pk2(Pm[0], Pm[1]); w.y = pk2(Pm[2], Pm[3]); w.z = pk2(Pm[4], Pm[5]); w.w = pk2(Pm[6], Pm[7]); Pb[ks] = __builtin_bit_cast(bf16x8, w);
        w.x = pk2(Qm[0], Qm[1]); w.y = pk2(Qm[2], Qm[3]); w.z = pk2(Qm[4], Qm[5]); w.w = pk2(Qm[6], Qm[7]); Qb[ks] = __builtin_bit_cast(bf16x8, w);
        w.x = pk2(Km[0], Km[1]); w.y = pk2(Km[2], Km[3]); w.z = pk2(Km[4], Km[5]); w.w = pk2(Km[6], Km[7]); Kb[ks] = __builtin_bit_cast(bf16x8, w);
        w.x = pk2(Rm[0], Rm[1]); w.y = pk2(Rm[2], Rm[3]); w.z = pk2(Rm[4], Rm[5]); w.w = pk2(Rm[6], Rm[7]); Rb[ks] = __builtin_bit_cast(bf16x8, w);
        if (fr == 15) { *(f32x4*)(rec + CH_AC + (16 * fq + 8 * ks) * 4) = (f32x4){acv[0], acv[1], acv[2], acv[3]}; *(f32x4*)(rec + CH_AC + (16 * fq + 8 * ks + 4) * 4) = (f32x4){acv[4], acv[5], acv[6], acv[7]}; }
    }
    *(v4u*)(rec + CH_P + fr * CH_PP + 32 * fq) = __builtin_bit_cast(v4u, Pb[0]); *(v4u*)(rec + CH_P + fr * CH_PP + 32 * fq + 16) = __builtin_bit_cast(v4u, Pb[1]);
    *(v4u*)(rec + CH_R + fr * CH_PP + 32 * fq) = __builtin_bit_cast(v4u, Rb[0]); *(v4u*)(rec + CH_R + fr * CH_PP + 32 * fq + 16) = __builtin_bit_cast(v4u, Rb[1]);
    *(v4u*)(rec + CH_Q + (fq * 16 + fr) * 32) = __builtin_bit_cast(v4u, Qb[0]); *(v4u*)(rec + CH_Q + (fq * 16 + fr) * 32 + 16) = __builtin_bit_cast(v4u, Qb[1]);
    *(v4u*)(rec + CH_K + (fq * 16 + fr) * 32) = __builtin_bit_cast(v4u, Kb[0]); *(v4u*)(rec + CH_K + (fq * 16 + fr) * 32 + 16) = __builtin_bit_cast(v4u, Kb[1]);
    f32x4 gqp = (f32x4){0.f, 0.f, 0.f, 0.f}, gkp = gqp, gqr = gqp, gkr = gqp;
#pragma unroll
    for (int ks = 0; ks < 2; ++ks) { gqp = MFMA16(Qb[ks], Pb[ks], gqp); gkp = MFMA16(Kb[ks], Pb[ks], gkp); gqr = MFMA16(Qb[ks], Rb[ks], gqr); gkr = MFMA16(Kb[ks], Rb[ks], gkr); }
#pragma unroll
    for (int rg = 0; rg < 4; ++rg) { const int s = 4 * fq + rg; if (!(s < fr)) { gqp[rg] = 0.f; gkp[rg] = 0.f; } if (!(s <= fr)) { gqr[rg] = 0.f; gkr[rg] = 0.f; } }
    *(v2u*)(rec + CH_G + 0 * 512 + (fr * 16 + 4 * fq) * 2) = pk4(gkp);
    *(v2u*)(rec + CH_G + 2 * 512 + (fr * 16 + 4 * fq) * 2) = pk4(gqr);
    *(v2u*)(rec + CH_G + 3 * 512 + (fr * 16 + 4 * fq) * 2) = pk4(gkr);
    LAS float* Nl = (LAS float*)(F.lds + F.wave * 4096);
#pragma unroll
    for (int rg = 0; rg < 4; ++rg) Nl[(4 * fq + rg) * 20 + fr] = gqp[rg];
    LDS_WAIT(); __builtin_amdgcn_wave_barrier(); asm volatile("" ::: "memory");
    float Tc[16];
#pragma unroll
    for (int s = 15; s >= 0; --s) {
        float acc = 0.f;
#pragma unroll
        for (int q4 = 0; q4 < 4; ++q4) if (4 * q4 + 3 > s) { const f32x4 nv = *(const LAS f32x4*)(Nl + s * 20 + 4 * q4);
#pragma unroll
            for (int u = 0; u < 4; ++u) if (4 * q4 + u > s) acc += nv[u] * Tc[4 * q4 + u]; }
        Tc[s] = (s == fr) ? 1.0f : acc; }
    { f32x4 tv;
#pragma unroll
      for (int u = 0; u < 4; ++u) tv[u] = fq == 0 ? Tc[u] : (fq == 1 ? Tc[4 + u] : (fq == 2 ? Tc[8 + u] : Tc[12 + u]));
      *(v2u*)(rec + CH_G + 1 * 512 + (fr * 16 + 4 * fq) * 2) = pk4(tv); }
    LDS_WAIT(); __builtin_amdgcn_wave_barrier(); asm volatile("" ::: "memory");
#undef PREP_MM
#undef PREP_UNP
}
__device__ __forceinline__ void prep_fill_par(Frame& F, LAS float* par, int h) {
    const int l = F.lane; const float* mu = F.ap->in[4];
    par[0 * 64 + l] = mu[ZC_R + h * 64 + l]; par[1 * 64 + l] = mu[ZC_K + h * 64 + l]; par[2 * 64 + l] = mu[ZC_V + h * 64 + l];
    par[3 * 64 + l] = F.ap->in[5][h * 64 + l]; par[4 * 64 + l] = F.ap->in[7][h * 64 + l]; par[5 * 64 + l] = F.ap->in[10][h * 64 + l]; par[6 * 64 + l] = F.ap->in[11][h * 64 + l]; par[7 * 64 + l] = F.ap->in[12][h * 64 + l];
    LDS_WAIT(); __builtin_amdgcn_wave_barrier(); asm volatile("" ::: "memory");
}

__device__ __forceinline__ float nsa_slope(int g, int r) { return __uint_as_float((unsigned)(127 - (g * 4 + r + 1)) << 23); }

constexpr int CMP_KC_OFF = 32768, CMP_KP = 144, CMP_VC_OFF = CMP_KC_OFF + 128 * CMP_KP, CMP_VP = 264;
__device__ __forceinline__ void nsa_cmp_stage(Frame& F, int bg) {
    const bf16* kcmp = (const bf16*)(F.ws + WS_KCMP) + (size_t)bg * 128 * 64; const bf16* vcmpT = (const bf16*)(F.ws + WS_KCMP + 512 * 1024) + (size_t)bg * 64 * 128;
    v4u a[2], v[2];
#pragma unroll
    for (int i = 0; i < 2; ++i) { const int id = F.tid + 512 * i; a[i] = *(const v4u*)(kcmp + (size_t)(id >> 3) * 64 + (id & 7) * 8); v[i] = *(const v4u*)(vcmpT + (size_t)(id >> 4) * 128 + (id & 15) * 8); }
#pragma unroll
    for (int i = 0; i < 2; ++i) { const int id = F.tid + 512 * i; *(LAS v4u*)(F.lds + CMP_KC_OFF + (id >> 3) * CMP_KP + (id & 7) * 16) = a[i]; *(LAS v4u*)(F.lds + CMP_VC_OFF + (id >> 4) * CMP_VP + (id & 15) * 16) = v[i]; }
}
template <int ABL>
__device__ __forceinline__ void nsa_cmp_task(Frame& F, int task) {
    const int tile = task & 127, bg = task >> 7, b = bg >> 1, g = bg & 1;
    const int fr = F.lane & 15, fq = F.lane >> 4, t = tile * 16 + fr, m = b * SEQ + t;
    const bf16* z = (const bf16*)(F.ws + WS_Z);
    const float* zg = (const float*)(F.ws + WS_ZGATE); const float* gb = F.ap->in[21];
    bf16* Y = (bf16*)(F.ws + WS_YB);
    bf16x8 qall[4][2]; float gl[4];
#pragma unroll
    for (int r = 0; r < 4; ++r) { const bf16* qp = z + (size_t)m * NZ + ZC_Q + (g * 4 + r) * 64 + 8 * fq; qall[r][0] = *(const bf16x8*)qp; qall[r][1] = *(const bf16x8*)(qp + 32);
        gl[r] = zg[(size_t)m * 32 + (g * 4 + r) * 3 + 0] + gb[(g * 4 + r) * 3 + 0]; }
    const LAS unsigned char* kc = F.lds + CMP_KC_OFF + fr * CMP_KP + 16 * fq; const LAS unsigned char* vc = F.lds + CMP_VC_OFF + fr * CMP_VP + 8 * fq;
    const int tv = t - 31 - 64 * fq; const float tb = (float)t - 15.5f - 64.0f * (float)fq;
    float impl[8], imp3[8];
#pragma unroll
    for (int kt = 0; kt < 8; ++kt) { impl[kt] = 0.f; imp3[kt] = 0.f; }
#pragma unroll
    for (int r = 0; r < 4; ++r) {
        const float slope = nsa_slope(g, r);
        const bf16x8 q0 = qall[r][0], q1 = qall[r][1];
        float s[8][4]; float mx = -1e30f;
#pragma unroll
        for (int kt = 0; kt < 8; ++kt) {
            f32x4 a = (f32x4){0.f, 0.f, 0.f, 0.f};
            a = MFMA16(*(const LAS bf16x8*)(kc + 16 * kt * CMP_KP), q0, a); a = MFMA16(*(const LAS bf16x8*)(kc + 16 * kt * CMP_KP + 64), q1, a);
#pragma unroll
            for (int rg = 0; rg < 4; ++rg) { const bool valid = ((256 * kt + 16 * rg) <= tv);
                const float sc = a[rg] * 0.125f - slope * (tb - (float)(256 * kt + 16 * rg)); s[kt][rg] = valid ? sc : -1e30f; mx = fmaxf(mx, s[kt][rg]); }
        }
        mx = fmaxf(mx, __shfl_xor(mx, 16)); mx = fmaxf(mx, __shfl_xor(mx, 32));
        float sum = 0.f;
#pragma unroll
        for (int kt = 0; kt < 8; ++kt)
#pragma unroll
            for (int rg = 0; rg < 4; ++rg) { const float p = (s[kt][rg] > -1e29f) ? __expf(s[kt][rg] - mx) : 0.f; s[kt][rg] = p; sum += p; }
        sum += __shfl_xor(sum, 16); sum += __shfl_xor(sum, 32);
        const float inv = sum > 0.f ? 1.0f / sum : 0.f;
#pragma unroll
        for (int kt = 0; kt < 8; ++kt) {
#pragma unroll
            for (int rg = 0; rg < 4; ++rg) s[kt][rg] *= inv;
            impl[kt] += s[kt][0] + s[kt][1] + s[kt][2] + 0.5f * s[kt][3]; imp3[kt] += s[kt][3]; }
        f32x4 o[4];
#pragma unroll
        for (int dt = 0; dt < 4; ++dt) o[dt] = (f32x4){0.f, 0.f, 0.f, 0.f};
#pragma unroll
        for (int s2 = 0; s2 < 4; ++s2) {
            v4u pw; pw.x = pk2(s[2 * s2][0], s[2 * s2][1]); pw.y = pk2(s[2 * s2][2], s[2 * s2][3]); pw.z = pk2(s[2 * s2 + 1][0], s[2 * s2 + 1][1]); pw.w = pk2(s[2 * s2 + 1][2], s[2 * s2 + 1][3]);
            const bf16x8 pb = __builtin_bit_cast(bf16x8, pw);
#pragma unroll
            for (int dt = 0; dt < 4; ++dt) { const LAS unsigned char* vp = vc + 16 * dt * CMP_VP + 64 * s2; const v2u lo = *(const LAS v2u*)vp, hi = *(const LAS v2u*)(vp + 32);
                v4u aw; aw.x = lo.x; aw.y = lo.y; aw.z = hi.x; aw.w = hi.y; o[dt] = MFMA16(__builtin_bit_cast(bf16x8, aw), pb, o[dt]); }
        }
        const int hh = g * 4 + r; const float gate = sigmoidf_(gl[r]);
#pragma unroll
        for (int dt = 0; dt < 4; ++dt) *(v2u*)(Y + (size_t)m * 512 + hh * 64 + 16 * dt + 4 * fq) = pk4(o[dt] * gate);
        __builtin_amdgcn_sched_barrier(0);
    }
    if (ABL == 1) return;
    LAS float* sc = (LAS float*)(F.lds + F.wave * 4096);
    float y3prev = 0.f;
#pragma unroll
    for (int kt = 0; kt < 8; ++kt) {
        const float y3 = __shfl(imp3[kt], (F.lane + 48) & 63);
        const float prev = (fq > 0) ? y3 : y3prev; y3prev = y3;
        sc[fr * 33 + 4 * kt + fq] = impl[kt] + 0.5f * prev;
    }
    LDS_WAIT(); __builtin_amdgcn_wave_barrier(); asm volatile("" ::: "memory");
    const int blk_t = t >> 6, chi = blk_t - 2;
    unsigned mask = 1u | (1u << blk_t) | (blk_t > 0 ? (1u << (blk_t - 1)) : 0u);
#pragma unroll
    for (int kt = 0; kt < 8; ++kt) {
        const int k = 4 * kt + fq;
        if (k >= 1 && k <= chi) { const float me = sc[fr * 33 + k]; int rank = 0;
            for (int k2 = 1; k2 <= chi; ++k2) { const float o = sc[fr * 33 + k2]; rank += (o > me || (o == me && k2 < k)) ? 1 : 0; }
            if (rank < 5) mask |= (1u << k); }
    }
    mask |= (unsigned)__shfl_xor((int)mask, 16); mask |= (unsigned)__shfl_xor((int)mask, 32);
    if (fq == 0) ((unsigned*)(F.ws + WS_SELMASK))[(size_t)bg * SEQ + t] = mask;
    LDS_WAIT(); __builtin_amdgcn_wave_barrier(); asm volatile("" ::: "memory");
}
__device__ __forceinline__ void p3_phase(Frame& F) {
    constexpr int T0 = 2048, T1 = T0 + 8192;
#ifdef DUP_P3A
    for (int task = F.gw; task < T0; task += F.NGW) { __syncthreads(); nsa_cmp_stage(F, task >> 7); LDS_WAIT(); __syncthreads(); nsa_cmp_task<DUP_P3A>(F, task); }
    asm volatile("" ::: "memory");
#endif
    for (int task = F.gw; task < T0; task += F.NGW) { __syncthreads(); nsa_cmp_stage(F, task >> 7); LDS_WAIT(); __syncthreads(); nsa_cmp_task<0>(F, task); }
    asm volatile("" ::: "memory");
    const int h = F.vcu & 7;
    LAS float* par = (LAS float*)(F.lds + F.wave * 4096 + 2048);
    __syncthreads();
    prep_fill_par(F, par, h); prep_stage_w(F, h);
    LDS_WAIT(); __syncthreads();
#ifdef DUP_P3B
    for (int i = F.wave; i < 32; i += 8) rwkv_prep_task(F, (((F.vcu >> 3) + 32 * i) << 3) | h, par);
    asm volatile("" ::: "memory");
#endif
    for (int i = F.wave; i < 32; i += 8) rwkv_prep_task(F, (((F.vcu >> 3) + 32 * i) << 3) | h, par);
}

constexpr int NSA_KP = 144, NSA_VP = 136, NSA_BUF = 64 * NSA_KP + 64 * NSA_VP, NSA_CTL = 2 * NSA_BUF + 1024;
struct NsaState { f32x4 O[2][4]; float mrun[2], lrun[2]; };
template <int WHICH, bool MASKED>
__device__ __forceinline__ void nsa_block(NsaState& St, const LAS unsigned char* kb_, const LAS unsigned char* vb_, const bf16x8 (&qf)[2][2], int kb, unsigned mymask, int t, int fq, float slope0) {
    const int kpos0 = 64 * kb;
    bf16x8 kf[4][2];
#pragma unroll
    for (int kt = 0; kt < 4; ++kt) { kf[kt][0] = *(const LAS bf16x8*)(kb_ + 16 * kt * NSA_KP); kf[kt][1] = *(const LAS bf16x8*)(kb_ + 16 * kt * NSA_KP + 64); }
    const bool bsel = (mymask >> kb) & 1u; const int dbase = t - 4 * fq - kpos0;
    const float fdb = (float)dbase;
    bf16x8 P[2][2];
#pragma unroll
    for (int r = 0; r < 2; ++r) {
        const float slope = r ? 0.5f * slope0 : slope0;
        float s[4][4]; float bm = -1e30f;
        float base = -slope * fdb;
        const float s1 = slope, s2_ = 2.0f * slope, s3 = 3.0f * slope, s16 = 16.0f * slope;
#pragma unroll
        for (int kt = 0; kt < 4; ++kt) { f32x4 a = (f32x4){base, base + s1, base + s2_, base + s3}; base += s16;
            a = MFMA16(kf[kt][0], qf[r][0], a); a = MFMA16(kf[kt][1], qf[r][1], a);
#pragma unroll
            for (int rg = 0; rg < 4; ++rg) {
                if (MASKED) { const int dist = dbase - (16 * kt + rg); const bool valid = bsel && dist >= 0 && (WHICH == 0 || dist < 512); s[kt][rg] = valid ? a[rg] : -1e30f; }
                else s[kt][rg] = a[rg];
                bm = fmaxf(bm, s[kt][rg]); } }
        bm = fmaxf(bm, __shfl_xor(bm, 16)); bm = fmaxf(bm, __shfl_xor(bm, 32));
        const float mnew = fmaxf(St.mrun[r], bm); const float scale = __builtin_amdgcn_exp2f(St.mrun[r] - mnew); St.mrun[r] = mnew;
        float ps = 0.f;
#pragma unroll
        for (int kt = 0; kt < 4; ++kt)
#pragma unroll
            for (int rg = 0; rg < 4; ++rg) { float p = __builtin_amdgcn_exp2f(s[kt][rg] - mnew); if (MASKED) p = (s[kt][rg] > -1e29f) ? p : 0.f; s[kt][rg] = p; ps += p; }
        St.lrun[r] = St.lrun[r] * scale + ps;
#pragma unroll
        for (int dt = 0; dt < 4; ++dt) St.O[r][dt] = St.O[r][dt] * scale;
#pragma unroll
        for (int s2 = 0; s2 < 2; ++s2) { v4u pw; pw.x = pk2(s[2 * s2][0], s[2 * s2][1]); pw.y = pk2(s[2 * s2][2], s[2 * s2][3]); pw.z = pk2(s[2 * s2 + 1][0], s[2 * s2 + 1][1]); pw.w = pk2(s[2 * s2 + 1][2], s[2 * s2 + 1][3]);
            P[r][s2] = __builtin_bit_cast(bf16x8, pw); }
    }
#pragma unroll
    for (int dt = 0; dt < 4; ++dt)
#pragma unroll
        for (int s2 = 0; s2 < 2; ++s2) { const LAS unsigned char* vp = vb_ + 16 * dt * NSA_VP + 64 * s2; const v2u lo = *(const LAS v2u*)vp, hi = *(const LAS v2u*)(vp + 32);
            v4u aw; aw.x = lo.x; aw.y = lo.y; aw.z = hi.x; aw.w = hi.y; const bf16x8 vf = __builtin_bit_cast(bf16x8, aw);
#pragma unroll
            for (int r = 0; r < 2; ++r) St.O[r][dt] = MFMA16(vf, P[r][s2], St.O[r][dt]); }
}
template <int WHICH>
__device__ __forceinline__ void nsa_wg_task(Frame& F, int item) {
    const int hp = item & 1, bg = item >> 5, tg = (item >> 1) & 15, b = bg >> 1, g = bg & 1;
    const int fr = F.lane & 15, fq = F.lane >> 4, tile = tg * 8 + F.wave, t0 = tile * 16, t = t0 + fr, m = b * SEQ + t;
    const int h0 = g * 4 + 2 * hp;
    const bf16* z = (const bf16*)(F.ws + WS_Z);
    const bf16* Kb = z + (size_t)b * SEQ * NZ + (WHICH ? ZC_KW : ZC_KS) + g * 64;
    const bf16* VT = (const bf16*)(F.ws + (WHICH ? WS_VWT : WS_VST)) + (size_t)bg * 64 * SEQ;
    unsigned mymask, tile_or, full; const int kb_hi = (t0 + 15) >> 6;
    if (WHICH == 0) { mymask = ((const unsigned*)(F.ws + WS_SELMASK))[(size_t)bg * SEQ + t]; unsigned x = mymask, y = mymask;
        x |= (unsigned)__shfl_xor((int)x, 1); x |= (unsigned)__shfl_xor((int)x, 2); x |= (unsigned)__shfl_xor((int)x, 4); x |= (unsigned)__shfl_xor((int)x, 8);
        y &= (unsigned)__shfl_xor((int)y, 1); y &= (unsigned)__shfl_xor((int)y, 2); y &= (unsigned)__shfl_xor((int)y, 4); y &= (unsigned)__shfl_xor((int)y, 8);
        tile_or = (unsigned)__builtin_amdgcn_readfirstlane((int)x); full = (unsigned)__builtin_amdgcn_readfirstlane((int)y) & ((1u << kb_hi) - 1u); }
    else { mymask = 0xffffffffu; const int lo = (t0 - 511) > 0 ? ((t0 - 511) >> 6) : 0; tile_or = 0u; full = 0u;
        for (int k = lo; k <= kb_hi; ++k) { tile_or |= (1u << k); if (k < kb_hi && 64 * k >= t0 - 496) full |= (1u << k); } }
    tile_or &= (kb_hi >= 31) ? 0xffffffffu : ((2u << kb_hi) - 1u);
    LAS unsigned* ctl = (LAS unsigned*)(F.lds + NSA_CTL);
    __syncthreads();
    if (F.lane == 0) ctl[F.wave] = tile_or;
    LDS_WAIT(); __syncthreads();
    unsigned rem = 0u;
#pragma unroll
    for (int w = 0; w < 8; ++w) rem |= ctl[w];
    rem = (unsigned)__builtin_amdgcn_readfirstlane((int)rem);
    bf16x8 qf[2][2];
#pragma unroll
    for (int r = 0; r < 2; ++r)
#pragma unroll
        for (int ks = 0; ks < 2; ++ks) { const v4u raw = *(const v4u*)(z + (size_t)m * NZ + ZC_Q + (h0 + r) * 64 + 8 * fq + 32 * ks); float f[8]; unpk8(raw, f);
            constexpr float QS = 0.125f * 1.4426950408889634f; v4u w; w.x = pk2(f[0] * QS, f[1] * QS); w.y = pk2(f[2] * QS, f[3] * QS); w.z = pk2(f[4] * QS, f[5] * QS); w.w = pk2(f[6] * QS, f[7] * QS);
            qf[r][ks] = __builtin_bit_cast(bf16x8, w); }
    NsaState St;
#pragma unroll
    for (int r = 0; r < 2; ++r) { St.mrun[r] = -1e30f; St.lrun[r] = 0.f;
#pragma unroll
        for (int dt = 0; dt < 4; ++dt) St.O[r][dt] = (f32x4){0.f, 0.f, 0.f, 0.f}; }
    const float slope0 = 1.4426950408889634f * __uint_as_float((unsigned)(127 - (h0 + 1)) << 23);
    const int srow = F.tid >> 3, sc = F.tid & 7;
    const bf16* ksrc = Kb + (size_t)srow * NZ + sc * 8; const bf16* vsrc = VT + (size_t)srow * SEQ + sc * 8;
    const int kdst = srow * NSA_KP + sc * 16, vdst = 64 * NSA_KP + srow * NSA_VP + sc * 16;
    const LAS unsigned char* kfr = F.lds + fr * NSA_KP + 16 * fq; const LAS unsigned char* vfr = F.lds + 64 * NSA_KP + fr * NSA_VP + 8 * fq;
    int kb = __builtin_ctz(rem); rem &= rem - 1u;
    v4u kreg = *(const v4u*)(ksrc + (size_t)64 * kb * NZ), vreg = *(const v4u*)(vsrc + 64 * kb);
    *(LAS v4u*)(F.lds + kdst) = kreg; *(LAS v2u*)(F.lds + vdst) = (v2u){vreg.x, vreg.y}; *(LAS v2u*)(F.lds + vdst + 8) = (v2u){vreg.z, vreg.w};
    LDS_WAIT(); __syncthreads();
    int buf = 0;
    for (;;) {
        int kbn = -1;
        if (rem) { kbn = __builtin_ctz(rem); rem &= rem - 1u; kreg = *(const v4u*)(ksrc + (size_t)64 * kbn * NZ); vreg = *(const v4u*)(vsrc + 64 * kbn); }
        __builtin_amdgcn_sched_barrier(0);
        if ((tile_or >> kb) & 1u) {
            if ((full >> kb) & 1u) nsa_block<WHICH, false>(St, kfr + buf * NSA_BUF, vfr + buf * NSA_BUF, qf, kb, mymask, t, fq, slope0);
            else nsa_block<WHICH, true>(St, kfr + buf * NSA_BUF, vfr + buf * NSA_BUF, qf, kb, mymask, t, fq, slope0);
        }
        __builtin_amdgcn_sched_barrier(0);
        if (kbn < 0) break;
        buf ^= 1;
        *(LAS v4u*)(F.lds + buf * NSA_BUF + kdst) = kreg; *(LAS v2u*)(F.lds + buf * NSA_BUF + vdst) = (v2u){vreg.x, vreg.y}; *(LAS v2u*)(F.lds + buf * NSA_BUF + vdst + 8) = (v2u){vreg.z, vreg.w};
        LDS_WAIT(); __syncthreads();
        kb = kbn;
    }
    const float* zg = (const float*)(F.ws + WS_ZGATE); const float* gb = F.ap->in[21];
    bf16* Y = (bf16*)(F.ws + WS_YB + (size_t)(1 + WHICH) * 16 * MiB);
#pragma unroll
    for (int r = 0; r < 2; ++r) { float l = St.lrun[r]; l += __shfl_xor(l, 16); l += __shfl_xor(l, 32);
        const int hh = h0 + r; const float gate = sigmoidf_(zg[(size_t)m * 32 + hh * 3 + 1 + WHICH] + gb[hh * 3 + 1 + WHICH]); const float f = gate / l;
#pragma unroll
        for (int dt = 0; dt < 4; ++dt) *(v2u*)(Y + (size_t)m * 512 + hh * 64 + 16 * dt + 4 * fq) = pk4(St.O[r][dt] * f); }
}
__device__ __forceinline__ void p4_phase(Frame& F) {
    for (int it = F.vcu; it < 512; it += F.G) { nsa_wg_task<1>(F, it); nsa_wg_task<0>(F, 511 - it); }
}

typedef short v4i16_t __attribute__((ext_vector_type(4)));
__device__ __forceinline__ bf16x8 tr_lo(const LAS unsigned char* p) {
    const v4i16_t t = __builtin_amdgcn_ds_read_tr16_b64_v4i16((LAS v4i16_t*)p);
    return (bf16x8){t[0], t[1], t[2], t[3], 0, 0, 0, 0};
}
__device__ __forceinline__ bf16x8 lo4(v2u g) { v4u w; w.x = g.x; w.y = g.y; w.z = 0u; w.w = 0u; return __builtin_bit_cast(bf16x8, w); }
__device__ __forceinline__ bf16x8 cat8(v2u a, v2u b) { v4u w; w.x = a.x; w.y = a.y; w.z = b.x; w.w = b.y; return __builtin_bit_cast(bf16x8, w); }
struct ChunkOps { v2u pA[2][2], rA[2][2], g[4]; f32x4 ac[4]; bf16x8 aq[4], ak[4], bv; };
__device__ __forceinline__ void chunk_load(const LAS unsigned char* sl, ChunkOps& X, int lane) {
    const int fr = lane & 15, fq = lane >> 4;
#pragma unroll
    for (int m = 0; m < 2; ++m) { X.pA[m][0] = *(const LAS v2u*)(sl + CH_P + fr * CH_PP + 64 * m + 8 * fq); X.pA[m][1] = *(const LAS v2u*)(sl + CH_P + fr * CH_PP + 64 * m + 32 + 8 * fq);
        X.rA[m][0] = *(const LAS v2u*)(sl + CH_R + fr * CH_PP + 64 * m + 8 * fq); X.rA[m][1] = *(const LAS v2u*)(sl + CH_R + fr * CH_PP + 64 * m + 32 + 8 * fq); }
#pragma unroll
    for (int x = 0; x < 4; ++x) X.g[x] = *(const LAS v2u*)(sl + CH_G + 512 * x + (fr * 16 + 4 * fq) * 2);
    X.bv = tr_lo(sl + CH_V + 8 * lane);
#pragma unroll
    for (int jt = 0; jt < 4; ++jt) { X.aq[jt] = tr_lo(sl + CH_Q + jt * 512 + 8 * lane); X.ak[jt] = tr_lo(sl + CH_K + jt * 512 + 8 * lane);
        X.ac[jt] = *(const LAS f32x4*)(sl + CH_AC + (16 * jt + 4 * fq) * 4); }
}
__device__ __forceinline__ bf16x8 lo4t(bf16x8 t) { return t; }
__device__ __forceinline__ void chunk_math(const ChunkOps& X, f32x4 (&S)[4], f32x4& o_out) {
    bf16x8 bs[2];
#pragma unroll
    for (int m = 0; m < 2; ++m) { v4u w; w.x = pk2(S[2 * m][0], S[2 * m][1]); w.y = pk2(S[2 * m][2], S[2 * m][3]); w.z = pk2(S[2 * m + 1][0], S[2 * m + 1][1]); w.w = pk2(S[2 * m + 1][2], S[2 * m + 1][3]); bs[m] = __builtin_bit_cast(bf16x8, w); }
    const f32x4 z4 = (f32x4){0.f, 0.f, 0.f, 0.f};
    const bf16x8 bv = lo4t(X.bv);
    f32x4 y = MFMA16(cat8(X.pA[0][0], X.pA[0][1]), bs[0], z4); y = MFMA16(cat8(X.pA[1][0], X.pA[1][1]), bs[1], y); y = MFMA16(lo4(X.g[0]), bv, y);
    f32x4 o = MFMA16(cat8(X.rA[0][0], X.rA[0][1]), bs[0], z4); o = MFMA16(cat8(X.rA[1][0], X.rA[1][1]), bs[1], o); o = MFMA16(lo4(X.g[3]), bv, o);
    const bf16x8 by = lo4(pk4(y));
    const f32x4 u = MFMA16(lo4(X.g[1]), by, z4);
    const bf16x8 bu = lo4(pk4(u));
    o_out = MFMA16(lo4(X.g[2]), bu, o);
#pragma unroll
    for (int jt = 0; jt < 4; ++jt) { S[jt] = MFMA16(lo4t(X.aq[jt]), bu, S[jt]); S[jt] = MFMA16(lo4t(X.ak[jt]), bv, S[jt]); S[jt] = S[jt] * X.ac[jt]; }
}
#ifndef SC_CONVW
#define SC_CONVW 3
#endif
constexpr int SC_NS = 7, SC_AHEAD = 5, SC_CTL = SC_NS * CH_SLOT, SCAN_TR_OFF = 81920;
__device__ __forceinline__ void scan_dma(const unsigned char* rec, const bf16* vt, LAS unsigned char* slot, int lane) {
#pragma unroll
    for (int i = 0; i < 10; ++i) __builtin_amdgcn_global_load_lds((const unsigned*)(rec + (lane + 64 * i) * 16), (LAS unsigned*)(slot + i * 1024), 16, 0, 0);
    if (lane < 48) __builtin_amdgcn_global_load_lds((const unsigned*)(rec + (lane + 640) * 16), (LAS unsigned*)(slot + 10240), 16, 0, 0);
    if (lane < 32) __builtin_amdgcn_global_load_lds((const unsigned*)(vt + (size_t)(lane >> 1) * 512 + 8 * (lane & 1)), (LAS unsigned*)(slot + CH_V), 16, 0, 0);
}
__device__ __forceinline__ int sc_ld(LAS int* p) { int v; const unsigned a = (unsigned)(size_t)p; asm volatile("ds_read_b32 %0, %1\n\ts_waitcnt lgkmcnt(0)" : "=&v"(v) : "v"(a) : "memory"); return v; }
__device__ __forceinline__ void sc_st(LAS int* p, int v) { const unsigned a = (unsigned)(size_t)p; asm volatile("ds_write_b32 %0, %1" :: "v"(a), "v"(v) : "memory"); }
#define SC_LD(p) sc_ld(p)
#define SC_ST(p, v) sc_st((p), (v))
__device__ __forceinline__ void p5_scan(Frame& F, bool extras = true, int abl = 0) {
    LAS int* ctl = (LAS int*)(F.lds + SC_CTL);
    if (F.tid < 4) ctl[F.tid] = 0;
    LDS_WAIT(); __syncthreads();
    constexpr int NKQ = (tri::NITEMS - tri::E12) / 256;
    LAS float* mytile = (LAS float*)(F.lds + SCAN_TR_OFF + F.wave * 8448);
    const int bh = F.vcu >> 2, b = bh >> 3, h = bh & 7, i0 = (F.vcu & 3) * 16;
    if (F.wave == 0) {
        if (abl & 1) return;
        __builtin_amdgcn_s_setprio(3);
        float* o0 = (float*)(F.ws + WS_XN) + (size_t)b * SEQ * 512 + h * 64 + i0;
        const int fr = F.lane & 15, fq = F.lane >> 4;
        f32x4 S[4];
#pragma unroll
        for (int jt = 0; jt < 4; ++jt) S[jt] = (f32x4){0.f, 0.f, 0.f, 0.f};
        ChunkOps XA, XB;
        while (SC_LD(&ctl[0]) <= 0) __builtin_amdgcn_s_sleep(1);
        asm volatile("" ::: "memory");
        chunk_load(F.lds, XA, F.lane);
        LDS_WAIT(); asm volatile("" ::: "memory");
        if (F.lane == 0) SC_ST(&ctl[1], 1);
#define SCAN_ITER(XC, XN_, c_) do { const int cc = (c_); \
            if (cc + 1 < 128) { while (SC_LD(&ctl[0]) <= cc + 1) __builtin_amdgcn_s_sleep(1); asm volatile("" ::: "memory"); chunk_load(F.lds + ((cc + 1) % SC_NS) * CH_SLOT, XN_, F.lane); } \
            __builtin_amdgcn_sched_barrier(0); \
            f32x4 o; chunk_math(XC, S, o); \
            __builtin_amdgcn_sched_barrier(0); \
            float* orow = o0 + (size_t)cc * 16 * 512; \
            _Pragma("unroll") for (int rg = 0; rg < 4; ++rg) { float* pp = orow + (size_t)(4 * fq + rg) * 512 + fr; const float vv = o[rg]; asm volatile("global_store_dword %0, %1, off" :: "v"(pp), "v"(vv) : "memory"); } \
            if (cc + 1 < 128) { LDS_WAIT(); asm volatile("" ::: "memory"); if (F.lane == 0) SC_ST(&ctl[1], cc + 2); } } while (0)
#pragma unroll 1
        for (int c = 0; c < 128; c += 2) { SCAN_ITER(XA, XB, c); SCAN_ITER(XB, XA, c + 1); }
#undef SCAN_ITER
        asm volatile("s_waitcnt vmcnt(0)" ::: "memory");
        __builtin_amdgcn_s_setprio(0);
        if (F.lane == 0) SC_ST(&ctl[3], 1);
        if (!(abl & 2)) tr_run_q(F, mytile, &ctl[2], tri::E12 + F.vcu, F.G, NKQ);
    } else if (F.wave == 1) {
        if (abl & 1) return;
        const unsigned char* rec0 = F.ws + WS_S + ((size_t)(b * 128) * 8 + h) * CH_REC;
        const bf16* vt0 = (const bf16*)F.out + (size_t)b * SEQ * 512 + h * 64 + i0;
        for (int n = 0; n < 128; ++n) {
            while (SC_LD(&ctl[1]) < n - SC_NS + 1) __builtin_amdgcn_s_sleep(1);
            asm volatile("" ::: "memory");
            scan_dma(rec0 + (size_t)n * 8 * CH_REC, vt0 + (size_t)n * 16 * 512, F.lds + (n % SC_NS) * CH_SLOT, F.lane);
            if (n >= SC_AHEAD) { asm volatile("s_waitcnt vmcnt(60)" ::: "memory"); if (F.lane == 0) SC_ST(&ctl[0], n - SC_AHEAD + 1); }
        }
        asm volatile("s_waitcnt vmcnt(48)" ::: "memory"); if (F.lane == 0) SC_ST(&ctl[0], 124);
        asm volatile("s_waitcnt vmcnt(36)" ::: "memory"); if (F.lane == 0) SC_ST(&ctl[0], 125);
        asm volatile("s_waitcnt vmcnt(24)" ::: "memory"); if (F.lane == 0) SC_ST(&ctl[0], 126);
        asm volatile("s_waitcnt vmcnt(12)" ::: "memory"); if (F.lane == 0) SC_ST(&ctl[0], 127);
        asm volatile("s_waitcnt vmcnt(0)" ::: "memory"); if (F.lane == 0) SC_ST(&ctl[0], 128);
        if (!(abl & 2)) { while (SC_LD(&ctl[3]) == 0) __builtin_amdgcn_s_sleep(8); tr_run_q(F, mytile, &ctl[2], tri::E12 + F.vcu, F.G, NKQ); }
    } else {
        const int w2 = F.vcu * 6 + (F.wave - 2), NW2 = F.G * 6;
        if (!(abl & 2) && F.wave - 2 < SC_CONVW) tr_run_q(F, mytile, &ctl[2], tri::E12 + F.vcu, F.G, NKQ);
        if (!extras) return;
        for (int mb = w2; mb < M; mb += 4 * NW2) {
            v4u a0[4], a1[4], a2[4];
#pragma unroll
            for (int u = 0; u < 4; ++u) { const int mr = (mb + u * NW2 < M) ? mb + u * NW2 : mb; const bf16* y0 = (const bf16*)(F.ws + WS_YB) + (size_t)mr * 512 + 8 * F.lane; a0[u] = *(const v4u*)y0; a1[u] = *(const v4u*)(y0 + 8 * MiB); a2[u] = *(const v4u*)(y0 + 16 * MiB); }
#pragma unroll
            for (int u = 0; u < 4; ++u) { float f0[8], f1[8], f2[8]; unpk8(a0[u], f0); unpk8(a1[u], f1); unpk8(a2[u], f2);
                v4u w; w.x = pk2(f0[0] + f1[0] + f2[0], f0[1] + f1[1] + f2[1]); w.y = pk2(f0[2] + f1[2] + f2[2], f0[3] + f1[3] + f2[3]); w.z = pk2(f0[4] + f1[4] + f2[4], f0[5] + f1[5] + f2[5]); w.w = pk2(f0[6] + f1[6] + f2[6], f0[7] + f1[7] + f2[7]);
                if (mb + u * NW2 < M) *(v4u*)((bf16*)(F.ws + WS_YB) + (size_t)(mb + u * NW2) * 512 + 8 * F.lane) = w; } }
        const float* p = F.ap->in[1]; bf16* PB = (bf16*)(F.ws + WS_PBF);
        constexpr size_t NV = (size_t)M * 256 / 4;
        for (size_t b0 = (size_t)w2 * 64 + F.lane; b0 < NV; b0 += (size_t)8 * NW2 * 64) {
            f32x4 pv[8];
#pragma unroll
            for (int i = 0; i < 8; ++i) { const size_t idx = b0 + (size_t)i * NW2 * 64; pv[i] = (idx < NV) ? *(const f32x4*)(p + idx * 4) : (f32x4){0.f, 0.f, 0.f, 0.f}; }
#pragma unroll
            for (int i = 0; i < 8; ++i) { const size_t idx = b0 + (size_t)i * NW2 * 64; if (idx < NV) *(v2u*)(PB + idx * 4) = pk4(pv[i]); } }
        if (!(abl & 2) && F.wave - 2 >= SC_CONVW) { while (SC_LD(&ctl[3]) == 0) __builtin_amdgcn_s_sleep(8); tr_run_q(F, mytile, &ctl[2], tri::E12 + F.vcu, F.G, NKQ); }
    }
}

struct P6Par { float lw[8], lb[8]; };
__device__ __forceinline__ void p6_rows2(Frame& F, int ma, int mb_, const P6Par& P) {
    const int l = F.lane, c = 8 * l, h = l >> 3;
    f32x4 oa[2][2]; v4u vv_[2], gg_[2]; float bsv[2];
#pragma unroll
    for (int u = 0; u < 2; ++u) { const int m = u ? mb_ : ma;
        const float* oraw = (const float*)(F.ws + WS_XN) + (size_t)m * 512 + c;
        oa[u][0] = *(const f32x4*)oraw; oa[u][1] = *(const f32x4*)(oraw + 4); bsv[u] = ((const float*)(F.ws + WS_BONUS))[(size_t)m * 8 + h];
        vv_[u] = *(const v4u*)((const bf16*)F.out + (size_t)m * 512 + c); gg_[u] = *(const v4u*)((const bf16*)(F.ws + WS_G) + (size_t)m * 512 + c);
    }
    __builtin_amdgcn_sched_barrier(0);
#pragma unroll
    for (int u = 0; u < 2; ++u) { const int m = u ? mb_ : ma;
        float o[8] = {oa[u][0].x, oa[u][0].y, oa[u][0].z, oa[u][0].w, oa[u][1].x, oa[u][1].y, oa[u][1].z, oa[u][1].w};
        float s = 0.f;
#pragma unroll
        for (int j = 0; j < 8; ++j) s += o[j];
        s += __shfl_xor(s, 1); s += __shfl_xor(s, 2); s += __shfl_xor(s, 4);
        const float mu = s * (1.f / 64.f); float q = 0.f;
#pragma unroll
        for (int j = 0; j < 8; ++j) { o[j] -= mu; q += o[j] * o[j]; }
        q += __shfl_xor(q, 1); q += __shfl_xor(q, 2); q += __shfl_xor(q, 4);
        const float rstd = 1.0f / sqrtf(q * (1.f / 64.f) + GN_EPS);
        float vv[8], gg[8];
        unpk8(vv_[u], vv); unpk8(gg_[u], gg);
        const float bs = bsv[u];
        float y[8];
#pragma unroll
        for (int j = 0; j < 8; ++j) y[j] = (o[j] * rstd * P.lw[j] + P.lb[j] + bs * vv[j]) * gg[j];
        v4u w; w.x = pk2(y[0], y[1]); w.y = pk2(y[2], y[3]); w.z = pk2(y[4], y[5]); w.w = pk2(y[6], y[7]);
        *(v4u*)((bf16*)(F.ws + WS_YRW) + (size_t)m * 512 + c) = w;
    }
}
__device__ __forceinline__ void p6_phase(Frame& F) {
    const int l = F.lane, c = 8 * l;
    P6Par P;
#pragma unroll
    for (int j = 0; j < 8; ++j) { P.lw[j] = F.ap->in[13][c + j]; P.lb[j] = F.ap->in[14][c + j]; }
    for (int m = F.gw; m < M; m += 2 * F.NGW) p6_rows2(F, m, m + F.NGW, P);
}

struct RouteW { f32x4 wv[3][8]; };
__device__ __forceinline__ void route_ldx(Frame& F, int tile, v4u (&xv)[4]) {
    const int fr = F.lane & 15, fq = F.lane >> 4; const bf16* xp = (const bf16*)(F.ws + WS_Z) + (size_t)(tile * 16 + fr) * D + F.wave * 128 + 8 * fq;
#pragma unroll
    for (int g = 0; g < 4; ++g) xv[g] = *(const v4u*)(xp + 32 * g);
}
__device__ __forceinline__ void route_tile(Frame& F, int tile, const RouteW& W, const v4u (&xv_)[4], int par) {
    const int fr = F.lane & 15, fq = F.lane >> 4, m0 = tile * 16;
    f32x4 acc[3] = {(f32x4){0.f, 0.f, 0.f, 0.f}, (f32x4){0.f, 0.f, 0.f, 0.f}, (f32x4){0.f, 0.f, 0.f, 0.f}};
    float ssq = 0.f;
#pragma unroll
    for (int g2 = 0; g2 < 4; ++g2) {
        float xf[8]; unpk8(xv_[g2], xf);
#pragma unroll
        for (int hh = 0; hh < 2; ++hh) { const int g = 2 * g2 + hh;
            ssq += (xf[4 * hh] * xf[4 * hh] + xf[4 * hh + 1] * xf[4 * hh + 1]) + (xf[4 * hh + 2] * xf[4 * hh + 2] + xf[4 * hh + 3] * xf[4 * hh + 3]);
#pragma unroll
            for (int s = 0; s < 4; ++s)
#pragma unroll
                for (int ct = 0; ct < 3; ++ct) acc[ct] = __builtin_amdgcn_mfma_f32_16x16x4f32(W.wv[ct][g][s], xf[4 * hh + s], acc[ct], 0, 0, 0); }
    }
    ssq += __shfl_xor(ssq, 16); ssq += __shfl_xor(ssq, 32);
    LAS float* red = (LAS float*)(F.lds + par * 32768);
    LAS float* ssqb = red + 8 * 3 * 64 * 4; LAS float* rsb = ssqb + 128;
#pragma unroll
    for (int ct = 0; ct < 3; ++ct) *(LAS f32x4*)(red + ((F.wave * 3 + ct) * 64 + F.lane) * 4) = acc[ct];
    if (fq == 0) ssqb[F.wave * 16 + fr] = ssq;
    LDS_WAIT(); __syncthreads();
    if (F.wave == 0) { float st = 0.f;
#pragma unroll
      for (int w = 0; w < 8; ++w) st += ssqb[w * 16 + (F.lane & 15)];
      const float rs = 1.0f / sqrtf(st * (1.f / D) + NORM_EPS);
      if (fq == 0) ((float*)(F.ws + WS_RSE))[m0 + fr] = rs;
#pragma unroll
      for (int ct = 0; ct < 3; ++ct) { f32x4 t = (f32x4){0.f, 0.f, 0.f, 0.f};
#pragma unroll
          for (int w = 0; w < 8; ++w) t = t + *(const LAS f32x4*)(red + ((w * 3 + ct) * 64 + F.lane) * 4);
          *(f32x4*)((float*)(F.ws + WS_LOGITS) + (size_t)(m0 + fr) * 48 + 16 * ct + 4 * fq) = t * rs; } }
}
__device__ __forceinline__ void p9_phase(Frame& F, int rep_ = 0) {
    const int fr = F.lane & 15, fq = F.lane >> 4;
    RouteW W;
    { const float* wp = (const float*)(F.ws + WS_SMALLW + SW_ROUTEW) + (size_t)fr * D + F.wave * 128 + 8 * fq;
#pragma unroll
      for (int ct = 0; ct < 3; ++ct)
#pragma unroll
          for (int g = 0; g < 8; ++g) W.wv[ct][g] = *(const f32x4*)(wp + (size_t)ct * 16 * D + 32 * (g >> 1) + 4 * (g & 1)); }
    v4u xa[4], xb[4];
    int tile = F.vcu, par = 0;
    if (tile < 1024) route_ldx(F, tile, xa);
    while (tile < 1024) {
        const int nt = tile + F.G;
        if (nt < 1024) route_ldx(F, nt, xb);
        __builtin_amdgcn_sched_barrier(0);
        route_tile(F, tile, W, xa, par);
#pragma unroll
        for (int g = 0; g < 4; ++g) xa[g] = xb[g];
        tile = nt; par ^= 1;
    }
}

__device__ __forceinline__ void p9b_phase(Frame& F) {
    if (F.wave != 0) return;
    for (int base = F.vcu * 64; base < M; base += F.G * 64) {
        const int tok = base + F.lane;
        const float* lgp = (const float*)(F.ws + WS_LOGITS) + (size_t)tok * 48;
        float lg[36];
#pragma unroll
        for (int q = 0; q < 9; ++q) { const f32x4 v = *(const f32x4*)(lgp + 4 * q); lg[4 * q] = v.x; lg[4 * q + 1] = v.y; lg[4 * q + 2] = v.z; lg[4 * q + 3] = v.w; }
        const float* bg = F.ap->in[27]; const float* br = F.ap->in[29];
        float gl[4]; int gs = 0; float gm = -3.0e38f;
#pragma unroll
        for (int c = 0; c < 4; ++c) { gl[c] = lg[c] + bg[c]; if (gl[c] > gm) { gm = gl[c]; gs = c; } }
        float gsum = 0.f;
#pragma unroll
        for (int c = 0; c < 4; ++c) gsum += __expf(gl[c] - gm);
        const float pgroup = 1.0f / gsum;
        float el[8]; float em = -3.0e38f;
#pragma unroll
        for (int c = 0; c < 8; ++c) { const float lv = gs == 0 ? lg[4 + c] : (gs == 1 ? lg[12 + c] : (gs == 2 ? lg[20 + c] : lg[28 + c])); el[c] = lv + br[gs * 8 + c]; em = fmaxf(em, el[c]); }
        int i1 = 0; float v1 = -3.0e38f;
#pragma unroll
        for (int c = 0; c < 8; ++c) if (el[c] > v1) { v1 = el[c]; i1 = c; }
        int i2 = 0; float v2 = -3.0e38f;
#pragma unroll
        for (int c = 0; c < 8; ++c) if (c != i1 && el[c] > v2) { v2 = el[c]; i2 = c; }
        const float p1 = __expf(v1 - em), p2 = __expf(v2 - em);
        const float g1 = pgroup * p1 / (p1 + p2), g2 = pgroup * p2 / (p1 + p2);
        const int e1 = gs * 8 + i1, e2 = gs * 8 + i2;
        const unsigned long long lt = (1ull << F.lane) - 1ull;
        int r1 = 0, r2 = 0, mycnt = 0;
        for (int e = 0; e < 32; ++e) {
            const unsigned long long m1 = __ballot(e1 == e), m2 = __ballot(e2 == e);
            const int c1 = __popcll(m1), c2 = __popcll(m2);
            if (e1 == e) r1 = __popcll(m1 & lt);
            if (e2 == e) r2 = c1 + __popcll(m2 & lt);
            if (F.lane == e) mycnt = c1 + c2;
        }
        unsigned* cnt = (unsigned*)(F.ws + WS_CTL) + CW_CNT; int* list = (int*)(F.ws + WS_LIST); float* gateA = (float*)(F.ws + WS_GATEA); unsigned* slotA = (unsigned*)(F.ws + WS_SLOTA);
        int bs = 0;
        if (F.lane < 32 && mycnt > 0) bs = (int)atomicAdd(&cnt[F.lane], (unsigned)mycnt);
        const unsigned q1 = (unsigned)(__shfl(bs, e1) + r1), q2 = (unsigned)(__shfl(bs, e2) + r2);
        gateA[tok * 2 + 0] = g1; gateA[tok * 2 + 1] = g2;
        list[(size_t)e1 * 16384 + q1] = tok * 2 + 0; slotA[tok * 2 + 0] = ((unsigned)e1 << 16) | q1;
        list[(size_t)e2 * 16384 + q2] = tok * 2 + 1; slotA[tok * 2 + 1] = ((unsigned)e2 << 16) | q2;
    }
}

__device__ __forceinline__ void p12_rows2(Frame& F, int ma, int mb_, int prelane) {
    const unsigned* slotA = (const unsigned*)(F.ws + WS_SLOTA); const float* gateA = (const float*)(F.ws + WS_GATEA);
    unsigned sl[2][2]; float gt[2][2];
#pragma unroll
    for (int u = 0; u < 2; ++u) { const int m = u ? mb_ : ma; sl[u][0] = slotA[2 * m]; sl[u][1] = slotA[2 * m + 1]; gt[u][0] = gateA[2 * m]; gt[u][1] = gateA[2 * m + 1]; }
    f32x4 xv[2][4]; v2u cv[2][2][4]; float se[2];
#pragma unroll
    for (int u = 0; u < 2; ++u) { const int m = u ? mb_ : ma;
        const bf16* x1 = (const bf16*)(F.ws + WS_Z) + (size_t)m * D;
        se[u] = (F.lane < 16) ? ((const float*)(F.ws + WS_ZGATE + 1 * MiB))[(size_t)m * 16 + F.lane] : 0.f;
#pragma unroll
        for (int j = 0; j < 4; ++j) { const int o = 4 * F.lane + 256 * j; xv[u][j] = unpk4(*(const v2u*)(x1 + o)); }
#pragma unroll
        for (int k = 0; k < 2; ++k) { const unsigned s = (unsigned)__builtin_amdgcn_readfirstlane((int)sl[u][k]); const int pre = __builtin_amdgcn_readlane(prelane, (int)(s >> 16));
            const bf16* cp = (const bf16*)(F.ws + WS_Z + 64 * MiB) + ((size_t)pre * 256 + (s & 0xffffu)) * D;
#pragma unroll
            for (int j = 0; j < 4; ++j) cv[u][k][j] = *(const v2u*)(cp + 4 * F.lane + 256 * j); } }
    __builtin_amdgcn_sched_barrier(0);
    float s2[2];
#pragma unroll
    for (int u = 0; u < 2; ++u) { s2[u] = 0.f;
#pragma unroll
        for (int j = 0; j < 4; ++j) { xv[u][j] = xv[u][j] + unpk4(cv[u][0][j]) * gt[u][0] + unpk4(cv[u][1][j]) * gt[u][1];
            s2[u] += (xv[u][j].x * xv[u][j].x + xv[u][j].y * xv[u][j].y) + (xv[u][j].z * xv[u][j].z + xv[u][j].w * xv[u][j].w);
        } }
#pragma unroll
    for (int o = 1; o < 64; o <<= 1) {
#pragma unroll
        for (int u = 0; u < 2; ++u) { s2[u] += __shfl_xor(s2[u], o); se[u] += __shfl_xor(se[u], o); } }
#pragma unroll
    for (int u = 0; u < 2; ++u) { const int m = u ? mb_ : ma;
        const float rs = 1.0f / sqrtf(s2[u] * (1.f / D) + NORM_EPS); const float rse = 1.0f / sqrtf(se[u] * (1.f / D) + NORM_EPS);
        bf16* x2 = (bf16*)(F.ws + WS_S) + (size_t)m * D; if (F.lane == 0) { ((float*)(F.ws + WS_RSE))[M + m] = rs; ((float*)(F.ws + WS_RSE))[2 * M + m] = rse; }
#pragma unroll
        for (int j = 0; j < 4; ++j) { const int o = 4 * F.lane + 256 * j; *(v2u*)(x2 + o) = pk4(xv[u][j]); }
    }
}
__device__ __forceinline__ void p12_phase(Frame& F) {
    const unsigned* cnt = (const unsigned*)(F.ws + WS_CTL) + CW_CNT;
    int nt = (F.lane < 32) ? (((int)cnt[F.lane & 31] + 255) >> 8) : 0;
    int incl = nt;
#pragma unroll
    for (int o = 1; o < 32; o <<= 1) { const int v = __shfl_up(incl, o); if (F.lane >= o) incl += v; }
    const int prelane = incl - nt;
    for (int m = F.gw; m < M; m += 2 * F.NGW) p12_rows2(F, m, m + F.NGW, prelane);
}
__device__ __forceinline__ void p14_rows4(Frame& F, int mb) {
    const float* gf = F.ap->in[36];
    f32x4 v[4][4]; float s[4];
#pragma unroll
    for (int u = 0; u < 4; ++u) { const bf16* xr = (const bf16*)(F.ws + WS_Z) + (size_t)(mb + u * F.NGW) * D;
#pragma unroll
        for (int j = 0; j < 4; ++j) v[u][j] = unpk4(*(const v2u*)(xr + 4 * F.lane + 256 * j)); }
#pragma unroll
    for (int u = 0; u < 4; ++u) { s[u] = 0.f;
#pragma unroll
        for (int j = 0; j < 4; ++j) s[u] += (v[u][j].x * v[u][j].x + v[u][j].y * v[u][j].y) + (v[u][j].z * v[u][j].z + v[u][j].w * v[u][j].w); }
#pragma unroll
    for (int o = 1; o < 64; o <<= 1) {
#pragma unroll
        for (int u = 0; u < 4; ++u) s[u] += __shfl_xor(s[u], o); }
#pragma unroll
    for (int u = 0; u < 4; ++u) { const float rs = 1.0f / sqrtf(s[u] * (1.f / D) + NORM_EPS); float* orow = F.out + (size_t)(mb + u * F.NGW) * D;
#pragma unroll
        for (int j = 0; j < 4; ++j) { const int o = 4 * F.lane + 256 * j; *(f32x4*)(orow + o) = v[u][j] * rs * *(const f32x4*)(gf + o); } }
}

#ifndef MK_ONE_LAUNCH
#define MK_ONE_LAUNCH 1
#endif
constexpr int N_PHASES = 14;
__global__ void __launch_bounds__(NWAVES * 64, 2) mk_fwd(Args args) {
    extern __shared__ __attribute__((aligned(16))) unsigned char lds[];
    Frame F;
    F.lds = (LAS unsigned char*)lds;
    F.tid = threadIdx.x; F.lane = F.tid & 63; F.wave = __builtin_amdgcn_readfirstlane(F.tid >> 6);
    F.G = gridDim.x; { const int bx = blockIdx.x; F.vcu = (F.G % 8 == 0) ? (bx % 8) * (F.G / 8) + bx / 8 : bx; }
    F.gw = F.vcu * NWAVES + F.wave; F.NGW = F.G * NWAVES;
    F.ws = args.ws; F.out = args.out;
    F.ap = (ArgsP)__builtin_amdgcn_kernarg_segment_ptr();
    unsigned char* ws = args.ws;
    const int lo = args.ph_lo, hi = args.ph_hi;
#ifdef ONLY
#define IN(k) ((k) == ONLY && lo <= (k) && (k) < hi)
#else
#define IN(k) (lo <= (k) && (k) < hi)
#endif
#if MK_ONE_LAUNCH
    if (F.tid < 16) ((LAS unsigned*)(F.lds + MISC_OFF))[F.tid] = 0u;
    __syncthreads();
    XcdBarrier bar = xcd_barrier_post((unsigned*)(ws + WS_CTL) + CW_BAR, (volatile LAS unsigned*)(F.lds + MISC_OFF));
#define GRID_BAR(k) do { if (IN(k) && IN((k) + 1)) { if ((k) == 12) cg::this_grid().sync(); else xcd_barrier(bar); } } while (0)
#else
#define GRID_BAR(k) do { } while (0)
#endif
    LAS unsigned char* L = F.lds;
#ifdef PROBE_A
    unsigned long long* tsb = (unsigned long long*)(ws + WS_CTL + 32768);
    int n_st = 0;
#define STAMP() do { if (blockIdx.x == 0 && F.tid == 0) tsb[n_st] = __builtin_amdgcn_s_memrealtime(); ++n_st; } while (0)
    STAMP();
#else
#define STAMP() do { } while (0)
#endif
    const bf16* z = (const bf16*)(ws + WS_Z);

    if (IN(0)) { p0_prologue(F); } GRID_BAR(0); STAMP();

    if (IN(1)) {
        pg8::Gemm g{(const bf16*)(ws + WS_XN), (const bf16*)(ws + WS_WIN), M, NZ, D, nullptr}; pg8::StaticOrder S; S.init(M, NZ, F.G, (int)blockIdx.x);
        EpiStoreBf16 E{(bf16*)(ws + WS_Z), NZ};
        pg8::gemm_phase<EpiStoreBf16, pg8::StaticOrder, true, false>(L, g, S, E);
    } GRID_BAR(1); STAMP();

    if (IN(2)) { p2_prep(F); } GRID_BAR(2); STAMP();
    if (IN(3)) { p3_phase(F); } GRID_BAR(3); STAMP();
    if (IN(4)) { p4_phase(F); } GRID_BAR(4); STAMP();
    if (IN(5)) { if (F.G == 256) p5_scan(F); } GRID_BAR(5); STAMP();
    if (IN(6)) { p6_phase(F); } GRID_BAR(6); STAMP();

    if (IN(7)) {
        pg8::Gemm g{(const bf16*)(ws + WS_YRW), (const bf16*)(ws + WS_UR), 2 * M, 2 * D, 512, nullptr}; DualOrder S; S.S.init(M, D, F.G, (int)blockIdx.x);
        EpiMix E{z, (bf16*)(ws + WS_S), (bf16*)(ws + WS_S + 64 * MiB)};
        pg8::gemm_phase<EpiMix, DualOrder, true, false>(L, g, S, E);
    } GRID_BAR(7); STAMP();

    if (IN(8)) {
        pg8::Gemm g{(const bf16*)(ws + WS_S + 64 * MiB), (const bf16*)(ws + WS_WO), M, D, D, nullptr}; pg8::StaticOrder S; S.init(M, D, F.G, (int)blockIdx.x);
        EpiResBf16 E{F.ap->in[0], (bf16*)(ws + WS_Z)};
        pg8::gemm_phase<EpiResBf16, pg8::StaticOrder, true, false>(L, g, S, E);
    } GRID_BAR(8); STAMP();

    if (IN(9)) { p9_phase(F); xcd_barrier(bar); p9b_phase(F); } GRID_BAR(9); STAMP();

    if (IN(10)) {
        pg8::Gemm g{(const bf16*)(ws + WS_Z), (const bf16*)(ws + WS_WGU), M, 1024, D, (const int*)(ws + WS_LIST), (const float*)(ws + WS_RSE)};
        pg8::moe_fill_tab((LAS int*)(F.lds + MISC_OFF - 256), (const unsigned*)(ws + WS_CTL) + CW_CNT); LDS_WAIT(); __syncthreads();
        pg8::MoeOrder S{(const LAS int*)(F.lds + MISC_OFF - 256), F.G, (int)blockIdx.x, false, 0, nullptr};
        EpiMoe1 E{(bf16*)(ws + WS_S), (const LAS float*)(F.lds + pg8::STAGE_BYTES + 4096), (unsigned*)(ws + WS_CTL) + CW_DEP};
        pg8::gemm_phase<EpiMoe1, pg8::MoeOrder, true, true>(L, g, S, E);
    } STAMP();

    if (IN(11)) {
#ifndef NO_MOE2
        { pg8::Gemm g{(const bf16*)(ws + WS_S), (const bf16*)(ws + WS_WD), M, 1024, 512, nullptr};
          pg8::moe_fill_tab((LAS int*)(F.lds + MISC_OFF - 256), (const unsigned*)(ws + WS_CTL) + CW_CNT); LDS_WAIT(); __syncthreads();
          const LAS int* tb = (const LAS int*)(F.lds + MISC_OFF - 256); const int n10 = 4 * (tb[31] + ((tb[63] + 255) >> 8));
          pg8::MoeOrderT<true> S{tb, F.G, (int)blockIdx.x, true, n10 % F.G, (const unsigned*)(ws + WS_CTL) + CW_DEP};
          EpiStoreBf16 E{(bf16*)(ws + WS_Z + 64 * MiB), D};
          pg8::gemm_phase<EpiStoreBf16, pg8::MoeOrderT<true>, true, false>(L, g, S, E); }
#endif
        { pg8::Gemm g2{(const bf16*)(ws + WS_PBF), (const bf16*)(ws + WS_WPP), M, D, 256, nullptr}; ErawOrder S2; S2.S.init(M, D, F.G, 0); S2.c = (int)blockIdx.x; S2.G = F.G;
          S2.nheavy = 0;
          EpiStoreSsq E2{(bf16*)(ws + WS_S + 64 * MiB), D, (float*)(ws + WS_ZGATE + 1 * MiB)};
          pg8::gemm_phase<EpiStoreSsq, ErawOrder, true, false>(L, g2, S2, E2); }
    } GRID_BAR(11); STAMP();

    if (IN(12)) { p12_phase(F); } GRID_BAR(12); STAMP();

    if (IN(13)) {
        pg8::Gemm g{(const bf16*)(ws + WS_S), (const bf16*)(ws + WS_WPG), M, D, D, nullptr}; pg8::StaticOrder S; S.init(M, D, F.G, (int)blockIdx.x);
        EpiPleNorm E{(const bf16*)(ws + WS_S), (const bf16*)(ws + WS_S + 64 * MiB), (const float*)(ws + WS_RSE) + 2 * M, F.ap->in[33], (const float*)(ws + WS_RSE) + M, F.ap->in[36], F.out, (float*)(ws + WS_ZGATE), (unsigned*)(ws + WS_CTL) + CW_PANEL, (LAS float*)(F.lds + 131072)};
        pg8::gemm_phase<EpiPleNorm, pg8::StaticOrder, true, false>(L, g, S, E);
    } STAMP();

#ifdef PROBE_A
    xcd_barrier(bar); STAMP(); __threadfence();
    if (blockIdx.x == 0 && F.tid == 0) { __threadfence(); }
    xcd_barrier(bar);
    {
        volatile unsigned long long* tv = (volatile unsigned long long*)tsb;
        const float dA = (float)(tv[PROBE_A + 1] - tv[PROBE_A]) * 0.01f, dB = (float)(tv[PROBE_B + 1] - tv[PROBE_B]) * 0.01f;
        for (size_t i = (size_t)blockIdx.x * 512 + F.tid; i < (size_t)M * D; i += (size_t)F.G * 512) F.out[i] = 10.0f * dB;
        __syncthreads();
        if (blockIdx.x == 0 && F.tid == 0) F.out[0] = 300.0f * dA;
    }
#endif
#undef IN
#undef GRID_BAR
}

extern "C" void kernel_launch(void* const* d_in, const int* in_sizes, int n_in, void* d_out, int out_size, void* d_ws, size_t ws_size, hipStream_t stream) {
    static int grid = 0;
    if (grid == 0) {
        if (n_in != 37 || out_size != M * D || ws_size < WS_END) { fprintf(stderr, "kernel_launch: unexpected problem (n_in %d, out %d, ws %zu < %zu); nothing launched\n", n_in, out_size, ws_size, (size_t)WS_END); grid = -1; return; }
        int dev = 0, cus = 0, per_cu = 0;
        if (hipGetDevice(&dev) != hipSuccess || hipDeviceGetAttribute(&cus, hipDeviceAttributeMultiprocessorCount, dev) != hipSuccess) { grid = -1; return; }
        if (hipFuncSetAttribute((const void*)mk_fwd, hipFuncAttributeMaxDynamicSharedMemorySize, LDS_BYTES) != hipSuccess) { fprintf(stderr, "kernel_launch: hipFuncSetAttribute failed\n"); grid = -1; return; }
        if (hipOccupancyMaxActiveBlocksPerMultiprocessor(&per_cu, (const void*)mk_fwd, NWAVES * 64, LDS_BYTES) != hipSuccess || per_cu < 1) { fprintf(stderr, "kernel_launch: occupancy query says %d blocks per CU\n", per_cu); (void)hipGetLastError(); grid = -1; return; }
        grid = cus;
        if (grid != 256) fprintf(stderr, "kernel_launch: %d CUs; this kernel is built for 256\n", grid);
    }
    if (grid < 0) return;
    (void)hipMemsetAsync((char*)d_ws + WS_CTL, 0, CTL_ZERO_BYTES, stream);
    Args a{};
    for (int i = 0; i < 37; ++i) a.in[i] = (const float*)d_in[i];
    a.out = (float*)d_out; a.ws = (unsigned char*)d_ws;
#if MK_ONE_LAUNCH
    a.ph_lo = 0; a.ph_hi = N_PHASES;
    void* kargs[] = {&a};
    hipError_t e = hipLaunchCooperativeKernel((const void*)mk_fwd, dim3(grid), dim3(NWAVES * 64), kargs, LDS_BYTES, stream);
    if (e != hipSuccess) fprintf(stderr, "kernel_launch: cooperative launch failed: %s (grid %d)\n", hipGetErrorString(e), grid);
#else
    for (int ph = 0; ph < N_PHASES; ++ph) { a.ph_lo = ph; a.ph_hi = ph + 1; hipLaunchKernelGGL(mk_fwd, dim3(grid), dim3(NWAVES * 64), LDS_BYTES, stream, a); }
#endif
}
```

```cpp
#include <hip/hip_runtime.h>
#include <hip/hip_cooperative_groups.h>
#include <cstdio>
#include <cstdint>
namespace cg = cooperative_groups;

namespace pg8 {
#define PG8_LAS __attribute__((address_space(3)))
typedef unsigned short bf16_t;
typedef short bf16x8 __attribute__((ext_vector_type(8)));
typedef float f32x4 __attribute__((ext_vector_type(4)));
typedef unsigned u32x4 __attribute__((ext_vector_type(4)));
typedef unsigned u32x2 __attribute__((ext_vector_type(2)));
constexpr int BM = 256, BK = 64, HALF = 128, HTB = HALF * BK * 2  , STAGE_BYTES = 8 * HTB, NXCD = 8, WGM = 8;

__host__ __device__ __forceinline__ int lds_byte(int r, int c) { const int st = (r >> 4) * 2 + (c >> 5), rr = r & 15, cc = c & 31, ob = rr * 64 + cc * 2; return st * 1024 + (ob ^ (((ob >> 9) & 1) << 5)); }
__host__ __device__ __forceinline__ void stage_rc(int b, int& R, int& C) { const int st = b / 1024, sb = b % 1024, swz = sb ^ (((sb >> 9) & 1) << 5); R = (st >> 1) * 16 + swz / 64; C = (st & 1) * 32 + (swz % 64) / 2; }
__host__ __device__ __forceinline__ int perm32(int rho) { const int n = rho >> 4, i = rho & 15; return 8 * (i >> 2) + 4 * n + (i & 3); }

struct Unit { int pm, pn, pmo, lt, nvalid, pnl; };
struct Gemm { const bf16_t* A; const bf16_t* Bt; int M, N, K; const int* rowidx; const float* rowscale; };

struct StaticOrder {
    static constexpr bool DEP = false;
    int nM, nN, nwg, G, c;
    __host__ __device__ void init(int M, int N, int G_, int c_) { nM = M / BM; nN = N / BM; nwg = nM * nN; G = G_; c = c_; }
    __host__ __device__ bool next(int i, Unit& u) const {
        const long L = (long)i * G + c; if (L >= nwg) return false;
        int wgid = (int)L; { const int q = nwg / NXCD, r = nwg % NXCD, xcd = wgid % NXCD, off = wgid / NXCD; wgid = (xcd < r ? xcd * (q + 1) : r * (q + 1) + (xcd - r) * q) + off; }
        const int nig = WGM * nN, gid = wgid / nig, fm = gid * WGM, gsz = (nM - fm) < WGM ? (nM - fm) : WGM;
        u.pm = fm + ((wgid % nig) % gsz); u.pn = (wgid % nig) / gsz; u.pmo = u.pm; u.lt = u.pm; u.nvalid = 256; u.pnl = u.pn; return true;
    }
};
template <bool DEP_>
struct MoeOrderT {
    static constexpr bool DEP = DEP_;
    const PG8_LAS int* tab; int G, c; bool a_is_out;
    int nheavy; const unsigned* dep;
    __device__ void wait(const Unit& u) const {
        const unsigned* p = dep + 16 * u.pmo; unsigned sp = 0;
        while (__hip_atomic_load(p, __ATOMIC_RELAXED, __HIP_MEMORY_SCOPE_AGENT) < 4u) { __builtin_amdgcn_s_sleep(2); if (++sp > (1u << 22)) break; }
        asm volatile("s_waitcnt vmcnt(0)" ::: "memory");
    }
    __device__ bool next(int i, Unit& u) const {
        int L;
        if constexpr (DEP_) { const int nl = G - nheavy; L = (c >= nheavy) ? (i < 2 ? i * nl + (c - nheavy) : 2 * nl + (i - 2) * G + c) : 2 * nl + i * G + c; }
        else L = i * G + c;
        const int tile = L >> 2, pnl = L & 3;
        const int lane = (int)__builtin_amdgcn_mbcnt_hi(~0u, __builtin_amdgcn_mbcnt_lo(~0u, 0u)), e_ = lane & 31;
        const int pre = tab[e_], ce = tab[32 + e_]; const int nt = (ce + 255) >> 8;
        const unsigned long long mk = __ballot(lane < 32 && tile >= pre && tile < pre + nt);
        if (mk == 0ull) return false;
        const int e = (int)__builtin_ctzll(mk);
        const int pre_e = __builtin_amdgcn_readlane(pre, e), ce_e = __builtin_amdgcn_readlane(ce, e);
        const int rt = tile - pre_e; u.pmo = tile; u.pm = a_is_out ? tile : 0; u.lt = e * 64 + rt; u.pn = e * 4 + pnl; u.pnl = pnl; const int rem = ce_e - rt * 256; u.nvalid = rem < 256 ? rem : 256; return true;
    }
};
typedef MoeOrderT<false> MoeOrder;
__device__ __forceinline__ void moe_fill_tab(PG8_LAS int* tab, const unsigned* cnt) {
    const int lane = (int)__builtin_amdgcn_mbcnt_hi(~0u, __builtin_amdgcn_mbcnt_lo(~0u, 0u));
    const int ce = (lane < 32) ? (int)cnt[lane & 31] : 0; const int nt = (ce + 255) >> 8;
    int incl = nt;
#pragma unroll
    for (int o = 1; o < 32; o <<= 1) { const int v = __shfl_up(incl, o); if (lane >= o) incl += v; }
    if (lane < 32) { tab[lane] = incl - nt; tab[32 + lane] = ce; }
}

__device__ __forceinline__ unsigned cvt_pk_bf16(float lo, float hi) { unsigned r; asm volatile("v_cvt_pk_bf16_f32 %0, %1, %2" : "=v"(r) : "v"(lo), "v"(hi)); return r; }

template <class Epi, class Sched, bool ALIGN_EPI, bool GATHER>
__device__ __forceinline__ void gemm_phase(PG8_LAS unsigned char* lds, const Gemm g, const Sched& S, const Epi& E) {
    const int tid = threadIdx.x, wid = __builtin_amdgcn_readfirstlane(tid >> 6), lane = tid & 63, wr = wid >> 2, wc = wid & 3, fr = lane & 15, fq = lane >> 4;
    constexpr int AUX_A = Sched::DEP ? 16 : 0;
    int K_ = g.K; asm volatile("" : "+s"(K_));
    const int K = K_, nt = K / BK;
    unsigned voffB[2]; int RA[2], CA[2];
#pragma unroll
    for (int i = 0; i < 2; ++i) { int R, C; stage_rc(tid * 16 + i * 8192, R, C); const int Rb = Epi::PERM ? ((R & ~31) + perm32(R & 31)) : R;
        RA[i] = R; CA[i] = C; voffB[i] = (unsigned)(Rb * K + C) * 2u; }
    const size_t kstep = (size_t)(BK * 2);
    const size_t hstep = (size_t)HALF * K * 2;
    const size_t tstep = 2 * hstep;
    const unsigned ldsw = (unsigned)wid * 1024u;
    const int aoff = lds_byte(wr * 64 + fr, fq * 8), boff = lds_byte(wc * 32 + fr, fq * 8);
    unsigned vA[2][2], vN[2][2];
    PG8_LAS int* rowl = (PG8_LAS int*)(lds + STAGE_BYTES);
    if constexpr (GATHER) {
        for (int i = 0; i < 4; ++i) { Unit uu; if (!S.next(i, uu)) break; if (tid < 256) { const int tk = (tid < uu.nvalid) ? (g.rowidx[(size_t)uu.lt * 256 + tid] >> 1) : 0; rowl[i * 256 + tid] = tk; ((PG8_LAS float*)(rowl + 1024))[i * 256 + tid] = g.rowscale[tk]; } }
        asm volatile("s_waitcnt vmcnt(0) lgkmcnt(0)" ::: "memory"); __builtin_amdgcn_s_barrier(); asm volatile("" ::: "memory");
    }
    auto compute_v = [&](const Unit& u, unsigned (&v)[2][2], int ui_) {
#pragma unroll
        for (int h = 0; h < 2; ++h)
#pragma unroll
            for (int i = 0; i < 2; ++i) {
                const int rl = h * HALF + RA[i];
                if constexpr (GATHER) { const int tok = rowl[ui_ * 256 + rl]; v[h][i] = ((unsigned)tok * (unsigned)K + (unsigned)CA[i]) * 2u; }
                else v[h][i] = ((unsigned)rl * (unsigned)K + (unsigned)CA[i]) * 2u;
            }
    };
#define PG8_SA(b, h) (((b) * 2 + (h)) * HTB)
#define PG8_SB(b, h) ((4 + (b) * 2 + (h)) * HTB)
#define PG8_STAGE_X(bufoff, gbase, voff, aux) do { _Pragma("unroll") for (int _i = 0; _i < 2; ++_i) \
        __builtin_amdgcn_global_load_lds((const unsigned*)((const char*)(gbase) + (voff)[_i]), (PG8_LAS unsigned*)(lds + (bufoff) + ldsw + _i * 8192), 16, 0, aux); } while (0)
#define PG8_STAGE(bufoff, gbase, voff) PG8_STAGE_X(bufoff, gbase, voff, 0)
#define PG8_STAGE_A(bufoff, gbase, voff) PG8_STAGE_X(bufoff, gbase, voff, AUX_A)
#define PG8_LDA(dst, b, h) do { _Pragma("unroll") for (int m = 0; m < 4; ++m) _Pragma("unroll") for (int k = 0; k < 2; ++k) dst[m][k] = *(const PG8_LAS bf16x8*)(lds + PG8_SA(b, h) + aoff + m * 2048 + k * 1024); } while (0)
#define PG8_LDB(dst, b, h) do { _Pragma("unroll") for (int n = 0; n < 2; ++n) _Pragma("unroll") for (int k = 0; k < 2; ++k) dst[n][k] = *(const PG8_LAS bf16x8*)(lds + PG8_SB(b, h) + boff + n * 2048 + k * 1024); } while (0)
#define PG8_MMA(ai, bj, At, Bt) do { __builtin_amdgcn_s_setprio(1); _Pragma("unroll") for (int m = 0; m < 4; ++m) _Pragma("unroll") for (int n = 0; n < 2; ++n) _Pragma("unroll") for (int k = 0; k < 2; ++k) \
        acc[ai][bj][m][n] = __builtin_amdgcn_mfma_f32_16x16x32_bf16(Bt[n][k], At[m][k], acc[ai][bj][m][n], 0, 0, 0); __builtin_amdgcn_s_setprio(0); } while (0)
#define PG8_WAIT_V(n) asm volatile("s_waitcnt vmcnt(" #n ")" ::: "memory")
#define PG8_WAIT_L(n) asm volatile("s_waitcnt lgkmcnt(" #n ")" ::: "memory")
#define PG8_BAR __builtin_amdgcn_s_barrier()
#define PG8_SCHED __builtin_amdgcn_sched_barrier(0)
    Unit cur, nxt; int ui = 0;
    if (!S.next(0, cur)) return;
    f32x4 acc[2][2][4][2];
#pragma unroll
    for (int a = 0; a < 2; ++a)
#pragma unroll
        for (int b = 0; b < 2; ++b)
#pragma unroll
            for (int m = 0; m < 4; ++m)
#pragma unroll
                for (int n = 0; n < 2; ++n) acc[a][b][m][n] = (f32x4){0.f, 0.f, 0.f, 0.f};
    bf16x8 At[4][2], B0[2][2], B1[2][2];
    if constexpr (Sched::DEP) { if (tid == 0) S.wait(cur); PG8_BAR; }
    compute_v(cur, vA, 0);
    const char* cA = (const char*)g.A + (GATHER ? (size_t)0 : (size_t)cur.pm * tstep); const char* cB = (const char*)g.Bt + (size_t)cur.pn * tstep;
    PG8_STAGE(PG8_SB(0, 0), cB, voffB); PG8_STAGE(PG8_SB(0, 1), cB + hstep, voffB); PG8_STAGE_A(PG8_SA(0, 0), cA, vA[0]); PG8_STAGE_A(PG8_SA(0, 1), cA, vA[1]);
    if (wr == 1) PG8_BAR;
    PG8_WAIT_V(2); PG8_BAR;
    PG8_STAGE(PG8_SB(1, 0), cB + kstep, voffB); PG8_STAGE_A(PG8_SA(1, 0), cA + kstep, vA[0]); PG8_STAGE(PG8_SB(1, 1), cB + hstep + kstep, voffB);
    PG8_WAIT_V(6); PG8_BAR;
    for (;;) {
        const bool has_next = S.next(ui + 1, nxt);
        if (has_next) compute_v(nxt, vN, ui + 1);
        else {
#pragma unroll
            for (int h = 0; h < 2; ++h)
#pragma unroll
                for (int i = 0; i < 2; ++i) vN[h][i] = vA[h][i];
        }
        const char* nA = has_next ? ((const char*)g.A + (GATHER ? (size_t)0 : (size_t)nxt.pm * tstep)) : cA; const char* nB = has_next ? (const char*)g.Bt + (size_t)nxt.pn * tstep : cB;
#pragma unroll 1
        for (int t = 0; t < nt; t += 2) {
            const bool last = (t == nt - 2);
            if constexpr (Sched::DEP) { if (last && has_next) { if (tid == 0) S.wait(nxt); PG8_BAR; } }
            const char* a1 = cA + (size_t)(t + 1) * kstep;
            const char* a2 = last ? nA : cA + (size_t)(t + 2) * kstep; const char* b2 = last ? nB : cB + (size_t)(t + 2) * kstep;
            const char* a3 = a2 + kstep; const char* b3 = b2 + kstep;
            unsigned vX0[2], vX1[2];
#pragma unroll
            for (int i = 0; i < 2; ++i) { vX0[i] = last ? vN[0][i] : vA[0][i]; vX1[i] = last ? vN[1][i] : vA[1][i]; }
            PG8_LDB(B0, 0, 0); PG8_LDB(B1, 0, 1); PG8_SCHED; PG8_LDA(At, 0, 0); PG8_STAGE_A(PG8_SA(1, 1), a1, vA[1]);
            PG8_WAIT_V(8); PG8_WAIT_L(0); PG8_BAR; PG8_MMA(0, 0, At, B0); PG8_MMA(0, 1, At, B1); PG8_BAR; PG8_SCHED;
            PG8_LDA(At, 0, 1); PG8_STAGE(PG8_SB(0, 0), b2, voffB); PG8_STAGE(PG8_SB(0, 1), b2 + hstep, voffB); PG8_STAGE_A(PG8_SA(0, 0), a2, vX0);
            PG8_WAIT_V(8); PG8_WAIT_L(0); PG8_BAR; PG8_MMA(1, 0, At, B0); PG8_MMA(1, 1, At, B1); PG8_BAR; PG8_SCHED;
            PG8_LDB(B0, 1, 0); PG8_LDB(B1, 1, 1); PG8_SCHED; PG8_LDA(At, 1, 0); PG8_STAGE_A(PG8_SA(0, 1), a2, vX1);
            PG8_WAIT_V(8); PG8_WAIT_L(0); PG8_BAR; PG8_MMA(0, 0, At, B0); PG8_MMA(0, 1, At, B1); PG8_BAR; PG8_SCHED;
            PG8_LDA(At, 1, 1); PG8_STAGE(PG8_SB(1, 0), b3, voffB); PG8_STAGE(PG8_SB(1, 1), b3 + hstep, voffB); PG8_STAGE_A(PG8_SA(1, 0), a3, vX0);
            PG8_WAIT_V(8); PG8_WAIT_L(0); PG8_BAR; PG8_MMA(1, 0, At, B0); PG8_MMA(1, 1, At, B1); PG8_BAR; PG8_SCHED;
        }
        if constexpr (ALIGN_EPI) { if (wr == 0) PG8_BAR; }
        if constexpr (GATHER) cur.pm = ui;
        E(acc, cur, wr, wc, fr, fq);
        if (!has_next) break;
#pragma unroll
        for (int a = 0; a < 2; ++a)
#pragma unroll
            for (int b = 0; b < 2; ++b)
#pragma unroll
                for (int m = 0; m < 4; ++m)
#pragma unroll
                    for (int n = 0; n < 2; ++n) acc[a][b][m][n] = (f32x4){0.f, 0.f, 0.f, 0.f};
        cur = nxt; cA = nA; cB = nB; ++ui;
#pragma unroll
        for (int h = 0; h < 2; ++h)
#pragma unroll
            for (int i = 0; i < 2; ++i) vA[h][i] = vN[h][i];
        if constexpr (ALIGN_EPI) { if (wr == 1) PG8_BAR; }
    }
    PG8_WAIT_V(0);
    if constexpr (!ALIGN_EPI) { if (wr == 0) PG8_BAR; }
    PG8_BAR;
#undef PG8_SA
#undef PG8_SB
#undef PG8_STAGE
#undef PG8_STAGE_X
#undef PG8_STAGE_A
#undef PG8_LDA
#undef PG8_LDB
#undef PG8_MMA
#undef PG8_WAIT_V
#undef PG8_WAIT_L
#undef PG8_BAR
#undef PG8_SCHED
}
}

constexpr int NWAVES = 8;
constexpr int M = 16384, D = 1024, SEQ = 2048, NBATCH = 8;
constexpr int NIN = 5144;
constexpr int NZ = 5120;
constexpr int ZC_R = 0, ZC_K = 512, ZC_V = 1024, ZC_W = 1536, ZC_Q = 1792, ZC_KC = 2304, ZC_VC = 2432, ZC_KS = 2560, ZC_VS = 2688, ZC_KW = 2816, ZC_VW = 2944, ZC_MR = 3072, ZC_MN = 4096;
constexpr float NORM_EPS = 1e-6f, GN_EPS = 64e-5f;

constexpr size_t MiB = 1u << 20;
constexpr size_t WS_CTL = 0, CTL_ZERO_BYTES = 64 * 1024;
constexpr size_t WS_LIST = 1 * MiB;
constexpr size_t WS_GATEA = 3 * MiB;
constexpr size_t WS_RSE = 4 * MiB;
constexpr size_t WS_SLOTA = 4 * MiB + 512 * 1024;
constexpr size_t WS_SELMASK = 5 * MiB;
constexpr size_t WS_ZGATE = 6 * MiB;
constexpr size_t WS_SMALLW = 8 * MiB;
constexpr size_t SW_W2T = 0, SW_A2T = 65536, SW_G2T = 131072, SW_CK1 = 262144, SW_CV1 = 524288, SW_CK2 = 786432, SW_CV2 = 794624, SW_GATEW = 802816, SW_ROUTEW = 868352;
constexpr size_t WS_KCMP = 10 * MiB;
constexpr size_t WS_VST = 11 * MiB, WS_VWT = 15 * MiB;
constexpr size_t WS_WIN = 19 * MiB, WS_UR = 29 * MiB, WS_UN = 30 * MiB, WS_WO = 31 * MiB, WS_WPP = 33 * MiB, WS_WPG = 34 * MiB, WS_WGU = 36 * MiB, WS_WD = 100 * MiB;
constexpr size_t WS_XN = 132 * MiB;
constexpr size_t WS_PBF = 164 * MiB;
constexpr size_t WS_Z = 172 * MiB;
constexpr size_t WS_S = 332 * MiB;
constexpr size_t WS_YRW = 428 * MiB, WS_YB = 444 * MiB, WS_G = 492 * MiB, WS_LOGITS = 508 * MiB  , WS_BONUS = 508 * MiB  , WS_END = 511 * MiB;
constexpr int CH_PP = 144, CH_P = 0, CH_R = 2304, CH_Q = 4608, CH_K = 6656, CH_G = 8704, CH_AC = 10752, CH_REC = 11008, CH_V = 11008, CH_SLOT = 11520;
constexpr int CW_CNT = 0;
constexpr int CW_PANEL = 8192;
constexpr int CW_DEP = 12288;
constexpr int CW_BAR = 1024;
constexpr int MISC_OFF = 163840 - 64;

constexpr int LDS_BYTES = 163840;

#define GAS __attribute__((address_space(1)))
#define LAS __attribute__((address_space(3)))
typedef unsigned short bf16;
typedef unsigned v4u __attribute__((ext_vector_type(4)));
typedef unsigned v2u __attribute__((ext_vector_type(2)));
typedef float f32x4 __attribute__((ext_vector_type(4)));
typedef float f32x2 __attribute__((ext_vector_type(2)));
typedef short bf16x8 __attribute__((ext_vector_type(8)));
typedef short bf16x4 __attribute__((ext_vector_type(4)));
typedef __bf16 bf16x2_t __attribute__((ext_vector_type(2)));
#define LDS_WAIT() asm volatile("s_waitcnt lgkmcnt(0)" ::: "memory")
#define MFMA16(a, b, c) __builtin_amdgcn_mfma_f32_16x16x32_bf16((a), (b), (c), 0, 0, 0)

__device__ __forceinline__ float bf2f(unsigned short v) { return __uint_as_float((unsigned)v << 16); }
__device__ __forceinline__ unsigned pk2(float lo, float hi) { f32x2 v = {lo, hi}; bf16x2_t b = __builtin_convertvector(v, bf16x2_t); return __builtin_bit_cast(unsigned, b); }
__device__ __forceinline__ v2u pk4(f32x4 v) { v2u r; r.x = pk2(v.x, v.y); r.y = pk2(v.z, v.w); return r; }
__device__ __forceinline__ f32x4 unpk4(v2u w) { f32x4 r; r.x = __uint_as_float(w.x << 16); r.y = __uint_as_float(w.x & 0xffff0000u); r.z = __uint_as_float(w.y << 16); r.w = __uint_as_float(w.y & 0xffff0000u); return r; }
__device__ __forceinline__ void unpk8(v4u w, float (&f)[8]) { f[0] = __uint_as_float(w.x << 16); f[1] = __uint_as_float(w.x & 0xffff0000u); f[2] = __uint_as_float(w.y << 16); f[3] = __uint_as_float(w.y & 0xffff0000u);
    f[4] = __uint_as_float(w.z << 16); f[5] = __uint_as_float(w.z & 0xffff0000u); f[6] = __uint_as_float(w.w << 16); f[7] = __uint_as_float(w.w & 0xffff0000u); }
__device__ __forceinline__ float sigmoidf_(float x) { return __builtin_amdgcn_rcpf(1.0f + __expf(-x)); }
__device__ __forceinline__ float wave_sum(float v) {
#pragma unroll
    for (int o = 1; o < 64; o <<= 1) v += __shfl_xor(v, o);
    return v;
}
template <int CTRL> __device__ __forceinline__ float dppf(float x) { return __builtin_bit_cast(float, __builtin_amdgcn_update_dpp(0, __builtin_bit_cast(int, x), CTRL, 0xf, 0xf, false)); }
__device__ __forceinline__ float row16_sum(float x) { x += dppf<0x128>(x); x += dppf<0x124>(x); x += dppf<0x122>(x); x += dppf<0x121>(x); return x; }

typedef GAS unsigned gu32;
#define XB_TMO      128
#define XB_XCNT(j)  (256  + 64 * (j))
#define XB_XSUB(j)  (1280 + 64 * (j))
#define XB_XGEN(j)  (2304 + 64 * (j))
#define XB_TOP      3328
#define XB_TOPGEN   3392
#define XCD_BAR_WORDS 3456
#define XB_SPIN_CAP (1u << 18)

__device__ __forceinline__ unsigned xb_ld(unsigned* p)              { return __hip_atomic_load(p, __ATOMIC_RELAXED, __HIP_MEMORY_SCOPE_AGENT); }
__device__ __forceinline__ unsigned xb_add(unsigned* p, unsigned v) { return __hip_atomic_fetch_add(p, v, __ATOMIC_RELAXED, __HIP_MEMORY_SCOPE_AGENT); }
__device__ __forceinline__ unsigned xb_xcc_id() { return (unsigned)__builtin_amdgcn_s_getreg((3 << 11) | 20) & 0xFu; }
#define XB_SPIN(cond, bar) do { unsigned _sp = 0; while (cond) { __builtin_amdgcn_s_sleep(1); \
    if ((++_sp & 255u) == 0u) { if (xb_ld(&(bar)[XB_TMO])) break; if (_sp > XB_SPIN_CAP) { atomicAdd(&(bar)[XB_TMO], 1u); break; } } } } while (0)

struct XcdBarrier {
    unsigned* bar; unsigned x;
    volatile LAS unsigned* st;
};

__device__ __forceinline__ XcdBarrier xcd_barrier_post(unsigned* bar, volatile LAS unsigned* st) {
    XcdBarrier b; b.bar = bar; b.x = xb_xcc_id(); b.st = st;
    if (threadIdx.x == 0) (void)xb_add(&bar[XB_XCNT(b.x)], 1u);
    return b;
}
__device__ __forceinline__ void xcd_barrier_complete(unsigned* bar, unsigned x, unsigned& nloc, unsigned& nx) {
    const unsigned G = gridDim.x * gridDim.y * gridDim.z;
    unsigned sum, cnt, mine, sp = 0u;
    for (;;) {
        sum = 0u; cnt = 0u; mine = 0u;
#pragma unroll
        for (unsigned j = 0; j < 16; ++j) { const unsigned c = xb_ld(&bar[XB_XCNT(j)]); sum += c; cnt += (c > 0u) ? 1u : 0u; mine = (j == x) ? c : mine; }
        if (sum == G) break;
        __builtin_amdgcn_s_sleep(1);
        if ((++sp & 255u) == 0u) { if (xb_ld(&bar[XB_TMO])) break; if (sp > XB_SPIN_CAP) { atomicAdd(&bar[XB_TMO], 1u); break; } }
    }
    nloc = mine > 0u ? mine : 1u; nx = cnt > 0u ? cnt : 1u;
}

__device__ __forceinline__ void xcd_barrier(const XcdBarrier& b) {
    asm volatile("s_waitcnt vmcnt(0)" ::: "memory");
    __syncthreads();
    if (threadIdx.x == 0) {
        unsigned* bar = b.bar;
        __builtin_amdgcn_s_waitcnt(0);
        unsigned nloc = b.st[0], nx = b.st[1];
        if (nloc == 0u) { xcd_barrier_complete(bar, b.x, nloc, nx); b.st[0] = nloc; b.st[1] = nx; }
        const unsigned old = xb_add(&bar[XB_XSUB(b.x)], 1u);
        const unsigned gen = old / nloc;
        if (old + 1u == (gen + 1u) * nloc) {
            __builtin_amdgcn_fence(__ATOMIC_RELEASE, "agent");
            asm volatile("s_waitcnt vmcnt(0)" ::: "memory");
            const unsigned og = xb_add(&bar[XB_TOP], 1u);
            const unsigned tg = og / nx;
            if (og + 1u == (tg + 1u) * nx) xb_add(&bar[XB_TOPGEN], 1u);
            else XB_SPIN(xb_ld(&bar[XB_TOPGEN]) == tg, bar);
            __builtin_amdgcn_fence(__ATOMIC_ACQUIRE, "agent");
            xb_add(&bar[XB_XGEN(b.x)], 1u);
            asm volatile("s_waitcnt vmcnt(0)" ::: "memory");
        } else {
            XB_SPIN(xb_ld(&bar[XB_XGEN(b.x)]) == gen, bar);
            __builtin_amdgcn_fence(__ATOMIC_ACQUIRE, "agent");
            asm volatile("s_waitcnt vmcnt(0)" ::: "memory");
        }
    }
    __syncthreads();
}

struct Args { const float* in[37]; float* out; unsigned char* ws; int ph_lo, ph_hi, rep_mask, pad; };
typedef __attribute__((address_space(4))) const Args* ArgsP;
struct Frame {
    LAS unsigned char* lds;
    int tid, lane, wave, vcu, G, gw, NGW;
    unsigned char* ws;
    ArgsP ap;
    float* out;
};

struct TrDesc { const float* W; bf16* T; bf16* T2; const float* gain; int K, ld, nc, item, mode; };
__device__ __forceinline__ void tr_load(const TrDesc& d, int lane, float (&tv)[32], f32x4 (&gn)[2]) {
    const int nblk = (d.nc + 31) / 32, kb = d.item / nblk, nb = d.item % nblk, k0 = 64 * kb, n0 = 32 * nb;
    const int nn = n0 + (lane & 31);
    gn[0] = (f32x4){1.f, 1.f, 1.f, 1.f}; gn[1] = gn[0];
    if (d.gain) { const float* gp = d.gain + k0 + 8 * (lane & 7); gn[0] = *(const f32x4*)gp; gn[1] = *(const f32x4*)(gp + 4); }
    const float* wsrc = d.W + (size_t)(k0 + (lane >> 5)) * d.ld + (nn < d.nc ? nn : 0);
#pragma unroll
    for (int i = 0; i < 32; ++i) tv[i] = wsrc[(size_t)(2 * i) * d.ld];
}
__device__ __forceinline__ void tr_finish(const TrDesc& d, LAS float* scr, int lane, const float (&tv)[32], const f32x4 (&gn)[2]) {
    const int nblk = (d.nc + 31) / 32, kb = d.item / nblk, nb = d.item % nblk, k0 = 64 * kb, n0 = 32 * nb;
#pragma unroll
    for (int i = 0; i < 32; ++i) scr[(2 * i + (lane >> 5)) * 33 + (lane & 31)] = tv[i];
    LDS_WAIT(); asm volatile("" ::: "memory");
    const int c = lane & 7;
#pragma unroll
    for (int j = 0; j < 4; ++j) { const int nl = (lane >> 3) + 8 * j, n = n0 + nl; const LAS float* s = scr + (8 * c) * 33 + nl;
        v4u o; o.x = pk2(s[0 * 33] * gn[0].x, s[1 * 33] * gn[0].y); o.y = pk2(s[2 * 33] * gn[0].z, s[3 * 33] * gn[0].w); o.z = pk2(s[4 * 33] * gn[1].x, s[5 * 33] * gn[1].y); o.w = pk2(s[6 * 33] * gn[1].z, s[7 * 33] * gn[1].w);
        if (n < d.nc) { bf16* rp;
            if (d.mode == 1) rp = n < 3072 ? d.T + (size_t)n * 1024 : (n < 3096 ? d.T2 + (size_t)(n - 3072) * 1024 : d.T + (size_t)(n - 24) * 1024);
            else if (d.mode == 2) { const int n2 = n & 511; rp = d.T + (size_t)((n2 >> 7) * 256 + (n >> 9) * 128 + (n2 & 127)) * 1024; }
            else rp = d.T + (size_t)n * d.K;
            *(v4u*)(rp + k0 + 8 * c) = o; } }
    LDS_WAIT(); asm volatile("" ::: "memory");
}
__device__ __forceinline__ void rms_row_to_bf16(int lane, const float* xrow, const float* gain, bf16* orow) {
    const f32x4* xr = (const f32x4*)xrow + lane; const f32x4* gr = (const f32x4*)gain + lane;
    f32x4 v[4]; float s = 0.f;
#pragma unroll
    for (int j = 0; j < 4; ++j) { v[j] = xr[64 * j]; s += (v[j].x * v[j].x + v[j].y * v[j].y) + (v[j].z * v[j].z + v[j].w * v[j].w); }
    const float rs = 1.0f / sqrtf(wave_sum(s) * (1.f / D) + NORM_EPS);
    v2u* o8 = (v2u*)orow + lane;
#pragma unroll
    for (int j = 0; j < 4; ++j) { const f32x4 g = gr[64 * j]; o8[64 * j] = pk4(v[j] * rs * g); }
}

namespace tri {
constexpr int I_WIN = 16 * 161, I_UR = 8 * 32, I_WO = 16 * 32, I_WPP = 4 * 32, I_L64 = 16, I_L128 = 32, I_C1 = 32 * 2, I_C2 = 2, I_GU = 16 * 32, I_DN = 8 * 32;
constexpr int E0 = I_WIN, E1 = E0 + I_UR, E2 = E1 + I_UR, E3 = E2 + I_WO, E4 = E3 + I_WPP, E5 = E4 + I_WO, E6 = E5 + I_L64, E7 = E6 + I_L64, E8 = E7 + I_L128, E9 = E8 + I_C1, E10 = E9 + I_C1, E11 = E10 + I_C2, E12 = E11 + I_C2,
              E13 = E12 + 32 * I_GU, NITEMS = E13 + 32 * I_DN;
}
__device__ __forceinline__ TrDesc tr_desc(Frame& F, int it) {
    using namespace tri;
    unsigned char* ws = F.ws;
    const float* W; const float* gain = nullptr; int K, ld, nc, item, mode = 0; size_t dst;
    if (it < E0) { W = F.ap->in[3]; K = 1024; ld = NIN; nc = NIN; item = it; mode = 1; dst = WS_WIN; }
    else if (it < E1) { W = F.ap->in[22]; K = 512; ld = 1024; nc = 1024; item = it - E0; dst = WS_UR; }
    else if (it < E2) { W = F.ap->in[23]; K = 512; ld = 1024; nc = 1024; item = it - E1; dst = WS_UN; }
    else if (it < E3) { W = F.ap->in[24]; K = 1024; ld = 1024; nc = 1024; item = it - E2; dst = WS_WO; }
    else if (it < E4) { W = F.ap->in[32]; K = 256; ld = 1024; nc = 1024; item = it - E3; dst = WS_WPP; }
    else if (it < E5) { W = F.ap->in[35]; K = 1024; ld = 1024; nc = 1024; item = it - E4; dst = WS_WPG; gain = F.ap->in[34]; }
    else if (it < E6) { W = F.ap->in[6]; K = 64; ld = 512; nc = 512; item = it - E5; dst = WS_SMALLW + SW_W2T; }
    else if (it < E7) { W = F.ap->in[8]; K = 64; ld = 512; nc = 512; item = it - E6; dst = WS_SMALLW + SW_A2T; }
    else if (it < E8) { W = F.ap->in[9]; K = 128; ld = 512; nc = 512; item = it - E7; dst = WS_SMALLW + SW_G2T; }
    else if (it < E9) { W = F.ap->in[17]; K = 2048; ld = 64; nc = 64; item = it - E8; dst = WS_SMALLW + SW_CK1; }
    else if (it < E10) { W = F.ap->in[19]; K = 2048; ld = 64; nc = 64; item = it - E9; dst = WS_SMALLW + SW_CV1; }
    else if (it < E11) { W = F.ap->in[18]; K = 64; ld = 64; nc = 64; item = it - E10; dst = WS_SMALLW + SW_CK2; }
    else if (it < E12) { W = F.ap->in[20]; K = 64; ld = 64; nc = 64; item = it - E11; dst = WS_SMALLW + SW_CV2; }
    else if (it < E13) { const int r = it - E12, e = r / I_GU; W = F.ap->in[30] + (size_t)e * 1024 * 1024; K = 1024; ld = 1024; nc = 1024; item = r % I_GU; mode = 2; dst = WS_WGU + (size_t)e * 1024 * 1024 * 2; gain = F.ap->in[25]; }
    else { const int r = it - E13, e = r / I_DN; W = F.ap->in[31] + (size_t)e * 512 * 1024; K = 512; ld = 1024; nc = 1024; item = r % I_DN; dst = WS_WD + (size_t)e * 1024 * 512 * 2; }
    return TrDesc{W, (bf16*)(ws + dst), (bf16*)(ws + WS_SMALLW + SW_GATEW), gain, K, ld, nc, item, mode};
}
__device__ __forceinline__ void tr_run(Frame& F, LAS float* scr, int it0, int stride, int it_end) {
    if (it0 >= it_end) return;
    float tvA[32], tvB[32]; f32x4 gnA[2], gnB[2];
    int it = it0; TrDesc cur = tr_desc(F, it); tr_load(cur, F.lane, tvA, gnA);
    for (;;) {
        const int nxt = it + stride; const bool has = nxt < it_end; TrDesc dn = cur;
        if (has) { dn = tr_desc(F, nxt); tr_load(dn, F.lane, tvB, gnB); }
        __builtin_amdgcn_sched_barrier(0);
        tr_finish(cur, scr, F.lane, tvA, gnA);
        if (!has) break;
        cur = dn; it = nxt;
#pragma unroll
        for (int i = 0; i < 32; ++i) tvA[i] = tvB[i];
        gnA[0] = gnB[0]; gnA[1] = gnB[1];
    }
}
__device__ __forceinline__ int tr_qnext(LAS int* qh) {
    int k = 0; const unsigned a = (unsigned)(size_t)qh; const int one = 1;
    if (__builtin_amdgcn_mbcnt_hi(~0u, __builtin_amdgcn_mbcnt_lo(~0u, 0u)) == 0) asm volatile("ds_add_rtn_u32 %0, %1, %2\n\ts_waitcnt lgkmcnt(0)" : "=&v"(k) : "v"(a), "v"(one) : "memory");
    return __builtin_amdgcn_readfirstlane(k);
}
__device__ __forceinline__ void tr_run_q(Frame& F, LAS float* scr, LAS int* qh, int base, int stride, int nk) {
    int k = tr_qnext(qh); if (k >= nk) return;
    float tvA[32], tvB[32]; f32x4 gnA[2], gnB[2];
    TrDesc cur = tr_desc(F, base + k * stride); tr_load(cur, F.lane, tvA, gnA);
    for (;;) {
        const int kn = tr_qnext(qh); const bool has = kn < nk; TrDesc dn = cur;
        if (has) { dn = tr_desc(F, base + kn * stride); tr_load(dn, F.lane, tvB, gnB); }
        __builtin_amdgcn_sched_barrier(0);
        tr_finish(cur, scr, F.lane, tvA, gnA);
        if (!has) break;
        cur = dn;
#pragma unroll
        for (int i = 0; i < 32; ++i) tvA[i] = tvB[i];
        gnA[0] = gnB[0]; gnA[1] = gnB[1];
    }
}
#ifndef MK_EXPERTS_IN_SCAN
#define MK_EXPERTS_IN_SCAN 1
#endif
__device__ __forceinline__ void p0_prologue(Frame& F) {
    LAS float* scr = (LAS float*)(F.lds + F.wave * 16384);
    unsigned char* ws = F.ws;
    bf16* gateWT = (bf16*)(ws + WS_SMALLW + SW_GATEW);
    tr_run(F, scr, F.gw, F.NGW, MK_EXPERTS_IN_SCAN ? tri::E12 : tri::NITEMS);
    for (int mb = F.gw; mb < M; mb += 4 * F.NGW) {
        f32x4 v[4][4]; float s[4];
#pragma unroll
        for (int u = 0; u < 4; ++u) { const f32x4* xr = (const f32x4*)(F.ap->in[0] + (size_t)(mb + u * F.NGW) * D) + F.lane;
#pragma unroll
            for (int j = 0; j < 4; ++j) v[u][j] = xr[64 * j]; }
#pragma unroll
        for (int u = 0; u < 4; ++u) { s[u] = 0.f;
#pragma unroll
            for (int j = 0; j < 4; ++j) s[u] += (v[u][j].x * v[u][j].x + v[u][j].y * v[u][j].y) + (v[u][j].z * v[u][j].z + v[u][j].w * v[u][j].w); }
#pragma unroll
        for (int o = 1; o < 64; o <<= 1) {
#pragma unroll
            for (int u = 0; u < 4; ++u) s[u] += __shfl_xor(s[u], o); }
        const f32x4* gr = (const f32x4*)F.ap->in[2] + F.lane;
#pragma unroll
        for (int u = 0; u < 4; ++u) { const float rs = 1.0f / sqrtf(s[u] * (1.f / D) + NORM_EPS); v2u* o8 = (v2u*)((bf16*)(ws + WS_XN) + (size_t)(mb + u * F.NGW) * D) + F.lane;
#pragma unroll
            for (int j = 0; j < 4; ++j) o8[64 * j] = pk4(v[u][j] * rs * gr[64 * j]); }
    }
    {
        float* RW = (float*)(ws + WS_SMALLW + SW_ROUTEW); const float* gf = F.ap->in[25]; const float* wg = F.ap->in[26]; const float* wr = F.ap->in[28];
        for (int idx = F.gw * 64 + F.lane; idx < 48 * 1024; idx += F.NGW * 64) { const int c = idx >> 10, k = idx & 1023; float v = 0.f;
            if (c < 4) v = wg[k * 4 + c]; else if (c < 36) v = wr[k * 32 + (c - 4)];
            RW[idx] = v * gf[k]; }
        for (int idx = F.gw * 64 + F.lane; idx < 8 * 1024; idx += F.NGW * 64) gateWT[24 * 1024 + idx] = 0;
    }
}

struct EpiStoreBf16 {
    static constexpr bool PERM = true;
    bf16* O; int ldc;
    __device__ __forceinline__ void operator()(const f32x4 (&acc)[2][2][4][2], const pg8::Unit& u, int wr, int wc, int fr, int fq) const {
        const int row0 = u.pmo * 256 + wr * 64 + fr, col0 = u.pnl * 256 + wc * 32 + 8 * fq;
#pragma unroll
        for (int ai = 0; ai < 2; ++ai)
#pragma unroll
            for (int m = 0; m < 4; ++m) { bf16* rowp = O + (size_t)(row0 + ai * 128 + m * 16) * ldc + col0;
#pragma unroll
                for (int bj = 0; bj < 2; ++bj) { const f32x4 v0 = acc[ai][bj][m][0], v1 = acc[ai][bj][m][1]; v4u w; w.x = pk2(v0[0], v0[1]); w.y = pk2(v0[2], v0[3]); w.z = pk2(v1[0], v1[1]); w.w = pk2(v1[2], v1[3]);
                    *(v4u*)(rowp + bj * 128) = w; } }
    }
};
struct EpiStoreSsq {
    static constexpr bool PERM = true;
    bf16* O; int ldc; float* part;
    __device__ __forceinline__ void operator()(const f32x4 (&acc)[2][2][4][2], const pg8::Unit& u, int wr, int wc, int fr, int fq) const {
        const int row0 = u.pmo * 256 + wr * 64 + fr, col0 = u.pnl * 256 + wc * 32 + 8 * fq;
#pragma unroll
        for (int ai = 0; ai < 2; ++ai)
#pragma unroll
            for (int m = 0; m < 4; ++m) { bf16* rowp = O + (size_t)(row0 + ai * 128 + m * 16) * ldc + col0; float ss = 0.f;
#pragma unroll
                for (int bj = 0; bj < 2; ++bj) { const f32x4 v0 = acc[ai][bj][m][0], v1 = acc[ai][bj][m][1]; v4u w; w.x = pk2(v0[0], v0[1]); w.y = pk2(v0[2], v0[3]); w.z = pk2(v1[0], v1[1]); w.w = pk2(v1[2], v1[3]);
                    *(v4u*)(rowp + bj * 128) = w;
                    ss += ((v0[0] * v0[0] + v0[1] * v0[1]) + (v0[2] * v0[2] + v0[3] * v0[3])) + ((v1[0] * v1[0] + v1[1] * v1[1]) + (v1[2] * v1[2] + v1[3] * v1[3])); }
                ss += __shfl_xor(ss, 16); ss += __shfl_xor(ss, 32);
                if (fq == 0) part[(size_t)(row0 + ai * 128 + m * 16) * 16 + u.pnl * 4 + wc] = ss; }
    }
};
#define EPI_LOOP_BEGIN \
    _Pragma("unroll") for (int ai = 0; ai < 2; ++ai) _Pragma("unroll") for (int m = 0; m < 4; ++m) { if (m == 0 || m == 2) asm volatile("" ::: "memory"); const int rl = ai * 128 + wr * 64 + m * 16 + fr; const size_t row = (size_t)u.pmo * 256 + rl; (void)row; \
    _Pragma("unroll") for (int bj = 0; bj < 2; ++bj) _Pragma("unroll") for (int n = 0; n < 2; ++n) { const int col = u.pnl * 256 + bj * 128 + wc * 32 + n * 16 + 4 * fq; (void)col; const f32x4 a = acc[ai][bj][m][n];
#define EPI_LOOP_END } }
struct EpiMix {
    static constexpr bool PERM = false;
    const bf16* z; bf16* A; bf16* O;
    __device__ __forceinline__ void operator()(const f32x4 (&acc)[2][2][4][2], const pg8::Unit& u, int wr, int wc, int fr, int fq) const {
        const int zc = u.lt ? ZC_MN : ZC_MR;
        EPI_LOOP_BEGIN
            const f32x4 zz = unpk4(*(const v2u*)(z + row * NZ + zc + col)); f32x4 o;
            o.x = sigmoidf_(zz.x) * a.x; o.y = sigmoidf_(zz.y) * a.y; o.z = sigmoidf_(zz.z) * a.z; o.w = sigmoidf_(zz.w) * a.w;
            if (u.lt == 0) *(v2u*)(A + row * D + col) = pk4(o);
            else { o = o + unpk4(*(const v2u*)(A + row * D + col)); *(v2u*)(O + row * D + col) = pk4(o); }
        EPI_LOOP_END
    }
};
struct ErawOrder {
    static constexpr bool DEP = false;
    pg8::StaticOrder S; int c, G, nheavy;
    __device__ bool next(int i, pg8::Unit& u) const { const int nl = G - nheavy, l = c - nheavy; if (l < 0) return false; const int q = l + i * nl; if (q >= S.nwg) return false;
        pg8::StaticOrder T = S; T.c = q; T.G = S.nwg + 1; return T.next(0, u); }
};
struct DualOrder {
    static constexpr bool DEP = false;
    pg8::StaticOrder S;
    __device__ bool next(int i, pg8::Unit& u) const { if (i >= 2) return false; if (!S.next(0, u)) return false; if (i == 1) { u.pm += 64; u.pn += 4; } u.lt = i; return true; }
};
struct EpiResBf16 {
    static constexpr bool PERM = true;
    const float* base; bf16* O;
    __device__ __forceinline__ void operator()(const f32x4 (&acc)[2][2][4][2], const pg8::Unit& u, int wr, int wc, int fr, int fq) const {
        const int row0 = u.pmo * 256 + wr * 64 + fr, col0 = u.pnl * 256 + wc * 32 + 8 * fq;
#pragma unroll
        for (int ai = 0; ai < 2; ++ai)
#pragma unroll
            for (int m = 0; m < 4; ++m) { if (m == 0 || m == 2) asm volatile("" ::: "memory"); const size_t ro = (size_t)(row0 + ai * 128 + m * 16) * D + col0;
#pragma unroll
                for (int bj = 0; bj < 2; ++bj) { const f32x4 v0 = acc[ai][bj][m][0] + *(const f32x4*)(base + ro + bj * 128), v1 = acc[ai][bj][m][1] + *(const f32x4*)(base + ro + bj * 128 + 4);
                    v4u w; w.x = pk2(v0[0], v0[1]); w.y = pk2(v0[2], v0[3]); w.z = pk2(v1[0], v1[1]); w.w = pk2(v1[2], v1[3]);
                    *(v4u*)(O + ro + bj * 128) = w; } }
    }
};
struct EpiResF32 {
    static constexpr bool PERM = false;
    const float* base; float* O;
    __device__ __forceinline__ void operator()(const f32x4 (&acc)[2][2][4][2], const pg8::Unit& u, int wr, int wc, int fr, int fq) const {
        EPI_LOOP_BEGIN
            *(f32x4*)(O + row * D + col) = *(const f32x4*)(base + row * D + col) + a;
        EPI_LOOP_END
    }
};
struct EpiMoe1 {
    static constexpr bool PERM = false;
    bf16* H; const LAS float* rsl; unsigned* dep;
    __device__ __forceinline__ void operator()(const f32x4 (&acc)[2][2][4][2], const pg8::Unit& u, int wr, int wc, int fr, int fq) const {
#pragma unroll
        for (int ai = 0; ai < 2; ++ai)
#pragma unroll
            for (int m = 0; m < 4; ++m) { const int rl = ai * 128 + wr * 64 + m * 16 + fr; const size_t row = (size_t)u.pmo * 256 + rl; const float rs = rsl[u.pm * 256 + rl];
#pragma unroll
                for (int n = 0; n < 2; ++n) { const f32x4 gt = acc[ai][0][m][n] * rs, up = acc[ai][1][m][n] * rs; f32x4 o;
                    o.x = gt.x * sigmoidf_(gt.x) * up.x; o.y = gt.y * sigmoidf_(gt.y) * up.y; o.z = gt.z * sigmoidf_(gt.z) * up.z; o.w = gt.w * sigmoidf_(gt.w) * up.w;
                    { bf16* hp = H + row * 512 + u.pnl * 128 + wc * 32 + n * 16 + 4 * fq; const v2u hv = pk4(o); asm volatile("global_store_dwordx2 %0, %1, off sc1" :: "v"(hp), "v"(hv) : "memory"); } } }
        asm volatile("s_waitcnt vmcnt(0)" ::: "memory"); __builtin_amdgcn_s_barrier(); asm volatile("" ::: "memory");
        if (threadIdx.x == 0) __hip_atomic_fetch_add(dep + 16 * u.pmo, 1u, __ATOMIC_RELAXED, __HIP_MEMORY_SCOPE_AGENT);
    }
};
struct EpiPle {
    static constexpr bool PERM = false;
    const bf16* x2; const bf16* Eraw; const float* rse; const float* gpn; bf16* O;
    __device__ __forceinline__ void operator()(const f32x4 (&acc)[2][2][4][2], const pg8::Unit& u, int wr, int wc, int fr, int fq) const {
        EPI_LOOP_BEGIN
            const f32x4 e = unpk4(*(const v2u*)(Eraw + row * D + col)); const f32x4 g = *(const f32x4*)(gpn + col); const float rs = rse[row]; f32x4 o = unpk4(*(const v2u*)(x2 + row * D + col));
            o.x += sigmoidf_(a.x) * e.x * rs * g.x; o.y += sigmoidf_(a.y) * e.y * rs * g.y; o.z += sigmoidf_(a.z) * e.z * rs * g.z; o.w += sigmoidf_(a.w) * e.w * rs * g.w;
            *(v2u*)(O + row * D + col) = pk4(o);
        EPI_LOOP_END
    }
};

struct EpiPleNorm {
    static constexpr bool PERM = false;
    const bf16* x2; const bf16* Eraw; const float* rse; const float* gpn; const float* rs3; const float* gfin; float* out; float* xbuf; unsigned* cnt; LAS float* ldsx;
    __device__ __forceinline__ void operator()(const f32x4 (&acc_)[2][2][4][2], const pg8::Unit& u_, int wr, int wc, int fr, int fq) const {
        f32x4 (&acc)[2][2][4][2] = const_cast<f32x4 (&)[2][2][4][2]>(acc_);
        pg8::Unit u = u_; asm volatile("" : "+s"(u.pmo), "+s"(u.pnl)); asm volatile("" : "+v"(fr), "+v"(fq)); asm volatile("" : "+s"(wr), "+s"(wc));
        int tid = threadIdx.x; asm volatile("" : "+v"(tid)); const int lane = tid & 63, wid = __builtin_amdgcn_readfirstlane(tid >> 6);
        LAS float* Pl = ldsx; LAS float* Sl = ldsx + 1024; LAS unsigned* flag = (LAS unsigned*)(ldsx + 1280);
#pragma unroll
        for (int ai = 0; ai < 2; ++ai)
#pragma unroll
            for (int m = 0; m < 4; ++m) { if (m == 0 || m == 2) asm volatile("" ::: "memory"); const int rl = ai * 128 + wr * 64 + m * 16 + fr; const size_t row = (size_t)u.pmo * 256 + rl;
                float ss = 0.f; const float r3 = rs3[row], re = rse[row];
#pragma unroll
                for (int bj = 0; bj < 2; ++bj)
#pragma unroll
                    for (int n = 0; n < 2; ++n) { const int col = u.pnl * 256 + bj * 128 + wc * 32 + n * 16 + 4 * fq; const f32x4 a = acc[ai][bj][m][n];
                        const f32x4 e = unpk4(*(const v2u*)(Eraw + row * D + col)) * re * *(const f32x4*)(gpn + col); f32x4 o = unpk4(*(const v2u*)(x2 + row * D + col));
                        o.x += sigmoidf_(a.x * r3) * e.x; o.y += sigmoidf_(a.y * r3) * e.y; o.z += sigmoidf_(a.z * r3) * e.z; o.w += sigmoidf_(a.w * r3) * e.w;
                        acc[ai][bj][m][n] = o; ss += (o.x * o.x + o.y * o.y) + (o.z * o.z + o.w * o.w); }
                ss += __shfl_xor(ss, 16); ss += __shfl_xor(ss, 32);
                if (fq == 0) Pl[rl * 4 + wc] = ss; }
        asm volatile("s_waitcnt lgkmcnt(0)" ::: "memory"); __builtin_amdgcn_s_barrier(); asm volatile("" ::: "memory");
        if (tid < 256) { const float tot = (Pl[tid * 4 + 0] + Pl[tid * 4 + 1]) + (Pl[tid * 4 + 2] + Pl[tid * 4 + 3]);
            __hip_atomic_store(xbuf + ((size_t)u.pmo * 256 + tid) * 4 + u.pnl, tot, __ATOMIC_RELAXED, __HIP_MEMORY_SCOPE_AGENT);
            asm volatile("s_waitcnt vmcnt(0)" ::: "memory");
            if (lane == 0) __hip_atomic_fetch_add(cnt + 64 * u.pmo, 1u, __ATOMIC_RELAXED, __HIP_MEMORY_SCOPE_AGENT); }
        if (wid == 0) {
            unsigned spins = 0;
            while ((unsigned)__builtin_amdgcn_readfirstlane((int)__hip_atomic_load(cnt + 64 * u.pmo, __ATOMIC_RELAXED, __HIP_MEMORY_SCOPE_AGENT)) < 16u) { __builtin_amdgcn_s_sleep(2); if (++spins > (1u << 22)) break; }
            __builtin_amdgcn_fence(__ATOMIC_ACQUIRE, "agent");
            if (lane == 0) flag[0] = 1u; }
        asm volatile("s_waitcnt vmcnt(0) lgkmcnt(0)" ::: "memory"); __builtin_amdgcn_s_barrier(); asm volatile("" ::: "memory");
        if (tid < 256) { const float* sp = xbuf + ((size_t)u.pmo * 256 + tid) * 4; float tot = 0.f;
#pragma unroll
            for (int t = 0; t < 4; ++t) tot += __hip_atomic_load(sp + t, __ATOMIC_RELAXED, __HIP_MEMORY_SCOPE_AGENT);
            Sl[tid] = 1.0f / sqrtf(tot * (1.f / D) + NORM_EPS); }
        asm volatile("s_waitcnt vmcnt(0) lgkmcnt(0)" ::: "memory"); __builtin_amdgcn_s_barrier(); asm volatile("" ::: "memory");
#pragma unroll
        for (int ai = 0; ai < 2; ++ai)
#pragma unroll
            for (int m = 0; m < 4; ++m) { const int rl = ai * 128 + wr * 64 + m * 16 + fr; const size_t row = (size_t)u.pmo * 256 + rl; const float rs = Sl[rl];
#pragma unroll
                for (int bj = 0; bj < 2; ++bj)
#pragma unroll
                    for (int n = 0; n < 2; ++n) { const int col = u.pnl * 256 + bj * 128 + wc * 32 + n * 16 + 4 * fq; *(f32x4*)(out + row * D + col) = acc[ai][bj][m][n] * rs * *(const f32x4*)(gfin + col); } }
    }
};

__device__ __forceinline__ float gelu_tanh(float x) { const float u = 0.7978845608028654f * (x + 0.044715f * x * x * x); const float t = 1.0f - 2.0f * __builtin_amdgcn_rcpf(__expf(2.0f * u) + 1.0f); return 0.5f * x * (1.0f + t); }

__device__ __forceinline__ void compress_wg_task(Frame& F, int idx) {
    const int kv = idx & 1, tile8 = (idx >> 1) & 7, bg = idx >> 4, b = bg >> 1, g = bg & 1;
    const int fr = F.lane & 15, fq = F.lane >> 4;
    const bf16* z = (const bf16*)(F.ws + WS_Z);
    const bf16* w1T = (const bf16*)(F.ws + WS_SMALLW + (kv ? SW_CV1 : SW_CK1));
    const bf16* w2T = (const bf16*)(F.ws + WS_SMALLW + (kv ? SW_CV2 : SW_CK2));
    const float* pos = kv ? F.ap->in[16] : F.ap->in[15];
    const int j0 = 16 * tile8; int j = j0 + fr; const bool jvalid = j < 127; if (!jvalid) j = 126;
    const bf16* zb = z + ((size_t)b * SEQ + 16 * j) * NZ + (kv ? ZC_VC : ZC_KC) + g * 64;
    v4u zr[8]; f32x4 p0[8], p1[8]; bf16x8 aop[8][4];
#pragma unroll
    for (int i = 0; i < 8; ++i) { const int ks = 8 * F.wave + i, l = ks >> 1, d = 32 * (ks & 1) + 8 * fq;
        zr[i] = *(const v4u*)(zb + (size_t)l * NZ + d); p0[i] = *(const f32x4*)(pos + l * 64 + d); p1[i] = *(const f32x4*)(pos + l * 64 + d + 4);
#pragma unroll
        for (int mt = 0; mt < 4; ++mt) aop[i][mt] = *(const bf16x8*)(w1T + (size_t)(16 * mt + fr) * 2048 + 32 * ks + 8 * fq); }
    f32x4 acc[4];
#pragma unroll
    for (int mt = 0; mt < 4; ++mt) acc[mt] = (f32x4){0.f, 0.f, 0.f, 0.f};
#pragma unroll
    for (int i = 0; i < 8; ++i) {
        float f[8]; unpk8(zr[i], f);
        v4u bb; bb.x = pk2(f[0] + p0[i].x, f[1] + p0[i].y); bb.y = pk2(f[2] + p0[i].z, f[3] + p0[i].w); bb.z = pk2(f[4] + p1[i].x, f[5] + p1[i].y); bb.w = pk2(f[6] + p1[i].z, f[7] + p1[i].w);
        const bf16x8 bop = __builtin_bit_cast(bf16x8, bb);
#pragma unroll
        for (int mt = 0; mt < 4; ++mt) acc[mt] = MFMA16(aop[i][mt], bop, acc[mt]);
    }
    LAS float* red = (LAS float*)F.lds;
    __syncthreads();
#pragma unroll
    for (int mt = 0; mt < 4; ++mt) *(LAS f32x4*)(red + ((F.wave * 4 + mt) * 64 + F.lane) * 4) = acc[mt];
    LDS_WAIT(); __syncthreads();
    if (F.wave != 0) return;
#pragma unroll
    for (int mt = 0; mt < 4; ++mt) { f32x4 t = (f32x4){0.f, 0.f, 0.f, 0.f};
#pragma unroll
        for (int w = 0; w < 8; ++w) t = t + *(const LAS f32x4*)(red + ((w * 4 + mt) * 64 + F.lane) * 4);
        acc[mt] = t; }
    bf16x8 hb[2];
#pragma unroll
    for (int s2 = 0; s2 < 2; ++s2) { v4u w; const f32x4 a0 = acc[2 * s2], a1 = acc[2 * s2 + 1];
        w.x = pk2(gelu_tanh(a0.x), gelu_tanh(a0.y)); w.y = pk2(gelu_tanh(a0.z), gelu_tanh(a0.w)); w.z = pk2(gelu_tanh(a1.x), gelu_tanh(a1.y)); w.w = pk2(gelu_tanh(a1.z), gelu_tanh(a1.w));
        hb[s2] = __builtin_bit_cast(bf16x8, w); }
    bf16* kcmp = (bf16*)(F.ws + WS_KCMP); bf16* vcmpT = (bf16*)(F.ws + WS_KCMP + 512 * 1024);
#pragma unroll
    for (int ntl = 0; ntl < 4; ++ntl) {
        f32x4 o = (f32x4){0.f, 0.f, 0.f, 0.f};
#pragma unroll
        for (int s2 = 0; s2 < 2; ++s2) { const bf16* wp = w2T + (size_t)(16 * ntl + fr) * 64 + 32 * s2 + 4 * fq; const v2u lo = *(const v2u*)wp, hi = *(const v2u*)(wp + 16);
            v4u aw; aw.x = lo.x; aw.y = lo.y; aw.z = hi.x; aw.w = hi.y; o = MFMA16(__builtin_bit_cast(bf16x8, aw), hb[s2], o); }
        if (!jvalid) o = (f32x4){0.f, 0.f, 0.f, 0.f};
        const int jj = j0 + fr, n = 16 * ntl + 4 * fq;
        if (kv == 0) *(v2u*)(kcmp + ((size_t)bg * 128 + jj) * 64 + n) = pk4(o);
        else { const v2u w = pk4(o); bf16* vp = vcmpT + ((size_t)bg * 64 + n) * 128 + jj; vp[0] = (bf16)(w.x & 0xffff); vp[128] = (bf16)(w.x >> 16); vp[256] = (bf16)(w.y & 0xffff); vp[384] = (bf16)(w.y >> 16); }
    }
}
__device__ __forceinline__ void zgate_task(Frame& F, int tile) {
    const int fr = F.lane & 15, fq = F.lane >> 4, m0 = tile * 16;
    const bf16* XN = (const bf16*)(F.ws + WS_XN); const bf16* gw = (const bf16*)(F.ws + WS_SMALLW + SW_GATEW);
    f32x4 acc[2] = {(f32x4){0.f, 0.f, 0.f, 0.f}, (f32x4){0.f, 0.f, 0.f, 0.f}};
#pragma unroll 16
    for (int ks = 0; ks < 32; ++ks) {
        const bf16x8 bop = *(const bf16x8*)(XN + (size_t)(m0 + fr) * D + 32 * ks + 8 * fq);
#pragma unroll
        for (int ct = 0; ct < 2; ++ct) { const bf16x8 aop = *(const bf16x8*)(gw + (size_t)(16 * ct + fr) * D + 32 * ks + 8 * fq); acc[ct] = MFMA16(aop, bop, acc[ct]); }
    }
    float* zg = (float*)(F.ws + WS_ZGATE);
#pragma unroll
    for (int ct = 0; ct < 2; ++ct) *(f32x4*)(zg + (size_t)(m0 + fr) * 32 + 16 * ct + 4 * fq) = acc[ct];
}
__device__ __forceinline__ void vt_task(Frame& F, int idx) {
    const int which = idx & 1, blk = (idx >> 1) & 31, bg = idx >> 6, b = bg >> 1, g = bg & 1;
    const bf16* z = (const bf16*)(F.ws + WS_Z);
    bf16* vT = (bf16*)(F.ws + (which ? WS_VWT : WS_VST));
    const int t = 64 * blk + F.lane;
    const bf16* src = z + ((size_t)b * SEQ + t) * NZ + (which ? ZC_VW : ZC_VS) + g * 64;
#pragma unroll
    for (int dc = 0; dc < 8; ++dc) { const v4u w = *(const v4u*)(src + 8 * dc); bf16* dst = vT + ((size_t)bg * 64 + 8 * dc) * SEQ + t;
        dst[0 * SEQ] = (bf16)(w.x & 0xffff); dst[1 * SEQ] = (bf16)(w.x >> 16); dst[2 * SEQ] = (bf16)(w.y & 0xffff); dst[3 * SEQ] = (bf16)(w.y >> 16);
        dst[4 * SEQ] = (bf16)(w.z & 0xffff); dst[5 * SEQ] = (bf16)(w.z >> 16); dst[6 * SEQ] = (bf16)(w.w & 0xffff); dst[7 * SEQ] = (bf16)(w.w >> 16); }
}
__device__ __forceinline__ void alora_task4(Frame& F, int mb) {
    const bf16* z = (const bf16*)(F.ws + WS_Z); bf16* AL = (bf16*)(F.ws + WS_PBF);
    const int l = F.lane;
    const f32x4 mu = *(const f32x4*)(F.ap->in[4] + ZC_W + 4 * l);
    v2u cw[4], pw[4];
#pragma unroll
    for (int u = 0; u < 4; ++u) { const int m = mb + u * F.NGW; const int t = m & (SEQ - 1); cw[u] = *(const v2u*)(z + (size_t)m * NZ + ZC_W + 4 * l); pw[u] = *(const v2u*)(z + (size_t)(t > 0 ? m - 1 : m) * NZ + ZC_W + 4 * l); }
#pragma unroll
    for (int u = 0; u < 4; ++u) { const int m = mb + u * F.NGW; const int t = m & (SEQ - 1);
        const f32x4 cur = unpk4(cw[u]); const f32x4 prev = unpk4(pw[u]) * (t > 0 ? 1.0f : 0.0f);
        f32x4 s = cur + (prev - cur) * mu;
        if (l < 16) { s.x = tanhf(s.x); s.y = tanhf(s.y); s.z = tanhf(s.z); s.w = tanhf(s.w); }
        else if (l >= 32) { s.x = sigmoidf_(s.x); s.y = sigmoidf_(s.y); s.z = sigmoidf_(s.z); s.w = sigmoidf_(s.w); }
        *(v2u*)(AL + (size_t)m * 256 + 4 * l) = pk4(s); }
}
__device__ __forceinline__ void p2_prep(Frame& F) {
    constexpr int T1 = 1024, T2 = T1 + 1024;
    for (int it = F.vcu; it < 256; it += F.G) compress_wg_task(F, it);
    for (int task = F.gw; task < T2; task += F.NGW) {
        if (task < T1) zgate_task(F, task);
        else vt_task(F, task - T1);
    }
    for (int base = F.gw; base < M; base += 4 * F.NGW) alora_task4(F, base);
}

__device__ __forceinline__ void ld16(const bf16* p, float (&f)[16]) { float a[8], b[8]; unpk8(*(const v4u*)p, a); unpk8(*(const v4u*)(p + 8), b);
#pragma unroll
    for (int i = 0; i < 8; ++i) { f[i] = a[i]; f[8 + i] = b[i]; } }
__device__ __forceinline__ void ld16f(const float* p, float (&f)[16]) {
#pragma unroll
    for (int q = 0; q < 4; ++q) { const f32x4 v = *(const f32x4*)(p + 4 * q); f[4 * q] = v.x; f[4 * q + 1] = v.y; f[4 * q + 2] = v.z; f[4 * q + 3] = v.w; } }
__device__ __forceinline__ void st16(bf16* p, const float (&f)[16]) { v4u a, b; a.x = pk2(f[0], f[1]); a.y = pk2(f[2], f[3]); a.z = pk2(f[4], f[5]); a.w = pk2(f[6], f[7]); b.x = pk2(f[8], f[9]); b.y = pk2(f[10], f[11]); b.z = pk2(f[12], f[13]); b.w = pk2(f[14], f[15]);
    *(v4u*)p = a; *(v4u*)(p + 8) = b; }
struct PrepW { bf16x8 w[2], a[2], g[4]; };
constexpr int PW_OFF = 32768, PW_P64 = 144, PW_P128 = 272, PW_A_OFF = PW_OFF + 64 * PW_P64, PW_G_OFF = PW_A_OFF + 64 * PW_P64;
__device__ __forceinline__ void prep_stage_w(Frame& F, int h) {
    const bf16* w2T = (const bf16*)(F.ws + WS_SMALLW + SW_W2T) + (size_t)h * 64 * 64; const bf16* a2T = (const bf16*)(F.ws + WS_SMALLW + SW_A2T) + (size_t)h * 64 * 64; const bf16* g2T = (const bf16*)(F.ws + WS_SMALLW + SW_G2T) + (size_t)h * 64 * 128;
    { const int R = F.tid >> 3, c = F.tid & 7, slot = ((R >> 2) & 3) * 16 + (R >> 4) * 4 + (R & 3);
      *(LAS v4u*)(F.lds + PW_OFF + slot * PW_P64 + c * 16) = *(const v4u*)(w2T + R * 64 + c * 8); *(LAS v4u*)(F.lds + PW_A_OFF + slot * PW_P64 + c * 16) = *(const v4u*)(a2T + R * 64 + c * 8); }
#pragma unroll
    for (int i = 0; i < 2; ++i) { const int id = F.tid + 512 * i, R = id >> 4, c = id & 15, slot = ((R >> 2) & 3) * 16 + (R >> 4) * 4 + (R & 3);
      *(LAS v4u*)(F.lds + PW_G_OFF + slot * PW_P128 + c * 16) = *(const v4u*)(g2T + R * 128 + c * 8); }
}
__device__ __forceinline__ void prep_ldw(PrepW& W, const LAS unsigned char* lds, int n, int fr, int fq) {
#pragma unroll
    for (int ks = 0; ks < 2; ++ks) { W.w[ks] = *(const LAS bf16x8*)(lds + PW_OFF + (n * 16 + fr) * PW_P64 + 64 * ks + 16 * fq); W.a[ks] = *(const LAS bf16x8*)(lds + PW_A_OFF + (n * 16 + fr) * PW_P64 + 64 * ks + 16 * fq); }
#pragma unroll
    for (int ks = 0; ks < 4; ++ks) W.g[ks] = *(const LAS bf16x8*)(lds + PW_G_OFF + (n * 16 + fr) * PW_P128 + 64 * ks + 16 * fq);
}
__device__ __forceinline__ void ldpar(const LAS float* p, float (&f)[16]) {
#pragma unroll
    for (int q = 0; q < 4; ++q) { const f32x4 v = *(const LAS f32x4*)(p + 4 * q); f[4 * q] = v.x; f[4 * q + 1] = v.y; f[4 * q + 2] = v.z; f[4 * q + 3] = v.w; } }
__device__ __forceinline__ void rwkv_prep_task(Frame& F, int task, const LAS float* par) {
    const int h = task & 7, m0 = (task >> 3) * 16, fr = F.lane & 15, fq = F.lane >> 4, m = m0 + fr, t = m & (SEQ - 1);
    const bf16* z = (const bf16*)(F.ws + WS_Z); const bf16* AL = (const bf16*)(F.ws + WS_PBF);
    bf16* vbuf = (bf16*)F.out; bf16* gbuf = (bf16*)(F.ws + WS_G);
    const int cl = h * 64 + 16 * fq;
    bf16x8 bw[2], ba[2], bgf[4];
    const bf16* alr = AL + (size_t)m * 256 + 8 * fq;
#pragma unroll
    for (int ks = 0; ks < 2; ++ks) { bw[ks] = *(const bf16x8*)(alr + 32 * ks); ba[ks] = *(const bf16x8*)(alr + 64 + 32 * ks); }
#pragma unroll
    for (int ks = 0; ks < 4; ++ks) bgf[ks] = *(const bf16x8*)(alr + 128 + 32 * ks);
    const bf16* zc = z + (size_t)m * NZ + cl; const bf16* zp = (t > 0) ? zc - NZ : zc;
    v4u zraw[6][2];
#pragma unroll
    for (int q = 0; q < 3; ++q) { zraw[q][0] = *(const v4u*)(zc + 512 * q); zraw[q][1] = *(const v4u*)(zc + 512 * q + 8); zraw[3 + q][0] = *(const v4u*)(zp + 512 * q); zraw[3 + q][1] = *(const v4u*)(zp + 512 * q + 8); }
    __builtin_amdgcn_sched_barrier(0);
    float ev[16], av[16], gv[16];
#define PREP_MM(W, n) do { f32x4 accw = (f32x4){0.f, 0.f, 0.f, 0.f}, acca = accw, accg = accw; \
        _Pragma("unroll") for (int ks = 0; ks < 2; ++ks) { accw = MFMA16(W.w[ks], bw[ks], accw); acca = MFMA16(W.a[ks], ba[ks], acca); } \
        _Pragma("unroll") for (int ks = 0; ks < 4; ++ks) accg = MFMA16(W.g[ks], bgf[ks], accg); \
        _Pragma("unroll") for (int r = 0; r < 4; ++r) { ev[4 * (n) + r] = accw[r]; av[4 * (n) + r] = acca[r]; gv[4 * (n) + r] = accg[r]; } } while (0)
    { PrepW Wa, Wb;
      prep_ldw(Wa, F.lds, 0, fr, fq); prep_ldw(Wb, F.lds, 1, fr, fq); PREP_MM(Wa, 0); PREP_MM(Wb, 1);
      prep_ldw(Wa, F.lds, 2, fr, fq); prep_ldw(Wb, F.lds, 3, fr, fq); PREP_MM(Wa, 2); PREP_MM(Wb, 3); }
    float zr[16], zk[16], zv[16], tmp[16];
    const float pm = (t > 0) ? 1.0f : 0.0f;
    {   float c[16], p[16];
#define PREP_UNP(q, dst) do { float a_[8], b_[8]; unpk8(zraw[q][0], a_); unpk8(zraw[q][1], b_); _Pragma("unroll") for (int i = 0; i < 8; ++i) { dst[i] = a_[i]; dst[8 + i] = b_[i]; } } while (0)
        PREP_UNP(0, c); PREP_UNP(3, p); ldpar(par + 0 * 64 + 16 * fq, tmp);
#pragma unroll
        for (int e = 0; e < 16; ++e) zr[e] = c[e] + (p[e] * pm - c[e]) * tmp[e];
        PREP_UNP(1, c); PREP_UNP(4, p); ldpar(par + 1 * 64 + 16 * fq, tmp);
#pragma unroll
        for (int e = 0; e < 16; ++e) zk[e] = c[e] + (p[e] * pm - c[e]) * tmp[e];
        PREP_UNP(2, c); PREP_UNP(5, p); ldpar(par + 2 * 64 + 16 * fq, tmp);
#pragma unroll
        for (int e = 0; e < 16; ++e) zv[e] = c[e] + (p[e] * pm - c[e]) * tmp[e];
    }
    float kkr[16]; float ss = 0.f;
    ldpar(par + 3 * 64 + 16 * fq, tmp);
#pragma unroll
    for (int e = 0; e < 16; ++e) { const float x = -(tmp[e] + ev[e]); const float sp = fmaxf(x, 0.f) + __logf(1.0f + __expf(-fabsf(x))); ev[e] = __expf(-sp - 0.5f); }
    ldpar(par + 4 * 64 + 16 * fq, tmp);
#pragma unroll
    for (int e = 0; e < 16; ++e) av[e] = sigmoidf_(tmp[e] + av[e]);
    ldpar(par + 5 * 64 + 16 * fq, tmp);
#pragma unroll
    for (int e = 0; e < 16; ++e) { kkr[e] = zk[e] * tmp[e]; ss += kkr[e] * kkr[e]; }
    ss += __shfl_xor(ss, 16); ss += __shfl_xor(ss, 32);
    const float inv = 1.0f / fmaxf(sqrtf(ss), 1e-12f);
    ldpar(par + 6 * 64 + 16 * fq, tmp);
    float kp[16], kka[16];
#pragma unroll
    for (int e = 0; e < 16; ++e) { kkr[e] *= inv; kka[e] = kkr[e] * av[e]; kp[e] = zk[e] * (1.0f + (av[e] - 1.0f) * tmp[e]); }
    st16(vbuf + (size_t)m * 512 + cl, zv); st16(gbuf + (size_t)m * 512 + cl, gv);
    { ldpar(par + 7 * 64 + 16 * fq, tmp);
      float bsum = 0.f;
#pragma unroll
      for (int e = 0; e < 16; ++e) bsum += zr[e] * kp[e] * tmp[e];
      bsum += __shfl_xor(bsum, 16); bsum += __shfl_xor(bsum, 32);
      if (fq == 0) ((float*)(F.ws + WS_BONUS))[(size_t)m * 8 + h] = bsum; }
    asm volatile("" ::: "memory");
    unsigned char* rec = F.ws + WS_S + (size_t)task * CH_REC;
    bf16x8 Pb[2], Qb[2], Kb[2], Rb[2];
#pragma unroll
    for (int ks = 0; ks < 2; ++ks) {
        float Pm[8], Qm[8], Km[8], Rm[8], acv[8];
#pragma unroll
        for (int e8 = 0; e8 < 8; ++e8) { const int e = 8 * ks + e8;
            float cs = ev[e]; cs += dppf<0x111>(cs); cs += dppf<0x112>(cs); cs += dppf<0x114>(cs); cs += dppf<0x118>(cs);
            const float A = __expf(-cs), Ap = __expf(ev[e] - cs), iA = __expf(cs);
            Pm[e8] = kkr[e] * Ap; Qm[e8] = -kka[e] * iA; Km[e8] = kp[e] * iA; Rm[e8] = zr[e] * A; acv[e8] = A; }
        v4u w;
        w.x = pk2(Pm[0], Pm[1]); w.y = pk2(Pm[2], Pm[3]); w.z = pk2(Pm[4], Pm[5]); w.w = pk2(Pm[6], Pm[7]); Pb[ks] = __builtin_bit_cast(bf16x8, w);
        w.x = pk2(Qm[0], Qm[1]); w.y = pk2(Qm[2], Qm[3]); w.z = pk2(Qm[4], Qm[5]); w.w = pk2(Qm[6], Qm[7]); Qb[ks] = __builtin_bit_cast(bf16x8, w);
        w.x = pk2(Km[0], Km[1]); w.y = pk2(Km[2], Km[3]); w.z = pk2(Km[4], Km[5]); w.w = pk2(Km[6], Km[7]); Kb[ks] = __builtin_bit_cast(bf16x8, w);
        w.x = pk2(Rm[0], Rm[1]); w.y = pk2(Rm[2], Rm[3]); w.z = pk2(Rm[4], Rm[5]); w.w = pk2(Rm[6], Rm[7]); Rb[ks] = __builtin_bit_cast(bf16x8, w);
        if (fr == 15) { *(f32x4*)(rec + CH_AC + (16 * fq + 8 * ks) * 4) = (f32x4){acv[0], acv[1], acv[2], acv[3]}; *(f32x4*)(rec + CH_AC + (16 * fq + 8 * ks + 4) * 4) = (f32x4){acv[4], acv[5], acv[6], acv[7]}; }
    }
    *(v4u*)(rec + CH_P + fr * CH_PP + 32 * fq) = __builtin_bit_cast(v4u, Pb[0]); *(v4u*)(rec + CH_P + fr * CH_PP + 32 * fq + 16) = __builtin_bit_cast(v4u, Pb[1]);
    *(v4u*)(rec + CH_R + fr * CH_PP + 32 * fq) = __builtin_bit_cast(v4u, Rb[0]); *(v4u*)(rec + CH_R + fr * CH_PP + 32 * fq + 16) = __builtin_bit_cast(v4u, Rb[1]);
    *(v4u*)(rec + CH_Q + (fq * 16 + fr) * 32) = __builtin_bit_cast(v4u, Qb[0]); *(v4u*)(rec + CH_Q + (fq * 16 + fr) * 32 + 16) = __builtin_bit_cast(v4u, Qb[1]);
    *(v4u*)(rec + CH_K + (fq * 16 + fr) * 32) = __builtin_bit_cast(v4u, Kb[0]); *(v4u*)(rec + CH_K + (fq * 16 + fr) * 32 + 16) = __builtin_bit_cast(v4u, Kb[1]);
    f32x4 gqp = (f32x4){0.f, 0.f, 0.f, 0.f}, gkp = gqp, gqr = gqp, gkr = gqp;
#pragma unroll
    for (int ks = 0; ks < 2; ++ks) { gqp = MFMA16(Qb[ks], Pb[ks], gqp); gkp = MFMA16(Kb[ks], Pb[ks], gkp); gqr = MFMA16(Qb[ks], Rb[ks], gqr); gkr = MFMA16(Kb[ks], Rb[ks], gkr); }
#pragma unroll
    for (int rg = 0; rg < 4; ++rg) { const int s = 4 * fq + rg; if (!(s < fr)) { gqp[rg] = 0.f; gkp[rg] = 0.f; } if (!(s <= fr)) { gqr[rg] = 0.f; gkr[rg] = 0.f; } }
    *(v2u*)(rec + CH_G + 0 * 512 + (fr * 16 + 4 * fq) * 2) = pk4(gkp);
    *(v2u*)(rec + CH_G + 2 * 512 + (fr * 16 + 4 * fq) * 2) = pk4(gqr);
    *(v2u*)(rec + CH_G + 3 * 512 + (fr * 16 + 4 * fq) * 2) = pk4(gkr);
    LAS float* Nl = (LAS float*)(F.lds + F.wave * 4096);
#pragma unroll
    for (int rg = 0; rg < 4; ++rg) Nl[(4 * fq + rg) * 20 + fr] = gqp[rg];
    LDS_WAIT(); __builtin_amdgcn_wave_barrier(); asm volatile("" ::: "memory");
    float Tc[16];
#pragma unroll
    for (int s = 15; s >= 0; --s) {
        float acc = 0.f;
#pragma unroll
        for (int q4 = 0; q4 < 4; ++q4) if (4 * q4 + 3 > s) { const f32x4 nv = *(const LAS f32x4*)(Nl + s * 20 + 4 * q4);
#pragma unroll
            for (int u = 0; u < 4; ++u) if (4 * q4 + u > s) acc += nv[u] * Tc[4 * q4 + u]; }
        Tc[s] = (s == fr) ? 1.0f : acc; }
    { f32x4 tv;
#pragma unroll
      for (int u = 0; u < 4; ++u) tv[u] = fq == 0 ? Tc[u] : (fq == 1 ? Tc[4 + u] : (fq == 2 ? Tc[8 + u] : Tc[12 + u]));
      *(v2u*)(rec + CH_G + 1 * 512 + (fr * 16 + 4 * fq) * 2) = pk4(tv); }
    LDS_WAIT(); __builtin_amdgcn_wave_barrier(); asm volatile("" ::: "memory");
#undef PREP_MM
#undef PREP_UNP
}
__device__ __forceinline__ void prep_fill_par(Frame& F, LAS float* par, int h) {
    const int l = F.lane; const float* mu = F.ap->in[4];
    par[0 * 64 + l] = mu[ZC_R + h * 64 + l]; par[1 * 64 + l] = mu[ZC_K + h * 64 + l]; par[2 * 64 + l] = mu[ZC_V + h * 64 + l];
    par[3 * 64 + l] = F.ap->in[5][h * 64 + l]; par[4 * 64 + l] = F.ap->in[7][h * 64 + l]; par[5 * 64 + l] = F.ap->in[10][h * 64 + l]; par[6 * 64 + l] = F.ap->in[11][h * 64 + l]; par[7 * 64 + l] = F.ap->in[12][h * 64 + l];
    LDS_WAIT(); __builtin_amdgcn_wave_barrier(); asm volatile("" ::: "memory");
}

__device__ __forceinline__ float nsa_slope(int g, int r) { return __uint_as_float((unsigned)(127 - (g * 4 + r + 1)) << 23); }

constexpr int CMP_KC_OFF = 32768, CMP_KP = 144, CMP_VC_OFF = CMP_KC_OFF + 128 * CMP_KP, CMP_VP = 264;
__device__ __forceinline__ void nsa_cmp_stage(Frame& F, int bg) {
    const bf16* kcmp = (const bf16*)(F.ws + WS_KCMP) + (size_t)bg * 128 * 64; const bf16* vcmpT = (const bf16*)(F.ws + WS_KCMP + 512 * 1024) + (size_t)bg * 64 * 128;
    v4u a[2], v[2];
#pragma unroll
    for (int i = 0; i < 2; ++i) { const int id = F.tid + 512 * i; a[i] = *(const v4u*)(kcmp + (size_t)(id >> 3) * 64 + (id & 7) * 8); v[i] = *(const v4u*)(vcmpT + (size_t)(id >> 4) * 128 + (id & 15) * 8); }
#pragma unroll
    for (int i = 0; i < 2; ++i) { const int id = F.tid + 512 * i; *(LAS v4u*)(F.lds + CMP_KC_OFF + (id >> 3) * CMP_KP + (id & 7) * 16) = a[i]; *(LAS v4u*)(F.lds + CMP_VC_OFF + (id >> 4) * CMP_VP + (id & 15) * 16) = v[i]; }
}
template <int ABL>
__device__ __forceinline__ void nsa_cmp_task(Frame& F, int task) {
    const int tile = task & 127, bg = task >> 7, b = bg >> 1, g = bg & 1;
    const int fr = F.lane & 15, fq = F.lane >> 4, t = tile * 16 + fr, m = b * SEQ + t;
    const bf16* z = (const bf16*)(F.ws + WS_Z);
    const float* zg = (const float*)(F.ws + WS_ZGATE); const float* gb = F.ap->in[21];
    bf16* Y = (bf16*)(F.ws + WS_YB);
    bf16x8 qall[4][2]; float gl[4];
#pragma unroll
    for (int r = 0; r < 4; ++r) { const bf16* qp = z + (size_t)m * NZ + ZC_Q + (g * 4 + r) * 64 + 8 * fq; qall[r][0] = *(const bf16x8*)qp; qall[r][1] = *(const bf16x8*)(qp + 32);
        gl[r] = zg[(size_t)m * 32 + (g * 4 + r) * 3 + 0] + gb[(g * 4 + r) * 3 + 0]; }
    const LAS unsigned char* kc = F.lds + CMP_KC_OFF + fr * CMP_KP + 16 * fq; const LAS unsigned char* vc = F.lds + CMP_VC_OFF + fr * CMP_VP + 8 * fq;
    const int tv = t - 31 - 64 * fq; const float tb = (float)t - 15.5f - 64.0f * (float)fq;
    float impl[8], imp3[8];
#pragma unroll
    for (int kt = 0; kt < 8; ++kt) { impl[kt] = 0.f; imp3[kt] = 0.f; }
#pragma unroll
    for (int r = 0; r < 4; ++r) {
        const float slope = nsa_slope(g, r);
        const bf16x8 q0 = qall[r][0], q1 = qall[r][1];
        float s[8][4]; float mx = -1e30f;
#pragma unroll
        for (int kt = 0; kt < 8; ++kt) {
            f32x4 a = (f32x4){0.f, 0.f, 0.f, 0.f};
            a = MFMA16(*(const LAS bf16x8*)(kc + 16 * kt * CMP_KP), q0, a); a = MFMA16(*(const LAS bf16x8*)(kc + 16 * kt * CMP_KP + 64), q1, a);
#pragma unroll
            for (int rg = 0; rg < 4; ++rg) { const bool valid = ((256 * kt + 16 * rg) <= tv);
                const float sc = a[rg] * 0.125f - slope * (tb - (float)(256 * kt + 16 * rg)); s[kt][rg] = valid ? sc : -1e30f; mx = fmaxf(mx, s[kt][rg]); }
        }
        mx = fmaxf(mx, __shfl_xor(mx, 16)); mx = fmaxf(mx, __shfl_xor(mx, 32));
        float sum = 0.f;
#pragma unroll
        for (int kt = 0; kt < 8; ++kt)
#pragma unroll
            for (int rg = 0; rg < 4; ++rg) { const float p = (s[kt][rg] > -1e29f) ? __expf(s[kt][rg] - mx) : 0.f; s[kt][rg] = p; sum += p; }
        sum += __shfl_xor(sum, 16); sum += __shfl_xor(sum, 32);
        const float inv = sum > 0.f ? 1.0f / sum : 0.f;
#pragma unroll
        for (int kt = 0; kt < 8; ++kt) {
#pragma unroll
            for (int rg = 0; rg < 4; ++rg) s[kt][rg] *= inv;
            impl[kt] += s[kt][0] + s[kt][1] + s[kt][2] + 0.5f * s[kt][3]; imp3[kt] += s[kt][3]; }
        f32x4 o[4];
#pragma unroll
        for (int dt = 0; dt < 4; ++dt) o[dt] = (f32x4){0.f, 0.f, 0.f, 0.f};
#pragma unroll
        for (int s2 = 0; s2 < 4; ++s2) {
            v4u pw; pw.x = pk2(s[2 * s2][0], s[2 * s2][1]); pw.y = pk2(s[2 * s2][2], s[2 * s2][3]); pw.z = pk2(s[2 * s2 + 1][0], s[2 * s2 + 1][1]); pw.w = pk2(s[2 * s2 + 1][2], s[2 * s2 + 1][3]);
            const bf16x8 pb = __builtin_bit_cast(bf16x8, pw);
#pragma unroll
            for (int dt = 0; dt < 4; ++dt) { const LAS unsigned char* vp = vc + 16 * dt * CMP_VP + 64 * s2; const v2u lo = *(const LAS v2u*)vp, hi = *(const LAS v2u*)(vp + 32);
                v4u aw; aw.x = lo.x; aw.y = lo.y; aw.z = hi.x; aw.w = hi.y; o[dt] = MFMA16(__builtin_bit_cast(bf16x8, aw), pb, o[dt]); }
        }
        const int hh = g * 4 + r; const float gate = sigmoidf_(gl[r]);
#pragma unroll
        for (int dt = 0; dt < 4; ++dt) *(v2u*)(Y + (size_t)m * 512 + hh * 64 + 16 * dt + 4 * fq) = pk4(o[dt] * gate);
        __builtin_amdgcn_sched_barrier(0);
    }
    if (ABL == 1) return;
    LAS float* sc = (LAS float*)(F.lds + F.wave * 4096);
    float y3prev = 0.f;
#pragma unroll
    for (int kt = 0; kt < 8; ++kt) {
        const float y3 = __shfl(imp3[kt], (F.lane + 48) & 63);
        const float prev = (fq > 0) ? y3 : y3prev; y3prev = y3;
        sc[fr * 33 + 4 * kt + fq] = impl[kt] + 0.5f * prev;
    }
    LDS_WAIT(); __builtin_amdgcn_wave_barrier(); asm volatile("" ::: "memory");
    const int blk_t = t >> 6, chi = blk_t - 2;
    unsigned mask = 1u | (1u << blk_t) | (blk_t > 0 ? (1u << (blk_t - 1)) : 0u);
#pragma unroll
    for (int kt = 0; kt < 8; ++kt) {
        const int k = 4 * kt + fq;
        if (k >= 1 && k <= chi) { const float me = sc[fr * 33 + k]; int rank = 0;
            for (int k2 = 1; k2 <= chi; ++k2) { const float o = sc[fr * 33 + k2]; rank += (o > me || (o == me && k2 < k)) ? 1 : 0; }
            if (rank < 5) mask |= (1u << k); }
    }
    mask |= (unsigned)__shfl_xor((int)mask, 16); mask |= (unsigned)__shfl_xor((int)mask, 32);
    if (fq == 0) ((unsigned*)(F.ws + WS_SELMASK))[(size_t)bg * SEQ + t] = mask;
    LDS_WAIT(); __builtin_amdgcn_wave_barrier(); asm volatile("" ::: "memory");
}
__device__ __forceinline__ void p3_phase(Frame& F) {
    constexpr int T0 = 2048, T1 = T0 + 8192;
#ifdef DUP_P3A
    for (int task = F.gw; task < T0; task += F.NGW) { __syncthreads(); nsa_cmp_stage(F, task >> 7); LDS_WAIT(); __syncthreads(); nsa_cmp_task<DUP_P3A>(F, task); }
    asm volatile("" ::: "memory");
#endif
    for (int task = F.gw; task < T0; task += F.NGW) { __syncthreads(); nsa_cmp_stage(F, task >> 7); LDS_WAIT(); __syncthreads(); nsa_cmp_task<0>(F, task); }
    asm volatile("" ::: "memory");
    const int h = F.vcu & 7;
    LAS float* par = (LAS float*)(F.lds + F.wave * 4096 + 2048);
    __syncthreads();
    prep_fill_par(F, par, h); prep_stage_w(F, h);
    LDS_WAIT(); __syncthreads();
#ifdef DUP_P3B
    for (int i = F.wave; i < 32; i += 8) rwkv_prep_task(F, (((F.vcu >> 3) + 32 * i) << 3) | h, par);
    asm volatile("" ::: "memory");
#endif
    for (int i = F.wave; i < 32; i += 8) rwkv_prep_task(F, (((F.vcu >> 3) + 32 * i) << 3) | h, par);
}

constexpr int NSA_KP = 144, NSA_VP = 136, NSA_BUF = 64 * NSA_KP + 64 * NSA_VP, NSA_CTL = 2 * NSA_BUF + 1024;
struct NsaState { f32x4 O[2][4]; float mrun[2], lrun[2]; };
template <int WHICH, bool MASKED>
__device__ __forceinline__ void nsa_block(NsaState& St, const LAS unsigned char* kb_, const LAS unsigned char* vb_, const bf16x8 (&qf)[2][2], int kb, unsigned mymask, int t, int fq, float slope0) {
    const int kpos0 = 64 * kb;
    bf16x8 kf[4][2];
#pragma unroll
    for (int kt = 0; kt < 4; ++kt) { kf[kt][0] = *(const LAS bf16x8*)(kb_ + 16 * kt * NSA_KP); kf[kt][1] = *(const LAS bf16x8*)(kb_ + 16 * kt * NSA_KP + 64); }
    const bool bsel = (mymask >> kb) & 1u; const int dbase = t - 4 * fq - kpos0;
    const float fdb = (float)dbase;
    bf16x8 P[2][2];
#pragma unroll
    for (int r = 0; r < 2; ++r) {
        const float slope = r ? 0.5f * slope0 : slope0;
        float s[4][4]; float bm = -1e30f;
        float base = -slope * fdb;
        const float s1 = slope, s2_ = 2.0f * slope, s3 = 3.0f * slope, s16 = 16.0f * slope;
#pragma unroll
        for (int kt = 0; kt < 4; ++kt) { f32x4 a = (f32x4){base, base + s1, base + s2_, base + s3}; base += s16;
            a = MFMA16(kf[kt][0], qf[r][0], a); a = MFMA16(kf[kt][1], qf[r][1], a);
#pragma unroll
            for (int rg = 0; rg < 4; ++rg) {
                if (MASKED) { const int dist = dbase - (16 * kt + rg); const bool valid = bsel && dist >= 0 && (WHICH == 0 || dist < 512); s[kt][rg] = valid ? a[rg] : -1e30f; }
                else s[kt][rg] = a[rg];
                bm = fmaxf(bm, s[kt][rg]); } }
        bm = fmaxf(bm, __shfl_xor(bm, 16)); bm = fmaxf(bm, __shfl_xor(bm, 32));
        const float mnew = fmaxf(St.mrun[r], bm); const float scale = __builtin_amdgcn_exp2f(St.mrun[r] - mnew); St.mrun[r] = mnew;
        float ps = 0.f;
#pragma unroll
        for (int kt = 0; kt < 4; ++kt)
#pragma unroll
            for (int rg = 0; rg < 4; ++rg) { float p = __builtin_amdgcn_exp2f(s[kt][rg] - mnew); if (MASKED) p = (s[kt][rg] > -1e29f) ? p : 0.f; s[kt][rg] = p; ps += p; }
        St.lrun[r] = St.lrun[r] * scale + ps;
#pragma unroll
        for (int dt = 0; dt < 4; ++dt) St.O[r][dt] = St.O[r][dt] * scale;
#pragma unroll
        for (int s2 = 0; s2 < 2; ++s2) { v4u pw; pw.x = pk2(s[2 * s2][0], s[2 * s2][1]); pw.y = pk2(s[2 * s2][2], s[2 * s2][3]); pw.z = pk2(s[2 * s2 + 1][0], s[2 * s2 + 1][1]); pw.w = pk2(s[2 * s2 + 1][2], s[2 * s2 + 1][3]);
            P[r][s2] = __builtin_bit_cast(bf16x8, pw); }
    }
#pragma unroll
    for (int dt = 0; dt < 4; ++dt)
#pragma unroll
        for (int s2 = 0; s2 < 2; ++s2) { const LAS unsigned char* vp = vb_ + 16 * dt * NSA_VP + 64 * s2; const v2u lo = *(const LAS v2u*)vp, hi = *(const LAS v2u*)(vp + 32);
            v4u aw; aw.x = lo.x; aw.y = lo.y; aw.z = hi.x; aw.w = hi.y; const bf16x8 vf = __builtin_bit_cast(bf16x8, aw);
#pragma unroll
            for (int r = 0; r < 2; ++r) St.O[r][dt] = MFMA16(vf, P[r][s2], St.O[r][dt]); }
}
template <int WHICH>
__device__ __forceinline__ void nsa_wg_task(Frame& F, int item) {
    const int hp = item & 1, bg = item >> 5, tg = (item >> 1) & 15, b = bg >> 1, g = bg & 1;
    const int fr = F.lane & 15, fq = F.lane >> 4, tile = tg * 8 + F.wave, t0 = tile * 16, t = t0 + fr, m = b * SEQ + t;
    const int h0 = g * 4 + 2 * hp;
    const bf16* z = (const bf16*)(F.ws + WS_Z);
    const bf16* Kb = z + (size_t)b * SEQ * NZ + (WHICH ? ZC_KW : ZC_KS) + g * 64;
    const bf16* VT = (const bf16*)(F.ws + (WHICH ? WS_VWT : WS_VST)) + (size_t)bg * 64 * SEQ;
    unsigned mymask, tile_or, full; const int kb_hi = (t0 + 15) >> 6;
    if (WHICH == 0) { mymask = ((const unsigned*)(F.ws + WS_SELMASK))[(size_t)bg * SEQ + t]; unsigned x = mymask, y = mymask;
        x |= (unsigned)__shfl_xor((int)x, 1); x |= (unsigned)__shfl_xor((int)x, 2); x |= (unsigned)__shfl_xor((int)x, 4); x |= (unsigned)__shfl_xor((int)x, 8);
        y &= (unsigned)__shfl_xor((int)y, 1); y &= (unsigned)__shfl_xor((int)y, 2); y &= (unsigned)__shfl_xor((int)y, 4); y &= (unsigned)__shfl_xor((int)y, 8);
        tile_or = (unsigned)__builtin_amdgcn_readfirstlane((int)x); full = (unsigned)__builtin_amdgcn_readfirstlane((int)y) & ((1u << kb_hi) - 1u); }
    else { mymask = 0xffffffffu; const int lo = (t0 - 511) > 0 ? ((t0 - 511) >> 6) : 0; tile_or = 0u; full = 0u;
        for (int k = lo; k <= kb_hi; ++k) { tile_or |= (1u << k); if (k < kb_hi && 64 * k >= t0 - 496) full |= (1u << k); } }
    tile_or &= (kb_hi >= 31) ? 0xffffffffu : ((2u << kb_hi) - 1u);
    LAS unsigned* ctl = (LAS unsigned*)(F.lds + NSA_CTL);
    __syncthreads();
    if (F.lane == 0) ctl[F.wave] = tile_or;
    LDS_WAIT(); __syncthreads();
    unsigned rem = 0u;
#pragma unroll
    for (int w = 0; w < 8; ++w) rem |= ctl[w];
    rem = (unsigned)__builtin_amdgcn_readfirstlane((int)rem);
    bf16x8 qf[2][2];
#pragma unroll
    for (int r = 0; r < 2; ++r)
#pragma unroll
        for (int ks = 0; ks < 2; ++ks) { const v4u raw = *(const v4u*)(z + (size_t)m * NZ + ZC_Q + (h0 + r) * 64 + 8 * fq + 32 * ks); float f[8]; unpk8(raw, f);
            constexpr float QS = 0.125f * 1.4426950408889634f; v4u w; w.x = pk2(f[0] * QS, f[1] * QS); w.y = pk2(f[2] * QS, f[3] * QS); w.z = pk2(f[4] * QS, f[5] * QS); w.w = pk2(f[6] * QS, f[7] * QS);
            qf[r][ks] = __builtin_bit_cast(bf16x8, w); }
    NsaState St;
#pragma unroll
    for (int r = 0; r < 2; ++r) { St.mrun[r] = -1e30f; St.lrun[r] = 0.f;
#pragma unroll
        for (int dt = 0; dt < 4; ++dt) St.O[r][dt] = (f32x4){0.f, 0.f, 0.f, 0.f}; }
    const float slope0 = 1.4426950408889634f * __uint_as_float((unsigned)(127 - (h0 + 1)) << 23);
    const int srow = F.tid >> 3, sc = F.tid & 7;
    const bf16* ksrc = Kb + (size_t)srow * NZ + sc * 8; const bf16* vsrc = VT + (size_t)srow * SEQ + sc * 8;
    const int kdst = srow * NSA_KP + sc * 16, vdst = 64 * NSA_KP + srow * NSA_VP + sc * 16;
    const LAS unsigned char* kfr = F.lds + fr * NSA_KP + 16 * fq; const LAS unsigned char* vfr = F.lds + 64 * NSA_KP + fr * NSA_VP + 8 * fq;
    int kb = __builtin_ctz(rem); rem &= rem - 1u;
    v4u kreg = *(const v4u*)(ksrc + (size_t)64 * kb * NZ), vreg = *(const v4u*)(vsrc + 64 * kb);
    *(LAS v4u*)(F.lds + kdst) = kreg; *(LAS v2u*)(F.lds + vdst) = (v2u){vreg.x, vreg.y}; *(LAS v2u*)(F.lds + vdst + 8) = (v2u){vreg.z, vreg.w};
    LDS_WAIT(); __syncthreads();
    int buf = 0;
    for (;;) {
        int kbn = -1;
        if (rem) { kbn = __builtin_ctz(rem); rem &= rem - 1u; kreg = *(const v4u*)(ksrc + (size_t)64 * kbn * NZ); vreg = *(const v4u*)(vsrc + 64 * kbn); }
        __builtin_amdgcn_sched_barrier(0);
        if ((tile_or >> kb) & 1u) {
            if ((full >> kb) & 1u) nsa_block<WHICH, false>(St, kfr + buf * NSA_BUF, vfr + buf * NSA_BUF, qf, kb, mymask, t, fq, slope0);
            else nsa_block<WHICH, true>(St, kfr + buf * NSA_BUF, vfr + buf * NSA_BUF, qf, kb, mymask, t, fq, slope0);
        }
        __builtin_amdgcn_sched_barrier(0);
        if (kbn < 0) break;
        buf ^= 1;
        *(LAS v4u*)(F.lds + buf * NSA_BUF + kdst) = kreg; *(LAS v2u*)(F.lds + buf * NSA_BUF + vdst) = (v2u){vreg.x, vreg.y}; *(LAS v2u*)(F.lds + buf * NSA_BUF + vdst + 8) = (v2u){vreg.z, vreg.w};
        LDS_WAIT(); __syncthreads();
        kb = kbn;
    }
    const float* zg = (const float*)(F.ws + WS_ZGATE); const float* gb = F.ap->in[21];
    bf16* Y = (bf16*)(F.ws + WS_YB + (size_t)(1 + WHICH) * 16 * MiB);
#pragma unroll
    for (int r = 0; r < 2; ++r) { float l = St.lrun[r]; l += __shfl_xor(l, 16); l += __shfl_xor(l, 32);
        const int hh = h0 + r; const float gate = sigmoidf_(zg[(size_t)m * 32 + hh * 3 + 1 + WHICH] + gb[hh * 3 + 1 + WHICH]); const float f = gate / l;
#pragma unroll
        for (int dt = 0; dt < 4; ++dt) *(v2u*)(Y + (size_t)m * 512 + hh * 64 + 16 * dt + 4 * fq) = pk4(St.O[r][dt] * f); }
}
__device__ __forceinline__ void p4_phase(Frame& F) {
    for (int it = F.vcu; it < 512; it += F.G) { nsa_wg_task<1>(F, it); nsa_wg_task<0>(F, 511 - it); }
}

typedef short v4i16_t __attribute__((ext_vector_type(4)));
__device__ __forceinline__ bf16x8 tr_lo(const LAS unsigned char* p) {
    const v4i16_t t = __builtin_amdgcn_ds_read_tr16_b64_v4i16((LAS v4i16_t*)p);
    return (bf16x8){t[0], t[1], t[2], t[3], 0, 0, 0, 0};
}
__device__ __forceinline__ bf16x8 lo4(v2u g) { v4u w; w.x = g.x; w.y = g.y; w.z = 0u; w.w = 0u; return __builtin_bit_cast(bf16x8, w); }
__device__ __forceinline__ bf16x8 cat8(v2u a, v2u b) { v4u w; w.x = a.x; w.y = a.y; w.z = b.x; w.w = b.y; return __builtin_bit_cast(bf16x8, w); }
struct ChunkOps { v2u pA[2][2], rA[2][2], g[4]; f32x4 ac[4]; bf16x8 aq[4], ak[4], bv; };
__device__ __forceinline__ void chunk_load(const LAS unsigned char* sl, ChunkOps& X, int lane) {
    const int fr = lane & 15, fq = lane >> 4;
#pragma unroll
    for (int m = 0; m < 2; ++m) { X.pA[m][0] = *(const LAS v2u*)(sl + CH_P + fr * CH_PP + 64 * m + 8 * fq); X.pA[m][1] = *(const LAS v2u*)(sl + CH_P + fr * CH_PP + 64 * m + 32 + 8 * fq);
        X.rA[m][0] = *(const LAS v2u*)(sl + CH_R + fr * CH_PP + 64 * m + 8 * fq); X.rA[m][1] = *(const LAS v2u*)(sl + CH_R + fr * CH_PP + 64 * m + 32 + 8 * fq); }
#pragma unroll
    for (int x = 0; x < 4; ++x) X.g[x] = *(const LAS v2u*)(sl + CH_G + 512 * x + (fr * 16 + 4 * fq) * 2);
    X.bv = tr_lo(sl + CH_V + 8 * lane);
#pragma unroll
    for (int jt = 0; jt < 4; ++jt) { X.aq[jt] = tr_lo(sl + CH_Q + jt * 512 + 8 * lane); X.ak[jt] = tr_lo(sl + CH_K + jt * 512 + 8 * lane);
        X.ac[jt] = *(const LAS f32x4*)(sl + CH_AC + (16 * jt + 4 * fq) * 4); }
}
__device__ __forceinline__ bf16x8 lo4t(bf16x8 t) { return t; }
__device__ __forceinline__ void chunk_math(const ChunkOps& X, f32x4 (&S)[4], f32x4& o_out) {
    bf16x8 bs[2];
#pragma unroll
    for (int m = 0; m < 2; ++m) { v4u w; w.x = pk2(S[2 * m][0], S[2 * m][1]); w.y = pk2(S[2 * m][2], S[2 * m][3]); w.z = pk2(S[2 * m + 1][0], S[2 * m + 1][1]); w.w = pk2(S[2 * m + 1][2], S[2 * m + 1][3]); bs[m] = __builtin_bit_cast(bf16x8, w); }
    const f32x4 z4 = (f32x4){0.f, 0.f, 0.f, 0.f};
    const bf16x8 bv = lo4t(X.bv);
    f32x4 y = MFMA16(cat8(X.pA[0][0], X.pA[0][1]), bs[0], z4); y = MFMA16(cat8(X.pA[1][0], X.pA[1][1]), bs[1], y); y = MFMA16(lo4(X.g[0]), bv, y);
    f32x4 o = MFMA16(cat8(X.rA[0][0], X.rA[0][1]), bs[0], z4); o = MFMA16(cat8(X.rA[1][0], X.rA[1][1]), bs[1], o); o = MFMA16(lo4(X.g[3]), bv, o);
    const bf16x8 by = lo4(pk4(y));
    const f32x4 u = MFMA16(lo4(X.g[1]), by, z4);
    const bf16x8 bu = lo4(pk4(u));
    o_out = MFMA16(lo4(X.g[2]), bu, o);
#pragma unroll
    for (int jt = 0; jt < 4; ++jt) { S[jt] = MFMA16(lo4t(X.aq[jt]), bu, S[jt]); S[jt] = MFMA16(lo4t(X.ak[jt]), bv, S[jt]); S[jt] = S[jt] * X.ac[jt]; }
}
#ifndef SC_CONVW
#define SC_CONVW 3
#endif
constexpr int SC_NS = 7, SC_AHEAD = 5, SC_CTL = SC_NS * CH_SLOT, SCAN_TR_OFF = 81920;
__device__ __forceinline__ void scan_dma(const unsigned char* rec, const bf16* vt, LAS unsigned char* slot, int lane) {
#pragma unroll
    for (int i = 0; i < 10; ++i) __builtin_amdgcn_global_load_lds((const unsigned*)(rec + (lane + 64 * i) * 16), (LAS unsigned*)(slot + i * 1024), 16, 0, 0);
    if (lane < 48) __builtin_amdgcn_global_load_lds((const unsigned*)(rec + (lane + 640) * 16), (LAS unsigned*)(slot + 10240), 16, 0, 0);
    if (lane < 32) __builtin_amdgcn_global_load_lds((const unsigned*)(vt + (size_t)(lane >> 1) * 512 + 8 * (lane & 1)), (LAS unsigned*)(slot + CH_V), 16, 0, 0);
}
__device__ __forceinline__ int sc_ld(LAS int* p) { int v; const unsigned a = (unsigned)(size_t)p; asm volatile("ds_read_b32 %0, %1\n\ts_waitcnt lgkmcnt(0)" : "=&v"(v) : "v"(a) : "memory"); return v; }
__device__ __forceinline__ void sc_st(LAS int* p, int v) { const unsigned a = (unsigned)(size_t)p; asm volatile("ds_write_b32 %0, %1" :: "v"(a), "v"(v) : "memory"); }
#define SC_LD(p) sc_ld(p)
#define SC_ST(p, v) sc_st((p), (v))
__device__ __forceinline__ void p5_scan(Frame& F, bool extras = true, int abl = 0) {
    LAS int* ctl = (LAS int*)(F.lds + SC_CTL);
    if (F.tid < 4) ctl[F.tid] = 0;
    LDS_WAIT(); __syncthreads();
    constexpr int NKQ = (tri::NITEMS - tri::E12) / 256;
    LAS float* mytile = (LAS float*)(F.lds + SCAN_TR_OFF + F.wave * 8448);
    const int bh = F.vcu >> 2, b = bh >> 3, h = bh & 7, i0 = (F.vcu & 3) * 16;
    if (F.wave == 0) {
        if (abl & 1) return;
        __builtin_amdgcn_s_setprio(3);
        float* o0 = (float*)(F.ws + WS_XN) + (size_t)b * SEQ * 512 + h * 64 + i0;
        const int fr = F.lane & 15, fq = F.lane >> 4;
        f32x4 S[4];
#pragma unroll
        for (int jt = 0; jt < 4; ++jt) S[jt] = (f32x4){0.f, 0.f, 0.f, 0.f};
        ChunkOps XA, XB;
        while (SC_LD(&ctl[0]) <= 0) __builtin_amdgcn_s_sleep(1);
        asm volatile("" ::: "memory");
        chunk_load(F.lds, XA, F.lane);
        LDS_WAIT(); asm volatile("" ::: "memory");
        if (F.lane == 0) SC_ST(&ctl[1], 1);
#define SCAN_ITER(XC, XN_, c_) do { const int cc = (c_); \
            if (cc + 1 < 128) { while (SC_LD(&ctl[0]) <= cc + 1) __builtin_amdgcn_s_sleep(1); asm volatile("" ::: "memory"); chunk_load(F.lds + ((cc + 1) % SC_NS) * CH_SLOT, XN_, F.lane); } \
            __builtin_amdgcn_sched_barrier(0); \
            f32x4 o; chunk_math(XC, S, o); \
            __builtin_amdgcn_sched_barrier(0); \
            float* orow = o0 + (size_t)cc * 16 * 512; \
            _Pragma("unroll") for (int rg = 0; rg < 4; ++rg) { float* pp = orow + (size_t)(4 * fq + rg) * 512 + fr; const float vv = o[rg]; asm volatile("global_store_dword %0, %1, off" :: "v"(pp), "v"(vv) : "memory"); } \
            if (cc + 1 < 128) { LDS_WAIT(); asm volatile("" ::: "memory"); if (F.lane == 0) SC_ST(&ctl[1], cc + 2); } } while (0)
#pragma unroll 1
        for (int c = 0; c < 128; c += 2) { SCAN_ITER(XA, XB, c); SCAN_ITER(XB, XA, c + 1); }
#undef SCAN_ITER
        asm volatile("s_waitcnt vmcnt(0)" ::: "memory");
        __builtin_amdgcn_s_setprio(0);
        if (F.lane == 0) SC_ST(&ctl[3], 1);
        if (!(abl & 2)) tr_run_q(F, mytile, &ctl[2], tri::E12 + F.vcu, F.G, NKQ);
    } else if (F.wave == 1) {
        if (abl & 1) return;
        const unsigned char* rec0 = F.ws + WS_S + ((size_t)(b * 128) * 8 + h) * CH_REC;
        const bf16* vt0 = (const bf16*)F.out + (size_t)b * SEQ * 512 + h * 64 + i0;
        for (int n = 0; n < 128; ++n) {
            while (SC_LD(&ctl[1]) < n - SC_NS + 1) __builtin_amdgcn_s_sleep(1);
            asm volatile("" ::: "memory");
            scan_dma(rec0 + (size_t)n * 8 * CH_REC, vt0 + (size_t)n * 16 * 512, F.lds + (n % SC_NS) * CH_SLOT, F.lane);
            if (n >= SC_AHEAD) { asm volatile("s_waitcnt vmcnt(60)" ::: "memory"); if (F.lane == 0) SC_ST(&ctl[0], n - SC_AHEAD + 1); }
        }
        asm volatile("s_waitcnt vmcnt(48)" ::: "memory"); if (F.lane == 0) SC_ST(&ctl[0], 124);
        asm volatile("s_waitcnt vmcnt(36)" ::: "memory"); if (F.lane == 0) SC_ST(&ctl[0], 125);
        asm volatile("s_waitcnt vmcnt(24)" ::: "memory"); if (F.lane == 0) SC_ST(&ctl[0], 126);
        asm volatile("s_waitcnt vmcnt(12)" ::: "memory"); if (F.lane == 0) SC_ST(&ctl[0], 127);
        asm volatile("s_waitcnt vmcnt(0)" ::: "memory"); if (F.lane == 0) SC_ST(&ctl[0], 128);
        if (!(abl & 2)) { while (SC_LD(&ctl[3]) == 0) __builtin_amdgcn_s_sleep(8); tr_run_q(F, mytile, &ctl[2], tri::E12 + F.vcu, F.G, NKQ); }
    } else {
        const int w2 = F.vcu * 6 + (F.wave - 2), NW2 = F.G * 6;
        if (!(abl & 2) && F.wave - 2 < SC_CONVW) tr_run_q(F, mytile, &ctl[2], tri::E12 + F.vcu, F.G, NKQ);
        if (!extras) return;
        for (int mb = w2; mb < M; mb += 4 * NW2) {
            v4u a0[4], a1[4], a2[4];
#pragma unroll
            for (int u = 0; u < 4; ++u) { const int mr = (mb + u * NW2 < M) ? mb + u * NW2 : mb; const bf16* y0 = (const bf16*)(F.ws + WS_YB) + (size_t)mr * 512 + 8 * F.lane; a0[u] = *(const v4u*)y0; a1[u] = *(const v4u*)(y0 + 8 * MiB); a2[u] = *(const v4u*)(y0 + 16 * MiB); }
#pragma unroll
            for (int u = 0; u < 4; ++u) { float f0[8], f1[8], f2[8]; unpk8(a0[u], f0); unpk8(a1[u], f1); unpk8(a2[u], f2);
                v4u w; w.x = pk2(f0[0] + f1[0] + f2[0], f0[1] + f1[1] + f2[1]); w.y = pk2(f0[2] + f1[2] + f2[2], f0[3] + f1[3] + f2[3]); w.z = pk2(f0[4] + f1[4] + f2[4], f0[5] + f1[5] + f2[5]); w.w = pk2(f0[6] + f1[6] + f2[6], f0[7] + f1[7] + f2[7]);
                if (mb + u * NW2 < M) *(v4u*)((bf16*)(F.ws + WS_YB) + (size_t)(mb + u * NW2) * 512 + 8 * F.lane) = w; } }
        const float* p = F.ap->in[1]; bf16* PB = (bf16*)(F.ws + WS_PBF);
        constexpr size_t NV = (size_t)M * 256 / 4;
        for (size_t b0 = (size_t)w2 * 64 + F.lane; b0 < NV; b0 += (size_t)8 * NW2 * 64) {
            f32x4 pv[8];
#pragma unroll
            for (int i = 0; i < 8; ++i) { const size_t idx = b0 + (size_t)i * NW2 * 64; pv[i] = (idx < NV) ? *(const f32x4*)(p + idx * 4) : (f32x4){0.f, 0.f, 0.f, 0.f}; }
#pragma unroll
            for (int i = 0; i < 8; ++i) { const size_t idx = b0 + (size_t)i * NW2 * 64; if (idx < NV) *(v2u*)(PB + idx * 4) = pk4(pv[i]); } }
        if (!(abl & 2) && F.wave - 2 >= SC_CONVW) { while (SC_LD(&ctl[3]) == 0) __builtin_amdgcn_s_sleep(8); tr_run_q(F, mytile, &ctl[2], tri::E12 + F.vcu, F.G, NKQ); }
    }
}

struct P6Par { float lw[8], lb[8]; };
__device__ __forceinline__ void p6_rows2(Frame& F, int ma, int mb_, const P6Par& P) {
    const int l = F.lane, c = 8 * l, h = l >> 3;
    f32x4 oa[2][2]; v4u vv_[2], gg_[2]; float bsv[2];
#pragma unroll
    for (int u = 0; u < 2; ++u) { const int m = u ? mb_ : ma;
        const float* oraw = (const float*)(F.ws + WS_XN) + (size_t)m * 512 + c;
        oa[u][0] = *(const f32x4*)oraw; oa[u][1] = *(const f32x4*)(oraw + 4); bsv[u] = ((const float*)(F.ws + WS_BONUS))[(size_t)m * 8 + h];
        vv_[u] = *(const v4u*)((const bf16*)F.out + (size_t)m * 512 + c); gg_[u] = *(const v4u*)((const bf16*)(F.ws + WS_G) + (size_t)m * 512 + c);
    }
    __builtin_amdgcn_sched_barrier(0);
#pragma unroll
    for (int u = 0; u < 2; ++u) { const int m = u ? mb_ : ma;
        float o[8] = {oa[u][0].x, oa[u][0].y, oa[u][0].z, oa[u][0].w, oa[u][1].x, oa[u][1].y, oa[u][1].z, oa[u][1].w};
        float s = 0.f;
#pragma unroll
        for (int j = 0; j < 8; ++j) s += o[j];
        s += __shfl_xor(s, 1); s += __shfl_xor(s, 2); s += __shfl_xor(s, 4);
        const float mu = s * (1.f / 64.f); float q = 0.f;
#pragma unroll
        for (int j = 0; j < 8; ++j) { o[j] -= mu; q += o[j] * o[j]; }
        q += __shfl_xor(q, 1); q += __shfl_xor(q, 2); q += __shfl_xor(q, 4);
        const float rstd = 1.0f / sqrtf(q * (1.f / 64.f) + GN_EPS);
        float vv[8], gg[8];
        unpk8(vv_[u], vv); unpk8(gg_[u], gg);
        const float bs = bsv[u];
        float y[8];
#pragma unroll
        for (int j = 0; j < 8; ++j) y[j] = (o[j] * rstd * P.lw[j] + P.lb[j] + bs * vv[j]) * gg[j];
        v4u w; w.x = pk2(y[0], y[1]); w.y = pk2(y[2], y[3]); w.z = pk2(y[4], y[5]); w.w = pk2(y[6], y[7]);
        *(v4u*)((bf16*)(F.ws + WS_YRW) + (size_t)m * 512 + c) = w;
    }
}
__device__ __forceinline__ void p6_phase(Frame& F) {
    const int l = F.lane, c = 8 * l;
    P6Par P;
#pragma unroll
    for (int j = 0; j < 8; ++j) { P.lw[j] = F.ap->in[13][c + j]; P.lb[j] = F.ap->in[14][c + j]; }
    for (int m = F.gw; m < M; m += 2 * F.NGW) p6_rows2(F, m, m + F.NGW, P);
}

struct RouteW { f32x4 wv[3][8]; };
__device__ __forceinline__ void route_ldx(Frame& F, int tile, v4u (&xv)[4]) {
    const int fr = F.lane & 15, fq = F.lane >> 4; const bf16* xp = (const bf16*)(F.ws + WS_Z) + (size_t)(tile * 16 + fr) * D + F.wave * 128 + 8 * fq;
#pragma unroll
    for (int g = 0; g < 4; ++g) xv[g] = *(const v4u*)(xp + 32 * g);
}
__device__ __forceinline__ void route_tile(Frame& F, int tile, const RouteW& W, const v4u (&xv_)[4], int par) {
    const int fr = F.lane & 15, fq = F.lane >> 4, m0 = tile * 16;
    f32x4 acc[3] = {(f32x4){0.f, 0.f, 0.f, 0.f}, (f32x4){0.f, 0.f, 0.f, 0.f}, (f32x4){0.f, 0.f, 0.f, 0.f}};
    float ssq = 0.f;
#pragma unroll
    for (int g2 = 0; g2 < 4; ++g2) {
        float xf[8]; unpk8(xv_[g2], xf);
#pragma unroll
        for (int hh = 0; hh < 2; ++hh) { const int g = 2 * g2 + hh;
            ssq += (xf[4 * hh] * xf[4 * hh] + xf[4 * hh + 1] * xf[4 * hh + 1]) + (xf[4 * hh + 2] * xf[4 * hh + 2] + xf[4 * hh + 3] * xf[4 * hh + 3]);
#pragma unroll
            for (int s = 0; s < 4; ++s)
#pragma unroll
                for (int ct = 0; ct < 3; ++ct) acc[ct] = __builtin_amdgcn_mfma_f32_16x16x4f32(W.wv[ct][g][s], xf[4 * hh + s], acc[ct], 0, 0, 0); }
    }
    ssq += __shfl_xor(ssq, 16); ssq += __shfl_xor(ssq, 32);
    LAS float* red = (LAS float*)(F.lds + par * 32768);
    LAS float* ssqb = red + 8 * 3 * 64 * 4; LAS float* rsb = ssqb + 128;
#pragma unroll
    for (int ct = 0; ct < 3; ++ct) *(LAS f32x4*)(red + ((F.wave * 3 + ct) * 64 + F.lane) * 4) = acc[ct];
    if (fq == 0) ssqb[F.wave * 16 + fr] = ssq;
    LDS_WAIT(); __syncthreads();
    if (F.wave == 0) { float st = 0.f;
#pragma unroll
      for (int w = 0; w < 8; ++w) st += ssqb[w * 16 + (F.lane & 15)];
      const float rs = 1.0f / sqrtf(st * (1.f / D) + NORM_EPS);
      if (fq == 0) ((float*)(F.ws + WS_RSE))[m0 + fr] = rs;
#pragma unroll
      for (int ct = 0; ct < 3; ++ct) { f32x4 t = (f32x4){0.f, 0.f, 0.f, 0.f};
#pragma unroll
          for (int w = 0; w < 8; ++w) t = t + *(const LAS f32x4*)(red + ((w * 3 + ct) * 64 + F.lane) * 4);
          *(f32x4*)((float*)(F.ws + WS_LOGITS) + (size_t)(m0 + fr) * 48 + 16 * ct + 4 * fq) = t * rs; } }
}
__device__ __forceinline__ void p9_phase(Frame& F, int rep_ = 0) {
    const int fr = F.lane & 15, fq = F.lane >> 4;
    RouteW W;
    { const float* wp = (const float*)(F.ws + WS_SMALLW + SW_ROUTEW) + (size_t)fr * D + F.wave * 128 + 8 * fq;
#pragma unroll
      for (int ct = 0; ct < 3; ++ct)
#pragma unroll
          for (int g = 0; g < 8; ++g) W.wv[ct][g] = *(const f32x4*)(wp + (size_t)ct * 16 * D + 32 * (g >> 1) + 4 * (g & 1)); }
    v4u xa[4], xb[4];
    int tile = F.vcu, par = 0;
    if (tile < 1024) route_ldx(F, tile, xa);
    while (tile < 1024) {
        const int nt = tile + F.G;
        if (nt < 1024) route_ldx(F, nt, xb);
        __builtin_amdgcn_sched_barrier(0);
        route_tile(F, tile, W, xa, par);
#pragma unroll
        for (int g = 0; g < 4; ++g) xa[g] = xb[g];
        tile = nt; par ^= 1;
    }
}

__device__ __forceinline__ void p9b_phase(Frame& F) {
    if (F.wave != 0) return;
    for (int base = F.vcu * 64; base < M; base += F.G * 64) {
        const int tok = base + F.lane;
        const float* lgp = (const float*)(F.ws + WS_LOGITS) + (size_t)tok * 48;
        float lg[36];
#pragma unroll
        for (int q = 0; q < 9; ++q) { const f32x4 v = *(const f32x4*)(lgp + 4 * q); lg[4 * q] = v.x; lg[4 * q + 1] = v.y; lg[4 * q + 2] = v.z; lg[4 * q + 3] = v.w; }
        const float* bg = F.ap->in[27]; const float* br = F.ap->in[29];
        float gl[4]; int gs = 0; float gm = -3.0e38f;
#pragma unroll
        for (int c = 0; c < 4; ++c) { gl[c] = lg[c] + bg[c]; if (gl[c] > gm) { gm = gl[c]; gs = c; } }
        float gsum = 0.f;
#pragma unroll
        for (int c = 0; c < 4; ++c) gsum += __expf(gl[c] - gm);
        const float pgroup = 1.0f / gsum;
        float el[8]; float em = -3.0e38f;
#pragma unroll
        for (int c = 0; c < 8; ++c) { const float lv = gs == 0 ? lg[4 + c] : (gs == 1 ? lg[12 + c] : (gs == 2 ? lg[20 + c] : lg[28 + c])); el[c] = lv + br[gs * 8 + c]; em = fmaxf(em, el[c]); }
        int i1 = 0; float v1 = -3.0e38f;
#pragma unroll
        for (int c = 0; c < 8; ++c) if (el[c] > v1) { v1 = el[c]; i1 = c; }
        int i2 = 0; float v2 = -3.0e38f;
#pragma unroll
        for (int c = 0; c < 8; ++c) if (c != i1 && el[c] > v2) { v2 = el[c]; i2 = c; }
        const float p1 = __expf(v1 - em), p2 = __expf(v2 - em);
        const float g1 = pgroup * p1 / (p1 + p2), g2 = pgroup * p2 / (p1 + p2);
        const int e1 = gs * 8 + i1, e2 = gs * 8 + i2;
        const unsigned long long lt = (1ull << F.lane) - 1ull;
        int r1 = 0, r2 = 0, mycnt = 0;
        for (int e = 0; e < 32; ++e) {
            const unsigned long long m1 = __ballot(e1 == e), m2 = __ballot(e2 == e);
            const int c1 = __popcll(m1), c2 = __popcll(m2);
            if (e1 == e) r1 = __popcll(m1 & lt);
            if (e2 == e) r2 = c1 + __popcll(m2 & lt);
            if (F.lane == e) mycnt = c1 + c2;
        }
        unsigned* cnt = (unsigned*)(F.ws + WS_CTL) + CW_CNT; int* list = (int*)(F.ws + WS_LIST); float* gateA = (float*)(F.ws + WS_GATEA); unsigned* slotA = (unsigned*)(F.ws + WS_SLOTA);
        int bs = 0;
        if (F.lane < 32 && mycnt > 0) bs = (int)atomicAdd(&cnt[F.lane], (unsigned)mycnt);
        const unsigned q1 = (unsigned)(__shfl(bs, e1) + r1), q2 = (unsigned)(__shfl(bs, e2) + r2);
        gateA[tok * 2 + 0] = g1; gateA[tok * 2 + 1] = g2;
        list[(size_t)e1 * 16384 + q1] = tok * 2 + 0; slotA[tok * 2 + 0] = ((unsigned)e1 << 16) | q1;
        list[(size_t)e2 * 16384 + q2] = tok * 2 + 1; slotA[tok * 2 + 1] = ((unsigned)e2 << 16) | q2;
    }
}

__device__ __forceinline__ void p12_rows2(Frame& F, int ma, int mb_, int prelane) {
    const unsigned* slotA = (const unsigned*)(F.ws + WS_SLOTA); const float* gateA = (const float*)(F.ws + WS_GATEA);
    unsigned sl[2][2]; float gt[2][2];
#pragma unroll
    for (int u = 0; u < 2; ++u) { const int m = u ? mb_ : ma; sl[u][0] = slotA[2 * m]; sl[u][1] = slotA[2 * m + 1]; gt[u][0] = gateA[2 * m]; gt[u][1] = gateA[2 * m + 1]; }
    f32x4 xv[2][4]; v2u cv[2][2][4]; float se[2];
#pragma unroll
    for (int u = 0; u < 2; ++u) { const int m = u ? mb_ : ma;
        const bf16* x1 = (const bf16*)(F.ws + WS_Z) + (size_t)m * D;
        se[u] = (F.lane < 16) ? ((const float*)(F.ws + WS_ZGATE + 1 * MiB))[(size_t)m * 16 + F.lane] : 0.f;
#pragma unroll
        for (int j = 0; j < 4; ++j) { const int o = 4 * F.lane + 256 * j; xv[u][j] = unpk4(*(const v2u*)(x1 + o)); }
#pragma unroll
        for (int k = 0; k < 2; ++k) { const unsigned s = (unsigned)__builtin_amdgcn_readfirstlane((int)sl[u][k]); const int pre = __builtin_amdgcn_readlane(prelane, (int)(s >> 16));
            const bf16* cp = (const bf16*)(F.ws + WS_Z + 64 * MiB) + ((size_t)pre * 256 + (s & 0xffffu)) * D;
#pragma unroll
            for (int j = 0; j < 4; ++j) cv[u][k][j] = *(const v2u*)(cp + 4 * F.lane + 256 * j); } }
    __builtin_amdgcn_sched_barrier(0);
    float s2[2];
#pragma unroll
    for (int u = 0; u < 2; ++u) { s2[u] = 0.f;
#pragma unroll
        for (int j = 0; j < 4; ++j) { xv[u][j] = xv[u][j] + unpk4(cv[u][0][j]) * gt[u][0] + unpk4(cv[u][1][j]) * gt[u][1];
            s2[u] += (xv[u][j].x * xv[u][j].x + xv[u][j].y * xv[u][j].y) + (xv[u][j].z * xv[u][j].z + xv[u][j].w * xv[u][j].w);
        } }
#pragma unroll
    for (int o = 1; o < 64; o <<= 1) {
#pragma unroll
        for (int u = 0; u < 2; ++u) { s2[u] += __shfl_xor(s2[u], o); se[u] += __shfl_xor(se[u], o); } }
#pragma unroll
    for (int u = 0; u < 2; ++u) { const int m = u ? mb_ : ma;
        const float rs = 1.0f / sqrtf(s2[u] * (1.f / D) + NORM_EPS); const float rse = 1.0f / sqrtf(se[u] * (1.f / D) + NORM_EPS);
        bf16* x2 = (bf16*)(F.ws + WS_S) + (size_t)m * D; if (F.lane == 0) { ((float*)(F.ws + WS_RSE))[M + m] = rs; ((float*)(F.ws + WS_RSE))[2 * M + m] = rse; }
#pragma unroll
        for (int j = 0; j < 4; ++j) { const int o = 4 * F.lane + 256 * j; *(v2u*)(x2 + o) = pk4(xv[u][j]); }
    }
}
__device__ __forceinline__ void p12_phase(Frame& F) {
    const unsigned* cnt = (const unsigned*)(F.ws + WS_CTL) + CW_CNT;
    int nt = (F.lane < 32) ? (((int)cnt[F.lane & 31] + 255) >> 8) : 0;
    int incl = nt;
#pragma unroll
    for (int o = 1; o < 32; o <<= 1) { const int v = __shfl_up(incl, o); if (F.lane >= o) incl += v; }
    const int prelane = incl - nt;
    for (int m = F.gw; m < M; m += 2 * F.NGW) p12_rows2(F, m, m + F.NGW, prelane);
}
__device__ __forceinline__ void p14_rows4(Frame& F, int mb) {
    const float* gf = F.ap->in[36];
    f32x4 v[4][4]; float s[4];
#pragma unroll
    for (int u = 0; u < 4; ++u) { const bf16* xr = (const bf16*)(F.ws + WS_Z) + (size_t)(mb + u * F.NGW) * D;
#pragma unroll
        for (int j = 0; j < 4; ++j) v[u][j] = unpk4(*(const v2u*)(xr + 4 * F.lane + 256 * j)); }
#pragma unroll
    for (int u = 0; u < 4; ++u) { s[u] = 0.f;
#pragma unroll
        for (int j = 0; j < 4; ++j) s[u] += (v[u][j].x * v[u][j].x + v[u][j].y * v[u][j].y) + (v[u][j].z * v[u][j].z + v[u][j].w * v[u][j].w); }
#pragma unroll
    for (int o = 1; o < 64; o <<= 1) {
#pragma unroll
        for (int u = 0; u < 4; ++u) s[u] += __shfl_xor(s[u], o); }
#pragma unroll
    for (int u = 0; u < 4; ++u) { const float rs = 1.0f / sqrtf(s[u] * (1.f / D) + NORM_EPS); float* orow = F.out + (size_t)(mb + u * F.NGW) * D;
#pragma unroll
        for (int j = 0; j < 4; ++j) { const int o = 4 * F.lane + 256 * j; *(f32x4*)(orow + o) = v[u][j] * rs * *(const f32x4*)(gf + o); } }
}

#ifndef MK_ONE_LAUNCH
#define MK_ONE_LAUNCH 1
#endif
constexpr int N_PHASES = 14;
__global__ void __launch_bounds__(NWAVES * 64, 2) mk_fwd(Args args) {
    extern __shared__ __attribute__((aligned(16))) unsigned char lds[];
    Frame F;
    F.lds = (LAS unsigned char*)lds;
    F.tid = threadIdx.x; F.lane = F.tid & 63; F.wave = __builtin_amdgcn_readfirstlane(F.tid >> 6);
    F.G = gridDim.x; { const int bx = blockIdx.x; F.vcu = (F.G % 8 == 0) ? (bx % 8) * (F.G / 8) + bx / 8 : bx; }
    F.gw = F.vcu * NWAVES + F.wave; F.NGW = F.G * NWAVES;
    F.ws = args.ws; F.out = args.out;
    F.ap = (ArgsP)__builtin_amdgcn_kernarg_segment_ptr();
    unsigned char* ws = args.ws;
    const int lo = args.ph_lo, hi = args.ph_hi;
#ifdef ONLY
#define IN(k) ((k) == ONLY && lo <= (k) && (k) < hi)
#else
#define IN(k) (lo <= (k) && (k) < hi)
#endif
#if MK_ONE_LAUNCH
    if (F.tid < 16) ((LAS unsigned*)(F.lds + MISC_OFF))[F.tid] = 0u;
    __syncthreads();
    XcdBarrier bar = xcd_barrier_post((unsigned*)(ws + WS_CTL) + CW_BAR, (volatile LAS unsigned*)(F.lds + MISC_OFF));
#define GRID_BAR(k) do { if (IN(k) && IN((k) + 1)) { if ((k) == 12) cg::this_grid().sync(); else xcd_barrier(bar); } } while (0)
#else
#define GRID_BAR(k) do { } while (0)
#endif
    LAS unsigned char* L = F.lds;
#ifdef PROBE_A
    unsigned long long* tsb = (unsigned long long*)(ws + WS_CTL + 32768);
    int n_st = 0;
#define STAMP() do { if (blockIdx.x == 0 && F.tid == 0) tsb[n_st] = __builtin_amdgcn_s_memrealtime(); ++n_st; } while (0)
    STAMP();
#else
#define STAMP() do { } while (0)
#endif
    const bf16* z = (const bf16*)(ws + WS_Z);

    if (IN(0)) { p0_prologue(F); } GRID_BAR(0); STAMP();

    if (IN(1)) {
        pg8::Gemm g{(const bf16*)(ws + WS_XN), (const bf16*)(ws + WS_WIN), M, NZ, D, nullptr}; pg8::StaticOrder S; S.init(M, NZ, F.G, (int)blockIdx.x);
        EpiStoreBf16 E{(bf16*)(ws + WS_Z), NZ};
        pg8::gemm_phase<EpiStoreBf16, pg8::StaticOrder, true, false>(L, g, S, E);
    } GRID_BAR(1); STAMP();

    if (IN(2)) { p2_prep(F); } GRID_BAR(2); STAMP();
    if (IN(3)) { p3_phase(F); } GRID_BAR(3); STAMP();
    if (IN(4)) { p4_phase(F); } GRID_BAR(4); STAMP();
    if (IN(5)) { if (F.G == 256) p5_scan(F); } GRID_BAR(5); STAMP();
    if (IN(6)) { p6_phase(F); } GRID_BAR(6); STAMP();

    if (IN(7)) {
        pg8::Gemm g{(const bf16*)(ws + WS_YRW), (const bf16*)(ws + WS_UR), 2 * M, 2 * D, 512, nullptr}; DualOrder S; S.S.init(M, D, F.G, (int)blockIdx.x);
        EpiMix E{z, (bf16*)(ws + WS_S), (bf16*)(ws + WS_S + 64 * MiB)};
        pg8::gemm_phase<EpiMix, DualOrder, true, false>(L, g, S, E);
    } GRID_BAR(7); STAMP();

    if (IN(8)) {
        pg8::Gemm g{(const bf16*)(ws + WS_S + 64 * MiB), (const bf16*)(ws + WS_WO), M, D, D, nullptr}; pg8::StaticOrder S; S.init(M, D, F.G, (int)blockIdx.x);
        EpiResBf16 E{F.ap->in[0], (bf16*)(ws + WS_Z)};
        pg8::gemm_phase<EpiResBf16, pg8::StaticOrder, true, false>(L, g, S, E);
    } GRID_BAR(8); STAMP();

    if (IN(9)) { p9_phase(F); xcd_barrier(bar); p9b_phase(F); } GRID_BAR(9); STAMP();

    if (IN(10)) {
        pg8::Gemm g{(const bf16*)(ws + WS_Z), (const bf16*)(ws + WS_WGU), M, 1024, D, (const int*)(ws + WS_LIST), (const float*)(ws + WS_RSE)};
        pg8::moe_fill_tab((LAS int*)(F.lds + MISC_OFF - 256), (const unsigned*)(ws + WS_CTL) + CW_CNT); LDS_WAIT(); __syncthreads();
        pg8::MoeOrder S{(const LAS int*)(F.lds + MISC_OFF - 256), F.G, F.vcu, false, 0, nullptr};
        EpiMoe1 E{(bf16*)(ws + WS_S), (const LAS float*)(F.lds + pg8::STAGE_BYTES + 4096), (unsigned*)(ws + WS_CTL) + CW_DEP};
        pg8::gemm_phase<EpiMoe1, pg8::MoeOrder, true, true>(L, g, S, E);
    } STAMP();

    if (IN(11)) {
#ifndef NO_MOE2
        { pg8::Gemm g{(const bf16*)(ws + WS_S), (const bf16*)(ws + WS_WD), M, 1024, 512, nullptr};
          pg8::moe_fill_tab((LAS int*)(F.lds + MISC_OFF - 256), (const unsigned*)(ws + WS_CTL) + CW_CNT); LDS_WAIT(); __syncthreads();
          const LAS int* tb = (const LAS int*)(F.lds + MISC_OFF - 256); const int n10 = 4 * (tb[31] + ((tb[63] + 255) >> 8));
          pg8::MoeOrderT<true> S{tb, F.G, F.vcu, true, n10 % F.G, (const unsigned*)(ws + WS_CTL) + CW_DEP};
          EpiStoreBf16 E{(bf16*)(ws + WS_Z + 64 * MiB), D};
          pg8::gemm_phase<EpiStoreBf16, pg8::MoeOrderT<true>, true, false>(L, g, S, E); }
#endif
        { pg8::Gemm g2{(const bf16*)(ws + WS_PBF), (const bf16*)(ws + WS_WPP), M, D, 256, nullptr}; ErawOrder S2; S2.S.init(M, D, F.G, 0); S2.c = (int)blockIdx.x; S2.G = F.G;
          S2.nheavy = 0;
          EpiStoreSsq E2{(bf16*)(ws + WS_S + 64 * MiB), D, (float*)(ws + WS_ZGATE + 1 * MiB)};
          pg8::gemm_phase<EpiStoreSsq, ErawOrder, true, false>(L, g2, S2, E2); }
    } GRID_BAR(11); STAMP();

    if (IN(12)) { p12_phase(F); } GRID_BAR(12); STAMP();

    if (IN(13)) {
        pg8::Gemm g{(const bf16*)(ws + WS_S), (const bf16*)(ws + WS_WPG), M, D, D, nullptr}; pg8::StaticOrder S; S.init(M, D, F.G, (int)blockIdx.x);
        EpiPleNorm E{(const bf16*)(ws + WS_S), (const bf16*)(ws + WS_S + 64 * MiB), (const float*)(ws + WS_RSE) + 2 * M, F.ap->in[33], (const float*)(ws + WS_RSE) + M, F.ap->in[36], F.out, (float*)(ws + WS_ZGATE), (unsigned*)(ws + WS_CTL) + CW_PANEL, (LAS float*)(F.lds + 131072)};
        pg8::gemm_phase<EpiPleNorm, pg8::StaticOrder, true, false>(L, g, S, E);
    } STAMP();

#ifdef PROBE_A
    xcd_barrier(bar); STAMP(); __threadfence();
    if (blockIdx.x == 0 && F.tid == 0) { __threadfence(); }
    xcd_barrier(bar);
    {
        volatile unsigned long long* tv = (volatile unsigned long long*)tsb;
        const float dA = (float)(tv[PROBE_A + 1] - tv[PROBE_A]) * 0.01f, dB = (float)(tv[PROBE_B + 1] - tv[PROBE_B]) * 0.01f;
        for (size_t i = (size_t)blockIdx.x * 512 + F.tid; i < (size_t)M * D; i += (size_t)F.G * 512) F.out[i] = 10.0f * dB;
        __syncthreads();
        if (blockIdx.x == 0 && F.tid == 0) F.out[0] = 300.0f * dA;
    }
#endif
#undef IN
#undef GRID_BAR
}

extern "C" void kernel_launch(void* const* d_in, const int* in_sizes, int n_in, void* d_out, int out_size, void* d_ws, size_t ws_size, hipStream_t stream) {
    static int grid = 0;
    if (grid == 0) {
        if (n_in != 37 || out_size != M * D || ws_size < WS_END) { fprintf(stderr, "kernel_launch: unexpected problem (n_in %d, out %d, ws %zu < %zu); nothing launched\n", n_in, out_size, ws_size, (size_t)WS_END); grid = -1; return; }
        int dev = 0, cus = 0, per_cu = 0;
        if (hipGetDevice(&dev) != hipSuccess || hipDeviceGetAttribute(&cus, hipDeviceAttributeMultiprocessorCount, dev) != hipSuccess) { grid = -1; return; }
        if (hipFuncSetAttribute((const void*)mk_fwd, hipFuncAttributeMaxDynamicSharedMemorySize, LDS_BYTES) != hipSuccess) { fprintf(stderr, "kernel_launch: hipFuncSetAttribute failed\n"); grid = -1; return; }
        if (hipOccupancyMaxActiveBlocksPerMultiprocessor(&per_cu, (const void*)mk_fwd, NWAVES * 64, LDS_BYTES) != hipSuccess || per_cu < 1) { fprintf(stderr, "kernel_launch: occupancy query says %d blocks per CU\n", per_cu); (void)hipGetLastError(); grid = -1; return; }
        grid = cus;
        if (grid != 256) fprintf(stderr, "kernel_launch: %d CUs; this kernel is built for 256\n", grid);
    }
    if (grid < 0) return;
    (void)hipMemsetAsync((char*)d_ws + WS_CTL, 0, CTL_ZERO_BYTES, stream);
    Args a{};
    for (int i = 0; i < 37; ++i) a.in[i] = (const float*)d_in[i];
    a.out = (float*)d_out; a.ws = (unsigned char*)d_ws;
#if MK_ONE_LAUNCH
    a.ph_lo = 0; a.ph_hi = N_PHASES;
    void* kargs[] = {&a};
    hipError_t e = hipLaunchCooperativeKernel((const void*)mk_fwd, dim3(grid), dim3(NWAVES * 64), kargs, LDS_BYTES, stream);
    if (e != hipSuccess) fprintf(stderr, "kernel_launch: cooperative launch failed: %s (grid %d)\n", hipGetErrorString(e), grid);
#else
    for (int ph = 0; ph < N_PHASES; ++ph) { a.ph_lo = ph; a.ph_hi = ph + 1; hipLaunchKernelGGL(mk_fwd, dim3(grid), dim3(NWAVES * 64), LDS_BYTES, stream, a); }
#endif
}
```

```cpp
#include <hip/hip_runtime.h>
#include <hip/hip_cooperative_groups.h>
#include <cstdio>
#include <cstdint>
namespace cg = cooperative_groups;

namespace pg8 {
#define PG8_LAS __attribute__((address_space(3)))
typedef unsigned short bf16_t;
typedef short bf16x8 __attribute__((ext_vector_type(8)));
typedef float f32x4 __attribute__((ext_vector_type(4)));
typedef unsigned u32x4 __attribute__((ext_vector_type(4)));
typedef unsigned u32x2 __attribute__((ext_vector_type(2)));
constexpr int BM = 256, BK = 64, HALF = 128, HTB = HALF * BK * 2  , STAGE_BYTES = 8 * HTB, NXCD = 8, WGM = 8;

__host__ __device__ __forceinline__ int lds_byte(int r, int c) { const int st = (r >> 4) * 2 + (c >> 5), rr = r & 15, cc = c & 31, ob = rr * 64 + cc * 2; return st * 1024 + (ob ^ (((ob >> 9) & 1) << 5)); }
__host__ __device__ __forceinline__ void stage_rc(int b, int& R, int& C) { const int st = b / 1024, sb = b % 1024, swz = sb ^ (((sb >> 9) & 1) << 5); R = (st >> 1) * 16 + swz / 64; C = (st & 1) * 32 + (swz % 64) / 2; }
__host__ __device__ __forceinline__ int perm32(int rho) { const int n = rho >> 4, i = rho & 15; return 8 * (i >> 2) + 4 * n + (i & 3); }

struct Unit { int pm, pn, pmo, lt, nvalid, pnl; };
struct Gemm { const bf16_t* A; const bf16_t* Bt; int M, N, K; const int* rowidx; const float* rowscale; };

struct StaticOrder {
    static constexpr bool DEP = false, KEEP_ACC = false;
    int nM, nN, nwg, G, c;
    __host__ __device__ void init(int M, int N, int G_, int c_) { nM = M / BM; nN = N / BM; nwg = nM * nN; G = G_; c = c_; }
    __host__ __device__ bool next(int i, Unit& u) const {
        const long L = (long)i * G + c; if (L >= nwg) return false;
        int wgid = (int)L; { const int q = nwg / NXCD, r = nwg % NXCD, xcd = wgid % NXCD, off = wgid / NXCD; wgid = (xcd < r ? xcd * (q + 1) : r * (q + 1) + (xcd - r) * q) + off; }
        const int nig = WGM * nN, gid = wgid / nig, fm = gid * WGM, gsz = (nM - fm) < WGM ? (nM - fm) : WGM;
        u.pm = fm + ((wgid % nig) % gsz); u.pn = (wgid % nig) / gsz; u.pmo = u.pm; u.lt = u.pm; u.nvalid = 256; u.pnl = u.pn; return true;
    }
};
template <bool DEP_>
struct MoeOrderT {
    static constexpr bool DEP = DEP_, KEEP_ACC = false;
    const PG8_LAS int* tab; int G, c; bool a_is_out;
    int nheavy; const unsigned* dep;
    __device__ void wait(const Unit& u) const {
        const unsigned* p = dep + 16 * u.pmo; unsigned sp = 0;
        while (__hip_atomic_load(p, __ATOMIC_RELAXED, __HIP_MEMORY_SCOPE_AGENT) < 4u) { __builtin_amdgcn_s_sleep(2); if (++sp > (1u << 22)) break; }
        asm volatile("s_waitcnt vmcnt(0)" ::: "memory");
    }
    __device__ bool next(int i, Unit& u) const {
        int L;
        if constexpr (DEP_) { const int nl = G - nheavy; L = (c >= nheavy) ? (i < 2 ? i * nl + (c - nheavy) : 2 * nl + (i - 2) * G + c) : 2 * nl + i * G + c; }
        else L = i * G + c;
        const int tile = L >> 2, pnl = L & 3;
        const int lane = (int)__builtin_amdgcn_mbcnt_hi(~0u, __builtin_amdgcn_mbcnt_lo(~0u, 0u)), e_ = lane & 31;
        const int pre = tab[e_], ce = tab[32 + e_]; const int nt = (ce + 255) >> 8;
        const unsigned long long mk = __ballot(lane < 32 && tile >= pre && tile < pre + nt);
        if (mk == 0ull) return false;
        const int e = (int)__builtin_ctzll(mk);
        const int pre_e = __builtin_amdgcn_readlane(pre, e), ce_e = __builtin_amdgcn_readlane(ce, e);
        const int rt = tile - pre_e; u.pmo = tile; u.pm = a_is_out ? tile : 0; u.lt = e * 64 + rt; u.pn = e * 4 + pnl; u.pnl = pnl; const int rem = ce_e - rt * 256; u.nvalid = rem < 256 ? rem : 256; return true;
    }
};
typedef MoeOrderT<false> MoeOrder;
__device__ __forceinline__ void moe_fill_tab(PG8_LAS int* tab, const unsigned* cnt) {
    const int lane = (int)__builtin_amdgcn_mbcnt_hi(~0u, __builtin_amdgcn_mbcnt_lo(~0u, 0u));
    const int ce = (lane < 32) ? (int)cnt[lane & 31] : 0; const int nt = (ce + 255) >> 8;
    int incl = nt;
#pragma unroll
    for (int o = 1; o < 32; o <<= 1) { const int v = __shfl_up(incl, o); if (lane >= o) incl += v; }
    if (lane < 32) { tab[lane] = incl - nt; tab[32 + lane] = ce; }
}

__device__ __forceinline__ unsigned cvt_pk_bf16(float lo, float hi) { unsigned r; asm volatile("v_cvt_pk_bf16_f32 %0, %1, %2" : "=v"(r) : "v"(lo), "v"(hi)); return r; }

template <class Epi, class Sched, bool ALIGN_EPI, bool GATHER>
__device__ __forceinline__ void gemm_phase(PG8_LAS unsigned char* lds, const Gemm g, const Sched& S, const Epi& E) {
    const int tid = threadIdx.x, wid = __builtin_amdgcn_readfirstlane(tid >> 6), lane = tid & 63, wr = wid >> 2, wc = wid & 3, fr = lane & 15, fq = lane >> 4;
    constexpr int AUX_A = Sched::DEP ? 16 : 0;
    int K_ = g.K; asm volatile("" : "+s"(K_));
    const int K = K_, nt = K / BK;
    unsigned voffB[2]; int RA[2], CA[2];
#pragma unroll
    for (int i = 0; i < 2; ++i) { int R, C; stage_rc(tid * 16 + i * 8192, R, C); const int Rb = Epi::PERM ? ((R & ~31) + perm32(R & 31)) : R;
        RA[i] = R; CA[i] = C; voffB[i] = (unsigned)(Rb * K + C) * 2u; }
    const size_t kstep = (size_t)(BK * 2);
    const size_t hstep = (size_t)HALF * K * 2;
    const size_t tstep = 2 * hstep;
    const unsigned ldsw = (unsigned)wid * 1024u;
    const int aoff = lds_byte(wr * 64 + fr, fq * 8), boff = lds_byte(wc * 32 + fr, fq * 8);
    unsigned vA[2][2], vN[2][2];
    PG8_LAS int* rowl = (PG8_LAS int*)(lds + STAGE_BYTES);
    if constexpr (GATHER) {
        for (int i = 0; i < 4; ++i) { Unit uu; if (!S.next(i, uu)) break; if (tid < 256) { const int tk = (tid < uu.nvalid) ? (g.rowidx[(size_t)uu.lt * 256 + tid] >> 1) : 0; rowl[i * 256 + tid] = tk; ((PG8_LAS float*)(rowl + 1024))[i * 256 + tid] = g.rowscale[tk]; } }
        asm volatile("s_waitcnt vmcnt(0) lgkmcnt(0)" ::: "memory"); __builtin_amdgcn_s_barrier(); asm volatile("" ::: "memory");
    }
    auto compute_v = [&](const Unit& u, unsigned (&v)[2][2], int ui_) {
#pragma unroll
        for (int h = 0; h < 2; ++h)
#pragma unroll
            for (int i = 0; i < 2; ++i) {
                const int rl = h * HALF + RA[i];
                if constexpr (GATHER) { const int tok = rowl[ui_ * 256 + rl]; v[h][i] = ((unsigned)tok * (unsigned)K + (unsigned)CA[i]) * 2u; }
                else v[h][i] = ((unsigned)rl * (unsigned)K + (unsigned)CA[i]) * 2u;
            }
    };
#define PG8_SA(b, h) (((b) * 2 + (h)) * HTB)
#define PG8_SB(b, h) ((4 + (b) * 2 + (h)) * HTB)
#define PG8_STAGE_X(bufoff, gbase, voff, aux) do { _Pragma("unroll") for (int _i = 0; _i < 2; ++_i) \
        __builtin_amdgcn_global_load_lds((const unsigned*)((const char*)(gbase) + (voff)[_i]), (PG8_LAS unsigned*)(lds + (bufoff) + ldsw + _i * 8192), 16, 0, aux); } while (0)
#define PG8_STAGE(bufoff, gbase, voff) PG8_STAGE_X(bufoff, gbase, voff, 0)
#define PG8_STAGE_A(bufoff, gbase, voff) PG8_STAGE_X(bufoff, gbase, voff, AUX_A)
#define PG8_LDA(dst, b, h) do { _Pragma("unroll") for (int m = 0; m < 4; ++m) _Pragma("unroll") for (int k = 0; k < 2; ++k) dst[m][k] = *(const PG8_LAS bf16x8*)(lds + PG8_SA(b, h) + aoff + m * 2048 + k * 1024); } while (0)
#define PG8_LDB(dst, b, h) do { _Pragma("unroll") for (int n = 0; n < 2; ++n) _Pragma("unroll") for (int k = 0; k < 2; ++k) dst[n][k] = *(const PG8_LAS bf16x8*)(lds + PG8_SB(b, h) + boff + n * 2048 + k * 1024); } while (0)
#define PG8_MMA(ai, bj, At, Bt) do { __builtin_amdgcn_s_setprio(1); _Pragma("unroll") for (int m = 0; m < 4; ++m) _Pragma("unroll") for (int n = 0; n < 2; ++n) _Pragma("unroll") for (int k = 0; k < 2; ++k) \
        acc[ai][bj][m][n] = __builtin_amdgcn_mfma_f32_16x16x32_bf16(Bt[n][k], At[m][k], acc[ai][bj][m][n], 0, 0, 0); __builtin_amdgcn_s_setprio(0); } while (0)
#define PG8_WAIT_V(n) asm volatile("s_waitcnt vmcnt(" #n ")" ::: "memory")
#define PG8_WAIT_L(n) asm volatile("s_waitcnt lgkmcnt(" #n ")" ::: "memory")
#define PG8_BAR __builtin_amdgcn_s_barrier()
#define PG8_SCHED __builtin_amdgcn_sched_barrier(0)
    Unit cur, nxt; int ui = 0;
    if (!S.next(0, cur)) return;
    f32x4 acc[2][2][4][2];
#pragma unroll
    for (int a = 0; a < 2; ++a)
#pragma unroll
        for (int b = 0; b < 2; ++b)
#pragma unroll
            for (int m = 0; m < 4; ++m)
#pragma unroll
                for (int n = 0; n < 2; ++n) acc[a][b][m][n] = (f32x4){0.f, 0.f, 0.f, 0.f};
    bf16x8 At[4][2], B0[2][2], B1[2][2];
    if constexpr (Sched::DEP) { if (tid == 0) S.wait(cur); PG8_BAR; }
    compute_v(cur, vA, 0);
    const char* cA = (const char*)g.A + (GATHER ? (size_t)0 : (size_t)cur.pm * tstep); const char* cB = (const char*)g.Bt + (size_t)cur.pn * tstep;
    PG8_STAGE(PG8_SB(0, 0), cB, voffB); PG8_STAGE(PG8_SB(0, 1), cB + hstep, voffB); PG8_STAGE_A(PG8_SA(0, 0), cA, vA[0]); PG8_STAGE_A(PG8_SA(0, 1), cA, vA[1]);
    if (wr == 1) PG8_BAR;
    PG8_WAIT_V(2); PG8_BAR;
    PG8_STAGE(PG8_SB(1, 0), cB + kstep, voffB); PG8_STAGE_A(PG8_SA(1, 0), cA + kstep, vA[0]); PG8_STAGE(PG8_SB(1, 1), cB + hstep + kstep, voffB);
    PG8_WAIT_V(6); PG8_BAR;
    for (;;) {
        const bool has_next = S.next(ui + 1, nxt);
        if (has_next) compute_v(nxt, vN, ui + 1);
        else {
#pragma unroll
            for (int h = 0; h < 2; ++h)
#pragma unroll
                for (int i = 0; i < 2; ++i) vN[h][i] = vA[h][i];
        }
        const char* nA = has_next ? ((const char*)g.A + (GATHER ? (size_t)0 : (size_t)nxt.pm * tstep)) : cA; const char* nB = has_next ? (const char*)g.Bt + (size_t)nxt.pn * tstep : cB;
#pragma unroll 1
        for (int t = 0; t < nt; t += 2) {
            const bool last = (t == nt - 2);
            if constexpr (Sched::DEP) { if (last && has_next) { if (tid == 0) S.wait(nxt); PG8_BAR; } }
            const char* a1 = cA + (size_t)(t + 1) * kstep;
            const char* a2 = last ? nA : cA + (size_t)(t + 2) * kstep; const char* b2 = last ? nB : cB + (size_t)(t + 2) * kstep;
            const char* a3 = a2 + kstep; const char* b3 = b2 + kstep;
            unsigned vX0[2], vX1[2];
#pragma unroll
            for (int i = 0; i < 2; ++i) { vX0[i] = last ? vN[0][i] : vA[0][i]; vX1[i] = last ? vN[1][i] : vA[1][i]; }
            PG8_LDB(B0, 0, 0); PG8_LDB(B1, 0, 1); PG8_SCHED; PG8_LDA(At, 0, 0); PG8_STAGE_A(PG8_SA(1, 1), a1, vA[1]);
            PG8_WAIT_V(8); PG8_WAIT_L(0); PG8_BAR; PG8_MMA(0, 0, At, B0); PG8_MMA(0, 1, At, B1); PG8_BAR; PG8_SCHED;
            PG8_LDA(At, 0, 1); PG8_STAGE(PG8_SB(0, 0), b2, voffB); PG8_STAGE(PG8_SB(0, 1), b2 + hstep, voffB); PG8_STAGE_A(PG8_SA(0, 0), a2, vX0);
            PG8_WAIT_V(8); PG8_WAIT_L(0); PG8_BAR; PG8_MMA(1, 0, At, B0); PG8_MMA(1, 1, At, B1); PG8_BAR; PG8_SCHED;
            PG8_LDB(B0, 1, 0); PG8_LDB(B1, 1, 1); PG8_SCHED; PG8_LDA(At, 1, 0); PG8_STAGE_A(PG8_SA(0, 1), a2, vX1);
            PG8_WAIT_V(8); PG8_WAIT_L(0); PG8_BAR; PG8_MMA(0, 0, At, B0); PG8_MMA(0, 1, At, B1); PG8_BAR; PG8_SCHED;
            PG8_LDA(At, 1, 1); PG8_STAGE(PG8_SB(1, 0), b3, voffB); PG8_STAGE(PG8_SB(1, 1), b3 + hstep, voffB); PG8_STAGE_A(PG8_SA(1, 0), a3, vX0);
            PG8_WAIT_V(8); PG8_WAIT_L(0); PG8_BAR; PG8_MMA(1, 0, At, B0); PG8_MMA(1, 1, At, B1); PG8_BAR; PG8_SCHED;
        }
        if constexpr (ALIGN_EPI) { if (wr == 0) PG8_BAR; }
        if constexpr (GATHER) cur.pm = ui;
        E(acc, cur, wr, wc, fr, fq);
        if (!has_next) break;
        if constexpr (!Sched::KEEP_ACC) {
#pragma unroll
        for (int a = 0; a < 2; ++a)
#pragma unroll
            for (int b = 0; b < 2; ++b)
#pragma unroll
                for (int m = 0; m < 4; ++m)
#pragma unroll
                    for (int n = 0; n < 2; ++n) acc[a][b][m][n] = (f32x4){0.f, 0.f, 0.f, 0.f};
        }
        cur = nxt; cA = nA; cB = nB; ++ui;
#pragma unroll
        for (int h = 0; h < 2; ++h)
#pragma unroll
            for (int i = 0; i < 2; ++i) vA[h][i] = vN[h][i];
        if constexpr (ALIGN_EPI) { if (wr == 1) PG8_BAR; }
    }
    PG8_WAIT_V(0);
    if constexpr (!ALIGN_EPI) { if (wr == 0) PG8_BAR; }
    PG8_BAR;
#undef PG8_SA
#undef PG8_SB
#undef PG8_STAGE
#undef PG8_STAGE_X
#undef PG8_STAGE_A
#undef PG8_LDA
#undef PG8_LDB
#undef PG8_MMA
#undef PG8_WAIT_V
#undef PG8_WAIT_L
#undef PG8_BAR
#undef PG8_SCHED
}
}

constexpr int NWAVES = 8;
constexpr int M = 16384, D = 1024, SEQ = 2048, NBATCH = 8;
constexpr int NIN = 5144;
constexpr int NZ = 5120;
constexpr int ZC_R = 0, ZC_K = 512, ZC_V = 1024, ZC_W = 1536, ZC_Q = 1792, ZC_KC = 2304, ZC_VC = 2432, ZC_KS = 2560, ZC_VS = 2688, ZC_KW = 2816, ZC_VW = 2944, ZC_MR = 3072, ZC_MN = 4096;
constexpr float NORM_EPS = 1e-6f, GN_EPS = 64e-5f;

constexpr size_t MiB = 1u << 20;
constexpr size_t WS_CTL = 0, CTL_ZERO_BYTES = 64 * 1024;
constexpr size_t WS_LIST = 1 * MiB;
constexpr size_t WS_GATEA = 3 * MiB;
constexpr size_t WS_RSE = 4 * MiB;
constexpr size_t WS_SLOTA = 4 * MiB + 512 * 1024;
constexpr size_t WS_SELMASK = 5 * MiB;
constexpr size_t WS_ZGATE = 6 * MiB;
constexpr size_t WS_SMALLW = 8 * MiB;
constexpr size_t SW_W2T = 0, SW_A2T = 65536, SW_G2T = 131072, SW_CK1 = 262144, SW_CV1 = 524288, SW_CK2 = 786432, SW_CV2 = 794624, SW_GATEW = 802816, SW_ROUTEW = 868352;
constexpr size_t WS_KCMP = 10 * MiB;
constexpr size_t WS_VST = 11 * MiB, WS_VWT = 15 * MiB;
constexpr size_t WS_WIN = 19 * MiB, WS_UR = 29 * MiB, WS_UN = 30 * MiB, WS_WO = 31 * MiB, WS_WPP = 33 * MiB, WS_WPG = 34 * MiB, WS_WGU = 36 * MiB, WS_WD = 100 * MiB;
constexpr size_t WS_XN = 132 * MiB;
constexpr size_t WS_PBF = 164 * MiB;
constexpr size_t WS_Z = 172 * MiB;
constexpr size_t WS_S = 332 * MiB;
constexpr size_t WS_YRW = 428 * MiB, WS_YB = 444 * MiB, WS_G = 492 * MiB, WS_LOGITS = 508 * MiB  , WS_BONUS = 508 * MiB  , WS_END = 511 * MiB;
constexpr int CH_PP = 144, CH_P = 0, CH_R = 2304, CH_Q = 4608, CH_K = 6656, CH_G = 8704, CH_AC = 10752, CH_REC = 11008, CH_V = 11008, CH_SLOT = 11520;
constexpr int CW_CNT = 0;
constexpr int CW_PANEL = 8192;
constexpr int CW_DEP = 12288;
constexpr int CW_BAR = 1024;
constexpr int MISC_OFF = 163840 - 64;

constexpr int LDS_BYTES = 163840;

#define GAS __attribute__((address_space(1)))
#define LAS __attribute__((address_space(3)))
typedef unsigned short bf16;
typedef unsigned v4u __attribute__((ext_vector_type(4)));
typedef unsigned v2u __attribute__((ext_vector_type(2)));
typedef float f32x4 __attribute__((ext_vector_type(4)));
typedef float f32x2 __attribute__((ext_vector_type(2)));
typedef short bf16x8 __attribute__((ext_vector_type(8)));
typedef short bf16x4 __attribute__((ext_vector_type(4)));
typedef __bf16 bf16x2_t __attribute__((ext_vector_type(2)));
#define LDS_WAIT() asm volatile("s_waitcnt lgkmcnt(0)" ::: "memory")
#define MFMA16(a, b, c) __builtin_amdgcn_mfma_f32_16x16x32_bf16((a), (b), (c), 0, 0, 0)

__device__ __forceinline__ float bf2f(unsigned short v) { return __uint_as_float((unsigned)v << 16); }
__device__ __forceinline__ unsigned pk2(float lo, float hi) { f32x2 v = {lo, hi}; bf16x2_t b = __builtin_convertvector(v, bf16x2_t); return __builtin_bit_cast(unsigned, b); }
__device__ __forceinline__ v2u pk4(f32x4 v) { v2u r; r.x = pk2(v.x, v.y); r.y = pk2(v.z, v.w); return r; }
__device__ __forceinline__ f32x4 unpk4(v2u w) { f32x4 r; r.x = __uint_as_float(w.x << 16); r.y = __uint_as_float(w.x & 0xffff0000u); r.z = __uint_as_float(w.y << 16); r.w = __uint_as_float(w.y & 0xffff0000u); return r; }
__device__ __forceinline__ void unpk8(v4u w, float (&f)[8]) { f[0] = __uint_as_float(w.x << 16); f[1] = __uint_as_float(w.x & 0xffff0000u); f[2] = __uint_as_float(w.y << 16); f[3] = __uint_as_float(w.y & 0xffff0000u);
    f[4] = __uint_as_float(w.z << 16); f[5] = __uint_as_float(w.z & 0xffff0000u); f[6] = __uint_as_float(w.w << 16); f[7] = __uint_as_float(w.w & 0xffff0000u); }
__device__ __forceinline__ float sigmoidf_(float x) { return __builtin_amdgcn_rcpf(1.0f + __expf(-x)); }
__device__ __forceinline__ float wave_sum(float v) {
#pragma unroll
    for (int o = 1; o < 64; o <<= 1) v += __shfl_xor(v, o);
    return v;
}
template <int CTRL> __device__ __forceinline__ float dppf(float x) { return __builtin_bit_cast(float, __builtin_amdgcn_update_dpp(0, __builtin_bit_cast(int, x), CTRL, 0xf, 0xf, false)); }
__device__ __forceinline__ float row16_sum(float x) { x += dppf<0x128>(x); x += dppf<0x124>(x); x += dppf<0x122>(x); x += dppf<0x121>(x); return x; }

typedef GAS unsigned gu32;
#define XB_TMO      128
#define XB_XCNT(j)  (256  + 64 * (j))
#define XB_XSUB(j)  (1280 + 64 * (j))
#define XB_XGEN(j)  (2304 + 64 * (j))
#define XB_TOP      3328
#define XB_TOPGEN   3392
#define XCD_BAR_WORDS 3456
#define XB_SPIN_CAP (1u << 18)

__device__ __forceinline__ unsigned xb_ld(unsigned* p)              { return __hip_atomic_load(p, __ATOMIC_RELAXED, __HIP_MEMORY_SCOPE_AGENT); }
__device__ __forceinline__ unsigned xb_add(unsigned* p, unsigned v) { return __hip_atomic_fetch_add(p, v, __ATOMIC_RELAXED, __HIP_MEMORY_SCOPE_AGENT); }
__device__ __forceinline__ unsigned xb_xcc_id() { return (unsigned)__builtin_amdgcn_s_getreg((3 << 11) | 20) & 0xFu; }
#define XB_SPIN(cond, bar) do { unsigned _sp = 0; while (cond) { __builtin_amdgcn_s_sleep(1); \
    if ((++_sp & 255u) == 0u) { if (xb_ld(&(bar)[XB_TMO])) break; if (_sp > XB_SPIN_CAP) { atomicAdd(&(bar)[XB_TMO], 1u); break; } } } } while (0)

struct XcdBarrier {
    unsigned* bar; unsigned x;
    volatile LAS unsigned* st;
};

__device__ __forceinline__ XcdBarrier xcd_barrier_post(unsigned* bar, volatile LAS unsigned* st) {
    XcdBarrier b; b.bar = bar; b.x = xb_xcc_id(); b.st = st;
    if (threadIdx.x == 0) (void)xb_add(&bar[XB_XCNT(b.x)], 1u);
    return b;
}
__device__ __forceinline__ void xcd_barrier_complete(unsigned* bar, unsigned x, unsigned& nloc, unsigned& nx) {
    const unsigned G = gridDim.x * gridDim.y * gridDim.z;
    unsigned sum, cnt, mine, sp = 0u;
    for (;;) {
        sum = 0u; cnt = 0u; mine = 0u;
#pragma unroll
        for (unsigned j = 0; j < 16; ++j) { const unsigned c = xb_ld(&bar[XB_XCNT(j)]); sum += c; cnt += (c > 0u) ? 1u : 0u; mine = (j == x) ? c : mine; }
        if (sum == G) break;
        __builtin_amdgcn_s_sleep(1);
        if ((++sp & 255u) == 0u) { if (xb_ld(&bar[XB_TMO])) break; if (sp > XB_SPIN_CAP) { atomicAdd(&bar[XB_TMO], 1u); break; } }
    }
    nloc = mine > 0u ? mine : 1u; nx = cnt > 0u ? cnt : 1u;
}

__device__ __forceinline__ void xcd_barrier(const XcdBarrier& b) {
    asm volatile("s_waitcnt vmcnt(0)" ::: "memory");
    __syncthreads();
    if (threadIdx.x == 0) {
        unsigned* bar = b.bar;
        __builtin_amdgcn_s_waitcnt(0);
        unsigned nloc = b.st[0], nx = b.st[1];
        if (nloc == 0u) { xcd_barrier_complete(bar, b.x, nloc, nx); b.st[0] = nloc; b.st[1] = nx; }
        const unsigned old = xb_add(&bar[XB_XSUB(b.x)], 1u);
        const unsigned gen = old / nloc;
        if (old + 1u == (gen + 1u) * nloc) {
            __builtin_amdgcn_fence(__ATOMIC_RELEASE, "agent");
            asm volatile("s_waitcnt vmcnt(0)" ::: "memory");
            const unsigned og = xb_add(&bar[XB_TOP], 1u);
            const unsigned tg = og / nx;
            if (og + 1u == (tg + 1u) * nx) xb_add(&bar[XB_TOPGEN], 1u);
            else XB_SPIN(xb_ld(&bar[XB_TOPGEN]) == tg, bar);
            __builtin_amdgcn_fence(__ATOMIC_ACQUIRE, "agent");
            xb_add(&bar[XB_XGEN(b.x)], 1u);
            asm volatile("s_waitcnt vmcnt(0)" ::: "memory");
        } else {
            XB_SPIN(xb_ld(&bar[XB_XGEN(b.x)]) == gen, bar);
            __builtin_amdgcn_fence(__ATOMIC_ACQUIRE, "agent");
            asm volatile("s_waitcnt vmcnt(0)" ::: "memory");
        }
    }
    __syncthreads();
}

struct Args { const float* in[37]; float* out; unsigned char* ws; int ph_lo, ph_hi, rep_mask, pad; };
typedef __attribute__((address_space(4))) const Args* ArgsP;
struct Frame {
    LAS unsigned char* lds;
    int tid, lane, wave, vcu, G, gw, NGW;
    unsigned char* ws;
    ArgsP ap;
    float* out;
};

struct TrDesc { const float* W; bf16* T; bf16* T2; const float* gain; int K, ld, nc, item, mode; };
__device__ __forceinline__ void tr_load(const TrDesc& d, int lane, float (&tv)[32], f32x4 (&gn)[2]) {
    const int nblk = (d.nc + 31) / 32, kb = d.item / nblk, nb = d.item % nblk, k0 = 64 * kb, n0 = 32 * nb;
    const int nn = n0 + (lane & 31);
    gn[0] = (f32x4){1.f, 1.f, 1.f, 1.f}; gn[1] = gn[0];
    if (d.gain) { const float* gp = d.gain + k0 + 8 * (lane & 7); gn[0] = *(const f32x4*)gp; gn[1] = *(const f32x4*)(gp + 4); }
    const float* wsrc = d.W + (size_t)(k0 + (lane >> 5)) * d.ld + (nn < d.nc ? nn : 0);
#pragma unroll
    for (int i = 0; i < 32; ++i) tv[i] = wsrc[(size_t)(2 * i) * d.ld];
}
__device__ __forceinline__ void tr_finish(const TrDesc& d, LAS float* scr, int lane, const float (&tv)[32], const f32x4 (&gn)[2]) {
    const int nblk = (d.nc + 31) / 32, kb = d.item / nblk, nb = d.item % nblk, k0 = 64 * kb, n0 = 32 * nb;
#pragma unroll
    for (int i = 0; i < 32; ++i) scr[(2 * i + (lane >> 5)) * 33 + (lane & 31)] = tv[i];
    LDS_WAIT(); asm volatile("" ::: "memory");
    const int c = lane & 7;
#pragma unroll
    for (int j = 0; j < 4; ++j) { const int nl = (lane >> 3) + 8 * j, n = n0 + nl; const LAS float* s = scr + (8 * c) * 33 + nl;
        v4u o; o.x = pk2(s[0 * 33] * gn[0].x, s[1 * 33] * gn[0].y); o.y = pk2(s[2 * 33] * gn[0].z, s[3 * 33] * gn[0].w); o.z = pk2(s[4 * 33] * gn[1].x, s[5 * 33] * gn[1].y); o.w = pk2(s[6 * 33] * gn[1].z, s[7 * 33] * gn[1].w);
        if (n < d.nc) { bf16* rp;
            if (d.mode == 1) rp = n < 3072 ? d.T + (size_t)n * 1024 : (n < 3096 ? d.T2 + (size_t)(n - 3072) * 1024 : d.T + (size_t)(n - 24) * 1024);
            else if (d.mode == 2) { const int n2 = n & 511; rp = d.T + (size_t)((n2 >> 7) * 256 + (n >> 9) * 128 + (n2 & 127)) * 1024; }
            else rp = d.T + (size_t)n * d.K;
            *(v4u*)(rp + k0 + 8 * c) = o; } }
    LDS_WAIT(); asm volatile("" ::: "memory");
}
__device__ __forceinline__ void rms_row_to_bf16(int lane, const float* xrow, const float* gain, bf16* orow) {
    const f32x4* xr = (const f32x4*)xrow + lane; const f32x4* gr = (const f32x4*)gain + lane;
    f32x4 v[4]; float s = 0.f;
#pragma unroll
    for (int j = 0; j < 4; ++j) { v[j] = xr[64 * j]; s += (v[j].x * v[j].x + v[j].y * v[j].y) + (v[j].z * v[j].z + v[j].w * v[j].w); }
    const float rs = 1.0f / sqrtf(wave_sum(s) * (1.f / D) + NORM_EPS);
    v2u* o8 = (v2u*)orow + lane;
#pragma unroll
    for (int j = 0; j < 4; ++j) { const f32x4 g = gr[64 * j]; o8[64 * j] = pk4(v[j] * rs * g); }
}

namespace tri {
constexpr int I_WIN = 16 * 161, I_UR = 8 * 32, I_WO = 16 * 32, I_WPP = 4 * 32, I_L64 = 16, I_L128 = 32, I_C1 = 32 * 2, I_C2 = 2, I_GU = 16 * 32, I_DN = 8 * 32;
constexpr int E0 = I_WIN, E1 = E0 + I_UR, E2 = E1 + I_UR, E3 = E2 + I_WO, E4 = E3 + I_WPP, E5 = E4 + I_WO, E6 = E5 + I_L64, E7 = E6 + I_L64, E8 = E7 + I_L128, E9 = E8 + I_C1, E10 = E9 + I_C1, E11 = E10 + I_C2, E12 = E11 + I_C2,
              E13 = E12 + 32 * I_GU, NITEMS = E13 + 32 * I_DN;
}
__device__ __forceinline__ TrDesc tr_desc(Frame& F, int it) {
    using namespace tri;
    unsigned char* ws = F.ws;
    const float* W; const float* gain = nullptr; int K, ld, nc, item, mode = 0; size_t dst;
    if (it < E0) { W = F.ap->in[3]; K = 1024; ld = NIN; nc = NIN; item = it; mode = 1; dst = WS_WIN; }
    else if (it < E1) { W = F.ap->in[22]; K = 512; ld = 1024; nc = 1024; item = it - E0; dst = WS_UR; }
    else if (it < E2) { W = F.ap->in[23]; K = 512; ld = 1024; nc = 1024; item = it - E1; dst = WS_UN; }
    else if (it < E3) { W = F.ap->in[24]; K = 1024; ld = 1024; nc = 1024; item = it - E2; dst = WS_WO; }
    else if (it < E4) { W = F.ap->in[32]; K = 256; ld = 1024; nc = 1024; item = it - E3; dst = WS_WPP; }
    else if (it < E5) { W = F.ap->in[35]; K = 1024; ld = 1024; nc = 1024; item = it - E4; dst = WS_WPG; gain = F.ap->in[34]; }
    else if (it < E6) { W = F.ap->in[6]; K = 64; ld = 512; nc = 512; item = it - E5; dst = WS_SMALLW + SW_W2T; }
    else if (it < E7) { W = F.ap->in[8]; K = 64; ld = 512; nc = 512; item = it - E6; dst = WS_SMALLW + SW_A2T; }
    else if (it < E8) { W = F.ap->in[9]; K = 128; ld = 512; nc = 512; item = it - E7; dst = WS_SMALLW + SW_G2T; }
    else if (it < E9) { W = F.ap->in[17]; K = 2048; ld = 64; nc = 64; item = it - E8; dst = WS_SMALLW + SW_CK1; }
    else if (it < E10) { W = F.ap->in[19]; K = 2048; ld = 64; nc = 64; item = it - E9; dst = WS_SMALLW + SW_CV1; }
    else if (it < E11) { W = F.ap->in[18]; K = 64; ld = 64; nc = 64; item = it - E10; dst = WS_SMALLW + SW_CK2; }
    else if (it < E12) { W = F.ap->in[20]; K = 64; ld = 64; nc = 64; item = it - E11; dst = WS_SMALLW + SW_CV2; }
    else if (it < E13) { const int r = it - E12, e = r / I_GU; W = F.ap->in[30] + (size_t)e * 1024 * 1024; K = 1024; ld = 1024; nc = 1024; item = r % I_GU; mode = 2; dst = WS_WGU + (size_t)e * 1024 * 1024 * 2; gain = F.ap->in[25]; }
    else { const int r = it - E13, e = r / I_DN; W = F.ap->in[31] + (size_t)e * 512 * 1024; K = 512; ld = 1024; nc = 1024; item = r % I_DN; dst = WS_WD + (size_t)e * 1024 * 512 * 2; }
    return TrDesc{W, (bf16*)(ws + dst), (bf16*)(ws + WS_SMALLW + SW_GATEW), gain, K, ld, nc, item, mode};
}
__device__ __forceinline__ void tr_run(Frame& F, LAS float* scr, int it0, int stride, int it_end) {
    if (it0 >= it_end) return;
    float tvA[32], tvB[32]; f32x4 gnA[2], gnB[2];
    int it = it0; TrDesc cur = tr_desc(F, it); tr_load(cur, F.lane, tvA, gnA);
    for (;;) {
        const int nxt = it + stride; const bool has = nxt < it_end; TrDesc dn = cur;
        if (has) { dn = tr_desc(F, nxt); tr_load(dn, F.lane, tvB, gnB); }
        __builtin_amdgcn_sched_barrier(0);
        tr_finish(cur, scr, F.lane, tvA, gnA);
        if (!has) break;
        cur = dn; it = nxt;
#pragma unroll
        for (int i = 0; i < 32; ++i) tvA[i] = tvB[i];
        gnA[0] = gnB[0]; gnA[1] = gnB[1];
    }
}
__device__ __forceinline__ int tr_qnext(LAS int* qh) {
    int k = 0; const unsigned a = (unsigned)(size_t)qh; const int one = 1;
    if (__builtin_amdgcn_mbcnt_hi(~0u, __builtin_amdgcn_mbcnt_lo(~0u, 0u)) == 0) asm volatile("ds_add_rtn_u32 %0, %1, %2\n\ts_waitcnt lgkmcnt(0)" : "=&v"(k) : "v"(a), "v"(one) : "memory");
    return __builtin_amdgcn_readfirstlane(k);
}
__device__ __forceinline__ void tr_run_q(Frame& F, LAS float* scr, LAS int* qh, int base, int stride, int nk) {
    int k = tr_qnext(qh); if (k >= nk) return;
    float tvA[32], tvB[32]; f32x4 gnA[2], gnB[2];
    TrDesc cur = tr_desc(F, base + k * stride); tr_load(cur, F.lane, tvA, gnA);
    for (;;) {
        const int kn = tr_qnext(qh); const bool has = kn < nk; TrDesc dn = cur;
        if (has) { dn = tr_desc(F, base + kn * stride); tr_load(dn, F.lane, tvB, gnB); }
        __builtin_amdgcn_sched_barrier(0);
        tr_finish(cur, scr, F.lane, tvA, gnA);
        if (!has) break;
        cur = dn;
#pragma unroll
        for (int i = 0; i < 32; ++i) tvA[i] = tvB[i];
        gnA[0] = gnB[0]; gnA[1] = gnB[1];
    }
}
#ifndef MK_EXPERTS_IN_SCAN
#define MK_EXPERTS_IN_SCAN 1
#endif
__device__ __forceinline__ void p0_prologue(Frame& F) {
    LAS float* scr = (LAS float*)(F.lds + F.wave * 16384);
    unsigned char* ws = F.ws;
    bf16* gateWT = (bf16*)(ws + WS_SMALLW + SW_GATEW);
    tr_run(F, scr, F.gw, F.NGW, MK_EXPERTS_IN_SCAN ? tri::E12 : tri::NITEMS);
    for (int mb = F.gw; mb < M; mb += 4 * F.NGW) {
        f32x4 v[4][4]; float s[4];
#pragma unroll
        for (int u = 0; u < 4; ++u) { const f32x4* xr = (const f32x4*)(F.ap->in[0] + (size_t)(mb + u * F.NGW) * D) + F.lane;
#pragma unroll
            for (int j = 0; j < 4; ++j) v[u][j] = xr[64 * j]; }
#pragma unroll
        for (int u = 0; u < 4; ++u) { s[u] = 0.f;
#pragma unroll
            for (int j = 0; j < 4; ++j) s[u] += (v[u][j].x * v[u][j].x + v[u][j].y * v[u][j].y) + (v[u][j].z * v[u][j].z + v[u][j].w * v[u][j].w); }
#pragma unroll
        for (int o = 1; o < 64; o <<= 1) {
#pragma unroll
            for (int u = 0; u < 4; ++u) s[u] += __shfl_xor(s[u], o); }
        const f32x4* gr = (const f32x4*)F.ap->in[2] + F.lane;
#pragma unroll
        for (int u = 0; u < 4; ++u) { const float rs = 1.0f / sqrtf(s[u] * (1.f / D) + NORM_EPS); v2u* o8 = (v2u*)((bf16*)(ws + WS_XN) + (size_t)(mb + u * F.NGW) * D) + F.lane;
#pragma unroll
            for (int j = 0; j < 4; ++j) o8[64 * j] = pk4(v[u][j] * rs * gr[64 * j]); }
    }
    {
        float* RW = (float*)(ws + WS_SMALLW + SW_ROUTEW); const float* gf = F.ap->in[25]; const float* wg = F.ap->in[26]; const float* wr = F.ap->in[28];
        for (int idx = F.gw * 64 + F.lane; idx < 48 * 1024; idx += F.NGW * 64) { const int c = idx >> 10, k = idx & 1023; float v = 0.f;
            if (c < 4) v = wg[k * 4 + c]; else if (c < 36) v = wr[k * 32 + (c - 4)];
            RW[idx] = v * gf[k]; }
        for (int idx = F.gw * 64 + F.lane; idx < 8 * 1024; idx += F.NGW * 64) gateWT[24 * 1024 + idx] = 0;
    }
}

struct EpiStoreBf16 {
    static constexpr bool PERM = true;
    bf16* O; int ldc;
    __device__ __forceinline__ void operator()(const f32x4 (&acc)[2][2][4][2], const pg8::Unit& u, int wr, int wc, int fr, int fq) const {
        const int row0 = u.pmo * 256 + wr * 64 + fr, col0 = u.pnl * 256 + wc * 32 + 8 * fq;
#pragma unroll
        for (int ai = 0; ai < 2; ++ai)
#pragma unroll
            for (int m = 0; m < 4; ++m) { bf16* rowp = O + (size_t)(row0 + ai * 128 + m * 16) * ldc + col0;
#pragma unroll
                for (int bj = 0; bj < 2; ++bj) { const f32x4 v0 = acc[ai][bj][m][0], v1 = acc[ai][bj][m][1]; v4u w; w.x = pk2(v0[0], v0[1]); w.y = pk2(v0[2], v0[3]); w.z = pk2(v1[0], v1[1]); w.w = pk2(v1[2], v1[3]);
                    *(v4u*)(rowp + bj * 128) = w; } }
    }
};
struct EpiStoreSsq {
    static constexpr bool PERM = true;
    bf16* O; int ldc; float* part;
    __device__ __forceinline__ void operator()(const f32x4 (&acc)[2][2][4][2], const pg8::Unit& u, int wr, int wc, int fr, int fq) const {
        const int row0 = u.pmo * 256 + wr * 64 + fr, col0 = u.pnl * 256 + wc * 32 + 8 * fq;
#pragma unroll
        for (int ai = 0; ai < 2; ++ai)
#pragma unroll
            for (int m = 0; m < 4; ++m) { bf16* rowp = O + (size_t)(row0 + ai * 128 + m * 16) * ldc + col0; float ss = 0.f;
#pragma unroll
                for (int bj = 0; bj < 2; ++bj) { const f32x4 v0 = acc[ai][bj][m][0], v1 = acc[ai][bj][m][1]; v4u w; w.x = pk2(v0[0], v0[1]); w.y = pk2(v0[2], v0[3]); w.z = pk2(v1[0], v1[1]); w.w = pk2(v1[2], v1[3]);
                    *(v4u*)(rowp + bj * 128) = w;
                    ss += ((v0[0] * v0[0] + v0[1] * v0[1]) + (v0[2] * v0[2] + v0[3] * v0[3])) + ((v1[0] * v1[0] + v1[1] * v1[1]) + (v1[2] * v1[2] + v1[3] * v1[3])); }
                ss += __shfl_xor(ss, 16); ss += __shfl_xor(ss, 32);
                if (fq == 0) part[(size_t)(row0 + ai * 128 + m * 16) * 16 + u.pnl * 4 + wc] = ss; }
    }
};
#define EPI_LOOP_BEGIN \
    _Pragma("unroll") for (int ai = 0; ai < 2; ++ai) _Pragma("unroll") for (int m = 0; m < 4; ++m) { if (m == 0 || m == 2) asm volatile("" ::: "memory"); const int rl = ai * 128 + wr * 64 + m * 16 + fr; const size_t row = (size_t)u.pmo * 256 + rl; (void)row; \
    _Pragma("unroll") for (int bj = 0; bj < 2; ++bj) _Pragma("unroll") for (int n = 0; n < 2; ++n) { const int col = u.pnl * 256 + bj * 128 + wc * 32 + n * 16 + 4 * fq; (void)col; const f32x4 a = acc[ai][bj][m][n];
#define EPI_LOOP_END } }
struct EpiMix {
    static constexpr bool PERM = false;
    const bf16* z; bf16* A; bf16* O;
    __device__ __forceinline__ void operator()(const f32x4 (&acc)[2][2][4][2], const pg8::Unit& u, int wr, int wc, int fr, int fq) const {
        const int zc = u.lt ? ZC_MN : ZC_MR;
        EPI_LOOP_BEGIN
            const f32x4 zz = unpk4(*(const v2u*)(z + row * NZ + zc + col)); f32x4 o;
            o.x = sigmoidf_(zz.x) * a.x; o.y = sigmoidf_(zz.y) * a.y; o.z = sigmoidf_(zz.z) * a.z; o.w = sigmoidf_(zz.w) * a.w;
            if (u.lt == 0) *(v2u*)(A + row * D + col) = pk4(o);
            else { o = o + unpk4(*(const v2u*)(A + row * D + col)); *(v2u*)(O + row * D + col) = pk4(o); }
        EPI_LOOP_END
    }
};
struct EpiMix2 {
    static constexpr bool PERM = true;
    const bf16* z; bf16* O;
    __device__ __forceinline__ void operator()(const f32x4 (&acc_)[2][2][4][2], const pg8::Unit& u, int wr, int wc, int fr, int fq) const {
        f32x4 (&acc)[2][2][4][2] = const_cast<f32x4 (&)[2][2][4][2]>(acc_);
        const int row0 = u.pmo * 256 + wr * 64 + fr, col0 = u.pnl * 256 + wc * 32 + 8 * fq;
#pragma unroll
        for (int ai = 0; ai < 2; ++ai)
#pragma unroll
            for (int m = 0; m < 4; ++m) { if (m == 0 || m == 2) asm volatile("" ::: "memory"); const size_t row = (size_t)(row0 + ai * 128 + m * 16); const bf16* zr = z + row * NZ + col0;
#pragma unroll
                for (int bj = 0; bj < 2; ++bj) {
                    float b[8]; unpk8(*(const v4u*)(zr + ZC_MN + bj * 128), b);
                    if (u.lt == 0) { float a[8]; unpk8(*(const v4u*)(zr + ZC_MR + bj * 128), a);
#pragma unroll
                        for (int j = 0; j < 8; ++j) acc[ai][bj][m][j >> 2][j & 3] *= (1.0f + __expf(-fmaxf(b[j], -60.f))) * __builtin_amdgcn_rcpf(1.0f + __expf(-a[j])); }
                    else { float o[8];
#pragma unroll
                        for (int j = 0; j < 8; ++j) o[j] = acc[ai][bj][m][j >> 2][j & 3] * __builtin_amdgcn_rcpf(1.0f + __expf(-fmaxf(b[j], -60.f)));
                        v4u w; w.x = pk2(o[0], o[1]); w.y = pk2(o[2], o[3]); w.z = pk2(o[4], o[5]); w.w = pk2(o[6], o[7]);
                        *(v4u*)(O + row * D + col0 + bj * 128) = w; } } }
    }
};
struct ErawOrder {
    static constexpr bool DEP = false, KEEP_ACC = false;
    pg8::StaticOrder S; int c, G, nheavy;
    __device__ bool next(int i, pg8::Unit& u) const { const int nl = G - nheavy, l = c - nheavy; if (l < 0) return false; const int q = l + i * nl; if (q >= S.nwg) return false;
        pg8::StaticOrder T = S; T.c = q; T.G = S.nwg + 1; return T.next(0, u); }
};
struct DualOrder {
    static constexpr bool DEP = false, KEEP_ACC = true;
    pg8::StaticOrder S;
    __device__ bool next(int i, pg8::Unit& u) const { if (i >= 2) return false; if (!S.next(0, u)) return false; if (i == 1) { u.pm += 64; u.pn += 4; } u.lt = i; return true; }
};
struct EpiResBf16 {
    static constexpr bool PERM = true;
    const float* base; bf16* O;
    __device__ __forceinline__ void operator()(const f32x4 (&acc)[2][2][4][2], const pg8::Unit& u, int wr, int wc, int fr, int fq) const {
        const int row0 = u.pmo * 256 + wr * 64 + fr, col0 = u.pnl * 256 + wc * 32 + 8 * fq;
#pragma unroll
        for (int ai = 0; ai < 2; ++ai)
#pragma unroll
            for (int m = 0; m < 4; ++m) { if (m == 0 || m == 2) asm volatile("" ::: "memory"); const size_t ro = (size_t)(row0 + ai * 128 + m * 16) * D + col0;
#pragma unroll
                for (int bj = 0; bj < 2; ++bj) { const f32x4 v0 = acc[ai][bj][m][0] + *(const f32x4*)(base + ro + bj * 128), v1 = acc[ai][bj][m][1] + *(const f32x4*)(base + ro + bj * 128 + 4);
                    v4u w; w.x = pk2(v0[0], v0[1]); w.y = pk2(v0[2], v0[3]); w.z = pk2(v1[0], v1[1]); w.w = pk2(v1[2], v1[3]);
                    *(v4u*)(O + ro + bj * 128) = w; } }
    }
};
struct EpiResF32 {
    static constexpr bool PERM = false;
    const float* base; float* O;
    __device__ __forceinline__ void operator()(const f32x4 (&acc)[2][2][4][2], const pg8::Unit& u, int wr, int wc, int fr, int fq) const {
        EPI_LOOP_BEGIN
            *(f32x4*)(O + row * D + col) = *(const f32x4*)(base + row * D + col) + a;
        EPI_LOOP_END
    }
};
struct EpiMoe1 {
    static constexpr bool PERM = false;
    bf16* H; const LAS float* rsl; unsigned* dep;
    __device__ __forceinline__ void operator()(const f32x4 (&acc)[2][2][4][2], const pg8::Unit& u, int wr, int wc, int fr, int fq) const {
#pragma unroll
        for (int ai = 0; ai < 2; ++ai)
#pragma unroll
            for (int m = 0; m < 4; ++m) { const int rl = ai * 128 + wr * 64 + m * 16 + fr; const size_t row = (size_t)u.pmo * 256 + rl; const float rs = rsl[u.pm * 256 + rl];
#pragma unroll
                for (int n = 0; n < 2; ++n) { const f32x4 gt = acc[ai][0][m][n] * rs, up = acc[ai][1][m][n] * rs; f32x4 o;
                    o.x = gt.x * sigmoidf_(gt.x) * up.x; o.y = gt.y * sigmoidf_(gt.y) * up.y; o.z = gt.z * sigmoidf_(gt.z) * up.z; o.w = gt.w * sigmoidf_(gt.w) * up.w;
                    { bf16* hp = H + row * 512 + u.pnl * 128 + wc * 32 + n * 16 + 4 * fq; const v2u hv = pk4(o); asm volatile("global_store_dwordx2 %0, %1, off sc1" :: "v"(hp), "v"(hv) : "memory"); } } }
        asm volatile("s_waitcnt vmcnt(0)" ::: "memory"); __builtin_amdgcn_s_barrier(); asm volatile("" ::: "memory");
        if (threadIdx.x == 0) __hip_atomic_fetch_add(dep + 16 * u.pmo, 1u, __ATOMIC_RELAXED, __HIP_MEMORY_SCOPE_AGENT);
    }
};
struct EpiPle {
    static constexpr bool PERM = false;
    const bf16* x2; const bf16* Eraw; const float* rse; const float* gpn; bf16* O;
    __device__ __forceinline__ void operator()(const f32x4 (&acc)[2][2][4][2], const pg8::Unit& u, int wr, int wc, int fr, int fq) const {
        EPI_LOOP_BEGIN
            const f32x4 e = unpk4(*(const v2u*)(Eraw + row * D + col)); const f32x4 g = *(const f32x4*)(gpn + col); const float rs = rse[row]; f32x4 o = unpk4(*(const v2u*)(x2 + row * D + col));
            o.x += sigmoidf_(a.x) * e.x * rs * g.x; o.y += sigmoidf_(a.y) * e.y * rs * g.y; o.z += sigmoidf_(a.z) * e.z * rs * g.z; o.w += sigmoidf_(a.w) * e.w * rs * g.w;
            *(v2u*)(O + row * D + col) = pk4(o);
        EPI_LOOP_END
    }
};

struct EpiPleNorm {
    static constexpr bool PERM = false;
    const bf16* x2; const bf16* Eraw; const float* rse; const float* gpn; const float* rs3; const float* gfin; float* out; float* xbuf; unsigned* cnt; LAS float* ldsx;
    __device__ __forceinline__ void operator()(const f32x4 (&acc_)[2][2][4][2], const pg8::Unit& u_, int wr, int wc, int fr, int fq) const {
        f32x4 (&acc)[2][2][4][2] = const_cast<f32x4 (&)[2][2][4][2]>(acc_);
        pg8::Unit u = u_; asm volatile("" : "+s"(u.pmo), "+s"(u.pnl)); asm volatile("" : "+v"(fr), "+v"(fq)); asm volatile("" : "+s"(wr), "+s"(wc));
        int tid = threadIdx.x; asm volatile("" : "+v"(tid)); const int lane = tid & 63, wid = __builtin_amdgcn_readfirstlane(tid >> 6);
        LAS float* Pl = ldsx; LAS float* Sl = ldsx + 1024; LAS unsigned* flag = (LAS unsigned*)(ldsx + 1280);
#pragma unroll
        for (int ai = 0; ai < 2; ++ai)
#pragma unroll
            for (int m = 0; m < 4; ++m) { if (m == 0 || m == 2) asm volatile("" ::: "memory"); const int rl = ai * 128 + wr * 64 + m * 16 + fr; const size_t row = (size_t)u.pmo * 256 + rl;
                float ss = 0.f; const float r3 = rs3[row], re = rse[row];
#pragma unroll
                for (int bj = 0; bj < 2; ++bj)
#pragma unroll
                    for (int n = 0; n < 2; ++n) { const int col = u.pnl * 256 + bj * 128 + wc * 32 + n * 16 + 4 * fq; const f32x4 a = acc[ai][bj][m][n];
                        const f32x4 e = unpk4(*(const v2u*)(Eraw + row * D + col)) * re * *(const f32x4*)(gpn + col); f32x4 o = unpk4(*(const v2u*)(x2 + row * D + col));
                        o.x += sigmoidf_(a.x * r3) * e.x; o.y += sigmoidf_(a.y * r3) * e.y; o.z += sigmoidf_(a.z * r3) * e.z; o.w += sigmoidf_(a.w * r3) * e.w;
                        acc[ai][bj][m][n] = o; ss += (o.x * o.x + o.y * o.y) + (o.z * o.z + o.w * o.w); }
                ss += __shfl_xor(ss, 16); ss += __shfl_xor(ss, 32);
                if (fq == 0) Pl[rl * 4 + wc] = ss; }
        asm volatile("s_waitcnt lgkmcnt(0)" ::: "memory"); __builtin_amdgcn_s_barrier(); asm volatile("" ::: "memory");
        if (tid < 256) { const float tot = (Pl[tid * 4 + 0] + Pl[tid * 4 + 1]) + (Pl[tid * 4 + 2] + Pl[tid * 4 + 3]);
            __hip_atomic_store(xbuf + ((size_t)u.pmo * 256 + tid) * 4 + u.pnl, tot, __ATOMIC_RELAXED, __HIP_MEMORY_SCOPE_AGENT);
            asm volatile("s_waitcnt vmcnt(0)" ::: "memory");
            if (lane == 0) __hip_atomic_fetch_add(cnt + 64 * u.pmo, 1u, __ATOMIC_RELAXED, __HIP_MEMORY_SCOPE_AGENT); }
        if (wid == 0) {
            unsigned spins = 0;
            while ((unsigned)__builtin_amdgcn_readfirstlane((int)__hip_atomic_load(cnt + 64 * u.pmo, __ATOMIC_RELAXED, __HIP_MEMORY_SCOPE_AGENT)) < 16u) { __builtin_amdgcn_s_sleep(2); if (++spins > (1u << 22)) break; }
            __builtin_amdgcn_fence(__ATOMIC_ACQUIRE, "agent");
            if (lane == 0) flag[0] = 1u; }
        asm volatile("s_waitcnt vmcnt(0) lgkmcnt(0)" ::: "memory"); __builtin_amdgcn_s_barrier(); asm volatile("" ::: "memory");
        if (tid < 256) { const float* sp = xbuf + ((size_t)u.pmo * 256 + tid) * 4; float tot = 0.f;
#pragma unroll
            for (int t = 0; t < 4; ++t) tot += __hip_atomic_load(sp + t, __ATOMIC_RELAXED, __HIP_MEMORY_SCOPE_AGENT);
            Sl[tid] = 1.0f / sqrtf(tot * (1.f / D) + NORM_EPS); }
        asm volatile("s_waitcnt vmcnt(0) lgkmcnt(0)" ::: "memory"); __builtin_amdgcn_s_barrier(); asm volatile("" ::: "memory");
#pragma unroll
        for (int ai = 0; ai < 2; ++ai)
#pragma unroll
            for (int m = 0; m < 4; ++m) { const int rl = ai * 128 + wr * 64 + m * 16 + fr; const size_t row = (size_t)u.pmo * 256 + rl; const float rs = Sl[rl];
#pragma unroll
                for (int bj = 0; bj < 2; ++bj)
#pragma unroll
                    for (int n = 0; n < 2; ++n) { const int col = u.pnl * 256 + bj * 128 + wc * 32 + n * 16 + 4 * fq; *(f32x4*)(out + row * D + col) = acc[ai][bj][m][n] * rs * *(const f32x4*)(gfin + col); } }
    }
};

__device__ __forceinline__ float gelu_tanh(float x) { const float u = 0.7978845608028654f * (x + 0.044715f * x * x * x); const float t = 1.0f - 2.0f * __builtin_amdgcn_rcpf(__expf(2.0f * u) + 1.0f); return 0.5f * x * (1.0f + t); }

__device__ __forceinline__ void compress_wg_task(Frame& F, int idx) {
    const int kv = idx & 1, tile8 = (idx >> 1) & 7, bg = idx >> 4, b = bg >> 1, g = bg & 1;
    const int fr = F.lane & 15, fq = F.lane >> 4;
    const bf16* z = (const bf16*)(F.ws + WS_Z);
    const bf16* w1T = (const bf16*)(F.ws + WS_SMALLW + (kv ? SW_CV1 : SW_CK1));
    const bf16* w2T = (const bf16*)(F.ws + WS_SMALLW + (kv ? SW_CV2 : SW_CK2));
    const float* pos = kv ? F.ap->in[16] : F.ap->in[15];
    const int j0 = 16 * tile8; int j = j0 + fr; const bool jvalid = j < 127; if (!jvalid) j = 126;
    const bf16* zb = z + ((size_t)b * SEQ + 16 * j) * NZ + (kv ? ZC_VC : ZC_KC) + g * 64;
    v4u zr[8]; f32x4 p0[8], p1[8]; bf16x8 aop[8][4];
#pragma unroll
    for (int i = 0; i < 8; ++i) { const int ks = 8 * F.wave + i, l = ks >> 1, d = 32 * (ks & 1) + 8 * fq;
        zr[i] = *(const v4u*)(zb + (size_t)l * NZ + d); p0[i] = *(const f32x4*)(pos + l * 64 + d); p1[i] = *(const f32x4*)(pos + l * 64 + d + 4);
#pragma unroll
        for (int mt = 0; mt < 4; ++mt) aop[i][mt] = *(const bf16x8*)(w1T + (size_t)(16 * mt + fr) * 2048 + 32 * ks + 8 * fq); }
    f32x4 acc[4];
#pragma unroll
    for (int mt = 0; mt < 4; ++mt) acc[mt] = (f32x4){0.f, 0.f, 0.f, 0.f};
#pragma unroll
    for (int i = 0; i < 8; ++i) {
        float f[8]; unpk8(zr[i], f);
        v4u bb; bb.x = pk2(f[0] + p0[i].x, f[1] + p0[i].y); bb.y = pk2(f[2] + p0[i].z, f[3] + p0[i].w); bb.z = pk2(f[4] + p1[i].x, f[5] + p1[i].y); bb.w = pk2(f[6] + p1[i].z, f[7] + p1[i].w);
        const bf16x8 bop = __builtin_bit_cast(bf16x8, bb);
#pragma unroll
        for (int mt = 0; mt < 4; ++mt) acc[mt] = MFMA16(aop[i][mt], bop, acc[mt]);
    }
    LAS float* red = (LAS float*)F.lds;
    __syncthreads();
#pragma unroll
    for (int mt = 0; mt < 4; ++mt) *(LAS f32x4*)(red + ((F.wave * 4 + mt) * 64 + F.lane) * 4) = acc[mt];
    LDS_WAIT(); __syncthreads();
    if (F.wave != 0) return;
#pragma unroll
    for (int mt = 0; mt < 4; ++mt) { f32x4 t = (f32x4){0.f, 0.f, 0.f, 0.f};
#pragma unroll
        for (int w = 0; w < 8; ++w) t = t + *(const LAS f32x4*)(red + ((w * 4 + mt) * 64 + F.lane) * 4);
        acc[mt] = t; }
    bf16x8 hb[2];
#pragma unroll
    for (int s2 = 0; s2 < 2; ++s2) { v4u w; const f32x4 a0 = acc[2 * s2], a1 = acc[2 * s2 + 1];
        w.x = pk2(gelu_tanh(a0.x), gelu_tanh(a0.y)); w.y = pk2(gelu_tanh(a0.z), gelu_tanh(a0.w)); w.z = pk2(gelu_tanh(a1.x), gelu_tanh(a1.y)); w.w = pk2(gelu_tanh(a1.z), gelu_tanh(a1.w));
        hb[s2] = __builtin_bit_cast(bf16x8, w); }
    bf16* kcmp = (bf16*)(F.ws + WS_KCMP); bf16* vcmpT = (bf16*)(F.ws + WS_KCMP + 512 * 1024);
#pragma unroll
    for (int ntl = 0; ntl < 4; ++ntl) {
        f32x4 o = (f32x4){0.f, 0.f, 0.f, 0.f};
#pragma unroll
        for (int s2 = 0; s2 < 2; ++s2) { const bf16* wp = w2T + (size_t)(16 * ntl + fr) * 64 + 32 * s2 + 4 * fq; const v2u lo = *(const v2u*)wp, hi = *(const v2u*)(wp + 16);
            v4u aw; aw.x = lo.x; aw.y = lo.y; aw.z = hi.x; aw.w = hi.y; o = MFMA16(__builtin_bit_cast(bf16x8, aw), hb[s2], o); }
        if (!jvalid) o = (f32x4){0.f, 0.f, 0.f, 0.f};
        const int jj = j0 + fr, n = 16 * ntl + 4 * fq;
        if (kv == 0) *(v2u*)(kcmp + ((size_t)bg * 128 + jj) * 64 + n) = pk4(o);
        else { const v2u w = pk4(o); bf16* vp = vcmpT + ((size_t)bg * 64 + n) * 128 + jj; vp[0] = (bf16)(w.x & 0xffff); vp[128] = (bf16)(w.x >> 16); vp[256] = (bf16)(w.y & 0xffff); vp[384] = (bf16)(w.y >> 16); }
    }
}
__device__ __forceinline__ void zgate_task(Frame& F, int tile) {
    const int fr = F.lane & 15, fq = F.lane >> 4, m0 = tile * 16;
    const bf16* XN = (const bf16*)(F.ws + WS_XN); const bf16* gw = (const bf16*)(F.ws + WS_SMALLW + SW_GATEW);
    f32x4 acc[2] = {(f32x4){0.f, 0.f, 0.f, 0.f}, (f32x4){0.f, 0.f, 0.f, 0.f}};
#pragma unroll 16
    for (int ks = 0; ks < 32; ++ks) {
        const bf16x8 bop = *(const bf16x8*)(XN + (size_t)(m0 + fr) * D + 32 * ks + 8 * fq);
#pragma unroll
        for (int ct = 0; ct < 2; ++ct) { const bf16x8 aop = *(const bf16x8*)(gw + (size_t)(16 * ct + fr) * D + 32 * ks + 8 * fq); acc[ct] = MFMA16(aop, bop, acc[ct]); }
    }
    float* zg = (float*)(F.ws + WS_ZGATE);
#pragma unroll
    for (int ct = 0; ct < 2; ++ct) *(f32x4*)(zg + (size_t)(m0 + fr) * 32 + 16 * ct + 4 * fq) = acc[ct];
}
__device__ __forceinline__ void vt_task(Frame& F, int idx) {
    const int which = idx & 1, blk = (idx >> 1) & 31, bg = idx >> 6, b = bg >> 1, g = bg & 1;
    const bf16* z = (const bf16*)(F.ws + WS_Z);
    bf16* vT = (bf16*)(F.ws + (which ? WS_VWT : WS_VST));
    const int t = 64 * blk + F.lane;
    const bf16* src = z + ((size_t)b * SEQ + t) * NZ + (which ? ZC_VW : ZC_VS) + g * 64;
#pragma unroll
    for (int dc = 0; dc < 8; ++dc) { const v4u w = *(const v4u*)(src + 8 * dc); bf16* dst = vT + ((size_t)bg * 64 + 8 * dc) * SEQ + t;
        dst[0 * SEQ] = (bf16)(w.x & 0xffff); dst[1 * SEQ] = (bf16)(w.x >> 16); dst[2 * SEQ] = (bf16)(w.y & 0xffff); dst[3 * SEQ] = (bf16)(w.y >> 16);
        dst[4 * SEQ] = (bf16)(w.z & 0xffff); dst[5 * SEQ] = (bf16)(w.z >> 16); dst[6 * SEQ] = (bf16)(w.w & 0xffff); dst[7 * SEQ] = (bf16)(w.w >> 16); }
}
__device__ __forceinline__ void alora_task4(Frame& F, int mb) {
    const bf16* z = (const bf16*)(F.ws + WS_Z); bf16* AL = (bf16*)(F.ws + WS_PBF);
    const int l = F.lane;
    const f32x4 mu = *(const f32x4*)(F.ap->in[4] + ZC_W + 4 * l);
    v2u cw[4], pw[4];
#pragma unroll
    for (int u = 0; u < 4; ++u) { const int m = mb + u * F.NGW; const int t = m & (SEQ - 1); cw[u] = *(const v2u*)(z + (size_t)m * NZ + ZC_W + 4 * l); pw[u] = *(const v2u*)(z + (size_t)(t > 0 ? m - 1 : m) * NZ + ZC_W + 4 * l); }
#pragma unroll
    for (int u = 0; u < 4; ++u) { const int m = mb + u * F.NGW; const int t = m & (SEQ - 1);
        const f32x4 cur = unpk4(cw[u]); const f32x4 prev = unpk4(pw[u]) * (t > 0 ? 1.0f : 0.0f);
        f32x4 s = cur + (prev - cur) * mu;
        if (l < 16) { s.x = tanhf(s.x); s.y = tanhf(s.y); s.z = tanhf(s.z); s.w = tanhf(s.w); }
        else if (l >= 32) { s.x = sigmoidf_(s.x); s.y = sigmoidf_(s.y); s.z = sigmoidf_(s.z); s.w = sigmoidf_(s.w); }
        *(v2u*)(AL + (size_t)m * 256 + 4 * l) = pk4(s); }
}
__device__ __forceinline__ void p2_prep(Frame& F) {
    constexpr int T1 = 1024, T2 = T1 + 1024;
    for (int it = F.vcu; it < 256; it += F.G) compress_wg_task(F, it);
    for (int task = F.gw; task < T2; task += F.NGW) {
        if (task < T1) zgate_task(F, task);
        else vt_task(F, task - T1);
    }
    for (int base = F.gw; base < M; base += 4 * F.NGW) alora_task4(F, base);
}

__device__ __forceinline__ void ld16(const bf16* p, float (&f)[16]) { float a[8], b[8]; unpk8(*(const v4u*)p, a); unpk8(*(const v4u*)(p + 8), b);
#pragma unroll
    for (int i = 0; i < 8; ++i) { f[i] = a[i]; f[8 + i] = b[i]; } }
__device__ __forceinline__ void ld16f(const float* p, float (&f)[16]) {
#pragma unroll
    for (int q = 0; q < 4; ++q) { const f32x4 v = *(const f32x4*)(p + 4 * q); f[4 * q] = v.x; f[4 * q + 1] = v.y; f[4 * q + 2] = v.z; f[4 * q + 3] = v.w; } }
__device__ __forceinline__ void st16(bf16* p, const float (&f)[16]) { v4u a, b; a.x = pk2(f[0], f[1]); a.y = pk2(f[2], f[3]); a.z = pk2(f[4], f[5]); a.w = pk2(f[6], f[7]); b.x = pk2(f[8], f[9]); b.y = pk2(f[10], f[11]); b.z = pk2(f[12], f[13]); b.w = pk2(f[14], f[15]);
    *(v4u*)p = a; *(v4u*)(p + 8) = b; }
struct PrepW { bf16x8 w[2], a[2], g[4]; };
constexpr int PW_OFF = 32768, PW_P64 = 144, PW_P128 = 272, PW_A_OFF = PW_OFF + 64 * PW_P64, PW_G_OFF = PW_A_OFF + 64 * PW_P64;
__device__ __forceinline__ void prep_stage_w(Frame& F, int h) {
    const bf16* w2T = (const bf16*)(F.ws + WS_SMALLW + SW_W2T) + (size_t)h * 64 * 64; const bf16* a2T = (const bf16*)(F.ws + WS_SMALLW + SW_A2T) + (size_t)h * 64 * 64; const bf16* g2T = (const bf16*)(F.ws + WS_SMALLW + SW_G2T) + (size_t)h * 64 * 128;
    { const int R = F.tid >> 3, c = F.tid & 7, slot = ((R >> 2) & 3) * 16 + (R >> 4) * 4 + (R & 3);
      *(LAS v4u*)(F.lds + PW_OFF + slot * PW_P64 + c * 16) = *(const v4u*)(w2T + R * 64 + c * 8); *(LAS v4u*)(F.lds + PW_A_OFF + slot * PW_P64 + c * 16) = *(const v4u*)(a2T + R * 64 + c * 8); }
#pragma unroll
    for (int i = 0; i < 2; ++i) { const int id = F.tid + 512 * i, R = id >> 4, c = id & 15, slot = ((R >> 2) & 3) * 16 + (R >> 4) * 4 + (R & 3);
      *(LAS v4u*)(F.lds + PW_G_OFF + slot * PW_P128 + c * 16) = *(const v4u*)(g2T + R * 128 + c * 8); }
}
__device__ __forceinline__ void prep_ldw(PrepW& W, const LAS unsigned char* lds, int n, int fr, int fq) {
#pragma unroll
    for (int ks = 0; ks < 2; ++ks) { W.w[ks] = *(const LAS bf16x8*)(lds + PW_OFF + (n * 16 + fr) * PW_P64 + 64 * ks + 16 * fq); W.a[ks] = *(const LAS bf16x8*)(lds + PW_A_OFF + (n * 16 + fr) * PW_P64 + 64 * ks + 16 * fq); }
#pragma unroll
    for (int ks = 0; ks < 4; ++ks) W.g[ks] = *(const LAS bf16x8*)(lds + PW_G_OFF + (n * 16 + fr) * PW_P128 + 64 * ks + 16 * fq);
}
__device__ __forceinline__ void ldpar(const LAS float* p, float (&f)[16]) {
#pragma unroll
    for (int q = 0; q < 4; ++q) { const f32x4 v = *(const LAS f32x4*)(p + 4 * q); f[4 * q] = v.x; f[4 * q + 1] = v.y; f[4 * q + 2] = v.z; f[4 * q + 3] = v.w; } }
__device__ __forceinline__ void rwkv_prep_task(Frame& F, int task, const LAS float* par) {
    const int h = task & 7, m0 = (task >> 3) * 16, fr = F.lane & 15, fq = F.lane >> 4, m = m0 + fr, t = m & (SEQ - 1);
    const bf16* z = (const bf16*)(F.ws + WS_Z); const bf16* AL = (const bf16*)(F.ws + WS_PBF);
    bf16* vbuf = (bf16*)F.out; bf16* gbuf = (bf16*)(F.ws + WS_G);
    const int cl = h * 64 + 16 * fq;
    bf16x8 bw[2], ba[2], bgf[4];
    const bf16* alr = AL + (size_t)m * 256 + 8 * fq;
#pragma unroll
    for (int ks = 0; ks < 2; ++ks) { bw[ks] = *(const bf16x8*)(alr + 32 * ks); ba[ks] = *(const bf16x8*)(alr + 64 + 32 * ks); }
#pragma unroll
    for (int ks = 0; ks < 4; ++ks) bgf[ks] = *(const bf16x8*)(alr + 128 + 32 * ks);
    const bf16* zc = z + (size_t)m * NZ + cl; const bf16* zp = (t > 0) ? zc - NZ : zc;
    v4u zraw[6][2];
#pragma unroll
    for (int q = 0; q < 3; ++q) { zraw[q][0] = *(const v4u*)(zc + 512 * q); zraw[q][1] = *(const v4u*)(zc + 512 * q + 8); zraw[3 + q][0] = *(const v4u*)(zp + 512 * q); zraw[3 + q][1] = *(const v4u*)(zp + 512 * q + 8); }
    __builtin_amdgcn_sched_barrier(0);
    float ev[16], av[16], gv[16];
#define PREP_MM(W, n) do { f32x4 accw = (f32x4){0.f, 0.f, 0.f, 0.f}, acca = accw, accg = accw; \
        _Pragma("unroll") for (int ks = 0; ks < 2; ++ks) { accw = MFMA16(W.w[ks], bw[ks], accw); acca = MFMA16(W.a[ks], ba[ks], acca); } \
        _Pragma("unroll") for (int ks = 0; ks < 4; ++ks) accg = MFMA16(W.g[ks], bgf[ks], accg); \
        _Pragma("unroll") for (int r = 0; r < 4; ++r) { ev[4 * (n) + r] = accw[r]; av[4 * (n) + r] = acca[r]; gv[4 * (n) + r] = accg[r]; } } while (0)
    { PrepW Wa, Wb;
      prep_ldw(Wa, F.lds, 0, fr, fq); prep_ldw(Wb, F.lds, 1, fr, fq); PREP_MM(Wa, 0); PREP_MM(Wb, 1);
      prep_ldw(Wa, F.lds, 2, fr, fq); prep_ldw(Wb, F.lds, 3, fr, fq); PREP_MM(Wa, 2); PREP_MM(Wb, 3); }
    float zr[16], zk[16], zv[16], tmp[16];
    const float pm = (t > 0) ? 1.0f : 0.0f;
    {   float c[16], p[16];
#define PREP_UNP(q, dst) do { float a_[8], b_[8]; unpk8(zraw[q][0], a_); unpk8(zraw[q][1], b_); _Pragma("unroll") for (int i = 0; i < 8; ++i) { dst[i] = a_[i]; dst[8 + i] = b_[i]; } } while (0)
        PREP_UNP(0, c); PREP_UNP(3, p); ldpar(par + 0 * 64 + 16 * fq, tmp);
#pragma unroll
        for (int e = 0; e < 16; ++e) zr[e] = c[e] + (p[e] * pm - c[e]) * tmp[e];
        PREP_UNP(1, c); PREP_UNP(4, p); ldpar(par + 1 * 64 + 16 * fq, tmp);
#pragma unroll
        for (int e = 0; e < 16; ++e) zk[e] = c[e] + (p[e] * pm - c[e]) * tmp[e];
        PREP_UNP(2, c); PREP_UNP(5, p); ldpar(par + 2 * 64 + 16 * fq, tmp);
#pragma unroll
        for (int e = 0; e < 16; ++e) zv[e] = c[e] + (p[e] * pm - c[e]) * tmp[e];
    }
    float kkr[16]; float ss = 0.f;
    ldpar(par + 3 * 64 + 16 * fq, tmp);
#pragma unroll
    for (int e = 0; e < 16; ++e) { const float x = -(tmp[e] + ev[e]); const float sp = fmaxf(x, 0.f) + __logf(1.0f + __expf(-fabsf(x))); ev[e] = __expf(-sp - 0.5f); }
    ldpar(par + 4 * 64 + 16 * fq, tmp);
#pragma unroll
    for (int e = 0; e < 16; ++e) av[e] = sigmoidf_(tmp[e] + av[e]);
    ldpar(par + 5 * 64 + 16 * fq, tmp);
#pragma unroll
    for (int e = 0; e < 16; ++e) { kkr[e] = zk[e] * tmp[e]; ss += kkr[e] * kkr[e]; }
    ss += __shfl_xor(ss, 16); ss += __shfl_xor(ss, 32);
    const float inv = 1.0f / fmaxf(sqrtf(ss), 1e-12f);
    ldpar(par + 6 * 64 + 16 * fq, tmp);
    float kp[16], kka[16];
#pragma unroll
    for (int e = 0; e < 16; ++e) { kkr[e] *= inv; kka[e] = kkr[e] * av[e]; kp[e] = zk[e] * (1.0f + (av[e] - 1.0f) * tmp[e]); }
    st16(vbuf + (size_t)m * 512 + cl, zv); st16(gbuf + (size_t)m * 512 + cl, gv);
    { ldpar(par + 7 * 64 + 16 * fq, tmp);
      float bsum = 0.f;
#pragma unroll
      for (int e = 0; e < 16; ++e) bsum += zr[e] * kp[e] * tmp[e];
      bsum += __shfl_xor(bsum, 16); bsum += __shfl_xor(bsum, 32);
      if (fq == 0) ((float*)(F.ws + WS_BONUS))[(size_t)m * 8 + h] = bsum; }
    asm volatile("" ::: "memory");
    unsigned char* rec = F.ws + WS_S + (size_t)task * CH_REC;
    bf16x8 Pb[2], Qb[2], Kb[2], Rb[2];
#pragma unroll
    for (int ks = 0; ks < 2; ++ks) {
        float Pm[8], Qm[8], Km[8], Rm[8], acv[8];
#pragma unroll
        for (int e8 = 0; e8 < 8; ++e8) { const int e = 8 * ks + e8;
            float cs = ev[e]; cs += dppf<0x111>(cs); cs += dppf<0x112>(cs); cs += dppf<0x114>(cs); cs += dppf<0x118>(cs);
            const float A = __expf(-cs), Ap = __expf(ev[e] - cs), iA = __expf(cs);
            Pm[e8] = kkr[e] * Ap; Qm[e8] = -kka[e] * iA; Km[e8] = kp[e] * iA; Rm[e8] = zr[e] * A; acv[e8] = A; }
        v4u w;
        w.x = pk2(Pm[0], Pm[1]); w.y = pk2(Pm[2], Pm[3]); w.z = pk2(Pm[4], Pm[5]); w.w = pk2(Pm[6], Pm[7]); Pb[ks] = __builtin_bit_cast(bf16x8, w);
        w.x = pk2(Qm[0], Qm[1]); w.y = pk2(Qm[2], Qm[3]); w.z = pk2(Qm[4], Qm[5]); w.w = pk2(Qm[6], Qm[7]); Qb[ks] = __builtin_bit_cast(bf16x8, w);
        w.x = pk2(Km[0], Km[1]); w.y = pk2(Km[2], Km[3]); w.z = pk2(Km[4], Km[5]); w.w = pk2(Km[6], Km[7]); Kb[ks] = __builtin_bit_cast(bf16x8, w);
        w.x = pk2(Rm[0], Rm[1]); w.y = pk2(Rm[2], Rm[3]); w.z = pk2(Rm[4], Rm[5]); w.w = pk2(Rm[6], Rm[7]); Rb[ks] = __builtin_bit_cast(bf16x8, w);
        if (fr == 15) { *(f32x4*)(rec + CH_AC + (16 * fq + 8 * ks) * 4) = (f32x4){acv[0], acv[1], acv[2], acv[3]}; *(f32x4*)(rec + CH_AC + (16 * fq + 8 * ks + 4) * 4) = (f32x4){acv[4], acv[5], acv[6], acv[7]}; }
    }
    *(v4u*)(rec + CH_P + fr * CH_PP + 32 * fq) = __builtin_bit_cast(v4u, Pb[0]); *(v4u*)(rec + CH_P + fr * CH_PP + 32 * fq + 16) = __builtin_bit_cast(v4u, Pb[1]);
    *(v4u*)(rec + CH_R + fr * CH_PP + 32 * fq) = __builtin_bit_cast(v4u, Rb[0]); *(v4u*)(rec + CH_R + fr * CH_PP + 32 * fq + 16) = __builtin_bit_cast(v4u, Rb[1]);
    *(v4u*)(rec + CH_Q + (fq * 16 + fr) * 32) = __builtin_bit_cast(v4u, Qb[0]); *(v4u*)(rec + CH_Q + (fq * 16 + fr) * 32 + 16) = __builtin_bit_cast(v4u, Qb[1]);
    *(v4u*)(rec + CH_K + (fq * 16 + fr) * 32) = __builtin_bit_cast(v4u, Kb[0]); *(v4u*)(rec + CH_K + (fq * 16 + fr) * 32 + 16) = __builtin_bit_cast(v4u, Kb[1]);
    f32x4 gqp = (f32x4){0.f, 0.f, 0.f, 0.f}, gkp = gqp, gqr = gqp, gkr = gqp;
#pragma unroll
    for (int ks = 0; ks < 2; ++ks) { gqp = MFMA16(Qb[ks], Pb[ks], gqp); gkp = MFMA16(Kb[ks], Pb[ks], gkp); gqr = MFMA16(Qb[ks], Rb[ks], gqr); gkr = MFMA16(Kb[ks], Rb[ks], gkr); }
#pragma unroll
    for (int rg = 0; rg < 4; ++rg) { const int s = 4 * fq + rg; if (!(s < fr)) { gqp[rg] = 0.f; gkp[rg] = 0.f; } if (!(s <= fr)) { gqr[rg] = 0.f; gkr[rg] = 0.f; } }
    *(v2u*)(rec + CH_G + 0 * 512 + (fr * 16 + 4 * fq) * 2) = pk4(gkp);
    *(v2u*)(rec + CH_G + 2 * 512 + (fr * 16 + 4 * fq) * 2) = pk4(gqr);
    *(v2u*)(rec + CH_G + 3 * 512 + (fr * 16 + 4 * fq) * 2) = pk4(gkr);
    LAS float* Nl = (LAS float*)(F.lds + F.wave * 4096);
#pragma unroll
    for (int rg = 0; rg < 4; ++rg) Nl[(4 * fq + rg) * 20 + fr] = gqp[rg];
    LDS_WAIT(); __builtin_amdgcn_wave_barrier(); asm volatile("" ::: "memory");
    float Tc[16];
#pragma unroll
    for (int s = 15; s >= 0; --s) {
        float acc = 0.f;
#pragma unroll
        for (int q4 = 0; q4 < 4; ++q4) if (4 * q4 + 3 > s) { const f32x4 nv = *(const LAS f32x4*)(Nl + s * 20 + 4 * q4);
#pragma unroll
            for (int u = 0; u < 4; ++u) if (4 * q4 + u > s) acc += nv[u] * Tc[4 * q4 + u]; }
        Tc[s] = (s == fr) ? 1.0f : acc; }
    { f32x4 tv;
#pragma unroll
      for (int u = 0; u < 4; ++u) tv[u] = fq == 0 ? Tc[u] : (fq == 1 ? Tc[4 + u] : (fq == 2 ? Tc[8 + u] : Tc[12 + u]));
      *(v2u*)(rec + CH_G + 1 * 512 + (fr * 16 + 4 * fq) * 2) = pk4(tv); }
    LDS_WAIT(); __builtin_amdgcn_wave_barrier(); asm volatile("" ::: "memory");
#undef PREP_MM
#undef PREP_UNP
}
__device__ __forceinline__ void prep_fill_par(Frame& F, LAS float* par, int h) {
    const int l = F.lane; const float* mu = F.ap->in[4];
    par[0 * 64 + l] = mu[ZC_R + h * 64 + l]; par[1 * 64 + l] = mu[ZC_K + h * 64 + l]; par[2 * 64 + l] = mu[ZC_V + h * 64 + l];
    par[3 * 64 + l] = F.ap->in[5][h * 64 + l]; par[4 * 64 + l] = F.ap->in[7][h * 64 + l]; par[5 * 64 + l] = F.ap->in[10][h * 64 + l]; par[6 * 64 + l] = F.ap->in[11][h * 64 + l]; par[7 * 64 + l] = F.ap->in[12][h * 64 + l];
    LDS_WAIT(); __builtin_amdgcn_wave_barrier(); asm volatile("" ::: "memory");
}

__device__ __forceinline__ float nsa_slope(int g, int r) { return __uint_as_float((unsigned)(127 - (g * 4 + r + 1)) << 23); }

constexpr int CMP_KC_OFF = 32768, CMP_KP = 144, CMP_VC_OFF = CMP_KC_OFF + 128 * CMP_KP, CMP_VP = 264;
__device__ __forceinline__ void nsa_cmp_stage(Frame& F, int bg) {
    const bf16* kcmp = (const bf16*)(F.ws + WS_KCMP) + (size_t)bg * 128 * 64; const bf16* vcmpT = (const bf16*)(F.ws + WS_KCMP + 512 * 1024) + (size_t)bg * 64 * 128;
    v4u a[2], v[2];
#pragma unroll
    for (int i = 0; i < 2; ++i) { const int id = F.tid + 512 * i; a[i] = *(const v4u*)(kcmp + (size_t)(id >> 3) * 64 + (id & 7) * 8); v[i] = *(const v4u*)(vcmpT + (size_t)(id >> 4) * 128 + (id & 15) * 8); }
#pragma unroll
    for (int i = 0; i < 2; ++i) { const int id = F.tid + 512 * i; *(LAS v4u*)(F.lds + CMP_KC_OFF + (id >> 3) * CMP_KP + (id & 7) * 16) = a[i]; *(LAS v4u*)(F.lds + CMP_VC_OFF + (id >> 4) * CMP_VP + (id & 15) * 16) = v[i]; }
}
template <int ABL>
__device__ __forceinline__ void nsa_cmp_task(Frame& F, int task) {
    const int tile = task & 127, bg = task >> 7, b = bg >> 1, g = bg & 1;
    const int fr = F.lane & 15, fq = F.lane >> 4, t = tile * 16 + fr, m = b * SEQ + t;
    const bf16* z = (const bf16*)(F.ws + WS_Z);
    const float* zg = (const float*)(F.ws + WS_ZGATE); const float* gb = F.ap->in[21];
    bf16* Y = (bf16*)(F.ws + WS_YB);
    bf16x8 qall[4][2]; float gl[4];
#pragma unroll
    for (int r = 0; r < 4; ++r) { const bf16* qp = z + (size_t)m * NZ + ZC_Q + (g * 4 + r) * 64 + 8 * fq; qall[r][0] = *(const bf16x8*)qp; qall[r][1] = *(const bf16x8*)(qp + 32);
        gl[r] = zg[(size_t)m * 32 + (g * 4 + r) * 3 + 0] + gb[(g * 4 + r) * 3 + 0]; }
    const LAS unsigned char* kc = F.lds + CMP_KC_OFF + fr * CMP_KP + 16 * fq; const LAS unsigned char* vc = F.lds + CMP_VC_OFF + fr * CMP_VP + 8 * fq;
    const int tv = t - 31 - 64 * fq; const float tb = (float)t - 15.5f - 64.0f * (float)fq;
    float impl[8], imp3[8];
#pragma unroll
    for (int kt = 0; kt < 8; ++kt) { impl[kt] = 0.f; imp3[kt] = 0.f; }
#pragma unroll
    for (int r = 0; r < 4; ++r) {
        const float slope = nsa_slope(g, r);
        const bf16x8 q0 = qall[r][0], q1 = qall[r][1];
        float s[8][4]; float mx = -1e30f;
#pragma unroll
        for (int kt = 0; kt < 8; ++kt) {
            f32x4 a = (f32x4){0.f, 0.f, 0.f, 0.f};
            a = MFMA16(*(const LAS bf16x8*)(kc + 16 * kt * CMP_KP), q0, a); a = MFMA16(*(const LAS bf16x8*)(kc + 16 * kt * CMP_KP + 64), q1, a);
#pragma unroll
            for (int rg = 0; rg < 4; ++rg) { const bool valid = ((256 * kt + 16 * rg) <= tv);
                const float sc = a[rg] * 0.125f - slope * (tb - (float)(256 * kt + 16 * rg)); s[kt][rg] = valid ? sc : -1e30f; mx = fmaxf(mx, s[kt][rg]); }
        }
        mx = fmaxf(mx, __shfl_xor(mx, 16)); mx = fmaxf(mx, __shfl_xor(mx, 32));
        float sum = 0.f;
#pragma unroll
        for (int kt = 0; kt < 8; ++kt)
#pragma unroll
            for (int rg = 0; rg < 4; ++rg) { const float p = (s[kt][rg] > -1e29f) ? __expf(s[kt][rg] - mx) : 0.f; s[kt][rg] = p; sum += p; }
        sum += __shfl_xor(sum, 16); sum += __shfl_xor(sum, 32);
        const float inv = sum > 0.f ? 1.0f / sum : 0.f;
#pragma unroll
        for (int kt = 0; kt < 8; ++kt) {
#pragma unroll
            for (int rg = 0; rg < 4; ++rg) s[kt][rg] *= inv;
            impl[kt] += s[kt][0] + s[kt][1] + s[kt][2] + 0.5f * s[kt][3]; imp3[kt] += s[kt][3]; }
        f32x4 o[4];
#pragma unroll
        for (int dt = 0; dt < 4; ++dt) o[dt] = (f32x4){0.f, 0.f, 0.f, 0.f};
#pragma unroll
        for (int s2 = 0; s2 < 4; ++s2) {
            v4u pw; pw.x = pk2(s[2 * s2][0], s[2 * s2][1]); pw.y = pk2(s[2 * s2][2], s[2 * s2][3]); pw.z = pk2(s[2 * s2 + 1][0], s[2 * s2 + 1][1]); pw.w = pk2(s[2 * s2 + 1][2], s[2 * s2 + 1][3]);
            const bf16x8 pb = __builtin_bit_cast(bf16x8, pw);
#pragma unroll
            for (int dt = 0; dt < 4; ++dt) { const LAS unsigned char* vp = vc + 16 * dt * CMP_VP + 64 * s2; const v2u lo = *(const LAS v2u*)vp, hi = *(const LAS v2u*)(vp + 32);
                v4u aw; aw.x = lo.x; aw.y = lo.y; aw.z = hi.x; aw.w = hi.y; o[dt] = MFMA16(__builtin_bit_cast(bf16x8, aw), pb, o[dt]); }
        }
        const int hh = g * 4 + r; const float gate = sigmoidf_(gl[r]);
#pragma unroll
        for (int dt = 0; dt < 4; ++dt) *(v2u*)(Y + (size_t)m * 512 + hh * 64 + 16 * dt + 4 * fq) = pk4(o[dt] * gate);
        __builtin_amdgcn_sched_barrier(0);
    }
    if (ABL == 1) return;
    LAS float* sc = (LAS float*)(F.lds + F.wave * 4096);
    float y3prev = 0.f;
#pragma unroll
    for (int kt = 0; kt < 8; ++kt) {
        const float y3 = __shfl(imp3[kt], (F.lane + 48) & 63);
        const float prev = (fq > 0) ? y3 : y3prev; y3prev = y3;
        sc[fr * 33 + 4 * kt + fq] = impl[kt] + 0.5f * prev;
    }
    LDS_WAIT(); __builtin_amdgcn_wave_barrier(); asm volatile("" ::: "memory");
    const int blk_t = t >> 6, chi = blk_t - 2;
    unsigned mask = 1u | (1u << blk_t) | (blk_t > 0 ? (1u << (blk_t - 1)) : 0u);
#pragma unroll
    for (int kt = 0; kt < 8; ++kt) {
        const int k = 4 * kt + fq;
        if (k >= 1 && k <= chi) { const float me = sc[fr * 33 + k]; int rank = 0;
            for (int k2 = 1; k2 <= chi; ++k2) { const float o = sc[fr * 33 + k2]; rank += (o > me || (o == me && k2 < k)) ? 1 : 0; }
            if (rank < 5) mask |= (1u << k); }
    }
    mask |= (unsigned)__shfl_xor((int)mask, 16); mask |= (unsigned)__shfl_xor((int)mask, 32);
    if (fq == 0) ((unsigned*)(F.ws + WS_SELMASK))[(size_t)bg * SEQ + t] = mask;
    LDS_WAIT(); __builtin_amdgcn_wave_barrier(); asm volatile("" ::: "memory");
}
__device__ __forceinline__ void p3_phase(Frame& F) {
    constexpr int T0 = 2048, T1 = T0 + 8192;
#ifdef DUP_P3A
    for (int task = F.gw; task < T0; task += F.NGW) { __syncthreads(); nsa_cmp_stage(F, task >> 7); LDS_WAIT(); __syncthreads(); nsa_cmp_task<DUP_P3A>(F, task); }
    asm volatile("" ::: "memory");
#endif
    for (int task = F.gw; task < T0; task += F.NGW) { __syncthreads(); nsa_cmp_stage(F, task >> 7); LDS_WAIT(); __syncthreads(); nsa_cmp_task<0>(F, task); }
    asm volatile("" ::: "memory");
    const int h = F.vcu & 7;
    LAS float* par = (LAS float*)(F.lds + F.wave * 4096 + 2048);
    __syncthreads();
    prep_fill_par(F, par, h); prep_stage_w(F, h);
    LDS_WAIT(); __syncthreads();
#ifdef DUP_P3B
    for (int i = F.wave; i < 32; i += 8) rwkv_prep_task(F, (((F.vcu >> 3) + 32 * i) << 3) | h, par);
    asm volatile("" ::: "memory");
#endif
    for (int i = F.wave; i < 32; i += 8) rwkv_prep_task(F, (((F.vcu >> 3) + 32 * i) << 3) | h, par);
}

constexpr int NSA_KP = 144, NSA_VP = 136, NSA_BUF = 64 * NSA_KP + 64 * NSA_VP, NSA_CTL = 2 * NSA_BUF + 1024;
struct NsaState { f32x4 O[2][4]; float mrun[2], lrun[2]; };
template <int WHICH, bool MASKED>
__device__ __forceinline__ void nsa_block(NsaState& St, const LAS unsigned char* kb_, const LAS unsigned char* vb_, const bf16x8 (&qf)[2][2], int kb, unsigned mymask, int t, int fq, float slope0) {
    const int kpos0 = 64 * kb;
    bf16x8 kf[4][2];
#pragma unroll
    for (int kt = 0; kt < 4; ++kt) { kf[kt][0] = *(const LAS bf16x8*)(kb_ + 16 * kt * NSA_KP); kf[kt][1] = *(const LAS bf16x8*)(kb_ + 16 * kt * NSA_KP + 64); }
    const bool bsel = (mymask >> kb) & 1u; const int dbase = t - 4 * fq - kpos0;
    const float fdb = (float)dbase;
    bf16x8 P[2][2];
#pragma unroll
    for (int r = 0; r < 2; ++r) {
        const float slope = r ? 0.5f * slope0 : slope0;
        float s[4][4]; float bm = -1e30f;
        float base = -slope * fdb;
        const float s1 = slope, s2_ = 2.0f * slope, s3 = 3.0f * slope, s16 = 16.0f * slope;
#pragma unroll
        for (int kt = 0; kt < 4; ++kt) { f32x4 a = (f32x4){base, base + s1, base + s2_, base + s3}; base += s16;
            a = MFMA16(kf[kt][0], qf[r][0], a); a = MFMA16(kf[kt][1], qf[r][1], a);
#pragma unroll
            for (int rg = 0; rg < 4; ++rg) {
                if (MASKED) { const int dist = dbase - (16 * kt + rg); const bool valid = bsel && dist >= 0 && (WHICH == 0 || dist < 512); s[kt][rg] = valid ? a[rg] : -1e30f; }
                else s[kt][rg] = a[rg];
                bm = fmaxf(bm, s[kt][rg]); } }
        bm = fmaxf(bm, __shfl_xor(bm, 16)); bm = fmaxf(bm, __shfl_xor(bm, 32));
        const float mnew = fmaxf(St.mrun[r], bm); const float scale = __builtin_amdgcn_exp2f(St.mrun[r] - mnew); St.mrun[r] = mnew;
        float ps = 0.f;
#pragma unroll
        for (int kt = 0; kt < 4; ++kt)
#pragma unroll
            for (int rg = 0; rg < 4; ++rg) { float p = __builtin_amdgcn_exp2f(s[kt][rg] - mnew); if (MASKED) p = (s[kt][rg] > -1e29f) ? p : 0.f; s[kt][rg] = p; ps += p; }
        St.lrun[r] = St.lrun[r] * scale + ps;
#pragma unroll
        for (int dt = 0; dt < 4; ++dt) St.O[r][dt] = St.O[r][dt] * scale;
#pragma unroll
        for (int s2 = 0; s2 < 2; ++s2) { v4u pw; pw.x = pk2(s[2 * s2][0], s[2 * s2][1]); pw.y = pk2(s[2 * s2][2], s[2 * s2][3]); pw.z = pk2(s[2 * s2 + 1][0], s[2 * s2 + 1][1]); pw.w = pk2(s[2 * s2 + 1][2], s[2 * s2 + 1][3]);
            P[r][s2] = __builtin_bit_cast(bf16x8, pw); }
    }
#pragma unroll
    for (int dt = 0; dt < 4; ++dt)
#pragma unroll
        for (int s2 = 0; s2 < 2; ++s2) { const LAS unsigned char* vp = vb_ + 16 * dt * NSA_VP + 64 * s2; const v2u lo = *(const LAS v2u*)vp, hi = *(const LAS v2u*)(vp + 32);
            v4u aw; aw.x = lo.x; aw.y = lo.y; aw.z = hi.x; aw.w = hi.y; const bf16x8 vf = __builtin_bit_cast(bf16x8, aw);
#pragma unroll
            for (int r = 0; r < 2; ++r) St.O[r][dt] = MFMA16(vf, P[r][s2], St.O[r][dt]); }
}
template <int WHICH>
__device__ __forceinline__ void nsa_wg_task(Frame& F, int item) {
    const int hp = item & 1, bg = item >> 5, tg = (item >> 1) & 15, b = bg >> 1, g = bg & 1;
    const int fr = F.lane & 15, fq = F.lane >> 4, tile = tg * 8 + F.wave, t0 = tile * 16, t = t0 + fr, m = b * SEQ + t;
    const int h0 = g * 4 + 2 * hp;
    const bf16* z = (const bf16*)(F.ws + WS_Z);
    const bf16* Kb = z + (size_t)b * SEQ * NZ + (WHICH ? ZC_KW : ZC_KS) + g * 64;
    const bf16* VT = (const bf16*)(F.ws + (WHICH ? WS_VWT : WS_VST)) + (size_t)bg * 64 * SEQ;
    unsigned mymask, tile_or, full; const int kb_hi = (t0 + 15) >> 6;
    if (WHICH == 0) { mymask = ((const unsigned*)(F.ws + WS_SELMASK))[(size_t)bg * SEQ + t]; unsigned x = mymask, y = mymask;
        x |= (unsigned)__shfl_xor((int)x, 1); x |= (unsigned)__shfl_xor((int)x, 2); x |= (unsigned)__shfl_xor((int)x, 4); x |= (unsigned)__shfl_xor((int)x, 8);
        y &= (unsigned)__shfl_xor((int)y, 1); y &= (unsigned)__shfl_xor((int)y, 2); y &= (unsigned)__shfl_xor((int)y, 4); y &= (unsigned)__shfl_xor((int)y, 8);
        tile_or = (unsigned)__builtin_amdgcn_readfirstlane((int)x); full = (unsigned)__builtin_amdgcn_readfirstlane((int)y) & ((1u << kb_hi) - 1u); }
    else { mymask = 0xffffffffu; const int lo = (t0 - 511) > 0 ? ((t0 - 511) >> 6) : 0; tile_or = 0u; full = 0u;
        for (int k = lo; k <= kb_hi; ++k) { tile_or |= (1u << k); if (k < kb_hi && 64 * k >= t0 - 496) full |= (1u << k); } }
    tile_or &= (kb_hi >= 31) ? 0xffffffffu : ((2u << kb_hi) - 1u);
    LAS unsigned* ctl = (LAS unsigned*)(F.lds + NSA_CTL);
    __syncthreads();
    if (F.lane == 0) ctl[F.wave] = tile_or;
    LDS_WAIT(); __syncthreads();
    unsigned rem = 0u;
#pragma unroll
    for (int w = 0; w < 8; ++w) rem |= ctl[w];
    rem = (unsigned)__builtin_amdgcn_readfirstlane((int)rem);
    bf16x8 qf[2][2];
#pragma unroll
    for (int r = 0; r < 2; ++r)
#pragma unroll
        for (int ks = 0; ks < 2; ++ks) { const v4u raw = *(const v4u*)(z + (size_t)m * NZ + ZC_Q + (h0 + r) * 64 + 8 * fq + 32 * ks); float f[8]; unpk8(raw, f);
            constexpr float QS = 0.125f * 1.4426950408889634f; v4u w; w.x = pk2(f[0] * QS, f[1] * QS); w.y = pk2(f[2] * QS, f[3] * QS); w.z = pk2(f[4] * QS, f[5] * QS); w.w = pk2(f[6] * QS, f[7] * QS);
            qf[r][ks] = __builtin_bit_cast(bf16x8, w); }
    NsaState St;
#pragma unroll
    for (int r = 0; r < 2; ++r) { St.mrun[r] = -1e30f; St.lrun[r] = 0.f;
#pragma unroll
        for (int dt = 0; dt < 4; ++dt) St.O[r][dt] = (f32x4){0.f, 0.f, 0.f, 0.f}; }
    const float slope0 = 1.4426950408889634f * __uint_as_float((unsigned)(127 - (h0 + 1)) << 23);
    const int srow = F.tid >> 3, sc = F.tid & 7;
    const bf16* ksrc = Kb + (size_t)srow * NZ + sc * 8; const bf16* vsrc = VT + (size_t)srow * SEQ + sc * 8;
    const int kdst = srow * NSA_KP + sc * 16, vdst = 64 * NSA_KP + srow * NSA_VP + sc * 16;
    const LAS unsigned char* kfr = F.lds + fr * NSA_KP + 16 * fq; const LAS unsigned char* vfr = F.lds + 64 * NSA_KP + fr * NSA_VP + 8 * fq;
    int kb = __builtin_ctz(rem); rem &= rem - 1u;
    v4u kreg = *(const v4u*)(ksrc + (size_t)64 * kb * NZ), vreg = *(const v4u*)(vsrc + 64 * kb);
    *(LAS v4u*)(F.lds + kdst) = kreg; *(LAS v2u*)(F.lds + vdst) = (v2u){vreg.x, vreg.y}; *(LAS v2u*)(F.lds + vdst + 8) = (v2u){vreg.z, vreg.w};
    LDS_WAIT(); __syncthreads();
    int buf = 0;
    for (;;) {
        int kbn = -1;
        if (rem) { kbn = __builtin_ctz(rem); rem &= rem - 1u; kreg = *(const v4u*)(ksrc + (size_t)64 * kbn * NZ); vreg = *(const v4u*)(vsrc + 64 * kbn); }
        __builtin_amdgcn_sched_barrier(0);
        if ((tile_or >> kb) & 1u) {
            if ((full >> kb) & 1u) nsa_block<WHICH, false>(St, kfr + buf * NSA_BUF, vfr + buf * NSA_BUF, qf, kb, mymask, t, fq, slope0);
            else nsa_block<WHICH, true>(St, kfr + buf * NSA_BUF, vfr + buf * NSA_BUF, qf, kb, mymask, t, fq, slope0);
        }
        __builtin_amdgcn_sched_barrier(0);
        if (kbn < 0) break;
        buf ^= 1;
        *(LAS v4u*)(F.lds + buf * NSA_BUF + kdst) = kreg; *(LAS v2u*)(F.lds + buf * NSA_BUF + vdst) = (v2u){vreg.x, vreg.y}; *(LAS v2u*)(F.lds + buf * NSA_BUF + vdst + 8) = (v2u){vreg.z, vreg.w};
        LDS_WAIT(); __syncthreads();
        kb = kbn;
    }
    const float* zg = (const float*)(F.ws + WS_ZGATE); const float* gb = F.ap->in[21];
    bf16* Y = (bf16*)(F.ws + WS_YB + (size_t)(1 + WHICH) * 16 * MiB);
#pragma unroll
    for (int r = 0; r < 2; ++r) { float l = St.lrun[r]; l += __shfl_xor(l, 16); l += __shfl_xor(l, 32);
        const int hh = h0 + r; const float gate = sigmoidf_(zg[(size_t)m * 32 + hh * 3 + 1 + WHICH] + gb[hh * 3 + 1 + WHICH]); const float f = gate / l;
#pragma unroll
        for (int dt = 0; dt < 4; ++dt) *(v2u*)(Y + (size_t)m * 512 + hh * 64 + 16 * dt + 4 * fq) = pk4(St.O[r][dt] * f); }
}
__device__ __forceinline__ void p4_phase(Frame& F) {
    for (int it = F.vcu; it < 512; it += F.G) { nsa_wg_task<1>(F, it); nsa_wg_task<0>(F, 511 - it); }
}

typedef short v4i16_t __attribute__((ext_vector_type(4)));
__device__ __forceinline__ bf16x8 tr_lo(const LAS unsigned char* p) {
    const v4i16_t t = __builtin_amdgcn_ds_read_tr16_b64_v4i16((LAS v4i16_t*)p);
    return (bf16x8){t[0], t[1], t[2], t[3], 0, 0, 0, 0};
}
__device__ __forceinline__ bf16x8 lo4(v2u g) { v4u w; w.x = g.x; w.y = g.y; w.z = 0u; w.w = 0u; return __builtin_bit_cast(bf16x8, w); }
__device__ __forceinline__ bf16x8 cat8(v2u a, v2u b) { v4u w; w.x = a.x; w.y = a.y; w.z = b.x; w.w = b.y; return __builtin_bit_cast(bf16x8, w); }
struct ChunkOps { v2u pA[2][2], rA[2][2], g[4]; f32x4 ac[4]; bf16x8 aq[4], ak[4], bv; };
__device__ __forceinline__ void chunk_load(const LAS unsigned char* sl, ChunkOps& X, int lane) {
    const int fr = lane & 15, fq = lane >> 4;
#pragma unroll
    for (int m = 0; m < 2; ++m) { X.pA[m][0] = *(const LAS v2u*)(sl + CH_P + fr * CH_PP + 64 * m + 8 * fq); X.pA[m][1] = *(const LAS v2u*)(sl + CH_P + fr * CH_PP + 64 * m + 32 + 8 * fq);
        X.rA[m][0] = *(const LAS v2u*)(sl + CH_R + fr * CH_PP + 64 * m + 8 * fq); X.rA[m][1] = *(const LAS v2u*)(sl + CH_R + fr * CH_PP + 64 * m + 32 + 8 * fq); }
#pragma unroll
    for (int x = 0; x < 4; ++x) X.g[x] = *(const LAS v2u*)(sl + CH_G + 512 * x + (fr * 16 + 4 * fq) * 2);
    X.bv = tr_lo(sl + CH_V + 8 * lane);
#pragma unroll
    for (int jt = 0; jt < 4; ++jt) { X.aq[jt] = tr_lo(sl + CH_Q + jt * 512 + 8 * lane); X.ak[jt] = tr_lo(sl + CH_K + jt * 512 + 8 * lane);
        X.ac[jt] = *(const LAS f32x4*)(sl + CH_AC + (16 * jt + 4 * fq) * 4); }
}
__device__ __forceinline__ bf16x8 lo4t(bf16x8 t) { return t; }
__device__ __forceinline__ void chunk_math(const ChunkOps& X, f32x4 (&S)[4], f32x4& o_out) {
    bf16x8 bs[2];
#pragma unroll
    for (int m = 0; m < 2; ++m) { v4u w; w.x = pk2(S[2 * m][0], S[2 * m][1]); w.y = pk2(S[2 * m][2], S[2 * m][3]); w.z = pk2(S[2 * m + 1][0], S[2 * m + 1][1]); w.w = pk2(S[2 * m + 1][2], S[2 * m + 1][3]); bs[m] = __builtin_bit_cast(bf16x8, w); }
    const f32x4 z4 = (f32x4){0.f, 0.f, 0.f, 0.f};
    const bf16x8 bv = lo4t(X.bv);
    f32x4 y = MFMA16(cat8(X.pA[0][0], X.pA[0][1]), bs[0], z4); y = MFMA16(cat8(X.pA[1][0], X.pA[1][1]), bs[1], y); y = MFMA16(lo4(X.g[0]), bv, y);
    f32x4 o = MFMA16(cat8(X.rA[0][0], X.rA[0][1]), bs[0], z4); o = MFMA16(cat8(X.rA[1][0], X.rA[1][1]), bs[1], o); o = MFMA16(lo4(X.g[3]), bv, o);
    const bf16x8 by = lo4(pk4(y));
    const f32x4 u = MFMA16(lo4(X.g[1]), by, z4);
    const bf16x8 bu = lo4(pk4(u));
    o_out = MFMA16(lo4(X.g[2]), bu, o);
#pragma unroll
    for (int jt = 0; jt < 4; ++jt) { S[jt] = MFMA16(lo4t(X.aq[jt]), bu, S[jt]); S[jt] = MFMA16(lo4t(X.ak[jt]), bv, S[jt]); S[jt] = S[jt] * X.ac[jt]; }
}
#ifndef SC_CONVW
#define SC_CONVW 3
#endif
constexpr int SC_NS = 7, SC_AHEAD = 5, SC_CTL = SC_NS * CH_SLOT, SCAN_TR_OFF = 81920;
__device__ __forceinline__ void scan_dma(const unsigned char* rec, const bf16* vt, LAS unsigned char* slot, int lane) {
#pragma unroll
    for (int i = 0; i < 10; ++i) __builtin_amdgcn_global_load_lds((const unsigned*)(rec + (lane + 64 * i) * 16), (LAS unsigned*)(slot + i * 1024), 16, 0, 0);
    if (lane < 48) __builtin_amdgcn_global_load_lds((const unsigned*)(rec + (lane + 640) * 16), (LAS unsigned*)(slot + 10240), 16, 0, 0);
    if (lane < 32) __builtin_amdgcn_global_load_lds((const unsigned*)(vt + (size_t)(lane >> 1) * 512 + 8 * (lane & 1)), (LAS unsigned*)(slot + CH_V), 16, 0, 0);
}
__device__ __forceinline__ int sc_ld(LAS int* p) { int v; const unsigned a = (unsigned)(size_t)p; asm volatile("ds_read_b32 %0, %1\n\ts_waitcnt lgkmcnt(0)" : "=&v"(v) : "v"(a) : "memory"); return v; }
__device__ __forceinline__ void sc_st(LAS int* p, int v) { const unsigned a = (unsigned)(size_t)p; asm volatile("ds_write_b32 %0, %1" :: "v"(a), "v"(v) : "memory"); }
#define SC_LD(p) sc_ld(p)
#define SC_ST(p, v) sc_st((p), (v))
__device__ __forceinline__ void p5_scan(Frame& F, bool extras = true, int abl = 0) {
    LAS int* ctl = (LAS int*)(F.lds + SC_CTL);
    if (F.tid < 4) ctl[F.tid] = 0;
    LDS_WAIT(); __syncthreads();
    constexpr int NKQ = (tri::NITEMS - tri::E12) / 256;
    LAS float* mytile = (LAS float*)(F.lds + SCAN_TR_OFF + F.wave * 8448);
    const int bh = F.vcu >> 2, b = bh >> 3, h = bh & 7, i0 = (F.vcu & 3) * 16;
    if (F.wave == 0) {
        if (abl & 1) return;
        __builtin_amdgcn_s_setprio(3);
        float* o0 = (float*)(F.ws + WS_XN) + (size_t)b * SEQ * 512 + h * 64 + i0;
        const int fr = F.lane & 15, fq = F.lane >> 4;
        f32x4 S[4];
#pragma unroll
        for (int jt = 0; jt < 4; ++jt) S[jt] = (f32x4){0.f, 0.f, 0.f, 0.f};
        ChunkOps XA, XB;
        while (SC_LD(&ctl[0]) <= 0) __builtin_amdgcn_s_sleep(1);
        asm volatile("" ::: "memory");
        chunk_load(F.lds, XA, F.lane);
        LDS_WAIT(); asm volatile("" ::: "memory");
        if (F.lane == 0) SC_ST(&ctl[1], 1);
#define SCAN_ITER(XC, XN_, c_) do { const int cc = (c_); \
            if (cc + 1 < 128) { while (SC_LD(&ctl[0]) <= cc + 1) __builtin_amdgcn_s_sleep(1); asm volatile("" ::: "memory"); chunk_load(F.lds + ((cc + 1) % SC_NS) * CH_SLOT, XN_, F.lane); } \
            __builtin_amdgcn_sched_barrier(0); \
            f32x4 o; chunk_math(XC, S, o); \
            __builtin_amdgcn_sched_barrier(0); \
            float* orow = o0 + (size_t)cc * 16 * 512; \
            _Pragma("unroll") for (int rg = 0; rg < 4; ++rg) { float* pp = orow + (size_t)(4 * fq + rg) * 512 + fr; const float vv = o[rg]; asm volatile("global_store_dword %0, %1, off" :: "v"(pp), "v"(vv) : "memory"); } \
            if (cc + 1 < 128) { LDS_WAIT(); asm volatile("" ::: "memory"); if (F.lane == 0) SC_ST(&ctl[1], cc + 2); } } while (0)
#pragma unroll 1
        for (int c = 0; c < 128; c += 2) { SCAN_ITER(XA, XB, c); SCAN_ITER(XB, XA, c + 1); }
#undef SCAN_ITER
        asm volatile("s_waitcnt vmcnt(0)" ::: "memory");
        __builtin_amdgcn_s_setprio(0);
        if (F.lane == 0) SC_ST(&ctl[3], 1);
        if (!(abl & 2)) tr_run_q(F, mytile, &ctl[2], tri::E12 + F.vcu, F.G, NKQ);
    } else if (F.wave == 1) {
        if (abl & 1) return;
        const unsigned char* rec0 = F.ws + WS_S + ((size_t)(b * 128) * 8 + h) * CH_REC;
        const bf16* vt0 = (const bf16*)F.out + (size_t)b * SEQ * 512 + h * 64 + i0;
        for (int n = 0; n < 128; ++n) {
            while (SC_LD(&ctl[1]) < n - SC_NS + 1) __builtin_amdgcn_s_sleep(1);
            asm volatile("" ::: "memory");
            scan_dma(rec0 + (size_t)n * 8 * CH_REC, vt0 + (size_t)n * 16 * 512, F.lds + (n % SC_NS) * CH_SLOT, F.lane);
            if (n >= SC_AHEAD) { asm volatile("s_waitcnt vmcnt(60)" ::: "memory"); if (F.lane == 0) SC_ST(&ctl[0], n - SC_AHEAD + 1); }
        }
        asm volatile("s_waitcnt vmcnt(48)" ::: "memory"); if (F.lane == 0) SC_ST(&ctl[0], 124);
        asm volatile("s_waitcnt vmcnt(36)" ::: "memory"); if (F.lane == 0) SC_ST(&ctl[0], 125);
        asm volatile("s_waitcnt vmcnt(24)" ::: "memory"); if (F.lane == 0) SC_ST(&ctl[0], 126);
        asm volatile("s_waitcnt vmcnt(12)" ::: "memory"); if (F.lane == 0) SC_ST(&ctl[0], 127);
        asm volatile("s_waitcnt vmcnt(0)" ::: "memory"); if (F.lane == 0) SC_ST(&ctl[0], 128);
        if (!(abl & 2)) { while (SC_LD(&ctl[3]) == 0) __builtin_amdgcn_s_sleep(8); tr_run_q(F, mytile, &ctl[2], tri::E12 + F.vcu, F.G, NKQ); }
    } else {
        const int w2 = F.vcu * 6 + (F.wave - 2), NW2 = F.G * 6;
        if (!(abl & 2) && F.wave - 2 < SC_CONVW) tr_run_q(F, mytile, &ctl[2], tri::E12 + F.vcu, F.G, NKQ);
        if (!extras) return;
        for (int mb = w2; mb < M; mb += 4 * NW2) {
            v4u a0[4], a1[4], a2[4];
#pragma unroll
            for (int u = 0; u < 4; ++u) { const int mr = (mb + u * NW2 < M) ? mb + u * NW2 : mb; const bf16* y0 = (const bf16*)(F.ws + WS_YB) + (size_t)mr * 512 + 8 * F.lane; a0[u] = *(const v4u*)y0; a1[u] = *(const v4u*)(y0 + 8 * MiB); a2[u] = *(const v4u*)(y0 + 16 * MiB); }
#pragma unroll
            for (int u = 0; u < 4; ++u) { float f0[8], f1[8], f2[8]; unpk8(a0[u], f0); unpk8(a1[u], f1); unpk8(a2[u], f2);
                v4u w; w.x = pk2(f0[0] + f1[0] + f2[0], f0[1] + f1[1] + f2[1]); w.y = pk2(f0[2] + f1[2] + f2[2], f0[3] + f1[3] + f2[3]); w.z = pk2(f0[4] + f1[4] + f2[4], f0[5] + f1[5] + f2[5]); w.w = pk2(f0[6] + f1[6] + f2[6], f0[7] + f1[7] + f2[7]);
                if (mb + u * NW2 < M) *(v4u*)((bf16*)(F.ws + WS_YB) + (size_t)(mb + u * NW2) * 512 + 8 * F.lane) = w; } }
        const float* p = F.ap->in[1]; bf16* PB = (bf16*)(F.ws + WS_PBF);
        constexpr size_t NV = (size_t)M * 256 / 4;
        for (size_t b0 = (size_t)w2 * 64 + F.lane; b0 < NV; b0 += (size_t)8 * NW2 * 64) {
            f32x4 pv[8];
#pragma unroll
            for (int i = 0; i < 8; ++i) { const size_t idx = b0 + (size_t)i * NW2 * 64; pv[i] = (idx < NV) ? *(const f32x4*)(p + idx * 4) : (f32x4){0.f, 0.f, 0.f, 0.f}; }
#pragma unroll
            for (int i = 0; i < 8; ++i) { const size_t idx = b0 + (size_t)i * NW2 * 64; if (idx < NV) *(v2u*)(PB + idx * 4) = pk4(pv[i]); } }
        if (!(abl & 2) && F.wave - 2 >= SC_CONVW) { while (SC_LD(&ctl[3]) == 0) __builtin_amdgcn_s_sleep(8); tr_run_q(F, mytile, &ctl[2], tri::E12 + F.vcu, F.G, NKQ); }
    }
}

struct P6Par { float lw[8], lb[8]; };
__device__ __forceinline__ void p6_rows2(Frame& F, int ma, int mb_, const P6Par& P) {
    const int l = F.lane, c = 8 * l, h = l >> 3;
    f32x4 oa[2][2]; v4u vv_[2], gg_[2]; float bsv[2];
#pragma unroll
    for (int u = 0; u < 2; ++u) { const int m = u ? mb_ : ma;
        const float* oraw = (const float*)(F.ws + WS_XN) + (size_t)m * 512 + c;
        oa[u][0] = *(const f32x4*)oraw; oa[u][1] = *(const f32x4*)(oraw + 4); bsv[u] = ((const float*)(F.ws + WS_BONUS))[(size_t)m * 8 + h];
        vv_[u] = *(const v4u*)((const bf16*)F.out + (size_t)m * 512 + c); gg_[u] = *(const v4u*)((const bf16*)(F.ws + WS_G) + (size_t)m * 512 + c);
    }
    __builtin_amdgcn_sched_barrier(0);
#pragma unroll
    for (int u = 0; u < 2; ++u) { const int m = u ? mb_ : ma;
        float o[8] = {oa[u][0].x, oa[u][0].y, oa[u][0].z, oa[u][0].w, oa[u][1].x, oa[u][1].y, oa[u][1].z, oa[u][1].w};
        float s = 0.f;
#pragma unroll
        for (int j = 0; j < 8; ++j) s += o[j];
        s += __shfl_xor(s, 1); s += __shfl_xor(s, 2); s += __shfl_xor(s, 4);
        const float mu = s * (1.f / 64.f); float q = 0.f;
#pragma unroll
        for (int j = 0; j < 8; ++j) { o[j] -= mu; q += o[j] * o[j]; }
        q += __shfl_xor(q, 1); q += __shfl_xor(q, 2); q += __shfl_xor(q, 4);
        const float rstd = 1.0f / sqrtf(q * (1.f / 64.f) + GN_EPS);
        float vv[8], gg[8];
        unpk8(vv_[u], vv); unpk8(gg_[u], gg);
        const float bs = bsv[u];
        float y[8];
#pragma unroll
        for (int j = 0; j < 8; ++j) y[j] = (o[j] * rstd * P.lw[j] + P.lb[j] + bs * vv[j]) * gg[j];
        v4u w; w.x = pk2(y[0], y[1]); w.y = pk2(y[2], y[3]); w.z = pk2(y[4], y[5]); w.w = pk2(y[6], y[7]);
        *(v4u*)((bf16*)(F.ws + WS_YRW) + (size_t)m * 512 + c) = w;
    }
}
__device__ __forceinline__ void p6_phase(Frame& F) {
    const int l = F.lane, c = 8 * l;
    P6Par P;
#pragma unroll
    for (int j = 0; j < 8; ++j) { P.lw[j] = F.ap->in[13][c + j]; P.lb[j] = F.ap->in[14][c + j]; }
    for (int m = F.gw; m < M; m += 2 * F.NGW) p6_rows2(F, m, m + F.NGW, P);
}

struct RouteW { f32x4 wv[3][8]; };
__device__ __forceinline__ void route_ldx(Frame& F, int tile, v4u (&xv)[4]) {
    const int fr = F.lane & 15, fq = F.lane >> 4; const bf16* xp = (const bf16*)(F.ws + WS_Z) + (size_t)(tile * 16 + fr) * D + F.wave * 128 + 8 * fq;
#pragma unroll
    for (int g = 0; g < 4; ++g) xv[g] = *(const v4u*)(xp + 32 * g);
}
__device__ __forceinline__ void route_tile(Frame& F, int tile, const RouteW& W, const v4u (&xv_)[4], int par) {
    const int fr = F.lane & 15, fq = F.lane >> 4, m0 = tile * 16;
    f32x4 acc[3] = {(f32x4){0.f, 0.f, 0.f, 0.f}, (f32x4){0.f, 0.f, 0.f, 0.f}, (f32x4){0.f, 0.f, 0.f, 0.f}};
    float ssq = 0.f;
#pragma unroll
    for (int g2 = 0; g2 < 4; ++g2) {
        float xf[8]; unpk8(xv_[g2], xf);
#pragma unroll
        for (int hh = 0; hh < 2; ++hh) { const int g = 2 * g2 + hh;
            ssq += (xf[4 * hh] * xf[4 * hh] + xf[4 * hh + 1] * xf[4 * hh + 1]) + (xf[4 * hh + 2] * xf[4 * hh + 2] + xf[4 * hh + 3] * xf[4 * hh + 3]);
#pragma unroll
            for (int s = 0; s < 4; ++s)
#pragma unroll
                for (int ct = 0; ct < 3; ++ct) acc[ct] = __builtin_amdgcn_mfma_f32_16x16x4f32(W.wv[ct][g][s], xf[4 * hh + s], acc[ct], 0, 0, 0); }
    }
    ssq += __shfl_xor(ssq, 16); ssq += __shfl_xor(ssq, 32);
    LAS float* red = (LAS float*)(F.lds + par * 32768);
    LAS float* ssqb = red + 8 * 3 * 64 * 4; LAS float* rsb = ssqb + 128;
#pragma unroll
    for (int ct = 0; ct < 3; ++ct) *(LAS f32x4*)(red + ((F.wave * 3 + ct) * 64 + F.lane) * 4) = acc[ct];
    if (fq == 0) ssqb[F.wave * 16 + fr] = ssq;
    LDS_WAIT(); __syncthreads();
    if (F.wave == 0) { float st = 0.f;
#pragma unroll
      for (int w = 0; w < 8; ++w) st += ssqb[w * 16 + (F.lane & 15)];
      const float rs = 1.0f / sqrtf(st * (1.f / D) + NORM_EPS);
      if (fq == 0) ((float*)(F.ws + WS_RSE))[m0 + fr] = rs;
#pragma unroll
      for (int ct = 0; ct < 3; ++ct) { f32x4 t = (f32x4){0.f, 0.f, 0.f, 0.f};
#pragma unroll
          for (int w = 0; w < 8; ++w) t = t + *(const LAS f32x4*)(red + ((w * 3 + ct) * 64 + F.lane) * 4);
          *(f32x4*)((float*)(F.ws + WS_LOGITS) + (size_t)(m0 + fr) * 48 + 16 * ct + 4 * fq) = t * rs; } }
}
__device__ __forceinline__ void p9_phase(Frame& F, int rep_ = 0) {
    const int fr = F.lane & 15, fq = F.lane >> 4;
    RouteW W;
    { const float* wp = (const float*)(F.ws + WS_SMALLW + SW_ROUTEW) + (size_t)fr * D + F.wave * 128 + 8 * fq;
#pragma unroll
      for (int ct = 0; ct < 3; ++ct)
#pragma unroll
          for (int g = 0; g < 8; ++g) W.wv[ct][g] = *(const f32x4*)(wp + (size_t)ct * 16 * D + 32 * (g >> 1) + 4 * (g & 1)); }
    v4u xa[4], xb[4];
    int tile = F.vcu, par = 0;
    if (tile < 1024) route_ldx(F, tile, xa);
    while (tile < 1024) {
        const int nt = tile + F.G;
        if (nt < 1024) route_ldx(F, nt, xb);
        __builtin_amdgcn_sched_barrier(0);
        route_tile(F, tile, W, xa, par);
#pragma unroll
        for (int g = 0; g < 4; ++g) xa[g] = xb[g];
        tile = nt; par ^= 1;
    }
}

__device__ __forceinline__ void p9b_phase(Frame& F) {
    if (F.wave != 0) return;
    for (int base = F.vcu * 64; base < M; base += F.G * 64) {
        const int tok = base + F.lane;
        const float* lgp = (const float*)(F.ws + WS_LOGITS) + (size_t)tok * 48;
        float lg[36];
#pragma unroll
        for (int q = 0; q < 9; ++q) { const f32x4 v = *(const f32x4*)(lgp + 4 * q); lg[4 * q] = v.x; lg[4 * q + 1] = v.y; lg[4 * q + 2] = v.z; lg[4 * q + 3] = v.w; }
        const float* bg = F.ap->in[27]; const float* br = F.ap->in[29];
        float gl[4]; int gs = 0; float gm = -3.0e38f;
#pragma unroll
        for (int c = 0; c < 4; ++c) { gl[c] = lg[c] + bg[c]; if (gl[c] > gm) { gm = gl[c]; gs = c; } }
        float gsum = 0.f;
#pragma unroll
        for (int c = 0; c < 4; ++c) gsum += __expf(gl[c] - gm);
        const float pgroup = 1.0f / gsum;
        float el[8]; float em = -3.0e38f;
#pragma unroll
        for (int c = 0; c < 8; ++c) { const float lv = gs == 0 ? lg[4 + c] : (gs == 1 ? lg[12 + c] : (gs == 2 ? lg[20 + c] : lg[28 + c])); el[c] = lv + br[gs * 8 + c]; em = fmaxf(em, el[c]); }
        int i1 = 0; float v1 = -3.0e38f;
#pragma unroll
        for (int c = 0; c < 8; ++c) if (el[c] > v1) { v1 = el[c]; i1 = c; }
        int i2 = 0; float v2 = -3.0e38f;
#pragma unroll
        for (int c = 0; c < 8; ++c) if (c != i1 && el[c] > v2) { v2 = el[c]; i2 = c; }
        const float p1 = __expf(v1 - em), p2 = __expf(v2 - em);
        const float g1 = pgroup * p1 / (p1 + p2), g2 = pgroup * p2 / (p1 + p2);
        const int e1 = gs * 8 + i1, e2 = gs * 8 + i2;
        const unsigned long long lt = (1ull << F.lane) - 1ull;
        int r1 = 0, r2 = 0, mycnt = 0;
        for (int e = 0; e < 32; ++e) {
            const unsigned long long m1 = __ballot(e1 == e), m2 = __ballot(e2 == e);
            const int c1 = __popcll(m1), c2 = __popcll(m2);
            if (e1 == e) r1 = __popcll(m1 & lt);
            if (e2 == e) r2 = c1 + __popcll(m2 & lt);
            if (F.lane == e) mycnt = c1 + c2;
        }
        unsigned* cnt = (unsigned*)(F.ws + WS_CTL) + CW_CNT; int* list = (int*)(F.ws + WS_LIST); float* gateA = (float*)(F.ws + WS_GATEA); unsigned* slotA = (unsigned*)(F.ws + WS_SLOTA);
        int bs = 0;
        if (F.lane < 32 && mycnt > 0) bs = (int)atomicAdd(&cnt[F.lane], (unsigned)mycnt);
        const unsigned q1 = (unsigned)(__shfl(bs, e1) + r1), q2 = (unsigned)(__shfl(bs, e2) + r2);
        gateA[tok * 2 + 0] = g1; gateA[tok * 2 + 1] = g2;
        list[(size_t)e1 * 16384 + q1] = tok * 2 + 0; slotA[tok * 2 + 0] = ((unsigned)e1 << 16) | q1;
        list[(size_t)e2 * 16384 + q2] = tok * 2 + 1; slotA[tok * 2 + 1] = ((unsigned)e2 << 16) | q2;
    }
}

__device__ __forceinline__ void p12_rows2(Frame& F, int ma, int mb_, int prelane) {
    const unsigned* slotA = (const unsigned*)(F.ws + WS_SLOTA); const float* gateA = (const float*)(F.ws + WS_GATEA);
    unsigned sl[2][2]; float gt[2][2];
#pragma unroll
    for (int u = 0; u < 2; ++u) { const int m = u ? mb_ : ma; sl[u][0] = slotA[2 * m]; sl[u][1] = slotA[2 * m + 1]; gt[u][0] = gateA[2 * m]; gt[u][1] = gateA[2 * m + 1]; }
    f32x4 xv[2][4]; v2u cv[2][2][4]; float se[2];
#pragma unroll
    for (int u = 0; u < 2; ++u) { const int m = u ? mb_ : ma;
        const bf16* x1 = (const bf16*)(F.ws + WS_Z) + (size_t)m * D;
        se[u] = (F.lane < 16) ? ((const float*)(F.ws + WS_ZGATE + 1 * MiB))[(size_t)m * 16 + F.lane] : 0.f;
#pragma unroll
        for (int j = 0; j < 4; ++j) { const int o = 4 * F.lane + 256 * j; xv[u][j] = unpk4(*(const v2u*)(x1 + o)); }
#pragma unroll
        for (int k = 0; k < 2; ++k) { const unsigned s = (unsigned)__builtin_amdgcn_readfirstlane((int)sl[u][k]); const int pre = __builtin_amdgcn_readlane(prelane, (int)(s >> 16));
            const bf16* cp = (const bf16*)(F.ws + WS_Z + 64 * MiB) + ((size_t)pre * 256 + (s & 0xffffu)) * D;
#pragma unroll
            for (int j = 0; j < 4; ++j) cv[u][k][j] = *(const v2u*)(cp + 4 * F.lane + 256 * j); } }
    __builtin_amdgcn_sched_barrier(0);
    float s2[2];
#pragma unroll
    for (int u = 0; u < 2; ++u) { s2[u] = 0.f;
#pragma unroll
        for (int j = 0; j < 4; ++j) { xv[u][j] = xv[u][j] + unpk4(cv[u][0][j]) * gt[u][0] + unpk4(cv[u][1][j]) * gt[u][1];
            s2[u] += (xv[u][j].x * xv[u][j].x + xv[u][j].y * xv[u][j].y) + (xv[u][j].z * xv[u][j].z + xv[u][j].w * xv[u][j].w);
        } }
#pragma unroll
    for (int o = 1; o < 64; o <<= 1) {
#pragma unroll
        for (int u = 0; u < 2; ++u) { s2[u] += __shfl_xor(s2[u], o); se[u] += __shfl_xor(se[u], o); } }
#pragma unroll
    for (int u = 0; u < 2; ++u) { const int m = u ? mb_ : ma;
        const float rs = 1.0f / sqrtf(s2[u] * (1.f / D) + NORM_EPS); const float rse = 1.0f / sqrtf(se[u] * (1.f / D) + NORM_EPS);
        bf16* x2 = (bf16*)(F.ws + WS_S) + (size_t)m * D; if (F.lane == 0) { ((float*)(F.ws + WS_RSE))[M + m] = rs; ((float*)(F.ws + WS_RSE))[2 * M + m] = rse; }
#pragma unroll
        for (int j = 0; j < 4; ++j) { const int o = 4 * F.lane + 256 * j; *(v2u*)(x2 + o) = pk4(xv[u][j]); }
    }
}
__device__ __forceinline__ void p12_phase(Frame& F) {
    const unsigned* cnt = (const unsigned*)(F.ws + WS_CTL) + CW_CNT;
    int nt = (F.lane < 32) ? (((int)cnt[F.lane & 31] + 255) >> 8) : 0;
    int incl = nt;
#pragma unroll
    for (int o = 1; o < 32; o <<= 1) { const int v = __shfl_up(incl, o); if (F.lane >= o) incl += v; }
    const int prelane = incl - nt;
    for (int m = F.gw; m < M; m += 2 * F.NGW) p12_rows2(F, m, m + F.NGW, prelane);
}
__device__ __forceinline__ void p14_rows4(Frame& F, int mb) {
    const float* gf = F.ap->in[36];
    f32x4 v[4][4]; float s[4];
#pragma unroll
    for (int u = 0; u < 4; ++u) { const bf16* xr = (const bf16*)(F.ws + WS_Z) + (size_t)(mb + u * F.NGW) * D;
#pragma unroll
        for (int j = 0; j < 4; ++j) v[u][j] = unpk4(*(const v2u*)(xr + 4 * F.lane + 256 * j)); }
#pragma unroll
    for (int u = 0; u < 4; ++u) { s[u] = 0.f;
#pragma unroll
        for (int j = 0; j < 4; ++j) s[u] += (v[u][j].x * v[u][j].x + v[u][j].y * v[u][j].y) + (v[u][j].z * v[u][j].z + v[u][j].w * v[u][j].w); }
#pragma unroll
    for (int o = 1; o < 64; o <<= 1) {
#pragma unroll
        for (int u = 0; u < 4; ++u) s[u] += __shfl_xor(s[u], o); }
#pragma unroll
    for (int u = 0; u < 4; ++u) { const float rs = 1.0f / sqrtf(s[u] * (1.f / D) + NORM_EPS); float* orow = F.out + (size_t)(mb + u * F.NGW) * D;
#pragma unroll
        for (int j = 0; j < 4; ++j) { const int o = 4 * F.lane + 256 * j; *(f32x4*)(orow + o) = v[u][j] * rs * *(const f32x4*)(gf + o); } }
}

#ifndef MK_ONE_LAUNCH
#define MK_ONE_LAUNCH 1
#endif
constexpr int N_PHASES = 14;
__global__ void __launch_bounds__(NWAVES * 64, 2) mk_fwd(Args args) {
    extern __shared__ __attribute__((aligned(16))) unsigned char lds[];
    Frame F;
    F.lds = (LAS unsigned char*)lds;
    F.tid = threadIdx.x; F.lane = F.tid & 63; F.wave = __builtin_amdgcn_readfirstlane(F.tid >> 6);
    F.G = gridDim.x; { const int bx = blockIdx.x; F.vcu = (F.G % 8 == 0) ? (bx % 8) * (F.G / 8) + bx / 8 : bx; }
    F.gw = F.vcu * NWAVES + F.wave; F.NGW = F.G * NWAVES;
    F.ws = args.ws; F.out = args.out;
    F.ap = (ArgsP)__builtin_amdgcn_kernarg_segment_ptr();
    unsigned char* ws = args.ws;
    const int lo = args.ph_lo, hi = args.ph_hi;
#ifdef ONLY
#define IN(k) ((k) == ONLY && lo <= (k) && (k) < hi)
#else
#define IN(k) (lo <= (k) && (k) < hi)
#endif
#if MK_ONE_LAUNCH
    if (F.tid < 16) ((LAS unsigned*)(F.lds + MISC_OFF))[F.tid] = 0u;
    __syncthreads();
    XcdBarrier bar = xcd_barrier_post((unsigned*)(ws + WS_CTL) + CW_BAR, (volatile LAS unsigned*)(F.lds + MISC_OFF));
#define GRID_BAR(k) do { if (IN(k) && IN((k) + 1)) { if ((k) == 12) cg::this_grid().sync(); else xcd_barrier(bar); } } while (0)
#else
#define GRID_BAR(k) do { } while (0)
#endif
    LAS unsigned char* L = F.lds;
#ifdef PROBE_A
    unsigned long long* tsb = (unsigned long long*)(ws + WS_CTL + 32768);
    int n_st = 0;
#define STAMP() do { if (blockIdx.x == 0 && F.tid == 0) tsb[n_st] = __builtin_amdgcn_s_memrealtime(); ++n_st; } while (0)
    STAMP();
#else
#define STAMP() do { } while (0)
#endif
    const bf16* z = (const bf16*)(ws + WS_Z);

    if (IN(0)) { p0_prologue(F); } GRID_BAR(0); STAMP();

    if (IN(1)) {
        pg8::Gemm g{(const bf16*)(ws + WS_XN), (const bf16*)(ws + WS_WIN), M, NZ, D, nullptr}; pg8::StaticOrder S; S.init(M, NZ, F.G, (int)blockIdx.x);
        EpiStoreBf16 E{(bf16*)(ws + WS_Z), NZ};
        pg8::gemm_phase<EpiStoreBf16, pg8::StaticOrder, true, false>(L, g, S, E);
    } GRID_BAR(1); STAMP();

    if (IN(2)) { p2_prep(F); } GRID_BAR(2); STAMP();
    if (IN(3)) { p3_phase(F); } GRID_BAR(3); STAMP();
    if (IN(4)) { p4_phase(F); } GRID_BAR(4); STAMP();
    if (IN(5)) { if (F.G == 256) p5_scan(F); } GRID_BAR(5); STAMP();
    if (IN(6)) { p6_phase(F); } GRID_BAR(6); STAMP();

    if (IN(7)) {
        pg8::Gemm g{(const bf16*)(ws + WS_YRW), (const bf16*)(ws + WS_UR), 2 * M, 2 * D, 512, nullptr}; DualOrder S; S.S.init(M, D, F.G, (int)blockIdx.x);
        EpiMix2 E{z, (bf16*)(ws + WS_S + 64 * MiB)};
        pg8::gemm_phase<EpiMix2, DualOrder, true, false>(L, g, S, E);
    } GRID_BAR(7); STAMP();

    if (IN(8)) {
        pg8::Gemm g{(const bf16*)(ws + WS_S + 64 * MiB), (const bf16*)(ws + WS_WO), M, D, D, nullptr}; pg8::StaticOrder S; S.init(M, D, F.G, (int)blockIdx.x);
        EpiResBf16 E{F.ap->in[0], (bf16*)(ws + WS_Z)};
        pg8::gemm_phase<EpiResBf16, pg8::StaticOrder, true, false>(L, g, S, E);
    } GRID_BAR(8); STAMP();

    if (IN(9)) { p9_phase(F); xcd_barrier(bar); p9b_phase(F); } GRID_BAR(9); STAMP();

    if (IN(10)) {
        pg8::Gemm g{(const bf16*)(ws + WS_Z), (const bf16*)(ws + WS_WGU), M, 1024, D, (const int*)(ws + WS_LIST), (const float*)(ws + WS_RSE)};
        pg8::moe_fill_tab((LAS int*)(F.lds + MISC_OFF - 256), (const unsigned*)(ws + WS_CTL) + CW_CNT); LDS_WAIT(); __syncthreads();
        pg8::MoeOrder S{(const LAS int*)(F.lds + MISC_OFF - 256), F.G, F.vcu, false, 0, nullptr};
        EpiMoe1 E{(bf16*)(ws + WS_S), (const LAS float*)(F.lds + pg8::STAGE_BYTES + 4096), (unsigned*)(ws + WS_CTL) + CW_DEP};
        pg8::gemm_phase<EpiMoe1, pg8::MoeOrder, true, true>(L, g, S, E);
    } STAMP();

    if (IN(11)) {
#ifndef NO_MOE2
        { pg8::Gemm g{(const bf16*)(ws + WS_S), (const bf16*)(ws + WS_WD), M, 1024, 512, nullptr};
          pg8::moe_fill_tab((LAS int*)(F.lds + MISC_OFF - 256), (const unsigned*)(ws + WS_CTL) + CW_CNT); LDS_WAIT(); __syncthreads();
          const LAS int* tb = (const LAS int*)(F.lds + MISC_OFF - 256); const int n10 = 4 * (tb[31] + ((tb[63] + 255) >> 8));
          pg8::MoeOrderT<true> S{tb, F.G, F.vcu, true, n10 % F.G, (const unsigned*)(ws + WS_CTL) + CW_DEP};
          EpiStoreBf16 E{(bf16*)(ws + WS_Z + 64 * MiB), D};
          pg8::gemm_phase<EpiStoreBf16, pg8::MoeOrderT<true>, true, false>(L, g, S, E); }
#endif
        { pg8::Gemm g2{(const bf16*)(ws + WS_PBF), (const bf16*)(ws + WS_WPP), M, D, 256, nullptr}; ErawOrder S2; S2.S.init(M, D, F.G, 0); S2.c = (int)blockIdx.x; S2.G = F.G;
          S2.nheavy = 0;
          EpiStoreSsq E2{(bf16*)(ws + WS_S + 64 * MiB), D, (float*)(ws + WS_ZGATE + 1 * MiB)};
          pg8::gemm_phase<EpiStoreSsq, ErawOrder, true, false>(L, g2, S2, E2); }
    } GRID_BAR(11); STAMP();

    if (IN(12)) { p12_phase(F); } GRID_BAR(12); STAMP();

    if (IN(13)) {
        pg8::Gemm g{(const bf16*)(ws + WS_S), (const bf16*)(ws + WS_WPG), M, D, D, nullptr}; pg8::StaticOrder S; S.init(M, D, F.G, (int)blockIdx.x);
        EpiPleNorm E{(const bf16*)(ws + WS_S), (const bf16*)(ws + WS_S + 64 * MiB), (const float*)(ws + WS_RSE) + 2 * M, F.ap->in[33], (const float*)(ws + WS_RSE) + M, F.ap->in[36], F.out, (float*)(ws + WS_ZGATE), (unsigned*)(ws + WS_CTL) + CW_PANEL, (LAS float*)(F.lds + 131072)};
        pg8::gemm_phase<EpiPleNorm, pg8::StaticOrder, true, false>(L, g, S, E);
    } STAMP();

#ifdef PROBE_A
    xcd_barrier(bar); STAMP(); __threadfence();
    if (blockIdx.x == 0 && F.tid == 0) { __threadfence(); }
    xcd_barrier(bar);
    {
        volatile unsigned long long* tv = (volatile unsigned long long*)tsb;
        const float dA = (float)(tv[PROBE_A + 1] - tv[PROBE_A]) * 0.01f, dB = (float)(tv[PROBE_B + 1] - tv[PROBE_B]) * 0.01f;
        for (size_t i = (size_t)blockIdx.x * 512 + F.tid; i < (size_t)M * D; i += (size_t)F.G * 512) F.out[i] = 10.0f * dB;
        __syncthreads();
        if (blockIdx.x == 0 && F.tid == 0) F.out[0] = 300.0f * dA;
    }
#endif
#undef IN
#undef GRID_BAR
}

extern "C" void kernel_launch(void* const* d_in, const int* in_sizes, int n_in, void* d_out, int out_size, void* d_ws, size_t ws_size, hipStream_t stream) {
    static int grid = 0;
    if (grid == 0) {
        if (n_in != 37 || out_size != M * D || ws_size < WS_END) { fprintf(stderr, "kernel_launch: unexpected problem (n_in %d, out %d, ws %zu < %zu); nothing launched\n", n_in, out_size, ws_size, (size_t)WS_END); grid = -1; return; }
        int dev = 0, cus = 0, per_cu = 0;
        if (hipGetDevice(&dev) != hipSuccess || hipDeviceGetAttribute(&cus, hipDeviceAttributeMultiprocessorCount, dev) != hipSuccess) { grid = -1; return; }
        if (hipFuncSetAttribute((const void*)mk_fwd, hipFuncAttributeMaxDynamicSharedMemorySize, LDS_BYTES) != hipSuccess) { fprintf(stderr, "kernel_launch: hipFuncSetAttribute failed\n"); grid = -1; return; }
        if (hipOccupancyMaxActiveBlocksPerMultiprocessor(&per_cu, (const void*)mk_fwd, NWAVES * 64, LDS_BYTES) != hipSuccess || per_cu < 1) { fprintf(stderr, "kernel_launch: occupancy query says %d blocks per CU\n", per_cu); (void)hipGetLastError(); grid = -1; return; }
        grid = cus;
        if (grid != 256) fprintf(stderr, "kernel_launch: %d CUs; this kernel is built for 256\n", grid);
    }
    if (grid < 0) return;
    (void)hipMemsetAsync((char*)d_ws + WS_CTL, 0, CTL_ZERO_BYTES, stream);
    Args a{};
    for (int i = 0; i < 37; ++i) a.in[i] = (const float*)d_in[i];
    a.out = (float*)d_out; a.ws = (unsigned char*)d_ws;
#if MK_ONE_LAUNCH
    a.ph_lo = 0; a.ph_hi = N_PHASES;
    void* kargs[] = {&a};
    hipError_t e = hipLaunchCooperativeKernel((const void*)mk_fwd, dim3(grid), dim3(NWAVES * 64), kargs, LDS_BYTES, stream);
    if (e != hipSuccess) fprintf(stderr, "kernel_launch: cooperative launch failed: %s (grid %d)\n", hipGetErrorString(e), grid);
#else
    for (int ph = 0; ph < N_PHASES; ++ph) { a.ph_lo = ph; a.ph_hi = ph + 1; hipLaunchKernelGGL(mk_fwd, dim3(grid), dim3(NWAVES * 64), LDS_BYTES, stream, a); }
#endif
}
```

```cpp
#include <hip/hip_runtime.h>
#include <hip/hip_cooperative_groups.h>
#include <cstdio>
#include <cstdint>
namespace cg = cooperative_groups;

namespace pg8 {
#define PG8_LAS __attribute__((address_space(3)))
typedef unsigned short bf16_t;
typedef short bf16x8 __attribute__((ext_vector_type(8)));
typedef float f32x4 __attribute__((ext_vector_type(4)));
typedef unsigned u32x4 __attribute__((ext_vector_type(4)));
typedef unsigned u32x2 __attribute__((ext_vector_type(2)));
constexpr int BM = 256, BK = 64, HALF = 128, HTB = HALF * BK * 2  , STAGE_BYTES = 8 * HTB, NXCD = 8, WGM = 8;

__host__ __device__ __forceinline__ int lds_byte(int r, int c) { const int st = (r >> 4) * 2 + (c >> 5), rr = r & 15, cc = c & 31, ob = rr * 64 + cc * 2; return st * 1024 + (ob ^ (((ob >> 9) & 1) << 5)); }
__host__ __device__ __forceinline__ void stage_rc(int b, int& R, int& C) { const int st = b / 1024, sb = b % 1024, swz = sb ^ (((sb >> 9) & 1) << 5); R = (st >> 1) * 16 + swz / 64; C = (st & 1) * 32 + (swz % 64) / 2; }
__host__ __device__ __forceinline__ int perm32(int rho) { const int n = rho >> 4, i = rho & 15; return 8 * (i >> 2) + 4 * n + (i & 3); }

struct Unit { int pm, pn, pmo, lt, nvalid, pnl; };
struct Gemm { const bf16_t* A; const bf16_t* Bt; int M, N, K; const int* rowidx; const float* rowscale; };

struct StaticOrder {
    static constexpr bool DEP = false, KEEP_ACC = false;
    int nM, nN, nwg, G, c;
    __host__ __device__ void init(int M, int N, int G_, int c_) { nM = M / BM; nN = N / BM; nwg = nM * nN; G = G_; c = c_; }
    __host__ __device__ bool next(int i, Unit& u) const {
        const long L = (long)i * G + c; if (L >= nwg) return false;
        int wgid = (int)L; { const int q = nwg / NXCD, r = nwg % NXCD, xcd = wgid % NXCD, off = wgid / NXCD; wgid = (xcd < r ? xcd * (q + 1) : r * (q + 1) + (xcd - r) * q) + off; }
        const int nig = WGM * nN, gid = wgid / nig, fm = gid * WGM, gsz = (nM - fm) < WGM ? (nM - fm) : WGM;
        u.pm = fm + ((wgid % nig) % gsz); u.pn = (wgid % nig) / gsz; u.pmo = u.pm; u.lt = u.pm; u.nvalid = 256; u.pnl = u.pn; return true;
    }
};
template <bool DEP_>
struct MoeOrderT {
    static constexpr bool DEP = DEP_, KEEP_ACC = false;
    const PG8_LAS int* tab; int G, c; bool a_is_out;
    int nheavy; const unsigned* dep;
    __device__ void wait(const Unit& u) const {
        const unsigned* p = dep + 16 * u.pmo; unsigned sp = 0;
        while (__hip_atomic_load(p, __ATOMIC_RELAXED, __HIP_MEMORY_SCOPE_AGENT) < 4u) { __builtin_amdgcn_s_sleep(2); if (++sp > (1u << 22)) break; }
        asm volatile("s_waitcnt vmcnt(0)" ::: "memory");
    }
    __device__ bool next(int i, Unit& u) const {
        int L;
        if constexpr (DEP_) { const int nl = G - nheavy; L = (c >= nheavy) ? (i < 2 ? i * nl + (c - nheavy) : 2 * nl + (i - 2) * G + c) : 2 * nl + i * G + c; }
        else L = i * G + c;
        const int tile = L >> 2, pnl = L & 3;
        const int lane = (int)__builtin_amdgcn_mbcnt_hi(~0u, __builtin_amdgcn_mbcnt_lo(~0u, 0u)), e_ = lane & 31;
        const int pre = tab[e_], ce = tab[32 + e_]; const int nt = (ce + 255) >> 8;
        const unsigned long long mk = __ballot(lane < 32 && tile >= pre && tile < pre + nt);
        if (mk == 0ull) return false;
        const int e = (int)__builtin_ctzll(mk);
        const int pre_e = __builtin_amdgcn_readlane(pre, e), ce_e = __builtin_amdgcn_readlane(ce, e);
        const int rt = tile - pre_e; u.pmo = tile; u.pm = a_is_out ? tile : 0; u.lt = e * 64 + rt; u.pn = e * 4 + pnl; u.pnl = pnl; const int rem = ce_e - rt * 256; u.nvalid = rem < 256 ? rem : 256; return true;
    }
};
typedef MoeOrderT<false> MoeOrder;
__device__ __forceinline__ void moe_fill_tab(PG8_LAS int* tab, const unsigned* cnt) {
    const int lane = (int)__builtin_amdgcn_mbcnt_hi(~0u, __builtin_amdgcn_mbcnt_lo(~0u, 0u));
    const int ce = (lane < 32) ? (int)cnt[lane & 31] : 0; const int nt = (ce + 255) >> 8;
    int incl = nt;
#pragma unroll
    for (int o = 1; o < 32; o <<= 1) { const int v = __shfl_up(incl, o); if (lane >= o) incl += v; }
    if (lane < 32) { tab[lane] = incl - nt; tab[32 + lane] = ce; }
}

__device__ __forceinline__ unsigned cvt_pk_bf16(float lo, float hi) { unsigned r; asm volatile("v_cvt_pk_bf16_f32 %0, %1, %2" : "=v"(r) : "v"(lo), "v"(hi)); return r; }

template <class Epi, class Sched, bool ALIGN_EPI, bool GATHER>
__device__ __forceinline__ void gemm_phase(PG8_LAS unsigned char* lds, const Gemm g, const Sched& S, const Epi& E) {
    const int tid = threadIdx.x, wid = __builtin_amdgcn_readfirstlane(tid >> 6), lane = tid & 63, wr = wid >> 2, wc = wid & 3, fr = lane & 15, fq = lane >> 4;
    constexpr int AUX_A = Sched::DEP ? 16 : 0;
    int K_ = g.K; asm volatile("" : "+s"(K_));
    const int K = K_, nt = K / BK;
    unsigned voffB[2]; int RA[2], CA[2];
#pragma unroll
    for (int i = 0; i < 2; ++i) { int R, C; stage_rc(tid * 16 + i * 8192, R, C); const int Rb = Epi::PERM ? ((R & ~31) + perm32(R & 31)) : R;
        RA[i] = R; CA[i] = C; voffB[i] = (unsigned)(Rb * K + C) * 2u; }
    const size_t kstep = (size_t)(BK * 2);
    const size_t hstep = (size_t)HALF * K * 2;
    const size_t tstep = 2 * hstep;
    const unsigned ldsw = (unsigned)wid * 1024u;
    const int aoff = lds_byte(wr * 64 + fr, fq * 8), boff = lds_byte(wc * 32 + fr, fq * 8);
    unsigned vA[2][2], vN[2][2];
    PG8_LAS int* rowl = (PG8_LAS int*)(lds + STAGE_BYTES);
    if constexpr (GATHER) {
        for (int i = 0; i < 4; ++i) { Unit uu; if (!S.next(i, uu)) break; if (tid < 256) { const int tk = (tid < uu.nvalid) ? (g.rowidx[(size_t)uu.lt * 256 + tid] >> 1) : 0; rowl[i * 256 + tid] = tk; ((PG8_LAS float*)(rowl + 1024))[i * 256 + tid] = g.rowscale[tk]; } }
        asm volatile("s_waitcnt vmcnt(0) lgkmcnt(0)" ::: "memory"); __builtin_amdgcn_s_barrier(); asm volatile("" ::: "memory");
    }
    auto compute_v = [&](const Unit& u, unsigned (&v)[2][2], int ui_) {
#pragma unroll
        for (int h = 0; h < 2; ++h)
#pragma unroll
            for (int i = 0; i < 2; ++i) {
                const int rl = h * HALF + RA[i];
                if constexpr (GATHER) { const int tok = rowl[ui_ * 256 + rl]; v[h][i] = ((unsigned)tok * (unsigned)K + (unsigned)CA[i]) * 2u; }
                else v[h][i] = ((unsigned)rl * (unsigned)K + (unsigned)CA[i]) * 2u;
            }
    };
#define PG8_SA(b, h) (((b) * 2 + (h)) * HTB)
#define PG8_SB(b, h) ((4 + (b) * 2 + (h)) * HTB)
#define PG8_STAGE_X(bufoff, gbase, voff, aux) do { _Pragma("unroll") for (int _i = 0; _i < 2; ++_i) \
        __builtin_amdgcn_global_load_lds((const unsigned*)((const char*)(gbase) + (voff)[_i]), (PG8_LAS unsigned*)(lds + (bufoff) + ldsw + _i * 8192), 16, 0, aux); } while (0)
#define PG8_STAGE(bufoff, gbase, voff) PG8_STAGE_X(bufoff, gbase, voff, 0)
#define PG8_STAGE_A(bufoff, gbase, voff) PG8_STAGE_X(bufoff, gbase, voff, AUX_A)
#define PG8_LDA(dst, b, h) do { _Pragma("unroll") for (int m = 0; m < 4; ++m) _Pragma("unroll") for (int k = 0; k < 2; ++k) dst[m][k] = *(const PG8_LAS bf16x8*)(lds + PG8_SA(b, h) + aoff + m * 2048 + k * 1024); } while (0)
#define PG8_LDB(dst, b, h) do { _Pragma("unroll") for (int n = 0; n < 2; ++n) _Pragma("unroll") for (int k = 0; k < 2; ++k) dst[n][k] = *(const PG8_LAS bf16x8*)(lds + PG8_SB(b, h) + boff + n * 2048 + k * 1024); } while (0)
#define PG8_MMA(ai, bj, At, Bt) do { __builtin_amdgcn_s_setprio(1); _Pragma("unroll") for (int m = 0; m < 4; ++m) _Pragma("unroll") for (int n = 0; n < 2; ++n) _Pragma("unroll") for (int k = 0; k < 2; ++k) \
        acc[ai][bj][m][n] = __builtin_amdgcn_mfma_f32_16x16x32_bf16(Bt[n][k], At[m][k], acc[ai][bj][m][n], 0, 0, 0); __builtin_amdgcn_s_setprio(0); } while (0)
#define PG8_WAIT_V(n) asm volatile("s_waitcnt vmcnt(" #n ")" ::: "memory")
#define PG8_WAIT_L(n) asm volatile("s_waitcnt lgkmcnt(" #n ")" ::: "memory")
#define PG8_BAR __builtin_amdgcn_s_barrier()
#define PG8_SCHED __builtin_amdgcn_sched_barrier(0)
    Unit cur, nxt; int ui = 0;
    if (!S.next(0, cur)) return;
    f32x4 acc[2][2][4][2];
#pragma unroll
    for (int a = 0; a < 2; ++a)
#pragma unroll
        for (int b = 0; b < 2; ++b)
#pragma unroll
            for (int m = 0; m < 4; ++m)
#pragma unroll
                for (int n = 0; n < 2; ++n) acc[a][b][m][n] = (f32x4){0.f, 0.f, 0.f, 0.f};
    bf16x8 At[4][2], B0[2][2], B1[2][2];
    if constexpr (Sched::DEP) { if (tid == 0) S.wait(cur); PG8_BAR; }
    compute_v(cur, vA, 0);
    const char* cA = (const char*)g.A + (GATHER ? (size_t)0 : (size_t)cur.pm * tstep); const char* cB = (const char*)g.Bt + (size_t)cur.pn * tstep;
    PG8_STAGE(PG8_SB(0, 0), cB, voffB); PG8_STAGE(PG8_SB(0, 1), cB + hstep, voffB); PG8_STAGE_A(PG8_SA(0, 0), cA, vA[0]); PG8_STAGE_A(PG8_SA(0, 1), cA, vA[1]);
    if (wr == 1) PG8_BAR;
    PG8_WAIT_V(2); PG8_BAR;
    PG8_STAGE(PG8_SB(1, 0), cB + kstep, voffB); PG8_STAGE_A(PG8_SA(1, 0), cA + kstep, vA[0]); PG8_STAGE(PG8_SB(1, 1), cB + hstep + kstep, voffB);
    PG8_WAIT_V(6); PG8_BAR;
    for (;;) {
        const bool has_next = S.next(ui + 1, nxt);
        if (has_next) compute_v(nxt, vN, ui + 1);
        else {
#pragma unroll
            for (int h = 0; h < 2; ++h)
#pragma unroll
                for (int i = 0; i < 2; ++i) vN[h][i] = vA[h][i];
        }
        const char* nA = has_next ? ((const char*)g.A + (GATHER ? (size_t)0 : (size_t)nxt.pm * tstep)) : cA; const char* nB = has_next ? (const char*)g.Bt + (size_t)nxt.pn * tstep : cB;
#pragma unroll 1
        for (int t = 0; t < nt; t += 2) {
            const bool last = (t == nt - 2);
            if constexpr (Sched::DEP) { if (last && has_next) { if (tid == 0) S.wait(nxt); PG8_BAR; } }
            const char* a1 = cA + (size_t)(t + 1) * kstep;
            const char* a2 = last ? nA : cA + (size_t)(t + 2) * kstep; const char* b2 = last ? nB : cB + (size_t)(t + 2) * kstep;
            const char* a3 = a2 + kstep; const char* b3 = b2 + kstep;
            unsigned vX0[2], vX1[2];
#pragma unroll
            for (int i = 0; i < 2; ++i) { vX0[i] = last ? vN[0][i] : vA[0][i]; vX1[i] = last ? vN[1][i] : vA[1][i]; }
            PG8_LDB(B0, 0, 0); PG8_LDB(B1, 0, 1); PG8_SCHED; PG8_LDA(At, 0, 0); PG8_STAGE_A(PG8_SA(1, 1), a1, vA[1]);
            PG8_WAIT_V(8); PG8_WAIT_L(0); PG8_BAR; PG8_MMA(0, 0, At, B0); PG8_MMA(0, 1, At, B1); PG8_BAR; PG8_SCHED;
            PG8_LDA(At, 0, 1); PG8_STAGE(PG8_SB(0, 0), b2, voffB); PG8_STAGE(PG8_SB(0, 1), b2 + hstep, voffB); PG8_STAGE_A(PG8_SA(0, 0), a2, vX0);
            PG8_WAIT_V(8); PG8_WAIT_L(0); PG8_BAR; PG8_MMA(1, 0, At, B0); PG8_MMA(1, 1, At, B1); PG8_BAR; PG8_SCHED;
            PG8_LDB(B0, 1, 0); PG8_LDB(B1, 1, 1); PG8_SCHED; PG8_LDA(At, 1, 0); PG8_STAGE_A(PG8_SA(0, 1), a2, vX1);
            PG8_WAIT_V(8); PG8_WAIT_L(0); PG8_BAR; PG8_MMA(0, 0, At, B0); PG8_MMA(0, 1, At, B1); PG8_BAR; PG8_SCHED;
            PG8_LDA(At, 1, 1); PG8_STAGE(PG8_SB(1, 0), b3, voffB); PG8_STAGE(PG8_SB(1, 1), b3 + hstep, voffB); PG8_STAGE_A(PG8_SA(1, 0), a3, vX0);
            PG8_WAIT_V(8); PG8_WAIT_L(0); PG8_BAR; PG8_MMA(1, 0, At, B0); PG8_MMA(1, 1, At, B1); PG8_BAR; PG8_SCHED;
        }
        if constexpr (ALIGN_EPI) { if (wr == 0) PG8_BAR; }
        if constexpr (GATHER) cur.pm = ui;
        E(acc, cur, wr, wc, fr, fq);
        if (!has_next) break;
        if constexpr (!Sched::KEEP_ACC) {
#pragma unroll
        for (int a = 0; a < 2; ++a)
#pragma unroll
            for (int b = 0; b < 2; ++b)
#pragma unroll
                for (int m = 0; m < 4; ++m)
#pragma unroll
                    for (int n = 0; n < 2; ++n) acc[a][b][m][n] = (f32x4){0.f, 0.f, 0.f, 0.f};
        }
        cur = nxt; cA = nA; cB = nB; ++ui;
#pragma unroll
        for (int h = 0; h < 2; ++h)
#pragma unroll
            for (int i = 0; i < 2; ++i) vA[h][i] = vN[h][i];
        if constexpr (ALIGN_EPI) { if (wr == 1) PG8_BAR; }
    }
    PG8_WAIT_V(0);
    if constexpr (!ALIGN_EPI) { if (wr == 0) PG8_BAR; }
    PG8_BAR;
#undef PG8_SA
#undef PG8_SB
#undef PG8_STAGE
#undef PG8_STAGE_X
#undef PG8_STAGE_A
#undef PG8_LDA
#undef PG8_LDB
#undef PG8_MMA
#undef PG8_WAIT_V
#undef PG8_WAIT_L
#undef PG8_BAR
#undef PG8_SCHED
}
}

constexpr int NWAVES = 8;
constexpr int M = 16384, D = 1024, SEQ = 2048, NBATCH = 8;
constexpr int NIN = 5144;
constexpr int NZ = 5120;
constexpr int ZC_R = 0, ZC_K = 512, ZC_V = 1024, ZC_W = 1536, ZC_Q = 1792, ZC_KC = 2304, ZC_VC = 2432, ZC_KS = 2560, ZC_VS = 2688, ZC_KW = 2816, ZC_VW = 2944, ZC_MR = 3072, ZC_MN = 4096;
constexpr float NORM_EPS = 1e-6f, GN_EPS = 64e-5f;

constexpr size_t MiB = 1u << 20;
constexpr size_t WS_CTL = 0, CTL_ZERO_BYTES = 64 * 1024;
constexpr size_t WS_LIST = 1 * MiB;
constexpr size_t WS_GATEA = 3 * MiB;
constexpr size_t WS_RSE = 4 * MiB;
constexpr size_t WS_SLOTA = 4 * MiB + 512 * 1024;
constexpr size_t WS_SELMASK = 5 * MiB;
constexpr size_t WS_ZGATE = 6 * MiB;
constexpr size_t WS_SMALLW = 8 * MiB;
constexpr size_t SW_W2T = 0, SW_A2T = 65536, SW_G2T = 131072, SW_CK1 = 262144, SW_CV1 = 524288, SW_CK2 = 786432, SW_CV2 = 794624, SW_GATEW = 802816, SW_ROUTEW = 868352;
constexpr size_t WS_KCMP = 10 * MiB;
constexpr size_t WS_VST = 11 * MiB, WS_VWT = 15 * MiB;
constexpr size_t WS_WIN = 19 * MiB, WS_UR = 29 * MiB, WS_UN = 30 * MiB, WS_WO = 31 * MiB, WS_WPP = 33 * MiB, WS_WPG = 34 * MiB, WS_WGU = 36 * MiB, WS_WD = 100 * MiB;
constexpr size_t WS_XN = 132 * MiB;
constexpr size_t WS_PBF = 164 * MiB;
constexpr size_t WS_Z = 172 * MiB;
constexpr size_t WS_S = 332 * MiB;
constexpr size_t WS_YRW = 428 * MiB, WS_YB = 444 * MiB, WS_G = 492 * MiB, WS_LOGITS = 508 * MiB  , WS_BONUS = 508 * MiB  , WS_END = 511 * MiB;
constexpr int CH_PP = 144, CH_P = 0, CH_R = 2304, CH_Q = 4608, CH_K = 6656, CH_G = 8704, CH_AC = 10752, CH_REC = 11008, CH_V = 11008, CH_SLOT = 11520;
constexpr int CW_CNT = 0;
constexpr int CW_PANEL = 8192;
constexpr int CW_DEP = 12288;
constexpr int CW_DEP2 = 4608;
constexpr int CW_BAR = 1024;
constexpr int MISC_OFF = 163840 - 64;

constexpr int LDS_BYTES = 163840;

#define GAS __attribute__((address_space(1)))
#define LAS __attribute__((address_space(3)))
typedef unsigned short bf16;
typedef unsigned v4u __attribute__((ext_vector_type(4)));
typedef unsigned v2u __attribute__((ext_vector_type(2)));
typedef float f32x4 __attribute__((ext_vector_type(4)));
typedef float f32x2 __attribute__((ext_vector_type(2)));
typedef short bf16x8 __attribute__((ext_vector_type(8)));
typedef short bf16x4 __attribute__((ext_vector_type(4)));
typedef __bf16 bf16x2_t __attribute__((ext_vector_type(2)));
#define LDS_WAIT() asm volatile("s_waitcnt lgkmcnt(0)" ::: "memory")
#define MFMA16(a, b, c) __builtin_amdgcn_mfma_f32_16x16x32_bf16((a), (b), (c), 0, 0, 0)

__device__ __forceinline__ float bf2f(unsigned short v) { return __uint_as_float((unsigned)v << 16); }
__device__ __forceinline__ unsigned pk2(float lo, float hi) { f32x2 v = {lo, hi}; bf16x2_t b = __builtin_convertvector(v, bf16x2_t); return __builtin_bit_cast(unsigned, b); }
__device__ __forceinline__ v2u pk4(f32x4 v) { v2u r; r.x = pk2(v.x, v.y); r.y = pk2(v.z, v.w); return r; }
__device__ __forceinline__ f32x4 unpk4(v2u w) { f32x4 r; r.x = __uint_as_float(w.x << 16); r.y = __uint_as_float(w.x & 0xffff0000u); r.z = __uint_as_float(w.y << 16); r.w = __uint_as_float(w.y & 0xffff0000u); return r; }
__device__ __forceinline__ void unpk8(v4u w, float (&f)[8]) { f[0] = __uint_as_float(w.x << 16); f[1] = __uint_as_float(w.x & 0xffff0000u); f[2] = __uint_as_float(w.y << 16); f[3] = __uint_as_float(w.y & 0xffff0000u);
    f[4] = __uint_as_float(w.z << 16); f[5] = __uint_as_float(w.z & 0xffff0000u); f[6] = __uint_as_float(w.w << 16); f[7] = __uint_as_float(w.w & 0xffff0000u); }
__device__ __forceinline__ float sigmoidf_(float x) { return __builtin_amdgcn_rcpf(1.0f + __expf(-x)); }
__device__ __forceinline__ float wave_sum(float v) {
#pragma unroll
    for (int o = 1; o < 64; o <<= 1) v += __shfl_xor(v, o);
    return v;
}
template <int CTRL> __device__ __forceinline__ float dppf(float x) { return __builtin_bit_cast(float, __builtin_amdgcn_update_dpp(0, __builtin_bit_cast(int, x), CTRL, 0xf, 0xf, false)); }
__device__ __forceinline__ float row16_sum(float x) { x += dppf<0x128>(x); x += dppf<0x124>(x); x += dppf<0x122>(x); x += dppf<0x121>(x); return x; }

typedef GAS unsigned gu32;
#define XB_TMO      128
#define XB_XCNT(j)  (256  + 64 * (j))
#define XB_XSUB(j)  (1280 + 64 * (j))
#define XB_XGEN(j)  (2304 + 64 * (j))
#define XB_TOP      3328
#define XB_TOPGEN   3392
#define XCD_BAR_WORDS 3456
#define XB_SPIN_CAP (1u << 18)

__device__ __forceinline__ unsigned xb_ld(unsigned* p)              { return __hip_atomic_load(p, __ATOMIC_RELAXED, __HIP_MEMORY_SCOPE_AGENT); }
__device__ __forceinline__ unsigned xb_add(unsigned* p, unsigned v) { return __hip_atomic_fetch_add(p, v, __ATOMIC_RELAXED, __HIP_MEMORY_SCOPE_AGENT); }
__device__ __forceinline__ unsigned xb_xcc_id() { return (unsigned)__builtin_amdgcn_s_getreg((3 << 11) | 20) & 0xFu; }
#define XB_SPIN(cond, bar) do { unsigned _sp = 0; while (cond) { __builtin_amdgcn_s_sleep(1); \
    if ((++_sp & 255u) == 0u) { if (xb_ld(&(bar)[XB_TMO])) break; if (_sp > XB_SPIN_CAP) { atomicAdd(&(bar)[XB_TMO], 1u); break; } } } } while (0)

struct XcdBarrier {
    unsigned* bar; unsigned x;
    volatile LAS unsigned* st;
};

__device__ __forceinline__ XcdBarrier xcd_barrier_post(unsigned* bar, volatile LAS unsigned* st) {
    XcdBarrier b; b.bar = bar; b.x = xb_xcc_id(); b.st = st;
    if (threadIdx.x == 0) (void)xb_add(&bar[XB_XCNT(b.x)], 1u);
    return b;
}
__device__ __forceinline__ void xcd_barrier_complete(unsigned* bar, unsigned x, unsigned& nloc, unsigned& nx) {
    const unsigned G = gridDim.x * gridDim.y * gridDim.z;
    unsigned sum, cnt, mine, sp = 0u;
    for (;;) {
        sum = 0u; cnt = 0u; mine = 0u;
#pragma unroll
        for (unsigned j = 0; j < 16; ++j) { const unsigned c = xb_ld(&bar[XB_XCNT(j)]); sum += c; cnt += (c > 0u) ? 1u : 0u; mine = (j == x) ? c : mine; }
        if (sum == G) break;
        __builtin_amdgcn_s_sleep(1);
        if ((++sp & 255u) == 0u) { if (xb_ld(&bar[XB_TMO])) break; if (sp > XB_SPIN_CAP) { atomicAdd(&bar[XB_TMO], 1u); break; } }
    }
    nloc = mine > 0u ? mine : 1u; nx = cnt > 0u ? cnt : 1u;
}

__device__ __forceinline__ void xcd_barrier(const XcdBarrier& b) {
    asm volatile("s_waitcnt vmcnt(0)" ::: "memory");
    __syncthreads();
    if (threadIdx.x == 0) {
        unsigned* bar = b.bar;
        __builtin_amdgcn_s_waitcnt(0);
        unsigned nloc = b.st[0], nx = b.st[1];
        if (nloc == 0u) { xcd_barrier_complete(bar, b.x, nloc, nx); b.st[0] = nloc; b.st[1] = nx; }
        const unsigned old = xb_add(&bar[XB_XSUB(b.x)], 1u);
        const unsigned gen = old / nloc;
        if (old + 1u == (gen + 1u) * nloc) {
            __builtin_amdgcn_fence(__ATOMIC_RELEASE, "agent");
            asm volatile("s_waitcnt vmcnt(0)" ::: "memory");
            const unsigned og = xb_add(&bar[XB_TOP], 1u);
            const unsigned tg = og / nx;
            if (og + 1u == (tg + 1u) * nx) xb_add(&bar[XB_TOPGEN], 1u);
            else XB_SPIN(xb_ld(&bar[XB_TOPGEN]) == tg, bar);
            __builtin_amdgcn_fence(__ATOMIC_ACQUIRE, "agent");
            xb_add(&bar[XB_XGEN(b.x)], 1u);
            asm volatile("s_waitcnt vmcnt(0)" ::: "memory");
        } else {
            XB_SPIN(xb_ld(&bar[XB_XGEN(b.x)]) == gen, bar);
            __builtin_amdgcn_fence(__ATOMIC_ACQUIRE, "agent");
            asm volatile("s_waitcnt vmcnt(0)" ::: "memory");
        }
    }
    __syncthreads();
}

struct Args { const float* in[37]; float* out; unsigned char* ws; int ph_lo, ph_hi, rep_mask, pad; };
typedef __attribute__((address_space(4))) const Args* ArgsP;
struct Frame {
    LAS unsigned char* lds;
    int tid, lane, wave, vcu, G, gw, NGW;
    unsigned char* ws;
    ArgsP ap;
    float* out;
};

struct TrDesc { const float* W; bf16* T; bf16* T2; const float* gain; int K, ld, nc, item, mode; };
__device__ __forceinline__ void tr_load(const TrDesc& d, int lane, float (&tv)[32], f32x4 (&gn)[2]) {
    const int nblk = (d.nc + 31) / 32, kb = d.item / nblk, nb = d.item % nblk, k0 = 64 * kb, n0 = 32 * nb;
    const int nn = n0 + (lane & 31);
    gn[0] = (f32x4){1.f, 1.f, 1.f, 1.f}; gn[1] = gn[0];
    if (d.gain) { const float* gp = d.gain + k0 + 8 * (lane & 7); gn[0] = *(const f32x4*)gp; gn[1] = *(const f32x4*)(gp + 4); }
    const float* wsrc = d.W + (size_t)(k0 + (lane >> 5)) * d.ld + (nn < d.nc ? nn : 0);
#pragma unroll
    for (int i = 0; i < 32; ++i) tv[i] = wsrc[(size_t)(2 * i) * d.ld];
}
__device__ __forceinline__ void tr_finish(const TrDesc& d, LAS float* scr, int lane, const float (&tv)[32], const f32x4 (&gn)[2]) {
    const int nblk = (d.nc + 31) / 32, kb = d.item / nblk, nb = d.item % nblk, k0 = 64 * kb, n0 = 32 * nb;
#pragma unroll
    for (int i = 0; i < 32; ++i) scr[(2 * i + (lane >> 5)) * 33 + (lane & 31)] = tv[i];
    LDS_WAIT(); asm volatile("" ::: "memory");
    const int c = lane & 7;
#pragma unroll
    for (int j = 0; j < 4; ++j) { const int nl = (lane >> 3) + 8 * j, n = n0 + nl; const LAS float* s = scr + (8 * c) * 33 + nl;
        v4u o; o.x = pk2(s[0 * 33] * gn[0].x, s[1 * 33] * gn[0].y); o.y = pk2(s[2 * 33] * gn[0].z, s[3 * 33] * gn[0].w); o.z = pk2(s[4 * 33] * gn[1].x, s[5 * 33] * gn[1].y); o.w = pk2(s[6 * 33] * gn[1].z, s[7 * 33] * gn[1].w);
        if (n < d.nc) { bf16* rp;
            if (d.mode == 1) rp = n < 3072 ? d.T + (size_t)n * 1024 : (n < 3096 ? d.T2 + (size_t)(n - 3072) * 1024 : d.T + (size_t)(n - 24) * 1024);
            else if (d.mode == 2) { const int n2 = n & 511; rp = d.T + (size_t)((n2 >> 7) * 256 + (n >> 9) * 128 + (n2 & 127)) * 1024; }
            else rp = d.T + (size_t)n * d.K;
            *(v4u*)(rp + k0 + 8 * c) = o; } }
    LDS_WAIT(); asm volatile("" ::: "memory");
}
__device__ __forceinline__ void rms_row_to_bf16(int lane, const float* xrow, const float* gain, bf16* orow) {
    const f32x4* xr = (const f32x4*)xrow + lane; const f32x4* gr = (const f32x4*)gain + lane;
    f32x4 v[4]; float s = 0.f;
#pragma unroll
    for (int j = 0; j < 4; ++j) { v[j] = xr[64 * j]; s += (v[j].x * v[j].x + v[j].y * v[j].y) + (v[j].z * v[j].z + v[j].w * v[j].w); }
    const float rs = 1.0f / sqrtf(wave_sum(s) * (1.f / D) + NORM_EPS);
    v2u* o8 = (v2u*)orow + lane;
#pragma unroll
    for (int j = 0; j < 4; ++j) { const f32x4 g = gr[64 * j]; o8[64 * j] = pk4(v[j] * rs * g); }
}

namespace tri {
constexpr int I_WIN = 16 * 161, I_UR = 8 * 32, I_WO = 16 * 32, I_WPP = 4 * 32, I_L64 = 16, I_L128 = 32, I_C1 = 32 * 2, I_C2 = 2, I_GU = 16 * 32, I_DN = 8 * 32;
constexpr int E0 = I_WIN, E1 = E0 + I_UR, E2 = E1 + I_UR, E3 = E2 + I_WO, E4 = E3 + I_WPP, E5 = E4 + I_WO, E6 = E5 + I_L64, E7 = E6 + I_L64, E8 = E7 + I_L128, E9 = E8 + I_C1, E10 = E9 + I_C1, E11 = E10 + I_C2, E12 = E11 + I_C2,
              E13 = E12 + 32 * I_GU, NITEMS = E13 + 32 * I_DN;
}
__device__ __forceinline__ TrDesc tr_desc(Frame& F, int it) {
    using namespace tri;
    unsigned char* ws = F.ws;
    const float* W; const float* gain = nullptr; int K, ld, nc, item, mode = 0; size_t dst;
    if (it < E0) { W = F.ap->in[3]; K = 1024; ld = NIN; nc = NIN; item = it; mode = 1; dst = WS_WIN; }
    else if (it < E1) { W = F.ap->in[22]; K = 512; ld = 1024; nc = 1024; item = it - E0; dst = WS_UR; }
    else if (it < E2) { W = F.ap->in[23]; K = 512; ld = 1024; nc = 1024; item = it - E1; dst = WS_UN; }
    else if (it < E3) { W = F.ap->in[24]; K = 1024; ld = 1024; nc = 1024; item = it - E2; dst = WS_WO; }
    else if (it < E4) { W = F.ap->in[32]; K = 256; ld = 1024; nc = 1024; item = it - E3; dst = WS_WPP; }
    else if (it < E5) { W = F.ap->in[35]; K = 1024; ld = 1024; nc = 1024; item = it - E4; dst = WS_WPG; gain = F.ap->in[34]; }
    else if (it < E6) { W = F.ap->in[6]; K = 64; ld = 512; nc = 512; item = it - E5; dst = WS_SMALLW + SW_W2T; }
    else if (it < E7) { W = F.ap->in[8]; K = 64; ld = 512; nc = 512; item = it - E6; dst = WS_SMALLW + SW_A2T; }
    else if (it < E8) { W = F.ap->in[9]; K = 128; ld = 512; nc = 512; item = it - E7; dst = WS_SMALLW + SW_G2T; }
    else if (it < E9) { W = F.ap->in[17]; K = 2048; ld = 64; nc = 64; item = it - E8; dst = WS_SMALLW + SW_CK1; }
    else if (it < E10) { W = F.ap->in[19]; K = 2048; ld = 64; nc = 64; item = it - E9; dst = WS_SMALLW + SW_CV1; }
    else if (it < E11) { W = F.ap->in[18]; K = 64; ld = 64; nc = 64; item = it - E10; dst = WS_SMALLW + SW_CK2; }
    else if (it < E12) { W = F.ap->in[20]; K = 64; ld = 64; nc = 64; item = it - E11; dst = WS_SMALLW + SW_CV2; }
    else if (it < E13) { const int r = it - E12, e = r / I_GU; W = F.ap->in[30] + (size_t)e * 1024 * 1024; K = 1024; ld = 1024; nc = 1024; item = r % I_GU; mode = 2; dst = WS_WGU + (size_t)e * 1024 * 1024 * 2; gain = F.ap->in[25]; }
    else { const int r = it - E13, e = r / I_DN; W = F.ap->in[31] + (size_t)e * 512 * 1024; K = 512; ld = 1024; nc = 1024; item = r % I_DN; dst = WS_WD + (size_t)e * 1024 * 512 * 2; }
    return TrDesc{W, (bf16*)(ws + dst), (bf16*)(ws + WS_SMALLW + SW_GATEW), gain, K, ld, nc, item, mode};
}
__device__ __forceinline__ void tr_run(Frame& F, LAS float* scr, int it0, int stride, int it_end) {
    if (it0 >= it_end) return;
    float tvA[32], tvB[32]; f32x4 gnA[2], gnB[2];
    int it = it0; TrDesc cur = tr_desc(F, it); tr_load(cur, F.lane, tvA, gnA);
    for (;;) {
        const int nxt = it + stride; const bool has = nxt < it_end; TrDesc dn = cur;
        if (has) { dn = tr_desc(F, nxt); tr_load(dn, F.lane, tvB, gnB); }
        __builtin_amdgcn_sched_barrier(0);
        tr_finish(cur, scr, F.lane, tvA, gnA);
        if (!has) break;
        cur = dn; it = nxt;
#pragma unroll
        for (int i = 0; i < 32; ++i) tvA[i] = tvB[i];
        gnA[0] = gnB[0]; gnA[1] = gnB[1];
    }
}
__device__ __forceinline__ int tr_qnext(LAS int* qh) {
    int k = 0; const unsigned a = (unsigned)(size_t)qh; const int one = 1;
    if (__builtin_amdgcn_mbcnt_hi(~0u, __builtin_amdgcn_mbcnt_lo(~0u, 0u)) == 0) asm volatile("ds_add_rtn_u32 %0, %1, %2\n\ts_waitcnt lgkmcnt(0)" : "=&v"(k) : "v"(a), "v"(one) : "memory");
    return __builtin_amdgcn_readfirstlane(k);
}
__device__ __forceinline__ void tr_run_q(Frame& F, LAS float* scr, LAS int* qh, int base, int stride, int nk) {
    int k = tr_qnext(qh); if (k >= nk) return;
    float tvA[32], tvB[32]; f32x4 gnA[2], gnB[2];
    TrDesc cur = tr_desc(F, base + k * stride); tr_load(cur, F.lane, tvA, gnA);
    for (;;) {
        const int kn = tr_qnext(qh); const bool has = kn < nk; TrDesc dn = cur;
        if (has) { dn = tr_desc(F, base + kn * stride); tr_load(dn, F.lane, tvB, gnB); }
        __builtin_amdgcn_sched_barrier(0);
        tr_finish(cur, scr, F.lane, tvA, gnA);
        if (!has) break;
        cur = dn;
#pragma unroll
        for (int i = 0; i < 32; ++i) tvA[i] = tvB[i];
        gnA[0] = gnB[0]; gnA[1] = gnB[1];
    }
}
#ifndef MK_EXPERTS_IN_SCAN
#define MK_EXPERTS_IN_SCAN 1
#endif
__device__ __forceinline__ void p0_prologue(Frame& F) {
    LAS float* scr = (LAS float*)(F.lds + F.wave * 16384);
    unsigned char* ws = F.ws;
    bf16* gateWT = (bf16*)(ws + WS_SMALLW + SW_GATEW);
    tr_run(F, scr, F.gw, F.NGW, MK_EXPERTS_IN_SCAN ? tri::E12 : tri::NITEMS);
    for (int mb = F.gw; mb < M; mb += 4 * F.NGW) {
        f32x4 v[4][4]; float s[4];
#pragma unroll
        for (int u = 0; u < 4; ++u) { const f32x4* xr = (const f32x4*)(F.ap->in[0] + (size_t)(mb + u * F.NGW) * D) + F.lane;
#pragma unroll
            for (int j = 0; j < 4; ++j) v[u][j] = xr[64 * j]; }
#pragma unroll
        for (int u = 0; u < 4; ++u) { s[u] = 0.f;
#pragma unroll
            for (int j = 0; j < 4; ++j) s[u] += (v[u][j].x * v[u][j].x + v[u][j].y * v[u][j].y) + (v[u][j].z * v[u][j].z + v[u][j].w * v[u][j].w); }
#pragma unroll
        for (int o = 1; o < 64; o <<= 1) {
#pragma unroll
            for (int u = 0; u < 4; ++u) s[u] += __shfl_xor(s[u], o); }
        const f32x4* gr = (const f32x4*)F.ap->in[2] + F.lane;
#pragma unroll
        for (int u = 0; u < 4; ++u) { const float rs = 1.0f / sqrtf(s[u] * (1.f / D) + NORM_EPS); v2u* o8 = (v2u*)((bf16*)(ws + WS_XN) + (size_t)(mb + u * F.NGW) * D) + F.lane;
#pragma unroll
            for (int j = 0; j < 4; ++j) o8[64 * j] = pk4(v[u][j] * rs * gr[64 * j]); }
    }
    {
        float* RW = (float*)(ws + WS_SMALLW + SW_ROUTEW); const float* gf = F.ap->in[25]; const float* wg = F.ap->in[26]; const float* wr = F.ap->in[28];
        for (int idx = F.gw * 64 + F.lane; idx < 48 * 1024; idx += F.NGW * 64) { const int c = idx >> 10, k = idx & 1023; float v = 0.f;
            if (c < 4) v = wg[k * 4 + c]; else if (c < 36) v = wr[k * 32 + (c - 4)];
            RW[idx] = v * gf[k]; }
        for (int idx = F.gw * 64 + F.lane; idx < 8 * 1024; idx += F.NGW * 64) gateWT[24 * 1024 + idx] = 0;
    }
}

struct EpiStoreBf16 {
    static constexpr bool PERM = true;
    bf16* O; int ldc;
    __device__ __forceinline__ void operator()(const f32x4 (&acc)[2][2][4][2], const pg8::Unit& u, int wr, int wc, int fr, int fq) const {
        const int row0 = u.pmo * 256 + wr * 64 + fr, col0 = u.pnl * 256 + wc * 32 + 8 * fq;
#pragma unroll
        for (int ai = 0; ai < 2; ++ai)
#pragma unroll
            for (int m = 0; m < 4; ++m) { bf16* rowp = O + (size_t)(row0 + ai * 128 + m * 16) * ldc + col0;
#pragma unroll
                for (int bj = 0; bj < 2; ++bj) { const f32x4 v0 = acc[ai][bj][m][0], v1 = acc[ai][bj][m][1]; v4u w; w.x = pk2(v0[0], v0[1]); w.y = pk2(v0[2], v0[3]); w.z = pk2(v1[0], v1[1]); w.w = pk2(v1[2], v1[3]);
                    *(v4u*)(rowp + bj * 128) = w; } }
    }
};
struct EpiStoreSsq {
    static constexpr bool PERM = true;
    bf16* O; int ldc; float* part;
    __device__ __forceinline__ void operator()(const f32x4 (&acc)[2][2][4][2], const pg8::Unit& u, int wr, int wc, int fr, int fq) const {
        const int row0 = u.pmo * 256 + wr * 64 + fr, col0 = u.pnl * 256 + wc * 32 + 8 * fq;
#pragma unroll
        for (int ai = 0; ai < 2; ++ai)
#pragma unroll
            for (int m = 0; m < 4; ++m) { bf16* rowp = O + (size_t)(row0 + ai * 128 + m * 16) * ldc + col0; float ss = 0.f;
#pragma unroll
                for (int bj = 0; bj < 2; ++bj) { const f32x4 v0 = acc[ai][bj][m][0], v1 = acc[ai][bj][m][1]; v4u w; w.x = pk2(v0[0], v0[1]); w.y = pk2(v0[2], v0[3]); w.z = pk2(v1[0], v1[1]); w.w = pk2(v1[2], v1[3]);
                    *(v4u*)(rowp + bj * 128) = w;
                    ss += ((v0[0] * v0[0] + v0[1] * v0[1]) + (v0[2] * v0[2] + v0[3] * v0[3])) + ((v1[0] * v1[0] + v1[1] * v1[1]) + (v1[2] * v1[2] + v1[3] * v1[3])); }
                ss += __shfl_xor(ss, 16); ss += __shfl_xor(ss, 32);
                if (fq == 0) part[(size_t)(row0 + ai * 128 + m * 16) * 16 + u.pnl * 4 + wc] = ss; }
    }
};
#define EPI_LOOP_BEGIN \
    _Pragma("unroll") for (int ai = 0; ai < 2; ++ai) _Pragma("unroll") for (int m = 0; m < 4; ++m) { if (m == 0 || m == 2) asm volatile("" ::: "memory"); const int rl = ai * 128 + wr * 64 + m * 16 + fr; const size_t row = (size_t)u.pmo * 256 + rl; (void)row; \
    _Pragma("unroll") for (int bj = 0; bj < 2; ++bj) _Pragma("unroll") for (int n = 0; n < 2; ++n) { const int col = u.pnl * 256 + bj * 128 + wc * 32 + n * 16 + 4 * fq; (void)col; const f32x4 a = acc[ai][bj][m][n];
#define EPI_LOOP_END } }
struct EpiMix {
    static constexpr bool PERM = false;
    const bf16* z; bf16* A; bf16* O;
    __device__ __forceinline__ void operator()(const f32x4 (&acc)[2][2][4][2], const pg8::Unit& u, int wr, int wc, int fr, int fq) const {
        const int zc = u.lt ? ZC_MN : ZC_MR;
        EPI_LOOP_BEGIN
            const f32x4 zz = unpk4(*(const v2u*)(z + row * NZ + zc + col)); f32x4 o;
            o.x = sigmoidf_(zz.x) * a.x; o.y = sigmoidf_(zz.y) * a.y; o.z = sigmoidf_(zz.z) * a.z; o.w = sigmoidf_(zz.w) * a.w;
            if (u.lt == 0) *(v2u*)(A + row * D + col) = pk4(o);
            else { o = o + unpk4(*(const v2u*)(A + row * D + col)); *(v2u*)(O + row * D + col) = pk4(o); }
        EPI_LOOP_END
    }
};
struct StaticOrderDep {
    static constexpr bool DEP = true, KEEP_ACC = false;
    pg8::StaticOrder S; const unsigned* dep;
    __device__ bool next(int i, pg8::Unit& u) const { return S.next(i, u); }
    __device__ void wait(const pg8::Unit& u) const {
        const unsigned* p = dep + 16 * u.pm; unsigned sp = 0;
        while (__hip_atomic_load(p, __ATOMIC_RELAXED, __HIP_MEMORY_SCOPE_AGENT) < 4u) { __builtin_amdgcn_s_sleep(2); if (++sp > (1u << 22)) break; }
        asm volatile("s_waitcnt vmcnt(0)" ::: "memory");
    }
};
struct EpiMix2 {
    static constexpr bool PERM = true;
    const bf16* z; bf16* O; unsigned* dep;
    __device__ __forceinline__ void operator()(const f32x4 (&acc_)[2][2][4][2], const pg8::Unit& u, int wr, int wc, int fr, int fq) const {
        f32x4 (&acc)[2][2][4][2] = const_cast<f32x4 (&)[2][2][4][2]>(acc_);
        const int row0 = u.pmo * 256 + wr * 64 + fr, col0 = u.pnl * 256 + wc * 32 + 8 * fq;
#pragma unroll
        for (int ai = 0; ai < 2; ++ai)
#pragma unroll
            for (int m = 0; m < 4; ++m) { if (m == 0 || m == 2) asm volatile("" ::: "memory"); const size_t row = (size_t)(row0 + ai * 128 + m * 16); const bf16* zr = z + row * NZ + col0;
#pragma unroll
                for (int bj = 0; bj < 2; ++bj) {
                    float b[8]; unpk8(*(const v4u*)(zr + ZC_MN + bj * 128), b);
                    if (u.lt == 0) { float a[8]; unpk8(*(const v4u*)(zr + ZC_MR + bj * 128), a);
#pragma unroll
                        for (int j = 0; j < 8; ++j) acc[ai][bj][m][j >> 2][j & 3] *= (1.0f + __expf(-fmaxf(b[j], -60.f))) * __builtin_amdgcn_rcpf(1.0f + __expf(-a[j])); }
                    else { float o[8];
#pragma unroll
                        for (int j = 0; j < 8; ++j) o[j] = acc[ai][bj][m][j >> 2][j & 3] * __builtin_amdgcn_rcpf(1.0f + __expf(-fmaxf(b[j], -60.f)));
                        v4u w; w.x = pk2(o[0], o[1]); w.y = pk2(o[2], o[3]); w.z = pk2(o[4], o[5]); w.w = pk2(o[6], o[7]);
                        { bf16* op = O + row * D + col0 + bj * 128; asm volatile("global_store_dwordx4 %0, %1, off sc1" :: "v"(op), "v"(w) : "memory"); } } } }
        if (u.lt != 0) { asm volatile("s_waitcnt vmcnt(0)" ::: "memory"); __builtin_amdgcn_s_barrier(); asm volatile("" ::: "memory");
            if (threadIdx.x == 0) __hip_atomic_fetch_add(dep + 16 * u.pmo, 1u, __ATOMIC_RELAXED, __HIP_MEMORY_SCOPE_AGENT); }
    }
};
struct ErawOrder {
    static constexpr bool DEP = false, KEEP_ACC = false;
    pg8::StaticOrder S; int c, G, nheavy;
    __device__ bool next(int i, pg8::Unit& u) const { const int nl = G - nheavy, l = c - nheavy; if (l < 0) return false; const int q = l + i * nl; if (q >= S.nwg) return false;
        pg8::StaticOrder T = S; T.c = q; T.G = S.nwg + 1; return T.next(0, u); }
};
struct DualOrder {
    static constexpr bool DEP = false, KEEP_ACC = true;
    pg8::StaticOrder S;
    __device__ bool next(int i, pg8::Unit& u) const { if (i >= 2) return false; if (!S.next(0, u)) return false; if (i == 1) { u.pm += 64; u.pn += 4; } u.lt = i; return true; }
};
struct EpiResBf16 {
    static constexpr bool PERM = true;
    const float* base; bf16* O;
    __device__ __forceinline__ void operator()(const f32x4 (&acc)[2][2][4][2], const pg8::Unit& u, int wr, int wc, int fr, int fq) const {
        const int row0 = u.pmo * 256 + wr * 64 + fr, col0 = u.pnl * 256 + wc * 32 + 8 * fq;
#pragma unroll
        for (int ai = 0; ai < 2; ++ai)
#pragma unroll
            for (int m = 0; m < 4; ++m) { if (m == 0 || m == 2) asm volatile("" ::: "memory"); const size_t ro = (size_t)(row0 + ai * 128 + m * 16) * D + col0;
#pragma unroll
                for (int bj = 0; bj < 2; ++bj) { const f32x4 v0 = acc[ai][bj][m][0] + *(const f32x4*)(base + ro + bj * 128), v1 = acc[ai][bj][m][1] + *(const f32x4*)(base + ro + bj * 128 + 4);
                    v4u w; w.x = pk2(v0[0], v0[1]); w.y = pk2(v0[2], v0[3]); w.z = pk2(v1[0], v1[1]); w.w = pk2(v1[2], v1[3]);
                    *(v4u*)(O + ro + bj * 128) = w; } }
    }
};
struct EpiResF32 {
    static constexpr bool PERM = false;
    const float* base; float* O;
    __device__ __forceinline__ void operator()(const f32x4 (&acc)[2][2][4][2], const pg8::Unit& u, int wr, int wc, int fr, int fq) const {
        EPI_LOOP_BEGIN
            *(f32x4*)(O + row * D + col) = *(const f32x4*)(base + row * D + col) + a;
        EPI_LOOP_END
    }
};
struct EpiMoe1 {
    static constexpr bool PERM = false;
    bf16* H; const LAS float* rsl; unsigned* dep;
    __device__ __forceinline__ void operator()(const f32x4 (&acc)[2][2][4][2], const pg8::Unit& u, int wr, int wc, int fr, int fq) const {
#pragma unroll
        for (int ai = 0; ai < 2; ++ai)
#pragma unroll
            for (int m = 0; m < 4; ++m) { const int rl = ai * 128 + wr * 64 + m * 16 + fr; const size_t row = (size_t)u.pmo * 256 + rl; const float rs = rsl[u.pm * 256 + rl];
#pragma unroll
                for (int n = 0; n < 2; ++n) { const f32x4 gt = acc[ai][0][m][n] * rs, up = acc[ai][1][m][n] * rs; f32x4 o;
                    o.x = gt.x * sigmoidf_(gt.x) * up.x; o.y = gt.y * sigmoidf_(gt.y) * up.y; o.z = gt.z * sigmoidf_(gt.z) * up.z; o.w = gt.w * sigmoidf_(gt.w) * up.w;
                    { bf16* hp = H + row * 512 + u.pnl * 128 + wc * 32 + n * 16 + 4 * fq; const v2u hv = pk4(o); asm volatile("global_store_dwordx2 %0, %1, off sc1" :: "v"(hp), "v"(hv) : "memory"); } } }
        asm volatile("s_waitcnt vmcnt(0)" ::: "memory"); __builtin_amdgcn_s_barrier(); asm volatile("" ::: "memory");
        if (threadIdx.x == 0) __hip_atomic_fetch_add(dep + 16 * u.pmo, 1u, __ATOMIC_RELAXED, __HIP_MEMORY_SCOPE_AGENT);
    }
};
struct EpiPle {
    static constexpr bool PERM = false;
    const bf16* x2; const bf16* Eraw; const float* rse; const float* gpn; bf16* O;
    __device__ __forceinline__ void operator()(const f32x4 (&acc)[2][2][4][2], const pg8::Unit& u, int wr, int wc, int fr, int fq) const {
        EPI_LOOP_BEGIN
            const f32x4 e = unpk4(*(const v2u*)(Eraw + row * D + col)); const f32x4 g = *(const f32x4*)(gpn + col); const float rs = rse[row]; f32x4 o = unpk4(*(const v2u*)(x2 + row * D + col));
            o.x += sigmoidf_(a.x) * e.x * rs * g.x; o.y += sigmoidf_(a.y) * e.y * rs * g.y; o.z += sigmoidf_(a.z) * e.z * rs * g.z; o.w += sigmoidf_(a.w) * e.w * rs * g.w;
            *(v2u*)(O + row * D + col) = pk4(o);
        EPI_LOOP_END
    }
};

struct EpiPleNorm {
    static constexpr bool PERM = false;
    const bf16* x2; const bf16* Eraw; const float* rse; const float* gpn; const float* rs3; const float* gfin; float* out; float* xbuf; unsigned* cnt; LAS float* ldsx;
    __device__ __forceinline__ void operator()(const f32x4 (&acc_)[2][2][4][2], const pg8::Unit& u_, int wr, int wc, int fr, int fq) const {
        f32x4 (&acc)[2][2][4][2] = const_cast<f32x4 (&)[2][2][4][2]>(acc_);
        pg8::Unit u = u_; asm volatile("" : "+s"(u.pmo), "+s"(u.pnl)); asm volatile("" : "+v"(fr), "+v"(fq)); asm volatile("" : "+s"(wr), "+s"(wc));
        int tid = threadIdx.x; asm volatile("" : "+v"(tid)); const int lane = tid & 63, wid = __builtin_amdgcn_readfirstlane(tid >> 6);
        LAS float* Pl = ldsx; LAS float* Sl = ldsx + 1024; LAS unsigned* flag = (LAS unsigned*)(ldsx + 1280);
#pragma unroll
        for (int ai = 0; ai < 2; ++ai)
#pragma unroll
            for (int m = 0; m < 4; ++m) { if (m == 0 || m == 2) asm volatile("" ::: "memory"); const int rl = ai * 128 + wr * 64 + m * 16 + fr; const size_t row = (size_t)u.pmo * 256 + rl;
                float ss = 0.f; const float r3 = rs3[row], re = rse[row];
#pragma unroll
                for (int bj = 0; bj < 2; ++bj)
#pragma unroll
                    for (int n = 0; n < 2; ++n) { const int col = u.pnl * 256 + bj * 128 + wc * 32 + n * 16 + 4 * fq; const f32x4 a = acc[ai][bj][m][n];
                        const f32x4 e = unpk4(*(const v2u*)(Eraw + row * D + col)) * re * *(const f32x4*)(gpn + col); f32x4 o = unpk4(*(const v2u*)(x2 + row * D + col));
                        o.x += sigmoidf_(a.x * r3) * e.x; o.y += sigmoidf_(a.y * r3) * e.y; o.z += sigmoidf_(a.z * r3) * e.z; o.w += sigmoidf_(a.w * r3) * e.w;
                        acc[ai][bj][m][n] = o; ss += (o.x * o.x + o.y * o.y) + (o.z * o.z + o.w * o.w); }
                ss += __shfl_xor(ss, 16); ss += __shfl_xor(ss, 32);
                if (fq == 0) Pl[rl * 4 + wc] = ss; }
        asm volatile("s_waitcnt lgkmcnt(0)" ::: "memory"); __builtin_amdgcn_s_barrier(); asm volatile("" ::: "memory");
        if (tid < 256) { const float tot = (Pl[tid * 4 + 0] + Pl[tid * 4 + 1]) + (Pl[tid * 4 + 2] + Pl[tid * 4 + 3]);
            __hip_atomic_store(xbuf + ((size_t)u.pmo * 256 + tid) * 4 + u.pnl, tot, __ATOMIC_RELAXED, __HIP_MEMORY_SCOPE_AGENT);
            asm volatile("s_waitcnt vmcnt(0)" ::: "memory");
            if (lane == 0) __hip_atomic_fetch_add(cnt + 64 * u.pmo, 1u, __ATOMIC_RELAXED, __HIP_MEMORY_SCOPE_AGENT); }
        if (wid == 0) {
            unsigned spins = 0;
            while ((unsigned)__builtin_amdgcn_readfirstlane((int)__hip_atomic_load(cnt + 64 * u.pmo, __ATOMIC_RELAXED, __HIP_MEMORY_SCOPE_AGENT)) < 16u) { __builtin_amdgcn_s_sleep(2); if (++spins > (1u << 22)) break; }
            __builtin_amdgcn_fence(__ATOMIC_ACQUIRE, "agent");
            if (lane == 0) flag[0] = 1u; }
        asm volatile("s_waitcnt vmcnt(0) lgkmcnt(0)" ::: "memory"); __builtin_amdgcn_s_barrier(); asm volatile("" ::: "memory");
        if (tid < 256) { const float* sp = xbuf + ((size_t)u.pmo * 256 + tid) * 4; float tot = 0.f;
#pragma unroll
            for (int t = 0; t < 4; ++t) tot += __hip_atomic_load(sp + t, __ATOMIC_RELAXED, __HIP_MEMORY_SCOPE_AGENT);
            Sl[tid] = 1.0f / sqrtf(tot * (1.f / D) + NORM_EPS); }
        asm volatile("s_waitcnt vmcnt(0) lgkmcnt(0)" ::: "memory"); __builtin_amdgcn_s_barrier(); asm volatile("" ::: "memory");
#pragma unroll
        for (int ai = 0; ai < 2; ++ai)
#pragma unroll
            for (int m = 0; m < 4; ++m) { const int rl = ai * 128 + wr * 64 + m * 16 + fr; const size_t row = (size_t)u.pmo * 256 + rl; const float rs = Sl[rl];
#pragma unroll
                for (int bj = 0; bj < 2; ++bj)
#pragma unroll
                    for (int n = 0; n < 2; ++n) { const int col = u.pnl * 256 + bj * 128 + wc * 32 + n * 16 + 4 * fq; *(f32x4*)(out + row * D + col) = acc[ai][bj][m][n] * rs * *(const f32x4*)(gfin + col); } }
    }
};

__device__ __forceinline__ float gelu_tanh(float x) { const float u = 0.7978845608028654f * (x + 0.044715f * x * x * x); const float t = 1.0f - 2.0f * __builtin_amdgcn_rcpf(__expf(2.0f * u) + 1.0f); return 0.5f * x * (1.0f + t); }

__device__ __forceinline__ void compress_wg_task(Frame& F, int idx) {
    const int kv = idx & 1, tile8 = (idx >> 1) & 7, bg = idx >> 4, b = bg >> 1, g = bg & 1;
    const int fr = F.lane & 15, fq = F.lane >> 4;
    const bf16* z = (const bf16*)(F.ws + WS_Z);
    const bf16* w1T = (const bf16*)(F.ws + WS_SMALLW + (kv ? SW_CV1 : SW_CK1));
    const bf16* w2T = (const bf16*)(F.ws + WS_SMALLW + (kv ? SW_CV2 : SW_CK2));
    const float* pos = kv ? F.ap->in[16] : F.ap->in[15];
    const int j0 = 16 * tile8; int j = j0 + fr; const bool jvalid = j < 127; if (!jvalid) j = 126;
    const bf16* zb = z + ((size_t)b * SEQ + 16 * j) * NZ + (kv ? ZC_VC : ZC_KC) + g * 64;
    v4u zr[8]; f32x4 p0[8], p1[8]; bf16x8 aop[8][4];
#pragma unroll
    for (int i = 0; i < 8; ++i) { const int ks = 8 * F.wave + i, l = ks >> 1, d = 32 * (ks & 1) + 8 * fq;
        zr[i] = *(const v4u*)(zb + (size_t)l * NZ + d); p0[i] = *(const f32x4*)(pos + l * 64 + d); p1[i] = *(const f32x4*)(pos + l * 64 + d + 4);
#pragma unroll
        for (int mt = 0; mt < 4; ++mt) aop[i][mt] = *(const bf16x8*)(w1T + (size_t)(16 * mt + fr) * 2048 + 32 * ks + 8 * fq); }
    f32x4 acc[4];
#pragma unroll
    for (int mt = 0; mt < 4; ++mt) acc[mt] = (f32x4){0.f, 0.f, 0.f, 0.f};
#pragma unroll
    for (int i = 0; i < 8; ++i) {
        float f[8]; unpk8(zr[i], f);
        v4u bb; bb.x = pk2(f[0] + p0[i].x, f[1] + p0[i].y); bb.y = pk2(f[2] + p0[i].z, f[3] + p0[i].w); bb.z = pk2(f[4] + p1[i].x, f[5] + p1[i].y); bb.w = pk2(f[6] + p1[i].z, f[7] + p1[i].w);
        const bf16x8 bop = __builtin_bit_cast(bf16x8, bb);
#pragma unroll
        for (int mt = 0; mt < 4; ++mt) acc[mt] = MFMA16(aop[i][mt], bop, acc[mt]);
    }
    LAS float* red = (LAS float*)F.lds;
    __syncthreads();
#pragma unroll
    for (int mt = 0; mt < 4; ++mt) *(LAS f32x4*)(red + ((F.wave * 4 + mt) * 64 + F.lane) * 4) = acc[mt];
    LDS_WAIT(); __syncthreads();
    if (F.wave != 0) return;
#pragma unroll
    for (int mt = 0; mt < 4; ++mt) { f32x4 t = (f32x4){0.f, 0.f, 0.f, 0.f};
#pragma unroll
        for (int w = 0; w < 8; ++w) t = t + *(const LAS f32x4*)(red + ((w * 4 + mt) * 64 + F.lane) * 4);
        acc[mt] = t; }
    bf16x8 hb[2];
#pragma unroll
    for (int s2 = 0; s2 < 2; ++s2) { v4u w; const f32x4 a0 = acc[2 * s2], a1 = acc[2 * s2 + 1];
        w.x = pk2(gelu_tanh(a0.x), gelu_tanh(a0.y)); w.y = pk2(gelu_tanh(a0.z), gelu_tanh(a0.w)); w.z = pk2(gelu_tanh(a1.x), gelu_tanh(a1.y)); w.w = pk2(gelu_tanh(a1.z), gelu_tanh(a1.w));
        hb[s2] = __builtin_bit_cast(bf16x8, w); }
    bf16* kcmp = (bf16*)(F.ws + WS_KCMP); bf16* vcmpT = (bf16*)(F.ws + WS_KCMP + 512 * 1024);
#pragma unroll
    for (int ntl = 0; ntl < 4; ++ntl) {
        f32x4 o = (f32x4){0.f, 0.f, 0.f, 0.f};
#pragma unroll
        for (int s2 = 0; s2 < 2; ++s2) { const bf16* wp = w2T + (size_t)(16 * ntl + fr) * 64 + 32 * s2 + 4 * fq; const v2u lo = *(const v2u*)wp, hi = *(const v2u*)(wp + 16);
            v4u aw; aw.x = lo.x; aw.y = lo.y; aw.z = hi.x; aw.w = hi.y; o = MFMA16(__builtin_bit_cast(bf16x8, aw), hb[s2], o); }
        if (!jvalid) o = (f32x4){0.f, 0.f, 0.f, 0.f};
        const int jj = j0 + fr, n = 16 * ntl + 4 * fq;
        if (kv == 0) *(v2u*)(kcmp + ((size_t)bg * 128 + jj) * 64 + n) = pk4(o);
        else { const v2u w = pk4(o); bf16* vp = vcmpT + ((size_t)bg * 64 + n) * 128 + jj; vp[0] = (bf16)(w.x & 0xffff); vp[128] = (bf16)(w.x >> 16); vp[256] = (bf16)(w.y & 0xffff); vp[384] = (bf16)(w.y >> 16); }
    }
}
__device__ __forceinline__ void zgate_task(Frame& F, int tile) {
    const int fr = F.lane & 15, fq = F.lane >> 4, m0 = tile * 16;
    const bf16* XN = (const bf16*)(F.ws + WS_XN); const bf16* gw = (const bf16*)(F.ws + WS_SMALLW + SW_GATEW);
    f32x4 acc[2] = {(f32x4){0.f, 0.f, 0.f, 0.f}, (f32x4){0.f, 0.f, 0.f, 0.f}};
#pragma unroll 16
    for (int ks = 0; ks < 32; ++ks) {
        const bf16x8 bop = *(const bf16x8*)(XN + (size_t)(m0 + fr) * D + 32 * ks + 8 * fq);
#pragma unroll
        for (int ct = 0; ct < 2; ++ct) { const bf16x8 aop = *(const bf16x8*)(gw + (size_t)(16 * ct + fr) * D + 32 * ks + 8 * fq); acc[ct] = MFMA16(aop, bop, acc[ct]); }
    }
    float* zg = (float*)(F.ws + WS_ZGATE);
#pragma unroll
    for (int ct = 0; ct < 2; ++ct) *(f32x4*)(zg + (size_t)(m0 + fr) * 32 + 16 * ct + 4 * fq) = acc[ct];
}
__device__ __forceinline__ void vt_task(Frame& F, int idx) {
    const int which = idx & 1, blk = (idx >> 1) & 31, bg = idx >> 6, b = bg >> 1, g = bg & 1;
    const bf16* z = (const bf16*)(F.ws + WS_Z);
    bf16* vT = (bf16*)(F.ws + (which ? WS_VWT : WS_VST));
    const int t = 64 * blk + F.lane;
    const bf16* src = z + ((size_t)b * SEQ + t) * NZ + (which ? ZC_VW : ZC_VS) + g * 64;
#pragma unroll
    for (int dc = 0; dc < 8; ++dc) { const v4u w = *(const v4u*)(src + 8 * dc); bf16* dst = vT + ((size_t)bg * 64 + 8 * dc) * SEQ + t;
        dst[0 * SEQ] = (bf16)(w.x & 0xffff); dst[1 * SEQ] = (bf16)(w.x >> 16); dst[2 * SEQ] = (bf16)(w.y & 0xffff); dst[3 * SEQ] = (bf16)(w.y >> 16);
        dst[4 * SEQ] = (bf16)(w.z & 0xffff); dst[5 * SEQ] = (bf16)(w.z >> 16); dst[6 * SEQ] = (bf16)(w.w & 0xffff); dst[7 * SEQ] = (bf16)(w.w >> 16); }
}
__device__ __forceinline__ void alora_task4(Frame& F, int mb) {
    const bf16* z = (const bf16*)(F.ws + WS_Z); bf16* AL = (bf16*)(F.ws + WS_PBF);
    const int l = F.lane;
    const f32x4 mu = *(const f32x4*)(F.ap->in[4] + ZC_W + 4 * l);
    v2u cw[4], pw[4];
#pragma unroll
    for (int u = 0; u < 4; ++u) { const int m = mb + u * F.NGW; const int t = m & (SEQ - 1); cw[u] = *(const v2u*)(z + (size_t)m * NZ + ZC_W + 4 * l); pw[u] = *(const v2u*)(z + (size_t)(t > 0 ? m - 1 : m) * NZ + ZC_W + 4 * l); }
#pragma unroll
    for (int u = 0; u < 4; ++u) { const int m = mb + u * F.NGW; const int t = m & (SEQ - 1);
        const f32x4 cur = unpk4(cw[u]); const f32x4 prev = unpk4(pw[u]) * (t > 0 ? 1.0f : 0.0f);
        f32x4 s = cur + (prev - cur) * mu;
        if (l < 16) { s.x = tanhf(s.x); s.y = tanhf(s.y); s.z = tanhf(s.z); s.w = tanhf(s.w); }
        else if (l >= 32) { s.x = sigmoidf_(s.x); s.y = sigmoidf_(s.y); s.z = sigmoidf_(s.z); s.w = sigmoidf_(s.w); }
        *(v2u*)(AL + (size_t)m * 256 + 4 * l) = pk4(s); }
}
__device__ __forceinline__ void p2_prep(Frame& F) {
    constexpr int T1 = 1024, T2 = T1 + 1024;
    for (int it = F.vcu; it < 256; it += F.G) compress_wg_task(F, it);
    for (int task = F.gw; task < T2; task += F.NGW) {
        if (task < T1) zgate_task(F, task);
        else vt_task(F, task - T1);
    }
    for (int base = F.gw; base < M; base += 4 * F.NGW) alora_task4(F, base);
}

__device__ __forceinline__ void ld16(const bf16* p, float (&f)[16]) { float a[8], b[8]; unpk8(*(const v4u*)p, a); unpk8(*(const v4u*)(p + 8), b);
#pragma unroll
    for (int i = 0; i < 8; ++i) { f[i] = a[i]; f[8 + i] = b[i]; } }
__device__ __forceinline__ void ld16f(const float* p, float (&f)[16]) {
#pragma unroll
    for (int q = 0; q < 4; ++q) { const f32x4 v = *(const f32x4*)(p + 4 * q); f[4 * q] = v.x; f[4 * q + 1] = v.y; f[4 * q + 2] = v.z; f[4 * q + 3] = v.w; } }
__device__ __forceinline__ void st16(bf16* p, const float (&f)[16]) { v4u a, b; a.x = pk2(f[0], f[1]); a.y = pk2(f[2], f[3]); a.z = pk2(f[4], f[5]); a.w = pk2(f[6], f[7]); b.x = pk2(f[8], f[9]); b.y = pk2(f[10], f[11]); b.z = pk2(f[12], f[13]); b.w = pk2(f[14], f[15]);
    *(v4u*)p = a; *(v4u*)(p + 8) = b; }
struct PrepW { bf16x8 w[2], a[2], g[4]; };
constexpr int PW_OFF = 32768, PW_P64 = 144, PW_P128 = 272, PW_A_OFF = PW_OFF + 64 * PW_P64, PW_G_OFF = PW_A_OFF + 64 * PW_P64;
__device__ __forceinline__ void prep_stage_w(Frame& F, int h) {
    const bf16* w2T = (const bf16*)(F.ws + WS_SMALLW + SW_W2T) + (size_t)h * 64 * 64; const bf16* a2T = (const bf16*)(F.ws + WS_SMALLW + SW_A2T) + (size_t)h * 64 * 64; const bf16* g2T = (const bf16*)(F.ws + WS_SMALLW + SW_G2T) + (size_t)h * 64 * 128;
    { const int R = F.tid >> 3, c = F.tid & 7, slot = ((R >> 2) & 3) * 16 + (R >> 4) * 4 + (R & 3);
      *(LAS v4u*)(F.lds + PW_OFF + slot * PW_P64 + c * 16) = *(const v4u*)(w2T + R * 64 + c * 8); *(LAS v4u*)(F.lds + PW_A_OFF + slot * PW_P64 + c * 16) = *(const v4u*)(a2T + R * 64 + c * 8); }
#pragma unroll
    for (int i = 0; i < 2; ++i) { const int id = F.tid + 512 * i, R = id >> 4, c = id & 15, slot = ((R >> 2) & 3) * 16 + (R >> 4) * 4 + (R & 3);
      *(LAS v4u*)(F.lds + PW_G_OFF + slot * PW_P128 + c * 16) = *(const v4u*)(g2T + R * 128 + c * 8); }
}
__device__ __forceinline__ void prep_ldw(PrepW& W, const LAS unsigned char* lds, int n, int fr, int fq) {
#pragma unroll
    for (int ks = 0; ks < 2; ++ks) { W.w[ks] = *(const LAS bf16x8*)(lds + PW_OFF + (n * 16 + fr) * PW_P64 + 64 * ks + 16 * fq); W.a[ks] = *(const LAS bf16x8*)(lds + PW_A_OFF + (n * 16 + fr) * PW_P64 + 64 * ks + 16 * fq); }
#pragma unroll
    for (int ks = 0; ks < 4; ++ks) W.g[ks] = *(const LAS bf16x8*)(lds + PW_G_OFF + (n * 16 + fr) * PW_P128 + 64 * ks + 16 * fq);
}
__device__ __forceinline__ void ldpar(const LAS float* p, float (&f)[16]) {
#pragma unroll
    for (int q = 0; q < 4; ++q) { const f32x4 v = *(const LAS f32x4*)(p + 4 * q); f[4 * q] = v.x; f[4 * q + 1] = v.y; f[4 * q + 2] = v.z; f[4 * q + 3] = v.w; } }
__device__ __forceinline__ void rwkv_prep_task(Frame& F, int task, const LAS float* par) {
    const int h = task & 7, m0 = (task >> 3) * 16, fr = F.lane & 15, fq = F.lane >> 4, m = m0 + fr, t = m & (SEQ - 1);
    const bf16* z = (const bf16*)(F.ws + WS_Z); const bf16* AL = (const bf16*)(F.ws + WS_PBF);
    bf16* vbuf = (bf16*)F.out; bf16* gbuf = (bf16*)(F.ws + WS_G);
    const int cl = h * 64 + 16 * fq;
    bf16x8 bw[2], ba[2], bgf[4];
    const bf16* alr = AL + (size_t)m * 256 + 8 * fq;
#pragma unroll
    for (int ks = 0; ks < 2; ++ks) { bw[ks] = *(const bf16x8*)(alr + 32 * ks); ba[ks] = *(const bf16x8*)(alr + 64 + 32 * ks); }
#pragma unroll
    for (int ks = 0; ks < 4; ++ks) bgf[ks] = *(const bf16x8*)(alr + 128 + 32 * ks);
    const bf16* zc = z + (size_t)m * NZ + cl; const bf16* zp = (t > 0) ? zc - NZ : zc;
    v4u zraw[6][2];
#pragma unroll
    for (int q = 0; q < 3; ++q) { zraw[q][0] = *(const v4u*)(zc + 512 * q); zraw[q][1] = *(const v4u*)(zc + 512 * q + 8); zraw[3 + q][0] = *(const v4u*)(zp + 512 * q); zraw[3 + q][1] = *(const v4u*)(zp + 512 * q + 8); }
    __builtin_amdgcn_sched_barrier(0);
    float ev[16], av[16], gv[16];
#define PREP_MM(W, n) do { f32x4 accw = (f32x4){0.f, 0.f, 0.f, 0.f}, acca = accw, accg = accw; \
        _Pragma("unroll") for (int ks = 0; ks < 2; ++ks) { accw = MFMA16(W.w[ks], bw[ks], accw); acca = MFMA16(W.a[ks], ba[ks], acca); } \
        _Pragma("unroll") for (int ks = 0; ks < 4; ++ks) accg = MFMA16(W.g[ks], bgf[ks], accg); \
        _Pragma("unroll") for (int r = 0; r < 4; ++r) { ev[4 * (n) + r] = accw[r]; av[4 * (n) + r] = acca[r]; gv[4 * (n) + r] = accg[r]; } } while (0)
    { PrepW Wa, Wb;
      prep_ldw(Wa, F.lds, 0, fr, fq); prep_ldw(Wb, F.lds, 1, fr, fq); PREP_MM(Wa, 0); PREP_MM(Wb, 1);
      prep_ldw(Wa, F.lds, 2, fr, fq); prep_ldw(Wb, F.lds, 3, fr, fq); PREP_MM(Wa, 2); PREP_MM(Wb, 3); }
    float zr[16], zk[16], zv[16], tmp[16];
    const float pm = (t > 0) ? 1.0f : 0.0f;
    {   float c[16], p[16];
#define PREP_UNP(q, dst) do { float a_[8], b_[8]; unpk8(zraw[q][0], a_); unpk8(zraw[q][1], b_); _Pragma("unroll") for (int i = 0; i < 8; ++i) { dst[i] = a_[i]; dst[8 + i] = b_[i]; } } while (0)
        PREP_UNP(0, c); PREP_UNP(3, p); ldpar(par + 0 * 64 + 16 * fq, tmp);
#pragma unroll
        for (int e = 0; e < 16; ++e) zr[e] = c[e] + (p[e] * pm - c[e]) * tmp[e];
        PREP_UNP(1, c); PREP_UNP(4, p); ldpar(par + 1 * 64 + 16 * fq, tmp);
#pragma unroll
        for (int e = 0; e < 16; ++e) zk[e] = c[e] + (p[e] * pm - c[e]) * tmp[e];
        PREP_UNP(2, c); PREP_UNP(5, p); ldpar(par + 2 * 64 + 16 * fq, tmp);
#pragma unroll
        for (int e = 0; e < 16; ++e) zv[e] = c[e] + (p[e] * pm - c[e]) * tmp[e];
    }
    float kkr[16]; float ss = 0.f;
    ldpar(par + 3 * 64 + 16 * fq, tmp);
#pragma unroll
    for (int e = 0; e < 16; ++e) { const float x = -(tmp[e] + ev[e]); const float sp = fmaxf(x, 0.f) + __logf(1.0f + __expf(-fabsf(x))); ev[e] = __expf(-sp - 0.5f); }
    ldpar(par + 4 * 64 + 16 * fq, tmp);
#pragma unroll
    for (int e = 0; e < 16; ++e) av[e] = sigmoidf_(tmp[e] + av[e]);
    ldpar(par + 5 * 64 + 16 * fq, tmp);
#pragma unroll
    for (int e = 0; e < 16; ++e) { kkr[e] = zk[e] * tmp[e]; ss += kkr[e] * kkr[e]; }
    ss += __shfl_xor(ss, 16); ss += __shfl_xor(ss, 32);
    const float inv = 1.0f / fmaxf(sqrtf(ss), 1e-12f);
    ldpar(par + 6 * 64 + 16 * fq, tmp);
    float kp[16], kka[16];
#pragma unroll
    for (int e = 0; e < 16; ++e) { kkr[e] *= inv; kka[e] = kkr[e] * av[e]; kp[e] = zk[e] * (1.0f + (av[e] - 1.0f) * tmp[e]); }
    st16(vbuf + (size_t)m * 512 + cl, zv); st16(gbuf + (size_t)m * 512 + cl, gv);
    { ldpar(par + 7 * 64 + 16 * fq, tmp);
      float bsum = 0.f;
#pragma unroll
      for (int e = 0; e < 16; ++e) bsum += zr[e] * kp[e] * tmp[e];
      bsum += __shfl_xor(bsum, 16); bsum += __shfl_xor(bsum, 32);
      if (fq == 0) ((float*)(F.ws + WS_BONUS))[(size_t)m * 8 + h] = bsum; }
    asm volatile("" ::: "memory");
    unsigned char* rec = F.ws + WS_S + (size_t)task * CH_REC;
    bf16x8 Pb[2], Qb[2], Kb[2], Rb[2];
#pragma unroll
    for (int ks = 0; ks < 2; ++ks) {
        float Pm[8], Qm[8], Km[8], Rm[8], acv[8];
#pragma unroll
        for (int e8 = 0; e8 < 8; ++e8) { const int e = 8 * ks + e8;
            float cs = ev[e]; cs += dppf<0x111>(cs); cs += dppf<0x112>(cs); cs += dppf<0x114>(cs); cs += dppf<0x118>(cs);
            const float A = __expf(-cs), Ap = __expf(ev[e] - cs), iA = __expf(cs);
            Pm[e8] = kkr[e] * Ap; Qm[e8] = -kka[e] * iA; Km[e8] = kp[e] * iA; Rm[e8] = zr[e] * A; acv[e8] = A; }
        v4u w;
        w.x = pk2(Pm[0], Pm[1]); w.y = pk2(Pm[2], Pm[3]); w.z = pk2(Pm[4], Pm[5]); w.w = pk2(Pm[6], Pm[7]); Pb[ks] = __builtin_bit_cast(bf16x8, w);
        w.x = pk2(Qm[0], Qm[1]); w.y = pk2(Qm[2], Qm[3]); w.z = pk2(Qm[4], Qm[5]); w.w = pk2(Qm[6], Qm[7]); Qb[ks] = __builtin_bit_cast(bf16x8, w);
        w.x = pk2(Km[0], Km[1]); w.y = pk2(Km[2], Km[3]); w.z = pk2(Km[4], Km[5]); w.w = pk2(Km[6], Km[7]); Kb[ks] = __builtin_bit_cast(bf16x8, w);
        w.x = pk2(Rm[0], Rm[1]); w.y = pk2(Rm[2], Rm[3]); w.z = pk2(Rm[4], Rm[5]); w.w = pk2(Rm[6], Rm[7]); Rb[ks] = __builtin_bit_cast(bf16x8, w);
        if (fr == 15) { *(f32x4*)(rec + CH_AC + (16 * fq + 8 * ks) * 4) = (f32x4){acv[0], acv[1], acv[2], acv[3]}; *(f32x4*)(rec + CH_AC + (16 * fq + 8 * ks + 4) * 4) = (f32x4){acv[4], acv[5], acv[6], acv[7]}; }
    }
    *(v4u*)(rec + CH_P + fr * CH_PP + 32 * fq) = __builtin_bit_cast(v4u, Pb[0]); *(v4u*)(rec + CH_P + fr * CH_PP + 32 * fq + 16) = __builtin_bit_cast(v4u, Pb[1]);
    *(v4u*)(rec + CH_R + fr * CH_PP + 32 * fq) = __builtin_bit_cast(v4u, Rb[0]); *(v4u*)(rec + CH_R + fr * CH_PP + 32 * fq + 16) = __builtin_bit_cast(v4u, Rb[1]);
    *(v4u*)(rec + CH_Q + (fq * 16 + fr) * 32) = __builtin_bit_cast(v4u, Qb[0]); *(v4u*)(rec + CH_Q + (fq * 16 + fr) * 32 + 16) = __builtin_bit_cast(v4u, Qb[1]);
    *(v4u*)(rec + CH_K + (fq * 16 + fr) * 32) = __builtin_bit_cast(v4u, Kb[0]); *(v4u*)(rec + CH_K + (fq * 16 + fr) * 32 + 16) = __builtin_bit_cast(v4u, Kb[1]);
    f32x4 gqp = (f32x4){0.f, 0.f, 0.f, 0.f}, gkp = gqp, gqr = gqp, gkr = gqp;
#pragma unroll
    for (int ks = 0; ks < 2; ++ks) { gqp = MFMA16(Qb[ks], Pb[ks], gqp); gkp = MFMA16(Kb[ks], Pb[ks], gkp); gqr = MFMA16(Qb[ks], Rb[ks], gqr); gkr = MFMA16(Kb[ks], Rb[ks], gkr); }
#pragma unroll
    for (int rg = 0; rg < 4; ++rg) { const int s = 4 * fq + rg; if (!(s < fr)) { gqp[rg] = 0.f; gkp[rg] = 0.f; } if (!(s <= fr)) { gqr[rg] = 0.f; gkr[rg] = 0.f; } }
    *(v2u*)(rec + CH_G + 0 * 512 + (fr * 16 + 4 * fq) * 2) = pk4(gkp);
    *(v2u*)(rec + CH_G + 2 * 512 + (fr * 16 + 4 * fq) * 2) = pk4(gqr);
    *(v2u*)(rec + CH_G + 3 * 512 + (fr * 16 + 4 * fq) * 2) = pk4(gkr);
    LAS float* Nl = (LAS float*)(F.lds + F.wave * 4096);
#pragma unroll
    for (int rg = 0; rg < 4; ++rg) Nl[(4 * fq + rg) * 20 + fr] = gqp[rg];
    LDS_WAIT(); __builtin_amdgcn_wave_barrier(); asm volatile("" ::: "memory");
    float Tc[16];
#pragma unroll
    for (int s = 15; s >= 0; --s) {
        float acc = 0.f;
#pragma unroll
        for (int q4 = 0; q4 < 4; ++q4) if (4 * q4 + 3 > s) { const f32x4 nv = *(const LAS f32x4*)(Nl + s * 20 + 4 * q4);
#pragma unroll
            for (int u = 0; u < 4; ++u) if (4 * q4 + u > s) acc += nv[u] * Tc[4 * q4 + u]; }
        Tc[s] = (s == fr) ? 1.0f : acc; }
    { f32x4 tv;
#pragma unroll
      for (int u = 0; u < 4; ++u) tv[u] = fq == 0 ? Tc[u] : (fq == 1 ? Tc[4 + u] : (fq == 2 ? Tc[8 + u] : Tc[12 + u]));
      *(v2u*)(rec + CH_G + 1 * 512 + (fr * 16 + 4 * fq) * 2) = pk4(tv); }
    LDS_WAIT(); __builtin_amdgcn_wave_barrier(); asm volatile("" ::: "memory");
#undef PREP_MM
#undef PREP_UNP
}
__device__ __forceinline__ void prep_fill_par(Frame& F, LAS float* par, int h) {
    const int l = F.lane; const float* mu = F.ap->in[4];
    par[0 * 64 + l] = mu[ZC_R + h * 64 + l]; par[1 * 64 + l] = mu[ZC_K + h * 64 + l]; par[2 * 64 + l] = mu[ZC_V + h * 64 + l];
    par[3 * 64 + l] = F.ap->in[5][h * 64 + l]; par[4 * 64 + l] = F.ap->in[7][h * 64 + l]; par[5 * 64 + l] = F.ap->in[10][h * 64 + l]; par[6 * 64 + l] = F.ap->in[11][h * 64 + l]; par[7 * 64 + l] = F.ap->in[12][h * 64 + l];
    LDS_WAIT(); __builtin_amdgcn_wave_barrier(); asm volatile("" ::: "memory");
}

__device__ __forceinline__ float nsa_slope(int g, int r) { return __uint_as_float((unsigned)(127 - (g * 4 + r + 1)) << 23); }

constexpr int CMP_KC_OFF = 32768, CMP_KP = 144, CMP_VC_OFF = CMP_KC_OFF + 128 * CMP_KP, CMP_VP = 264;
__device__ __forceinline__ void nsa_cmp_stage(Frame& F, int bg) {
    const bf16* kcmp = (const bf16*)(F.ws + WS_KCMP) + (size_t)bg * 128 * 64; const bf16* vcmpT = (const bf16*)(F.ws + WS_KCMP + 512 * 1024) + (size_t)bg * 64 * 128;
    v4u a[2], v[2];
#pragma unroll
    for (int i = 0; i < 2; ++i) { const int id = F.tid + 512 * i; a[i] = *(const v4u*)(kcmp + (size_t)(id >> 3) * 64 + (id & 7) * 8); v[i] = *(const v4u*)(vcmpT + (size_t)(id >> 4) * 128 + (id & 15) * 8); }
#pragma unroll
    for (int i = 0; i < 2; ++i) { const int id = F.tid + 512 * i; *(LAS v4u*)(F.lds + CMP_KC_OFF + (id >> 3) * CMP_KP + (id & 7) * 16) = a[i]; *(LAS v4u*)(F.lds + CMP_VC_OFF + (id >> 4) * CMP_VP + (id & 15) * 16) = v[i]; }
}
template <int ABL>
__device__ __forceinline__ void nsa_cmp_task(Frame& F, int task) {
    const int tile = task & 127, bg = task >> 7, b = bg >> 1, g = bg & 1;
    const int fr = F.lane & 15, fq = F.lane >> 4, t = tile * 16 + fr, m = b * SEQ + t;
    const bf16* z = (const bf16*)(F.ws + WS_Z);
    const float* zg = (const float*)(F.ws + WS_ZGATE); const float* gb = F.ap->in[21];
    bf16* Y = (bf16*)(F.ws + WS_YB);
    bf16x8 qall[4][2]; float gl[4];
#pragma unroll
    for (int r = 0; r < 4; ++r) { const bf16* qp = z + (size_t)m * NZ + ZC_Q + (g * 4 + r) * 64 + 8 * fq; qall[r][0] = *(const bf16x8*)qp; qall[r][1] = *(const bf16x8*)(qp + 32);
        gl[r] = zg[(size_t)m * 32 + (g * 4 + r) * 3 + 0] + gb[(g * 4 + r) * 3 + 0]; }
    const LAS unsigned char* kc = F.lds + CMP_KC_OFF + fr * CMP_KP + 16 * fq; const LAS unsigned char* vc = F.lds + CMP_VC_OFF + fr * CMP_VP + 8 * fq;
    const int tv = t - 31 - 64 * fq; const float tb = (float)t - 15.5f - 64.0f * (float)fq;
    float impl[8], imp3[8];
#pragma unroll
    for (int kt = 0; kt < 8; ++kt) { impl[kt] = 0.f; imp3[kt] = 0.f; }
#pragma unroll
    for (int r = 0; r < 4; ++r) {
        const float slope = nsa_slope(g, r);
        const bf16x8 q0 = qall[r][0], q1 = qall[r][1];
        float s[8][4]; float mx = -1e30f;
#pragma unroll
        for (int kt = 0; kt < 8; ++kt) {
            f32x4 a = (f32x4){0.f, 0.f, 0.f, 0.f};
            a = MFMA16(*(const LAS bf16x8*)(kc + 16 * kt * CMP_KP), q0, a); a = MFMA16(*(const LAS bf16x8*)(kc + 16 * kt * CMP_KP + 64), q1, a);
#pragma unroll
            for (int rg = 0; rg < 4; ++rg) { const bool valid = ((256 * kt + 16 * rg) <= tv);
                const float sc = a[rg] * 0.125f - slope * (tb - (float)(256 * kt + 16 * rg)); s[kt][rg] = valid ? sc : -1e30f; mx = fmaxf(mx, s[kt][rg]); }
        }
        mx = fmaxf(mx, __shfl_xor(mx, 16)); mx = fmaxf(mx, __shfl_xor(mx, 32));
        float sum = 0.f;
#pragma unroll
        for (int kt = 0; kt < 8; ++kt)
#pragma unroll
            for (int rg = 0; rg < 4; ++rg) { const float p = (s[kt][rg] > -1e29f) ? __expf(s[kt][rg] - mx) : 0.f; s[kt][rg] = p; sum += p; }
        sum += __shfl_xor(sum, 16); sum += __shfl_xor(sum, 32);
        const float inv = sum > 0.f ? 1.0f / sum : 0.f;
#pragma unroll
        for (int kt = 0; kt < 8; ++kt) {
#pragma unroll
            for (int rg = 0; rg < 4; ++rg) s[kt][rg] *= inv;
            impl[kt] += s[kt][0] + s[kt][1] + s[kt][2] + 0.5f * s[kt][3]; imp3[kt] += s[kt][3]; }
        f32x4 o[4];
#pragma unroll
        for (int dt = 0; dt < 4; ++dt) o[dt] = (f32x4){0.f, 0.f, 0.f, 0.f};
#pragma unroll
        for (int s2 = 0; s2 < 4; ++s2) {
            v4u pw; pw.x = pk2(s[2 * s2][0], s[2 * s2][1]); pw.y = pk2(s[2 * s2][2], s[2 * s2][3]); pw.z = pk2(s[2 * s2 + 1][0], s[2 * s2 + 1][1]); pw.w = pk2(s[2 * s2 + 1][2], s[2 * s2 + 1][3]);
            const bf16x8 pb = __builtin_bit_cast(bf16x8, pw);
#pragma unroll
            for (int dt = 0; dt < 4; ++dt) { const LAS unsigned char* vp = vc + 16 * dt * CMP_VP + 64 * s2; const v2u lo = *(const LAS v2u*)vp, hi = *(const LAS v2u*)(vp + 32);
                v4u aw; aw.x = lo.x; aw.y = lo.y; aw.z = hi.x; aw.w = hi.y; o[dt] = MFMA16(__builtin_bit_cast(bf16x8, aw), pb, o[dt]); }
        }
        const int hh = g * 4 + r; const float gate = sigmoidf_(gl[r]);
#pragma unroll
        for (int dt = 0; dt < 4; ++dt) *(v2u*)(Y + (size_t)m * 512 + hh * 64 + 16 * dt + 4 * fq) = pk4(o[dt] * gate);
        __builtin_amdgcn_sched_barrier(0);
    }
    if (ABL == 1) return;
    LAS float* sc = (LAS float*)(F.lds + F.wave * 4096);
    float y3prev = 0.f;
#pragma unroll
    for (int kt = 0; kt < 8; ++kt) {
        const float y3 = __shfl(imp3[kt], (F.lane + 48) & 63);
        const float prev = (fq > 0) ? y3 : y3prev; y3prev = y3;
        sc[fr * 33 + 4 * kt + fq] = impl[kt] + 0.5f * prev;
    }
    LDS_WAIT(); __builtin_amdgcn_wave_barrier(); asm volatile("" ::: "memory");
    const int blk_t = t >> 6, chi = blk_t - 2;
    unsigned mask = 1u | (1u << blk_t) | (blk_t > 0 ? (1u << (blk_t - 1)) : 0u);
#pragma unroll
    for (int kt = 0; kt < 8; ++kt) {
        const int k = 4 * kt + fq;
        if (k >= 1 && k <= chi) { const float me = sc[fr * 33 + k]; int rank = 0;
            for (int k2 = 1; k2 <= chi; ++k2) { const float o = sc[fr * 33 + k2]; rank += (o > me || (o == me && k2 < k)) ? 1 : 0; }
            if (rank < 5) mask |= (1u << k); }
    }
    mask |= (unsigned)__shfl_xor((int)mask, 16); mask |= (unsigned)__shfl_xor((int)mask, 32);
    if (fq == 0) ((unsigned*)(F.ws + WS_SELMASK))[(size_t)bg * SEQ + t] = mask;
    LDS_WAIT(); __builtin_amdgcn_wave_barrier(); asm volatile("" ::: "memory");
}
__device__ __forceinline__ void p3_phase(Frame& F) {
    constexpr int T0 = 2048, T1 = T0 + 8192;
#ifdef DUP_P3A
    for (int task = F.gw; task < T0; task += F.NGW) { __syncthreads(); nsa_cmp_stage(F, task >> 7); LDS_WAIT(); __syncthreads(); nsa_cmp_task<DUP_P3A>(F, task); }
    asm volatile("" ::: "memory");
#endif
    for (int task = F.gw; task < T0; task += F.NGW) { __syncthreads(); nsa_cmp_stage(F, task >> 7); LDS_WAIT(); __syncthreads(); nsa_cmp_task<0>(F, task); }
    asm volatile("" ::: "memory");
    const int h = F.vcu & 7;
    LAS float* par = (LAS float*)(F.lds + F.wave * 4096 + 2048);
    __syncthreads();
    prep_fill_par(F, par, h); prep_stage_w(F, h);
    LDS_WAIT(); __syncthreads();
#ifdef DUP_P3B
    for (int i = F.wave; i < 32; i += 8) rwkv_prep_task(F, (((F.vcu >> 3) + 32 * i) << 3) | h, par);
    asm volatile("" ::: "memory");
#endif
    for (int i = F.wave; i < 32; i += 8) rwkv_prep_task(F, (((F.vcu >> 3) + 32 * i) << 3) | h, par);
}

constexpr int NSA_KP = 144, NSA_VP = 136, NSA_BUF = 64 * NSA_KP + 64 * NSA_VP, NSA_CTL = 2 * NSA_BUF + 1024;
struct NsaState { f32x4 O[2][4]; float mrun[2], lrun[2]; };
template <int WHICH, bool MASKED>
__device__ __forceinline__ void nsa_block(NsaState& St, const LAS unsigned char* kb_, const LAS unsigned char* vb_, const bf16x8 (&qf)[2][2], int kb, unsigned mymask, int t, int fq, float slope0) {
    const int kpos0 = 64 * kb;
    bf16x8 kf[4][2];
#pragma unroll
    for (int kt = 0; kt < 4; ++kt) { kf[kt][0] = *(const LAS bf16x8*)(kb_ + 16 * kt * NSA_KP); kf[kt][1] = *(const LAS bf16x8*)(kb_ + 16 * kt * NSA_KP + 64); }
    const bool bsel = (mymask >> kb) & 1u; const int dbase = t - 4 * fq - kpos0;
    const float fdb = (float)dbase;
    bf16x8 P[2][2];
#pragma unroll
    for (int r = 0; r < 2; ++r) {
        const float slope = r ? 0.5f * slope0 : slope0;
        float s[4][4]; float bm = -1e30f;
        float base = -slope * fdb;
        const float s1 = slope, s2_ = 2.0f * slope, s3 = 3.0f * slope, s16 = 16.0f * slope;
#pragma unroll
        for (int kt = 0; kt < 4; ++kt) { f32x4 a = (f32x4){base, base + s1, base + s2_, base + s3}; base += s16;
            a = MFMA16(kf[kt][0], qf[r][0], a); a = MFMA16(kf[kt][1], qf[r][1], a);
#pragma unroll
            for (int rg = 0; rg < 4; ++rg) {
                if (MASKED) { const int dist = dbase - (16 * kt + rg); const bool valid = bsel && dist >= 0 && (WHICH == 0 || dist < 512); s[kt][rg] = valid ? a[rg] : -1e30f; }
                else s[kt][rg] = a[rg];
                bm = fmaxf(bm, s[kt][rg]); } }
        bm = fmaxf(bm, __shfl_xor(bm, 16)); bm = fmaxf(bm, __shfl_xor(bm, 32));
        const float mnew = fmaxf(St.mrun[r], bm); const float scale = __builtin_amdgcn_exp2f(St.mrun[r] - mnew); St.mrun[r] = mnew;
        float ps = 0.f;
#pragma unroll
        for (int kt = 0; kt < 4; ++kt)
#pragma unroll
            for (int rg = 0; rg < 4; ++rg) { float p = __builtin_amdgcn_exp2f(s[kt][rg] - mnew); if (MASKED) p = (s[kt][rg] > -1e29f) ? p : 0.f; s[kt][rg] = p; ps += p; }
        St.lrun[r] = St.lrun[r] * scale + ps;
#pragma unroll
        for (int dt = 0; dt < 4; ++dt) St.O[r][dt] = St.O[r][dt] * scale;
#pragma unroll
        for (int s2 = 0; s2 < 2; ++s2) { v4u pw; pw.x = pk2(s[2 * s2][0], s[2 * s2][1]); pw.y = pk2(s[2 * s2][2], s[2 * s2][3]); pw.z = pk2(s[2 * s2 + 1][0], s[2 * s2 + 1][1]); pw.w = pk2(s[2 * s2 + 1][2], s[2 * s2 + 1][3]);
            P[r][s2] = __builtin_bit_cast(bf16x8, pw); }
    }
#pragma unroll
    for (int dt = 0; dt < 4; ++dt)
#pragma unroll
        for (int s2 = 0; s2 < 2; ++s2) { const LAS unsigned char* vp = vb_ + 16 * dt * NSA_VP + 64 * s2; const v2u lo = *(const LAS v2u*)vp, hi = *(const LAS v2u*)(vp + 32);
            v4u aw; aw.x = lo.x; aw.y = lo.y; aw.z = hi.x; aw.w = hi.y; const bf16x8 vf = __builtin_bit_cast(bf16x8, aw);
#pragma unroll
            for (int r = 0; r < 2; ++r) St.O[r][dt] = MFMA16(vf, P[r][s2], St.O[r][dt]); }
}
template <int WHICH>
__device__ __forceinline__ void nsa_wg_task(Frame& F, int item) {
    const int hp = item & 1, bg = item >> 5, tg = (item >> 1) & 15, b = bg >> 1, g = bg & 1;
    const int fr = F.lane & 15, fq = F.lane >> 4, tile = tg * 8 + F.wave, t0 = tile * 16, t = t0 + fr, m = b * SEQ + t;
    const int h0 = g * 4 + 2 * hp;
    const bf16* z = (const bf16*)(F.ws + WS_Z);
    const bf16* Kb = z + (size_t)b * SEQ * NZ + (WHICH ? ZC_KW : ZC_KS) + g * 64;
    const bf16* VT = (const bf16*)(F.ws + (WHICH ? WS_VWT : WS_VST)) + (size_t)bg * 64 * SEQ;
    unsigned mymask, tile_or, full; const int kb_hi = (t0 + 15) >> 6;
    if (WHICH == 0) { mymask = ((const unsigned*)(F.ws + WS_SELMASK))[(size_t)bg * SEQ + t]; unsigned x = mymask, y = mymask;
        x |= (unsigned)__shfl_xor((int)x, 1); x |= (unsigned)__shfl_xor((int)x, 2); x |= (unsigned)__shfl_xor((int)x, 4); x |= (unsigned)__shfl_xor((int)x, 8);
        y &= (unsigned)__shfl_xor((int)y, 1); y &= (unsigned)__shfl_xor((int)y, 2); y &= (unsigned)__shfl_xor((int)y, 4); y &= (unsigned)__shfl_xor((int)y, 8);
        tile_or = (unsigned)__builtin_amdgcn_readfirstlane((int)x); full = (unsigned)__builtin_amdgcn_readfirstlane((int)y) & ((1u << kb_hi) - 1u); }
    else { mymask = 0xffffffffu; const int lo = (t0 - 511) > 0 ? ((t0 - 511) >> 6) : 0; tile_or = 0u; full = 0u;
        for (int k = lo; k <= kb_hi; ++k) { tile_or |= (1u << k); if (k < kb_hi && 64 * k >= t0 - 496) full |= (1u << k); } }
    tile_or &= (kb_hi >= 31) ? 0xffffffffu : ((2u << kb_hi) - 1u);
    LAS unsigned* ctl = (LAS unsigned*)(F.lds + NSA_CTL);
    __syncthreads();
    if (F.lane == 0) ctl[F.wave] = tile_or;
    LDS_WAIT(); __syncthreads();
    unsigned rem = 0u;
#pragma unroll
    for (int w = 0; w < 8; ++w) rem |= ctl[w];
    rem = (unsigned)__builtin_amdgcn_readfirstlane((int)rem);
    bf16x8 qf[2][2];
#pragma unroll
    for (int r = 0; r < 2; ++r)
#pragma unroll
        for (int ks = 0; ks < 2; ++ks) { const v4u raw = *(const v4u*)(z + (size_t)m * NZ + ZC_Q + (h0 + r) * 64 + 8 * fq + 32 * ks); float f[8]; unpk8(raw, f);
            constexpr float QS = 0.125f * 1.4426950408889634f; v4u w; w.x = pk2(f[0] * QS, f[1] * QS); w.y = pk2(f[2] * QS, f[3] * QS); w.z = pk2(f[4] * QS, f[5] * QS); w.w = pk2(f[6] * QS, f[7] * QS);
            qf[r][ks] = __builtin_bit_cast(bf16x8, w); }
    NsaState St;
#pragma unroll
    for (int r = 0; r < 2; ++r) { St.mrun[r] = -1e30f; St.lrun[r] = 0.f;
#pragma unroll
        for (int dt = 0; dt < 4; ++dt) St.O[r][dt] = (f32x4){0.f, 0.f, 0.f, 0.f}; }
    const float slope0 = 1.4426950408889634f * __uint_as_float((unsigned)(127 - (h0 + 1)) << 23);
    const int srow = F.tid >> 3, sc = F.tid & 7;
    const bf16* ksrc = Kb + (size_t)srow * NZ + sc * 8; const bf16* vsrc = VT + (size_t)srow * SEQ + sc * 8;
    const int kdst = srow * NSA_KP + sc * 16, vdst = 64 * NSA_KP + srow * NSA_VP + sc * 16;
    const LAS unsigned char* kfr = F.lds + fr * NSA_KP + 16 * fq; const LAS unsigned char* vfr = F.lds + 64 * NSA_KP + fr * NSA_VP + 8 * fq;
    int kb = __builtin_ctz(rem); rem &= rem - 1u;
    v4u kreg = *(const v4u*)(ksrc + (size_t)64 * kb * NZ), vreg = *(const v4u*)(vsrc + 64 * kb);
    *(LAS v4u*)(F.lds + kdst) = kreg; *(LAS v2u*)(F.lds + vdst) = (v2u){vreg.x, vreg.y}; *(LAS v2u*)(F.lds + vdst + 8) = (v2u){vreg.z, vreg.w};
    LDS_WAIT(); __syncthreads();
    int buf = 0;
    for (;;) {
        int kbn = -1;
        if (rem) { kbn = __builtin_ctz(rem); rem &= rem - 1u; kreg = *(const v4u*)(ksrc + (size_t)64 * kbn * NZ); vreg = *(const v4u*)(vsrc + 64 * kbn); }
        __builtin_amdgcn_sched_barrier(0);
        if ((tile_or >> kb) & 1u) {
            if ((full >> kb) & 1u) nsa_block<WHICH, false>(St, kfr + buf * NSA_BUF, vfr + buf * NSA_BUF, qf, kb, mymask, t, fq, slope0);
            else nsa_block<WHICH, true>(St, kfr + buf * NSA_BUF, vfr + buf * NSA_BUF, qf, kb, mymask, t, fq, slope0);
        }
        __builtin_amdgcn_sched_barrier(0);
        if (kbn < 0) break;
        buf ^= 1;
        *(LAS v4u*)(F.lds + buf * NSA_BUF + kdst) = kreg; *(LAS v2u*)(F.lds + buf * NSA_BUF + vdst) = (v2u){vreg.x, vreg.y}; *(LAS v2u*)(F.lds + buf * NSA_BUF + vdst + 8) = (v2u){vreg.z, vreg.w};
        LDS_WAIT(); __syncthreads();
        kb = kbn;
    }
    const float* zg = (const float*)(F.ws + WS_ZGATE); const float* gb = F.ap->in[21];
    bf16* Y = (bf16*)(F.ws + WS_YB + (size_t)(1 + WHICH) * 16 * MiB);
#pragma unroll
    for (int r = 0; r < 2; ++r) { float l = St.lrun[r]; l += __shfl_xor(l, 16); l += __shfl_xor(l, 32);
        const int hh = h0 + r; const float gate = sigmoidf_(zg[(size_t)m * 32 + hh * 3 + 1 + WHICH] + gb[hh * 3 + 1 + WHICH]); const float f = gate / l;
#pragma unroll
        for (int dt = 0; dt < 4; ++dt) *(v2u*)(Y + (size_t)m * 512 + hh * 64 + 16 * dt + 4 * fq) = pk4(St.O[r][dt] * f); }
}
__device__ __forceinline__ void p4_phase(Frame& F) {
    for (int it = F.vcu; it < 512; it += F.G) { nsa_wg_task<1>(F, it); nsa_wg_task<0>(F, 511 - it); }
}

typedef short v4i16_t __attribute__((ext_vector_type(4)));
__device__ __forceinline__ bf16x8 tr_lo(const LAS unsigned char* p) {
    const v4i16_t t = __builtin_amdgcn_ds_read_tr16_b64_v4i16((LAS v4i16_t*)p);
    return (bf16x8){t[0], t[1], t[2], t[3], 0, 0, 0, 0};
}
__device__ __forceinline__ bf16x8 lo4(v2u g) { v4u w; w.x = g.x; w.y = g.y; w.z = 0u; w.w = 0u; return __builtin_bit_cast(bf16x8, w); }
__device__ __forceinline__ bf16x8 cat8(v2u a, v2u b) { v4u w; w.x = a.x; w.y = a.y; w.z = b.x; w.w = b.y; return __builtin_bit_cast(bf16x8, w); }
struct ChunkOps { v2u pA[2][2], rA[2][2], g[4]; f32x4 ac[4]; bf16x8 aq[4], ak[4], bv; };
__device__ __forceinline__ void chunk_load(const LAS unsigned char* sl, ChunkOps& X, int lane) {
    const int fr = lane & 15, fq = lane >> 4;
#pragma unroll
    for (int m = 0; m < 2; ++m) { X.pA[m][0] = *(const LAS v2u*)(sl + CH_P + fr * CH_PP + 64 * m + 8 * fq); X.pA[m][1] = *(const LAS v2u*)(sl + CH_P + fr * CH_PP + 64 * m + 32 + 8 * fq);
        X.rA[m][0] = *(const LAS v2u*)(sl + CH_R + fr * CH_PP + 64 * m + 8 * fq); X.rA[m][1] = *(const LAS v2u*)(sl + CH_R + fr * CH_PP + 64 * m + 32 + 8 * fq); }
#pragma unroll
    for (int x = 0; x < 4; ++x) X.g[x] = *(const LAS v2u*)(sl + CH_G + 512 * x + (fr * 16 + 4 * fq) * 2);
    X.bv = tr_lo(sl + CH_V + 8 * lane);
#pragma unroll
    for (int jt = 0; jt < 4; ++jt) { X.aq[jt] = tr_lo(sl + CH_Q + jt * 512 + 8 * lane); X.ak[jt] = tr_lo(sl + CH_K + jt * 512 + 8 * lane);
        X.ac[jt] = *(const LAS f32x4*)(sl + CH_AC + (16 * jt + 4 * fq) * 4); }
}
__device__ __forceinline__ bf16x8 lo4t(bf16x8 t) { return t; }
__device__ __forceinline__ void chunk_math(const ChunkOps& X, f32x4 (&S)[4], f32x4& o_out) {
    bf16x8 bs[2];
#pragma unroll
    for (int m = 0; m < 2; ++m) { v4u w; w.x = pk2(S[2 * m][0], S[2 * m][1]); w.y = pk2(S[2 * m][2], S[2 * m][3]); w.z = pk2(S[2 * m + 1][0], S[2 * m + 1][1]); w.w = pk2(S[2 * m + 1][2], S[2 * m + 1][3]); bs[m] = __builtin_bit_cast(bf16x8, w); }
    const f32x4 z4 = (f32x4){0.f, 0.f, 0.f, 0.f};
    const bf16x8 bv = lo4t(X.bv);
    f32x4 y = MFMA16(cat8(X.pA[0][0], X.pA[0][1]), bs[0], z4); y = MFMA16(cat8(X.pA[1][0], X.pA[1][1]), bs[1], y); y = MFMA16(lo4(X.g[0]), bv, y);
    f32x4 o = MFMA16(cat8(X.rA[0][0], X.rA[0][1]), bs[0], z4); o = MFMA16(cat8(X.rA[1][0], X.rA[1][1]), bs[1], o); o = MFMA16(lo4(X.g[3]), bv, o);
    const bf16x8 by = lo4(pk4(y));
    const f32x4 u = MFMA16(lo4(X.g[1]), by, z4);
    const bf16x8 bu = lo4(pk4(u));
    o_out = MFMA16(lo4(X.g[2]), bu, o);
#pragma unroll
    for (int jt = 0; jt < 4; ++jt) { S[jt] = MFMA16(lo4t(X.aq[jt]), bu, S[jt]); S[jt] = MFMA16(lo4t(X.ak[jt]), bv, S[jt]); S[jt] = S[jt] * X.ac[jt]; }
}
#ifndef SC_CONVW
#define SC_CONVW 3
#endif
constexpr int SC_NS = 7, SC_AHEAD = 5, SC_CTL = SC_NS * CH_SLOT, SCAN_TR_OFF = 81920;
__device__ __forceinline__ void scan_dma(const unsigned char* rec, const bf16* vt, LAS unsigned char* slot, int lane) {
#pragma unroll
    for (int i = 0; i < 10; ++i) __builtin_amdgcn_global_load_lds((const unsigned*)(rec + (lane + 64 * i) * 16), (LAS unsigned*)(slot + i * 1024), 16, 0, 0);
    if (lane < 48) __builtin_amdgcn_global_load_lds((const unsigned*)(rec + (lane + 640) * 16), (LAS unsigned*)(slot + 10240), 16, 0, 0);
    if (lane < 32) __builtin_amdgcn_global_load_lds((const unsigned*)(vt + (size_t)(lane >> 1) * 512 + 8 * (lane & 1)), (LAS unsigned*)(slot + CH_V), 16, 0, 0);
}
__device__ __forceinline__ int sc_ld(LAS int* p) { int v; const unsigned a = (unsigned)(size_t)p; asm volatile("ds_read_b32 %0, %1\n\ts_waitcnt lgkmcnt(0)" : "=&v"(v) : "v"(a) : "memory"); return v; }
__device__ __forceinline__ void sc_st(LAS int* p, int v) { const unsigned a = (unsigned)(size_t)p; asm volatile("ds_write_b32 %0, %1" :: "v"(a), "v"(v) : "memory"); }
#define SC_LD(p) sc_ld(p)
#define SC_ST(p, v) sc_st((p), (v))
__device__ __forceinline__ void p5_scan(Frame& F, bool extras = true, int abl = 0) {
    LAS int* ctl = (LAS int*)(F.lds + SC_CTL);
    if (F.tid < 4) ctl[F.tid] = 0;
    LDS_WAIT(); __syncthreads();
    constexpr int NKQ = (tri::NITEMS - tri::E12) / 256;
    LAS float* mytile = (LAS float*)(F.lds + SCAN_TR_OFF + F.wave * 8448);
    const int bh = F.vcu >> 2, b = bh >> 3, h = bh & 7, i0 = (F.vcu & 3) * 16;
    if (F.wave == 0) {
        if (abl & 1) return;
        __builtin_amdgcn_s_setprio(3);
        float* o0 = (float*)(F.ws + WS_XN) + (size_t)b * SEQ * 512 + h * 64 + i0;
        const int fr = F.lane & 15, fq = F.lane >> 4;
        f32x4 S[4];
#pragma unroll
        for (int jt = 0; jt < 4; ++jt) S[jt] = (f32x4){0.f, 0.f, 0.f, 0.f};
        ChunkOps XA, XB;
        while (SC_LD(&ctl[0]) <= 0) __builtin_amdgcn_s_sleep(1);
        asm volatile("" ::: "memory");
        chunk_load(F.lds, XA, F.lane);
        LDS_WAIT(); asm volatile("" ::: "memory");
        if (F.lane == 0) SC_ST(&ctl[1], 1);
#define SCAN_ITER(XC, XN_, c_) do { const int cc = (c_); \
            if (cc + 1 < 128) { while (SC_LD(&ctl[0]) <= cc + 1) __builtin_amdgcn_s_sleep(1); asm volatile("" ::: "memory"); chunk_load(F.lds + ((cc + 1) % SC_NS) * CH_SLOT, XN_, F.lane); } \
            __builtin_amdgcn_sched_barrier(0); \
            f32x4 o; chunk_math(XC, S, o); \
            __builtin_amdgcn_sched_barrier(0); \
            float* orow = o0 + (size_t)cc * 16 * 512; \
            _Pragma("unroll") for (int rg = 0; rg < 4; ++rg) { float* pp = orow + (size_t)(4 * fq + rg) * 512 + fr; const float vv = o[rg]; asm volatile("global_store_dword %0, %1, off" :: "v"(pp), "v"(vv) : "memory"); } \
            if (cc + 1 < 128) { LDS_WAIT(); asm volatile("" ::: "memory"); if (F.lane == 0) SC_ST(&ctl[1], cc + 2); } } while (0)
#pragma unroll 1
        for (int c = 0; c < 128; c += 2) { SCAN_ITER(XA, XB, c); SCAN_ITER(XB, XA, c + 1); }
#undef SCAN_ITER
        asm volatile("s_waitcnt vmcnt(0)" ::: "memory");
        __builtin_amdgcn_s_setprio(0);
        if (F.lane == 0) SC_ST(&ctl[3], 1);
        if (!(abl & 2)) tr_run_q(F, mytile, &ctl[2], tri::E12 + F.vcu, F.G, NKQ);
    } else if (F.wave == 1) {
        if (abl & 1) return;
        const unsigned char* rec0 = F.ws + WS_S + ((size_t)(b * 128) * 8 + h) * CH_REC;
        const bf16* vt0 = (const bf16*)F.out + (size_t)b * SEQ * 512 + h * 64 + i0;
        for (int n = 0; n < 128; ++n) {
            while (SC_LD(&ctl[1]) < n - SC_NS + 1) __builtin_amdgcn_s_sleep(1);
            asm volatile("" ::: "memory");
            scan_dma(rec0 + (size_t)n * 8 * CH_REC, vt0 + (size_t)n * 16 * 512, F.lds + (n % SC_NS) * CH_SLOT, F.lane);
            if (n >= SC_AHEAD) { asm volatile("s_waitcnt vmcnt(60)" ::: "memory"); if (F.lane == 0) SC_ST(&ctl[0], n - SC_AHEAD + 1); }
        }
        asm volatile("s_waitcnt vmcnt(48)" ::: "memory"); if (F.lane == 0) SC_ST(&ctl[0], 124);
        asm volatile("s_waitcnt vmcnt(36)" ::: "memory"); if (F.lane == 0) SC_ST(&ctl[0], 125);
        asm volatile("s_waitcnt vmcnt(24)" ::: "memory"); if (F.lane == 0) SC_ST(&ctl[0], 126);
        asm volatile("s_waitcnt vmcnt(12)" ::: "memory"); if (F.lane == 0) SC_ST(&ctl[0], 127);
        asm volatile("s_waitcnt vmcnt(0)" ::: "memory"); if (F.lane == 0) SC_ST(&ctl[0], 128);
        if (!(abl & 2)) { while (SC_LD(&ctl[3]) == 0) __builtin_amdgcn_s_sleep(8); tr_run_q(F, mytile, &ctl[2], tri::E12 + F.vcu, F.G, NKQ); }
    } else {
        const int w2 = F.vcu * 6 + (F.wave - 2), NW2 = F.G * 6;
        if (!(abl & 2) && F.wave - 2 < SC_CONVW) tr_run_q(F, mytile, &ctl[2], tri::E12 + F.vcu, F.G, NKQ);
        if (!extras) return;
        for (int mb = w2; mb < M; mb += 4 * NW2) {
            v4u a0[4], a1[4], a2[4];
#pragma unroll
            for (int u = 0; u < 4; ++u) { const int mr = (mb + u * NW2 < M) ? mb + u * NW2 : mb; const bf16* y0 = (const bf16*)(F.ws + WS_YB) + (size_t)mr * 512 + 8 * F.lane; a0[u] = *(const v4u*)y0; a1[u] = *(const v4u*)(y0 + 8 * MiB); a2[u] = *(const v4u*)(y0 + 16 * MiB); }
#pragma unroll
            for (int u = 0; u < 4; ++u) { float f0[8], f1[8], f2[8]; unpk8(a0[u], f0); unpk8(a1[u], f1); unpk8(a2[u], f2);
                v4u w; w.x = pk2(f0[0] + f1[0] + f2[0], f0[1] + f1[1] + f2[1]); w.y = pk2(f0[2] + f1[2] + f2[2], f0[3] + f1[3] + f2[3]); w.z = pk2(f0[4] + f1[4] + f2[4], f0[5] + f1[5] + f2[5]); w.w = pk2(f0[6] + f1[6] + f2[6], f0[7] + f1[7] + f2[7]);
                if (mb + u * NW2 < M) *(v4u*)((bf16*)(F.ws + WS_YB) + (size_t)(mb + u * NW2) * 512 + 8 * F.lane) = w; } }
        const float* p = F.ap->in[1]; bf16* PB = (bf16*)(F.ws + WS_PBF);
        constexpr size_t NV = (size_t)M * 256 / 4;
        for (size_t b0 = (size_t)w2 * 64 + F.lane; b0 < NV; b0 += (size_t)8 * NW2 * 64) {
            f32x4 pv[8];
#pragma unroll
            for (int i = 0; i < 8; ++i) { const size_t idx = b0 + (size_t)i * NW2 * 64; pv[i] = (idx < NV) ? *(const f32x4*)(p + idx * 4) : (f32x4){0.f, 0.f, 0.f, 0.f}; }
#pragma unroll
            for (int i = 0; i < 8; ++i) { const size_t idx = b0 + (size_t)i * NW2 * 64; if (idx < NV) *(v2u*)(PB + idx * 4) = pk4(pv[i]); } }
        if (!(abl & 2) && F.wave - 2 >= SC_CONVW) { while (SC_LD(&ctl[3]) == 0) __builtin_amdgcn_s_sleep(8); tr_run_q(F, mytile, &ctl[2], tri::E12 + F.vcu, F.G, NKQ); }
    }
}

struct P6Par { float lw[8], lb[8]; };
__device__ __forceinline__ void p6_rows2(Frame& F, int ma, int mb_, const P6Par& P) {
    const int l = F.lane, c = 8 * l, h = l >> 3;
    f32x4 oa[2][2]; v4u vv_[2], gg_[2]; float bsv[2];
#pragma unroll
    for (int u = 0; u < 2; ++u) { const int m = u ? mb_ : ma;
        const float* oraw = (const float*)(F.ws + WS_XN) + (size_t)m * 512 + c;
        oa[u][0] = *(const f32x4*)oraw; oa[u][1] = *(const f32x4*)(oraw + 4); bsv[u] = ((const float*)(F.ws + WS_BONUS))[(size_t)m * 8 + h];
        vv_[u] = *(const v4u*)((const bf16*)F.out + (size_t)m * 512 + c); gg_[u] = *(const v4u*)((const bf16*)(F.ws + WS_G) + (size_t)m * 512 + c);
    }
    __builtin_amdgcn_sched_barrier(0);
#pragma unroll
    for (int u = 0; u < 2; ++u) { const int m = u ? mb_ : ma;
        float o[8] = {oa[u][0].x, oa[u][0].y, oa[u][0].z, oa[u][0].w, oa[u][1].x, oa[u][1].y, oa[u][1].z, oa[u][1].w};
        float s = 0.f;
#pragma unroll
        for (int j = 0; j < 8; ++j) s += o[j];
        s += __shfl_xor(s, 1); s += __shfl_xor(s, 2); s += __shfl_xor(s, 4);
        const float mu = s * (1.f / 64.f); float q = 0.f;
#pragma unroll
        for (int j = 0; j < 8; ++j) { o[j] -= mu; q += o[j] * o[j]; }
        q += __shfl_xor(q, 1); q += __shfl_xor(q, 2); q += __shfl_xor(q, 4);
        const float rstd = 1.0f / sqrtf(q * (1.f / 64.f) + GN_EPS);
        float vv[8], gg[8];
        unpk8(vv_[u], vv); unpk8(gg_[u], gg);
        const float bs = bsv[u];
        float y[8];
#pragma unroll
        for (int j = 0; j < 8; ++j) y[j] = (o[j] * rstd * P.lw[j] + P.lb[j] + bs * vv[j]) * gg[j];
        v4u w; w.x = pk2(y[0], y[1]); w.y = pk2(y[2], y[3]); w.z = pk2(y[4], y[5]); w.w = pk2(y[6], y[7]);
        *(v4u*)((bf16*)(F.ws + WS_YRW) + (size_t)m * 512 + c) = w;
    }
}
__device__ __forceinline__ void p6_phase(Frame& F) {
    const int l = F.lane, c = 8 * l;
    P6Par P;
#pragma unroll
    for (int j = 0; j < 8; ++j) { P.lw[j] = F.ap->in[13][c + j]; P.lb[j] = F.ap->in[14][c + j]; }
    for (int m = F.gw; m < M; m += 2 * F.NGW) p6_rows2(F, m, m + F.NGW, P);
}

struct RouteW { f32x4 wv[3][8]; };
__device__ __forceinline__ void route_ldx(Frame& F, int tile, v4u (&xv)[4]) {
    const int fr = F.lane & 15, fq = F.lane >> 4; const bf16* xp = (const bf16*)(F.ws + WS_XN) + (size_t)(tile * 16 + fr) * D + F.wave * 128 + 8 * fq;
#pragma unroll
    for (int g = 0; g < 4; ++g) xv[g] = *(const v4u*)(xp + 32 * g);
}
__device__ __forceinline__ void route_tile(Frame& F, int tile, const RouteW& W, const v4u (&xv_)[4], int par) {
    const int fr = F.lane & 15, fq = F.lane >> 4, m0 = tile * 16;
    f32x4 acc[3] = {(f32x4){0.f, 0.f, 0.f, 0.f}, (f32x4){0.f, 0.f, 0.f, 0.f}, (f32x4){0.f, 0.f, 0.f, 0.f}};
    float ssq = 0.f;
#pragma unroll
    for (int g2 = 0; g2 < 4; ++g2) {
        float xf[8]; unpk8(xv_[g2], xf);
#pragma unroll
        for (int hh = 0; hh < 2; ++hh) { const int g = 2 * g2 + hh;
            ssq += (xf[4 * hh] * xf[4 * hh] + xf[4 * hh + 1] * xf[4 * hh + 1]) + (xf[4 * hh + 2] * xf[4 * hh + 2] + xf[4 * hh + 3] * xf[4 * hh + 3]);
#pragma unroll
            for (int s = 0; s < 4; ++s)
#pragma unroll
                for (int ct = 0; ct < 3; ++ct) acc[ct] = __builtin_amdgcn_mfma_f32_16x16x4f32(W.wv[ct][g][s], xf[4 * hh + s], acc[ct], 0, 0, 0); }
    }
    ssq += __shfl_xor(ssq, 16); ssq += __shfl_xor(ssq, 32);
    LAS float* red = (LAS float*)(F.lds + par * 32768);
    LAS float* ssqb = red + 8 * 3 * 64 * 4; LAS float* rsb = ssqb + 128;
#pragma unroll
    for (int ct = 0; ct < 3; ++ct) *(LAS f32x4*)(red + ((F.wave * 3 + ct) * 64 + F.lane) * 4) = acc[ct];
    if (fq == 0) ssqb[F.wave * 16 + fr] = ssq;
    LDS_WAIT(); __syncthreads();
    if (F.wave == 0) { float st = 0.f;
#pragma unroll
      for (int w = 0; w < 8; ++w) st += ssqb[w * 16 + (F.lane & 15)];
      const float rs = 1.0f / sqrtf(st * (1.f / D) + NORM_EPS);
      if (fq == 0) ((float*)(F.ws + WS_RSE))[m0 + fr] = rs;
#pragma unroll
      for (int ct = 0; ct < 3; ++ct) { f32x4 t = (f32x4){0.f, 0.f, 0.f, 0.f};
#pragma unroll
          for (int w = 0; w < 8; ++w) t = t + *(const LAS f32x4*)(red + ((w * 3 + ct) * 64 + F.lane) * 4);
          *(f32x4*)((float*)(F.ws + WS_LOGITS) + (size_t)(m0 + fr) * 48 + 16 * ct + 4 * fq) = t * rs; } }
}
__device__ __forceinline__ void p9_phase(Frame& F, int rep_ = 0) {
    const int fr = F.lane & 15, fq = F.lane >> 4;
    RouteW W;
    { const float* wp = (const float*)(F.ws + WS_SMALLW + SW_ROUTEW) + (size_t)fr * D + F.wave * 128 + 8 * fq;
#pragma unroll
      for (int ct = 0; ct < 3; ++ct)
#pragma unroll
          for (int g = 0; g < 8; ++g) W.wv[ct][g] = *(const f32x4*)(wp + (size_t)ct * 16 * D + 32 * (g >> 1) + 4 * (g & 1)); }
    v4u xa[4], xb[4];
    int tile = F.vcu, par = 0;
    if (tile < 1024) route_ldx(F, tile, xa);
    while (tile < 1024) {
        const int nt = tile + F.G;
        if (nt < 1024) route_ldx(F, nt, xb);
        __builtin_amdgcn_sched_barrier(0);
        route_tile(F, tile, W, xa, par);
#pragma unroll
        for (int g = 0; g < 4; ++g) xa[g] = xb[g];
        tile = nt; par ^= 1;
    }
}

__device__ __forceinline__ void p9b_phase(Frame& F) {
    if (F.wave != 0) return;
    for (int base = F.vcu * 64; base < M; base += F.G * 64) {
        const int tok = base + F.lane;
        const float* lgp = (const float*)(F.ws + WS_LOGITS) + (size_t)tok * 48;
        float lg[36];
#pragma unroll
        for (int q = 0; q < 9; ++q) { const f32x4 v = *(const f32x4*)(lgp + 4 * q); lg[4 * q] = v.x; lg[4 * q + 1] = v.y; lg[4 * q + 2] = v.z; lg[4 * q + 3] = v.w; }
        const float* bg = F.ap->in[27]; const float* br = F.ap->in[29];
        float gl[4]; int gs = 0; float gm = -3.0e38f;
#pragma unroll
        for (int c = 0; c < 4; ++c) { gl[c] = lg[c] + bg[c]; if (gl[c] > gm) { gm = gl[c]; gs = c; } }
        float gsum = 0.f;
#pragma unroll
        for (int c = 0; c < 4; ++c) gsum += __expf(gl[c] - gm);
        const float pgroup = 1.0f / gsum;
        float el[8]; float em = -3.0e38f;
#pragma unroll
        for (int c = 0; c < 8; ++c) { const float lv = gs == 0 ? lg[4 + c] : (gs == 1 ? lg[12 + c] : (gs == 2 ? lg[20 + c] : lg[28 + c])); el[c] = lv + br[gs * 8 + c]; em = fmaxf(em, el[c]); }
        int i1 = 0; float v1 = -3.0e38f;
#pragma unroll
        for (int c = 0; c < 8; ++c) if (el[c] > v1) { v1 = el[c]; i1 = c; }
        int i2 = 0; float v2 = -3.0e38f;
#pragma unroll
        for (int c = 0; c < 8; ++c) if (c != i1 && el[c] > v2) { v2 = el[c]; i2 = c; }
        const float p1 = __expf(v1 - em), p2 = __expf(v2 - em);
        const float g1 = pgroup * p1 / (p1 + p2), g2 = pgroup * p2 / (p1 + p2);
        const int e1 = gs * 8 + i1, e2 = gs * 8 + i2;
        const unsigned long long lt = (1ull << F.lane) - 1ull;
        int r1 = 0, r2 = 0, mycnt = 0;
        for (int e = 0; e < 32; ++e) {
            const unsigned long long m1 = __ballot(e1 == e), m2 = __ballot(e2 == e);
            const int c1 = __popcll(m1), c2 = __popcll(m2);
            if (e1 == e) r1 = __popcll(m1 & lt);
            if (e2 == e) r2 = c1 + __popcll(m2 & lt);
            if (F.lane == e) mycnt = c1 + c2;
        }
        unsigned* cnt = (unsigned*)(F.ws + WS_CTL) + CW_CNT; int* list = (int*)(F.ws + WS_LIST); float* gateA = (float*)(F.ws + WS_GATEA); unsigned* slotA = (unsigned*)(F.ws + WS_SLOTA);
        int bs = 0;
        if (F.lane < 32 && mycnt > 0) bs = (int)atomicAdd(&cnt[F.lane], (unsigned)mycnt);
        const unsigned q1 = (unsigned)(__shfl(bs, e1) + r1), q2 = (unsigned)(__shfl(bs, e2) + r2);
        gateA[tok * 2 + 0] = g1; gateA[tok * 2 + 1] = g2;
        list[(size_t)e1 * 16384 + q1] = tok * 2 + 0; slotA[tok * 2 + 0] = ((unsigned)e1 << 16) | q1;
        list[(size_t)e2 * 16384 + q2] = tok * 2 + 1; slotA[tok * 2 + 1] = ((unsigned)e2 << 16) | q2;
    }
}

__device__ __forceinline__ void p12_rows2(Frame& F, int ma, int mb_, int prelane) {
    const unsigned* slotA = (const unsigned*)(F.ws + WS_SLOTA); const float* gateA = (const float*)(F.ws + WS_GATEA);
    unsigned sl[2][2]; float gt[2][2];
#pragma unroll
    for (int u = 0; u < 2; ++u) { const int m = u ? mb_ : ma; sl[u][0] = slotA[2 * m]; sl[u][1] = slotA[2 * m + 1]; gt[u][0] = gateA[2 * m]; gt[u][1] = gateA[2 * m + 1]; }
    f32x4 xv[2][4]; v2u cv[2][2][4]; float se[2];
#pragma unroll
    for (int u = 0; u < 2; ++u) { const int m = u ? mb_ : ma;
        const bf16* x1 = (const bf16*)(F.ws + WS_XN) + (size_t)m * D;
        se[u] = (F.lane < 16) ? ((const float*)(F.ws + WS_ZGATE + 1 * MiB))[(size_t)m * 16 + F.lane] : 0.f;
#pragma unroll
        for (int j = 0; j < 4; ++j) { const int o = 4 * F.lane + 256 * j; xv[u][j] = unpk4(*(const v2u*)(x1 + o)); }
#pragma unroll
        for (int k = 0; k < 2; ++k) { const unsigned s = (unsigned)__builtin_amdgcn_readfirstlane((int)sl[u][k]); const int pre = __builtin_amdgcn_readlane(prelane, (int)(s >> 16));
            const bf16* cp = (const bf16*)(F.ws + WS_Z + 64 * MiB) + ((size_t)pre * 256 + (s & 0xffffu)) * D;
#pragma unroll
            for (int j = 0; j < 4; ++j) cv[u][k][j] = *(const v2u*)(cp + 4 * F.lane + 256 * j); } }
    __builtin_amdgcn_sched_barrier(0);
    float s2[2];
#pragma unroll
    for (int u = 0; u < 2; ++u) { s2[u] = 0.f;
#pragma unroll
        for (int j = 0; j < 4; ++j) { xv[u][j] = xv[u][j] + unpk4(cv[u][0][j]) * gt[u][0] + unpk4(cv[u][1][j]) * gt[u][1];
            s2[u] += (xv[u][j].x * xv[u][j].x + xv[u][j].y * xv[u][j].y) + (xv[u][j].z * xv[u][j].z + xv[u][j].w * xv[u][j].w);
        } }
#pragma unroll
    for (int o = 1; o < 64; o <<= 1) {
#pragma unroll
        for (int u = 0; u < 2; ++u) { s2[u] += __shfl_xor(s2[u], o); se[u] += __shfl_xor(se[u], o); } }
#pragma unroll
    for (int u = 0; u < 2; ++u) { const int m = u ? mb_ : ma;
        const float rs = 1.0f / sqrtf(s2[u] * (1.f / D) + NORM_EPS); const float rse = 1.0f / sqrtf(se[u] * (1.f / D) + NORM_EPS);
        bf16* x2 = (bf16*)(F.ws + WS_S) + (size_t)m * D; if (F.lane == 0) { ((float*)(F.ws + WS_RSE))[M + m] = rs; ((float*)(F.ws + WS_RSE))[2 * M + m] = rse; }
#pragma unroll
        for (int j = 0; j < 4; ++j) { const int o = 4 * F.lane + 256 * j; *(v2u*)(x2 + o) = pk4(xv[u][j]); }
    }
}
__device__ __forceinline__ void p12_phase(Frame& F) {
    const unsigned* cnt = (const unsigned*)(F.ws + WS_CTL) + CW_CNT;
    int nt = (F.lane < 32) ? (((int)cnt[F.lane & 31] + 255) >> 8) : 0;
    int incl = nt;
#pragma unroll
    for (int o = 1; o < 32; o <<= 1) { const int v = __shfl_up(incl, o); if (F.lane >= o) incl += v; }
    const int prelane = incl - nt;
    for (int m = F.gw; m < M; m += 2 * F.NGW) p12_rows2(F, m, m + F.NGW, prelane);
}
__device__ __forceinline__ void p14_rows4(Frame& F, int mb) {
    const float* gf = F.ap->in[36];
    f32x4 v[4][4]; float s[4];
#pragma unroll
    for (int u = 0; u < 4; ++u) { const bf16* xr = (const bf16*)(F.ws + WS_Z) + (size_t)(mb + u * F.NGW) * D;
#pragma unroll
        for (int j = 0; j < 4; ++j) v[u][j] = unpk4(*(const v2u*)(xr + 4 * F.lane + 256 * j)); }
#pragma unroll
    for (int u = 0; u < 4; ++u) { s[u] = 0.f;
#pragma unroll
        for (int j = 0; j < 4; ++j) s[u] += (v[u][j].x * v[u][j].x + v[u][j].y * v[u][j].y) + (v[u][j].z * v[u][j].z + v[u][j].w * v[u][j].w); }
#pragma unroll
    for (int o = 1; o < 64; o <<= 1) {
#pragma unroll
        for (int u = 0; u < 4; ++u) s[u] += __shfl_xor(s[u], o); }
#pragma unroll
    for (int u = 0; u < 4; ++u) { const float rs = 1.0f / sqrtf(s[u] * (1.f / D) + NORM_EPS); float* orow = F.out + (size_t)(mb + u * F.NGW) * D;
#pragma unroll
        for (int j = 0; j < 4; ++j) { const int o = 4 * F.lane + 256 * j; *(f32x4*)(orow + o) = v[u][j] * rs * *(const f32x4*)(gf + o); } }
}

#ifndef MK_ONE_LAUNCH
#define MK_ONE_LAUNCH 1
#endif
constexpr int N_PHASES = 14;
__global__ void __launch_bounds__(NWAVES * 64, 2) mk_fwd(Args args) {
    extern __shared__ __attribute__((aligned(16))) unsigned char lds[];
    Frame F;
    F.lds = (LAS unsigned char*)lds;
    F.tid = threadIdx.x; F.lane = F.tid & 63; F.wave = __builtin_amdgcn_readfirstlane(F.tid >> 6);
    F.G = gridDim.x; { const int bx = blockIdx.x; F.vcu = (F.G % 8 == 0) ? (bx % 8) * (F.G / 8) + bx / 8 : bx; }
    F.gw = F.vcu * NWAVES + F.wave; F.NGW = F.G * NWAVES;
    F.ws = args.ws; F.out = args.out;
    F.ap = (ArgsP)__builtin_amdgcn_kernarg_segment_ptr();
    unsigned char* ws = args.ws;
    const int lo = args.ph_lo, hi = args.ph_hi;
#ifdef ONLY
#define IN(k) ((k) == ONLY && lo <= (k) && (k) < hi)
#else
#define IN(k) (lo <= (k) && (k) < hi)
#endif
#if MK_ONE_LAUNCH
    if (F.tid < 16) ((LAS unsigned*)(F.lds + MISC_OFF))[F.tid] = 0u;
    __syncthreads();
    XcdBarrier bar = xcd_barrier_post((unsigned*)(ws + WS_CTL) + CW_BAR, (volatile LAS unsigned*)(F.lds + MISC_OFF));
#define GRID_BAR(k) do { if (IN(k) && IN((k) + 1)) { if ((k) == 12) cg::this_grid().sync(); else xcd_barrier(bar); } } while (0)
#else
#define GRID_BAR(k) do { } while (0)
#endif
    LAS unsigned char* L = F.lds;
#ifdef PROBE_A
    unsigned long long* tsb = (unsigned long long*)(ws + WS_CTL + 32768);
    int n_st = 0;
#define STAMP() do { if (blockIdx.x == 0 && F.tid == 0) tsb[n_st] = __builtin_amdgcn_s_memrealtime(); ++n_st; } while (0)
    STAMP();
#else
#define STAMP() do { } while (0)
#endif
    const bf16* z = (const bf16*)(ws + WS_Z);

    if (IN(0)) { p0_prologue(F); } GRID_BAR(0); STAMP();

    if (IN(1)) {
        pg8::Gemm g{(const bf16*)(ws + WS_XN), (const bf16*)(ws + WS_WIN), M, NZ, D, nullptr}; pg8::StaticOrder S; S.init(M, NZ, F.G, (int)blockIdx.x);
        EpiStoreBf16 E{(bf16*)(ws + WS_Z), NZ};
        pg8::gemm_phase<EpiStoreBf16, pg8::StaticOrder, true, false>(L, g, S, E);
    } GRID_BAR(1); STAMP();

    if (IN(2)) { p2_prep(F); } GRID_BAR(2); STAMP();
    if (IN(3)) { p3_phase(F); } GRID_BAR(3); STAMP();
    if (IN(4)) { p4_phase(F); } GRID_BAR(4); STAMP();
    if (IN(5)) { if (F.G == 256) p5_scan(F); } GRID_BAR(5); STAMP();
    if (IN(6)) { p6_phase(F); } GRID_BAR(6); STAMP();

    if (IN(7)) {
        pg8::Gemm g{(const bf16*)(ws + WS_YRW), (const bf16*)(ws + WS_UR), 2 * M, 2 * D, 512, nullptr}; DualOrder S; S.S.init(M, D, F.G, (int)blockIdx.x);
        EpiMix2 E{z, (bf16*)(ws + WS_S + 64 * MiB), (unsigned*)(ws + WS_CTL) + CW_DEP2};
        pg8::gemm_phase<EpiMix2, DualOrder, true, false>(L, g, S, E);
    } STAMP();

    if (IN(8)) {
        pg8::Gemm g{(const bf16*)(ws + WS_S + 64 * MiB), (const bf16*)(ws + WS_WO), M, D, D, nullptr}; StaticOrderDep S; S.S.init(M, D, F.G, (int)blockIdx.x); S.dep = (const unsigned*)(ws + WS_CTL) + CW_DEP2;
        EpiResBf16 E{F.ap->in[0], (bf16*)(ws + WS_XN)};
        pg8::gemm_phase<EpiResBf16, StaticOrderDep, true, false>(L, g, S, E);
    } GRID_BAR(8); STAMP();

    if (IN(9)) { p9_phase(F); xcd_barrier(bar); p9b_phase(F); } GRID_BAR(9); STAMP();

    if (IN(10)) {
        pg8::Gemm g{(const bf16*)(ws + WS_XN), (const bf16*)(ws + WS_WGU), M, 1024, D, (const int*)(ws + WS_LIST), (const float*)(ws + WS_RSE)};
        pg8::moe_fill_tab((LAS int*)(F.lds + MISC_OFF - 256), (const unsigned*)(ws + WS_CTL) + CW_CNT); LDS_WAIT(); __syncthreads();
        pg8::MoeOrder S{(const LAS int*)(F.lds + MISC_OFF - 256), F.G, F.vcu, false, 0, nullptr};
        EpiMoe1 E{(bf16*)(ws + WS_S), (const LAS float*)(F.lds + pg8::STAGE_BYTES + 4096), (unsigned*)(ws + WS_CTL) + CW_DEP};
        pg8::gemm_phase<EpiMoe1, pg8::MoeOrder, true, true>(L, g, S, E);
    } STAMP();

    if (IN(11)) {
#ifndef NO_MOE2
        { pg8::Gemm g{(const bf16*)(ws + WS_S), (const bf16*)(ws + WS_WD), M, 1024, 512, nullptr};
          pg8::moe_fill_tab((LAS int*)(F.lds + MISC_OFF - 256), (const unsigned*)(ws + WS_CTL) + CW_CNT); LDS_WAIT(); __syncthreads();
          const LAS int* tb = (const LAS int*)(F.lds + MISC_OFF - 256); const int n10 = 4 * (tb[31] + ((tb[63] + 255) >> 8));
          pg8::MoeOrderT<true> S{tb, F.G, F.vcu, true, n10 % F.G, (const unsigned*)(ws + WS_CTL) + CW_DEP};
          EpiStoreBf16 E{(bf16*)(ws + WS_Z + 64 * MiB), D};
          pg8::gemm_phase<EpiStoreBf16, pg8::MoeOrderT<true>, true, false>(L, g, S, E); }
#endif
        { pg8::Gemm g2{(const bf16*)(ws + WS_PBF), (const bf16*)(ws + WS_WPP), M, D, 256, nullptr}; ErawOrder S2; S2.S.init(M, D, F.G, 0); S2.c = (int)blockIdx.x; S2.G = F.G;
          S2.nheavy = 0;
          EpiStoreSsq E2{(bf16*)(ws + WS_S + 64 * MiB), D, (float*)(ws + WS_ZGATE + 1 * MiB)};
          pg8::gemm_phase<EpiStoreSsq, ErawOrder, true, false>(L, g2, S2, E2); }
    } GRID_BAR(11); STAMP();

    if (IN(12)) { p12_phase(F); } GRID_BAR(12); STAMP();

    if (IN(13)) {
        pg8::Gemm g{(const bf16*)(ws + WS_S), (const bf16*)(ws + WS_WPG), M, D, D, nullptr}; pg8::StaticOrder S; S.init(M, D, F.G, (int)blockIdx.x);
        EpiPleNorm E{(const bf16*)(ws + WS_S), (const bf16*)(ws + WS_S + 64 * MiB), (const float*)(ws + WS_RSE) + 2 * M, F.ap->in[33], (const float*)(ws + WS_RSE) + M, F.ap->in[36], F.out, (float*)(ws + WS_ZGATE), (unsigned*)(ws + WS_CTL) + CW_PANEL, (LAS float*)(F.lds + 131072)};
        pg8::gemm_phase<EpiPleNorm, pg8::StaticOrder, true, false>(L, g, S, E);
    } STAMP();

#ifdef PROBE_A
    xcd_barrier(bar); STAMP(); __threadfence();
    if (blockIdx.x == 0 && F.tid == 0) { __threadfence(); }
    xcd_barrier(bar);
    {
        volatile unsigned long long* tv = (volatile unsigned long long*)tsb;
        const float dA = (float)(tv[PROBE_A + 1] - tv[PROBE_A]) * 0.01f, dB = (float)(tv[PROBE_B + 1] - tv[PROBE_B]) * 0.01f;
        for (size_t i = (size_t)blockIdx.x * 512 + F.tid; i < (size_t)M * D; i += (size_t)F.G * 512) F.out[i] = 10.0f * dB;
        __syncthreads();
        if (blockIdx.x == 0 && F.tid == 0) F.out[0] = 300.0f * dA;
    }
#endif
#undef IN
#undef GRID_BAR
}

extern "C" void kernel_launch(void* const* d_in, const int* in_sizes, int n_in, void* d_out, int out_size, void* d_ws, size_t ws_size, hipStream_t stream) {
    static int grid = 0;
    if (grid == 0) {
        if (n_in != 37 || out_size != M * D || ws_size < WS_END) { fprintf(stderr, "kernel_launch: unexpected problem (n_in %d, out %d, ws %zu < %zu); nothing launched\n", n_in, out_size, ws_size, (size_t)WS_END); grid = -1; return; }
        int dev = 0, cus = 0, per_cu = 0;
        if (hipGetDevice(&dev) != hipSuccess || hipDeviceGetAttribute(&cus, hipDeviceAttributeMultiprocessorCount, dev) != hipSuccess) { grid = -1; return; }
        if (hipFuncSetAttribute((const void*)mk_fwd, hipFuncAttributeMaxDynamicSharedMemorySize, LDS_BYTES) != hipSuccess) { fprintf(stderr, "kernel_launch: hipFuncSetAttribute failed\n"); grid = -1; return; }
        if (hipOccupancyMaxActiveBlocksPerMultiprocessor(&per_cu, (const void*)mk_fwd, NWAVES * 64, LDS_BYTES) != hipSuccess || per_cu < 1) { fprintf(stderr, "kernel_launch: occupancy query says %d blocks per CU\n", per_cu); (void)hipGetLastError(); grid = -1; return; }
        grid = cus;
        if (grid != 256) fprintf(stderr, "kernel_launch: %d CUs; this kernel is built for 256\n", grid);
    }
    if (grid < 0) return;
    (void)hipMemsetAsync((char*)d_ws + WS_CTL, 0, CTL_ZERO_BYTES, stream);
    Args a{};
    for (int i = 0; i < 37; ++i) a.in[i] = (const float*)d_in[i];
    a.out = (float*)d_out; a.ws = (unsigned char*)d_ws;
#if MK_ONE_LAUNCH
    a.ph_lo = 0; a.ph_hi = N_PHASES;
    void* kargs[] = {&a};
    hipError_t e = hipLaunchCooperativeKernel((const void*)mk_fwd, dim3(grid), dim3(NWAVES * 64), kargs, LDS_BYTES, stream);
    if (e != hipSuccess) fprintf(stderr, "kernel_launch: cooperative launch failed: %s (grid %d)\n", hipGetErrorString(e), grid);
#else
    for (int ph = 0; ph < N_PHASES; ++ph) { a.ph_lo = ph; a.ph_hi = ph + 1; hipLaunchKernelGGL(mk_fwd, dim3(grid), dim3(NWAVES * 64), LDS_BYTES, stream, a); }
#endif
}
```

```cpp
#include <hip/hip_runtime.h>
#include <hip/hip_cooperative_groups.h>
#include <cstdio>
#include <cstdint>
namespace cg = cooperative_groups;

namespace pg8 {
#define PG8_LAS __attribute__((address_space(3)))
typedef unsigned short bf16_t;
typedef short bf16x8 __attribute__((ext_vector_type(8)));
typedef float f32x4 __attribute__((ext_vector_type(4)));
typedef unsigned u32x4 __attribute__((ext_vector_type(4)));
typedef unsigned u32x2 __attribute__((ext_vector_type(2)));
constexpr int BM = 256, BK = 64, HALF = 128, HTB = HALF * BK * 2  , STAGE_BYTES = 8 * HTB, NXCD = 8, WGM = 8;

__host__ __device__ __forceinline__ int lds_byte(int r, int c) { const int st = (r >> 4) * 2 + (c >> 5), rr = r & 15, cc = c & 31, ob = rr * 64 + cc * 2; return st * 1024 + (ob ^ (((ob >> 9) & 1) << 5)); }
__host__ __device__ __forceinline__ void stage_rc(int b, int& R, int& C) { const int st = b / 1024, sb = b % 1024, swz = sb ^ (((sb >> 9) & 1) << 5); R = (st >> 1) * 16 + swz / 64; C = (st & 1) * 32 + (swz % 64) / 2; }
__host__ __device__ __forceinline__ int perm32(int rho) { const int n = rho >> 4, i = rho & 15; return 8 * (i >> 2) + 4 * n + (i & 3); }

struct Unit { int pm, pn, pmo, lt, nvalid, pnl; };
struct Gemm { const bf16_t* A; const bf16_t* Bt; int M, N, K; const int* rowidx; const float* rowscale; };

struct StaticOrder {
    static constexpr bool DEP = false, KEEP_ACC = false;
    int nM, nN, nwg, G, c;
    __host__ __device__ void init(int M, int N, int G_, int c_) { nM = M / BM; nN = N / BM; nwg = nM * nN; G = G_; c = c_; }
    __host__ __device__ bool next(int i, Unit& u) const {
        const long L = (long)i * G + c; if (L >= nwg) return false;
        int wgid = (int)L; { const int q = nwg / NXCD, r = nwg % NXCD, xcd = wgid % NXCD, off = wgid / NXCD; wgid = (xcd < r ? xcd * (q + 1) : r * (q + 1) + (xcd - r) * q) + off; }
        const int nig = WGM * nN, gid = wgid / nig, fm = gid * WGM, gsz = (nM - fm) < WGM ? (nM - fm) : WGM;
        u.pm = fm + ((wgid % nig) % gsz); u.pn = (wgid % nig) / gsz; u.pmo = u.pm; u.lt = u.pm; u.nvalid = 256; u.pnl = u.pn; return true;
    }
};
template <bool DEP_>
struct MoeOrderT {
    static constexpr bool DEP = DEP_, KEEP_ACC = false;
    const PG8_LAS int* tab; int G, c; bool a_is_out;
    int nheavy; const unsigned* dep;
    __device__ void wait(const Unit& u) const {
        const unsigned* p = dep + 16 * u.pmo; unsigned sp = 0;
        while (__hip_atomic_load(p, __ATOMIC_RELAXED, __HIP_MEMORY_SCOPE_AGENT) < 4u) { __builtin_amdgcn_s_sleep(2); if (++sp > (1u << 22)) break; }
        asm volatile("s_waitcnt vmcnt(0)" ::: "memory");
    }
    __device__ bool next(int i, Unit& u) const {
        int L;
        if constexpr (DEP_) { const int nl = G - nheavy; L = (c >= nheavy) ? (i < 2 ? i * nl + (c - nheavy) : 2 * nl + (i - 2) * G + c) : 2 * nl + i * G + c; }
        else L = i * G + c;
        const int tile = L >> 2, pnl = L & 3;
        const int lane = (int)__builtin_amdgcn_mbcnt_hi(~0u, __builtin_amdgcn_mbcnt_lo(~0u, 0u)), e_ = lane & 31;
        const int pre = tab[e_], ce = tab[32 + e_]; const int nt = (ce + 255) >> 8;
        const unsigned long long mk = __ballot(lane < 32 && tile >= pre && tile < pre + nt);
        if (mk == 0ull) return false;
        const int e = (int)__builtin_ctzll(mk);
        const int pre_e = __builtin_amdgcn_readlane(pre, e), ce_e = __builtin_amdgcn_readlane(ce, e);
        const int rt = tile - pre_e; u.pmo = tile; u.pm = a_is_out ? tile : 0; u.lt = e * 64 + rt; u.pn = e * 4 + pnl; u.pnl = pnl; const int rem = ce_e - rt * 256; u.nvalid = rem < 256 ? rem : 256; return true;
    }
};
typedef MoeOrderT<false> MoeOrder;
__device__ __forceinline__ void moe_fill_tab(PG8_LAS int* tab, const unsigned* cnt) {
    const int lane = (int)__builtin_amdgcn_mbcnt_hi(~0u, __builtin_amdgcn_mbcnt_lo(~0u, 0u));
    const int ce = (lane < 32) ? (int)cnt[lane & 31] : 0; const int nt = (ce + 255) >> 8;
    int incl = nt;
#pragma unroll
    for (int o = 1; o < 32; o <<= 1) { const int v = __shfl_up(incl, o); if (lane >= o) incl += v; }
    if (lane < 32) { tab[lane] = incl - nt; tab[32 + lane] = ce; }
}

__device__ __forceinline__ unsigned cvt_pk_bf16(float lo, float hi) { unsigned r; asm volatile("v_cvt_pk_bf16_f32 %0, %1, %2" : "=v"(r) : "v"(lo), "v"(hi)); return r; }

template <class Epi, class Sched, bool ALIGN_EPI, bool GATHER>
__device__ __forceinline__ void gemm_phase(PG8_LAS unsigned char* lds, const Gemm g, const Sched& S, const Epi& E) {
    const int tid = threadIdx.x, wid = __builtin_amdgcn_readfirstlane(tid >> 6), lane = tid & 63, wr = wid >> 2, wc = wid & 3, fr = lane & 15, fq = lane >> 4;
    constexpr int AUX_A = Sched::DEP ? 16 : 0;
    int K_ = g.K; asm volatile("" : "+s"(K_));
    const int K = K_, nt = K / BK;
    unsigned voffB[2]; int RA[2], CA[2];
#pragma unroll
    for (int i = 0; i < 2; ++i) { int R, C; stage_rc(tid * 16 + i * 8192, R, C); const int Rb = Epi::PERM ? ((R & ~31) + perm32(R & 31)) : R;
        RA[i] = R; CA[i] = C; voffB[i] = (unsigned)(Rb * K + C) * 2u; }
    const size_t kstep = (size_t)(BK * 2);
    const size_t hstep = (size_t)HALF * K * 2;
    const size_t tstep = 2 * hstep;
    const unsigned ldsw = (unsigned)wid * 1024u;
    const int aoff = lds_byte(wr * 64 + fr, fq * 8), boff = lds_byte(wc * 32 + fr, fq * 8);
    unsigned vA[2][2], vN[2][2];
    PG8_LAS int* rowl = (PG8_LAS int*)(lds + STAGE_BYTES);
    if constexpr (GATHER) {
        for (int i = 0; i < 4; ++i) { Unit uu; if (!S.next(i, uu)) break; if (tid < 256) { const int tk = (tid < uu.nvalid) ? (g.rowidx[(size_t)uu.lt * 256 + tid] >> 1) : 0; rowl[i * 256 + tid] = tk; ((PG8_LAS float*)(rowl + 1024))[i * 256 + tid] = g.rowscale[tk]; } }
        asm volatile("s_waitcnt vmcnt(0) lgkmcnt(0)" ::: "memory"); __builtin_amdgcn_s_barrier(); asm volatile("" ::: "memory");
    }
    auto compute_v = [&](const Unit& u, unsigned (&v)[2][2], int ui_) {
#pragma unroll
        for (int h = 0; h < 2; ++h)
#pragma unroll
            for (int i = 0; i < 2; ++i) {
                const int rl = h * HALF + RA[i];
                if constexpr (GATHER) { const int tok = rowl[ui_ * 256 + rl]; v[h][i] = ((unsigned)tok * (unsigned)K + (unsigned)CA[i]) * 2u; }
                else v[h][i] = ((unsigned)rl * (unsigned)K + (unsigned)CA[i]) * 2u;
            }
    };
#define PG8_SA(b, h) (((b) * 2 + (h)) * HTB)
#define PG8_SB(b, h) ((4 + (b) * 2 + (h)) * HTB)
#define PG8_STAGE_X(bufoff, gbase, voff, aux) do { _Pragma("unroll") for (int _i = 0; _i < 2; ++_i) \
        __builtin_amdgcn_global_load_lds((const unsigned*)((const char*)(gbase) + (voff)[_i]), (PG8_LAS unsigned*)(lds + (bufoff) + ldsw + _i * 8192), 16, 0, aux); } while (0)
#define PG8_STAGE(bufoff, gbase, voff) PG8_STAGE_X(bufoff, gbase, voff, 0)
#define PG8_STAGE_A(bufoff, gbase, voff) PG8_STAGE_X(bufoff, gbase, voff, AUX_A)
#define PG8_LDA(dst, b, h) do { _Pragma("unroll") for (int m = 0; m < 4; ++m) _Pragma("unroll") for (int k = 0; k < 2; ++k) dst[m][k] = *(const PG8_LAS bf16x8*)(lds + PG8_SA(b, h) + aoff + m * 2048 + k * 1024); } while (0)
#define PG8_LDB(dst, b, h) do { _Pragma("unroll") for (int n = 0; n < 2; ++n) _Pragma("unroll") for (int k = 0; k < 2; ++k) dst[n][k] = *(const PG8_LAS bf16x8*)(lds + PG8_SB(b, h) + boff + n * 2048 + k * 1024); } while (0)
#define PG8_MMA(ai, bj, At, Bt) do { __builtin_amdgcn_s_setprio(1); _Pragma("unroll") for (int m = 0; m < 4; ++m) _Pragma("unroll") for (int n = 0; n < 2; ++n) _Pragma("unroll") for (int k = 0; k < 2; ++k) \
        acc[ai][bj][m][n] = __builtin_amdgcn_mfma_f32_16x16x32_bf16(Bt[n][k], At[m][k], acc[ai][bj][m][n], 0, 0, 0); __builtin_amdgcn_s_setprio(0); } while (0)
#define PG8_WAIT_V(n) asm volatile("s_waitcnt vmcnt(" #n ")" ::: "memory")
#define PG8_WAIT_L(n) asm volatile("s_waitcnt lgkmcnt(" #n ")" ::: "memory")
#define PG8_BAR __builtin_amdgcn_s_barrier()
#define PG8_SCHED __builtin_amdgcn_sched_barrier(0)
    Unit cur, nxt; int ui = 0;
    if (!S.next(0, cur)) return;
    f32x4 acc[2][2][4][2];
#pragma unroll
    for (int a = 0; a < 2; ++a)
#pragma unroll
        for (int b = 0; b < 2; ++b)
#pragma unroll
            for (int m = 0; m < 4; ++m)
#pragma unroll
                for (int n = 0; n < 2; ++n) acc[a][b][m][n] = (f32x4){0.f, 0.f, 0.f, 0.f};
    bf16x8 At[4][2], B0[2][2], B1[2][2];
    if constexpr (Sched::DEP) { if (tid == 0) S.wait(cur); PG8_BAR; }
    compute_v(cur, vA, 0);
    const char* cA = (const char*)g.A + (GATHER ? (size_t)0 : (size_t)cur.pm * tstep); const char* cB = (const char*)g.Bt + (size_t)cur.pn * tstep;
    PG8_STAGE(PG8_SB(0, 0), cB, voffB); PG8_STAGE(PG8_SB(0, 1), cB + hstep, voffB); PG8_STAGE_A(PG8_SA(0, 0), cA, vA[0]); PG8_STAGE_A(PG8_SA(0, 1), cA, vA[1]);
    if (wr == 1) PG8_BAR;
    PG8_WAIT_V(2); PG8_BAR;
    PG8_STAGE(PG8_SB(1, 0), cB + kstep, voffB); PG8_STAGE_A(PG8_SA(1, 0), cA + kstep, vA[0]); PG8_STAGE(PG8_SB(1, 1), cB + hstep + kstep, voffB);
    PG8_WAIT_V(6); PG8_BAR;
    for (;;) {
        const bool has_next = S.next(ui + 1, nxt);
        if (has_next) compute_v(nxt, vN, ui + 1);
        else {
#pragma unroll
            for (int h = 0; h < 2; ++h)
#pragma unroll
                for (int i = 0; i < 2; ++i) vN[h][i] = vA[h][i];
        }
        const char* nA = has_next ? ((const char*)g.A + (GATHER ? (size_t)0 : (size_t)nxt.pm * tstep)) : cA; const char* nB = has_next ? (const char*)g.Bt + (size_t)nxt.pn * tstep : cB;
#pragma unroll 1
        for (int t = 0; t < nt; t += 2) {
            const bool last = (t == nt - 2);
            if constexpr (Sched::DEP) { if (last && has_next) { if (tid == 0) S.wait(nxt); PG8_BAR; } }
            const char* a1 = cA + (size_t)(t + 1) * kstep;
            const char* a2 = last ? nA : cA + (size_t)(t + 2) * kstep; const char* b2 = last ? nB : cB + (size_t)(t + 2) * kstep;
            const char* a3 = a2 + kstep; const char* b3 = b2 + kstep;
            unsigned vX0[2], vX1[2];
#pragma unroll
            for (int i = 0; i < 2; ++i) { vX0[i] = last ? vN[0][i] : vA[0][i]; vX1[i] = last ? vN[1][i] : vA[1][i]; }
            PG8_LDB(B0, 0, 0); PG8_LDB(B1, 0, 1); PG8_SCHED; PG8_LDA(At, 0, 0); PG8_STAGE_A(PG8_SA(1, 1), a1, vA[1]);
            PG8_WAIT_V(8); PG8_WAIT_L(0); PG8_BAR; PG8_MMA(0, 0, At, B0); PG8_MMA(0, 1, At, B1); PG8_BAR; PG8_SCHED;
            PG8_LDA(At, 0, 1); PG8_STAGE(PG8_SB(0, 0), b2, voffB); PG8_STAGE(PG8_SB(0, 1), b2 + hstep, voffB); PG8_STAGE_A(PG8_SA(0, 0), a2, vX0);
            PG8_WAIT_V(8); PG8_WAIT_L(0); PG8_BAR; PG8_MMA(1, 0, At, B0); PG8_MMA(1, 1, At, B1); PG8_BAR; PG8_SCHED;
            PG8_LDB(B0, 1, 0); PG8_LDB(B1, 1, 1); PG8_SCHED; PG8_LDA(At, 1, 0); PG8_STAGE_A(PG8_SA(0, 1), a2, vX1);
            PG8_WAIT_V(8); PG8_WAIT_L(0); PG8_BAR; PG8_MMA(0, 0, At, B0); PG8_MMA(0, 1, At, B1); PG8_BAR; PG8_SCHED;
            PG8_LDA(At, 1, 1); PG8_STAGE(PG8_SB(1, 0), b3, voffB); PG8_STAGE(PG8_SB(1, 1), b3 + hstep, voffB); PG8_STAGE_A(PG8_SA(1, 0), a3, vX0);
            PG8_WAIT_V(8); PG8_WAIT_L(0); PG8_BAR; PG8_MMA(1, 0, At, B0); PG8_MMA(1, 1, At, B1); PG8_BAR; PG8_SCHED;
        }
        if constexpr (ALIGN_EPI) { if (wr == 0) PG8_BAR; }
        if constexpr (GATHER) cur.pm = ui;
        E(acc, cur, wr, wc, fr, fq);
        if (!has_next) break;
        if constexpr (!Sched::KEEP_ACC) {
#pragma unroll
        for (int a = 0; a < 2; ++a)
#pragma unroll
            for (int b = 0; b < 2; ++b)
#pragma unroll
                for (int m = 0; m < 4; ++m)
#pragma unroll
                    for (int n = 0; n < 2; ++n) acc[a][b][m][n] = (f32x4){0.f, 0.f, 0.f, 0.f};
        }
        cur = nxt; cA = nA; cB = nB; ++ui;
#pragma unroll
        for (int h = 0; h < 2; ++h)
#pragma unroll
            for (int i = 0; i < 2; ++i) vA[h][i] = vN[h][i];
        if constexpr (ALIGN_EPI) { if (wr == 1) PG8_BAR; }
    }
    PG8_WAIT_V(0);
    if constexpr (!ALIGN_EPI) { if (wr == 0) PG8_BAR; }
    PG8_BAR;
#undef PG8_SA
#undef PG8_SB
#undef PG8_STAGE
#undef PG8_STAGE_X
#undef PG8_STAGE_A
#undef PG8_LDA
#undef PG8_LDB
#undef PG8_MMA
#undef PG8_WAIT_V
#undef PG8_WAIT_L
#undef PG8_BAR
#undef PG8_SCHED
}
}

constexpr int NWAVES = 8;
constexpr int M = 16384, D = 1024, SEQ = 2048, NBATCH = 8;
constexpr int NIN = 5144;
constexpr int NZ = 5120;
constexpr int ZC_R = 0, ZC_K = 512, ZC_V = 1024, ZC_W = 1536, ZC_Q = 1792, ZC_KC = 2304, ZC_VC = 2432, ZC_KS = 2560, ZC_VS = 2688, ZC_KW = 2816, ZC_VW = 2944, ZC_MR = 3072, ZC_MN = 4096;
constexpr float NORM_EPS = 1e-6f, GN_EPS = 64e-5f;

constexpr size_t MiB = 1u << 20;
constexpr size_t WS_CTL = 0, CTL_ZERO_BYTES = 64 * 1024;
constexpr size_t WS_LIST = 1 * MiB;
constexpr size_t WS_GATEA = 3 * MiB;
constexpr size_t WS_RSE = 4 * MiB;
constexpr size_t WS_SLOTA = 4 * MiB + 512 * 1024;
constexpr size_t WS_SELMASK = 5 * MiB;
constexpr size_t WS_ZGATE = 6 * MiB;
constexpr size_t WS_SMALLW = 8 * MiB;
constexpr size_t SW_W2T = 0, SW_A2T = 65536, SW_G2T = 131072, SW_CK1 = 262144, SW_CV1 = 524288, SW_CK2 = 786432, SW_CV2 = 794624, SW_GATEW = 802816, SW_ROUTEW = 868352;
constexpr size_t WS_KCMP = 10 * MiB;
constexpr size_t WS_VST = 11 * MiB, WS_VWT = 15 * MiB;
constexpr size_t WS_WIN = 19 * MiB, WS_UR = 29 * MiB, WS_UN = 30 * MiB, WS_WO = 31 * MiB, WS_WPP = 33 * MiB, WS_WPG = 34 * MiB, WS_WGU = 36 * MiB, WS_WD = 100 * MiB;
constexpr size_t WS_XN = 132 * MiB;
constexpr size_t WS_PBF = 164 * MiB;
constexpr size_t WS_Z = 172 * MiB;
constexpr size_t WS_S = 332 * MiB;
constexpr size_t WS_YRW = 428 * MiB, WS_YB = 444 * MiB, WS_G = 492 * MiB, WS_LOGITS = 508 * MiB  , WS_BONUS = 508 * MiB  , WS_END = 511 * MiB;
constexpr int CH_PP = 144, CH_P = 0, CH_R = 2304, CH_Q = 4608, CH_K = 6656, CH_G = 8704, CH_AC = 10752, CH_REC = 11008, CH_V = 11008, CH_SLOT = 11520;
constexpr int CW_CNT = 0;
constexpr int CW_PANEL = 8192;
constexpr int CW_DEP = 12288;
constexpr int CW_DEP2 = 4608;
constexpr int CW_BAR = 1024;
constexpr int MISC_OFF = 163840 - 64;

constexpr int LDS_BYTES = 163840;

#define GAS __attribute__((address_space(1)))
#define LAS __attribute__((address_space(3)))
typedef unsigned short bf16;
typedef unsigned v4u __attribute__((ext_vector_type(4)));
typedef unsigned v2u __attribute__((ext_vector_type(2)));
typedef float f32x4 __attribute__((ext_vector_type(4)));
typedef float f32x2 __attribute__((ext_vector_type(2)));
typedef short bf16x8 __attribute__((ext_vector_type(8)));
typedef short bf16x4 __attribute__((ext_vector_type(4)));
typedef __bf16 bf16x2_t __attribute__((ext_vector_type(2)));
#define LDS_WAIT() asm volatile("s_waitcnt lgkmcnt(0)" ::: "memory")
#define MFMA16(a, b, c) __builtin_amdgcn_mfma_f32_16x16x32_bf16((a), (b), (c), 0, 0, 0)

__device__ __forceinline__ float bf2f(unsigned short v) { return __uint_as_float((unsigned)v << 16); }
__device__ __forceinline__ unsigned pk2(float lo, float hi) { f32x2 v = {lo, hi}; bf16x2_t b = __builtin_convertvector(v, bf16x2_t); return __builtin_bit_cast(unsigned, b); }
__device__ __forceinline__ v2u pk4(f32x4 v) { v2u r; r.x = pk2(v.x, v.y); r.y = pk2(v.z, v.w); return r; }
__device__ __forceinline__ f32x4 unpk4(v2u w) { f32x4 r; r.x = __uint_as_float(w.x << 16); r.y = __uint_as_float(w.x & 0xffff0000u); r.z = __uint_as_float(w.y << 16); r.w = __uint_as_float(w.y & 0xffff0000u); return r; }
__device__ __forceinline__ void unpk8(v4u w, float (&f)[8]) { f[0] = __uint_as_float(w.x << 16); f[1] = __uint_as_float(w.x & 0xffff0000u); f[2] = __uint_as_float(w.y << 16); f[3] = __uint_as_float(w.y & 0xffff0000u);
    f[4] = __uint_as_float(w.z << 16); f[5] = __uint_as_float(w.z & 0xffff0000u); f[6] = __uint_as_float(w.w << 16); f[7] = __uint_as_float(w.w & 0xffff0000u); }
__device__ __forceinline__ float sigmoidf_(float x) { return __builtin_amdgcn_rcpf(1.0f + __expf(-x)); }
__device__ __forceinline__ float wave_sum(float v) {
#pragma unroll
    for (int o = 1; o < 64; o <<= 1) v += __shfl_xor(v, o);
    return v;
}
template <int CTRL> __device__ __forceinline__ float dppf(float x) { return __builtin_bit_cast(float, __builtin_amdgcn_update_dpp(0, __builtin_bit_cast(int, x), CTRL, 0xf, 0xf, false)); }
__device__ __forceinline__ float row16_sum(float x) { x += dppf<0x128>(x); x += dppf<0x124>(x); x += dppf<0x122>(x); x += dppf<0x121>(x); return x; }

typedef GAS unsigned gu32;
#define XB_TMO      128
#define XB_XCNT(j)  (256  + 64 * (j))
#define XB_XSUB(j)  (1280 + 64 * (j))
#define XB_XGEN(j)  (2304 + 64 * (j))
#define XB_TOP      3328
#define XB_TOPGEN   3392
#define XCD_BAR_WORDS 3456
#define XB_SPIN_CAP (1u << 18)

__device__ __forceinline__ unsigned xb_ld(unsigned* p)              { return __hip_atomic_load(p, __ATOMIC_RELAXED, __HIP_MEMORY_SCOPE_AGENT); }
__device__ __forceinline__ unsigned xb_add(unsigned* p, unsigned v) { return __hip_atomic_fetch_add(p, v, __ATOMIC_RELAXED, __HIP_MEMORY_SCOPE_AGENT); }
__device__ __forceinline__ unsigned xb_xcc_id() { return (unsigned)__builtin_amdgcn_s_getreg((3 << 11) | 20) & 0xFu; }
#define XB_SPIN(cond, bar) do { unsigned _sp = 0; while (cond) { __builtin_amdgcn_s_sleep(1); \
    if ((++_sp & 255u) == 0u) { if (xb_ld(&(bar)[XB_TMO])) break; if (_sp > XB_SPIN_CAP) { atomicAdd(&(bar)[XB_TMO], 1u); break; } } } } while (0)

struct XcdBarrier {
    unsigned* bar; unsigned x;
    volatile LAS unsigned* st;
};

__device__ __forceinline__ XcdBarrier xcd_barrier_post(unsigned* bar, volatile LAS unsigned* st) {
    XcdBarrier b; b.bar = bar; b.x = xb_xcc_id(); b.st = st;
    if (threadIdx.x == 0) (void)xb_add(&bar[XB_XCNT(b.x)], 1u);
    return b;
}
__device__ __forceinline__ void xcd_barrier_complete(unsigned* bar, unsigned x, unsigned& nloc, unsigned& nx) {
    const unsigned G = gridDim.x * gridDim.y * gridDim.z;
    unsigned sum, cnt, mine, sp = 0u;
    for (;;) {
        sum = 0u; cnt = 0u; mine = 0u;
#pragma unroll
        for (unsigned j = 0; j < 16; ++j) { const unsigned c = xb_ld(&bar[XB_XCNT(j)]); sum += c; cnt += (c > 0u) ? 1u : 0u; mine = (j == x) ? c : mine; }
        if (sum == G) break;
        __builtin_amdgcn_s_sleep(1);
        if ((++sp & 255u) == 0u) { if (xb_ld(&bar[XB_TMO])) break; if (sp > XB_SPIN_CAP) { atomicAdd(&bar[XB_TMO], 1u); break; } }
    }
    nloc = mine > 0u ? mine : 1u; nx = cnt > 0u ? cnt : 1u;
}

__device__ __forceinline__ void xcd_barrier(const XcdBarrier& b) {
    asm volatile("s_waitcnt vmcnt(0)" ::: "memory");
    __syncthreads();
    if (threadIdx.x == 0) {
        unsigned* bar = b.bar;
        __builtin_amdgcn_s_waitcnt(0);
        unsigned nloc = b.st[0], nx = b.st[1];
        if (nloc == 0u) { xcd_barrier_complete(bar, b.x, nloc, nx); b.st[0] = nloc; b.st[1] = nx; }
        const unsigned old = xb_add(&bar[XB_XSUB(b.x)], 1u);
        const unsigned gen = old / nloc;
        if (old + 1u == (gen + 1u) * nloc) {
            __builtin_amdgcn_fence(__ATOMIC_RELEASE, "agent");
            asm volatile("s_waitcnt vmcnt(0)" ::: "memory");
            const unsigned og = xb_add(&bar[XB_TOP], 1u);
            const unsigned tg = og / nx;
            if (og + 1u == (tg + 1u) * nx) xb_add(&bar[XB_TOPGEN], 1u);
            else XB_SPIN(xb_ld(&bar[XB_TOPGEN]) == tg, bar);
            __builtin_amdgcn_fence(__ATOMIC_ACQUIRE, "agent");
            xb_add(&bar[XB_XGEN(b.x)], 1u);
            asm volatile("s_waitcnt vmcnt(0)" ::: "memory");
        } else {
            XB_SPIN(xb_ld(&bar[XB_XGEN(b.x)]) == gen, bar);
            __builtin_amdgcn_fence(__ATOMIC_ACQUIRE, "agent");
            asm volatile("s_waitcnt vmcnt(0)" ::: "memory");
        }
    }
    __syncthreads();
}

struct Args { const float* in[37]; float* out; unsigned char* ws; int ph_lo, ph_hi, rep_mask, pad; };
typedef __attribute__((address_space(4))) const Args* ArgsP;
struct Frame {
    LAS unsigned char* lds;
    int tid, lane, wave, vcu, G, gw, NGW;
    unsigned char* ws;
    ArgsP ap;
    float* out;
};

struct TrDesc { const float* W; bf16* T; bf16* T2; const float* gain; int K, ld, nc, item, mode; };
__device__ __forceinline__ void tr_load(const TrDesc& d, int lane, float (&tv)[32], f32x4 (&gn)[2]) {
    const int nblk = (d.nc + 31) / 32, kb = d.item / nblk, nb = d.item % nblk, k0 = 64 * kb, n0 = 32 * nb;
    const int nn = n0 + (lane & 31);
    gn[0] = (f32x4){1.f, 1.f, 1.f, 1.f}; gn[1] = gn[0];
    if (d.gain) { const float* gp = d.gain + k0 + 8 * (lane & 7); gn[0] = *(const f32x4*)gp; gn[1] = *(const f32x4*)(gp + 4); }
    const float* wsrc = d.W + (size_t)(k0 + (lane >> 5)) * d.ld + (nn < d.nc ? nn : 0);
#pragma unroll
    for (int i = 0; i < 32; ++i) tv[i] = wsrc[(size_t)(2 * i) * d.ld];
}
__device__ __forceinline__ void tr_finish(const TrDesc& d, LAS float* scr, int lane, const float (&tv)[32], const f32x4 (&gn)[2]) {
    const int nblk = (d.nc + 31) / 32, kb = d.item / nblk, nb = d.item % nblk, k0 = 64 * kb, n0 = 32 * nb;
#pragma unroll
    for (int i = 0; i < 32; ++i) scr[(2 * i + (lane >> 5)) * 33 + (lane & 31)] = tv[i];
    LDS_WAIT(); asm volatile("" ::: "memory");
    const int c = lane & 7;
#pragma unroll
    for (int j = 0; j < 4; ++j) { const int nl = (lane >> 3) + 8 * j, n = n0 + nl; const LAS float* s = scr + (8 * c) * 33 + nl;
        v4u o; o.x = pk2(s[0 * 33] * gn[0].x, s[1 * 33] * gn[0].y); o.y = pk2(s[2 * 33] * gn[0].z, s[3 * 33] * gn[0].w); o.z = pk2(s[4 * 33] * gn[1].x, s[5 * 33] * gn[1].y); o.w = pk2(s[6 * 33] * gn[1].z, s[7 * 33] * gn[1].w);
        if (n < d.nc) { bf16* rp;
            if (d.mode == 1) rp = n < 3072 ? d.T + (size_t)n * 1024 : (n < 3096 ? d.T2 + (size_t)(n - 3072) * 1024 : d.T + (size_t)(n - 24) * 1024);
            else if (d.mode == 2) { const int n2 = n & 511; rp = d.T + (size_t)((n2 >> 7) * 256 + (n >> 9) * 128 + (n2 & 127)) * 1024; }
            else rp = d.T + (size_t)n * d.K;
            *(v4u*)(rp + k0 + 8 * c) = o; } }
    LDS_WAIT(); asm volatile("" ::: "memory");
}
__device__ __forceinline__ void rms_row_to_bf16(int lane, const float* xrow, const float* gain, bf16* orow) {
    const f32x4* xr = (const f32x4*)xrow + lane; const f32x4* gr = (const f32x4*)gain + lane;
    f32x4 v[4]; float s = 0.f;
#pragma unroll
    for (int j = 0; j < 4; ++j) { v[j] = xr[64 * j]; s += (v[j].x * v[j].x + v[j].y * v[j].y) + (v[j].z * v[j].z + v[j].w * v[j].w); }
    const float rs = 1.0f / sqrtf(wave_sum(s) * (1.f / D) + NORM_EPS);
    v2u* o8 = (v2u*)orow + lane;
#pragma unroll
    for (int j = 0; j < 4; ++j) { const f32x4 g = gr[64 * j]; o8[64 * j] = pk4(v[j] * rs * g); }
}

namespace tri {
constexpr int I_WIN = 16 * 161, I_UR = 8 * 32, I_WO = 16 * 32, I_WPP = 4 * 32, I_L64 = 16, I_L128 = 32, I_C1 = 32 * 2, I_C2 = 2, I_GU = 16 * 32, I_DN = 8 * 32;
constexpr int E0 = I_WIN, E1 = E0 + I_UR, E2 = E1 + I_UR, E3 = E2 + I_WO, E4 = E3 + I_WPP, E5 = E4 + I_WO, E6 = E5 + I_L64, E7 = E6 + I_L64, E8 = E7 + I_L128, E9 = E8 + I_C1, E10 = E9 + I_C1, E11 = E10 + I_C2, E12 = E11 + I_C2,
              E13 = E12 + 32 * I_GU, NITEMS = E13 + 32 * I_DN;
}
__device__ __forceinline__ TrDesc tr_desc(Frame& F, int it) {
    using namespace tri;
    unsigned char* ws = F.ws;
    const float* W; const float* gain = nullptr; int K, ld, nc, item, mode = 0; size_t dst;
    if (it < E0) { W = F.ap->in[3]; K = 1024; ld = NIN; nc = NIN; item = it; mode = 1; dst = WS_WIN; }
    else if (it < E1) { W = F.ap->in[22]; K = 512; ld = 1024; nc = 1024; item = it - E0; dst = WS_UR; }
    else if (it < E2) { W = F.ap->in[23]; K = 512; ld = 1024; nc = 1024; item = it - E1; dst = WS_UN; }
    else if (it < E3) { W = F.ap->in[24]; K = 1024; ld = 1024; nc = 1024; item = it - E2; dst = WS_WO; }
    else if (it < E4) { W = F.ap->in[32]; K = 256; ld = 1024; nc = 1024; item = it - E3; dst = WS_WPP; }
    else if (it < E5) { W = F.ap->in[35]; K = 1024; ld = 1024; nc = 1024; item = it - E4; dst = WS_WPG; gain = F.ap->in[34]; }
    else if (it < E6) { W = F.ap->in[6]; K = 64; ld = 512; nc = 512; item = it - E5; dst = WS_SMALLW + SW_W2T; }
    else if (it < E7) { W = F.ap->in[8]; K = 64; ld = 512; nc = 512; item = it - E6; dst = WS_SMALLW + SW_A2T; }
    else if (it < E8) { W = F.ap->in[9]; K = 128; ld = 512; nc = 512; item = it - E7; dst = WS_SMALLW + SW_G2T; }
    else if (it < E9) { W = F.ap->in[17]; K = 2048; ld = 64; nc = 64; item = it - E8; dst = WS_SMALLW + SW_CK1; }
    else if (it < E10) { W = F.ap->in[19]; K = 2048; ld = 64; nc = 64; item = it - E9; dst = WS_SMALLW + SW_CV1; }
    else if (it < E11) { W = F.ap->in[18]; K = 64; ld = 64; nc = 64; item = it - E10; dst = WS_SMALLW + SW_CK2; }
    else if (it < E12) { W = F.ap->in[20]; K = 64; ld = 64; nc = 64; item = it - E11; dst = WS_SMALLW + SW_CV2; }
    else if (it < E13) { const int r = it - E12, e = r / I_GU; W = F.ap->in[30] + (size_t)e * 1024 * 1024; K = 1024; ld = 1024; nc = 1024; item = r % I_GU; mode = 2; dst = WS_WGU + (size_t)e * 1024 * 1024 * 2; gain = F.ap->in[25]; }
    else { const int r = it - E13, e = r / I_DN; W = F.ap->in[31] + (size_t)e * 512 * 1024; K = 512; ld = 1024; nc = 1024; item = r % I_DN; dst = WS_WD + (size_t)e * 1024 * 512 * 2; }
    return TrDesc{W, (bf16*)(ws + dst), (bf16*)(ws + WS_SMALLW + SW_GATEW), gain, K, ld, nc, item, mode};
}
__device__ __forceinline__ void tr_run(Frame& F, LAS float* scr, int it0, int stride, int it_end) {
    if (it0 >= it_end) return;
    float tvA[32], tvB[32]; f32x4 gnA[2], gnB[2];
    int it = it0; TrDesc cur = tr_desc(F, it); tr_load(cur, F.lane, tvA, gnA);
    for (;;) {
        const int nxt = it + stride; const bool has = nxt < it_end; TrDesc dn = cur;
        if (has) { dn = tr_desc(F, nxt); tr_load(dn, F.lane, tvB, gnB); }
        __builtin_amdgcn_sched_barrier(0);
        tr_finish(cur, scr, F.lane, tvA, gnA);
        if (!has) break;
        cur = dn; it = nxt;
#pragma unroll
        for (int i = 0; i < 32; ++i) tvA[i] = tvB[i];
        gnA[0] = gnB[0]; gnA[1] = gnB[1];
    }
}
__device__ __forceinline__ int tr_qnext(LAS int* qh) {
    int k = 0; const unsigned a = (unsigned)(size_t)qh; const int one = 1;
    if (__builtin_amdgcn_mbcnt_hi(~0u, __builtin_amdgcn_mbcnt_lo(~0u, 0u)) == 0) asm volatile("ds_add_rtn_u32 %0, %1, %2\n\ts_waitcnt lgkmcnt(0)" : "=&v"(k) : "v"(a), "v"(one) : "memory");
    return __builtin_amdgcn_readfirstlane(k);
}
__device__ __forceinline__ void tr_run_q(Frame& F, LAS float* scr, LAS int* qh, int base, int stride, int nk) {
    int k = tr_qnext(qh); if (k >= nk) return;
    float tvA[32], tvB[32]; f32x4 gnA[2], gnB[2];
    TrDesc cur = tr_desc(F, base + k * stride); tr_load(cur, F.lane, tvA, gnA);
    for (;;) {
        const int kn = tr_qnext(qh); const bool has = kn < nk; TrDesc dn = cur;
        if (has) { dn = tr_desc(F, base + kn * stride); tr_load(dn, F.lane, tvB, gnB); }
        __builtin_amdgcn_sched_barrier(0);
        tr_finish(cur, scr, F.lane, tvA, gnA);
        if (!has) break;
        cur = dn;
#pragma unroll
        for (int i = 0; i < 32; ++i) tvA[i] = tvB[i];
        gnA[0] = gnB[0]; gnA[1] = gnB[1];
    }
}
#ifndef MK_EXPERTS_IN_SCAN
#define MK_EXPERTS_IN_SCAN 1
#endif
__device__ __forceinline__ void p0_prologue(Frame& F) {
    LAS float* scr = (LAS float*)(F.lds + F.wave * 16384);
    unsigned char* ws = F.ws;
    bf16* gateWT = (bf16*)(ws + WS_SMALLW + SW_GATEW);
    tr_run(F, scr, F.gw, F.NGW, MK_EXPERTS_IN_SCAN ? tri::E12 : tri::NITEMS);
    for (int mb = F.gw; mb < M; mb += 4 * F.NGW) {
        f32x4 v[4][4]; float s[4];
#pragma unroll
        for (int u = 0; u < 4; ++u) { const f32x4* xr = (const f32x4*)(F.ap->in[0] + (size_t)(mb + u * F.NGW) * D) + F.lane;
#pragma unroll
            for (int j = 0; j < 4; ++j) v[u][j] = xr[64 * j]; }
#pragma unroll
        for (int u = 0; u < 4; ++u) { s[u] = 0.f;
#pragma unroll
            for (int j = 0; j < 4; ++j) s[u] += (v[u][j].x * v[u][j].x + v[u][j].y * v[u][j].y) + (v[u][j].z * v[u][j].z + v[u][j].w * v[u][j].w); }
#pragma unroll
        for (int o = 1; o < 64; o <<= 1) {
#pragma unroll
            for (int u = 0; u < 4; ++u) s[u] += __shfl_xor(s[u], o); }
        const f32x4* gr = (const f32x4*)F.ap->in[2] + F.lane;
#pragma unroll
        for (int u = 0; u < 4; ++u) { const float rs = 1.0f / sqrtf(s[u] * (1.f / D) + NORM_EPS); v2u* o8 = (v2u*)((bf16*)(ws + WS_XN) + (size_t)(mb + u * F.NGW) * D) + F.lane;
#pragma unroll
            for (int j = 0; j < 4; ++j) o8[64 * j] = pk4(v[u][j] * rs * gr[64 * j]); }
    }
    {
        float* RW = (float*)(ws + WS_SMALLW + SW_ROUTEW); const float* gf = F.ap->in[25]; const float* wg = F.ap->in[26]; const float* wr = F.ap->in[28];
        for (int idx = F.gw * 64 + F.lane; idx < 48 * 1024; idx += F.NGW * 64) { const int c = idx >> 10, k = idx & 1023; float v = 0.f;
            if (c < 4) v = wg[k * 4 + c]; else if (c < 36) v = wr[k * 32 + (c - 4)];
            RW[idx] = v * gf[k]; }
        for (int idx = F.gw * 64 + F.lane; idx < 8 * 1024; idx += F.NGW * 64) gateWT[24 * 1024 + idx] = 0;
    }
}

struct EpiStoreBf16 {
    static constexpr bool PERM = true;
    bf16* O; int ldc;
    __device__ __forceinline__ void operator()(const f32x4 (&acc)[2][2][4][2], const pg8::Unit& u, int wr, int wc, int fr, int fq) const {
        const int row0 = u.pmo * 256 + wr * 64 + fr, col0 = u.pnl * 256 + wc * 32 + 8 * fq;
#pragma unroll
        for (int ai = 0; ai < 2; ++ai)
#pragma unroll
            for (int m = 0; m < 4; ++m) { bf16* rowp = O + (size_t)(row0 + ai * 128 + m * 16) * ldc + col0;
#pragma unroll
                for (int bj = 0; bj < 2; ++bj) { const f32x4 v0 = acc[ai][bj][m][0], v1 = acc[ai][bj][m][1]; v4u w; w.x = pk2(v0[0], v0[1]); w.y = pk2(v0[2], v0[3]); w.z = pk2(v1[0], v1[1]); w.w = pk2(v1[2], v1[3]);
                    *(v4u*)(rowp + bj * 128) = w; } }
    }
};
struct EpiStoreSsq {
    static constexpr bool PERM = true;
    bf16* O; int ldc; float* part;
    __device__ __forceinline__ void operator()(const f32x4 (&acc)[2][2][4][2], const pg8::Unit& u, int wr, int wc, int fr, int fq) const {
        const int row0 = u.pmo * 256 + wr * 64 + fr, col0 = u.pnl * 256 + wc * 32 + 8 * fq;
#pragma unroll
        for (int ai = 0; ai < 2; ++ai)
#pragma unroll
            for (int m = 0; m < 4; ++m) { bf16* rowp = O + (size_t)(row0 + ai * 128 + m * 16) * ldc + col0; float ss = 0.f;
#pragma unroll
                for (int bj = 0; bj < 2; ++bj) { const f32x4 v0 = acc[ai][bj][m][0], v1 = acc[ai][bj][m][1]; v4u w; w.x = pk2(v0[0], v0[1]); w.y = pk2(v0[2], v0[3]); w.z = pk2(v1[0], v1[1]); w.w = pk2(v1[2], v1[3]);
                    *(v4u*)(rowp + bj * 128) = w;
                    ss += ((v0[0] * v0[0] + v0[1] * v0[1]) + (v0[2] * v0[2] + v0[3] * v0[3])) + ((v1[0] * v1[0] + v1[1] * v1[1]) + (v1[2] * v1[2] + v1[3] * v1[3])); }
                ss += __shfl_xor(ss, 16); ss += __shfl_xor(ss, 32);
                if (fq == 0) part[(size_t)(row0 + ai * 128 + m * 16) * 16 + u.pnl * 4 + wc] = ss; }
    }
};
#define EPI_LOOP_BEGIN \
    _Pragma("unroll") for (int ai = 0; ai < 2; ++ai) _Pragma("unroll") for (int m = 0; m < 4; ++m) { if (m == 0 || m == 2) asm volatile("" ::: "memory"); const int rl = ai * 128 + wr * 64 + m * 16 + fr; const size_t row = (size_t)u.pmo * 256 + rl; (void)row; \
    _Pragma("unroll") for (int bj = 0; bj < 2; ++bj) _Pragma("unroll") for (int n = 0; n < 2; ++n) { const int col = u.pnl * 256 + bj * 128 + wc * 32 + n * 16 + 4 * fq; (void)col; const f32x4 a = acc[ai][bj][m][n];
#define EPI_LOOP_END } }
struct EpiMix {
    static constexpr bool PERM = false;
    const bf16* z; bf16* A; bf16* O;
    __device__ __forceinline__ void operator()(const f32x4 (&acc)[2][2][4][2], const pg8::Unit& u, int wr, int wc, int fr, int fq) const {
        const int zc = u.lt ? ZC_MN : ZC_MR;
        EPI_LOOP_BEGIN
            const f32x4 zz = unpk4(*(const v2u*)(z + row * NZ + zc + col)); f32x4 o;
            o.x = sigmoidf_(zz.x) * a.x; o.y = sigmoidf_(zz.y) * a.y; o.z = sigmoidf_(zz.z) * a.z; o.w = sigmoidf_(zz.w) * a.w;
            if (u.lt == 0) *(v2u*)(A + row * D + col) = pk4(o);
            else { o = o + unpk4(*(const v2u*)(A + row * D + col)); *(v2u*)(O + row * D + col) = pk4(o); }
        EPI_LOOP_END
    }
};
struct StaticOrderDep {
    static constexpr bool DEP = true, KEEP_ACC = false;
    pg8::StaticOrder S; const unsigned* dep;
    __device__ bool next(int i, pg8::Unit& u) const { return S.next(i, u); }
    __device__ void wait(const pg8::Unit& u) const {
        const unsigned* p = dep + 16 * u.pm; unsigned sp = 0;
        while (__hip_atomic_load(p, __ATOMIC_RELAXED, __HIP_MEMORY_SCOPE_AGENT) < 4u) { __builtin_amdgcn_s_sleep(2); if (++sp > (1u << 22)) break; }
        asm volatile("s_waitcnt vmcnt(0)" ::: "memory");
    }
};
struct EpiMix2 {
    static constexpr bool PERM = true;
    const bf16* z; bf16* O; unsigned* dep;
    __device__ __forceinline__ void operator()(const f32x4 (&acc_)[2][2][4][2], const pg8::Unit& u, int wr, int wc, int fr, int fq) const {
        f32x4 (&acc)[2][2][4][2] = const_cast<f32x4 (&)[2][2][4][2]>(acc_);
        const int row0 = u.pmo * 256 + wr * 64 + fr, col0 = u.pnl * 256 + wc * 32 + 8 * fq;
#pragma unroll
        for (int ai = 0; ai < 2; ++ai)
#pragma unroll
            for (int m = 0; m < 4; ++m) { if (m == 0 || m == 2) asm volatile("" ::: "memory"); const size_t row = (size_t)(row0 + ai * 128 + m * 16); const bf16* zr = z + row * NZ + col0;
#pragma unroll
                for (int bj = 0; bj < 2; ++bj) {
                    float b[8]; unpk8(*(const v4u*)(zr + ZC_MN + bj * 128), b);
                    if (u.lt == 0) { float a[8]; unpk8(*(const v4u*)(zr + ZC_MR + bj * 128), a);
#pragma unroll
                        for (int j = 0; j < 8; ++j) acc[ai][bj][m][j >> 2][j & 3] *= (1.0f + __expf(-fmaxf(b[j], -60.f))) * __builtin_amdgcn_rcpf(1.0f + __expf(-a[j])); }
                    else { float o[8];
#pragma unroll
                        for (int j = 0; j < 8; ++j) o[j] = acc[ai][bj][m][j >> 2][j & 3] * __builtin_amdgcn_rcpf(1.0f + __expf(-fmaxf(b[j], -60.f)));
                        v4u w; w.x = pk2(o[0], o[1]); w.y = pk2(o[2], o[3]); w.z = pk2(o[4], o[5]); w.w = pk2(o[6], o[7]);
                        { bf16* op = O + row * D + col0 + bj * 128; asm volatile("global_store_dwordx4 %0, %1, off sc1" :: "v"(op), "v"(w) : "memory"); } } } }
        if (u.lt != 0) { asm volatile("s_waitcnt vmcnt(0)" ::: "memory"); __builtin_amdgcn_s_barrier(); asm volatile("" ::: "memory");
            if (threadIdx.x == 0) __hip_atomic_fetch_add(dep + 16 * u.pmo, 1u, __ATOMIC_RELAXED, __HIP_MEMORY_SCOPE_AGENT); }
    }
};
struct ErawOrder {
    static constexpr bool DEP = false, KEEP_ACC = false;
    pg8::StaticOrder S; int c, G, nheavy;
    __device__ bool next(int i, pg8::Unit& u) const { const int nl = G - nheavy, l = c - nheavy; if (l < 0) return false; const int q = l + i * nl; if (q >= S.nwg) return false;
        pg8::StaticOrder T = S; T.c = q; T.G = S.nwg + 1; return T.next(0, u); }
};
struct DualOrder {
    static constexpr bool DEP = false, KEEP_ACC = true;
    pg8::StaticOrder S;
    __device__ bool next(int i, pg8::Unit& u) const { if (i >= 2) return false; if (!S.next(0, u)) return false; if (i == 1) { u.pm += 64; u.pn += 4; } u.lt = i; return true; }
};
struct EpiResBf16 {
    static constexpr bool PERM = true;
    const float* base; bf16* O;
    __device__ __forceinline__ void operator()(const f32x4 (&acc)[2][2][4][2], const pg8::Unit& u, int wr, int wc, int fr, int fq) const {
        const int row0 = u.pmo * 256 + wr * 64 + fr, col0 = u.pnl * 256 + wc * 32 + 8 * fq;
#pragma unroll
        for (int ai = 0; ai < 2; ++ai)
#pragma unroll
            for (int m = 0; m < 4; ++m) { if (m == 0 || m == 2) asm volatile("" ::: "memory"); const size_t ro = (size_t)(row0 + ai * 128 + m * 16) * D + col0;
#pragma unroll
                for (int bj = 0; bj < 2; ++bj) { const f32x4 v0 = acc[ai][bj][m][0] + *(const f32x4*)(base + ro + bj * 128), v1 = acc[ai][bj][m][1] + *(const f32x4*)(base + ro + bj * 128 + 4);
                    v4u w; w.x = pk2(v0[0], v0[1]); w.y = pk2(v0[2], v0[3]); w.z = pk2(v1[0], v1[1]); w.w = pk2(v1[2], v1[3]);
                    *(v4u*)(O + ro + bj * 128) = w; } }
    }
};
struct EpiResF32 {
    static constexpr bool PERM = false;
    const float* base; float* O;
    __device__ __forceinline__ void operator()(const f32x4 (&acc)[2][2][4][2], const pg8::Unit& u, int wr, int wc, int fr, int fq) const {
        EPI_LOOP_BEGIN
            *(f32x4*)(O + row * D + col) = *(const f32x4*)(base + row * D + col) + a;
        EPI_LOOP_END
    }
};
struct EpiMoe1 {
    static constexpr bool PERM = false;
    bf16* H; const LAS float* rsl; unsigned* dep;
    __device__ __forceinline__ void operator()(const f32x4 (&acc)[2][2][4][2], const pg8::Unit& u, int wr, int wc, int fr, int fq) const {
#pragma unroll
        for (int ai = 0; ai < 2; ++ai)
#pragma unroll
            for (int m = 0; m < 4; ++m) { const int rl = ai * 128 + wr * 64 + m * 16 + fr; const size_t row = (size_t)u.pmo * 256 + rl; const float rs = rsl[u.pm * 256 + rl];
#pragma unroll
                for (int n = 0; n < 2; ++n) { const f32x4 gt = acc[ai][0][m][n] * rs, up = acc[ai][1][m][n] * rs; f32x4 o;
                    o.x = gt.x * sigmoidf_(gt.x) * up.x; o.y = gt.y * sigmoidf_(gt.y) * up.y; o.z = gt.z * sigmoidf_(gt.z) * up.z; o.w = gt.w * sigmoidf_(gt.w) * up.w;
                    { bf16* hp = H + row * 512 + u.pnl * 128 + wc * 32 + n * 16 + 4 * fq; const v2u hv = pk4(o); asm volatile("global_store_dwordx2 %0, %1, off sc1" :: "v"(hp), "v"(hv) : "memory"); } } }
        asm volatile("s_waitcnt vmcnt(0)" ::: "memory"); __builtin_amdgcn_s_barrier(); asm volatile("" ::: "memory");
        if (threadIdx.x == 0) __hip_atomic_fetch_add(dep + 16 * u.pmo, 1u, __ATOMIC_RELAXED, __HIP_MEMORY_SCOPE_AGENT);
    }
};
struct EpiPle {
    static constexpr bool PERM = false;
    const bf16* x2; const bf16* Eraw; const float* rse; const float* gpn; bf16* O;
    __device__ __forceinline__ void operator()(const f32x4 (&acc)[2][2][4][2], const pg8::Unit& u, int wr, int wc, int fr, int fq) const {
        EPI_LOOP_BEGIN
            const f32x4 e = unpk4(*(const v2u*)(Eraw + row * D + col)); const f32x4 g = *(const f32x4*)(gpn + col); const float rs = rse[row]; f32x4 o = unpk4(*(const v2u*)(x2 + row * D + col));
            o.x += sigmoidf_(a.x) * e.x * rs * g.x; o.y += sigmoidf_(a.y) * e.y * rs * g.y; o.z += sigmoidf_(a.z) * e.z * rs * g.z; o.w += sigmoidf_(a.w) * e.w * rs * g.w;
            *(v2u*)(O + row * D + col) = pk4(o);
        EPI_LOOP_END
    }
};

struct EpiPleNorm {
    static constexpr bool PERM = false;
    const bf16* x2; const bf16* Eraw; const float* rse; const float* gpn; const float* rs3; const float* gfin; float* out; float* xbuf; unsigned* cnt; LAS float* ldsx;
    __device__ __forceinline__ void operator()(const f32x4 (&acc_)[2][2][4][2], const pg8::Unit& u_, int wr, int wc, int fr, int fq) const {
        f32x4 (&acc)[2][2][4][2] = const_cast<f32x4 (&)[2][2][4][2]>(acc_);
        pg8::Unit u = u_; asm volatile("" : "+s"(u.pmo), "+s"(u.pnl)); asm volatile("" : "+v"(fr), "+v"(fq)); asm volatile("" : "+s"(wr), "+s"(wc));
        int tid = threadIdx.x; asm volatile("" : "+v"(tid)); const int lane = tid & 63, wid = __builtin_amdgcn_readfirstlane(tid >> 6);
        LAS float* Pl = ldsx; LAS float* Sl = ldsx + 1024; LAS unsigned* flag = (LAS unsigned*)(ldsx + 1280);
#pragma unroll
        for (int ai = 0; ai < 2; ++ai)
#pragma unroll
            for (int m = 0; m < 4; ++m) { if (m == 0 || m == 2) asm volatile("" ::: "memory"); const int rl = ai * 128 + wr * 64 + m * 16 + fr; const size_t row = (size_t)u.pmo * 256 + rl;
                float ss = 0.f; const float r3 = rs3[row], re = rse[row];
#pragma unroll
                for (int bj = 0; bj < 2; ++bj)
#pragma unroll
                    for (int n = 0; n < 2; ++n) { const int col = u.pnl * 256 + bj * 128 + wc * 32 + n * 16 + 4 * fq; const f32x4 a = acc[ai][bj][m][n];
                        const f32x4 e = unpk4(*(const v2u*)(Eraw + row * D + col)) * re * *(const f32x4*)(gpn + col); f32x4 o = unpk4(*(const v2u*)(x2 + row * D + col));
                        o.x += sigmoidf_(a.x * r3) * e.x; o.y += sigmoidf_(a.y * r3) * e.y; o.z += sigmoidf_(a.z * r3) * e.z; o.w += sigmoidf_(a.w * r3) * e.w;
                        acc[ai][bj][m][n] = o; ss += (o.x * o.x + o.y * o.y) + (o.z * o.z + o.w * o.w); }
                ss += __shfl_xor(ss, 16); ss += __shfl_xor(ss, 32);
                if (fq == 0) Pl[rl * 4 + wc] = ss; }
        asm volatile("s_waitcnt lgkmcnt(0)" ::: "memory"); __builtin_amdgcn_s_barrier(); asm volatile("" ::: "memory");
        if (tid < 256) { const float tot = (Pl[tid * 4 + 0] + Pl[tid * 4 + 1]) + (Pl[tid * 4 + 2] + Pl[tid * 4 + 3]);
            __hip_atomic_store(xbuf + ((size_t)u.pmo * 256 + tid) * 4 + u.pnl, tot, __ATOMIC_RELAXED, __HIP_MEMORY_SCOPE_AGENT);
            asm volatile("s_waitcnt vmcnt(0)" ::: "memory");
            if (lane == 0) __hip_atomic_fetch_add(cnt + 64 * u.pmo, 1u, __ATOMIC_RELAXED, __HIP_MEMORY_SCOPE_AGENT); }
        if (wid == 0) {
            unsigned spins = 0;
            while ((unsigned)__builtin_amdgcn_readfirstlane((int)__hip_atomic_load(cnt + 64 * u.pmo, __ATOMIC_RELAXED, __HIP_MEMORY_SCOPE_AGENT)) < 16u) { __builtin_amdgcn_s_sleep(2); if (++spins > (1u << 22)) break; }
            __builtin_amdgcn_fence(__ATOMIC_ACQUIRE, "agent");
            if (lane == 0) flag[0] = 1u; }
        asm volatile("s_waitcnt vmcnt(0) lgkmcnt(0)" ::: "memory"); __builtin_amdgcn_s_barrier(); asm volatile("" ::: "memory");
        if (tid < 256) { const float* sp = xbuf + ((size_t)u.pmo * 256 + tid) * 4; float tot = 0.f;
#pragma unroll
            for (int t = 0; t < 4; ++t) tot += __hip_atomic_load(sp + t, __ATOMIC_RELAXED, __HIP_MEMORY_SCOPE_AGENT);
            Sl[tid] = 1.0f / sqrtf(tot * (1.f / D) + NORM_EPS); }
        asm volatile("s_waitcnt vmcnt(0) lgkmcnt(0)" ::: "memory"); __builtin_amdgcn_s_barrier(); asm volatile("" ::: "memory");
#pragma unroll
        for (int ai = 0; ai < 2; ++ai)
#pragma unroll
            for (int m = 0; m < 4; ++m) { const int rl = ai * 128 + wr * 64 + m * 16 + fr; const size_t row = (size_t)u.pmo * 256 + rl; const float rs = Sl[rl];
#pragma unroll
                for (int bj = 0; bj < 2; ++bj)
#pragma unroll
                    for (int n = 0; n < 2; ++n) { const int col = u.pnl * 256 + bj * 128 + wc * 32 + n * 16 + 4 * fq; *(f32x4*)(out + row * D + col) = acc[ai][bj][m][n] * rs * *(const f32x4*)(gfin + col); } }
    }
};

__device__ __forceinline__ float gelu_tanh(float x) { const float u = 0.7978845608028654f * (x + 0.044715f * x * x * x); const float t = 1.0f - 2.0f * __builtin_amdgcn_rcpf(__expf(2.0f * u) + 1.0f); return 0.5f * x * (1.0f + t); }

__device__ __forceinline__ void compress_wg_task(Frame& F, int idx) {
    const int kv = idx & 1, tile8 = (idx >> 1) & 7, bg = idx >> 4, b = bg >> 1, g = bg & 1;
    const int fr = F.lane & 15, fq = F.lane >> 4;
    const bf16* z = (const bf16*)(F.ws + WS_Z);
    const bf16* w1T = (const bf16*)(F.ws + WS_SMALLW + (kv ? SW_CV1 : SW_CK1));
    const bf16* w2T = (const bf16*)(F.ws + WS_SMALLW + (kv ? SW_CV2 : SW_CK2));
    const float* pos = kv ? F.ap->in[16] : F.ap->in[15];
    const int j0 = 16 * tile8; int j = j0 + fr; const bool jvalid = j < 127; if (!jvalid) j = 126;
    const bf16* zb = z + ((size_t)b * SEQ + 16 * j) * NZ + (kv ? ZC_VC : ZC_KC) + g * 64;
    v4u zr[8]; f32x4 p0[8], p1[8]; bf16x8 aop[8][4];
#pragma unroll
    for (int i = 0; i < 8; ++i) { const int ks = 8 * F.wave + i, l = ks >> 1, d = 32 * (ks & 1) + 8 * fq;
        zr[i] = *(const v4u*)(zb + (size_t)l * NZ + d); p0[i] = *(const f32x4*)(pos + l * 64 + d); p1[i] = *(const f32x4*)(pos + l * 64 + d + 4);
#pragma unroll
        for (int mt = 0; mt < 4; ++mt) aop[i][mt] = *(const bf16x8*)(w1T + (size_t)(16 * mt + fr) * 2048 + 32 * ks + 8 * fq); }
    f32x4 acc[4];
#pragma unroll
    for (int mt = 0; mt < 4; ++mt) acc[mt] = (f32x4){0.f, 0.f, 0.f, 0.f};
#pragma unroll
    for (int i = 0; i < 8; ++i) {
        float f[8]; unpk8(zr[i], f);
        v4u bb; bb.x = pk2(f[0] + p0[i].x, f[1] + p0[i].y); bb.y = pk2(f[2] + p0[i].z, f[3] + p0[i].w); bb.z = pk2(f[4] + p1[i].x, f[5] + p1[i].y); bb.w = pk2(f[6] + p1[i].z, f[7] + p1[i].w);
        const bf16x8 bop = __builtin_bit_cast(bf16x8, bb);
#pragma unroll
        for (int mt = 0; mt < 4; ++mt) acc[mt] = MFMA16(aop[i][mt], bop, acc[mt]);
    }
    LAS float* red = (LAS float*)F.lds;
    __syncthreads();
#pragma unroll
    for (int mt = 0; mt < 4; ++mt) *(LAS f32x4*)(red + ((F.wave * 4 + mt) * 64 + F.lane) * 4) = acc[mt];
    LDS_WAIT(); __syncthreads();
    if (F.wave != 0) return;
#pragma unroll
    for (int mt = 0; mt < 4; ++mt) { f32x4 t = (f32x4){0.f, 0.f, 0.f, 0.f};
#pragma unroll
        for (int w = 0; w < 8; ++w) t = t + *(const LAS f32x4*)(red + ((w * 4 + mt) * 64 + F.lane) * 4);
        acc[mt] = t; }
    bf16x8 hb[2];
#pragma unroll
    for (int s2 = 0; s2 < 2; ++s2) { v4u w; const f32x4 a0 = acc[2 * s2], a1 = acc[2 * s2 + 1];
        w.x = pk2(gelu_tanh(a0.x), gelu_tanh(a0.y)); w.y = pk2(gelu_tanh(a0.z), gelu_tanh(a0.w)); w.z = pk2(gelu_tanh(a1.x), gelu_tanh(a1.y)); w.w = pk2(gelu_tanh(a1.z), gelu_tanh(a1.w));
        hb[s2] = __builtin_bit_cast(bf16x8, w); }
    bf16* kcmp = (bf16*)(F.ws + WS_KCMP); bf16* vcmpT = (bf16*)(F.ws + WS_KCMP + 512 * 1024);
#pragma unroll
    for (int ntl = 0; ntl < 4; ++ntl) {
        f32x4 o = (f32x4){0.f, 0.f, 0.f, 0.f};
#pragma unroll
        for (int s2 = 0; s2 < 2; ++s2) { const bf16* wp = w2T + (size_t)(16 * ntl + fr) * 64 + 32 * s2 + 4 * fq; const v2u lo = *(const v2u*)wp, hi = *(const v2u*)(wp + 16);
            v4u aw; aw.x = lo.x; aw.y = lo.y; aw.z = hi.x; aw.w = hi.y; o = MFMA16(__builtin_bit_cast(bf16x8, aw), hb[s2], o); }
        if (!jvalid) o = (f32x4){0.f, 0.f, 0.f, 0.f};
        const int jj = j0 + fr, n = 16 * ntl + 4 * fq;
        if (kv == 0) *(v2u*)(kcmp + ((size_t)bg * 128 + jj) * 64 + n) = pk4(o);
        else { const v2u w = pk4(o); bf16* vp = vcmpT + ((size_t)bg * 64 + n) * 128 + jj; vp[0] = (bf16)(w.x & 0xffff); vp[128] = (bf16)(w.x >> 16); vp[256] = (bf16)(w.y & 0xffff); vp[384] = (bf16)(w.y >> 16); }
    }
}
__device__ __forceinline__ void zgate_task(Frame& F, int tile) {
    const int fr = F.lane & 15, fq = F.lane >> 4, m0 = tile * 16;
    const bf16* XN = (const bf16*)(F.ws + WS_XN); const bf16* gw = (const bf16*)(F.ws + WS_SMALLW + SW_GATEW);
    f32x4 acc[2] = {(f32x4){0.f, 0.f, 0.f, 0.f}, (f32x4){0.f, 0.f, 0.f, 0.f}};
#pragma unroll 16
    for (int ks = 0; ks < 32; ++ks) {
        const bf16x8 bop = *(const bf16x8*)(XN + (size_t)(m0 + fr) * D + 32 * ks + 8 * fq);
#pragma unroll
        for (int ct = 0; ct < 2; ++ct) { const bf16x8 aop = *(const bf16x8*)(gw + (size_t)(16 * ct + fr) * D + 32 * ks + 8 * fq); acc[ct] = MFMA16(aop, bop, acc[ct]); }
    }
    float* zg = (float*)(F.ws + WS_ZGATE);
#pragma unroll
    for (int ct = 0; ct < 2; ++ct) *(f32x4*)(zg + (size_t)(m0 + fr) * 32 + 16 * ct + 4 * fq) = acc[ct];
}
__device__ __forceinline__ void vt_task(Frame& F, int idx) {
    const int which = idx & 1, blk = (idx >> 1) & 31, bg = idx >> 6, b = bg >> 1, g = bg & 1;
    const bf16* z = (const bf16*)(F.ws + WS_Z);
    bf16* vT = (bf16*)(F.ws + (which ? WS_VWT : WS_VST));
    const int t = 64 * blk + F.lane;
    const bf16* src = z + ((size_t)b * SEQ + t) * NZ + (which ? ZC_VW : ZC_VS) + g * 64;
#pragma unroll
    for (int dc = 0; dc < 8; ++dc) { const v4u w = *(const v4u*)(src + 8 * dc); bf16* dst = vT + ((size_t)bg * 64 + 8 * dc) * SEQ + t;
        dst[0 * SEQ] = (bf16)(w.x & 0xffff); dst[1 * SEQ] = (bf16)(w.x >> 16); dst[2 * SEQ] = (bf16)(w.y & 0xffff); dst[3 * SEQ] = (bf16)(w.y >> 16);
        dst[4 * SEQ] = (bf16)(w.z & 0xffff); dst[5 * SEQ] = (bf16)(w.z >> 16); dst[6 * SEQ] = (bf16)(w.w & 0xffff); dst[7 * SEQ] = (bf16)(w.w >> 16); }
}
__device__ __forceinline__ void alora_task4(Frame& F, int mb) {
    const bf16* z = (const bf16*)(F.ws + WS_Z); bf16* AL = (bf16*)(F.ws + WS_PBF);
    const int l = F.lane;
    const f32x4 mu = *(const f32x4*)(F.ap->in[4] + ZC_W + 4 * l);
    v2u cw[4], pw[4];
#pragma unroll
    for (int u = 0; u < 4; ++u) { const int m = mb + u * F.NGW; const int t = m & (SEQ - 1); cw[u] = *(const v2u*)(z + (size_t)m * NZ + ZC_W + 4 * l); pw[u] = *(const v2u*)(z + (size_t)(t > 0 ? m - 1 : m) * NZ + ZC_W + 4 * l); }
#pragma unroll
    for (int u = 0; u < 4; ++u) { const int m = mb + u * F.NGW; const int t = m & (SEQ - 1);
        const f32x4 cur = unpk4(cw[u]); const f32x4 prev = unpk4(pw[u]) * (t > 0 ? 1.0f : 0.0f);
        f32x4 s = cur + (prev - cur) * mu;
        if (l < 16) { s.x = tanhf(s.x); s.y = tanhf(s.y); s.z = tanhf(s.z); s.w = tanhf(s.w); }
        else if (l >= 32) { s.x = sigmoidf_(s.x); s.y = sigmoidf_(s.y); s.z = sigmoidf_(s.z); s.w = sigmoidf_(s.w); }
        *(v2u*)(AL + (size_t)m * 256 + 4 * l) = pk4(s); }
}
__device__ __forceinline__ void p2_prep(Frame& F) {
    constexpr int T1 = 1024, T2 = T1 + 1024;
    for (int it = F.vcu; it < 256; it += F.G) compress_wg_task(F, it);
    for (int task = F.gw; task < T2; task += F.NGW) {
        if (task < T1) zgate_task(F, task);
        else vt_task(F, task - T1);
    }
    for (int base = F.gw; base < M; base += 4 * F.NGW) alora_task4(F, base);
}

__device__ __forceinline__ void ld16(const bf16* p, float (&f)[16]) { float a[8], b[8]; unpk8(*(const v4u*)p, a); unpk8(*(const v4u*)(p + 8), b);
#pragma unroll
    for (int i = 0; i < 8; ++i) { f[i] = a[i]; f[8 + i] = b[i]; } }
__device__ __forceinline__ void ld16f(const float* p, float (&f)[16]) {
#pragma unroll
    for (int q = 0; q < 4; ++q) { const f32x4 v = *(const f32x4*)(p + 4 * q); f[4 * q] = v.x; f[4 * q + 1] = v.y; f[4 * q + 2] = v.z; f[4 * q + 3] = v.w; } }
__device__ __forceinline__ void st16(bf16* p, const float (&f)[16]) { v4u a, b; a.x = pk2(f[0], f[1]); a.y = pk2(f[2], f[3]); a.z = pk2(f[4], f[5]); a.w = pk2(f[6], f[7]); b.x = pk2(f[8], f[9]); b.y = pk2(f[10], f[11]); b.z = pk2(f[12], f[13]); b.w = pk2(f[14], f[15]);
    *(v4u*)p = a; *(v4u*)(p + 8) = b; }
struct PrepW { bf16x8 w[2], a[2], g[4]; };
constexpr int PW_OFF = 32768, PW_P64 = 144, PW_P128 = 272, PW_A_OFF = PW_OFF + 64 * PW_P64, PW_G_OFF = PW_A_OFF + 64 * PW_P64;
__device__ __forceinline__ void prep_stage_w(Frame& F, int h) {
    const bf16* w2T = (const bf16*)(F.ws + WS_SMALLW + SW_W2T) + (size_t)h * 64 * 64; const bf16* a2T = (const bf16*)(F.ws + WS_SMALLW + SW_A2T) + (size_t)h * 64 * 64; const bf16* g2T = (const bf16*)(F.ws + WS_SMALLW + SW_G2T) + (size_t)h * 64 * 128;
    { const int R = F.tid >> 3, c = F.tid & 7, slot = ((R >> 2) & 3) * 16 + (R >> 4) * 4 + (R & 3);
      *(LAS v4u*)(F.lds + PW_OFF + slot * PW_P64 + c * 16) = *(const v4u*)(w2T + R * 64 + c * 8); *(LAS v4u*)(F.lds + PW_A_OFF + slot * PW_P64 + c * 16) = *(const v4u*)(a2T + R * 64 + c * 8); }
#pragma unroll
    for (int i = 0; i < 2; ++i) { const int id = F.tid + 512 * i, R = id >> 4, c = id & 15, slot = ((R >> 2) & 3) * 16 + (R >> 4) * 4 + (R & 3);
      *(LAS v4u*)(F.lds + PW_G_OFF + slot * PW_P128 + c * 16) = *(const v4u*)(g2T + R * 128 + c * 8); }
}
__device__ __forceinline__ void prep_ldw(PrepW& W, const LAS unsigned char* lds, int n, int fr, int fq) {
#pragma unroll
    for (int ks = 0; ks < 2; ++ks) { W.w[ks] = *(const LAS bf16x8*)(lds + PW_OFF + (n * 16 + fr) * PW_P64 + 64 * ks + 16 * fq); W.a[ks] = *(const LAS bf16x8*)(lds + PW_A_OFF + (n * 16 + fr) * PW_P64 + 64 * ks + 16 * fq); }
#pragma unroll
    for (int ks = 0; ks < 4; ++ks) W.g[ks] = *(const LAS bf16x8*)(lds + PW_G_OFF + (n * 16 + fr) * PW_P128 + 64 * ks + 16 * fq);
}
__device__ __forceinline__ void ldpar(const LAS float* p, float (&f)[16]) {
#pragma unroll
    for (int q = 0; q < 4; ++q) { const f32x4 v = *(const LAS f32x4*)(p + 4 * q); f[4 * q] = v.x; f[4 * q + 1] = v.y; f[4 * q + 2] = v.z; f[4 * q + 3] = v.w; } }
__device__ __forceinline__ void rwkv_prep_task(Frame& F, int task, const LAS float* par) {
    const int h = task & 7, m0 = (task >> 3) * 16, fr = F.lane & 15, fq = F.lane >> 4, m = m0 + fr, t = m & (SEQ - 1);
    const bf16* z = (const bf16*)(F.ws + WS_Z); const bf16* AL = (const bf16*)(F.ws + WS_PBF);
    bf16* vbuf = (bf16*)F.out; bf16* gbuf = (bf16*)(F.ws + WS_G);
    const int cl = h * 64 + 16 * fq;
    bf16x8 bw[2], ba[2], bgf[4];
    const bf16* alr = AL + (size_t)m * 256 + 8 * fq;
#pragma unroll
    for (int ks = 0; ks < 2; ++ks) { bw[ks] = *(const bf16x8*)(alr + 32 * ks); ba[ks] = *(const bf16x8*)(alr + 64 + 32 * ks); }
#pragma unroll
    for (int ks = 0; ks < 4; ++ks) bgf[ks] = *(const bf16x8*)(alr + 128 + 32 * ks);
    const bf16* zc = z + (size_t)m * NZ + cl; const bf16* zp = (t > 0) ? zc - NZ : zc;
    v4u zraw[6][2];
#pragma unroll
    for (int q = 0; q < 3; ++q) { zraw[q][0] = *(const v4u*)(zc + 512 * q); zraw[q][1] = *(const v4u*)(zc + 512 * q + 8); zraw[3 + q][0] = *(const v4u*)(zp + 512 * q); zraw[3 + q][1] = *(const v4u*)(zp + 512 * q + 8); }
    __builtin_amdgcn_sched_barrier(0);
    float ev[16], av[16], gv[16];
#define PREP_MM(W, n) do { f32x4 accw = (f32x4){0.f, 0.f, 0.f, 0.f}, acca = accw, accg = accw; \
        _Pragma("unroll") for (int ks = 0; ks < 2; ++ks) { accw = MFMA16(W.w[ks], bw[ks], accw); acca = MFMA16(W.a[ks], ba[ks], acca); } \
        _Pragma("unroll") for (int ks = 0; ks < 4; ++ks) accg = MFMA16(W.g[ks], bgf[ks], accg); \
        _Pragma("unroll") for (int r = 0; r < 4; ++r) { ev[4 * (n) + r] = accw[r]; av[4 * (n) + r] = acca[r]; gv[4 * (n) + r] = accg[r]; } } while (0)
    { PrepW Wa, Wb;
      prep_ldw(Wa, F.lds, 0, fr, fq); prep_ldw(Wb, F.lds, 1, fr, fq); PREP_MM(Wa, 0); PREP_MM(Wb, 1);
      prep_ldw(Wa, F.lds, 2, fr, fq); prep_ldw(Wb, F.lds, 3, fr, fq); PREP_MM(Wa, 2); PREP_MM(Wb, 3); }
    float zr[16], zk[16], zv[16], tmp[16];
    const float pm = (t > 0) ? 1.0f : 0.0f;
    {   float c[16], p[16];
#define PREP_UNP(q, dst) do { float a_[8], b_[8]; unpk8(zraw[q][0], a_); unpk8(zraw[q][1], b_); _Pragma("unroll") for (int i = 0; i < 8; ++i) { dst[i] = a_[i]; dst[8 + i] = b_[i]; } } while (0)
        PREP_UNP(0, c); PREP_UNP(3, p); ldpar(par + 0 * 64 + 16 * fq, tmp);
#pragma unroll
        for (int e = 0; e < 16; ++e) zr[e] = c[e] + (p[e] * pm - c[e]) * tmp[e];
        PREP_UNP(1, c); PREP_UNP(4, p); ldpar(par + 1 * 64 + 16 * fq, tmp);
#pragma unroll
        for (int e = 0; e < 16; ++e) zk[e] = c[e] + (p[e] * pm - c[e]) * tmp[e];
        PREP_UNP(2, c); PREP_UNP(5, p); ldpar(par + 2 * 64 + 16 * fq, tmp);
#pragma unroll
        for (int e = 0; e < 16; ++e) zv[e] = c[e] + (p[e] * pm - c[e]) * tmp[e];
    }
    float kkr[16]; float ss = 0.f;
    ldpar(par + 3 * 64 + 16 * fq, tmp);
#pragma unroll
    for (int e = 0; e < 16; ++e) { const float x = -(tmp[e] + ev[e]); const float sp = fmaxf(x, 0.f) + __logf(1.0f + __expf(-fabsf(x))); ev[e] = __expf(-sp - 0.5f); }
    ldpar(par + 4 * 64 + 16 * fq, tmp);
#pragma unroll
    for (int e = 0; e < 16; ++e) av[e] = sigmoidf_(tmp[e] + av[e]);
    ldpar(par + 5 * 64 + 16 * fq, tmp);
#pragma unroll
    for (int e = 0; e < 16; ++e) { kkr[e] = zk[e] * tmp[e]; ss += kkr[e] * kkr[e]; }
    ss += __shfl_xor(ss, 16); ss += __shfl_xor(ss, 32);
    const float inv = 1.0f / fmaxf(sqrtf(ss), 1e-12f);
    ldpar(par + 6 * 64 + 16 * fq, tmp);
    float kp[16], kka[16];
#pragma unroll
    for (int e = 0; e < 16; ++e) { kkr[e] *= inv; kka[e] = kkr[e] * av[e]; kp[e] = zk[e] * (1.0f + (av[e] - 1.0f) * tmp[e]); }
    st16(vbuf + (size_t)m * 512 + cl, zv); st16(gbuf + (size_t)m * 512 + cl, gv);
    { ldpar(par + 7 * 64 + 16 * fq, tmp);
      float bsum = 0.f;
#pragma unroll
      for (int e = 0; e < 16; ++e) bsum += zr[e] * kp[e] * tmp[e];
      bsum += __shfl_xor(bsum, 16); bsum += __shfl_xor(bsum, 32);
      if (fq == 0) ((float*)(F.ws + WS_BONUS))[(size_t)m * 8 + h] = bsum; }
    asm volatile("" ::: "memory");
    unsigned char* rec = F.ws + WS_S + (size_t)task * CH_REC;
    bf16x8 Pb[2], Qb[2], Kb[2], Rb[2];
#pragma unroll
    for (int ks = 0; ks < 2; ++ks) {
        float Pm[8], Qm[8], Km[8], Rm[8], acv[8];
#pragma unroll
        for (int e8 = 0; e8 < 8; ++e8) { const int e = 8 * ks + e8;
            float cs = ev[e]; cs += dppf<0x111>(cs); cs += dppf<0x112>(cs); cs += dppf<0x114>(cs); cs += dppf<0x118>(cs);
            const float A = __expf(-cs), Ap = __expf(ev[e] - cs), iA = __expf(cs);
            Pm[e8] = kkr[e] * Ap; Qm[e8] = -kka[e] * iA; Km[e8] = kp[e] * iA; Rm[e8] = zr[e] * A; acv[e8] = A; }
        v4u w;
        w.x = pk2(Pm[0], Pm[1]); w.y = pk2(Pm[2], Pm[3]); w.z = pk2(Pm[4], Pm[5]); w.w = pk2(Pm[6], Pm[7]); Pb[ks] = __builtin_bit_cast(bf16x8, w);
        w.x = pk2(Qm[0], Qm[1]); w.y = pk2(Qm[2], Qm[3]); w.z = pk2(Qm[4], Qm[5]); w.w = pk2(Qm[6], Qm[7]); Qb[ks] = __builtin_bit_cast(bf16x8, w);
        w.x = pk2(Km[0], Km[1]); w.y = pk2(Km[2], Km[3]); w.z = pk2(Km[4], Km[5]); w.w = pk2(Km[6], Km[7]); Kb[ks] = __builtin_bit_cast(bf16x8, w);
        w.x = pk2(Rm[0], Rm[1]); w.y = pk2(Rm[2], Rm[3]); w.z = pk2(Rm[4], Rm[5]); w.w = pk2(Rm[6], Rm[7]); Rb[ks] = __builtin_bit_cast(bf16x8, w);
        if (fr == 15) { *(f32x4*)(rec + CH_AC + (16 * fq + 8 * ks) * 4) = (f32x4){acv[0], acv[1], acv[2], acv[3]}; *(f32x4*)(rec + CH_AC + (16 * fq + 8 * ks + 4) * 4) = (f32x4){acv[4], acv[5], acv[6], acv[7]}; }
    }
    *(v4u*)(rec + CH_P + fr * CH_PP + 32 * fq) = __builtin_bit_cast(v4u, Pb[0]); *(v4u*)(rec + CH_P + fr * CH_PP + 32 * fq + 16) = __builtin_bit_cast(v4u, Pb[1]);
    *(v4u*)(rec + CH_R + fr * CH_PP + 32 * fq) = __builtin_bit_cast(v4u, Rb[0]); *(v4u*)(rec + CH_R + fr * CH_PP + 32 * fq + 16) = __builtin_bit_cast(v4u, Rb[1]);
    *(v4u*)(rec + CH_Q + (fq * 16 + fr) * 32) = __builtin_bit_cast(v4u, Qb[0]); *(v4u*)(rec + CH_Q + (fq * 16 + fr) * 32 + 16) = __builtin_bit_cast(v4u, Qb[1]);
    *(v4u*)(rec + CH_K + (fq * 16 + fr) * 32) = __builtin_bit_cast(v4u, Kb[0]); *(v4u*)(rec + CH_K + (fq * 16 + fr) * 32 + 16) = __builtin_bit_cast(v4u, Kb[1]);
    f32x4 gqp = (f32x4){0.f, 0.f, 0.f, 0.f}, gkp = gqp, gqr = gqp, gkr = gqp;
#pragma unroll
    for (int ks = 0; ks < 2; ++ks) { gqp = MFMA16(Qb[ks], Pb[ks], gqp); gkp = MFMA16(Kb[ks], Pb[ks], gkp); gqr = MFMA16(Qb[ks], Rb[ks], gqr); gkr = MFMA16(Kb[ks], Rb[ks], gkr); }
#pragma unroll
    for (int rg = 0; rg < 4; ++rg) { const int s = 4 * fq + rg; if (!(s < fr)) { gqp[rg] = 0.f; gkp[rg] = 0.f; } if (!(s <= fr)) { gqr[rg] = 0.f; gkr[rg] = 0.f; } }
    *(v2u*)(rec + CH_G + 0 * 512 + (fr * 16 + 4 * fq) * 2) = pk4(gkp);
    *(v2u*)(rec + CH_G + 2 * 512 + (fr * 16 + 4 * fq) * 2) = pk4(gqr);
    *(v2u*)(rec + CH_G + 3 * 512 + (fr * 16 + 4 * fq) * 2) = pk4(gkr);
    LAS float* Nl = (LAS float*)(F.lds + F.wave * 4096);
#pragma unroll
    for (int rg = 0; rg < 4; ++rg) Nl[(4 * fq + rg) * 20 + fr] = gqp[rg];
    LDS_WAIT(); __builtin_amdgcn_wave_barrier(); asm volatile("" ::: "memory");
    float Tc[16];
#pragma unroll
    for (int s = 15; s >= 0; --s) {
        float acc = 0.f;
#pragma unroll
        for (int q4 = 0; q4 < 4; ++q4) if (4 * q4 + 3 > s) { const f32x4 nv = *(const LAS f32x4*)(Nl + s * 20 + 4 * q4);
#pragma unroll
            for (int u = 0; u < 4; ++u) if (4 * q4 + u > s) acc += nv[u] * Tc[4 * q4 + u]; }
        Tc[s] = (s == fr) ? 1.0f : acc; }
    { f32x4 tv;
#pragma unroll
      for (int u = 0; u < 4; ++u) tv[u] = fq == 0 ? Tc[u] : (fq == 1 ? Tc[4 + u] : (fq == 2 ? Tc[8 + u] : Tc[12 + u]));
      *(v2u*)(rec + CH_G + 1 * 512 + (fr * 16 + 4 * fq) * 2) = pk4(tv); }
    LDS_WAIT(); __builtin_amdgcn_wave_barrier(); asm volatile("" ::: "memory");
#undef PREP_MM
#undef PREP_UNP
}
__device__ __forceinline__ void prep_fill_par(Frame& F, LAS float* par, int h) {
    const int l = F.lane; const float* mu = F.ap->in[4];
    par[0 * 64 + l] = mu[ZC_R + h * 64 + l]; par[1 * 64 + l] = mu[ZC_K + h * 64 + l]; par[2 * 64 + l] = mu[ZC_V + h * 64 + l];
    par[3 * 64 + l] = F.ap->in[5][h * 64 + l]; par[4 * 64 + l] = F.ap->in[7][h * 64 + l]; par[5 * 64 + l] = F.ap->in[10][h * 64 + l]; par[6 * 64 + l] = F.ap->in[11][h * 64 + l]; par[7 * 64 + l] = F.ap->in[12][h * 64 + l];
    LDS_WAIT(); __builtin_amdgcn_wave_barrier(); asm volatile("" ::: "memory");
}

__device__ __forceinline__ float nsa_slope(int g, int r) { return __uint_as_float((unsigned)(127 - (g * 4 + r + 1)) << 23); }

constexpr int CMP_KC_OFF = 32768, CMP_KP = 144, CMP_VC_OFF = CMP_KC_OFF + 128 * CMP_KP, CMP_VP = 264;
__device__ __forceinline__ void nsa_cmp_stage(Frame& F, int bg) {
    const bf16* kcmp = (const bf16*)(F.ws + WS_KCMP) + (size_t)bg * 128 * 64; const bf16* vcmpT = (const bf16*)(F.ws + WS_KCMP + 512 * 1024) + (size_t)bg * 64 * 128;
    v4u a[2], v[2];
#pragma unroll
    for (int i = 0; i < 2; ++i) { const int id = F.tid + 512 * i; a[i] = *(const v4u*)(kcmp + (size_t)(id >> 3) * 64 + (id & 7) * 8); v[i] = *(const v4u*)(vcmpT + (size_t)(id >> 4) * 128 + (id & 15) * 8); }
#pragma unroll
    for (int i = 0; i < 2; ++i) { const int id = F.tid + 512 * i; *(LAS v4u*)(F.lds + CMP_KC_OFF + (id >> 3) * CMP_KP + (id & 7) * 16) = a[i]; *(LAS v4u*)(F.lds + CMP_VC_OFF + (id >> 4) * CMP_VP + (id & 15) * 16) = v[i]; }
}
template <int ABL>
__device__ __forceinline__ void nsa_cmp_task(Frame& F, int task) {
    const int tile = task & 127, bg = task >> 7, b = bg >> 1, g = bg & 1;
    const int fr = F.lane & 15, fq = F.lane >> 4, t = tile * 16 + fr, m = b * SEQ + t;
    const bf16* z = (const bf16*)(F.ws + WS_Z);
    const float* zg = (const float*)(F.ws + WS_ZGATE); const float* gb = F.ap->in[21];
    bf16* Y = (bf16*)(F.ws + WS_YB);
    bf16x8 qall[4][2]; float gl[4];
#pragma unroll
    for (int r = 0; r < 4; ++r) { const bf16* qp = z + (size_t)m * NZ + ZC_Q + (g * 4 + r) * 64 + 8 * fq; qall[r][0] = *(const bf16x8*)qp; qall[r][1] = *(const bf16x8*)(qp + 32);
        gl[r] = zg[(size_t)m * 32 + (g * 4 + r) * 3 + 0] + gb[(g * 4 + r) * 3 + 0]; }
    const LAS unsigned char* kc = F.lds + CMP_KC_OFF + fr * CMP_KP + 16 * fq; const LAS unsigned char* vc = F.lds + CMP_VC_OFF + fr * CMP_VP + 8 * fq;
    const int tv = t - 31 - 64 * fq; const float tb = (float)t - 15.5f - 64.0f * (float)fq;
    float impl[8], imp3[8];
#pragma unroll
    for (int kt = 0; kt < 8; ++kt) { impl[kt] = 0.f; imp3[kt] = 0.f; }
#pragma unroll
    for (int r = 0; r < 4; ++r) {
        const float slope = nsa_slope(g, r);
        const bf16x8 q0 = qall[r][0], q1 = qall[r][1];
        float s[8][4]; float mx = -1e30f;
#pragma unroll
        for (int kt = 0; kt < 8; ++kt) {
            f32x4 a = (f32x4){0.f, 0.f, 0.f, 0.f};
            a = MFMA16(*(const LAS bf16x8*)(kc + 16 * kt * CMP_KP), q0, a); a = MFMA16(*(const LAS bf16x8*)(kc + 16 * kt * CMP_KP + 64), q1, a);
#pragma unroll
            for (int rg = 0; rg < 4; ++rg) { const bool valid = ((256 * kt + 16 * rg) <= tv);
                const float sc = a[rg] * 0.125f - slope * (tb - (float)(256 * kt + 16 * rg)); s[kt][rg] = valid ? sc : -1e30f; mx = fmaxf(mx, s[kt][rg]); }
        }
        mx = fmaxf(mx, __shfl_xor(mx, 16)); mx = fmaxf(mx, __shfl_xor(mx, 32));
        float sum = 0.f;
#pragma unroll
        for (int kt = 0; kt < 8; ++kt)
#pragma unroll
            for (int rg = 0; rg < 4; ++rg) { const float p = (s[kt][rg] > -1e29f) ? __expf(s[kt][rg] - mx) : 0.f; s[kt][rg] = p; sum += p; }
        sum += __shfl_xor(sum, 16); sum += __shfl_xor(sum, 32);
        const float inv = sum > 0.f ? 1.0f / sum : 0.f;
#pragma unroll
        for (int kt = 0; kt < 8; ++kt) {
#pragma unroll
            for (int rg = 0; rg < 4; ++rg) s[kt][rg] *= inv;
            impl[kt] += s[kt][0] + s[kt][1] + s[kt][2] + 0.5f * s[kt][3]; imp3[kt] += s[kt][3]; }
        f32x4 o[4];
#pragma unroll
        for (int dt = 0; dt < 4; ++dt) o[dt] = (f32x4){0.f, 0.f, 0.f, 0.f};
#pragma unroll
        for (int s2 = 0; s2 < 4; ++s2) {
            v4u pw; pw.x = pk2(s[2 * s2][0], s[2 * s2][1]); pw.y = pk2(s[2 * s2][2], s[2 * s2][3]); pw.z = pk2(s[2 * s2 + 1][0], s[2 * s2 + 1][1]); pw.w = pk2(s[2 * s2 + 1][2], s[2 * s2 + 1][3]);
            const bf16x8 pb = __builtin_bit_cast(bf16x8, pw);
#pragma unroll
            for (int dt = 0; dt < 4; ++dt) { const LAS unsigned char* vp = vc + 16 * dt * CMP_VP + 64 * s2; const v2u lo = *(const LAS v2u*)vp, hi = *(const LAS v2u*)(vp + 32);
                v4u aw; aw.x = lo.x; aw.y = lo.y; aw.z = hi.x; aw.w = hi.y; o[dt] = MFMA16(__builtin_bit_cast(bf16x8, aw), pb, o[dt]); }
        }
        const int hh = g * 4 + r; const float gate = sigmoidf_(gl[r]);
#pragma unroll
        for (int dt = 0; dt < 4; ++dt) *(v2u*)(Y + (size_t)m * 512 + hh * 64 + 16 * dt + 4 * fq) = pk4(o[dt] * gate);
        __builtin_amdgcn_sched_barrier(0);
    }
    if (ABL == 1) return;
    LAS float* sc = (LAS float*)(F.lds + F.wave * 4096);
    float y3prev = 0.f;
#pragma unroll
    for (int kt = 0; kt < 8; ++kt) {
        const float y3 = __shfl(imp3[kt], (F.lane + 48) & 63);
        const float prev = (fq > 0) ? y3 : y3prev; y3prev = y3;
        sc[fr * 33 + 4 * kt + fq] = impl[kt] + 0.5f * prev;
    }
    LDS_WAIT(); __builtin_amdgcn_wave_barrier(); asm volatile("" ::: "memory");
    const int blk_t = t >> 6, chi = blk_t - 2;
    unsigned mask = 1u | (1u << blk_t) | (blk_t > 0 ? (1u << (blk_t - 1)) : 0u);
#pragma unroll
    for (int kt = 0; kt < 8; ++kt) {
        const int k = 4 * kt + fq;
        if (k >= 1 && k <= chi) { const float me = sc[fr * 33 + k]; int rank = 0;
            for (int k2 = 1; k2 <= chi; ++k2) { const float o = sc[fr * 33 + k2]; rank += (o > me || (o == me && k2 < k)) ? 1 : 0; }
            if (rank < 5) mask |= (1u << k); }
    }
    mask |= (unsigned)__shfl_xor((int)mask, 16); mask |= (unsigned)__shfl_xor((int)mask, 32);
    if (fq == 0) ((unsigned*)(F.ws + WS_SELMASK))[(size_t)bg * SEQ + t] = mask;
    LDS_WAIT(); __builtin_amdgcn_wave_barrier(); asm volatile("" ::: "memory");
}
__device__ __forceinline__ void p3_phase(Frame& F) {
    constexpr int T0 = 2048, T1 = T0 + 8192;
#ifdef DUP_P3A
    for (int task = F.gw; task < T0; task += F.NGW) { __syncthreads(); nsa_cmp_stage(F, task >> 7); LDS_WAIT(); __syncthreads(); nsa_cmp_task<DUP_P3A>(F, task); }
    asm volatile("" ::: "memory");
#endif
    for (int task = F.gw; task < T0; task += F.NGW) { __syncthreads(); nsa_cmp_stage(F, task >> 7); LDS_WAIT(); __syncthreads(); nsa_cmp_task<0>(F, task); }
    asm volatile("" ::: "memory");
    const int h = F.vcu & 7;
    LAS float* par = (LAS float*)(F.lds + F.wave * 4096 + 2048);
    __syncthreads();
    prep_fill_par(F, par, h); prep_stage_w(F, h);
    LDS_WAIT(); __syncthreads();
#ifdef DUP_P3B
    for (int i = F.wave; i < 32; i += 8) rwkv_prep_task(F, (((F.vcu >> 3) + 32 * i) << 3) | h, par);
    asm volatile("" ::: "memory");
#endif
    for (int i = F.wave; i < 32; i += 8) rwkv_prep_task(F, (((F.vcu >> 3) + 32 * i) << 3) | h, par);
}

constexpr int NSA_KP = 144, NSA_VP = 136, NSA_BUF = 64 * NSA_KP + 64 * NSA_VP, NSA_CTL = 2 * NSA_BUF + 1024;
struct NsaState { f32x4 O[2][4]; float mrun[2], lrun[2]; };
template <int WHICH, bool MASKED>
__device__ __forceinline__ void nsa_block(NsaState& St, const LAS unsigned char* kb_, const LAS unsigned char* vb_, const bf16x8 (&qf)[2][2], int kb, unsigned mymask, int t, int fq, float slope0) {
    const int kpos0 = 64 * kb;
    bf16x8 kf[4][2];
#pragma unroll
    for (int kt = 0; kt < 4; ++kt) { kf[kt][0] = *(const LAS bf16x8*)(kb_ + 16 * kt * NSA_KP); kf[kt][1] = *(const LAS bf16x8*)(kb_ + 16 * kt * NSA_KP + 64); }
    const bool bsel = (mymask >> kb) & 1u; const int dbase = t - 4 * fq - kpos0;
    const float fdb = (float)dbase;
    bf16x8 P[2][2];
#pragma unroll
    for (int r = 0; r < 2; ++r) {
        const float slope = r ? 0.5f * slope0 : slope0;
        float s[4][4]; float bm = -1e30f;
        float base = -slope * fdb;
        const float s1 = slope, s2_ = 2.0f * slope, s3 = 3.0f * slope, s16 = 16.0f * slope;
#pragma unroll
        for (int kt = 0; kt < 4; ++kt) { f32x4 a = (f32x4){base, base + s1, base + s2_, base + s3}; base += s16;
            a = MFMA16(kf[kt][0], qf[r][0], a); a = MFMA16(kf[kt][1], qf[r][1], a);
#pragma unroll
            for (int rg = 0; rg < 4; ++rg) {
                if (MASKED) { const int dist = dbase - (16 * kt + rg); const bool valid = bsel && dist >= 0 && (WHICH == 0 || dist < 512); s[kt][rg] = valid ? a[rg] : -1e30f; }
                else s[kt][rg] = a[rg];
                bm = fmaxf(bm, s[kt][rg]); } }
        bm = fmaxf(bm, __shfl_xor(bm, 16)); bm = fmaxf(bm, __shfl_xor(bm, 32));
        const float mnew = fmaxf(St.mrun[r], bm); const float scale = __builtin_amdgcn_exp2f(St.mrun[r] - mnew); St.mrun[r] = mnew;
        float ps = 0.f;
#pragma unroll
        for (int kt = 0; kt < 4; ++kt)
#pragma unroll
            for (int rg = 0; rg < 4; ++rg) { float p = __builtin_amdgcn_exp2f(s[kt][rg] - mnew); if (MASKED) p = (s[kt][rg] > -1e29f) ? p : 0.f; s[kt][rg] = p; ps += p; }
        St.lrun[r] = St.lrun[r] * scale + ps;
#pragma unroll
        for (int dt = 0; dt < 4; ++dt) St.O[r][dt] = St.O[r][dt] * scale;
#pragma unroll
        for (int s2 = 0; s2 < 2; ++s2) { v4u pw; pw.x = pk2(s[2 * s2][0], s[2 * s2][1]); pw.y = pk2(s[2 * s2][2], s[2 * s2][3]); pw.z = pk2(s[2 * s2 + 1][0], s[2 * s2 + 1][1]); pw.w = pk2(s[2 * s2 + 1][2], s[2 * s2 + 1][3]);
            P[r][s2] = __builtin_bit_cast(bf16x8, pw); }
    }
#pragma unroll
    for (int dt = 0; dt < 4; ++dt)
#pragma unroll
        for (int s2 = 0; s2 < 2; ++s2) { const LAS unsigned char* vp = vb_ + 16 * dt * NSA_VP + 64 * s2; const v2u lo = *(const LAS v2u*)vp, hi = *(const LAS v2u*)(vp + 32);
            v4u aw; aw.x = lo.x; aw.y = lo.y; aw.z = hi.x; aw.w = hi.y; const bf16x8 vf = __builtin_bit_cast(bf16x8, aw);
#pragma unroll
            for (int r = 0; r < 2; ++r) St.O[r][dt] = MFMA16(vf, P[r][s2], St.O[r][dt]); }
}
template <int WHICH>
__device__ __forceinline__ void nsa_wg_task(Frame& F, int item, v2u (&carry)[2][4]) {
    const int hp = item & 1, bg = item >> 5, tg = (item >> 1) & 15, b = bg >> 1, g = bg & 1;
    const int fr = F.lane & 15, fq = F.lane >> 4, tile = tg * 8 + F.wave, t0 = tile * 16, t = t0 + fr, m = b * SEQ + t;
    const int h0 = g * 4 + 2 * hp;
    const bf16* z = (const bf16*)(F.ws + WS_Z);
    const bf16* Kb = z + (size_t)b * SEQ * NZ + (WHICH ? ZC_KW : ZC_KS) + g * 64;
    const bf16* VT = (const bf16*)(F.ws + (WHICH ? WS_VWT : WS_VST)) + (size_t)bg * 64 * SEQ;
    unsigned mymask, tile_or, full; const int kb_hi = (t0 + 15) >> 6;
    if (WHICH == 0) { mymask = ((const unsigned*)(F.ws + WS_SELMASK))[(size_t)bg * SEQ + t]; unsigned x = mymask, y = mymask;
        x |= (unsigned)__shfl_xor((int)x, 1); x |= (unsigned)__shfl_xor((int)x, 2); x |= (unsigned)__shfl_xor((int)x, 4); x |= (unsigned)__shfl_xor((int)x, 8);
        y &= (unsigned)__shfl_xor((int)y, 1); y &= (unsigned)__shfl_xor((int)y, 2); y &= (unsigned)__shfl_xor((int)y, 4); y &= (unsigned)__shfl_xor((int)y, 8);
        tile_or = (unsigned)__builtin_amdgcn_readfirstlane((int)x); full = (unsigned)__builtin_amdgcn_readfirstlane((int)y) & ((1u << kb_hi) - 1u); }
    else { mymask = 0xffffffffu; const int lo = (t0 - 511) > 0 ? ((t0 - 511) >> 6) : 0; tile_or = 0u; full = 0u;
        for (int k = lo; k <= kb_hi; ++k) { tile_or |= (1u << k); if (k < kb_hi && 64 * k >= t0 - 496) full |= (1u << k); } }
    tile_or &= (kb_hi >= 31) ? 0xffffffffu : ((2u << kb_hi) - 1u);
    LAS unsigned* ctl = (LAS unsigned*)(F.lds + NSA_CTL);
    __syncthreads();
    if (F.lane == 0) ctl[F.wave] = tile_or;
    LDS_WAIT(); __syncthreads();
    unsigned rem = 0u;
#pragma unroll
    for (int w = 0; w < 8; ++w) rem |= ctl[w];
    rem = (unsigned)__builtin_amdgcn_readfirstlane((int)rem);
    bf16x8 qf[2][2];
#pragma unroll
    for (int r = 0; r < 2; ++r)
#pragma unroll
        for (int ks = 0; ks < 2; ++ks) { const v4u raw = *(const v4u*)(z + (size_t)m * NZ + ZC_Q + (h0 + r) * 64 + 8 * fq + 32 * ks); float f[8]; unpk8(raw, f);
            constexpr float QS = 0.125f * 1.4426950408889634f; v4u w; w.x = pk2(f[0] * QS, f[1] * QS); w.y = pk2(f[2] * QS, f[3] * QS); w.z = pk2(f[4] * QS, f[5] * QS); w.w = pk2(f[6] * QS, f[7] * QS);
            qf[r][ks] = __builtin_bit_cast(bf16x8, w); }
    NsaState St;
#pragma unroll
    for (int r = 0; r < 2; ++r) { St.mrun[r] = -1e30f; St.lrun[r] = 0.f;
#pragma unroll
        for (int dt = 0; dt < 4; ++dt) St.O[r][dt] = (f32x4){0.f, 0.f, 0.f, 0.f}; }
    const float slope0 = 1.4426950408889634f * __uint_as_float((unsigned)(127 - (h0 + 1)) << 23);
    const int srow = F.tid >> 3, sc = F.tid & 7;
    const bf16* ksrc = Kb + (size_t)srow * NZ + sc * 8; const bf16* vsrc = VT + (size_t)srow * SEQ + sc * 8;
    const int kdst = srow * NSA_KP + sc * 16, vdst = 64 * NSA_KP + srow * NSA_VP + sc * 16;
    const LAS unsigned char* kfr = F.lds + fr * NSA_KP + 16 * fq; const LAS unsigned char* vfr = F.lds + 64 * NSA_KP + fr * NSA_VP + 8 * fq;
    int kb = __builtin_ctz(rem); rem &= rem - 1u;
    v4u kreg = *(const v4u*)(ksrc + (size_t)64 * kb * NZ), vreg = *(const v4u*)(vsrc + 64 * kb);
    *(LAS v4u*)(F.lds + kdst) = kreg; *(LAS v2u*)(F.lds + vdst) = (v2u){vreg.x, vreg.y}; *(LAS v2u*)(F.lds + vdst + 8) = (v2u){vreg.z, vreg.w};
    LDS_WAIT(); __syncthreads();
    int buf = 0;
    for (;;) {
        int kbn = -1;
        if (rem) { kbn = __builtin_ctz(rem); rem &= rem - 1u; kreg = *(const v4u*)(ksrc + (size_t)64 * kbn * NZ); vreg = *(const v4u*)(vsrc + 64 * kbn); }
        __builtin_amdgcn_sched_barrier(0);
        if ((tile_or >> kb) & 1u) {
            if ((full >> kb) & 1u) nsa_block<WHICH, false>(St, kfr + buf * NSA_BUF, vfr + buf * NSA_BUF, qf, kb, mymask, t, fq, slope0);
            else nsa_block<WHICH, true>(St, kfr + buf * NSA_BUF, vfr + buf * NSA_BUF, qf, kb, mymask, t, fq, slope0);
        }
        __builtin_amdgcn_sched_barrier(0);
        if (kbn < 0) break;
        buf ^= 1;
        *(LAS v4u*)(F.lds + buf * NSA_BUF + kdst) = kreg; *(LAS v2u*)(F.lds + buf * NSA_BUF + vdst) = (v2u){vreg.x, vreg.y}; *(LAS v2u*)(F.lds + buf * NSA_BUF + vdst + 8) = (v2u){vreg.z, vreg.w};
        LDS_WAIT(); __syncthreads();
        kb = kbn;
    }
    const float* zg = (const float*)(F.ws + WS_ZGATE); const float* gb = F.ap->in[21];
    bf16* Y = (bf16*)(F.ws + WS_YB);
#pragma unroll
    for (int r = 0; r < 2; ++r) { float l = St.lrun[r]; l += __shfl_xor(l, 16); l += __shfl_xor(l, 32);
        const int hh = h0 + r; const float gate = sigmoidf_(zg[(size_t)m * 32 + hh * 3 + 1 + WHICH] + gb[hh * 3 + 1 + WHICH]); const float f = gate / l;
        if (WHICH == 1) {
#pragma unroll
            for (int dt = 0; dt < 4; ++dt) carry[r][dt] = pk4(St.O[r][dt] * f);
        } else {
            v2u yc[4];
#pragma unroll
            for (int dt = 0; dt < 4; ++dt) yc[dt] = *(const v2u*)(Y + (size_t)m * 512 + hh * 64 + 16 * dt + 4 * fq);
#pragma unroll
            for (int dt = 0; dt < 4; ++dt) *(v2u*)(Y + (size_t)m * 512 + hh * 64 + 16 * dt + 4 * fq) = pk4(unpk4(yc[dt]) + unpk4(pk4(St.O[r][dt] * f)) + unpk4(carry[r][dt]));
        } }
}
__device__ __forceinline__ void p4_phase(Frame& F) {
    for (int it = F.vcu; it < 256; it += F.G)
        for (int k = 0; k < 2; ++k) { const int item = k ? 511 - it : it; v2u carry[2][4]; nsa_wg_task<1>(F, item, carry); nsa_wg_task<0>(F, item, carry); }
}

typedef short v4i16_t __attribute__((ext_vector_type(4)));
__device__ __forceinline__ bf16x8 tr_lo(const LAS unsigned char* p) {
    const v4i16_t t = __builtin_amdgcn_ds_read_tr16_b64_v4i16((LAS v4i16_t*)p);
    return (bf16x8){t[0], t[1], t[2], t[3], 0, 0, 0, 0};
}
__device__ __forceinline__ bf16x8 lo4(v2u g) { v4u w; w.x = g.x; w.y = g.y; w.z = 0u; w.w = 0u; return __builtin_bit_cast(bf16x8, w); }
__device__ __forceinline__ bf16x8 cat8(v2u a, v2u b) { v4u w; w.x = a.x; w.y = a.y; w.z = b.x; w.w = b.y; return __builtin_bit_cast(bf16x8, w); }
struct ChunkOps { v2u pA[2][2], rA[2][2], g[4]; f32x4 ac[4]; bf16x8 aq[4], ak[4], bv; };
__device__ __forceinline__ void chunk_load(const LAS unsigned char* sl, ChunkOps& X, int lane) {
    const int fr = lane & 15, fq = lane >> 4;
#pragma unroll
    for (int m = 0; m < 2; ++m) { X.pA[m][0] = *(const LAS v2u*)(sl + CH_P + fr * CH_PP + 64 * m + 8 * fq); X.pA[m][1] = *(const LAS v2u*)(sl + CH_P + fr * CH_PP + 64 * m + 32 + 8 * fq);
        X.rA[m][0] = *(const LAS v2u*)(sl + CH_R + fr * CH_PP + 64 * m + 8 * fq); X.rA[m][1] = *(const LAS v2u*)(sl + CH_R + fr * CH_PP + 64 * m + 32 + 8 * fq); }
#pragma unroll
    for (int x = 0; x < 4; ++x) X.g[x] = *(const LAS v2u*)(sl + CH_G + 512 * x + (fr * 16 + 4 * fq) * 2);
    X.bv = tr_lo(sl + CH_V + 8 * lane);
#pragma unroll
    for (int jt = 0; jt < 4; ++jt) { X.aq[jt] = tr_lo(sl + CH_Q + jt * 512 + 8 * lane); X.ak[jt] = tr_lo(sl + CH_K + jt * 512 + 8 * lane);
        X.ac[jt] = *(const LAS f32x4*)(sl + CH_AC + (16 * jt + 4 * fq) * 4); }
}
__device__ __forceinline__ bf16x8 lo4t(bf16x8 t) { return t; }
__device__ __forceinline__ void chunk_math(const ChunkOps& X, f32x4 (&S)[4], f32x4& o_out) {
    bf16x8 bs[2];
#pragma unroll
    for (int m = 0; m < 2; ++m) { v4u w; w.x = pk2(S[2 * m][0], S[2 * m][1]); w.y = pk2(S[2 * m][2], S[2 * m][3]); w.z = pk2(S[2 * m + 1][0], S[2 * m + 1][1]); w.w = pk2(S[2 * m + 1][2], S[2 * m + 1][3]); bs[m] = __builtin_bit_cast(bf16x8, w); }
    const f32x4 z4 = (f32x4){0.f, 0.f, 0.f, 0.f};
    const bf16x8 bv = lo4t(X.bv);
    f32x4 y = MFMA16(cat8(X.pA[0][0], X.pA[0][1]), bs[0], z4); y = MFMA16(cat8(X.pA[1][0], X.pA[1][1]), bs[1], y); y = MFMA16(lo4(X.g[0]), bv, y);
    f32x4 o = MFMA16(cat8(X.rA[0][0], X.rA[0][1]), bs[0], z4); o = MFMA16(cat8(X.rA[1][0], X.rA[1][1]), bs[1], o); o = MFMA16(lo4(X.g[3]), bv, o);
    const bf16x8 by = lo4(pk4(y));
    const f32x4 u = MFMA16(lo4(X.g[1]), by, z4);
    const bf16x8 bu = lo4(pk4(u));
    o_out = MFMA16(lo4(X.g[2]), bu, o);
#pragma unroll
    for (int jt = 0; jt < 4; ++jt) { S[jt] = MFMA16(lo4t(X.aq[jt]), bu, S[jt]); S[jt] = MFMA16(lo4t(X.ak[jt]), bv, S[jt]); S[jt] = S[jt] * X.ac[jt]; }
}
#ifndef SC_CONVW
#define SC_CONVW 3
#endif
constexpr int SC_NS = 7, SC_AHEAD = 5, SC_CTL = SC_NS * CH_SLOT, SCAN_TR_OFF = 81920;
__device__ __forceinline__ void scan_dma(const unsigned char* rec, const bf16* vt, LAS unsigned char* slot, int lane) {
#pragma unroll
    for (int i = 0; i < 10; ++i) __builtin_amdgcn_global_load_lds((const unsigned*)(rec + (lane + 64 * i) * 16), (LAS unsigned*)(slot + i * 1024), 16, 0, 0);
    if (lane < 48) __builtin_amdgcn_global_load_lds((const unsigned*)(rec + (lane + 640) * 16), (LAS unsigned*)(slot + 10240), 16, 0, 0);
    if (lane < 32) __builtin_amdgcn_global_load_lds((const unsigned*)(vt + (size_t)(lane >> 1) * 512 + 8 * (lane & 1)), (LAS unsigned*)(slot + CH_V), 16, 0, 0);
}
__device__ __forceinline__ int sc_ld(LAS int* p) { int v; const unsigned a = (unsigned)(size_t)p; asm volatile("ds_read_b32 %0, %1\n\ts_waitcnt lgkmcnt(0)" : "=&v"(v) : "v"(a) : "memory"); return v; }
__device__ __forceinline__ void sc_st(LAS int* p, int v) { const unsigned a = (unsigned)(size_t)p; asm volatile("ds_write_b32 %0, %1" :: "v"(a), "v"(v) : "memory"); }
#define SC_LD(p) sc_ld(p)
#define SC_ST(p, v) sc_st((p), (v))
__device__ __forceinline__ void p5_scan(Frame& F, bool extras = true, int abl = 0) {
    LAS int* ctl = (LAS int*)(F.lds + SC_CTL);
    if (F.tid < 4) ctl[F.tid] = 0;
    LDS_WAIT(); __syncthreads();
    constexpr int NKQ = (tri::NITEMS - tri::E12) / 256;
    LAS float* mytile = (LAS float*)(F.lds + SCAN_TR_OFF + F.wave * 8448);
    const int bh = F.vcu >> 2, b = bh >> 3, h = bh & 7, i0 = (F.vcu & 3) * 16;
    if (F.wave == 0) {
        if (abl & 1) return;
        __builtin_amdgcn_s_setprio(3);
        float* o0 = (float*)(F.ws + WS_XN) + (size_t)b * SEQ * 512 + h * 64 + i0;
        const int fr = F.lane & 15, fq = F.lane >> 4;
        f32x4 S[4];
#pragma unroll
        for (int jt = 0; jt < 4; ++jt) S[jt] = (f32x4){0.f, 0.f, 0.f, 0.f};
        ChunkOps XA, XB;
        while (SC_LD(&ctl[0]) <= 0) __builtin_amdgcn_s_sleep(1);
        asm volatile("" ::: "memory");
        chunk_load(F.lds, XA, F.lane);
        LDS_WAIT(); asm volatile("" ::: "memory");
        if (F.lane == 0) SC_ST(&ctl[1], 1);
#define SCAN_ITER(XC, XN_, c_) do { const int cc = (c_); \
            if (cc + 1 < 128) { while (SC_LD(&ctl[0]) <= cc + 1) __builtin_amdgcn_s_sleep(1); asm volatile("" ::: "memory"); chunk_load(F.lds + ((cc + 1) % SC_NS) * CH_SLOT, XN_, F.lane); } \
            __builtin_amdgcn_sched_barrier(0); \
            f32x4 o; chunk_math(XC, S, o); \
            __builtin_amdgcn_sched_barrier(0); \
            float* orow = o0 + (size_t)cc * 16 * 512; \
            _Pragma("unroll") for (int rg = 0; rg < 4; ++rg) { float* pp = orow + (size_t)(4 * fq + rg) * 512 + fr; const float vv = o[rg]; asm volatile("global_store_dword %0, %1, off" :: "v"(pp), "v"(vv) : "memory"); } \
            if (cc + 1 < 128) { LDS_WAIT(); asm volatile("" ::: "memory"); if (F.lane == 0) SC_ST(&ctl[1], cc + 2); } } while (0)
#pragma unroll 1
        for (int c = 0; c < 128; c += 2) { SCAN_ITER(XA, XB, c); SCAN_ITER(XB, XA, c + 1); }
#undef SCAN_ITER
        asm volatile("s_waitcnt vmcnt(0)" ::: "memory");
        __builtin_amdgcn_s_setprio(0);
        if (F.lane == 0) SC_ST(&ctl[3], 1);
        if (!(abl & 2)) tr_run_q(F, mytile, &ctl[2], tri::E12 + F.vcu, F.G, NKQ);
    } else if (F.wave == 1) {
        if (abl & 1) return;
        const unsigned char* rec0 = F.ws + WS_S + ((size_t)(b * 128) * 8 + h) * CH_REC;
        const bf16* vt0 = (const bf16*)F.out + (size_t)b * SEQ * 512 + h * 64 + i0;
        for (int n = 0; n < 128; ++n) {
            while (SC_LD(&ctl[1]) < n - SC_NS + 1) __builtin_amdgcn_s_sleep(1);
            asm volatile("" ::: "memory");
            scan_dma(rec0 + (size_t)n * 8 * CH_REC, vt0 + (size_t)n * 16 * 512, F.lds + (n % SC_NS) * CH_SLOT, F.lane);
            if (n >= SC_AHEAD) { asm volatile("s_waitcnt vmcnt(60)" ::: "memory"); if (F.lane == 0) SC_ST(&ctl[0], n - SC_AHEAD + 1); }
        }
        asm volatile("s_waitcnt vmcnt(48)" ::: "memory"); if (F.lane == 0) SC_ST(&ctl[0], 124);
        asm volatile("s_waitcnt vmcnt(36)" ::: "memory"); if (F.lane == 0) SC_ST(&ctl[0], 125);
        asm volatile("s_waitcnt vmcnt(24)" ::: "memory"); if (F.lane == 0) SC_ST(&ctl[0], 126);
        asm volatile("s_waitcnt vmcnt(12)" ::: "memory"); if (F.lane == 0) SC_ST(&ctl[0], 127);
        asm volatile("s_waitcnt vmcnt(0)" ::: "memory"); if (F.lane == 0) SC_ST(&ctl[0], 128);
        if (!(abl & 2)) { while (SC_LD(&ctl[3]) == 0) __builtin_amdgcn_s_sleep(8); tr_run_q(F, mytile, &ctl[2], tri::E12 + F.vcu, F.G, NKQ); }
    } else {
        const int w2 = F.vcu * 6 + (F.wave - 2), NW2 = F.G * 6;
        if (!(abl & 2) && F.wave - 2 < SC_CONVW) tr_run_q(F, mytile, &ctl[2], tri::E12 + F.vcu, F.G, NKQ);
        if (!extras) return;
        const float* p = F.ap->in[1]; bf16* PB = (bf16*)(F.ws + WS_PBF);
        constexpr size_t NV = (size_t)M * 256 / 4;
        for (size_t b0 = (size_t)w2 * 64 + F.lane; b0 < NV; b0 += (size_t)8 * NW2 * 64) {
            f32x4 pv[8];
#pragma unroll
            for (int i = 0; i < 8; ++i) { const size_t idx = b0 + (size_t)i * NW2 * 64; pv[i] = (idx < NV) ? *(const f32x4*)(p + idx * 4) : (f32x4){0.f, 0.f, 0.f, 0.f}; }
#pragma unroll
            for (int i = 0; i < 8; ++i) { const size_t idx = b0 + (size_t)i * NW2 * 64; if (idx < NV) *(v2u*)(PB + idx * 4) = pk4(pv[i]); } }
        if (!(abl & 2) && F.wave - 2 >= SC_CONVW) { while (SC_LD(&ctl[3]) == 0) __builtin_amdgcn_s_sleep(8); tr_run_q(F, mytile, &ctl[2], tri::E12 + F.vcu, F.G, NKQ); }
    }
}

struct P6Par { float lw[8], lb[8]; };
__device__ __forceinline__ void p6_rows2(Frame& F, int ma, int mb_, const P6Par& P) {
    const int l = F.lane, c = 8 * l, h = l >> 3;
    f32x4 oa[2][2]; v4u vv_[2], gg_[2]; float bsv[2];
#pragma unroll
    for (int u = 0; u < 2; ++u) { const int m = u ? mb_ : ma;
        const float* oraw = (const float*)(F.ws + WS_XN) + (size_t)m * 512 + c;
        oa[u][0] = *(const f32x4*)oraw; oa[u][1] = *(const f32x4*)(oraw + 4); bsv[u] = ((const float*)(F.ws + WS_BONUS))[(size_t)m * 8 + h];
        vv_[u] = *(const v4u*)((const bf16*)F.out + (size_t)m * 512 + c); gg_[u] = *(const v4u*)((const bf16*)(F.ws + WS_G) + (size_t)m * 512 + c);
    }
    __builtin_amdgcn_sched_barrier(0);
#pragma unroll
    for (int u = 0; u < 2; ++u) { const int m = u ? mb_ : ma;
        float o[8] = {oa[u][0].x, oa[u][0].y, oa[u][0].z, oa[u][0].w, oa[u][1].x, oa[u][1].y, oa[u][1].z, oa[u][1].w};
        float s = 0.f;
#pragma unroll
        for (int j = 0; j < 8; ++j) s += o[j];
        s += __shfl_xor(s, 1); s += __shfl_xor(s, 2); s += __shfl_xor(s, 4);
        const float mu = s * (1.f / 64.f); float q = 0.f;
#pragma unroll
        for (int j = 0; j < 8; ++j) { o[j] -= mu; q += o[j] * o[j]; }
        q += __shfl_xor(q, 1); q += __shfl_xor(q, 2); q += __shfl_xor(q, 4);
        const float rstd = 1.0f / sqrtf(q * (1.f / 64.f) + GN_EPS);
        float vv[8], gg[8];
        unpk8(vv_[u], vv); unpk8(gg_[u], gg);
        const float bs = bsv[u];
        float y[8];
#pragma unroll
        for (int j = 0; j < 8; ++j) y[j] = (o[j] * rstd * P.lw[j] + P.lb[j] + bs * vv[j]) * gg[j];
        v4u w; w.x = pk2(y[0], y[1]); w.y = pk2(y[2], y[3]); w.z = pk2(y[4], y[5]); w.w = pk2(y[6], y[7]);
        *(v4u*)((bf16*)(F.ws + WS_YRW) + (size_t)m * 512 + c) = w;
    }
}
__device__ __forceinline__ void p6_phase(Frame& F) {
    const int l = F.lane, c = 8 * l;
    P6Par P;
#pragma unroll
    for (int j = 0; j < 8; ++j) { P.lw[j] = F.ap->in[13][c + j]; P.lb[j] = F.ap->in[14][c + j]; }
    for (int m = F.gw; m < M; m += 2 * F.NGW) p6_rows2(F, m, m + F.NGW, P);
}

struct RouteW { f32x4 wv[3][8]; };
__device__ __forceinline__ void route_ldx(Frame& F, int tile, v4u (&xv)[4]) {
    const int fr = F.lane & 15, fq = F.lane >> 4; const bf16* xp = (const bf16*)(F.ws + WS_XN) + (size_t)(tile * 16 + fr) * D + F.wave * 128 + 8 * fq;
#pragma unroll
    for (int g = 0; g < 4; ++g) xv[g] = *(const v4u*)(xp + 32 * g);
}
__device__ __forceinline__ void route_tile(Frame& F, int tile, const RouteW& W, const v4u (&xv_)[4], int par) {
    const int fr = F.lane & 15, fq = F.lane >> 4, m0 = tile * 16;
    f32x4 acc[3] = {(f32x4){0.f, 0.f, 0.f, 0.f}, (f32x4){0.f, 0.f, 0.f, 0.f}, (f32x4){0.f, 0.f, 0.f, 0.f}};
    float ssq = 0.f;
#pragma unroll
    for (int g2 = 0; g2 < 4; ++g2) {
        float xf[8]; unpk8(xv_[g2], xf);
#pragma unroll
        for (int hh = 0; hh < 2; ++hh) { const int g = 2 * g2 + hh;
            ssq += (xf[4 * hh] * xf[4 * hh] + xf[4 * hh + 1] * xf[4 * hh + 1]) + (xf[4 * hh + 2] * xf[4 * hh + 2] + xf[4 * hh + 3] * xf[4 * hh + 3]);
#pragma unroll
            for (int s = 0; s < 4; ++s)
#pragma unroll
                for (int ct = 0; ct < 3; ++ct) acc[ct] = __builtin_amdgcn_mfma_f32_16x16x4f32(W.wv[ct][g][s], xf[4 * hh + s], acc[ct], 0, 0, 0); }
    }
    ssq += __shfl_xor(ssq, 16); ssq += __shfl_xor(ssq, 32);
    LAS float* red = (LAS float*)(F.lds + par * 32768);
    LAS float* ssqb = red + 8 * 3 * 64 * 4; LAS float* rsb = ssqb + 128;
#pragma unroll
    for (int ct = 0; ct < 3; ++ct) *(LAS f32x4*)(red + ((F.wave * 3 + ct) * 64 + F.lane) * 4) = acc[ct];
    if (fq == 0) ssqb[F.wave * 16 + fr] = ssq;
    LDS_WAIT(); __syncthreads();
    if (F.wave == 0) { float st = 0.f;
#pragma unroll
      for (int w = 0; w < 8; ++w) st += ssqb[w * 16 + (F.lane & 15)];
      const float rs = 1.0f / sqrtf(st * (1.f / D) + NORM_EPS);
      if (fq == 0) ((float*)(F.ws + WS_RSE))[m0 + fr] = rs;
#pragma unroll
      for (int ct = 0; ct < 3; ++ct) { f32x4 t = (f32x4){0.f, 0.f, 0.f, 0.f};
#pragma unroll
          for (int w = 0; w < 8; ++w) t = t + *(const LAS f32x4*)(red + ((w * 3 + ct) * 64 + F.lane) * 4);
          *(f32x4*)((float*)(F.ws + WS_LOGITS) + (size_t)(m0 + fr) * 48 + 16 * ct + 4 * fq) = t * rs; } }
}
__device__ __forceinline__ void p9_phase(Frame& F, int rep_ = 0) {
    const int fr = F.lane & 15, fq = F.lane >> 4;
    RouteW W;
    { const float* wp = (const float*)(F.ws + WS_SMALLW + SW_ROUTEW) + (size_t)fr * D + F.wave * 128 + 8 * fq;
#pragma unroll
      for (int ct = 0; ct < 3; ++ct)
#pragma unroll
          for (int g = 0; g < 8; ++g) W.wv[ct][g] = *(const f32x4*)(wp + (size_t)ct * 16 * D + 32 * (g >> 1) + 4 * (g & 1)); }
    v4u xa[4], xb[4];
    int tile = F.vcu, par = 0;
    if (tile < 1024) route_ldx(F, tile, xa);
    while (tile < 1024) {
        const int nt = tile + F.G;
        if (nt < 1024) route_ldx(F, nt, xb);
        __builtin_amdgcn_sched_barrier(0);
        route_tile(F, tile, W, xa, par);
#pragma unroll
        for (int g = 0; g < 4; ++g) xa[g] = xb[g];
        tile = nt; par ^= 1;
    }
}

__device__ __forceinline__ void p9b_phase(Frame& F) {
    if (F.wave != 0) return;
    for (int base = F.vcu * 64; base < M; base += F.G * 64) {
        const int tok = base + F.lane;
        const float* lgp = (const float*)(F.ws + WS_LOGITS) + (size_t)tok * 48;
        float lg[36];
#pragma unroll
        for (int q = 0; q < 9; ++q) { const f32x4 v = *(const f32x4*)(lgp + 4 * q); lg[4 * q] = v.x; lg[4 * q + 1] = v.y; lg[4 * q + 2] = v.z; lg[4 * q + 3] = v.w; }
        const float* bg = F.ap->in[27]; const float* br = F.ap->in[29];
        float gl[4]; int gs = 0; float gm = -3.0e38f;
#pragma unroll
        for (int c = 0; c < 4; ++c) { gl[c] = lg[c] + bg[c]; if (gl[c] > gm) { gm = gl[c]; gs = c; } }
        float gsum = 0.f;
#pragma unroll
        for (int c = 0; c < 4; ++c) gsum += __expf(gl[c] - gm);
        const float pgroup = 1.0f / gsum;
        float el[8]; float em = -3.0e38f;
#pragma unroll
        for (int c = 0; c < 8; ++c) { const float lv = gs == 0 ? lg[4 + c] : (gs == 1 ? lg[12 + c] : (gs == 2 ? lg[20 + c] : lg[28 + c])); el[c] = lv + br[gs * 8 + c]; em = fmaxf(em, el[c]); }
        int i1 = 0; float v1 = -3.0e38f;
#pragma unroll
        for (int c = 0; c < 8; ++c) if (el[c] > v1) { v1 = el[c]; i1 = c; }
        int i2 = 0; float v2 = -3.0e38f;
#pragma unroll
        for (int c = 0; c < 8; ++c) if (c != i1 && el[c] > v2) { v2 = el[c]; i2 = c; }
        const float p1 = __expf(v1 - em), p2 = __expf(v2 - em);
        const float g1 = pgroup * p1 / (p1 + p2), g2 = pgroup * p2 / (p1 + p2);
        const int e1 = gs * 8 + i1, e2 = gs * 8 + i2;
        const unsigned long long lt = (1ull << F.lane) - 1ull;
        int r1 = 0, r2 = 0, mycnt = 0;
        for (int e = 0; e < 32; ++e) {
            const unsigned long long m1 = __ballot(e1 == e), m2 = __ballot(e2 == e);
            const int c1 = __popcll(m1), c2 = __popcll(m2);
            if (e1 == e) r1 = __popcll(m1 & lt);
            if (e2 == e) r2 = c1 + __popcll(m2 & lt);
            if (F.lane == e) mycnt = c1 + c2;
        }
        unsigned* cnt = (unsigned*)(F.ws + WS_CTL) + CW_CNT; int* list = (int*)(F.ws + WS_LIST); float* gateA = (float*)(F.ws + WS_GATEA); unsigned* slotA = (unsigned*)(F.ws + WS_SLOTA);
        int bs = 0;
        if (F.lane < 32 && mycnt > 0) bs = (int)atomicAdd(&cnt[F.lane], (unsigned)mycnt);
        const unsigned q1 = (unsigned)(__shfl(bs, e1) + r1), q2 = (unsigned)(__shfl(bs, e2) + r2);
        gateA[tok * 2 + 0] = g1; gateA[tok * 2 + 1] = g2;
        list[(size_t)e1 * 16384 + q1] = tok * 2 + 0; slotA[tok * 2 + 0] = ((unsigned)e1 << 16) | q1;
        list[(size_t)e2 * 16384 + q2] = tok * 2 + 1; slotA[tok * 2 + 1] = ((unsigned)e2 << 16) | q2;
    }
}

__device__ __forceinline__ void p12_rows2(Frame& F, int ma, int mb_, int prelane) {
    const unsigned* slotA = (const unsigned*)(F.ws + WS_SLOTA); const float* gateA = (const float*)(F.ws + WS_GATEA);
    unsigned sl[2][2]; float gt[2][2];
#pragma unroll
    for (int u = 0; u < 2; ++u) { const int m = u ? mb_ : ma; sl[u][0] = slotA[2 * m]; sl[u][1] = slotA[2 * m + 1]; gt[u][0] = gateA[2 * m]; gt[u][1] = gateA[2 * m + 1]; }
    f32x4 xv[2][4]; v2u cv[2][2][4]; float se[2];
#pragma unroll
    for (int u = 0; u < 2; ++u) { const int m = u ? mb_ : ma;
        const bf16* x1 = (const bf16*)(F.ws + WS_XN) + (size_t)m * D;
        se[u] = (F.lane < 16) ? ((const float*)(F.ws + WS_ZGATE + 1 * MiB))[(size_t)m * 16 + F.lane] : 0.f;
#pragma unroll
        for (int j = 0; j < 4; ++j) { const int o = 4 * F.lane + 256 * j; xv[u][j] = unpk4(*(const v2u*)(x1 + o)); }
#pragma unroll
        for (int k = 0; k < 2; ++k) { const unsigned s = (unsigned)__builtin_amdgcn_readfirstlane((int)sl[u][k]); const int pre = __builtin_amdgcn_readlane(prelane, (int)(s >> 16));
            const bf16* cp = (const bf16*)(F.ws + WS_Z + 64 * MiB) + ((size_t)pre * 256 + (s & 0xffffu)) * D;
#pragma unroll
            for (int j = 0; j < 4; ++j) cv[u][k][j] = *(const v2u*)(cp + 4 * F.lane + 256 * j); } }
    __builtin_amdgcn_sched_barrier(0);
    float s2[2];
#pragma unroll
    for (int u = 0; u < 2; ++u) { s2[u] = 0.f;
#pragma unroll
        for (int j = 0; j < 4; ++j) { xv[u][j] = xv[u][j] + unpk4(cv[u][0][j]) * gt[u][0] + unpk4(cv[u][1][j]) * gt[u][1];
            s2[u] += (xv[u][j].x * xv[u][j].x + xv[u][j].y * xv[u][j].y) + (xv[u][j].z * xv[u][j].z + xv[u][j].w * xv[u][j].w);
        } }
#pragma unroll
    for (int o = 1; o < 64; o <<= 1) {
#pragma unroll
        for (int u = 0; u < 2; ++u) { s2[u] += __shfl_xor(s2[u], o); se[u] += __shfl_xor(se[u], o); } }
#pragma unroll
    for (int u = 0; u < 2; ++u) { const int m = u ? mb_ : ma;
        const float rs = 1.0f / sqrtf(s2[u] * (1.f / D) + NORM_EPS); const float rse = 1.0f / sqrtf(se[u] * (1.f / D) + NORM_EPS);
        bf16* x2 = (bf16*)(F.ws + WS_S) + (size_t)m * D; if (F.lane == 0) { ((float*)(F.ws + WS_RSE))[M + m] = rs; ((float*)(F.ws + WS_RSE))[2 * M + m] = rse; }
#pragma unroll
        for (int j = 0; j < 4; ++j) { const int o = 4 * F.lane + 256 * j; *(v2u*)(x2 + o) = pk4(xv[u][j]); }
    }
}
__device__ __forceinline__ void p12_phase(Frame& F) {
    const unsigned* cnt = (const unsigned*)(F.ws + WS_CTL) + CW_CNT;
    int nt = (F.lane < 32) ? (((int)cnt[F.lane & 31] + 255) >> 8) : 0;
    int incl = nt;
#pragma unroll
    for (int o = 1; o < 32; o <<= 1) { const int v = __shfl_up(incl, o); if (F.lane >= o) incl += v; }
    const int prelane = incl - nt;
    for (int m = F.gw; m < M; m += 2 * F.NGW) p12_rows2(F, m, m + F.NGW, prelane);
}
__device__ __forceinline__ void p14_rows4(Frame& F, int mb) {
    const float* gf = F.ap->in[36];
    f32x4 v[4][4]; float s[4];
#pragma unroll
    for (int u = 0; u < 4; ++u) { const bf16* xr = (const bf16*)(F.ws + WS_Z) + (size_t)(mb + u * F.NGW) * D;
#pragma unroll
        for (int j = 0; j < 4; ++j) v[u][j] = unpk4(*(const v2u*)(xr + 4 * F.lane + 256 * j)); }
#pragma unroll
    for (int u = 0; u < 4; ++u) { s[u] = 0.f;
#pragma unroll
        for (int j = 0; j < 4; ++j) s[u] += (v[u][j].x * v[u][j].x + v[u][j].y * v[u][j].y) + (v[u][j].z * v[u][j].z + v[u][j].w * v[u][j].w); }
#pragma unroll
    for (int o = 1; o < 64; o <<= 1) {
#pragma unroll
        for (int u = 0; u < 4; ++u) s[u] += __shfl_xor(s[u], o); }
#pragma unroll
    for (int u = 0; u < 4; ++u) { const float rs = 1.0f / sqrtf(s[u] * (1.f / D) + NORM_EPS); float* orow = F.out + (size_t)(mb + u * F.NGW) * D;
#pragma unroll
        for (int j = 0; j < 4; ++j) { const int o = 4 * F.lane + 256 * j; *(f32x4*)(orow + o) = v[u][j] * rs * *(const f32x4*)(gf + o); } }
}

#ifndef MK_ONE_LAUNCH
#define MK_ONE_LAUNCH 1
#endif
constexpr int N_PHASES = 14;
__global__ void __launch_bounds__(NWAVES * 64, 2) mk_fwd(Args args) {
    extern __shared__ __attribute__((aligned(16))) unsigned char lds[];
    Frame F;
    F.lds = (LAS unsigned char*)lds;
    F.tid = threadIdx.x; F.lane = F.tid & 63; F.wave = __builtin_amdgcn_readfirstlane(F.tid >> 6);
    F.G = gridDim.x; { const int bx = blockIdx.x; F.vcu = (F.G % 8 == 0) ? (bx % 8) * (F.G / 8) + bx / 8 : bx; }
    F.gw = F.vcu * NWAVES + F.wave; F.NGW = F.G * NWAVES;
    F.ws = args.ws; F.out = args.out;
    F.ap = (ArgsP)__builtin_amdgcn_kernarg_segment_ptr();
    unsigned char* ws = args.ws;
    const int lo = args.ph_lo, hi = args.ph_hi;
#ifdef ONLY
#define IN(k) ((k) == ONLY && lo <= (k) && (k) < hi)
#else
#define IN(k) (lo <= (k) && (k) < hi)
#endif
#if MK_ONE_LAUNCH
    if (F.tid < 16) ((LAS unsigned*)(F.lds + MISC_OFF))[F.tid] = 0u;
    __syncthreads();
    XcdBarrier bar = xcd_barrier_post((unsigned*)(ws + WS_CTL) + CW_BAR, (volatile LAS unsigned*)(F.lds + MISC_OFF));
#define GRID_BAR(k) do { if (IN(k) && IN((k) + 1)) { if ((k) == 12) cg::this_grid().sync(); else xcd_barrier(bar); } } while (0)
#else
#define GRID_BAR(k) do { } while (0)
#endif
    LAS unsigned char* L = F.lds;
#ifdef PROBE_A
    unsigned long long* tsb = (unsigned long long*)(ws + WS_CTL + 32768);
    int n_st = 0;
#define STAMP() do { if (blockIdx.x == 0 && F.tid == 0) tsb[n_st] = __builtin_amdgcn_s_memrealtime(); ++n_st; } while (0)
    STAMP();
#else
#define STAMP() do { } while (0)
#endif
    const bf16* z = (const bf16*)(ws + WS_Z);

    if (IN(0)) { p0_prologue(F); } GRID_BAR(0); STAMP();

    if (IN(1)) {
        pg8::Gemm g{(const bf16*)(ws + WS_XN), (const bf16*)(ws + WS_WIN), M, NZ, D, nullptr}; pg8::StaticOrder S; S.init(M, NZ, F.G, (int)blockIdx.x);
        EpiStoreBf16 E{(bf16*)(ws + WS_Z), NZ};
        pg8::gemm_phase<EpiStoreBf16, pg8::StaticOrder, true, false>(L, g, S, E);
    } GRID_BAR(1); STAMP();

    if (IN(2)) { p2_prep(F); } GRID_BAR(2); STAMP();
    if (IN(3)) { p3_phase(F); } GRID_BAR(3); STAMP();
    if (IN(4)) { p4_phase(F); } GRID_BAR(4); STAMP();
    if (IN(5)) { if (F.G == 256) p5_scan(F); } GRID_BAR(5); STAMP();
    if (IN(6)) { p6_phase(F); } GRID_BAR(6); STAMP();

    if (IN(7)) {
        pg8::Gemm g{(const bf16*)(ws + WS_YRW), (const bf16*)(ws + WS_UR), 2 * M, 2 * D, 512, nullptr}; DualOrder S; S.S.init(M, D, F.G, (int)blockIdx.x);
        EpiMix2 E{z, (bf16*)(ws + WS_S + 64 * MiB), (unsigned*)(ws + WS_CTL) + CW_DEP2};
        pg8::gemm_phase<EpiMix2, DualOrder, true, false>(L, g, S, E);
    } STAMP();

    if (IN(8)) {
        pg8::Gemm g{(const bf16*)(ws + WS_S + 64 * MiB), (const bf16*)(ws + WS_WO), M, D, D, nullptr}; StaticOrderDep S; S.S.init(M, D, F.G, (int)blockIdx.x); S.dep = (const unsigned*)(ws + WS_CTL) + CW_DEP2;
        EpiResBf16 E{F.ap->in[0], (bf16*)(ws + WS_XN)};
        pg8::gemm_phase<EpiResBf16, StaticOrderDep, true, false>(L, g, S, E);
    } GRID_BAR(8); STAMP();

    if (IN(9)) { p9_phase(F); xcd_barrier(bar); p9b_phase(F); } GRID_BAR(9); STAMP();

    if (IN(10)) {
        pg8::Gemm g{(const bf16*)(ws + WS_XN), (const bf16*)(ws + WS_WGU), M, 1024, D, (const int*)(ws + WS_LIST), (const float*)(ws + WS_RSE)};
        pg8::moe_fill_tab((LAS int*)(F.lds + MISC_OFF - 256), (const unsigned*)(ws + WS_CTL) + CW_CNT); LDS_WAIT(); __syncthreads();
        pg8::MoeOrder S{(const LAS int*)(F.lds + MISC_OFF - 256), F.G, F.vcu, false, 0, nullptr};
        EpiMoe1 E{(bf16*)(ws + WS_S), (const LAS float*)(F.lds + pg8::STAGE_BYTES + 4096), (unsigned*)(ws + WS_CTL) + CW_DEP};
        pg8::gemm_phase<EpiMoe1, pg8::MoeOrder, true, true>(L, g, S, E);
    } STAMP();

    if (IN(11)) {
#ifndef NO_MOE2
        { pg8::Gemm g{(const bf16*)(ws + WS_S), (const bf16*)(ws + WS_WD), M, 1024, 512, nullptr};
          pg8::moe_fill_tab((LAS int*)(F.lds + MISC_OFF - 256), (const unsigned*)(ws + WS_CTL) + CW_CNT); LDS_WAIT(); __syncthreads();
          const LAS int* tb = (const LAS int*)(F.lds + MISC_OFF - 256); const int n10 = 4 * (tb[31] + ((tb[63] + 255) >> 8));
          pg8::MoeOrderT<true> S{tb, F.G, F.vcu, true, n10 % F.G, (const unsigned*)(ws + WS_CTL) + CW_DEP};
          EpiStoreBf16 E{(bf16*)(ws + WS_Z + 64 * MiB), D};
          pg8::gemm_phase<EpiStoreBf16, pg8::MoeOrderT<true>, true, false>(L, g, S, E); }
#endif
        { pg8::Gemm g2{(const bf16*)(ws + WS_PBF), (const bf16*)(ws + WS_WPP), M, D, 256, nullptr}; ErawOrder S2; S2.S.init(M, D, F.G, 0); S2.c = (int)blockIdx.x; S2.G = F.G;
          S2.nheavy = 0;
          EpiStoreSsq E2{(bf16*)(ws + WS_S + 64 * MiB), D, (float*)(ws + WS_ZGATE + 1 * MiB)};
          pg8::gemm_phase<EpiStoreSsq, ErawOrder, true, false>(L, g2, S2, E2); }
    } GRID_BAR(11); STAMP();

    if (IN(12)) { p12_phase(F); } GRID_BAR(12); STAMP();

    if (IN(13)) {
        pg8::Gemm g{(const bf16*)(ws + WS_S), (const bf16*)(ws + WS_WPG), M, D, D, nullptr}; pg8::StaticOrder S; S.init(M, D, F.G, (int)blockIdx.x);
        EpiPleNorm E{(const bf16*)(ws + WS_S), (const bf16*)(ws + WS_S + 64 * MiB), (const float*)(ws + WS_RSE) + 2 * M, F.ap->in[33], (const float*)(ws + WS_RSE) + M, F.ap->in[36], F.out, (float*)(ws + WS_ZGATE), (unsigned*)(ws + WS_CTL) + CW_PANEL, (LAS float*)(F.lds + 131072)};
        pg8::gemm_phase<EpiPleNorm, pg8::StaticOrder, true, false>(L, g, S, E);
    } STAMP();

#ifdef PROBE_A
    xcd_barrier(bar); STAMP(); __threadfence();
    if (blockIdx.x == 0 && F.tid == 0) { __threadfence(); }
    xcd_barrier(bar);
    {
        volatile unsigned long long* tv = (volatile unsigned long long*)tsb;
        const float dA = (float)(tv[PROBE_A + 1] - tv[PROBE_A]) * 0.01f, dB = (float)(tv[PROBE_B + 1] - tv[PROBE_B]) * 0.01f;
        for (size_t i = (size_t)blockIdx.x * 512 + F.tid; i < (size_t)M * D; i += (size_t)F.G * 512) F.out[i] = 10.0f * dB;
        __syncthreads();
        if (blockIdx.x == 0 && F.tid == 0) F.out[0] = 300.0f * dA;
    }
#endif
#undef IN
#undef GRID_BAR
}

extern "C" void kernel_launch(void* const* d_in, const int* in_sizes, int n_in, void* d_out, int out_size, void* d_ws, size_t ws_size, hipStream_t stream) {
    static int grid = 0;
    if (grid == 0) {
        if (n_in != 37 || out_size != M * D || ws_size < WS_END) { fprintf(stderr, "kernel_launch: unexpected problem (n_in %d, out %d, ws %zu < %zu); nothing launched\n", n_in, out_size, ws_size, (size_t)WS_END); grid = -1; return; }
        int dev = 0, cus = 0, per_cu = 0;
        if (hipGetDevice(&dev) != hipSuccess || hipDeviceGetAttribute(&cus, hipDeviceAttributeMultiprocessorCount, dev) != hipSuccess) { grid = -1; return; }
        if (hipFuncSetAttribute((const void*)mk_fwd, hipFuncAttributeMaxDynamicSharedMemorySize, LDS_BYTES) != hipSuccess) { fprintf(stderr, "kernel_launch: hipFuncSetAttribute failed\n"); grid = -1; return; }
        if (hipOccupancyMaxActiveBlocksPerMultiprocessor(&per_cu, (const void*)mk_fwd, NWAVES * 64, LDS_BYTES) != hipSuccess || per_cu < 1) { fprintf(stderr, "kernel_launch: occupancy query says %d blocks per CU\n", per_cu); (void)hipGetLastError(); grid = -1; return; }
        grid = cus;
        if (grid != 256) fprintf(stderr, "kernel_launch: %d CUs; this kernel is built for 256\n", grid);
    }
    if (grid < 0) return;
    (void)hipMemsetAsync((char*)d_ws + WS_CTL, 0, CTL_ZERO_BYTES, stream);
    Args a{};
    for (int i = 0; i < 37; ++i) a.in[i] = (const float*)d_in[i];
    a.out = (float*)d_out; a.ws = (unsigned char*)d_ws;
#if MK_ONE_LAUNCH
    a.ph_lo = 0; a.ph_hi = N_PHASES;
    void* kargs[] = {&a};
    hipError_t e = hipLaunchCooperativeKernel((const void*)mk_fwd, dim3(grid), dim3(NWAVES * 64), kargs, LDS_BYTES, stream);
    if (e != hipSuccess) fprintf(stderr, "kernel_launch: cooperative launch failed: %s (grid %d)\n", hipGetErrorString(e), grid);
#else
    for (int ph = 0; ph < N_PHASES; ++ph) { a.ph_lo = ph; a.ph_hi = ph + 1; hipLaunchKernelGGL(mk_fwd, dim3(grid), dim3(NWAVES * 64), LDS_BYTES, stream, a); }
#endif
}
```

```cpp
#include <hip/hip_runtime.h>
#include <hip/hip_cooperative_groups.h>
#include <cstdio>
#include <cstdint>
namespace cg = cooperative_groups;

namespace pg8 {
#define PG8_LAS __attribute__((address_space(3)))
typedef unsigned short bf16_t;
typedef short bf16x8 __attribute__((ext_vector_type(8)));
typedef float f32x4 __attribute__((ext_vector_type(4)));
typedef unsigned u32x4 __attribute__((ext_vector_type(4)));
typedef unsigned u32x2 __attribute__((ext_vector_type(2)));
constexpr int BM = 256, BK = 64, HALF = 128, HTB = HALF * BK * 2  , STAGE_BYTES = 8 * HTB, NXCD = 8, WGM = 8;

__host__ __device__ __forceinline__ int lds_byte(int r, int c) { const int st = (r >> 4) * 2 + (c >> 5), rr = r & 15, cc = c & 31, ob = rr * 64 + cc * 2; return st * 1024 + (ob ^ (((ob >> 9) & 1) << 5)); }
__host__ __device__ __forceinline__ void stage_rc(int b, int& R, int& C) { const int st = b / 1024, sb = b % 1024, swz = sb ^ (((sb >> 9) & 1) << 5); R = (st >> 1) * 16 + swz / 64; C = (st & 1) * 32 + (swz % 64) / 2; }
__host__ __device__ __forceinline__ int perm32(int rho) { const int n = rho >> 4, i = rho & 15; return 8 * (i >> 2) + 4 * n + (i & 3); }

struct Unit { int pm, pn, pmo, lt, nvalid, pnl; };
struct Gemm { const bf16_t* A; const bf16_t* Bt; int M, N, K; const int* rowidx; const float* rowscale; };

struct StaticOrder {
    static constexpr bool DEP = false, KEEP_ACC = false;
    int nM, nN, nwg, G, c;
    __host__ __device__ void init(int M, int N, int G_, int c_) { nM = M / BM; nN = N / BM; nwg = nM * nN; G = G_; c = c_; }
    __host__ __device__ bool next(int i, Unit& u) const {
        const long L = (long)i * G + c; if (L >= nwg) return false;
        int wgid = (int)L; { const int q = nwg / NXCD, r = nwg % NXCD, xcd = wgid % NXCD, off = wgid / NXCD; wgid = (xcd < r ? xcd * (q + 1) : r * (q + 1) + (xcd - r) * q) + off; }
        const int nig = WGM * nN, gid = wgid / nig, fm = gid * WGM, gsz = (nM - fm) < WGM ? (nM - fm) : WGM;
        u.pm = fm + ((wgid % nig) % gsz); u.pn = (wgid % nig) / gsz; u.pmo = u.pm; u.lt = u.pm; u.nvalid = 256; u.pnl = u.pn; return true;
    }
};
template <bool DEP_>
struct MoeOrderT {
    static constexpr bool DEP = DEP_, KEEP_ACC = false;
    const PG8_LAS int* tab; int G, c; bool a_is_out;
    int nheavy; const unsigned* dep;
    __device__ void wait(const Unit& u) const {
        const unsigned* p = dep + 16 * u.pmo; unsigned sp = 0;
        while (__hip_atomic_load(p, __ATOMIC_RELAXED, __HIP_MEMORY_SCOPE_AGENT) < 4u) { __builtin_amdgcn_s_sleep(2); if (++sp > (1u << 22)) break; }
        asm volatile("s_waitcnt vmcnt(0)" ::: "memory");
    }
    __device__ bool next(int i, Unit& u) const {
        int L;
        if constexpr (DEP_) { const int nl = G - nheavy; L = (c >= nheavy) ? (i < 2 ? i * nl + (c - nheavy) : 2 * nl + (i - 2) * G + c) : 2 * nl + i * G + c; }
        else L = i * G + c;
        const int tile = L >> 2, pnl = L & 3;
        const int lane = (int)__builtin_amdgcn_mbcnt_hi(~0u, __builtin_amdgcn_mbcnt_lo(~0u, 0u)), e_ = lane & 31;
        const int pre = tab[e_], ce = tab[32 + e_]; const int nt = (ce + 255) >> 8;
        const unsigned long long mk = __ballot(lane < 32 && tile >= pre && tile < pre + nt);
        if (mk == 0ull) return false;
        const int e = (int)__builtin_ctzll(mk);
        const int pre_e = __builtin_amdgcn_readlane(pre, e), ce_e = __builtin_amdgcn_readlane(ce, e);
        const int rt = tile - pre_e; u.pmo = tile; u.pm = a_is_out ? tile : 0; u.lt = e * 64 + rt; u.pn = e * 4 + pnl; u.pnl = pnl; const int rem = ce_e - rt * 256; u.nvalid = rem < 256 ? rem : 256; return true;
    }
};
typedef MoeOrderT<false> MoeOrder;
__device__ __forceinline__ void moe_fill_tab(PG8_LAS int* tab, const unsigned* cnt) {
    const int lane = (int)__builtin_amdgcn_mbcnt_hi(~0u, __builtin_amdgcn_mbcnt_lo(~0u, 0u));
    const int ce = (lane < 32) ? (int)cnt[lane & 31] : 0; const int nt = (ce + 255) >> 8;
    int incl = nt;
#pragma unroll
    for (int o = 1; o < 32; o <<= 1) { const int v = __shfl_up(incl, o); if (lane >= o) incl += v; }
    if (lane < 32) { tab[lane] = incl - nt; tab[32 + lane] = ce; }
}

__device__ __forceinline__ unsigned cvt_pk_bf16(float lo, float hi) { unsigned r; asm volatile("v_cvt_pk_bf16_f32 %0, %1, %2" : "=v"(r) : "v"(lo), "v"(hi)); return r; }

template <class Epi, class Sched, bool ALIGN_EPI, bool GATHER>
__device__ __forceinline__ void gemm_phase(PG8_LAS unsigned char* lds, const Gemm g, const Sched& S, const Epi& E) {
    const int tid = threadIdx.x, wid = __builtin_amdgcn_readfirstlane(tid >> 6), lane = tid & 63, wr = wid >> 2, wc = wid & 3, fr = lane & 15, fq = lane >> 4;
    constexpr int AUX_A = Sched::DEP ? 16 : 0;
    int K_ = g.K; asm volatile("" : "+s"(K_));
    const int K = K_, nt = K / BK;
    unsigned voffB[2]; int RA[2], CA[2];
#pragma unroll
    for (int i = 0; i < 2; ++i) { int R, C; stage_rc(tid * 16 + i * 8192, R, C); const int Rb = Epi::PERM ? ((R & ~31) + perm32(R & 31)) : R;
        RA[i] = R; CA[i] = C; voffB[i] = (unsigned)(Rb * K + C) * 2u; }
    const size_t kstep = (size_t)(BK * 2);
    const size_t hstep = (size_t)HALF * K * 2;
    const size_t tstep = 2 * hstep;
    const unsigned ldsw = (unsigned)wid * 1024u;
    const int aoff = lds_byte(wr * 64 + fr, fq * 8), boff = lds_byte(wc * 32 + fr, fq * 8);
    unsigned vA[2][2], vN[2][2];
    PG8_LAS int* rowl = (PG8_LAS int*)(lds + STAGE_BYTES);
    if constexpr (GATHER) {
        for (int i = 0; i < 4; ++i) { Unit uu; if (!S.next(i, uu)) break; if (tid < 256) { const int tk = (tid < uu.nvalid) ? (g.rowidx[(size_t)uu.lt * 256 + tid] >> 1) : 0; rowl[i * 256 + tid] = tk; ((PG8_LAS float*)(rowl + 1024))[i * 256 + tid] = g.rowscale[tk]; } }
        asm volatile("s_waitcnt vmcnt(0) lgkmcnt(0)" ::: "memory"); __builtin_amdgcn_s_barrier(); asm volatile("" ::: "memory");
    }
    auto compute_v = [&](const Unit& u, unsigned (&v)[2][2], int ui_) {
#pragma unroll
        for (int h = 0; h < 2; ++h)
#pragma unroll
            for (int i = 0; i < 2; ++i) {
                const int rl = h * HALF + RA[i];
                if constexpr (GATHER) { const int tok = rowl[ui_ * 256 + rl]; v[h][i] = ((unsigned)tok * (unsigned)K + (unsigned)CA[i]) * 2u; }
                else v[h][i] = ((unsigned)rl * (unsigned)K + (unsigned)CA[i]) * 2u;
            }
    };
#define PG8_SA(b, h) (((b) * 2 + (h)) * HTB)
#define PG8_SB(b, h) ((4 + (b) * 2 + (h)) * HTB)
#define PG8_STAGE_X(bufoff, gbase, voff, aux) do { _Pragma("unroll") for (int _i = 0; _i < 2; ++_i) \
        __builtin_amdgcn_global_load_lds((const unsigned*)((const char*)(gbase) + (voff)[_i]), (PG8_LAS unsigned*)(lds + (bufoff) + ldsw + _i * 8192), 16, 0, aux); } while (0)
#define PG8_STAGE(bufoff, gbase, voff) PG8_STAGE_X(bufoff, gbase, voff, 0)
#define PG8_STAGE_A(bufoff, gbase, voff) PG8_STAGE_X(bufoff, gbase, voff, AUX_A)
#define PG8_LDA(dst, b, h) do { _Pragma("unroll") for (int m = 0; m < 4; ++m) _Pragma("unroll") for (int k = 0; k < 2; ++k) dst[m][k] = *(const PG8_LAS bf16x8*)(lds + PG8_SA(b, h) + aoff + m * 2048 + k * 1024); } while (0)
#define PG8_LDB(dst, b, h) do { _Pragma("unroll") for (int n = 0; n < 2; ++n) _Pragma("unroll") for (int k = 0; k < 2; ++k) dst[n][k] = *(const PG8_LAS bf16x8*)(lds + PG8_SB(b, h) + boff + n * 2048 + k * 1024); } while (0)
#define PG8_MMA(ai, bj, At, Bt) do { __builtin_amdgcn_s_setprio(1); _Pragma("unroll") for (int m = 0; m < 4; ++m) _Pragma("unroll") for (int n = 0; n < 2; ++n) _Pragma("unroll") for (int k = 0; k < 2; ++k) \
        acc[ai][bj][m][n] = __builtin_amdgcn_mfma_f32_16x16x32_bf16(Bt[n][k], At[m][k], acc[ai][bj][m][n], 0, 0, 0); __builtin_amdgcn_s_setprio(0); } while (0)
#define PG8_WAIT_V(n) asm volatile("s_waitcnt vmcnt(" #n ")" ::: "memory")
#define PG8_WAIT_L(n) asm volatile("s_waitcnt lgkmcnt(" #n ")" ::: "memory")
#define PG8_BAR __builtin_amdgcn_s_barrier()
#define PG8_SCHED __builtin_amdgcn_sched_barrier(0)
    Unit cur, nxt; int ui = 0;
    if (!S.next(0, cur)) return;
    f32x4 acc[2][2][4][2];
#pragma unroll
    for (int a = 0; a < 2; ++a)
#pragma unroll
        for (int b = 0; b < 2; ++b)
#pragma unroll
            for (int m = 0; m < 4; ++m)
#pragma unroll
                for (int n = 0; n < 2; ++n) acc[a][b][m][n] = (f32x4){0.f, 0.f, 0.f, 0.f};
    bf16x8 At[4][2], B0[2][2], B1[2][2];
    if constexpr (Sched::DEP) { if (tid == 0) S.wait(cur); PG8_BAR; }
    compute_v(cur, vA, 0);
    const char* cA = (const char*)g.A + (GATHER ? (size_t)0 : (size_t)cur.pm * tstep); const char* cB = (const char*)g.Bt + (size_t)cur.pn * tstep;
    PG8_STAGE(PG8_SB(0, 0), cB, voffB); PG8_STAGE(PG8_SB(0, 1), cB + hstep, voffB); PG8_STAGE_A(PG8_SA(0, 0), cA, vA[0]); PG8_STAGE_A(PG8_SA(0, 1), cA, vA[1]);
    if (wr == 1) PG8_BAR;
    PG8_WAIT_V(2); PG8_BAR;
    PG8_STAGE(PG8_SB(1, 0), cB + kstep, voffB); PG8_STAGE_A(PG8_SA(1, 0), cA + kstep, vA[0]); PG8_STAGE(PG8_SB(1, 1), cB + hstep + kstep, voffB);
    PG8_WAIT_V(6); PG8_BAR;
    for (;;) {
        const bool has_next = S.next(ui + 1, nxt);
        if (has_next) compute_v(nxt, vN, ui + 1);
        else {
#pragma unroll
            for (int h = 0; h < 2; ++h)
#pragma unroll
                for (int i = 0; i < 2; ++i) vN[h][i] = vA[h][i];
        }
        const char* nA = has_next ? ((const char*)g.A + (GATHER ? (size_t)0 : (size_t)nxt.pm * tstep)) : cA; const char* nB = has_next ? (const char*)g.Bt + (size_t)nxt.pn * tstep : cB;
#pragma unroll 1
        for (int t = 0; t < nt; t += 2) {
            const bool last = (t == nt - 2);
            if constexpr (Sched::DEP) { if (last && has_next) { if (tid == 0) S.wait(nxt); PG8_BAR; } }
            const char* a1 = cA + (size_t)(t + 1) * kstep;
            const char* a2 = last ? nA : cA + (size_t)(t + 2) * kstep; const char* b2 = last ? nB : cB + (size_t)(t + 2) * kstep;
            const char* a3 = a2 + kstep; const char* b3 = b2 + kstep;
            unsigned vX0[2], vX1[2];
#pragma unroll
            for (int i = 0; i < 2; ++i) { vX0[i] = last ? vN[0][i] : vA[0][i]; vX1[i] = last ? vN[1][i] : vA[1][i]; }
            PG8_LDB(B0, 0, 0); PG8_LDB(B1, 0, 1); PG8_SCHED; PG8_LDA(At, 0, 0); PG8_STAGE_A(PG8_SA(1, 1), a1, vA[1]);
            PG8_WAIT_V(8); PG8_WAIT_L(0); PG8_BAR; PG8_MMA(0, 0, At, B0); PG8_MMA(0, 1, At, B1); PG8_BAR; PG8_SCHED;
            PG8_LDA(At, 0, 1); PG8_STAGE(PG8_SB(0, 0), b2, voffB); PG8_STAGE(PG8_SB(0, 1), b2 + hstep, voffB); PG8_STAGE_A(PG8_SA(0, 0), a2, vX0);
            PG8_WAIT_V(8); PG8_WAIT_L(0); PG8_BAR; PG8_MMA(1, 0, At, B0); PG8_MMA(1, 1, At, B1); PG8_BAR; PG8_SCHED;
            PG8_LDB(B0, 1, 0); PG8_LDB(B1, 1, 1); PG8_SCHED; PG8_LDA(At, 1, 0); PG8_STAGE_A(PG8_SA(0, 1), a2, vX1);
            PG8_WAIT_V(8); PG8_WAIT_L(0); PG8_BAR; PG8_MMA(0, 0, At, B0); PG8_MMA(0, 1, At, B1); PG8_BAR; PG8_SCHED;
            PG8_LDA(At, 1, 1); PG8_STAGE(PG8_SB(1, 0), b3, voffB); PG8_STAGE(PG8_SB(1, 1), b3 + hstep, voffB); PG8_STAGE_A(PG8_SA(1, 0), a3, vX0);
            PG8_WAIT_V(8); PG8_WAIT_L(0); PG8_BAR; PG8_MMA(1, 0, At, B0); PG8_MMA(1, 1, At, B1); PG8_BAR; PG8_SCHED;
        }
        if constexpr (ALIGN_EPI) { if (wr == 0) PG8_BAR; }
        if constexpr (GATHER) cur.pm = ui;
        E(acc, cur, wr, wc, fr, fq);
        if (!has_next) break;
        if constexpr (!Sched::KEEP_ACC) {
#pragma unroll
        for (int a = 0; a < 2; ++a)
#pragma unroll
            for (int b = 0; b < 2; ++b)
#pragma unroll
                for (int m = 0; m < 4; ++m)
#pragma unroll
                    for (int n = 0; n < 2; ++n) acc[a][b][m][n] = (f32x4){0.f, 0.f, 0.f, 0.f};
        }
        cur = nxt; cA = nA; cB = nB; ++ui;
#pragma unroll
        for (int h = 0; h < 2; ++h)
#pragma unroll
            for (int i = 0; i < 2; ++i) vA[h][i] = vN[h][i];
        if constexpr (ALIGN_EPI) { if (wr == 1) PG8_BAR; }
    }
    PG8_WAIT_V(0);
    if constexpr (!ALIGN_EPI) { if (wr == 0) PG8_BAR; }
    PG8_BAR;
#undef PG8_SA
#undef PG8_SB
#undef PG8_STAGE
#undef PG8_STAGE_X
#undef PG8_STAGE_A
#undef PG8_LDA
#undef PG8_LDB
#undef PG8_MMA
#undef PG8_WAIT_V
#undef PG8_WAIT_L
#undef PG8_BAR
#undef PG8_SCHED
}
}

constexpr int NWAVES = 8;
constexpr int M = 16384, D = 1024, SEQ = 2048, NBATCH = 8;
constexpr int NIN = 5144;
constexpr int NZ = 5120;
constexpr int ZC_R = 0, ZC_K = 512, ZC_V = 1024, ZC_W = 1536, ZC_Q = 1792, ZC_KC = 2304, ZC_VC = 2432, ZC_KS = 2560, ZC_VS = 2688, ZC_KW = 2816, ZC_VW = 2944, ZC_MR = 3072, ZC_MN = 4096;
constexpr float NORM_EPS = 1e-6f, GN_EPS = 64e-5f;

constexpr size_t MiB = 1u << 20;
constexpr size_t WS_CTL = 0, CTL_ZERO_BYTES = 64 * 1024;
constexpr size_t WS_LIST = 1 * MiB;
constexpr size_t WS_GATEA = 3 * MiB;
constexpr size_t WS_RSE = 4 * MiB;
constexpr size_t WS_SLOTA = 4 * MiB + 512 * 1024;
constexpr size_t WS_SELMASK = 5 * MiB;
constexpr size_t WS_ZGATE = 6 * MiB;
constexpr size_t WS_SMALLW = 8 * MiB;
constexpr size_t SW_W2T = 0, SW_A2T = 65536, SW_G2T = 131072, SW_CK1 = 262144, SW_CV1 = 524288, SW_CK2 = 786432, SW_CV2 = 794624, SW_GATEW = 802816, SW_ROUTEW = 868352;
constexpr size_t WS_KCMP = 10 * MiB;
constexpr size_t WS_VST = 11 * MiB, WS_VWT = 15 * MiB;
constexpr size_t WS_WIN = 19 * MiB, WS_UR = 29 * MiB, WS_UN = 30 * MiB, WS_WO = 31 * MiB, WS_WPP = 33 * MiB, WS_WPG = 34 * MiB, WS_WGU = 36 * MiB, WS_WD = 100 * MiB;
constexpr size_t WS_XN = 132 * MiB;
constexpr size_t WS_PBF = 164 * MiB;
constexpr size_t WS_Z = 172 * MiB;
constexpr size_t WS_S = 332 * MiB;
constexpr size_t WS_YRW = 428 * MiB, WS_YB = 444 * MiB, WS_G = 492 * MiB, WS_LOGITS = 508 * MiB  , WS_BONUS = 508 * MiB  , WS_END = 511 * MiB;
constexpr int CH_PP = 144, CH_P = 0, CH_R = 2304, CH_Q = 4608, CH_K = 6656, CH_G = 8704, CH_AC = 10752, CH_REC = 11008, CH_V = 11008, CH_SLOT = 11520;
constexpr int CW_CNT = 0;
constexpr int CW_PANEL = 8192;
constexpr int CW_DEP = 12288;
constexpr int CW_DEP2 = 4608;
constexpr int CW_BAR = 1024;
constexpr int MISC_OFF = 163840 - 64;

constexpr int LDS_BYTES = 163840;

#define GAS __attribute__((address_space(1)))
#define LAS __attribute__((address_space(3)))
typedef unsigned short bf16;
typedef unsigned v4u __attribute__((ext_vector_type(4)));
typedef unsigned v2u __attribute__((ext_vector_type(2)));
typedef float f32x4 __attribute__((ext_vector_type(4)));
typedef float f32x2 __attribute__((ext_vector_type(2)));
typedef short bf16x8 __attribute__((ext_vector_type(8)));
typedef short bf16x4 __attribute__((ext_vector_type(4)));
typedef __bf16 bf16x2_t __attribute__((ext_vector_type(2)));
#define LDS_WAIT() asm volatile("s_waitcnt lgkmcnt(0)" ::: "memory")
#define MFMA16(a, b, c) __builtin_amdgcn_mfma_f32_16x16x32_bf16((a), (b), (c), 0, 0, 0)

__device__ __forceinline__ float bf2f(unsigned short v) { return __uint_as_float((unsigned)v << 16); }
__device__ __forceinline__ unsigned pk2(float lo, float hi) { f32x2 v = {lo, hi}; bf16x2_t b = __builtin_convertvector(v, bf16x2_t); return __builtin_bit_cast(unsigned, b); }
__device__ __forceinline__ v2u pk4(f32x4 v) { v2u r; r.x = pk2(v.x, v.y); r.y = pk2(v.z, v.w); return r; }
__device__ __forceinline__ f32x4 unpk4(v2u w) { f32x4 r; r.x = __uint_as_float(w.x << 16); r.y = __uint_as_float(w.x & 0xffff0000u); r.z = __uint_as_float(w.y << 16); r.w = __uint_as_float(w.y & 0xffff0000u); return r; }
__device__ __forceinline__ void unpk8(v4u w, float (&f)[8]) { f[0] = __uint_as_float(w.x << 16); f[1] = __uint_as_float(w.x & 0xffff0000u); f[2] = __uint_as_float(w.y << 16); f[3] = __uint_as_float(w.y & 0xffff0000u);
    f[4] = __uint_as_float(w.z << 16); f[5] = __uint_as_float(w.z & 0xffff0000u); f[6] = __uint_as_float(w.w << 16); f[7] = __uint_as_float(w.w & 0xffff0000u); }
__device__ __forceinline__ float sigmoidf_(float x) { return __builtin_amdgcn_rcpf(1.0f + __expf(-x)); }
__device__ __forceinline__ float wave_sum(float v) {
#pragma unroll
    for (int o = 1; o < 64; o <<= 1) v += __shfl_xor(v, o);
    return v;
}
template <int CTRL> __device__ __forceinline__ float dppf(float x) { return __builtin_bit_cast(float, __builtin_amdgcn_update_dpp(0, __builtin_bit_cast(int, x), CTRL, 0xf, 0xf, false)); }
__device__ __forceinline__ float row16_sum(float x) { x += dppf<0x128>(x); x += dppf<0x124>(x); x += dppf<0x122>(x); x += dppf<0x121>(x); return x; }

typedef GAS unsigned gu32;
#define XB_TMO      128
#define XB_XCNT(j)  (256  + 64 * (j))
#define XB_XSUB(j)  (1280 + 64 * (j))
#define XB_XGEN(j)  (2304 + 64 * (j))
#define XB_TOP      3328
#define XB_TOPGEN   3392
#define XCD_BAR_WORDS 3456
#define XB_SPIN_CAP (1u << 18)

__device__ __forceinline__ unsigned xb_ld(unsigned* p)              { return __hip_atomic_load(p, __ATOMIC_RELAXED, __HIP_MEMORY_SCOPE_AGENT); }
__device__ __forceinline__ unsigned xb_add(unsigned* p, unsigned v) { return __hip_atomic_fetch_add(p, v, __ATOMIC_RELAXED, __HIP_MEMORY_SCOPE_AGENT); }
__device__ __forceinline__ unsigned xb_xcc_id() { return (unsigned)__builtin_amdgcn_s_getreg((3 << 11) | 20) & 0xFu; }
#define XB_SPIN(cond, bar) do { unsigned _sp = 0; while (cond) { __builtin_amdgcn_s_sleep(1); \
    if ((++_sp & 255u) == 0u) { if (xb_ld(&(bar)[XB_TMO])) break; if (_sp > XB_SPIN_CAP) { atomicAdd(&(bar)[XB_TMO], 1u); break; } } } } while (0)

struct XcdBarrier {
    unsigned* bar; unsigned x;
    volatile LAS unsigned* st;
};

__device__ __forceinline__ XcdBarrier xcd_barrier_post(unsigned* bar, volatile LAS unsigned* st) {
    XcdBarrier b; b.bar = bar; b.x = xb_xcc_id(); b.st = st;
    if (threadIdx.x == 0) (void)xb_add(&bar[XB_XCNT(b.x)], 1u);
    return b;
}
__device__ __forceinline__ void xcd_barrier_complete(unsigned* bar, unsigned x, unsigned& nloc, unsigned& nx) {
    const unsigned G = gridDim.x * gridDim.y * gridDim.z;
    unsigned sum, cnt, mine, sp = 0u;
    for (;;) {
        sum = 0u; cnt = 0u; mine = 0u;
#pragma unroll
        for (unsigned j = 0; j < 16; ++j) { const unsigned c = xb_ld(&bar[XB_XCNT(j)]); sum += c; cnt += (c > 0u) ? 1u : 0u; mine = (j == x) ? c : mine; }
        if (sum == G) break;
        __builtin_amdgcn_s_sleep(1);
        if ((++sp & 255u) == 0u) { if (xb_ld(&bar[XB_TMO])) break; if (sp > XB_SPIN_CAP) { atomicAdd(&bar[XB_TMO], 1u); break; } }
    }
    nloc = mine > 0u ? mine : 1u; nx = cnt > 0u ? cnt : 1u;
}

__device__ __forceinline__ void xcd_barrier(const XcdBarrier& b) {
    asm volatile("s_waitcnt vmcnt(0)" ::: "memory");
    __syncthreads();
    if (threadIdx.x == 0) {
        unsigned* bar = b.bar;
        __builtin_amdgcn_s_waitcnt(0);
        unsigned nloc = b.st[0], nx = b.st[1];
        if (nloc == 0u) { xcd_barrier_complete(bar, b.x, nloc, nx); b.st[0] = nloc; b.st[1] = nx; }
        const unsigned old = xb_add(&bar[XB_XSUB(b.x)], 1u);
        const unsigned gen = old / nloc;
        if (old + 1u == (gen + 1u) * nloc) {
            __builtin_amdgcn_fence(__ATOMIC_RELEASE, "agent");
            asm volatile("s_waitcnt vmcnt(0)" ::: "memory");
            const unsigned og = xb_add(&bar[XB_TOP], 1u);
            const unsigned tg = og / nx;
            if (og + 1u == (tg + 1u) * nx) xb_add(&bar[XB_TOPGEN], 1u);
            else XB_SPIN(xb_ld(&bar[XB_TOPGEN]) == tg, bar);
            __builtin_amdgcn_fence(__ATOMIC_ACQUIRE, "agent");
            xb_add(&bar[XB_XGEN(b.x)], 1u);
            asm volatile("s_waitcnt vmcnt(0)" ::: "memory");
        } else {
            XB_SPIN(xb_ld(&bar[XB_XGEN(b.x)]) == gen, bar);
            __builtin_amdgcn_fence(__ATOMIC_ACQUIRE, "agent");
            asm volatile("s_waitcnt vmcnt(0)" ::: "memory");
        }
    }
    __syncthreads();
}

struct Args { const float* in[37]; float* out; unsigned char* ws; int ph_lo, ph_hi, rep_mask, pad; };
typedef __attribute__((address_space(4))) const Args* ArgsP;
struct Frame {
    LAS unsigned char* lds;
    int tid, lane, wave, vcu, G, gw, NGW;
    unsigned char* ws;
    ArgsP ap;
    float* out;
};

struct TrDesc { const float* W; bf16* T; bf16* T2; const float* gain; int K, ld, nc, item, mode; };
__device__ __forceinline__ void tr_load(const TrDesc& d, int lane, float (&tv)[32], f32x4 (&gn)[2]) {
    const int nblk = (d.nc + 31) / 32, kb = d.item / nblk, nb = d.item % nblk, k0 = 64 * kb, n0 = 32 * nb;
    const int nn = n0 + (lane & 31);
    gn[0] = (f32x4){1.f, 1.f, 1.f, 1.f}; gn[1] = gn[0];
    if (d.gain) { const float* gp = d.gain + k0 + 8 * (lane & 7); gn[0] = *(const f32x4*)gp; gn[1] = *(const f32x4*)(gp + 4); }
    const float* wsrc = d.W + (size_t)(k0 + (lane >> 5)) * d.ld + (nn < d.nc ? nn : 0);
#pragma unroll
    for (int i = 0; i < 32; ++i) tv[i] = wsrc[(size_t)(2 * i) * d.ld];
}
__device__ __forceinline__ void tr_finish(const TrDesc& d, LAS float* scr, int lane, const float (&tv)[32], const f32x4 (&gn)[2]) {
    const int nblk = (d.nc + 31) / 32, kb = d.item / nblk, nb = d.item % nblk, k0 = 64 * kb, n0 = 32 * nb;
#pragma unroll
    for (int i = 0; i < 32; ++i) scr[(2 * i + (lane >> 5)) * 33 + (lane & 31)] = tv[i];
    LDS_WAIT(); asm volatile("" ::: "memory");
    const int c = lane & 7;
#pragma unroll
    for (int j = 0; j < 4; ++j) { const int nl = (lane >> 3) + 8 * j, n = n0 + nl; const LAS float* s = scr + (8 * c) * 33 + nl;
        v4u o; o.x = pk2(s[0 * 33] * gn[0].x, s[1 * 33] * gn[0].y); o.y = pk2(s[2 * 33] * gn[0].z, s[3 * 33] * gn[0].w); o.z = pk2(s[4 * 33] * gn[1].x, s[5 * 33] * gn[1].y); o.w = pk2(s[6 * 33] * gn[1].z, s[7 * 33] * gn[1].w);
        if (n < d.nc) { bf16* rp;
            if (d.mode == 1) rp = n < 3072 ? d.T + (size_t)n * 1024 : (n < 3096 ? d.T2 + (size_t)(n - 3072) * 1024 : d.T + (size_t)(n - 24) * 1024);
            else if (d.mode == 2) { const int n2 = n & 511; rp = d.T + (size_t)((n2 >> 7) * 256 + (n >> 9) * 128 + (n2 & 127)) * 1024; }
            else rp = d.T + (size_t)n * d.K;
            *(v4u*)(rp + k0 + 8 * c) = o; } }
    LDS_WAIT(); asm volatile("" ::: "memory");
}
__device__ __forceinline__ void rms_row_to_bf16(int lane, const float* xrow, const float* gain, bf16* orow) {
    const f32x4* xr = (const f32x4*)xrow + lane; const f32x4* gr = (const f32x4*)gain + lane;
    f32x4 v[4]; float s = 0.f;
#pragma unroll
    for (int j = 0; j < 4; ++j) { v[j] = xr[64 * j]; s += (v[j].x * v[j].x + v[j].y * v[j].y) + (v[j].z * v[j].z + v[j].w * v[j].w); }
    const float rs = 1.0f / sqrtf(wave_sum(s) * (1.f / D) + NORM_EPS);
    v2u* o8 = (v2u*)orow + lane;
#pragma unroll
    for (int j = 0; j < 4; ++j) { const f32x4 g = gr[64 * j]; o8[64 * j] = pk4(v[j] * rs * g); }
}

namespace tri {
constexpr int I_WIN = 16 * 161, I_UR = 8 * 32, I_WO = 16 * 32, I_WPP = 4 * 32, I_L64 = 16, I_L128 = 32, I_C1 = 32 * 2, I_C2 = 2, I_GU = 16 * 32, I_DN = 8 * 32;
constexpr int E0 = I_WIN, E1 = E0 + I_UR, E2 = E1 + I_UR, E3 = E2 + I_WO, E4 = E3 + I_WPP, E5 = E4 + I_WO, E6 = E5 + I_L64, E7 = E6 + I_L64, E8 = E7 + I_L128, E9 = E8 + I_C1, E10 = E9 + I_C1, E11 = E10 + I_C2, E12 = E11 + I_C2,
              E13 = E12 + 32 * I_GU, NITEMS = E13 + 32 * I_DN;
}
__device__ __forceinline__ TrDesc tr_desc(Frame& F, int it) {
    using namespace tri;
    unsigned char* ws = F.ws;
    const float* W; const float* gain = nullptr; int K, ld, nc, item, mode = 0; size_t dst;
    if (it < E0) { W = F.ap->in[3]; K = 1024; ld = NIN; nc = NIN; item = it; mode = 1; dst = WS_WIN; }
    else if (it < E1) { W = F.ap->in[22]; K = 512; ld = 1024; nc = 1024; item = it - E0; dst = WS_UR; }
    else if (it < E2) { W = F.ap->in[23]; K = 512; ld = 1024; nc = 1024; item = it - E1; dst = WS_UN; }
    else if (it < E3) { W = F.ap->in[24]; K = 1024; ld = 1024; nc = 1024; item = it - E2; dst = WS_WO; }
    else if (it < E4) { W = F.ap->in[32]; K = 256; ld = 1024; nc = 1024; item = it - E3; dst = WS_WPP; }
    else if (it < E5) { W = F.ap->in[35]; K = 1024; ld = 1024; nc = 1024; item = it - E4; dst = WS_WPG; gain = F.ap->in[34]; }
    else if (it < E6) { W = F.ap->in[6]; K = 64; ld = 512; nc = 512; item = it - E5; dst = WS_SMALLW + SW_W2T; }
    else if (it < E7) { W = F.ap->in[8]; K = 64; ld = 512; nc = 512; item = it - E6; dst = WS_SMALLW + SW_A2T; }
    else if (it < E8) { W = F.ap->in[9]; K = 128; ld = 512; nc = 512; item = it - E7; dst = WS_SMALLW + SW_G2T; }
    else if (it < E9) { W = F.ap->in[17]; K = 2048; ld = 64; nc = 64; item = it - E8; dst = WS_SMALLW + SW_CK1; }
    else if (it < E10) { W = F.ap->in[19]; K = 2048; ld = 64; nc = 64; item = it - E9; dst = WS_SMALLW + SW_CV1; }
    else if (it < E11) { W = F.ap->in[18]; K = 64; ld = 64; nc = 64; item = it - E10; dst = WS_SMALLW + SW_CK2; }
    else if (it < E12) { W = F.ap->in[20]; K = 64; ld = 64; nc = 64; item = it - E11; dst = WS_SMALLW + SW_CV2; }
    else if (it < E13) { const int r = it - E12, e = r / I_GU; W = F.ap->in[30] + (size_t)e * 1024 * 1024; K = 1024; ld = 1024; nc = 1024; item = r % I_GU; mode = 2; dst = WS_WGU + (size_t)e * 1024 * 1024 * 2; gain = F.ap->in[25]; }
    else { const int r = it - E13, e = r / I_DN; W = F.ap->in[31] + (size_t)e * 512 * 1024; K = 512; ld = 1024; nc = 1024; item = r % I_DN; dst = WS_WD + (size_t)e * 1024 * 512 * 2; }
    return TrDesc{W, (bf16*)(ws + dst), (bf16*)(ws + WS_SMALLW + SW_GATEW), gain, K, ld, nc, item, mode};
}
__device__ __forceinline__ void tr_run(Frame& F, LAS float* scr, int it0, int stride, int it_end) {
    if (it0 >= it_end) return;
    float tvA[32], tvB[32]; f32x4 gnA[2], gnB[2];
    int it = it0; TrDesc cur = tr_desc(F, it); tr_load(cur, F.lane, tvA, gnA);
    for (;;) {
        const int nxt = it + stride; const bool has = nxt < it_end; TrDesc dn = cur;
        if (has) { dn = tr_desc(F, nxt); tr_load(dn, F.lane, tvB, gnB); }
        __builtin_amdgcn_sched_barrier(0);
        tr_finish(cur, scr, F.lane, tvA, gnA);
        if (!has) break;
        cur = dn; it = nxt;
#pragma unroll
        for (int i = 0; i < 32; ++i) tvA[i] = tvB[i];
        gnA[0] = gnB[0]; gnA[1] = gnB[1];
    }
}
__device__ __forceinline__ int tr_qnext(LAS int* qh) {
    int k = 0; const unsigned a = (unsigned)(size_t)qh; const int one = 1;
    if (__builtin_amdgcn_mbcnt_hi(~0u, __builtin_amdgcn_mbcnt_lo(~0u, 0u)) == 0) asm volatile("ds_add_rtn_u32 %0, %1, %2\n\ts_waitcnt lgkmcnt(0)" : "=&v"(k) : "v"(a), "v"(one) : "memory");
    return __builtin_amdgcn_readfirstlane(k);
}
__device__ __forceinline__ void tr_run_q(Frame& F, LAS float* scr, LAS int* qh, int base, int stride, int nk) {
    int k = tr_qnext(qh); if (k >= nk) return;
    float tvA[32], tvB[32]; f32x4 gnA[2], gnB[2];
    TrDesc cur = tr_desc(F, base + k * stride); tr_load(cur, F.lane, tvA, gnA);
    for (;;) {
        const int kn = tr_qnext(qh); const bool has = kn < nk; TrDesc dn = cur;
        if (has) { dn = tr_desc(F, base + kn * stride); tr_load(dn, F.lane, tvB, gnB); }
        __builtin_amdgcn_sched_barrier(0);
        tr_finish(cur, scr, F.lane, tvA, gnA);
        if (!has) break;
        cur = dn;
#pragma unroll
        for (int i = 0; i < 32; ++i) tvA[i] = tvB[i];
        gnA[0] = gnB[0]; gnA[1] = gnB[1];
    }
}
#ifndef MK_EXPERTS_IN_SCAN
#define MK_EXPERTS_IN_SCAN 1
#endif
__device__ __forceinline__ void p0_prologue(Frame& F) {
    LAS float* scr = (LAS float*)(F.lds + F.wave * 16384);
    unsigned char* ws = F.ws;
    bf16* gateWT = (bf16*)(ws + WS_SMALLW + SW_GATEW);
    tr_run(F, scr, F.gw, F.NGW, MK_EXPERTS_IN_SCAN ? tri::E12 : tri::NITEMS);
    for (int mb = F.gw; mb < M; mb += 4 * F.NGW) {
        f32x4 v[4][4]; float s[4];
#pragma unroll
        for (int u = 0; u < 4; ++u) { const f32x4* xr = (const f32x4*)(F.ap->in[0] + (size_t)(mb + u * F.NGW) * D) + F.lane;
#pragma unroll
            for (int j = 0; j < 4; ++j) v[u][j] = xr[64 * j]; }
#pragma unroll
        for (int u = 0; u < 4; ++u) { s[u] = 0.f;
#pragma unroll
            for (int j = 0; j < 4; ++j) s[u] += (v[u][j].x * v[u][j].x + v[u][j].y * v[u][j].y) + (v[u][j].z * v[u][j].z + v[u][j].w * v[u][j].w); }
#pragma unroll
        for (int o = 1; o < 64; o <<= 1) {
#pragma unroll
            for (int u = 0; u < 4; ++u) s[u] += __shfl_xor(s[u], o); }
        const f32x4* gr = (const f32x4*)F.ap->in[2] + F.lane;
#pragma unroll
        for (int u = 0; u < 4; ++u) { const float rs = 1.0f / sqrtf(s[u] * (1.f / D) + NORM_EPS); v2u* o8 = (v2u*)((bf16*)(ws + WS_XN) + (size_t)(mb + u * F.NGW) * D) + F.lane;
#pragma unroll
            for (int j = 0; j < 4; ++j) o8[64 * j] = pk4(v[u][j] * rs * gr[64 * j]); }
    }
    {
        float* RW = (float*)(ws + WS_SMALLW + SW_ROUTEW); const float* gf = F.ap->in[25]; const float* wg = F.ap->in[26]; const float* wr = F.ap->in[28];
        for (int idx = F.gw * 64 + F.lane; idx < 48 * 1024; idx += F.NGW * 64) { const int c = idx >> 10, k = idx & 1023; float v = 0.f;
            if (c < 4) v = wg[k * 4 + c]; else if (c < 36) v = wr[k * 32 + (c - 4)];
            RW[idx] = v * gf[k]; }
        for (int idx = F.gw * 64 + F.lane; idx < 8 * 1024; idx += F.NGW * 64) gateWT[24 * 1024 + idx] = 0;
    }
}

struct EpiStoreBf16 {
    static constexpr bool PERM = true;
    bf16* O; int ldc;
    __device__ __forceinline__ void operator()(const f32x4 (&acc)[2][2][4][2], const pg8::Unit& u, int wr, int wc, int fr, int fq) const {
        const int row0 = u.pmo * 256 + wr * 64 + fr, col0 = u.pnl * 256 + wc * 32 + 8 * fq;
#pragma unroll
        for (int ai = 0; ai < 2; ++ai)
#pragma unroll
            for (int m = 0; m < 4; ++m) { bf16* rowp = O + (size_t)(row0 + ai * 128 + m * 16) * ldc + col0;
#pragma unroll
                for (int bj = 0; bj < 2; ++bj) { const f32x4 v0 = acc[ai][bj][m][0], v1 = acc[ai][bj][m][1]; v4u w; w.x = pk2(v0[0], v0[1]); w.y = pk2(v0[2], v0[3]); w.z = pk2(v1[0], v1[1]); w.w = pk2(v1[2], v1[3]);
                    *(v4u*)(rowp + bj * 128) = w; } }
    }
};
struct EpiStoreSsq {
    static constexpr bool PERM = true;
    bf16* O; int ldc; float* part;
    __device__ __forceinline__ void operator()(const f32x4 (&acc)[2][2][4][2], const pg8::Unit& u, int wr, int wc, int fr, int fq) const {
        const int row0 = u.pmo * 256 + wr * 64 + fr, col0 = u.pnl * 256 + wc * 32 + 8 * fq;
#pragma unroll
        for (int ai = 0; ai < 2; ++ai)
#pragma unroll
            for (int m = 0; m < 4; ++m) { bf16* rowp = O + (size_t)(row0 + ai * 128 + m * 16) * ldc + col0; float ss = 0.f;
#pragma unroll
                for (int bj = 0; bj < 2; ++bj) { const f32x4 v0 = acc[ai][bj][m][0], v1 = acc[ai][bj][m][1]; v4u w; w.x = pk2(v0[0], v0[1]); w.y = pk2(v0[2], v0[3]); w.z = pk2(v1[0], v1[1]); w.w = pk2(v1[2], v1[3]);
                    *(v4u*)(rowp + bj * 128) = w;
                    ss += ((v0[0] * v0[0] + v0[1] * v0[1]) + (v0[2] * v0[2] + v0[3] * v0[3])) + ((v1[0] * v1[0] + v1[1] * v1[1]) + (v1[2] * v1[2] + v1[3] * v1[3])); }
                ss += __shfl_xor(ss, 16); ss += __shfl_xor(ss, 32);
                if (fq == 0) part[(size_t)(row0 + ai * 128 + m * 16) * 16 + u.pnl * 4 + wc] = ss; }
    }
};
#define EPI_LOOP_BEGIN \
    _Pragma("unroll") for (int ai = 0; ai < 2; ++ai) _Pragma("unroll") for (int m = 0; m < 4; ++m) { if (m == 0 || m == 2) asm volatile("" ::: "memory"); const int rl = ai * 128 + wr * 64 + m * 16 + fr; const size_t row = (size_t)u.pmo * 256 + rl; (void)row; \
    _Pragma("unroll") for (int bj = 0; bj < 2; ++bj) _Pragma("unroll") for (int n = 0; n < 2; ++n) { const int col = u.pnl * 256 + bj * 128 + wc * 32 + n * 16 + 4 * fq; (void)col; const f32x4 a = acc[ai][bj][m][n];
#define EPI_LOOP_END } }
struct EpiMix {
    static constexpr bool PERM = false;
    const bf16* z; bf16* A; bf16* O;
    __device__ __forceinline__ void operator()(const f32x4 (&acc)[2][2][4][2], const pg8::Unit& u, int wr, int wc, int fr, int fq) const {
        const int zc = u.lt ? ZC_MN : ZC_MR;
        EPI_LOOP_BEGIN
            const f32x4 zz = unpk4(*(const v2u*)(z + row * NZ + zc + col)); f32x4 o;
            o.x = sigmoidf_(zz.x) * a.x; o.y = sigmoidf_(zz.y) * a.y; o.z = sigmoidf_(zz.z) * a.z; o.w = sigmoidf_(zz.w) * a.w;
            if (u.lt == 0) *(v2u*)(A + row * D + col) = pk4(o);
            else { o = o + unpk4(*(const v2u*)(A + row * D + col)); *(v2u*)(O + row * D + col) = pk4(o); }
        EPI_LOOP_END
    }
};
struct StaticOrderDep {
    static constexpr bool DEP = true, KEEP_ACC = false;
    pg8::StaticOrder S; const unsigned* dep;
    __device__ bool next(int i, pg8::Unit& u) const { return S.next(i, u); }
    __device__ void wait(const pg8::Unit& u) const {
        const unsigned* p = dep + 16 * u.pm; unsigned sp = 0;
        while (__hip_atomic_load(p, __ATOMIC_RELAXED, __HIP_MEMORY_SCOPE_AGENT) < 4u) { __builtin_amdgcn_s_sleep(2); if (++sp > (1u << 22)) break; }
        asm volatile("s_waitcnt vmcnt(0)" ::: "memory");
    }
};
struct EpiMix2 {
    static constexpr bool PERM = true;
    const bf16* z; bf16* O; unsigned* dep;
    __device__ __forceinline__ void operator()(const f32x4 (&acc_)[2][2][4][2], const pg8::Unit& u, int wr, int wc, int fr, int fq) const {
        f32x4 (&acc)[2][2][4][2] = const_cast<f32x4 (&)[2][2][4][2]>(acc_);
        const int row0 = u.pmo * 256 + wr * 64 + fr, col0 = u.pnl * 256 + wc * 32 + 8 * fq;
#pragma unroll
        for (int ai = 0; ai < 2; ++ai)
#pragma unroll
            for (int m = 0; m < 4; ++m) { if (m == 0 || m == 2) asm volatile("" ::: "memory"); const size_t row = (size_t)(row0 + ai * 128 + m * 16); const bf16* zr = z + row * NZ + col0;
#pragma unroll
                for (int bj = 0; bj < 2; ++bj) {
                    float b[8]; unpk8(*(const v4u*)(zr + ZC_MN + bj * 128), b);
                    if (u.lt == 0) { float a[8]; unpk8(*(const v4u*)(zr + ZC_MR + bj * 128), a);
#pragma unroll
                        for (int j = 0; j < 8; ++j) acc[ai][bj][m][j >> 2][j & 3] *= (1.0f + __expf(-fmaxf(b[j], -60.f))) * __builtin_amdgcn_rcpf(1.0f + __expf(-a[j])); }
                    else { float o[8];
#pragma unroll
                        for (int j = 0; j < 8; ++j) o[j] = acc[ai][bj][m][j >> 2][j & 3] * __builtin_amdgcn_rcpf(1.0f + __expf(-fmaxf(b[j], -60.f)));
                        v4u w; w.x = pk2(o[0], o[1]); w.y = pk2(o[2], o[3]); w.z = pk2(o[4], o[5]); w.w = pk2(o[6], o[7]);
                        { bf16* op = O + row * D + col0 + bj * 128; asm volatile("global_store_dwordx4 %0, %1, off sc1" :: "v"(op), "v"(w) : "memory"); } } } }
        if (u.lt != 0) { asm volatile("s_waitcnt vmcnt(0)" ::: "memory"); __builtin_amdgcn_s_barrier(); asm volatile("" ::: "memory");
            if (threadIdx.x == 0) __hip_atomic_fetch_add(dep + 16 * u.pmo, 1u, __ATOMIC_RELAXED, __HIP_MEMORY_SCOPE_AGENT); }
    }
};
struct ErawOrder {
    static constexpr bool DEP = false, KEEP_ACC = false;
    pg8::StaticOrder S; int c, G, nheavy;
    __device__ bool next(int i, pg8::Unit& u) const { const int nl = G - nheavy, l = c - nheavy; if (l < 0) return false; const int q = l + i * nl; if (q >= S.nwg) return false;
        pg8::StaticOrder T = S; T.c = q; T.G = S.nwg + 1; return T.next(0, u); }
};
struct DualOrder {
    static constexpr bool DEP = false, KEEP_ACC = true;
    pg8::StaticOrder S;
    __device__ bool next(int i, pg8::Unit& u) const { if (i >= 2) return false; if (!S.next(0, u)) return false; if (i == 1) { u.pm += 64; u.pn += 4; } u.lt = i; return true; }
};
struct EpiResBf16 {
    static constexpr bool PERM = true;
    const float* base; bf16* O;
    __device__ __forceinline__ void operator()(const f32x4 (&acc)[2][2][4][2], const pg8::Unit& u, int wr, int wc, int fr, int fq) const {
        const int row0 = u.pmo * 256 + wr * 64 + fr, col0 = u.pnl * 256 + wc * 32 + 8 * fq;
#pragma unroll
        for (int ai = 0; ai < 2; ++ai)
#pragma unroll
            for (int m = 0; m < 4; ++m) { if (m == 0 || m == 2) asm volatile("" ::: "memory"); const size_t ro = (size_t)(row0 + ai * 128 + m * 16) * D + col0;
#pragma unroll
                for (int bj = 0; bj < 2; ++bj) { const f32x4 v0 = acc[ai][bj][m][0] + *(const f32x4*)(base + ro + bj * 128), v1 = acc[ai][bj][m][1] + *(const f32x4*)(base + ro + bj * 128 + 4);
                    v4u w; w.x = pk2(v0[0], v0[1]); w.y = pk2(v0[2], v0[3]); w.z = pk2(v1[0], v1[1]); w.w = pk2(v1[2], v1[3]);
                    *(v4u*)(O + ro + bj * 128) = w; } }
    }
};
struct EpiResF32 {
    static constexpr bool PERM = false;
    const float* base; float* O;
    __device__ __forceinline__ void operator()(const f32x4 (&acc)[2][2][4][2], const pg8::Unit& u, int wr, int wc, int fr, int fq) const {
        EPI_LOOP_BEGIN
            *(f32x4*)(O + row * D + col) = *(const f32x4*)(base + row * D + col) + a;
        EPI_LOOP_END
    }
};
struct EpiMoe1 {
    static constexpr bool PERM = false;
    bf16* H; const LAS float* rsl; unsigned* dep;
    __device__ __forceinline__ void operator()(const f32x4 (&acc)[2][2][4][2], const pg8::Unit& u, int wr, int wc, int fr, int fq) const {
#pragma unroll
        for (int ai = 0; ai < 2; ++ai)
#pragma unroll
            for (int m = 0; m < 4; ++m) { const int rl = ai * 128 + wr * 64 + m * 16 + fr; const size_t row = (size_t)u.pmo * 256 + rl; const float rs = rsl[u.pm * 256 + rl];
#pragma unroll
                for (int n = 0; n < 2; ++n) { const f32x4 gt = acc[ai][0][m][n] * rs, up = acc[ai][1][m][n] * rs; f32x4 o;
                    o.x = gt.x * sigmoidf_(gt.x) * up.x; o.y = gt.y * sigmoidf_(gt.y) * up.y; o.z = gt.z * sigmoidf_(gt.z) * up.z; o.w = gt.w * sigmoidf_(gt.w) * up.w;
                    { bf16* hp = H + row * 512 + u.pnl * 128 + wc * 32 + n * 16 + 4 * fq; const v2u hv = pk4(o); asm volatile("global_store_dwordx2 %0, %1, off sc1" :: "v"(hp), "v"(hv) : "memory"); } } }
        asm volatile("s_waitcnt vmcnt(0)" ::: "memory"); __builtin_amdgcn_s_barrier(); asm volatile("" ::: "memory");
        if (threadIdx.x == 0) __hip_atomic_fetch_add(dep + 16 * u.pmo, 1u, __ATOMIC_RELAXED, __HIP_MEMORY_SCOPE_AGENT);
    }
};
struct EpiPle {
    static constexpr bool PERM = false;
    const bf16* x2; const bf16* Eraw; const float* rse; const float* gpn; bf16* O;
    __device__ __forceinline__ void operator()(const f32x4 (&acc)[2][2][4][2], const pg8::Unit& u, int wr, int wc, int fr, int fq) const {
        EPI_LOOP_BEGIN
            const f32x4 e = unpk4(*(const v2u*)(Eraw + row * D + col)); const f32x4 g = *(const f32x4*)(gpn + col); const float rs = rse[row]; f32x4 o = unpk4(*(const v2u*)(x2 + row * D + col));
            o.x += sigmoidf_(a.x) * e.x * rs * g.x; o.y += sigmoidf_(a.y) * e.y * rs * g.y; o.z += sigmoidf_(a.z) * e.z * rs * g.z; o.w += sigmoidf_(a.w) * e.w * rs * g.w;
            *(v2u*)(O + row * D + col) = pk4(o);
        EPI_LOOP_END
    }
};

struct EpiPleNorm {
    static constexpr bool PERM = false;
    const bf16* x2; const bf16* Eraw; const float* rse; const float* gpn; const float* rs3; const float* gfin; float* out; float* xbuf; unsigned* cnt; LAS float* ldsx;
    __device__ __forceinline__ void operator()(const f32x4 (&acc_)[2][2][4][2], const pg8::Unit& u_, int wr, int wc, int fr, int fq) const {
        f32x4 (&acc)[2][2][4][2] = const_cast<f32x4 (&)[2][2][4][2]>(acc_);
        pg8::Unit u = u_; asm volatile("" : "+s"(u.pmo), "+s"(u.pnl)); asm volatile("" : "+v"(fr), "+v"(fq)); asm volatile("" : "+s"(wr), "+s"(wc));
        int tid = threadIdx.x; asm volatile("" : "+v"(tid)); const int lane = tid & 63, wid = __builtin_amdgcn_readfirstlane(tid >> 6);
        LAS float* Pl = ldsx; LAS float* Sl = ldsx + 1024; LAS unsigned* flag = (LAS unsigned*)(ldsx + 1280);
#pragma unroll
        for (int ai = 0; ai < 2; ++ai)
#pragma unroll
            for (int m = 0; m < 4; ++m) { if (m == 0 || m == 2) asm volatile("" ::: "memory"); const int rl = ai * 128 + wr * 64 + m * 16 + fr; const size_t row = (size_t)u.pmo * 256 + rl;
                float ss = 0.f; const float r3 = rs3[row], re = rse[row];
#pragma unroll
                for (int bj = 0; bj < 2; ++bj)
#pragma unroll
                    for (int n = 0; n < 2; ++n) { const int col = u.pnl * 256 + bj * 128 + wc * 32 + n * 16 + 4 * fq; const f32x4 a = acc[ai][bj][m][n];
                        const f32x4 e = unpk4(*(const v2u*)(Eraw + row * D + col)) * re * *(const f32x4*)(gpn + col); f32x4 o = unpk4(*(const v2u*)(x2 + row * D + col));
                        o.x += sigmoidf_(a.x * r3) * e.x; o.y += sigmoidf_(a.y * r3) * e.y; o.z += sigmoidf_(a.z * r3) * e.z; o.w += sigmoidf_(a.w * r3) * e.w;
                        acc[ai][bj][m][n] = o; ss += (o.x * o.x + o.y * o.y) + (o.z * o.z + o.w * o.w); }
                ss += __shfl_xor(ss, 16); ss += __shfl_xor(ss, 32);
                if (fq == 0) Pl[rl * 4 + wc] = ss; }
        asm volatile("s_waitcnt lgkmcnt(0)" ::: "memory"); __builtin_amdgcn_s_barrier(); asm volatile("" ::: "memory");
        if (tid < 256) { const float tot = (Pl[tid * 4 + 0] + Pl[tid * 4 + 1]) + (Pl[tid * 4 + 2] + Pl[tid * 4 + 3]);
            __hip_atomic_store(xbuf + ((size_t)u.pmo * 256 + tid) * 4 + u.pnl, tot, __ATOMIC_RELAXED, __HIP_MEMORY_SCOPE_AGENT);
            asm volatile("s_waitcnt vmcnt(0)" ::: "memory");
            if (lane == 0) __hip_atomic_fetch_add(cnt + 64 * u.pmo, 1u, __ATOMIC_RELAXED, __HIP_MEMORY_SCOPE_AGENT); }
        if (wid == 0) {
            unsigned spins = 0;
            while ((unsigned)__builtin_amdgcn_readfirstlane((int)__hip_atomic_load(cnt + 64 * u.pmo, __ATOMIC_RELAXED, __HIP_MEMORY_SCOPE_AGENT)) < 16u) { __builtin_amdgcn_s_sleep(2); if (++spins > (1u << 22)) break; }
            __builtin_amdgcn_fence(__ATOMIC_ACQUIRE, "agent");
            if (lane == 0) flag[0] = 1u; }
        asm volatile("s_waitcnt vmcnt(0) lgkmcnt(0)" ::: "memory"); __builtin_amdgcn_s_barrier(); asm volatile("" ::: "memory");
        if (tid < 256) { const float* sp = xbuf + ((size_t)u.pmo * 256 + tid) * 4; float tot = 0.f;
#pragma unroll
            for (int t = 0; t < 4; ++t) tot += __hip_atomic_load(sp + t, __ATOMIC_RELAXED, __HIP_MEMORY_SCOPE_AGENT);
            Sl[tid] = 1.0f / sqrtf(tot * (1.f / D) + NORM_EPS); }
        asm volatile("s_waitcnt vmcnt(0) lgkmcnt(0)" ::: "memory"); __builtin_amdgcn_s_barrier(); asm volatile("" ::: "memory");
#pragma unroll
        for (int ai = 0; ai < 2; ++ai)
#pragma unroll
            for (int m = 0; m < 4; ++m) { const int rl = ai * 128 + wr * 64 + m * 16 + fr; const size_t row = (size_t)u.pmo * 256 + rl; const float rs = Sl[rl];
#pragma unroll
                for (int bj = 0; bj < 2; ++bj)
#pragma unroll
                    for (int n = 0; n < 2; ++n) { const int col = u.pnl * 256 + bj * 128 + wc * 32 + n * 16 + 4 * fq; *(f32x4*)(out + row * D + col) = acc[ai][bj][m][n] * rs * *(const f32x4*)(gfin + col); } }
    }
};

__device__ __forceinline__ float gelu_tanh(float x) { const float u = 0.7978845608028654f * (x + 0.044715f * x * x * x); const float t = 1.0f - 2.0f * __builtin_amdgcn_rcpf(__expf(2.0f * u) + 1.0f); return 0.5f * x * (1.0f + t); }

__device__ __forceinline__ void compress_wg_task(Frame& F, int idx) {
    const int kv = idx & 1, tile8 = (idx >> 1) & 7, bg = idx >> 4, b = bg >> 1, g = bg & 1;
    const int fr = F.lane & 15, fq = F.lane >> 4;
    const bf16* z = (const bf16*)(F.ws + WS_Z);
    const bf16* w1T = (const bf16*)(F.ws + WS_SMALLW + (kv ? SW_CV1 : SW_CK1));
    const bf16* w2T = (const bf16*)(F.ws + WS_SMALLW + (kv ? SW_CV2 : SW_CK2));
    const float* pos = kv ? F.ap->in[16] : F.ap->in[15];
    const int j0 = 16 * tile8; int j = j0 + fr; const bool jvalid = j < 127; if (!jvalid) j = 126;
    const bf16* zb = z + ((size_t)b * SEQ + 16 * j) * NZ + (kv ? ZC_VC : ZC_KC) + g * 64;
    v4u zr[8]; f32x4 p0[8], p1[8]; bf16x8 aop[8][4];
#pragma unroll
    for (int i = 0; i < 8; ++i) { const int ks = 8 * F.wave + i, l = ks >> 1, d = 32 * (ks & 1) + 8 * fq;
        zr[i] = *(const v4u*)(zb + (size_t)l * NZ + d); p0[i] = *(const f32x4*)(pos + l * 64 + d); p1[i] = *(const f32x4*)(pos + l * 64 + d + 4);
#pragma unroll
        for (int mt = 0; mt < 4; ++mt) aop[i][mt] = *(const bf16x8*)(w1T + (size_t)(16 * mt + fr) * 2048 + 32 * ks + 8 * fq); }
    f32x4 acc[4];
#pragma unroll
    for (int mt = 0; mt < 4; ++mt) acc[mt] = (f32x4){0.f, 0.f, 0.f, 0.f};
#pragma unroll
    for (int i = 0; i < 8; ++i) {
        float f[8]; unpk8(zr[i], f);
        v4u bb; bb.x = pk2(f[0] + p0[i].x, f[1] + p0[i].y); bb.y = pk2(f[2] + p0[i].z, f[3] + p0[i].w); bb.z = pk2(f[4] + p1[i].x, f[5] + p1[i].y); bb.w = pk2(f[6] + p1[i].z, f[7] + p1[i].w);
        const bf16x8 bop = __builtin_bit_cast(bf16x8, bb);
#pragma unroll
        for (int mt = 0; mt < 4; ++mt) acc[mt] = MFMA16(aop[i][mt], bop, acc[mt]);
    }
    LAS float* red = (LAS float*)F.lds;
    __syncthreads();
#pragma unroll
    for (int mt = 0; mt < 4; ++mt) *(LAS f32x4*)(red + ((F.wave * 4 + mt) * 64 + F.lane) * 4) = acc[mt];
    LDS_WAIT(); __syncthreads();
    if (F.wave != 0) return;
#pragma unroll
    for (int mt = 0; mt < 4; ++mt) { f32x4 t = (f32x4){0.f, 0.f, 0.f, 0.f};
#pragma unroll
        for (int w = 0; w < 8; ++w) t = t + *(const LAS f32x4*)(red + ((w * 4 + mt) * 64 + F.lane) * 4);
        acc[mt] = t; }
    bf16x8 hb[2];
#pragma unroll
    for (int s2 = 0; s2 < 2; ++s2) { v4u w; const f32x4 a0 = acc[2 * s2], a1 = acc[2 * s2 + 1];
        w.x = pk2(gelu_tanh(a0.x), gelu_tanh(a0.y)); w.y = pk2(gelu_tanh(a0.z), gelu_tanh(a0.w)); w.z = pk2(gelu_tanh(a1.x), gelu_tanh(a1.y)); w.w = pk2(gelu_tanh(a1.z), gelu_tanh(a1.w));
        hb[s2] = __builtin_bit_cast(bf16x8, w); }
    bf16* kcmp = (bf16*)(F.ws + WS_KCMP); bf16* vcmpT = (bf16*)(F.ws + WS_KCMP + 512 * 1024);
#pragma unroll
    for (int ntl = 0; ntl < 4; ++ntl) {
        f32x4 o = (f32x4){0.f, 0.f, 0.f, 0.f};
#pragma unroll
        for (int s2 = 0; s2 < 2; ++s2) { const bf16* wp = w2T + (size_t)(16 * ntl + fr) * 64 + 32 * s2 + 4 * fq; const v2u lo = *(const v2u*)wp, hi = *(const v2u*)(wp + 16);
            v4u aw; aw.x = lo.x; aw.y = lo.y; aw.z = hi.x; aw.w = hi.y; o = MFMA16(__builtin_bit_cast(bf16x8, aw), hb[s2], o); }
        if (!jvalid) o = (f32x4){0.f, 0.f, 0.f, 0.f};
        const int jj = j0 + fr, n = 16 * ntl + 4 * fq;
        if (kv == 0) *(v2u*)(kcmp + ((size_t)bg * 128 + jj) * 64 + n) = pk4(o);
        else { const v2u w = pk4(o); bf16* vp = vcmpT + ((size_t)bg * 64 + n) * 128 + jj; vp[0] = (bf16)(w.x & 0xffff); vp[128] = (bf16)(w.x >> 16); vp[256] = (bf16)(w.y & 0xffff); vp[384] = (bf16)(w.y >> 16); }
    }
}
__device__ __forceinline__ void zgate_task(Frame& F, int tile) {
    const int fr = F.lane & 15, fq = F.lane >> 4, m0 = tile * 16;
    const bf16* XN = (const bf16*)(F.ws + WS_XN); const bf16* gw = (const bf16*)(F.ws + WS_SMALLW + SW_GATEW);
    f32x4 acc[2] = {(f32x4){0.f, 0.f, 0.f, 0.f}, (f32x4){0.f, 0.f, 0.f, 0.f}};
#pragma unroll 16
    for (int ks = 0; ks < 32; ++ks) {
        const bf16x8 bop = *(const bf16x8*)(XN + (size_t)(m0 + fr) * D + 32 * ks + 8 * fq);
#pragma unroll
        for (int ct = 0; ct < 2; ++ct) { const bf16x8 aop = *(const bf16x8*)(gw + (size_t)(16 * ct + fr) * D + 32 * ks + 8 * fq); acc[ct] = MFMA16(aop, bop, acc[ct]); }
    }
    float* zg = (float*)(F.ws + WS_ZGATE);
#pragma unroll
    for (int ct = 0; ct < 2; ++ct) *(f32x4*)(zg + (size_t)(m0 + fr) * 32 + 16 * ct + 4 * fq) = acc[ct];
}
__device__ __forceinline__ void vt_task(Frame& F, int idx) {
    const int which = idx & 1, blk = (idx >> 1) & 31, bg = idx >> 6, b = bg >> 1, g = bg & 1;
    const bf16* z = (const bf16*)(F.ws + WS_Z);
    bf16* vT = (bf16*)(F.ws + (which ? WS_VWT : WS_VST));
    const int t = 64 * blk + F.lane;
    const bf16* src = z + ((size_t)b * SEQ + t) * NZ + (which ? ZC_VW : ZC_VS) + g * 64;
#pragma unroll
    for (int dc = 0; dc < 8; ++dc) { const v4u w = *(const v4u*)(src + 8 * dc); bf16* dst = vT + ((size_t)bg * 64 + 8 * dc) * SEQ + t;
        dst[0 * SEQ] = (bf16)(w.x & 0xffff); dst[1 * SEQ] = (bf16)(w.x >> 16); dst[2 * SEQ] = (bf16)(w.y & 0xffff); dst[3 * SEQ] = (bf16)(w.y >> 16);
        dst[4 * SEQ] = (bf16)(w.z & 0xffff); dst[5 * SEQ] = (bf16)(w.z >> 16); dst[6 * SEQ] = (bf16)(w.w & 0xffff); dst[7 * SEQ] = (bf16)(w.w >> 16); }
}
__device__ __forceinline__ void alora_task4(Frame& F, int mb) {
    const bf16* z = (const bf16*)(F.ws + WS_Z); bf16* AL = (bf16*)(F.ws + WS_PBF);
    const int l = F.lane;
    const f32x4 mu = *(const f32x4*)(F.ap->in[4] + ZC_W + 4 * l);
    v2u cw[4], pw[4];
#pragma unroll
    for (int u = 0; u < 4; ++u) { const int m = mb + u * F.NGW; const int t = m & (SEQ - 1); cw[u] = *(const v2u*)(z + (size_t)m * NZ + ZC_W + 4 * l); pw[u] = *(const v2u*)(z + (size_t)(t > 0 ? m - 1 : m) * NZ + ZC_W + 4 * l); }
#pragma unroll
    for (int u = 0; u < 4; ++u) { const int m = mb + u * F.NGW; const int t = m & (SEQ - 1);
        const f32x4 cur = unpk4(cw[u]); const f32x4 prev = unpk4(pw[u]) * (t > 0 ? 1.0f : 0.0f);
        f32x4 s = cur + (prev - cur) * mu;
        if (l < 16) { s.x = tanhf(s.x); s.y = tanhf(s.y); s.z = tanhf(s.z); s.w = tanhf(s.w); }
        else if (l >= 32) { s.x = sigmoidf_(s.x); s.y = sigmoidf_(s.y); s.z = sigmoidf_(s.z); s.w = sigmoidf_(s.w); }
        *(v2u*)(AL + (size_t)m * 256 + 4 * l) = pk4(s); }
}
__device__ __forceinline__ void p2_prep(Frame& F) {
    constexpr int T1 = 1024, T2 = T1 + 1024;
    for (int it = F.vcu; it < 256; it += F.G) compress_wg_task(F, it);
    for (int task = F.gw; task < T2; task += F.NGW) {
        if (task < T1) zgate_task(F, task);
        else vt_task(F, task - T1);
    }
    for (int base = F.gw; base < M; base += 4 * F.NGW) alora_task4(F, base);
}

__device__ __forceinline__ void ld16(const bf16* p, float (&f)[16]) { float a[8], b[8]; unpk8(*(const v4u*)p, a); unpk8(*(const v4u*)(p + 8), b);
#pragma unroll
    for (int i = 0; i < 8; ++i) { f[i] = a[i]; f[8 + i] = b[i]; } }
__device__ __forceinline__ void ld16f(const float* p, float (&f)[16]) {
#pragma unroll
    for (int q = 0; q < 4; ++q) { const f32x4 v = *(const f32x4*)(p + 4 * q); f[4 * q] = v.x; f[4 * q + 1] = v.y; f[4 * q + 2] = v.z; f[4 * q + 3] = v.w; } }
__device__ __forceinline__ void st16(bf16* p, const float (&f)[16]) { v4u a, b; a.x = pk2(f[0], f[1]); a.y = pk2(f[2], f[3]); a.z = pk2(f[4], f[5]); a.w = pk2(f[6], f[7]); b.x = pk2(f[8], f[9]); b.y = pk2(f[10], f[11]); b.z = pk2(f[12], f[13]); b.w = pk2(f[14], f[15]);
    *(v4u*)p = a; *(v4u*)(p + 8) = b; }
struct PrepW { bf16x8 w[2], a[2], g[4]; };
constexpr int PW_OFF = 32768, PW_P64 = 144, PW_P128 = 272, PW_A_OFF = PW_OFF + 64 * PW_P64, PW_G_OFF = PW_A_OFF + 64 * PW_P64;
__device__ __forceinline__ void prep_stage_w(Frame& F, int h) {
    const bf16* w2T = (const bf16*)(F.ws + WS_SMALLW + SW_W2T) + (size_t)h * 64 * 64; const bf16* a2T = (const bf16*)(F.ws + WS_SMALLW + SW_A2T) + (size_t)h * 64 * 64; const bf16* g2T = (const bf16*)(F.ws + WS_SMALLW + SW_G2T) + (size_t)h * 64 * 128;
    { const int R = F.tid >> 3, c = F.tid & 7, slot = ((R >> 2) & 3) * 16 + (R >> 4) * 4 + (R & 3);
      *(LAS v4u*)(F.lds + PW_OFF + slot * PW_P64 + c * 16) = *(const v4u*)(w2T + R * 64 + c * 8); *(LAS v4u*)(F.lds + PW_A_OFF + slot * PW_P64 + c * 16) = *(const v4u*)(a2T + R * 64 + c * 8); }
#pragma unroll
    for (int i = 0; i < 2; ++i) { const int id = F.tid + 512 * i, R = id >> 4, c = id & 15, slot = ((R >> 2) & 3) * 16 + (R >> 4) * 4 + (R & 3);
      *(LAS v4u*)(F.lds + PW_G_OFF + slot * PW_P128 + c * 16) = *(const v4u*)(g2T + R * 128 + c * 8); }
}
__device__ __forceinline__ void prep_ldw(PrepW& W, const LAS unsigned char* lds, int n, int fr, int fq) {
#pragma unroll
    for (int ks = 0; ks < 2; ++ks) { W.w[ks] = *(const LAS bf16x8*)(lds + PW_OFF + (n * 16 + fr) * PW_P64 + 64 * ks + 16 * fq); W.a[ks] = *(const LAS bf16x8*)(lds + PW_A_OFF + (n * 16 + fr) * PW_P64 + 64 * ks + 16 * fq); }
#pragma unroll
    for (int ks = 0; ks < 4; ++ks) W.g[ks] = *(const LAS bf16x8*)(lds + PW_G_OFF + (n * 16 + fr) * PW_P128 + 64 * ks + 16 * fq);
}
__device__ __forceinline__ void ldpar(const LAS float* p, float (&f)[16]) {
#pragma unroll
    for (int q = 0; q < 4; ++q) { const f32x4 v = *(const LAS f32x4*)(p + 4 * q); f[4 * q] = v.x; f[4 * q + 1] = v.y; f[4 * q + 2] = v.z; f[4 * q + 3] = v.w; } }
__device__ __forceinline__ void rwkv_prep_task(Frame& F, int task, const LAS float* par) {
    const int h = task & 7, m0 = (task >> 3) * 16, fr = F.lane & 15, fq = F.lane >> 4, m = m0 + fr, t = m & (SEQ - 1);
    const bf16* z = (const bf16*)(F.ws + WS_Z); const bf16* AL = (const bf16*)(F.ws + WS_PBF);
    bf16* vbuf = (bf16*)F.out; bf16* gbuf = (bf16*)(F.ws + WS_G);
    const int cl = h * 64 + 16 * fq;
    bf16x8 bw[2], ba[2], bgf[4];
    const bf16* alr = AL + (size_t)m * 256 + 8 * fq;
#pragma unroll
    for (int ks = 0; ks < 2; ++ks) { bw[ks] = *(const bf16x8*)(alr + 32 * ks); ba[ks] = *(const bf16x8*)(alr + 64 + 32 * ks); }
#pragma unroll
    for (int ks = 0; ks < 4; ++ks) bgf[ks] = *(const bf16x8*)(alr + 128 + 32 * ks);
    const bf16* zc = z + (size_t)m * NZ + cl; const bf16* zp = (t > 0) ? zc - NZ : zc;
    v4u zraw[6][2];
#pragma unroll
    for (int q = 0; q < 3; ++q) { zraw[q][0] = *(const v4u*)(zc + 512 * q); zraw[q][1] = *(const v4u*)(zc + 512 * q + 8); zraw[3 + q][0] = *(const v4u*)(zp + 512 * q); zraw[3 + q][1] = *(const v4u*)(zp + 512 * q + 8); }
    __builtin_amdgcn_sched_barrier(0);
    float ev[16], av[16], gv[16];
#define PREP_MM(W, n) do { f32x4 accw = (f32x4){0.f, 0.f, 0.f, 0.f}, acca = accw, accg = accw; \
        _Pragma("unroll") for (int ks = 0; ks < 2; ++ks) { accw = MFMA16(W.w[ks], bw[ks], accw); acca = MFMA16(W.a[ks], ba[ks], acca); } \
        _Pragma("unroll") for (int ks = 0; ks < 4; ++ks) accg = MFMA16(W.g[ks], bgf[ks], accg); \
        _Pragma("unroll") for (int r = 0; r < 4; ++r) { ev[4 * (n) + r] = accw[r]; av[4 * (n) + r] = acca[r]; gv[4 * (n) + r] = accg[r]; } } while (0)
    { PrepW Wa, Wb;
      prep_ldw(Wa, F.lds, 0, fr, fq); prep_ldw(Wb, F.lds, 1, fr, fq); PREP_MM(Wa, 0); PREP_MM(Wb, 1);
      prep_ldw(Wa, F.lds, 2, fr, fq); prep_ldw(Wb, F.lds, 3, fr, fq); PREP_MM(Wa, 2); PREP_MM(Wb, 3); }
    float zr[16], zk[16], zv[16], tmp[16];
    const float pm = (t > 0) ? 1.0f : 0.0f;
    {   float c[16], p[16];
#define PREP_UNP(q, dst) do { float a_[8], b_[8]; unpk8(zraw[q][0], a_); unpk8(zraw[q][1], b_); _Pragma("unroll") for (int i = 0; i < 8; ++i) { dst[i] = a_[i]; dst[8 + i] = b_[i]; } } while (0)
        PREP_UNP(0, c); PREP_UNP(3, p); ldpar(par + 0 * 64 + 16 * fq, tmp);
#pragma unroll
        for (int e = 0; e < 16; ++e) zr[e] = c[e] + (p[e] * pm - c[e]) * tmp[e];
        PREP_UNP(1, c); PREP_UNP(4, p); ldpar(par + 1 * 64 + 16 * fq, tmp);
#pragma unroll
        for (int e = 0; e < 16; ++e) zk[e] = c[e] + (p[e] * pm - c[e]) * tmp[e];
        PREP_UNP(2, c); PREP_UNP(5, p); ldpar(par + 2 * 64 + 16 * fq, tmp);
#pragma unroll
        for (int e = 0; e < 16; ++e) zv[e] = c[e] + (p[e] * pm - c[e]) * tmp[e];
    }
    float kkr[16]; float ss = 0.f;
    ldpar(par + 3 * 64 + 16 * fq, tmp);
#pragma unroll
    for (int e = 0; e < 16; ++e) { const float x = -(tmp[e] + ev[e]); const float sp = fmaxf(x, 0.f) + __logf(1.0f + __expf(-fabsf(x))); ev[e] = __expf(-sp - 0.5f); }
    ldpar(par + 4 * 64 + 16 * fq, tmp);
#pragma unroll
    for (int e = 0; e < 16; ++e) av[e] = sigmoidf_(tmp[e] + av[e]);
    ldpar(par + 5 * 64 + 16 * fq, tmp);
#pragma unroll
    for (int e = 0; e < 16; ++e) { kkr[e] = zk[e] * tmp[e]; ss += kkr[e] * kkr[e]; }
    ss += __shfl_xor(ss, 16); ss += __shfl_xor(ss, 32);
    const float inv = 1.0f / fmaxf(sqrtf(ss), 1e-12f);
    ldpar(par + 6 * 64 + 16 * fq, tmp);
    float kp[16], kka[16];
#pragma unroll
    for (int e = 0; e < 16; ++e) { kkr[e] *= inv; kka[e] = kkr[e] * av[e]; kp[e] = zk[e] * (1.0f + (av[e] - 1.0f) * tmp[e]); }
    st16(vbuf + (size_t)m * 512 + cl, zv); st16(gbuf + (size_t)m * 512 + cl, gv);
    { ldpar(par + 7 * 64 + 16 * fq, tmp);
      float bsum = 0.f;
#pragma unroll
      for (int e = 0; e < 16; ++e) bsum += zr[e] * kp[e] * tmp[e];
      bsum += __shfl_xor(bsum, 16); bsum += __shfl_xor(bsum, 32);
      if (fq == 0) ((float*)(F.ws + WS_BONUS))[(size_t)m * 8 + h] = bsum; }
    asm volatile("" ::: "memory");
    unsigned char* rec = F.ws + WS_S + (size_t)task * CH_REC;
    bf16x8 Pb[2], Qb[2], Kb[2], Rb[2];
#pragma unroll
    for (int ks = 0; ks < 2; ++ks) {
        float Pm[8], Qm[8], Km[8], Rm[8], acv[8];
#pragma unroll
        for (int e8 = 0; e8 < 8; ++e8) { const int e = 8 * ks + e8;
            float cs = ev[e]; cs += dppf<0x111>(cs); cs += dppf<0x112>(cs); cs += dppf<0x114>(cs); cs += dppf<0x118>(cs);
            const float A = __expf(-cs), Ap = __expf(ev[e] - cs), iA = __expf(cs);
            Pm[e8] = kkr[e] * Ap; Qm[e8] = -kka[e] * iA; Km[e8] = kp[e] * iA; Rm[e8] = zr[e] * A; acv[e8] = A; }
        v4u w;
        w.x = pk2(Pm[0], Pm[1]); w.y = pk2(Pm[2], Pm[3]); w.z = pk2(Pm[4], Pm[5]); w.w = pk2(Pm[6], Pm[7]); Pb[ks] = __builtin_bit_cast(bf16x8, w);
        w.x = pk2(Qm[0], Qm[1]); w.y = pk2(Qm[2], Qm[3]); w.z = pk2(Qm[4], Qm[5]); w.w = pk2(Qm[6], Qm[7]); Qb[ks] = __builtin_bit_cast(bf16x8, w);
        w.x = pk2(Km[0], Km[1]); w.y = pk2(Km[2], Km[3]); w.z = pk2(Km[4], Km[5]); w.w = pk2(Km[6], Km[7]); Kb[ks] = __builtin_bit_cast(bf16x8, w);
        w.x = pk2(Rm[0], Rm[1]); w.y = pk2(Rm[2], Rm[3]); w.z = pk2(Rm[4], Rm[5]); w.w = pk2(Rm[6], Rm[7]); Rb[ks] = __builtin_bit_cast(bf16x8, w);
        if (fr == 15) { *(f32x4*)(rec + CH_AC + (16 * fq + 8 * ks) * 4) = (f32x4){acv[0], acv[1], acv[2], acv[3]}; *(f32x4*)(rec + CH_AC + (16 * fq + 8 * ks + 4) * 4) = (f32x4){acv[4], acv[5], acv[6], acv[7]}; }
    }
    *(v4u*)(rec + CH_P + fr * CH_PP + 32 * fq) = __builtin_bit_cast(v4u, Pb[0]); *(v4u*)(rec + CH_P + fr * CH_PP + 32 * fq + 16) = __builtin_bit_cast(v4u, Pb[1]);
    *(v4u*)(rec + CH_R + fr * CH_PP + 32 * fq) = __builtin_bit_cast(v4u, Rb[0]); *(v4u*)(rec + CH_R + fr * CH_PP + 32 * fq + 16) = __builtin_bit_cast(v4u, Rb[1]);
    *(v4u*)(rec + CH_Q + (fq * 16 + fr) * 32) = __builtin_bit_cast(v4u, Qb[0]); *(v4u*)(rec + CH_Q + (fq * 16 + fr) * 32 + 16) = __builtin_bit_cast(v4u, Qb[1]);
    *(v4u*)(rec + CH_K + (fq * 16 + fr) * 32) = __builtin_bit_cast(v4u, Kb[0]); *(v4u*)(rec + CH_K + (fq * 16 + fr) * 32 + 16) = __builtin_bit_cast(v4u, Kb[1]);
    f32x4 gqp = (f32x4){0.f, 0.f, 0.f, 0.f}, gkp = gqp, gqr = gqp, gkr = gqp;
#pragma unroll
    for (int ks = 0; ks < 2; ++ks) { gqp = MFMA16(Qb[ks], Pb[ks], gqp); gkp = MFMA16(Kb[ks], Pb[ks], gkp); gqr = MFMA16(Qb[ks], Rb[ks], gqr); gkr = MFMA16(Kb[ks], Rb[ks], gkr); }
#pragma unroll
    for (int rg = 0; rg < 4; ++rg) { const int s = 4 * fq + rg; if (!(s < fr)) { gqp[rg] = 0.f; gkp[rg] = 0.f; } if (!(s <= fr)) { gqr[rg] = 0.f; gkr[rg] = 0.f; } }
    *(v2u*)(rec + CH_G + 0 * 512 + (fr * 16 + 4 * fq) * 2) = pk4(gkp);
    *(v2u*)(rec + CH_G + 2 * 512 + (fr * 16 + 4 * fq) * 2) = pk4(gqr);
    *(v2u*)(rec + CH_G + 3 * 512 + (fr * 16 + 4 * fq) * 2) = pk4(gkr);
    LAS float* Nl = (LAS float*)(F.lds + F.wave * 4096);
#pragma unroll
    for (int rg = 0; rg < 4; ++rg) Nl[(4 * fq + rg) * 20 + fr] = gqp[rg];
    LDS_WAIT(); __builtin_amdgcn_wave_barrier(); asm volatile("" ::: "memory");
    float Tc[16];
#pragma unroll
    for (int s = 15; s >= 0; --s) {
        float acc = 0.f;
#pragma unroll
        for (int q4 = 0; q4 < 4; ++q4) if (4 * q4 + 3 > s) { const f32x4 nv = *(const LAS f32x4*)(Nl + s * 20 + 4 * q4);
#pragma unroll
            for (int u = 0; u < 4; ++u) if (4 * q4 + u > s) acc += nv[u] * Tc[4 * q4 + u]; }
        Tc[s] = (s == fr) ? 1.0f : acc; }
    { f32x4 tv;
#pragma unroll
      for (int u = 0; u < 4; ++u) tv[u] = fq == 0 ? Tc[u] : (fq == 1 ? Tc[4 + u] : (fq == 2 ? Tc[8 + u] : Tc[12 + u]));
      *(v2u*)(rec + CH_G + 1 * 512 + (fr * 16 + 4 * fq) * 2) = pk4(tv); }
    LDS_WAIT(); __builtin_amdgcn_wave_barrier(); asm volatile("" ::: "memory");
#undef PREP_MM
#undef PREP_UNP
}
__device__ __forceinline__ void prep_fill_par(Frame& F, LAS float* par, int h) {
    const int l = F.lane; const float* mu = F.ap->in[4];
    par[0 * 64 + l] = mu[ZC_R + h * 64 + l]; par[1 * 64 + l] = mu[ZC_K + h * 64 + l]; par[2 * 64 + l] = mu[ZC_V + h * 64 + l];
    par[3 * 64 + l] = F.ap->in[5][h * 64 + l]; par[4 * 64 + l] = F.ap->in[7][h * 64 + l]; par[5 * 64 + l] = F.ap->in[10][h * 64 + l]; par[6 * 64 + l] = F.ap->in[11][h * 64 + l]; par[7 * 64 + l] = F.ap->in[12][h * 64 + l];
    LDS_WAIT(); __builtin_amdgcn_wave_barrier(); asm volatile("" ::: "memory");
}

__device__ __forceinline__ float nsa_slope(int g, int r) { return __uint_as_float((unsigned)(127 - (g * 4 + r + 1)) << 23); }

constexpr int CMP_KC_OFF = 32768, CMP_KP = 144, CMP_VC_OFF = CMP_KC_OFF + 128 * CMP_KP, CMP_VP = 264;
__device__ __forceinline__ void nsa_cmp_stage(Frame& F, int bg) {
    const bf16* kcmp = (const bf16*)(F.ws + WS_KCMP) + (size_t)bg * 128 * 64; const bf16* vcmpT = (const bf16*)(F.ws + WS_KCMP + 512 * 1024) + (size_t)bg * 64 * 128;
    v4u a[2], v[2];
#pragma unroll
    for (int i = 0; i < 2; ++i) { const int id = F.tid + 512 * i; a[i] = *(const v4u*)(kcmp + (size_t)(id >> 3) * 64 + (id & 7) * 8); v[i] = *(const v4u*)(vcmpT + (size_t)(id >> 4) * 128 + (id & 15) * 8); }
#pragma unroll
    for (int i = 0; i < 2; ++i) { const int id = F.tid + 512 * i; *(LAS v4u*)(F.lds + CMP_KC_OFF + (id >> 3) * CMP_KP + (id & 7) * 16) = a[i]; *(LAS v4u*)(F.lds + CMP_VC_OFF + (id >> 4) * CMP_VP + (id & 15) * 16) = v[i]; }
}
template <int ABL>
__device__ __forceinline__ void nsa_cmp_task(Frame& F, int task) {
    const int tile = task & 127, bg = task >> 7, b = bg >> 1, g = bg & 1;
    const int fr = F.lane & 15, fq = F.lane >> 4, t = tile * 16 + fr, m = b * SEQ + t;
    const bf16* z = (const bf16*)(F.ws + WS_Z);
    const float* zg = (const float*)(F.ws + WS_ZGATE); const float* gb = F.ap->in[21];
    bf16* Y = (bf16*)(F.ws + WS_YB);
    bf16x8 qall[4][2]; float gl[4];
#pragma unroll
    for (int r = 0; r < 4; ++r) { const bf16* qp = z + (size_t)m * NZ + ZC_Q + (g * 4 + r) * 64 + 8 * fq; qall[r][0] = *(const bf16x8*)qp; qall[r][1] = *(const bf16x8*)(qp + 32);
        gl[r] = zg[(size_t)m * 32 + (g * 4 + r) * 3 + 0] + gb[(g * 4 + r) * 3 + 0]; }
    const LAS unsigned char* kc = F.lds + CMP_KC_OFF + fr * CMP_KP + 16 * fq; const LAS unsigned char* vc = F.lds + CMP_VC_OFF + fr * CMP_VP + 8 * fq;
    const int tv = t - 31 - 64 * fq; const float tb = (float)t - 15.5f - 64.0f * (float)fq;
    float impl[8], imp3[8];
#pragma unroll
    for (int kt = 0; kt < 8; ++kt) { impl[kt] = 0.f; imp3[kt] = 0.f; }
#pragma unroll
    for (int r = 0; r < 4; ++r) {
        const float slope = nsa_slope(g, r);
        const bf16x8 q0 = qall[r][0], q1 = qall[r][1];
        float s[8][4]; float mx = -1e30f;
#pragma unroll
        for (int kt = 0; kt < 8; ++kt) {
            f32x4 a = (f32x4){0.f, 0.f, 0.f, 0.f};
            a = MFMA16(*(const LAS bf16x8*)(kc + 16 * kt * CMP_KP), q0, a); a = MFMA16(*(const LAS bf16x8*)(kc + 16 * kt * CMP_KP + 64), q1, a);
#pragma unroll
            for (int rg = 0; rg < 4; ++rg) { const bool valid = ((256 * kt + 16 * rg) <= tv);
                const float sc = a[rg] * 0.125f - slope * (tb - (float)(256 * kt + 16 * rg)); s[kt][rg] = valid ? sc : -1e30f; mx = fmaxf(mx, s[kt][rg]); }
        }
        mx = fmaxf(mx, __shfl_xor(mx, 16)); mx = fmaxf(mx, __shfl_xor(mx, 32));
        float sum = 0.f;
#pragma unroll
        for (int kt = 0; kt < 8; ++kt)
#pragma unroll
            for (int rg = 0; rg < 4; ++rg) { const float p = (s[kt][rg] > -1e29f) ? __expf(s[kt][rg] - mx) : 0.f; s[kt][rg] = p; sum += p; }
        sum += __shfl_xor(sum, 16); sum += __shfl_xor(sum, 32);
        const float inv = sum > 0.f ? 1.0f / sum : 0.f;
#pragma unroll
        for (int kt = 0; kt < 8; ++kt) {
#pragma unroll
            for (int rg = 0; rg < 4; ++rg) s[kt][rg] *= inv;
            impl[kt] += s[kt][0] + s[kt][1] + s[kt][2] + 0.5f * s[kt][3]; imp3[kt] += s[kt][3]; }
        f32x4 o[4];
#pragma unroll
        for (int dt = 0; dt < 4; ++dt) o[dt] = (f32x4){0.f, 0.f, 0.f, 0.f};
#pragma unroll
        for (int s2 = 0; s2 < 4; ++s2) {
            v4u pw; pw.x = pk2(s[2 * s2][0], s[2 * s2][1]); pw.y = pk2(s[2 * s2][2], s[2 * s2][3]); pw.z = pk2(s[2 * s2 + 1][0], s[2 * s2 + 1][1]); pw.w = pk2(s[2 * s2 + 1][2], s[2 * s2 + 1][3]);
            const bf16x8 pb = __builtin_bit_cast(bf16x8, pw);
#pragma unroll
            for (int dt = 0; dt < 4; ++dt) { const LAS unsigned char* vp = vc + 16 * dt * CMP_VP + 64 * s2; const v2u lo = *(const LAS v2u*)vp, hi = *(const LAS v2u*)(vp + 32);
                v4u aw; aw.x = lo.x; aw.y = lo.y; aw.z = hi.x; aw.w = hi.y; o[dt] = MFMA16(__builtin_bit_cast(bf16x8, aw), pb, o[dt]); }
        }
        const int hh = g * 4 + r; const float gate = sigmoidf_(gl[r]);
#pragma unroll
        for (int dt = 0; dt < 4; ++dt) *(v2u*)(Y + (size_t)m * 512 + hh * 64 + 16 * dt + 4 * fq) = pk4(o[dt] * gate);
        __builtin_amdgcn_sched_barrier(0);
    }
    if (ABL == 1) return;
    LAS float* sc = (LAS float*)(F.lds + F.wave * 4096);
    float y3prev = 0.f;
#pragma unroll
    for (int kt = 0; kt < 8; ++kt) {
        const float y3 = __shfl(imp3[kt], (F.lane + 48) & 63);
        const float prev = (fq > 0) ? y3 : y3prev; y3prev = y3;
        sc[fr * 33 + 4 * kt + fq] = impl[kt] + 0.5f * prev;
    }
    LDS_WAIT(); __builtin_amdgcn_wave_barrier(); asm volatile("" ::: "memory");
    const int blk_t = t >> 6, chi = blk_t - 2;
    unsigned mask = 1u | (1u << blk_t) | (blk_t > 0 ? (1u << (blk_t - 1)) : 0u);
#pragma unroll
    for (int kt = 0; kt < 8; ++kt) {
        const int k = 4 * kt + fq;
        if (k >= 1 && k <= chi) { const float me = sc[fr * 33 + k]; int rank = 0;
            for (int k2 = 1; k2 <= chi; ++k2) { const float o = sc[fr * 33 + k2]; rank += (o > me || (o == me && k2 < k)) ? 1 : 0; }
            if (rank < 5) mask |= (1u << k); }
    }
    mask |= (unsigned)__shfl_xor((int)mask, 16); mask |= (unsigned)__shfl_xor((int)mask, 32);
    if (fq == 0) ((unsigned*)(F.ws + WS_SELMASK))[(size_t)bg * SEQ + t] = mask;
    LDS_WAIT(); __builtin_amdgcn_wave_barrier(); asm volatile("" ::: "memory");
}
__device__ __forceinline__ void p3_phase(Frame& F) {
    constexpr int T0 = 2048, T1 = T0 + 8192;
#ifdef DUP_P3A
    for (int task = F.gw; task < T0; task += F.NGW) { __syncthreads(); nsa_cmp_stage(F, task >> 7); LDS_WAIT(); __syncthreads(); nsa_cmp_task<DUP_P3A>(F, task); }
    asm volatile("" ::: "memory");
#endif
    for (int task = F.gw; task < T0; task += F.NGW) { __syncthreads(); nsa_cmp_stage(F, task >> 7); LDS_WAIT(); __syncthreads(); nsa_cmp_task<0>(F, task); }
    asm volatile("" ::: "memory");
    const int h = F.vcu & 7;
    LAS float* par = (LAS float*)(F.lds + F.wave * 4096 + 2048);
    __syncthreads();
    prep_fill_par(F, par, h); prep_stage_w(F, h);
    LDS_WAIT(); __syncthreads();
#ifdef DUP_P3B
    for (int i = F.wave; i < 32; i += 8) rwkv_prep_task(F, (((F.vcu >> 3) + 32 * i) << 3) | h, par);
    asm volatile("" ::: "memory");
#endif
    for (int i = F.wave; i < 32; i += 8) rwkv_prep_task(F, (((F.vcu >> 3) + 32 * i) << 3) | h, par);
}

constexpr int NSA_KP = 144, NSA_VP = 136, NSA_BUF = 64 * NSA_KP + 64 * NSA_VP, NSA_CTL = 2 * NSA_BUF + 1024;
struct NsaState { f32x4 O[2][4]; float mrun[2], lrun[2]; };
template <int WHICH, bool MASKED>
__device__ __forceinline__ void nsa_block(NsaState& St, const LAS unsigned char* kb_, const LAS unsigned char* vb_, const bf16x8 (&qf)[2][2], int kb, unsigned mymask, int t, int fq, float slope0) {
    const int kpos0 = 64 * kb;
    bf16x8 kf[4][2];
#pragma unroll
    for (int kt = 0; kt < 4; ++kt) { kf[kt][0] = *(const LAS bf16x8*)(kb_ + 16 * kt * NSA_KP); kf[kt][1] = *(const LAS bf16x8*)(kb_ + 16 * kt * NSA_KP + 64); }
    const bool bsel = (mymask >> kb) & 1u; const int dbase = t - 4 * fq - kpos0;
    const float fdb = (float)dbase;
    bf16x8 P[2][2];
#pragma unroll
    for (int r = 0; r < 2; ++r) {
        const float slope = r ? 0.5f * slope0 : slope0;
        float s[4][4]; float bm = -1e30f;
        float base = -slope * fdb;
        const float s1 = slope, s2_ = 2.0f * slope, s3 = 3.0f * slope, s16 = 16.0f * slope;
#pragma unroll
        for (int kt = 0; kt < 4; ++kt) { f32x4 a = (f32x4){base, base + s1, base + s2_, base + s3}; base += s16;
            a = MFMA16(kf[kt][0], qf[r][0], a); a = MFMA16(kf[kt][1], qf[r][1], a);
#pragma unroll
            for (int rg = 0; rg < 4; ++rg) {
                if (MASKED) { const int dist = dbase - (16 * kt + rg); const bool valid = bsel && dist >= 0 && (WHICH == 0 || dist < 512); s[kt][rg] = valid ? a[rg] : -1e30f; }
                else s[kt][rg] = a[rg];
                bm = fmaxf(bm, s[kt][rg]); } }
        bm = fmaxf(bm, __shfl_xor(bm, 16)); bm = fmaxf(bm, __shfl_xor(bm, 32));
        const float mnew = fmaxf(St.mrun[r], bm); const float scale = __builtin_amdgcn_exp2f(St.mrun[r] - mnew); St.mrun[r] = mnew;
        float ps = 0.f;
#pragma unroll
        for (int kt = 0; kt < 4; ++kt)
#pragma unroll
            for (int rg = 0; rg < 4; ++rg) { float p = __builtin_amdgcn_exp2f(s[kt][rg] - mnew); if (MASKED) p = (s[kt][rg] > -1e29f) ? p : 0.f; s[kt][rg] = p; ps += p; }
        St.lrun[r] = St.lrun[r] * scale + ps;
#pragma unroll
        for (int dt = 0; dt < 4; ++dt) St.O[r][dt] = St.O[r][dt] * scale;
#pragma unroll
        for (int s2 = 0; s2 < 2; ++s2) { v4u pw; pw.x = pk2(s[2 * s2][0], s[2 * s2][1]); pw.y = pk2(s[2 * s2][2], s[2 * s2][3]); pw.z = pk2(s[2 * s2 + 1][0], s[2 * s2 + 1][1]); pw.w = pk2(s[2 * s2 + 1][2], s[2 * s2 + 1][3]);
            P[r][s2] = __builtin_bit_cast(bf16x8, pw); }
    }
#pragma unroll
    for (int dt = 0; dt < 4; ++dt)
#pragma unroll
        for (int s2 = 0; s2 < 2; ++s2) { const LAS unsigned char* vp = vb_ + 16 * dt * NSA_VP + 64 * s2; const v2u lo = *(const LAS v2u*)vp, hi = *(const LAS v2u*)(vp + 32);
            v4u aw; aw.x = lo.x; aw.y = lo.y; aw.z = hi.x; aw.w = hi.y; const bf16x8 vf = __builtin_bit_cast(bf16x8, aw);
#pragma unroll
            for (int r = 0; r < 2; ++r) St.O[r][dt] = MFMA16(vf, P[r][s2], St.O[r][dt]); }
}
template <int WHICH>
__device__ __forceinline__ void nsa_wg_task(Frame& F, int item, v2u (&carry)[2][4]) {
    const int hp = item & 1, bg = item >> 5, tg = (item >> 1) & 15, b = bg >> 1, g = bg & 1;
    const int fr = F.lane & 15, fq = F.lane >> 4, tile = tg * 8 + F.wave, t0 = tile * 16, t = t0 + fr, m = b * SEQ + t;
    const int h0 = g * 4 + 2 * hp;
    const bf16* z = (const bf16*)(F.ws + WS_Z);
    const bf16* Kb = z + (size_t)b * SEQ * NZ + (WHICH ? ZC_KW : ZC_KS) + g * 64;
    const bf16* VT = (const bf16*)(F.ws + (WHICH ? WS_VWT : WS_VST)) + (size_t)bg * 64 * SEQ;
    unsigned mymask, tile_or, full; const int kb_hi = (t0 + 15) >> 6;
    if (WHICH == 0) { mymask = ((const unsigned*)(F.ws + WS_SELMASK))[(size_t)bg * SEQ + t]; unsigned x = mymask, y = mymask;
        x |= (unsigned)__shfl_xor((int)x, 1); x |= (unsigned)__shfl_xor((int)x, 2); x |= (unsigned)__shfl_xor((int)x, 4); x |= (unsigned)__shfl_xor((int)x, 8);
        y &= (unsigned)__shfl_xor((int)y, 1); y &= (unsigned)__shfl_xor((int)y, 2); y &= (unsigned)__shfl_xor((int)y, 4); y &= (unsigned)__shfl_xor((int)y, 8);
        tile_or = (unsigned)__builtin_amdgcn_readfirstlane((int)x); full = (unsigned)__builtin_amdgcn_readfirstlane((int)y) & ((1u << kb_hi) - 1u); }
    else { mymask = 0xffffffffu; const int lo = (t0 - 511) > 0 ? ((t0 - 511) >> 6) : 0; tile_or = 0u; full = 0u;
        for (int k = lo; k <= kb_hi; ++k) { tile_or |= (1u << k); if (k < kb_hi && 64 * k >= t0 - 496) full |= (1u << k); } }
    tile_or &= (kb_hi >= 31) ? 0xffffffffu : ((2u << kb_hi) - 1u);
    LAS unsigned* ctl = (LAS unsigned*)(F.lds + NSA_CTL);
    __syncthreads();
    if (F.lane == 0) ctl[F.wave] = tile_or;
    LDS_WAIT(); __syncthreads();
    unsigned rem = 0u;
#pragma unroll
    for (int w = 0; w < 8; ++w) rem |= ctl[w];
    rem = (unsigned)__builtin_amdgcn_readfirstlane((int)rem);
    bf16x8 qf[2][2];
#pragma unroll
    for (int r = 0; r < 2; ++r)
#pragma unroll
        for (int ks = 0; ks < 2; ++ks) { const v4u raw = *(const v4u*)(z + (size_t)m * NZ + ZC_Q + (h0 + r) * 64 + 8 * fq + 32 * ks); float f[8]; unpk8(raw, f);
            constexpr float QS = 0.125f * 1.4426950408889634f; v4u w; w.x = pk2(f[0] * QS, f[1] * QS); w.y = pk2(f[2] * QS, f[3] * QS); w.z = pk2(f[4] * QS, f[5] * QS); w.w = pk2(f[6] * QS, f[7] * QS);
            qf[r][ks] = __builtin_bit_cast(bf16x8, w); }
    NsaState St;
#pragma unroll
    for (int r = 0; r < 2; ++r) { St.mrun[r] = -1e30f; St.lrun[r] = 0.f;
#pragma unroll
        for (int dt = 0; dt < 4; ++dt) St.O[r][dt] = (f32x4){0.f, 0.f, 0.f, 0.f}; }
    const float slope0 = 1.4426950408889634f * __uint_as_float((unsigned)(127 - (h0 + 1)) << 23);
    const int srow = F.tid >> 3, sc = F.tid & 7;
    const bf16* ksrc = Kb + (size_t)srow * NZ + sc * 8; const bf16* vsrc = VT + (size_t)srow * SEQ + sc * 8;
    const int kdst = srow * NSA_KP + sc * 16, vdst = 64 * NSA_KP + srow * NSA_VP + sc * 16;
    const LAS unsigned char* kfr = F.lds + fr * NSA_KP + 16 * fq; const LAS unsigned char* vfr = F.lds + 64 * NSA_KP + fr * NSA_VP + 8 * fq;
    int kb = __builtin_ctz(rem); rem &= rem - 1u;
    v4u kreg = *(const v4u*)(ksrc + (size_t)64 * kb * NZ), vreg = *(const v4u*)(vsrc + 64 * kb);
    *(LAS v4u*)(F.lds + kdst) = kreg; *(LAS v2u*)(F.lds + vdst) = (v2u){vreg.x, vreg.y}; *(LAS v2u*)(F.lds + vdst + 8) = (v2u){vreg.z, vreg.w};
    LDS_WAIT(); __syncthreads();
    int buf = 0;
    for (;;) {
        int kbn = -1;
        if (rem) { kbn = __builtin_ctz(rem); rem &= rem - 1u; kreg = *(const v4u*)(ksrc + (size_t)64 * kbn * NZ); vreg = *(const v4u*)(vsrc + 64 * kbn); }
        __builtin_amdgcn_sched_barrier(0);
        if ((tile_or >> kb) & 1u) {
            if ((full >> kb) & 1u) nsa_block<WHICH, false>(St, kfr + buf * NSA_BUF, vfr + buf * NSA_BUF, qf, kb, mymask, t, fq, slope0);
            else nsa_block<WHICH, true>(St, kfr + buf * NSA_BUF, vfr + buf * NSA_BUF, qf, kb, mymask, t, fq, slope0);
        }
        __builtin_amdgcn_sched_barrier(0);
        if (kbn < 0) break;
        buf ^= 1;
        *(LAS v4u*)(F.lds + buf * NSA_BUF + kdst) = kreg; *(LAS v2u*)(F.lds + buf * NSA_BUF + vdst) = (v2u){vreg.x, vreg.y}; *(LAS v2u*)(F.lds + buf * NSA_BUF + vdst + 8) = (v2u){vreg.z, vreg.w};
        LDS_WAIT(); __syncthreads();
        kb = kbn;
    }
    const float* zg = (const float*)(F.ws + WS_ZGATE); const float* gb = F.ap->in[21];
    bf16* Y = (bf16*)(F.ws + WS_YB);
#pragma unroll
    for (int r = 0; r < 2; ++r) { float l = St.lrun[r]; l += __shfl_xor(l, 16); l += __shfl_xor(l, 32);
        const int hh = h0 + r; const float gate = sigmoidf_(zg[(size_t)m * 32 + hh * 3 + 1 + WHICH] + gb[hh * 3 + 1 + WHICH]); const float f = gate / l;
        if (WHICH == 1) {
#pragma unroll
            for (int dt = 0; dt < 4; ++dt) carry[r][dt] = pk4(St.O[r][dt] * f);
        } else {
            v2u yc[4];
#pragma unroll
            for (int dt = 0; dt < 4; ++dt) yc[dt] = *(const v2u*)(Y + (size_t)m * 512 + hh * 64 + 16 * dt + 4 * fq);
#pragma unroll
            for (int dt = 0; dt < 4; ++dt) *(v2u*)(Y + (size_t)m * 512 + hh * 64 + 16 * dt + 4 * fq) = pk4(unpk4(yc[dt]) + unpk4(pk4(St.O[r][dt] * f)) + unpk4(carry[r][dt]));
        } }
}
__device__ __forceinline__ void p4_phase(Frame& F) {
    for (int it = F.vcu; it < 256; it += F.G)
        for (int k = 0; k < 2; ++k) { const int item = k ? 511 - it : it; v2u carry[2][4]; nsa_wg_task<1>(F, item, carry); nsa_wg_task<0>(F, item, carry); }
}

typedef short v4i16_t __attribute__((ext_vector_type(4)));
__device__ __forceinline__ bf16x8 tr_lo(const LAS unsigned char* p) {
    const v4i16_t t = __builtin_amdgcn_ds_read_tr16_b64_v4i16((LAS v4i16_t*)p);
    return (bf16x8){t[0], t[1], t[2], t[3], 0, 0, 0, 0};
}
__device__ __forceinline__ bf16x8 lo4(v2u g) { v4u w; w.x = g.x; w.y = g.y; w.z = 0u; w.w = 0u; return __builtin_bit_cast(bf16x8, w); }
__device__ __forceinline__ bf16x8 cat8(v2u a, v2u b) { v4u w; w.x = a.x; w.y = a.y; w.z = b.x; w.w = b.y; return __builtin_bit_cast(bf16x8, w); }
struct ChunkOps { v2u pA[2][2], rA[2][2], g[4]; f32x4 ac[4]; bf16x8 aq[4], ak[4], bv; };
__device__ __forceinline__ void chunk_load(const LAS unsigned char* sl, ChunkOps& X, int lane) {
    const int fr = lane & 15, fq = lane >> 4;
#pragma unroll
    for (int m = 0; m < 2; ++m) { X.pA[m][0] = *(const LAS v2u*)(sl + CH_P + fr * CH_PP + 64 * m + 8 * fq); X.pA[m][1] = *(const LAS v2u*)(sl + CH_P + fr * CH_PP + 64 * m + 32 + 8 * fq);
        X.rA[m][0] = *(const LAS v2u*)(sl + CH_R + fr * CH_PP + 64 * m + 8 * fq); X.rA[m][1] = *(const LAS v2u*)(sl + CH_R + fr * CH_PP + 64 * m + 32 + 8 * fq); }
#pragma unroll
    for (int x = 0; x < 4; ++x) X.g[x] = *(const LAS v2u*)(sl + CH_G + 512 * x + (fr * 16 + 4 * fq) * 2);
    X.bv = tr_lo(sl + CH_V + 8 * lane);
#pragma unroll
    for (int jt = 0; jt < 4; ++jt) { X.aq[jt] = tr_lo(sl + CH_Q + jt * 512 + 8 * lane); X.ak[jt] = tr_lo(sl + CH_K + jt * 512 + 8 * lane);
        X.ac[jt] = *(const LAS f32x4*)(sl + CH_AC + (16 * jt + 4 * fq) * 4); }
}
__device__ __forceinline__ bf16x8 lo4t(bf16x8 t) { return t; }
__device__ __forceinline__ void chunk_math(const ChunkOps& X, f32x4 (&S)[4], f32x4& o_out) {
    bf16x8 bs[2];
#pragma unroll
    for (int m = 0; m < 2; ++m) { v4u w; w.x = pk2(S[2 * m][0], S[2 * m][1]); w.y = pk2(S[2 * m][2], S[2 * m][3]); w.z = pk2(S[2 * m + 1][0], S[2 * m + 1][1]); w.w = pk2(S[2 * m + 1][2], S[2 * m + 1][3]); bs[m] = __builtin_bit_cast(bf16x8, w); }
    const f32x4 z4 = (f32x4){0.f, 0.f, 0.f, 0.f};
    const bf16x8 bv = lo4t(X.bv);
    f32x4 y = MFMA16(cat8(X.pA[0][0], X.pA[0][1]), bs[0], z4); y = MFMA16(cat8(X.pA[1][0], X.pA[1][1]), bs[1], y); y = MFMA16(lo4(X.g[0]), bv, y);
    f32x4 o = MFMA16(cat8(X.rA[0][0], X.rA[0][1]), bs[0], z4); o = MFMA16(cat8(X.rA[1][0], X.rA[1][1]), bs[1], o); o = MFMA16(lo4(X.g[3]), bv, o);
    const bf16x8 by = lo4(pk4(y));
    const f32x4 u = MFMA16(lo4(X.g[1]), by, z4);
    const bf16x8 bu = lo4(pk4(u));
    o_out = MFMA16(lo4(X.g[2]), bu, o);
#pragma unroll
    for (int jt = 0; jt < 4; ++jt) { S[jt] = MFMA16(lo4t(X.aq[jt]), bu, S[jt]); S[jt] = MFMA16(lo4t(X.ak[jt]), bv, S[jt]); S[jt] = S[jt] * X.ac[jt]; }
}
#ifndef SC_CONVW
#define SC_CONVW 3
#endif
constexpr int SC_NS = 7, SC_AHEAD = 5, SC_CTL = SC_NS * CH_SLOT, SCAN_TR_OFF = 81920;
__device__ __forceinline__ void scan_dma(const unsigned char* rec, const bf16* vt, LAS unsigned char* slot, int lane) {
#pragma unroll
    for (int i = 0; i < 10; ++i) __builtin_amdgcn_global_load_lds((const unsigned*)(rec + (lane + 64 * i) * 16), (LAS unsigned*)(slot + i * 1024), 16, 0, 0);
    if (lane < 48) __builtin_amdgcn_global_load_lds((const unsigned*)(rec + (lane + 640) * 16), (LAS unsigned*)(slot + 10240), 16, 0, 0);
    if (lane < 32) __builtin_amdgcn_global_load_lds((const unsigned*)(vt + (size_t)(lane >> 1) * 512 + 8 * (lane & 1)), (LAS unsigned*)(slot + CH_V), 16, 0, 0);
}
__device__ __forceinline__ int sc_ld(LAS int* p) { int v; const unsigned a = (unsigned)(size_t)p; asm volatile("ds_read_b32 %0, %1\n\ts_waitcnt lgkmcnt(0)" : "=&v"(v) : "v"(a) : "memory"); return v; }
__device__ __forceinline__ void sc_st(LAS int* p, int v) { const unsigned a = (unsigned)(size_t)p; asm volatile("ds_write_b32 %0, %1" :: "v"(a), "v"(v) : "memory"); }
#define SC_LD(p) sc_ld(p)
#define SC_ST(p, v) sc_st((p), (v))
__device__ __forceinline__ void p5_scan(Frame& F, bool extras = true, int abl = 0) {
    LAS int* ctl = (LAS int*)(F.lds + SC_CTL);
    if (F.tid < 4) ctl[F.tid] = 0;
    LDS_WAIT(); __syncthreads();
    constexpr int NKQ = (tri::NITEMS - tri::E12) / 256;
    LAS float* mytile = (LAS float*)(F.lds + SCAN_TR_OFF + F.wave * 8448);
    const int bh = F.vcu >> 2, b = bh >> 3, h = bh & 7, i0 = (F.vcu & 3) * 16;
    if (F.wave == 0) {
        if (abl & 1) return;
        __builtin_amdgcn_s_setprio(3);
        float* o0 = (float*)(F.ws + WS_XN) + (size_t)b * SEQ * 512 + h * 64 + i0;
        const int fr = F.lane & 15, fq = F.lane >> 4;
        f32x4 S[4];
#pragma unroll
        for (int jt = 0; jt < 4; ++jt) S[jt] = (f32x4){0.f, 0.f, 0.f, 0.f};
        ChunkOps XA, XB;
        while (SC_LD(&ctl[0]) <= 0) __builtin_amdgcn_s_sleep(1);
        asm volatile("" ::: "memory");
        chunk_load(F.lds, XA, F.lane);
        LDS_WAIT(); asm volatile("" ::: "memory");
        if (F.lane == 0) SC_ST(&ctl[1], 1);
#define SCAN_ITER(XC, XN_, c_) do { const int cc = (c_); \
            if (cc + 1 < 128) { while (SC_LD(&ctl[0]) <= cc + 1) __builtin_amdgcn_s_sleep(1); asm volatile("" ::: "memory"); chunk_load(F.lds + ((cc + 1) % SC_NS) * CH_SLOT, XN_, F.lane); } \
            __builtin_amdgcn_sched_barrier(0); \
            f32x4 o; chunk_math(XC, S, o); \
            __builtin_amdgcn_sched_barrier(0); \
            float* orow = o0 + (size_t)cc * 16 * 512; \
            _Pragma("unroll") for (int rg = 0; rg < 4; ++rg) { float* pp = orow + (size_t)(4 * fq + rg) * 512 + fr; const float vv = o[rg]; asm volatile("global_store_dword %0, %1, off" :: "v"(pp), "v"(vv) : "memory"); } \
            if (cc + 1 < 128) { LDS_WAIT(); asm volatile("" ::: "memory"); if (F.lane == 0) SC_ST(&ctl[1], cc + 2); } } while (0)
#pragma unroll 1
        for (int c = 0; c < 128; c += 2) { SCAN_ITER(XA, XB, c); SCAN_ITER(XB, XA, c + 1); }
#undef SCAN_ITER
        asm volatile("s_waitcnt vmcnt(0)" ::: "memory");
        __builtin_amdgcn_s_setprio(0);
        if (F.lane == 0) SC_ST(&ctl[3], 1);
        if (!(abl & 2)) tr_run_q(F, mytile, &ctl[2], tri::E12 + F.vcu, F.G, NKQ);
    } else if (F.wave == 1) {
        if (abl & 1) return;
        const unsigned char* rec0 = F.ws + WS_S + ((size_t)(b * 128) * 8 + h) * CH_REC;
        const bf16* vt0 = (const bf16*)F.out + (size_t)b * SEQ * 512 + h * 64 + i0;
        for (int n = 0; n < 128; ++n) {
            while (SC_LD(&ctl[1]) < n - SC_NS + 1) __builtin_amdgcn_s_sleep(1);
            asm volatile("" ::: "memory");
            scan_dma(rec0 + (size_t)n * 8 * CH_REC, vt0 + (size_t)n * 16 * 512, F.lds + (n % SC_NS) * CH_SLOT, F.lane);
            if (n >= SC_AHEAD) { asm volatile("s_waitcnt vmcnt(60)" ::: "memory"); if (F.lane == 0) SC_ST(&ctl[0], n - SC_AHEAD + 1); }
        }
        asm volatile("s_waitcnt vmcnt(48)" ::: "memory"); if (F.lane == 0) SC_ST(&ctl[0], 124);
        asm volatile("s_waitcnt vmcnt(36)" ::: "memory"); if (F.lane == 0) SC_ST(&ctl[0], 125);
        asm volatile("s_waitcnt vmcnt(24)" ::: "memory"); if (F.lane == 0) SC_ST(&ctl[0], 126);
        asm volatile("s_waitcnt vmcnt(12)" ::: "memory"); if (F.lane == 0) SC_ST(&ctl[0], 127);
        asm volatile("s_waitcnt vmcnt(0)" ::: "memory"); if (F.lane == 0) SC_ST(&ctl[0], 128);
        if (!(abl & 2)) { while (SC_LD(&ctl[3]) == 0) __builtin_amdgcn_s_sleep(8); tr_run_q(F, mytile, &ctl[2], tri::E12 + F.vcu, F.G, NKQ); }
    } else {
        const int w2 = F.vcu * 6 + (F.wave - 2), NW2 = F.G * 6;
        if (!(abl & 2) && F.wave - 2 < SC_CONVW) tr_run_q(F, mytile, &ctl[2], tri::E12 + F.vcu, F.G, NKQ);
        if (!extras) return;
        const float* p = F.ap->in[1]; bf16* PB = (bf16*)(F.ws + WS_PBF);
        constexpr size_t NV = (size_t)M * 256 / 4;
        for (size_t b0 = (size_t)w2 * 64 + F.lane; b0 < NV; b0 += (size_t)8 * NW2 * 64) {
            f32x4 pv[8];
#pragma unroll
            for (int i = 0; i < 8; ++i) { const size_t idx = b0 + (size_t)i * NW2 * 64; pv[i] = (idx < NV) ? *(const f32x4*)(p + idx * 4) : (f32x4){0.f, 0.f, 0.f, 0.f}; }
#pragma unroll
            for (int i = 0; i < 8; ++i) { const size_t idx = b0 + (size_t)i * NW2 * 64; if (idx < NV) *(v2u*)(PB + idx * 4) = pk4(pv[i]); } }
        if (!(abl & 2) && F.wave - 2 >= SC_CONVW) { while (SC_LD(&ctl[3]) == 0) __builtin_amdgcn_s_sleep(8); tr_run_q(F, mytile, &ctl[2], tri::E12 + F.vcu, F.G, NKQ); }
    }
}

struct P6Par { float lw[8], lb[8]; };
__device__ __forceinline__ void p6_rows2(Frame& F, int ma, int mb_, const P6Par& P) {
    const int l = F.lane, c = 8 * l, h = l >> 3;
    f32x4 oa[2][2]; v4u vv_[2], gg_[2]; float bsv[2];
#pragma unroll
    for (int u = 0; u < 2; ++u) { const int m = u ? mb_ : ma;
        const float* oraw = (const float*)(F.ws + WS_XN) + (size_t)m * 512 + c;
        oa[u][0] = *(const f32x4*)oraw; oa[u][1] = *(const f32x4*)(oraw + 4); bsv[u] = ((const float*)(F.ws + WS_BONUS))[(size_t)m * 8 + h];
        vv_[u] = *(const v4u*)((const bf16*)F.out + (size_t)m * 512 + c); gg_[u] = *(const v4u*)((const bf16*)(F.ws + WS_G) + (size_t)m * 512 + c);
    }
    __builtin_amdgcn_sched_barrier(0);
#pragma unroll
    for (int u = 0; u < 2; ++u) { const int m = u ? mb_ : ma;
        float o[8] = {oa[u][0].x, oa[u][0].y, oa[u][0].z, oa[u][0].w, oa[u][1].x, oa[u][1].y, oa[u][1].z, oa[u][1].w};
        float s = 0.f;
#pragma unroll
        for (int j = 0; j < 8; ++j) s += o[j];
        s += __shfl_xor(s, 1); s += __shfl_xor(s, 2); s += __shfl_xor(s, 4);
        const float mu = s * (1.f / 64.f); float q = 0.f;
#pragma unroll
        for (int j = 0; j < 8; ++j) { o[j] -= mu; q += o[j] * o[j]; }
        q += __shfl_xor(q, 1); q += __shfl_xor(q, 2); q += __shfl_xor(q, 4);
        const float rstd = 1.0f / sqrtf(q * (1.f / 64.f) + GN_EPS);
        float vv[8], gg[8];
        unpk8(vv_[u], vv); unpk8(gg_[u], gg);
        const float bs = bsv[u];
        float y[8];
#pragma unroll
        for (int j = 0; j < 8; ++j) y[j] = (o[j] * rstd * P.lw[j] + P.lb[j] + bs * vv[j]) * gg[j];
        v4u w; w.x = pk2(y[0], y[1]); w.y = pk2(y[2], y[3]); w.z = pk2(y[4], y[5]); w.w = pk2(y[6], y[7]);
        *(v4u*)((bf16*)(F.ws + WS_YRW) + (size_t)m * 512 + c) = w;
    }
}
__device__ __forceinline__ void p6_phase(Frame& F) {
    const int l = F.lane, c = 8 * l;
    P6Par P;
#pragma unroll
    for (int j = 0; j < 8; ++j) { P.lw[j] = F.ap->in[13][c + j]; P.lb[j] = F.ap->in[14][c + j]; }
    for (int m = F.gw; m < M; m += 2 * F.NGW) p6_rows2(F, m, m + F.NGW, P);
}

__device__ __forceinline__ void p9b_decide(Frame& F, int base, const LAS float* LG) {
        const int tok = base + F.lane;
        const LAS float* lgp = LG + F.lane * 48;
        float lg[36];
#pragma unroll
        for (int q = 0; q < 9; ++q) { const f32x4 v = *(const LAS f32x4*)(lgp + 4 * q); lg[4 * q] = v.x; lg[4 * q + 1] = v.y; lg[4 * q + 2] = v.z; lg[4 * q + 3] = v.w; }
        const float* bg = F.ap->in[27]; const float* br = F.ap->in[29];
        float gl[4]; int gs = 0; float gm = -3.0e38f;
#pragma unroll
        for (int c = 0; c < 4; ++c) { gl[c] = lg[c] + bg[c]; if (gl[c] > gm) { gm = gl[c]; gs = c; } }
        float gsum = 0.f;
#pragma unroll
        for (int c = 0; c < 4; ++c) gsum += __expf(gl[c] - gm);
        const float pgroup = 1.0f / gsum;
        float el[8]; float em = -3.0e38f;
#pragma unroll
        for (int c = 0; c < 8; ++c) { const float lv = gs == 0 ? lg[4 + c] : (gs == 1 ? lg[12 + c] : (gs == 2 ? lg[20 + c] : lg[28 + c])); el[c] = lv + br[gs * 8 + c]; em = fmaxf(em, el[c]); }
        int i1 = 0; float v1 = -3.0e38f;
#pragma unroll
        for (int c = 0; c < 8; ++c) if (el[c] > v1) { v1 = el[c]; i1 = c; }
        int i2 = 0; float v2 = -3.0e38f;
#pragma unroll
        for (int c = 0; c < 8; ++c) if (c != i1 && el[c] > v2) { v2 = el[c]; i2 = c; }
        const float p1 = __expf(v1 - em), p2 = __expf(v2 - em);
        const float g1 = pgroup * p1 / (p1 + p2), g2 = pgroup * p2 / (p1 + p2);
        const int e1 = gs * 8 + i1, e2 = gs * 8 + i2;
        const unsigned long long lt = (1ull << F.lane) - 1ull;
        int r1 = 0, r2 = 0, mycnt = 0;
        for (int e = 0; e < 32; ++e) {
            const unsigned long long m1 = __ballot(e1 == e), m2 = __ballot(e2 == e);
            const int c1 = __popcll(m1), c2 = __popcll(m2);
            if (e1 == e) r1 = __popcll(m1 & lt);
            if (e2 == e) r2 = c1 + __popcll(m2 & lt);
            if (F.lane == e) mycnt = c1 + c2;
        }
        unsigned* cnt = (unsigned*)(F.ws + WS_CTL) + CW_CNT; int* list = (int*)(F.ws + WS_LIST); float* gateA = (float*)(F.ws + WS_GATEA); unsigned* slotA = (unsigned*)(F.ws + WS_SLOTA);
        int bs = 0;
        if (F.lane < 32 && mycnt > 0) bs = (int)atomicAdd(&cnt[F.lane], (unsigned)mycnt);
        const unsigned q1 = (unsigned)(__shfl(bs, e1) + r1), q2 = (unsigned)(__shfl(bs, e2) + r2);
        gateA[tok * 2 + 0] = g1; gateA[tok * 2 + 1] = g2;
        list[(size_t)e1 * 16384 + q1] = tok * 2 + 0; slotA[tok * 2 + 0] = ((unsigned)e1 << 16) | q1;
        list[(size_t)e2 * 16384 + q2] = tok * 2 + 1; slotA[tok * 2 + 1] = ((unsigned)e2 << 16) | q2;
}
struct RouteW { f32x4 wv[3][8]; };
__device__ __forceinline__ void route_ldx(Frame& F, int tile, v4u (&xv)[4]) {
    const int fr = F.lane & 15, fq = F.lane >> 4; const bf16* xp = (const bf16*)(F.ws + WS_XN) + (size_t)(tile * 16 + fr) * D + F.wave * 128 + 8 * fq;
#pragma unroll
    for (int g = 0; g < 4; ++g) xv[g] = *(const v4u*)(xp + 32 * g);
}
__device__ __forceinline__ void route_tile(Frame& F, int tile, const RouteW& W, const v4u (&xv_)[4], int par, LAS float* LG) {
    const int fr = F.lane & 15, fq = F.lane >> 4, m0 = tile * 16;
    f32x4 acc[3] = {(f32x4){0.f, 0.f, 0.f, 0.f}, (f32x4){0.f, 0.f, 0.f, 0.f}, (f32x4){0.f, 0.f, 0.f, 0.f}};
    float ssq = 0.f;
#pragma unroll
    for (int g2 = 0; g2 < 4; ++g2) {
        float xf[8]; unpk8(xv_[g2], xf);
#pragma unroll
        for (int hh = 0; hh < 2; ++hh) { const int g = 2 * g2 + hh;
            ssq += (xf[4 * hh] * xf[4 * hh] + xf[4 * hh + 1] * xf[4 * hh + 1]) + (xf[4 * hh + 2] * xf[4 * hh + 2] + xf[4 * hh + 3] * xf[4 * hh + 3]);
#pragma unroll
            for (int s = 0; s < 4; ++s)
#pragma unroll
                for (int ct = 0; ct < 3; ++ct) acc[ct] = __builtin_amdgcn_mfma_f32_16x16x4f32(W.wv[ct][g][s], xf[4 * hh + s], acc[ct], 0, 0, 0); }
    }
    ssq += __shfl_xor(ssq, 16); ssq += __shfl_xor(ssq, 32);
    LAS float* red = (LAS float*)(F.lds + par * 32768);
    LAS float* ssqb = red + 8 * 3 * 64 * 4; LAS float* rsb = ssqb + 128;
#pragma unroll
    for (int ct = 0; ct < 3; ++ct) *(LAS f32x4*)(red + ((F.wave * 3 + ct) * 64 + F.lane) * 4) = acc[ct];
    if (fq == 0) ssqb[F.wave * 16 + fr] = ssq;
    LDS_WAIT(); __syncthreads();
    if (F.wave == 0) { float st = 0.f;
#pragma unroll
      for (int w = 0; w < 8; ++w) st += ssqb[w * 16 + (F.lane & 15)];
      const float rs = 1.0f / sqrtf(st * (1.f / D) + NORM_EPS);
      if (fq == 0) ((float*)(F.ws + WS_RSE))[m0 + fr] = rs;
#pragma unroll
      for (int ct = 0; ct < 3; ++ct) { f32x4 t = (f32x4){0.f, 0.f, 0.f, 0.f};
#pragma unroll
          for (int w = 0; w < 8; ++w) t = t + *(const LAS f32x4*)(red + ((w * 3 + ct) * 64 + F.lane) * 4);
          *(LAS f32x4*)(LG + fr * 48 + 16 * ct + 4 * fq) = t * rs; } }
}
__device__ __forceinline__ void p9_phase(Frame& F, int rep_ = 0) {
    const int fr = F.lane & 15, fq = F.lane >> 4;
    RouteW W;
    { const float* wp = (const float*)(F.ws + WS_SMALLW + SW_ROUTEW) + (size_t)fr * D + F.wave * 128 + 8 * fq;
#pragma unroll
      for (int ct = 0; ct < 3; ++ct)
#pragma unroll
          for (int g = 0; g < 8; ++g) W.wv[ct][g] = *(const f32x4*)(wp + (size_t)ct * 16 * D + 32 * (g >> 1) + 4 * (g & 1)); }
    LAS float* LGb = (LAS float*)(F.lds + 65536);
    v4u xa[4], xb[4];
    int par = 0;
    if (F.vcu < 256) route_ldx(F, 4 * F.vcu, xa);
    for (int grp = F.vcu; grp < 256; grp += F.G) {
#pragma unroll 1
        for (int i = 0; i < 4; ++i) {
            const int tile = 4 * grp + i, nt = (i < 3) ? tile + 1 : 4 * (grp + F.G);
            if (nt < 1024) route_ldx(F, nt, xb);
            __builtin_amdgcn_sched_barrier(0);
            route_tile(F, tile, W, xa, par, LGb + i * 16 * 48);
#pragma unroll
            for (int g = 0; g < 4; ++g) xa[g] = xb[g];
            par ^= 1;
        }
        if (F.wave == 0) { LDS_WAIT(); p9b_decide(F, grp * 64, LGb); }
    }
}

__device__ __forceinline__ void p12_rows2(Frame& F, int ma, int mb_, int prelane) {
    const unsigned* slotA = (const unsigned*)(F.ws + WS_SLOTA); const float* gateA = (const float*)(F.ws + WS_GATEA);
    unsigned sl[2][2]; float gt[2][2];
#pragma unroll
    for (int u = 0; u < 2; ++u) { const int m = u ? mb_ : ma; sl[u][0] = slotA[2 * m]; sl[u][1] = slotA[2 * m + 1]; gt[u][0] = gateA[2 * m]; gt[u][1] = gateA[2 * m + 1]; }
    f32x4 xv[2][4]; v2u cv[2][2][4]; float se[2];
#pragma unroll
    for (int u = 0; u < 2; ++u) { const int m = u ? mb_ : ma;
        const bf16* x1 = (const bf16*)(F.ws + WS_XN) + (size_t)m * D;
        se[u] = (F.lane < 16) ? ((const float*)(F.ws + WS_ZGATE + 1 * MiB))[(size_t)m * 16 + F.lane] : 0.f;
#pragma unroll
        for (int j = 0; j < 4; ++j) { const int o = 4 * F.lane + 256 * j; xv[u][j] = unpk4(*(const v2u*)(x1 + o)); }
#pragma unroll
        for (int k = 0; k < 2; ++k) { const unsigned s = (unsigned)__builtin_amdgcn_readfirstlane((int)sl[u][k]); const int pre = __builtin_amdgcn_readlane(prelane, (int)(s >> 16));
            const bf16* cp = (const bf16*)(F.ws + WS_Z + 64 * MiB) + ((size_t)pre * 256 + (s & 0xffffu)) * D;
#pragma unroll
            for (int j = 0; j < 4; ++j) cv[u][k][j] = *(const v2u*)(cp + 4 * F.lane + 256 * j); } }
    __builtin_amdgcn_sched_barrier(0);
    float s2[2];
#pragma unroll
    for (int u = 0; u < 2; ++u) { s2[u] = 0.f;
#pragma unroll
        for (int j = 0; j < 4; ++j) { xv[u][j] = xv[u][j] + unpk4(cv[u][0][j]) * gt[u][0] + unpk4(cv[u][1][j]) * gt[u][1];
            s2[u] += (xv[u][j].x * xv[u][j].x + xv[u][j].y * xv[u][j].y) + (xv[u][j].z * xv[u][j].z + xv[u][j].w * xv[u][j].w);
        } }
#pragma unroll
    for (int o = 1; o < 64; o <<= 1) {
#pragma unroll
        for (int u = 0; u < 2; ++u) { s2[u] += __shfl_xor(s2[u], o); se[u] += __shfl_xor(se[u], o); } }
#pragma unroll
    for (int u = 0; u < 2; ++u) { const int m = u ? mb_ : ma;
        const float rs = 1.0f / sqrtf(s2[u] * (1.f / D) + NORM_EPS); const float rse = 1.0f / sqrtf(se[u] * (1.f / D) + NORM_EPS);
        bf16* x2 = (bf16*)(F.ws + WS_S) + (size_t)m * D; if (F.lane == 0) { ((float*)(F.ws + WS_RSE))[M + m] = rs; ((float*)(F.ws + WS_RSE))[2 * M + m] = rse; }
#pragma unroll
        for (int j = 0; j < 4; ++j) { const int o = 4 * F.lane + 256 * j; *(v2u*)(x2 + o) = pk4(xv[u][j]); }
    }
}
__device__ __forceinline__ void p12_phase(Frame& F) {
    const unsigned* cnt = (const unsigned*)(F.ws + WS_CTL) + CW_CNT;
    int nt = (F.lane < 32) ? (((int)cnt[F.lane & 31] + 255) >> 8) : 0;
    int incl = nt;
#pragma unroll
    for (int o = 1; o < 32; o <<= 1) { const int v = __shfl_up(incl, o); if (F.lane >= o) incl += v; }
    const int prelane = incl - nt;
    for (int m = F.gw; m < M; m += 2 * F.NGW) p12_rows2(F, m, m + F.NGW, prelane);
}
__device__ __forceinline__ void p14_rows4(Frame& F, int mb) {
    const float* gf = F.ap->in[36];
    f32x4 v[4][4]; float s[4];
#pragma unroll
    for (int u = 0; u < 4; ++u) { const bf16* xr = (const bf16*)(F.ws + WS_Z) + (size_t)(mb + u * F.NGW) * D;
#pragma unroll
        for (int j = 0; j < 4; ++j) v[u][j] = unpk4(*(const v2u*)(xr + 4 * F.lane + 256 * j)); }
#pragma unroll
    for (int u = 0; u < 4; ++u) { s[u] = 0.f;
#pragma unroll
        for (int j = 0; j < 4; ++j) s[u] += (v[u][j].x * v[u][j].x + v[u][j].y * v[u][j].y) + (v[u][j].z * v[u][j].z + v[u][j].w * v[u][j].w); }
#pragma unroll
    for (int o = 1; o < 64; o <<= 1) {
#pragma unroll
        for (int u = 0; u < 4; ++u) s[u] += __shfl_xor(s[u], o); }
#pragma unroll
    for (int u = 0; u < 4; ++u) { const float rs = 1.0f / sqrtf(s[u] * (1.f / D) + NORM_EPS); float* orow = F.out + (size_t)(mb + u * F.NGW) * D;
#pragma unroll
        for (int j = 0; j < 4; ++j) { const int o = 4 * F.lane + 256 * j; *(f32x4*)(orow + o) = v[u][j] * rs * *(const f32x4*)(gf + o); } }
}

#ifndef MK_ONE_LAUNCH
#define MK_ONE_LAUNCH 1
#endif
constexpr int N_PHASES = 14;
__global__ void __launch_bounds__(NWAVES * 64, 2) mk_fwd(Args args) {
    extern __shared__ __attribute__((aligned(16))) unsigned char lds[];
    Frame F;
    F.lds = (LAS unsigned char*)lds;
    F.tid = threadIdx.x; F.lane = F.tid & 63; F.wave = __builtin_amdgcn_readfirstlane(F.tid >> 6);
    F.G = gridDim.x; { const int bx = blockIdx.x; F.vcu = (F.G % 8 == 0) ? (bx % 8) * (F.G / 8) + bx / 8 : bx; }
    F.gw = F.vcu * NWAVES + F.wave; F.NGW = F.G * NWAVES;
    F.ws = args.ws; F.out = args.out;
    F.ap = (ArgsP)__builtin_amdgcn_kernarg_segment_ptr();
    unsigned char* ws = args.ws;
    const int lo = args.ph_lo, hi = args.ph_hi;
#ifdef ONLY
#define IN(k) ((k) == ONLY && lo <= (k) && (k) < hi)
#else
#define IN(k) (lo <= (k) && (k) < hi)
#endif
#if MK_ONE_LAUNCH
    if (F.tid < 16) ((LAS unsigned*)(F.lds + MISC_OFF))[F.tid] = 0u;
    __syncthreads();
    XcdBarrier bar = xcd_barrier_post((unsigned*)(ws + WS_CTL) + CW_BAR, (volatile LAS unsigned*)(F.lds + MISC_OFF));
#define GRID_BAR(k) do { if (IN(k) && IN((k) + 1)) { if ((k) == 12) cg::this_grid().sync(); else xcd_barrier(bar); } } while (0)
#else
#define GRID_BAR(k) do { } while (0)
#endif
    LAS unsigned char* L = F.lds;
#ifdef PROBE_A
    unsigned long long* tsb = (unsigned long long*)(ws + WS_CTL + 32768);
    int n_st = 0;
#define STAMP() do { if (blockIdx.x == 0 && F.tid == 0) tsb[n_st] = __builtin_amdgcn_s_memrealtime(); ++n_st; } while (0)
    STAMP();
#else
#define STAMP() do { } while (0)
#endif
    const bf16* z = (const bf16*)(ws + WS_Z);

    if (IN(0)) { p0_prologue(F); } GRID_BAR(0); STAMP();

    if (IN(1)) {
        pg8::Gemm g{(const bf16*)(ws + WS_XN), (const bf16*)(ws + WS_WIN), M, NZ, D, nullptr}; pg8::StaticOrder S; S.init(M, NZ, F.G, (int)blockIdx.x);
        EpiStoreBf16 E{(bf16*)(ws + WS_Z), NZ};
        pg8::gemm_phase<EpiStoreBf16, pg8::StaticOrder, true, false>(L, g, S, E);
    } GRID_BAR(1); STAMP();

    if (IN(2)) { p2_prep(F); } GRID_BAR(2); STAMP();
    if (IN(3)) { p3_phase(F); } GRID_BAR(3); STAMP();
    if (IN(4)) { p4_phase(F); } GRID_BAR(4); STAMP();
    if (IN(5)) { if (F.G == 256) p5_scan(F); } GRID_BAR(5); STAMP();
    if (IN(6)) { p6_phase(F); } GRID_BAR(6); STAMP();

    if (IN(7)) {
        pg8::Gemm g{(const bf16*)(ws + WS_YRW), (const bf16*)(ws + WS_UR), 2 * M, 2 * D, 512, nullptr}; DualOrder S; S.S.init(M, D, F.G, (int)blockIdx.x);
        EpiMix2 E{z, (bf16*)(ws + WS_S + 64 * MiB), (unsigned*)(ws + WS_CTL) + CW_DEP2};
        pg8::gemm_phase<EpiMix2, DualOrder, true, false>(L, g, S, E);
    } STAMP();

    if (IN(8)) {
        pg8::Gemm g{(const bf16*)(ws + WS_S + 64 * MiB), (const bf16*)(ws + WS_WO), M, D, D, nullptr}; StaticOrderDep S; S.S.init(M, D, F.G, (int)blockIdx.x); S.dep = (const unsigned*)(ws + WS_CTL) + CW_DEP2;
        EpiResBf16 E{F.ap->in[0], (bf16*)(ws + WS_XN)};
        pg8::gemm_phase<EpiResBf16, StaticOrderDep, true, false>(L, g, S, E);
    } GRID_BAR(8); STAMP();

    if (IN(9)) { p9_phase(F); } GRID_BAR(9); STAMP();

    if (IN(10)) {
        pg8::Gemm g{(const bf16*)(ws + WS_XN), (const bf16*)(ws + WS_WGU), M, 1024, D, (const int*)(ws + WS_LIST), (const float*)(ws + WS_RSE)};
        pg8::moe_fill_tab((LAS int*)(F.lds + MISC_OFF - 256), (const unsigned*)(ws + WS_CTL) + CW_CNT); LDS_WAIT(); __syncthreads();
        pg8::MoeOrder S{(const LAS int*)(F.lds + MISC_OFF - 256), F.G, F.vcu, false, 0, nullptr};
        EpiMoe1 E{(bf16*)(ws + WS_S), (const LAS float*)(F.lds + pg8::STAGE_BYTES + 4096), (unsigned*)(ws + WS_CTL) + CW_DEP};
        pg8::gemm_phase<EpiMoe1, pg8::MoeOrder, true, true>(L, g, S, E);
    } STAMP();

    if (IN(11)) {
#ifndef NO_MOE2
        { pg8::Gemm g{(const bf16*)(ws + WS_S), (const bf16*)(ws + WS_WD), M, 1024, 512, nullptr};
          pg8::moe_fill_tab((LAS int*)(F.lds + MISC_OFF - 256), (const unsigned*)(ws + WS_CTL) + CW_CNT); LDS_WAIT(); __syncthreads();
          const LAS int* tb = (const LAS int*)(F.lds + MISC_OFF - 256); const int n10 = 4 * (tb[31] + ((tb[63] + 255) >> 8));
          pg8::MoeOrderT<true> S{tb, F.G, F.vcu, true, n10 % F.G, (const unsigned*)(ws + WS_CTL) + CW_DEP};
          EpiStoreBf16 E{(bf16*)(ws + WS_Z + 64 * MiB), D};
          pg8::gemm_phase<EpiStoreBf16, pg8::MoeOrderT<true>, true, false>(L, g, S, E); }
#endif
        { pg8::Gemm g2{(const bf16*)(ws + WS_PBF), (const bf16*)(ws + WS_WPP), M, D, 256, nullptr}; ErawOrder S2; S2.S.init(M, D, F.G, 0); S2.c = (int)blockIdx.x; S2.G = F.G;
          S2.nheavy = 0;
          EpiStoreSsq E2{(bf16*)(ws + WS_S + 64 * MiB), D, (float*)(ws + WS_ZGATE + 1 * MiB)};
          pg8::gemm_phase<EpiStoreSsq, ErawOrder, true, false>(L, g2, S2, E2); }
    } GRID_BAR(11); STAMP();

    if (IN(12)) { p12_phase(F); } GRID_BAR(12); STAMP();

    if (IN(13)) {
        pg8::Gemm g{(const bf16*)(ws + WS_S), (const bf16*)(ws + WS_WPG), M, D, D, nullptr}; pg8::StaticOrder S; S.init(M, D, F.G, (int)blockIdx.x);
        EpiPleNorm E{(const bf16*)(ws + WS_S), (const bf16*)(ws + WS_S + 64 * MiB), (const float*)(ws + WS_RSE) + 2 * M, F.ap->in[33], (const float*)(ws + WS_RSE) + M, F.ap->in[36], F.out, (float*)(ws + WS_ZGATE), (unsigned*)(ws + WS_CTL) + CW_PANEL, (LAS float*)(F.lds + 131072)};
        pg8::gemm_phase<EpiPleNorm, pg8::StaticOrder, true, false>(L, g, S, E);
    } STAMP();

#ifdef PROBE_A
    xcd_barrier(bar); STAMP(); __threadfence();
    if (blockIdx.x == 0 && F.tid == 0) { __threadfence(); }
    xcd_barrier(bar);
    {
        volatile unsigned long long* tv = (volatile unsigned long long*)tsb;
        const float dA = (float)(tv[PROBE_A + 1] - tv[PROBE_A]) * 0.01f, dB = (float)(tv[PROBE_B + 1] - tv[PROBE_B]) * 0.01f;
        for (size_t i = (size_t)blockIdx.x * 512 + F.tid; i < (size_t)M * D; i += (size_t)F.G * 512) F.out[i] = 10.0f * dB;
        __syncthreads();
        if (blockIdx.x == 0 && F.tid == 0) F.out[0] = 300.0f * dA;
    }
#endif
#undef IN
#undef GRID_BAR
}

extern "C" void kernel_launch(void* const* d_in, const int* in_sizes, int n_in, void* d_out, int out_size, void* d_ws, size_t ws_size, hipStream_t stream) {
    static int grid = 0;
    if (grid == 0) {
        if (n_in != 37 || out_size != M * D || ws_size < WS_END) { fprintf(stderr, "kernel_launch: unexpected problem (n_in %d, out %d, ws %zu < %zu); nothing launched\n", n_in, out_size, ws_size, (size_t)WS_END); grid = -1; return; }
        int dev = 0, cus = 0, per_cu = 0;
        if (hipGetDevice(&dev) != hipSuccess || hipDeviceGetAttribute(&cus, hipDeviceAttributeMultiprocessorCount, dev) != hipSuccess) { grid = -1; return; }
        if (hipFuncSetAttribute((const void*)mk_fwd, hipFuncAttributeMaxDynamicSharedMemorySize, LDS_BYTES) != hipSuccess) { fprintf(stderr, "kernel_launch: hipFuncSetAttribute failed\n"); grid = -1; return; }
        if (hipOccupancyMaxActiveBlocksPerMultiprocessor(&per_cu, (const void*)mk_fwd, NWAVES * 64, LDS_BYTES) != hipSuccess || per_cu < 1) { fprintf(stderr, "kernel_launch: occupancy query says %d blocks per CU\n", per_cu); (void)hipGetLastError(); grid = -1; return; }
        grid = cus;
        if (grid != 256) fprintf(stderr, "kernel_launch: %d CUs; this kernel is built for 256\n", grid);
    }
    if (grid < 0) return;
    (void)hipMemsetAsync((char*)d_ws + WS_CTL, 0, CTL_ZERO_BYTES, stream);
    Args a{};
    for (int i = 0; i < 37; ++i) a.in[i] = (const float*)d_in[i];
    a.out = (float*)d_out; a.ws = (unsigned char*)d_ws;
#if MK_ONE_LAUNCH
    a.ph_lo = 0; a.ph_hi = N_PHASES;
    void* kargs[] = {&a};
    hipError_t e = hipLaunchCooperativeKernel((const void*)mk_fwd, dim3(grid), dim3(NWAVES * 64), kargs, LDS_BYTES, stream);
    if (e != hipSuccess) fprintf(stderr, "kernel_launch: cooperative launch failed: %s (grid %d)\n", hipGetErrorString(e), grid);
#else
    for (int ph = 0; ph < N_PHASES; ++ph) { a.ph_lo = ph; a.ph_hi = ph + 1; hipLaunchKernelGGL(mk_fwd, dim3(grid), dim3(NWAVES * 64), LDS_BYTES, stream, a); }
#endif
}
```

```cpp
#include <hip/hip_runtime.h>
#include <hip/hip_cooperative_groups.h>
#include <cstdio>
#include <cstdint>
namespace cg = cooperative_groups;

namespace pg8 {
#define PG8_LAS __attribute__((address_space(3)))
typedef unsigned short bf16_t;
typedef short bf16x8 __attribute__((ext_vector_type(8)));
typedef float f32x4 __attribute__((ext_vector_type(4)));
typedef unsigned u32x4 __attribute__((ext_vector_type(4)));
typedef unsigned u32x2 __attribute__((ext_vector_type(2)));
constexpr int BM = 256, BK = 64, HALF = 128, HTB = HALF * BK * 2  , STAGE_BYTES = 8 * HTB, NXCD = 8, WGM = 8;

__host__ __device__ __forceinline__ int lds_byte(int r, int c) { const int st = (r >> 4) * 2 + (c >> 5), rr = r & 15, cc = c & 31, ob = rr * 64 + cc * 2; return st * 1024 + (ob ^ (((ob >> 9) & 1) << 5)); }
__host__ __device__ __forceinline__ void stage_rc(int b, int& R, int& C) { const int st = b / 1024, sb = b % 1024, swz = sb ^ (((sb >> 9) & 1) << 5); R = (st >> 1) * 16 + swz / 64; C = (st & 1) * 32 + (swz % 64) / 2; }
__host__ __device__ __forceinline__ int perm32(int rho) { const int n = rho >> 4, i = rho & 15; return 8 * (i >> 2) + 4 * n + (i & 3); }

struct Unit { int pm, pn, pmo, lt, nvalid, pnl; };
struct Gemm { const bf16_t* A; const bf16_t* Bt; int M, N, K; const int* rowidx; const float* rowscale; };

struct StaticOrder {
    static constexpr bool DEP = false, KEEP_ACC = false;
    int nM, nN, nwg, G, c;
    __host__ __device__ void init(int M, int N, int G_, int c_) { nM = M / BM; nN = N / BM; nwg = nM * nN; G = G_; c = c_; }
    __host__ __device__ bool next(int i, Unit& u) const {
        const long L = (long)i * G + c; if (L >= nwg) return false;
        int wgid = (int)L; { const int q = nwg / NXCD, r = nwg % NXCD, xcd = wgid % NXCD, off = wgid / NXCD; wgid = (xcd < r ? xcd * (q + 1) : r * (q + 1) + (xcd - r) * q) + off; }
        const int nig = WGM * nN, gid = wgid / nig, fm = gid * WGM, gsz = (nM - fm) < WGM ? (nM - fm) : WGM;
        u.pm = fm + ((wgid % nig) % gsz); u.pn = (wgid % nig) / gsz; u.pmo = u.pm; u.lt = u.pm; u.nvalid = 256; u.pnl = u.pn; return true;
    }
};
template <bool DEP_>
struct MoeOrderT {
    static constexpr bool DEP = DEP_, KEEP_ACC = false;
    const PG8_LAS int* tab; int G, c; bool a_is_out;
    int nheavy; const unsigned* dep;
    __device__ void wait(const Unit& u) const {
        const unsigned* p = dep + 16 * u.pmo; unsigned sp = 0;
        while (__hip_atomic_load(p, __ATOMIC_RELAXED, __HIP_MEMORY_SCOPE_AGENT) < 4u) { __builtin_amdgcn_s_sleep(2); if (++sp > (1u << 22)) break; }
        asm volatile("s_waitcnt vmcnt(0)" ::: "memory");
    }
    __device__ bool next(int i, Unit& u) const {
        int L;
        if constexpr (DEP_) { const int nl = G - nheavy; L = (c >= nheavy) ? (i < 2 ? i * nl + (c - nheavy) : 2 * nl + (i - 2) * G + c) : 2 * nl + i * G + c; }
        else L = i * G + c;
        const int tile = L >> 2, pnl = L & 3;
        const int lane = (int)__builtin_amdgcn_mbcnt_hi(~0u, __builtin_amdgcn_mbcnt_lo(~0u, 0u)), e_ = lane & 31;
        const int pre = tab[e_], ce = tab[32 + e_]; const int nt = (ce + 255) >> 8;
        const unsigned long long mk = __ballot(lane < 32 && tile >= pre && tile < pre + nt);
        if (mk == 0ull) return false;
        const int e = (int)__builtin_ctzll(mk);
        const int pre_e = __builtin_amdgcn_readlane(pre, e), ce_e = __builtin_amdgcn_readlane(ce, e);
        const int rt = tile - pre_e; u.pmo = tile; u.pm = a_is_out ? tile : 0; u.lt = e * 64 + rt; u.pn = e * 4 + pnl; u.pnl = pnl; const int rem = ce_e - rt * 256; u.nvalid = rem < 256 ? rem : 256; return true;
    }
};
typedef MoeOrderT<false> MoeOrder;
__device__ __forceinline__ void moe_fill_tab(PG8_LAS int* tab, const unsigned* cnt) {
    const int lane = (int)__builtin_amdgcn_mbcnt_hi(~0u, __builtin_amdgcn_mbcnt_lo(~0u, 0u));
    const int ce = (lane < 32) ? (int)cnt[lane & 31] : 0; const int nt = (ce + 255) >> 8;
    int incl = nt;
#pragma unroll
    for (int o = 1; o < 32; o <<= 1) { const int v = __shfl_up(incl, o); if (lane >= o) incl += v; }
    if (lane < 32) { tab[lane] = incl - nt; tab[32 + lane] = ce; }
}

__device__ __forceinline__ unsigned cvt_pk_bf16(float lo, float hi) { unsigned r; asm volatile("v_cvt_pk_bf16_f32 %0, %1, %2" : "=v"(r) : "v"(lo), "v"(hi)); return r; }

template <class Epi, class Sched, bool ALIGN_EPI, bool GATHER>
__device__ __forceinline__ void gemm_phase(PG8_LAS unsigned char* lds, const Gemm g, const Sched& S, const Epi& E) {
    const int tid = threadIdx.x, wid = __builtin_amdgcn_readfirstlane(tid >> 6), lane = tid & 63, wr = wid >> 2, wc = wid & 3, fr = lane & 15, fq = lane >> 4;
    constexpr int AUX_A = Sched::DEP ? 16 : 0;
    int K_ = g.K; asm volatile("" : "+s"(K_));
    const int K = K_, nt = K / BK;
    unsigned voffB[2]; int RA[2], CA[2];
#pragma unroll
    for (int i = 0; i < 2; ++i) { int R, C; stage_rc(tid * 16 + i * 8192, R, C); const int Rb = Epi::PERM ? ((R & ~31) + perm32(R & 31)) : R;
        RA[i] = R; CA[i] = C; voffB[i] = (unsigned)(Rb * K + C) * 2u; }
    const size_t kstep = (size_t)(BK * 2);
    const size_t hstep = (size_t)HALF * K * 2;
    const size_t tstep = 2 * hstep;
    const unsigned ldsw = (unsigned)wid * 1024u;
    const int aoff = lds_byte(wr * 64 + fr, fq * 8), boff = lds_byte(wc * 32 + fr, fq * 8);
    unsigned vA[2][2], vN[2][2];
    PG8_LAS int* rowl = (PG8_LAS int*)(lds + STAGE_BYTES);
    if constexpr (GATHER) {
        for (int i = 0; i < 4; ++i) { Unit uu; if (!S.next(i, uu)) break; if (tid < 256) { const int tk = (tid < uu.nvalid) ? (g.rowidx[(size_t)uu.lt * 256 + tid] >> 1) : 0; rowl[i * 256 + tid] = tk; ((PG8_LAS float*)(rowl + 1024))[i * 256 + tid] = g.rowscale[tk]; } }
        asm volatile("s_waitcnt vmcnt(0) lgkmcnt(0)" ::: "memory"); __builtin_amdgcn_s_barrier(); asm volatile("" ::: "memory");
    }
    auto compute_v = [&](const Unit& u, unsigned (&v)[2][2], int ui_) {
#pragma unroll
        for (int h = 0; h < 2; ++h)
#pragma unroll
            for (int i = 0; i < 2; ++i) {
                const int rl = h * HALF + RA[i];
                if constexpr (GATHER) { const int tok = rowl[ui_ * 256 + rl]; v[h][i] = ((unsigned)tok * (unsigned)K + (unsigned)CA[i]) * 2u; }
                else v[h][i] = ((unsigned)rl * (unsigned)K + (unsigned)CA[i]) * 2u;
            }
    };
#define PG8_SA(b, h) (((b) * 2 + (h)) * HTB)
#define PG8_SB(b, h) ((4 + (b) * 2 + (h)) * HTB)
#define PG8_STAGE_X(bufoff, gbase, voff, aux) do { _Pragma("unroll") for (int _i = 0; _i < 2; ++_i) \
        __builtin_amdgcn_global_load_lds((const unsigned*)((const char*)(gbase) + (voff)[_i]), (PG8_LAS unsigned*)(lds + (bufoff) + ldsw + _i * 8192), 16, 0, aux); } while (0)
#define PG8_STAGE(bufoff, gbase, voff) PG8_STAGE_X(bufoff, gbase, voff, 0)
#define PG8_STAGE_A(bufoff, gbase, voff) PG8_STAGE_X(bufoff, gbase, voff, AUX_A)
#define PG8_LDA(dst, b, h) do { _Pragma("unroll") for (int m = 0; m < 4; ++m) _Pragma("unroll") for (int k = 0; k < 2; ++k) dst[m][k] = *(const PG8_LAS bf16x8*)(lds + PG8_SA(b, h) + aoff + m * 2048 + k * 1024); } while (0)
#define PG8_LDB(dst, b, h) do { _Pragma("unroll") for (int n = 0; n < 2; ++n) _Pragma("unroll") for (int k = 0; k < 2; ++k) dst[n][k] = *(const PG8_LAS bf16x8*)(lds + PG8_SB(b, h) + boff + n * 2048 + k * 1024); } while (0)
#define PG8_MMA(ai, bj, At, Bt) do { __builtin_amdgcn_s_setprio(1); _Pragma("unroll") for (int m = 0; m < 4; ++m) _Pragma("unroll") for (int n = 0; n < 2; ++n) _Pragma("unroll") for (int k = 0; k < 2; ++k) \
        acc[ai][bj][m][n] = __builtin_amdgcn_mfma_f32_16x16x32_bf16(Bt[n][k], At[m][k], acc[ai][bj][m][n], 0, 0, 0); __builtin_amdgcn_s_setprio(0); } while (0)
#define PG8_WAIT_V(n) asm volatile("s_waitcnt vmcnt(" #n ")" ::: "memory")
#define PG8_WAIT_L(n) asm volatile("s_waitcnt lgkmcnt(" #n ")" ::: "memory")
#define PG8_BAR __builtin_amdgcn_s_barrier()
#define PG8_SCHED __builtin_amdgcn_sched_barrier(0)
    Unit cur, nxt; int ui = 0;
    if (!S.next(0, cur)) return;
    f32x4 acc[2][2][4][2];
#pragma unroll
    for (int a = 0; a < 2; ++a)
#pragma unroll
        for (int b = 0; b < 2; ++b)
#pragma unroll
            for (int m = 0; m < 4; ++m)
#pragma unroll
                for (int n = 0; n < 2; ++n) acc[a][b][m][n] = (f32x4){0.f, 0.f, 0.f, 0.f};
    bf16x8 At[4][2], B0[2][2], B1[2][2];
    if constexpr (Sched::DEP) { if (tid == 0) S.wait(cur); PG8_BAR; }
    compute_v(cur, vA, 0);
    const char* cA = (const char*)g.A + (GATHER ? (size_t)0 : (size_t)cur.pm * tstep); const char* cB = (const char*)g.Bt + (size_t)cur.pn * tstep;
    PG8_STAGE(PG8_SB(0, 0), cB, voffB); PG8_STAGE(PG8_SB(0, 1), cB + hstep, voffB); PG8_STAGE_A(PG8_SA(0, 0), cA, vA[0]); PG8_STAGE_A(PG8_SA(0, 1), cA, vA[1]);
    if (wr == 1) PG8_BAR;
    PG8_WAIT_V(2); PG8_BAR;
    PG8_STAGE(PG8_SB(1, 0), cB + kstep, voffB); PG8_STAGE_A(PG8_SA(1, 0), cA + kstep, vA[0]); PG8_STAGE(PG8_SB(1, 1), cB + hstep + kstep, voffB);
    PG8_WAIT_V(6); PG8_BAR;
    for (;;) {
        const bool has_next = S.next(ui + 1, nxt);
        if (has_next) compute_v(nxt, vN, ui + 1);
        else {
#pragma unroll
            for (int h = 0; h < 2; ++h)
#pragma unroll
                for (int i = 0; i < 2; ++i) vN[h][i] = vA[h][i];
        }
        const char* nA = has_next ? ((const char*)g.A + (GATHER ? (size_t)0 : (size_t)nxt.pm * tstep)) : cA; const char* nB = has_next ? (const char*)g.Bt + (size_t)nxt.pn * tstep : cB;
#pragma unroll 1
        for (int t = 0; t < nt; t += 2) {
            const bool last = (t == nt - 2);
            if constexpr (Sched::DEP) { if (last && has_next) { if (tid == 0) S.wait(nxt); PG8_BAR; } }
            const char* a1 = cA + (size_t)(t + 1) * kstep;
            const char* a2 = last ? nA : cA + (size_t)(t + 2) * kstep; const char* b2 = last ? nB : cB + (size_t)(t + 2) * kstep;
            const char* a3 = a2 + kstep; const char* b3 = b2 + kstep;
            unsigned vX0[2], vX1[2];
#pragma unroll
            for (int i = 0; i < 2; ++i) { vX0[i] = last ? vN[0][i] : vA[0][i]; vX1[i] = last ? vN[1][i] : vA[1][i]; }
            PG8_LDB(B0, 0, 0); PG8_LDB(B1, 0, 1); PG8_SCHED; PG8_LDA(At, 0, 0); PG8_STAGE_A(PG8_SA(1, 1), a1, vA[1]);
            PG8_WAIT_V(8); PG8_WAIT_L(0); PG8_BAR; PG8_MMA(0, 0, At, B0); PG8_MMA(0, 1, At, B1); PG8_BAR; PG8_SCHED;
            PG8_LDA(At, 0, 1); PG8_STAGE(PG8_SB(0, 0), b2, voffB); PG8_STAGE(PG8_SB(0, 1), b2 + hstep, voffB); PG8_STAGE_A(PG8_SA(0, 0), a2, vX0);
            PG8_WAIT_V(8); PG8_WAIT_L(0); PG8_BAR; PG8_MMA(1, 0, At, B0); PG8_MMA(1, 1, At, B1); PG8_BAR; PG8_SCHED;
            PG8_LDB(B0, 1, 0); PG8_LDB(B1, 1, 1); PG8_SCHED; PG8_LDA(At, 1, 0); PG8_STAGE_A(PG8_SA(0, 1), a2, vX1);
            PG8_WAIT_V(8); PG8_WAIT_L(0); PG8_BAR; PG8_MMA(0, 0, At, B0); PG8_MMA(0, 1, At, B1); PG8_BAR; PG8_SCHED;
            PG8_LDA(At, 1, 1); PG8_STAGE(PG8_SB(1, 0), b3, voffB); PG8_STAGE(PG8_SB(1, 1), b3 + hstep, voffB); PG8_STAGE_A(PG8_SA(1, 0), a3, vX0);
            PG8_WAIT_V(8); PG8_WAIT_L(0); PG8_BAR; PG8_MMA(1, 0, At, B0); PG8_MMA(1, 1, At, B1); PG8_BAR; PG8_SCHED;
        }
        if constexpr (ALIGN_EPI) { if (wr == 0) PG8_BAR; }
        if constexpr (GATHER) cur.pm = ui;
        E(acc, cur, wr, wc, fr, fq);
        if (!has_next) break;
        if constexpr (!Sched::KEEP_ACC) {
#pragma unroll
        for (int a = 0; a < 2; ++a)
#pragma unroll
            for (int b = 0; b < 2; ++b)
#pragma unroll
                for (int m = 0; m < 4; ++m)
#pragma unroll
                    for (int n = 0; n < 2; ++n) acc[a][b][m][n] = (f32x4){0.f, 0.f, 0.f, 0.f};
        }
        cur = nxt; cA = nA; cB = nB; ++ui;
#pragma unroll
        for (int h = 0; h < 2; ++h)
#pragma unroll
            for (int i = 0; i < 2; ++i) vA[h][i] = vN[h][i];
        if constexpr (ALIGN_EPI) { if (wr == 1) PG8_BAR; }
    }
    PG8_WAIT_V(0);
    if constexpr (!ALIGN_EPI) { if (wr == 0) PG8_BAR; }
    PG8_BAR;
#undef PG8_SA
#undef PG8_SB
#undef PG8_STAGE
#undef PG8_STAGE_X
#undef PG8_STAGE_A
#undef PG8_LDA
#undef PG8_LDB
#undef PG8_MMA
#undef PG8_WAIT_V
#undef PG8_WAIT_L
#undef PG8_BAR
#undef PG8_SCHED
}
}

constexpr int NWAVES = 8;
constexpr int M = 16384, D = 1024, SEQ = 2048, NBATCH = 8;
constexpr int NIN = 5144;
constexpr int NZ = 5120;
constexpr int ZC_R = 0, ZC_K = 512, ZC_V = 1024, ZC_W = 1536, ZC_Q = 1792, ZC_KC = 2304, ZC_VC = 2432, ZC_KS = 2560, ZC_VS = 2688, ZC_KW = 2816, ZC_VW = 2944, ZC_MR = 3072, ZC_MN = 4096;
constexpr float NORM_EPS = 1e-6f, GN_EPS = 64e-5f;

constexpr size_t MiB = 1u << 20;
constexpr size_t WS_CTL = 0, CTL_ZERO_BYTES = 64 * 1024;
constexpr size_t WS_LIST = 1 * MiB;
constexpr size_t WS_GATEA = 3 * MiB;
constexpr size_t WS_RSE = 4 * MiB;
constexpr size_t WS_SLOTA = 4 * MiB + 512 * 1024;
constexpr size_t WS_SELMASK = 5 * MiB;
constexpr size_t WS_ZGATE = 6 * MiB;
constexpr size_t WS_SMALLW = 8 * MiB;
constexpr size_t SW_W2T = 0, SW_A2T = 65536, SW_G2T = 131072, SW_CK1 = 262144, SW_CV1 = 524288, SW_CK2 = 786432, SW_CV2 = 794624, SW_GATEW = 802816, SW_ROUTEW = 868352;
constexpr size_t WS_KCMP = 10 * MiB;
constexpr size_t WS_VST = 11 * MiB, WS_VWT = 15 * MiB;
constexpr size_t WS_WIN = 19 * MiB, WS_UR = 29 * MiB, WS_UN = 30 * MiB, WS_WO = 31 * MiB, WS_WPP = 33 * MiB, WS_WPG = 34 * MiB, WS_WGU = 36 * MiB, WS_WD = 100 * MiB;
constexpr size_t WS_XN = 132 * MiB;
constexpr size_t WS_PBF = 164 * MiB;
constexpr size_t WS_Z = 172 * MiB;
constexpr size_t WS_S = 332 * MiB;
constexpr size_t WS_YRW = 428 * MiB, WS_YB = 444 * MiB, WS_G = 492 * MiB, WS_LOGITS = 508 * MiB  , WS_BONUS = 508 * MiB  , WS_END = 511 * MiB;
constexpr int CH_PP = 144, CH_P = 0, CH_R = 2304, CH_Q = 4608, CH_K = 6656, CH_G = 8704, CH_AC = 10752, CH_REC = 11008, CH_V = 11008, CH_SLOT = 11520;
constexpr int CW_CNT = 0;
constexpr int CW_PANEL = 8192;
constexpr int CW_DEP = 12288;
constexpr int CW_DEP2 = 4608;
constexpr int CW_BAR = 1024;
constexpr int MISC_OFF = 163840 - 64;

constexpr int LDS_BYTES = 163840;

#define GAS __attribute__((address_space(1)))
#define LAS __attribute__((address_space(3)))
typedef unsigned short bf16;
typedef unsigned v4u __attribute__((ext_vector_type(4)));
typedef unsigned v2u __attribute__((ext_vector_type(2)));
typedef float f32x4 __attribute__((ext_vector_type(4)));
typedef float f32x2 __attribute__((ext_vector_type(2)));
typedef short bf16x8 __attribute__((ext_vector_type(8)));
typedef short bf16x4 __attribute__((ext_vector_type(4)));
typedef __bf16 bf16x2_t __attribute__((ext_vector_type(2)));
#define LDS_WAIT() asm volatile("s_waitcnt lgkmcnt(0)" ::: "memory")
#define MFMA16(a, b, c) __builtin_amdgcn_mfma_f32_16x16x32_bf16((a), (b), (c), 0, 0, 0)

__device__ __forceinline__ float bf2f(unsigned short v) { return __uint_as_float((unsigned)v << 16); }
__device__ __forceinline__ unsigned pk2(float lo, float hi) { f32x2 v = {lo, hi}; bf16x2_t b = __builtin_convertvector(v, bf16x2_t); return __builtin_bit_cast(unsigned, b); }
__device__ __forceinline__ v2u pk4(f32x4 v) { v2u r; r.x = pk2(v.x, v.y); r.y = pk2(v.z, v.w); return r; }
__device__ __forceinline__ f32x4 unpk4(v2u w) { f32x4 r; r.x = __uint_as_float(w.x << 16); r.y = __uint_as_float(w.x & 0xffff0000u); r.z = __uint_as_float(w.y << 16); r.w = __uint_as_float(w.y & 0xffff0000u); return r; }
__device__ __forceinline__ void unpk8(v4u w, float (&f)[8]) { f[0] = __uint_as_float(w.x << 16); f[1] = __uint_as_float(w.x & 0xffff0000u); f[2] = __uint_as_float(w.y << 16); f[3] = __uint_as_float(w.y & 0xffff0000u);
    f[4] = __uint_as_float(w.z << 16); f[5] = __uint_as_float(w.z & 0xffff0000u); f[6] = __uint_as_float(w.w << 16); f[7] = __uint_as_float(w.w & 0xffff0000u); }
__device__ __forceinline__ float sigmoidf_(float x) { return __builtin_amdgcn_rcpf(1.0f + __expf(-x)); }
__device__ __forceinline__ float wave_sum(float v) {
#pragma unroll
    for (int o = 1; o < 64; o <<= 1) v += __shfl_xor(v, o);
    return v;
}
template <int CTRL> __device__ __forceinline__ float dppf(float x) { return __builtin_bit_cast(float, __builtin_amdgcn_update_dpp(0, __builtin_bit_cast(int, x), CTRL, 0xf, 0xf, false)); }
__device__ __forceinline__ float row16_sum(float x) { x += dppf<0x128>(x); x += dppf<0x124>(x); x += dppf<0x122>(x); x += dppf<0x121>(x); return x; }

typedef GAS unsigned gu32;
#define XB_TMO      128
#define XB_XCNT(j)  (256  + 64 * (j))
#define XB_XSUB(j)  (1280 + 64 * (j))
#define XB_XGEN(j)  (2304 + 64 * (j))
#define XB_TOP      3328
#define XB_TOPGEN   3392
#define XCD_BAR_WORDS 3456
#define XB_SPIN_CAP (1u << 18)

__device__ __forceinline__ unsigned xb_ld(unsigned* p)              { return __hip_atomic_load(p, __ATOMIC_RELAXED, __HIP_MEMORY_SCOPE_AGENT); }
__device__ __forceinline__ unsigned xb_add(unsigned* p, unsigned v) { return __hip_atomic_fetch_add(p, v, __ATOMIC_RELAXED, __HIP_MEMORY_SCOPE_AGENT); }
__device__ __forceinline__ unsigned xb_xcc_id() { return (unsigned)__builtin_amdgcn_s_getreg((3 << 11) | 20) & 0xFu; }
#define XB_SPIN(cond, bar) do { unsigned _sp = 0; while (cond) { __builtin_amdgcn_s_sleep(1); \
    if ((++_sp & 255u) == 0u) { if (xb_ld(&(bar)[XB_TMO])) break; if (_sp > XB_SPIN_CAP) { atomicAdd(&(bar)[XB_TMO], 1u); break; } } } } while (0)

struct XcdBarrier {
    unsigned* bar; unsigned x;
    volatile LAS unsigned* st;
};

__device__ __forceinline__ XcdBarrier xcd_barrier_post(unsigned* bar, volatile LAS unsigned* st) {
    XcdBarrier b; b.bar = bar; b.x = xb_xcc_id(); b.st = st;
    if (threadIdx.x == 0) (void)xb_add(&bar[XB_XCNT(b.x)], 1u);
    return b;
}
__device__ __forceinline__ void xcd_barrier_complete(unsigned* bar, unsigned x, unsigned& nloc, unsigned& nx) {
    const unsigned G = gridDim.x * gridDim.y * gridDim.z;
    unsigned sum, cnt, mine, sp = 0u;
    for (;;) {
        sum = 0u; cnt = 0u; mine = 0u;
#pragma unroll
        for (unsigned j = 0; j < 16; ++j) { const unsigned c = xb_ld(&bar[XB_XCNT(j)]); sum += c; cnt += (c > 0u) ? 1u : 0u; mine = (j == x) ? c : mine; }
        if (sum == G) break;
        __builtin_amdgcn_s_sleep(1);
        if ((++sp & 255u) == 0u) { if (xb_ld(&bar[XB_TMO])) break; if (sp > XB_SPIN_CAP) { atomicAdd(&bar[XB_TMO], 1u); break; } }
    }
    nloc = mine > 0u ? mine : 1u; nx = cnt > 0u ? cnt : 1u;
}

__device__ __forceinline__ void xcd_barrier(const XcdBarrier& b) {
    asm volatile("s_waitcnt vmcnt(0)" ::: "memory");
    __syncthreads();
    if (threadIdx.x == 0) {
        unsigned* bar = b.bar;
        __builtin_amdgcn_s_waitcnt(0);
        unsigned nloc = b.st[0], nx = b.st[1];
        if (nloc == 0u) { xcd_barrier_complete(bar, b.x, nloc, nx); b.st[0] = nloc; b.st[1] = nx; }
        const unsigned old = xb_add(&bar[XB_XSUB(b.x)], 1u);
        const unsigned gen = old / nloc;
        if (old + 1u == (gen + 1u) * nloc) {
            __builtin_amdgcn_fence(__ATOMIC_RELEASE, "agent");
            asm volatile("s_waitcnt vmcnt(0)" ::: "memory");
            const unsigned og = xb_add(&bar[XB_TOP], 1u);
            const unsigned tg = og / nx;
            if (og + 1u == (tg + 1u) * nx) xb_add(&bar[XB_TOPGEN], 1u);
            else XB_SPIN(xb_ld(&bar[XB_TOPGEN]) == tg, bar);
            __builtin_amdgcn_fence(__ATOMIC_ACQUIRE, "agent");
            xb_add(&bar[XB_XGEN(b.x)], 1u);
            asm volatile("s_waitcnt vmcnt(0)" ::: "memory");
        } else {
            XB_SPIN(xb_ld(&bar[XB_XGEN(b.x)]) == gen, bar);
            __builtin_amdgcn_fence(__ATOMIC_ACQUIRE, "agent");
            asm volatile("s_waitcnt vmcnt(0)" ::: "memory");
        }
    }
    __syncthreads();
}

struct Args { const float* in[37]; float* out; unsigned char* ws; int ph_lo, ph_hi, rep_mask, pad; };
typedef __attribute__((address_space(4))) const Args* ArgsP;
struct Frame {
    LAS unsigned char* lds;
    int tid, lane, wave, vcu, G, gw, NGW;
    unsigned char* ws;
    ArgsP ap;
    float* out;
};

struct TrDesc { const float* W; bf16* T; bf16* T2; const float* gain; int K, ld, nc, item, mode; };
__device__ __forceinline__ void tr_load(const TrDesc& d, int lane, float (&tv)[32], f32x4 (&gn)[2]) {
    const int nblk = (d.nc + 31) / 32, kb = d.item / nblk, nb = d.item % nblk, k0 = 64 * kb, n0 = 32 * nb;
    const int nn = n0 + (lane & 31);
    gn[0] = (f32x4){1.f, 1.f, 1.f, 1.f}; gn[1] = gn[0];
    if (d.gain) { const float* gp = d.gain + k0 + 8 * (lane & 7); gn[0] = *(const f32x4*)gp; gn[1] = *(const f32x4*)(gp + 4); }
    const float* wsrc = d.W + (size_t)(k0 + (lane >> 5)) * d.ld + (nn < d.nc ? nn : 0);
#pragma unroll
    for (int i = 0; i < 32; ++i) tv[i] = wsrc[(size_t)(2 * i) * d.ld];
}
__device__ __forceinline__ void tr_finish(const TrDesc& d, LAS float* scr, int lane, const float (&tv)[32], const f32x4 (&gn)[2]) {
    const int nblk = (d.nc + 31) / 32, kb = d.item / nblk, nb = d.item % nblk, k0 = 64 * kb, n0 = 32 * nb;
#pragma unroll
    for (int i = 0; i < 32; ++i) scr[(2 * i + (lane >> 5)) * 33 + (lane & 31)] = tv[i];
    LDS_WAIT(); asm volatile("" ::: "memory");
    const int c = lane & 7;
#pragma unroll
    for (int j = 0; j < 4; ++j) { const int nl = (lane >> 3) + 8 * j, n = n0 + nl; const LAS float* s = scr + (8 * c) * 33 + nl;
        v4u o; o.x = pk2(s[0 * 33] * gn[0].x, s[1 * 33] * gn[0].y); o.y = pk2(s[2 * 33] * gn[0].z, s[3 * 33] * gn[0].w); o.z = pk2(s[4 * 33] * gn[1].x, s[5 * 33] * gn[1].y); o.w = pk2(s[6 * 33] * gn[1].z, s[7 * 33] * gn[1].w);
        if (n < d.nc) { bf16* rp;
            if (d.mode == 1) rp = n < 3072 ? d.T + (size_t)n * 1024 : (n < 3096 ? d.T2 + (size_t)(n - 3072) * 1024 : d.T + (size_t)(n - 24) * 1024);
            else if (d.mode == 2) { const int n2 = n & 511; rp = d.T + (size_t)((n2 >> 7) * 256 + (n >> 9) * 128 + (n2 & 127)) * 1024; }
            else rp = d.T + (size_t)n * d.K;
            *(v4u*)(rp + k0 + 8 * c) = o; } }
    LDS_WAIT(); asm volatile("" ::: "memory");
}
__device__ __forceinline__ void rms_row_to_bf16(int lane, const float* xrow, const float* gain, bf16* orow) {
    const f32x4* xr = (const f32x4*)xrow + lane; const f32x4* gr = (const f32x4*)gain + lane;
    f32x4 v[4]; float s = 0.f;
#pragma unroll
    for (int j = 0; j < 4; ++j) { v[j] = xr[64 * j]; s += (v[j].x * v[j].x + v[j].y * v[j].y) + (v[j].z * v[j].z + v[j].w * v[j].w); }
    const float rs = 1.0f / sqrtf(wave_sum(s) * (1.f / D) + NORM_EPS);
    v2u* o8 = (v2u*)orow + lane;
#pragma unroll
    for (int j = 0; j < 4; ++j) { const f32x4 g = gr[64 * j]; o8[64 * j] = pk4(v[j] * rs * g); }
}

namespace tri {
constexpr int I_WIN = 16 * 161, I_UR = 8 * 32, I_WO = 16 * 32, I_WPP = 4 * 32, I_L64 = 16, I_L128 = 32, I_C1 = 32 * 2, I_C2 = 2, I_GU = 16 * 32, I_DN = 8 * 32;
constexpr int E0 = I_WIN, E1 = E0 + I_UR, E2 = E1 + I_UR, E3 = E2 + I_WO, E4 = E3 + I_WPP, E5 = E4 + I_WO, E6 = E5 + I_L64, E7 = E6 + I_L64, E8 = E7 + I_L128, E9 = E8 + I_C1, E10 = E9 + I_C1, E11 = E10 + I_C2, E12 = E11 + I_C2,
              E13 = E12 + 32 * I_GU, NITEMS = E13 + 32 * I_DN;
}
__device__ __forceinline__ TrDesc tr_desc(Frame& F, int it) {
    using namespace tri;
    unsigned char* ws = F.ws;
    const float* W; const float* gain = nullptr; int K, ld, nc, item, mode = 0; size_t dst;
    if (it < E0) { W = F.ap->in[3]; K = 1024; ld = NIN; nc = NIN; item = it; mode = 1; dst = WS_WIN; }
    else if (it < E1) { W = F.ap->in[22]; K = 512; ld = 1024; nc = 1024; item = it - E0; dst = WS_UR; }
    else if (it < E2) { W = F.ap->in[23]; K = 512; ld = 1024; nc = 1024; item = it - E1; dst = WS_UN; }
    else if (it < E3) { W = F.ap->in[24]; K = 1024; ld = 1024; nc = 1024; item = it - E2; dst = WS_WO; }
    else if (it < E4) { W = F.ap->in[32]; K = 256; ld = 1024; nc = 1024; item = it - E3; dst = WS_WPP; }
    else if (it < E5) { W = F.ap->in[35]; K = 1024; ld = 1024; nc = 1024; item = it - E4; dst = WS_WPG; gain = F.ap->in[34]; }
    else if (it < E6) { W = F.ap->in[6]; K = 64; ld = 512; nc = 512; item = it - E5; dst = WS_SMALLW + SW_W2T; }
    else if (it < E7) { W = F.ap->in[8]; K = 64; ld = 512; nc = 512; item = it - E6; dst = WS_SMALLW + SW_A2T; }
    else if (it < E8) { W = F.ap->in[9]; K = 128; ld = 512; nc = 512; item = it - E7; dst = WS_SMALLW + SW_G2T; }
    else if (it < E9) { W = F.ap->in[17]; K = 2048; ld = 64; nc = 64; item = it - E8; dst = WS_SMALLW + SW_CK1; }
    else if (it < E10) { W = F.ap->in[19]; K = 2048; ld = 64; nc = 64; item = it - E9; dst = WS_SMALLW + SW_CV1; }
    else if (it < E11) { W = F.ap->in[18]; K = 64; ld = 64; nc = 64; item = it - E10; dst = WS_SMALLW + SW_CK2; }
    else if (it < E12) { W = F.ap->in[20]; K = 64; ld = 64; nc = 64; item = it - E11; dst = WS_SMALLW + SW_CV2; }
    else if (it < E13) { const int r = it - E12, e = r / I_GU; W = F.ap->in[30] + (size_t)e * 1024 * 1024; K = 1024; ld = 1024; nc = 1024; item = r % I_GU; mode = 2; dst = WS_WGU + (size_t)e * 1024 * 1024 * 2; gain = F.ap->in[25]; }
    else { const int r = it - E13, e = r / I_DN; W = F.ap->in[31] + (size_t)e * 512 * 1024; K = 512; ld = 1024; nc = 1024; item = r % I_DN; dst = WS_WD + (size_t)e * 1024 * 512 * 2; }
    return TrDesc{W, (bf16*)(ws + dst), (bf16*)(ws + WS_SMALLW + SW_GATEW), gain, K, ld, nc, item, mode};
}
__device__ __forceinline__ void tr_run(Frame& F, LAS float* scr, int it0, int stride, int it_end) {
    if (it0 >= it_end) return;
    float tvA[32], tvB[32]; f32x4 gnA[2], gnB[2];
    int it = it0; TrDesc cur = tr_desc(F, it); tr_load(cur, F.lane, tvA, gnA);
    for (;;) {
        const int nxt = it + stride; const bool has = nxt < it_end; TrDesc dn = cur;
        if (has) { dn = tr_desc(F, nxt); tr_load(dn, F.lane, tvB, gnB); }
        __builtin_amdgcn_sched_barrier(0);
        tr_finish(cur, scr, F.lane, tvA, gnA);
        if (!has) break;
        cur = dn; it = nxt;
#pragma unroll
        for (int i = 0; i < 32; ++i) tvA[i] = tvB[i];
        gnA[0] = gnB[0]; gnA[1] = gnB[1];
    }
}
__device__ __forceinline__ int tr_qnext(LAS int* qh) {
    int k = 0; const unsigned a = (unsigned)(size_t)qh; const int one = 1;
    if (__builtin_amdgcn_mbcnt_hi(~0u, __builtin_amdgcn_mbcnt_lo(~0u, 0u)) == 0) asm volatile("ds_add_rtn_u32 %0, %1, %2\n\ts_waitcnt lgkmcnt(0)" : "=&v"(k) : "v"(a), "v"(one) : "memory");
    return __builtin_amdgcn_readfirstlane(k);
}
__device__ __forceinline__ void tr_run_q(Frame& F, LAS float* scr, LAS int* qh, int base, int stride, int nk) {
    int k = tr_qnext(qh); if (k >= nk) return;
    float tvA[32], tvB[32]; f32x4 gnA[2], gnB[2];
    TrDesc cur = tr_desc(F, base + k * stride); tr_load(cur, F.lane, tvA, gnA);
    for (;;) {
        const int kn = tr_qnext(qh); const bool has = kn < nk; TrDesc dn = cur;
        if (has) { dn = tr_desc(F, base + kn * stride); tr_load(dn, F.lane, tvB, gnB); }
        __builtin_amdgcn_sched_barrier(0);
        tr_finish(cur, scr, F.lane, tvA, gnA);
        if (!has) break;
        cur = dn;
#pragma unroll
        for (int i = 0; i < 32; ++i) tvA[i] = tvB[i];
        gnA[0] = gnB[0]; gnA[1] = gnB[1];
    }
}
#ifndef MK_EXPERTS_IN_SCAN
#define MK_EXPERTS_IN_SCAN 1
#endif
__device__ __forceinline__ void p0_prologue(Frame& F) {
    LAS float* scr = (LAS float*)(F.lds + F.wave * 16384);
    unsigned char* ws = F.ws;
    bf16* gateWT = (bf16*)(ws + WS_SMALLW + SW_GATEW);
    tr_run(F, scr, F.gw, F.NGW, MK_EXPERTS_IN_SCAN ? tri::E12 : tri::NITEMS);
    for (int mb = F.gw; mb < M; mb += 4 * F.NGW) {
        f32x4 v[4][4]; float s[4];
#pragma unroll
        for (int u = 0; u < 4; ++u) { const f32x4* xr = (const f32x4*)(F.ap->in[0] + (size_t)(mb + u * F.NGW) * D) + F.lane;
#pragma unroll
            for (int j = 0; j < 4; ++j) v[u][j] = xr[64 * j]; }
#pragma unroll
        for (int u = 0; u < 4; ++u) { s[u] = 0.f;
#pragma unroll
            for (int j = 0; j < 4; ++j) s[u] += (v[u][j].x * v[u][j].x + v[u][j].y * v[u][j].y) + (v[u][j].z * v[u][j].z + v[u][j].w * v[u][j].w); }
#pragma unroll
        for (int o = 1; o < 64; o <<= 1) {
#pragma unroll
            for (int u = 0; u < 4; ++u) s[u] += __shfl_xor(s[u], o); }
        const f32x4* gr = (const f32x4*)F.ap->in[2] + F.lane;
#pragma unroll
        for (int u = 0; u < 4; ++u) { const float rs = 1.0f / sqrtf(s[u] * (1.f / D) + NORM_EPS); v2u* o8 = (v2u*)((bf16*)(ws + WS_XN) + (size_t)(mb + u * F.NGW) * D) + F.lane;
#pragma unroll
            for (int j = 0; j < 4; ++j) o8[64 * j] = pk4(v[u][j] * rs * gr[64 * j]); }
    }
    {
        float* RW = (float*)(ws + WS_SMALLW + SW_ROUTEW); const float* gf = F.ap->in[25]; const float* wg = F.ap->in[26]; const float* wr = F.ap->in[28];
        for (int idx = F.gw * 64 + F.lane; idx < 48 * 1024; idx += F.NGW * 64) { const int c = idx >> 10, k = idx & 1023; float v = 0.f;
            if (c < 4) v = wg[k * 4 + c]; else if (c < 36) v = wr[k * 32 + (c - 4)];
            RW[idx] = v * gf[k]; }
        for (int idx = F.gw * 64 + F.lane; idx < 8 * 1024; idx += F.NGW * 64) gateWT[24 * 1024 + idx] = 0;
    }
}

struct EpiStoreBf16 {
    static constexpr bool PERM = true;
    bf16* O; int ldc;
    __device__ __forceinline__ void operator()(const f32x4 (&acc)[2][2][4][2], const pg8::Unit& u, int wr, int wc, int fr, int fq) const {
        const int row0 = u.pmo * 256 + wr * 64 + fr, col0 = u.pnl * 256 + wc * 32 + 8 * fq;
#pragma unroll
        for (int ai = 0; ai < 2; ++ai)
#pragma unroll
            for (int m = 0; m < 4; ++m) { bf16* rowp = O + (size_t)(row0 + ai * 128 + m * 16) * ldc + col0;
#pragma unroll
                for (int bj = 0; bj < 2; ++bj) { const f32x4 v0 = acc[ai][bj][m][0], v1 = acc[ai][bj][m][1]; v4u w; w.x = pk2(v0[0], v0[1]); w.y = pk2(v0[2], v0[3]); w.z = pk2(v1[0], v1[1]); w.w = pk2(v1[2], v1[3]);
                    *(v4u*)(rowp + bj * 128) = w; } }
    }
};
struct EpiStoreSsq {
    static constexpr bool PERM = true;
    bf16* O; int ldc; float* part;
    __device__ __forceinline__ void operator()(const f32x4 (&acc)[2][2][4][2], const pg8::Unit& u, int wr, int wc, int fr, int fq) const {
        const int row0 = u.pmo * 256 + wr * 64 + fr, col0 = u.pnl * 256 + wc * 32 + 8 * fq;
#pragma unroll
        for (int ai = 0; ai < 2; ++ai)
#pragma unroll
            for (int m = 0; m < 4; ++m) { bf16* rowp = O + (size_t)(row0 + ai * 128 + m * 16) * ldc + col0; float ss = 0.f;
#pragma unroll
                for (int bj = 0; bj < 2; ++bj) { const f32x4 v0 = acc[ai][bj][m][0], v1 = acc[ai][bj][m][1]; v4u w; w.x = pk2(v0[0], v0[1]); w.y = pk2(v0[2], v0[3]); w.z = pk2(v1[0], v1[1]); w.w = pk2(v1[2], v1[3]);
                    *(v4u*)(rowp + bj * 128) = w;
                    ss += ((v0[0] * v0[0] + v0[1] * v0[1]) + (v0[2] * v0[2] + v0[3] * v0[3])) + ((v1[0] * v1[0] + v1[1] * v1[1]) + (v1[2] * v1[2] + v1[3] * v1[3])); }
                ss += __shfl_xor(ss, 16); ss += __shfl_xor(ss, 32);
                if (fq == 0) part[(size_t)(row0 + ai * 128 + m * 16) * 16 + u.pnl * 4 + wc] = ss; }
    }
};
#define EPI_LOOP_BEGIN \
    _Pragma("unroll") for (int ai = 0; ai < 2; ++ai) _Pragma("unroll") for (int m = 0; m < 4; ++m) { if (m == 0 || m == 2) asm volatile("" ::: "memory"); const int rl = ai * 128 + wr * 64 + m * 16 + fr; const size_t row = (size_t)u.pmo * 256 + rl; (void)row; \
    _Pragma("unroll") for (int bj = 0; bj < 2; ++bj) _Pragma("unroll") for (int n = 0; n < 2; ++n) { const int col = u.pnl * 256 + bj * 128 + wc * 32 + n * 16 + 4 * fq; (void)col; const f32x4 a = acc[ai][bj][m][n];
#define EPI_LOOP_END } }
struct EpiMix {
    static constexpr bool PERM = false;
    const bf16* z; bf16* A; bf16* O;
    __device__ __forceinline__ void operator()(const f32x4 (&acc)[2][2][4][2], const pg8::Unit& u, int wr, int wc, int fr, int fq) const {
        const int zc = u.lt ? ZC_MN : ZC_MR;
        EPI_LOOP_BEGIN
            const f32x4 zz = unpk4(*(const v2u*)(z + row * NZ + zc + col)); f32x4 o;
            o.x = sigmoidf_(zz.x) * a.x; o.y = sigmoidf_(zz.y) * a.y; o.z = sigmoidf_(zz.z) * a.z; o.w = sigmoidf_(zz.w) * a.w;
            if (u.lt == 0) *(v2u*)(A + row * D + col) = pk4(o);
            else { o = o + unpk4(*(const v2u*)(A + row * D + col)); *(v2u*)(O + row * D + col) = pk4(o); }
        EPI_LOOP_END
    }
};
struct StaticOrderDep {
    static constexpr bool DEP = true, KEEP_ACC = false;
    pg8::StaticOrder S; const unsigned* dep;
    __device__ bool next(int i, pg8::Unit& u) const { return S.next(i, u); }
    __device__ void wait(const pg8::Unit& u) const {
        const unsigned* p = dep + 16 * u.pm; unsigned sp = 0;
        while (__hip_atomic_load(p, __ATOMIC_RELAXED, __HIP_MEMORY_SCOPE_AGENT) < 4u) { __builtin_amdgcn_s_sleep(2); if (++sp > (1u << 22)) break; }
        asm volatile("s_waitcnt vmcnt(0)" ::: "memory");
    }
};
struct EpiMix2 {
    static constexpr bool PERM = true;
    const bf16* z; bf16* O; unsigned* dep;
    __device__ __forceinline__ void operator()(const f32x4 (&acc_)[2][2][4][2], const pg8::Unit& u, int wr, int wc, int fr, int fq) const {
        f32x4 (&acc)[2][2][4][2] = const_cast<f32x4 (&)[2][2][4][2]>(acc_);
        const int row0 = u.pmo * 256 + wr * 64 + fr, col0 = u.pnl * 256 + wc * 32 + 8 * fq;
#pragma unroll
        for (int ai = 0; ai < 2; ++ai)
#pragma unroll
            for (int m = 0; m < 4; ++m) { if (m == 0 || m == 2) asm volatile("" ::: "memory"); const size_t row = (size_t)(row0 + ai * 128 + m * 16); const bf16* zr = z + row * NZ + col0;
#pragma unroll
                for (int bj = 0; bj < 2; ++bj) {
                    float b[8]; unpk8(*(const v4u*)(zr + ZC_MN + bj * 128), b);
                    if (u.lt == 0) { float a[8]; unpk8(*(const v4u*)(zr + ZC_MR + bj * 128), a);
#pragma unroll
                        for (int j = 0; j < 8; ++j) acc[ai][bj][m][j >> 2][j & 3] *= (1.0f + __expf(-fmaxf(b[j], -60.f))) * __builtin_amdgcn_rcpf(1.0f + __expf(-a[j])); }
                    else { float o[8];
#pragma unroll
                        for (int j = 0; j < 8; ++j) o[j] = acc[ai][bj][m][j >> 2][j & 3] * __builtin_amdgcn_rcpf(1.0f + __expf(-fmaxf(b[j], -60.f)));
                        v4u w; w.x = pk2(o[0], o[1]); w.y = pk2(o[2], o[3]); w.z = pk2(o[4], o[5]); w.w = pk2(o[6], o[7]);
                        { bf16* op = O + row * D + col0 + bj * 128; asm volatile("global_store_dwordx4 %0, %1, off sc1" :: "v"(op), "v"(w) : "memory"); } } } }
        if (u.lt != 0) { asm volatile("s_waitcnt vmcnt(0)" ::: "memory"); __builtin_amdgcn_s_barrier(); asm volatile("" ::: "memory");
            if (threadIdx.x == 0) __hip_atomic_fetch_add(dep + 16 * u.pmo, 1u, __ATOMIC_RELAXED, __HIP_MEMORY_SCOPE_AGENT); }
    }
};
struct ErawOrder {
    static constexpr bool DEP = false, KEEP_ACC = false;
    pg8::StaticOrder S; int c, G, nheavy;
    __device__ bool next(int i, pg8::Unit& u) const { const int nl = G - nheavy, l = c - nheavy; if (l < 0) return false; const int q = l + i * nl; if (q >= S.nwg) return false;
        pg8::StaticOrder T = S; T.c = q; T.G = S.nwg + 1; return T.next(0, u); }
};
struct DualOrder {
    static constexpr bool DEP = false, KEEP_ACC = true;
    pg8::StaticOrder S;
    __device__ bool next(int i, pg8::Unit& u) const { if (i >= 2) return false; if (!S.next(0, u)) return false; if (i == 1) { u.pm += 64; u.pn += 4; } u.lt = i; return true; }
};
struct EpiResBf16 {
    static constexpr bool PERM = true;
    const float* base; bf16* O;
    __device__ __forceinline__ void operator()(const f32x4 (&acc)[2][2][4][2], const pg8::Unit& u, int wr, int wc, int fr, int fq) const {
        const int row0 = u.pmo * 256 + wr * 64 + fr, col0 = u.pnl * 256 + wc * 32 + 8 * fq;
#pragma unroll
        for (int ai = 0; ai < 2; ++ai)
#pragma unroll
            for (int m = 0; m < 4; ++m) { if (m == 0 || m == 2) asm volatile("" ::: "memory"); const size_t ro = (size_t)(row0 + ai * 128 + m * 16) * D + col0;
#pragma unroll
                for (int bj = 0; bj < 2; ++bj) { const f32x4 v0 = acc[ai][bj][m][0] + *(const f32x4*)(base + ro + bj * 128), v1 = acc[ai][bj][m][1] + *(const f32x4*)(base + ro + bj * 128 + 4);
                    v4u w; w.x = pk2(v0[0], v0[1]); w.y = pk2(v0[2], v0[3]); w.z = pk2(v1[0], v1[1]); w.w = pk2(v1[2], v1[3]);
                    *(v4u*)(O + ro + bj * 128) = w; } }
    }
};
struct EpiResF32 {
    static constexpr bool PERM = false;
    const float* base; float* O;
    __device__ __forceinline__ void operator()(const f32x4 (&acc)[2][2][4][2], const pg8::Unit& u, int wr, int wc, int fr, int fq) const {
        EPI_LOOP_BEGIN
            *(f32x4*)(O + row * D + col) = *(const f32x4*)(base + row * D + col) + a;
        EPI_LOOP_END
    }
};
struct EpiMoe1 {
    static constexpr bool PERM = false;
    bf16* H; const LAS float* rsl; unsigned* dep;
    __device__ __forceinline__ void operator()(const f32x4 (&acc)[2][2][4][2], const pg8::Unit& u, int wr, int wc, int fr, int fq) const {
#pragma unroll
        for (int ai = 0; ai < 2; ++ai)
#pragma unroll
            for (int m = 0; m < 4; ++m) { const int rl = ai * 128 + wr * 64 + m * 16 + fr; const size_t row = (size_t)u.pmo * 256 + rl; const float rs = rsl[u.pm * 256 + rl];
#pragma unroll
                for (int n = 0; n < 2; ++n) { const f32x4 gt = acc[ai][0][m][n] * rs, up = acc[ai][1][m][n] * rs; f32x4 o;
                    o.x = gt.x * sigmoidf_(gt.x) * up.x; o.y = gt.y * sigmoidf_(gt.y) * up.y; o.z = gt.z * sigmoidf_(gt.z) * up.z; o.w = gt.w * sigmoidf_(gt.w) * up.w;
                    { bf16* hp = H + row * 512 + u.pnl * 128 + wc * 32 + n * 16 + 4 * fq; const v2u hv = pk4(o); asm volatile("global_store_dwordx2 %0, %1, off sc1" :: "v"(hp), "v"(hv) : "memory"); } } }
        asm volatile("s_waitcnt vmcnt(0)" ::: "memory"); __builtin_amdgcn_s_barrier(); asm volatile("" ::: "memory");
        if (threadIdx.x == 0) __hip_atomic_fetch_add(dep + 16 * u.pmo, 1u, __ATOMIC_RELAXED, __HIP_MEMORY_SCOPE_AGENT);
    }
};
struct EpiPle {
    static constexpr bool PERM = false;
    const bf16* x2; const bf16* Eraw; const float* rse; const float* gpn; bf16* O;
    __device__ __forceinline__ void operator()(const f32x4 (&acc)[2][2][4][2], const pg8::Unit& u, int wr, int wc, int fr, int fq) const {
        EPI_LOOP_BEGIN
            const f32x4 e = unpk4(*(const v2u*)(Eraw + row * D + col)); const f32x4 g = *(const f32x4*)(gpn + col); const float rs = rse[row]; f32x4 o = unpk4(*(const v2u*)(x2 + row * D + col));
            o.x += sigmoidf_(a.x) * e.x * rs * g.x; o.y += sigmoidf_(a.y) * e.y * rs * g.y; o.z += sigmoidf_(a.z) * e.z * rs * g.z; o.w += sigmoidf_(a.w) * e.w * rs * g.w;
            *(v2u*)(O + row * D + col) = pk4(o);
        EPI_LOOP_END
    }
};

struct EpiPleNorm {
    static constexpr bool PERM = false;
    const bf16* x2; const bf16* Eraw; const float* rse; const float* gpn; const float* rs3; const float* gfin; float* out; float* xbuf; unsigned* cnt; LAS float* ldsx;
    __device__ __forceinline__ void operator()(const f32x4 (&acc_)[2][2][4][2], const pg8::Unit& u_, int wr, int wc, int fr, int fq) const {
        f32x4 (&acc)[2][2][4][2] = const_cast<f32x4 (&)[2][2][4][2]>(acc_);
        pg8::Unit u = u_; asm volatile("" : "+s"(u.pmo), "+s"(u.pnl)); asm volatile("" : "+v"(fr), "+v"(fq)); asm volatile("" : "+s"(wr), "+s"(wc));
        int tid = threadIdx.x; asm volatile("" : "+v"(tid)); const int lane = tid & 63, wid = __builtin_amdgcn_readfirstlane(tid >> 6);
        LAS float* Pl = ldsx; LAS float* Sl = ldsx + 1024; LAS unsigned* flag = (LAS unsigned*)(ldsx + 1280);
#pragma unroll
        for (int ai = 0; ai < 2; ++ai)
#pragma unroll
            for (int m = 0; m < 4; ++m) { if (m == 0 || m == 2) asm volatile("" ::: "memory"); const int rl = ai * 128 + wr * 64 + m * 16 + fr; const size_t row = (size_t)u.pmo * 256 + rl;
                float ss = 0.f; const float r3 = rs3[row], re = rse[row];
#pragma unroll
                for (int bj = 0; bj < 2; ++bj)
#pragma unroll
                    for (int n = 0; n < 2; ++n) { const int col = u.pnl * 256 + bj * 128 + wc * 32 + n * 16 + 4 * fq; const f32x4 a = acc[ai][bj][m][n];
                        const f32x4 e = unpk4(*(const v2u*)(Eraw + row * D + col)) * re * *(const f32x4*)(gpn + col); f32x4 o = unpk4(*(const v2u*)(x2 + row * D + col));
                        o.x += sigmoidf_(a.x * r3) * e.x; o.y += sigmoidf_(a.y * r3) * e.y; o.z += sigmoidf_(a.z * r3) * e.z; o.w += sigmoidf_(a.w * r3) * e.w;
                        acc[ai][bj][m][n] = o; ss += (o.x * o.x + o.y * o.y) + (o.z * o.z + o.w * o.w); }
                ss += __shfl_xor(ss, 16); ss += __shfl_xor(ss, 32);
                if (fq == 0) Pl[rl * 4 + wc] = ss; }
        asm volatile("s_waitcnt lgkmcnt(0)" ::: "memory"); __builtin_amdgcn_s_barrier(); asm volatile("" ::: "memory");
        if (tid < 256) { const float tot = (Pl[tid * 4 + 0] + Pl[tid * 4 + 1]) + (Pl[tid * 4 + 2] + Pl[tid * 4 + 3]);
            __hip_atomic_store(xbuf + ((size_t)u.pmo * 256 + tid) * 4 + u.pnl, tot, __ATOMIC_RELAXED, __HIP_MEMORY_SCOPE_AGENT);
            asm volatile("s_waitcnt vmcnt(0)" ::: "memory");
            if (lane == 0) __hip_atomic_fetch_add(cnt + 64 * u.pmo, 1u, __ATOMIC_RELAXED, __HIP_MEMORY_SCOPE_AGENT); }
        if (wid == 0) {
            unsigned spins = 0;
            while ((unsigned)__builtin_amdgcn_readfirstlane((int)__hip_atomic_load(cnt + 64 * u.pmo, __ATOMIC_RELAXED, __HIP_MEMORY_SCOPE_AGENT)) < 16u) { __builtin_amdgcn_s_sleep(2); if (++spins > (1u << 22)) break; }
            __builtin_amdgcn_fence(__ATOMIC_ACQUIRE, "agent");
            if (lane == 0) flag[0] = 1u; }
        asm volatile("s_waitcnt vmcnt(0) lgkmcnt(0)" ::: "memory"); __builtin_amdgcn_s_barrier(); asm volatile("" ::: "memory");
        if (tid < 256) { const float* sp = xbuf + ((size_t)u.pmo * 256 + tid) * 4; float tot = 0.f;
#pragma unroll
            for (int t = 0; t < 4; ++t) tot += __hip_atomic_load(sp + t, __ATOMIC_RELAXED, __HIP_MEMORY_SCOPE_AGENT);
            Sl[tid] = 1.0f / sqrtf(tot * (1.f / D) + NORM_EPS); }
        asm volatile("s_waitcnt vmcnt(0) lgkmcnt(0)" ::: "memory"); __builtin_amdgcn_s_barrier(); asm volatile("" ::: "memory");
#pragma unroll
        for (int ai = 0; ai < 2; ++ai)
#pragma unroll
            for (int m = 0; m < 4; ++m) { const int rl = ai * 128 + wr * 64 + m * 16 + fr; const size_t row = (size_t)u.pmo * 256 + rl; const float rs = Sl[rl];
#pragma unroll
                for (int bj = 0; bj < 2; ++bj)
#pragma unroll
                    for (int n = 0; n < 2; ++n) { const int col = u.pnl * 256 + bj * 128 + wc * 32 + n * 16 + 4 * fq; *(f32x4*)(out + row * D + col) = acc[ai][bj][m][n] * rs * *(const f32x4*)(gfin + col); } }
    }
};

__device__ __forceinline__ float gelu_tanh(float x) { const float u = 0.7978845608028654f * (x + 0.044715f * x * x * x); const float t = 1.0f - 2.0f * __builtin_amdgcn_rcpf(__expf(2.0f * u) + 1.0f); return 0.5f * x * (1.0f + t); }

__device__ __forceinline__ void compress_wg_task(Frame& F, int idx) {
    const int kv = idx & 1, tile8 = (idx >> 1) & 7, bg = idx >> 4, b = bg >> 1, g = bg & 1;
    const int fr = F.lane & 15, fq = F.lane >> 4;
    const bf16* z = (const bf16*)(F.ws + WS_Z);
    const bf16* w1T = (const bf16*)(F.ws + WS_SMALLW + (kv ? SW_CV1 : SW_CK1));
    const bf16* w2T = (const bf16*)(F.ws + WS_SMALLW + (kv ? SW_CV2 : SW_CK2));
    const float* pos = kv ? F.ap->in[16] : F.ap->in[15];
    const int j0 = 16 * tile8; int j = j0 + fr; const bool jvalid = j < 127; if (!jvalid) j = 126;
    const bf16* zb = z + ((size_t)b * SEQ + 16 * j) * NZ + (kv ? ZC_VC : ZC_KC) + g * 64;
    v4u zr[8]; f32x4 p0[8], p1[8]; bf16x8 aop[8][4];
#pragma unroll
    for (int i = 0; i < 8; ++i) { const int ks = 8 * F.wave + i, l = ks >> 1, d = 32 * (ks & 1) + 8 * fq;
        zr[i] = *(const v4u*)(zb + (size_t)l * NZ + d); p0[i] = *(const f32x4*)(pos + l * 64 + d); p1[i] = *(const f32x4*)(pos + l * 64 + d + 4);
#pragma unroll
        for (int mt = 0; mt < 4; ++mt) aop[i][mt] = *(const bf16x8*)(w1T + (size_t)(16 * mt + fr) * 2048 + 32 * ks + 8 * fq); }
    f32x4 acc[4];
#pragma unroll
    for (int mt = 0; mt < 4; ++mt) acc[mt] = (f32x4){0.f, 0.f, 0.f, 0.f};
#pragma unroll
    for (int i = 0; i < 8; ++i) {
        float f[8]; unpk8(zr[i], f);
        v4u bb; bb.x = pk2(f[0] + p0[i].x, f[1] + p0[i].y); bb.y = pk2(f[2] + p0[i].z, f[3] + p0[i].w); bb.z = pk2(f[4] + p1[i].x, f[5] + p1[i].y); bb.w = pk2(f[6] + p1[i].z, f[7] + p1[i].w);
        const bf16x8 bop = __builtin_bit_cast(bf16x8, bb);
#pragma unroll
        for (int mt = 0; mt < 4; ++mt) acc[mt] = MFMA16(aop[i][mt], bop, acc[mt]);
    }
    LAS float* red = (LAS float*)F.lds;
    __syncthreads();
#pragma unroll
    for (int mt = 0; mt < 4; ++mt) *(LAS f32x4*)(red + ((F.wave * 4 + mt) * 64 + F.lane) * 4) = acc[mt];
    LDS_WAIT(); __syncthreads();
    if (F.wave != 0) return;
#pragma unroll
    for (int mt = 0; mt < 4; ++mt) { f32x4 t = (f32x4){0.f, 0.f, 0.f, 0.f};
#pragma unroll
        for (int w = 0; w < 8; ++w) t = t + *(const LAS f32x4*)(red + ((w * 4 + mt) * 64 + F.lane) * 4);
        acc[mt] = t; }
    bf16x8 hb[2];
#pragma unroll
    for (int s2 = 0; s2 < 2; ++s2) { v4u w; const f32x4 a0 = acc[2 * s2], a1 = acc[2 * s2 + 1];
        w.x = pk2(gelu_tanh(a0.x), gelu_tanh(a0.y)); w.y = pk2(gelu_tanh(a0.z), gelu_tanh(a0.w)); w.z = pk2(gelu_tanh(a1.x), gelu_tanh(a1.y)); w.w = pk2(gelu_tanh(a1.z), gelu_tanh(a1.w));
        hb[s2] = __builtin_bit_cast(bf16x8, w); }
    bf16* kcmp = (bf16*)(F.ws + WS_KCMP); bf16* vcmpT = (bf16*)(F.ws + WS_KCMP + 512 * 1024);
#pragma unroll
    for (int ntl = 0; ntl < 4; ++ntl) {
        f32x4 o = (f32x4){0.f, 0.f, 0.f, 0.f};
#pragma unroll
        for (int s2 = 0; s2 < 2; ++s2) { const bf16* wp = w2T + (size_t)(16 * ntl + fr) * 64 + 32 * s2 + 4 * fq; const v2u lo = *(const v2u*)wp, hi = *(const v2u*)(wp + 16);
            v4u aw; aw.x = lo.x; aw.y = lo.y; aw.z = hi.x; aw.w = hi.y; o = MFMA16(__builtin_bit_cast(bf16x8, aw), hb[s2], o); }
        if (!jvalid) o = (f32x4){0.f, 0.f, 0.f, 0.f};
        const int jj = j0 + fr, n = 16 * ntl + 4 * fq;
        if (kv == 0) *(v2u*)(kcmp + ((size_t)bg * 128 + jj) * 64 + n) = pk4(o);
        else { const v2u w = pk4(o); bf16* vp = vcmpT + ((size_t)bg * 64 + n) * 128 + jj; vp[0] = (bf16)(w.x & 0xffff); vp[128] = (bf16)(w.x >> 16); vp[256] = (bf16)(w.y & 0xffff); vp[384] = (bf16)(w.y >> 16); }
    }
}
__device__ __forceinline__ void zgate_task(Frame& F, int tile) {
    const int fr = F.lane & 15, fq = F.lane >> 4, m0 = tile * 16;
    const bf16* XN = (const bf16*)(F.ws + WS_XN); const bf16* gw = (const bf16*)(F.ws + WS_SMALLW + SW_GATEW);
    f32x4 acc[2] = {(f32x4){0.f, 0.f, 0.f, 0.f}, (f32x4){0.f, 0.f, 0.f, 0.f}};
#pragma unroll 16
    for (int ks = 0; ks < 32; ++ks) {
        const bf16x8 bop = *(const bf16x8*)(XN + (size_t)(m0 + fr) * D + 32 * ks + 8 * fq);
#pragma unroll
        for (int ct = 0; ct < 2; ++ct) { const bf16x8 aop = *(const bf16x8*)(gw + (size_t)(16 * ct + fr) * D + 32 * ks + 8 * fq); acc[ct] = MFMA16(aop, bop, acc[ct]); }
    }
    float* zg = (float*)(F.ws + WS_ZGATE);
#pragma unroll
    for (int ct = 0; ct < 2; ++ct) *(f32x4*)(zg + (size_t)(m0 + fr) * 32 + 16 * ct + 4 * fq) = acc[ct];
}
__device__ __forceinline__ void vt_task(Frame& F, int idx) {
    const int which = idx & 1, blk = (idx >> 1) & 31, bg = idx >> 6, b = bg >> 1, g = bg & 1;
    const bf16* z = (const bf16*)(F.ws + WS_Z);
    bf16* vT = (bf16*)(F.ws + (which ? WS_VWT : WS_VST));
    const int t = 64 * blk + F.lane;
    const bf16* src = z + ((size_t)b * SEQ + t) * NZ + (which ? ZC_VW : ZC_VS) + g * 64;
#pragma unroll
    for (int dc = 0; dc < 8; ++dc) { const v4u w = *(const v4u*)(src + 8 * dc); bf16* dst = vT + ((size_t)bg * 64 + 8 * dc) * SEQ + t;
        dst[0 * SEQ] = (bf16)(w.x & 0xffff); dst[1 * SEQ] = (bf16)(w.x >> 16); dst[2 * SEQ] = (bf16)(w.y & 0xffff); dst[3 * SEQ] = (bf16)(w.y >> 16);
        dst[4 * SEQ] = (bf16)(w.z & 0xffff); dst[5 * SEQ] = (bf16)(w.z >> 16); dst[6 * SEQ] = (bf16)(w.w & 0xffff); dst[7 * SEQ] = (bf16)(w.w >> 16); }
}
__device__ __forceinline__ void alora_task4(Frame& F, int mb) {
    const bf16* z = (const bf16*)(F.ws + WS_Z); bf16* AL = (bf16*)(F.ws + WS_PBF);
    const int l = F.lane;
    const f32x4 mu = *(const f32x4*)(F.ap->in[4] + ZC_W + 4 * l);
    v2u cw[4], pw[4];
#pragma unroll
    for (int u = 0; u < 4; ++u) { const int m = mb + u * F.NGW; const int t = m & (SEQ - 1); cw[u] = *(const v2u*)(z + (size_t)m * NZ + ZC_W + 4 * l); pw[u] = *(const v2u*)(z + (size_t)(t > 0 ? m - 1 : m) * NZ + ZC_W + 4 * l); }
#pragma unroll
    for (int u = 0; u < 4; ++u) { const int m = mb + u * F.NGW; const int t = m & (SEQ - 1);
        const f32x4 cur = unpk4(cw[u]); const f32x4 prev = unpk4(pw[u]) * (t > 0 ? 1.0f : 0.0f);
        f32x4 s = cur + (prev - cur) * mu;
        if (l < 16) { s.x = tanhf(s.x); s.y = tanhf(s.y); s.z = tanhf(s.z); s.w = tanhf(s.w); }
        else if (l >= 32) { s.x = sigmoidf_(s.x); s.y = sigmoidf_(s.y); s.z = sigmoidf_(s.z); s.w = sigmoidf_(s.w); }
        *(v2u*)(AL + (size_t)m * 256 + 4 * l) = pk4(s); }
}
__device__ __forceinline__ void p2_prep(Frame& F) {
    constexpr int T1 = 1024, T2 = T1 + 1024;
    for (int it = F.vcu; it < 256; it += F.G) compress_wg_task(F, it);
    for (int task = F.gw; task < T2; task += F.NGW) {
        if (task < T1) zgate_task(F, task);
        else vt_task(F, task - T1);
    }
    for (int base = F.gw; base < M; base += 4 * F.NGW) alora_task4(F, base);
}

__device__ __forceinline__ void ld16(const bf16* p, float (&f)[16]) { float a[8], b[8]; unpk8(*(const v4u*)p, a); unpk8(*(const v4u*)(p + 8), b);
#pragma unroll
    for (int i = 0; i < 8; ++i) { f[i] = a[i]; f[8 + i] = b[i]; } }
__device__ __forceinline__ void ld16f(const float* p, float (&f)[16]) {
#pragma unroll
    for (int q = 0; q < 4; ++q) { const f32x4 v = *(const f32x4*)(p + 4 * q); f[4 * q] = v.x; f[4 * q + 1] = v.y; f[4 * q + 2] = v.z; f[4 * q + 3] = v.w; } }
__device__ __forceinline__ void st16(bf16* p, const float (&f)[16]) { v4u a, b; a.x = pk2(f[0], f[1]); a.y = pk2(f[2], f[3]); a.z = pk2(f[4], f[5]); a.w = pk2(f[6], f[7]); b.x = pk2(f[8], f[9]); b.y = pk2(f[10], f[11]); b.z = pk2(f[12], f[13]); b.w = pk2(f[14], f[15]);
    *(v4u*)p = a; *(v4u*)(p + 8) = b; }
struct PrepW { bf16x8 w[2], a[2], g[4]; };
constexpr int PW_OFF = 32768, PW_P64 = 144, PW_P128 = 272, PW_A_OFF = PW_OFF + 64 * PW_P64, PW_G_OFF = PW_A_OFF + 64 * PW_P64;
__device__ __forceinline__ void prep_stage_w(Frame& F, int h) {
    const bf16* w2T = (const bf16*)(F.ws + WS_SMALLW + SW_W2T) + (size_t)h * 64 * 64; const bf16* a2T = (const bf16*)(F.ws + WS_SMALLW + SW_A2T) + (size_t)h * 64 * 64; const bf16* g2T = (const bf16*)(F.ws + WS_SMALLW + SW_G2T) + (size_t)h * 64 * 128;
    { const int R = F.tid >> 3, c = F.tid & 7, slot = ((R >> 2) & 3) * 16 + (R >> 4) * 4 + (R & 3);
      *(LAS v4u*)(F.lds + PW_OFF + slot * PW_P64 + c * 16) = *(const v4u*)(w2T + R * 64 + c * 8); *(LAS v4u*)(F.lds + PW_A_OFF + slot * PW_P64 + c * 16) = *(const v4u*)(a2T + R * 64 + c * 8); }
#pragma unroll
    for (int i = 0; i < 2; ++i) { const int id = F.tid + 512 * i, R = id >> 4, c = id & 15, slot = ((R >> 2) & 3) * 16 + (R >> 4) * 4 + (R & 3);
      *(LAS v4u*)(F.lds + PW_G_OFF + slot * PW_P128 + c * 16) = *(const v4u*)(g2T + R * 128 + c * 8); }
}
__device__ __forceinline__ void prep_ldw(PrepW& W, const LAS unsigned char* lds, int n, int fr, int fq) {
#pragma unroll
    for (int ks = 0; ks < 2; ++ks) { W.w[ks] = *(const LAS bf16x8*)(lds + PW_OFF + (n * 16 + fr) * PW_P64 + 64 * ks + 16 * fq); W.a[ks] = *(const LAS bf16x8*)(lds + PW_A_OFF + (n * 16 + fr) * PW_P64 + 64 * ks + 16 * fq); }
#pragma unroll
    for (int ks = 0; ks < 4; ++ks) W.g[ks] = *(const LAS bf16x8*)(lds + PW_G_OFF + (n * 16 + fr) * PW_P128 + 64 * ks + 16 * fq);
}
__device__ __forceinline__ void ldpar(const LAS float* p, float (&f)[16]) {
#pragma unroll
    for (int q = 0; q < 4; ++q) { const f32x4 v = *(const LAS f32x4*)(p + 4 * q); f[4 * q] = v.x; f[4 * q + 1] = v.y; f[4 * q + 2] = v.z; f[4 * q + 3] = v.w; } }
__device__ __forceinline__ void rwkv_prep_task(Frame& F, int task, const LAS float* par) {
    const int h = task & 7, m0 = (task >> 3) * 16, fr = F.lane & 15, fq = F.lane >> 4, m = m0 + fr, t = m & (SEQ - 1);
    const bf16* z = (const bf16*)(F.ws + WS_Z); const bf16* AL = (const bf16*)(F.ws + WS_PBF);
    bf16* vbuf = (bf16*)F.out; bf16* gbuf = (bf16*)(F.ws + WS_G);
    const int cl = h * 64 + 16 * fq;
    bf16x8 bw[2], ba[2], bgf[4];
    const bf16* alr = AL + (size_t)m * 256 + 8 * fq;
#pragma unroll
    for (int ks = 0; ks < 2; ++ks) { bw[ks] = *(const bf16x8*)(alr + 32 * ks); ba[ks] = *(const bf16x8*)(alr + 64 + 32 * ks); }
#pragma unroll
    for (int ks = 0; ks < 4; ++ks) bgf[ks] = *(const bf16x8*)(alr + 128 + 32 * ks);
    const bf16* zc = z + (size_t)m * NZ + cl; const bf16* zp = (t > 0) ? zc - NZ : zc;
    v4u zraw[6][2];
#pragma unroll
    for (int q = 0; q < 3; ++q) { zraw[q][0] = *(const v4u*)(zc + 512 * q); zraw[q][1] = *(const v4u*)(zc + 512 * q + 8); zraw[3 + q][0] = *(const v4u*)(zp + 512 * q); zraw[3 + q][1] = *(const v4u*)(zp + 512 * q + 8); }
    __builtin_amdgcn_sched_barrier(0);
    float ev[16], av[16], gv[16];
#define PREP_MM(W, n) do { f32x4 accw = (f32x4){0.f, 0.f, 0.f, 0.f}, acca = accw, accg = accw; \
        _Pragma("unroll") for (int ks = 0; ks < 2; ++ks) { accw = MFMA16(W.w[ks], bw[ks], accw); acca = MFMA16(W.a[ks], ba[ks], acca); } \
        _Pragma("unroll") for (int ks = 0; ks < 4; ++ks) accg = MFMA16(W.g[ks], bgf[ks], accg); \
        _Pragma("unroll") for (int r = 0; r < 4; ++r) { ev[4 * (n) + r] = accw[r]; av[4 * (n) + r] = acca[r]; gv[4 * (n) + r] = accg[r]; } } while (0)
    { PrepW Wa, Wb;
      prep_ldw(Wa, F.lds, 0, fr, fq); prep_ldw(Wb, F.lds, 1, fr, fq); PREP_MM(Wa, 0); PREP_MM(Wb, 1);
      prep_ldw(Wa, F.lds, 2, fr, fq); prep_ldw(Wb, F.lds, 3, fr, fq); PREP_MM(Wa, 2); PREP_MM(Wb, 3); }
    float zr[16], zk[16], zv[16], tmp[16];
    const float pm = (t > 0) ? 1.0f : 0.0f;
    {   float c[16], p[16];
#define PREP_UNP(q, dst) do { float a_[8], b_[8]; unpk8(zraw[q][0], a_); unpk8(zraw[q][1], b_); _Pragma("unroll") for (int i = 0; i < 8; ++i) { dst[i] = a_[i]; dst[8 + i] = b_[i]; } } while (0)
        PREP_UNP(0, c); PREP_UNP(3, p); ldpar(par + 0 * 64 + 16 * fq, tmp);
#pragma unroll
        for (int e = 0; e < 16; ++e) zr[e] = c[e] + (p[e] * pm - c[e]) * tmp[e];
        PREP_UNP(1, c); PREP_UNP(4, p); ldpar(par + 1 * 64 + 16 * fq, tmp);
#pragma unroll
        for (int e = 0; e < 16; ++e) zk[e] = c[e] + (p[e] * pm - c[e]) * tmp[e];
        PREP_UNP(2, c); PREP_UNP(5, p); ldpar(par + 2 * 64 + 16 * fq, tmp);
#pragma unroll
        for (int e = 0; e < 16; ++e) zv[e] = c[e] + (p[e] * pm - c[e]) * tmp[e];
    }
    float kkr[16]; float ss = 0.f;
    ldpar(par + 3 * 64 + 16 * fq, tmp);
#pragma unroll
    for (int e = 0; e < 16; ++e) { const float x = -(tmp[e] + ev[e]); const float sp = fmaxf(x, 0.f) + __logf(1.0f + __expf(-fabsf(x))); ev[e] = __expf(-sp - 0.5f); }
    ldpar(par + 4 * 64 + 16 * fq, tmp);
#pragma unroll
    for (int e = 0; e < 16; ++e) av[e] = sigmoidf_(tmp[e] + av[e]);
    ldpar(par + 5 * 64 + 16 * fq, tmp);
#pragma unroll
    for (int e = 0; e < 16; ++e) { kkr[e] = zk[e] * tmp[e]; ss += kkr[e] * kkr[e]; }
    ss += __shfl_xor(ss, 16); ss += __shfl_xor(ss, 32);
    const float inv = 1.0f / fmaxf(sqrtf(ss), 1e-12f);
    ldpar(par + 6 * 64 + 16 * fq, tmp);
    float kp[16], kka[16];
#pragma unroll
    for (int e = 0; e < 16; ++e) { kkr[e] *= inv; kka[e] = kkr[e] * av[e]; kp[e] = zk[e] * (1.0f + (av[e] - 1.0f) * tmp[e]); }
    st16(vbuf + (size_t)m * 512 + cl, zv); st16(gbuf + (size_t)m * 512 + cl, gv);
    { ldpar(par + 7 * 64 + 16 * fq, tmp);
      float bsum = 0.f;
#pragma unroll
      for (int e = 0; e < 16; ++e) bsum += zr[e] * kp[e] * tmp[e];
      bsum += __shfl_xor(bsum, 16); bsum += __shfl_xor(bsum, 32);
      if (fq == 0) ((float*)(F.ws + WS_BONUS))[(size_t)m * 8 + h] = bsum; }
    asm volatile("" ::: "memory");
    unsigned char* rec = F.ws + WS_S + (size_t)task * CH_REC;
    bf16x8 Pb[2], Qb[2], Kb[2], Rb[2];
#pragma unroll
    for (int ks = 0; ks < 2; ++ks) {
        float Pm[8], Qm[8], Km[8], Rm[8], acv[8];
#pragma unroll
        for (int e8 = 0; e8 < 8; ++e8) { const int e = 8 * ks + e8;
            float cs = ev[e]; cs += dppf<0x111>(cs); cs += dppf<0x112>(cs); cs += dppf<0x114>(cs); cs += dppf<0x118>(cs);
            const float A = __expf(-cs), Ap = __expf(ev[e] - cs), iA = __expf(cs);
            Pm[e8] = kkr[e] * Ap; Qm[e8] = -kka[e] * iA; Km[e8] = kp[e] * iA; Rm[e8] = zr[e] * A; acv[e8] = A; }
        v4u w;
        w.x = pk2(Pm[0], Pm[1]); w.y = pk2(Pm[2], Pm[3]); w.z = pk2(Pm[4], Pm[5]); w.w = pk2(Pm[6], Pm[7]); Pb[ks] = __builtin_bit_cast(bf16x8, w);
        w.x = pk2(Qm[0], Qm[1]); w.y = pk2(Qm[2], Qm[3]); w.z = pk2(Qm[4], Qm[5]); w.w = pk2(Qm[6], Qm[7]); Qb[ks] = __builtin_bit_cast(bf16x8, w);
        w.x = pk2(Km[0], Km[1]); w.y = pk2(Km[2], Km[3]); w.z = pk2(Km[4], Km[5]); w.w = pk2(Km[6], Km[7]); Kb[ks] = __builtin_bit_cast(bf16x8, w);
        w.x = pk2(Rm[0], Rm[1]); w.y = pk2(Rm[2], Rm[3]); w.z = pk2(Rm[4], Rm[5]); w.w = pk2(Rm[6], Rm[7]); Rb[ks] = __builtin_bit_cast(bf16x8, w);
        if (fr == 15) { *(f32x4*)(rec + CH_AC + (16 * fq + 8 * ks) * 4) = (f32x4){acv[0], acv[1], acv[2], acv[3]}; *(f32x4*)(rec + CH_AC + (16 * fq + 8 * ks + 4) * 4) = (f32x4){acv[4], acv[5], acv[6], acv[7]}; }
    }
    *(v4u*)(rec + CH_P + fr * CH_PP + 32 * fq) = __builtin_bit_cast(v4u, Pb[0]); *(v4u*)(rec + CH_P + fr * CH_PP + 32 * fq + 16) = __builtin_bit_cast(v4u, Pb[1]);
    *(v4u*)(rec + CH_R + fr * CH_PP + 32 * fq) = __builtin_bit_cast(v4u, Rb[0]); *(v4u*)(rec + CH_R + fr * CH_PP + 32 * fq + 16) = __builtin_bit_cast(v4u, Rb[1]);
    *(v4u*)(rec + CH_Q + (fq * 16 + fr) * 32) = __builtin_bit_cast(v4u, Qb[0]); *(v4u*)(rec + CH_Q + (fq * 16 + fr) * 32 + 16) = __builtin_bit_cast(v4u, Qb[1]);
    *(v4u*)(rec + CH_K + (fq * 16 + fr) * 32) = __builtin_bit_cast(v4u, Kb[0]); *(v4u*)(rec + CH_K + (fq * 16 + fr) * 32 + 16) = __builtin_bit_cast(v4u, Kb[1]);
    f32x4 gqp = (f32x4){0.f, 0.f, 0.f, 0.f}, gkp = gqp, gqr = gqp, gkr = gqp;
#pragma unroll
    for (int ks = 0; ks < 2; ++ks) { gqp = MFMA16(Qb[ks], Pb[ks], gqp); gkp = MFMA16(Kb[ks], Pb[ks], gkp); gqr = MFMA16(Qb[ks], Rb[ks], gqr); gkr = MFMA16(Kb[ks], Rb[ks], gkr); }
#pragma unroll
    for (int rg = 0; rg < 4; ++rg) { const int s = 4 * fq + rg; if (!(s < fr)) { gqp[rg] = 0.f; gkp[rg] = 0.f; } if (!(s <= fr)) { gqr[rg] = 0.f; gkr[rg] = 0.f; } }
    *(v2u*)(rec + CH_G + 0 * 512 + (fr * 16 + 4 * fq) * 2) = pk4(gkp);
    *(v2u*)(rec + CH_G + 2 * 512 + (fr * 16 + 4 * fq) * 2) = pk4(gqr);
    *(v2u*)(rec + CH_G + 3 * 512 + (fr * 16 + 4 * fq) * 2) = pk4(gkr);
    LAS float* Nl = (LAS float*)(F.lds + F.wave * 4096);
#pragma unroll
    for (int rg = 0; rg < 4; ++rg) Nl[(4 * fq + rg) * 20 + fr] = gqp[rg];
    LDS_WAIT(); __builtin_amdgcn_wave_barrier(); asm volatile("" ::: "memory");
    float Tc[16];
#pragma unroll
    for (int s = 15; s >= 0; --s) {
        float acc = 0.f;
#pragma unroll
        for (int q4 = 0; q4 < 4; ++q4) if (4 * q4 + 3 > s) { const f32x4 nv = *(const LAS f32x4*)(Nl + s * 20 + 4 * q4);
#pragma unroll
            for (int u = 0; u < 4; ++u) if (4 * q4 + u > s) acc += nv[u] * Tc[4 * q4 + u]; }
        Tc[s] = (s == fr) ? 1.0f : acc; }
    { f32x4 tv;
#pragma unroll
      for (int u = 0; u < 4; ++u) tv[u] = fq == 0 ? Tc[u] : (fq == 1 ? Tc[4 + u] : (fq == 2 ? Tc[8 + u] : Tc[12 + u]));
      *(v2u*)(rec + CH_G + 1 * 512 + (fr * 16 + 4 * fq) * 2) = pk4(tv); }
    LDS_WAIT(); __builtin_amdgcn_wave_barrier(); asm volatile("" ::: "memory");
#undef PREP_MM
#undef PREP_UNP
}
__device__ __forceinline__ void prep_fill_par(Frame& F, LAS float* par, int h) {
    const int l = F.lane; const float* mu = F.ap->in[4];
    par[0 * 64 + l] = mu[ZC_R + h * 64 + l]; par[1 * 64 + l] = mu[ZC_K + h * 64 + l]; par[2 * 64 + l] = mu[ZC_V + h * 64 + l];
    par[3 * 64 + l] = F.ap->in[5][h * 64 + l]; par[4 * 64 + l] = F.ap->in[7][h * 64 + l]; par[5 * 64 + l] = F.ap->in[10][h * 64 + l]; par[6 * 64 + l] = F.ap->in[11][h * 64 + l]; par[7 * 64 + l] = F.ap->in[12][h * 64 + l];
    LDS_WAIT(); __builtin_amdgcn_wave_barrier(); asm volatile("" ::: "memory");
}

__device__ __forceinline__ float nsa_slope(int g, int r) { return __uint_as_float((unsigned)(127 - (g * 4 + r + 1)) << 23); }

constexpr int CMP_KC_OFF = 32768, CMP_KP = 144, CMP_VC_OFF = CMP_KC_OFF + 128 * CMP_KP, CMP_VP = 264;
__device__ __forceinline__ void nsa_cmp_stage(Frame& F, int bg) {
    const bf16* kcmp = (const bf16*)(F.ws + WS_KCMP) + (size_t)bg * 128 * 64; const bf16* vcmpT = (const bf16*)(F.ws + WS_KCMP + 512 * 1024) + (size_t)bg * 64 * 128;
    v4u a[2], v[2];
#pragma unroll
    for (int i = 0; i < 2; ++i) { const int id = F.tid + 512 * i; a[i] = *(const v4u*)(kcmp + (size_t)(id >> 3) * 64 + (id & 7) * 8); v[i] = *(const v4u*)(vcmpT + (size_t)(id >> 4) * 128 + (id & 15) * 8); }
#pragma unroll
    for (int i = 0; i < 2; ++i) { const int id = F.tid + 512 * i; *(LAS v4u*)(F.lds + CMP_KC_OFF + (id >> 3) * CMP_KP + (id & 7) * 16) = a[i]; *(LAS v4u*)(F.lds + CMP_VC_OFF + (id >> 4) * CMP_VP + (id & 15) * 16) = v[i]; }
}
template <int ABL>
__device__ __forceinline__ void nsa_cmp_task(Frame& F, int task) {
    const int tile = task & 127, bg = task >> 7, b = bg >> 1, g = bg & 1;
    const int fr = F.lane & 15, fq = F.lane >> 4, t = tile * 16 + fr, m = b * SEQ + t;
    const bf16* z = (const bf16*)(F.ws + WS_Z);
    const float* zg = (const float*)(F.ws + WS_ZGATE); const float* gb = F.ap->in[21];
    bf16* Y = (bf16*)(F.ws + WS_YB);
    bf16x8 qall[4][2]; float gl[4];
#pragma unroll
    for (int r = 0; r < 4; ++r) { const bf16* qp = z + (size_t)m * NZ + ZC_Q + (g * 4 + r) * 64 + 8 * fq; qall[r][0] = *(const bf16x8*)qp; qall[r][1] = *(const bf16x8*)(qp + 32);
        gl[r] = zg[(size_t)m * 32 + (g * 4 + r) * 3 + 0] + gb[(g * 4 + r) * 3 + 0]; }
    const LAS unsigned char* kc = F.lds + CMP_KC_OFF + fr * CMP_KP + 16 * fq; const LAS unsigned char* vc = F.lds + CMP_VC_OFF + fr * CMP_VP + 8 * fq;
    const int tv = t - 31 - 64 * fq; const float tb = (float)t - 15.5f - 64.0f * (float)fq;
    float impl[8], imp3[8];
#pragma unroll
    for (int kt = 0; kt < 8; ++kt) { impl[kt] = 0.f; imp3[kt] = 0.f; }
#pragma unroll
    for (int r = 0; r < 4; ++r) {
        const float slope = nsa_slope(g, r);
        const bf16x8 q0 = qall[r][0], q1 = qall[r][1];
        float s[8][4]; float mx = -1e30f;
#pragma unroll
        for (int kt = 0; kt < 8; ++kt) {
            f32x4 a = (f32x4){0.f, 0.f, 0.f, 0.f};
            a = MFMA16(*(const LAS bf16x8*)(kc + 16 * kt * CMP_KP), q0, a); a = MFMA16(*(const LAS bf16x8*)(kc + 16 * kt * CMP_KP + 64), q1, a);
#pragma unroll
            for (int rg = 0; rg < 4; ++rg) { const bool valid = ((256 * kt + 16 * rg) <= tv);
                const float sc = a[rg] * 0.125f - slope * (tb - (float)(256 * kt + 16 * rg)); s[kt][rg] = valid ? sc : -1e30f; mx = fmaxf(mx, s[kt][rg]); }
        }
        mx = fmaxf(mx, __shfl_xor(mx, 16)); mx = fmaxf(mx, __shfl_xor(mx, 32));
        float sum = 0.f;
#pragma unroll
        for (int kt = 0; kt < 8; ++kt)
#pragma unroll
            for (int rg = 0; rg < 4; ++rg) { const float p = (s[kt][rg] > -1e29f) ? __expf(s[kt][rg] - mx) : 0.f; s[kt][rg] = p; sum += p; }
        sum += __shfl_xor(sum, 16); sum += __shfl_xor(sum, 32);
        const float inv = sum > 0.f ? 1.0f / sum : 0.f;
#pragma unroll
        for (int kt = 0; kt < 8; ++kt) {
#pragma unroll
            for (int rg = 0; rg < 4; ++rg) s[kt][rg] *= inv;
            impl[kt] += s[kt][0] + s[kt][1] + s[kt][2] + 0.5f * s[kt][3]; imp3[kt] += s[kt][3]; }
        f32x4 o[4];
#pragma unroll
        for (int dt = 0; dt < 4; ++dt) o[dt] = (f32x4){0.f, 0.f, 0.f, 0.f};
#pragma unroll
        for (int s2 = 0; s2 < 4; ++s2) {
            v4u pw; pw.x = pk2(s[2 * s2][0], s[2 * s2][1]); pw.y = pk2(s[2 * s2][2], s[2 * s2][3]); pw.z = pk2(s[2 * s2 + 1][0], s[2 * s2 + 1][1]); pw.w = pk2(s[2 * s2 + 1][2], s[2 * s2 + 1][3]);
            const bf16x8 pb = __builtin_bit_cast(bf16x8, pw);
#pragma unroll
            for (int dt = 0; dt < 4; ++dt) { const LAS unsigned char* vp = vc + 16 * dt * CMP_VP + 64 * s2; const v2u lo = *(const LAS v2u*)vp, hi = *(const LAS v2u*)(vp + 32);
                v4u aw; aw.x = lo.x; aw.y = lo.y; aw.z = hi.x; aw.w = hi.y; o[dt] = MFMA16(__builtin_bit_cast(bf16x8, aw), pb, o[dt]); }
        }
        const int hh = g * 4 + r; const float gate = sigmoidf_(gl[r]);
#pragma unroll
        for (int dt = 0; dt < 4; ++dt) *(v2u*)(Y + (size_t)m * 512 + hh * 64 + 16 * dt + 4 * fq) = pk4(o[dt] * gate);
        __builtin_amdgcn_sched_barrier(0);
    }
    if (ABL == 1) return;
    LAS float* sc = (LAS float*)(F.lds + F.wave * 4096);
    float y3prev = 0.f;
#pragma unroll
    for (int kt = 0; kt < 8; ++kt) {
        const float y3 = __shfl(imp3[kt], (F.lane + 48) & 63);
        const float prev = (fq > 0) ? y3 : y3prev; y3prev = y3;
        sc[fr * 33 + 4 * kt + fq] = impl[kt] + 0.5f * prev;
    }
    LDS_WAIT(); __builtin_amdgcn_wave_barrier(); asm volatile("" ::: "memory");
    const int blk_t = t >> 6, chi = blk_t - 2;
    unsigned mask = 1u | (1u << blk_t) | (blk_t > 0 ? (1u << (blk_t - 1)) : 0u);
#pragma unroll
    for (int kt = 0; kt < 8; ++kt) {
        const int k = 4 * kt + fq;
        if (k >= 1 && k <= chi) { const float me = sc[fr * 33 + k]; int rank = 0;
            for (int k2 = 1; k2 <= chi; ++k2) { const float o = sc[fr * 33 + k2]; rank += (o > me || (o == me && k2 < k)) ? 1 : 0; }
            if (rank < 5) mask |= (1u << k); }
    }
    mask |= (unsigned)__shfl_xor((int)mask, 16); mask |= (unsigned)__shfl_xor((int)mask, 32);
    if (fq == 0) ((unsigned*)(F.ws + WS_SELMASK))[(size_t)bg * SEQ + t] = mask;
    LDS_WAIT(); __builtin_amdgcn_wave_barrier(); asm volatile("" ::: "memory");
}
__device__ __forceinline__ void p3_phase(Frame& F) {
    constexpr int T0 = 2048, T1 = T0 + 8192;
#ifdef DUP_P3A
    for (int task = F.gw; task < T0; task += F.NGW) { __syncthreads(); nsa_cmp_stage(F, task >> 7); LDS_WAIT(); __syncthreads(); nsa_cmp_task<DUP_P3A>(F, task); }
    asm volatile("" ::: "memory");
#endif
    for (int task = F.gw; task < T0; task += F.NGW) { __syncthreads(); nsa_cmp_stage(F, task >> 7); LDS_WAIT(); __syncthreads(); nsa_cmp_task<0>(F, task); }
    asm volatile("" ::: "memory");
    const int h = F.vcu & 7;
    LAS float* par = (LAS float*)(F.lds + F.wave * 4096 + 2048);
    __syncthreads();
    prep_fill_par(F, par, h); prep_stage_w(F, h);
    LDS_WAIT(); __syncthreads();
#ifdef DUP_P3B
    for (int i = F.wave; i < 32; i += 8) rwkv_prep_task(F, (((F.vcu >> 3) + 32 * i) << 3) | h, par);
    asm volatile("" ::: "memory");
#endif
    for (int i = F.wave; i < 32; i += 8) rwkv_prep_task(F, (((F.vcu >> 3) + 32 * i) << 3) | h, par);
}

constexpr int NSA_KP = 144, NSA_VP = 136, NSA_BUF = 64 * NSA_KP + 64 * NSA_VP, NSA_CTL = 2 * NSA_BUF + 1024;
struct NsaState { f32x4 O[2][4]; float mrun[2], lrun[2]; };
template <int WHICH, bool MASKED>
__device__ __forceinline__ void nsa_block(NsaState& St, const LAS unsigned char* kb_, const LAS unsigned char* vb_, const bf16x8 (&qf)[2][2], int kb, unsigned mymask, int t, int fq, float slope0) {
    const int kpos0 = 64 * kb;
    bf16x8 kf[4][2];
#pragma unroll
    for (int kt = 0; kt < 4; ++kt) { kf[kt][0] = *(const LAS bf16x8*)(kb_ + 16 * kt * NSA_KP); kf[kt][1] = *(const LAS bf16x8*)(kb_ + 16 * kt * NSA_KP + 64); }
    const bool bsel = (mymask >> kb) & 1u; const int dbase = t - 4 * fq - kpos0;
    const float fdb = (float)dbase;
    bf16x8 P[2][2];
#pragma unroll
    for (int r = 0; r < 2; ++r) {
        const float slope = r ? 0.5f * slope0 : slope0;
        float s[4][4]; float bm = -1e30f;
        float base = -slope * fdb;
        const float s1 = slope, s2_ = 2.0f * slope, s3 = 3.0f * slope, s16 = 16.0f * slope;
#pragma unroll
        for (int kt = 0; kt < 4; ++kt) { f32x4 a = (f32x4){base, base + s1, base + s2_, base + s3}; base += s16;
            a = MFMA16(kf[kt][0], qf[r][0], a); a = MFMA16(kf[kt][1], qf[r][1], a);
#pragma unroll
            for (int rg = 0; rg < 4; ++rg) {
                if (MASKED) { const int dist = dbase - (16 * kt + rg); const bool valid = bsel && dist >= 0 && (WHICH == 0 || dist < 512); s[kt][rg] = valid ? a[rg] : -1e30f; }
                else s[kt][rg] = a[rg];
                bm = fmaxf(bm, s[kt][rg]); } }
        bm = fmaxf(bm, __shfl_xor(bm, 16)); bm = fmaxf(bm, __shfl_xor(bm, 32));
        const float mnew = fmaxf(St.mrun[r], bm); const float scale = __builtin_amdgcn_exp2f(St.mrun[r] - mnew); St.mrun[r] = mnew;
        float ps = 0.f;
#pragma unroll
        for (int kt = 0; kt < 4; ++kt)
#pragma unroll
            for (int rg = 0; rg < 4; ++rg) { float p = __builtin_amdgcn_exp2f(s[kt][rg] - mnew); if (MASKED) p = (s[kt][rg] > -1e29f) ? p : 0.f; s[kt][rg] = p; ps += p; }
        St.lrun[r] = St.lrun[r] * scale + ps;
#pragma unroll
        for (int dt = 0; dt < 4; ++dt) St.O[r][dt] = St.O[r][dt] * scale;
#pragma unroll
        for (int s2 = 0; s2 < 2; ++s2) { v4u pw; pw.x = pk2(s[2 * s2][0], s[2 * s2][1]); pw.y = pk2(s[2 * s2][2], s[2 * s2][3]); pw.z = pk2(s[2 * s2 + 1][0], s[2 * s2 + 1][1]); pw.w = pk2(s[2 * s2 + 1][2], s[2 * s2 + 1][3]);
            P[r][s2] = __builtin_bit_cast(bf16x8, pw); }
    }
#pragma unroll
    for (int dt = 0; dt < 4; ++dt)
#pragma unroll
        for (int s2 = 0; s2 < 2; ++s2) { const LAS unsigned char* vp = vb_ + 16 * dt * NSA_VP + 64 * s2; const v2u lo = *(const LAS v2u*)vp, hi = *(const LAS v2u*)(vp + 32);
            v4u aw; aw.x = lo.x; aw.y = lo.y; aw.z = hi.x; aw.w = hi.y; const bf16x8 vf = __builtin_bit_cast(bf16x8, aw);
#pragma unroll
            for (int r = 0; r < 2; ++r) St.O[r][dt] = MFMA16(vf, P[r][s2], St.O[r][dt]); }
}
template <int WHICH>
__device__ __forceinline__ void nsa_wg_task(Frame& F, int item, v2u (&carry)[2][4]) {
    const int hp = item & 1, bg = item >> 5, tg = (item >> 1) & 15, b = bg >> 1, g = bg & 1;
    const int fr = F.lane & 15, fq = F.lane >> 4, tile = tg * 8 + F.wave, t0 = tile * 16, t = t0 + fr, m = b * SEQ + t;
    const int h0 = g * 4 + 2 * hp;
    const bf16* z = (const bf16*)(F.ws + WS_Z);
    const bf16* Kb = z + (size_t)b * SEQ * NZ + (WHICH ? ZC_KW : ZC_KS) + g * 64;
    const bf16* VT = (const bf16*)(F.ws + (WHICH ? WS_VWT : WS_VST)) + (size_t)bg * 64 * SEQ;
    unsigned mymask, tile_or, full; const int kb_hi = (t0 + 15) >> 6;
    if (WHICH == 0) { mymask = ((const unsigned*)(F.ws + WS_SELMASK))[(size_t)bg * SEQ + t]; unsigned x = mymask, y = mymask;
        x |= (unsigned)__shfl_xor((int)x, 1); x |= (unsigned)__shfl_xor((int)x, 2); x |= (unsigned)__shfl_xor((int)x, 4); x |= (unsigned)__shfl_xor((int)x, 8);
        y &= (unsigned)__shfl_xor((int)y, 1); y &= (unsigned)__shfl_xor((int)y, 2); y &= (unsigned)__shfl_xor((int)y, 4); y &= (unsigned)__shfl_xor((int)y, 8);
        tile_or = (unsigned)__builtin_amdgcn_readfirstlane((int)x); full = (unsigned)__builtin_amdgcn_readfirstlane((int)y) & ((1u << kb_hi) - 1u); }
    else { mymask = 0xffffffffu; const int lo = (t0 - 511) > 0 ? ((t0 - 511) >> 6) : 0; tile_or = 0u; full = 0u;
        for (int k = lo; k <= kb_hi; ++k) { tile_or |= (1u << k); if (k < kb_hi && 64 * k >= t0 - 496) full |= (1u << k); } }
    tile_or &= (kb_hi >= 31) ? 0xffffffffu : ((2u << kb_hi) - 1u);
    LAS unsigned* ctl = (LAS unsigned*)(F.lds + NSA_CTL);
    __syncthreads();
    if (F.lane == 0) ctl[F.wave] = tile_or;
    LDS_WAIT(); __syncthreads();
    unsigned rem = 0u;
#pragma unroll
    for (int w = 0; w < 8; ++w) rem |= ctl[w];
    rem = (unsigned)__builtin_amdgcn_readfirstlane((int)rem);
    bf16x8 qf[2][2];
#pragma unroll
    for (int r = 0; r < 2; ++r)
#pragma unroll
        for (int ks = 0; ks < 2; ++ks) { const v4u raw = *(const v4u*)(z + (size_t)m * NZ + ZC_Q + (h0 + r) * 64 + 8 * fq + 32 * ks); float f[8]; unpk8(raw, f);
            constexpr float QS = 0.125f * 1.4426950408889634f; v4u w; w.x = pk2(f[0] * QS, f[1] * QS); w.y = pk2(f[2] * QS, f[3] * QS); w.z = pk2(f[4] * QS, f[5] * QS); w.w = pk2(f[6] * QS, f[7] * QS);
            qf[r][ks] = __builtin_bit_cast(bf16x8, w); }
    NsaState St;
#pragma unroll
    for (int r = 0; r < 2; ++r) { St.mrun[r] = -1e30f; St.lrun[r] = 0.f;
#pragma unroll
        for (int dt = 0; dt < 4; ++dt) St.O[r][dt] = (f32x4){0.f, 0.f, 0.f, 0.f}; }
    const float slope0 = 1.4426950408889634f * __uint_as_float((unsigned)(127 - (h0 + 1)) << 23);
    const int srow = F.tid >> 3, sc = F.tid & 7;
    const bf16* ksrc = Kb + (size_t)srow * NZ + sc * 8; const bf16* vsrc = VT + (size_t)srow * SEQ + sc * 8;
    const int kdst = srow * NSA_KP + sc * 16, vdst = 64 * NSA_KP + srow * NSA_VP + sc * 16;
    const LAS unsigned char* kfr = F.lds + fr * NSA_KP + 16 * fq; const LAS unsigned char* vfr = F.lds + 64 * NSA_KP + fr * NSA_VP + 8 * fq;
    int kb = __builtin_ctz(rem); rem &= rem - 1u;
    v4u kreg = *(const v4u*)(ksrc + (size_t)64 * kb * NZ), vreg = *(const v4u*)(vsrc + 64 * kb);
    *(LAS v4u*)(F.lds + kdst) = kreg; *(LAS v2u*)(F.lds + vdst) = (v2u){vreg.x, vreg.y}; *(LAS v2u*)(F.lds + vdst + 8) = (v2u){vreg.z, vreg.w};
    LDS_WAIT(); __syncthreads();
    int buf = 0;
    for (;;) {
        int kbn = -1;
        if (rem) { kbn = __builtin_ctz(rem); rem &= rem - 1u; kreg = *(const v4u*)(ksrc + (size_t)64 * kbn * NZ); vreg = *(const v4u*)(vsrc + 64 * kbn); }
        __builtin_amdgcn_sched_barrier(0);
        if ((tile_or >> kb) & 1u) {
            if ((full >> kb) & 1u) nsa_block<WHICH, false>(St, kfr + buf * NSA_BUF, vfr + buf * NSA_BUF, qf, kb, mymask, t, fq, slope0);
            else nsa_block<WHICH, true>(St, kfr + buf * NSA_BUF, vfr + buf * NSA_BUF, qf, kb, mymask, t, fq, slope0);
        }
        __builtin_amdgcn_sched_barrier(0);
        if (kbn < 0) break;
        buf ^= 1;
        *(LAS v4u*)(F.lds + buf * NSA_BUF + kdst) = kreg; *(LAS v2u*)(F.lds + buf * NSA_BUF + vdst) = (v2u){vreg.x, vreg.y}; *(LAS v2u*)(F.lds + buf * NSA_BUF + vdst + 8) = (v2u){vreg.z, vreg.w};
        LDS_WAIT(); __syncthreads();
        kb = kbn;
    }
    const float* zg = (const float*)(F.ws + WS_ZGATE); const float* gb = F.ap->in[21];
    bf16* Y = (bf16*)(F.ws + WS_YB);
#pragma unroll
    for (int r = 0; r < 2; ++r) { float l = St.lrun[r]; l += __shfl_xor(l, 16); l += __shfl_xor(l, 32);
        const int hh = h0 + r; const float gate = sigmoidf_(zg[(size_t)m * 32 + hh * 3 + 1 + WHICH] + gb[hh * 3 + 1 + WHICH]); const float f = gate / l;
        if (WHICH == 1) {
#pragma unroll
            for (int dt = 0; dt < 4; ++dt) carry[r][dt] = pk4(St.O[r][dt] * f);
        } else {
            v2u yc[4];
#pragma unroll
            for (int dt = 0; dt < 4; ++dt) yc[dt] = *(const v2u*)(Y + (size_t)m * 512 + hh * 64 + 16 * dt + 4 * fq);
#pragma unroll
            for (int dt = 0; dt < 4; ++dt) *(v2u*)(Y + (size_t)m * 512 + hh * 64 + 16 * dt + 4 * fq) = pk4(unpk4(yc[dt]) + unpk4(pk4(St.O[r][dt] * f)) + unpk4(carry[r][dt]));
        } }
}
__device__ __forceinline__ void p4_phase(Frame& F) {
    for (int it = F.vcu; it < 256; it += F.G)
        for (int k = 0; k < 2; ++k) { const int item = k ? 511 - it : it; v2u carry[2][4]; nsa_wg_task<1>(F, item, carry); nsa_wg_task<0>(F, item, carry); }
}

typedef short v4i16_t __attribute__((ext_vector_type(4)));
__device__ __forceinline__ bf16x8 tr_lo(const LAS unsigned char* p) {
    const v4i16_t t = __builtin_amdgcn_ds_read_tr16_b64_v4i16((LAS v4i16_t*)p);
    return (bf16x8){t[0], t[1], t[2], t[3], 0, 0, 0, 0};
}
__device__ __forceinline__ bf16x8 lo4(v2u g) { v4u w; w.x = g.x; w.y = g.y; w.z = 0u; w.w = 0u; return __builtin_bit_cast(bf16x8, w); }
__device__ __forceinline__ bf16x8 cat8(v2u a, v2u b) { v4u w; w.x = a.x; w.y = a.y; w.z = b.x; w.w = b.y; return __builtin_bit_cast(bf16x8, w); }
struct ChunkOps { v2u pA[2][2], rA[2][2], g[4]; f32x4 ac[4]; bf16x8 aq[4], ak[4], bv; };
__device__ __forceinline__ void chunk_load(const LAS unsigned char* sl, ChunkOps& X, int lane) {
    const int fr = lane & 15, fq = lane >> 4;
#pragma unroll
    for (int m = 0; m < 2; ++m) { X.pA[m][0] = *(const LAS v2u*)(sl + CH_P + fr * CH_PP + 64 * m + 8 * fq); X.pA[m][1] = *(const LAS v2u*)(sl + CH_P + fr * CH_PP + 64 * m + 32 + 8 * fq);
        X.rA[m][0] = *(const LAS v2u*)(sl + CH_R + fr * CH_PP + 64 * m + 8 * fq); X.rA[m][1] = *(const LAS v2u*)(sl + CH_R + fr * CH_PP + 64 * m + 32 + 8 * fq); }
#pragma unroll
    for (int x = 0; x < 4; ++x) X.g[x] = *(const LAS v2u*)(sl + CH_G + 512 * x + (fr * 16 + 4 * fq) * 2);
    X.bv = tr_lo(sl + CH_V + 8 * lane);
#pragma unroll
    for (int jt = 0; jt < 4; ++jt) { X.aq[jt] = tr_lo(sl + CH_Q + jt * 512 + 8 * lane); X.ak[jt] = tr_lo(sl + CH_K + jt * 512 + 8 * lane);
        X.ac[jt] = *(const LAS f32x4*)(sl + CH_AC + (16 * jt + 4 * fq) * 4); }
}
__device__ __forceinline__ bf16x8 lo4t(bf16x8 t) { return t; }
__device__ __forceinline__ void chunk_math(const ChunkOps& X, f32x4 (&S)[4], f32x4& o_out) {
    bf16x8 bs[2];
#pragma unroll
    for (int m = 0; m < 2; ++m) { v4u w; w.x = pk2(S[2 * m][0], S[2 * m][1]); w.y = pk2(S[2 * m][2], S[2 * m][3]); w.z = pk2(S[2 * m + 1][0], S[2 * m + 1][1]); w.w = pk2(S[2 * m + 1][2], S[2 * m + 1][3]); bs[m] = __builtin_bit_cast(bf16x8, w); }
    const f32x4 z4 = (f32x4){0.f, 0.f, 0.f, 0.f};
    const bf16x8 bv = lo4t(X.bv);
    f32x4 y = MFMA16(cat8(X.pA[0][0], X.pA[0][1]), bs[0], z4); y = MFMA16(cat8(X.pA[1][0], X.pA[1][1]), bs[1], y); y = MFMA16(lo4(X.g[0]), bv, y);
    f32x4 o = MFMA16(cat8(X.rA[0][0], X.rA[0][1]), bs[0], z4); o = MFMA16(cat8(X.rA[1][0], X.rA[1][1]), bs[1], o); o = MFMA16(lo4(X.g[3]), bv, o);
    const bf16x8 by = lo4(pk4(y));
    const f32x4 u = MFMA16(lo4(X.g[1]), by, z4);
    const bf16x8 bu = lo4(pk4(u));
    o_out = MFMA16(lo4(X.g[2]), bu, o);
#pragma unroll
    for (int jt = 0; jt < 4; ++jt) { S[jt] = MFMA16(lo4t(X.aq[jt]), bu, S[jt]); S[jt] = MFMA16(lo4t(X.ak[jt]), bv, S[jt]); S[jt] = S[jt] * X.ac[jt]; }
}
#ifndef SC_CONVW
#define SC_CONVW 3
#endif
constexpr int SC_NS = 7, SC_AHEAD = 5, SC_CTL = SC_NS * CH_SLOT, SCAN_TR_OFF = 81920;
__device__ __forceinline__ void scan_dma(const unsigned char* rec, const bf16* vt, LAS unsigned char* slot, int lane) {
#pragma unroll
    for (int i = 0; i < 10; ++i) __builtin_amdgcn_global_load_lds((const unsigned*)(rec + (lane + 64 * i) * 16), (LAS unsigned*)(slot + i * 1024), 16, 0, 0);
    if (lane < 48) __builtin_amdgcn_global_load_lds((const unsigned*)(rec + (lane + 640) * 16), (LAS unsigned*)(slot + 10240), 16, 0, 0);
    if (lane < 32) __builtin_amdgcn_global_load_lds((const unsigned*)(vt + (size_t)(lane >> 1) * 512 + 8 * (lane & 1)), (LAS unsigned*)(slot + CH_V), 16, 0, 0);
}
__device__ __forceinline__ int sc_ld(LAS int* p) { int v; const unsigned a = (unsigned)(size_t)p; asm volatile("ds_read_b32 %0, %1\n\ts_waitcnt lgkmcnt(0)" : "=&v"(v) : "v"(a) : "memory"); return v; }
__device__ __forceinline__ void sc_st(LAS int* p, int v) { const unsigned a = (unsigned)(size_t)p; asm volatile("ds_write_b32 %0, %1" :: "v"(a), "v"(v) : "memory"); }
#define SC_LD(p) sc_ld(p)
#define SC_ST(p, v) sc_st((p), (v))
__device__ __forceinline__ void p5_scan(Frame& F, bool extras = true, int abl = 0) {
    LAS int* ctl = (LAS int*)(F.lds + SC_CTL);
    if (F.tid < 4) ctl[F.tid] = 0;
    LDS_WAIT(); __syncthreads();
    constexpr int NKQ = (tri::NITEMS - tri::E12) / 256;
    LAS float* mytile = (LAS float*)(F.lds + SCAN_TR_OFF + F.wave * 8448);
    const int bh = F.vcu >> 2, b = bh >> 3, h = bh & 7, i0 = (F.vcu & 3) * 16;
    if (F.wave == 0) {
        if (abl & 1) return;
        __builtin_amdgcn_s_setprio(3);
        float* o0 = (float*)(F.ws + WS_XN) + (size_t)b * SEQ * 512 + h * 64 + i0;
        const int fr = F.lane & 15, fq = F.lane >> 4;
        f32x4 S[4];
#pragma unroll
        for (int jt = 0; jt < 4; ++jt) S[jt] = (f32x4){0.f, 0.f, 0.f, 0.f};
        ChunkOps XA, XB;
        while (SC_LD(&ctl[0]) <= 0) __builtin_amdgcn_s_sleep(1);
        asm volatile("" ::: "memory");
        chunk_load(F.lds, XA, F.lane);
        LDS_WAIT(); asm volatile("" ::: "memory");
        if (F.lane == 0) SC_ST(&ctl[1], 1);
#define SCAN_ITER(XC, XN_, c_) do { const int cc = (c_); \
            if (cc + 1 < 128) { while (SC_LD(&ctl[0]) <= cc + 1) __builtin_amdgcn_s_sleep(1); asm volatile("" ::: "memory"); chunk_load(F.lds + ((cc + 1) % SC_NS) * CH_SLOT, XN_, F.lane); } \
            __builtin_amdgcn_sched_barrier(0); \
            f32x4 o; chunk_math(XC, S, o); \
            __builtin_amdgcn_sched_barrier(0); \
            float* orow = o0 + (size_t)cc * 16 * 512; \
            _Pragma("unroll") for (int rg = 0; rg < 4; ++rg) { float* pp = orow + (size_t)(4 * fq + rg) * 512 + fr; const float vv = o[rg]; asm volatile("global_store_dword %0, %1, off" :: "v"(pp), "v"(vv) : "memory"); } \
            if (cc + 1 < 128) { LDS_WAIT(); asm volatile("" ::: "memory"); if (F.lane == 0) SC_ST(&ctl[1], cc + 2); } } while (0)
#pragma unroll 1
        for (int c = 0; c < 128; c += 2) { SCAN_ITER(XA, XB, c); SCAN_ITER(XB, XA, c + 1); }
#undef SCAN_ITER
        asm volatile("s_waitcnt vmcnt(0)" ::: "memory");
        __builtin_amdgcn_s_setprio(0);
        if (F.lane == 0) SC_ST(&ctl[3], 1);
        if (!(abl & 2)) tr_run_q(F, mytile, &ctl[2], tri::E12 + F.vcu, F.G, NKQ);
    } else if (F.wave == 1) {
        if (abl & 1) return;
        const unsigned char* rec0 = F.ws + WS_S + ((size_t)(b * 128) * 8 + h) * CH_REC;
        const bf16* vt0 = (const bf16*)F.out + (size_t)b * SEQ * 512 + h * 64 + i0;
        for (int n = 0; n < 128; ++n) {
            while (SC_LD(&ctl[1]) < n - SC_NS + 1) __builtin_amdgcn_s_sleep(1);
            asm volatile("" ::: "memory");
            scan_dma(rec0 + (size_t)n * 8 * CH_REC, vt0 + (size_t)n * 16 * 512, F.lds + (n % SC_NS) * CH_SLOT, F.lane);
            if (n >= SC_AHEAD) { asm volatile("s_waitcnt vmcnt(60)" ::: "memory"); if (F.lane == 0) SC_ST(&ctl[0], n - SC_AHEAD + 1); }
        }
        asm volatile("s_waitcnt vmcnt(48)" ::: "memory"); if (F.lane == 0) SC_ST(&ctl[0], 124);
        asm volatile("s_waitcnt vmcnt(36)" ::: "memory"); if (F.lane == 0) SC_ST(&ctl[0], 125);
        asm volatile("s_waitcnt vmcnt(24)" ::: "memory"); if (F.lane == 0) SC_ST(&ctl[0], 126);
        asm volatile("s_waitcnt vmcnt(12)" ::: "memory"); if (F.lane == 0) SC_ST(&ctl[0], 127);
        asm volatile("s_waitcnt vmcnt(0)" ::: "memory"); if (F.lane == 0) SC_ST(&ctl[0], 128);
        if (!(abl & 2)) { while (SC_LD(&ctl[3]) == 0) __builtin_amdgcn_s_sleep(8); tr_run_q(F, mytile, &ctl[2], tri::E12 + F.vcu, F.G, NKQ); }
    } else {
        const int w2 = F.vcu * 6 + (F.wave - 2), NW2 = F.G * 6;
        if (!(abl & 2) && F.wave - 2 < SC_CONVW) tr_run_q(F, mytile, &ctl[2], tri::E12 + F.vcu, F.G, NKQ);
        if (!extras) return;
        const float* p = F.ap->in[1]; bf16* PB = (bf16*)(F.ws + WS_PBF);
        constexpr size_t NV = (size_t)M * 256 / 4;
        for (size_t b0 = (size_t)w2 * 64 + F.lane; b0 < NV; b0 += (size_t)8 * NW2 * 64) {
            f32x4 pv[8];
#pragma unroll
            for (int i = 0; i < 8; ++i) { const size_t idx = b0 + (size_t)i * NW2 * 64; pv[i] = (idx < NV) ? *(const f32x4*)(p + idx * 4) : (f32x4){0.f, 0.f, 0.f, 0.f}; }
#pragma unroll
            for (int i = 0; i < 8; ++i) { const size_t idx = b0 + (size_t)i * NW2 * 64; if (idx < NV) *(v2u*)(PB + idx * 4) = pk4(pv[i]); } }
        if (!(abl & 2) && F.wave - 2 >= SC_CONVW) { while (SC_LD(&ctl[3]) == 0) __builtin_amdgcn_s_sleep(8); tr_run_q(F, mytile, &ctl[2], tri::E12 + F.vcu, F.G, NKQ); }
    }
}

struct P6Par { float lw[8], lb[8]; };
__device__ __forceinline__ void p6_rows2(Frame& F, int ma, int mb_, const P6Par& P) {
    const int l = F.lane, c = 8 * l, h = l >> 3;
    f32x4 oa[2][2]; v4u vv_[2], gg_[2]; float bsv[2];
#pragma unroll
    for (int u = 0; u < 2; ++u) { const int m = u ? mb_ : ma;
        const float* oraw = (const float*)(F.ws + WS_XN) + (size_t)m * 512 + c;
        oa[u][0] = *(const f32x4*)oraw; oa[u][1] = *(const f32x4*)(oraw + 4); bsv[u] = ((const float*)(F.ws + WS_BONUS))[(size_t)m * 8 + h];
        vv_[u] = *(const v4u*)((const bf16*)F.out + (size_t)m * 512 + c); gg_[u] = *(const v4u*)((const bf16*)(F.ws + WS_G) + (size_t)m * 512 + c);
    }
    __builtin_amdgcn_sched_barrier(0);
#pragma unroll
    for (int u = 0; u < 2; ++u) { const int m = u ? mb_ : ma;
        float o[8] = {oa[u][0].x, oa[u][0].y, oa[u][0].z, oa[u][0].w, oa[u][1].x, oa[u][1].y, oa[u][1].z, oa[u][1].w};
        float s = 0.f;
#pragma unroll
        for (int j = 0; j < 8; ++j) s += o[j];
        s += __shfl_xor(s, 1); s += __shfl_xor(s, 2); s += __shfl_xor(s, 4);
        const float mu = s * (1.f / 64.f); float q = 0.f;
#pragma unroll
        for (int j = 0; j < 8; ++j) { o[j] -= mu; q += o[j] * o[j]; }
        q += __shfl_xor(q, 1); q += __shfl_xor(q, 2); q += __shfl_xor(q, 4);
        const float rstd = 1.0f / sqrtf(q * (1.f / 64.f) + GN_EPS);
        float vv[8], gg[8];
        unpk8(vv_[u], vv); unpk8(gg_[u], gg);
        const float bs = bsv[u];
        float y[8];
#pragma unroll
        for (int j = 0; j < 8; ++j) y[j] = (o[j] * rstd * P.lw[j] + P.lb[j] + bs * vv[j]) * gg[j];
        v4u w; w.x = pk2(y[0], y[1]); w.y = pk2(y[2], y[3]); w.z = pk2(y[4], y[5]); w.w = pk2(y[6], y[7]);
        *(v4u*)((bf16*)(F.ws + WS_YRW) + (size_t)m * 512 + c) = w;
    }
}
__device__ __forceinline__ void p6_phase(Frame& F) {
    const int l = F.lane, c = 8 * l;
    P6Par P;
#pragma unroll
    for (int j = 0; j < 8; ++j) { P.lw[j] = F.ap->in[13][c + j]; P.lb[j] = F.ap->in[14][c + j]; }
    for (int m = F.gw; m < M; m += 2 * F.NGW) p6_rows2(F, m, m + F.NGW, P);
}

__device__ __forceinline__ void p9b_decide(Frame& F, int base, const LAS float* LG) {
        const int tok = base + F.lane;
        const LAS float* lgp = LG + F.lane * 48;
        float lg[36];
#pragma unroll
        for (int q = 0; q < 9; ++q) { const f32x4 v = *(const LAS f32x4*)(lgp + 4 * q); lg[4 * q] = v.x; lg[4 * q + 1] = v.y; lg[4 * q + 2] = v.z; lg[4 * q + 3] = v.w; }
        const float* bg = F.ap->in[27]; const float* br = F.ap->in[29];
        float gl[4]; int gs = 0; float gm = -3.0e38f;
#pragma unroll
        for (int c = 0; c < 4; ++c) { gl[c] = lg[c] + bg[c]; if (gl[c] > gm) { gm = gl[c]; gs = c; } }
        float gsum = 0.f;
#pragma unroll
        for (int c = 0; c < 4; ++c) gsum += __expf(gl[c] - gm);
        const float pgroup = 1.0f / gsum;
        float el[8]; float em = -3.0e38f;
#pragma unroll
        for (int c = 0; c < 8; ++c) { const float lv = gs == 0 ? lg[4 + c] : (gs == 1 ? lg[12 + c] : (gs == 2 ? lg[20 + c] : lg[28 + c])); el[c] = lv + br[gs * 8 + c]; em = fmaxf(em, el[c]); }
        int i1 = 0; float v1 = -3.0e38f;
#pragma unroll
        for (int c = 0; c < 8; ++c) if (el[c] > v1) { v1 = el[c]; i1 = c; }
        int i2 = 0; float v2 = -3.0e38f;
#pragma unroll
        for (int c = 0; c < 8; ++c) if (c != i1 && el[c] > v2) { v2 = el[c]; i2 = c; }
        const float p1 = __expf(v1 - em), p2 = __expf(v2 - em);
        const float g1 = pgroup * p1 / (p1 + p2), g2 = pgroup * p2 / (p1 + p2);
        const int e1 = gs * 8 + i1, e2 = gs * 8 + i2;
        const unsigned long long lt = (1ull << F.lane) - 1ull;
        int r1 = 0, r2 = 0, mycnt = 0;
        for (int e = 0; e < 32; ++e) {
            const unsigned long long m1 = __ballot(e1 == e), m2 = __ballot(e2 == e);
            const int c1 = __popcll(m1), c2 = __popcll(m2);
            if (e1 == e) r1 = __popcll(m1 & lt);
            if (e2 == e) r2 = c1 + __popcll(m2 & lt);
            if (F.lane == e) mycnt = c1 + c2;
        }
        unsigned* cnt = (unsigned*)(F.ws + WS_CTL) + CW_CNT; int* list = (int*)(F.ws + WS_LIST); float* gateA = (float*)(F.ws + WS_GATEA); unsigned* slotA = (unsigned*)(F.ws + WS_SLOTA);
        int bs = 0;
        if (F.lane < 32 && mycnt > 0) bs = (int)atomicAdd(&cnt[F.lane], (unsigned)mycnt);
        const unsigned q1 = (unsigned)(__shfl(bs, e1) + r1), q2 = (unsigned)(__shfl(bs, e2) + r2);
        gateA[tok * 2 + 0] = g1; gateA[tok * 2 + 1] = g2;
        list[(size_t)e1 * 16384 + q1] = tok * 2 + 0; slotA[tok * 2 + 0] = ((unsigned)e1 << 16) | q1;
        list[(size_t)e2 * 16384 + q2] = tok * 2 + 1; slotA[tok * 2 + 1] = ((unsigned)e2 << 16) | q2;
}
struct RouteW { f32x4 wv[3][8]; };
__device__ __forceinline__ void route_ldx(Frame& F, int tile, v4u (&xv)[4]) {
    const int fr = F.lane & 15, fq = F.lane >> 4; const bf16* xp = (const bf16*)(F.ws + WS_XN) + (size_t)(tile * 16 + fr) * D + F.wave * 128 + 8 * fq;
#pragma unroll
    for (int g = 0; g < 4; ++g) xv[g] = *(const v4u*)(xp + 32 * g);
}
__device__ __forceinline__ void route_tile(Frame& F, int tile, const RouteW& W, const v4u (&xv_)[4], int par, LAS float* LG) {
    const int fr = F.lane & 15, fq = F.lane >> 4, m0 = tile * 16;
    f32x4 acc[3] = {(f32x4){0.f, 0.f, 0.f, 0.f}, (f32x4){0.f, 0.f, 0.f, 0.f}, (f32x4){0.f, 0.f, 0.f, 0.f}};
    float ssq = 0.f;
#pragma unroll
    for (int g2 = 0; g2 < 4; ++g2) {
        float xf[8]; unpk8(xv_[g2], xf);
#pragma unroll
        for (int hh = 0; hh < 2; ++hh) { const int g = 2 * g2 + hh;
            ssq += (xf[4 * hh] * xf[4 * hh] + xf[4 * hh + 1] * xf[4 * hh + 1]) + (xf[4 * hh + 2] * xf[4 * hh + 2] + xf[4 * hh + 3] * xf[4 * hh + 3]);
#pragma unroll
            for (int s = 0; s < 4; ++s)
#pragma unroll
                for (int ct = 0; ct < 3; ++ct) acc[ct] = __builtin_amdgcn_mfma_f32_16x16x4f32(W.wv[ct][g][s], xf[4 * hh + s], acc[ct], 0, 0, 0); }
    }
    ssq += __shfl_xor(ssq, 16); ssq += __shfl_xor(ssq, 32);
    LAS float* red = (LAS float*)(F.lds + par * 32768);
    LAS float* ssqb = red + 8 * 3 * 64 * 4; LAS float* rsb = ssqb + 128;
#pragma unroll
    for (int ct = 0; ct < 3; ++ct) *(LAS f32x4*)(red + ((F.wave * 3 + ct) * 64 + F.lane) * 4) = acc[ct];
    if (fq == 0) ssqb[F.wave * 16 + fr] = ssq;
    LDS_WAIT(); __syncthreads();
    if (F.wave == 0) { float st = 0.f;
#pragma unroll
      for (int w = 0; w < 8; ++w) st += ssqb[w * 16 + (F.lane & 15)];
      const float rs = 1.0f / sqrtf(st * (1.f / D) + NORM_EPS);
      if (fq == 0) ((float*)(F.ws + WS_RSE))[m0 + fr] = rs;
#pragma unroll
      for (int ct = 0; ct < 3; ++ct) { f32x4 t = (f32x4){0.f, 0.f, 0.f, 0.f};
#pragma unroll
          for (int w = 0; w < 8; ++w) t = t + *(const LAS f32x4*)(red + ((w * 3 + ct) * 64 + F.lane) * 4);
          *(LAS f32x4*)(LG + fr * 48 + 16 * ct + 4 * fq) = t * rs; } }
}
__device__ __forceinline__ void p9_phase(Frame& F, int rep_ = 0) {
    const int fr = F.lane & 15, fq = F.lane >> 4;
    RouteW W;
    { const float* wp = (const float*)(F.ws + WS_SMALLW + SW_ROUTEW) + (size_t)fr * D + F.wave * 128 + 8 * fq;
#pragma unroll
      for (int ct = 0; ct < 3; ++ct)
#pragma unroll
          for (int g = 0; g < 8; ++g) W.wv[ct][g] = *(const f32x4*)(wp + (size_t)ct * 16 * D + 32 * (g >> 1) + 4 * (g & 1)); }
    LAS float* LGb = (LAS float*)(F.lds + 65536);
    v4u xa[4], xb[4];
    int par = 0;
    if (F.vcu < 256) route_ldx(F, 4 * F.vcu, xa);
    for (int grp = F.vcu; grp < 256; grp += F.G) {
#pragma unroll 1
        for (int i = 0; i < 4; ++i) {
            const int tile = 4 * grp + i, nt = (i < 3) ? tile + 1 : 4 * (grp + F.G);
            if (nt < 1024) route_ldx(F, nt, xb);
            __builtin_amdgcn_sched_barrier(0);
            route_tile(F, tile, W, xa, par, LGb + i * 16 * 48);
#pragma unroll
            for (int g = 0; g < 4; ++g) xa[g] = xb[g];
            par ^= 1;
        }
        if (F.wave == 0) { LDS_WAIT(); p9b_decide(F, grp * 64, LGb); }
    }
}

__device__ __forceinline__ void p12_rows2(Frame& F, int ma, int mb_, int prelane) {
    const unsigned* slotA = (const unsigned*)(F.ws + WS_SLOTA); const float* gateA = (const float*)(F.ws + WS_GATEA);
    unsigned sl[2][2]; float gt[2][2];
#pragma unroll
    for (int u = 0; u < 2; ++u) { const int m = u ? mb_ : ma; sl[u][0] = slotA[2 * m]; sl[u][1] = slotA[2 * m + 1]; gt[u][0] = gateA[2 * m]; gt[u][1] = gateA[2 * m + 1]; }
    f32x4 xv[2][4]; v2u cv[2][2][4]; float se[2];
#pragma unroll
    for (int u = 0; u < 2; ++u) { const int m = u ? mb_ : ma;
        const bf16* x1 = (const bf16*)(F.ws + WS_XN) + (size_t)m * D;
        se[u] = (F.lane < 16) ? ((const float*)(F.ws + WS_ZGATE + 1 * MiB))[(size_t)m * 16 + F.lane] : 0.f;
#pragma unroll
        for (int j = 0; j < 4; ++j) { const int o = 4 * F.lane + 256 * j; xv[u][j] = unpk4(*(const v2u*)(x1 + o)); }
#pragma unroll
        for (int k = 0; k < 2; ++k) { const unsigned s = (unsigned)__builtin_amdgcn_readfirstlane((int)sl[u][k]); const int pre = __builtin_amdgcn_readlane(prelane, (int)(s >> 16));
            const bf16* cp = (const bf16*)(F.ws + WS_Z + 64 * MiB) + ((size_t)pre * 256 + (s & 0xffffu)) * D;
#pragma unroll
            for (int j = 0; j < 4; ++j) cv[u][k][j] = *(const v2u*)(cp + 4 * F.lane + 256 * j); } }
    __builtin_amdgcn_sched_barrier(0);
    float s2[2];
#pragma unroll
    for (int u = 0; u < 2; ++u) { s2[u] = 0.f;
#pragma unroll
        for (int j = 0; j < 4; ++j) { xv[u][j] = xv[u][j] + unpk4(cv[u][0][j]) * gt[u][0] + unpk4(cv[u][1][j]) * gt[u][1];
            s2[u] += (xv[u][j].x * xv[u][j].x + xv[u][j].y * xv[u][j].y) + (xv[u][j].z * xv[u][j].z + xv[u][j].w * xv[u][j].w);
        } }
#pragma unroll
    for (int o = 1; o < 64; o <<= 1) {
#pragma unroll
        for (int u = 0; u < 2; ++u) { s2[u] += __shfl_xor(s2[u], o); se[u] += __shfl_xor(se[u], o); } }
#pragma unroll
    for (int u = 0; u < 2; ++u) { const int m = u ? mb_ : ma;
        const float rs = 1.0f / sqrtf(s2[u] * (1.f / D) + NORM_EPS); const float rse = 1.0f / sqrtf(se[u] * (1.f / D) + NORM_EPS);
        bf16* x2 = (bf16*)(F.ws + WS_S) + (size_t)m * D; if (F.lane == 0) { ((float*)(F.ws + WS_RSE))[M + m] = rs; ((float*)(F.ws + WS_RSE))[2 * M + m] = rse; }
#pragma unroll
        for (int j = 0; j < 4; ++j) { const int o = 4 * F.lane + 256 * j; *(v2u*)(x2 + o) = pk4(xv[u][j]); }
    }
}
__device__ __forceinline__ void p12_phase(Frame& F) {
    const unsigned* cnt = (const unsigned*)(F.ws + WS_CTL) + CW_CNT;
    int nt = (F.lane < 32) ? (((int)cnt[F.lane & 31] + 255) >> 8) : 0;
    int incl = nt;
#pragma unroll
    for (int o = 1; o < 32; o <<= 1) { const int v = __shfl_up(incl, o); if (F.lane >= o) incl += v; }
    const int prelane = incl - nt;
    for (int m = F.gw; m < M; m += 2 * F.NGW) p12_rows2(F, m, m + F.NGW, prelane);
}
__device__ __forceinline__ void p14_rows4(Frame& F, int mb) {
    const float* gf = F.ap->in[36];
    f32x4 v[4][4]; float s[4];
#pragma unroll
    for (int u = 0; u < 4; ++u) { const bf16* xr = (const bf16*)(F.ws + WS_Z) + (size_t)(mb + u * F.NGW) * D;
#pragma unroll
        for (int j = 0; j < 4; ++j) v[u][j] = unpk4(*(const v2u*)(xr + 4 * F.lane + 256 * j)); }
#pragma unroll
    for (int u = 0; u < 4; ++u) { s[u] = 0.f;
#pragma unroll
        for (int j = 0; j < 4; ++j) s[u] += (v[u][j].x * v[u][j].x + v[u][j].y * v[u][j].y) + (v[u][j].z * v[u][j].z + v[u][j].w * v[u][j].w); }
#pragma unroll
    for (int o = 1; o < 64; o <<= 1) {
#pragma unroll
        for (int u = 0; u < 4; ++u) s[u] += __shfl_xor(s[u], o); }
#pragma unroll
    for (int u = 0; u < 4; ++u) { const float rs = 1.0f / sqrtf(s[u] * (1.f / D) + NORM_EPS); float* orow = F.out + (size_t)(mb + u * F.NGW) * D;
#pragma unroll
        for (int j = 0; j < 4; ++j) { const int o = 4 * F.lane + 256 * j; *(f32x4*)(orow + o) = v[u][j] * rs * *(const f32x4*)(gf + o); } }
}

#ifndef MK_ONE_LAUNCH
#define MK_ONE_LAUNCH 1
#endif
constexpr int N_PHASES = 14;
__global__ void __launch_bounds__(NWAVES * 64, 2) mk_fwd(Args args) {
    extern __shared__ __attribute__((aligned(16))) unsigned char lds[];
    Frame F;
    F.lds = (LAS unsigned char*)lds;
    F.tid = threadIdx.x; F.lane = F.tid & 63; F.wave = __builtin_amdgcn_readfirstlane(F.tid >> 6);
    F.G = gridDim.x; { const int bx = blockIdx.x; F.vcu = (F.G % 8 == 0) ? (bx % 8) * (F.G / 8) + bx / 8 : bx; }
    F.gw = F.vcu * NWAVES + F.wave; F.NGW = F.G * NWAVES;
    F.ws = args.ws; F.out = args.out;
    F.ap = (ArgsP)__builtin_amdgcn_kernarg_segment_ptr();
    unsigned char* ws = args.ws;
    const int lo = args.ph_lo, hi = args.ph_hi;
#ifdef ONLY
#define IN(k) ((k) == ONLY && lo <= (k) && (k) < hi)
#else
#define IN(k) (lo <= (k) && (k) < hi)
#endif
#if MK_ONE_LAUNCH
    if (F.tid < 16) ((LAS unsigned*)(F.lds + MISC_OFF))[F.tid] = 0u;
    __syncthreads();
    XcdBarrier bar = xcd_barrier_post((unsigned*)(ws + WS_CTL) + CW_BAR, (volatile LAS unsigned*)(F.lds + MISC_OFF));
#define GRID_BAR(k) do { if (IN(k) && IN((k) + 1)) xcd_barrier(bar); } while (0)
    cg::this_grid().sync();
#else
#define GRID_BAR(k) do { } while (0)
#endif
    LAS unsigned char* L = F.lds;
#ifdef PROBE_A
    unsigned long long* tsb = (unsigned long long*)(ws + WS_CTL + 32768);
    int n_st = 0;
#define STAMP() do { if (blockIdx.x == 0 && F.tid == 0) tsb[n_st] = __builtin_amdgcn_s_memrealtime(); ++n_st; } while (0)
    STAMP();
#else
#define STAMP() do { } while (0)
#endif
    const bf16* z = (const bf16*)(ws + WS_Z);

    if (IN(0)) { p0_prologue(F); } GRID_BAR(0); STAMP();

    if (IN(1)) {
        pg8::Gemm g{(const bf16*)(ws + WS_XN), (const bf16*)(ws + WS_WIN), M, NZ, D, nullptr}; pg8::StaticOrder S; S.init(M, NZ, F.G, (int)blockIdx.x);
        EpiStoreBf16 E{(bf16*)(ws + WS_Z), NZ};
        pg8::gemm_phase<EpiStoreBf16, pg8::StaticOrder, true, false>(L, g, S, E);
    } GRID_BAR(1); STAMP();

    if (IN(2)) { p2_prep(F); } GRID_BAR(2); STAMP();
    if (IN(3)) { p3_phase(F); } GRID_BAR(3); STAMP();
    if (IN(4)) { p4_phase(F); } GRID_BAR(4); STAMP();
    if (IN(5)) { if (F.G == 256) p5_scan(F); } GRID_BAR(5); STAMP();
    if (IN(6)) { p6_phase(F); } GRID_BAR(6); STAMP();

    if (IN(7)) {
        pg8::Gemm g{(const bf16*)(ws + WS_YRW), (const bf16*)(ws + WS_UR), 2 * M, 2 * D, 512, nullptr}; DualOrder S; S.S.init(M, D, F.G, (int)blockIdx.x);
        EpiMix2 E{z, (bf16*)(ws + WS_S + 64 * MiB), (unsigned*)(ws + WS_CTL) + CW_DEP2};
        pg8::gemm_phase<EpiMix2, DualOrder, true, false>(L, g, S, E);
    } STAMP();

    if (IN(8)) {
        pg8::Gemm g{(const bf16*)(ws + WS_S + 64 * MiB), (const bf16*)(ws + WS_WO), M, D, D, nullptr}; StaticOrderDep S; S.S.init(M, D, F.G, (int)blockIdx.x); S.dep = (const unsigned*)(ws + WS_CTL) + CW_DEP2;
        EpiResBf16 E{F.ap->in[0], (bf16*)(ws + WS_XN)};
        pg8::gemm_phase<EpiResBf16, StaticOrderDep, true, false>(L, g, S, E);
    } GRID_BAR(8); STAMP();

    if (IN(9)) { p9_phase(F); } GRID_BAR(9); STAMP();

    if (IN(10)) {
        pg8::Gemm g{(const bf16*)(ws + WS_XN), (const bf16*)(ws + WS_WGU), M, 1024, D, (const int*)(ws + WS_LIST), (const float*)(ws + WS_RSE)};
        pg8::moe_fill_tab((LAS int*)(F.lds + MISC_OFF - 256), (const unsigned*)(ws + WS_CTL) + CW_CNT); LDS_WAIT(); __syncthreads();
        pg8::MoeOrder S{(const LAS int*)(F.lds + MISC_OFF - 256), F.G, F.vcu, false, 0, nullptr};
        EpiMoe1 E{(bf16*)(ws + WS_S), (const LAS float*)(F.lds + pg8::STAGE_BYTES + 4096), (unsigned*)(ws + WS_CTL) + CW_DEP};
        pg8::gemm_phase<EpiMoe1, pg8::MoeOrder, true, true>(L, g, S, E);
    } STAMP();

    if (IN(11)) {
#ifndef NO_MOE2
        { pg8::Gemm g{(const bf16*)(ws + WS_S), (const bf16*)(ws + WS_WD), M, 1024, 512, nullptr};
          pg8::moe_fill_tab((LAS int*)(F.lds + MISC_OFF - 256), (const unsigned*)(ws + WS_CTL) + CW_CNT); LDS_WAIT(); __syncthreads();
          const LAS int* tb = (const LAS int*)(F.lds + MISC_OFF - 256); const int n10 = 4 * (tb[31] + ((tb[63] + 255) >> 8));
          pg8::MoeOrderT<true> S{tb, F.G, F.vcu, true, n10 % F.G, (const unsigned*)(ws + WS_CTL) + CW_DEP};
          EpiStoreBf16 E{(bf16*)(ws + WS_Z + 64 * MiB), D};
          pg8::gemm_phase<EpiStoreBf16, pg8::MoeOrderT<true>, true, false>(L, g, S, E); }
#endif
        { pg8::Gemm g2{(const bf16*)(ws + WS_PBF), (const bf16*)(ws + WS_WPP), M, D, 256, nullptr}; ErawOrder S2; S2.S.init(M, D, F.G, 0); S2.c = (int)blockIdx.x; S2.G = F.G;
          S2.nheavy = 0;
          EpiStoreSsq E2{(bf16*)(ws + WS_S + 64 * MiB), D, (float*)(ws + WS_ZGATE + 1 * MiB)};
          pg8::gemm_phase<EpiStoreSsq, ErawOrder, true, false>(L, g2, S2, E2); }
    } GRID_BAR(11); STAMP();

    if (IN(12)) { p12_phase(F); } GRID_BAR(12); STAMP();

    if (IN(13)) {
        pg8::Gemm g{(const bf16*)(ws + WS_S), (const bf16*)(ws + WS_WPG), M, D, D, nullptr}; pg8::StaticOrder S; S.init(M, D, F.G, (int)blockIdx.x);
        EpiPleNorm E{(const bf16*)(ws + WS_S), (const bf16*)(ws + WS_S + 64 * MiB), (const float*)(ws + WS_RSE) + 2 * M, F.ap->in[33], (const float*)(ws + WS_RSE) + M, F.ap->in[36], F.out, (float*)(ws + WS_ZGATE), (unsigned*)(ws + WS_CTL) + CW_PANEL, (LAS float*)(F.lds + 131072)};
        pg8::gemm_phase<EpiPleNorm, pg8::StaticOrder, true, false>(L, g, S, E);
    } STAMP();

#ifdef PROBE_A
    xcd_barrier(bar); STAMP(); __threadfence();
    if (blockIdx.x == 0 && F.tid == 0) { __threadfence(); }
    xcd_barrier(bar);
    {
        volatile unsigned long long* tv = (volatile unsigned long long*)tsb;
        const float dA = (float)(tv[PROBE_A + 1] - tv[PROBE_A]) * 0.01f, dB = (float)(tv[PROBE_B + 1] - tv[PROBE_B]) * 0.01f;
        for (size_t i = (size_t)blockIdx.x * 512 + F.tid; i < (size_t)M * D; i += (size_t)F.G * 512) F.out[i] = 10.0f * dB;
        __syncthreads();
        if (blockIdx.x == 0 && F.tid == 0) F.out[0] = 300.0f * dA;
    }
#endif
#undef IN
#undef GRID_BAR
}

extern "C" void kernel_launch(void* const* d_in, const int* in_sizes, int n_in, void* d_out, int out_size, void* d_ws, size_t ws_size, hipStream_t stream) {
    static int grid = 0;
    if (grid == 0) {
        if (n_in != 37 || out_size != M * D || ws_size < WS_END) { fprintf(stderr, "kernel_launch: unexpected problem (n_in %d, out %d, ws %zu < %zu); nothing launched\n", n_in, out_size, ws_size, (size_t)WS_END); grid = -1; return; }
        int dev = 0, cus = 0, per_cu = 0;
        if (hipGetDevice(&dev) != hipSuccess || hipDeviceGetAttribute(&cus, hipDeviceAttributeMultiprocessorCount, dev) != hipSuccess) { grid = -1; return; }
        if (hipFuncSetAttribute((const void*)mk_fwd, hipFuncAttributeMaxDynamicSharedMemorySize, LDS_BYTES) != hipSuccess) { fprintf(stderr, "kernel_launch: hipFuncSetAttribute failed\n"); grid = -1; return; }
        if (hipOccupancyMaxActiveBlocksPerMultiprocessor(&per_cu, (const void*)mk_fwd, NWAVES * 64, LDS_BYTES) != hipSuccess || per_cu < 1) { fprintf(stderr, "kernel_launch: occupancy query says %d blocks per CU\n", per_cu); (void)hipGetLastError(); grid = -1; return; }
        grid = cus;
        if (grid != 256) fprintf(stderr, "kernel_launch: %d CUs; this kernel is built for 256\n", grid);
    }
    if (grid < 0) return;
    (void)hipMemsetAsync((char*)d_ws + WS_CTL, 0, CTL_ZERO_BYTES, stream);
    Args a{};
    for (int i = 0; i < 37; ++i) a.in[i] = (const float*)d_in[i];
    a.out = (float*)d_out; a.ws = (unsigned char*)d_ws;
#if MK_ONE_LAUNCH
    a.ph_lo = 0; a.ph_hi = N_PHASES;
    void* kargs[] = {&a};
    hipError_t e = hipLaunchCooperativeKernel((const void*)mk_fwd, dim3(grid), dim3(NWAVES * 64), kargs, LDS_BYTES, stream);
    if (e != hipSuccess) fprintf(stderr, "kernel_launch: cooperative launch failed: %s (grid %d)\n", hipGetErrorString(e), grid);
#else
    for (int ph = 0; ph < N_PHASES; ++ph) { a.ph_lo = ph; a.ph_hi = ph + 1; hipLaunchKernelGGL(mk_fwd, dim3(grid), dim3(NWAVES * 64), LDS_BYTES, stream, a); }
#endif
}
```
